# Optimizing an MI355X kernel written in HIP

```python
import math
import jax
import jax.numpy as jnp
from jax import lax
import numpy as np

D_MODEL = 2048
BATCH = 4
SEQ = 4096
DEPTH = 2

GRID_W = 64
CTX_LEN = 256
MIX = D_MODEL
N_MIXERS = 4
BR = MIX // N_MIXERS
S5_GSIZE = 16
S5_GROUPS = BR // S5_GSIZE
S5_STATE = 64
HY_ORDER = 2
HY_EMB = 33
HY_BANDS = (HY_EMB - 1) // 2
HY_FFN = 64
HY_SHORT = 3
HY_FAST_DECAY = 0.3
HY_SLOW_DECAY = 1.5
HY_TARGET = 1e-2
RET_HEADS = 4
RET_DK = BR // RET_HEADS
RET_DV = BR // RET_HEADS
RET_CHUNK = 128
GLA_HEADS = 4
GLA_KW = BR // 2
GLA_DK = GLA_KW // GLA_HEADS
GLA_DV = BR // GLA_HEADS
GLA_LR = 16
GLA_TAU = 16.0
GLA_CHUNK = 64
ROPE_BASE = 10000.0
EPS = 1e-6

SEGMENTS = (
    ('s5_u', BR), ('s5_g', BR),
    ('hy_x', 3 * BR), ('hy_g', BR),
    ('ret_q', RET_HEADS * RET_DK), ('ret_k', RET_HEADS * RET_DK), ('ret_v', BR), ('ret_g', BR),
    ('gla_q', GLA_KW), ('gla_k', GLA_KW), ('gla_v', BR), ('gla_lr', 2 * GLA_LR), ('gla_g', BR),
)
SEG_NAMES = tuple(name for name, _ in SEGMENTS)
IN_W = sum(size for _, size in SEGMENTS)
CTX_STATE_SEGMENTS = ('s5_u', 'ret_k', 'ret_v', 'gla_k', 'gla_v', 'gla_lr')

kernel_name = 'hybrid_s5_hyena_retnet_gla_prefix_dit'

F32 = jnp.float32


def _rmsnorm(x, w):
    xf = x.astype(F32)
    y = xf * lax.rsqrt(jnp.mean(xf * xf, axis=-1, keepdims=True) + EPS)
    return (y * w.astype(F32)).astype(x.dtype)


def _project(h, w_in, names):
    blocks, sizes, off = [], [], 0
    for name, size in SEGMENTS:
        if name in names:
            blocks.append(w_in[:, off:off + size])
            sizes.append((name, size))
        off += size
    w = w_in if len(blocks) == len(SEGMENTS) else jnp.concatenate(blocks, axis=1)
    p = h @ w
    out, off = {}, 0
    for name, size in sizes:
        out[name] = p[..., off:off + size]
        off += size
    return out


def _heads(t, n):
    b, l, _ = t.shape
    return t.astype(F32).reshape(b, l, n, -1).transpose(0, 2, 1, 3)


def _merge_norm(o, w):
    o = o * lax.rsqrt(jnp.mean(o * o, axis=-1, keepdims=True) + EPS)
    b, h, l, d = o.shape
    return o.transpose(0, 2, 1, 3).reshape(b, l, h * d) * w.astype(F32)


def _rope(x, ang):
    cos, sin = jnp.cos(ang), jnp.sin(ang)
    x1, x2 = jnp.split(x, 2, axis=-1)
    return jnp.concatenate([x1 * cos - x2 * sin, x1 * sin + x2 * cos], axis=-1)


def _latent_angles(rows):
    half = RET_DK // 4
    inv = ROPE_BASE ** (-jnp.arange(half, dtype=F32) / half)
    r = jnp.repeat(jnp.arange(rows, dtype=F32), GRID_W)
    cl = jnp.tile(jnp.arange(GRID_W, dtype=F32), rows)
    return jnp.concatenate([r[:, None] * inv, cl[:, None] * inv], axis=-1)


def _ctx_angles(n_ctx):
    n = RET_DK // 2
    inv = ROPE_BASE ** (-jnp.arange(n, dtype=F32) / n)
    return jnp.arange(n_ctx, dtype=F32)[:, None] * inv


def _s5_discretize(a_re, a_im, log_dt):
    a_re, a_im = a_re.astype(F32), a_im.astype(F32)
    dt = jnp.exp(log_dt.astype(F32))[:, None]
    mag = jnp.exp(a_re * dt)
    ab_re, ab_im = mag * jnp.cos(a_im * dt), mag * jnp.sin(a_im * dt)
    den = a_re * a_re + a_im * a_im
    nr = ab_re - 1.0
    co_re = (nr * a_re + ab_im * a_im) / den
    co_im = (ab_im * a_re - nr * a_im) / den
    return ab_re, ab_im, co_re, co_im


def _cplx_combine(e1, e2):
    ar1, ai1, br1, bi1 = e1
    ar2, ai2, br2, bi2 = e2
    return (ar2 * ar1 - ai2 * ai1, ar2 * ai1 + ai2 * ar1,
            ar2 * br1 - ai2 * bi1 + br2, ar2 * bi1 + ai2 * br1 + bi2)


def _s5_scan(u, h0, disc, b_re, b_im):
    ab_re, ab_im, co_re, co_im = disc
    r_re = jnp.einsum('blgi,gpi->lbgp', u, b_re.astype(F32))
    r_im = jnp.einsum('blgi,gpi->lbgp', u, b_im.astype(F32))
    bu_re = co_re * r_re - co_im * r_im
    bu_im = co_re * r_im + co_im * r_re
    if h0 is not None:
        h0_re, h0_im = h0
        bu_re = bu_re.at[0].add(ab_re * h0_re - ab_im * h0_im)
        bu_im = bu_im.at[0].add(ab_re * h0_im + ab_im * h0_re)
    L = u.shape[1]
    a_re = jnp.broadcast_to(ab_re, (L, 1) + ab_re.shape)
    a_im = jnp.broadcast_to(ab_im, (L, 1) + ab_im.shape)
    _, _, h_re, h_im = lax.associative_scan(_cplx_combine, (a_re, a_im, bu_re, bu_im), axis=0)
    return h_re, h_im


def _s5_readout(h, c_re, c_im):
    h_re, h_im = h
    return (jnp.einsum('lbgp,gip->blgi', h_re, c_re)
            - jnp.einsum('lbgp,gip->blgi', h_im, c_im))


def _s5_mixer(u_c, u_l, a_re, a_im, log_dt, b_re, b_im, c_re, c_im, d_skip,
              glu_w, glu_b, ctx_out):
    bsz, l_lat, _ = u_l.shape
    l_ctx = u_c.shape[1]
    uc = u_c.astype(F32).reshape(bsz, l_ctx, S5_GROUPS, S5_GSIZE)
    ul = u_l.astype(F32).reshape(bsz, l_lat, S5_GROUPS, S5_GSIZE)
    dsk = d_skip.astype(F32).reshape(S5_GROUPS, S5_GSIZE)
    y_l = ul * dsk
    y_c = uc * dsk if ctx_out else None
    for dr in range(2):
        disc = _s5_discretize(a_re[dr], a_im[dr], log_dt[dr])
        cr, ci = c_re[dr].astype(F32), c_im[dr].astype(F32)
        flip = (lambda t: t[:, ::-1]) if dr == 1 else (lambda t: t)
        h_c = _s5_scan(flip(uc), None, disc, b_re[dr], b_im[dr])
        h_l = _s5_scan(flip(ul), (h_c[0][-1], h_c[1][-1]), disc, b_re[dr], b_im[dr])
        y_l = y_l + flip(_s5_readout(h_l, cr, ci))
        if ctx_out:
            y_c = y_c + flip(_s5_readout(h_c, cr, ci))

    def glu(y):
        g = jax.nn.gelu(y.reshape(y.shape[0], y.shape[1], BR))
        return g * jax.nn.sigmoid(g @ glu_w.astype(F32) + glu_b.astype(F32))

    return (glu(y_c) if ctx_out else None), glu(y_l)


def _short_conv(t, w, b):
    ch = t.shape[-1]
    y = lax.conv_general_dilated(
        t, w[:, None, :].astype(t.dtype), window_strides=(1,),
        padding=[(HY_SHORT // 2, HY_SHORT // 2)],
        dimension_numbers=('NWC', 'WIO', 'NWC'), feature_group_count=ch)
    return y + b.astype(t.dtype)


def _hyena_filters(L, w1, b1, f1, w2, b2, f2, w3, b3, f3, w4):
    t = jnp.linspace(0.0, 1.0, L, dtype=F32)[:, None]
    wpos = 2.0 * math.pi * jnp.arange(L, dtype=F32)[:, None] / L
    f = jnp.linspace(1e-4, HY_BANDS - 1, HY_BANDS, dtype=F32)[None, :]
    z = jnp.concatenate([t, jnp.cos(f * wpos), -jnp.sin(f * wpos)], axis=-1)
    h = jnp.sin(f1 * (z @ w1 + b1))
    h = jnp.sin(f2 * (h @ w2 + b2))
    h = jnp.sin(f3 * (h @ w3 + b3))
    h = (h @ w4).reshape(L, 2, HY_ORDER, BR)
    deltas = jnp.linspace(math.log(HY_TARGET) / HY_SLOW_DECAY,
                          math.log(HY_TARGET) / HY_FAST_DECAY, BR, dtype=F32)
    h = h * jnp.exp(-t * jnp.abs(deltas))[:, None, None, :]
    fwd, bwd = h[:, 0], h[:, 1]
    k = jnp.concatenate([fwd, jnp.zeros_like(fwd[:1]), bwd[:0:-1]], axis=0)
    return k * lax.rsqrt(jnp.sum(k * k, axis=0, keepdims=True) + EPS)


def _hyena_seq(xp, conv_w, conv_b, filt, bias):
    L = xp.shape[1]
    xs = _short_conv(xp, conv_w, conv_b).astype(F32)
    v, g1, g2 = jnp.split(xs, 3, axis=-1)
    kf = jnp.fft.rfft(_hyena_filters(L, *[p.astype(F32) for p in filt]), n=2 * L, axis=0)
    z = v
    for o, g in enumerate((g1, g2)):
        zf = jnp.fft.rfft(z, n=2 * L, axis=1)
        conv = jnp.fft.irfft(zf * kf[None, :, o], n=2 * L, axis=1)[:, :L]
        z = g * (conv + bias[o].astype(F32) * z)
    return z


def _retention_dir(q, k, v, s0, log_g, with_output):
    bsz, nh, L, dk = k.shape
    dv = v.shape[-1]
    C = min(RET_CHUNK, L)
    n = L // C
    k = k.reshape(bsz, nh, n, C, dk)
    v = v.reshape(bsz, nh, n, C, dv)
    idx = jnp.arange(C, dtype=F32)
    lg = log_g[:, None]
    kv = jnp.einsum('bhncd,bhnce->bhnde',
                    k * jnp.exp((C - 1 - idx) * lg)[None, :, None, :, None], v)
    decay_c = jnp.exp(C * log_g)[None, :, None, None]
    s_init = jnp.zeros((bsz, nh, dk, dv), F32) if s0 is None else s0

    def step(s, kv_c):
        return decay_c * s + kv_c, s

    s_fin, s_prev = lax.scan(step, s_init, jnp.moveaxis(kv, 2, 0))
    if not with_output:
        return None, s_fin
    s_prev = jnp.moveaxis(s_prev, 0, 2)
    q = q.reshape(bsz, nh, n, C, dk)
    rel = idx[:, None] - idx[None, :]
    dmask = jnp.where(rel >= 0, jnp.exp(jnp.maximum(rel, 0.0)[None] * log_g[:, None, None]), 0.0)
    att = jnp.einsum('bhncd,bhnjd->bhncj', q, k) * dmask[None, :, None]
    o = jnp.einsum('bhncj,bhnje->bhnce', att, v)
    o = o + jnp.einsum('bhncd,bhnde->bhnce',
                       q * jnp.exp((idx + 1.0) * lg)[None, :, None, :, None], s_prev)
    return o.reshape(bsz, nh, L, dv), s_fin


def _retention_mixer(pc, pl, ang_c, ang_l, norm_w, ctx_out):
    log_g = jnp.log(1.0 - 2.0 ** (-5.0 - jnp.arange(RET_HEADS, dtype=F32)))

    def prep(p, ang, with_q):
        k = _rope(_heads(p['ret_k'], RET_HEADS), ang) * RET_DK ** -0.5
        v = _heads(p['ret_v'], RET_HEADS)
        q = _rope(_heads(p['ret_q'], RET_HEADS), ang) if with_q else None
        return q, k, v

    rev = lambda t: None if t is None else t[:, :, ::-1]
    qc, kc, vc = prep(pc, ang_c, ctx_out)
    ql, kl, vl = prep(pl, ang_l, True)
    oc_f, sc_f = _retention_dir(qc, kc, vc, None, log_g, ctx_out)
    oc_b, sc_b = _retention_dir(rev(qc), rev(kc), rev(vc), None, log_g, ctx_out)
    ol_f, _ = _retention_dir(ql, kl, vl, sc_f, log_g, True)
    ol_b, _ = _retention_dir(rev(ql), rev(kl), rev(vl), sc_b, log_g, True)
    y_l = _merge_norm(ol_f + rev(ol_b), norm_w)
    y_c = _merge_norm(oc_f + rev(oc_b), norm_w) if ctx_out else None
    return y_c, y_l


def _gla_dir(q, k, v, log_a, s0, with_output):
    bsz, nh, L, dk = k.shape
    dv = v.shape[-1]
    C = min(GLA_CHUNK, L)
    n = L // C
    r = lambda t: t.reshape(bsz, nh, n, C, t.shape[-1])
    k, v, log_a = r(k), r(v), r(log_a)
    b = jnp.cumsum(log_a, axis=3)
    b_last = b[:, :, :, -1:]
    kv = jnp.einsum('bhncd,bhnce->bhnde', k * jnp.exp(b_last - b), v)
    s_init = jnp.zeros((bsz, nh, dk, dv), F32) if s0 is None else s0

    def step(s, inp):
        dec, kv_c = inp
        return dec[..., None] * s + kv_c, s

    s_fin, s_prev = lax.scan(step, s_init, (jnp.moveaxis(jnp.exp(b_last[:, :, :, 0]), 2, 0),
                                            jnp.moveaxis(kv, 2, 0)))
    if not with_output:
        return None, s_fin
    s_prev = jnp.moveaxis(s_prev, 0, 2)
    q = r(q)
    ref = b[:, :, :, C // 2 - 1:C // 2]
    att = jnp.einsum('bhncd,bhnjd->bhncj', q * jnp.exp(b - ref), k * jnp.exp(ref - b))
    lower = jnp.tril(jnp.ones((C, C), dtype=bool))
    att = jnp.where(lower, att, 0.0)
    o = (jnp.einsum('bhncj,bhnje->bhnce', att, v)
         + jnp.einsum('bhncd,bhnde->bhnce', q * jnp.exp(b), s_prev))
    return o.reshape(bsz, nh, L, dv), s_fin


def _gla_mixer(pc, pl, gate_w, gate_b, norm_w, ctx_out):
    def prep(p, with_q):
        k = _heads(p['gla_k'], GLA_HEADS)
        v = _heads(p['gla_v'], GLA_HEADS)
        q = _heads(p['gla_q'], GLA_HEADS) * GLA_DK ** -0.5 if with_q else None
        lr = p['gla_lr'].astype(F32)
        la = [_heads(jax.nn.log_sigmoid(lr[..., d * GLA_LR:(d + 1) * GLA_LR] @ gate_w[d].astype(F32)
                                        + gate_b[d].astype(F32)) / GLA_TAU, GLA_HEADS)
              for d in range(2)]
        return q, k, v, la

    rev = lambda t: None if t is None else t[:, :, ::-1]
    qc, kc, vc, lac = prep(pc, ctx_out)
    ql, kl, vl, lal = prep(pl, True)
    oc_f, sc_f = _gla_dir(qc, kc, vc, lac[0], None, ctx_out)
    oc_b, sc_b = _gla_dir(rev(qc), rev(kc), rev(vc), rev(lac[1]), None, ctx_out)
    ol_f, _ = _gla_dir(ql, kl, vl, lal[0], sc_f, True)
    ol_b, _ = _gla_dir(rev(ql), rev(kl), rev(vl), rev(lal[1]), sc_b, True)
    y_l = _merge_norm(ol_f + rev(ol_b), norm_w)
    y_c = _merge_norm(oc_f + rev(oc_b), norm_w) if ctx_out else None
    return y_c, y_l


def _merge_branches(p, ys, w_out):
    gated = [y * jax.nn.silu(p[g].astype(F32))
             for y, g in zip(ys, ('s5_g', 'hy_g', 'ret_g', 'gla_g'))]
    return jnp.concatenate(gated, axis=-1).astype(w_out.dtype) @ w_out


def setup_inputs(seed: int = 0) -> dict:
    key = jax.random.key(seed)
    ks = iter(jax.random.split(key, 40))
    nrm = lambda shape, scale: jax.random.normal(next(ks), shape, jnp.float32) * scale
    G, P, S = S5_GROUPS, S5_STATE, S5_GSIZE
    n_idx = jnp.arange(P, dtype=jnp.float32)
    return {
        'x': nrm((BATCH, SEQ, D_MODEL), 1.0),
        'c': nrm((BATCH, D_MODEL), 1.0),
        'ctx': nrm((BATCH, CTX_LEN, D_MODEL), 1.0),
        'c_ctx': nrm((D_MODEL,), 1.0),
        'norm_w': 1.0 + nrm((DEPTH, D_MODEL), 0.02),
        'ada_w': nrm((DEPTH, D_MODEL, 3 * D_MODEL), D_MODEL ** -0.5),
        'ada_b': nrm((DEPTH, 3 * D_MODEL), 0.02),
        'w_in': nrm((DEPTH, D_MODEL, IN_W), D_MODEL ** -0.5),
        'w_out': nrm((DEPTH, MIX, D_MODEL), MIX ** -0.5),
        's5_a_re': -0.5 + nrm((DEPTH, 2, G, P), 0.01),
        's5_a_im': math.pi * n_idx + nrm((DEPTH, 2, G, P), 0.01),
        's5_log_dt': jax.random.uniform(next(ks), (DEPTH, 2, G), jnp.float32,
                                        math.log(1e-3), math.log(1e-1)),
        's5_b_re': nrm((DEPTH, 2, G, P, S), (2 * S) ** -0.5),
        's5_b_im': nrm((DEPTH, 2, G, P, S), (2 * S) ** -0.5),
        's5_c_re': nrm((DEPTH, 2, G, S, P), 0.5),
        's5_c_im': nrm((DEPTH, 2, G, S, P), 0.5),
        's5_d': nrm((DEPTH, BR), 1.0),
        's5_glu_w': nrm((DEPTH, BR, BR), BR ** -0.5),
        's5_glu_b': nrm((DEPTH, BR), 0.02),
        'hy_conv_w': nrm((DEPTH, HY_SHORT, 3 * BR), HY_SHORT ** -0.5),
        'hy_conv_b': nrm((DEPTH, 3 * BR), 0.02),
        'hy_w1': nrm((DEPTH, HY_EMB, HY_FFN), HY_EMB ** -0.5),
        'hy_b1': nrm((DEPTH, HY_FFN), 0.1),
        'hy_f1': 1.0 + nrm((DEPTH, HY_FFN), 0.02),
        'hy_w2': nrm((DEPTH, HY_FFN, HY_FFN), HY_FFN ** -0.5),
        'hy_b2': nrm((DEPTH, HY_FFN), 0.1),
        'hy_f2': 1.0 + nrm((DEPTH, HY_FFN), 0.02),
        'hy_w3': nrm((DEPTH, HY_FFN, HY_FFN), HY_FFN ** -0.5),
        'hy_b3': nrm((DEPTH, HY_FFN), 0.1),
        'hy_f3': 1.0 + nrm((DEPTH, HY_FFN), 0.02),
        'hy_w4': nrm((DEPTH, HY_FFN, 2 * HY_ORDER * BR), HY_FFN ** -0.5),
        'hy_bias': nrm((DEPTH, HY_ORDER, BR), 0.5),
        'ret_norm_w': 1.0 + nrm((DEPTH, BR), 0.02),
        'gla_gate_w': nrm((DEPTH, 2, GLA_LR, GLA_KW), GLA_LR ** -0.5),
        'gla_gate_b': nrm((DEPTH, 2, GLA_KW), 0.1),
        'gla_norm_w': 1.0 + nrm((DEPTH, BR), 0.02),
        'final_norm_w': 1.0 + nrm((D_MODEL,), 0.02),
    }


def reference(x, c, ctx, c_ctx, norm_w, ada_w, ada_b, w_in, w_out,
              s5_a_re, s5_a_im, s5_log_dt, s5_b_re, s5_b_im, s5_c_re, s5_c_im,
              s5_d, s5_glu_w, s5_glu_b,
              hy_conv_w, hy_conv_b, hy_w1, hy_b1, hy_f1, hy_w2, hy_b2, hy_f2,
              hy_w3, hy_b3, hy_f3, hy_w4, hy_bias,
              ret_norm_w, gla_gate_w, gla_gate_b, gla_norm_w, final_norm_w):
    rows = x.shape[1] // GRID_W
    ang_l = _latent_angles(rows)
    ang_c = _ctx_angles(ctx.shape[1])
    x_l, x_c = x, ctx
    for i in range(DEPTH):
        ctx_out = i < DEPTH - 1
        mod_l = jax.nn.silu(c) @ ada_w[i] + ada_b[i]
        mod_c = jax.nn.silu(c_ctx) @ ada_w[i] + ada_b[i]
        sh_l, sc_l, gt_l = jnp.split(mod_l[:, None, :], 3, axis=-1)
        sh_c, sc_c, gt_c = jnp.split(mod_c, 3, axis=-1)
        h_l = _rmsnorm(x_l, norm_w[i]) * (1.0 + sc_l) + sh_l
        h_c = _rmsnorm(x_c, norm_w[i]) * (1.0 + sc_c) + sh_c
        pl = _project(h_l, w_in[i], SEG_NAMES)
        pc = _project(h_c, w_in[i], SEG_NAMES if ctx_out else CTX_STATE_SEGMENTS)

        s5_c, s5_l = _s5_mixer(pc['s5_u'], pl['s5_u'], s5_a_re[i], s5_a_im[i], s5_log_dt[i],
                               s5_b_re[i], s5_b_im[i], s5_c_re[i], s5_c_im[i], s5_d[i],
                               s5_glu_w[i], s5_glu_b[i], ctx_out)
        hy_filt = (hy_w1[i], hy_b1[i], hy_f1[i], hy_w2[i], hy_b2[i], hy_f2[i],
                   hy_w3[i], hy_b3[i], hy_f3[i], hy_w4[i])
        hy_l = _hyena_seq(pl['hy_x'], hy_conv_w[i], hy_conv_b[i], hy_filt, hy_bias[i])
        ret_c, ret_l = _retention_mixer(pc, pl, ang_c, ang_l, ret_norm_w[i], ctx_out)
        gla_c, gla_l = _gla_mixer(pc, pl, gla_gate_w[i], gla_gate_b[i], gla_norm_w[i], ctx_out)

        x_l = x_l + gt_l * _merge_branches(pl, (s5_l, hy_l, ret_l, gla_l), w_out[i])
        if ctx_out:
            hy_c = _hyena_seq(pc['hy_x'], hy_conv_w[i], hy_conv_b[i], hy_filt, hy_bias[i])
            x_c = x_c + gt_c * _merge_branches(pc, (s5_c, hy_c, ret_c, gla_c), w_out[i])
    return _rmsnorm(x_l, final_norm_w)
```

```cpp
#include <hip/hip_runtime.h>
#include <hip/hip_cooperative_groups.h>
#include <cstdio>
#include <cstdint>
namespace cg = cooperative_groups;

#define LAS __attribute__((address_space(3)))
typedef unsigned short bf16_t;
typedef float f32x4 __attribute__((ext_vector_type(4)));
typedef float f32x2 __attribute__((ext_vector_type(2)));
typedef unsigned u32x4 __attribute__((ext_vector_type(4)));
typedef unsigned u32x2 __attribute__((ext_vector_type(2)));

constexpr int D = 2048, NB = 4, SEQL = 4096, LC = 256, NLAT = NB * SEQL, NCTX = NB * LC, MR = NLAT + NCTX;
constexpr int BR = 512, INW = 6688, NPAD = 6912, LDP = 4608, ADA = 3 * D;
constexpr int NT = 512, NWAVES = 8;
constexpr float EPS = 1e-6f;
constexpr int PC_S5U = 0, PC_S5G = 512, PC_RQ = 1024, PC_RK = 1536, PC_RV = 2048, PC_RG = 2560, PC_GQ = 3072, PC_GK = 3328, PC_GV = 3584, PC_GG = 4096;
constexpr int PT_V = 0, PT_G1 = 512, PT_G2 = 1024, PT_HG = 1536;
constexpr int FFTN = 8192;

enum { I_X = 0, I_C, I_CTX, I_CCTX, I_NORMW, I_ADAW, I_ADAB, I_WIN, I_WOUT, I_S5ARE, I_S5AIM, I_S5LDT, I_S5BRE, I_S5BIM, I_S5CRE, I_S5CIM,
       I_S5D, I_GLUW, I_GLUB, I_HCW, I_HCB, I_HW1, I_HB1, I_HF1, I_HW2, I_HB2, I_HF2, I_HW3, I_HB3, I_HF3, I_HW4, I_HBIAS, I_RNW, I_GGW, I_GGB, I_GNW, I_FNW, N_IN };

constexpr size_t al256(size_t x) { return (x + 255) & ~(size_t)255; }
constexpr size_t WS_CTL  = 0;
constexpr size_t WS_MOD  = WS_CTL + 65536;
constexpr size_t WS_ZERO_BYTES = 65536 + al256((size_t)2 * 5 * ADA * 4);
constexpr size_t WS_S5AB = WS_MOD + al256((size_t)2 * 5 * ADA * 4);
constexpr size_t WS_S5BT = WS_S5AB + (size_t)2 * 2 * 32 * 64 * 8;
constexpr size_t WS_H3   = WS_S5BT + (size_t)2 * 2 * 32 * 64 * 16 * 8;
constexpr size_t WS_H3C  = WS_H3 + (size_t)2 * 4096 * 64 * 4;
constexpr size_t WS_KC   = WS_H3C + (size_t)256 * 64 * 4;
constexpr size_t WS_LR   = WS_KC + (size_t)2 * 512 * 512 * 4;
constexpr size_t WS_XC1  = WS_LR + (size_t)MR * 32 * 4;
constexpr size_t WS_WOUT = WS_XC1 + (size_t)NCTX * D * 4;
constexpr size_t WS_GLUW = WS_WOUT + (size_t)D * D * 2;
constexpr size_t WS_WIN  = WS_GLUW + (size_t)512 * 512 * 2;
constexpr size_t WS_H    = WS_WIN + (size_t)NPAD * D * 2;
constexpr size_t WS_P    = WS_H + (size_t)MR * D * 2;
constexpr size_t WS_PT   = WS_P + (size_t)MR * LDP * 2;
constexpr size_t WS_KF   = WS_PT + (size_t)2048 * MR * 2;
constexpr size_t WS_OB   = WS_KF + (size_t)2 * 512 * FFTN * 8;
constexpr size_t WS_END  = WS_OB + (size_t)6 * MR * 512 * 2;
constexpr size_t OBSZ = (size_t)MR * 512;

constexpr int LDS_BYTES = 131072 + 2048;
constexpr int LDS_CTL_OFF = 131072;

__device__ __forceinline__ unsigned f2bf(float f) { unsigned u = __float_as_uint(f); return (u + 0x7fffu + ((u >> 16) & 1u)) >> 16; }
__device__ __forceinline__ unsigned pk2(float lo, float hi) { return f2bf(lo) | (f2bf(hi) << 16); }
__device__ __forceinline__ float bf2f(bf16_t b) { return __uint_as_float((unsigned)b << 16); }
__device__ __forceinline__ float bflo(unsigned w) { return __uint_as_float(w << 16); }
__device__ __forceinline__ float bfhi(unsigned w) { return __uint_as_float(w & 0xffff0000u); }
__device__ __forceinline__ void unpack8(const u32x4 r, float (&f)[8]) { f[0] = bflo(r.x); f[1] = bfhi(r.x); f[2] = bflo(r.y); f[3] = bfhi(r.y); f[4] = bflo(r.z); f[5] = bfhi(r.z); f[6] = bflo(r.w); f[7] = bfhi(r.w); }
__device__ __forceinline__ u32x4 pack8(const float (&f)[8]) { u32x4 o; o.x = pk2(f[0], f[1]); o.y = pk2(f[2], f[3]); o.z = pk2(f[4], f[5]); o.w = pk2(f[6], f[7]); return o; }
__device__ __forceinline__ float sigmoidf_(float x) { return 1.0f / (1.0f + __expf(-x)); }
__device__ __forceinline__ float siluf_(float x) { return x * sigmoidf_(x); }
__device__ __forceinline__ float gelu_tanh(float x) { const float u = 0.7978845608028654f * (x + 0.044715f * x * x * x); return 0.5f * x * (1.0f + tanhf(u)); }
__device__ __forceinline__ float wave_sum(float v) {
#pragma unroll
    for (int o = 1; o < 64; o <<= 1) v += __shfl_xor(v, o);
    return v;
}
#define LDS_WAIT() asm volatile("s_waitcnt lgkmcnt(0)" ::: "memory")

struct Args { const float* in[N_IN]; float* out; unsigned char* ws; int ph_lo, ph_hi; };
namespace pg8 {
#define PG8_LAS __attribute__((address_space(3)))
typedef unsigned short bf16_t;
typedef short bf16x8 __attribute__((ext_vector_type(8)));
typedef float f32x4 __attribute__((ext_vector_type(4)));
typedef unsigned u32x4 __attribute__((ext_vector_type(4)));
constexpr int BM = 256, BK = 64, HALF = 128, HTB = HALF * BK * 2, STAGE_BYTES = 8 * HTB, NXCD = 8, WGM = 8;

__host__ __device__ __forceinline__ int lds_byte(int r, int c) { const int st = (r >> 4) * 2 + (c >> 5), rr = r & 15, cc = c & 31, ob = rr * 64 + cc * 2; return st * 1024 + (ob ^ (((ob >> 9) & 1) << 5)); }
__host__ __device__ __forceinline__ void stage_rc(int b, int& R, int& C) { const int st = b / 1024, sb = b % 1024, swz = sb ^ (((sb >> 9) & 1) << 5); R = (st >> 1) * 16 + swz / 64; C = (st & 1) * 32 + (swz % 64) / 2; }
__host__ __device__ __forceinline__ int perm32(int rho) { const int n = rho >> 4, i = rho & 15; return 8 * (i >> 2) + 4 * n + (i & 3); }

struct Unit { int pm, pn; };
struct Gemm { const bf16_t* A; const bf16_t* Bt; int M, N, K; };

struct StaticOrder {
    int nM, nN, nwg, G, c;
    __host__ __device__ void init(int M, int N, int G_, int c_) { nM = M / BM; nN = N / BM; nwg = nM * nN; G = G_; c = c_; }
    __host__ __device__ bool next(int i, Unit& u) const {
        const long L = (long)i * G + c; if (L >= nwg) return false;
        int wgid = (int)L; { const int q = nwg / NXCD, r = nwg % NXCD, xcd = wgid % NXCD, off = wgid / NXCD; wgid = (xcd < r ? xcd * (q + 1) : r * (q + 1) + (xcd - r) * q) + off; }
        const int nig = WGM * nN, gid = wgid / nig, fm = gid * WGM, gsz = (nM - fm) < WGM ? (nM - fm) : WGM;
        u.pm = fm + ((wgid % nig) % gsz); u.pn = (wgid % nig) / gsz; return true;
    }
    __device__ __forceinline__ void a_ready(const Unit&) const {}
    __device__ __forceinline__ void done(const Unit&) const {}
};

template <class Epi, class Sched>
__device__ __forceinline__ void gemm_phase(PG8_LAS unsigned char* lds, const Gemm g, const Sched& S, const Epi& E, const int tid) {
    const int wid = __builtin_amdgcn_readfirstlane(tid >> 6), lane = tid & 63, wr = wid >> 2, wc = wid & 3, fr = lane & 15, fq = lane >> 4;
    const int K = g.K, nt = K / BK;
    unsigned voffA[2], voffB[2];
#pragma unroll
    for (int i = 0; i < 2; ++i) { int R, C; stage_rc(tid * 16 + i * 8192, R, C); const int Rb = Epi::PERM ? ((R & ~31) + perm32(R & 31)) : R;
        voffA[i] = (unsigned)(R * K + C) * 2u; voffB[i] = (unsigned)(Rb * K + C) * 2u; }
    const size_t kstep = (size_t)(BK * 2);
    const size_t hstep = (size_t)HALF * K * 2;
    const size_t tstep = 2 * hstep;
    const unsigned ldsw = (unsigned)wid * 1024u;
    const int aoff = lds_byte(wr * 64 + fr, fq * 8), boff = lds_byte(wc * 32 + fr, fq * 8);
#define PG8_SA(b, h) (((b) * 2 + (h)) * HTB)
#define PG8_SB(b, h) ((4 + (b) * 2 + (h)) * HTB)
#define PG8_STAGE(bufoff, gbase, voff) do { _Pragma("unroll") for (int _i = 0; _i < 2; ++_i) \
        __builtin_amdgcn_global_load_lds((const unsigned*)((const char*)(gbase) + (voff)[_i]), (PG8_LAS unsigned*)(lds + (bufoff) + ldsw + _i * 8192), 16, 0, 0); } while (0)
#define PG8_LDA(dst, b, h) do { _Pragma("unroll") for (int m = 0; m < 4; ++m) _Pragma("unroll") for (int k = 0; k < 2; ++k) dst[m][k] = *(const PG8_LAS bf16x8*)(lds + PG8_SA(b, h) + aoff + m * 2048 + k * 1024); } while (0)
#define PG8_LDB(dst, b, h) do { _Pragma("unroll") for (int n = 0; n < 2; ++n) _Pragma("unroll") for (int k = 0; k < 2; ++k) dst[n][k] = *(const PG8_LAS bf16x8*)(lds + PG8_SB(b, h) + boff + n * 2048 + k * 1024); } while (0)
#define PG8_MMA(ai, bj, At, Bt) do { __builtin_amdgcn_s_setprio(1); _Pragma("unroll") for (int m = 0; m < 4; ++m) _Pragma("unroll") for (int n = 0; n < 2; ++n) _Pragma("unroll") for (int k = 0; k < 2; ++k) \
        acc[ai][bj][m][n] = __builtin_amdgcn_mfma_f32_16x16x32_bf16(Bt[n][k], At[m][k], acc[ai][bj][m][n], 0, 0, 0); __builtin_amdgcn_s_setprio(0); } while (0)
#define PG8_WAIT_V(n) asm volatile("s_waitcnt vmcnt(" #n ")" ::: "memory")
#define PG8_WAIT_L(n) asm volatile("s_waitcnt lgkmcnt(" #n ")" ::: "memory")
#define PG8_BAR __builtin_amdgcn_s_barrier()
#define PG8_SCHED __builtin_amdgcn_sched_barrier(0)
    Unit cur, nxt; int ui = 0;
    if (!S.next(0, cur)) return;
    f32x4 acc[2][2][4][2];
#pragma unroll
    for (int a = 0; a < 2; ++a)
#pragma unroll
        for (int b = 0; b < 2; ++b)
#pragma unroll
            for (int m = 0; m < 4; ++m)
#pragma unroll
                for (int n = 0; n < 2; ++n) acc[a][b][m][n] = (f32x4){0.f, 0.f, 0.f, 0.f};
    bf16x8 At[4][2], B0[2][2], B1[2][2];
    const char* cA = (const char*)g.A + (size_t)cur.pm * tstep; const char* cB = (const char*)g.Bt + (size_t)cur.pn * tstep;
    S.a_ready(cur);
    PG8_STAGE(PG8_SB(0, 0), cB, voffB); PG8_STAGE(PG8_SA(0, 0), cA, voffA); PG8_STAGE(PG8_SB(0, 1), cB + hstep, voffB); PG8_STAGE(PG8_SA(0, 1), cA + hstep, voffA);
    if (wr == 1) PG8_BAR;
    PG8_WAIT_V(4); PG8_BAR;
    PG8_STAGE(PG8_SB(1, 0), cB + kstep, voffB); PG8_STAGE(PG8_SA(1, 0), cA + kstep, voffA); PG8_STAGE(PG8_SB(1, 1), cB + hstep + kstep, voffB);
    PG8_WAIT_V(6); PG8_BAR;
    for (;;) {
        const bool has_next = S.next(ui + 1, nxt);
        const char* nA = has_next ? (const char*)g.A + (size_t)nxt.pm * tstep : cA; const char* nB = has_next ? (const char*)g.Bt + (size_t)nxt.pn * tstep : cB;
        for (int t = 0; t < nt; t += 2) {
            const bool last = (t == nt - 2);
            const char* a1 = cA + (size_t)(t + 1) * kstep;
            const char* a2 = last ? nA : cA + (size_t)(t + 2) * kstep; const char* b2 = last ? nB : cB + (size_t)(t + 2) * kstep;
            const char* a3 = a2 + kstep; const char* b3 = b2 + kstep;
            if (last && has_next) S.a_ready(nxt);
            PG8_LDB(B0, 0, 0); PG8_SCHED; PG8_LDA(At, 0, 0); PG8_STAGE(PG8_SA(1, 1), a1 + hstep, voffA);
            PG8_WAIT_L(8); PG8_BAR; PG8_WAIT_L(0); PG8_MMA(0, 0, At, B0); PG8_BAR; PG8_SCHED;
            PG8_LDB(B1, 0, 1); PG8_STAGE(PG8_SB(0, 0), b2, voffB);
            PG8_BAR; PG8_WAIT_L(0); PG8_MMA(0, 1, At, B1); PG8_BAR;
            PG8_LDA(At, 0, 1); PG8_STAGE(PG8_SA(0, 0), a2, voffA);
            PG8_BAR; PG8_WAIT_L(0); PG8_MMA(1, 0, At, B0); PG8_BAR; PG8_SCHED;
            PG8_STAGE(PG8_SB(0, 1), b2 + hstep, voffB);
            PG8_WAIT_V(6); PG8_BAR; PG8_MMA(1, 1, At, B1); PG8_BAR;
            PG8_LDB(B0, 1, 0); PG8_SCHED; PG8_LDA(At, 1, 0); PG8_STAGE(PG8_SA(0, 1), a2 + hstep, voffA);
            PG8_WAIT_L(8); PG8_BAR; PG8_WAIT_L(0); PG8_MMA(0, 0, At, B0); PG8_BAR; PG8_SCHED;
            PG8_LDB(B1, 1, 1); PG8_STAGE(PG8_SB(1, 0), b3, voffB);
            PG8_BAR; PG8_WAIT_L(0); PG8_MMA(0, 1, At, B1); PG8_BAR;
            PG8_LDA(At, 1, 1); PG8_STAGE(PG8_SA(1, 0), a3, voffA);
            PG8_BAR; PG8_WAIT_L(0); PG8_MMA(1, 0, At, B0); PG8_BAR; PG8_SCHED;
            PG8_STAGE(PG8_SB(1, 1), b3 + hstep, voffB);
            PG8_WAIT_V(6); PG8_BAR; PG8_MMA(1, 1, At, B1); PG8_BAR;
        }
        E(acc, cur, wr, wc, fr, fq); S.done(cur);
        if (!has_next) break;
#pragma unroll
        for (int a = 0; a < 2; ++a)
#pragma unroll
            for (int b = 0; b < 2; ++b)
#pragma unroll
                for (int m = 0; m < 4; ++m)
#pragma unroll
                    for (int n = 0; n < 2; ++n) acc[a][b][m][n] = (f32x4){0.f, 0.f, 0.f, 0.f};
        cur = nxt; cA = nA; cB = nB; ++ui;
    }
    PG8_WAIT_V(0);
    if (wr == 0) PG8_BAR;
    PG8_BAR;
#undef PG8_SA
#undef PG8_SB
#undef PG8_STAGE
#undef PG8_LDA
#undef PG8_LDB
#undef PG8_MMA
#undef PG8_WAIT_V
#undef PG8_WAIT_L
#undef PG8_BAR
#undef PG8_SCHED
}
}
__device__ __forceinline__ void prep_adaln(const float* c, const float* cctx, const float* adaw, const float* adab, float* MOD, int it, LAS float* sv, int tid) {
    const int l = it / 384, r = it % 384, ntile = r >> 5, ks = r & 31, k0 = ks * 64;
    if (tid < 320) { const int v = tid >> 6, k = tid & 63; const float cv = v < 4 ? c[v * D + k0 + k] : cctx[k0 + k]; sv[tid] = cv / (1.0f + expf(-cv)); }
    __syncthreads();
    const int n = ntile * 512 + tid; const float* w = adaw + (size_t)l * D * ADA + (size_t)k0 * ADA + n;
    float acc[5] = {0.f, 0.f, 0.f, 0.f, 0.f};
#pragma unroll 8
    for (int k = 0; k < 64; ++k) { const float wv = w[(size_t)k * ADA];
#pragma unroll
        for (int v = 0; v < 5; ++v) acc[v] += sv[v * 64 + k] * wv; }
    if (ks == 0) { const float bb = adab[l * ADA + n];
#pragma unroll
        for (int v = 0; v < 5; ++v) acc[v] += bb; }
#pragma unroll
    for (int v = 0; v < 5; ++v) atomicAdd(MOD + (size_t)(l * 5 + v) * ADA + n, acc[v]);
    __syncthreads();
}

__device__ __forceinline__ void prep_s5(const Args& a, unsigned char* ws, int it, int tid) {
    const int idx = it * 512 + tid;
    const float a_re = a.in[I_S5ARE][idx], a_im = a.in[I_S5AIM][idx], ldt = a.in[I_S5LDT][idx >> 6];
    const float dt = expf(ldt), mag = expf(a_re * dt);
    float sn, cs; sincosf(a_im * dt, &sn, &cs);
    const float ab_re = mag * cs, ab_im = mag * sn, den = a_re * a_re + a_im * a_im, nr = ab_re - 1.0f;
    const float co_re = (nr * a_re + ab_im * a_im) / den, co_im = (ab_im * a_re - nr * a_im) / den;
    ((f32x2*)(ws + WS_S5AB))[idx] = (f32x2){ab_re, ab_im};
    const float* bre = a.in[I_S5BRE] + (size_t)idx * 16; const float* bim = a.in[I_S5BIM] + (size_t)idx * 16;
    f32x2* bt = (f32x2*)(ws + WS_S5BT) + (size_t)idx * 16;
#pragma unroll
    for (int i = 0; i < 16; ++i) { const float br = bre[i], bi = bim[i]; bt[i] = (f32x2){co_re * br - co_im * bi, co_re * bi + co_im * br}; }
}

__device__ __forceinline__ void prep_hymlp(const Args& a, float* H3out, int l, int Lx, int t0, LAS float* zs, LAS float* h1, LAS float* h2, int tid) {
    const int pos = tid >> 6, f = tid & 63, t = t0 + pos;
    if (f < 33) {
        float z;
        if (f == 0) z = (float)t / (float)(Lx - 1);
        else { const int j = (f - 1) & 15; const float fj = 1e-4f + (float)j * ((15.0f - 1e-4f) / 15.0f); const float wpos = (6.283185307179586f * (float)t) / (float)Lx; const float arg = fj * wpos;
               z = (f <= 16) ? cosf(arg) : -sinf(arg); }
        zs[pos * 36 + f] = z;
    }
    __syncthreads();
    const float* w1 = a.in[I_HW1] + (size_t)l * 33 * 64; const float* w2 = a.in[I_HW2] + (size_t)l * 64 * 64; const float* w3 = a.in[I_HW3] + (size_t)l * 64 * 64;
    float s = a.in[I_HB1][l * 64 + f];
#pragma unroll 3
    for (int j = 0; j < 33; ++j) s += zs[pos * 36 + j] * w1[j * 64 + f];
    h1[pos * 64 + f] = sinf(a.in[I_HF1][l * 64 + f] * s);
    __syncthreads();
    s = a.in[I_HB2][l * 64 + f];
#pragma unroll 4
    for (int j = 0; j < 64; ++j) s += h1[pos * 64 + j] * w2[j * 64 + f];
    h2[pos * 64 + f] = sinf(a.in[I_HF2][l * 64 + f] * s);
    __syncthreads();
    s = a.in[I_HB3][l * 64 + f];
#pragma unroll 4
    for (int j = 0; j < 64; ++j) s += h2[pos * 64 + j] * w3[j * 64 + f];
    H3out[(size_t)t * 64 + f] = sinf(a.in[I_HF3][l * 64 + f] * s);
    __syncthreads();
}

__device__ __forceinline__ void transpose_item(const float* W, int ldw, int srccol0, int k0, bf16_t* WT, int K, int dstrow0, LAS float* scr, int lane) {
    if (srccol0 >= 0) {
#pragma unroll 8
        for (int i = 0; i < 32; ++i) { const int kk = 2 * i + (lane >> 5); scr[kk * 33 + (lane & 31)] = W[(size_t)(k0 + kk) * ldw + srccol0 + (lane & 31)]; }
    } else {
#pragma unroll 8
        for (int i = 0; i < 32; ++i) { const int kk = 2 * i + (lane >> 5); scr[kk * 33 + (lane & 31)] = 0.f; }
    }
    LDS_WAIT();
    const int c = lane & 7;
#pragma unroll
    for (int j = 0; j < 4; ++j) { const int n = (lane >> 3) + 8 * j; const LAS float* s = scr + (8 * c) * 33 + n;
        u32x4 o; o.x = pk2(s[0 * 33], s[1 * 33]); o.y = pk2(s[2 * 33], s[3 * 33]); o.z = pk2(s[4 * 33], s[5 * 33]); o.w = pk2(s[6 * 33], s[7 * 33]);
        *(u32x4*)(WT + (size_t)(dstrow0 + n) * K + k0 + 8 * c) = o; }
    LDS_WAIT();
}
__device__ __forceinline__ int win_srccol(int n) { return n < 6144 ? n : (n < 6656 ? n + 32 : (n < 6688 ? n - 512 : -1)); }

__device__ __forceinline__ void norm_row(const float* xrow, const float* nw, const float* mod, bf16_t* hrow, int lane) {
    f32x4 v[8]; float ss = 0.f;
#pragma unroll
    for (int j = 0; j < 8; ++j) { v[j] = ((const f32x4*)xrow)[lane + 64 * j]; ss += (v[j].x * v[j].x + v[j].y * v[j].y) + (v[j].z * v[j].z + v[j].w * v[j].w); }
    const float rstd = rsqrtf(wave_sum(ss) * (1.0f / D) + EPS);
#pragma unroll
    for (int j = 0; j < 8; ++j) { const int k = 4 * (lane + 64 * j);
        const f32x4 w = *(const f32x4*)(nw + k), sh = *(const f32x4*)(mod + k), sc = *(const f32x4*)(mod + D + k);
        const f32x4 o = v[j] * rstd * w * (sc + 1.0f) + sh;
        u32x2 pk; pk.x = pk2(o.x, o.y); pk.y = pk2(o.z, o.w);
        *(u32x2*)(hrow + k) = pk; }
}

__device__ __forceinline__ void fft_twiddles(LAS f32x2* W, int tid) {
    for (int j = tid; j < 4096; j += NT) { float s, c; sincospif(-(float)j * (1.0f / 4096.0f), &s, &c); W[j] = (f32x2){c, s}; }
}
template <int R, int BETA, bool INV> __device__ __forceinline__ void fft_pass(LAS f32x2* X, const LAS f32x2* W, int tid) {
    constexpr int LOW = BETA - R + 1, NG = FFTN >> R;
    for (int gi = tid; gi < NG; gi += NT) {
        const int base = ((gi >> LOW) << (BETA + 1)) | (gi & ((1 << LOW) - 1));
        f32x2 e[1 << R];
#pragma unroll
        for (int m = 0; m < (1 << R); ++m) e[m] = X[base + (m << LOW)];
#pragma unroll
        for (int ss = 0; ss < R; ++ss) {
            const int s = INV ? (R - 1 - ss) : ss; const int bit = BETA - s, h = 1 << (R - 1 - s);
#pragma unroll
            for (int m = 0; m < (1 << R); ++m) {
                if (m & h) continue;
                const int idx = base + (m << LOW); const int ex = (idx & ((1 << bit) - 1)) << (12 - bit);
                const f32x2 w = W[ex]; const f32x2 a_ = e[m], b_ = e[m | h];
                if (!INV) { const f32x2 d = a_ - b_; e[m] = a_ + b_; e[m | h] = (f32x2){d.x * w.x - d.y * w.y, d.x * w.y + d.y * w.x}; }
                else { const f32x2 t = (f32x2){b_.x * w.x + b_.y * w.y, b_.y * w.x - b_.x * w.y}; e[m] = a_ + t; e[m | h] = a_ - t; }
            }
        }
#pragma unroll
        for (int m = 0; m < (1 << R); ++m) X[base + (m << LOW)] = e[m];
    }
}
__device__ __forceinline__ void fft_forward(LAS f32x2* X, const LAS f32x2* W, int tid) {
    fft_pass<4, 12, false>(X, W, tid); __syncthreads(); fft_pass<3, 8, false>(X, W, tid); __syncthreads();
    fft_pass<3, 5, false>(X, W, tid); __syncthreads(); fft_pass<3, 2, false>(X, W, tid); __syncthreads();
}
__device__ __forceinline__ void fft_inverse(LAS f32x2* X, const LAS f32x2* W, int tid) {
    fft_pass<3, 2, true>(X, W, tid); __syncthreads(); fft_pass<3, 5, true>(X, W, tid); __syncthreads();
    fft_pass<3, 8, true>(X, W, tid); __syncthreads(); fft_pass<4, 12, true>(X, W, tid); __syncthreads();
}
__device__ __forceinline__ float block_sum(float v, LAS float* red, int tid) {
    v = wave_sum(v);
    if ((tid & 63) == 0) red[tid >> 6] = v;
    __syncthreads();
    float t = 0.f;
#pragma unroll
    for (int i = 0; i < NWAVES; ++i) t += red[i];
    __syncthreads();
    return t;
}
constexpr float HY_D0 = -3.0701134573253945f  , HY_D1 = -15.350567286626973f  ;

__device__ __forceinline__ void filt_item(const Args& a, unsigned char* ws, LAS unsigned char* lds, int l, int c, int tid) {
    LAS f32x2* X = (LAS f32x2*)lds; LAS f32x2* W = (LAS f32x2*)(lds + 65536); LAS float* w4s = (LAS float*)(lds + 98304); LAS float* red = (LAS float*)(lds + 98304 + 1024);
    LAS float* k1b = (LAS float*)(lds + 100352);
    fft_twiddles(W, tid);
    if (tid < 256) { const int cc = tid >> 6, f = tid & 63; w4s[tid] = a.in[I_HW4][(size_t)l * 64 * 2048 + (size_t)f * 2048 + (cc >> 1) * 1024 + (cc & 1) * 512 + c]; }
    __syncthreads();
    const float dl = fabsf(HY_D0 + (HY_D1 - HY_D0) * ((float)c / 511.0f));
    const float* H3 = (const float*)(ws + WS_H3) + (size_t)l * 4096 * 64;
    float ss0 = 0.f, ss1 = 0.f;
#pragma unroll 1
    for (int j = 0; j < 16; ++j) {
        const int n = tid + 512 * j; const int dir = j >= 8 ? 1 : 0; const int t = dir ? (8192 - n) : n;
        float s0 = 0.f, s1 = 0.f;
        if (n != 4096) {
            const f32x4* hr = (const f32x4*)(H3 + (size_t)t * 64);
#pragma unroll
            for (int q = 0; q < 16; ++q) { const f32x4 hv = hr[q]; const f32x4 wa = ((const LAS f32x4*)(w4s + (dir * 2 + 0) * 64))[q], wb = ((const LAS f32x4*)(w4s + (dir * 2 + 1) * 64))[q];
                s0 += (hv.x * wa.x + hv.y * wa.y) + (hv.z * wa.z + hv.w * wa.w); s1 += (hv.x * wb.x + hv.y * wb.y) + (hv.z * wb.z + hv.w * wb.w); }
            const float dec = expf(-((float)t / 4095.0f) * dl); s0 *= dec; s1 *= dec;
        }
        X[n] = (f32x2){s0, 0.f}; k1b[n] = s1; ss0 += s0 * s0; ss1 += s1 * s1;
    }
    const float rs0 = rsqrtf(block_sum(ss0, red, tid) + EPS), rs1 = rsqrtf(block_sum(ss1, red, tid) + EPS);
    f32x2* KF0 = (f32x2*)(ws + WS_KF) + (size_t)(0 * 512 + c) * FFTN; f32x2* KF1 = (f32x2*)(ws + WS_KF) + (size_t)(1 * 512 + c) * FFTN;
#pragma unroll 4
    for (int j = 0; j < 16; ++j) { const f32x2 x = X[tid + 512 * j]; X[tid + 512 * j] = (f32x2){x.x * rs0, 0.f}; }
    __syncthreads(); fft_forward(X, W, tid);
#pragma unroll 4
    for (int j = 0; j < 16; ++j) KF0[tid + 512 * j] = X[tid + 512 * j];
    __syncthreads();
#pragma unroll 4
    for (int j = 0; j < 16; ++j) X[tid + 512 * j] = (f32x2){k1b[tid + 512 * j] * rs1, 0.f};
    __syncthreads(); fft_forward(X, W, tid);
#pragma unroll 4
    for (int j = 0; j < 16; ++j) KF1[tid + 512 * j] = X[tid + 512 * j];
    __syncthreads();
}
__device__ __forceinline__ void filt_ctx_item(const Args& a, unsigned char* ws, LAS unsigned char* lds, int c, int tid) {
    LAS float* w4s = (LAS float*)lds; LAS float* red = (LAS float*)(lds + 1024);
    if (tid < 256) { const int cc = tid >> 6, f = tid & 63; w4s[tid] = a.in[I_HW4][(size_t)f * 2048 + (cc >> 1) * 1024 + (cc & 1) * 512 + c]; }
    __syncthreads();
    const float dl = fabsf(HY_D0 + (HY_D1 - HY_D0) * ((float)c / 511.0f));
    const float* H3C = (const float*)(ws + WS_H3C);
    const int n = tid, dir = n >= 256 ? 1 : 0, t = dir ? (512 - n) : n;
    float s0 = 0.f, s1 = 0.f;
    if (n != 256) {
        const f32x4* hr = (const f32x4*)(H3C + (size_t)t * 64);
#pragma unroll
        for (int q = 0; q < 16; ++q) { const f32x4 hv = hr[q]; const f32x4 wa = ((const LAS f32x4*)(w4s + (dir * 2 + 0) * 64))[q], wb = ((const LAS f32x4*)(w4s + (dir * 2 + 1) * 64))[q];
            s0 += (hv.x * wa.x + hv.y * wa.y) + (hv.z * wa.z + hv.w * wa.w); s1 += (hv.x * wb.x + hv.y * wb.y) + (hv.z * wb.z + hv.w * wb.w); }
        const float dec = expf(-((float)t / 255.0f) * dl); s0 *= dec; s1 *= dec;
    }
    const float rs0 = rsqrtf(block_sum(s0 * s0, red, tid) + EPS), rs1 = rsqrtf(block_sum(s1 * s1, red, tid) + EPS);
    float* KC = (float*)(ws + WS_KC);
    KC[(size_t)(0 * 512 + c) * 512 + n] = s0 * rs0; KC[(size_t)(1 * 512 + c) * 512 + n] = s1 * rs1;
    __syncthreads();
}

__device__ __forceinline__ void rope_row(const Args& a, unsigned char* ws, int l, int row, int lane) {
    bf16_t* P = (bf16_t*)(ws + WS_P) + (size_t)row * LDP;
    float ang;
    if (row < NLAT) { const int t = row & (SEQL - 1); const int j = lane & 31; const float inv = exp2f(-(float)j * (13.287712379549449f / 32.0f)); ang = (float)(lane < 32 ? (t >> 6) : (t & 63)) * inv; }
    else { const int t = (row - NLAT) & (LC - 1); const float inv = exp2f(-(float)lane * (13.287712379549449f / 64.0f)); ang = (float)t * inv; }
    float sn, cs; sincosf(ang, &sn, &cs);
    const float ksc = 0.08838834764831845f;
#pragma unroll
    for (int h = 0; h < 4; ++h) {
        bf16_t* q = P + PC_RQ + h * 128; bf16_t* k = P + PC_RK + h * 128;
        const float q1 = bf2f(q[lane]), q2 = bf2f(q[lane + 64]), k1 = bf2f(k[lane]), k2 = bf2f(k[lane + 64]);
        q[lane] = (bf16_t)f2bf(q1 * cs - q2 * sn); q[lane + 64] = (bf16_t)f2bf(q1 * sn + q2 * cs);
        k[lane] = (bf16_t)f2bf((k1 * cs - k2 * sn) * ksc); k[lane + 64] = (bf16_t)f2bf((k1 * sn + k2 * cs) * ksc);
    }
    const float* lr = (const float*)(ws + WS_LR) + (size_t)row * 32;
    bf16_t* GLG = (bf16_t*)(ws + WS_WIN);
#pragma unroll
    for (int dir = 0; dir < 2; ++dir) {
        const float* gw = a.in[I_GGW] + (size_t)(l * 2 + dir) * 16 * 256; const float* gb = a.in[I_GGB] + (size_t)(l * 2 + dir) * 256;
        float lrv[16];
#pragma unroll
        for (int j = 0; j < 16; ++j) lrv[j] = lr[dir * 16 + j];
#pragma unroll
        for (int q = 0; q < 4; ++q) { const int d = lane + 64 * q; float s = gb[d];
#pragma unroll
            for (int j = 0; j < 16; ++j) s += lrv[j] * gw[j * 256 + d];
            const float ls = (s >= 0.f) ? -log1pf(expf(-s)) : (s - log1pf(expf(s)));
            GLG[((size_t)dir * MR + row) * 256 + d] = (bf16_t)f2bf(ls * (1.0f / 16.0f)); }
    }
}

__device__ __forceinline__ void ret_chain(const bf16_t* P, bf16_t* O, int b, int h, int dir, bool ctx_out, int wave, int lane) {
    const int e = wave * 16 + (lane & 15), dq = lane >> 4;
    const float gamma = 1.0f - exp2f(-5.0f - (float)h);
    float S[32];
#pragma unroll
    for (int i = 0; i < 32; ++i) S[i] = 0.f;
    for (int seg = 0; seg < 2; ++seg) {
        const int n = seg ? SEQL : LC, rowbase = seg ? b * SEQL : NLAT + b * LC; const bool wr_out = seg || ctx_out;
        u32x4 qn[4], kn[4]; bf16_t vn;
        { const int row = rowbase + (dir ? n - 1 : 0); const bf16_t* pr = P + (size_t)row * LDP;
#pragma unroll
          for (int c4 = 0; c4 < 4; ++c4) { qn[c4] = ((const u32x4*)(pr + PC_RQ + h * 128 + dq * 32))[c4]; kn[c4] = ((const u32x4*)(pr + PC_RK + h * 128 + dq * 32))[c4]; }
          vn = pr[PC_RV + h * 128 + e]; }
        for (int i = 0; i < n; ++i) {
            const int row = rowbase + (dir ? n - 1 - i : i);
            u32x4 q[4], k[4];
#pragma unroll
            for (int c4 = 0; c4 < 4; ++c4) { q[c4] = qn[c4]; k[c4] = kn[c4]; }
            const float vf = bf2f(vn);
            if (i + 1 < n) { const int rown = rowbase + (dir ? n - 2 - i : i + 1); const bf16_t* pr = P + (size_t)rown * LDP;
#pragma unroll
                for (int c4 = 0; c4 < 4; ++c4) { qn[c4] = ((const u32x4*)(pr + PC_RQ + h * 128 + dq * 32))[c4]; kn[c4] = ((const u32x4*)(pr + PC_RK + h * 128 + dq * 32))[c4]; }
                vn = pr[PC_RV + h * 128 + e]; }
            float o = 0.f;
#pragma unroll
            for (int c4 = 0; c4 < 4; ++c4) { float qf[8], kf[8]; unpack8(q[c4], qf); unpack8(k[c4], kf);
#pragma unroll
                for (int x = 0; x < 8; ++x) { const int ix = c4 * 8 + x; S[ix] = gamma * S[ix] + kf[x] * vf; o += qf[x] * S[ix]; } }
            o += __shfl_xor(o, 16); o += __shfl_xor(o, 32);
            if (wr_out && dq == 0) O[(size_t)row * 512 + h * 128 + e] = (bf16_t)f2bf(o);
        }
    }
}
__device__ __forceinline__ void gla_chain(const bf16_t* P, const bf16_t* GLGd, bf16_t* O, int b, int h, int dir, bool ctx_out, int wave, int lane) {
    const int e = wave * 16 + (lane & 15), dq = lane >> 4;
    float S[16];
#pragma unroll
    for (int i = 0; i < 16; ++i) S[i] = 0.f;
    for (int seg = 0; seg < 2; ++seg) {
        const int n = seg ? SEQL : LC, rowbase = seg ? b * SEQL : NLAT + b * LC; const bool wr_out = seg || ctx_out;
        u32x4 qn[2], kn[2], gn[2]; bf16_t vn;
        { const int row = rowbase + (dir ? n - 1 : 0); const bf16_t* pr = P + (size_t)row * LDP; const bf16_t* gr = GLGd + (size_t)row * 256 + h * 64 + dq * 16;
#pragma unroll
          for (int c4 = 0; c4 < 2; ++c4) { qn[c4] = ((const u32x4*)(pr + PC_GQ + h * 64 + dq * 16))[c4]; kn[c4] = ((const u32x4*)(pr + PC_GK + h * 64 + dq * 16))[c4]; gn[c4] = ((const u32x4*)gr)[c4]; }
          vn = pr[PC_GV + h * 128 + e]; }
        for (int i = 0; i < n; ++i) {
            const int row = rowbase + (dir ? n - 1 - i : i);
            u32x4 q[2], k[2], g[2];
#pragma unroll
            for (int c4 = 0; c4 < 2; ++c4) { q[c4] = qn[c4]; k[c4] = kn[c4]; g[c4] = gn[c4]; }
            const float vf = bf2f(vn);
            if (i + 1 < n) { const int rown = rowbase + (dir ? n - 2 - i : i + 1); const bf16_t* pr = P + (size_t)rown * LDP; const bf16_t* gr = GLGd + (size_t)rown * 256 + h * 64 + dq * 16;
#pragma unroll
                for (int c4 = 0; c4 < 2; ++c4) { qn[c4] = ((const u32x4*)(pr + PC_GQ + h * 64 + dq * 16))[c4]; kn[c4] = ((const u32x4*)(pr + PC_GK + h * 64 + dq * 16))[c4]; gn[c4] = ((const u32x4*)gr)[c4]; }
                vn = pr[PC_GV + h * 128 + e]; }
            float o = 0.f;
#pragma unroll
            for (int c4 = 0; c4 < 2; ++c4) { float qf[8], kf[8], gf[8]; unpack8(q[c4], qf); unpack8(k[c4], kf); unpack8(g[c4], gf);
#pragma unroll
                for (int x = 0; x < 8; ++x) { const int ix = c4 * 8 + x; S[ix] = __expf(gf[x]) * S[ix] + kf[x] * vf; o += qf[x] * S[ix]; } }
            o += __shfl_xor(o, 16); o += __shfl_xor(o, 32);
            if (wr_out && dq == 0) O[(size_t)row * 512 + h * 128 + e] = (bf16_t)f2bf(o * 0.125f);
        }
    }
}
__device__ __forceinline__ void s5_chain(const Args& a, unsigned char* ws, LAS unsigned char* lds, int l, int b, int g, int dir, bool ctx_out, int tid) {
    LAS f32x2* cs = (LAS f32x2*)lds; LAS f32x2* hs = (LAS f32x2*)(lds + 16 * 65 * 8); LAS float* us = (LAS float*)(lds + 2 * 16 * 65 * 8);
    const int wave = tid >> 6, lane = tid & 63;
    const int gi = (l * 2 + dir) * 32 + g;
    const float* cre = a.in[I_S5CRE] + (size_t)gi * 1024; const float* cim = a.in[I_S5CIM] + (size_t)gi * 1024;
    for (int idx = tid; idx < 1024; idx += NT) { const int i = idx >> 6, p = idx & 63; cs[i * 65 + p] = (f32x2){cre[idx], cim[idx]}; }
    f32x2 ab = {0.f, 0.f}; f32x2 bt[16]; f32x2 hst = {0.f, 0.f};
    if (wave == 0) { ab = ((const f32x2*)(ws + WS_S5AB))[gi * 64 + lane]; const f32x2* bp = (const f32x2*)(ws + WS_S5BT) + (size_t)(gi * 64 + lane) * 16;
#pragma unroll
        for (int i = 0; i < 16; ++i) bt[i] = bp[i]; }
    else {
#pragma unroll
        for (int i = 0; i < 16; ++i) bt[i] = (f32x2){0.f, 0.f}; }
    const bf16_t* P = (const bf16_t*)(ws + WS_P);
    bf16_t* Y = (bf16_t*)(ws + WS_OB) + (size_t)(4 + dir) * OBSZ;
    __syncthreads();
    for (int seg = 0; seg < 2; ++seg) {
        const int n = seg ? SEQL : LC, rowbase = seg ? b * SEQL : NLAT + b * LC; const bool wr_out = seg || ctx_out;
        for (int bt0 = 0; bt0 < n; bt0 += 16) {
            const int tt = tid >> 4, i = tid & 15; const int ii = bt0 + tt; const int row = rowbase + (dir ? n - 1 - ii : ii);
            if (tid < 256) us[tid] = bf2f(P[(size_t)row * LDP + PC_S5U + g * 16 + i]);
            __syncthreads();
            if (wave == 0) {
#pragma unroll 4
                for (int t2 = 0; t2 < 16; ++t2) {
                    float bur = 0.f, bui = 0.f;
#pragma unroll
                    for (int q = 0; q < 4; ++q) { const f32x4 u = ((const LAS f32x4*)(us + t2 * 16))[q];
                        bur += bt[4 * q].x * u.x + bt[4 * q + 1].x * u.y + bt[4 * q + 2].x * u.z + bt[4 * q + 3].x * u.w;
                        bui += bt[4 * q].y * u.x + bt[4 * q + 1].y * u.y + bt[4 * q + 2].y * u.z + bt[4 * q + 3].y * u.w; }
                    const float hr = ab.x * hst.x - ab.y * hst.y + bur, hi = ab.x * hst.y + ab.y * hst.x + bui;
                    hst = (f32x2){hr, hi};
                    hs[t2 * 65 + lane] = hst;
                }
            }
            __syncthreads();
            if (tid < 256) {
                float y = 0.f;
#pragma unroll 8
                for (int p = 0; p < 64; ++p) { const f32x2 cv = cs[i * 65 + p], hv = hs[tt * 65 + p]; y += cv.x * hv.x - cv.y * hv.y; }
                if (wr_out) Y[(size_t)row * 512 + g * 16 + i] = (bf16_t)f2bf(y);
            }
        }
    }
    __syncthreads();
}

__device__ __forceinline__ float sconv3(const bf16_t* p, int t, int Lx, float w0, float w1, float w2, float cb) {
    const float x0 = t > 0 ? bf2f(p[t - 1]) : 0.f, x1 = bf2f(p[t]), x2 = t < Lx - 1 ? bf2f(p[t + 1]) : 0.f;
    return w0 * x0 + w1 * x1 + w2 * x2 + cb;
}
__device__ __forceinline__ void hyena_item(const Args& a, unsigned char* ws, LAS unsigned char* lds, int l, int c, int tid) {
    LAS f32x2* X = (LAS f32x2*)lds; LAS f32x2* W = (LAS f32x2*)(lds + 65536);
    fft_twiddles(W, tid);
    const float* cw = a.in[I_HCW] + (size_t)l * 3 * 1536; const float* cbp = a.in[I_HCB] + (size_t)l * 1536;
    const float wv0 = cw[c], wv1 = cw[1536 + c], wv2 = cw[3072 + c], bv = cbp[c];
    const float wa0 = cw[512 + c], wa1 = cw[1536 + 512 + c], wa2 = cw[3072 + 512 + c], ba = cbp[512 + c];
    const float wb0 = cw[1024 + c], wb1 = cw[1536 + 1024 + c], wb2 = cw[3072 + 1024 + c], bb = cbp[1024 + c];
    const float bias0 = a.in[I_HBIAS][(l * 2 + 0) * 512 + c], bias1 = a.in[I_HBIAS][(l * 2 + 1) * 512 + c];
    const bf16_t* PT = (const bf16_t*)(ws + WS_PT);
    const bf16_t* pv = PT + (size_t)(PT_V + c) * MR; const bf16_t* pg1 = PT + (size_t)(PT_G1 + c) * MR; const bf16_t* pg2 = PT + (size_t)(PT_G2 + c) * MR; const bf16_t* phg = PT + (size_t)(PT_HG + c) * MR;
    const f32x2* KF0 = (const f32x2*)(ws + WS_KF) + (size_t)(0 * 512 + c) * FFTN; const f32x2* KF1 = (const f32x2*)(ws + WS_KF) + (size_t)(1 * 512 + c) * FFTN;
    bf16_t* GATED = (bf16_t*)(ws + WS_H);
    __syncthreads();
    for (int bp = 0; bp < 2; ++bp) {
        const int r0 = (2 * bp) * SEQL, r1 = (2 * bp + 1) * SEQL;
        float zr[8], zi[8];
#pragma unroll
        for (int j = 0; j < 8; ++j) { const int t = tid + 512 * j; zr[j] = sconv3(pv + r0, t, SEQL, wv0, wv1, wv2, bv); zi[j] = sconv3(pv + r1, t, SEQL, wv0, wv1, wv2, bv);
            X[t] = (f32x2){zr[j], zi[j]}; X[4096 + t] = (f32x2){0.f, 0.f}; if (j & 1) asm volatile("" ::: "memory"); }
        __syncthreads(); fft_forward(X, W, tid);
#pragma unroll 4
        for (int j = 0; j < 16; ++j) { const int pos = tid + 512 * j; const f32x2 x = X[pos], k = KF0[pos]; X[pos] = (f32x2){x.x * k.x - x.y * k.y, x.x * k.y + x.y * k.x}; }
        __syncthreads(); fft_inverse(X, W, tid);
#pragma unroll
        for (int j = 0; j < 8; ++j) { const int t = tid + 512 * j; const f32x2 cv = X[t] * (1.0f / 8192.0f);
            const float g1r = sconv3(pg1 + r0, t, SEQL, wa0, wa1, wa2, ba), g1i = sconv3(pg1 + r1, t, SEQL, wa0, wa1, wa2, ba);
            zr[j] = g1r * (cv.x + bias0 * zr[j]); zi[j] = g1i * (cv.y + bias0 * zi[j]); if (j & 1) asm volatile("" ::: "memory"); }
        __syncthreads();
#pragma unroll
        for (int j = 0; j < 8; ++j) { const int t = tid + 512 * j; X[t] = (f32x2){zr[j], zi[j]}; X[4096 + t] = (f32x2){0.f, 0.f}; }
        __syncthreads(); fft_forward(X, W, tid);
#pragma unroll 4
        for (int j = 0; j < 16; ++j) { const int pos = tid + 512 * j; const f32x2 x = X[pos], k = KF1[pos]; X[pos] = (f32x2){x.x * k.x - x.y * k.y, x.x * k.y + x.y * k.x}; }
        __syncthreads(); fft_inverse(X, W, tid);
#pragma unroll
        for (int j = 0; j < 8; ++j) { const int t = tid + 512 * j; const f32x2 cv = X[t] * (1.0f / 8192.0f);
            const float g2r = sconv3(pg2 + r0, t, SEQL, wb0, wb1, wb2, bb), g2i = sconv3(pg2 + r1, t, SEQL, wb0, wb1, wb2, bb);
            const float z2r = g2r * (cv.x + bias1 * zr[j]), z2i = g2i * (cv.y + bias1 * zi[j]);
            const float hg0 = bf2f(phg[r0 + t]), hg1 = bf2f(phg[r1 + t]);
            GATED[(size_t)(r0 + t) * D + 512 + c] = (bf16_t)f2bf(z2r * siluf_(hg0)); GATED[(size_t)(r1 + t) * D + 512 + c] = (bf16_t)f2bf(z2i * siluf_(hg1)); if (j & 1) asm volatile("" ::: "memory"); }
        __syncthreads();
    }
}
__device__ __forceinline__ void hyena_ctx_item(const Args& a, unsigned char* ws, LAS unsigned char* lds, int c, int tid) {
    LAS float* kc = (LAS float*)lds; LAS float* za = (LAS float*)(lds + 4096); LAS float* zb = (LAS float*)(lds + 8192);
    const float* KC = (const float*)(ws + WS_KC);
    kc[tid] = KC[(size_t)(0 * 512 + c) * 512 + tid]; kc[512 + tid] = KC[(size_t)(1 * 512 + c) * 512 + tid];
    const float* cw = a.in[I_HCW]; const float* cbp = a.in[I_HCB];
    const float wv0 = cw[c], wv1 = cw[1536 + c], wv2 = cw[3072 + c], bv = cbp[c];
    const float wa0 = cw[512 + c], wa1 = cw[1536 + 512 + c], wa2 = cw[3072 + 512 + c], ba = cbp[512 + c];
    const float wb0 = cw[1024 + c], wb1 = cw[1536 + 1024 + c], wb2 = cw[3072 + 1024 + c], bb = cbp[1024 + c];
    const float bias0 = a.in[I_HBIAS][0 * 512 + c], bias1 = a.in[I_HBIAS][1 * 512 + c];
    const bf16_t* PT = (const bf16_t*)(ws + WS_PT);
    const int b = tid >> 7, tt = tid & 127; const int rb = NLAT + b * LC;
    const bf16_t* pv = PT + (size_t)(PT_V + c) * MR + rb; const bf16_t* pg1 = PT + (size_t)(PT_G1 + c) * MR + rb; const bf16_t* pg2 = PT + (size_t)(PT_G2 + c) * MR + rb; const bf16_t* phg = PT + (size_t)(PT_HG + c) * MR + rb;
    bf16_t* GATED = (bf16_t*)(ws + WS_H);
    float z0[2], z1[2];
#pragma unroll
    for (int q = 0; q < 2; ++q) { const int t = tt + 128 * q; z0[q] = sconv3(pv, t, LC, wv0, wv1, wv2, bv); za[b * 256 + t] = z0[q]; }
    __syncthreads();
#pragma unroll
    for (int q = 0; q < 2; ++q) { const int t = tt + 128 * q; float s = 0.f;
        for (int sidx = 0; sidx < 256; ++sidx) s += kc[(t - sidx) & 511] * za[b * 256 + sidx];
        z1[q] = sconv3(pg1, t, LC, wa0, wa1, wa2, ba) * (s + bias0 * z0[q]); zb[b * 256 + t] = z1[q]; }
    __syncthreads();
#pragma unroll
    for (int q = 0; q < 2; ++q) { const int t = tt + 128 * q; float s = 0.f;
        for (int sidx = 0; sidx < 256; ++sidx) s += kc[512 + ((t - sidx) & 511)] * zb[b * 256 + sidx];
        const float z2 = sconv3(pg2, t, LC, wb0, wb1, wb2, bb) * (s + bias1 * z1[q]);
        GATED[(size_t)(rb + t) * D + 512 + c] = (bf16_t)f2bf(z2 * siluf_(bf2f(phg[t]))); }
    __syncthreads();
}

__device__ __forceinline__ void merge_row(const Args& a, unsigned char* ws, int l, int row, int lane) {
    const int col = 8 * lane;
    const bf16_t* OB = (const bf16_t*)(ws + WS_OB); const bf16_t* P = (const bf16_t*)(ws + WS_P) + (size_t)row * LDP;
    bf16_t* GATED = (bf16_t*)(ws + WS_H) + (size_t)row * D; bf16_t* G5 = (bf16_t*)(ws + WS_KF) + (size_t)row * 512;
#pragma unroll
    for (int mx = 0; mx < 2; ++mx) {
        float of[8], ob[8], gt[8], o[8];
        unpack8(*(const u32x4*)(OB + (size_t)(2 * mx) * OBSZ + (size_t)row * 512 + col), of); unpack8(*(const u32x4*)(OB + (size_t)(2 * mx + 1) * OBSZ + (size_t)row * 512 + col), ob);
        unpack8(*(const u32x4*)(P + (mx ? PC_GG : PC_RG) + col), gt);
        float ss = 0.f;
#pragma unroll
        for (int x = 0; x < 8; ++x) { o[x] = of[x] + ob[x]; ss += o[x] * o[x]; }
        ss += __shfl_xor(ss, 1); ss += __shfl_xor(ss, 2); ss += __shfl_xor(ss, 4); ss += __shfl_xor(ss, 8);
        const float r = rsqrtf(ss * (1.0f / 128.0f) + EPS);
        const float* nw = a.in[mx ? I_GNW : I_RNW] + l * 512 + col;
        float res[8];
#pragma unroll
        for (int x = 0; x < 8; ++x) res[x] = o[x] * r * nw[x] * siluf_(gt[x]);
        *(u32x4*)(GATED + 1024 + 512 * mx + col) = pack8(res);
    }
    { float yf[8], yb[8], u[8], res[8];
      unpack8(*(const u32x4*)(OB + (size_t)4 * OBSZ + (size_t)row * 512 + col), yf); unpack8(*(const u32x4*)(OB + (size_t)5 * OBSZ + (size_t)row * 512 + col), yb);
      unpack8(*(const u32x4*)(P + PC_S5U + col), u);
      const float* dsk = a.in[I_S5D] + l * 512 + col;
#pragma unroll
      for (int x = 0; x < 8; ++x) res[x] = gelu_tanh(yf[x] + yb[x] + u[x] * dsk[x]);
      *(u32x4*)(G5 + col) = pack8(res); }
}

struct EpiInProj {
    static constexpr bool PERM = true, AFTER_DRAIN = false;
    bf16_t* P; bf16_t* PT; float* LR;
    __device__ __forceinline__ void operator()(const pg8::f32x4 (&acc)[2][2][4][2], const pg8::Unit& u, int wr, int wc, int fr, int fq) const {
        const int row0 = u.pm * 256 + wr * 64 + fr, pn = u.pn;
        if (pn < 4 || (pn >= 12 && pn < 26)) {
            const int colbase = (pn < 4 ? pn * 256 : pn * 256 - 2048) + wc * 32 + 8 * fq;
#pragma unroll
            for (int ai = 0; ai < 2; ++ai)
#pragma unroll
                for (int m = 0; m < 4; ++m) { bf16_t* rowp = P + (size_t)(row0 + ai * 128 + m * 16) * LDP + colbase;
#pragma unroll
                    for (int bj = 0; bj < 2; ++bj) { const pg8::f32x4 v0 = acc[ai][bj][m][0], v1 = acc[ai][bj][m][1];
                        u32x4 w; w.x = pk2(v0[0], v0[1]); w.y = pk2(v0[2], v0[3]); w.z = pk2(v1[0], v1[1]); w.w = pk2(v1[2], v1[3]);
                        *(u32x4*)(rowp + bj * 128) = w; } }
        } else if (pn < 12) {
            const int colbase = (pn - 4) * 256 + wc * 32 + 8 * fq;
#pragma unroll
            for (int bj = 0; bj < 2; ++bj)
#pragma unroll
                for (int n = 0; n < 2; ++n)
#pragma unroll
                    for (int j = 0; j < 4; ++j) { bf16_t* cp = PT + (size_t)(colbase + bj * 128 + 4 * n + j) * MR + row0;
#pragma unroll
                        for (int ai = 0; ai < 2; ++ai)
#pragma unroll
                            for (int m = 0; m < 4; ++m) cp[ai * 128 + m * 16] = (bf16_t)f2bf(acc[ai][bj][m][n][j]);
                        asm volatile("" ::: "memory"); }
        } else {
            if (wc == 0) {
#pragma unroll
                for (int ai = 0; ai < 2; ++ai)
#pragma unroll
                    for (int m = 0; m < 4; ++m) { float* rowp = LR + (size_t)(row0 + ai * 128 + m * 16) * 32 + 8 * fq;
                        *(pg8::f32x4*)(rowp) = acc[ai][0][m][0]; *(pg8::f32x4*)(rowp + 4) = acc[ai][0][m][1]; }
            }
        }
    }
};
struct EpiGlu {
    static constexpr bool PERM = true, AFTER_DRAIN = false;
    const bf16_t* G5; const bf16_t* P; bf16_t* GATED; const float* bias;
    __device__ __forceinline__ void operator()(const pg8::f32x4 (&acc)[2][2][4][2], const pg8::Unit& u, int wr, int wc, int fr, int fq) const {
        const int row0 = u.pm * 256 + wr * 64 + fr, col0 = u.pn * 256 + wc * 32 + 8 * fq;
#pragma unroll
        for (int ai = 0; ai < 2; ++ai)
#pragma unroll
            for (int m = 0; m < 4; ++m) { const size_t row = (size_t)(row0 + ai * 128 + m * 16);
#pragma unroll
                for (int bj = 0; bj < 2; ++bj) { const int col = col0 + bj * 128;
                    float g[8], sg[8], res[8]; unpack8(*(const u32x4*)(G5 + row * 512 + col), g); unpack8(*(const u32x4*)(P + row * LDP + PC_S5G + col), sg);
                    const pg8::f32x4 b0 = *(const pg8::f32x4*)(bias + col), b1 = *(const pg8::f32x4*)(bias + col + 4);
#pragma unroll
                    for (int j = 0; j < 4; ++j) { res[j] = g[j] * sigmoidf_(acc[ai][bj][m][0][j] + b0[j]) * siluf_(sg[j]); res[4 + j] = g[4 + j] * sigmoidf_(acc[ai][bj][m][1][j] + b1[j]) * siluf_(sg[4 + j]); }
                    *(u32x4*)(GATED + row * D + col) = pack8(res); } }
    }
};
struct EpiOut {
    static constexpr bool PERM = false, AFTER_DRAIN = false;
    const float* xl_old; const float* xc_old; float* xl_new; float* xc_new; const float* mod;
    __device__ __forceinline__ void operator()(const pg8::f32x4 (&acc)[2][2][4][2], const pg8::Unit& u, int wr, int wc, int fr, int fq) const {
        const int row0 = u.pm * 256 + wr * 64 + fr, col0 = u.pn * 256 + wc * 32 + 4 * fq;
        const bool lat = u.pm < 64;
        const float* xo = lat ? xl_old : xc_old - (size_t)NLAT * D; float* xn = lat ? xl_new : xc_new - (size_t)NLAT * D;
#pragma unroll
        for (int ai = 0; ai < 2; ++ai) {
            const int v = lat ? ((u.pm * 256 + ai * 128) >> 12) : 4;
            const float* gt = mod + (size_t)v * ADA + 2 * D;
#pragma unroll
            for (int m = 0; m < 4; ++m) { const size_t off = (size_t)(row0 + ai * 128 + m * 16) * D + col0;
#pragma unroll
                for (int bj = 0; bj < 2; ++bj)
#pragma unroll
                    for (int n = 0; n < 2; ++n) { const int cc = bj * 128 + n * 16; const pg8::f32x4 gv = *(const pg8::f32x4*)(gt + col0 + cc), xv = *(const pg8::f32x4*)(xo + off + cc);
                        *(pg8::f32x4*)(xn + off + cc) = xv + gv * acc[ai][bj][m][n]; } }
        }
    }
};
#ifndef MK_EN
#define MK_EN 0xffff
#endif
#define EN(x) ((MK_EN >> (x)) & 1)
constexpr int PH_PREP = 0, PH_PER_LAYER = 7, PH_FNORM = 1 + 2 * PH_PER_LAYER, N_PHASES = PH_FNORM + 1;

__global__ void __launch_bounds__(NT, 2) fwd_kernel(Args a) {
    extern __shared__ __attribute__((aligned(16))) unsigned char lds_raw[];
    LAS unsigned char* lds = (LAS unsigned char*)lds_raw;
    const int G = gridDim.x;

    for (int ph = a.ph_lo; ph < a.ph_hi; ++ph) {
        int tid = threadIdx.x; asm volatile("" : "+v"(tid));
        int bid = blockIdx.x; asm volatile("" : "+s"(bid));
        const int lane = tid & 63, wave = __builtin_amdgcn_readfirstlane(tid >> 6);
        unsigned char* ws = a.ws; asm volatile("" : "+s"(ws));
        float* MOD = (float*)(ws + WS_MOD);
        if (EN(0) && ph == PH_PREP) {
            for (int it = bid; it < 1840; it += G) {
                if (it < 768) prep_adaln(a.in[I_C], a.in[I_CCTX], a.in[I_ADAW], a.in[I_ADAB], MOD, it, (LAS float*)lds, tid);
                else if (it < 784) prep_s5(a, ws, it - 768, tid);
                else { const bool big = it < 1808; const int r = big ? it - 784 : it - 1808, l = big ? (r >> 9) : 0, t0 = (big ? (r & 511) : r) * 8;
                    float* H3o = big ? (float*)(ws + WS_H3) + (size_t)l * 4096 * 64 : (float*)(ws + WS_H3C);
                    prep_hymlp(a, H3o, l, big ? 4096 : 256, t0, (LAS float*)lds, (LAS float*)(lds + 2048), (LAS float*)(lds + 4096), tid); }
            }
        } else if (EN(1) && ph == PH_FNORM) {
            const float* fw = a.in[I_FNW];
            for (int row = bid * NWAVES + wave; row < NLAT; row += G * NWAVES) {
                float* xr = a.out + (size_t)row * D; f32x4 v[8]; float ss = 0.f;
#pragma unroll
                for (int j = 0; j < 8; ++j) { v[j] = ((const f32x4*)xr)[lane + 64 * j]; ss += (v[j].x * v[j].x + v[j].y * v[j].y) + (v[j].z * v[j].z + v[j].w * v[j].w); }
                const float rstd = rsqrtf(wave_sum(ss) * (1.0f / D) + EPS);
#pragma unroll
                for (int j = 0; j < 8; ++j) { const f32x4 w = *(const f32x4*)(fw + 4 * (lane + 64 * j)); ((f32x4*)xr)[lane + 64 * j] = v[j] * rstd * w; }
            }
        } else {
            const int l = (ph - 1) / PH_PER_LAYER, sub = (ph - 1) % PH_PER_LAYER;
            const bool ctx_out = (l == 0);
            const int Mrows = ctx_out ? MR : NLAT;
            if (EN(2) && sub == 0) {
                LAS float* scr = (LAS float*)(lds + wave * 8704);
                const int gw = bid * NWAVES + wave, NGW = G * NWAVES;
                constexpr int I_W1 = 32 * (NPAD / 32), I_W2 = 32 * 64, I_W3 = 8 * 16;
                for (int it = gw; it < I_W1 + I_W2 + I_W3; it += NGW) {
                    int r = it;
                    if (r < I_W1) { const int kb = r / (NPAD / 32), nb = r % (NPAD / 32); transpose_item(a.in[I_WIN] + (size_t)l * D * INW, INW, win_srccol(nb * 32), kb * 64, (bf16_t*)(ws + WS_WIN), D, nb * 32, scr, lane); continue; }
                    r -= I_W1;
                    if (r < I_W2) { const int kb = r / 64, nb = r % 64; transpose_item(a.in[I_WOUT] + (size_t)l * D * D, D, nb * 32, kb * 64, (bf16_t*)(ws + WS_WOUT), D, nb * 32, scr, lane); continue; }
                    r -= I_W2;
                    { const int kb = r / 16, nb = r % 16; transpose_item(a.in[I_GLUW] + (size_t)l * 512 * 512, 512, nb * 32, kb * 64, (bf16_t*)(ws + WS_GLUW), 512, nb * 32, scr, lane); }
                }
                const float* nw = a.in[I_NORMW] + (size_t)l * D;
                for (int row = gw; row < MR; row += NGW) {
                    const float* xr; int v;
                    if (row < NLAT) { xr = (l == 0 ? a.in[I_X] : a.out) + (size_t)row * D; v = row >> 12; }
                    else { xr = (l == 0 ? a.in[I_CTX] : (const float*)(ws + WS_XC1)) + (size_t)(row - NLAT) * D; v = 4; }
                    norm_row(xr, nw, MOD + (size_t)(l * 5 + v) * ADA, (bf16_t*)(ws + WS_H) + (size_t)row * D, lane);
                }
                __syncthreads();
                const int nfilt = ctx_out ? 1024 : 512;
                for (int it = bid; it < nfilt; it += G) { if (it < 512) filt_item(a, ws, lds, l, it, tid); else filt_ctx_item(a, ws, lds, it - 512, tid); }
            } else if (EN(3) && sub == 1) {
                pg8::Gemm g{(const bf16_t*)(ws + WS_H), (const bf16_t*)(ws + WS_WIN), MR, NPAD, D}; pg8::StaticOrder S; S.init(MR, NPAD, G, bid);
                EpiInProj E{(bf16_t*)(ws + WS_P), (bf16_t*)(ws + WS_PT), (float*)(ws + WS_LR)};
                pg8::gemm_phase<EpiInProj, pg8::StaticOrder>(lds, g, S, E, tid);
            } else if (EN(4) && sub == 2) {
                for (int row = bid * NWAVES + wave; row < MR; row += G * NWAVES) rope_row(a, ws, l, row, lane);
            } else if (EN(5) && sub == 3) {
                const int nit = ctx_out ? 1344 : 832;
                const bf16_t* P = (const bf16_t*)(ws + WS_P);
                for (int it = bid; it < nit; it += G) {
                    if (it < 32) ret_chain(P, (bf16_t*)(ws + WS_OB) + (size_t)(it & 1) * OBSZ, it >> 3, (it >> 1) & 3, it & 1, ctx_out, wave, lane);
                    else if (it < 64) { const int r = it - 32; gla_chain(P, (const bf16_t*)(ws + WS_WIN) + (size_t)(r & 1) * MR * 256, (bf16_t*)(ws + WS_OB) + (size_t)(2 + (r & 1)) * OBSZ, r >> 3, (r >> 1) & 3, r & 1, ctx_out, wave, lane); }
                    else if (it < 320) { const int r = it - 64; s5_chain(a, ws, lds, l, r >> 6, (r >> 1) & 31, r & 1, ctx_out, tid); }
                    else if (it < 832) hyena_item(a, ws, lds, l, it - 320, tid);
                    else hyena_ctx_item(a, ws, lds, it - 832, tid);
                }
            } else if (EN(6) && sub == 4) {
                for (int row = bid * NWAVES + wave; row < Mrows; row += G * NWAVES) merge_row(a, ws, l, row, lane);
            } else if (EN(7) && sub == 5) {
                pg8::Gemm g{(const bf16_t*)(ws + WS_KF), (const bf16_t*)(ws + WS_GLUW), Mrows, 512, 512}; pg8::StaticOrder S; S.init(Mrows, 512, G, bid);
                EpiGlu E{(const bf16_t*)(ws + WS_KF), (const bf16_t*)(ws + WS_P), (bf16_t*)(ws + WS_H), a.in[I_GLUB] + (size_t)l * 512};
                pg8::gemm_phase<EpiGlu, pg8::StaticOrder>(lds, g, S, E, tid);
            } else if (EN(8)) {
                pg8::Gemm g{(const bf16_t*)(ws + WS_H), (const bf16_t*)(ws + WS_WOUT), Mrows, D, D}; pg8::StaticOrder S; S.init(Mrows, D, G, bid);
                EpiOut E{l == 0 ? a.in[I_X] : a.out, a.in[I_CTX], a.out, (float*)(ws + WS_XC1), MOD + (size_t)l * 5 * ADA};
                pg8::gemm_phase<EpiOut, pg8::StaticOrder>(lds, g, S, E, tid);
            }
        }
        if (ph + 1 < a.ph_hi) { cg::this_grid().sync(); }
    }
}

#ifndef MK_LAUNCH_PER_PHASE
#define MK_LAUNCH_PER_PHASE 1
#endif
extern "C" void kernel_launch(void* const* d_in, const int* in_sizes, int n_in, void* d_out, int out_size, void* d_ws, size_t ws_size, hipStream_t stream) {
    static int grid = 0;
    if (grid == 0) {
        if (n_in != N_IN || out_size != NLAT * D || ws_size < WS_END) { fprintf(stderr, "kernel_launch: unexpected shapes (n_in %d, out %d, ws %zu < %zu); nothing launched\n", n_in, out_size, ws_size, (size_t)WS_END); grid = -1; return; }
        int dev = 0, cus = 0, per_cu = 0;
        if (hipGetDevice(&dev) != hipSuccess || hipDeviceGetAttribute(&cus, hipDeviceAttributeMultiprocessorCount, dev) != hipSuccess) { grid = -1; return; }
        if (hipFuncSetAttribute((const void*)fwd_kernel, hipFuncAttributeMaxDynamicSharedMemorySize, LDS_BYTES) != hipSuccess) { fprintf(stderr, "kernel_launch: hipFuncSetAttribute failed\n"); grid = -1; return; }
        if (hipOccupancyMaxActiveBlocksPerMultiprocessor(&per_cu, (const void*)fwd_kernel, NT, LDS_BYTES) != hipSuccess || per_cu < 1) { fprintf(stderr, "kernel_launch: occupancy query says %d blocks per CU\n", per_cu); per_cu = 1; }
        (void)hipGetLastError();
        grid = cus;
    }
    if (grid < 0) return;
    (void)hipMemsetAsync((char*)d_ws + WS_CTL, 0, WS_ZERO_BYTES, stream);
    Args a{};
    for (int i = 0; i < N_IN; ++i) a.in[i] = (const float*)d_in[i];
    a.out = (float*)d_out; a.ws = (unsigned char*)d_ws;
#if MK_LAUNCH_PER_PHASE
    for (int ph = 0; ph < N_PHASES; ++ph) {
        a.ph_lo = ph; a.ph_hi = ph + 1;
        hipLaunchKernelGGL(fwd_kernel, dim3(grid), dim3(NT), LDS_BYTES, stream, a);
    }
#else
    a.ph_lo = 0; a.ph_hi = N_PHASES;
    void* args[] = {&a};
    hipError_t e = hipLaunchCooperativeKernel((const void*)fwd_kernel, dim3(grid), dim3(NT), args, LDS_BYTES, stream);
    if (e != hipSuccess) fprintf(stderr, "kernel_launch: cooperative launch failed: %s (grid %d)\n", hipGetErrorString(e), grid);
#endif
}
```

```cpp
#include <hip/hip_runtime.h>
#include <hip/hip_cooperative_groups.h>
#include <cstdio>
#include <cstdint>
namespace cg = cooperative_groups;

#define LAS __attribute__((address_space(3)))
typedef unsigned short bf16_t;
typedef float f32x4 __attribute__((ext_vector_type(4)));
typedef float f32x2 __attribute__((ext_vector_type(2)));
typedef unsigned u32x4 __attribute__((ext_vector_type(4)));
typedef unsigned u32x2 __attribute__((ext_vector_type(2)));

constexpr int D = 2048, NB = 4, SEQL = 4096, LC = 256, NLAT = NB * SEQL, NCTX = NB * LC, MR = NLAT + NCTX;
constexpr int BR = 512, INW = 6688, NPAD = 6912, LDP = 4608, ADA = 3 * D;
constexpr int NT = 512, NWAVES = 8;
constexpr float EPS = 1e-6f;
constexpr int PC_S5U = 0, PC_S5G = 512, PC_RQ = 1024, PC_RK = 1536, PC_RV = 2048, PC_RG = 2560, PC_GQ = 3072, PC_GK = 3328, PC_GV = 3584, PC_GG = 4096;
constexpr int PT_V = 0, PT_G1 = 512, PT_G2 = 1024, PT_HG = 1536;
constexpr int FFTN = 8192;

enum { I_X = 0, I_C, I_CTX, I_CCTX, I_NORMW, I_ADAW, I_ADAB, I_WIN, I_WOUT, I_S5ARE, I_S5AIM, I_S5LDT, I_S5BRE, I_S5BIM, I_S5CRE, I_S5CIM,
       I_S5D, I_GLUW, I_GLUB, I_HCW, I_HCB, I_HW1, I_HB1, I_HF1, I_HW2, I_HB2, I_HF2, I_HW3, I_HB3, I_HF3, I_HW4, I_HBIAS, I_RNW, I_GGW, I_GGB, I_GNW, I_FNW, N_IN };

constexpr size_t al256(size_t x) { return (x + 255) & ~(size_t)255; }
constexpr size_t WS_CTL  = 0;
constexpr size_t WS_MOD  = WS_CTL + 65536;
constexpr size_t WS_ZERO_BYTES = 65536 + al256((size_t)2 * 5 * ADA * 4);
constexpr size_t WS_S5AB = WS_MOD + al256((size_t)2 * 5 * ADA * 4);
constexpr size_t WS_S5BT = WS_S5AB + (size_t)2 * 2 * 32 * 64 * 8;
constexpr size_t WS_H3   = WS_S5BT + (size_t)2 * 2 * 32 * 64 * 16 * 8;
constexpr size_t WS_H3C  = WS_H3 + (size_t)2 * 4096 * 64 * 4;
constexpr size_t WS_KC   = WS_H3C + (size_t)256 * 64 * 4;
constexpr size_t WS_LR   = WS_KC + (size_t)2 * 512 * 512 * 4;
constexpr size_t WS_XC1  = WS_LR + (size_t)MR * 32 * 4;
constexpr size_t WS_WOUT = WS_XC1 + (size_t)NCTX * D * 4;
constexpr size_t WS_GLUW = WS_WOUT + (size_t)D * D * 2;
constexpr size_t WS_WIN  = WS_GLUW + (size_t)512 * 512 * 2;
constexpr size_t WS_H    = WS_WIN + (size_t)NPAD * D * 2;
constexpr size_t WS_P    = WS_H + (size_t)MR * D * 2;
constexpr size_t WS_PT   = WS_P + (size_t)MR * LDP * 2;
constexpr size_t WS_KF   = WS_PT + (size_t)2048 * MR * 2;
constexpr size_t WS_OB   = WS_KF + (size_t)2 * 512 * FFTN * 8;
constexpr size_t WS_END  = WS_OB + (size_t)6 * MR * 512 * 2;
constexpr size_t OBSZ = (size_t)MR * 512;

constexpr int LDS_BYTES = 131072 + 2048;
constexpr int LDS_CTL_OFF = 131072;

__device__ __forceinline__ unsigned f2bf(float f) { unsigned u = __float_as_uint(f); return (u + 0x7fffu + ((u >> 16) & 1u)) >> 16; }
__device__ __forceinline__ unsigned pk2(float lo, float hi) { return f2bf(lo) | (f2bf(hi) << 16); }
__device__ __forceinline__ float bf2f(bf16_t b) { return __uint_as_float((unsigned)b << 16); }
__device__ __forceinline__ float bflo(unsigned w) { return __uint_as_float(w << 16); }
__device__ __forceinline__ float bfhi(unsigned w) { return __uint_as_float(w & 0xffff0000u); }
__device__ __forceinline__ void unpack8(const u32x4 r, float (&f)[8]) { f[0] = bflo(r.x); f[1] = bfhi(r.x); f[2] = bflo(r.y); f[3] = bfhi(r.y); f[4] = bflo(r.z); f[5] = bfhi(r.z); f[6] = bflo(r.w); f[7] = bfhi(r.w); }
__device__ __forceinline__ u32x4 pack8(const float (&f)[8]) { u32x4 o; o.x = pk2(f[0], f[1]); o.y = pk2(f[2], f[3]); o.z = pk2(f[4], f[5]); o.w = pk2(f[6], f[7]); return o; }
__device__ __forceinline__ float sigmoidf_(float x) { return 1.0f / (1.0f + __expf(-x)); }
__device__ __forceinline__ float siluf_(float x) { return x * sigmoidf_(x); }
__device__ __forceinline__ float gelu_tanh(float x) { const float u = 0.7978845608028654f * (x + 0.044715f * x * x * x); return 0.5f * x * (1.0f + tanhf(u)); }
__device__ __forceinline__ float wave_sum(float v) {
#pragma unroll
    for (int o = 1; o < 64; o <<= 1) v += __shfl_xor(v, o);
    return v;
}
#define LDS_WAIT() asm volatile("s_waitcnt lgkmcnt(0)" ::: "memory")

struct Args { const float* in[N_IN]; float* out; unsigned char* ws; int ph_lo, ph_hi; };
namespace pg8 {
#define PG8_LAS __attribute__((address_space(3)))
typedef unsigned short bf16_t;
typedef short bf16x8 __attribute__((ext_vector_type(8)));
typedef float f32x4 __attribute__((ext_vector_type(4)));
typedef unsigned u32x4 __attribute__((ext_vector_type(4)));
constexpr int BM = 256, BK = 64, HALF = 128, HTB = HALF * BK * 2, STAGE_BYTES = 8 * HTB, NXCD = 8, WGM = 8;

__host__ __device__ __forceinline__ int lds_byte(int r, int c) { const int st = (r >> 4) * 2 + (c >> 5), rr = r & 15, cc = c & 31, ob = rr * 64 + cc * 2; return st * 1024 + (ob ^ (((ob >> 9) & 1) << 5)); }
__host__ __device__ __forceinline__ void stage_rc(int b, int& R, int& C) { const int st = b / 1024, sb = b % 1024, swz = sb ^ (((sb >> 9) & 1) << 5); R = (st >> 1) * 16 + swz / 64; C = (st & 1) * 32 + (swz % 64) / 2; }
__host__ __device__ __forceinline__ int perm32(int rho) { const int n = rho >> 4, i = rho & 15; return 8 * (i >> 2) + 4 * n + (i & 3); }

struct Unit { int pm, pn; };
struct Gemm { const bf16_t* A; const bf16_t* Bt; int M, N, K; };

struct StaticOrder {
    int nM, nN, nwg, G, c;
    __host__ __device__ void init(int M, int N, int G_, int c_) { nM = M / BM; nN = N / BM; nwg = nM * nN; G = G_; c = c_; }
    __host__ __device__ bool next(int i, Unit& u) const {
        const long L = (long)i * G + c; if (L >= nwg) return false;
        int wgid = (int)L; { const int q = nwg / NXCD, r = nwg % NXCD, xcd = wgid % NXCD, off = wgid / NXCD; wgid = (xcd < r ? xcd * (q + 1) : r * (q + 1) + (xcd - r) * q) + off; }
        const int nig = WGM * nN, gid = wgid / nig, fm = gid * WGM, gsz = (nM - fm) < WGM ? (nM - fm) : WGM;
        u.pm = fm + ((wgid % nig) % gsz); u.pn = (wgid % nig) / gsz; return true;
    }
    __device__ __forceinline__ void a_ready(const Unit&) const {}
    __device__ __forceinline__ void done(const Unit&) const {}
};

template <class Epi, class Sched>
__device__ __forceinline__ void gemm_phase(PG8_LAS unsigned char* lds, const Gemm g, const Sched& S, const Epi& E, const int tid) {
    const int wid = __builtin_amdgcn_readfirstlane(tid >> 6), lane = tid & 63, wr = wid >> 2, wc = wid & 3, fr = lane & 15, fq = lane >> 4;
    const int K = g.K, nt = K / BK;
    unsigned voffA[2], voffB[2];
#pragma unroll
    for (int i = 0; i < 2; ++i) { int R, C; stage_rc(tid * 16 + i * 8192, R, C); const int Rb = Epi::PERM ? ((R & ~31) + perm32(R & 31)) : R;
        voffA[i] = (unsigned)(R * K + C) * 2u; voffB[i] = (unsigned)(Rb * K + C) * 2u; }
    const size_t kstep = (size_t)(BK * 2);
    const size_t hstep = (size_t)HALF * K * 2;
    const size_t tstep = 2 * hstep;
    const unsigned ldsw = (unsigned)wid * 1024u;
    const int aoff = lds_byte(wr * 64 + fr, fq * 8), boff = lds_byte(wc * 32 + fr, fq * 8);
#define PG8_SA(b, h) (((b) * 2 + (h)) * HTB)
#define PG8_SB(b, h) ((4 + (b) * 2 + (h)) * HTB)
#define PG8_STAGE(bufoff, gbase, voff) do { _Pragma("unroll") for (int _i = 0; _i < 2; ++_i) \
        __builtin_amdgcn_global_load_lds((const unsigned*)((const char*)(gbase) + (voff)[_i]), (PG8_LAS unsigned*)(lds + (bufoff) + ldsw + _i * 8192), 16, 0, 0); } while (0)
#define PG8_LDA(dst, b, h) do { _Pragma("unroll") for (int m = 0; m < 4; ++m) _Pragma("unroll") for (int k = 0; k < 2; ++k) dst[m][k] = *(const PG8_LAS bf16x8*)(lds + PG8_SA(b, h) + aoff + m * 2048 + k * 1024); } while (0)
#define PG8_LDB(dst, b, h) do { _Pragma("unroll") for (int n = 0; n < 2; ++n) _Pragma("unroll") for (int k = 0; k < 2; ++k) dst[n][k] = *(const PG8_LAS bf16x8*)(lds + PG8_SB(b, h) + boff + n * 2048 + k * 1024); } while (0)
#define PG8_MMA(ai, bj, At, Bt) do { __builtin_amdgcn_s_setprio(1); _Pragma("unroll") for (int m = 0; m < 4; ++m) _Pragma("unroll") for (int n = 0; n < 2; ++n) _Pragma("unroll") for (int k = 0; k < 2; ++k) \
        acc[ai][bj][m][n] = __builtin_amdgcn_mfma_f32_16x16x32_bf16(Bt[n][k], At[m][k], acc[ai][bj][m][n], 0, 0, 0); __builtin_amdgcn_s_setprio(0); } while (0)
#define PG8_WAIT_V(n) asm volatile("s_waitcnt vmcnt(" #n ")" ::: "memory")
#define PG8_WAIT_L(n) asm volatile("s_waitcnt lgkmcnt(" #n ")" ::: "memory")
#define PG8_BAR __builtin_amdgcn_s_barrier()
#define PG8_SCHED __builtin_amdgcn_sched_barrier(0)
    Unit cur, nxt; int ui = 0;
    if (!S.next(0, cur)) return;
    f32x4 acc[2][2][4][2];
#pragma unroll
    for (int a = 0; a < 2; ++a)
#pragma unroll
        for (int b = 0; b < 2; ++b)
#pragma unroll
            for (int m = 0; m < 4; ++m)
#pragma unroll
                for (int n = 0; n < 2; ++n) acc[a][b][m][n] = (f32x4){0.f, 0.f, 0.f, 0.f};
    bf16x8 At[4][2], B0[2][2], B1[2][2];
    const char* cA = (const char*)g.A + (size_t)cur.pm * tstep; const char* cB = (const char*)g.Bt + (size_t)cur.pn * tstep;
    S.a_ready(cur);
    PG8_STAGE(PG8_SB(0, 0), cB, voffB); PG8_STAGE(PG8_SA(0, 0), cA, voffA); PG8_STAGE(PG8_SB(0, 1), cB + hstep, voffB); PG8_STAGE(PG8_SA(0, 1), cA + hstep, voffA);
    if (wr == 1) PG8_BAR;
    PG8_WAIT_V(4); PG8_BAR;
    PG8_STAGE(PG8_SB(1, 0), cB + kstep, voffB); PG8_STAGE(PG8_SA(1, 0), cA + kstep, voffA); PG8_STAGE(PG8_SB(1, 1), cB + hstep + kstep, voffB);
    PG8_WAIT_V(6); PG8_BAR;
    for (;;) {
        const bool has_next = S.next(ui + 1, nxt);
        const char* nA = has_next ? (const char*)g.A + (size_t)nxt.pm * tstep : cA; const char* nB = has_next ? (const char*)g.Bt + (size_t)nxt.pn * tstep : cB;
        for (int t = 0; t < nt; t += 2) {
            const bool last = (t == nt - 2);
            const char* a1 = cA + (size_t)(t + 1) * kstep;
            const char* a2 = last ? nA : cA + (size_t)(t + 2) * kstep; const char* b2 = last ? nB : cB + (size_t)(t + 2) * kstep;
            const char* a3 = a2 + kstep; const char* b3 = b2 + kstep;
            if (last && has_next) S.a_ready(nxt);
            PG8_LDB(B0, 0, 0); PG8_SCHED; PG8_LDA(At, 0, 0); PG8_STAGE(PG8_SA(1, 1), a1 + hstep, voffA);
            PG8_WAIT_L(8); PG8_BAR; PG8_WAIT_L(0); PG8_MMA(0, 0, At, B0); PG8_BAR; PG8_SCHED;
            PG8_LDB(B1, 0, 1); PG8_STAGE(PG8_SB(0, 0), b2, voffB);
            PG8_BAR; PG8_WAIT_L(0); PG8_MMA(0, 1, At, B1); PG8_BAR;
            PG8_LDA(At, 0, 1); PG8_STAGE(PG8_SA(0, 0), a2, voffA);
            PG8_BAR; PG8_WAIT_L(0); PG8_MMA(1, 0, At, B0); PG8_BAR; PG8_SCHED;
            PG8_STAGE(PG8_SB(0, 1), b2 + hstep, voffB);
            PG8_WAIT_V(6); PG8_BAR; PG8_MMA(1, 1, At, B1); PG8_BAR;
            PG8_LDB(B0, 1, 0); PG8_SCHED; PG8_LDA(At, 1, 0); PG8_STAGE(PG8_SA(0, 1), a2 + hstep, voffA);
            PG8_WAIT_L(8); PG8_BAR; PG8_WAIT_L(0); PG8_MMA(0, 0, At, B0); PG8_BAR; PG8_SCHED;
            PG8_LDB(B1, 1, 1); PG8_STAGE(PG8_SB(1, 0), b3, voffB);
            PG8_BAR; PG8_WAIT_L(0); PG8_MMA(0, 1, At, B1); PG8_BAR;
            PG8_LDA(At, 1, 1); PG8_STAGE(PG8_SA(1, 0), a3, voffA);
            PG8_BAR; PG8_WAIT_L(0); PG8_MMA(1, 0, At, B0); PG8_BAR; PG8_SCHED;
            PG8_STAGE(PG8_SB(1, 1), b3 + hstep, voffB);
            PG8_WAIT_V(6); PG8_BAR; PG8_MMA(1, 1, At, B1); PG8_BAR;
        }
        E(acc, cur, wr, wc, fr, fq); S.done(cur);
        if (!has_next) break;
#pragma unroll
        for (int a = 0; a < 2; ++a)
#pragma unroll
            for (int b = 0; b < 2; ++b)
#pragma unroll
                for (int m = 0; m < 4; ++m)
#pragma unroll
                    for (int n = 0; n < 2; ++n) acc[a][b][m][n] = (f32x4){0.f, 0.f, 0.f, 0.f};
        cur = nxt; cA = nA; cB = nB; ++ui;
    }
    PG8_WAIT_V(0);
    if (wr == 0) PG8_BAR;
    PG8_BAR;
#undef PG8_SA
#undef PG8_SB
#undef PG8_STAGE
#undef PG8_LDA
#undef PG8_LDB
#undef PG8_MMA
#undef PG8_WAIT_V
#undef PG8_WAIT_L
#undef PG8_BAR
#undef PG8_SCHED
}
}
__device__ __forceinline__ void prep_adaln(const float* c, const float* cctx, const float* adaw, const float* adab, float* MOD, int it, LAS float* sv, int tid) {
    const int l = it / 384, r = it % 384, ntile = r >> 5, ks = r & 31, k0 = ks * 64;
    if (tid < 320) { const int v = tid >> 6, k = tid & 63; const float cv = v < 4 ? c[v * D + k0 + k] : cctx[k0 + k]; sv[tid] = cv / (1.0f + expf(-cv)); }
    __syncthreads();
    const int n = ntile * 512 + tid; const float* w = adaw + (size_t)l * D * ADA + (size_t)k0 * ADA + n;
    float acc[5] = {0.f, 0.f, 0.f, 0.f, 0.f};
#pragma unroll 8
    for (int k = 0; k < 64; ++k) { const float wv = w[(size_t)k * ADA];
#pragma unroll
        for (int v = 0; v < 5; ++v) acc[v] += sv[v * 64 + k] * wv; }
    if (ks == 0) { const float bb = adab[l * ADA + n];
#pragma unroll
        for (int v = 0; v < 5; ++v) acc[v] += bb; }
#pragma unroll
    for (int v = 0; v < 5; ++v) atomicAdd(MOD + (size_t)(l * 5 + v) * ADA + n, acc[v]);
    __syncthreads();
}

__device__ __forceinline__ void prep_s5(const Args& a, unsigned char* ws, int it, int tid) {
    const int idx = it * 512 + tid;
    const float a_re = a.in[I_S5ARE][idx], a_im = a.in[I_S5AIM][idx], ldt = a.in[I_S5LDT][idx >> 6];
    const float dt = expf(ldt), mag = expf(a_re * dt);
    float sn, cs; sincosf(a_im * dt, &sn, &cs);
    const float ab_re = mag * cs, ab_im = mag * sn, den = a_re * a_re + a_im * a_im, nr = ab_re - 1.0f;
    const float co_re = (nr * a_re + ab_im * a_im) / den, co_im = (ab_im * a_re - nr * a_im) / den;
    ((f32x2*)(ws + WS_S5AB))[idx] = (f32x2){ab_re, ab_im};
    const float* bre = a.in[I_S5BRE] + (size_t)idx * 16; const float* bim = a.in[I_S5BIM] + (size_t)idx * 16;
    f32x2* bt = (f32x2*)(ws + WS_S5BT) + (size_t)idx * 16;
#pragma unroll
    for (int i = 0; i < 16; ++i) { const float br = bre[i], bi = bim[i]; bt[i] = (f32x2){co_re * br - co_im * bi, co_re * bi + co_im * br}; }
}

__device__ __forceinline__ void prep_hymlp(const Args& a, float* H3out, int l, int Lx, int t0, LAS float* zs, LAS float* h1, LAS float* h2, int tid) {
    const int pos = tid >> 6, f = tid & 63, t = t0 + pos;
    if (f < 33) {
        float z;
        if (f == 0) z = (float)t / (float)(Lx - 1);
        else { const int j = (f - 1) & 15; const float fj = 1e-4f + (float)j * ((15.0f - 1e-4f) / 15.0f); const float wpos = (6.283185307179586f * (float)t) / (float)Lx; const float arg = fj * wpos;
               z = (f <= 16) ? cosf(arg) : -sinf(arg); }
        zs[pos * 36 + f] = z;
    }
    __syncthreads();
    const float* w1 = a.in[I_HW1] + (size_t)l * 33 * 64; const float* w2 = a.in[I_HW2] + (size_t)l * 64 * 64; const float* w3 = a.in[I_HW3] + (size_t)l * 64 * 64;
    float s = a.in[I_HB1][l * 64 + f];
#pragma unroll 3
    for (int j = 0; j < 33; ++j) s += zs[pos * 36 + j] * w1[j * 64 + f];
    h1[pos * 64 + f] = sinf(a.in[I_HF1][l * 64 + f] * s);
    __syncthreads();
    s = a.in[I_HB2][l * 64 + f];
#pragma unroll 4
    for (int j = 0; j < 64; ++j) s += h1[pos * 64 + j] * w2[j * 64 + f];
    h2[pos * 64 + f] = sinf(a.in[I_HF2][l * 64 + f] * s);
    __syncthreads();
    s = a.in[I_HB3][l * 64 + f];
#pragma unroll 4
    for (int j = 0; j < 64; ++j) s += h2[pos * 64 + j] * w3[j * 64 + f];
    H3out[(size_t)t * 64 + f] = sinf(a.in[I_HF3][l * 64 + f] * s);
    __syncthreads();
}

__device__ __forceinline__ void transpose_item(const float* W, int ldw, int srccol0, int k0, bf16_t* WT, int K, int dstrow0, LAS float* scr, int lane) {
    if (srccol0 >= 0) {
#pragma unroll 8
        for (int i = 0; i < 32; ++i) { const int kk = 2 * i + (lane >> 5); scr[kk * 33 + (lane & 31)] = W[(size_t)(k0 + kk) * ldw + srccol0 + (lane & 31)]; }
    } else {
#pragma unroll 8
        for (int i = 0; i < 32; ++i) { const int kk = 2 * i + (lane >> 5); scr[kk * 33 + (lane & 31)] = 0.f; }
    }
    LDS_WAIT();
    const int c = lane & 7;
#pragma unroll
    for (int j = 0; j < 4; ++j) { const int n = (lane >> 3) + 8 * j; const LAS float* s = scr + (8 * c) * 33 + n;
        u32x4 o; o.x = pk2(s[0 * 33], s[1 * 33]); o.y = pk2(s[2 * 33], s[3 * 33]); o.z = pk2(s[4 * 33], s[5 * 33]); o.w = pk2(s[6 * 33], s[7 * 33]);
        *(u32x4*)(WT + (size_t)(dstrow0 + n) * K + k0 + 8 * c) = o; }
    LDS_WAIT();
}
__device__ __forceinline__ int win_srccol(int n) { return n < 6144 ? n : (n < 6656 ? n + 32 : (n < 6688 ? n - 512 : -1)); }

__device__ __forceinline__ void norm_row(const float* xrow, const float* nw, const float* mod, bf16_t* hrow, int lane) {
    f32x4 v[8]; float ss = 0.f;
#pragma unroll
    for (int j = 0; j < 8; ++j) { v[j] = ((const f32x4*)xrow)[lane + 64 * j]; ss += (v[j].x * v[j].x + v[j].y * v[j].y) + (v[j].z * v[j].z + v[j].w * v[j].w); }
    const float rstd = rsqrtf(wave_sum(ss) * (1.0f / D) + EPS);
#pragma unroll
    for (int j = 0; j < 8; ++j) { const int k = 4 * (lane + 64 * j);
        const f32x4 w = *(const f32x4*)(nw + k), sh = *(const f32x4*)(mod + k), sc = *(const f32x4*)(mod + D + k);
        const f32x4 o = v[j] * rstd * w * (sc + 1.0f) + sh;
        u32x2 pk; pk.x = pk2(o.x, o.y); pk.y = pk2(o.z, o.w);
        *(u32x2*)(hrow + k) = pk; }
}

__device__ __forceinline__ void fft_twiddles(LAS f32x2* W, int tid) {
    for (int j = tid; j < 4096; j += NT) { float s, c; sincospif(-(float)j * (1.0f / 4096.0f), &s, &c); W[j] = (f32x2){c, s}; }
}
template <int R, int BETA, bool INV> __device__ __forceinline__ void fft_pass(LAS f32x2* X, const LAS f32x2* W, int tid) {
    constexpr int LOW = BETA - R + 1, NG = FFTN >> R;
    for (int gi = tid; gi < NG; gi += NT) {
        const int base = ((gi >> LOW) << (BETA + 1)) | (gi & ((1 << LOW) - 1));
        f32x2 e[1 << R];
#pragma unroll
        for (int m = 0; m < (1 << R); ++m) e[m] = X[base + (m << LOW)];
#pragma unroll
        for (int ss = 0; ss < R; ++ss) {
            const int s = INV ? (R - 1 - ss) : ss; const int bit = BETA - s, h = 1 << (R - 1 - s);
#pragma unroll
            for (int m = 0; m < (1 << R); ++m) {
                if (m & h) continue;
                const int idx = base + (m << LOW); const int ex = (idx & ((1 << bit) - 1)) << (12 - bit);
                const f32x2 w = W[ex]; const f32x2 a_ = e[m], b_ = e[m | h];
                if (!INV) { const f32x2 d = a_ - b_; e[m] = a_ + b_; e[m | h] = (f32x2){d.x * w.x - d.y * w.y, d.x * w.y + d.y * w.x}; }
                else { const f32x2 t = (f32x2){b_.x * w.x + b_.y * w.y, b_.y * w.x - b_.x * w.y}; e[m] = a_ + t; e[m | h] = a_ - t; }
            }
        }
#pragma unroll
        for (int m = 0; m < (1 << R); ++m) X[base + (m << LOW)] = e[m];
    }
}
__device__ __forceinline__ void fft_forward(LAS f32x2* X, const LAS f32x2* W, int tid) {
    fft_pass<4, 12, false>(X, W, tid); __syncthreads(); fft_pass<3, 8, false>(X, W, tid); __syncthreads();
    fft_pass<3, 5, false>(X, W, tid); __syncthreads(); fft_pass<3, 2, false>(X, W, tid); __syncthreads();
}
__device__ __forceinline__ void fft_inverse(LAS f32x2* X, const LAS f32x2* W, int tid) {
    fft_pass<3, 2, true>(X, W, tid); __syncthreads(); fft_pass<3, 5, true>(X, W, tid); __syncthreads();
    fft_pass<3, 8, true>(X, W, tid); __syncthreads(); fft_pass<4, 12, true>(X, W, tid); __syncthreads();
}
__device__ __forceinline__ float block_sum(float v, LAS float* red, int tid) {
    v = wave_sum(v);
    if ((tid & 63) == 0) red[tid >> 6] = v;
    __syncthreads();
    float t = 0.f;
#pragma unroll
    for (int i = 0; i < NWAVES; ++i) t += red[i];
    __syncthreads();
    return t;
}
constexpr float HY_D0 = -3.0701134573253945f  , HY_D1 = -15.350567286626973f  ;

__device__ __forceinline__ void filt_item(const Args& a, unsigned char* ws, LAS unsigned char* lds, int l, int c, int tid) {
    LAS f32x2* X = (LAS f32x2*)lds; LAS f32x2* W = (LAS f32x2*)(lds + 65536); LAS float* w4s = (LAS float*)(lds + 98304); LAS float* red = (LAS float*)(lds + 98304 + 1024);
    LAS float* k1b = (LAS float*)(lds + 100352);
    fft_twiddles(W, tid);
    if (tid < 256) { const int cc = tid >> 6, f = tid & 63; w4s[tid] = a.in[I_HW4][(size_t)l * 64 * 2048 + (size_t)f * 2048 + (cc >> 1) * 1024 + (cc & 1) * 512 + c]; }
    __syncthreads();
    const float dl = fabsf(HY_D0 + (HY_D1 - HY_D0) * ((float)c / 511.0f));
    const float* H3 = (const float*)(ws + WS_H3) + (size_t)l * 4096 * 64;
    float ss0 = 0.f, ss1 = 0.f;
#pragma unroll 1
    for (int j = 0; j < 16; ++j) {
        const int n = tid + 512 * j; const int dir = j >= 8 ? 1 : 0; const int t = dir ? (8192 - n) : n;
        float s0 = 0.f, s1 = 0.f;
        if (n != 4096) {
            const f32x4* hr = (const f32x4*)(H3 + (size_t)t * 64);
#pragma unroll
            for (int q = 0; q < 16; ++q) { const f32x4 hv = hr[q]; const f32x4 wa = ((const LAS f32x4*)(w4s + (dir * 2 + 0) * 64))[q], wb = ((const LAS f32x4*)(w4s + (dir * 2 + 1) * 64))[q];
                s0 += (hv.x * wa.x + hv.y * wa.y) + (hv.z * wa.z + hv.w * wa.w); s1 += (hv.x * wb.x + hv.y * wb.y) + (hv.z * wb.z + hv.w * wb.w); }
            const float dec = expf(-((float)t / 4095.0f) * dl); s0 *= dec; s1 *= dec;
        }
        X[n] = (f32x2){s0, 0.f}; k1b[n] = s1; ss0 += s0 * s0; ss1 += s1 * s1;
    }
    const float rs0 = rsqrtf(block_sum(ss0, red, tid) + EPS), rs1 = rsqrtf(block_sum(ss1, red, tid) + EPS);
    f32x2* KF0 = (f32x2*)(ws + WS_KF) + (size_t)(0 * 512 + c) * FFTN; f32x2* KF1 = (f32x2*)(ws + WS_KF) + (size_t)(1 * 512 + c) * FFTN;
#pragma unroll 4
    for (int j = 0; j < 16; ++j) { const f32x2 x = X[tid + 512 * j]; X[tid + 512 * j] = (f32x2){x.x * rs0, 0.f}; }
    __syncthreads(); fft_forward(X, W, tid);
#pragma unroll 4
    for (int j = 0; j < 16; ++j) KF0[tid + 512 * j] = X[tid + 512 * j];
    __syncthreads();
#pragma unroll 4
    for (int j = 0; j < 16; ++j) X[tid + 512 * j] = (f32x2){k1b[tid + 512 * j] * rs1, 0.f};
    __syncthreads(); fft_forward(X, W, tid);
#pragma unroll 4
    for (int j = 0; j < 16; ++j) KF1[tid + 512 * j] = X[tid + 512 * j];
    __syncthreads();
}
__device__ __forceinline__ void filt_ctx_item(const Args& a, unsigned char* ws, LAS unsigned char* lds, int c, int tid) {
    LAS float* w4s = (LAS float*)lds; LAS float* red = (LAS float*)(lds + 1024);
    if (tid < 256) { const int cc = tid >> 6, f = tid & 63; w4s[tid] = a.in[I_HW4][(size_t)f * 2048 + (cc >> 1) * 1024 + (cc & 1) * 512 + c]; }
    __syncthreads();
    const float dl = fabsf(HY_D0 + (HY_D1 - HY_D0) * ((float)c / 511.0f));
    const float* H3C = (const float*)(ws + WS_H3C);
    const int n = tid, dir = n >= 256 ? 1 : 0, t = dir ? (512 - n) : n;
    float s0 = 0.f, s1 = 0.f;
    if (n != 256) {
        const f32x4* hr = (const f32x4*)(H3C + (size_t)t * 64);
#pragma unroll
        for (int q = 0; q < 16; ++q) { const f32x4 hv = hr[q]; const f32x4 wa = ((const LAS f32x4*)(w4s + (dir * 2 + 0) * 64))[q], wb = ((const LAS f32x4*)(w4s + (dir * 2 + 1) * 64))[q];
            s0 += (hv.x * wa.x + hv.y * wa.y) + (hv.z * wa.z + hv.w * wa.w); s1 += (hv.x * wb.x + hv.y * wb.y) + (hv.z * wb.z + hv.w * wb.w); }
        const float dec = expf(-((float)t / 255.0f) * dl); s0 *= dec; s1 *= dec;
    }
    const float rs0 = rsqrtf(block_sum(s0 * s0, red, tid) + EPS), rs1 = rsqrtf(block_sum(s1 * s1, red, tid) + EPS);
    float* KC = (float*)(ws + WS_KC);
    KC[(size_t)(0 * 512 + c) * 512 + n] = s0 * rs0; KC[(size_t)(1 * 512 + c) * 512 + n] = s1 * rs1;
    __syncthreads();
}

__device__ __forceinline__ void rope_row(const Args& a, unsigned char* ws, int l, int row, int lane) {
    bf16_t* P = (bf16_t*)(ws + WS_P) + (size_t)row * LDP;
    float ang;
    if (row < NLAT) { const int t = row & (SEQL - 1); const int j = lane & 31; const float inv = exp2f(-(float)j * (13.287712379549449f / 32.0f)); ang = (float)(lane < 32 ? (t >> 6) : (t & 63)) * inv; }
    else { const int t = (row - NLAT) & (LC - 1); const float inv = exp2f(-(float)lane * (13.287712379549449f / 64.0f)); ang = (float)t * inv; }
    float sn, cs; sincosf(ang, &sn, &cs);
    const float ksc = 0.08838834764831845f;
#pragma unroll
    for (int h = 0; h < 4; ++h) {
        bf16_t* q = P + PC_RQ + h * 128; bf16_t* k = P + PC_RK + h * 128;
        const float q1 = bf2f(q[lane]), q2 = bf2f(q[lane + 64]), k1 = bf2f(k[lane]), k2 = bf2f(k[lane + 64]);
        q[lane] = (bf16_t)f2bf(q1 * cs - q2 * sn); q[lane + 64] = (bf16_t)f2bf(q1 * sn + q2 * cs);
        k[lane] = (bf16_t)f2bf((k1 * cs - k2 * sn) * ksc); k[lane + 64] = (bf16_t)f2bf((k1 * sn + k2 * cs) * ksc);
    }
    const float* lr = (const float*)(ws + WS_LR) + (size_t)row * 32;
    bf16_t* GLG = (bf16_t*)(ws + WS_WIN);
#pragma unroll
    for (int dir = 0; dir < 2; ++dir) {
        const float* gw = a.in[I_GGW] + (size_t)(l * 2 + dir) * 16 * 256; const float* gb = a.in[I_GGB] + (size_t)(l * 2 + dir) * 256;
        float lrv[16];
#pragma unroll
        for (int j = 0; j < 16; ++j) lrv[j] = lr[dir * 16 + j];
#pragma unroll
        for (int q = 0; q < 4; ++q) { const int d = lane + 64 * q; float s = gb[d];
#pragma unroll
            for (int j = 0; j < 16; ++j) s += lrv[j] * gw[j * 256 + d];
            const float ls = (s >= 0.f) ? -log1pf(expf(-s)) : (s - log1pf(expf(s)));
            GLG[((size_t)dir * MR + row) * 256 + d] = (bf16_t)f2bf(ls * (1.0f / 16.0f)); }
    }
}

__device__ __forceinline__ void ret_chain(const bf16_t* P, bf16_t* O, int b, int h, int dir, bool ctx_out, int wave, int lane) {
    const int e = wave * 16 + (lane & 15), dq = lane >> 4;
    const float gamma = 1.0f - exp2f(-5.0f - (float)h);
    float S[32];
#pragma unroll
    for (int i = 0; i < 32; ++i) S[i] = 0.f;
    for (int seg = 0; seg < 2; ++seg) {
        const int n = seg ? SEQL : LC, rowbase = seg ? b * SEQL : NLAT + b * LC; const bool wr_out = seg || ctx_out;
        u32x4 qn[4], kn[4]; bf16_t vn;
        { const int row = rowbase + (dir ? n - 1 : 0); const bf16_t* pr = P + (size_t)row * LDP;
#pragma unroll
          for (int c4 = 0; c4 < 4; ++c4) { qn[c4] = ((const u32x4*)(pr + PC_RQ + h * 128 + dq * 32))[c4]; kn[c4] = ((const u32x4*)(pr + PC_RK + h * 128 + dq * 32))[c4]; }
          vn = pr[PC_RV + h * 128 + e]; }
        for (int i = 0; i < n; ++i) {
            const int row = rowbase + (dir ? n - 1 - i : i);
            u32x4 q[4], k[4];
#pragma unroll
            for (int c4 = 0; c4 < 4; ++c4) { q[c4] = qn[c4]; k[c4] = kn[c4]; }
            const float vf = bf2f(vn);
            if (i + 1 < n) { const int rown = rowbase + (dir ? n - 2 - i : i + 1); const bf16_t* pr = P + (size_t)rown * LDP;
#pragma unroll
                for (int c4 = 0; c4 < 4; ++c4) { qn[c4] = ((const u32x4*)(pr + PC_RQ + h * 128 + dq * 32))[c4]; kn[c4] = ((const u32x4*)(pr + PC_RK + h * 128 + dq * 32))[c4]; }
                vn = pr[PC_RV + h * 128 + e]; }
            float o = 0.f;
#pragma unroll
            for (int c4 = 0; c4 < 4; ++c4) { float qf[8], kf[8]; unpack8(q[c4], qf); unpack8(k[c4], kf);
#pragma unroll
                for (int x = 0; x < 8; ++x) { const int ix = c4 * 8 + x; S[ix] = gamma * S[ix] + kf[x] * vf; o += qf[x] * S[ix]; } }
            o += __shfl_xor(o, 16); o += __shfl_xor(o, 32);
            if (wr_out && dq == 0) O[(size_t)row * 512 + h * 128 + e] = (bf16_t)f2bf(o);
        }
    }
}
__device__ __forceinline__ void gla_chain(const bf16_t* P, const bf16_t* GLGd, bf16_t* O, int b, int h, int dir, bool ctx_out, int wave, int lane) {
    const int e = wave * 16 + (lane & 15), dq = lane >> 4;
    float S[16];
#pragma unroll
    for (int i = 0; i < 16; ++i) S[i] = 0.f;
    for (int seg = 0; seg < 2; ++seg) {
        const int n = seg ? SEQL : LC, rowbase = seg ? b * SEQL : NLAT + b * LC; const bool wr_out = seg || ctx_out;
        u32x4 qn[2], kn[2], gn[2]; bf16_t vn;
        { const int row = rowbase + (dir ? n - 1 : 0); const bf16_t* pr = P + (size_t)row * LDP; const bf16_t* gr = GLGd + (size_t)row * 256 + h * 64 + dq * 16;
#pragma unroll
          for (int c4 = 0; c4 < 2; ++c4) { qn[c4] = ((const u32x4*)(pr + PC_GQ + h * 64 + dq * 16))[c4]; kn[c4] = ((const u32x4*)(pr + PC_GK + h * 64 + dq * 16))[c4]; gn[c4] = ((const u32x4*)gr)[c4]; }
          vn = pr[PC_GV + h * 128 + e]; }
        for (int i = 0; i < n; ++i) {
            const int row = rowbase + (dir ? n - 1 - i : i);
            u32x4 q[2], k[2], g[2];
#pragma unroll
            for (int c4 = 0; c4 < 2; ++c4) { q[c4] = qn[c4]; k[c4] = kn[c4]; g[c4] = gn[c4]; }
            const float vf = bf2f(vn);
            if (i + 1 < n) { const int rown = rowbase + (dir ? n - 2 - i : i + 1); const bf16_t* pr = P + (size_t)rown * LDP; const bf16_t* gr = GLGd + (size_t)rown * 256 + h * 64 + dq * 16;
#pragma unroll
                for (int c4 = 0; c4 < 2; ++c4) { qn[c4] = ((const u32x4*)(pr + PC_GQ + h * 64 + dq * 16))[c4]; kn[c4] = ((const u32x4*)(pr + PC_GK + h * 64 + dq * 16))[c4]; gn[c4] = ((const u32x4*)gr)[c4]; }
                vn = pr[PC_GV + h * 128 + e]; }
            float o = 0.f;
#pragma unroll
            for (int c4 = 0; c4 < 2; ++c4) { float qf[8], kf[8], gf[8]; unpack8(q[c4], qf); unpack8(k[c4], kf); unpack8(g[c4], gf);
#pragma unroll
                for (int x = 0; x < 8; ++x) { const int ix = c4 * 8 + x; S[ix] = __expf(gf[x]) * S[ix] + kf[x] * vf; o += qf[x] * S[ix]; } }
            o += __shfl_xor(o, 16); o += __shfl_xor(o, 32);
            if (wr_out && dq == 0) O[(size_t)row * 512 + h * 128 + e] = (bf16_t)f2bf(o * 0.125f);
        }
    }
}
__device__ __forceinline__ void s5_chain(const Args& a, unsigned char* ws, LAS unsigned char* lds, int l, int b, int g, int dir, bool ctx_out, int tid) {
    LAS f32x2* cs = (LAS f32x2*)lds; LAS f32x2* hs = (LAS f32x2*)(lds + 16 * 65 * 8); LAS float* us = (LAS float*)(lds + 2 * 16 * 65 * 8);
    const int wave = tid >> 6, lane = tid & 63;
    const int gi = (l * 2 + dir) * 32 + g;
    const float* cre = a.in[I_S5CRE] + (size_t)gi * 1024; const float* cim = a.in[I_S5CIM] + (size_t)gi * 1024;
    for (int idx = tid; idx < 1024; idx += NT) { const int i = idx >> 6, p = idx & 63; cs[i * 65 + p] = (f32x2){cre[idx], cim[idx]}; }
    f32x2 ab = {0.f, 0.f}; f32x2 bt[16]; f32x2 hst = {0.f, 0.f};
    if (wave == 0) { ab = ((const f32x2*)(ws + WS_S5AB))[gi * 64 + lane]; const f32x2* bp = (const f32x2*)(ws + WS_S5BT) + (size_t)(gi * 64 + lane) * 16;
#pragma unroll
        for (int i = 0; i < 16; ++i) bt[i] = bp[i]; }
    else {
#pragma unroll
        for (int i = 0; i < 16; ++i) bt[i] = (f32x2){0.f, 0.f}; }
    const bf16_t* P = (const bf16_t*)(ws + WS_P);
    bf16_t* Y = (bf16_t*)(ws + WS_OB) + (size_t)(4 + dir) * OBSZ;
    __syncthreads();
    for (int seg = 0; seg < 2; ++seg) {
        const int n = seg ? SEQL : LC, rowbase = seg ? b * SEQL : NLAT + b * LC; const bool wr_out = seg || ctx_out;
        for (int bt0 = 0; bt0 < n; bt0 += 16) {
            const int tt = tid >> 4, i = tid & 15; const int ii = bt0 + tt; const int row = rowbase + (dir ? n - 1 - ii : ii);
            if (tid < 256) us[tid] = bf2f(P[(size_t)row * LDP + PC_S5U + g * 16 + i]);
            __syncthreads();
            if (wave == 0) {
#pragma unroll 4
                for (int t2 = 0; t2 < 16; ++t2) {
                    float bur = 0.f, bui = 0.f;
#pragma unroll
                    for (int q = 0; q < 4; ++q) { const f32x4 u = ((const LAS f32x4*)(us + t2 * 16))[q];
                        bur += bt[4 * q].x * u.x + bt[4 * q + 1].x * u.y + bt[4 * q + 2].x * u.z + bt[4 * q + 3].x * u.w;
                        bui += bt[4 * q].y * u.x + bt[4 * q + 1].y * u.y + bt[4 * q + 2].y * u.z + bt[4 * q + 3].y * u.w; }
                    const float hr = ab.x * hst.x - ab.y * hst.y + bur, hi = ab.x * hst.y + ab.y * hst.x + bui;
                    hst = (f32x2){hr, hi};
                    hs[t2 * 65 + lane] = hst;
                }
            }
            __syncthreads();
            if (tid < 256) {
                float y = 0.f;
#pragma unroll 8
                for (int p = 0; p < 64; ++p) { const f32x2 cv = cs[i * 65 + p], hv = hs[tt * 65 + p]; y += cv.x * hv.x - cv.y * hv.y; }
                if (wr_out) Y[(size_t)row * 512 + g * 16 + i] = (bf16_t)f2bf(y);
            }
        }
    }
    __syncthreads();
}

__device__ __forceinline__ float sconv3(const bf16_t* p, int t, int Lx, float w0, float w1, float w2, float cb) {
    const float x0 = t > 0 ? bf2f(p[t - 1]) : 0.f, x1 = bf2f(p[t]), x2 = t < Lx - 1 ? bf2f(p[t + 1]) : 0.f;
    return w0 * x0 + w1 * x1 + w2 * x2 + cb;
}
__device__ __forceinline__ void hyena_item(const Args& a, unsigned char* ws, LAS unsigned char* lds, int l, int c, int tid) {
    LAS f32x2* X = (LAS f32x2*)lds; LAS f32x2* W = (LAS f32x2*)(lds + 65536);
    fft_twiddles(W, tid);
    const float* cw = a.in[I_HCW] + (size_t)l * 3 * 1536; const float* cbp = a.in[I_HCB] + (size_t)l * 1536;
    const float wv0 = cw[c], wv1 = cw[1536 + c], wv2 = cw[3072 + c], bv = cbp[c];
    const float wa0 = cw[512 + c], wa1 = cw[1536 + 512 + c], wa2 = cw[3072 + 512 + c], ba = cbp[512 + c];
    const float wb0 = cw[1024 + c], wb1 = cw[1536 + 1024 + c], wb2 = cw[3072 + 1024 + c], bb = cbp[1024 + c];
    const float bias0 = a.in[I_HBIAS][(l * 2 + 0) * 512 + c], bias1 = a.in[I_HBIAS][(l * 2 + 1) * 512 + c];
    const bf16_t* PT = (const bf16_t*)(ws + WS_PT);
    const bf16_t* pv = PT + (size_t)(PT_V + c) * MR; const bf16_t* pg1 = PT + (size_t)(PT_G1 + c) * MR; const bf16_t* pg2 = PT + (size_t)(PT_G2 + c) * MR; const bf16_t* phg = PT + (size_t)(PT_HG + c) * MR;
    const f32x2* KF0 = (const f32x2*)(ws + WS_KF) + (size_t)(0 * 512 + c) * FFTN; const f32x2* KF1 = (const f32x2*)(ws + WS_KF) + (size_t)(1 * 512 + c) * FFTN;
    bf16_t* GATED = (bf16_t*)(ws + WS_H);
    __syncthreads();
    for (int bp = 0; bp < 2; ++bp) {
        const int r0 = (2 * bp) * SEQL, r1 = (2 * bp + 1) * SEQL;
        float zr[8], zi[8];
#pragma unroll
        for (int j = 0; j < 8; ++j) { const int t = tid + 512 * j; zr[j] = sconv3(pv + r0, t, SEQL, wv0, wv1, wv2, bv); zi[j] = sconv3(pv + r1, t, SEQL, wv0, wv1, wv2, bv);
            X[t] = (f32x2){zr[j], zi[j]}; X[4096 + t] = (f32x2){0.f, 0.f}; if (j & 1) asm volatile("" ::: "memory"); }
        __syncthreads(); fft_forward(X, W, tid);
#pragma unroll 4
        for (int j = 0; j < 16; ++j) { const int pos = tid + 512 * j; const f32x2 x = X[pos], k = KF0[pos]; X[pos] = (f32x2){x.x * k.x - x.y * k.y, x.x * k.y + x.y * k.x}; }
        __syncthreads(); fft_inverse(X, W, tid);
#pragma unroll
        for (int j = 0; j < 8; ++j) { const int t = tid + 512 * j; const f32x2 cv = X[t] * (1.0f / 8192.0f);
            const float g1r = sconv3(pg1 + r0, t, SEQL, wa0, wa1, wa2, ba), g1i = sconv3(pg1 + r1, t, SEQL, wa0, wa1, wa2, ba);
            zr[j] = g1r * (cv.x + bias0 * zr[j]); zi[j] = g1i * (cv.y + bias0 * zi[j]); if (j & 1) asm volatile("" ::: "memory"); }
        __syncthreads();
#pragma unroll
        for (int j = 0; j < 8; ++j) { const int t = tid + 512 * j; X[t] = (f32x2){zr[j], zi[j]}; X[4096 + t] = (f32x2){0.f, 0.f}; }
        __syncthreads(); fft_forward(X, W, tid);
#pragma unroll 4
        for (int j = 0; j < 16; ++j) { const int pos = tid + 512 * j; const f32x2 x = X[pos], k = KF1[pos]; X[pos] = (f32x2){x.x * k.x - x.y * k.y, x.x * k.y + x.y * k.x}; }
        __syncthreads(); fft_inverse(X, W, tid);
#pragma unroll
        for (int j = 0; j < 8; ++j) { const int t = tid + 512 * j; const f32x2 cv = X[t] * (1.0f / 8192.0f);
            const float g2r = sconv3(pg2 + r0, t, SEQL, wb0, wb1, wb2, bb), g2i = sconv3(pg2 + r1, t, SEQL, wb0, wb1, wb2, bb);
            const float z2r = g2r * (cv.x + bias1 * zr[j]), z2i = g2i * (cv.y + bias1 * zi[j]);
            const float hg0 = bf2f(phg[r0 + t]), hg1 = bf2f(phg[r1 + t]);
            GATED[(size_t)(r0 + t) * D + 512 + c] = (bf16_t)f2bf(z2r * siluf_(hg0)); GATED[(size_t)(r1 + t) * D + 512 + c] = (bf16_t)f2bf(z2i * siluf_(hg1)); if (j & 1) asm volatile("" ::: "memory"); }
        __syncthreads();
    }
}
__device__ __forceinline__ void hyena_ctx_item(const Args& a, unsigned char* ws, LAS unsigned char* lds, int c, int tid) {
    LAS float* kc = (LAS float*)lds; LAS float* za = (LAS float*)(lds + 4096); LAS float* zb = (LAS float*)(lds + 8192);
    const float* KC = (const float*)(ws + WS_KC);
    kc[tid] = KC[(size_t)(0 * 512 + c) * 512 + tid]; kc[512 + tid] = KC[(size_t)(1 * 512 + c) * 512 + tid];
    const float* cw = a.in[I_HCW]; const float* cbp = a.in[I_HCB];
    const float wv0 = cw[c], wv1 = cw[1536 + c], wv2 = cw[3072 + c], bv = cbp[c];
    const float wa0 = cw[512 + c], wa1 = cw[1536 + 512 + c], wa2 = cw[3072 + 512 + c], ba = cbp[512 + c];
    const float wb0 = cw[1024 + c], wb1 = cw[1536 + 1024 + c], wb2 = cw[3072 + 1024 + c], bb = cbp[1024 + c];
    const float bias0 = a.in[I_HBIAS][0 * 512 + c], bias1 = a.in[I_HBIAS][1 * 512 + c];
    const bf16_t* PT = (const bf16_t*)(ws + WS_PT);
    const int b = tid >> 7, tt = tid & 127; const int rb = NLAT + b * LC;
    const bf16_t* pv = PT + (size_t)(PT_V + c) * MR + rb; const bf16_t* pg1 = PT + (size_t)(PT_G1 + c) * MR + rb; const bf16_t* pg2 = PT + (size_t)(PT_G2 + c) * MR + rb; const bf16_t* phg = PT + (size_t)(PT_HG + c) * MR + rb;
    bf16_t* GATED = (bf16_t*)(ws + WS_H);
    float z0[2], z1[2];
#pragma unroll
    for (int q = 0; q < 2; ++q) { const int t = tt + 128 * q; z0[q] = sconv3(pv, t, LC, wv0, wv1, wv2, bv); za[b * 256 + t] = z0[q]; }
    __syncthreads();
#pragma unroll
    for (int q = 0; q < 2; ++q) { const int t = tt + 128 * q; float s = 0.f;
        for (int sidx = 0; sidx < 256; ++sidx) s += kc[(t - sidx) & 511] * za[b * 256 + sidx];
        z1[q] = sconv3(pg1, t, LC, wa0, wa1, wa2, ba) * (s + bias0 * z0[q]); zb[b * 256 + t] = z1[q]; }
    __syncthreads();
#pragma unroll
    for (int q = 0; q < 2; ++q) { const int t = tt + 128 * q; float s = 0.f;
        for (int sidx = 0; sidx < 256; ++sidx) s += kc[512 + ((t - sidx) & 511)] * zb[b * 256 + sidx];
        const float z2 = sconv3(pg2, t, LC, wb0, wb1, wb2, bb) * (s + bias1 * z1[q]);
        GATED[(size_t)(rb + t) * D + 512 + c] = (bf16_t)f2bf(z2 * siluf_(bf2f(phg[t]))); }
    __syncthreads();
}

__device__ __forceinline__ void merge_row(const Args& a, unsigned char* ws, int l, int row, int lane) {
    const int col = 8 * lane;
    const bf16_t* OB = (const bf16_t*)(ws + WS_OB); const bf16_t* P = (const bf16_t*)(ws + WS_P) + (size_t)row * LDP;
    bf16_t* GATED = (bf16_t*)(ws + WS_H) + (size_t)row * D; bf16_t* G5 = (bf16_t*)(ws + WS_KF) + (size_t)row * 512;
#pragma unroll
    for (int mx = 0; mx < 2; ++mx) {
        float of[8], ob[8], gt[8], o[8];
        unpack8(*(const u32x4*)(OB + (size_t)(2 * mx) * OBSZ + (size_t)row * 512 + col), of); unpack8(*(const u32x4*)(OB + (size_t)(2 * mx + 1) * OBSZ + (size_t)row * 512 + col), ob);
        unpack8(*(const u32x4*)(P + (mx ? PC_GG : PC_RG) + col), gt);
        float ss = 0.f;
#pragma unroll
        for (int x = 0; x < 8; ++x) { o[x] = of[x] + ob[x]; ss += o[x] * o[x]; }
        ss += __shfl_xor(ss, 1); ss += __shfl_xor(ss, 2); ss += __shfl_xor(ss, 4); ss += __shfl_xor(ss, 8);
        const float r = rsqrtf(ss * (1.0f / 128.0f) + EPS);
        const float* nw = a.in[mx ? I_GNW : I_RNW] + l * 512 + col;
        float res[8];
#pragma unroll
        for (int x = 0; x < 8; ++x) res[x] = o[x] * r * nw[x] * siluf_(gt[x]);
        *(u32x4*)(GATED + 1024 + 512 * mx + col) = pack8(res);
    }
    { float yf[8], yb[8], u[8], res[8];
      unpack8(*(const u32x4*)(OB + (size_t)4 * OBSZ + (size_t)row * 512 + col), yf); unpack8(*(const u32x4*)(OB + (size_t)5 * OBSZ + (size_t)row * 512 + col), yb);
      unpack8(*(const u32x4*)(P + PC_S5U + col), u);
      const float* dsk = a.in[I_S5D] + l * 512 + col;
#pragma unroll
      for (int x = 0; x < 8; ++x) res[x] = gelu_tanh(yf[x] + yb[x] + u[x] * dsk[x]);
      *(u32x4*)(G5 + col) = pack8(res); }
}

struct EpiInProj {
    static constexpr bool PERM = true, AFTER_DRAIN = false;
    bf16_t* P; bf16_t* PT; float* LR;
    __device__ __forceinline__ void operator()(const pg8::f32x4 (&acc)[2][2][4][2], const pg8::Unit& u, int wr, int wc, int fr, int fq) const {
        const int row0 = u.pm * 256 + wr * 64 + fr, pn = u.pn;
        if (pn < 4 || (pn >= 12 && pn < 26)) {
            const int colbase = (pn < 4 ? pn * 256 : pn * 256 - 2048) + wc * 32 + 8 * fq;
#pragma unroll
            for (int ai = 0; ai < 2; ++ai)
#pragma unroll
                for (int m = 0; m < 4; ++m) { bf16_t* rowp = P + (size_t)(row0 + ai * 128 + m * 16) * LDP + colbase;
#pragma unroll
                    for (int bj = 0; bj < 2; ++bj) { const pg8::f32x4 v0 = acc[ai][bj][m][0], v1 = acc[ai][bj][m][1];
                        u32x4 w; w.x = pk2(v0[0], v0[1]); w.y = pk2(v0[2], v0[3]); w.z = pk2(v1[0], v1[1]); w.w = pk2(v1[2], v1[3]);
                        *(u32x4*)(rowp + bj * 128) = w; } }
        } else if (pn < 12) {
            const int colbase = (pn - 4) * 256 + wc * 32 + 8 * fq;
#pragma unroll
            for (int bj = 0; bj < 2; ++bj)
#pragma unroll
                for (int n = 0; n < 2; ++n)
#pragma unroll
                    for (int j = 0; j < 4; ++j) { bf16_t* cp = PT + (size_t)(colbase + bj * 128 + 4 * n + j) * MR + row0;
#pragma unroll
                        for (int ai = 0; ai < 2; ++ai)
#pragma unroll
                            for (int m = 0; m < 4; ++m) cp[ai * 128 + m * 16] = (bf16_t)f2bf(acc[ai][bj][m][n][j]);
                        asm volatile("" ::: "memory"); }
        } else {
            if (wc == 0) {
#pragma unroll
                for (int ai = 0; ai < 2; ++ai)
#pragma unroll
                    for (int m = 0; m < 4; ++m) { float* rowp = LR + (size_t)(row0 + ai * 128 + m * 16) * 32 + 8 * fq;
                        *(pg8::f32x4*)(rowp) = acc[ai][0][m][0]; *(pg8::f32x4*)(rowp + 4) = acc[ai][0][m][1]; }
            }
        }
    }
};
struct EpiGlu {
    static constexpr bool PERM = true, AFTER_DRAIN = false;
    const bf16_t* G5; const bf16_t* P; bf16_t* GATED; const float* bias;
    __device__ __forceinline__ void operator()(const pg8::f32x4 (&acc)[2][2][4][2], const pg8::Unit& u, int wr, int wc, int fr, int fq) const {
        const int row0 = u.pm * 256 + wr * 64 + fr, col0 = u.pn * 256 + wc * 32 + 8 * fq;
#pragma unroll
        for (int ai = 0; ai < 2; ++ai)
#pragma unroll
            for (int m = 0; m < 4; ++m) { const size_t row = (size_t)(row0 + ai * 128 + m * 16);
#pragma unroll
                for (int bj = 0; bj < 2; ++bj) { const int col = col0 + bj * 128;
                    float g[8], sg[8], res[8]; unpack8(*(const u32x4*)(G5 + row * 512 + col), g); unpack8(*(const u32x4*)(P + row * LDP + PC_S5G + col), sg);
                    const pg8::f32x4 b0 = *(const pg8::f32x4*)(bias + col), b1 = *(const pg8::f32x4*)(bias + col + 4);
#pragma unroll
                    for (int j = 0; j < 4; ++j) { res[j] = g[j] * sigmoidf_(acc[ai][bj][m][0][j] + b0[j]) * siluf_(sg[j]); res[4 + j] = g[4 + j] * sigmoidf_(acc[ai][bj][m][1][j] + b1[j]) * siluf_(sg[4 + j]); }
                    *(u32x4*)(GATED + row * D + col) = pack8(res); } }
    }
};
struct EpiOut {
    static constexpr bool PERM = false, AFTER_DRAIN = false;
    const float* xl_old; const float* xc_old; float* xl_new; float* xc_new; const float* mod;
    __device__ __forceinline__ void operator()(const pg8::f32x4 (&acc)[2][2][4][2], const pg8::Unit& u, int wr, int wc, int fr, int fq) const {
        const int row0 = u.pm * 256 + wr * 64 + fr, col0 = u.pn * 256 + wc * 32 + 4 * fq;
        const bool lat = u.pm < 64;
        const float* xo = lat ? xl_old : xc_old - (size_t)NLAT * D; float* xn = lat ? xl_new : xc_new - (size_t)NLAT * D;
#pragma unroll
        for (int ai = 0; ai < 2; ++ai) {
            const int v = lat ? ((u.pm * 256 + ai * 128) >> 12) : 4;
            const float* gt = mod + (size_t)v * ADA + 2 * D;
#pragma unroll
            for (int m = 0; m < 4; ++m) { const size_t off = (size_t)(row0 + ai * 128 + m * 16) * D + col0;
#pragma unroll
                for (int bj = 0; bj < 2; ++bj)
#pragma unroll
                    for (int n = 0; n < 2; ++n) { const int cc = bj * 128 + n * 16; const pg8::f32x4 gv = *(const pg8::f32x4*)(gt + col0 + cc), xv = *(const pg8::f32x4*)(xo + off + cc);
                        *(pg8::f32x4*)(xn + off + cc) = xv + gv * acc[ai][bj][m][n]; } }
        }
    }
};
#ifndef MK_EN
#define MK_EN 0xffff
#endif
#define EN(x) ((MK_EN >> (x)) & 1)
constexpr int PH_PREP = 0, PH_PER_LAYER = 7, PH_FNORM = 1 + 2 * PH_PER_LAYER, N_PHASES = PH_FNORM + 1;

__global__ void __launch_bounds__(NT, 2) fwd_kernel(Args a) {
    extern __shared__ __attribute__((aligned(16))) unsigned char lds_raw[];
    LAS unsigned char* lds = (LAS unsigned char*)lds_raw;
    const int G = gridDim.x;

    for (int ph = a.ph_lo; ph < a.ph_hi; ++ph) {
        int tid = threadIdx.x; asm volatile("" : "+v"(tid));
        int bid = blockIdx.x; asm volatile("" : "+s"(bid));
        const int lane = tid & 63, wave = __builtin_amdgcn_readfirstlane(tid >> 6);
        unsigned char* ws = a.ws; asm volatile("" : "+s"(ws));
        float* MOD = (float*)(ws + WS_MOD);
        if (EN(0) && ph == PH_PREP) {
            for (int it = bid; it < 1840; it += G) {
                if (it < 768) prep_adaln(a.in[I_C], a.in[I_CCTX], a.in[I_ADAW], a.in[I_ADAB], MOD, it, (LAS float*)lds, tid);
                else if (it < 784) prep_s5(a, ws, it - 768, tid);
                else { const bool big = it < 1808; const int r = big ? it - 784 : it - 1808, l = big ? (r >> 9) : 0, t0 = (big ? (r & 511) : r) * 8;
                    float* H3o = big ? (float*)(ws + WS_H3) + (size_t)l * 4096 * 64 : (float*)(ws + WS_H3C);
                    prep_hymlp(a, H3o, l, big ? 4096 : 256, t0, (LAS float*)lds, (LAS float*)(lds + 2048), (LAS float*)(lds + 4096), tid); }
            }
        } else if (EN(1) && ph == PH_FNORM) {
            const float* fw = a.in[I_FNW];
            for (int row = bid * NWAVES + wave; row < NLAT; row += G * NWAVES) {
                float* xr = a.out + (size_t)row * D; f32x4 v[8]; float ss = 0.f;
#pragma unroll
                for (int j = 0; j < 8; ++j) { v[j] = ((const f32x4*)xr)[lane + 64 * j]; ss += (v[j].x * v[j].x + v[j].y * v[j].y) + (v[j].z * v[j].z + v[j].w * v[j].w); }
                const float rstd = rsqrtf(wave_sum(ss) * (1.0f / D) + EPS);
#pragma unroll
                for (int j = 0; j < 8; ++j) { const f32x4 w = *(const f32x4*)(fw + 4 * (lane + 64 * j)); ((f32x4*)xr)[lane + 64 * j] = v[j] * rstd * w; }
            }
        } else {
            const int l = (ph - 1) / PH_PER_LAYER, sub = (ph - 1) % PH_PER_LAYER;
            const bool ctx_out = (l == 0);
            const int Mrows = ctx_out ? MR : NLAT;
            if (EN(2) && sub == 0) {
                LAS float* scr = (LAS float*)(lds + wave * 8704);
                const int gw = bid * NWAVES + wave, NGW = G * NWAVES;
                constexpr int I_W1 = 32 * (NPAD / 32), I_W2 = 32 * 64, I_W3 = 8 * 16;
                for (int it = gw; it < I_W1 + I_W2 + I_W3; it += NGW) {
                    int r = it;
                    if (r < I_W1) { const int kb = r / (NPAD / 32), nb = r % (NPAD / 32); transpose_item(a.in[I_WIN] + (size_t)l * D * INW, INW, win_srccol(nb * 32), kb * 64, (bf16_t*)(ws + WS_WIN), D, nb * 32, scr, lane); continue; }
                    r -= I_W1;
                    if (r < I_W2) { const int kb = r / 64, nb = r % 64; transpose_item(a.in[I_WOUT] + (size_t)l * D * D, D, nb * 32, kb * 64, (bf16_t*)(ws + WS_WOUT), D, nb * 32, scr, lane); continue; }
                    r -= I_W2;
                    { const int kb = r / 16, nb = r % 16; transpose_item(a.in[I_GLUW] + (size_t)l * 512 * 512, 512, nb * 32, kb * 64, (bf16_t*)(ws + WS_GLUW), 512, nb * 32, scr, lane); }
                }
                const float* nw = a.in[I_NORMW] + (size_t)l * D;
                for (int row = gw; row < MR; row += NGW) {
                    const float* xr; int v;
                    if (row < NLAT) { xr = (l == 0 ? a.in[I_X] : a.out) + (size_t)row * D; v = row >> 12; }
                    else { xr = (l == 0 ? a.in[I_CTX] : (const float*)(ws + WS_XC1)) + (size_t)(row - NLAT) * D; v = 4; }
                    norm_row(xr, nw, MOD + (size_t)(l * 5 + v) * ADA, (bf16_t*)(ws + WS_H) + (size_t)row * D, lane);
                }
                __syncthreads();
                const int nfilt = ctx_out ? 1024 : 512;
                for (int it = bid; it < nfilt; it += G) { if (it < 512) filt_item(a, ws, lds, l, it, tid); else filt_ctx_item(a, ws, lds, it - 512, tid); }
            } else if (EN(3) && sub == 1) {
                pg8::Gemm g{(const bf16_t*)(ws + WS_H), (const bf16_t*)(ws + WS_WIN), MR, NPAD, D}; pg8::StaticOrder S; S.init(MR, NPAD, G, bid);
                EpiInProj E{(bf16_t*)(ws + WS_P), (bf16_t*)(ws + WS_PT), (float*)(ws + WS_LR)};
                pg8::gemm_phase<EpiInProj, pg8::StaticOrder>(lds, g, S, E, tid);
            } else if (EN(4) && sub == 2) {
                for (int row = bid * NWAVES + wave; row < MR; row += G * NWAVES) rope_row(a, ws, l, row, lane);
            } else if (EN(5) && sub == 3) {
                const int nit = ctx_out ? 1344 : 832;
                const bf16_t* P = (const bf16_t*)(ws + WS_P);
                for (int it = bid; it < nit; it += G) {
                    if (it < 32) ret_chain(P, (bf16_t*)(ws + WS_OB) + (size_t)(it & 1) * OBSZ, it >> 3, (it >> 1) & 3, it & 1, ctx_out, wave, lane);
                    else if (it < 64) { const int r = it - 32; gla_chain(P, (const bf16_t*)(ws + WS_WIN) + (size_t)(r & 1) * MR * 256, (bf16_t*)(ws + WS_OB) + (size_t)(2 + (r & 1)) * OBSZ, r >> 3, (r >> 1) & 3, r & 1, ctx_out, wave, lane); }
                    else if (it < 320) { const int r = it - 64; s5_chain(a, ws, lds, l, r >> 6, (r >> 1) & 31, r & 1, ctx_out, tid); }
                    else if (it < 832) hyena_item(a, ws, lds, l, it - 320, tid);
                    else hyena_ctx_item(a, ws, lds, it - 832, tid);
                }
            } else if (EN(6) && sub == 4) {
                for (int row = bid * NWAVES + wave; row < Mrows; row += G * NWAVES) merge_row(a, ws, l, row, lane);
            } else if (EN(7) && sub == 5) {
                pg8::Gemm g{(const bf16_t*)(ws + WS_KF), (const bf16_t*)(ws + WS_GLUW), Mrows, 512, 512}; pg8::StaticOrder S; S.init(Mrows, 512, G, bid);
                EpiGlu E{(const bf16_t*)(ws + WS_KF), (const bf16_t*)(ws + WS_P), (bf16_t*)(ws + WS_H), a.in[I_GLUB] + (size_t)l * 512};
                pg8::gemm_phase<EpiGlu, pg8::StaticOrder>(lds, g, S, E, tid);
            } else if (EN(8)) {
                pg8::Gemm g{(const bf16_t*)(ws + WS_H), (const bf16_t*)(ws + WS_WOUT), Mrows, D, D}; pg8::StaticOrder S; S.init(Mrows, D, G, bid);
                EpiOut E{l == 0 ? a.in[I_X] : a.out, a.in[I_CTX], a.out, (float*)(ws + WS_XC1), MOD + (size_t)l * 5 * ADA};
                pg8::gemm_phase<EpiOut, pg8::StaticOrder>(lds, g, S, E, tid);
            }
        }
        if (ph + 1 < a.ph_hi) { cg::this_grid().sync(); }
    }
}

#ifndef MK_LAUNCH_PER_PHASE
#define MK_LAUNCH_PER_PHASE 0
#endif
extern "C" void kernel_launch(void* const* d_in, const int* in_sizes, int n_in, void* d_out, int out_size, void* d_ws, size_t ws_size, hipStream_t stream) {
    static int grid = 0;
    if (grid == 0) {
        if (n_in != N_IN || out_size != NLAT * D || ws_size < WS_END) { fprintf(stderr, "kernel_launch: unexpected shapes (n_in %d, out %d, ws %zu < %zu); nothing launched\n", n_in, out_size, ws_size, (size_t)WS_END); grid = -1; return; }
        int dev = 0, cus = 0, per_cu = 0;
        if (hipGetDevice(&dev) != hipSuccess || hipDeviceGetAttribute(&cus, hipDeviceAttributeMultiprocessorCount, dev) != hipSuccess) { grid = -1; return; }
        if (hipFuncSetAttribute((const void*)fwd_kernel, hipFuncAttributeMaxDynamicSharedMemorySize, LDS_BYTES) != hipSuccess) { fprintf(stderr, "kernel_launch: hipFuncSetAttribute failed\n"); grid = -1; return; }
        if (hipOccupancyMaxActiveBlocksPerMultiprocessor(&per_cu, (const void*)fwd_kernel, NT, LDS_BYTES) != hipSuccess || per_cu < 1) { fprintf(stderr, "kernel_launch: occupancy query says %d blocks per CU\n", per_cu); per_cu = 1; }
        (void)hipGetLastError();
        grid = cus;
    }
    if (grid < 0) return;
    (void)hipMemsetAsync((char*)d_ws + WS_CTL, 0, WS_ZERO_BYTES, stream);
    Args a{};
    for (int i = 0; i < N_IN; ++i) a.in[i] = (const float*)d_in[i];
    a.out = (float*)d_out; a.ws = (unsigned char*)d_ws;
#if MK_LAUNCH_PER_PHASE
    for (int ph = 0; ph < N_PHASES; ++ph) {
        a.ph_lo = ph; a.ph_hi = ph + 1;
        hipLaunchKernelGGL(fwd_kernel, dim3(grid), dim3(NT), LDS_BYTES, stream, a);
    }
#else
    a.ph_lo = 0; a.ph_hi = N_PHASES;
    void* args[] = {&a};
    hipError_t e = hipLaunchCooperativeKernel((const void*)fwd_kernel, dim3(grid), dim3(NT), args, LDS_BYTES, stream);
    if (e != hipSuccess) fprintf(stderr, "kernel_launch: cooperative launch failed: %s (grid %d)\n", hipGetErrorString(e), grid);
#endif
}
```

```cpp
#include <hip/hip_runtime.h>
#include <hip/hip_cooperative_groups.h>
#include <cstdio>
#include <cstdint>
namespace cg = cooperative_groups;

#define LAS __attribute__((address_space(3)))
typedef unsigned short bf16_t;
typedef float f32x4 __attribute__((ext_vector_type(4)));
typedef float f32x2 __attribute__((ext_vector_type(2)));
typedef unsigned u32x4 __attribute__((ext_vector_type(4)));
typedef unsigned u32x2 __attribute__((ext_vector_type(2)));

constexpr int D = 2048, NB = 4, SEQL = 4096, LC = 256, NLAT = NB * SEQL, NCTX = NB * LC, MR = NLAT + NCTX;
constexpr int BR = 512, INW = 6688, NPAD = 6912, LDP = 4608, ADA = 3 * D;
constexpr int NT = 512, NWAVES = 8;
constexpr float EPS = 1e-6f;
constexpr int PC_S5U = 0, PC_S5G = 512, PC_RQ = 1024, PC_RK = 1536, PC_RV = 2048, PC_RG = 2560, PC_GQ = 3072, PC_GK = 3328, PC_GV = 3584, PC_GG = 4096;
constexpr int PT_V = 0, PT_G1 = 512, PT_G2 = 1024, PT_HG = 1536;
constexpr int FFTN = 8192;

enum { I_X = 0, I_C, I_CTX, I_CCTX, I_NORMW, I_ADAW, I_ADAB, I_WIN, I_WOUT, I_S5ARE, I_S5AIM, I_S5LDT, I_S5BRE, I_S5BIM, I_S5CRE, I_S5CIM,
       I_S5D, I_GLUW, I_GLUB, I_HCW, I_HCB, I_HW1, I_HB1, I_HF1, I_HW2, I_HB2, I_HF2, I_HW3, I_HB3, I_HF3, I_HW4, I_HBIAS, I_RNW, I_GGW, I_GGB, I_GNW, I_FNW, N_IN };

constexpr size_t al256(size_t x) { return (x + 255) & ~(size_t)255; }
constexpr size_t WS_CTL  = 0;
constexpr size_t WS_MOD  = WS_CTL + 65536;
constexpr size_t WS_ZERO_BYTES = 65536 + al256((size_t)2 * 5 * ADA * 4);
constexpr size_t WS_S5AB = WS_MOD + al256((size_t)2 * 5 * ADA * 4);
constexpr size_t WS_S5BT = WS_S5AB + (size_t)2 * 2 * 32 * 64 * 8;
constexpr size_t WS_H3   = WS_S5BT + (size_t)2 * 2 * 32 * 64 * 16 * 8;
constexpr size_t WS_H3C  = WS_H3 + (size_t)2 * 4096 * 64 * 4;
constexpr size_t WS_KC   = WS_H3C + (size_t)256 * 64 * 4;
constexpr size_t WS_LR   = WS_KC + (size_t)2 * 512 * 512 * 4;
constexpr size_t WS_XC1  = WS_LR + (size_t)MR * 32 * 4;
constexpr size_t WS_WOUT = WS_XC1 + (size_t)NCTX * D * 4;
constexpr size_t WS_GLUW = WS_WOUT + (size_t)D * D * 2;
constexpr size_t WS_WIN  = WS_GLUW + (size_t)512 * 512 * 2;
constexpr size_t WS_H    = WS_WIN + (size_t)NPAD * D * 2;
constexpr size_t WS_P    = WS_H + (size_t)MR * D * 2;
constexpr size_t WS_PT   = WS_P + (size_t)MR * LDP * 2;
constexpr size_t WS_KF   = WS_PT + (size_t)2048 * MR * 2;
constexpr size_t WS_OB   = WS_KF + (size_t)2 * 512 * FFTN * 8;
constexpr size_t WS_END  = WS_OB + (size_t)6 * MR * 512 * 2;
constexpr size_t OBSZ = (size_t)MR * 512;

constexpr int LDS_CTL_OFF = 131072 + 2048;
constexpr int LDS_BYTES = LDS_CTL_OFF + 64;

__device__ __forceinline__ unsigned f2bf(float f) { unsigned u = __float_as_uint(f); return (u + 0x7fffu + ((u >> 16) & 1u)) >> 16; }
__device__ __forceinline__ unsigned pk2(float lo, float hi) { return f2bf(lo) | (f2bf(hi) << 16); }
__device__ __forceinline__ float bf2f(bf16_t b) { return __uint_as_float((unsigned)b << 16); }
__device__ __forceinline__ float bflo(unsigned w) { return __uint_as_float(w << 16); }
__device__ __forceinline__ float bfhi(unsigned w) { return __uint_as_float(w & 0xffff0000u); }
__device__ __forceinline__ void unpack8(const u32x4 r, float (&f)[8]) { f[0] = bflo(r.x); f[1] = bfhi(r.x); f[2] = bflo(r.y); f[3] = bfhi(r.y); f[4] = bflo(r.z); f[5] = bfhi(r.z); f[6] = bflo(r.w); f[7] = bfhi(r.w); }
__device__ __forceinline__ u32x4 pack8(const float (&f)[8]) { u32x4 o; o.x = pk2(f[0], f[1]); o.y = pk2(f[2], f[3]); o.z = pk2(f[4], f[5]); o.w = pk2(f[6], f[7]); return o; }
__device__ __forceinline__ float sigmoidf_(float x) { return 1.0f / (1.0f + __expf(-x)); }
__device__ __forceinline__ float siluf_(float x) { return x * sigmoidf_(x); }
__device__ __forceinline__ float gelu_tanh(float x) { const float u = 0.7978845608028654f * (x + 0.044715f * x * x * x); return 0.5f * x * (1.0f + tanhf(u)); }
__device__ __forceinline__ float wave_sum(float v) {
#pragma unroll
    for (int o = 1; o < 64; o <<= 1) v += __shfl_xor(v, o);
    return v;
}
#define LDS_WAIT() asm volatile("s_waitcnt lgkmcnt(0)" ::: "memory")

struct Args { const float* in[N_IN]; float* out; unsigned char* ws; int ph_lo, ph_hi; };

#define XB_TMO      128
#define XB_XCNT(j)  (256  + 64 * (j))
#define XB_XSUB(j)  (1280 + 64 * (j))
#define XB_XGEN(j)  (2304 + 64 * (j))
#define XB_TOP      3328
#define XB_TOPGEN   3392
#define XCD_BAR_WORDS 3456
#define XB_SPIN_CAP (1u << 22)
__device__ __forceinline__ unsigned xb_ld(unsigned* p)              { return __hip_atomic_load(p, __ATOMIC_RELAXED, __HIP_MEMORY_SCOPE_AGENT); }
__device__ __forceinline__ unsigned xb_add(unsigned* p, unsigned v) { return __hip_atomic_fetch_add(p, v, __ATOMIC_RELAXED, __HIP_MEMORY_SCOPE_AGENT); }
__device__ __forceinline__ unsigned xb_xcc_id() { return (unsigned)__builtin_amdgcn_s_getreg((3 << 11) | 20) & 0xFu; }
#define XB_SPIN(cond, bar) do { unsigned _sp = 0; while (cond) { __builtin_amdgcn_s_sleep(1); \
    if ((++_sp & 255u) == 0u) { if (xb_ld(&(bar)[XB_TMO])) break; if (_sp > XB_SPIN_CAP) { atomicAdd(&(bar)[XB_TMO], 1u); break; } } } } while (0)
struct XcdBarrier { unsigned* bar; unsigned x; volatile LAS unsigned* st; };
__device__ __forceinline__ XcdBarrier xcd_barrier_post(unsigned* bar, volatile LAS unsigned* st) {
    XcdBarrier b; b.bar = bar; b.x = xb_xcc_id(); b.st = st;
    if (threadIdx.x == 0) (void)xb_add(&bar[XB_XCNT(b.x)], 1u);
    return b;
}
__device__ __forceinline__ void xcd_barrier_complete(unsigned* bar, unsigned x, unsigned& nloc, unsigned& nx) {
    const unsigned G = gridDim.x * gridDim.y * gridDim.z;
    unsigned sum, cnt, mine, sp = 0u;
    for (;;) {
        sum = 0u; cnt = 0u; mine = 0u;
#pragma unroll
        for (unsigned j = 0; j < 16; ++j) { const unsigned c = xb_ld(&bar[XB_XCNT(j)]); sum += c; cnt += (c > 0u) ? 1u : 0u; mine = (j == x) ? c : mine; }
        if (sum == G) break;
        __builtin_amdgcn_s_sleep(1);
        if ((++sp & 255u) == 0u) { if (xb_ld(&bar[XB_TMO])) break; if (sp > XB_SPIN_CAP) { atomicAdd(&bar[XB_TMO], 1u); break; } }
    }
    nloc = mine > 0u ? mine : 1u; nx = cnt > 0u ? cnt : 1u;
}
__device__ __forceinline__ void xcd_barrier(const XcdBarrier& b) {
    asm volatile("s_waitcnt vmcnt(0)" ::: "memory");
    __syncthreads();
    if (threadIdx.x == 0) {
        unsigned* bar = b.bar;
        __builtin_amdgcn_s_waitcnt(0);
        unsigned nloc = b.st[0], nx = b.st[1];
        if (nloc == 0u) { xcd_barrier_complete(bar, b.x, nloc, nx); b.st[0] = nloc; b.st[1] = nx; }
        const unsigned old = xb_add(&bar[XB_XSUB(b.x)], 1u);
        const unsigned gen = old / nloc;
        if (old + 1u == (gen + 1u) * nloc) {
            __builtin_amdgcn_fence(__ATOMIC_RELEASE, "agent");
            asm volatile("s_waitcnt vmcnt(0)" ::: "memory");
            const unsigned og = xb_add(&bar[XB_TOP], 1u);
            const unsigned tg = og / nx;
            if (og + 1u == (tg + 1u) * nx) xb_add(&bar[XB_TOPGEN], 1u);
            else XB_SPIN(xb_ld(&bar[XB_TOPGEN]) == tg, bar);
            __builtin_amdgcn_fence(__ATOMIC_ACQUIRE, "agent");
            xb_add(&bar[XB_XGEN(b.x)], 1u);
            asm volatile("s_waitcnt vmcnt(0)" ::: "memory");
        } else {
            XB_SPIN(xb_ld(&bar[XB_XGEN(b.x)]) == gen, bar);
            __builtin_amdgcn_fence(__ATOMIC_ACQUIRE, "agent");
            asm volatile("s_waitcnt vmcnt(0)" ::: "memory");
        }
    }
    __syncthreads();
}
namespace pg8 {
#define PG8_LAS __attribute__((address_space(3)))
typedef unsigned short bf16_t;
typedef short bf16x8 __attribute__((ext_vector_type(8)));
typedef float f32x4 __attribute__((ext_vector_type(4)));
typedef unsigned u32x4 __attribute__((ext_vector_type(4)));
constexpr int BM = 256, BK = 64, HALF = 128, HTB = HALF * BK * 2, STAGE_BYTES = 8 * HTB, NXCD = 8, WGM = 8;

__host__ __device__ __forceinline__ int lds_byte(int r, int c) { const int st = (r >> 4) * 2 + (c >> 5), rr = r & 15, cc = c & 31, ob = rr * 64 + cc * 2; return st * 1024 + (ob ^ (((ob >> 9) & 1) << 5)); }
__host__ __device__ __forceinline__ void stage_rc(int b, int& R, int& C) { const int st = b / 1024, sb = b % 1024, swz = sb ^ (((sb >> 9) & 1) << 5); R = (st >> 1) * 16 + swz / 64; C = (st & 1) * 32 + (swz % 64) / 2; }
__host__ __device__ __forceinline__ int perm32(int rho) { const int n = rho >> 4, i = rho & 15; return 8 * (i >> 2) + 4 * n + (i & 3); }

struct Unit { int pm, pn; };
struct Gemm { const bf16_t* A; const bf16_t* Bt; int M, N, K; };

struct StaticOrder {
    int nM, nN, nwg, G, c;
    __host__ __device__ void init(int M, int N, int G_, int c_) { nM = M / BM; nN = N / BM; nwg = nM * nN; G = G_; c = c_; }
    __host__ __device__ bool next(int i, Unit& u) const {
        const long L = (long)i * G + c; if (L >= nwg) return false;
        int wgid = (int)L; { const int q = nwg / NXCD, r = nwg % NXCD, xcd = wgid % NXCD, off = wgid / NXCD; wgid = (xcd < r ? xcd * (q + 1) : r * (q + 1) + (xcd - r) * q) + off; }
        const int nig = WGM * nN, gid = wgid / nig, fm = gid * WGM, gsz = (nM - fm) < WGM ? (nM - fm) : WGM;
        u.pm = fm + ((wgid % nig) % gsz); u.pn = (wgid % nig) / gsz; return true;
    }
    __device__ __forceinline__ void a_ready(const Unit&) const {}
    __device__ __forceinline__ void done(const Unit&) const {}
};

template <class Epi, class Sched>
__device__ __forceinline__ void gemm_phase(PG8_LAS unsigned char* lds, const Gemm g, const Sched& S, const Epi& E, const int tid) {
    const int wid = __builtin_amdgcn_readfirstlane(tid >> 6), lane = tid & 63, wr = wid >> 2, wc = wid & 3, fr = lane & 15, fq = lane >> 4;
    const int K = g.K, nt = K / BK;
    unsigned voffA[2], voffB[2];
#pragma unroll
    for (int i = 0; i < 2; ++i) { int R, C; stage_rc(tid * 16 + i * 8192, R, C); const int Rb = Epi::PERM ? ((R & ~31) + perm32(R & 31)) : R;
        voffA[i] = (unsigned)(R * K + C) * 2u; voffB[i] = (unsigned)(Rb * K + C) * 2u; }
    const size_t kstep = (size_t)(BK * 2);
    const size_t hstep = (size_t)HALF * K * 2;
    const size_t tstep = 2 * hstep;
    const unsigned ldsw = (unsigned)wid * 1024u;
    const int aoff = lds_byte(wr * 64 + fr, fq * 8), boff = lds_byte(wc * 32 + fr, fq * 8);
#define PG8_SA(b, h) (((b) * 2 + (h)) * HTB)
#define PG8_SB(b, h) ((4 + (b) * 2 + (h)) * HTB)
#define PG8_STAGE(bufoff, gbase, voff) do { _Pragma("unroll") for (int _i = 0; _i < 2; ++_i) \
        __builtin_amdgcn_global_load_lds((const unsigned*)((const char*)(gbase) + (voff)[_i]), (PG8_LAS unsigned*)(lds + (bufoff) + ldsw + _i * 8192), 16, 0, 0); } while (0)
#define PG8_LDA(dst, b, h) do { _Pragma("unroll") for (int m = 0; m < 4; ++m) _Pragma("unroll") for (int k = 0; k < 2; ++k) dst[m][k] = *(const PG8_LAS bf16x8*)(lds + PG8_SA(b, h) + aoff + m * 2048 + k * 1024); } while (0)
#define PG8_LDB(dst, b, h) do { _Pragma("unroll") for (int n = 0; n < 2; ++n) _Pragma("unroll") for (int k = 0; k < 2; ++k) dst[n][k] = *(const PG8_LAS bf16x8*)(lds + PG8_SB(b, h) + boff + n * 2048 + k * 1024); } while (0)
#define PG8_MMA(ai, bj, At, Bt) do { __builtin_amdgcn_s_setprio(1); _Pragma("unroll") for (int m = 0; m < 4; ++m) _Pragma("unroll") for (int n = 0; n < 2; ++n) _Pragma("unroll") for (int k = 0; k < 2; ++k) \
        acc[ai][bj][m][n] = __builtin_amdgcn_mfma_f32_16x16x32_bf16(Bt[n][k], At[m][k], acc[ai][bj][m][n], 0, 0, 0); __builtin_amdgcn_s_setprio(0); } while (0)
#define PG8_WAIT_V(n) asm volatile("s_waitcnt vmcnt(" #n ")" ::: "memory")
#define PG8_WAIT_L(n) asm volatile("s_waitcnt lgkmcnt(" #n ")" ::: "memory")
#define PG8_BAR __builtin_amdgcn_s_barrier()
#define PG8_SCHED __builtin_amdgcn_sched_barrier(0)
    Unit cur, nxt; int ui = 0;
    if (!S.next(0, cur)) return;
    f32x4 acc[2][2][4][2];
#pragma unroll
    for (int a = 0; a < 2; ++a)
#pragma unroll
        for (int b = 0; b < 2; ++b)
#pragma unroll
            for (int m = 0; m < 4; ++m)
#pragma unroll
                for (int n = 0; n < 2; ++n) acc[a][b][m][n] = (f32x4){0.f, 0.f, 0.f, 0.f};
    bf16x8 At[4][2], B0[2][2], B1[2][2];
    const char* cA = (const char*)g.A + (size_t)cur.pm * tstep; const char* cB = (const char*)g.Bt + (size_t)cur.pn * tstep;
    S.a_ready(cur);
    PG8_STAGE(PG8_SB(0, 0), cB, voffB); PG8_STAGE(PG8_SA(0, 0), cA, voffA); PG8_STAGE(PG8_SB(0, 1), cB + hstep, voffB); PG8_STAGE(PG8_SA(0, 1), cA + hstep, voffA);
    if (wr == 1) PG8_BAR;
    PG8_WAIT_V(4); PG8_BAR;
    PG8_STAGE(PG8_SB(1, 0), cB + kstep, voffB); PG8_STAGE(PG8_SA(1, 0), cA + kstep, voffA); PG8_STAGE(PG8_SB(1, 1), cB + hstep + kstep, voffB);
    PG8_WAIT_V(6); PG8_BAR;
    for (;;) {
        const bool has_next = S.next(ui + 1, nxt);
        const char* nA = has_next ? (const char*)g.A + (size_t)nxt.pm * tstep : cA; const char* nB = has_next ? (const char*)g.Bt + (size_t)nxt.pn * tstep : cB;
        for (int t = 0; t < nt; t += 2) {
            const bool last = (t == nt - 2);
            const char* a1 = cA + (size_t)(t + 1) * kstep;
            const char* a2 = last ? nA : cA + (size_t)(t + 2) * kstep; const char* b2 = last ? nB : cB + (size_t)(t + 2) * kstep;
            const char* a3 = a2 + kstep; const char* b3 = b2 + kstep;
            if (last && has_next) S.a_ready(nxt);
            PG8_LDB(B0, 0, 0); PG8_SCHED; PG8_LDA(At, 0, 0); PG8_STAGE(PG8_SA(1, 1), a1 + hstep, voffA);
            PG8_WAIT_L(8); PG8_BAR; PG8_WAIT_L(0); PG8_MMA(0, 0, At, B0); PG8_BAR; PG8_SCHED;
            PG8_LDB(B1, 0, 1); PG8_STAGE(PG8_SB(0, 0), b2, voffB);
            PG8_BAR; PG8_WAIT_L(0); PG8_MMA(0, 1, At, B1); PG8_BAR;
            PG8_LDA(At, 0, 1); PG8_STAGE(PG8_SA(0, 0), a2, voffA);
            PG8_BAR; PG8_WAIT_L(0); PG8_MMA(1, 0, At, B0); PG8_BAR; PG8_SCHED;
            PG8_STAGE(PG8_SB(0, 1), b2 + hstep, voffB);
            PG8_WAIT_V(6); PG8_BAR; PG8_MMA(1, 1, At, B1); PG8_BAR;
            PG8_LDB(B0, 1, 0); PG8_SCHED; PG8_LDA(At, 1, 0); PG8_STAGE(PG8_SA(0, 1), a2 + hstep, voffA);
            PG8_WAIT_L(8); PG8_BAR; PG8_WAIT_L(0); PG8_MMA(0, 0, At, B0); PG8_BAR; PG8_SCHED;
            PG8_LDB(B1, 1, 1); PG8_STAGE(PG8_SB(1, 0), b3, voffB);
            PG8_BAR; PG8_WAIT_L(0); PG8_MMA(0, 1, At, B1); PG8_BAR;
            PG8_LDA(At, 1, 1); PG8_STAGE(PG8_SA(1, 0), a3, voffA);
            PG8_BAR; PG8_WAIT_L(0); PG8_MMA(1, 0, At, B0); PG8_BAR; PG8_SCHED;
            PG8_STAGE(PG8_SB(1, 1), b3 + hstep, voffB);
            PG8_WAIT_V(6); PG8_BAR; PG8_MMA(1, 1, At, B1); PG8_BAR;
        }
        E(acc, cur, wr, wc, fr, fq); S.done(cur);
        if (!has_next) break;
#pragma unroll
        for (int a = 0; a < 2; ++a)
#pragma unroll
            for (int b = 0; b < 2; ++b)
#pragma unroll
                for (int m = 0; m < 4; ++m)
#pragma unroll
                    for (int n = 0; n < 2; ++n) acc[a][b][m][n] = (f32x4){0.f, 0.f, 0.f, 0.f};
        cur = nxt; cA = nA; cB = nB; ++ui;
    }
    PG8_WAIT_V(0);
    if (wr == 0) PG8_BAR;
    PG8_BAR;
#undef PG8_SA
#undef PG8_SB
#undef PG8_STAGE
#undef PG8_LDA
#undef PG8_LDB
#undef PG8_MMA
#undef PG8_WAIT_V
#undef PG8_WAIT_L
#undef PG8_BAR
#undef PG8_SCHED
}
}
__device__ __forceinline__ void prep_adaln(const float* c, const float* cctx, const float* adaw, const float* adab, float* MOD, int it, LAS float* sv, int tid) {
    const int l = it / 384, r = it % 384, ntile = r >> 5, ks = r & 31, k0 = ks * 64;
    if (tid < 320) { const int v = tid >> 6, k = tid & 63; const float cv = v < 4 ? c[v * D + k0 + k] : cctx[k0 + k]; sv[tid] = cv / (1.0f + expf(-cv)); }
    __syncthreads();
    const int n = ntile * 512 + tid; const float* w = adaw + (size_t)l * D * ADA + (size_t)k0 * ADA + n;
    float acc[5] = {0.f, 0.f, 0.f, 0.f, 0.f};
#pragma unroll 8
    for (int k = 0; k < 64; ++k) { const float wv = w[(size_t)k * ADA];
#pragma unroll
        for (int v = 0; v < 5; ++v) acc[v] += sv[v * 64 + k] * wv; }
    if (ks == 0) { const float bb = adab[l * ADA + n];
#pragma unroll
        for (int v = 0; v < 5; ++v) acc[v] += bb; }
#pragma unroll
    for (int v = 0; v < 5; ++v) atomicAdd(MOD + (size_t)(l * 5 + v) * ADA + n, acc[v]);
    __syncthreads();
}

__device__ __forceinline__ void prep_s5(const Args& a, unsigned char* ws, int it, int tid) {
    const int idx = it * 512 + tid;
    const float a_re = a.in[I_S5ARE][idx], a_im = a.in[I_S5AIM][idx], ldt = a.in[I_S5LDT][idx >> 6];
    const float dt = expf(ldt), mag = expf(a_re * dt);
    float sn, cs; sincosf(a_im * dt, &sn, &cs);
    const float ab_re = mag * cs, ab_im = mag * sn, den = a_re * a_re + a_im * a_im, nr = ab_re - 1.0f;
    const float co_re = (nr * a_re + ab_im * a_im) / den, co_im = (ab_im * a_re - nr * a_im) / den;
    ((f32x2*)(ws + WS_S5AB))[idx] = (f32x2){ab_re, ab_im};
    const float* bre = a.in[I_S5BRE] + (size_t)idx * 16; const float* bim = a.in[I_S5BIM] + (size_t)idx * 16;
    f32x2* bt = (f32x2*)(ws + WS_S5BT) + (size_t)idx * 16;
#pragma unroll
    for (int i = 0; i < 16; ++i) { const float br = bre[i], bi = bim[i]; bt[i] = (f32x2){co_re * br - co_im * bi, co_re * bi + co_im * br}; }
}

__device__ __forceinline__ void prep_hymlp(const Args& a, float* H3out, int l, int Lx, int t0, LAS float* zs, LAS float* h1, LAS float* h2, int tid) {
    const int pos = tid >> 6, f = tid & 63, t = t0 + pos;
    if (f < 33) {
        float z;
        if (f == 0) z = (float)t / (float)(Lx - 1);
        else { const int j = (f - 1) & 15; const float fj = 1e-4f + (float)j * ((15.0f - 1e-4f) / 15.0f); const float wpos = (6.283185307179586f * (float)t) / (float)Lx; const float arg = fj * wpos;
               z = (f <= 16) ? cosf(arg) : -sinf(arg); }
        zs[pos * 36 + f] = z;
    }
    __syncthreads();
    const float* w1 = a.in[I_HW1] + (size_t)l * 33 * 64; const float* w2 = a.in[I_HW2] + (size_t)l * 64 * 64; const float* w3 = a.in[I_HW3] + (size_t)l * 64 * 64;
    float s = a.in[I_HB1][l * 64 + f];
#pragma unroll 3
    for (int j = 0; j < 33; ++j) s += zs[pos * 36 + j] * w1[j * 64 + f];
    h1[pos * 64 + f] = sinf(a.in[I_HF1][l * 64 + f] * s);
    __syncthreads();
    s = a.in[I_HB2][l * 64 + f];
#pragma unroll 4
    for (int j = 0; j < 64; ++j) s += h1[pos * 64 + j] * w2[j * 64 + f];
    h2[pos * 64 + f] = sinf(a.in[I_HF2][l * 64 + f] * s);
    __syncthreads();
    s = a.in[I_HB3][l * 64 + f];
#pragma unroll 4
    for (int j = 0; j < 64; ++j) s += h2[pos * 64 + j] * w3[j * 64 + f];
    H3out[(size_t)t * 64 + f] = sinf(a.in[I_HF3][l * 64 + f] * s);
    __syncthreads();
}

__device__ __forceinline__ void transpose_item(const float* W, int ldw, int srccol0, int k0, bf16_t* WT, int K, int dstrow0, LAS float* scr, int lane) {
    if (srccol0 >= 0) {
#pragma unroll 8
        for (int i = 0; i < 32; ++i) { const int kk = 2 * i + (lane >> 5); scr[kk * 33 + (lane & 31)] = W[(size_t)(k0 + kk) * ldw + srccol0 + (lane & 31)]; }
    } else {
#pragma unroll 8
        for (int i = 0; i < 32; ++i) { const int kk = 2 * i + (lane >> 5); scr[kk * 33 + (lane & 31)] = 0.f; }
    }
    LDS_WAIT();
    const int c = lane & 7;
#pragma unroll
    for (int j = 0; j < 4; ++j) { const int n = (lane >> 3) + 8 * j; const LAS float* s = scr + (8 * c) * 33 + n;
        u32x4 o; o.x = pk2(s[0 * 33], s[1 * 33]); o.y = pk2(s[2 * 33], s[3 * 33]); o.z = pk2(s[4 * 33], s[5 * 33]); o.w = pk2(s[6 * 33], s[7 * 33]);
        *(u32x4*)(WT + (size_t)(dstrow0 + n) * K + k0 + 8 * c) = o; }
    LDS_WAIT();
}
__device__ __forceinline__ int win_srccol(int n) { return n < 6144 ? n : (n < 6656 ? n + 32 : (n < 6688 ? n - 512 : -1)); }

__device__ __forceinline__ void norm_row(const float* xrow, const float* nw, const float* mod, bf16_t* hrow, int lane) {
    f32x4 v[8]; float ss = 0.f;
#pragma unroll
    for (int j = 0; j < 8; ++j) { v[j] = ((const f32x4*)xrow)[lane + 64 * j]; ss += (v[j].x * v[j].x + v[j].y * v[j].y) + (v[j].z * v[j].z + v[j].w * v[j].w); }
    const float rstd = rsqrtf(wave_sum(ss) * (1.0f / D) + EPS);
#pragma unroll
    for (int j = 0; j < 8; ++j) { const int k = 4 * (lane + 64 * j);
        const f32x4 w = *(const f32x4*)(nw + k), sh = *(const f32x4*)(mod + k), sc = *(const f32x4*)(mod + D + k);
        const f32x4 o = v[j] * rstd * w * (sc + 1.0f) + sh;
        u32x2 pk; pk.x = pk2(o.x, o.y); pk.y = pk2(o.z, o.w);
        *(u32x2*)(hrow + k) = pk; }
}

__device__ __forceinline__ void fft_twiddles(LAS f32x2* W, int tid) {
    for (int j = tid; j < 4096; j += NT) { float s, c; sincospif(-(float)j * (1.0f / 4096.0f), &s, &c); W[j] = (f32x2){c, s}; }
}
template <int R, int BETA, bool INV> __device__ __forceinline__ void fft_pass(LAS f32x2* X, const LAS f32x2* W, int tid) {
    constexpr int LOW = BETA - R + 1, NG = FFTN >> R;
    for (int gi = tid; gi < NG; gi += NT) {
        const int base = ((gi >> LOW) << (BETA + 1)) | (gi & ((1 << LOW) - 1));
        f32x2 e[1 << R];
#pragma unroll
        for (int m = 0; m < (1 << R); ++m) e[m] = X[base + (m << LOW)];
#pragma unroll
        for (int ss = 0; ss < R; ++ss) {
            const int s = INV ? (R - 1 - ss) : ss; const int bit = BETA - s, h = 1 << (R - 1 - s);
#pragma unroll
            for (int m = 0; m < (1 << R); ++m) {
                if (m & h) continue;
                const int idx = base + (m << LOW); const int ex = (idx & ((1 << bit) - 1)) << (12 - bit);
                const f32x2 w = W[ex]; const f32x2 a_ = e[m], b_ = e[m | h];
                if (!INV) { const f32x2 d = a_ - b_; e[m] = a_ + b_; e[m | h] = (f32x2){d.x * w.x - d.y * w.y, d.x * w.y + d.y * w.x}; }
                else { const f32x2 t = (f32x2){b_.x * w.x + b_.y * w.y, b_.y * w.x - b_.x * w.y}; e[m] = a_ + t; e[m | h] = a_ - t; }
            }
        }
#pragma unroll
        for (int m = 0; m < (1 << R); ++m) X[base + (m << LOW)] = e[m];
    }
}
__device__ __forceinline__ void fft_forward(LAS f32x2* X, const LAS f32x2* W, int tid) {
    fft_pass<4, 12, false>(X, W, tid); __syncthreads(); fft_pass<3, 8, false>(X, W, tid); __syncthreads();
    fft_pass<3, 5, false>(X, W, tid); __syncthreads(); fft_pass<3, 2, false>(X, W, tid); __syncthreads();
}
__device__ __forceinline__ void fft_inverse(LAS f32x2* X, const LAS f32x2* W, int tid) {
    fft_pass<3, 2, true>(X, W, tid); __syncthreads(); fft_pass<3, 5, true>(X, W, tid); __syncthreads();
    fft_pass<3, 8, true>(X, W, tid); __syncthreads(); fft_pass<4, 12, true>(X, W, tid); __syncthreads();
}
__device__ __forceinline__ float block_sum(float v, LAS float* red, int tid) {
    v = wave_sum(v);
    if ((tid & 63) == 0) red[tid >> 6] = v;
    __syncthreads();
    float t = 0.f;
#pragma unroll
    for (int i = 0; i < NWAVES; ++i) t += red[i];
    __syncthreads();
    return t;
}
constexpr float HY_D0 = -3.0701134573253945f  , HY_D1 = -15.350567286626973f  ;

__device__ __forceinline__ void filt_item(const Args& a, unsigned char* ws, LAS unsigned char* lds, int l, int c, int tid) {
    LAS f32x2* X = (LAS f32x2*)lds; LAS f32x2* W = (LAS f32x2*)(lds + 65536); LAS float* w4s = (LAS float*)(lds + 98304); LAS float* red = (LAS float*)(lds + 98304 + 1024);
    LAS float* k1b = (LAS float*)(lds + 100352);
    fft_twiddles(W, tid);
    if (tid < 256) { const int cc = tid >> 6, f = tid & 63; w4s[tid] = a.in[I_HW4][(size_t)l * 64 * 2048 + (size_t)f * 2048 + (cc >> 1) * 1024 + (cc & 1) * 512 + c]; }
    __syncthreads();
    const float dl = fabsf(HY_D0 + (HY_D1 - HY_D0) * ((float)c / 511.0f));
    const float* H3 = (const float*)(ws + WS_H3) + (size_t)l * 4096 * 64;
    float ss0 = 0.f, ss1 = 0.f;
#pragma unroll 1
    for (int j = 0; j < 16; ++j) {
        const int n = tid + 512 * j; const int dir = j >= 8 ? 1 : 0; const int t = dir ? (8192 - n) : n;
        float s0 = 0.f, s1 = 0.f;
        if (n != 4096) {
            const f32x4* hr = (const f32x4*)(H3 + (size_t)t * 64);
#pragma unroll
            for (int q = 0; q < 16; ++q) { const f32x4 hv = hr[q]; const f32x4 wa = ((const LAS f32x4*)(w4s + (dir * 2 + 0) * 64))[q], wb = ((const LAS f32x4*)(w4s + (dir * 2 + 1) * 64))[q];
                s0 += (hv.x * wa.x + hv.y * wa.y) + (hv.z * wa.z + hv.w * wa.w); s1 += (hv.x * wb.x + hv.y * wb.y) + (hv.z * wb.z + hv.w * wb.w); }
            const float dec = expf(-((float)t / 4095.0f) * dl); s0 *= dec; s1 *= dec;
        }
        X[n] = (f32x2){s0, 0.f}; k1b[n] = s1; ss0 += s0 * s0; ss1 += s1 * s1;
    }
    const float rs0 = rsqrtf(block_sum(ss0, red, tid) + EPS), rs1 = rsqrtf(block_sum(ss1, red, tid) + EPS);
    f32x2* KF0 = (f32x2*)(ws + WS_KF) + (size_t)(0 * 512 + c) * FFTN; f32x2* KF1 = (f32x2*)(ws + WS_KF) + (size_t)(1 * 512 + c) * FFTN;
#pragma unroll 4
    for (int j = 0; j < 16; ++j) { const f32x2 x = X[tid + 512 * j]; X[tid + 512 * j] = (f32x2){x.x * rs0, 0.f}; }
    __syncthreads(); fft_forward(X, W, tid);
#pragma unroll 4
    for (int j = 0; j < 16; ++j) KF0[tid + 512 * j] = X[tid + 512 * j];
    __syncthreads();
#pragma unroll 4
    for (int j = 0; j < 16; ++j) X[tid + 512 * j] = (f32x2){k1b[tid + 512 * j] * rs1, 0.f};
    __syncthreads(); fft_forward(X, W, tid);
#pragma unroll 4
    for (int j = 0; j < 16; ++j) KF1[tid + 512 * j] = X[tid + 512 * j];
    __syncthreads();
}
__device__ __forceinline__ void filt_ctx_item(const Args& a, unsigned char* ws, LAS unsigned char* lds, int c, int tid) {
    LAS float* w4s = (LAS float*)lds; LAS float* red = (LAS float*)(lds + 1024);
    if (tid < 256) { const int cc = tid >> 6, f = tid & 63; w4s[tid] = a.in[I_HW4][(size_t)f * 2048 + (cc >> 1) * 1024 + (cc & 1) * 512 + c]; }
    __syncthreads();
    const float dl = fabsf(HY_D0 + (HY_D1 - HY_D0) * ((float)c / 511.0f));
    const float* H3C = (const float*)(ws + WS_H3C);
    const int n = tid, dir = n >= 256 ? 1 : 0, t = dir ? (512 - n) : n;
    float s0 = 0.f, s1 = 0.f;
    if (n != 256) {
        const f32x4* hr = (const f32x4*)(H3C + (size_t)t * 64);
#pragma unroll
        for (int q = 0; q < 16; ++q) { const f32x4 hv = hr[q]; const f32x4 wa = ((const LAS f32x4*)(w4s + (dir * 2 + 0) * 64))[q], wb = ((const LAS f32x4*)(w4s + (dir * 2 + 1) * 64))[q];
            s0 += (hv.x * wa.x + hv.y * wa.y) + (hv.z * wa.z + hv.w * wa.w); s1 += (hv.x * wb.x + hv.y * wb.y) + (hv.z * wb.z + hv.w * wb.w); }
        const float dec = expf(-((float)t / 255.0f) * dl); s0 *= dec; s1 *= dec;
    }
    const float rs0 = rsqrtf(block_sum(s0 * s0, red, tid) + EPS), rs1 = rsqrtf(block_sum(s1 * s1, red, tid) + EPS);
    float* KC = (float*)(ws + WS_KC);
    KC[(size_t)(0 * 512 + c) * 512 + n] = s0 * rs0; KC[(size_t)(1 * 512 + c) * 512 + n] = s1 * rs1;
    __syncthreads();
}

__device__ __forceinline__ void rope_row(const Args& a, unsigned char* ws, int l, int row, int lane) {
    bf16_t* P = (bf16_t*)(ws + WS_P) + (size_t)row * LDP;
    float ang;
    if (row < NLAT) { const int t = row & (SEQL - 1); const int j = lane & 31; const float inv = exp2f(-(float)j * (13.287712379549449f / 32.0f)); ang = (float)(lane < 32 ? (t >> 6) : (t & 63)) * inv; }
    else { const int t = (row - NLAT) & (LC - 1); const float inv = exp2f(-(float)lane * (13.287712379549449f / 64.0f)); ang = (float)t * inv; }
    float sn, cs; sincosf(ang, &sn, &cs);
    const float ksc = 0.08838834764831845f;
#pragma unroll
    for (int h = 0; h < 4; ++h) {
        bf16_t* q = P + PC_RQ + h * 128; bf16_t* k = P + PC_RK + h * 128;
        const float q1 = bf2f(q[lane]), q2 = bf2f(q[lane + 64]), k1 = bf2f(k[lane]), k2 = bf2f(k[lane + 64]);
        q[lane] = (bf16_t)f2bf(q1 * cs - q2 * sn); q[lane + 64] = (bf16_t)f2bf(q1 * sn + q2 * cs);
        k[lane] = (bf16_t)f2bf((k1 * cs - k2 * sn) * ksc); k[lane + 64] = (bf16_t)f2bf((k1 * sn + k2 * cs) * ksc);
    }
    const float* lr = (const float*)(ws + WS_LR) + (size_t)row * 32;
    bf16_t* GLG = (bf16_t*)(ws + WS_WIN);
#pragma unroll
    for (int dir = 0; dir < 2; ++dir) {
        const float* gw = a.in[I_GGW] + (size_t)(l * 2 + dir) * 16 * 256; const float* gb = a.in[I_GGB] + (size_t)(l * 2 + dir) * 256;
        float lrv[16];
#pragma unroll
        for (int j = 0; j < 16; ++j) lrv[j] = lr[dir * 16 + j];
#pragma unroll
        for (int q = 0; q < 4; ++q) { const int d = lane + 64 * q; float s = gb[d];
#pragma unroll
            for (int j = 0; j < 16; ++j) s += lrv[j] * gw[j * 256 + d];
            const float ls = (s >= 0.f) ? -log1pf(expf(-s)) : (s - log1pf(expf(s)));
            GLG[((size_t)dir * MR + row) * 256 + d] = (bf16_t)f2bf(ls * (1.0f / 16.0f)); }
    }
}

__device__ __forceinline__ void ret_chain(const bf16_t* P, bf16_t* O, int b, int h, int dir, bool ctx_out, int wave, int lane) {
    const int e = wave * 16 + (lane & 15), dq = lane >> 4;
    const float gamma = 1.0f - exp2f(-5.0f - (float)h);
    constexpr int TB = 2;
    float S[32];
#pragma unroll
    for (int i = 0; i < 32; ++i) S[i] = 0.f;
    for (int seg = 0; seg < 2; ++seg) {
        const int n = seg ? SEQL : LC, rowbase = seg ? b * SEQL : NLAT + b * LC; const bool wr_out = seg || ctx_out;
        for (int i0 = 0; i0 < n; i0 += TB) {
            u32x4 q[TB][4], k[TB][4]; bf16_t v[TB];
#pragma unroll
            for (int tb = 0; tb < TB; ++tb) { const int row = rowbase + (dir ? n - 1 - (i0 + tb) : i0 + tb); const bf16_t* pr = P + (size_t)row * LDP;
#pragma unroll
                for (int c4 = 0; c4 < 4; ++c4) { q[tb][c4] = ((const u32x4*)(pr + PC_RQ + h * 128 + dq * 32))[c4]; k[tb][c4] = ((const u32x4*)(pr + PC_RK + h * 128 + dq * 32))[c4]; }
                v[tb] = pr[PC_RV + h * 128 + e]; }
#pragma unroll
            for (int tb = 0; tb < TB; ++tb) {
                const int row = rowbase + (dir ? n - 1 - (i0 + tb) : i0 + tb);
                const float vf = bf2f(v[tb]); float o = 0.f;
#pragma unroll
                for (int c4 = 0; c4 < 4; ++c4) { float qf[8], kf[8]; unpack8(q[tb][c4], qf); unpack8(k[tb][c4], kf);
#pragma unroll
                    for (int x = 0; x < 8; ++x) { const int ix = c4 * 8 + x; S[ix] = gamma * S[ix] + kf[x] * vf; o += qf[x] * S[ix]; } }
                o += __shfl_xor(o, 16); o += __shfl_xor(o, 32);
                if (wr_out && dq == 0) O[(size_t)row * 512 + h * 128 + e] = (bf16_t)f2bf(o);
            }
        }
    }
}
__device__ __forceinline__ void gla_chain(const bf16_t* P, const bf16_t* GLGd, bf16_t* O, int b, int h, int dir, bool ctx_out, int wave, int lane) {
    const int e = wave * 16 + (lane & 15), dq = lane >> 4;
    constexpr int TB = 4;
    float S[16];
#pragma unroll
    for (int i = 0; i < 16; ++i) S[i] = 0.f;
    for (int seg = 0; seg < 2; ++seg) {
        const int n = seg ? SEQL : LC, rowbase = seg ? b * SEQL : NLAT + b * LC; const bool wr_out = seg || ctx_out;
        for (int i0 = 0; i0 < n; i0 += TB) {
            u32x4 q[TB][2], k[TB][2], g[TB][2]; bf16_t v[TB];
#pragma unroll
            for (int tb = 0; tb < TB; ++tb) { const int row = rowbase + (dir ? n - 1 - (i0 + tb) : i0 + tb); const bf16_t* pr = P + (size_t)row * LDP; const bf16_t* gr = GLGd + (size_t)row * 256 + h * 64 + dq * 16;
#pragma unroll
                for (int c4 = 0; c4 < 2; ++c4) { q[tb][c4] = ((const u32x4*)(pr + PC_GQ + h * 64 + dq * 16))[c4]; k[tb][c4] = ((const u32x4*)(pr + PC_GK + h * 64 + dq * 16))[c4]; g[tb][c4] = ((const u32x4*)gr)[c4]; }
                v[tb] = pr[PC_GV + h * 128 + e]; }
#pragma unroll
            for (int tb = 0; tb < TB; ++tb) {
                const int row = rowbase + (dir ? n - 1 - (i0 + tb) : i0 + tb);
                const float vf = bf2f(v[tb]); float o = 0.f;
#pragma unroll
                for (int c4 = 0; c4 < 2; ++c4) { float qf[8], kf[8], gf[8]; unpack8(q[tb][c4], qf); unpack8(k[tb][c4], kf); unpack8(g[tb][c4], gf);
#pragma unroll
                    for (int x = 0; x < 8; ++x) { const int ix = c4 * 8 + x; S[ix] = __expf(gf[x]) * S[ix] + kf[x] * vf; o += qf[x] * S[ix]; } }
                o += __shfl_xor(o, 16); o += __shfl_xor(o, 32);
                if (wr_out && dq == 0) O[(size_t)row * 512 + h * 128 + e] = (bf16_t)f2bf(o * 0.125f);
            }
        }
    }
}
__device__ __forceinline__ void s5_chain(const Args& a, unsigned char* ws, LAS unsigned char* lds, int l, int b, int g, int dir, bool ctx_out, int tid) {
    LAS f32x2* cs = (LAS f32x2*)lds; LAS f32x2* hs = (LAS f32x2*)(lds + 16 * 65 * 8); LAS float* us = (LAS float*)(lds + 2 * 16 * 65 * 8);
    const int wave = tid >> 6, lane = tid & 63;
    const int gi = (l * 2 + dir) * 32 + g;
    const float* cre = a.in[I_S5CRE] + (size_t)gi * 1024; const float* cim = a.in[I_S5CIM] + (size_t)gi * 1024;
    for (int idx = tid; idx < 1024; idx += NT) { const int i = idx >> 6, p = idx & 63; cs[i * 65 + p] = (f32x2){cre[idx], cim[idx]}; }
    f32x2 ab = {0.f, 0.f}; f32x2 bt[16]; f32x2 hst = {0.f, 0.f};
    if (wave == 0) { ab = ((const f32x2*)(ws + WS_S5AB))[gi * 64 + lane]; const f32x2* bp = (const f32x2*)(ws + WS_S5BT) + (size_t)(gi * 64 + lane) * 16;
#pragma unroll
        for (int i = 0; i < 16; ++i) bt[i] = bp[i]; }
    else {
#pragma unroll
        for (int i = 0; i < 16; ++i) bt[i] = (f32x2){0.f, 0.f}; }
    const bf16_t* P = (const bf16_t*)(ws + WS_P);
    bf16_t* Y = (bf16_t*)(ws + WS_OB) + (size_t)(4 + dir) * OBSZ;
    const int tt = tid >> 4, i = tid & 15;
    for (int seg = 0; seg < 2; ++seg) {
        const int n = seg ? SEQL : LC, rowbase = seg ? b * SEQL : NLAT + b * LC; const bool wr_out = seg || ctx_out;
        __syncthreads();
        if (tid < 256) us[tid] = bf2f(P[(size_t)(rowbase + (dir ? n - 1 - tt : tt)) * LDP + PC_S5U + g * 16 + i]);
        for (int bt0 = 0; bt0 < n; bt0 += 16) {
            const int ii = bt0 + tt; const int row = rowbase + (dir ? n - 1 - ii : ii);
            bf16_t unext = 0;
            if (tid < 256 && bt0 + 16 < n) { const int iin = ii + 16; unext = P[(size_t)(rowbase + (dir ? n - 1 - iin : iin)) * LDP + PC_S5U + g * 16 + i]; }
            __syncthreads();
            if (wave == 0) {
#pragma unroll 4
                for (int t2 = 0; t2 < 16; ++t2) {
                    float bur = 0.f, bui = 0.f;
#pragma unroll
                    for (int q = 0; q < 4; ++q) { const f32x4 u = ((const LAS f32x4*)(us + t2 * 16))[q];
                        bur += bt[4 * q].x * u.x + bt[4 * q + 1].x * u.y + bt[4 * q + 2].x * u.z + bt[4 * q + 3].x * u.w;
                        bui += bt[4 * q].y * u.x + bt[4 * q + 1].y * u.y + bt[4 * q + 2].y * u.z + bt[4 * q + 3].y * u.w; }
                    const float hr = ab.x * hst.x - ab.y * hst.y + bur, hi = ab.x * hst.y + ab.y * hst.x + bui;
                    hst = (f32x2){hr, hi};
                    hs[t2 * 65 + lane] = hst;
                }
            }
            __syncthreads();
            if (tid < 256) {
                us[tid] = bf2f(unext);
                float y = 0.f;
#pragma unroll 8
                for (int p = 0; p < 64; ++p) { const f32x2 cv = cs[i * 65 + p], hv = hs[tt * 65 + p]; y += cv.x * hv.x - cv.y * hv.y; }
                if (wr_out) Y[(size_t)row * 512 + g * 16 + i] = (bf16_t)f2bf(y);
            }
        }
    }
    __syncthreads();
}

__device__ __forceinline__ float sconv3(const bf16_t* p, int t, int Lx, float w0, float w1, float w2, float cb) {
    const float x0 = t > 0 ? bf2f(p[t - 1]) : 0.f, x1 = bf2f(p[t]), x2 = t < Lx - 1 ? bf2f(p[t + 1]) : 0.f;
    return w0 * x0 + w1 * x1 + w2 * x2 + cb;
}
__device__ __forceinline__ void hyena_item(const Args& a, unsigned char* ws, LAS unsigned char* lds, int l, int c, int tid) {
    LAS f32x2* X = (LAS f32x2*)lds; LAS f32x2* W = (LAS f32x2*)(lds + 65536);
    fft_twiddles(W, tid);
    const float* cw = a.in[I_HCW] + (size_t)l * 3 * 1536; const float* cbp = a.in[I_HCB] + (size_t)l * 1536;
    const float wv0 = cw[c], wv1 = cw[1536 + c], wv2 = cw[3072 + c], bv = cbp[c];
    const float wa0 = cw[512 + c], wa1 = cw[1536 + 512 + c], wa2 = cw[3072 + 512 + c], ba = cbp[512 + c];
    const float wb0 = cw[1024 + c], wb1 = cw[1536 + 1024 + c], wb2 = cw[3072 + 1024 + c], bb = cbp[1024 + c];
    const float bias0 = a.in[I_HBIAS][(l * 2 + 0) * 512 + c], bias1 = a.in[I_HBIAS][(l * 2 + 1) * 512 + c];
    const bf16_t* PT = (const bf16_t*)(ws + WS_PT);
    const bf16_t* pv = PT + (size_t)(PT_V + c) * MR; const bf16_t* pg1 = PT + (size_t)(PT_G1 + c) * MR; const bf16_t* pg2 = PT + (size_t)(PT_G2 + c) * MR; const bf16_t* phg = PT + (size_t)(PT_HG + c) * MR;
    const f32x2* KF0 = (const f32x2*)(ws + WS_KF) + (size_t)(0 * 512 + c) * FFTN; const f32x2* KF1 = (const f32x2*)(ws + WS_KF) + (size_t)(1 * 512 + c) * FFTN;
    bf16_t* GATED = (bf16_t*)(ws + WS_H);
    __syncthreads();
    for (int bp = 0; bp < 2; ++bp) {
        const int r0 = (2 * bp) * SEQL, r1 = (2 * bp + 1) * SEQL;
        float zr[8], zi[8];
#pragma unroll
        for (int j = 0; j < 8; ++j) { const int t = tid + 512 * j; zr[j] = sconv3(pv + r0, t, SEQL, wv0, wv1, wv2, bv); zi[j] = sconv3(pv + r1, t, SEQL, wv0, wv1, wv2, bv);
            X[t] = (f32x2){zr[j], zi[j]}; X[4096 + t] = (f32x2){0.f, 0.f}; if (j & 1) asm volatile("" ::: "memory"); }
        __syncthreads(); fft_forward(X, W, tid);
#pragma unroll 4
        for (int j = 0; j < 16; ++j) { const int pos = tid + 512 * j; const f32x2 x = X[pos], k = KF0[pos]; X[pos] = (f32x2){x.x * k.x - x.y * k.y, x.x * k.y + x.y * k.x}; }
        __syncthreads(); fft_inverse(X, W, tid);
#pragma unroll
        for (int j = 0; j < 8; ++j) { const int t = tid + 512 * j; const f32x2 cv = X[t] * (1.0f / 8192.0f);
            const float g1r = sconv3(pg1 + r0, t, SEQL, wa0, wa1, wa2, ba), g1i = sconv3(pg1 + r1, t, SEQL, wa0, wa1, wa2, ba);
            zr[j] = g1r * (cv.x + bias0 * zr[j]); zi[j] = g1i * (cv.y + bias0 * zi[j]); if (j & 1) asm volatile("" ::: "memory"); }
        __syncthreads();
#pragma unroll
        for (int j = 0; j < 8; ++j) { const int t = tid + 512 * j; X[t] = (f32x2){zr[j], zi[j]}; X[4096 + t] = (f32x2){0.f, 0.f}; }
        __syncthreads(); fft_forward(X, W, tid);
#pragma unroll 4
        for (int j = 0; j < 16; ++j) { const int pos = tid + 512 * j; const f32x2 x = X[pos], k = KF1[pos]; X[pos] = (f32x2){x.x * k.x - x.y * k.y, x.x * k.y + x.y * k.x}; }
        __syncthreads(); fft_inverse(X, W, tid);
#pragma unroll
        for (int j = 0; j < 8; ++j) { const int t = tid + 512 * j; const f32x2 cv = X[t] * (1.0f / 8192.0f);
            const float g2r = sconv3(pg2 + r0, t, SEQL, wb0, wb1, wb2, bb), g2i = sconv3(pg2 + r1, t, SEQL, wb0, wb1, wb2, bb);
            const float z2r = g2r * (cv.x + bias1 * zr[j]), z2i = g2i * (cv.y + bias1 * zi[j]);
            const float hg0 = bf2f(phg[r0 + t]), hg1 = bf2f(phg[r1 + t]);
            GATED[(size_t)(r0 + t) * D + 512 + c] = (bf16_t)f2bf(z2r * siluf_(hg0)); GATED[(size_t)(r1 + t) * D + 512 + c] = (bf16_t)f2bf(z2i * siluf_(hg1)); if (j & 1) asm volatile("" ::: "memory"); }
        __syncthreads();
    }
}
__device__ __forceinline__ void hyena_ctx_item(const Args& a, unsigned char* ws, LAS unsigned char* lds, int c, int tid) {
    LAS float* kc = (LAS float*)lds; LAS float* za = (LAS float*)(lds + 4096); LAS float* zb = (LAS float*)(lds + 8192);
    const float* KC = (const float*)(ws + WS_KC);
    kc[tid] = KC[(size_t)(0 * 512 + c) * 512 + tid]; kc[512 + tid] = KC[(size_t)(1 * 512 + c) * 512 + tid];
    const float* cw = a.in[I_HCW]; const float* cbp = a.in[I_HCB];
    const float wv0 = cw[c], wv1 = cw[1536 + c], wv2 = cw[3072 + c], bv = cbp[c];
    const float wa0 = cw[512 + c], wa1 = cw[1536 + 512 + c], wa2 = cw[3072 + 512 + c], ba = cbp[512 + c];
    const float wb0 = cw[1024 + c], wb1 = cw[1536 + 1024 + c], wb2 = cw[3072 + 1024 + c], bb = cbp[1024 + c];
    const float bias0 = a.in[I_HBIAS][0 * 512 + c], bias1 = a.in[I_HBIAS][1 * 512 + c];
    const bf16_t* PT = (const bf16_t*)(ws + WS_PT);
    const int b = tid >> 7, tt = tid & 127; const int rb = NLAT + b * LC;
    const bf16_t* pv = PT + (size_t)(PT_V + c) * MR + rb; const bf16_t* pg1 = PT + (size_t)(PT_G1 + c) * MR + rb; const bf16_t* pg2 = PT + (size_t)(PT_G2 + c) * MR + rb; const bf16_t* phg = PT + (size_t)(PT_HG + c) * MR + rb;
    bf16_t* GATED = (bf16_t*)(ws + WS_H);
    float z0[2], z1[2];
#pragma unroll
    for (int q = 0; q < 2; ++q) { const int t = tt + 128 * q; z0[q] = sconv3(pv, t, LC, wv0, wv1, wv2, bv); za[b * 256 + t] = z0[q]; }
    __syncthreads();
#pragma unroll
    for (int q = 0; q < 2; ++q) { const int t = tt + 128 * q; float s = 0.f;
        for (int sidx = 0; sidx < 256; ++sidx) s += kc[(t - sidx) & 511] * za[b * 256 + sidx];
        z1[q] = sconv3(pg1, t, LC, wa0, wa1, wa2, ba) * (s + bias0 * z0[q]); zb[b * 256 + t] = z1[q]; }
    __syncthreads();
#pragma unroll
    for (int q = 0; q < 2; ++q) { const int t = tt + 128 * q; float s = 0.f;
        for (int sidx = 0; sidx < 256; ++sidx) s += kc[512 + ((t - sidx) & 511)] * zb[b * 256 + sidx];
        const float z2 = sconv3(pg2, t, LC, wb0, wb1, wb2, bb) * (s + bias1 * z1[q]);
        GATED[(size_t)(rb + t) * D + 512 + c] = (bf16_t)f2bf(z2 * siluf_(bf2f(phg[t]))); }
    __syncthreads();
}

__device__ __forceinline__ void merge_row(const Args& a, unsigned char* ws, int l, int row, int lane) {
    const int col = 8 * lane;
    const bf16_t* OB = (const bf16_t*)(ws + WS_OB); const bf16_t* P = (const bf16_t*)(ws + WS_P) + (size_t)row * LDP;
    bf16_t* GATED = (bf16_t*)(ws + WS_H) + (size_t)row * D; bf16_t* G5 = (bf16_t*)(ws + WS_KF) + (size_t)row * 512;
#pragma unroll
    for (int mx = 0; mx < 2; ++mx) {
        float of[8], ob[8], gt[8], o[8];
        unpack8(*(const u32x4*)(OB + (size_t)(2 * mx) * OBSZ + (size_t)row * 512 + col), of); unpack8(*(const u32x4*)(OB + (size_t)(2 * mx + 1) * OBSZ + (size_t)row * 512 + col), ob);
        unpack8(*(const u32x4*)(P + (mx ? PC_GG : PC_RG) + col), gt);
        float ss = 0.f;
#pragma unroll
        for (int x = 0; x < 8; ++x) { o[x] = of[x] + ob[x]; ss += o[x] * o[x]; }
        ss += __shfl_xor(ss, 1); ss += __shfl_xor(ss, 2); ss += __shfl_xor(ss, 4); ss += __shfl_xor(ss, 8);
        const float r = rsqrtf(ss * (1.0f / 128.0f) + EPS);
        const float* nw = a.in[mx ? I_GNW : I_RNW] + l * 512 + col;
        float res[8];
#pragma unroll
        for (int x = 0; x < 8; ++x) res[x] = o[x] * r * nw[x] * siluf_(gt[x]);
        *(u32x4*)(GATED + 1024 + 512 * mx + col) = pack8(res);
    }
    { float yf[8], yb[8], u[8], res[8];
      unpack8(*(const u32x4*)(OB + (size_t)4 * OBSZ + (size_t)row * 512 + col), yf); unpack8(*(const u32x4*)(OB + (size_t)5 * OBSZ + (size_t)row * 512 + col), yb);
      unpack8(*(const u32x4*)(P + PC_S5U + col), u);
      const float* dsk = a.in[I_S5D] + l * 512 + col;
#pragma unroll
      for (int x = 0; x < 8; ++x) res[x] = gelu_tanh(yf[x] + yb[x] + u[x] * dsk[x]);
      *(u32x4*)(G5 + col) = pack8(res); }
}

struct EpiInProj {
    static constexpr bool PERM = true, AFTER_DRAIN = false;
    bf16_t* P; bf16_t* PT; float* LR;
    __device__ __forceinline__ void operator()(const pg8::f32x4 (&acc)[2][2][4][2], const pg8::Unit& u, int wr, int wc, int fr, int fq) const {
        const int row0 = u.pm * 256 + wr * 64 + fr, pn = u.pn;
        if (pn < 4 || (pn >= 12 && pn < 26)) {
            const int colbase = (pn < 4 ? pn * 256 : pn * 256 - 2048) + wc * 32 + 8 * fq;
#pragma unroll
            for (int ai = 0; ai < 2; ++ai)
#pragma unroll
                for (int m = 0; m < 4; ++m) { bf16_t* rowp = P + (size_t)(row0 + ai * 128 + m * 16) * LDP + colbase;
#pragma unroll
                    for (int bj = 0; bj < 2; ++bj) { const pg8::f32x4 v0 = acc[ai][bj][m][0], v1 = acc[ai][bj][m][1];
                        u32x4 w; w.x = pk2(v0[0], v0[1]); w.y = pk2(v0[2], v0[3]); w.z = pk2(v1[0], v1[1]); w.w = pk2(v1[2], v1[3]);
                        *(u32x4*)(rowp + bj * 128) = w; } }
        } else if (pn < 12) {
            const int colbase = (pn - 4) * 256 + wc * 32 + 8 * fq;
#pragma unroll
            for (int bj = 0; bj < 2; ++bj)
#pragma unroll
                for (int n = 0; n < 2; ++n)
#pragma unroll
                    for (int j = 0; j < 4; ++j) { bf16_t* cp = PT + (size_t)(colbase + bj * 128 + 4 * n + j) * MR + row0;
#pragma unroll
                        for (int ai = 0; ai < 2; ++ai)
#pragma unroll
                            for (int m = 0; m < 4; ++m) cp[ai * 128 + m * 16] = (bf16_t)f2bf(acc[ai][bj][m][n][j]);
                        asm volatile("" ::: "memory"); }
        } else {
            if (wc == 0) {
#pragma unroll
                for (int ai = 0; ai < 2; ++ai)
#pragma unroll
                    for (int m = 0; m < 4; ++m) { float* rowp = LR + (size_t)(row0 + ai * 128 + m * 16) * 32 + 8 * fq;
                        *(pg8::f32x4*)(rowp) = acc[ai][0][m][0]; *(pg8::f32x4*)(rowp + 4) = acc[ai][0][m][1]; }
            }
        }
    }
};
struct EpiGlu {
    static constexpr bool PERM = true, AFTER_DRAIN = false;
    const bf16_t* G5; const bf16_t* P; bf16_t* GATED; const float* bias;
    __device__ __forceinline__ void operator()(const pg8::f32x4 (&acc)[2][2][4][2], const pg8::Unit& u, int wr, int wc, int fr, int fq) const {
        const int row0 = u.pm * 256 + wr * 64 + fr, col0 = u.pn * 256 + wc * 32 + 8 * fq;
#pragma unroll
        for (int ai = 0; ai < 2; ++ai)
#pragma unroll
            for (int m = 0; m < 4; ++m) { const size_t row = (size_t)(row0 + ai * 128 + m * 16);
#pragma unroll
                for (int bj = 0; bj < 2; ++bj) { const int col = col0 + bj * 128;
                    float g[8], sg[8], res[8]; unpack8(*(const u32x4*)(G5 + row * 512 + col), g); unpack8(*(const u32x4*)(P + row * LDP + PC_S5G + col), sg);
                    const pg8::f32x4 b0 = *(const pg8::f32x4*)(bias + col), b1 = *(const pg8::f32x4*)(bias + col + 4);
#pragma unroll
                    for (int j = 0; j < 4; ++j) { res[j] = g[j] * sigmoidf_(acc[ai][bj][m][0][j] + b0[j]) * siluf_(sg[j]); res[4 + j] = g[4 + j] * sigmoidf_(acc[ai][bj][m][1][j] + b1[j]) * siluf_(sg[4 + j]); }
                    *(u32x4*)(GATED + row * D + col) = pack8(res); } }
    }
};
struct EpiOut {
    static constexpr bool PERM = false, AFTER_DRAIN = false;
    const float* xl_old; const float* xc_old; float* xl_new; float* xc_new; const float* mod;
    __device__ __forceinline__ void operator()(const pg8::f32x4 (&acc)[2][2][4][2], const pg8::Unit& u, int wr, int wc, int fr, int fq) const {
        const int row0 = u.pm * 256 + wr * 64 + fr, col0 = u.pn * 256 + wc * 32 + 4 * fq;
        const bool lat = u.pm < 64;
        const float* xo = lat ? xl_old : xc_old - (size_t)NLAT * D; float* xn = lat ? xl_new : xc_new - (size_t)NLAT * D;
#pragma unroll
        for (int ai = 0; ai < 2; ++ai) {
            const int v = lat ? ((u.pm * 256 + ai * 128) >> 12) : 4;
            const float* gt = mod + (size_t)v * ADA + 2 * D;
#pragma unroll
            for (int m = 0; m < 4; ++m) { const size_t off = (size_t)(row0 + ai * 128 + m * 16) * D + col0;
#pragma unroll
                for (int bj = 0; bj < 2; ++bj)
#pragma unroll
                    for (int n = 0; n < 2; ++n) { const int cc = bj * 128 + n * 16; const pg8::f32x4 gv = *(const pg8::f32x4*)(gt + col0 + cc), xv = *(const pg8::f32x4*)(xo + off + cc);
                        *(pg8::f32x4*)(xn + off + cc) = xv + gv * acc[ai][bj][m][n]; } }
        }
    }
};
#ifndef MK_EN
#define MK_EN 0xffff
#endif
#define EN(x) ((MK_EN >> (x)) & 1)
constexpr int PH_PREP = 0, PH_PER_LAYER = 7, PH_FNORM = 1 + 2 * PH_PER_LAYER, N_PHASES = PH_FNORM + 1;

__global__ void __launch_bounds__(NT, 2) fwd_kernel(Args a) {
    extern __shared__ __attribute__((aligned(16))) unsigned char lds_raw[];
    LAS unsigned char* lds = (LAS unsigned char*)lds_raw;
    const int G = gridDim.x;
    volatile LAS unsigned* bst = (volatile LAS unsigned*)(lds + LDS_CTL_OFF);
    if (threadIdx.x < 16) bst[threadIdx.x] = 0u;
    __syncthreads();
    XcdBarrier gbar; gbar.bar = (unsigned*)(a.ws + WS_CTL); gbar.x = 0; gbar.st = bst;
    if (a.ph_hi - a.ph_lo > 1) gbar = xcd_barrier_post((unsigned*)(a.ws + WS_CTL), bst);

    for (int ph = a.ph_lo; ph < a.ph_hi; ++ph) {
        int tid = threadIdx.x; asm volatile("" : "+v"(tid));
        int bid = blockIdx.x; asm volatile("" : "+s"(bid));
        const int lane = tid & 63, wave = __builtin_amdgcn_readfirstlane(tid >> 6);
        unsigned char* ws = a.ws; asm volatile("" : "+s"(ws));
        float* MOD = (float*)(ws + WS_MOD);
        if (EN(0) && ph == PH_PREP) {
            for (int it = bid; it < 1840; it += G) {
                if (it < 768) prep_adaln(a.in[I_C], a.in[I_CCTX], a.in[I_ADAW], a.in[I_ADAB], MOD, it, (LAS float*)lds, tid);
                else if (it < 784) prep_s5(a, ws, it - 768, tid);
                else { const bool big = it < 1808; const int r = big ? it - 784 : it - 1808, l = big ? (r >> 9) : 0, t0 = (big ? (r & 511) : r) * 8;
                    float* H3o = big ? (float*)(ws + WS_H3) + (size_t)l * 4096 * 64 : (float*)(ws + WS_H3C);
                    prep_hymlp(a, H3o, l, big ? 4096 : 256, t0, (LAS float*)lds, (LAS float*)(lds + 2048), (LAS float*)(lds + 4096), tid); }
            }
        } else if (EN(1) && ph == PH_FNORM) {
            const float* fw = a.in[I_FNW];
            for (int row = bid * NWAVES + wave; row < NLAT; row += G * NWAVES) {
                float* xr = a.out + (size_t)row * D; f32x4 v[8]; float ss = 0.f;
#pragma unroll
                for (int j = 0; j < 8; ++j) { v[j] = ((const f32x4*)xr)[lane + 64 * j]; ss += (v[j].x * v[j].x + v[j].y * v[j].y) + (v[j].z * v[j].z + v[j].w * v[j].w); }
                const float rstd = rsqrtf(wave_sum(ss) * (1.0f / D) + EPS);
#pragma unroll
                for (int j = 0; j < 8; ++j) { const f32x4 w = *(const f32x4*)(fw + 4 * (lane + 64 * j)); ((f32x4*)xr)[lane + 64 * j] = v[j] * rstd * w; }
            }
        } else {
            const int l = (ph - 1) / PH_PER_LAYER, sub = (ph - 1) % PH_PER_LAYER;
            const bool ctx_out = (l == 0);
            const int Mrows = ctx_out ? MR : NLAT;
            if (EN(2) && sub == 0) {
                LAS float* scr = (LAS float*)(lds + wave * 8704);
                const int gw = bid * NWAVES + wave, NGW = G * NWAVES;
                constexpr int I_W1 = 32 * (NPAD / 32), I_W2 = 32 * 64, I_W3 = 8 * 16;
                for (int it = gw; it < I_W1 + I_W2 + I_W3; it += NGW) {
                    int r = it;
                    if (r < I_W1) { const int kb = r / (NPAD / 32), nb = r % (NPAD / 32); transpose_item(a.in[I_WIN] + (size_t)l * D * INW, INW, win_srccol(nb * 32), kb * 64, (bf16_t*)(ws + WS_WIN), D, nb * 32, scr, lane); continue; }
                    r -= I_W1;
                    if (r < I_W2) { const int kb = r / 64, nb = r % 64; transpose_item(a.in[I_WOUT] + (size_t)l * D * D, D, nb * 32, kb * 64, (bf16_t*)(ws + WS_WOUT), D, nb * 32, scr, lane); continue; }
                    r -= I_W2;
                    { const int kb = r / 16, nb = r % 16; transpose_item(a.in[I_GLUW] + (size_t)l * 512 * 512, 512, nb * 32, kb * 64, (bf16_t*)(ws + WS_GLUW), 512, nb * 32, scr, lane); }
                }
                const float* nw = a.in[I_NORMW] + (size_t)l * D;
                for (int row = gw; row < MR; row += NGW) {
                    const float* xr; int v;
                    if (row < NLAT) { xr = (l == 0 ? a.in[I_X] : a.out) + (size_t)row * D; v = row >> 12; }
                    else { xr = (l == 0 ? a.in[I_CTX] : (const float*)(ws + WS_XC1)) + (size_t)(row - NLAT) * D; v = 4; }
                    norm_row(xr, nw, MOD + (size_t)(l * 5 + v) * ADA, (bf16_t*)(ws + WS_H) + (size_t)row * D, lane);
                }
                __syncthreads();
                const int nfilt = ctx_out ? 1024 : 512;
                for (int it = bid; it < nfilt; it += G) { if (it < 512) filt_item(a, ws, lds, l, it, tid); else filt_ctx_item(a, ws, lds, it - 512, tid); }
            } else if (EN(3) && sub == 1) {
                pg8::Gemm g{(const bf16_t*)(ws + WS_H), (const bf16_t*)(ws + WS_WIN), MR, NPAD, D}; pg8::StaticOrder S; S.init(MR, NPAD, G, bid);
                EpiInProj E{(bf16_t*)(ws + WS_P), (bf16_t*)(ws + WS_PT), (float*)(ws + WS_LR)};
                pg8::gemm_phase<EpiInProj, pg8::StaticOrder>(lds, g, S, E, tid);
            } else if (EN(4) && sub == 2) {
                for (int row = bid * NWAVES + wave; row < MR; row += G * NWAVES) rope_row(a, ws, l, row, lane);
            } else if (EN(5) && sub == 3) {
                const int nit = ctx_out ? 1344 : 832;
                const bf16_t* P = (const bf16_t*)(ws + WS_P);
                for (int it = bid; it < nit; it += G) {
                    if (it < 32) ret_chain(P, (bf16_t*)(ws + WS_OB) + (size_t)(it & 1) * OBSZ, it >> 3, (it >> 1) & 3, it & 1, ctx_out, wave, lane);
                    else if (it < 64) { const int r = it - 32; gla_chain(P, (const bf16_t*)(ws + WS_WIN) + (size_t)(r & 1) * MR * 256, (bf16_t*)(ws + WS_OB) + (size_t)(2 + (r & 1)) * OBSZ, r >> 3, (r >> 1) & 3, r & 1, ctx_out, wave, lane); }
                    else if (it < 320) { const int r = it - 64; s5_chain(a, ws, lds, l, r >> 6, (r >> 1) & 31, r & 1, ctx_out, tid); }
                    else if (it < 832) hyena_item(a, ws, lds, l, it - 320, tid);
                    else hyena_ctx_item(a, ws, lds, it - 832, tid);
                }
            } else if (EN(6) && sub == 4) {
                for (int row = bid * NWAVES + wave; row < Mrows; row += G * NWAVES) merge_row(a, ws, l, row, lane);
            } else if (EN(7) && sub == 5) {
                pg8::Gemm g{(const bf16_t*)(ws + WS_KF), (const bf16_t*)(ws + WS_GLUW), Mrows, 512, 512}; pg8::StaticOrder S; S.init(Mrows, 512, G, bid);
                EpiGlu E{(const bf16_t*)(ws + WS_KF), (const bf16_t*)(ws + WS_P), (bf16_t*)(ws + WS_H), a.in[I_GLUB] + (size_t)l * 512};
                pg8::gemm_phase<EpiGlu, pg8::StaticOrder>(lds, g, S, E, tid);
            } else if (EN(8)) {
                pg8::Gemm g{(const bf16_t*)(ws + WS_H), (const bf16_t*)(ws + WS_WOUT), Mrows, D, D}; pg8::StaticOrder S; S.init(Mrows, D, G, bid);
                EpiOut E{l == 0 ? a.in[I_X] : a.out, a.in[I_CTX], a.out, (float*)(ws + WS_XC1), MOD + (size_t)l * 5 * ADA};
                pg8::gemm_phase<EpiOut, pg8::StaticOrder>(lds, g, S, E, tid);
            }
        }
        if (ph + 1 < a.ph_hi) xcd_barrier(gbar);
    }
}

#ifndef MK_LAUNCH_PER_PHASE
#define MK_LAUNCH_PER_PHASE 0
#endif
extern "C" void kernel_launch(void* const* d_in, const int* in_sizes, int n_in, void* d_out, int out_size, void* d_ws, size_t ws_size, hipStream_t stream) {
    static int grid = 0;
    if (grid == 0) {
        if (n_in != N_IN || out_size != NLAT * D || ws_size < WS_END) { fprintf(stderr, "kernel_launch: unexpected shapes (n_in %d, out %d, ws %zu < %zu); nothing launched\n", n_in, out_size, ws_size, (size_t)WS_END); grid = -1; return; }
        int dev = 0, cus = 0, per_cu = 0;
        if (hipGetDevice(&dev) != hipSuccess || hipDeviceGetAttribute(&cus, hipDeviceAttributeMultiprocessorCount, dev) != hipSuccess) { grid = -1; return; }
        if (hipFuncSetAttribute((const void*)fwd_kernel, hipFuncAttributeMaxDynamicSharedMemorySize, LDS_BYTES) != hipSuccess) { fprintf(stderr, "kernel_launch: hipFuncSetAttribute failed\n"); grid = -1; return; }
        if (hipOccupancyMaxActiveBlocksPerMultiprocessor(&per_cu, (const void*)fwd_kernel, NT, LDS_BYTES) != hipSuccess || per_cu < 1) { fprintf(stderr, "kernel_launch: occupancy query says %d blocks per CU\n", per_cu); per_cu = 1; }
        (void)hipGetLastError();
        grid = cus;
    }
    if (grid < 0) return;
    (void)hipMemsetAsync((char*)d_ws + WS_CTL, 0, WS_ZERO_BYTES, stream);
    Args a{};
    for (int i = 0; i < N_IN; ++i) a.in[i] = (const float*)d_in[i];
    a.out = (float*)d_out; a.ws = (unsigned char*)d_ws;
#if MK_LAUNCH_PER_PHASE
    for (int ph = 0; ph < N_PHASES; ++ph) {
        a.ph_lo = ph; a.ph_hi = ph + 1;
        hipLaunchKernelGGL(fwd_kernel, dim3(grid), dim3(NT), LDS_BYTES, stream, a);
    }
#else
    a.ph_lo = 0; a.ph_hi = N_PHASES;
    void* args[] = {&a};
    hipError_t e = hipLaunchCooperativeKernel((const void*)fwd_kernel, dim3(grid), dim3(NT), args, LDS_BYTES, stream);
    if (e != hipSuccess) fprintf(stderr, "kernel_launch: cooperative launch failed: %s (grid %d)\n", hipGetErrorString(e), grid);
#endif
}
```

```cpp
#include <hip/hip_runtime.h>
#include <hip/hip_cooperative_groups.h>
#include <cstdio>
#include <cstdint>
namespace cg = cooperative_groups;

#define LAS __attribute__((address_space(3)))
typedef unsigned short bf16_t;
typedef float f32x4 __attribute__((ext_vector_type(4)));
typedef float f32x2 __attribute__((ext_vector_type(2)));
typedef unsigned u32x4 __attribute__((ext_vector_type(4)));
typedef unsigned u32x2 __attribute__((ext_vector_type(2)));

constexpr int D = 2048, NB = 4, SEQL = 4096, LC = 256, NLAT = NB * SEQL, NCTX = NB * LC, MR = NLAT + NCTX;
constexpr int BR = 512, INW = 6688, NPAD = 6912, LDP = 4608, ADA = 3 * D;
constexpr int NT = 512, NWAVES = 8;
constexpr float EPS = 1e-6f;
constexpr int PC_S5U = 0, PC_S5G = 512, PC_RQ = 1024, PC_RK = 1536, PC_RV = 2048, PC_RG = 2560, PC_GQ = 3072, PC_GK = 3328, PC_GV = 3584, PC_GG = 4096;
constexpr int PT_V = 0, PT_G1 = 512, PT_G2 = 1024, PT_HG = 1536;
constexpr int FFTN = 8192;

enum { I_X = 0, I_C, I_CTX, I_CCTX, I_NORMW, I_ADAW, I_ADAB, I_WIN, I_WOUT, I_S5ARE, I_S5AIM, I_S5LDT, I_S5BRE, I_S5BIM, I_S5CRE, I_S5CIM,
       I_S5D, I_GLUW, I_GLUB, I_HCW, I_HCB, I_HW1, I_HB1, I_HF1, I_HW2, I_HB2, I_HF2, I_HW3, I_HB3, I_HF3, I_HW4, I_HBIAS, I_RNW, I_GGW, I_GGB, I_GNW, I_FNW, N_IN };

constexpr size_t al256(size_t x) { return (x + 255) & ~(size_t)255; }
constexpr size_t WS_CTL  = 0;
constexpr size_t WS_MOD  = WS_CTL + 65536;
constexpr size_t WS_ZERO_BYTES = 65536 + al256((size_t)2 * 5 * ADA * 4);
constexpr size_t WS_S5AB = WS_MOD + al256((size_t)2 * 5 * ADA * 4);
constexpr size_t WS_S5BT = WS_S5AB + (size_t)2 * 2 * 32 * 64 * 8;
constexpr size_t WS_H3   = WS_S5BT + (size_t)2 * 2 * 32 * 64 * 16 * 8;
constexpr size_t WS_H3C  = WS_H3 + (size_t)2 * 4096 * 64 * 4;
constexpr size_t WS_KC   = WS_H3C + (size_t)256 * 64 * 4;
constexpr size_t WS_LR   = WS_KC + (size_t)2 * 512 * 512 * 4;
constexpr size_t WS_XC1  = WS_LR + (size_t)MR * 32 * 4;
constexpr size_t WS_WOUT = WS_XC1 + (size_t)NCTX * D * 4;
constexpr size_t WS_GLUW = WS_WOUT + (size_t)D * D * 2;
constexpr size_t WS_WIN  = WS_GLUW + (size_t)512 * 512 * 2;
constexpr size_t WS_H    = WS_WIN + (size_t)NPAD * D * 2;
constexpr size_t WS_P    = WS_H + (size_t)MR * D * 2;
constexpr size_t WS_PT   = WS_P + (size_t)MR * LDP * 2;
constexpr size_t WS_KF   = WS_PT + (size_t)2048 * MR * 2;
constexpr size_t WS_OB   = WS_KF + (size_t)2 * 512 * FFTN * 8;
constexpr size_t WS_END  = WS_OB + (size_t)6 * MR * 512 * 2;
constexpr size_t OBSZ = (size_t)MR * 512;

constexpr int LDS_CTL_OFF = 131072 + 2048;
constexpr int LDS_PTR_OFF = LDS_CTL_OFF + 64;
constexpr int LDS_BYTES = LDS_PTR_OFF + 320;

__device__ __forceinline__ unsigned f2bf(float f) { unsigned u = __float_as_uint(f); return (u + 0x7fffu + ((u >> 16) & 1u)) >> 16; }
__device__ __forceinline__ unsigned pk2(float lo, float hi) { return f2bf(lo) | (f2bf(hi) << 16); }
__device__ __forceinline__ float bf2f(bf16_t b) { return __uint_as_float((unsigned)b << 16); }
__device__ __forceinline__ float bflo(unsigned w) { return __uint_as_float(w << 16); }
__device__ __forceinline__ float bfhi(unsigned w) { return __uint_as_float(w & 0xffff0000u); }
__device__ __forceinline__ void unpack8(const u32x4 r, float (&f)[8]) { f[0] = bflo(r.x); f[1] = bfhi(r.x); f[2] = bflo(r.y); f[3] = bfhi(r.y); f[4] = bflo(r.z); f[5] = bfhi(r.z); f[6] = bflo(r.w); f[7] = bfhi(r.w); }
__device__ __forceinline__ u32x4 pack8(const float (&f)[8]) { u32x4 o; o.x = pk2(f[0], f[1]); o.y = pk2(f[2], f[3]); o.z = pk2(f[4], f[5]); o.w = pk2(f[6], f[7]); return o; }
__device__ __forceinline__ float sigmoidf_(float x) { return 1.0f / (1.0f + __expf(-x)); }
__device__ __forceinline__ float siluf_(float x) { return x * sigmoidf_(x); }
__device__ __forceinline__ float gelu_tanh(float x) { const float u = 0.7978845608028654f * (x + 0.044715f * x * x * x); return 0.5f * x * (1.0f + tanhf(u)); }
__device__ __forceinline__ float wave_sum(float v) {
#pragma unroll
    for (int o = 1; o < 64; o <<= 1) v += __shfl_xor(v, o);
    return v;
}
#define LDS_WAIT() asm volatile("s_waitcnt lgkmcnt(0)" ::: "memory")

struct Args { const float* in[N_IN]; float* out; unsigned char* ws; int ph_lo, ph_hi; };
struct InTab { const LAS unsigned long long* t;
    __device__ __forceinline__ const float* operator[](int i) const { const unsigned long long v = t[i];
        const unsigned lo = __builtin_amdgcn_readfirstlane((unsigned)v), hi = __builtin_amdgcn_readfirstlane((unsigned)(v >> 32)); return (const float*)(((unsigned long long)hi << 32) | lo); } };
struct DArgs { InTab in; float* out; };

#define XB_TMO      128
#define XB_XCNT(j)  (256  + 64 * (j))
#define XB_XSUB(j)  (1280 + 64 * (j))
#define XB_XGEN(j)  (2304 + 64 * (j))
#define XB_TOP      3328
#define XB_TOPGEN   3392
#define XCD_BAR_WORDS 3456
#define XB_SPIN_CAP (1u << 22)
__device__ __forceinline__ unsigned xb_ld(unsigned* p)              { return __hip_atomic_load(p, __ATOMIC_RELAXED, __HIP_MEMORY_SCOPE_AGENT); }
__device__ __forceinline__ unsigned xb_add(unsigned* p, unsigned v) { return __hip_atomic_fetch_add(p, v, __ATOMIC_RELAXED, __HIP_MEMORY_SCOPE_AGENT); }
__device__ __forceinline__ unsigned xb_xcc_id() { return (unsigned)__builtin_amdgcn_s_getreg((3 << 11) | 20) & 0xFu; }
#define XB_SPIN(cond, bar) do { unsigned _sp = 0; while (cond) { __builtin_amdgcn_s_sleep(1); \
    if ((++_sp & 255u) == 0u) { if (xb_ld(&(bar)[XB_TMO])) break; if (_sp > XB_SPIN_CAP) { atomicAdd(&(bar)[XB_TMO], 1u); break; } } } } while (0)
struct XcdBarrier { unsigned* bar; unsigned x; volatile LAS unsigned* st; };
__device__ __forceinline__ XcdBarrier xcd_barrier_post(unsigned* bar, volatile LAS unsigned* st) {
    XcdBarrier b; b.bar = bar; b.x = xb_xcc_id(); b.st = st;
    if (threadIdx.x == 0) (void)xb_add(&bar[XB_XCNT(b.x)], 1u);
    return b;
}
__device__ __forceinline__ void xcd_barrier_complete(unsigned* bar, unsigned x, unsigned& nloc, unsigned& nx) {
    const unsigned G = gridDim.x * gridDim.y * gridDim.z;
    unsigned sum, cnt, mine, sp = 0u;
    for (;;) {
        sum = 0u; cnt = 0u; mine = 0u;
#pragma unroll
        for (unsigned j = 0; j < 16; ++j) { const unsigned c = xb_ld(&bar[XB_XCNT(j)]); sum += c; cnt += (c > 0u) ? 1u : 0u; mine = (j == x) ? c : mine; }
        if (sum == G) break;
        __builtin_amdgcn_s_sleep(1);
        if ((++sp & 255u) == 0u) { if (xb_ld(&bar[XB_TMO])) break; if (sp > XB_SPIN_CAP) { atomicAdd(&bar[XB_TMO], 1u); break; } }
    }
    nloc = mine > 0u ? mine : 1u; nx = cnt > 0u ? cnt : 1u;
}
__device__ __forceinline__ void xcd_barrier(const XcdBarrier& b) {
    asm volatile("s_waitcnt vmcnt(0)" ::: "memory");
    __syncthreads();
    if (threadIdx.x == 0) {
        unsigned* bar = b.bar;
        __builtin_amdgcn_s_waitcnt(0);
        unsigned nloc = b.st[0], nx = b.st[1];
        if (nloc == 0u) { xcd_barrier_complete(bar, b.x, nloc, nx); b.st[0] = nloc; b.st[1] = nx; }
        const unsigned old = xb_add(&bar[XB_XSUB(b.x)], 1u);
        const unsigned gen = old / nloc;
        if (old + 1u == (gen + 1u) * nloc) {
            __builtin_amdgcn_fence(__ATOMIC_RELEASE, "agent");
            asm volatile("s_waitcnt vmcnt(0)" ::: "memory");
            const unsigned og = xb_add(&bar[XB_TOP], 1u);
            const unsigned tg = og / nx;
            if (og + 1u == (tg + 1u) * nx) xb_add(&bar[XB_TOPGEN], 1u);
            else XB_SPIN(xb_ld(&bar[XB_TOPGEN]) == tg, bar);
            __builtin_amdgcn_fence(__ATOMIC_ACQUIRE, "agent");
            xb_add(&bar[XB_XGEN(b.x)], 1u);
            asm volatile("s_waitcnt vmcnt(0)" ::: "memory");
        } else {
            XB_SPIN(xb_ld(&bar[XB_XGEN(b.x)]) == gen, bar);
            __builtin_amdgcn_fence(__ATOMIC_ACQUIRE, "agent");
            asm volatile("s_waitcnt vmcnt(0)" ::: "memory");
        }
    }
    __syncthreads();
}
namespace pg8 {
#define PG8_LAS __attribute__((address_space(3)))
typedef unsigned short bf16_t;
typedef short bf16x8 __attribute__((ext_vector_type(8)));
typedef float f32x4 __attribute__((ext_vector_type(4)));
typedef unsigned u32x4 __attribute__((ext_vector_type(4)));
constexpr int BM = 256, BK = 64, HALF = 128, HTB = HALF * BK * 2, STAGE_BYTES = 8 * HTB, NXCD = 8, WGM = 8;

__host__ __device__ __forceinline__ int lds_byte(int r, int c) { const int st = (r >> 4) * 2 + (c >> 5), rr = r & 15, cc = c & 31, ob = rr * 64 + cc * 2; return st * 1024 + (ob ^ (((ob >> 9) & 1) << 5)); }
__host__ __device__ __forceinline__ void stage_rc(int b, int& R, int& C) { const int st = b / 1024, sb = b % 1024, swz = sb ^ (((sb >> 9) & 1) << 5); R = (st >> 1) * 16 + swz / 64; C = (st & 1) * 32 + (swz % 64) / 2; }
__host__ __device__ __forceinline__ int perm32(int rho) { const int n = rho >> 4, i = rho & 15; return 8 * (i >> 2) + 4 * n + (i & 3); }

struct Unit { int pm, pn; };
struct Gemm { const bf16_t* A; const bf16_t* Bt; int M, N, K; };

struct StaticOrder {
    int nM, nN, nwg, G, c;
    __host__ __device__ void init(int M, int N, int G_, int c_) { nM = M / BM; nN = N / BM; nwg = nM * nN; G = G_; c = c_; }
    __host__ __device__ bool next(int i, Unit& u) const {
        const long L = (long)i * G + c; if (L >= nwg) return false;
        int wgid = (int)L; { const int q = nwg / NXCD, r = nwg % NXCD, xcd = wgid % NXCD, off = wgid / NXCD; wgid = (xcd < r ? xcd * (q + 1) : r * (q + 1) + (xcd - r) * q) + off; }
        const int nig = WGM * nN, gid = wgid / nig, fm = gid * WGM, gsz = (nM - fm) < WGM ? (nM - fm) : WGM;
        u.pm = fm + ((wgid % nig) % gsz); u.pn = (wgid % nig) / gsz; return true;
    }
    __device__ __forceinline__ void a_ready(const Unit&) const {}
    __device__ __forceinline__ void done(const Unit&) const {}
};

template <class Epi, class Sched>
__device__ __forceinline__ void gemm_phase(PG8_LAS unsigned char* lds, const Gemm g, const Sched& S, const Epi& E, const int tid) {
    const int wid = __builtin_amdgcn_readfirstlane(tid >> 6), lane = tid & 63, wr = wid >> 2, wc = wid & 3, fr = lane & 15, fq = lane >> 4;
    const int K = g.K, nt = K / BK;
    unsigned voffA[2], voffB[2];
#pragma unroll
    for (int i = 0; i < 2; ++i) { int R, C; stage_rc(tid * 16 + i * 8192, R, C); const int Rb = Epi::PERM ? ((R & ~31) + perm32(R & 31)) : R;
        voffA[i] = (unsigned)(R * K + C) * 2u; voffB[i] = (unsigned)(Rb * K + C) * 2u; }
    const size_t kstep = (size_t)(BK * 2);
    const size_t hstep = (size_t)HALF * K * 2;
    const size_t tstep = 2 * hstep;
    const unsigned ldsw = (unsigned)wid * 1024u;
    const int aoff = lds_byte(wr * 64 + fr, fq * 8), boff = lds_byte(wc * 32 + fr, fq * 8);
#define PG8_SA(b, h) (((b) * 2 + (h)) * HTB)
#define PG8_SB(b, h) ((4 + (b) * 2 + (h)) * HTB)
#define PG8_STAGE(bufoff, gbase, voff) do { _Pragma("unroll") for (int _i = 0; _i < 2; ++_i) \
        __builtin_amdgcn_global_load_lds((const unsigned*)((const char*)(gbase) + (voff)[_i]), (PG8_LAS unsigned*)(lds + (bufoff) + ldsw + _i * 8192), 16, 0, 0); } while (0)
#define PG8_LDA(dst, b, h) do { _Pragma("unroll") for (int m = 0; m < 4; ++m) _Pragma("unroll") for (int k = 0; k < 2; ++k) dst[m][k] = *(const PG8_LAS bf16x8*)(lds + PG8_SA(b, h) + aoff + m * 2048 + k * 1024); } while (0)
#define PG8_LDB(dst, b, h) do { _Pragma("unroll") for (int n = 0; n < 2; ++n) _Pragma("unroll") for (int k = 0; k < 2; ++k) dst[n][k] = *(const PG8_LAS bf16x8*)(lds + PG8_SB(b, h) + boff + n * 2048 + k * 1024); } while (0)
#define PG8_MMA(ai, bj, At, Bt) do { __builtin_amdgcn_s_setprio(1); _Pragma("unroll") for (int m = 0; m < 4; ++m) _Pragma("unroll") for (int n = 0; n < 2; ++n) _Pragma("unroll") for (int k = 0; k < 2; ++k) \
        acc[ai][bj][m][n] = __builtin_amdgcn_mfma_f32_16x16x32_bf16(Bt[n][k], At[m][k], acc[ai][bj][m][n], 0, 0, 0); __builtin_amdgcn_s_setprio(0); } while (0)
#define PG8_WAIT_V(n) asm volatile("s_waitcnt vmcnt(" #n ")" ::: "memory")
#define PG8_WAIT_L(n) asm volatile("s_waitcnt lgkmcnt(" #n ")" ::: "memory")
#define PG8_BAR __builtin_amdgcn_s_barrier()
#define PG8_SCHED __builtin_amdgcn_sched_barrier(0)
    Unit cur, nxt; int ui = 0;
    if (!S.next(0, cur)) return;
    f32x4 acc[2][2][4][2];
#pragma unroll
    for (int a = 0; a < 2; ++a)
#pragma unroll
        for (int b = 0; b < 2; ++b)
#pragma unroll
            for (int m = 0; m < 4; ++m)
#pragma unroll
                for (int n = 0; n < 2; ++n) acc[a][b][m][n] = (f32x4){0.f, 0.f, 0.f, 0.f};
    bf16x8 At[4][2], B0[2][2], B1[2][2];
    const char* cA = (const char*)g.A + (size_t)cur.pm * tstep; const char* cB = (const char*)g.Bt + (size_t)cur.pn * tstep;
    S.a_ready(cur);
    PG8_STAGE(PG8_SB(0, 0), cB, voffB); PG8_STAGE(PG8_SA(0, 0), cA, voffA); PG8_STAGE(PG8_SB(0, 1), cB + hstep, voffB); PG8_STAGE(PG8_SA(0, 1), cA + hstep, voffA);
    if (wr == 1) PG8_BAR;
    PG8_WAIT_V(4); PG8_BAR;
    PG8_STAGE(PG8_SB(1, 0), cB + kstep, voffB); PG8_STAGE(PG8_SA(1, 0), cA + kstep, voffA); PG8_STAGE(PG8_SB(1, 1), cB + hstep + kstep, voffB);
    PG8_WAIT_V(6); PG8_BAR;
    for (;;) {
        const bool has_next = S.next(ui + 1, nxt);
        const char* nA = has_next ? (const char*)g.A + (size_t)nxt.pm * tstep : cA; const char* nB = has_next ? (const char*)g.Bt + (size_t)nxt.pn * tstep : cB;
        for (int t = 0; t < nt; t += 2) {
            const bool last = (t == nt - 2);
            const char* a1 = cA + (size_t)(t + 1) * kstep;
            const char* a2 = last ? nA : cA + (size_t)(t + 2) * kstep; const char* b2 = last ? nB : cB + (size_t)(t + 2) * kstep;
            const char* a3 = a2 + kstep; const char* b3 = b2 + kstep;
            if (last && has_next) S.a_ready(nxt);
            PG8_LDB(B0, 0, 0); PG8_SCHED; PG8_LDA(At, 0, 0); PG8_STAGE(PG8_SA(1, 1), a1 + hstep, voffA);
            PG8_WAIT_L(8); PG8_BAR; PG8_WAIT_L(0); PG8_MMA(0, 0, At, B0); PG8_BAR; PG8_SCHED;
            PG8_LDB(B1, 0, 1); PG8_STAGE(PG8_SB(0, 0), b2, voffB);
            PG8_BAR; PG8_WAIT_L(0); PG8_MMA(0, 1, At, B1); PG8_BAR;
            PG8_LDA(At, 0, 1); PG8_STAGE(PG8_SA(0, 0), a2, voffA);
            PG8_BAR; PG8_WAIT_L(0); PG8_MMA(1, 0, At, B0); PG8_BAR; PG8_SCHED;
            PG8_STAGE(PG8_SB(0, 1), b2 + hstep, voffB);
            PG8_WAIT_V(6); PG8_BAR; PG8_MMA(1, 1, At, B1); PG8_BAR;
            PG8_LDB(B0, 1, 0); PG8_SCHED; PG8_LDA(At, 1, 0); PG8_STAGE(PG8_SA(0, 1), a2 + hstep, voffA);
            PG8_WAIT_L(8); PG8_BAR; PG8_WAIT_L(0); PG8_MMA(0, 0, At, B0); PG8_BAR; PG8_SCHED;
            PG8_LDB(B1, 1, 1); PG8_STAGE(PG8_SB(1, 0), b3, voffB);
            PG8_BAR; PG8_WAIT_L(0); PG8_MMA(0, 1, At, B1); PG8_BAR;
            PG8_LDA(At, 1, 1); PG8_STAGE(PG8_SA(1, 0), a3, voffA);
            PG8_BAR; PG8_WAIT_L(0); PG8_MMA(1, 0, At, B0); PG8_BAR; PG8_SCHED;
            PG8_STAGE(PG8_SB(1, 1), b3 + hstep, voffB);
            PG8_WAIT_V(6); PG8_BAR; PG8_MMA(1, 1, At, B1); PG8_BAR;
        }
        E(acc, cur, wr, wc, fr, fq); S.done(cur);
        if (!has_next) break;
#pragma unroll
        for (int a = 0; a < 2; ++a)
#pragma unroll
            for (int b = 0; b < 2; ++b)
#pragma unroll
                for (int m = 0; m < 4; ++m)
#pragma unroll
                    for (int n = 0; n < 2; ++n) acc[a][b][m][n] = (f32x4){0.f, 0.f, 0.f, 0.f};
        cur = nxt; cA = nA; cB = nB; ++ui;
    }
    PG8_WAIT_V(0);
    if (wr == 0) PG8_BAR;
    PG8_BAR;
#undef PG8_SA
#undef PG8_SB
#undef PG8_STAGE
#undef PG8_LDA
#undef PG8_LDB
#undef PG8_MMA
#undef PG8_WAIT_V
#undef PG8_WAIT_L
#undef PG8_BAR
#undef PG8_SCHED
}
}
__device__ __forceinline__ void prep_adaln(const float* c, const float* cctx, const float* adaw, const float* adab, float* MOD, int it, LAS float* sv, int tid) {
    const int l = it / 384, r = it % 384, ntile = r >> 5, ks = r & 31, k0 = ks * 64;
    if (tid < 320) { const int v = tid >> 6, k = tid & 63; const float cv = v < 4 ? c[v * D + k0 + k] : cctx[k0 + k]; sv[tid] = cv / (1.0f + expf(-cv)); }
    __syncthreads();
    const int n = ntile * 512 + tid; const float* w = adaw + (size_t)l * D * ADA + (size_t)k0 * ADA + n;
    float acc[5] = {0.f, 0.f, 0.f, 0.f, 0.f};
#pragma unroll 8
    for (int k = 0; k < 64; ++k) { const float wv = w[(size_t)k * ADA];
#pragma unroll
        for (int v = 0; v < 5; ++v) acc[v] += sv[v * 64 + k] * wv; }
    if (ks == 0) { const float bb = adab[l * ADA + n];
#pragma unroll
        for (int v = 0; v < 5; ++v) acc[v] += bb; }
#pragma unroll
    for (int v = 0; v < 5; ++v) atomicAdd(MOD + (size_t)(l * 5 + v) * ADA + n, acc[v]);
    __syncthreads();
}

__device__ __forceinline__ void prep_s5(const DArgs& a, unsigned char* ws, int it, int tid) {
    const int idx = it * 512 + tid;
    const float a_re = a.in[I_S5ARE][idx], a_im = a.in[I_S5AIM][idx], ldt = a.in[I_S5LDT][idx >> 6];
    const float dt = expf(ldt), mag = expf(a_re * dt);
    float sn, cs; sincosf(a_im * dt, &sn, &cs);
    const float ab_re = mag * cs, ab_im = mag * sn, den = a_re * a_re + a_im * a_im, nr = ab_re - 1.0f;
    const float co_re = (nr * a_re + ab_im * a_im) / den, co_im = (ab_im * a_re - nr * a_im) / den;
    ((f32x2*)(ws + WS_S5AB))[idx] = (f32x2){ab_re, ab_im};
    const float* bre = a.in[I_S5BRE] + (size_t)idx * 16; const float* bim = a.in[I_S5BIM] + (size_t)idx * 16;
    f32x2* bt = (f32x2*)(ws + WS_S5BT) + (size_t)idx * 16;
#pragma unroll
    for (int i = 0; i < 16; ++i) { const float br = bre[i], bi = bim[i]; bt[i] = (f32x2){co_re * br - co_im * bi, co_re * bi + co_im * br}; }
}

__device__ __forceinline__ void prep_hymlp(const DArgs& a, float* H3out, int l, int Lx, int t0, LAS float* zs, LAS float* h1, LAS float* h2, int tid) {
    const int pos = tid >> 6, f = tid & 63, t = t0 + pos;
    if (f < 33) {
        float z;
        if (f == 0) z = (float)t / (float)(Lx - 1);
        else { const int j = (f - 1) & 15; const float fj = 1e-4f + (float)j * ((15.0f - 1e-4f) / 15.0f); const float wpos = (6.283185307179586f * (float)t) / (float)Lx; const float arg = fj * wpos;
               z = (f <= 16) ? cosf(arg) : -sinf(arg); }
        zs[pos * 36 + f] = z;
    }
    __syncthreads();
    const float* w1 = a.in[I_HW1] + (size_t)l * 33 * 64; const float* w2 = a.in[I_HW2] + (size_t)l * 64 * 64; const float* w3 = a.in[I_HW3] + (size_t)l * 64 * 64;
    float s = a.in[I_HB1][l * 64 + f];
#pragma unroll 3
    for (int j = 0; j < 33; ++j) s += zs[pos * 36 + j] * w1[j * 64 + f];
    h1[pos * 64 + f] = sinf(a.in[I_HF1][l * 64 + f] * s);
    __syncthreads();
    s = a.in[I_HB2][l * 64 + f];
#pragma unroll 4
    for (int j = 0; j < 64; ++j) s += h1[pos * 64 + j] * w2[j * 64 + f];
    h2[pos * 64 + f] = sinf(a.in[I_HF2][l * 64 + f] * s);
    __syncthreads();
    s = a.in[I_HB3][l * 64 + f];
#pragma unroll 4
    for (int j = 0; j < 64; ++j) s += h2[pos * 64 + j] * w3[j * 64 + f];
    H3out[(size_t)t * 64 + f] = sinf(a.in[I_HF3][l * 64 + f] * s);
    __syncthreads();
}

__device__ __forceinline__ void transpose_item(const float* W, int ldw, int srccol0, int k0, bf16_t* WT, int K, int dstrow0, LAS float* scr, int lane) {
    if (srccol0 >= 0) {
#pragma unroll 8
        for (int i = 0; i < 32; ++i) { const int kk = 2 * i + (lane >> 5); scr[kk * 33 + (lane & 31)] = W[(size_t)(k0 + kk) * ldw + srccol0 + (lane & 31)]; }
    } else {
#pragma unroll 8
        for (int i = 0; i < 32; ++i) { const int kk = 2 * i + (lane >> 5); scr[kk * 33 + (lane & 31)] = 0.f; }
    }
    LDS_WAIT();
    const int c = lane & 7;
#pragma unroll
    for (int j = 0; j < 4; ++j) { const int n = (lane >> 3) + 8 * j; const LAS float* s = scr + (8 * c) * 33 + n;
        u32x4 o; o.x = pk2(s[0 * 33], s[1 * 33]); o.y = pk2(s[2 * 33], s[3 * 33]); o.z = pk2(s[4 * 33], s[5 * 33]); o.w = pk2(s[6 * 33], s[7 * 33]);
        *(u32x4*)(WT + (size_t)(dstrow0 + n) * K + k0 + 8 * c) = o; }
    LDS_WAIT();
}
__device__ __forceinline__ int win_srccol(int n) { return n < 6144 ? n : (n < 6656 ? n + 32 : (n < 6688 ? n - 512 : -1)); }

__device__ __forceinline__ void norm_row(const float* xrow, const float* nw, const float* mod, bf16_t* hrow, int lane) {
    f32x4 v[8]; float ss = 0.f;
#pragma unroll
    for (int j = 0; j < 8; ++j) { v[j] = ((const f32x4*)xrow)[lane + 64 * j]; ss += (v[j].x * v[j].x + v[j].y * v[j].y) + (v[j].z * v[j].z + v[j].w * v[j].w); }
    const float rstd = rsqrtf(wave_sum(ss) * (1.0f / D) + EPS);
#pragma unroll
    for (int j = 0; j < 8; ++j) { const int k = 4 * (lane + 64 * j);
        const f32x4 w = *(const f32x4*)(nw + k), sh = *(const f32x4*)(mod + k), sc = *(const f32x4*)(mod + D + k);
        const f32x4 o = v[j] * rstd * w * (sc + 1.0f) + sh;
        u32x2 pk; pk.x = pk2(o.x, o.y); pk.y = pk2(o.z, o.w);
        *(u32x2*)(hrow + k) = pk; }
}

__device__ __forceinline__ void fft_twiddles(LAS f32x2* W, int tid) {
    for (int j = tid; j < 4096; j += NT) { float s, c; sincospif(-(float)j * (1.0f / 4096.0f), &s, &c); W[j] = (f32x2){c, s}; }
}
template <int R, int BETA, bool INV> __device__ __forceinline__ void fft_pass(LAS f32x2* X, const LAS f32x2* W, int tid) {
    constexpr int LOW = BETA - R + 1, NG = FFTN >> R;
    for (int gi = tid; gi < NG; gi += NT) {
        const int base = ((gi >> LOW) << (BETA + 1)) | (gi & ((1 << LOW) - 1));
        f32x2 e[1 << R];
#pragma unroll
        for (int m = 0; m < (1 << R); ++m) e[m] = X[base + (m << LOW)];
#pragma unroll
        for (int ss = 0; ss < R; ++ss) {
            const int s = INV ? (R - 1 - ss) : ss; const int bit = BETA - s, h = 1 << (R - 1 - s);
#pragma unroll
            for (int m = 0; m < (1 << R); ++m) {
                if (m & h) continue;
                const int idx = base + (m << LOW); const int ex = (idx & ((1 << bit) - 1)) << (12 - bit);
                const f32x2 w = W[ex]; const f32x2 a_ = e[m], b_ = e[m | h];
                if (!INV) { const f32x2 d = a_ - b_; e[m] = a_ + b_; e[m | h] = (f32x2){d.x * w.x - d.y * w.y, d.x * w.y + d.y * w.x}; }
                else { const f32x2 t = (f32x2){b_.x * w.x + b_.y * w.y, b_.y * w.x - b_.x * w.y}; e[m] = a_ + t; e[m | h] = a_ - t; }
            }
        }
#pragma unroll
        for (int m = 0; m < (1 << R); ++m) X[base + (m << LOW)] = e[m];
    }
}
__device__ __forceinline__ void fft_forward(LAS f32x2* X, const LAS f32x2* W, int tid) {
    fft_pass<4, 12, false>(X, W, tid); __syncthreads(); fft_pass<3, 8, false>(X, W, tid); __syncthreads();
    fft_pass<3, 5, false>(X, W, tid); __syncthreads(); fft_pass<3, 2, false>(X, W, tid); __syncthreads();
}
__device__ __forceinline__ void fft_inverse(LAS f32x2* X, const LAS f32x2* W, int tid) {
    fft_pass<3, 2, true>(X, W, tid); __syncthreads(); fft_pass<3, 5, true>(X, W, tid); __syncthreads();
    fft_pass<3, 8, true>(X, W, tid); __syncthreads(); fft_pass<4, 12, true>(X, W, tid); __syncthreads();
}
__device__ __forceinline__ float block_sum(float v, LAS float* red, int tid) {
    v = wave_sum(v);
    if ((tid & 63) == 0) red[tid >> 6] = v;
    __syncthreads();
    float t = 0.f;
#pragma unroll
    for (int i = 0; i < NWAVES; ++i) t += red[i];
    __syncthreads();
    return t;
}
constexpr float HY_D0 = -3.0701134573253945f  , HY_D1 = -15.350567286626973f  ;

__device__ __forceinline__ void filt_item(const DArgs& a, unsigned char* ws, LAS unsigned char* lds, int l, int c, int tid) {
    LAS f32x2* X = (LAS f32x2*)lds; LAS f32x2* W = (LAS f32x2*)(lds + 65536); LAS float* w4s = (LAS float*)(lds + 98304); LAS float* red = (LAS float*)(lds + 98304 + 1024);
    LAS float* k1b = (LAS float*)(lds + 100352);
    fft_twiddles(W, tid);
    if (tid < 256) { const int cc = tid >> 6, f = tid & 63; w4s[tid] = a.in[I_HW4][(size_t)l * 64 * 2048 + (size_t)f * 2048 + (cc >> 1) * 1024 + (cc & 1) * 512 + c]; }
    __syncthreads();
    const float dl = fabsf(HY_D0 + (HY_D1 - HY_D0) * ((float)c / 511.0f));
    const float* H3 = (const float*)(ws + WS_H3) + (size_t)l * 4096 * 64;
    float ss0 = 0.f, ss1 = 0.f;
#pragma unroll 1
    for (int j = 0; j < 16; ++j) {
        const int n = tid + 512 * j; const int dir = j >= 8 ? 1 : 0; const int t = dir ? (8192 - n) : n;
        float s0 = 0.f, s1 = 0.f;
        if (n != 4096) {
            const f32x4* hr = (const f32x4*)(H3 + (size_t)t * 64);
#pragma unroll
            for (int q = 0; q < 16; ++q) { const f32x4 hv = hr[q]; const f32x4 wa = ((const LAS f32x4*)(w4s + (dir * 2 + 0) * 64))[q], wb = ((const LAS f32x4*)(w4s + (dir * 2 + 1) * 64))[q];
                s0 += (hv.x * wa.x + hv.y * wa.y) + (hv.z * wa.z + hv.w * wa.w); s1 += (hv.x * wb.x + hv.y * wb.y) + (hv.z * wb.z + hv.w * wb.w); }
            const float dec = expf(-((float)t / 4095.0f) * dl); s0 *= dec; s1 *= dec;
        }
        X[n] = (f32x2){s0, 0.f}; k1b[n] = s1; ss0 += s0 * s0; ss1 += s1 * s1;
    }
    const float rs0 = rsqrtf(block_sum(ss0, red, tid) + EPS), rs1 = rsqrtf(block_sum(ss1, red, tid) + EPS);
    f32x2* KF0 = (f32x2*)(ws + WS_KF) + (size_t)(0 * 512 + c) * FFTN; f32x2* KF1 = (f32x2*)(ws + WS_KF) + (size_t)(1 * 512 + c) * FFTN;
#pragma unroll 4
    for (int j = 0; j < 16; ++j) { const f32x2 x = X[tid + 512 * j]; X[tid + 512 * j] = (f32x2){x.x * rs0, 0.f}; }
    __syncthreads(); fft_forward(X, W, tid);
#pragma unroll 4
    for (int j = 0; j < 16; ++j) KF0[tid + 512 * j] = X[tid + 512 * j];
    __syncthreads();
#pragma unroll 4
    for (int j = 0; j < 16; ++j) X[tid + 512 * j] = (f32x2){k1b[tid + 512 * j] * rs1, 0.f};
    __syncthreads(); fft_forward(X, W, tid);
#pragma unroll 4
    for (int j = 0; j < 16; ++j) KF1[tid + 512 * j] = X[tid + 512 * j];
    __syncthreads();
}
__device__ __forceinline__ void filt_ctx_item(const DArgs& a, unsigned char* ws, LAS unsigned char* lds, int c, int tid) {
    LAS float* w4s = (LAS float*)lds; LAS float* red = (LAS float*)(lds + 1024);
    if (tid < 256) { const int cc = tid >> 6, f = tid & 63; w4s[tid] = a.in[I_HW4][(size_t)f * 2048 + (cc >> 1) * 1024 + (cc & 1) * 512 + c]; }
    __syncthreads();
    const float dl = fabsf(HY_D0 + (HY_D1 - HY_D0) * ((float)c / 511.0f));
    const float* H3C = (const float*)(ws + WS_H3C);
    const int n = tid, dir = n >= 256 ? 1 : 0, t = dir ? (512 - n) : n;
    float s0 = 0.f, s1 = 0.f;
    if (n != 256) {
        const f32x4* hr = (const f32x4*)(H3C + (size_t)t * 64);
#pragma unroll
        for (int q = 0; q < 16; ++q) { const f32x4 hv = hr[q]; const f32x4 wa = ((const LAS f32x4*)(w4s + (dir * 2 + 0) * 64))[q], wb = ((const LAS f32x4*)(w4s + (dir * 2 + 1) * 64))[q];
            s0 += (hv.x * wa.x + hv.y * wa.y) + (hv.z * wa.z + hv.w * wa.w); s1 += (hv.x * wb.x + hv.y * wb.y) + (hv.z * wb.z + hv.w * wb.w); }
        const float dec = expf(-((float)t / 255.0f) * dl); s0 *= dec; s1 *= dec;
    }
    const float rs0 = rsqrtf(block_sum(s0 * s0, red, tid) + EPS), rs1 = rsqrtf(block_sum(s1 * s1, red, tid) + EPS);
    float* KC = (float*)(ws + WS_KC);
    KC[(size_t)(0 * 512 + c) * 512 + n] = s0 * rs0; KC[(size_t)(1 * 512 + c) * 512 + n] = s1 * rs1;
    __syncthreads();
}

__device__ __forceinline__ void rope_row(const DArgs& a, unsigned char* ws, int l, int row, int lane) {
    bf16_t* P = (bf16_t*)(ws + WS_P) + (size_t)row * LDP;
    float ang;
    if (row < NLAT) { const int t = row & (SEQL - 1); const int j = lane & 31; const float inv = exp2f(-(float)j * (13.287712379549449f / 32.0f)); ang = (float)(lane < 32 ? (t >> 6) : (t & 63)) * inv; }
    else { const int t = (row - NLAT) & (LC - 1); const float inv = exp2f(-(float)lane * (13.287712379549449f / 64.0f)); ang = (float)t * inv; }
    float sn, cs; sincosf(ang, &sn, &cs);
    const float ksc = 0.08838834764831845f;
#pragma unroll
    for (int h = 0; h < 4; ++h) {
        bf16_t* q = P + PC_RQ + h * 128; bf16_t* k = P + PC_RK + h * 128;
        const float q1 = bf2f(q[lane]), q2 = bf2f(q[lane + 64]), k1 = bf2f(k[lane]), k2 = bf2f(k[lane + 64]);
        q[lane] = (bf16_t)f2bf(q1 * cs - q2 * sn); q[lane + 64] = (bf16_t)f2bf(q1 * sn + q2 * cs);
        k[lane] = (bf16_t)f2bf((k1 * cs - k2 * sn) * ksc); k[lane + 64] = (bf16_t)f2bf((k1 * sn + k2 * cs) * ksc);
    }
    const float* lr = (const float*)(ws + WS_LR) + (size_t)row * 32;
    bf16_t* GLG = (bf16_t*)(ws + WS_WIN);
#pragma unroll
    for (int dir = 0; dir < 2; ++dir) {
        const float* gw = a.in[I_GGW] + (size_t)(l * 2 + dir) * 16 * 256; const float* gb = a.in[I_GGB] + (size_t)(l * 2 + dir) * 256;
        float lrv[16];
#pragma unroll
        for (int j = 0; j < 16; ++j) lrv[j] = lr[dir * 16 + j];
#pragma unroll
        for (int q = 0; q < 4; ++q) { const int d = lane + 64 * q; float s = gb[d];
#pragma unroll
            for (int j = 0; j < 16; ++j) s += lrv[j] * gw[j * 256 + d];
            const float ls = (s >= 0.f) ? -log1pf(expf(-s)) : (s - log1pf(expf(s)));
            GLG[((size_t)dir * MR + row) * 256 + d] = (bf16_t)f2bf(ls * (1.0f / 16.0f)); }
    }
}

__device__ __forceinline__ void ret_chain(const bf16_t* P, bf16_t* O, int b, int h, int dir, bool ctx_out, int wave, int lane) {
    const int e = wave * 16 + (lane & 15), dq = lane >> 4;
    const float gamma = 1.0f - exp2f(-5.0f - (float)h);
    constexpr int TB = 2;
    float S[32];
#pragma unroll
    for (int i = 0; i < 32; ++i) S[i] = 0.f;
    for (int seg = 0; seg < 2; ++seg) {
        const int n = seg ? SEQL : LC, rowbase = seg ? b * SEQL : NLAT + b * LC; const bool wr_out = seg || ctx_out;
        for (int i0 = 0; i0 < n; i0 += TB) {
            u32x4 q[TB][4], k[TB][4]; bf16_t v[TB];
#pragma unroll
            for (int tb = 0; tb < TB; ++tb) { const int row = rowbase + (dir ? n - 1 - (i0 + tb) : i0 + tb); const bf16_t* pr = P + (size_t)row * LDP;
#pragma unroll
                for (int c4 = 0; c4 < 4; ++c4) { q[tb][c4] = ((const u32x4*)(pr + PC_RQ + h * 128 + dq * 32))[c4]; k[tb][c4] = ((const u32x4*)(pr + PC_RK + h * 128 + dq * 32))[c4]; }
                v[tb] = pr[PC_RV + h * 128 + e]; }
#pragma unroll
            for (int tb = 0; tb < TB; ++tb) {
                const int row = rowbase + (dir ? n - 1 - (i0 + tb) : i0 + tb);
                const float vf = bf2f(v[tb]); float o = 0.f;
#pragma unroll
                for (int c4 = 0; c4 < 4; ++c4) { float qf[8], kf[8]; unpack8(q[tb][c4], qf); unpack8(k[tb][c4], kf);
#pragma unroll
                    for (int x = 0; x < 8; ++x) { const int ix = c4 * 8 + x; S[ix] = gamma * S[ix] + kf[x] * vf; o += qf[x] * S[ix]; } }
                o += __shfl_xor(o, 16); o += __shfl_xor(o, 32);
                if (wr_out && dq == 0) O[(size_t)row * 512 + h * 128 + e] = (bf16_t)f2bf(o);
            }
        }
    }
}
__device__ __forceinline__ void gla_chain(const bf16_t* P, const bf16_t* GLGd, bf16_t* O, int b, int h, int dir, bool ctx_out, int wave, int lane) {
    const int e = wave * 16 + (lane & 15), dq = lane >> 4;
    constexpr int TB = 4;
    float S[16];
#pragma unroll
    for (int i = 0; i < 16; ++i) S[i] = 0.f;
    for (int seg = 0; seg < 2; ++seg) {
        const int n = seg ? SEQL : LC, rowbase = seg ? b * SEQL : NLAT + b * LC; const bool wr_out = seg || ctx_out;
        for (int i0 = 0; i0 < n; i0 += TB) {
            u32x4 q[TB][2], k[TB][2], g[TB][2]; bf16_t v[TB];
#pragma unroll
            for (int tb = 0; tb < TB; ++tb) { const int row = rowbase + (dir ? n - 1 - (i0 + tb) : i0 + tb); const bf16_t* pr = P + (size_t)row * LDP; const bf16_t* gr = GLGd + (size_t)row * 256 + h * 64 + dq * 16;
#pragma unroll
                for (int c4 = 0; c4 < 2; ++c4) { q[tb][c4] = ((const u32x4*)(pr + PC_GQ + h * 64 + dq * 16))[c4]; k[tb][c4] = ((const u32x4*)(pr + PC_GK + h * 64 + dq * 16))[c4]; g[tb][c4] = ((const u32x4*)gr)[c4]; }
                v[tb] = pr[PC_GV + h * 128 + e]; }
#pragma unroll
            for (int tb = 0; tb < TB; ++tb) {
                const int row = rowbase + (dir ? n - 1 - (i0 + tb) : i0 + tb);
                const float vf = bf2f(v[tb]); float o = 0.f;
#pragma unroll
                for (int c4 = 0; c4 < 2; ++c4) { float qf[8], kf[8], gf[8]; unpack8(q[tb][c4], qf); unpack8(k[tb][c4], kf); unpack8(g[tb][c4], gf);
#pragma unroll
                    for (int x = 0; x < 8; ++x) { const int ix = c4 * 8 + x; S[ix] = __expf(gf[x]) * S[ix] + kf[x] * vf; o += qf[x] * S[ix]; } }
                o += __shfl_xor(o, 16); o += __shfl_xor(o, 32);
                if (wr_out && dq == 0) O[(size_t)row * 512 + h * 128 + e] = (bf16_t)f2bf(o * 0.125f);
            }
        }
    }
}
__device__ __forceinline__ void s5_chain(const DArgs& a, unsigned char* ws, LAS unsigned char* lds, int l, int b, int g, int dir, bool ctx_out, int tid) {
    LAS f32x2* cs = (LAS f32x2*)lds; LAS f32x2* hs = (LAS f32x2*)(lds + 16 * 65 * 8); LAS float* us = (LAS float*)(lds + 2 * 16 * 65 * 8);
    const int wave = tid >> 6, lane = tid & 63;
    const int gi = (l * 2 + dir) * 32 + g;
    const float* cre = a.in[I_S5CRE] + (size_t)gi * 1024; const float* cim = a.in[I_S5CIM] + (size_t)gi * 1024;
    for (int idx = tid; idx < 1024; idx += NT) { const int i = idx >> 6, p = idx & 63; cs[i * 65 + p] = (f32x2){cre[idx], cim[idx]}; }
    f32x2 ab = {0.f, 0.f}; f32x2 bt[16]; f32x2 hst = {0.f, 0.f};
    if (wave == 0) { ab = ((const f32x2*)(ws + WS_S5AB))[gi * 64 + lane]; const f32x2* bp = (const f32x2*)(ws + WS_S5BT) + (size_t)(gi * 64 + lane) * 16;
#pragma unroll
        for (int i = 0; i < 16; ++i) bt[i] = bp[i]; }
    else {
#pragma unroll
        for (int i = 0; i < 16; ++i) bt[i] = (f32x2){0.f, 0.f}; }
    const bf16_t* P = (const bf16_t*)(ws + WS_P);
    bf16_t* Y = (bf16_t*)(ws + WS_OB) + (size_t)(4 + dir) * OBSZ;
    const int tt = tid >> 4, i = tid & 15;
    for (int seg = 0; seg < 2; ++seg) {
        const int n = seg ? SEQL : LC, rowbase = seg ? b * SEQL : NLAT + b * LC; const bool wr_out = seg || ctx_out;
        __syncthreads();
        if (tid < 256) us[tid] = bf2f(P[(size_t)(rowbase + (dir ? n - 1 - tt : tt)) * LDP + PC_S5U + g * 16 + i]);
        for (int bt0 = 0; bt0 < n; bt0 += 16) {
            const int ii = bt0 + tt; const int row = rowbase + (dir ? n - 1 - ii : ii);
            bf16_t unext = 0;
            if (tid < 256 && bt0 + 16 < n) { const int iin = ii + 16; unext = P[(size_t)(rowbase + (dir ? n - 1 - iin : iin)) * LDP + PC_S5U + g * 16 + i]; }
            __syncthreads();
            if (wave == 0) {
#pragma unroll 4
                for (int t2 = 0; t2 < 16; ++t2) {
                    float bur = 0.f, bui = 0.f;
#pragma unroll
                    for (int q = 0; q < 4; ++q) { const f32x4 u = ((const LAS f32x4*)(us + t2 * 16))[q];
                        bur += bt[4 * q].x * u.x + bt[4 * q + 1].x * u.y + bt[4 * q + 2].x * u.z + bt[4 * q + 3].x * u.w;
                        bui += bt[4 * q].y * u.x + bt[4 * q + 1].y * u.y + bt[4 * q + 2].y * u.z + bt[4 * q + 3].y * u.w; }
                    const float hr = ab.x * hst.x - ab.y * hst.y + bur, hi = ab.x * hst.y + ab.y * hst.x + bui;
                    hst = (f32x2){hr, hi};
                    hs[t2 * 65 + lane] = hst;
                }
            }
            __syncthreads();
            if (tid < 256) {
                us[tid] = bf2f(unext);
                float y = 0.f;
#pragma unroll 8
                for (int p = 0; p < 64; ++p) { const f32x2 cv = cs[i * 65 + p], hv = hs[tt * 65 + p]; y += cv.x * hv.x - cv.y * hv.y; }
                if (wr_out) Y[(size_t)row * 512 + g * 16 + i] = (bf16_t)f2bf(y);
            }
        }
    }
    __syncthreads();
}

__device__ __forceinline__ float sconv3(const bf16_t* p, int t, int Lx, float w0, float w1, float w2, float cb) {
    const float x0 = t > 0 ? bf2f(p[t - 1]) : 0.f, x1 = bf2f(p[t]), x2 = t < Lx - 1 ? bf2f(p[t + 1]) : 0.f;
    return w0 * x0 + w1 * x1 + w2 * x2 + cb;
}
__device__ __forceinline__ void hyena_item(const DArgs& a, unsigned char* ws, LAS unsigned char* lds, int l, int c, int tid) {
    LAS f32x2* X = (LAS f32x2*)lds; LAS f32x2* W = (LAS f32x2*)(lds + 65536);
    fft_twiddles(W, tid);
    const float* cw = a.in[I_HCW] + (size_t)l * 3 * 1536; const float* cbp = a.in[I_HCB] + (size_t)l * 1536;
    const float wv0 = cw[c], wv1 = cw[1536 + c], wv2 = cw[3072 + c], bv = cbp[c];
    const float wa0 = cw[512 + c], wa1 = cw[1536 + 512 + c], wa2 = cw[3072 + 512 + c], ba = cbp[512 + c];
    const float wb0 = cw[1024 + c], wb1 = cw[1536 + 1024 + c], wb2 = cw[3072 + 1024 + c], bb = cbp[1024 + c];
    const float bias0 = a.in[I_HBIAS][(l * 2 + 0) * 512 + c], bias1 = a.in[I_HBIAS][(l * 2 + 1) * 512 + c];
    const bf16_t* PT = (const bf16_t*)(ws + WS_PT);
    const bf16_t* pv = PT + (size_t)(PT_V + c) * MR; const bf16_t* pg1 = PT + (size_t)(PT_G1 + c) * MR; const bf16_t* pg2 = PT + (size_t)(PT_G2 + c) * MR; const bf16_t* phg = PT + (size_t)(PT_HG + c) * MR;
    const f32x2* KF0 = (const f32x2*)(ws + WS_KF) + (size_t)(0 * 512 + c) * FFTN; const f32x2* KF1 = (const f32x2*)(ws + WS_KF) + (size_t)(1 * 512 + c) * FFTN;
    bf16_t* GATED = (bf16_t*)(ws + WS_H);
    __syncthreads();
    for (int bp = 0; bp < 2; ++bp) {
        const int r0 = (2 * bp) * SEQL, r1 = (2 * bp + 1) * SEQL;
        float zr[8], zi[8];
#pragma unroll
        for (int j = 0; j < 8; ++j) { const int t = tid + 512 * j; zr[j] = sconv3(pv + r0, t, SEQL, wv0, wv1, wv2, bv); zi[j] = sconv3(pv + r1, t, SEQL, wv0, wv1, wv2, bv);
            X[t] = (f32x2){zr[j], zi[j]}; X[4096 + t] = (f32x2){0.f, 0.f}; if (j & 1) asm volatile("" ::: "memory"); }
        __syncthreads(); fft_forward(X, W, tid);
#pragma unroll 4
        for (int j = 0; j < 16; ++j) { const int pos = tid + 512 * j; const f32x2 x = X[pos], k = KF0[pos]; X[pos] = (f32x2){x.x * k.x - x.y * k.y, x.x * k.y + x.y * k.x}; }
        __syncthreads(); fft_inverse(X, W, tid);
#pragma unroll
        for (int j = 0; j < 8; ++j) { const int t = tid + 512 * j; const f32x2 cv = X[t] * (1.0f / 8192.0f);
            const float g1r = sconv3(pg1 + r0, t, SEQL, wa0, wa1, wa2, ba), g1i = sconv3(pg1 + r1, t, SEQL, wa0, wa1, wa2, ba);
            zr[j] = g1r * (cv.x + bias0 * zr[j]); zi[j] = g1i * (cv.y + bias0 * zi[j]); if (j & 1) asm volatile("" ::: "memory"); }
        __syncthreads();
#pragma unroll
        for (int j = 0; j < 8; ++j) { const int t = tid + 512 * j; X[t] = (f32x2){zr[j], zi[j]}; X[4096 + t] = (f32x2){0.f, 0.f}; }
        __syncthreads(); fft_forward(X, W, tid);
#pragma unroll 4
        for (int j = 0; j < 16; ++j) { const int pos = tid + 512 * j; const f32x2 x = X[pos], k = KF1[pos]; X[pos] = (f32x2){x.x * k.x - x.y * k.y, x.x * k.y + x.y * k.x}; }
        __syncthreads(); fft_inverse(X, W, tid);
#pragma unroll
        for (int j = 0; j < 8; ++j) { const int t = tid + 512 * j; const f32x2 cv = X[t] * (1.0f / 8192.0f);
            const float g2r = sconv3(pg2 + r0, t, SEQL, wb0, wb1, wb2, bb), g2i = sconv3(pg2 + r1, t, SEQL, wb0, wb1, wb2, bb);
            const float z2r = g2r * (cv.x + bias1 * zr[j]), z2i = g2i * (cv.y + bias1 * zi[j]);
            const float hg0 = bf2f(phg[r0 + t]), hg1 = bf2f(phg[r1 + t]);
            GATED[(size_t)(r0 + t) * D + 512 + c] = (bf16_t)f2bf(z2r * siluf_(hg0)); GATED[(size_t)(r1 + t) * D + 512 + c] = (bf16_t)f2bf(z2i * siluf_(hg1)); if (j & 1) asm volatile("" ::: "memory"); }
        __syncthreads();
    }
}
__device__ __forceinline__ void hyena_ctx_item(const DArgs& a, unsigned char* ws, LAS unsigned char* lds, int c, int tid) {
    LAS float* kc = (LAS float*)lds; LAS float* za = (LAS float*)(lds + 4096); LAS float* zb = (LAS float*)(lds + 8192);
    const float* KC = (const float*)(ws + WS_KC);
    kc[tid] = KC[(size_t)(0 * 512 + c) * 512 + tid]; kc[512 + tid] = KC[(size_t)(1 * 512 + c) * 512 + tid];
    const float* cw = a.in[I_HCW]; const float* cbp = a.in[I_HCB];
    const float wv0 = cw[c], wv1 = cw[1536 + c], wv2 = cw[3072 + c], bv = cbp[c];
    const float wa0 = cw[512 + c], wa1 = cw[1536 + 512 + c], wa2 = cw[3072 + 512 + c], ba = cbp[512 + c];
    const float wb0 = cw[1024 + c], wb1 = cw[1536 + 1024 + c], wb2 = cw[3072 + 1024 + c], bb = cbp[1024 + c];
    const float bias0 = a.in[I_HBIAS][0 * 512 + c], bias1 = a.in[I_HBIAS][1 * 512 + c];
    const bf16_t* PT = (const bf16_t*)(ws + WS_PT);
    const int b = tid >> 7, tt = tid & 127; const int rb = NLAT + b * LC;
    const bf16_t* pv = PT + (size_t)(PT_V + c) * MR + rb; const bf16_t* pg1 = PT + (size_t)(PT_G1 + c) * MR + rb; const bf16_t* pg2 = PT + (size_t)(PT_G2 + c) * MR + rb; const bf16_t* phg = PT + (size_t)(PT_HG + c) * MR + rb;
    bf16_t* GATED = (bf16_t*)(ws + WS_H);
    float z0[2], z1[2];
#pragma unroll
    for (int q = 0; q < 2; ++q) { const int t = tt + 128 * q; z0[q] = sconv3(pv, t, LC, wv0, wv1, wv2, bv); za[b * 256 + t] = z0[q]; }
    __syncthreads();
#pragma unroll
    for (int q = 0; q < 2; ++q) { const int t = tt + 128 * q; float s = 0.f;
        for (int sidx = 0; sidx < 256; ++sidx) s += kc[(t - sidx) & 511] * za[b * 256 + sidx];
        z1[q] = sconv3(pg1, t, LC, wa0, wa1, wa2, ba) * (s + bias0 * z0[q]); zb[b * 256 + t] = z1[q]; }
    __syncthreads();
#pragma unroll
    for (int q = 0; q < 2; ++q) { const int t = tt + 128 * q; float s = 0.f;
        for (int sidx = 0; sidx < 256; ++sidx) s += kc[512 + ((t - sidx) & 511)] * zb[b * 256 + sidx];
        const float z2 = sconv3(pg2, t, LC, wb0, wb1, wb2, bb) * (s + bias1 * z1[q]);
        GATED[(size_t)(rb + t) * D + 512 + c] = (bf16_t)f2bf(z2 * siluf_(bf2f(phg[t]))); }
    __syncthreads();
}

__device__ __forceinline__ void merge_row(const DArgs& a, unsigned char* ws, int l, int row, int lane) {
    const int col = 8 * lane;
    const bf16_t* OB = (const bf16_t*)(ws + WS_OB); const bf16_t* P = (const bf16_t*)(ws + WS_P) + (size_t)row * LDP;
    bf16_t* GATED = (bf16_t*)(ws + WS_H) + (size_t)row * D; bf16_t* G5 = (bf16_t*)(ws + WS_KF) + (size_t)row * 512;
    { float yf[8], yb[8], u[8], res[8];
      unpack8(*(const u32x4*)(OB + (size_t)4 * OBSZ + (size_t)row * 512 + col), yf); unpack8(*(const u32x4*)(OB + (size_t)5 * OBSZ + (size_t)row * 512 + col), yb);
      unpack8(*(const u32x4*)(P + PC_S5U + col), u);
      const float* dsk = a.in[I_S5D] + l * 512 + col;
#pragma unroll
      for (int x = 0; x < 8; ++x) res[x] = gelu_tanh(yf[x] + yb[x] + u[x] * dsk[x]);
      *(u32x4*)(G5 + col) = pack8(res); }
}

struct EpiInProj {
    static constexpr bool PERM = true, AFTER_DRAIN = false;
    bf16_t* P; bf16_t* PT; float* LR;
    __device__ __forceinline__ void operator()(const pg8::f32x4 (&acc)[2][2][4][2], const pg8::Unit& u, int wr, int wc, int fr, int fq) const {
        const int row0 = u.pm * 256 + wr * 64 + fr, pn = u.pn;
        if (pn < 4 || (pn >= 12 && pn < 26)) {
            const int colbase = (pn < 4 ? pn * 256 : pn * 256 - 2048) + wc * 32 + 8 * fq;
#pragma unroll
            for (int ai = 0; ai < 2; ++ai)
#pragma unroll
                for (int m = 0; m < 4; ++m) { bf16_t* rowp = P + (size_t)(row0 + ai * 128 + m * 16) * LDP + colbase;
#pragma unroll
                    for (int bj = 0; bj < 2; ++bj) { const pg8::f32x4 v0 = acc[ai][bj][m][0], v1 = acc[ai][bj][m][1];
                        u32x4 w; w.x = pk2(v0[0], v0[1]); w.y = pk2(v0[2], v0[3]); w.z = pk2(v1[0], v1[1]); w.w = pk2(v1[2], v1[3]);
                        *(u32x4*)(rowp + bj * 128) = w; } }
        } else if (pn < 12) {
            const int colbase = (pn - 4) * 256 + wc * 32 + 8 * fq;
#pragma unroll
            for (int bj = 0; bj < 2; ++bj)
#pragma unroll
                for (int n = 0; n < 2; ++n)
#pragma unroll
                    for (int j = 0; j < 4; ++j) { bf16_t* cp = PT + (size_t)(colbase + bj * 128 + 4 * n + j) * MR + row0;
#pragma unroll
                        for (int ai = 0; ai < 2; ++ai)
#pragma unroll
                            for (int m = 0; m < 4; ++m) cp[ai * 128 + m * 16] = (bf16_t)f2bf(acc[ai][bj][m][n][j]);
                        asm volatile("" ::: "memory"); }
        } else {
            if (wc == 0) {
#pragma unroll
                for (int ai = 0; ai < 2; ++ai)
#pragma unroll
                    for (int m = 0; m < 4; ++m) { float* rowp = LR + (size_t)(row0 + ai * 128 + m * 16) * 32 + 8 * fq;
                        *(pg8::f32x4*)(rowp) = acc[ai][0][m][0]; *(pg8::f32x4*)(rowp + 4) = acc[ai][0][m][1]; }
            }
        }
    }
};
struct EpiGlu {
    static constexpr bool PERM = true, AFTER_DRAIN = false;
    const bf16_t* G5; const bf16_t* P; bf16_t* GATED; const float* bias;
    __device__ __forceinline__ void operator()(const pg8::f32x4 (&acc)[2][2][4][2], const pg8::Unit& u, int wr, int wc, int fr, int fq) const {
        const int row0 = u.pm * 256 + wr * 64 + fr, col0 = u.pn * 256 + wc * 32 + 8 * fq;
#pragma unroll
        for (int ai = 0; ai < 2; ++ai)
#pragma unroll
            for (int m = 0; m < 4; ++m) { const size_t row = (size_t)(row0 + ai * 128 + m * 16);
#pragma unroll
                for (int bj = 0; bj < 2; ++bj) { const int col = col0 + bj * 128;
                    float g[8], sg[8], res[8]; unpack8(*(const u32x4*)(G5 + row * 512 + col), g); unpack8(*(const u32x4*)(P + row * LDP + PC_S5G + col), sg);
                    const pg8::f32x4 b0 = *(const pg8::f32x4*)(bias + col), b1 = *(const pg8::f32x4*)(bias + col + 4);
#pragma unroll
                    for (int j = 0; j < 4; ++j) { res[j] = g[j] * sigmoidf_(acc[ai][bj][m][0][j] + b0[j]) * siluf_(sg[j]); res[4 + j] = g[4 + j] * sigmoidf_(acc[ai][bj][m][1][j] + b1[j]) * siluf_(sg[4 + j]); }
                    *(u32x4*)(GATED + row * D + col) = pack8(res); } }
    }
};
struct EpiOut {
    static constexpr bool PERM = false, AFTER_DRAIN = false;
    const float* xl_old; const float* xc_old; float* xl_new; float* xc_new; const float* mod;
    __device__ __forceinline__ void operator()(const pg8::f32x4 (&acc)[2][2][4][2], const pg8::Unit& u, int wr, int wc, int fr, int fq) const {
        const int row0 = u.pm * 256 + wr * 64 + fr, col0 = u.pn * 256 + wc * 32 + 4 * fq;
        const bool lat = u.pm < 64;
        const float* xo = lat ? xl_old : xc_old - (size_t)NLAT * D; float* xn = lat ? xl_new : xc_new - (size_t)NLAT * D;
#pragma unroll
        for (int ai = 0; ai < 2; ++ai) {
            const int v = lat ? ((u.pm * 256 + ai * 128) >> 12) : 4;
            const float* gt = mod + (size_t)v * ADA + 2 * D;
#pragma unroll
            for (int m = 0; m < 4; ++m) { const size_t off = (size_t)(row0 + ai * 128 + m * 16) * D + col0;
#pragma unroll
                for (int bj = 0; bj < 2; ++bj)
#pragma unroll
                    for (int n = 0; n < 2; ++n) { const int cc = bj * 128 + n * 16; const pg8::f32x4 gv = *(const pg8::f32x4*)(gt + col0 + cc), xv = *(const pg8::f32x4*)(xo + off + cc);
                        *(pg8::f32x4*)(xn + off + cc) = xv + gv * acc[ai][bj][m][n]; } }
        }
    }
};
typedef short bf16x8 __attribute__((ext_vector_type(8)));
typedef short bf16x4 __attribute__((ext_vector_type(4)));
__device__ __forceinline__ unsigned off_b(unsigned row, unsigned ch) { return 256u * row + 16u * (ch ^ (((row & 3) << 2) | ((row >> 2) & 3))); }
__device__ __forceinline__ bf16x8 img_row_frag(const LAS unsigned char* img, unsigned lane, unsigned rb, unsigned s) { return *(const LAS bf16x8*)(img + off_b((lane & 15) + 16 * rb, 4 * s + (lane >> 4))); }
__device__ __forceinline__ bf16x4 img_tr4(const LAS unsigned char* img, unsigned lane, unsigned c, unsigned row0) {
    const unsigned q = (lane & 15) >> 2, p = lane & 3;
    return __builtin_amdgcn_ds_read_tr16_b64_v4i16((LAS bf16x4*)(img + off_b(row0 + q, 2 * c + (p >> 1)) + 8 * (p & 1)));
}
__device__ __forceinline__ bf16x8 img_tr_frag(const LAS unsigned char* img, unsigned lane, unsigned c, unsigned ks) {
    const unsigned g = lane >> 4; const bf16x4 lo = img_tr4(img, lane, c, 32 * ks + 8 * g), hi = img_tr4(img, lane, c, 32 * ks + 8 * g + 4);
    return __builtin_shufflevector(lo, hi, 0, 1, 2, 3, 4, 5, 6, 7);
}
__device__ __forceinline__ bf16x8 img_tr_frag_acc(const LAS unsigned char* img, unsigned lane, unsigned c, unsigned ks) {
    const unsigned g = lane >> 4; const bf16x4 lo = img_tr4(img, lane, c, 32 * ks + 4 * g), hi = img_tr4(img, lane, c, 32 * ks + 16 + 4 * g);
    return __builtin_shufflevector(lo, hi, 0, 1, 2, 3, 4, 5, 6, 7);
}
__device__ __forceinline__ bf16x8 acc_pair_frag(const f32x4 a0, const f32x4 a1) {
    u32x4 w; w.x = pk2(a0.x, a0.y); w.y = pk2(a0.z, a0.w); w.z = pk2(a1.x, a1.y); w.w = pk2(a1.z, a1.w);
    return __builtin_bit_cast(bf16x8, w);
}
#define MFMA16(A_, B_, C_) __builtin_amdgcn_mfma_f32_16x16x32_bf16((A_), (B_), (C_), 0, 0, 0)
__device__ __forceinline__ void stage_tile128(LAS unsigned char* img, const bf16_t* g, size_t ld, int tid) {
#pragma unroll
    for (int i = 0; i < 4; ++i) { const int n = tid + NT * i, row = n >> 4, ch = n & 15; *(LAS u32x4*)(img + off_b(row, ch)) = *(const u32x4*)(g + (size_t)row * ld + ch * 8); }
}

constexpr int RCH = 128, RNCH = 34;
constexpr size_t WS_RST = WS_OB;
__device__ __forceinline__ int ret_rowbase(int b, int cc) { return cc < 2 ? NLAT + b * LC + cc * RCH : b * SEQL + (cc - 2) * RCH; }
__device__ __forceinline__ float ret_log2g(int h) { return log2f(1.0f - exp2f(-5.0f - (float)h)); }

__device__ __forceinline__ void ret_passA(unsigned char* ws, LAS unsigned char* lds, int item, int tid) {
    const int bh = item / RNCH, cc = item % RNCH, b = bh >> 2, h = bh & 3;
    const int lane = tid & 63, w = tid >> 6, g = lane >> 4;
    LAS unsigned char* KF = lds; LAS unsigned char* KB = lds + 32768; LAS unsigned char* VI = lds + 65536;
    const bf16_t* P = (const bf16_t*)(ws + WS_P) + (size_t)ret_rowbase(b, cc) * LDP;
    const float l2g = ret_log2g(h);
    __syncthreads();
#pragma unroll
    for (int i = 0; i < 4; ++i) { const int n = tid + NT * i, row = n >> 4, ch = n & 15;
        const u32x4 kr = *(const u32x4*)(P + (size_t)row * LDP + PC_RK + h * 128 + ch * 8);
        float kf[8], a[8], c[8]; unpack8(kr, kf);
        const float sf = exp2f(l2g * (float)(RCH - 1 - row)), sb = exp2f(l2g * (float)row);
#pragma unroll
        for (int x = 0; x < 8; ++x) { a[x] = kf[x] * sf; c[x] = kf[x] * sb; }
        *(LAS u32x4*)(KF + off_b(row, ch)) = pack8(a); *(LAS u32x4*)(KB + off_b(row, ch)) = pack8(c);
        *(LAS u32x4*)(VI + off_b(row, ch)) = *(const u32x4*)(P + (size_t)row * LDP + PC_RV + h * 128 + ch * 8); }
    __syncthreads();
    bf16x8 af[4], ab[4];
#pragma unroll
    for (int ks = 0; ks < 4; ++ks) { af[ks] = img_tr_frag(KF, lane, w, ks); ab[ks] = img_tr_frag(KB, lane, w, ks); }
    bf16_t* ST = (bf16_t*)(ws + WS_RST) + ((size_t)(bh * 2) * RNCH + cc) * (128 * 128);
#pragma unroll 2
    for (int E = 0; E < 8; ++E) {
        f32x4 cf = {0.f, 0.f, 0.f, 0.f}, cb = {0.f, 0.f, 0.f, 0.f};
#pragma unroll
        for (int ks = 0; ks < 4; ++ks) { const bf16x8 vb = img_tr_frag(VI, lane, E, ks); cf = MFMA16(af[ks], vb, cf); cb = MFMA16(ab[ks], vb, cb); }
        const int e = 16 * E + (lane & 15), d0 = 16 * w + 4 * g;
        u32x2 o; o.x = pk2(cf.x, cf.y); o.y = pk2(cf.z, cf.w); *(u32x2*)(ST + (size_t)e * 128 + d0) = o;
        o.x = pk2(cb.x, cb.y); o.y = pk2(cb.z, cb.w); *(u32x2*)(ST + (size_t)RNCH * 128 * 128 + (size_t)e * 128 + d0) = o;
    }
}
__device__ __forceinline__ void ret_passB(unsigned char* ws, int gt  ) {
    if (gt >= 16 * 2 * 2048) return;
    const int el = gt & 2047, bd = gt >> 11, bh = bd >> 1, dir = bd & 1, h = bh & 3;
    const float gC = exp2f(ret_log2g(h) * (float)RCH);
    bf16_t* base = (bf16_t*)(ws + WS_RST) + (size_t)bd * RNCH * (128 * 128) + (size_t)el * 8;
    float acc[8];
#pragma unroll
    for (int x = 0; x < 8; ++x) acc[x] = 0.f;
#pragma unroll 2
    for (int s = 0; s < RNCH; ++s) {
        const int cc = dir == 0 ? s : (s < 2 ? 1 - s : 35 - s);
        u32x4* p = (u32x4*)(base + (size_t)cc * (128 * 128));
        float kv[8]; unpack8(*p, kv);
        *p = pack8(acc);
#pragma unroll
        for (int x = 0; x < 8; ++x) acc[x] = gC * acc[x] + kv[x];
    }
}
__device__ __forceinline__ void ret_passC(const DArgs& a, unsigned char* ws, LAS unsigned char* lds, int l, int item, int tid) {
    const int bh = item / RNCH, cc = item % RNCH, b = bh >> 2, h = bh & 3;
    const int lane = tid & 63, w = tid >> 6, g = lane >> 4, il = lane & 15;
    LAS unsigned char* KI = lds; LAS unsigned char* VI = lds + 32768; LAS unsigned char* SF = lds + 65536; LAS unsigned char* SB = lds + 98304;
    const int rowbase = ret_rowbase(b, cc);
    const bf16_t* P = (const bf16_t*)(ws + WS_P) + (size_t)rowbase * LDP;
    const bf16_t* STf = (const bf16_t*)(ws + WS_RST) + ((size_t)(bh * 2) * RNCH + cc) * (128 * 128);
    const bf16_t* STb = STf + (size_t)RNCH * 128 * 128;
    __syncthreads();
    stage_tile128(KI, P + PC_RK + h * 128, LDP, tid); stage_tile128(VI, P + PC_RV + h * 128, LDP, tid);
    stage_tile128(SF, STf, 128, tid); stage_tile128(SB, STb, 128, tid);
    bf16x8 qf[4];
    { const bf16_t* qr = P + (size_t)(16 * w + il) * LDP + PC_RQ + h * 128 + 8 * g;
#pragma unroll
      for (int ks = 0; ks < 4; ++ks) qf[ks] = *(const bf16x8*)(qr + 32 * ks); }
    __syncthreads();
    const float l2g = ret_log2g(h);
    const int iloc = 16 * w + il;
    f32x4 o[8];
    { const float sf = exp2f(l2g * (float)(iloc + 1)), sb = exp2f(l2g * (float)(RCH - iloc));
#pragma unroll
      for (int E = 0; E < 8; ++E) { f32x4 rf = {0.f, 0.f, 0.f, 0.f}, rb = {0.f, 0.f, 0.f, 0.f};
#pragma unroll
          for (int ks = 0; ks < 4; ++ks) { rf = MFMA16(img_row_frag(SF, lane, E, ks), qf[ks], rf); rb = MFMA16(img_row_frag(SB, lane, E, ks), qf[ks], rb); }
          o[E] = rf * sf + rb * sb; } }
    f32x4 at[8];
#pragma unroll
    for (int T = 0; T < 8; ++T) { f32x4 c = {0.f, 0.f, 0.f, 0.f};
#pragma unroll
        for (int ks = 0; ks < 4; ++ks) c = MFMA16(img_row_frag(KI, lane, T, ks), qf[ks], c);
#pragma unroll
        for (int r = 0; r < 4; ++r) { const int j = 16 * T + 4 * g + r; const int dd = iloc > j ? iloc - j : j - iloc; c[r] *= (dd == 0 ? 2.0f : exp2f(l2g * (float)dd)); }
        at[T] = c; }
#pragma unroll
    for (int s = 0; s < 4; ++s) { const bf16x8 bfr = acc_pair_frag(at[2 * s], at[2 * s + 1]);
#pragma unroll
        for (int E = 0; E < 8; ++E) o[E] = MFMA16(img_tr_frag_acc(VI, lane, E, s), bfr, o[E]); }
    float ss = 0.f;
#pragma unroll
    for (int E = 0; E < 8; ++E) ss += (o[E].x * o[E].x + o[E].y * o[E].y) + (o[E].z * o[E].z + o[E].w * o[E].w);
    ss += __shfl_xor(ss, 16); ss += __shfl_xor(ss, 32);
    const float rn = rsqrtf(ss * (1.0f / 128.0f) + EPS);
    const size_t row = (size_t)rowbase + iloc;
    const bf16_t* gp = (const bf16_t*)(ws + WS_P) + row * LDP + PC_RG + h * 128 + 4 * g;
    const float* nw = a.in[I_RNW] + l * 512 + h * 128 + 4 * g;
    bf16_t* op = (bf16_t*)(ws + WS_H) + row * D + 1024 + h * 128 + 4 * g;
#pragma unroll
    for (int E = 0; E < 8; ++E) { const u32x2 gr = *(const u32x2*)(gp + 16 * E); const f32x4 nv = *(const f32x4*)(nw + 16 * E);
        u32x2 ov; ov.x = pk2(o[E].x * rn * nv.x * siluf_(bflo(gr.x)), o[E].y * rn * nv.y * siluf_(bfhi(gr.x)));
        ov.y = pk2(o[E].z * rn * nv.z * siluf_(bflo(gr.y)), o[E].w * rn * nv.w * siluf_(bfhi(gr.y)));
        *(u32x2*)(op + 16 * E) = ov; }
}
constexpr int GCH = 64, GNCH = 68;
constexpr size_t WS_GST = WS_OB + (size_t)2 * OBSZ * 2;
constexpr size_t WS_GDEC = WS_END;
constexpr size_t WS_END2 = WS_GDEC + (size_t)16 * 2 * GNCH * 64 * 4;
__device__ __forceinline__ int gla_rowbase(int b, int cg) { return cg < 4 ? NLAT + b * LC + cg * GCH : b * SEQL + (cg - 4) * GCH; }

__device__ __forceinline__ void gla_gates(const DArgs& a, unsigned char* ws, LAS float* BF, LAS float* BB, int l, int h, int rowbase, int tid) {
    const int t = tid >> 3, d8 = tid & 7;
    const float* lr = (const float*)(ws + WS_LR) + (size_t)(rowbase + t) * 32;
    f32x4 lv[8];
#pragma unroll
    for (int q = 0; q < 8; ++q) lv[q] = ((const f32x4*)lr)[q];
#pragma unroll
    for (int dir = 0; dir < 2; ++dir) {
        const float* gw = a.in[I_GGW] + (size_t)(l * 2 + dir) * 16 * 256 + h * 64 + 8 * d8; const float* gb = a.in[I_GGB] + (size_t)(l * 2 + dir) * 256 + h * 64 + 8 * d8;
        f32x4 s0 = *(const f32x4*)gb, s1 = *(const f32x4*)(gb + 4);
#pragma unroll
        for (int j = 0; j < 16; ++j) { const float lj = lv[dir * 4 + (j >> 2)][j & 3]; s0 += lj * *(const f32x4*)(gw + j * 256); s1 += lj * *(const f32x4*)(gw + j * 256 + 4); }
        LAS float* dst = (dir ? BB : BF) + t * 64 + 8 * d8;
#pragma unroll
        for (int x = 0; x < 8; ++x) { const float s = x < 4 ? s0[x] : s1[x - 4]; const float ls = (s >= 0.f) ? -log1pf(__expf(-s)) : (s - log1pf(__expf(s))); dst[x] = ls * (1.0f / 16.0f); }
    }
    __syncthreads();
    if (tid < 128) { const int dir = tid >> 6, d = tid & 63; float run = 0.f;
        if (dir == 0) { for (int tt = 0; tt < 64; ++tt) { run += BF[tt * 64 + d]; BF[tt * 64 + d] = run; } }
        else { for (int tt = 63; tt >= 0; --tt) { run += BB[tt * 64 + d]; BB[tt * 64 + d] = run; } } }
    __syncthreads();
}

__device__ __forceinline__ void gla_passA(const DArgs& a, unsigned char* ws, LAS unsigned char* lds, int l, int item, int tid) {
    const int bh = item / GNCH, cg = item % GNCH, b = bh >> 2, h = bh & 3;
    const int lane = tid & 63, w = tid >> 6, g = lane >> 4;
    LAS float* BF = (LAS float*)lds; LAS float* BB = (LAS float*)(lds + 16384); LAS unsigned char* KH = lds + 32768; LAS unsigned char* VI = lds + 49152;
    const int rowbase = gla_rowbase(b, cg);
    gla_gates(a, ws, BF, BB, l, h, rowbase, tid);
    const bf16_t* P = (const bf16_t*)(ws + WS_P) + (size_t)rowbase * LDP;
    { const int t = tid >> 3, d8 = tid & 7;
      float kf[8], x0[8], x1[8]; unpack8(*(const u32x4*)(P + (size_t)t * LDP + PC_GK + h * 64 + 8 * d8), kf);
#pragma unroll
      for (int x = 0; x < 8; ++x) { const int d = 8 * d8 + x; x0[x] = kf[x] * __expf(BF[63 * 64 + d] - BF[t * 64 + d]); x1[x] = kf[x] * __expf(BB[d] - BB[t * 64 + d]); }
      *(LAS u32x4*)(KH + off_b(t, d8)) = pack8(x0); *(LAS u32x4*)(KH + off_b(t, 8 + d8)) = pack8(x1);
#pragma unroll
      for (int i = 0; i < 2; ++i) { const int n = tid + NT * i, row = n >> 4, ch = n & 15; *(LAS u32x4*)(VI + off_b(row, ch)) = *(const u32x4*)(P + (size_t)row * LDP + PC_GV + h * 128 + ch * 8); }
      if (tid < 128) { const int dir = tid >> 6, d = tid & 63; ((float*)(ws + WS_GDEC))[((size_t)(bh * 2 + dir) * GNCH + cg) * 64 + d] = __expf(dir ? BB[d] : BF[63 * 64 + d]); } }
    __syncthreads();
    const int dir = w >> 2, Dt = w & 3;
    bf16x8 af[2];
#pragma unroll
    for (int ks = 0; ks < 2; ++ks) af[ks] = img_tr_frag(KH, lane, dir * 4 + Dt, ks);
    bf16_t* ST = (bf16_t*)(ws + WS_GST) + ((size_t)(bh * 2 + dir) * GNCH + cg) * (128 * 64);
#pragma unroll 2
    for (int E = 0; E < 8; ++E) {
        f32x4 c = {0.f, 0.f, 0.f, 0.f};
#pragma unroll
        for (int ks = 0; ks < 2; ++ks) c = MFMA16(af[ks], img_tr_frag(VI, lane, E, ks), c);
        u32x2 o; o.x = pk2(c.x, c.y); o.y = pk2(c.z, c.w);
        *(u32x2*)(ST + (size_t)(16 * E + (lane & 15)) * 64 + 16 * Dt + 4 * g) = o;
    }
}
__device__ __forceinline__ void gla_passB(unsigned char* ws, int gt) {
    if (gt >= 16 * 2 * 1024) return;
    const int el = gt & 1023, bd = gt >> 10, dir = bd & 1;
    bf16_t* base = (bf16_t*)(ws + WS_GST) + (size_t)bd * GNCH * (128 * 64) + (size_t)el * 8;
    const float* dec = (const float*)(ws + WS_GDEC) + (size_t)bd * GNCH * 64 + (el & 7) * 8;
    float acc[8];
#pragma unroll
    for (int x = 0; x < 8; ++x) acc[x] = 0.f;
#pragma unroll 2
    for (int s = 0; s < GNCH; ++s) {
        const int cg = dir == 0 ? s : (s < 4 ? 3 - s : 71 - s);
        u32x4* p = (u32x4*)(base + (size_t)cg * (128 * 64));
        float kv[8]; unpack8(*p, kv);
        const f32x4 d0 = *(const f32x4*)(dec + cg * 64), d1 = *(const f32x4*)(dec + cg * 64 + 4);
        *p = pack8(acc);
#pragma unroll
        for (int x = 0; x < 8; ++x) acc[x] = (x < 4 ? d0[x] : d1[x - 4]) * acc[x] + kv[x];
    }
}
__device__ __forceinline__ void gla_passC(const DArgs& a, unsigned char* ws, LAS unsigned char* lds, int l, int item, int tid) {
    const int bh = item / GNCH, cg = item % GNCH, b = bh >> 2, h = bh & 3;
    const int lane = tid & 63, w = tid >> 6, g = lane >> 4, il = lane & 15;
    LAS float* BF = (LAS float*)lds; LAS float* BB = (LAS float*)(lds + 16384);
    LAS unsigned char* QKF = lds + 32768; LAS unsigned char* QKB = lds + 49152; LAS unsigned char* QH = lds + 65536; LAS unsigned char* VI = lds + 81920; LAS unsigned char* SI = lds + 98304;
    const int rowbase = gla_rowbase(b, cg);
    gla_gates(a, ws, BF, BB, l, h, rowbase, tid);
    const bf16_t* P = (const bf16_t*)(ws + WS_P) + (size_t)rowbase * LDP;
    { const int t = tid >> 3, d8 = tid & 7;
      float qf[8], kf[8], o0[8], o1[8], o2[8], o3[8], o4[8], o5[8];
      unpack8(*(const u32x4*)(P + (size_t)t * LDP + PC_GQ + h * 64 + 8 * d8), qf); unpack8(*(const u32x4*)(P + (size_t)t * LDP + PC_GK + h * 64 + 8 * d8), kf);
#pragma unroll
      for (int x = 0; x < 8; ++x) { const int d = 8 * d8 + x; const float bf = BF[t * 64 + d], bb = BB[t * 64 + d], rf = BF[31 * 64 + d], rb = BB[32 * 64 + d]; const float q = qf[x] * 0.125f;
          o0[x] = q * __expf(bf - rf); o1[x] = kf[x] * __expf(rf - bf); o2[x] = q * __expf(bb - rb); o3[x] = kf[x] * __expf(rb - bb); o4[x] = q * __expf(bf); o5[x] = q * __expf(bb); }
      *(LAS u32x4*)(QKF + off_b(t, d8)) = pack8(o0); *(LAS u32x4*)(QKF + off_b(t, 8 + d8)) = pack8(o1);
      *(LAS u32x4*)(QKB + off_b(t, d8)) = pack8(o2); *(LAS u32x4*)(QKB + off_b(t, 8 + d8)) = pack8(o3);
      *(LAS u32x4*)(QH + off_b(t, d8)) = pack8(o4); *(LAS u32x4*)(QH + off_b(t, 8 + d8)) = pack8(o5);
#pragma unroll
      for (int i = 0; i < 2; ++i) { const int n = tid + NT * i, row = n >> 4, ch = n & 15; *(LAS u32x4*)(VI + off_b(row, ch)) = *(const u32x4*)(P + (size_t)row * LDP + PC_GV + h * 128 + ch * 8); }
      const bf16_t* STf = (const bf16_t*)(ws + WS_GST) + ((size_t)(bh * 2) * GNCH + cg) * (128 * 64); const bf16_t* STb = STf + (size_t)GNCH * 128 * 64;
#pragma unroll
      for (int i = 0; i < 4; ++i) { const int n = tid + NT * i, row = n >> 4, ch = n & 15; *(LAS u32x4*)(SI + off_b(row, ch)) = *(const u32x4*)((ch < 8 ? STf : STb) + (size_t)row * 64 + (ch & 7) * 8); } }
    __syncthreads();
    const int ib = w & 3, eh = w >> 2, iloc = 16 * ib + il;
    f32x4 at[4];
    { bf16x8 qff[2], qfb[2];
#pragma unroll
      for (int ks = 0; ks < 2; ++ks) { qff[ks] = img_row_frag(QKF, lane, ib, ks); qfb[ks] = img_row_frag(QKB, lane, ib, ks); }
#pragma unroll
      for (int T = 0; T < 4; ++T) { f32x4 cf = {0.f, 0.f, 0.f, 0.f}, cb = {0.f, 0.f, 0.f, 0.f};
#pragma unroll
          for (int ks = 0; ks < 2; ++ks) { cf = MFMA16(img_row_frag(QKF, lane, T, 2 + ks), qff[ks], cf); cb = MFMA16(img_row_frag(QKB, lane, T, 2 + ks), qfb[ks], cb); }
#pragma unroll
          for (int r = 0; r < 4; ++r) { const int j = 16 * T + 4 * g + r; cf[r] = (j <= iloc ? cf[r] : 0.f) + (j >= iloc ? cb[r] : 0.f); }
          at[T] = cf; } }
    f32x4 o[4];
    { bf16x8 hf[2], hb[2];
#pragma unroll
      for (int ks = 0; ks < 2; ++ks) { hf[ks] = img_row_frag(QH, lane, ib, ks); hb[ks] = img_row_frag(QH, lane, ib, 2 + ks); }
#pragma unroll
      for (int E4 = 0; E4 < 4; ++E4) { const int E = 4 * eh + E4; f32x4 c = {0.f, 0.f, 0.f, 0.f};
#pragma unroll
          for (int ks = 0; ks < 2; ++ks) { c = MFMA16(img_row_frag(SI, lane, E, ks), hf[ks], c); c = MFMA16(img_row_frag(SI, lane, E, 2 + ks), hb[ks], c); }
          o[E4] = c; } }
#pragma unroll
    for (int s = 0; s < 2; ++s) { const bf16x8 bfr = acc_pair_frag(at[2 * s], at[2 * s + 1]);
#pragma unroll
        for (int E4 = 0; E4 < 4; ++E4) o[E4] = MFMA16(img_tr_frag_acc(VI, lane, 4 * eh + E4, s), bfr, o[E4]); }
    float ss = 0.f;
#pragma unroll
    for (int E4 = 0; E4 < 4; ++E4) ss += (o[E4].x * o[E4].x + o[E4].y * o[E4].y) + (o[E4].z * o[E4].z + o[E4].w * o[E4].w);
    ss += __shfl_xor(ss, 16); ss += __shfl_xor(ss, 32);
    LAS float* red = (LAS float*)lds;
    if (g == 0) red[eh * 64 + iloc] = ss;
    __syncthreads();
    const float rn = rsqrtf((red[iloc] + red[64 + iloc]) * (1.0f / 128.0f) + EPS);
    const size_t row = (size_t)rowbase + iloc;
    const bf16_t* gp = (const bf16_t*)(ws + WS_P) + row * LDP + PC_GG + h * 128 + 64 * eh + 4 * g;
    const float* nw = a.in[I_GNW] + l * 512 + h * 128 + 64 * eh + 4 * g;
    bf16_t* op = (bf16_t*)(ws + WS_H) + row * D + 1536 + h * 128 + 64 * eh + 4 * g;
#pragma unroll
    for (int E4 = 0; E4 < 4; ++E4) { const u32x2 gr = *(const u32x2*)(gp + 16 * E4); const f32x4 nv = *(const f32x4*)(nw + 16 * E4);
        u32x2 ov; ov.x = pk2(o[E4].x * rn * nv.x * siluf_(bflo(gr.x)), o[E4].y * rn * nv.y * siluf_(bfhi(gr.x)));
        ov.y = pk2(o[E4].z * rn * nv.z * siluf_(bflo(gr.y)), o[E4].w * rn * nv.w * siluf_(bfhi(gr.y)));
        *(u32x2*)(op + 16 * E4) = ov; }
}
#ifndef MK_EN
#define MK_EN 0xffff
#endif
#define EN(x) ((MK_EN >> (x)) & 1)
constexpr int PH_PREP = 0, PH_PER_LAYER = 8, PH_FNORM = 1 + 2 * PH_PER_LAYER, N_PHASES = PH_FNORM + 1;

__global__ void __launch_bounds__(NT, 2) fwd_kernel(Args ka) {
    extern __shared__ __attribute__((aligned(16))) unsigned char lds_raw[];
    LAS unsigned char* lds = (LAS unsigned char*)lds_raw;
    const int G = gridDim.x;
    volatile LAS unsigned* bst = (volatile LAS unsigned*)(lds + LDS_CTL_OFF);
    if (threadIdx.x < 16) bst[threadIdx.x] = 0u;
    if (threadIdx.x == 0) { LAS unsigned long long* tab = (LAS unsigned long long*)(lds + LDS_PTR_OFF);
#pragma unroll
        for (int i = 0; i < N_IN; ++i) tab[i] = (unsigned long long)ka.in[i]; }
    __syncthreads();
    DArgs a; a.in.t = (const LAS unsigned long long*)(lds + LDS_PTR_OFF); a.out = ka.out;
    XcdBarrier gbar; gbar.bar = (unsigned*)(ka.ws + WS_CTL); gbar.x = 0; gbar.st = bst;
    if (ka.ph_hi - ka.ph_lo > 1) gbar = xcd_barrier_post((unsigned*)(ka.ws + WS_CTL), bst);

    for (int ph = ka.ph_lo; ph < ka.ph_hi; ++ph) {
        int tid = threadIdx.x; asm volatile("" : "+v"(tid));
        int bid = blockIdx.x; asm volatile("" : "+s"(bid));
        const int lane = tid & 63, wave = __builtin_amdgcn_readfirstlane(tid >> 6);
        unsigned char* ws = ka.ws; asm volatile("" : "+s"(ws));
        float* MOD = (float*)(ws + WS_MOD);
        if (EN(0) && ph == PH_PREP) {
            for (int it = bid; it < 1840; it += G) {
                int tid = threadIdx.x; asm volatile("" : "+v"(tid));
                __syncthreads();
                if (it < 768) prep_adaln(a.in[I_C], a.in[I_CCTX], a.in[I_ADAW], a.in[I_ADAB], MOD, it, (LAS float*)lds, tid);
                else if (it < 784) prep_s5(a, ws, it - 768, tid);
                else { const bool big = it < 1808; const int r = big ? it - 784 : it - 1808, l = big ? (r >> 9) : 0, t0 = (big ? (r & 511) : r) * 8;
                    float* H3o = big ? (float*)(ws + WS_H3) + (size_t)l * 4096 * 64 : (float*)(ws + WS_H3C);
                    prep_hymlp(a, H3o, l, big ? 4096 : 256, t0, (LAS float*)lds, (LAS float*)(lds + 2048), (LAS float*)(lds + 4096), tid); }
            }
        } else if (EN(1) && ph == PH_FNORM) {
            const float* fw = a.in[I_FNW];
            for (int row = bid * NWAVES + wave; row < NLAT; row += G * NWAVES) {
                float* xr = a.out + (size_t)row * D; f32x4 v[8]; float ss = 0.f;
#pragma unroll
                for (int j = 0; j < 8; ++j) { v[j] = ((const f32x4*)xr)[lane + 64 * j]; ss += (v[j].x * v[j].x + v[j].y * v[j].y) + (v[j].z * v[j].z + v[j].w * v[j].w); }
                const float rstd = rsqrtf(wave_sum(ss) * (1.0f / D) + EPS);
#pragma unroll
                for (int j = 0; j < 8; ++j) { const f32x4 w = *(const f32x4*)(fw + 4 * (lane + 64 * j)); ((f32x4*)xr)[lane + 64 * j] = v[j] * rstd * w; }
            }
        } else {
            const int l = (ph - 1) / PH_PER_LAYER, sub = (ph - 1) % PH_PER_LAYER;
            const bool ctx_out = (l == 0);
            const int Mrows = ctx_out ? MR : NLAT;
            if (EN(2) && sub == 0) {
                LAS float* scr = (LAS float*)(lds + wave * 8704);
                const int gw = bid * NWAVES + wave, NGW = G * NWAVES;
                constexpr int I_W1 = 32 * (NPAD / 32), I_W2 = 32 * 64, I_W3 = 8 * 16;
                for (int it = gw; it < I_W1 + I_W2 + I_W3; it += NGW) {
                    int r = it;
                    if (r < I_W1) { const int kb = r / (NPAD / 32), nb = r % (NPAD / 32); transpose_item(a.in[I_WIN] + (size_t)l * D * INW, INW, win_srccol(nb * 32), kb * 64, (bf16_t*)(ws + WS_WIN), D, nb * 32, scr, lane); continue; }
                    r -= I_W1;
                    if (r < I_W2) { const int kb = r / 64, nb = r % 64; transpose_item(a.in[I_WOUT] + (size_t)l * D * D, D, nb * 32, kb * 64, (bf16_t*)(ws + WS_WOUT), D, nb * 32, scr, lane); continue; }
                    r -= I_W2;
                    { const int kb = r / 16, nb = r % 16; transpose_item(a.in[I_GLUW] + (size_t)l * 512 * 512, 512, nb * 32, kb * 64, (bf16_t*)(ws + WS_GLUW), 512, nb * 32, scr, lane); }
                }
                const float* nw = a.in[I_NORMW] + (size_t)l * D;
                for (int row = gw; row < MR; row += NGW) {
                    const float* xr; int v;
                    if (row < NLAT) { xr = (l == 0 ? a.in[I_X] : a.out) + (size_t)row * D; v = row >> 12; }
                    else { xr = (l == 0 ? a.in[I_CTX] : (const float*)(ws + WS_XC1)) + (size_t)(row - NLAT) * D; v = 4; }
                    norm_row(xr, nw, MOD + (size_t)(l * 5 + v) * ADA, (bf16_t*)(ws + WS_H) + (size_t)row * D, lane);
                }
                __syncthreads();
                const int nfilt = ctx_out ? 1024 : 512;
                for (int it = bid; it < nfilt; it += G) { int tid = threadIdx.x; asm volatile("" : "+v"(tid)); __syncthreads(); if (it < 512) filt_item(a, ws, lds, l, it, tid); else filt_ctx_item(a, ws, lds, it - 512, tid); }
            } else if (EN(3) && sub == 1) {
                pg8::Gemm g{(const bf16_t*)(ws + WS_H), (const bf16_t*)(ws + WS_WIN), MR, NPAD, D}; pg8::StaticOrder S; S.init(MR, NPAD, G, bid);
                EpiInProj E{(bf16_t*)(ws + WS_P), (bf16_t*)(ws + WS_PT), (float*)(ws + WS_LR)};
                pg8::gemm_phase<EpiInProj, pg8::StaticOrder>(lds, g, S, E, tid);
            } else if (EN(4) && sub == 2) {
                for (int row = bid * NWAVES + wave; row < MR; row += G * NWAVES) rope_row(a, ws, l, row, lane);
            } else if (EN(5) && sub == 3) {
                const int nit = ctx_out ? 2912 : 2400;
                for (int it = bid; it < nit; it += G) {
                    int tid = threadIdx.x; asm volatile("" : "+v"(tid));
                    __syncthreads();
                    if (it < 256) { const int r = it; s5_chain(a, ws, lds, l, r >> 6, (r >> 1) & 31, r & 1, ctx_out, tid); }
                    else if (it < 800) ret_passA(ws, lds, it - 256, tid);
                    else if (it < 1888) gla_passA(a, ws, lds, l, it - 800, tid);
                    else if (it < 2400) hyena_item(a, ws, lds, l, it - 1888, tid);
                    else hyena_ctx_item(a, ws, lds, it - 2400, tid);
                }
            } else if (EN(9) && sub == 4) {
                for (int gt = bid * NT + tid; gt < 16 * 2 * 2048; gt += G * NT) { ret_passB(ws, gt); gla_passB(ws, gt); }
            } else if (EN(6) && sub == 5) {
                const int nrc = ctx_out ? 16 * RNCH : 16 * 32, ngc = ctx_out ? 16 * GNCH : 16 * 64;
                for (int it = bid; it < nrc + ngc; it += G) { int tid = threadIdx.x; asm volatile("" : "+v"(tid)); __syncthreads();
                    if (it < nrc) { const int item = ctx_out ? it : (it >> 5) * RNCH + 2 + (it & 31); ret_passC(a, ws, lds, l, item, tid); }
                    else { const int r = it - nrc; const int item = ctx_out ? r : (r >> 6) * GNCH + 4 + (r & 63); gla_passC(a, ws, lds, l, item, tid); } }
                for (int row = bid * NWAVES + wave; row < Mrows; row += G * NWAVES) merge_row(a, ws, l, row, lane);
            } else if (EN(7) && sub == 6) {
                pg8::Gemm g{(const bf16_t*)(ws + WS_KF), (const bf16_t*)(ws + WS_GLUW), Mrows, 512, 512}; pg8::StaticOrder S; S.init(Mrows, 512, G, bid);
                EpiGlu E{(const bf16_t*)(ws + WS_KF), (const bf16_t*)(ws + WS_P), (bf16_t*)(ws + WS_H), a.in[I_GLUB] + (size_t)l * 512};
                pg8::gemm_phase<EpiGlu, pg8::StaticOrder>(lds, g, S, E, tid);
            } else if (EN(8)) {
                pg8::Gemm g{(const bf16_t*)(ws + WS_H), (const bf16_t*)(ws + WS_WOUT), Mrows, D, D}; pg8::StaticOrder S; S.init(Mrows, D, G, bid);
                EpiOut E{l == 0 ? a.in[I_X] : a.out, a.in[I_CTX], a.out, (float*)(ws + WS_XC1), MOD + (size_t)l * 5 * ADA};
                pg8::gemm_phase<EpiOut, pg8::StaticOrder>(lds, g, S, E, tid);
            }
        }
        if (ph + 1 < ka.ph_hi) xcd_barrier(gbar);
    }
}

#ifndef MK_LAUNCH_PER_PHASE
#define MK_LAUNCH_PER_PHASE 0
#endif
extern "C" void kernel_launch(void* const* d_in, const int* in_sizes, int n_in, void* d_out, int out_size, void* d_ws, size_t ws_size, hipStream_t stream) {
    static int grid = 0;
    if (grid == 0) {
        if (n_in != N_IN || out_size != NLAT * D || ws_size < WS_END2) { fprintf(stderr, "kernel_launch: unexpected shapes (n_in %d, out %d, ws %zu < %zu); nothing launched\n", n_in, out_size, ws_size, (size_t)WS_END2); grid = -1; return; }
        int dev = 0, cus = 0, per_cu = 0;
        if (hipGetDevice(&dev) != hipSuccess || hipDeviceGetAttribute(&cus, hipDeviceAttributeMultiprocessorCount, dev) != hipSuccess) { grid = -1; return; }
        if (hipFuncSetAttribute((const void*)fwd_kernel, hipFuncAttributeMaxDynamicSharedMemorySize, LDS_BYTES) != hipSuccess) { fprintf(stderr, "kernel_launch: hipFuncSetAttribute failed\n"); grid = -1; return; }
        if (hipOccupancyMaxActiveBlocksPerMultiprocessor(&per_cu, (const void*)fwd_kernel, NT, LDS_BYTES) != hipSuccess || per_cu < 1) { fprintf(stderr, "kernel_launch: occupancy query says %d blocks per CU\n", per_cu); per_cu = 1; }
        (void)hipGetLastError();
        grid = cus;
    }
    if (grid < 0) return;
    (void)hipMemsetAsync((char*)d_ws + WS_CTL, 0, WS_ZERO_BYTES, stream);
    Args a{};
    for (int i = 0; i < N_IN; ++i) a.in[i] = (const float*)d_in[i];
    a.out = (float*)d_out; a.ws = (unsigned char*)d_ws;
#if MK_LAUNCH_PER_PHASE
    for (int ph = 0; ph < N_PHASES; ++ph) {
        a.ph_lo = ph; a.ph_hi = ph + 1;
        hipLaunchKernelGGL(fwd_kernel, dim3(grid), dim3(NT), LDS_BYTES, stream, a);
    }
#else
    a.ph_lo = 0; a.ph_hi = N_PHASES;
    void* args[] = {&a};
    hipError_t e = hipLaunchCooperativeKernel((const void*)fwd_kernel, dim3(grid), dim3(NT), args, LDS_BYTES, stream);
    if (e != hipSuccess) fprintf(stderr, "kernel_launch: cooperative launch failed: %s (grid %d)\n", hipGetErrorString(e), grid);
#endif
}
```

```cpp
#include <hip/hip_runtime.h>
#include <hip/hip_cooperative_groups.h>
#include <cstdio>
#include <cstdint>
namespace cg = cooperative_groups;

#define LAS __attribute__((address_space(3)))
typedef unsigned short bf16_t;
typedef float f32x4 __attribute__((ext_vector_type(4)));
typedef float f32x2 __attribute__((ext_vector_type(2)));
typedef unsigned u32x4 __attribute__((ext_vector_type(4)));
typedef unsigned u32x2 __attribute__((ext_vector_type(2)));

constexpr int D = 2048, NB = 4, SEQL = 4096, LC = 256, NLAT = NB * SEQL, NCTX = NB * LC, MR = NLAT + NCTX;
constexpr int BR = 512, INW = 6688, NPAD = 6912, LDP = 4608, ADA = 3 * D;
constexpr int NT = 512, NWAVES = 8;
constexpr float EPS = 1e-6f;
constexpr int PC_S5U = 0, PC_S5G = 512, PC_RQ = 1024, PC_RK = 1536, PC_RV = 2048, PC_RG = 2560, PC_GQ = 3072, PC_GK = 3328, PC_GV = 3584, PC_GG = 4096;
constexpr int PT_V = 0, PT_G1 = 512, PT_G2 = 1024, PT_HG = 1536;
constexpr int FFTN = 8192;

enum { I_X = 0, I_C, I_CTX, I_CCTX, I_NORMW, I_ADAW, I_ADAB, I_WIN, I_WOUT, I_S5ARE, I_S5AIM, I_S5LDT, I_S5BRE, I_S5BIM, I_S5CRE, I_S5CIM,
       I_S5D, I_GLUW, I_GLUB, I_HCW, I_HCB, I_HW1, I_HB1, I_HF1, I_HW2, I_HB2, I_HF2, I_HW3, I_HB3, I_HF3, I_HW4, I_HBIAS, I_RNW, I_GGW, I_GGB, I_GNW, I_FNW, N_IN };

constexpr size_t al256(size_t x) { return (x + 255) & ~(size_t)255; }
constexpr size_t WS_CTL  = 0;
constexpr size_t WS_MOD  = WS_CTL + 65536;
constexpr size_t WS_ZERO_BYTES = 65536 + al256((size_t)2 * 5 * ADA * 4);
constexpr size_t WS_S5AB = WS_MOD + al256((size_t)2 * 5 * ADA * 4);
constexpr size_t WS_S5BT = WS_S5AB + (size_t)2 * 2 * 32 * 64 * 8;
constexpr size_t WS_H3   = WS_S5BT + (size_t)1048576 + 65536;
constexpr size_t WS_H3C  = WS_H3 + (size_t)2 * 4096 * 64 * 4;
constexpr size_t WS_KC   = WS_H3C + (size_t)256 * 64 * 4;
constexpr size_t WS_LR   = WS_KC + (size_t)2 * 512 * 512 * 4;
constexpr size_t WS_XC1  = WS_LR + (size_t)MR * 32 * 4;
constexpr size_t WS_WOUT = WS_XC1 + (size_t)NCTX * D * 4;
constexpr size_t WS_GLUW = WS_WOUT + (size_t)D * D * 2;
constexpr size_t WS_WIN  = WS_GLUW + (size_t)512 * 512 * 2;
constexpr size_t WS_H    = WS_WIN + (size_t)NPAD * D * 2;
constexpr size_t WS_P    = WS_H + (size_t)MR * D * 2;
constexpr size_t WS_PT   = WS_P + (size_t)MR * LDP * 2;
constexpr size_t WS_KF   = WS_PT + (size_t)2048 * MR * 2;
constexpr size_t WS_OB   = WS_KF + (size_t)2 * 512 * FFTN * 8;
constexpr size_t WS_END  = WS_OB + (size_t)6 * MR * 512 * 2;
constexpr size_t OBSZ = (size_t)MR * 512;

constexpr int LDS_CTL_OFF = 131072 + 2048;
constexpr int LDS_PTR_OFF = LDS_CTL_OFF + 64;
constexpr int LDS_BYTES = LDS_PTR_OFF + 320;

__device__ __forceinline__ unsigned f2bf(float f) { unsigned u = __float_as_uint(f); return (u + 0x7fffu + ((u >> 16) & 1u)) >> 16; }
__device__ __forceinline__ unsigned pk2(float lo, float hi) { return f2bf(lo) | (f2bf(hi) << 16); }
__device__ __forceinline__ float bf2f(bf16_t b) { return __uint_as_float((unsigned)b << 16); }
__device__ __forceinline__ float bflo(unsigned w) { return __uint_as_float(w << 16); }
__device__ __forceinline__ float bfhi(unsigned w) { return __uint_as_float(w & 0xffff0000u); }
__device__ __forceinline__ void unpack8(const u32x4 r, float (&f)[8]) { f[0] = bflo(r.x); f[1] = bfhi(r.x); f[2] = bflo(r.y); f[3] = bfhi(r.y); f[4] = bflo(r.z); f[5] = bfhi(r.z); f[6] = bflo(r.w); f[7] = bfhi(r.w); }
__device__ __forceinline__ u32x4 pack8(const float (&f)[8]) { u32x4 o; o.x = pk2(f[0], f[1]); o.y = pk2(f[2], f[3]); o.z = pk2(f[4], f[5]); o.w = pk2(f[6], f[7]); return o; }
__device__ __forceinline__ float sigmoidf_(float x) { return 1.0f / (1.0f + __expf(-x)); }
__device__ __forceinline__ float siluf_(float x) { return x * sigmoidf_(x); }
__device__ __forceinline__ float gelu_tanh(float x) { const float u = 0.7978845608028654f * (x + 0.044715f * x * x * x); return 0.5f * x * (1.0f + tanhf(u)); }
__device__ __forceinline__ float wave_sum(float v) {
#pragma unroll
    for (int o = 1; o < 64; o <<= 1) v += __shfl_xor(v, o);
    return v;
}
#define LDS_WAIT() asm volatile("s_waitcnt lgkmcnt(0)" ::: "memory")

struct Args { const float* in[N_IN]; float* out; unsigned char* ws; int ph_lo, ph_hi; };
struct InTab { const LAS unsigned long long* t;
    __device__ __forceinline__ const float* operator[](int i) const { const unsigned long long v = t[i];
        const unsigned lo = __builtin_amdgcn_readfirstlane((unsigned)v), hi = __builtin_amdgcn_readfirstlane((unsigned)(v >> 32)); return (const float*)(((unsigned long long)hi << 32) | lo); } };
struct DArgs { InTab in; float* out; };

#define XB_TMO      128
#define XB_XCNT(j)  (256  + 64 * (j))
#define XB_XSUB(j)  (1280 + 64 * (j))
#define XB_XGEN(j)  (2304 + 64 * (j))
#define XB_TOP      3328
#define XB_TOPGEN   3392
#define XCD_BAR_WORDS 3456
#define XB_SPIN_CAP (1u << 22)
__device__ __forceinline__ unsigned xb_ld(unsigned* p)              { return __hip_atomic_load(p, __ATOMIC_RELAXED, __HIP_MEMORY_SCOPE_AGENT); }
__device__ __forceinline__ unsigned xb_add(unsigned* p, unsigned v) { return __hip_atomic_fetch_add(p, v, __ATOMIC_RELAXED, __HIP_MEMORY_SCOPE_AGENT); }
__device__ __forceinline__ unsigned xb_xcc_id() { return (unsigned)__builtin_amdgcn_s_getreg((3 << 11) | 20) & 0xFu; }
#define XB_SPIN(cond, bar) do { unsigned _sp = 0; while (cond) { __builtin_amdgcn_s_sleep(1); \
    if ((++_sp & 255u) == 0u) { if (xb_ld(&(bar)[XB_TMO])) break; if (_sp > XB_SPIN_CAP) { atomicAdd(&(bar)[XB_TMO], 1u); break; } } } } while (0)
struct XcdBarrier { unsigned* bar; unsigned x; volatile LAS unsigned* st; };
__device__ __forceinline__ XcdBarrier xcd_barrier_post(unsigned* bar, volatile LAS unsigned* st) {
    XcdBarrier b; b.bar = bar; b.x = xb_xcc_id(); b.st = st;
    if (threadIdx.x == 0) (void)xb_add(&bar[XB_XCNT(b.x)], 1u);
    return b;
}
__device__ __forceinline__ void xcd_barrier_complete(unsigned* bar, unsigned x, unsigned& nloc, unsigned& nx) {
    const unsigned G = gridDim.x * gridDim.y * gridDim.z;
    unsigned sum, cnt, mine, sp = 0u;
    for (;;) {
        sum = 0u; cnt = 0u; mine = 0u;
#pragma unroll
        for (unsigned j = 0; j < 16; ++j) { const unsigned c = xb_ld(&bar[XB_XCNT(j)]); sum += c; cnt += (c > 0u) ? 1u : 0u; mine = (j == x) ? c : mine; }
        if (sum == G) break;
        __builtin_amdgcn_s_sleep(1);
        if ((++sp & 255u) == 0u) { if (xb_ld(&bar[XB_TMO])) break; if (sp > XB_SPIN_CAP) { atomicAdd(&bar[XB_TMO], 1u); break; } }
    }
    nloc = mine > 0u ? mine : 1u; nx = cnt > 0u ? cnt : 1u;
}
__device__ __forceinline__ void xcd_barrier(const XcdBarrier& b) {
    asm volatile("s_waitcnt vmcnt(0)" ::: "memory");
    __syncthreads();
    if (threadIdx.x == 0) {
        unsigned* bar = b.bar;
        __builtin_amdgcn_s_waitcnt(0);
        unsigned nloc = b.st[0], nx = b.st[1];
        if (nloc == 0u) { xcd_barrier_complete(bar, b.x, nloc, nx); b.st[0] = nloc; b.st[1] = nx; }
        const unsigned old = xb_add(&bar[XB_XSUB(b.x)], 1u);
        const unsigned gen = old / nloc;
        if (old + 1u == (gen + 1u) * nloc) {
            __builtin_amdgcn_fence(__ATOMIC_RELEASE, "agent");
            asm volatile("s_waitcnt vmcnt(0)" ::: "memory");
            const unsigned og = xb_add(&bar[XB_TOP], 1u);
            const unsigned tg = og / nx;
            if (og + 1u == (tg + 1u) * nx) xb_add(&bar[XB_TOPGEN], 1u);
            else XB_SPIN(xb_ld(&bar[XB_TOPGEN]) == tg, bar);
            __builtin_amdgcn_fence(__ATOMIC_ACQUIRE, "agent");
            xb_add(&bar[XB_XGEN(b.x)], 1u);
            asm volatile("s_waitcnt vmcnt(0)" ::: "memory");
        } else {
            XB_SPIN(xb_ld(&bar[XB_XGEN(b.x)]) == gen, bar);
            __builtin_amdgcn_fence(__ATOMIC_ACQUIRE, "agent");
            asm volatile("s_waitcnt vmcnt(0)" ::: "memory");
        }
    }
    __syncthreads();
}
namespace pg8 {
#define PG8_LAS __attribute__((address_space(3)))
typedef unsigned short bf16_t;
typedef short bf16x8 __attribute__((ext_vector_type(8)));
typedef float f32x4 __attribute__((ext_vector_type(4)));
typedef unsigned u32x4 __attribute__((ext_vector_type(4)));
constexpr int BM = 256, BK = 64, HALF = 128, HTB = HALF * BK * 2, STAGE_BYTES = 8 * HTB, NXCD = 8, WGM = 8;

__host__ __device__ __forceinline__ int lds_byte(int r, int c) { const int st = (r >> 4) * 2 + (c >> 5), rr = r & 15, cc = c & 31, ob = rr * 64 + cc * 2; return st * 1024 + (ob ^ (((ob >> 9) & 1) << 5)); }
__host__ __device__ __forceinline__ void stage_rc(int b, int& R, int& C) { const int st = b / 1024, sb = b % 1024, swz = sb ^ (((sb >> 9) & 1) << 5); R = (st >> 1) * 16 + swz / 64; C = (st & 1) * 32 + (swz % 64) / 2; }
__host__ __device__ __forceinline__ int perm32(int rho) { const int n = rho >> 4, i = rho & 15; return 8 * (i >> 2) + 4 * n + (i & 3); }

struct Unit { int pm, pn; };
struct Gemm { const bf16_t* A; const bf16_t* Bt; int M, N, K; };

struct StaticOrder {
    int nM, nN, nwg, G, c;
    __host__ __device__ void init(int M, int N, int G_, int c_) { nM = M / BM; nN = N / BM; nwg = nM * nN; G = G_; c = c_; }
    __host__ __device__ bool next(int i, Unit& u) const {
        const long L = (long)i * G + c; if (L >= nwg) return false;
        int wgid = (int)L; { const int q = nwg / NXCD, r = nwg % NXCD, xcd = wgid % NXCD, off = wgid / NXCD; wgid = (xcd < r ? xcd * (q + 1) : r * (q + 1) + (xcd - r) * q) + off; }
        const int nig = WGM * nN, gid = wgid / nig, fm = gid * WGM, gsz = (nM - fm) < WGM ? (nM - fm) : WGM;
        u.pm = fm + ((wgid % nig) % gsz); u.pn = (wgid % nig) / gsz; return true;
    }
    __device__ __forceinline__ void a_ready(const Unit&) const {}
    __device__ __forceinline__ void done(const Unit&) const {}
};

template <class Epi, class Sched>
__device__ __forceinline__ void gemm_phase(PG8_LAS unsigned char* lds, const Gemm g, const Sched& S, const Epi& E, const int tid) {
    const int wid = __builtin_amdgcn_readfirstlane(tid >> 6), lane = tid & 63, wr = wid >> 2, wc = wid & 3, fr = lane & 15, fq = lane >> 4;
    const int K = g.K, nt = K / BK;
    unsigned voffA[2], voffB[2];
#pragma unroll
    for (int i = 0; i < 2; ++i) { int R, C; stage_rc(tid * 16 + i * 8192, R, C); const int Rb = Epi::PERM ? ((R & ~31) + perm32(R & 31)) : R;
        voffA[i] = (unsigned)(R * K + C) * 2u; voffB[i] = (unsigned)(Rb * K + C) * 2u; }
    const size_t kstep = (size_t)(BK * 2);
    const size_t hstep = (size_t)HALF * K * 2;
    const size_t tstep = 2 * hstep;
    const unsigned ldsw = (unsigned)wid * 1024u;
    const int aoff = lds_byte(wr * 64 + fr, fq * 8), boff = lds_byte(wc * 32 + fr, fq * 8);
#define PG8_SA(b, h) (((b) * 2 + (h)) * HTB)
#define PG8_SB(b, h) ((4 + (b) * 2 + (h)) * HTB)
#define PG8_STAGE(bufoff, gbase, voff) do { _Pragma("unroll") for (int _i = 0; _i < 2; ++_i) \
        __builtin_amdgcn_global_load_lds((const unsigned*)((const char*)(gbase) + (voff)[_i]), (PG8_LAS unsigned*)(lds + (bufoff) + ldsw + _i * 8192), 16, 0, 0); } while (0)
#define PG8_LDA(dst, b, h) do { _Pragma("unroll") for (int m = 0; m < 4; ++m) _Pragma("unroll") for (int k = 0; k < 2; ++k) dst[m][k] = *(const PG8_LAS bf16x8*)(lds + PG8_SA(b, h) + aoff + m * 2048 + k * 1024); } while (0)
#define PG8_LDB(dst, b, h) do { _Pragma("unroll") for (int n = 0; n < 2; ++n) _Pragma("unroll") for (int k = 0; k < 2; ++k) dst[n][k] = *(const PG8_LAS bf16x8*)(lds + PG8_SB(b, h) + boff + n * 2048 + k * 1024); } while (0)
#define PG8_MMA(ai, bj, At, Bt) do { __builtin_amdgcn_s_setprio(1); _Pragma("unroll") for (int m = 0; m < 4; ++m) _Pragma("unroll") for (int n = 0; n < 2; ++n) _Pragma("unroll") for (int k = 0; k < 2; ++k) \
        acc[ai][bj][m][n] = __builtin_amdgcn_mfma_f32_16x16x32_bf16(Bt[n][k], At[m][k], acc[ai][bj][m][n], 0, 0, 0); __builtin_amdgcn_s_setprio(0); } while (0)
#define PG8_WAIT_V(n) asm volatile("s_waitcnt vmcnt(" #n ")" ::: "memory")
#define PG8_WAIT_L(n) asm volatile("s_waitcnt lgkmcnt(" #n ")" ::: "memory")
#define PG8_BAR __builtin_amdgcn_s_barrier()
#define PG8_SCHED __builtin_amdgcn_sched_barrier(0)
    Unit cur, nxt; int ui = 0;
    if (!S.next(0, cur)) return;
    f32x4 acc[2][2][4][2];
#pragma unroll
    for (int a = 0; a < 2; ++a)
#pragma unroll
        for (int b = 0; b < 2; ++b)
#pragma unroll
            for (int m = 0; m < 4; ++m)
#pragma unroll
                for (int n = 0; n < 2; ++n) acc[a][b][m][n] = (f32x4){0.f, 0.f, 0.f, 0.f};
    bf16x8 At[4][2], B0[2][2], B1[2][2];
    const char* cA = (const char*)g.A + (size_t)cur.pm * tstep; const char* cB = (const char*)g.Bt + (size_t)cur.pn * tstep;
    S.a_ready(cur);
    PG8_STAGE(PG8_SB(0, 0), cB, voffB); PG8_STAGE(PG8_SA(0, 0), cA, voffA); PG8_STAGE(PG8_SB(0, 1), cB + hstep, voffB); PG8_STAGE(PG8_SA(0, 1), cA + hstep, voffA);
    if (wr == 1) PG8_BAR;
    PG8_WAIT_V(4); PG8_BAR;
    PG8_STAGE(PG8_SB(1, 0), cB + kstep, voffB); PG8_STAGE(PG8_SA(1, 0), cA + kstep, voffA); PG8_STAGE(PG8_SB(1, 1), cB + hstep + kstep, voffB);
    PG8_WAIT_V(6); PG8_BAR;
    for (;;) {
        const bool has_next = S.next(ui + 1, nxt);
        const char* nA = has_next ? (const char*)g.A + (size_t)nxt.pm * tstep : cA; const char* nB = has_next ? (const char*)g.Bt + (size_t)nxt.pn * tstep : cB;
        for (int t = 0; t < nt; t += 2) {
            const bool last = (t == nt - 2);
            const char* a1 = cA + (size_t)(t + 1) * kstep;
            const char* a2 = last ? nA : cA + (size_t)(t + 2) * kstep; const char* b2 = last ? nB : cB + (size_t)(t + 2) * kstep;
            const char* a3 = a2 + kstep; const char* b3 = b2 + kstep;
            if (last && has_next) S.a_ready(nxt);
            PG8_LDB(B0, 0, 0); PG8_SCHED; PG8_LDA(At, 0, 0); PG8_STAGE(PG8_SA(1, 1), a1 + hstep, voffA);
            PG8_WAIT_L(8); PG8_BAR; PG8_WAIT_L(0); PG8_MMA(0, 0, At, B0); PG8_BAR; PG8_SCHED;
            PG8_LDB(B1, 0, 1); PG8_STAGE(PG8_SB(0, 0), b2, voffB);
            PG8_BAR; PG8_WAIT_L(0); PG8_MMA(0, 1, At, B1); PG8_BAR;
            PG8_LDA(At, 0, 1); PG8_STAGE(PG8_SA(0, 0), a2, voffA);
            PG8_BAR; PG8_WAIT_L(0); PG8_MMA(1, 0, At, B0); PG8_BAR; PG8_SCHED;
            PG8_STAGE(PG8_SB(0, 1), b2 + hstep, voffB);
            PG8_WAIT_V(6); PG8_BAR; PG8_MMA(1, 1, At, B1); PG8_BAR;
            PG8_LDB(B0, 1, 0); PG8_SCHED; PG8_LDA(At, 1, 0); PG8_STAGE(PG8_SA(0, 1), a2 + hstep, voffA);
            PG8_WAIT_L(8); PG8_BAR; PG8_WAIT_L(0); PG8_MMA(0, 0, At, B0); PG8_BAR; PG8_SCHED;
            PG8_LDB(B1, 1, 1); PG8_STAGE(PG8_SB(1, 0), b3, voffB);
            PG8_BAR; PG8_WAIT_L(0); PG8_MMA(0, 1, At, B1); PG8_BAR;
            PG8_LDA(At, 1, 1); PG8_STAGE(PG8_SA(1, 0), a3, voffA);
            PG8_BAR; PG8_WAIT_L(0); PG8_MMA(1, 0, At, B0); PG8_BAR; PG8_SCHED;
            PG8_STAGE(PG8_SB(1, 1), b3 + hstep, voffB);
            PG8_WAIT_V(6); PG8_BAR; PG8_MMA(1, 1, At, B1); PG8_BAR;
        }
        E(acc, cur, wr, wc, fr, fq); S.done(cur);
        if (!has_next) break;
#pragma unroll
        for (int a = 0; a < 2; ++a)
#pragma unroll
            for (int b = 0; b < 2; ++b)
#pragma unroll
                for (int m = 0; m < 4; ++m)
#pragma unroll
                    for (int n = 0; n < 2; ++n) acc[a][b][m][n] = (f32x4){0.f, 0.f, 0.f, 0.f};
        cur = nxt; cA = nA; cB = nB; ++ui;
    }
    PG8_WAIT_V(0);
    if (wr == 0) PG8_BAR;
    PG8_BAR;
#undef PG8_SA
#undef PG8_SB
#undef PG8_STAGE
#undef PG8_LDA
#undef PG8_LDB
#undef PG8_MMA
#undef PG8_WAIT_V
#undef PG8_WAIT_L
#undef PG8_BAR
#undef PG8_SCHED
}
}
__device__ __forceinline__ void prep_adaln(const float* c, const float* cctx, const float* adaw, const float* adab, float* MOD, int it, LAS float* sv, int tid) {
    const int l = it / 384, r = it % 384, ntile = r >> 5, ks = r & 31, k0 = ks * 64;
    if (tid < 320) { const int v = tid >> 6, k = tid & 63; const float cv = v < 4 ? c[v * D + k0 + k] : cctx[k0 + k]; sv[tid] = cv / (1.0f + expf(-cv)); }
    __syncthreads();
    const int n = ntile * 512 + tid; const float* w = adaw + (size_t)l * D * ADA + (size_t)k0 * ADA + n;
    float acc[5] = {0.f, 0.f, 0.f, 0.f, 0.f};
#pragma unroll 8
    for (int k = 0; k < 64; ++k) { const float wv = w[(size_t)k * ADA];
#pragma unroll
        for (int v = 0; v < 5; ++v) acc[v] += sv[v * 64 + k] * wv; }
    if (ks == 0) { const float bb = adab[l * ADA + n];
#pragma unroll
        for (int v = 0; v < 5; ++v) acc[v] += bb; }
#pragma unroll
    for (int v = 0; v < 5; ++v) atomicAdd(MOD + (size_t)(l * 5 + v) * ADA + n, acc[v]);
    __syncthreads();
}

__device__ __forceinline__ void prep_s5(const DArgs& a, unsigned char* ws, int it, int tid) {
    const int idx = it * 512 + tid;
    const float a_re = a.in[I_S5ARE][idx], a_im = a.in[I_S5AIM][idx], ldt = a.in[I_S5LDT][idx >> 6];
    const float dt = expf(ldt), mag = expf(a_re * dt);
    float sn, cs; sincosf(a_im * dt, &sn, &cs);
    const float ab_re = mag * cs, ab_im = mag * sn, den = a_re * a_re + a_im * a_im, nr = ab_re - 1.0f;
    const float co_re = (nr * a_re + ab_im * a_im) / den, co_im = (ab_im * a_re - nr * a_im) / den;
    ((f32x2*)(ws + WS_S5AB))[idx] = (f32x2){ab_re, ab_im};
    const float* bre = a.in[I_S5BRE] + (size_t)idx * 16; const float* bim = a.in[I_S5BIM] + (size_t)idx * 16;
    f32x2* bt = (f32x2*)(ws + WS_S5BT) + (size_t)idx * 16;
#pragma unroll
    for (int i = 0; i < 16; ++i) { const float br = bre[i], bi = bim[i]; bt[i] = (f32x2){co_re * br - co_im * bi, co_re * bi + co_im * br}; }
}

__device__ __forceinline__ void prep_hymlp(const DArgs& a, float* H3out, int l, int Lx, int t0, LAS float* zs, LAS float* h1, LAS float* h2, int tid) {
    const int pos = tid >> 6, f = tid & 63, t = t0 + pos;
    if (f < 33) {
        float z;
        if (f == 0) z = (float)t / (float)(Lx - 1);
        else { const int j = (f - 1) & 15; const float fj = 1e-4f + (float)j * ((15.0f - 1e-4f) / 15.0f); const float wpos = (6.283185307179586f * (float)t) / (float)Lx; const float arg = fj * wpos;
               z = (f <= 16) ? cosf(arg) : -sinf(arg); }
        zs[pos * 36 + f] = z;
    }
    __syncthreads();
    const float* w1 = a.in[I_HW1] + (size_t)l * 33 * 64; const float* w2 = a.in[I_HW2] + (size_t)l * 64 * 64; const float* w3 = a.in[I_HW3] + (size_t)l * 64 * 64;
    float s = a.in[I_HB1][l * 64 + f];
#pragma unroll 3
    for (int j = 0; j < 33; ++j) s += zs[pos * 36 + j] * w1[j * 64 + f];
    h1[pos * 64 + f] = sinf(a.in[I_HF1][l * 64 + f] * s);
    __syncthreads();
    s = a.in[I_HB2][l * 64 + f];
#pragma unroll 4
    for (int j = 0; j < 64; ++j) s += h1[pos * 64 + j] * w2[j * 64 + f];
    h2[pos * 64 + f] = sinf(a.in[I_HF2][l * 64 + f] * s);
    __syncthreads();
    s = a.in[I_HB3][l * 64 + f];
#pragma unroll 4
    for (int j = 0; j < 64; ++j) s += h2[pos * 64 + j] * w3[j * 64 + f];
    H3out[(size_t)t * 64 + f] = sinf(a.in[I_HF3][l * 64 + f] * s);
    __syncthreads();
}

__device__ __forceinline__ void transpose_item(const float* W, int ldw, int srccol0, int k0, bf16_t* WT, int K, int dstrow0, LAS float* scr, int lane) {
    if (srccol0 >= 0) {
#pragma unroll 8
        for (int i = 0; i < 32; ++i) { const int kk = 2 * i + (lane >> 5); scr[kk * 33 + (lane & 31)] = W[(size_t)(k0 + kk) * ldw + srccol0 + (lane & 31)]; }
    } else {
#pragma unroll 8
        for (int i = 0; i < 32; ++i) { const int kk = 2 * i + (lane >> 5); scr[kk * 33 + (lane & 31)] = 0.f; }
    }
    LDS_WAIT();
    const int c = lane & 7;
#pragma unroll
    for (int j = 0; j < 4; ++j) { const int n = (lane >> 3) + 8 * j; const LAS float* s = scr + (8 * c) * 33 + n;
        u32x4 o; o.x = pk2(s[0 * 33], s[1 * 33]); o.y = pk2(s[2 * 33], s[3 * 33]); o.z = pk2(s[4 * 33], s[5 * 33]); o.w = pk2(s[6 * 33], s[7 * 33]);
        *(u32x4*)(WT + (size_t)(dstrow0 + n) * K + k0 + 8 * c) = o; }
    LDS_WAIT();
}
__device__ __forceinline__ int win_srccol(int n) { return n < 6144 ? n : (n < 6656 ? n + 32 : (n < 6688 ? n - 512 : -1)); }

__device__ __forceinline__ void norm_row(const float* xrow, const float* nw, const float* mod, bf16_t* hrow, int lane) {
    f32x4 v[8]; float ss = 0.f;
#pragma unroll
    for (int j = 0; j < 8; ++j) { v[j] = ((const f32x4*)xrow)[lane + 64 * j]; ss += (v[j].x * v[j].x + v[j].y * v[j].y) + (v[j].z * v[j].z + v[j].w * v[j].w); }
    const float rstd = rsqrtf(wave_sum(ss) * (1.0f / D) + EPS);
#pragma unroll
    for (int j = 0; j < 8; ++j) { const int k = 4 * (lane + 64 * j);
        const f32x4 w = *(const f32x4*)(nw + k), sh = *(const f32x4*)(mod + k), sc = *(const f32x4*)(mod + D + k);
        const f32x4 o = v[j] * rstd * w * (sc + 1.0f) + sh;
        u32x2 pk; pk.x = pk2(o.x, o.y); pk.y = pk2(o.z, o.w);
        *(u32x2*)(hrow + k) = pk; }
}

__device__ __forceinline__ void fft_twiddles(LAS f32x2* W, int tid) {
    for (int j = tid; j < 4096; j += NT) { float s, c; sincospif(-(float)j * (1.0f / 4096.0f), &s, &c); W[j] = (f32x2){c, s}; }
}
template <int R, int BETA, bool INV> __device__ __forceinline__ void fft_pass(LAS f32x2* X, const LAS f32x2* W, int tid) {
    constexpr int LOW = BETA - R + 1, NG = FFTN >> R;
    for (int gi = tid; gi < NG; gi += NT) {
        const int base = ((gi >> LOW) << (BETA + 1)) | (gi & ((1 << LOW) - 1));
        f32x2 e[1 << R];
#pragma unroll
        for (int m = 0; m < (1 << R); ++m) e[m] = X[base + (m << LOW)];
#pragma unroll
        for (int ss = 0; ss < R; ++ss) {
            const int s = INV ? (R - 1 - ss) : ss; const int bit = BETA - s, h = 1 << (R - 1 - s);
#pragma unroll
            for (int m = 0; m < (1 << R); ++m) {
                if (m & h) continue;
                const int idx = base + (m << LOW); const int ex = (idx & ((1 << bit) - 1)) << (12 - bit);
                const f32x2 w = W[ex]; const f32x2 a_ = e[m], b_ = e[m | h];
                if (!INV) { const f32x2 d = a_ - b_; e[m] = a_ + b_; e[m | h] = (f32x2){d.x * w.x - d.y * w.y, d.x * w.y + d.y * w.x}; }
                else { const f32x2 t = (f32x2){b_.x * w.x + b_.y * w.y, b_.y * w.x - b_.x * w.y}; e[m] = a_ + t; e[m | h] = a_ - t; }
            }
        }
#pragma unroll
        for (int m = 0; m < (1 << R); ++m) X[base + (m << LOW)] = e[m];
    }
}
__device__ __forceinline__ void fft_forward(LAS f32x2* X, const LAS f32x2* W, int tid) {
    fft_pass<4, 12, false>(X, W, tid); __syncthreads(); fft_pass<3, 8, false>(X, W, tid); __syncthreads();
    fft_pass<3, 5, false>(X, W, tid); __syncthreads(); fft_pass<3, 2, false>(X, W, tid); __syncthreads();
}
__device__ __forceinline__ void fft_inverse(LAS f32x2* X, const LAS f32x2* W, int tid) {
    fft_pass<3, 2, true>(X, W, tid); __syncthreads(); fft_pass<3, 5, true>(X, W, tid); __syncthreads();
    fft_pass<3, 8, true>(X, W, tid); __syncthreads(); fft_pass<4, 12, true>(X, W, tid); __syncthreads();
}
__device__ __forceinline__ float block_sum(float v, LAS float* red, int tid) {
    v = wave_sum(v);
    if ((tid & 63) == 0) red[tid >> 6] = v;
    __syncthreads();
    float t = 0.f;
#pragma unroll
    for (int i = 0; i < NWAVES; ++i) t += red[i];
    __syncthreads();
    return t;
}
constexpr float HY_D0 = -3.0701134573253945f  , HY_D1 = -15.350567286626973f  ;

__device__ __forceinline__ void filt_item(const DArgs& a, unsigned char* ws, LAS unsigned char* lds, int l, int c, int tid) {
    LAS f32x2* X = (LAS f32x2*)lds; LAS f32x2* W = (LAS f32x2*)(lds + 65536); LAS float* w4s = (LAS float*)(lds + 98304); LAS float* red = (LAS float*)(lds + 98304 + 1024);
    LAS float* k1b = (LAS float*)(lds + 100352);
    fft_twiddles(W, tid);
    if (tid < 256) { const int cc = tid >> 6, f = tid & 63; w4s[tid] = a.in[I_HW4][(size_t)l * 64 * 2048 + (size_t)f * 2048 + (cc >> 1) * 1024 + (cc & 1) * 512 + c]; }
    __syncthreads();
    const float dl = fabsf(HY_D0 + (HY_D1 - HY_D0) * ((float)c / 511.0f));
    const float* H3 = (const float*)(ws + WS_H3) + (size_t)l * 4096 * 64;
    float ss0 = 0.f, ss1 = 0.f;
#pragma unroll 1
    for (int j = 0; j < 16; ++j) {
        const int n = tid + 512 * j; const int dir = j >= 8 ? 1 : 0; const int t = dir ? (8192 - n) : n;
        float s0 = 0.f, s1 = 0.f;
        if (n != 4096) {
            const f32x4* hr = (const f32x4*)(H3 + (size_t)t * 64);
#pragma unroll
            for (int q = 0; q < 16; ++q) { const f32x4 hv = hr[q]; const f32x4 wa = ((const LAS f32x4*)(w4s + (dir * 2 + 0) * 64))[q], wb = ((const LAS f32x4*)(w4s + (dir * 2 + 1) * 64))[q];
                s0 += (hv.x * wa.x + hv.y * wa.y) + (hv.z * wa.z + hv.w * wa.w); s1 += (hv.x * wb.x + hv.y * wb.y) + (hv.z * wb.z + hv.w * wb.w); }
            const float dec = expf(-((float)t / 4095.0f) * dl); s0 *= dec; s1 *= dec;
        }
        X[n] = (f32x2){s0, 0.f}; k1b[n] = s1; ss0 += s0 * s0; ss1 += s1 * s1;
    }
    const float rs0 = rsqrtf(block_sum(ss0, red, tid) + EPS), rs1 = rsqrtf(block_sum(ss1, red, tid) + EPS);
    f32x2* KF0 = (f32x2*)(ws + WS_KF) + (size_t)(0 * 512 + c) * FFTN; f32x2* KF1 = (f32x2*)(ws + WS_KF) + (size_t)(1 * 512 + c) * FFTN;
#pragma unroll 4
    for (int j = 0; j < 16; ++j) { const f32x2 x = X[tid + 512 * j]; X[tid + 512 * j] = (f32x2){x.x * rs0, 0.f}; }
    __syncthreads(); fft_forward(X, W, tid);
#pragma unroll 4
    for (int j = 0; j < 16; ++j) KF0[tid + 512 * j] = X[tid + 512 * j];
    __syncthreads();
#pragma unroll 4
    for (int j = 0; j < 16; ++j) X[tid + 512 * j] = (f32x2){k1b[tid + 512 * j] * rs1, 0.f};
    __syncthreads(); fft_forward(X, W, tid);
#pragma unroll 4
    for (int j = 0; j < 16; ++j) KF1[tid + 512 * j] = X[tid + 512 * j];
    __syncthreads();
}
__device__ __forceinline__ void filt_ctx_item(const DArgs& a, unsigned char* ws, LAS unsigned char* lds, int c, int tid) {
    LAS float* w4s = (LAS float*)lds; LAS float* red = (LAS float*)(lds + 1024);
    if (tid < 256) { const int cc = tid >> 6, f = tid & 63; w4s[tid] = a.in[I_HW4][(size_t)f * 2048 + (cc >> 1) * 1024 + (cc & 1) * 512 + c]; }
    __syncthreads();
    const float dl = fabsf(HY_D0 + (HY_D1 - HY_D0) * ((float)c / 511.0f));
    const float* H3C = (const float*)(ws + WS_H3C);
    const int n = tid, dir = n >= 256 ? 1 : 0, t = dir ? (512 - n) : n;
    float s0 = 0.f, s1 = 0.f;
    if (n != 256) {
        const f32x4* hr = (const f32x4*)(H3C + (size_t)t * 64);
#pragma unroll
        for (int q = 0; q < 16; ++q) { const f32x4 hv = hr[q]; const f32x4 wa = ((const LAS f32x4*)(w4s + (dir * 2 + 0) * 64))[q], wb = ((const LAS f32x4*)(w4s + (dir * 2 + 1) * 64))[q];
            s0 += (hv.x * wa.x + hv.y * wa.y) + (hv.z * wa.z + hv.w * wa.w); s1 += (hv.x * wb.x + hv.y * wb.y) + (hv.z * wb.z + hv.w * wb.w); }
        const float dec = expf(-((float)t / 255.0f) * dl); s0 *= dec; s1 *= dec;
    }
    const float rs0 = rsqrtf(block_sum(s0 * s0, red, tid) + EPS), rs1 = rsqrtf(block_sum(s1 * s1, red, tid) + EPS);
    float* KC = (float*)(ws + WS_KC);
    KC[(size_t)(0 * 512 + c) * 512 + n] = s0 * rs0; KC[(size_t)(1 * 512 + c) * 512 + n] = s1 * rs1;
    __syncthreads();
}

__device__ __forceinline__ void rope_row(const DArgs& a, unsigned char* ws, int l, int row, int lane) {
    bf16_t* P = (bf16_t*)(ws + WS_P) + (size_t)row * LDP;
    float ang;
    if (row < NLAT) { const int t = row & (SEQL - 1); const int j = lane & 31; const float inv = exp2f(-(float)j * (13.287712379549449f / 32.0f)); ang = (float)(lane < 32 ? (t >> 6) : (t & 63)) * inv; }
    else { const int t = (row - NLAT) & (LC - 1); const float inv = exp2f(-(float)lane * (13.287712379549449f / 64.0f)); ang = (float)t * inv; }
    float sn, cs; sincosf(ang, &sn, &cs);
    const float ksc = 0.08838834764831845f;
#pragma unroll
    for (int h = 0; h < 4; ++h) {
        bf16_t* q = P + PC_RQ + h * 128; bf16_t* k = P + PC_RK + h * 128;
        const float q1 = bf2f(q[lane]), q2 = bf2f(q[lane + 64]), k1 = bf2f(k[lane]), k2 = bf2f(k[lane + 64]);
        q[lane] = (bf16_t)f2bf(q1 * cs - q2 * sn); q[lane + 64] = (bf16_t)f2bf(q1 * sn + q2 * cs);
        k[lane] = (bf16_t)f2bf((k1 * cs - k2 * sn) * ksc); k[lane + 64] = (bf16_t)f2bf((k1 * sn + k2 * cs) * ksc);
    }
    const float* lr = (const float*)(ws + WS_LR) + (size_t)row * 32;
    bf16_t* GLG = (bf16_t*)(ws + WS_WIN);
#pragma unroll
    for (int dir = 0; dir < 2; ++dir) {
        const float* gw = a.in[I_GGW] + (size_t)(l * 2 + dir) * 16 * 256; const float* gb = a.in[I_GGB] + (size_t)(l * 2 + dir) * 256;
        float lrv[16];
#pragma unroll
        for (int j = 0; j < 16; ++j) lrv[j] = lr[dir * 16 + j];
#pragma unroll
        for (int q = 0; q < 4; ++q) { const int d = lane + 64 * q; float s = gb[d];
#pragma unroll
            for (int j = 0; j < 16; ++j) s += lrv[j] * gw[j * 256 + d];
            const float ls = (s >= 0.f) ? -log1pf(expf(-s)) : (s - log1pf(expf(s)));
            GLG[((size_t)dir * MR + row) * 256 + d] = (bf16_t)f2bf(ls * (1.0f / 16.0f)); }
    }
}

__device__ __forceinline__ void ret_chain(const bf16_t* P, bf16_t* O, int b, int h, int dir, bool ctx_out, int wave, int lane) {
    const int e = wave * 16 + (lane & 15), dq = lane >> 4;
    const float gamma = 1.0f - exp2f(-5.0f - (float)h);
    constexpr int TB = 2;
    float S[32];
#pragma unroll
    for (int i = 0; i < 32; ++i) S[i] = 0.f;
    for (int seg = 0; seg < 2; ++seg) {
        const int n = seg ? SEQL : LC, rowbase = seg ? b * SEQL : NLAT + b * LC; const bool wr_out = seg || ctx_out;
        for (int i0 = 0; i0 < n; i0 += TB) {
            u32x4 q[TB][4], k[TB][4]; bf16_t v[TB];
#pragma unroll
            for (int tb = 0; tb < TB; ++tb) { const int row = rowbase + (dir ? n - 1 - (i0 + tb) : i0 + tb); const bf16_t* pr = P + (size_t)row * LDP;
#pragma unroll
                for (int c4 = 0; c4 < 4; ++c4) { q[tb][c4] = ((const u32x4*)(pr + PC_RQ + h * 128 + dq * 32))[c4]; k[tb][c4] = ((const u32x4*)(pr + PC_RK + h * 128 + dq * 32))[c4]; }
                v[tb] = pr[PC_RV + h * 128 + e]; }
#pragma unroll
            for (int tb = 0; tb < TB; ++tb) {
                const int row = rowbase + (dir ? n - 1 - (i0 + tb) : i0 + tb);
                const float vf = bf2f(v[tb]); float o = 0.f;
#pragma unroll
                for (int c4 = 0; c4 < 4; ++c4) { float qf[8], kf[8]; unpack8(q[tb][c4], qf); unpack8(k[tb][c4], kf);
#pragma unroll
                    for (int x = 0; x < 8; ++x) { const int ix = c4 * 8 + x; S[ix] = gamma * S[ix] + kf[x] * vf; o += qf[x] * S[ix]; } }
                o += __shfl_xor(o, 16); o += __shfl_xor(o, 32);
                if (wr_out && dq == 0) O[(size_t)row * 512 + h * 128 + e] = (bf16_t)f2bf(o);
            }
        }
    }
}
__device__ __forceinline__ void gla_chain(const bf16_t* P, const bf16_t* GLGd, bf16_t* O, int b, int h, int dir, bool ctx_out, int wave, int lane) {
    const int e = wave * 16 + (lane & 15), dq = lane >> 4;
    constexpr int TB = 4;
    float S[16];
#pragma unroll
    for (int i = 0; i < 16; ++i) S[i] = 0.f;
    for (int seg = 0; seg < 2; ++seg) {
        const int n = seg ? SEQL : LC, rowbase = seg ? b * SEQL : NLAT + b * LC; const bool wr_out = seg || ctx_out;
        for (int i0 = 0; i0 < n; i0 += TB) {
            u32x4 q[TB][2], k[TB][2], g[TB][2]; bf16_t v[TB];
#pragma unroll
            for (int tb = 0; tb < TB; ++tb) { const int row = rowbase + (dir ? n - 1 - (i0 + tb) : i0 + tb); const bf16_t* pr = P + (size_t)row * LDP; const bf16_t* gr = GLGd + (size_t)row * 256 + h * 64 + dq * 16;
#pragma unroll
                for (int c4 = 0; c4 < 2; ++c4) { q[tb][c4] = ((const u32x4*)(pr + PC_GQ + h * 64 + dq * 16))[c4]; k[tb][c4] = ((const u32x4*)(pr + PC_GK + h * 64 + dq * 16))[c4]; g[tb][c4] = ((const u32x4*)gr)[c4]; }
                v[tb] = pr[PC_GV + h * 128 + e]; }
#pragma unroll
            for (int tb = 0; tb < TB; ++tb) {
                const int row = rowbase + (dir ? n - 1 - (i0 + tb) : i0 + tb);
                const float vf = bf2f(v[tb]); float o = 0.f;
#pragma unroll
                for (int c4 = 0; c4 < 2; ++c4) { float qf[8], kf[8], gf[8]; unpack8(q[tb][c4], qf); unpack8(k[tb][c4], kf); unpack8(g[tb][c4], gf);
#pragma unroll
                    for (int x = 0; x < 8; ++x) { const int ix = c4 * 8 + x; S[ix] = __expf(gf[x]) * S[ix] + kf[x] * vf; o += qf[x] * S[ix]; } }
                o += __shfl_xor(o, 16); o += __shfl_xor(o, 32);
                if (wr_out && dq == 0) O[(size_t)row * 512 + h * 128 + e] = (bf16_t)f2bf(o * 0.125f);
            }
        }
    }
}
__device__ __forceinline__ void s5_chain(const DArgs& a, unsigned char* ws, LAS unsigned char* lds, int l, int b, int g, int dir, bool ctx_out, int tid) {
    LAS f32x2* cs = (LAS f32x2*)lds; LAS f32x2* hs = (LAS f32x2*)(lds + 16 * 65 * 8); LAS float* us = (LAS float*)(lds + 2 * 16 * 65 * 8);
    const int wave = tid >> 6, lane = tid & 63;
    const int gi = (l * 2 + dir) * 32 + g;
    const float* cre = a.in[I_S5CRE] + (size_t)gi * 1024; const float* cim = a.in[I_S5CIM] + (size_t)gi * 1024;
    for (int idx = tid; idx < 1024; idx += NT) { const int i = idx >> 6, p = idx & 63; cs[i * 65 + p] = (f32x2){cre[idx], cim[idx]}; }
    f32x2 ab = {0.f, 0.f}; f32x2 bt[16]; f32x2 hst = {0.f, 0.f};
    if (wave == 0) { ab = ((const f32x2*)(ws + WS_S5AB))[gi * 64 + lane]; const f32x2* bp = (const f32x2*)(ws + WS_S5BT) + (size_t)(gi * 64 + lane) * 16;
#pragma unroll
        for (int i = 0; i < 16; ++i) bt[i] = bp[i]; }
    else {
#pragma unroll
        for (int i = 0; i < 16; ++i) bt[i] = (f32x2){0.f, 0.f}; }
    const bf16_t* P = (const bf16_t*)(ws + WS_P);
    bf16_t* Y = (bf16_t*)(ws + WS_OB) + (size_t)(4 + dir) * OBSZ;
    const int tt = tid >> 4, i = tid & 15;
    for (int seg = 0; seg < 2; ++seg) {
        const int n = seg ? SEQL : LC, rowbase = seg ? b * SEQL : NLAT + b * LC; const bool wr_out = seg || ctx_out;
        __syncthreads();
        if (tid < 256) us[tid] = bf2f(P[(size_t)(rowbase + (dir ? n - 1 - tt : tt)) * LDP + PC_S5U + g * 16 + i]);
        for (int bt0 = 0; bt0 < n; bt0 += 16) {
            const int ii = bt0 + tt; const int row = rowbase + (dir ? n - 1 - ii : ii);
            bf16_t unext = 0;
            if (tid < 256 && bt0 + 16 < n) { const int iin = ii + 16; unext = P[(size_t)(rowbase + (dir ? n - 1 - iin : iin)) * LDP + PC_S5U + g * 16 + i]; }
            __syncthreads();
            if (wave == 0) {
#pragma unroll 4
                for (int t2 = 0; t2 < 16; ++t2) {
                    float bur = 0.f, bui = 0.f;
#pragma unroll
                    for (int q = 0; q < 4; ++q) { const f32x4 u = ((const LAS f32x4*)(us + t2 * 16))[q];
                        bur += bt[4 * q].x * u.x + bt[4 * q + 1].x * u.y + bt[4 * q + 2].x * u.z + bt[4 * q + 3].x * u.w;
                        bui += bt[4 * q].y * u.x + bt[4 * q + 1].y * u.y + bt[4 * q + 2].y * u.z + bt[4 * q + 3].y * u.w; }
                    const float hr = ab.x * hst.x - ab.y * hst.y + bur, hi = ab.x * hst.y + ab.y * hst.x + bui;
                    hst = (f32x2){hr, hi};
                    hs[t2 * 65 + lane] = hst;
                }
            }
            __syncthreads();
            if (tid < 256) {
                us[tid] = bf2f(unext);
                float y = 0.f;
#pragma unroll 8
                for (int p = 0; p < 64; ++p) { const f32x2 cv = cs[i * 65 + p], hv = hs[tt * 65 + p]; y += cv.x * hv.x - cv.y * hv.y; }
                if (wr_out) Y[(size_t)row * 512 + g * 16 + i] = (bf16_t)f2bf(y);
            }
        }
    }
    __syncthreads();
}

__device__ __forceinline__ float sconv3(const bf16_t* p, int t, int Lx, float w0, float w1, float w2, float cb) {
    const float x0 = t > 0 ? bf2f(p[t - 1]) : 0.f, x1 = bf2f(p[t]), x2 = t < Lx - 1 ? bf2f(p[t + 1]) : 0.f;
    return w0 * x0 + w1 * x1 + w2 * x2 + cb;
}
__device__ __forceinline__ void hyena_item(const DArgs& a, unsigned char* ws, LAS unsigned char* lds, int l, int c, int tid) {
    LAS f32x2* X = (LAS f32x2*)lds; LAS f32x2* W = (LAS f32x2*)(lds + 65536);
    fft_twiddles(W, tid);
    const float* cw = a.in[I_HCW] + (size_t)l * 3 * 1536; const float* cbp = a.in[I_HCB] + (size_t)l * 1536;
    const float wv0 = cw[c], wv1 = cw[1536 + c], wv2 = cw[3072 + c], bv = cbp[c];
    const float wa0 = cw[512 + c], wa1 = cw[1536 + 512 + c], wa2 = cw[3072 + 512 + c], ba = cbp[512 + c];
    const float wb0 = cw[1024 + c], wb1 = cw[1536 + 1024 + c], wb2 = cw[3072 + 1024 + c], bb = cbp[1024 + c];
    const float bias0 = a.in[I_HBIAS][(l * 2 + 0) * 512 + c], bias1 = a.in[I_HBIAS][(l * 2 + 1) * 512 + c];
    const bf16_t* PT = (const bf16_t*)(ws + WS_PT);
    const bf16_t* pv = PT + (size_t)(PT_V + c) * MR; const bf16_t* pg1 = PT + (size_t)(PT_G1 + c) * MR; const bf16_t* pg2 = PT + (size_t)(PT_G2 + c) * MR; const bf16_t* phg = PT + (size_t)(PT_HG + c) * MR;
    const f32x2* KF0 = (const f32x2*)(ws + WS_KF) + (size_t)(0 * 512 + c) * FFTN; const f32x2* KF1 = (const f32x2*)(ws + WS_KF) + (size_t)(1 * 512 + c) * FFTN;
    bf16_t* GATED = (bf16_t*)(ws + WS_H);
    __syncthreads();
    for (int bp = 0; bp < 2; ++bp) {
        const int r0 = (2 * bp) * SEQL, r1 = (2 * bp + 1) * SEQL;
        float zr[8], zi[8];
#pragma unroll
        for (int j = 0; j < 8; ++j) { const int t = tid + 512 * j; zr[j] = sconv3(pv + r0, t, SEQL, wv0, wv1, wv2, bv); zi[j] = sconv3(pv + r1, t, SEQL, wv0, wv1, wv2, bv);
            X[t] = (f32x2){zr[j], zi[j]}; X[4096 + t] = (f32x2){0.f, 0.f}; if (j & 1) asm volatile("" ::: "memory"); }
        __syncthreads(); fft_forward(X, W, tid);
#pragma unroll 4
        for (int j = 0; j < 16; ++j) { const int pos = tid + 512 * j; const f32x2 x = X[pos], k = KF0[pos]; X[pos] = (f32x2){x.x * k.x - x.y * k.y, x.x * k.y + x.y * k.x}; }
        __syncthreads(); fft_inverse(X, W, tid);
#pragma unroll
        for (int j = 0; j < 8; ++j) { const int t = tid + 512 * j; const f32x2 cv = X[t] * (1.0f / 8192.0f);
            const float g1r = sconv3(pg1 + r0, t, SEQL, wa0, wa1, wa2, ba), g1i = sconv3(pg1 + r1, t, SEQL, wa0, wa1, wa2, ba);
            zr[j] = g1r * (cv.x + bias0 * zr[j]); zi[j] = g1i * (cv.y + bias0 * zi[j]); if (j & 1) asm volatile("" ::: "memory"); }
        __syncthreads();
#pragma unroll
        for (int j = 0; j < 8; ++j) { const int t = tid + 512 * j; X[t] = (f32x2){zr[j], zi[j]}; X[4096 + t] = (f32x2){0.f, 0.f}; }
        __syncthreads(); fft_forward(X, W, tid);
#pragma unroll 4
        for (int j = 0; j < 16; ++j) { const int pos = tid + 512 * j; const f32x2 x = X[pos], k = KF1[pos]; X[pos] = (f32x2){x.x * k.x - x.y * k.y, x.x * k.y + x.y * k.x}; }
        __syncthreads(); fft_inverse(X, W, tid);
#pragma unroll
        for (int j = 0; j < 8; ++j) { const int t = tid + 512 * j; const f32x2 cv = X[t] * (1.0f / 8192.0f);
            const float g2r = sconv3(pg2 + r0, t, SEQL, wb0, wb1, wb2, bb), g2i = sconv3(pg2 + r1, t, SEQL, wb0, wb1, wb2, bb);
            const float z2r = g2r * (cv.x + bias1 * zr[j]), z2i = g2i * (cv.y + bias1 * zi[j]);
            const float hg0 = bf2f(phg[r0 + t]), hg1 = bf2f(phg[r1 + t]);
            GATED[(size_t)(r0 + t) * D + 512 + c] = (bf16_t)f2bf(z2r * siluf_(hg0)); GATED[(size_t)(r1 + t) * D + 512 + c] = (bf16_t)f2bf(z2i * siluf_(hg1)); if (j & 1) asm volatile("" ::: "memory"); }
        __syncthreads();
    }
}
__device__ __forceinline__ void hyena_ctx_item(const DArgs& a, unsigned char* ws, LAS unsigned char* lds, int c, int tid) {
    LAS float* kc = (LAS float*)lds; LAS float* za = (LAS float*)(lds + 4096); LAS float* zb = (LAS float*)(lds + 8192);
    const float* KC = (const float*)(ws + WS_KC);
    kc[tid] = KC[(size_t)(0 * 512 + c) * 512 + tid]; kc[512 + tid] = KC[(size_t)(1 * 512 + c) * 512 + tid];
    const float* cw = a.in[I_HCW]; const float* cbp = a.in[I_HCB];
    const float wv0 = cw[c], wv1 = cw[1536 + c], wv2 = cw[3072 + c], bv = cbp[c];
    const float wa0 = cw[512 + c], wa1 = cw[1536 + 512 + c], wa2 = cw[3072 + 512 + c], ba = cbp[512 + c];
    const float wb0 = cw[1024 + c], wb1 = cw[1536 + 1024 + c], wb2 = cw[3072 + 1024 + c], bb = cbp[1024 + c];
    const float bias0 = a.in[I_HBIAS][0 * 512 + c], bias1 = a.in[I_HBIAS][1 * 512 + c];
    const bf16_t* PT = (const bf16_t*)(ws + WS_PT);
    const int b = tid >> 7, tt = tid & 127; const int rb = NLAT + b * LC;
    const bf16_t* pv = PT + (size_t)(PT_V + c) * MR + rb; const bf16_t* pg1 = PT + (size_t)(PT_G1 + c) * MR + rb; const bf16_t* pg2 = PT + (size_t)(PT_G2 + c) * MR + rb; const bf16_t* phg = PT + (size_t)(PT_HG + c) * MR + rb;
    bf16_t* GATED = (bf16_t*)(ws + WS_H);
    float z0[2], z1[2];
#pragma unroll
    for (int q = 0; q < 2; ++q) { const int t = tt + 128 * q; z0[q] = sconv3(pv, t, LC, wv0, wv1, wv2, bv); za[b * 256 + t] = z0[q]; }
    __syncthreads();
#pragma unroll
    for (int q = 0; q < 2; ++q) { const int t = tt + 128 * q; float s = 0.f;
        for (int sidx = 0; sidx < 256; ++sidx) s += kc[(t - sidx) & 511] * za[b * 256 + sidx];
        z1[q] = sconv3(pg1, t, LC, wa0, wa1, wa2, ba) * (s + bias0 * z0[q]); zb[b * 256 + t] = z1[q]; }
    __syncthreads();
#pragma unroll
    for (int q = 0; q < 2; ++q) { const int t = tt + 128 * q; float s = 0.f;
        for (int sidx = 0; sidx < 256; ++sidx) s += kc[512 + ((t - sidx) & 511)] * zb[b * 256 + sidx];
        const float z2 = sconv3(pg2, t, LC, wb0, wb1, wb2, bb) * (s + bias1 * z1[q]);
        GATED[(size_t)(rb + t) * D + 512 + c] = (bf16_t)f2bf(z2 * siluf_(bf2f(phg[t]))); }
    __syncthreads();
}

__device__ __forceinline__ void merge_row(const DArgs& a, unsigned char* ws, int l, int row, int lane) {
    const int col = 8 * lane;
    const bf16_t* OB = (const bf16_t*)(ws + WS_OB); const bf16_t* P = (const bf16_t*)(ws + WS_P) + (size_t)row * LDP;
    bf16_t* GATED = (bf16_t*)(ws + WS_H) + (size_t)row * D; bf16_t* G5 = (bf16_t*)(ws + WS_KF) + (size_t)row * 512;
    { float yf[8], yb[8], u[8], res[8];
      unpack8(*(const u32x4*)(OB + (size_t)4 * OBSZ + (size_t)row * 512 + col), yf); unpack8(*(const u32x4*)(OB + (size_t)5 * OBSZ + (size_t)row * 512 + col), yb);
      unpack8(*(const u32x4*)(P + PC_S5U + col), u);
      const float* dsk = a.in[I_S5D] + l * 512 + col;
#pragma unroll
      for (int x = 0; x < 8; ++x) res[x] = gelu_tanh(yf[x] + yb[x] + u[x] * dsk[x]);
      *(u32x4*)(G5 + col) = pack8(res); }
}

struct EpiInProj {
    static constexpr bool PERM = true, AFTER_DRAIN = false;
    bf16_t* P; bf16_t* PT; float* LR;
    __device__ __forceinline__ void operator()(const pg8::f32x4 (&acc)[2][2][4][2], const pg8::Unit& u, int wr, int wc, int fr, int fq) const {
        const int row0 = u.pm * 256 + wr * 64 + fr, pn = u.pn;
        if (pn < 4 || (pn >= 12 && pn < 26)) {
            const int colbase = (pn < 4 ? pn * 256 : pn * 256 - 2048) + wc * 32 + 8 * fq;
#pragma unroll
            for (int ai = 0; ai < 2; ++ai)
#pragma unroll
                for (int m = 0; m < 4; ++m) { bf16_t* rowp = P + (size_t)(row0 + ai * 128 + m * 16) * LDP + colbase;
#pragma unroll
                    for (int bj = 0; bj < 2; ++bj) { const pg8::f32x4 v0 = acc[ai][bj][m][0], v1 = acc[ai][bj][m][1];
                        u32x4 w; w.x = pk2(v0[0], v0[1]); w.y = pk2(v0[2], v0[3]); w.z = pk2(v1[0], v1[1]); w.w = pk2(v1[2], v1[3]);
                        *(u32x4*)(rowp + bj * 128) = w; } }
        } else if (pn < 12) {
            const int colbase = (pn - 4) * 256 + wc * 32 + 8 * fq;
#pragma unroll
            for (int bj = 0; bj < 2; ++bj)
#pragma unroll
                for (int n = 0; n < 2; ++n)
#pragma unroll
                    for (int j = 0; j < 4; ++j) { bf16_t* cp = PT + (size_t)(colbase + bj * 128 + 4 * n + j) * MR + row0;
#pragma unroll
                        for (int ai = 0; ai < 2; ++ai)
#pragma unroll
                            for (int m = 0; m < 4; ++m) cp[ai * 128 + m * 16] = (bf16_t)f2bf(acc[ai][bj][m][n][j]);
                        asm volatile("" ::: "memory"); }
        } else {
            if (wc == 0) {
#pragma unroll
                for (int ai = 0; ai < 2; ++ai)
#pragma unroll
                    for (int m = 0; m < 4; ++m) { float* rowp = LR + (size_t)(row0 + ai * 128 + m * 16) * 32 + 8 * fq;
                        *(pg8::f32x4*)(rowp) = acc[ai][0][m][0]; *(pg8::f32x4*)(rowp + 4) = acc[ai][0][m][1]; }
            }
        }
    }
};
struct EpiGlu {
    static constexpr bool PERM = true, AFTER_DRAIN = false;
    const bf16_t* G5; const bf16_t* P; bf16_t* GATED; const float* bias;
    __device__ __forceinline__ void operator()(const pg8::f32x4 (&acc)[2][2][4][2], const pg8::Unit& u, int wr, int wc, int fr, int fq) const {
        const int row0 = u.pm * 256 + wr * 64 + fr, col0 = u.pn * 256 + wc * 32 + 8 * fq;
#pragma unroll
        for (int ai = 0; ai < 2; ++ai)
#pragma unroll
            for (int m = 0; m < 4; ++m) { const size_t row = (size_t)(row0 + ai * 128 + m * 16);
#pragma unroll
                for (int bj = 0; bj < 2; ++bj) { const int col = col0 + bj * 128;
                    float g[8], sg[8], res[8]; unpack8(*(const u32x4*)(G5 + row * 512 + col), g); unpack8(*(const u32x4*)(P + row * LDP + PC_S5G + col), sg);
                    const pg8::f32x4 b0 = *(const pg8::f32x4*)(bias + col), b1 = *(const pg8::f32x4*)(bias + col + 4);
#pragma unroll
                    for (int j = 0; j < 4; ++j) { res[j] = g[j] * sigmoidf_(acc[ai][bj][m][0][j] + b0[j]) * siluf_(sg[j]); res[4 + j] = g[4 + j] * sigmoidf_(acc[ai][bj][m][1][j] + b1[j]) * siluf_(sg[4 + j]); }
                    *(u32x4*)(GATED + row * D + col) = pack8(res); } }
    }
};
struct EpiOut {
    static constexpr bool PERM = false, AFTER_DRAIN = false;
    const float* xl_old; const float* xc_old; float* xl_new; float* xc_new; const float* mod;
    __device__ __forceinline__ void operator()(const pg8::f32x4 (&acc)[2][2][4][2], const pg8::Unit& u, int wr, int wc, int fr, int fq) const {
        const int row0 = u.pm * 256 + wr * 64 + fr, col0 = u.pn * 256 + wc * 32 + 4 * fq;
        const bool lat = u.pm < 64;
        const float* xo = lat ? xl_old : xc_old - (size_t)NLAT * D; float* xn = lat ? xl_new : xc_new - (size_t)NLAT * D;
#pragma unroll
        for (int ai = 0; ai < 2; ++ai) {
            const int v = lat ? ((u.pm * 256 + ai * 128) >> 12) : 4;
            const float* gt = mod + (size_t)v * ADA + 2 * D;
#pragma unroll
            for (int m = 0; m < 4; ++m) { const size_t off = (size_t)(row0 + ai * 128 + m * 16) * D + col0;
#pragma unroll
                for (int bj = 0; bj < 2; ++bj)
#pragma unroll
                    for (int n = 0; n < 2; ++n) { const int cc = bj * 128 + n * 16; const pg8::f32x4 gv = *(const pg8::f32x4*)(gt + col0 + cc), xv = *(const pg8::f32x4*)(xo + off + cc);
                        *(pg8::f32x4*)(xn + off + cc) = xv + gv * acc[ai][bj][m][n]; } }
        }
    }
};
typedef short bf16x8 __attribute__((ext_vector_type(8)));
typedef short bf16x4 __attribute__((ext_vector_type(4)));
__device__ __forceinline__ unsigned off_b(unsigned row, unsigned ch) { return 256u * row + 16u * (ch ^ (((row & 3) << 2) | ((row >> 2) & 3))); }
__device__ __forceinline__ bf16x8 img_row_frag(const LAS unsigned char* img, unsigned lane, unsigned rb, unsigned s) { return *(const LAS bf16x8*)(img + off_b((lane & 15) + 16 * rb, 4 * s + (lane >> 4))); }
__device__ __forceinline__ bf16x4 img_tr4(const LAS unsigned char* img, unsigned lane, unsigned c, unsigned row0) {
    const unsigned q = (lane & 15) >> 2, p = lane & 3;
    return __builtin_amdgcn_ds_read_tr16_b64_v4i16((LAS bf16x4*)(img + off_b(row0 + q, 2 * c + (p >> 1)) + 8 * (p & 1)));
}
__device__ __forceinline__ bf16x8 img_tr_frag(const LAS unsigned char* img, unsigned lane, unsigned c, unsigned ks) {
    const unsigned g = lane >> 4; const bf16x4 lo = img_tr4(img, lane, c, 32 * ks + 8 * g), hi = img_tr4(img, lane, c, 32 * ks + 8 * g + 4);
    return __builtin_shufflevector(lo, hi, 0, 1, 2, 3, 4, 5, 6, 7);
}
__device__ __forceinline__ bf16x8 img_tr_frag_acc(const LAS unsigned char* img, unsigned lane, unsigned c, unsigned ks) {
    const unsigned g = lane >> 4; const bf16x4 lo = img_tr4(img, lane, c, 32 * ks + 4 * g), hi = img_tr4(img, lane, c, 32 * ks + 16 + 4 * g);
    return __builtin_shufflevector(lo, hi, 0, 1, 2, 3, 4, 5, 6, 7);
}
__device__ __forceinline__ bf16x8 acc_pair_frag(const f32x4 a0, const f32x4 a1) {
    u32x4 w; w.x = pk2(a0.x, a0.y); w.y = pk2(a0.z, a0.w); w.z = pk2(a1.x, a1.y); w.w = pk2(a1.z, a1.w);
    return __builtin_bit_cast(bf16x8, w);
}
#define MFMA16(A_, B_, C_) __builtin_amdgcn_mfma_f32_16x16x32_bf16((A_), (B_), (C_), 0, 0, 0)
__device__ __forceinline__ void stage_tile128(LAS unsigned char* img, const bf16_t* g, size_t ld, int tid) {
#pragma unroll
    for (int i = 0; i < 4; ++i) { const int n = tid + NT * i, row = n >> 4, ch = n & 15; *(LAS u32x4*)(img + off_b(row, ch)) = *(const u32x4*)(g + (size_t)row * ld + ch * 8); }
}

constexpr int RCH = 128, RNCH = 34;
constexpr size_t WS_RST = WS_OB;
__device__ __forceinline__ int ret_rowbase(int b, int cc) { return cc < 2 ? NLAT + b * LC + cc * RCH : b * SEQL + (cc - 2) * RCH; }
__device__ __forceinline__ float ret_log2g(int h) { return log2f(1.0f - exp2f(-5.0f - (float)h)); }

__device__ __forceinline__ void ret_passA(unsigned char* ws, LAS unsigned char* lds, int item, int tid) {
    const int bh = item / RNCH, cc = item % RNCH, b = bh >> 2, h = bh & 3;
    const int lane = tid & 63, w = tid >> 6, g = lane >> 4;
    LAS unsigned char* KF = lds; LAS unsigned char* KB = lds + 32768; LAS unsigned char* VI = lds + 65536;
    const bf16_t* P = (const bf16_t*)(ws + WS_P) + (size_t)ret_rowbase(b, cc) * LDP;
    const float l2g = ret_log2g(h);
    __syncthreads();
#pragma unroll
    for (int i = 0; i < 4; ++i) { const int n = tid + NT * i, row = n >> 4, ch = n & 15;
        const u32x4 kr = *(const u32x4*)(P + (size_t)row * LDP + PC_RK + h * 128 + ch * 8);
        float kf[8], a[8], c[8]; unpack8(kr, kf);
        const float sf = exp2f(l2g * (float)(RCH - 1 - row)), sb = exp2f(l2g * (float)row);
#pragma unroll
        for (int x = 0; x < 8; ++x) { a[x] = kf[x] * sf; c[x] = kf[x] * sb; }
        *(LAS u32x4*)(KF + off_b(row, ch)) = pack8(a); *(LAS u32x4*)(KB + off_b(row, ch)) = pack8(c);
        *(LAS u32x4*)(VI + off_b(row, ch)) = *(const u32x4*)(P + (size_t)row * LDP + PC_RV + h * 128 + ch * 8); }
    __syncthreads();
    bf16x8 af[4], ab[4];
#pragma unroll
    for (int ks = 0; ks < 4; ++ks) { af[ks] = img_tr_frag(KF, lane, w, ks); ab[ks] = img_tr_frag(KB, lane, w, ks); }
    bf16_t* ST = (bf16_t*)(ws + WS_RST) + ((size_t)(bh * 2) * RNCH + cc) * (128 * 128);
#pragma unroll 2
    for (int E = 0; E < 8; ++E) {
        f32x4 cf = {0.f, 0.f, 0.f, 0.f}, cb = {0.f, 0.f, 0.f, 0.f};
#pragma unroll
        for (int ks = 0; ks < 4; ++ks) { const bf16x8 vb = img_tr_frag(VI, lane, E, ks); cf = MFMA16(af[ks], vb, cf); cb = MFMA16(ab[ks], vb, cb); }
        const int e = 16 * E + (lane & 15), d0 = 16 * w + 4 * g;
        u32x2 o; o.x = pk2(cf.x, cf.y); o.y = pk2(cf.z, cf.w); *(u32x2*)(ST + (size_t)e * 128 + d0) = o;
        o.x = pk2(cb.x, cb.y); o.y = pk2(cb.z, cb.w); *(u32x2*)(ST + (size_t)RNCH * 128 * 128 + (size_t)e * 128 + d0) = o;
    }
}
__device__ __forceinline__ void ret_passB(unsigned char* ws, int gt  ) {
    if (gt >= 16 * 2 * 2048) return;
    const int el = gt & 2047, bd = gt >> 11, bh = bd >> 1, dir = bd & 1, h = bh & 3;
    const float gC = exp2f(ret_log2g(h) * (float)RCH);
    bf16_t* base = (bf16_t*)(ws + WS_RST) + (size_t)bd * RNCH * (128 * 128) + (size_t)el * 8;
    float acc[8];
#pragma unroll
    for (int x = 0; x < 8; ++x) acc[x] = 0.f;
#pragma unroll 2
    for (int s = 0; s < RNCH; ++s) {
        const int cc = dir == 0 ? s : (s < 2 ? 1 - s : 35 - s);
        u32x4* p = (u32x4*)(base + (size_t)cc * (128 * 128));
        float kv[8]; unpack8(*p, kv);
        *p = pack8(acc);
#pragma unroll
        for (int x = 0; x < 8; ++x) acc[x] = gC * acc[x] + kv[x];
    }
}
__device__ __forceinline__ void ret_passC(const DArgs& a, unsigned char* ws, LAS unsigned char* lds, int l, int item, int tid) {
    const int bh = item / RNCH, cc = item % RNCH, b = bh >> 2, h = bh & 3;
    const int lane = tid & 63, w = tid >> 6, g = lane >> 4, il = lane & 15;
    LAS unsigned char* KI = lds; LAS unsigned char* VI = lds + 32768; LAS unsigned char* SF = lds + 65536; LAS unsigned char* SB = lds + 98304;
    const int rowbase = ret_rowbase(b, cc);
    const bf16_t* P = (const bf16_t*)(ws + WS_P) + (size_t)rowbase * LDP;
    const bf16_t* STf = (const bf16_t*)(ws + WS_RST) + ((size_t)(bh * 2) * RNCH + cc) * (128 * 128);
    const bf16_t* STb = STf + (size_t)RNCH * 128 * 128;
    __syncthreads();
    stage_tile128(KI, P + PC_RK + h * 128, LDP, tid); stage_tile128(VI, P + PC_RV + h * 128, LDP, tid);
    stage_tile128(SF, STf, 128, tid); stage_tile128(SB, STb, 128, tid);
    bf16x8 qf[4];
    { const bf16_t* qr = P + (size_t)(16 * w + il) * LDP + PC_RQ + h * 128 + 8 * g;
#pragma unroll
      for (int ks = 0; ks < 4; ++ks) qf[ks] = *(const bf16x8*)(qr + 32 * ks); }
    __syncthreads();
    const float l2g = ret_log2g(h);
    const int iloc = 16 * w + il;
    f32x4 o[8];
    { const float sf = exp2f(l2g * (float)(iloc + 1)), sb = exp2f(l2g * (float)(RCH - iloc));
#pragma unroll
      for (int E = 0; E < 8; ++E) { f32x4 rf = {0.f, 0.f, 0.f, 0.f}, rb = {0.f, 0.f, 0.f, 0.f};
#pragma unroll
          for (int ks = 0; ks < 4; ++ks) { rf = MFMA16(img_row_frag(SF, lane, E, ks), qf[ks], rf); rb = MFMA16(img_row_frag(SB, lane, E, ks), qf[ks], rb); }
          o[E] = rf * sf + rb * sb; } }
    f32x4 at[8];
#pragma unroll
    for (int T = 0; T < 8; ++T) { f32x4 c = {0.f, 0.f, 0.f, 0.f};
#pragma unroll
        for (int ks = 0; ks < 4; ++ks) c = MFMA16(img_row_frag(KI, lane, T, ks), qf[ks], c);
#pragma unroll
        for (int r = 0; r < 4; ++r) { const int j = 16 * T + 4 * g + r; const int dd = iloc > j ? iloc - j : j - iloc; c[r] *= (dd == 0 ? 2.0f : exp2f(l2g * (float)dd)); }
        at[T] = c; }
#pragma unroll
    for (int s = 0; s < 4; ++s) { const bf16x8 bfr = acc_pair_frag(at[2 * s], at[2 * s + 1]);
#pragma unroll
        for (int E = 0; E < 8; ++E) o[E] = MFMA16(img_tr_frag_acc(VI, lane, E, s), bfr, o[E]); }
    float ss = 0.f;
#pragma unroll
    for (int E = 0; E < 8; ++E) ss += (o[E].x * o[E].x + o[E].y * o[E].y) + (o[E].z * o[E].z + o[E].w * o[E].w);
    ss += __shfl_xor(ss, 16); ss += __shfl_xor(ss, 32);
    const float rn = rsqrtf(ss * (1.0f / 128.0f) + EPS);
    const size_t row = (size_t)rowbase + iloc;
    const bf16_t* gp = (const bf16_t*)(ws + WS_P) + row * LDP + PC_RG + h * 128 + 4 * g;
    const float* nw = a.in[I_RNW] + l * 512 + h * 128 + 4 * g;
    bf16_t* op = (bf16_t*)(ws + WS_H) + row * D + 1024 + h * 128 + 4 * g;
#pragma unroll
    for (int E = 0; E < 8; ++E) { const u32x2 gr = *(const u32x2*)(gp + 16 * E); const f32x4 nv = *(const f32x4*)(nw + 16 * E);
        u32x2 ov; ov.x = pk2(o[E].x * rn * nv.x * siluf_(bflo(gr.x)), o[E].y * rn * nv.y * siluf_(bfhi(gr.x)));
        ov.y = pk2(o[E].z * rn * nv.z * siluf_(bflo(gr.y)), o[E].w * rn * nv.w * siluf_(bfhi(gr.y)));
        *(u32x2*)(op + 16 * E) = ov; }
}
constexpr int GCH = 64, GNCH = 68;
constexpr size_t WS_GST = WS_OB + (size_t)2 * OBSZ * 2;
constexpr size_t WS_GDEC = WS_END;
constexpr size_t WS_END2 = WS_GDEC + (size_t)16 * 2 * GNCH * 64 * 4;
__device__ __forceinline__ int gla_rowbase(int b, int cg) { return cg < 4 ? NLAT + b * LC + cg * GCH : b * SEQL + (cg - 4) * GCH; }

__device__ __forceinline__ void gla_gates(const DArgs& a, unsigned char* ws, LAS float* BF, LAS float* BB, int l, int h, int rowbase, int tid) {
    const int t = tid >> 3, d8 = tid & 7;
    const float* lr = (const float*)(ws + WS_LR) + (size_t)(rowbase + t) * 32;
    f32x4 lv[8];
#pragma unroll
    for (int q = 0; q < 8; ++q) lv[q] = ((const f32x4*)lr)[q];
#pragma unroll
    for (int dir = 0; dir < 2; ++dir) {
        const float* gw = a.in[I_GGW] + (size_t)(l * 2 + dir) * 16 * 256 + h * 64 + 8 * d8; const float* gb = a.in[I_GGB] + (size_t)(l * 2 + dir) * 256 + h * 64 + 8 * d8;
        f32x4 s0 = *(const f32x4*)gb, s1 = *(const f32x4*)(gb + 4);
#pragma unroll
        for (int j = 0; j < 16; ++j) { const float lj = lv[dir * 4 + (j >> 2)][j & 3]; s0 += lj * *(const f32x4*)(gw + j * 256); s1 += lj * *(const f32x4*)(gw + j * 256 + 4); }
        LAS float* dst = (dir ? BB : BF) + t * 64 + 8 * d8;
#pragma unroll
        for (int x = 0; x < 8; ++x) { const float s = x < 4 ? s0[x] : s1[x - 4]; const float ls = (s >= 0.f) ? -log1pf(__expf(-s)) : (s - log1pf(__expf(s))); dst[x] = ls * (1.0f / 16.0f); }
    }
    __syncthreads();
    if (tid < 128) { const int dir = tid >> 6, d = tid & 63; float run = 0.f;
        if (dir == 0) { for (int tt = 0; tt < 64; ++tt) { run += BF[tt * 64 + d]; BF[tt * 64 + d] = run; } }
        else { for (int tt = 63; tt >= 0; --tt) { run += BB[tt * 64 + d]; BB[tt * 64 + d] = run; } } }
    __syncthreads();
}

__device__ __forceinline__ void gla_passA(const DArgs& a, unsigned char* ws, LAS unsigned char* lds, int l, int item, int tid) {
    const int bh = item / GNCH, cg = item % GNCH, b = bh >> 2, h = bh & 3;
    const int lane = tid & 63, w = tid >> 6, g = lane >> 4;
    LAS float* BF = (LAS float*)lds; LAS float* BB = (LAS float*)(lds + 16384); LAS unsigned char* KH = lds + 32768; LAS unsigned char* VI = lds + 49152;
    const int rowbase = gla_rowbase(b, cg);
    gla_gates(a, ws, BF, BB, l, h, rowbase, tid);
    const bf16_t* P = (const bf16_t*)(ws + WS_P) + (size_t)rowbase * LDP;
    { const int t = tid >> 3, d8 = tid & 7;
      float kf[8], x0[8], x1[8]; unpack8(*(const u32x4*)(P + (size_t)t * LDP + PC_GK + h * 64 + 8 * d8), kf);
#pragma unroll
      for (int x = 0; x < 8; ++x) { const int d = 8 * d8 + x; x0[x] = kf[x] * __expf(BF[63 * 64 + d] - BF[t * 64 + d]); x1[x] = kf[x] * __expf(BB[d] - BB[t * 64 + d]); }
      *(LAS u32x4*)(KH + off_b(t, d8)) = pack8(x0); *(LAS u32x4*)(KH + off_b(t, 8 + d8)) = pack8(x1);
#pragma unroll
      for (int i = 0; i < 2; ++i) { const int n = tid + NT * i, row = n >> 4, ch = n & 15; *(LAS u32x4*)(VI + off_b(row, ch)) = *(const u32x4*)(P + (size_t)row * LDP + PC_GV + h * 128 + ch * 8); }
      if (tid < 128) { const int dir = tid >> 6, d = tid & 63; ((float*)(ws + WS_GDEC))[((size_t)(bh * 2 + dir) * GNCH + cg) * 64 + d] = __expf(dir ? BB[d] : BF[63 * 64 + d]); } }
    __syncthreads();
    const int dir = w >> 2, Dt = w & 3;
    bf16x8 af[2];
#pragma unroll
    for (int ks = 0; ks < 2; ++ks) af[ks] = img_tr_frag(KH, lane, dir * 4 + Dt, ks);
    bf16_t* ST = (bf16_t*)(ws + WS_GST) + ((size_t)(bh * 2 + dir) * GNCH + cg) * (128 * 64);
#pragma unroll 2
    for (int E = 0; E < 8; ++E) {
        f32x4 c = {0.f, 0.f, 0.f, 0.f};
#pragma unroll
        for (int ks = 0; ks < 2; ++ks) c = MFMA16(af[ks], img_tr_frag(VI, lane, E, ks), c);
        u32x2 o; o.x = pk2(c.x, c.y); o.y = pk2(c.z, c.w);
        *(u32x2*)(ST + (size_t)(16 * E + (lane & 15)) * 64 + 16 * Dt + 4 * g) = o;
    }
}
__device__ __forceinline__ void gla_passB(unsigned char* ws, int gt) {
    if (gt >= 16 * 2 * 1024) return;
    const int el = gt & 1023, bd = gt >> 10, dir = bd & 1;
    bf16_t* base = (bf16_t*)(ws + WS_GST) + (size_t)bd * GNCH * (128 * 64) + (size_t)el * 8;
    const float* dec = (const float*)(ws + WS_GDEC) + (size_t)bd * GNCH * 64 + (el & 7) * 8;
    float acc[8];
#pragma unroll
    for (int x = 0; x < 8; ++x) acc[x] = 0.f;
#pragma unroll 2
    for (int s = 0; s < GNCH; ++s) {
        const int cg = dir == 0 ? s : (s < 4 ? 3 - s : 71 - s);
        u32x4* p = (u32x4*)(base + (size_t)cg * (128 * 64));
        float kv[8]; unpack8(*p, kv);
        const f32x4 d0 = *(const f32x4*)(dec + cg * 64), d1 = *(const f32x4*)(dec + cg * 64 + 4);
        *p = pack8(acc);
#pragma unroll
        for (int x = 0; x < 8; ++x) acc[x] = (x < 4 ? d0[x] : d1[x - 4]) * acc[x] + kv[x];
    }
}
__device__ __forceinline__ void gla_passC(const DArgs& a, unsigned char* ws, LAS unsigned char* lds, int l, int item, int tid) {
    const int bh = item / GNCH, cg = item % GNCH, b = bh >> 2, h = bh & 3;
    const int lane = tid & 63, w = tid >> 6, g = lane >> 4, il = lane & 15;
    LAS float* BF = (LAS float*)lds; LAS float* BB = (LAS float*)(lds + 16384);
    LAS unsigned char* QKF = lds + 32768; LAS unsigned char* QKB = lds + 49152; LAS unsigned char* QH = lds + 65536; LAS unsigned char* VI = lds + 81920; LAS unsigned char* SI = lds + 98304;
    const int rowbase = gla_rowbase(b, cg);
    gla_gates(a, ws, BF, BB, l, h, rowbase, tid);
    const bf16_t* P = (const bf16_t*)(ws + WS_P) + (size_t)rowbase * LDP;
    { const int t = tid >> 3, d8 = tid & 7;
      float qf[8], kf[8], o0[8], o1[8], o2[8], o3[8], o4[8], o5[8];
      unpack8(*(const u32x4*)(P + (size_t)t * LDP + PC_GQ + h * 64 + 8 * d8), qf); unpack8(*(const u32x4*)(P + (size_t)t * LDP + PC_GK + h * 64 + 8 * d8), kf);
#pragma unroll
      for (int x = 0; x < 8; ++x) { const int d = 8 * d8 + x; const float bf = BF[t * 64 + d], bb = BB[t * 64 + d], rf = BF[31 * 64 + d], rb = BB[32 * 64 + d]; const float q = qf[x] * 0.125f;
          o0[x] = q * __expf(bf - rf); o1[x] = kf[x] * __expf(rf - bf); o2[x] = q * __expf(bb - rb); o3[x] = kf[x] * __expf(rb - bb); o4[x] = q * __expf(bf); o5[x] = q * __expf(bb); }
      *(LAS u32x4*)(QKF + off_b(t, d8)) = pack8(o0); *(LAS u32x4*)(QKF + off_b(t, 8 + d8)) = pack8(o1);
      *(LAS u32x4*)(QKB + off_b(t, d8)) = pack8(o2); *(LAS u32x4*)(QKB + off_b(t, 8 + d8)) = pack8(o3);
      *(LAS u32x4*)(QH + off_b(t, d8)) = pack8(o4); *(LAS u32x4*)(QH + off_b(t, 8 + d8)) = pack8(o5);
#pragma unroll
      for (int i = 0; i < 2; ++i) { const int n = tid + NT * i, row = n >> 4, ch = n & 15; *(LAS u32x4*)(VI + off_b(row, ch)) = *(const u32x4*)(P + (size_t)row * LDP + PC_GV + h * 128 + ch * 8); }
      const bf16_t* STf = (const bf16_t*)(ws + WS_GST) + ((size_t)(bh * 2) * GNCH + cg) * (128 * 64); const bf16_t* STb = STf + (size_t)GNCH * 128 * 64;
#pragma unroll
      for (int i = 0; i < 4; ++i) { const int n = tid + NT * i, row = n >> 4, ch = n & 15; *(LAS u32x4*)(SI + off_b(row, ch)) = *(const u32x4*)((ch < 8 ? STf : STb) + (size_t)row * 64 + (ch & 7) * 8); } }
    __syncthreads();
    const int ib = w & 3, eh = w >> 2, iloc = 16 * ib + il;
    f32x4 at[4];
    { bf16x8 qff[2], qfb[2];
#pragma unroll
      for (int ks = 0; ks < 2; ++ks) { qff[ks] = img_row_frag(QKF, lane, ib, ks); qfb[ks] = img_row_frag(QKB, lane, ib, ks); }
#pragma unroll
      for (int T = 0; T < 4; ++T) { f32x4 cf = {0.f, 0.f, 0.f, 0.f}, cb = {0.f, 0.f, 0.f, 0.f};
#pragma unroll
          for (int ks = 0; ks < 2; ++ks) { cf = MFMA16(img_row_frag(QKF, lane, T, 2 + ks), qff[ks], cf); cb = MFMA16(img_row_frag(QKB, lane, T, 2 + ks), qfb[ks], cb); }
#pragma unroll
          for (int r = 0; r < 4; ++r) { const int j = 16 * T + 4 * g + r; cf[r] = (j <= iloc ? cf[r] : 0.f) + (j >= iloc ? cb[r] : 0.f); }
          at[T] = cf; } }
    f32x4 o[4];
    { bf16x8 hf[2], hb[2];
#pragma unroll
      for (int ks = 0; ks < 2; ++ks) { hf[ks] = img_row_frag(QH, lane, ib, ks); hb[ks] = img_row_frag(QH, lane, ib, 2 + ks); }
#pragma unroll
      for (int E4 = 0; E4 < 4; ++E4) { const int E = 4 * eh + E4; f32x4 c = {0.f, 0.f, 0.f, 0.f};
#pragma unroll
          for (int ks = 0; ks < 2; ++ks) { c = MFMA16(img_row_frag(SI, lane, E, ks), hf[ks], c); c = MFMA16(img_row_frag(SI, lane, E, 2 + ks), hb[ks], c); }
          o[E4] = c; } }
#pragma unroll
    for (int s = 0; s < 2; ++s) { const bf16x8 bfr = acc_pair_frag(at[2 * s], at[2 * s + 1]);
#pragma unroll
        for (int E4 = 0; E4 < 4; ++E4) o[E4] = MFMA16(img_tr_frag_acc(VI, lane, 4 * eh + E4, s), bfr, o[E4]); }
    float ss = 0.f;
#pragma unroll
    for (int E4 = 0; E4 < 4; ++E4) ss += (o[E4].x * o[E4].x + o[E4].y * o[E4].y) + (o[E4].z * o[E4].z + o[E4].w * o[E4].w);
    ss += __shfl_xor(ss, 16); ss += __shfl_xor(ss, 32);
    LAS float* red = (LAS float*)lds;
    if (g == 0) red[eh * 64 + iloc] = ss;
    __syncthreads();
    const float rn = rsqrtf((red[iloc] + red[64 + iloc]) * (1.0f / 128.0f) + EPS);
    const size_t row = (size_t)rowbase + iloc;
    const bf16_t* gp = (const bf16_t*)(ws + WS_P) + row * LDP + PC_GG + h * 128 + 64 * eh + 4 * g;
    const float* nw = a.in[I_GNW] + l * 512 + h * 128 + 64 * eh + 4 * g;
    bf16_t* op = (bf16_t*)(ws + WS_H) + row * D + 1536 + h * 128 + 64 * eh + 4 * g;
#pragma unroll
    for (int E4 = 0; E4 < 4; ++E4) { const u32x2 gr = *(const u32x2*)(gp + 16 * E4); const f32x4 nv = *(const f32x4*)(nw + 16 * E4);
        u32x2 ov; ov.x = pk2(o[E4].x * rn * nv.x * siluf_(bflo(gr.x)), o[E4].y * rn * nv.y * siluf_(bfhi(gr.x)));
        ov.y = pk2(o[E4].z * rn * nv.z * siluf_(bflo(gr.y)), o[E4].w * rn * nv.w * siluf_(bfhi(gr.y)));
        *(u32x2*)(op + 16 * E4) = ov; }
}
constexpr int SNCH = 68;
constexpr size_t WS_S5ST = WS_OB + (size_t)4 * OBSZ * 2;
constexpr size_t WS_S5BTB = WS_S5BT;
constexpr size_t WS_S5CPB = WS_S5BT + 524288;
constexpr size_t WS_S5A64 = WS_S5BT + 1048576;

__device__ __forceinline__ void prep_s5b(const DArgs& a, unsigned char* ws, int it, int tid) {
    const int idx = it * 512 + tid;
    const int gi = idx >> 6, p = idx & 63;
    const float a_re = a.in[I_S5ARE][idx], a_im = a.in[I_S5AIM][idx], ldt = a.in[I_S5LDT][gi];
    const float dt = expf(ldt), mag = expf(a_re * dt);
    float sn, cs; sincosf(a_im * dt, &sn, &cs);
    const float ab_re = mag * cs, ab_im = mag * sn, den = a_re * a_re + a_im * a_im, nr = ab_re - 1.0f;
    const float co_re = (nr * a_re + ab_im * a_im) / den, co_im = (ab_im * a_re - nr * a_im) / den;
    ((f32x2*)(ws + WS_S5AB))[idx] = (f32x2){ab_re, ab_im};
    float pr = ab_re, pi = ab_im;
#pragma unroll
    for (int q = 0; q < 6; ++q) { const float nr2 = pr * pr - pi * pi, ni2 = 2.0f * pr * pi; pr = nr2; pi = ni2; }
    ((f32x2*)(ws + WS_S5A64))[idx] = (f32x2){pr, pi};
    const float* bre = a.in[I_S5BRE] + (size_t)idx * 16; const float* bim = a.in[I_S5BIM] + (size_t)idx * 16;
    float tr[16], ti[16];
#pragma unroll
    for (int i = 0; i < 16; ++i) { const float br = bre[i], bi = bim[i]; tr[i] = co_re * br - co_im * bi; ti[i] = co_re * bi + co_im * br; }
    bf16_t* btb = (bf16_t*)(ws + WS_S5BTB) + (size_t)gi * 128 * 16;
#pragma unroll
    for (int hlf = 0; hlf < 2; ++hlf) { u32x4 w0, w1; const float* s = hlf ? ti : tr;
        w0.x = pk2(s[0], s[1]); w0.y = pk2(s[2], s[3]); w0.z = pk2(s[4], s[5]); w0.w = pk2(s[6], s[7]); w1.x = pk2(s[8], s[9]); w1.y = pk2(s[10], s[11]); w1.z = pk2(s[12], s[13]); w1.w = pk2(s[14], s[15]);
        *(u32x4*)(btb + (size_t)(64 * hlf + p) * 16) = w0; *(u32x4*)(btb + (size_t)(64 * hlf + p) * 16 + 8) = w1; }
    bf16_t* cpb = (bf16_t*)(ws + WS_S5CPB) + (size_t)gi * 16 * 128;
    const float* cre = a.in[I_S5CRE] + (size_t)gi * 1024; const float* cim = a.in[I_S5CIM] + (size_t)gi * 1024;
#pragma unroll
    for (int i = 0; i < 16; ++i) { cpb[i * 128 + p] = (bf16_t)f2bf(cre[i * 64 + p]); cpb[i * 128 + 64 + p] = (bf16_t)f2bf(-cim[i * 64 + p]); }
}

template <bool PASSC> __device__ __forceinline__ void s5_item(const DArgs& a, unsigned char* ws, LAS unsigned char* lds, int l, int item, int tid) {
    const int b = item / (SNCH * 2), rem = item % (SNCH * 2), cs = rem >> 1, half = rem & 1;
    const int lane = tid & 63, w = tid >> 6, g = lane >> 4, il = lane & 15;
    const int rowbase = gla_rowbase(b, cs);
    LAS float* BU = (LAS float*)(lds + w * 14336); LAS unsigned char* HW = lds + w * 14336 + 10240;
    const bf16_t* P = (const bf16_t*)(ws + WS_P);
    f32x2* ST = (f32x2*)(ws + WS_S5ST);
    const bf16x8 zero8 = {0, 0, 0, 0, 0, 0, 0, 0};
#pragma unroll 1
    for (int gg = 0; gg < 2; ++gg) {
        const int grp = 16 * half + 8 * gg + w;
        f32x4 yacc[4];
#pragma unroll
        for (int q = 0; q < 4; ++q) yacc[q] = (f32x4){0.f, 0.f, 0.f, 0.f};
#pragma unroll
        for (int dir = 0; dir < 2; ++dir) {
            const int gi = (l * 2 + dir) * 32 + grp;
            const f32x2 ab = ((const f32x2*)(ws + WS_S5AB))[gi * 64 + lane];
            const size_t sidx = ((size_t)(b * SNCH + cs) * 2 + dir) * 2048 + grp * 64 + lane;
            f32x2 h = PASSC ? ST[sidx] : (f32x2){0.f, 0.f};
            bf16x8 btf[8], cpf[4];
            { const bf16_t* bt = (const bf16_t*)(ws + WS_S5BTB) + (size_t)gi * 128 * 16 + (size_t)il * 16 + 8 * (g & 1);
#pragma unroll
              for (int Pt = 0; Pt < 8; ++Pt) { const bf16x8 v = *(const bf16x8*)(bt + Pt * 256); btf[Pt] = g < 2 ? v : zero8; } }
            if (PASSC) { const bf16_t* cp = (const bf16_t*)(ws + WS_S5CPB) + (size_t)gi * 16 * 128 + (size_t)il * 128 + 8 * g;
#pragma unroll
              for (int ks = 0; ks < 4; ++ks) cpf[ks] = *(const bf16x8*)(cp + 32 * ks); }
#pragma unroll
            for (int wi = 0; wi < 4; ++wi) {
                const int Tt = dir ? 3 - wi : wi;
                bf16x8 uf; { const bf16x8 v = *(const bf16x8*)(P + (size_t)(rowbase + 16 * Tt + il) * LDP + PC_S5U + grp * 16 + 8 * (g & 1)); uf = g < 2 ? v : zero8; }
#pragma unroll
                for (int Pt = 0; Pt < 8; ++Pt) { const f32x4 d = MFMA16(btf[Pt], uf, ((f32x4){0.f, 0.f, 0.f, 0.f}));
#pragma unroll
                    for (int r = 0; r < 4; ++r) BU[(16 * Pt + 4 * g + r) * 20 + il] = d[r]; }
                asm volatile("" ::: "memory");
                f32x4 br[4], bi[4];
#pragma unroll
                for (int q = 0; q < 4; ++q) { br[q] = *(const LAS f32x4*)(BU + lane * 20 + 4 * q); bi[q] = *(const LAS f32x4*)(BU + (64 + lane) * 20 + 4 * q); }
#pragma unroll
                for (int s = 0; s < 16; ++s) { const int tt = dir ? 15 - s : s;
                    const float hr = ab.x * h.x - ab.y * h.y + br[tt >> 2][tt & 3], hi = ab.x * h.y + ab.y * h.x + bi[tt >> 2][tt & 3];
                    h = (f32x2){hr, hi};
                    if (PASSC) { *(LAS bf16_t*)(HW + off_b(tt, lane >> 3) + (lane & 7) * 2) = (bf16_t)f2bf(hr); *(LAS bf16_t*)(HW + off_b(tt, 8 + (lane >> 3)) + (lane & 7) * 2) = (bf16_t)f2bf(hi); } }
                asm volatile("" ::: "memory");
                if (PASSC) {
#pragma unroll
                    for (int ks = 0; ks < 4; ++ks) yacc[Tt] = MFMA16(cpf[ks], img_row_frag(HW, lane, 0, ks), yacc[Tt]); }
                asm volatile("" ::: "memory");
            }
            if (!PASSC) ST[sidx] = h;
        }
        if (PASSC) {
            const f32x4 dsk = *(const f32x4*)(a.in[I_S5D] + l * 512 + grp * 16 + 4 * g);
            bf16_t* G5 = (bf16_t*)(ws + WS_KF);
#pragma unroll
            for (int Tt = 0; Tt < 4; ++Tt) { const size_t row = (size_t)rowbase + 16 * Tt + il;
                const u32x2 ur = *(const u32x2*)(P + row * LDP + PC_S5U + grp * 16 + 4 * g);
                u32x2 ov; ov.x = pk2(gelu_tanh(yacc[Tt].x + bflo(ur.x) * dsk.x), gelu_tanh(yacc[Tt].y + bfhi(ur.x) * dsk.y));
                ov.y = pk2(gelu_tanh(yacc[Tt].z + bflo(ur.y) * dsk.z), gelu_tanh(yacc[Tt].w + bfhi(ur.y) * dsk.w));
                *(u32x2*)(G5 + row * 512 + grp * 16 + 4 * g) = ov; }
        }
    }
}
__device__ __forceinline__ void s5_passB(unsigned char* ws, int l, int gt) {
    if (gt >= 16384) return;
    const int p = gt & 63, grp = (gt >> 6) & 31, dir = (gt >> 11) & 1, b = gt >> 12;
    const f32x2 a64 = ((const f32x2*)(ws + WS_S5A64))[((l * 2 + dir) * 32 + grp) * 64 + p];
    f32x2* ST = (f32x2*)(ws + WS_S5ST);
    f32x2 acc = {0.f, 0.f};
#pragma unroll 4
    for (int s = 0; s < SNCH; ++s) {
        const int cs = dir == 0 ? s : (s < 4 ? 3 - s : 71 - s);
        f32x2* ptr = ST + ((size_t)(b * SNCH + cs) * 2 + dir) * 2048 + grp * 64 + p;
        const f32x2 e = *ptr; *ptr = acc;
        acc = (f32x2){a64.x * acc.x - a64.y * acc.y + e.x, a64.x * acc.y + a64.y * acc.x + e.y};
    }
}
#ifndef MK_EN
#define MK_EN 0xffff
#endif
#define EN(x) ((MK_EN >> (x)) & 1)
constexpr int PH_PREP = 0, PH_PER_LAYER = 8, PH_FNORM = 1 + 2 * PH_PER_LAYER, N_PHASES = PH_FNORM + 1;

__global__ void __launch_bounds__(NT, 2) fwd_kernel(Args ka) {
    extern __shared__ __attribute__((aligned(16))) unsigned char lds_raw[];
    LAS unsigned char* lds = (LAS unsigned char*)lds_raw;
    const int G = gridDim.x;
    volatile LAS unsigned* bst = (volatile LAS unsigned*)(lds + LDS_CTL_OFF);
    if (threadIdx.x < 16) bst[threadIdx.x] = 0u;
    if (threadIdx.x == 0) { LAS unsigned long long* tab = (LAS unsigned long long*)(lds + LDS_PTR_OFF);
#pragma unroll
        for (int i = 0; i < N_IN; ++i) tab[i] = (unsigned long long)ka.in[i]; }
    __syncthreads();
    DArgs a; a.in.t = (const LAS unsigned long long*)(lds + LDS_PTR_OFF); a.out = ka.out;
    XcdBarrier gbar; gbar.bar = (unsigned*)(ka.ws + WS_CTL); gbar.x = 0; gbar.st = bst;
    if (ka.ph_hi - ka.ph_lo > 1) gbar = xcd_barrier_post((unsigned*)(ka.ws + WS_CTL), bst);

    for (int ph = ka.ph_lo; ph < ka.ph_hi; ++ph) {
        int tid = threadIdx.x; asm volatile("" : "+v"(tid));
        int bid = blockIdx.x; asm volatile("" : "+s"(bid));
        const int lane = tid & 63, wave = __builtin_amdgcn_readfirstlane(tid >> 6);
        unsigned char* ws = ka.ws; asm volatile("" : "+s"(ws));
        float* MOD = (float*)(ws + WS_MOD);
        if (EN(0) && ph == PH_PREP) {
            for (int it = bid; it < 1840; it += G) {
                int tid = threadIdx.x; asm volatile("" : "+v"(tid));
                __syncthreads();
                if (it < 768) prep_adaln(a.in[I_C], a.in[I_CCTX], a.in[I_ADAW], a.in[I_ADAB], MOD, it, (LAS float*)lds, tid);
                else if (it < 784) prep_s5b(a, ws, it - 768, tid);
                else { const bool big = it < 1808; const int r = big ? it - 784 : it - 1808, l = big ? (r >> 9) : 0, t0 = (big ? (r & 511) : r) * 8;
                    float* H3o = big ? (float*)(ws + WS_H3) + (size_t)l * 4096 * 64 : (float*)(ws + WS_H3C);
                    prep_hymlp(a, H3o, l, big ? 4096 : 256, t0, (LAS float*)lds, (LAS float*)(lds + 2048), (LAS float*)(lds + 4096), tid); }
            }
        } else if (EN(1) && ph == PH_FNORM) {
            const float* fw = a.in[I_FNW];
            for (int row = bid * NWAVES + wave; row < NLAT; row += G * NWAVES) {
                float* xr = a.out + (size_t)row * D; f32x4 v[8]; float ss = 0.f;
#pragma unroll
                for (int j = 0; j < 8; ++j) { v[j] = ((const f32x4*)xr)[lane + 64 * j]; ss += (v[j].x * v[j].x + v[j].y * v[j].y) + (v[j].z * v[j].z + v[j].w * v[j].w); }
                const float rstd = rsqrtf(wave_sum(ss) * (1.0f / D) + EPS);
#pragma unroll
                for (int j = 0; j < 8; ++j) { const f32x4 w = *(const f32x4*)(fw + 4 * (lane + 64 * j)); ((f32x4*)xr)[lane + 64 * j] = v[j] * rstd * w; }
            }
        } else {
            const int l = (ph - 1) / PH_PER_LAYER, sub = (ph - 1) % PH_PER_LAYER;
            const bool ctx_out = (l == 0);
            const int Mrows = ctx_out ? MR : NLAT;
            if (EN(2) && sub == 0) {
                LAS float* scr = (LAS float*)(lds + wave * 8704);
                const int gw = bid * NWAVES + wave, NGW = G * NWAVES;
                constexpr int I_W1 = 32 * (NPAD / 32), I_W2 = 32 * 64, I_W3 = 8 * 16;
                for (int it = gw; it < I_W1 + I_W2 + I_W3; it += NGW) {
                    int r = it;
                    if (r < I_W1) { const int kb = r / (NPAD / 32), nb = r % (NPAD / 32); transpose_item(a.in[I_WIN] + (size_t)l * D * INW, INW, win_srccol(nb * 32), kb * 64, (bf16_t*)(ws + WS_WIN), D, nb * 32, scr, lane); continue; }
                    r -= I_W1;
                    if (r < I_W2) { const int kb = r / 64, nb = r % 64; transpose_item(a.in[I_WOUT] + (size_t)l * D * D, D, nb * 32, kb * 64, (bf16_t*)(ws + WS_WOUT), D, nb * 32, scr, lane); continue; }
                    r -= I_W2;
                    { const int kb = r / 16, nb = r % 16; transpose_item(a.in[I_GLUW] + (size_t)l * 512 * 512, 512, nb * 32, kb * 64, (bf16_t*)(ws + WS_GLUW), 512, nb * 32, scr, lane); }
                }
                const float* nw = a.in[I_NORMW] + (size_t)l * D;
                for (int row = gw; row < MR; row += NGW) {
                    const float* xr; int v;
                    if (row < NLAT) { xr = (l == 0 ? a.in[I_X] : a.out) + (size_t)row * D; v = row >> 12; }
                    else { xr = (l == 0 ? a.in[I_CTX] : (const float*)(ws + WS_XC1)) + (size_t)(row - NLAT) * D; v = 4; }
                    norm_row(xr, nw, MOD + (size_t)(l * 5 + v) * ADA, (bf16_t*)(ws + WS_H) + (size_t)row * D, lane);
                }
                __syncthreads();
                const int nfilt = ctx_out ? 1024 : 512;
                for (int it = bid; it < nfilt; it += G) { int tid = threadIdx.x; asm volatile("" : "+v"(tid)); __syncthreads(); if (it < 512) filt_item(a, ws, lds, l, it, tid); else filt_ctx_item(a, ws, lds, it - 512, tid); }
            } else if (EN(3) && sub == 1) {
                pg8::Gemm g{(const bf16_t*)(ws + WS_H), (const bf16_t*)(ws + WS_WIN), MR, NPAD, D}; pg8::StaticOrder S; S.init(MR, NPAD, G, bid);
                EpiInProj E{(bf16_t*)(ws + WS_P), (bf16_t*)(ws + WS_PT), (float*)(ws + WS_LR)};
                pg8::gemm_phase<EpiInProj, pg8::StaticOrder>(lds, g, S, E, tid);
            } else if (EN(4) && sub == 2) {
                for (int row = bid * NWAVES + wave; row < MR; row += G * NWAVES) rope_row(a, ws, l, row, lane);
            } else if (EN(5) && sub == 3) {
                const int nit = ctx_out ? 3200 : 2688;
                for (int it = bid; it < nit; it += G) {
                    int tid = threadIdx.x; asm volatile("" : "+v"(tid));
                    __syncthreads();
                    if (it < 544) s5_item<false>(a, ws, lds, l, it, tid);
                    else if (it < 1088) ret_passA(ws, lds, it - 544, tid);
                    else if (it < 2176) gla_passA(a, ws, lds, l, it - 1088, tid);
                    else if (it < 2688) hyena_item(a, ws, lds, l, it - 2176, tid);
                    else hyena_ctx_item(a, ws, lds, it - 2688, tid);
                }
            } else if (EN(9) && sub == 4) {
                for (int gt = bid * NT + tid; gt < 16 * 2 * 2048; gt += G * NT) { ret_passB(ws, gt); gla_passB(ws, gt); s5_passB(ws, l, gt); }
            } else if (EN(6) && sub == 5) {
                const int nsc = ctx_out ? 544 : 512, nrc = ctx_out ? 16 * RNCH : 16 * 32, ngc = ctx_out ? 16 * GNCH : 16 * 64;
                for (int it = bid; it < nsc + nrc + ngc; it += G) { int tid = threadIdx.x; asm volatile("" : "+v"(tid)); __syncthreads();
                    if (it < nsc) { const int item = ctx_out ? it : (it >> 7) * (SNCH * 2) + 8 + (it & 127); s5_item<true>(a, ws, lds, l, item, tid); }
                    else if (it < nsc + nrc) { const int r = it - nsc; const int item = ctx_out ? r : (r >> 5) * RNCH + 2 + (r & 31); ret_passC(a, ws, lds, l, item, tid); }
                    else { const int r = it - nsc - nrc; const int item = ctx_out ? r : (r >> 6) * GNCH + 4 + (r & 63); gla_passC(a, ws, lds, l, item, tid); } }
            } else if (EN(7) && sub == 6) {
                pg8::Gemm g{(const bf16_t*)(ws + WS_KF), (const bf16_t*)(ws + WS_GLUW), Mrows, 512, 512}; pg8::StaticOrder S; S.init(Mrows, 512, G, bid);
                EpiGlu E{(const bf16_t*)(ws + WS_KF), (const bf16_t*)(ws + WS_P), (bf16_t*)(ws + WS_H), a.in[I_GLUB] + (size_t)l * 512};
                pg8::gemm_phase<EpiGlu, pg8::StaticOrder>(lds, g, S, E, tid);
            } else if (EN(8)) {
                pg8::Gemm g{(const bf16_t*)(ws + WS_H), (const bf16_t*)(ws + WS_WOUT), Mrows, D, D}; pg8::StaticOrder S; S.init(Mrows, D, G, bid);
                EpiOut E{l == 0 ? a.in[I_X] : a.out, a.in[I_CTX], a.out, (float*)(ws + WS_XC1), MOD + (size_t)l * 5 * ADA};
                pg8::gemm_phase<EpiOut, pg8::StaticOrder>(lds, g, S, E, tid);
            }
        }
        if (ph + 1 < ka.ph_hi) xcd_barrier(gbar);
    }
}

#ifndef MK_LAUNCH_PER_PHASE
#define MK_LAUNCH_PER_PHASE 0
#endif
extern "C" void kernel_launch(void* const* d_in, const int* in_sizes, int n_in, void* d_out, int out_size, void* d_ws, size_t ws_size, hipStream_t stream) {
    static int grid = 0;
    if (grid == 0) {
        if (n_in != N_IN || out_size != NLAT * D || ws_size < WS_END2) { fprintf(stderr, "kernel_launch: unexpected shapes (n_in %d, out %d, ws %zu < %zu); nothing launched\n", n_in, out_size, ws_size, (size_t)WS_END2); grid = -1; return; }
        int dev = 0, cus = 0, per_cu = 0;
        if (hipGetDevice(&dev) != hipSuccess || hipDeviceGetAttribute(&cus, hipDeviceAttributeMultiprocessorCount, dev) != hipSuccess) { grid = -1; return; }
        if (hipFuncSetAttribute((const void*)fwd_kernel, hipFuncAttributeMaxDynamicSharedMemorySize, LDS_BYTES) != hipSuccess) { fprintf(stderr, "kernel_launch: hipFuncSetAttribute failed\n"); grid = -1; return; }
        if (hipOccupancyMaxActiveBlocksPerMultiprocessor(&per_cu, (const void*)fwd_kernel, NT, LDS_BYTES) != hipSuccess || per_cu < 1) { fprintf(stderr, "kernel_launch: occupancy query says %d blocks per CU\n", per_cu); per_cu = 1; }
        (void)hipGetLastError();
        grid = cus;
    }
    if (grid < 0) return;
    (void)hipMemsetAsync((char*)d_ws + WS_CTL, 0, WS_ZERO_BYTES, stream);
    Args a{};
    for (int i = 0; i < N_IN; ++i) a.in[i] = (const float*)d_in[i];
    a.out = (float*)d_out; a.ws = (unsigned char*)d_ws;
#if MK_LAUNCH_PER_PHASE
    for (int ph = 0; ph < N_PHASES; ++ph) {
        a.ph_lo = ph; a.ph_hi = ph + 1;
        hipLaunchKernelGGL(fwd_kernel, dim3(grid), dim3(NT), LDS_BYTES, stream, a);
    }
#else
    a.ph_lo = 0; a.ph_hi = N_PHASES;
    void* args[] = {&a};
    hipError_t e = hipLaunchCooperativeKernel((const void*)fwd_kernel, dim3(grid), dim3(NT), args, LDS_BYTES, stream);
    if (e != hipSuccess) fprintf(stderr, "kernel_launch: cooperative launch failed: %s (grid %d)\n", hipGetErrorString(e), grid);
#endif
}
```

```cpp
#include <hip/hip_runtime.h>
#include <hip/hip_cooperative_groups.h>
#include <cstdio>
#include <cstdint>
namespace cg = cooperative_groups;

#define LAS __attribute__((address_space(3)))
typedef unsigned short bf16_t;
typedef float f32x4 __attribute__((ext_vector_type(4)));
typedef float f32x2 __attribute__((ext_vector_type(2)));
typedef unsigned u32x4 __attribute__((ext_vector_type(4)));
typedef unsigned u32x2 __attribute__((ext_vector_type(2)));

constexpr int D = 2048, NB = 4, SEQL = 4096, LC = 256, NLAT = NB * SEQL, NCTX = NB * LC, MR = NLAT + NCTX;
constexpr int BR = 512, INW = 6688, NPAD = 6912, LDP = 4608, ADA = 3 * D;
constexpr int NT = 512, NWAVES = 8;
constexpr float EPS = 1e-6f;
constexpr int PC_S5U = 0, PC_S5G = 512, PC_RQ = 1024, PC_RK = 1536, PC_RV = 2048, PC_RG = 2560, PC_GQ = 3072, PC_GK = 3328, PC_GV = 3584, PC_GG = 4096;
constexpr int PT_V = 0, PT_G1 = 512, PT_G2 = 1024, PT_HG = 1536;
constexpr int FFTN = 8192;

enum { I_X = 0, I_C, I_CTX, I_CCTX, I_NORMW, I_ADAW, I_ADAB, I_WIN, I_WOUT, I_S5ARE, I_S5AIM, I_S5LDT, I_S5BRE, I_S5BIM, I_S5CRE, I_S5CIM,
       I_S5D, I_GLUW, I_GLUB, I_HCW, I_HCB, I_HW1, I_HB1, I_HF1, I_HW2, I_HB2, I_HF2, I_HW3, I_HB3, I_HF3, I_HW4, I_HBIAS, I_RNW, I_GGW, I_GGB, I_GNW, I_FNW, N_IN };

constexpr size_t al256(size_t x) { return (x + 255) & ~(size_t)255; }
constexpr size_t WS_CTL  = 0;
constexpr size_t WS_MOD  = WS_CTL + 65536;
constexpr size_t WS_ZERO_BYTES = 65536 + al256((size_t)2 * 5 * ADA * 4);
constexpr size_t WS_S5AB = WS_MOD + al256((size_t)2 * 5 * ADA * 4);
constexpr size_t WS_S5BT = WS_S5AB + (size_t)2 * 2 * 32 * 64 * 8;
constexpr size_t WS_H3   = WS_S5BT + (size_t)1048576 + 65536;
constexpr size_t WS_H3C  = WS_H3 + (size_t)2 * 4096 * 64 * 4;
constexpr size_t WS_KC   = WS_H3C + (size_t)256 * 64 * 4;
constexpr size_t WS_LR   = WS_KC + (size_t)2 * 512 * 512 * 4;
constexpr size_t WS_XC1  = WS_LR + (size_t)MR * 32 * 4;
constexpr size_t WS_WOUT = WS_XC1 + (size_t)NCTX * D * 4;
constexpr size_t WS_GLUW = WS_WOUT + (size_t)D * D * 2;
constexpr size_t WS_WIN  = WS_GLUW + (size_t)512 * 512 * 2;
constexpr size_t WS_H    = WS_WIN + (size_t)NPAD * D * 2;
constexpr size_t WS_P    = WS_H + (size_t)MR * D * 2;
constexpr size_t WS_PT   = WS_P + (size_t)MR * LDP * 2;
constexpr size_t WS_KF   = WS_PT + (size_t)2048 * MR * 2;
constexpr size_t WS_OB   = WS_KF + (size_t)2 * 512 * FFTN * 8;
constexpr size_t WS_END  = WS_OB + (size_t)6 * MR * 512 * 2;
constexpr size_t OBSZ = (size_t)MR * 512;

constexpr int LDS_CTL_OFF = 131072 + 2048;
constexpr int LDS_PTR_OFF = LDS_CTL_OFF + 64;
constexpr int LDS_BYTES = LDS_PTR_OFF + 320;

__device__ __forceinline__ unsigned f2bf(float f) { unsigned u = __float_as_uint(f); return (u + 0x7fffu + ((u >> 16) & 1u)) >> 16; }
__device__ __forceinline__ unsigned pk2(float lo, float hi) { return f2bf(lo) | (f2bf(hi) << 16); }
__device__ __forceinline__ float bf2f(bf16_t b) { return __uint_as_float((unsigned)b << 16); }
__device__ __forceinline__ float bflo(unsigned w) { return __uint_as_float(w << 16); }
__device__ __forceinline__ float bfhi(unsigned w) { return __uint_as_float(w & 0xffff0000u); }
__device__ __forceinline__ void unpack8(const u32x4 r, float (&f)[8]) { f[0] = bflo(r.x); f[1] = bfhi(r.x); f[2] = bflo(r.y); f[3] = bfhi(r.y); f[4] = bflo(r.z); f[5] = bfhi(r.z); f[6] = bflo(r.w); f[7] = bfhi(r.w); }
__device__ __forceinline__ u32x4 pack8(const float (&f)[8]) { u32x4 o; o.x = pk2(f[0], f[1]); o.y = pk2(f[2], f[3]); o.z = pk2(f[4], f[5]); o.w = pk2(f[6], f[7]); return o; }
__device__ __forceinline__ float sigmoidf_(float x) { return 1.0f / (1.0f + __expf(-x)); }
__device__ __forceinline__ float siluf_(float x) { return x * sigmoidf_(x); }
__device__ __forceinline__ float gelu_tanh(float x) { const float u = 0.7978845608028654f * (x + 0.044715f * x * x * x); return 0.5f * x * (1.0f + tanhf(u)); }
__device__ __forceinline__ float wave_sum(float v) {
#pragma unroll
    for (int o = 1; o < 64; o <<= 1) v += __shfl_xor(v, o);
    return v;
}
#define LDS_WAIT() asm volatile("s_waitcnt lgkmcnt(0)" ::: "memory")

struct Args { const float* in[N_IN]; float* out; unsigned char* ws; int ph_lo, ph_hi; };
struct InTab { const LAS unsigned long long* t;
    __device__ __forceinline__ const float* operator[](int i) const { const unsigned long long v = t[i];
        const unsigned lo = __builtin_amdgcn_readfirstlane((unsigned)v), hi = __builtin_amdgcn_readfirstlane((unsigned)(v >> 32)); return (const float*)(((unsigned long long)hi << 32) | lo); } };
struct DArgs { InTab in; float* out; };

#define XB_TMO      128
#define XB_XCNT(j)  (256  + 64 * (j))
#define XB_XSUB(j)  (1280 + 64 * (j))
#define XB_XGEN(j)  (2304 + 64 * (j))
#define XB_TOP      3328
#define XB_TOPGEN   3392
#define XCD_BAR_WORDS 3456
#define XB_SPIN_CAP (1u << 22)
__device__ __forceinline__ unsigned xb_ld(unsigned* p)              { return __hip_atomic_load(p, __ATOMIC_RELAXED, __HIP_MEMORY_SCOPE_AGENT); }
__device__ __forceinline__ unsigned xb_add(unsigned* p, unsigned v) { return __hip_atomic_fetch_add(p, v, __ATOMIC_RELAXED, __HIP_MEMORY_SCOPE_AGENT); }
__device__ __forceinline__ unsigned xb_xcc_id() { return (unsigned)__builtin_amdgcn_s_getreg((3 << 11) | 20) & 0xFu; }
#define XB_SPIN(cond, bar) do { unsigned _sp = 0; while (cond) { __builtin_amdgcn_s_sleep(1); \
    if ((++_sp & 255u) == 0u) { if (xb_ld(&(bar)[XB_TMO])) break; if (_sp > XB_SPIN_CAP) { atomicAdd(&(bar)[XB_TMO], 1u); break; } } } } while (0)
struct XcdBarrier { unsigned* bar; unsigned x; volatile LAS unsigned* st; };
__device__ __forceinline__ XcdBarrier xcd_barrier_post(unsigned* bar, volatile LAS unsigned* st) {
    XcdBarrier b; b.bar = bar; b.x = xb_xcc_id(); b.st = st;
    if (threadIdx.x == 0) (void)xb_add(&bar[XB_XCNT(b.x)], 1u);
    return b;
}
__device__ __forceinline__ void xcd_barrier_complete(unsigned* bar, unsigned x, unsigned& nloc, unsigned& nx) {
    const unsigned G = gridDim.x * gridDim.y * gridDim.z;
    unsigned sum, cnt, mine, sp = 0u;
    for (;;) {
        sum = 0u; cnt = 0u; mine = 0u;
#pragma unroll
        for (unsigned j = 0; j < 16; ++j) { const unsigned c = xb_ld(&bar[XB_XCNT(j)]); sum += c; cnt += (c > 0u) ? 1u : 0u; mine = (j == x) ? c : mine; }
        if (sum == G) break;
        __builtin_amdgcn_s_sleep(1);
        if ((++sp & 255u) == 0u) { if (xb_ld(&bar[XB_TMO])) break; if (sp > XB_SPIN_CAP) { atomicAdd(&bar[XB_TMO], 1u); break; } }
    }
    nloc = mine > 0u ? mine : 1u; nx = cnt > 0u ? cnt : 1u;
}
__device__ __forceinline__ void xcd_barrier(const XcdBarrier& b) {
    asm volatile("s_waitcnt vmcnt(0)" ::: "memory");
    __syncthreads();
    if (threadIdx.x == 0) {
        unsigned* bar = b.bar;
        __builtin_amdgcn_s_waitcnt(0);
        unsigned nloc = b.st[0], nx = b.st[1];
        if (nloc == 0u) { xcd_barrier_complete(bar, b.x, nloc, nx); b.st[0] = nloc; b.st[1] = nx; }
        const unsigned old = xb_add(&bar[XB_XSUB(b.x)], 1u);
        const unsigned gen = old / nloc;
        if (old + 1u == (gen + 1u) * nloc) {
            __builtin_amdgcn_fence(__ATOMIC_RELEASE, "agent");
            asm volatile("s_waitcnt vmcnt(0)" ::: "memory");
            const unsigned og = xb_add(&bar[XB_TOP], 1u);
            const unsigned tg = og / nx;
            if (og + 1u == (tg + 1u) * nx) xb_add(&bar[XB_TOPGEN], 1u);
            else XB_SPIN(xb_ld(&bar[XB_TOPGEN]) == tg, bar);
            __builtin_amdgcn_fence(__ATOMIC_ACQUIRE, "agent");
            xb_add(&bar[XB_XGEN(b.x)], 1u);
            asm volatile("s_waitcnt vmcnt(0)" ::: "memory");
        } else {
            XB_SPIN(xb_ld(&bar[XB_XGEN(b.x)]) == gen, bar);
            __builtin_amdgcn_fence(__ATOMIC_ACQUIRE, "agent");
            asm volatile("s_waitcnt vmcnt(0)" ::: "memory");
        }
    }
    __syncthreads();
}
namespace pg8 {
#define PG8_LAS __attribute__((address_space(3)))
typedef unsigned short bf16_t;
typedef short bf16x8 __attribute__((ext_vector_type(8)));
typedef float f32x4 __attribute__((ext_vector_type(4)));
typedef unsigned u32x4 __attribute__((ext_vector_type(4)));
constexpr int BM = 256, BK = 64, HALF = 128, HTB = HALF * BK * 2, STAGE_BYTES = 8 * HTB, NXCD = 8, WGM = 8;

__host__ __device__ __forceinline__ int lds_byte(int r, int c) { const int st = (r >> 4) * 2 + (c >> 5), rr = r & 15, cc = c & 31, ob = rr * 64 + cc * 2; return st * 1024 + (ob ^ (((ob >> 9) & 1) << 5)); }
__host__ __device__ __forceinline__ void stage_rc(int b, int& R, int& C) { const int st = b / 1024, sb = b % 1024, swz = sb ^ (((sb >> 9) & 1) << 5); R = (st >> 1) * 16 + swz / 64; C = (st & 1) * 32 + (swz % 64) / 2; }
__host__ __device__ __forceinline__ int perm32(int rho) { const int n = rho >> 4, i = rho & 15; return 8 * (i >> 2) + 4 * n + (i & 3); }

struct Unit { int pm, pn; };
struct Gemm { const bf16_t* A; const bf16_t* Bt; int M, N, K; };

struct StaticOrder {
    int nM, nN, nwg, G, c;
    __host__ __device__ void init(int M, int N, int G_, int c_) { nM = M / BM; nN = N / BM; nwg = nM * nN; G = G_; c = c_; }
    __host__ __device__ bool next(int i, Unit& u) const {
        const long L = (long)i * G + c; if (L >= nwg) return false;
        int wgid = (int)L; { const int q = nwg / NXCD, r = nwg % NXCD, xcd = wgid % NXCD, off = wgid / NXCD; wgid = (xcd < r ? xcd * (q + 1) : r * (q + 1) + (xcd - r) * q) + off; }
        const int nig = WGM * nN, gid = wgid / nig, fm = gid * WGM, gsz = (nM - fm) < WGM ? (nM - fm) : WGM;
        u.pm = fm + ((wgid % nig) % gsz); u.pn = (wgid % nig) / gsz; return true;
    }
    __device__ __forceinline__ void a_ready(const Unit&) const {}
    __device__ __forceinline__ void done(const Unit&) const {}
};

template <class Epi, class Sched>
__device__ __forceinline__ void gemm_phase(PG8_LAS unsigned char* lds, const Gemm g, const Sched& S, const Epi& E, const int tid) {
    const int wid = __builtin_amdgcn_readfirstlane(tid >> 6), lane = tid & 63, wr = wid >> 2, wc = wid & 3, fr = lane & 15, fq = lane >> 4;
    const int K = g.K, nt = K / BK;
    unsigned voffA[2], voffB[2];
#pragma unroll
    for (int i = 0; i < 2; ++i) { int R, C; stage_rc(tid * 16 + i * 8192, R, C); const int Rb = Epi::PERM ? ((R & ~31) + perm32(R & 31)) : R;
        voffA[i] = (unsigned)(R * K + C) * 2u; voffB[i] = (unsigned)(Rb * K + C) * 2u; }
    const size_t kstep = (size_t)(BK * 2);
    const size_t hstep = (size_t)HALF * K * 2;
    const size_t tstep = 2 * hstep;
    const unsigned ldsw = (unsigned)wid * 1024u;
    const int aoff = lds_byte(wr * 64 + fr, fq * 8), boff = lds_byte(wc * 32 + fr, fq * 8);
#define PG8_SA(b, h) (((b) * 2 + (h)) * HTB)
#define PG8_SB(b, h) ((4 + (b) * 2 + (h)) * HTB)
#define PG8_STAGE(bufoff, gbase, voff) do { _Pragma("unroll") for (int _i = 0; _i < 2; ++_i) \
        __builtin_amdgcn_global_load_lds((const unsigned*)((const char*)(gbase) + (voff)[_i]), (PG8_LAS unsigned*)(lds + (bufoff) + ldsw + _i * 8192), 16, 0, 0); } while (0)
#define PG8_LDA(dst, b, h) do { _Pragma("unroll") for (int m = 0; m < 4; ++m) _Pragma("unroll") for (int k = 0; k < 2; ++k) dst[m][k] = *(const PG8_LAS bf16x8*)(lds + PG8_SA(b, h) + aoff + m * 2048 + k * 1024); } while (0)
#define PG8_LDB(dst, b, h) do { _Pragma("unroll") for (int n = 0; n < 2; ++n) _Pragma("unroll") for (int k = 0; k < 2; ++k) dst[n][k] = *(const PG8_LAS bf16x8*)(lds + PG8_SB(b, h) + boff + n * 2048 + k * 1024); } while (0)
#define PG8_MMA(ai, bj, At, Bt) do { __builtin_amdgcn_s_setprio(1); _Pragma("unroll") for (int m = 0; m < 4; ++m) _Pragma("unroll") for (int n = 0; n < 2; ++n) _Pragma("unroll") for (int k = 0; k < 2; ++k) \
        acc[ai][bj][m][n] = __builtin_amdgcn_mfma_f32_16x16x32_bf16(Bt[n][k], At[m][k], acc[ai][bj][m][n], 0, 0, 0); __builtin_amdgcn_s_setprio(0); } while (0)
#define PG8_WAIT_V(n) asm volatile("s_waitcnt vmcnt(" #n ")" ::: "memory")
#define PG8_WAIT_L(n) asm volatile("s_waitcnt lgkmcnt(" #n ")" ::: "memory")
#define PG8_BAR __builtin_amdgcn_s_barrier()
#define PG8_SCHED __builtin_amdgcn_sched_barrier(0)
    Unit cur, nxt; int ui = 0;
    if (!S.next(0, cur)) return;
    f32x4 acc[2][2][4][2];
#pragma unroll
    for (int a = 0; a < 2; ++a)
#pragma unroll
        for (int b = 0; b < 2; ++b)
#pragma unroll
            for (int m = 0; m < 4; ++m)
#pragma unroll
                for (int n = 0; n < 2; ++n) acc[a][b][m][n] = (f32x4){0.f, 0.f, 0.f, 0.f};
    bf16x8 At[4][2], B0[2][2], B1[2][2];
    const char* cA = (const char*)g.A + (size_t)cur.pm * tstep; const char* cB = (const char*)g.Bt + (size_t)cur.pn * tstep;
    S.a_ready(cur);
    PG8_STAGE(PG8_SB(0, 0), cB, voffB); PG8_STAGE(PG8_SA(0, 0), cA, voffA); PG8_STAGE(PG8_SB(0, 1), cB + hstep, voffB); PG8_STAGE(PG8_SA(0, 1), cA + hstep, voffA);
    if (wr == 1) PG8_BAR;
    PG8_WAIT_V(4); PG8_BAR;
    PG8_STAGE(PG8_SB(1, 0), cB + kstep, voffB); PG8_STAGE(PG8_SA(1, 0), cA + kstep, voffA); PG8_STAGE(PG8_SB(1, 1), cB + hstep + kstep, voffB);
    PG8_WAIT_V(6); PG8_BAR;
    for (;;) {
        const bool has_next = S.next(ui + 1, nxt);
        const char* nA = has_next ? (const char*)g.A + (size_t)nxt.pm * tstep : cA; const char* nB = has_next ? (const char*)g.Bt + (size_t)nxt.pn * tstep : cB;
        for (int t = 0; t < nt; t += 2) {
            const bool last = (t == nt - 2);
            const char* a1 = cA + (size_t)(t + 1) * kstep;
            const char* a2 = last ? nA : cA + (size_t)(t + 2) * kstep; const char* b2 = last ? nB : cB + (size_t)(t + 2) * kstep;
            const char* a3 = a2 + kstep; const char* b3 = b2 + kstep;
            if (last && has_next) S.a_ready(nxt);
            PG8_LDB(B0, 0, 0); PG8_SCHED; PG8_LDA(At, 0, 0); PG8_STAGE(PG8_SA(1, 1), a1 + hstep, voffA);
            PG8_WAIT_L(8); PG8_BAR; PG8_WAIT_L(0); PG8_MMA(0, 0, At, B0); PG8_BAR; PG8_SCHED;
            PG8_LDB(B1, 0, 1); PG8_STAGE(PG8_SB(0, 0), b2, voffB);
            PG8_BAR; PG8_WAIT_L(0); PG8_MMA(0, 1, At, B1); PG8_BAR;
            PG8_LDA(At, 0, 1); PG8_STAGE(PG8_SA(0, 0), a2, voffA);
            PG8_BAR; PG8_WAIT_L(0); PG8_MMA(1, 0, At, B0); PG8_BAR; PG8_SCHED;
            PG8_STAGE(PG8_SB(0, 1), b2 + hstep, voffB);
            PG8_WAIT_V(6); PG8_BAR; PG8_MMA(1, 1, At, B1); PG8_BAR;
            PG8_LDB(B0, 1, 0); PG8_SCHED; PG8_LDA(At, 1, 0); PG8_STAGE(PG8_SA(0, 1), a2 + hstep, voffA);
            PG8_WAIT_L(8); PG8_BAR; PG8_WAIT_L(0); PG8_MMA(0, 0, At, B0); PG8_BAR; PG8_SCHED;
            PG8_LDB(B1, 1, 1); PG8_STAGE(PG8_SB(1, 0), b3, voffB);
            PG8_BAR; PG8_WAIT_L(0); PG8_MMA(0, 1, At, B1); PG8_BAR;
            PG8_LDA(At, 1, 1); PG8_STAGE(PG8_SA(1, 0), a3, voffA);
            PG8_BAR; PG8_WAIT_L(0); PG8_MMA(1, 0, At, B0); PG8_BAR; PG8_SCHED;
            PG8_STAGE(PG8_SB(1, 1), b3 + hstep, voffB);
            PG8_WAIT_V(6); PG8_BAR; PG8_MMA(1, 1, At, B1); PG8_BAR;
        }
        E(acc, cur, wr, wc, fr, fq); S.done(cur);
        if (!has_next) break;
#pragma unroll
        for (int a = 0; a < 2; ++a)
#pragma unroll
            for (int b = 0; b < 2; ++b)
#pragma unroll
                for (int m = 0; m < 4; ++m)
#pragma unroll
                    for (int n = 0; n < 2; ++n) acc[a][b][m][n] = (f32x4){0.f, 0.f, 0.f, 0.f};
        cur = nxt; cA = nA; cB = nB; ++ui;
    }
    PG8_WAIT_V(0);
    if (wr == 0) PG8_BAR;
    PG8_BAR;
#undef PG8_SA
#undef PG8_SB
#undef PG8_STAGE
#undef PG8_LDA
#undef PG8_LDB
#undef PG8_MMA
#undef PG8_WAIT_V
#undef PG8_WAIT_L
#undef PG8_BAR
#undef PG8_SCHED
}
}
__device__ __forceinline__ void prep_adaln(const float* c, const float* cctx, const float* adaw, const float* adab, float* MOD, int it, LAS float* sv, int tid) {
    const int l = it / 384, r = it % 384, ntile = r >> 5, ks = r & 31, k0 = ks * 64;
    if (tid < 320) { const int v = tid >> 6, k = tid & 63; const float cv = v < 4 ? c[v * D + k0 + k] : cctx[k0 + k]; sv[tid] = cv / (1.0f + expf(-cv)); }
    __syncthreads();
    const int n = ntile * 512 + tid; const float* w = adaw + (size_t)l * D * ADA + (size_t)k0 * ADA + n;
    float acc[5] = {0.f, 0.f, 0.f, 0.f, 0.f};
#pragma unroll 8
    for (int k = 0; k < 64; ++k) { const float wv = w[(size_t)k * ADA];
#pragma unroll
        for (int v = 0; v < 5; ++v) acc[v] += sv[v * 64 + k] * wv; }
    if (ks == 0) { const float bb = adab[l * ADA + n];
#pragma unroll
        for (int v = 0; v < 5; ++v) acc[v] += bb; }
#pragma unroll
    for (int v = 0; v < 5; ++v) atomicAdd(MOD + (size_t)(l * 5 + v) * ADA + n, acc[v]);
    __syncthreads();
}

__device__ __forceinline__ void prep_s5(const DArgs& a, unsigned char* ws, int it, int tid) {
    const int idx = it * 512 + tid;
    const float a_re = a.in[I_S5ARE][idx], a_im = a.in[I_S5AIM][idx], ldt = a.in[I_S5LDT][idx >> 6];
    const float dt = expf(ldt), mag = expf(a_re * dt);
    float sn, cs; sincosf(a_im * dt, &sn, &cs);
    const float ab_re = mag * cs, ab_im = mag * sn, den = a_re * a_re + a_im * a_im, nr = ab_re - 1.0f;
    const float co_re = (nr * a_re + ab_im * a_im) / den, co_im = (ab_im * a_re - nr * a_im) / den;
    ((f32x2*)(ws + WS_S5AB))[idx] = (f32x2){ab_re, ab_im};
    const float* bre = a.in[I_S5BRE] + (size_t)idx * 16; const float* bim = a.in[I_S5BIM] + (size_t)idx * 16;
    f32x2* bt = (f32x2*)(ws + WS_S5BT) + (size_t)idx * 16;
#pragma unroll
    for (int i = 0; i < 16; ++i) { const float br = bre[i], bi = bim[i]; bt[i] = (f32x2){co_re * br - co_im * bi, co_re * bi + co_im * br}; }
}

__device__ __forceinline__ void prep_hymlp(const DArgs& a, float* H3out, int l, int Lx, int t0, LAS float* zs, LAS float* h1, LAS float* h2, int tid) {
    const int pos = tid >> 6, f = tid & 63, t = t0 + pos;
    if (f < 33) {
        float z;
        if (f == 0) z = (float)t / (float)(Lx - 1);
        else { const int j = (f - 1) & 15; const float fj = 1e-4f + (float)j * ((15.0f - 1e-4f) / 15.0f); const float wpos = (6.283185307179586f * (float)t) / (float)Lx; const float arg = fj * wpos;
               z = (f <= 16) ? cosf(arg) : -sinf(arg); }
        zs[pos * 36 + f] = z;
    }
    __syncthreads();
    const float* w1 = a.in[I_HW1] + (size_t)l * 33 * 64; const float* w2 = a.in[I_HW2] + (size_t)l * 64 * 64; const float* w3 = a.in[I_HW3] + (size_t)l * 64 * 64;
    float s = a.in[I_HB1][l * 64 + f];
#pragma unroll 3
    for (int j = 0; j < 33; ++j) s += zs[pos * 36 + j] * w1[j * 64 + f];
    h1[pos * 64 + f] = sinf(a.in[I_HF1][l * 64 + f] * s);
    __syncthreads();
    s = a.in[I_HB2][l * 64 + f];
#pragma unroll 4
    for (int j = 0; j < 64; ++j) s += h1[pos * 64 + j] * w2[j * 64 + f];
    h2[pos * 64 + f] = sinf(a.in[I_HF2][l * 64 + f] * s);
    __syncthreads();
    s = a.in[I_HB3][l * 64 + f];
#pragma unroll 4
    for (int j = 0; j < 64; ++j) s += h2[pos * 64 + j] * w3[j * 64 + f];
    H3out[(size_t)t * 64 + f] = sinf(a.in[I_HF3][l * 64 + f] * s);
    __syncthreads();
}

__device__ __forceinline__ void transpose_item(const float* W, int ldw, int srccol0, int k0, bf16_t* WT, int K, int dstrow0, LAS float* scr, int lane) {
    if (srccol0 >= 0) {
#pragma unroll 8
        for (int i = 0; i < 32; ++i) { const int kk = 2 * i + (lane >> 5); scr[kk * 33 + (lane & 31)] = W[(size_t)(k0 + kk) * ldw + srccol0 + (lane & 31)]; }
    } else {
#pragma unroll 8
        for (int i = 0; i < 32; ++i) { const int kk = 2 * i + (lane >> 5); scr[kk * 33 + (lane & 31)] = 0.f; }
    }
    LDS_WAIT();
    const int c = lane & 7;
#pragma unroll
    for (int j = 0; j < 4; ++j) { const int n = (lane >> 3) + 8 * j; const LAS float* s = scr + (8 * c) * 33 + n;
        u32x4 o; o.x = pk2(s[0 * 33], s[1 * 33]); o.y = pk2(s[2 * 33], s[3 * 33]); o.z = pk2(s[4 * 33], s[5 * 33]); o.w = pk2(s[6 * 33], s[7 * 33]);
        *(u32x4*)(WT + (size_t)(dstrow0 + n) * K + k0 + 8 * c) = o; }
    LDS_WAIT();
}
__device__ __forceinline__ int win_srccol(int n) { return n < 6144 ? n : (n < 6656 ? n + 32 : (n < 6688 ? n - 512 : -1)); }

__device__ __forceinline__ void norm_row(const float* xrow, const float* nw, const float* mod, bf16_t* hrow, int lane) {
    f32x4 v[8]; float ss = 0.f;
#pragma unroll
    for (int j = 0; j < 8; ++j) { v[j] = ((const f32x4*)xrow)[lane + 64 * j]; ss += (v[j].x * v[j].x + v[j].y * v[j].y) + (v[j].z * v[j].z + v[j].w * v[j].w); }
    const float rstd = rsqrtf(wave_sum(ss) * (1.0f / D) + EPS);
#pragma unroll
    for (int j = 0; j < 8; ++j) { const int k = 4 * (lane + 64 * j);
        const f32x4 w = *(const f32x4*)(nw + k), sh = *(const f32x4*)(mod + k), sc = *(const f32x4*)(mod + D + k);
        const f32x4 o = v[j] * rstd * w * (sc + 1.0f) + sh;
        u32x2 pk; pk.x = pk2(o.x, o.y); pk.y = pk2(o.z, o.w);
        *(u32x2*)(hrow + k) = pk; }
}

__device__ __forceinline__ void fft_twiddles(LAS f32x2* W, int tid) {
    for (int j = tid; j < 4096; j += NT) { float s, c; sincospif(-(float)j * (1.0f / 4096.0f), &s, &c); W[j] = (f32x2){c, s}; }
}
template <int R, int BETA, bool INV> __device__ __forceinline__ void fft_pass(LAS f32x2* X, const LAS f32x2* W, int tid) {
    constexpr int LOW = BETA - R + 1, NG = FFTN >> R;
    for (int gi = tid; gi < NG; gi += NT) {
        const int base = ((gi >> LOW) << (BETA + 1)) | (gi & ((1 << LOW) - 1));
        f32x2 e[1 << R];
#pragma unroll
        for (int m = 0; m < (1 << R); ++m) e[m] = X[base + (m << LOW)];
#pragma unroll
        for (int ss = 0; ss < R; ++ss) {
            const int s = INV ? (R - 1 - ss) : ss; const int bit = BETA - s, h = 1 << (R - 1 - s);
#pragma unroll
            for (int m = 0; m < (1 << R); ++m) {
                if (m & h) continue;
                const int idx = base + (m << LOW); const int ex = (idx & ((1 << bit) - 1)) << (12 - bit);
                const f32x2 w = W[ex]; const f32x2 a_ = e[m], b_ = e[m | h];
                if (!INV) { const f32x2 d = a_ - b_; e[m] = a_ + b_; e[m | h] = (f32x2){d.x * w.x - d.y * w.y, d.x * w.y + d.y * w.x}; }
                else { const f32x2 t = (f32x2){b_.x * w.x + b_.y * w.y, b_.y * w.x - b_.x * w.y}; e[m] = a_ + t; e[m | h] = a_ - t; }
            }
        }
#pragma unroll
        for (int m = 0; m < (1 << R); ++m) X[base + (m << LOW)] = e[m];
    }
}
__device__ __forceinline__ void fft_forward(LAS f32x2* X, const LAS f32x2* W, int tid) {
    fft_pass<4, 12, false>(X, W, tid); __syncthreads(); fft_pass<3, 8, false>(X, W, tid); __syncthreads();
    fft_pass<3, 5, false>(X, W, tid); __syncthreads(); fft_pass<3, 2, false>(X, W, tid); __syncthreads();
}
__device__ __forceinline__ void fft_inverse(LAS f32x2* X, const LAS f32x2* W, int tid) {
    fft_pass<3, 2, true>(X, W, tid); __syncthreads(); fft_pass<3, 5, true>(X, W, tid); __syncthreads();
    fft_pass<3, 8, true>(X, W, tid); __syncthreads(); fft_pass<4, 12, true>(X, W, tid); __syncthreads();
}
__device__ __forceinline__ float block_sum(float v, LAS float* red, int tid) {
    v = wave_sum(v);
    if ((tid & 63) == 0) red[tid >> 6] = v;
    __syncthreads();
    float t = 0.f;
#pragma unroll
    for (int i = 0; i < NWAVES; ++i) t += red[i];
    __syncthreads();
    return t;
}
constexpr float HY_D0 = -3.0701134573253945f  , HY_D1 = -15.350567286626973f  ;

__device__ __forceinline__ void filt_item(const DArgs& a, unsigned char* ws, LAS unsigned char* lds, int l, int c, int tid) {
    LAS f32x2* X = (LAS f32x2*)lds; LAS f32x2* W = (LAS f32x2*)(lds + 65536); LAS float* w4s = (LAS float*)(lds + 98304); LAS float* red = (LAS float*)(lds + 98304 + 1024);
    LAS float* k1b = (LAS float*)(lds + 100352);
    fft_twiddles(W, tid);
    if (tid < 256) { const int cc = tid >> 6, f = tid & 63; w4s[tid] = a.in[I_HW4][(size_t)l * 64 * 2048 + (size_t)f * 2048 + (cc >> 1) * 1024 + (cc & 1) * 512 + c]; }
    __syncthreads();
    const float dl = fabsf(HY_D0 + (HY_D1 - HY_D0) * ((float)c / 511.0f));
    const float* H3 = (const float*)(ws + WS_H3) + (size_t)l * 4096 * 64;
    float ss0 = 0.f, ss1 = 0.f;
#pragma unroll 1
    for (int j = 0; j < 16; ++j) {
        const int n = tid + 512 * j; const int dir = j >= 8 ? 1 : 0; const int t = dir ? (8192 - n) : n;
        float s0 = 0.f, s1 = 0.f;
        if (n != 4096) {
            const f32x4* hr = (const f32x4*)(H3 + (size_t)t * 64);
#pragma unroll
            for (int q = 0; q < 16; ++q) { const f32x4 hv = hr[q]; const f32x4 wa = ((const LAS f32x4*)(w4s + (dir * 2 + 0) * 64))[q], wb = ((const LAS f32x4*)(w4s + (dir * 2 + 1) * 64))[q];
                s0 += (hv.x * wa.x + hv.y * wa.y) + (hv.z * wa.z + hv.w * wa.w); s1 += (hv.x * wb.x + hv.y * wb.y) + (hv.z * wb.z + hv.w * wb.w); }
            const float dec = expf(-((float)t / 4095.0f) * dl); s0 *= dec; s1 *= dec;
        }
        X[n] = (f32x2){s0, 0.f}; k1b[n] = s1; ss0 += s0 * s0; ss1 += s1 * s1;
    }
    const float rs0 = rsqrtf(block_sum(ss0, red, tid) + EPS), rs1 = rsqrtf(block_sum(ss1, red, tid) + EPS);
    f32x2* KF0 = (f32x2*)(ws + WS_KF) + (size_t)(0 * 512 + c) * FFTN; f32x2* KF1 = (f32x2*)(ws + WS_KF) + (size_t)(1 * 512 + c) * FFTN;
#pragma unroll 4
    for (int j = 0; j < 16; ++j) { const f32x2 x = X[tid + 512 * j]; X[tid + 512 * j] = (f32x2){x.x * rs0, 0.f}; }
    __syncthreads(); fft_forward(X, W, tid);
#pragma unroll 4
    for (int j = 0; j < 16; ++j) KF0[tid + 512 * j] = X[tid + 512 * j];
    __syncthreads();
#pragma unroll 4
    for (int j = 0; j < 16; ++j) X[tid + 512 * j] = (f32x2){k1b[tid + 512 * j] * rs1, 0.f};
    __syncthreads(); fft_forward(X, W, tid);
#pragma unroll 4
    for (int j = 0; j < 16; ++j) KF1[tid + 512 * j] = X[tid + 512 * j];
    __syncthreads();
}
__device__ __forceinline__ void filt_ctx_item(const DArgs& a, unsigned char* ws, LAS unsigned char* lds, int c, int tid) {
    LAS float* w4s = (LAS float*)lds; LAS float* red = (LAS float*)(lds + 1024);
    if (tid < 256) { const int cc = tid >> 6, f = tid & 63; w4s[tid] = a.in[I_HW4][(size_t)f * 2048 + (cc >> 1) * 1024 + (cc & 1) * 512 + c]; }
    __syncthreads();
    const float dl = fabsf(HY_D0 + (HY_D1 - HY_D0) * ((float)c / 511.0f));
    const float* H3C = (const float*)(ws + WS_H3C);
    const int n = tid, dir = n >= 256 ? 1 : 0, t = dir ? (512 - n) : n;
    float s0 = 0.f, s1 = 0.f;
    if (n != 256) {
        const f32x4* hr = (const f32x4*)(H3C + (size_t)t * 64);
#pragma unroll
        for (int q = 0; q < 16; ++q) { const f32x4 hv = hr[q]; const f32x4 wa = ((const LAS f32x4*)(w4s + (dir * 2 + 0) * 64))[q], wb = ((const LAS f32x4*)(w4s + (dir * 2 + 1) * 64))[q];
            s0 += (hv.x * wa.x + hv.y * wa.y) + (hv.z * wa.z + hv.w * wa.w); s1 += (hv.x * wb.x + hv.y * wb.y) + (hv.z * wb.z + hv.w * wb.w); }
        const float dec = expf(-((float)t / 255.0f) * dl); s0 *= dec; s1 *= dec;
    }
    const float rs0 = rsqrtf(block_sum(s0 * s0, red, tid) + EPS), rs1 = rsqrtf(block_sum(s1 * s1, red, tid) + EPS);
    float* KC = (float*)(ws + WS_KC);
    KC[(size_t)(0 * 512 + c) * 512 + n] = s0 * rs0; KC[(size_t)(1 * 512 + c) * 512 + n] = s1 * rs1;
    __syncthreads();
}

__device__ __forceinline__ void rope_row(const DArgs& a, unsigned char* ws, int l, int row, int lane) {
    bf16_t* P = (bf16_t*)(ws + WS_P) + (size_t)row * LDP;
    float ang;
    if (row < NLAT) { const int t = row & (SEQL - 1); const int j = lane & 31; const float inv = exp2f(-(float)j * (13.287712379549449f / 32.0f)); ang = (float)(lane < 32 ? (t >> 6) : (t & 63)) * inv; }
    else { const int t = (row - NLAT) & (LC - 1); const float inv = exp2f(-(float)lane * (13.287712379549449f / 64.0f)); ang = (float)t * inv; }
    float sn, cs; sincosf(ang, &sn, &cs);
    const float ksc = 0.08838834764831845f;
#pragma unroll
    for (int h = 0; h < 4; ++h) {
        bf16_t* q = P + PC_RQ + h * 128; bf16_t* k = P + PC_RK + h * 128;
        const float q1 = bf2f(q[lane]), q2 = bf2f(q[lane + 64]), k1 = bf2f(k[lane]), k2 = bf2f(k[lane + 64]);
        q[lane] = (bf16_t)f2bf(q1 * cs - q2 * sn); q[lane + 64] = (bf16_t)f2bf(q1 * sn + q2 * cs);
        k[lane] = (bf16_t)f2bf((k1 * cs - k2 * sn) * ksc); k[lane + 64] = (bf16_t)f2bf((k1 * sn + k2 * cs) * ksc);
    }
    const float* lr = (const float*)(ws + WS_LR) + (size_t)row * 32;
    bf16_t* GLG = (bf16_t*)(ws + WS_WIN);
#pragma unroll
    for (int dir = 0; dir < 2; ++dir) {
        const float* gw = a.in[I_GGW] + (size_t)(l * 2 + dir) * 16 * 256; const float* gb = a.in[I_GGB] + (size_t)(l * 2 + dir) * 256;
        float lrv[16];
#pragma unroll
        for (int j = 0; j < 16; ++j) lrv[j] = lr[dir * 16 + j];
#pragma unroll
        for (int q = 0; q < 4; ++q) { const int d = lane + 64 * q; float s = gb[d];
#pragma unroll
            for (int j = 0; j < 16; ++j) s += lrv[j] * gw[j * 256 + d];
            const float ls = (s >= 0.f) ? -log1pf(expf(-s)) : (s - log1pf(expf(s)));
            GLG[((size_t)dir * MR + row) * 256 + d] = (bf16_t)f2bf(ls * (1.0f / 16.0f)); }
    }
}

__device__ __forceinline__ void ret_chain(const bf16_t* P, bf16_t* O, int b, int h, int dir, bool ctx_out, int wave, int lane) {
    const int e = wave * 16 + (lane & 15), dq = lane >> 4;
    const float gamma = 1.0f - exp2f(-5.0f - (float)h);
    constexpr int TB = 2;
    float S[32];
#pragma unroll
    for (int i = 0; i < 32; ++i) S[i] = 0.f;
    for (int seg = 0; seg < 2; ++seg) {
        const int n = seg ? SEQL : LC, rowbase = seg ? b * SEQL : NLAT + b * LC; const bool wr_out = seg || ctx_out;
        for (int i0 = 0; i0 < n; i0 += TB) {
            u32x4 q[TB][4], k[TB][4]; bf16_t v[TB];
#pragma unroll
            for (int tb = 0; tb < TB; ++tb) { const int row = rowbase + (dir ? n - 1 - (i0 + tb) : i0 + tb); const bf16_t* pr = P + (size_t)row * LDP;
#pragma unroll
                for (int c4 = 0; c4 < 4; ++c4) { q[tb][c4] = ((const u32x4*)(pr + PC_RQ + h * 128 + dq * 32))[c4]; k[tb][c4] = ((const u32x4*)(pr + PC_RK + h * 128 + dq * 32))[c4]; }
                v[tb] = pr[PC_RV + h * 128 + e]; }
#pragma unroll
            for (int tb = 0; tb < TB; ++tb) {
                const int row = rowbase + (dir ? n - 1 - (i0 + tb) : i0 + tb);
                const float vf = bf2f(v[tb]); float o = 0.f;
#pragma unroll
                for (int c4 = 0; c4 < 4; ++c4) { float qf[8], kf[8]; unpack8(q[tb][c4], qf); unpack8(k[tb][c4], kf);
#pragma unroll
                    for (int x = 0; x < 8; ++x) { const int ix = c4 * 8 + x; S[ix] = gamma * S[ix] + kf[x] * vf; o += qf[x] * S[ix]; } }
                o += __shfl_xor(o, 16); o += __shfl_xor(o, 32);
                if (wr_out && dq == 0) O[(size_t)row * 512 + h * 128 + e] = (bf16_t)f2bf(o);
            }
        }
    }
}
__device__ __forceinline__ void gla_chain(const bf16_t* P, const bf16_t* GLGd, bf16_t* O, int b, int h, int dir, bool ctx_out, int wave, int lane) {
    const int e = wave * 16 + (lane & 15), dq = lane >> 4;
    constexpr int TB = 4;
    float S[16];
#pragma unroll
    for (int i = 0; i < 16; ++i) S[i] = 0.f;
    for (int seg = 0; seg < 2; ++seg) {
        const int n = seg ? SEQL : LC, rowbase = seg ? b * SEQL : NLAT + b * LC; const bool wr_out = seg || ctx_out;
        for (int i0 = 0; i0 < n; i0 += TB) {
            u32x4 q[TB][2], k[TB][2], g[TB][2]; bf16_t v[TB];
#pragma unroll
            for (int tb = 0; tb < TB; ++tb) { const int row = rowbase + (dir ? n - 1 - (i0 + tb) : i0 + tb); const bf16_t* pr = P + (size_t)row * LDP; const bf16_t* gr = GLGd + (size_t)row * 256 + h * 64 + dq * 16;
#pragma unroll
                for (int c4 = 0; c4 < 2; ++c4) { q[tb][c4] = ((const u32x4*)(pr + PC_GQ + h * 64 + dq * 16))[c4]; k[tb][c4] = ((const u32x4*)(pr + PC_GK + h * 64 + dq * 16))[c4]; g[tb][c4] = ((const u32x4*)gr)[c4]; }
                v[tb] = pr[PC_GV + h * 128 + e]; }
#pragma unroll
            for (int tb = 0; tb < TB; ++tb) {
                const int row = rowbase + (dir ? n - 1 - (i0 + tb) : i0 + tb);
                const float vf = bf2f(v[tb]); float o = 0.f;
#pragma unroll
                for (int c4 = 0; c4 < 2; ++c4) { float qf[8], kf[8], gf[8]; unpack8(q[tb][c4], qf); unpack8(k[tb][c4], kf); unpack8(g[tb][c4], gf);
#pragma unroll
                    for (int x = 0; x < 8; ++x) { const int ix = c4 * 8 + x; S[ix] = __expf(gf[x]) * S[ix] + kf[x] * vf; o += qf[x] * S[ix]; } }
                o += __shfl_xor(o, 16); o += __shfl_xor(o, 32);
                if (wr_out && dq == 0) O[(size_t)row * 512 + h * 128 + e] = (bf16_t)f2bf(o * 0.125f);
            }
        }
    }
}
__device__ __forceinline__ void s5_chain(const DArgs& a, unsigned char* ws, LAS unsigned char* lds, int l, int b, int g, int dir, bool ctx_out, int tid) {
    LAS f32x2* cs = (LAS f32x2*)lds; LAS f32x2* hs = (LAS f32x2*)(lds + 16 * 65 * 8); LAS float* us = (LAS float*)(lds + 2 * 16 * 65 * 8);
    const int wave = tid >> 6, lane = tid & 63;
    const int gi = (l * 2 + dir) * 32 + g;
    const float* cre = a.in[I_S5CRE] + (size_t)gi * 1024; const float* cim = a.in[I_S5CIM] + (size_t)gi * 1024;
    for (int idx = tid; idx < 1024; idx += NT) { const int i = idx >> 6, p = idx & 63; cs[i * 65 + p] = (f32x2){cre[idx], cim[idx]}; }
    f32x2 ab = {0.f, 0.f}; f32x2 bt[16]; f32x2 hst = {0.f, 0.f};
    if (wave == 0) { ab = ((const f32x2*)(ws + WS_S5AB))[gi * 64 + lane]; const f32x2* bp = (const f32x2*)(ws + WS_S5BT) + (size_t)(gi * 64 + lane) * 16;
#pragma unroll
        for (int i = 0; i < 16; ++i) bt[i] = bp[i]; }
    else {
#pragma unroll
        for (int i = 0; i < 16; ++i) bt[i] = (f32x2){0.f, 0.f}; }
    const bf16_t* P = (const bf16_t*)(ws + WS_P);
    bf16_t* Y = (bf16_t*)(ws + WS_OB) + (size_t)(4 + dir) * OBSZ;
    const int tt = tid >> 4, i = tid & 15;
    for (int seg = 0; seg < 2; ++seg) {
        const int n = seg ? SEQL : LC, rowbase = seg ? b * SEQL : NLAT + b * LC; const bool wr_out = seg || ctx_out;
        __syncthreads();
        if (tid < 256) us[tid] = bf2f(P[(size_t)(rowbase + (dir ? n - 1 - tt : tt)) * LDP + PC_S5U + g * 16 + i]);
        for (int bt0 = 0; bt0 < n; bt0 += 16) {
            const int ii = bt0 + tt; const int row = rowbase + (dir ? n - 1 - ii : ii);
            bf16_t unext = 0;
            if (tid < 256 && bt0 + 16 < n) { const int iin = ii + 16; unext = P[(size_t)(rowbase + (dir ? n - 1 - iin : iin)) * LDP + PC_S5U + g * 16 + i]; }
            __syncthreads();
            if (wave == 0) {
#pragma unroll 4
                for (int t2 = 0; t2 < 16; ++t2) {
                    float bur = 0.f, bui = 0.f;
#pragma unroll
                    for (int q = 0; q < 4; ++q) { const f32x4 u = ((const LAS f32x4*)(us + t2 * 16))[q];
                        bur += bt[4 * q].x * u.x + bt[4 * q + 1].x * u.y + bt[4 * q + 2].x * u.z + bt[4 * q + 3].x * u.w;
                        bui += bt[4 * q].y * u.x + bt[4 * q + 1].y * u.y + bt[4 * q + 2].y * u.z + bt[4 * q + 3].y * u.w; }
                    const float hr = ab.x * hst.x - ab.y * hst.y + bur, hi = ab.x * hst.y + ab.y * hst.x + bui;
                    hst = (f32x2){hr, hi};
                    hs[t2 * 65 + lane] = hst;
                }
            }
            __syncthreads();
            if (tid < 256) {
                us[tid] = bf2f(unext);
                float y = 0.f;
#pragma unroll 8
                for (int p = 0; p < 64; ++p) { const f32x2 cv = cs[i * 65 + p], hv = hs[tt * 65 + p]; y += cv.x * hv.x - cv.y * hv.y; }
                if (wr_out) Y[(size_t)row * 512 + g * 16 + i] = (bf16_t)f2bf(y);
            }
        }
    }
    __syncthreads();
}

__device__ __forceinline__ float sconv3(const bf16_t* p, int t, int Lx, float w0, float w1, float w2, float cb) {
    const float x0 = t > 0 ? bf2f(p[t - 1]) : 0.f, x1 = bf2f(p[t]), x2 = t < Lx - 1 ? bf2f(p[t + 1]) : 0.f;
    return w0 * x0 + w1 * x1 + w2 * x2 + cb;
}
__device__ __forceinline__ void hyena_item(const DArgs& a, unsigned char* ws, LAS unsigned char* lds, int l, int c, int tid) {
    LAS f32x2* X = (LAS f32x2*)lds; LAS f32x2* W = (LAS f32x2*)(lds + 65536);
    fft_twiddles(W, tid);
    const float* cw = a.in[I_HCW] + (size_t)l * 3 * 1536; const float* cbp = a.in[I_HCB] + (size_t)l * 1536;
    const float wv0 = cw[c], wv1 = cw[1536 + c], wv2 = cw[3072 + c], bv = cbp[c];
    const float wa0 = cw[512 + c], wa1 = cw[1536 + 512 + c], wa2 = cw[3072 + 512 + c], ba = cbp[512 + c];
    const float wb0 = cw[1024 + c], wb1 = cw[1536 + 1024 + c], wb2 = cw[3072 + 1024 + c], bb = cbp[1024 + c];
    const float bias0 = a.in[I_HBIAS][(l * 2 + 0) * 512 + c], bias1 = a.in[I_HBIAS][(l * 2 + 1) * 512 + c];
    const bf16_t* PT = (const bf16_t*)(ws + WS_PT);
    const bf16_t* pv = PT + (size_t)(PT_V + c) * MR; const bf16_t* pg1 = PT + (size_t)(PT_G1 + c) * MR; const bf16_t* pg2 = PT + (size_t)(PT_G2 + c) * MR; const bf16_t* phg = PT + (size_t)(PT_HG + c) * MR;
    const f32x2* KF0 = (const f32x2*)(ws + WS_KF) + (size_t)(0 * 512 + c) * FFTN; const f32x2* KF1 = (const f32x2*)(ws + WS_KF) + (size_t)(1 * 512 + c) * FFTN;
    bf16_t* GATED = (bf16_t*)(ws + WS_H);
    __syncthreads();
    for (int bp = 0; bp < 2; ++bp) {
        const int r0 = (2 * bp) * SEQL, r1 = (2 * bp + 1) * SEQL;
        float zr[8], zi[8];
#pragma unroll
        for (int j = 0; j < 8; ++j) { const int t = tid + 512 * j; zr[j] = sconv3(pv + r0, t, SEQL, wv0, wv1, wv2, bv); zi[j] = sconv3(pv + r1, t, SEQL, wv0, wv1, wv2, bv);
            X[t] = (f32x2){zr[j], zi[j]}; X[4096 + t] = (f32x2){0.f, 0.f}; if (j & 1) asm volatile("" ::: "memory"); }
        __syncthreads(); fft_forward(X, W, tid);
#pragma unroll 4
        for (int j = 0; j < 16; ++j) { const int pos = tid + 512 * j; const f32x2 x = X[pos], k = KF0[pos]; X[pos] = (f32x2){x.x * k.x - x.y * k.y, x.x * k.y + x.y * k.x}; }
        __syncthreads(); fft_inverse(X, W, tid);
#pragma unroll
        for (int j = 0; j < 8; ++j) { const int t = tid + 512 * j; const f32x2 cv = X[t] * (1.0f / 8192.0f);
            const float g1r = sconv3(pg1 + r0, t, SEQL, wa0, wa1, wa2, ba), g1i = sconv3(pg1 + r1, t, SEQL, wa0, wa1, wa2, ba);
            zr[j] = g1r * (cv.x + bias0 * zr[j]); zi[j] = g1i * (cv.y + bias0 * zi[j]); if (j & 1) asm volatile("" ::: "memory"); }
        __syncthreads();
#pragma unroll
        for (int j = 0; j < 8; ++j) { const int t = tid + 512 * j; X[t] = (f32x2){zr[j], zi[j]}; X[4096 + t] = (f32x2){0.f, 0.f}; }
        __syncthreads(); fft_forward(X, W, tid);
#pragma unroll 4
        for (int j = 0; j < 16; ++j) { const int pos = tid + 512 * j; const f32x2 x = X[pos], k = KF1[pos]; X[pos] = (f32x2){x.x * k.x - x.y * k.y, x.x * k.y + x.y * k.x}; }
        __syncthreads(); fft_inverse(X, W, tid);
#pragma unroll
        for (int j = 0; j < 8; ++j) { const int t = tid + 512 * j; const f32x2 cv = X[t] * (1.0f / 8192.0f);
            const float g2r = sconv3(pg2 + r0, t, SEQL, wb0, wb1, wb2, bb), g2i = sconv3(pg2 + r1, t, SEQL, wb0, wb1, wb2, bb);
            const float z2r = g2r * (cv.x + bias1 * zr[j]), z2i = g2i * (cv.y + bias1 * zi[j]);
            const float hg0 = bf2f(phg[r0 + t]), hg1 = bf2f(phg[r1 + t]);
            GATED[(size_t)(r0 + t) * D + 512 + c] = (bf16_t)f2bf(z2r * siluf_(hg0)); GATED[(size_t)(r1 + t) * D + 512 + c] = (bf16_t)f2bf(z2i * siluf_(hg1)); if (j & 1) asm volatile("" ::: "memory"); }
        __syncthreads();
    }
}
__device__ __forceinline__ void hyena_ctx_item(const DArgs& a, unsigned char* ws, LAS unsigned char* lds, int c, int tid) {
    LAS float* kc = (LAS float*)lds; LAS float* za = (LAS float*)(lds + 4096); LAS float* zb = (LAS float*)(lds + 8192);
    const float* KC = (const float*)(ws + WS_KC);
    kc[tid] = KC[(size_t)(0 * 512 + c) * 512 + tid]; kc[512 + tid] = KC[(size_t)(1 * 512 + c) * 512 + tid];
    const float* cw = a.in[I_HCW]; const float* cbp = a.in[I_HCB];
    const float wv0 = cw[c], wv1 = cw[1536 + c], wv2 = cw[3072 + c], bv = cbp[c];
    const float wa0 = cw[512 + c], wa1 = cw[1536 + 512 + c], wa2 = cw[3072 + 512 + c], ba = cbp[512 + c];
    const float wb0 = cw[1024 + c], wb1 = cw[1536 + 1024 + c], wb2 = cw[3072 + 1024 + c], bb = cbp[1024 + c];
    const float bias0 = a.in[I_HBIAS][0 * 512 + c], bias1 = a.in[I_HBIAS][1 * 512 + c];
    const bf16_t* PT = (const bf16_t*)(ws + WS_PT);
    const int b = tid >> 7, tt = tid & 127; const int rb = NLAT + b * LC;
    const bf16_t* pv = PT + (size_t)(PT_V + c) * MR + rb; const bf16_t* pg1 = PT + (size_t)(PT_G1 + c) * MR + rb; const bf16_t* pg2 = PT + (size_t)(PT_G2 + c) * MR + rb; const bf16_t* phg = PT + (size_t)(PT_HG + c) * MR + rb;
    bf16_t* GATED = (bf16_t*)(ws + WS_H);
    float z0[2], z1[2];
#pragma unroll
    for (int q = 0; q < 2; ++q) { const int t = tt + 128 * q; z0[q] = sconv3(pv, t, LC, wv0, wv1, wv2, bv); za[b * 256 + t] = z0[q]; }
    __syncthreads();
#pragma unroll
    for (int q = 0; q < 2; ++q) { const int t = tt + 128 * q; float s = 0.f;
        for (int sidx = 0; sidx < 256; ++sidx) s += kc[(t - sidx) & 511] * za[b * 256 + sidx];
        z1[q] = sconv3(pg1, t, LC, wa0, wa1, wa2, ba) * (s + bias0 * z0[q]); zb[b * 256 + t] = z1[q]; }
    __syncthreads();
#pragma unroll
    for (int q = 0; q < 2; ++q) { const int t = tt + 128 * q; float s = 0.f;
        for (int sidx = 0; sidx < 256; ++sidx) s += kc[512 + ((t - sidx) & 511)] * zb[b * 256 + sidx];
        const float z2 = sconv3(pg2, t, LC, wb0, wb1, wb2, bb) * (s + bias1 * z1[q]);
        GATED[(size_t)(rb + t) * D + 512 + c] = (bf16_t)f2bf(z2 * siluf_(bf2f(phg[t]))); }
    __syncthreads();
}

__device__ __forceinline__ void merge_row(const DArgs& a, unsigned char* ws, int l, int row, int lane) {
    const int col = 8 * lane;
    const bf16_t* OB = (const bf16_t*)(ws + WS_OB); const bf16_t* P = (const bf16_t*)(ws + WS_P) + (size_t)row * LDP;
    bf16_t* GATED = (bf16_t*)(ws + WS_H) + (size_t)row * D; bf16_t* G5 = (bf16_t*)(ws + WS_KF) + (size_t)row * 512;
    { float yf[8], yb[8], u[8], res[8];
      unpack8(*(const u32x4*)(OB + (size_t)4 * OBSZ + (size_t)row * 512 + col), yf); unpack8(*(const u32x4*)(OB + (size_t)5 * OBSZ + (size_t)row * 512 + col), yb);
      unpack8(*(const u32x4*)(P + PC_S5U + col), u);
      const float* dsk = a.in[I_S5D] + l * 512 + col;
#pragma unroll
      for (int x = 0; x < 8; ++x) res[x] = gelu_tanh(yf[x] + yb[x] + u[x] * dsk[x]);
      *(u32x4*)(G5 + col) = pack8(res); }
}

struct EpiInProj {
    static constexpr bool PERM = true, AFTER_DRAIN = false;
    bf16_t* P; bf16_t* PT; float* LR;
    __device__ __forceinline__ void operator()(const pg8::f32x4 (&acc)[2][2][4][2], const pg8::Unit& u, int wr, int wc, int fr, int fq) const {
        const int row0 = u.pm * 256 + wr * 64 + fr, pn = u.pn;
        if (pn < 4 || (pn >= 12 && pn < 26)) {
            const int colbase = (pn < 4 ? pn * 256 : pn * 256 - 2048) + wc * 32 + 8 * fq;
#pragma unroll
            for (int ai = 0; ai < 2; ++ai)
#pragma unroll
                for (int m = 0; m < 4; ++m) { bf16_t* rowp = P + (size_t)(row0 + ai * 128 + m * 16) * LDP + colbase;
#pragma unroll
                    for (int bj = 0; bj < 2; ++bj) { const pg8::f32x4 v0 = acc[ai][bj][m][0], v1 = acc[ai][bj][m][1];
                        u32x4 w; w.x = pk2(v0[0], v0[1]); w.y = pk2(v0[2], v0[3]); w.z = pk2(v1[0], v1[1]); w.w = pk2(v1[2], v1[3]);
                        *(u32x4*)(rowp + bj * 128) = w; } }
        } else if (pn < 12) {
            const int colbase = (pn - 4) * 256 + wc * 32 + 8 * fq;
#pragma unroll
            for (int bj = 0; bj < 2; ++bj)
#pragma unroll
                for (int n = 0; n < 2; ++n)
#pragma unroll
                    for (int j = 0; j < 4; ++j) { bf16_t* cp = PT + (size_t)(colbase + bj * 128 + 4 * n + j) * MR + row0;
#pragma unroll
                        for (int ai = 0; ai < 2; ++ai)
#pragma unroll
                            for (int m = 0; m < 4; ++m) cp[ai * 128 + m * 16] = (bf16_t)f2bf(acc[ai][bj][m][n][j]);
                        asm volatile("" ::: "memory"); }
        } else {
            if (wc == 0) {
#pragma unroll
                for (int ai = 0; ai < 2; ++ai)
#pragma unroll
                    for (int m = 0; m < 4; ++m) { float* rowp = LR + (size_t)(row0 + ai * 128 + m * 16) * 32 + 8 * fq;
                        *(pg8::f32x4*)(rowp) = acc[ai][0][m][0]; *(pg8::f32x4*)(rowp + 4) = acc[ai][0][m][1]; }
            }
        }
    }
};
struct EpiGlu {
    static constexpr bool PERM = true, AFTER_DRAIN = false;
    const bf16_t* G5; const bf16_t* P; bf16_t* GATED; const float* bias;
    __device__ __forceinline__ void operator()(const pg8::f32x4 (&acc)[2][2][4][2], const pg8::Unit& u, int wr, int wc, int fr, int fq) const {
        const int row0 = u.pm * 256 + wr * 64 + fr, col0 = u.pn * 256 + wc * 32 + 8 * fq;
#pragma unroll
        for (int ai = 0; ai < 2; ++ai)
#pragma unroll
            for (int m = 0; m < 4; ++m) { const size_t row = (size_t)(row0 + ai * 128 + m * 16);
#pragma unroll
                for (int bj = 0; bj < 2; ++bj) { const int col = col0 + bj * 128;
                    float g[8], sg[8], res[8]; unpack8(*(const u32x4*)(G5 + row * 512 + col), g); unpack8(*(const u32x4*)(P + row * LDP + PC_S5G + col), sg);
                    const pg8::f32x4 b0 = *(const pg8::f32x4*)(bias + col), b1 = *(const pg8::f32x4*)(bias + col + 4);
#pragma unroll
                    for (int j = 0; j < 4; ++j) { res[j] = g[j] * sigmoidf_(acc[ai][bj][m][0][j] + b0[j]) * siluf_(sg[j]); res[4 + j] = g[4 + j] * sigmoidf_(acc[ai][bj][m][1][j] + b1[j]) * siluf_(sg[4 + j]); }
                    *(u32x4*)(GATED + row * D + col) = pack8(res); } }
    }
};
struct EpiOut {
    static constexpr bool PERM = false, AFTER_DRAIN = false;
    const float* xl_old; const float* xc_old; float* xl_new; float* xc_new; const float* mod;
    __device__ __forceinline__ void operator()(const pg8::f32x4 (&acc)[2][2][4][2], const pg8::Unit& u, int wr, int wc, int fr, int fq) const {
        const int row0 = u.pm * 256 + wr * 64 + fr, col0 = u.pn * 256 + wc * 32 + 4 * fq;
        const bool lat = u.pm < 64;
        const float* xo = lat ? xl_old : xc_old - (size_t)NLAT * D; float* xn = lat ? xl_new : xc_new - (size_t)NLAT * D;
#pragma unroll
        for (int ai = 0; ai < 2; ++ai) {
            const int v = lat ? ((u.pm * 256 + ai * 128) >> 12) : 4;
            const float* gt = mod + (size_t)v * ADA + 2 * D;
#pragma unroll
            for (int m = 0; m < 4; ++m) { const size_t off = (size_t)(row0 + ai * 128 + m * 16) * D + col0;
#pragma unroll
                for (int bj = 0; bj < 2; ++bj)
#pragma unroll
                    for (int n = 0; n < 2; ++n) { const int cc = bj * 128 + n * 16; const pg8::f32x4 gv = *(const pg8::f32x4*)(gt + col0 + cc), xv = *(const pg8::f32x4*)(xo + off + cc);
                        *(pg8::f32x4*)(xn + off + cc) = xv + gv * acc[ai][bj][m][n]; } }
        }
    }
};
typedef short bf16x8 __attribute__((ext_vector_type(8)));
typedef short bf16x4 __attribute__((ext_vector_type(4)));
__device__ __forceinline__ unsigned off_b(unsigned row, unsigned ch) { return 256u * row + 16u * (ch ^ (((row & 3) << 2) | ((row >> 2) & 3))); }
__device__ __forceinline__ bf16x8 img_row_frag(const LAS unsigned char* img, unsigned lane, unsigned rb, unsigned s) { return *(const LAS bf16x8*)(img + off_b((lane & 15) + 16 * rb, 4 * s + (lane >> 4))); }
__device__ __forceinline__ bf16x4 img_tr4(const LAS unsigned char* img, unsigned lane, unsigned c, unsigned row0) {
    const unsigned q = (lane & 15) >> 2, p = lane & 3;
    return __builtin_amdgcn_ds_read_tr16_b64_v4i16((LAS bf16x4*)(img + off_b(row0 + q, 2 * c + (p >> 1)) + 8 * (p & 1)));
}
__device__ __forceinline__ bf16x8 img_tr_frag(const LAS unsigned char* img, unsigned lane, unsigned c, unsigned ks) {
    const unsigned g = lane >> 4; const bf16x4 lo = img_tr4(img, lane, c, 32 * ks + 8 * g), hi = img_tr4(img, lane, c, 32 * ks + 8 * g + 4);
    return __builtin_shufflevector(lo, hi, 0, 1, 2, 3, 4, 5, 6, 7);
}
__device__ __forceinline__ bf16x8 img_tr_frag_acc(const LAS unsigned char* img, unsigned lane, unsigned c, unsigned ks) {
    const unsigned g = lane >> 4; const bf16x4 lo = img_tr4(img, lane, c, 32 * ks + 4 * g), hi = img_tr4(img, lane, c, 32 * ks + 16 + 4 * g);
    return __builtin_shufflevector(lo, hi, 0, 1, 2, 3, 4, 5, 6, 7);
}
__device__ __forceinline__ bf16x8 acc_pair_frag(const f32x4 a0, const f32x4 a1) {
    u32x4 w; w.x = pk2(a0.x, a0.y); w.y = pk2(a0.z, a0.w); w.z = pk2(a1.x, a1.y); w.w = pk2(a1.z, a1.w);
    return __builtin_bit_cast(bf16x8, w);
}
#define MFMA16(A_, B_, C_) __builtin_amdgcn_mfma_f32_16x16x32_bf16((A_), (B_), (C_), 0, 0, 0)
__device__ __forceinline__ void stage_tile128(LAS unsigned char* img, const bf16_t* g, size_t ld, int tid) {
#pragma unroll
    for (int i = 0; i < 4; ++i) { const int n = tid + NT * i, row = n >> 4, ch = n & 15; *(LAS u32x4*)(img + off_b(row, ch)) = *(const u32x4*)(g + (size_t)row * ld + ch * 8); }
}

constexpr int RCH = 128, RNCH = 34;
constexpr size_t WS_RST = WS_OB;
__device__ __forceinline__ int ret_rowbase(int b, int cc) { return cc < 2 ? NLAT + b * LC + cc * RCH : b * SEQL + (cc - 2) * RCH; }
__device__ __forceinline__ float ret_log2g(int h) { return log2f(1.0f - exp2f(-5.0f - (float)h)); }

__device__ __forceinline__ void ret_passA(unsigned char* ws, LAS unsigned char* lds, int item, int tid) {
    const int bh = item / RNCH, cc = item % RNCH, b = bh >> 2, h = bh & 3;
    const int lane = tid & 63, w = tid >> 6, g = lane >> 4;
    LAS unsigned char* KF = lds; LAS unsigned char* KB = lds + 32768; LAS unsigned char* VI = lds + 65536;
    const bf16_t* P = (const bf16_t*)(ws + WS_P) + (size_t)ret_rowbase(b, cc) * LDP;
    const float l2g = ret_log2g(h);
    __syncthreads();
#pragma unroll
    for (int i = 0; i < 4; ++i) { const int n = tid + NT * i, row = n >> 4, ch = n & 15;
        const u32x4 kr = *(const u32x4*)(P + (size_t)row * LDP + PC_RK + h * 128 + ch * 8);
        float kf[8], a[8], c[8]; unpack8(kr, kf);
        const float sf = exp2f(l2g * (float)(RCH - 1 - row)), sb = exp2f(l2g * (float)row);
#pragma unroll
        for (int x = 0; x < 8; ++x) { a[x] = kf[x] * sf; c[x] = kf[x] * sb; }
        *(LAS u32x4*)(KF + off_b(row, ch)) = pack8(a); *(LAS u32x4*)(KB + off_b(row, ch)) = pack8(c);
        *(LAS u32x4*)(VI + off_b(row, ch)) = *(const u32x4*)(P + (size_t)row * LDP + PC_RV + h * 128 + ch * 8); }
    __syncthreads();
    bf16x8 af[4], ab[4];
#pragma unroll
    for (int ks = 0; ks < 4; ++ks) { af[ks] = img_tr_frag(KF, lane, w, ks); ab[ks] = img_tr_frag(KB, lane, w, ks); }
    bf16_t* ST = (bf16_t*)(ws + WS_RST) + ((size_t)(bh * 2) * RNCH + cc) * (128 * 128);
#pragma unroll 2
    for (int E = 0; E < 8; ++E) {
        f32x4 cf = {0.f, 0.f, 0.f, 0.f}, cb = {0.f, 0.f, 0.f, 0.f};
#pragma unroll
        for (int ks = 0; ks < 4; ++ks) { const bf16x8 vb = img_tr_frag(VI, lane, E, ks); cf = MFMA16(af[ks], vb, cf); cb = MFMA16(ab[ks], vb, cb); }
        const int e = 16 * E + (lane & 15), d0 = 16 * w + 4 * g;
        u32x2 o; o.x = pk2(cf.x, cf.y); o.y = pk2(cf.z, cf.w); *(u32x2*)(ST + (size_t)e * 128 + d0) = o;
        o.x = pk2(cb.x, cb.y); o.y = pk2(cb.z, cb.w); *(u32x2*)(ST + (size_t)RNCH * 128 * 128 + (size_t)e * 128 + d0) = o;
    }
}
__device__ __forceinline__ void ret_passB(unsigned char* ws, int gt  ) {
    const int el = gt & 2047, bd = gt >> 11, bh = bd >> 1, dir = bd & 1, h = bh & 3;
    const float gC = exp2f(ret_log2g(h) * (float)RCH);
    bf16_t* base = (bf16_t*)(ws + WS_RST) + (size_t)bd * RNCH * (128 * 128) + (size_t)el * 8;
    float acc[8];
#pragma unroll
    for (int x = 0; x < 8; ++x) acc[x] = 0.f;
#pragma unroll 1
    for (int s0 = 0; s0 < RNCH; s0 += 17) {
        u32x4 kvr[17];
#pragma unroll
        for (int j = 0; j < 17; ++j) { const int s = s0 + j; const int cc = dir == 0 ? s : (s < 2 ? 1 - s : 35 - s); kvr[j] = *(const u32x4*)(base + (size_t)cc * (128 * 128)); }
#pragma unroll
        for (int j = 0; j < 17; ++j) { const int s = s0 + j; const int cc = dir == 0 ? s : (s < 2 ? 1 - s : 35 - s);
            float kv[8]; unpack8(kvr[j], kv);
            *(u32x4*)(base + (size_t)cc * (128 * 128)) = pack8(acc);
#pragma unroll
            for (int x = 0; x < 8; ++x) acc[x] = gC * acc[x] + kv[x]; }
    }
}
__device__ __forceinline__ void ret_passC(const DArgs& a, unsigned char* ws, LAS unsigned char* lds, int l, int item, int tid) {
    const int bh = item / RNCH, cc = item % RNCH, b = bh >> 2, h = bh & 3;
    const int lane = tid & 63, w = tid >> 6, g = lane >> 4, il = lane & 15;
    LAS unsigned char* KI = lds; LAS unsigned char* VI = lds + 32768; LAS unsigned char* SF = lds + 65536; LAS unsigned char* SB = lds + 98304;
    const int rowbase = ret_rowbase(b, cc);
    const bf16_t* P = (const bf16_t*)(ws + WS_P) + (size_t)rowbase * LDP;
    const bf16_t* STf = (const bf16_t*)(ws + WS_RST) + ((size_t)(bh * 2) * RNCH + cc) * (128 * 128);
    const bf16_t* STb = STf + (size_t)RNCH * 128 * 128;
    __syncthreads();
    stage_tile128(KI, P + PC_RK + h * 128, LDP, tid); stage_tile128(VI, P + PC_RV + h * 128, LDP, tid);
    stage_tile128(SF, STf, 128, tid); stage_tile128(SB, STb, 128, tid);
    bf16x8 qf[4];
    { const bf16_t* qr = P + (size_t)(16 * w + il) * LDP + PC_RQ + h * 128 + 8 * g;
#pragma unroll
      for (int ks = 0; ks < 4; ++ks) qf[ks] = *(const bf16x8*)(qr + 32 * ks); }
    __syncthreads();
    const float l2g = ret_log2g(h);
    const int iloc = 16 * w + il;
    f32x4 o[8];
    { const float sf = exp2f(l2g * (float)(iloc + 1)), sb = exp2f(l2g * (float)(RCH - iloc));
#pragma unroll
      for (int E = 0; E < 8; ++E) { f32x4 rf = {0.f, 0.f, 0.f, 0.f}, rb = {0.f, 0.f, 0.f, 0.f};
#pragma unroll
          for (int ks = 0; ks < 4; ++ks) { rf = MFMA16(img_row_frag(SF, lane, E, ks), qf[ks], rf); rb = MFMA16(img_row_frag(SB, lane, E, ks), qf[ks], rb); }
          o[E] = rf * sf + rb * sb; } }
    f32x4 at[8];
#pragma unroll
    for (int T = 0; T < 8; ++T) { f32x4 c = {0.f, 0.f, 0.f, 0.f};
#pragma unroll
        for (int ks = 0; ks < 4; ++ks) c = MFMA16(img_row_frag(KI, lane, T, ks), qf[ks], c);
#pragma unroll
        for (int r = 0; r < 4; ++r) { const int j = 16 * T + 4 * g + r; const int dd = iloc > j ? iloc - j : j - iloc; c[r] *= (dd == 0 ? 2.0f : exp2f(l2g * (float)dd)); }
        at[T] = c; }
#pragma unroll
    for (int s = 0; s < 4; ++s) { const bf16x8 bfr = acc_pair_frag(at[2 * s], at[2 * s + 1]);
#pragma unroll
        for (int E = 0; E < 8; ++E) o[E] = MFMA16(img_tr_frag_acc(VI, lane, E, s), bfr, o[E]); }
    float ss = 0.f;
#pragma unroll
    for (int E = 0; E < 8; ++E) ss += (o[E].x * o[E].x + o[E].y * o[E].y) + (o[E].z * o[E].z + o[E].w * o[E].w);
    ss += __shfl_xor(ss, 16); ss += __shfl_xor(ss, 32);
    const float rn = rsqrtf(ss * (1.0f / 128.0f) + EPS);
    const size_t row = (size_t)rowbase + iloc;
    const bf16_t* gp = (const bf16_t*)(ws + WS_P) + row * LDP + PC_RG + h * 128 + 4 * g;
    const float* nw = a.in[I_RNW] + l * 512 + h * 128 + 4 * g;
    bf16_t* op = (bf16_t*)(ws + WS_H) + row * D + 1024 + h * 128 + 4 * g;
#pragma unroll
    for (int E = 0; E < 8; ++E) { const u32x2 gr = *(const u32x2*)(gp + 16 * E); const f32x4 nv = *(const f32x4*)(nw + 16 * E);
        u32x2 ov; ov.x = pk2(o[E].x * rn * nv.x * siluf_(bflo(gr.x)), o[E].y * rn * nv.y * siluf_(bfhi(gr.x)));
        ov.y = pk2(o[E].z * rn * nv.z * siluf_(bflo(gr.y)), o[E].w * rn * nv.w * siluf_(bfhi(gr.y)));
        *(u32x2*)(op + 16 * E) = ov; }
}
constexpr int GCH = 64, GNCH = 68;
constexpr size_t WS_GST = WS_OB + (size_t)2 * OBSZ * 2;
constexpr size_t WS_GDEC = WS_END;
constexpr size_t WS_END2 = WS_GDEC + (size_t)16 * 2 * GNCH * 64 * 4;
__device__ __forceinline__ int gla_rowbase(int b, int cg) { return cg < 4 ? NLAT + b * LC + cg * GCH : b * SEQL + (cg - 4) * GCH; }

__device__ __forceinline__ void gla_gates(const DArgs& a, unsigned char* ws, LAS float* BF, LAS float* BB, int l, int h, int rowbase, int tid) {
    const int t = tid >> 3, d8 = tid & 7;
    const float* lr = (const float*)(ws + WS_LR) + (size_t)(rowbase + t) * 32;
    f32x4 lv[8];
#pragma unroll
    for (int q = 0; q < 8; ++q) lv[q] = ((const f32x4*)lr)[q];
#pragma unroll
    for (int dir = 0; dir < 2; ++dir) {
        const float* gw = a.in[I_GGW] + (size_t)(l * 2 + dir) * 16 * 256 + h * 64 + 8 * d8; const float* gb = a.in[I_GGB] + (size_t)(l * 2 + dir) * 256 + h * 64 + 8 * d8;
        f32x4 s0 = *(const f32x4*)gb, s1 = *(const f32x4*)(gb + 4);
#pragma unroll
        for (int j = 0; j < 16; ++j) { const float lj = lv[dir * 4 + (j >> 2)][j & 3]; s0 += lj * *(const f32x4*)(gw + j * 256); s1 += lj * *(const f32x4*)(gw + j * 256 + 4); }
        LAS float* dst = (dir ? BB : BF) + t * 64 + 8 * d8;
#pragma unroll
        for (int x = 0; x < 8; ++x) { const float s = x < 4 ? s0[x] : s1[x - 4]; const float ls = (s >= 0.f) ? -log1pf(__expf(-s)) : (s - log1pf(__expf(s))); dst[x] = ls * (1.0f / 16.0f); }
    }
    __syncthreads();
    if (tid < 128) { const int dir = tid >> 6, d = tid & 63; float run = 0.f;
        if (dir == 0) { for (int tt = 0; tt < 64; ++tt) { run += BF[tt * 64 + d]; BF[tt * 64 + d] = run; } }
        else { for (int tt = 63; tt >= 0; --tt) { run += BB[tt * 64 + d]; BB[tt * 64 + d] = run; } } }
    __syncthreads();
}

__device__ __forceinline__ void gla_passA(const DArgs& a, unsigned char* ws, LAS unsigned char* lds, int l, int item, int tid) {
    const int bh = item / GNCH, cg = item % GNCH, b = bh >> 2, h = bh & 3;
    const int lane = tid & 63, w = tid >> 6, g = lane >> 4;
    LAS float* BF = (LAS float*)lds; LAS float* BB = (LAS float*)(lds + 16384); LAS unsigned char* KH = lds + 32768; LAS unsigned char* VI = lds + 49152;
    const int rowbase = gla_rowbase(b, cg);
    gla_gates(a, ws, BF, BB, l, h, rowbase, tid);
    const bf16_t* P = (const bf16_t*)(ws + WS_P) + (size_t)rowbase * LDP;
    { const int t = tid >> 3, d8 = tid & 7;
      float kf[8], x0[8], x1[8]; unpack8(*(const u32x4*)(P + (size_t)t * LDP + PC_GK + h * 64 + 8 * d8), kf);
#pragma unroll
      for (int x = 0; x < 8; ++x) { const int d = 8 * d8 + x; x0[x] = kf[x] * __expf(BF[63 * 64 + d] - BF[t * 64 + d]); x1[x] = kf[x] * __expf(BB[d] - BB[t * 64 + d]); }
      *(LAS u32x4*)(KH + off_b(t, d8)) = pack8(x0); *(LAS u32x4*)(KH + off_b(t, 8 + d8)) = pack8(x1);
#pragma unroll
      for (int i = 0; i < 2; ++i) { const int n = tid + NT * i, row = n >> 4, ch = n & 15; *(LAS u32x4*)(VI + off_b(row, ch)) = *(const u32x4*)(P + (size_t)row * LDP + PC_GV + h * 128 + ch * 8); }
      if (tid < 128) { const int dir = tid >> 6, d = tid & 63; ((float*)(ws + WS_GDEC))[((size_t)(bh * 2 + dir) * GNCH + cg) * 64 + d] = __expf(dir ? BB[d] : BF[63 * 64 + d]); } }
    __syncthreads();
    const int dir = w >> 2, Dt = w & 3;
    bf16x8 af[2];
#pragma unroll
    for (int ks = 0; ks < 2; ++ks) af[ks] = img_tr_frag(KH, lane, dir * 4 + Dt, ks);
    bf16_t* ST = (bf16_t*)(ws + WS_GST) + ((size_t)(bh * 2 + dir) * GNCH + cg) * (128 * 64);
#pragma unroll 2
    for (int E = 0; E < 8; ++E) {
        f32x4 c = {0.f, 0.f, 0.f, 0.f};
#pragma unroll
        for (int ks = 0; ks < 2; ++ks) c = MFMA16(af[ks], img_tr_frag(VI, lane, E, ks), c);
        u32x2 o; o.x = pk2(c.x, c.y); o.y = pk2(c.z, c.w);
        *(u32x2*)(ST + (size_t)(16 * E + (lane & 15)) * 64 + 16 * Dt + 4 * g) = o;
    }
}
__device__ __forceinline__ void gla_passB(unsigned char* ws, LAS unsigned char* lds, int blk, int tid) {
    const int bd = blk >> 1, dir = bd & 1, el = (blk & 1) * 512 + tid;
    LAS float* decs = (LAS float*)lds;
    { const float* dsrc = (const float*)(ws + WS_GDEC) + (size_t)bd * GNCH * 64;
      for (int i = tid; i < GNCH * 64; i += NT) decs[i] = dsrc[i]; }
    __syncthreads();
    bf16_t* base = (bf16_t*)(ws + WS_GST) + (size_t)bd * GNCH * (128 * 64) + (size_t)el * 8;
    const int d0 = (el & 7) * 8;
    float acc[8];
#pragma unroll
    for (int x = 0; x < 8; ++x) acc[x] = 0.f;
#pragma unroll 1
    for (int s0 = 0; s0 < GNCH; s0 += 17) {
        u32x4 kvr[17];
#pragma unroll
        for (int j = 0; j < 17; ++j) { const int s = s0 + j; const int cg = dir == 0 ? s : (s < 4 ? 3 - s : 71 - s); kvr[j] = *(const u32x4*)(base + (size_t)cg * (128 * 64)); }
#pragma unroll
        for (int j = 0; j < 17; ++j) { const int s = s0 + j; const int cg = dir == 0 ? s : (s < 4 ? 3 - s : 71 - s);
            float kv[8]; unpack8(kvr[j], kv);
            const f32x4 q0 = *(const LAS f32x4*)(decs + cg * 64 + d0), q1 = *(const LAS f32x4*)(decs + cg * 64 + d0 + 4);
            *(u32x4*)(base + (size_t)cg * (128 * 64)) = pack8(acc);
#pragma unroll
            for (int x = 0; x < 8; ++x) acc[x] = (x < 4 ? q0[x] : q1[x - 4]) * acc[x] + kv[x]; }
    }
    __syncthreads();
}
__device__ __forceinline__ void gla_passC(const DArgs& a, unsigned char* ws, LAS unsigned char* lds, int l, int item, int tid) {
    const int bh = item / GNCH, cg = item % GNCH, b = bh >> 2, h = bh & 3;
    const int lane = tid & 63, w = tid >> 6, g = lane >> 4, il = lane & 15;
    LAS float* BF = (LAS float*)lds; LAS float* BB = (LAS float*)(lds + 16384);
    LAS unsigned char* QKF = lds + 32768; LAS unsigned char* QKB = lds + 49152; LAS unsigned char* QH = lds + 65536; LAS unsigned char* VI = lds + 81920; LAS unsigned char* SI = lds + 98304;
    const int rowbase = gla_rowbase(b, cg);
    gla_gates(a, ws, BF, BB, l, h, rowbase, tid);
    const bf16_t* P = (const bf16_t*)(ws + WS_P) + (size_t)rowbase * LDP;
    { const int t = tid >> 3, d8 = tid & 7;
      float qf[8], kf[8], o0[8], o1[8], o2[8], o3[8], o4[8], o5[8];
      unpack8(*(const u32x4*)(P + (size_t)t * LDP + PC_GQ + h * 64 + 8 * d8), qf); unpack8(*(const u32x4*)(P + (size_t)t * LDP + PC_GK + h * 64 + 8 * d8), kf);
#pragma unroll
      for (int x = 0; x < 8; ++x) { const int d = 8 * d8 + x; const float bf = BF[t * 64 + d], bb = BB[t * 64 + d], rf = BF[31 * 64 + d], rb = BB[32 * 64 + d]; const float q = qf[x] * 0.125f;
          o0[x] = q * __expf(bf - rf); o1[x] = kf[x] * __expf(rf - bf); o2[x] = q * __expf(bb - rb); o3[x] = kf[x] * __expf(rb - bb); o4[x] = q * __expf(bf); o5[x] = q * __expf(bb); }
      *(LAS u32x4*)(QKF + off_b(t, d8)) = pack8(o0); *(LAS u32x4*)(QKF + off_b(t, 8 + d8)) = pack8(o1);
      *(LAS u32x4*)(QKB + off_b(t, d8)) = pack8(o2); *(LAS u32x4*)(QKB + off_b(t, 8 + d8)) = pack8(o3);
      *(LAS u32x4*)(QH + off_b(t, d8)) = pack8(o4); *(LAS u32x4*)(QH + off_b(t, 8 + d8)) = pack8(o5);
#pragma unroll
      for (int i = 0; i < 2; ++i) { const int n = tid + NT * i, row = n >> 4, ch = n & 15; *(LAS u32x4*)(VI + off_b(row, ch)) = *(const u32x4*)(P + (size_t)row * LDP + PC_GV + h * 128 + ch * 8); }
      const bf16_t* STf = (const bf16_t*)(ws + WS_GST) + ((size_t)(bh * 2) * GNCH + cg) * (128 * 64); const bf16_t* STb = STf + (size_t)GNCH * 128 * 64;
#pragma unroll
      for (int i = 0; i < 4; ++i) { const int n = tid + NT * i, row = n >> 4, ch = n & 15; *(LAS u32x4*)(SI + off_b(row, ch)) = *(const u32x4*)((ch < 8 ? STf : STb) + (size_t)row * 64 + (ch & 7) * 8); } }
    __syncthreads();
    const int ib = w & 3, eh = w >> 2, iloc = 16 * ib + il;
    f32x4 at[4];
    { bf16x8 qff[2], qfb[2];
#pragma unroll
      for (int ks = 0; ks < 2; ++ks) { qff[ks] = img_row_frag(QKF, lane, ib, ks); qfb[ks] = img_row_frag(QKB, lane, ib, ks); }
#pragma unroll
      for (int T = 0; T < 4; ++T) { f32x4 cf = {0.f, 0.f, 0.f, 0.f}, cb = {0.f, 0.f, 0.f, 0.f};
#pragma unroll
          for (int ks = 0; ks < 2; ++ks) { cf = MFMA16(img_row_frag(QKF, lane, T, 2 + ks), qff[ks], cf); cb = MFMA16(img_row_frag(QKB, lane, T, 2 + ks), qfb[ks], cb); }
#pragma unroll
          for (int r = 0; r < 4; ++r) { const int j = 16 * T + 4 * g + r; cf[r] = (j <= iloc ? cf[r] : 0.f) + (j >= iloc ? cb[r] : 0.f); }
          at[T] = cf; } }
    f32x4 o[4];
    { bf16x8 hf[2], hb[2];
#pragma unroll
      for (int ks = 0; ks < 2; ++ks) { hf[ks] = img_row_frag(QH, lane, ib, ks); hb[ks] = img_row_frag(QH, lane, ib, 2 + ks); }
#pragma unroll
      for (int E4 = 0; E4 < 4; ++E4) { const int E = 4 * eh + E4; f32x4 c = {0.f, 0.f, 0.f, 0.f};
#pragma unroll
          for (int ks = 0; ks < 2; ++ks) { c = MFMA16(img_row_frag(SI, lane, E, ks), hf[ks], c); c = MFMA16(img_row_frag(SI, lane, E, 2 + ks), hb[ks], c); }
          o[E4] = c; } }
#pragma unroll
    for (int s = 0; s < 2; ++s) { const bf16x8 bfr = acc_pair_frag(at[2 * s], at[2 * s + 1]);
#pragma unroll
        for (int E4 = 0; E4 < 4; ++E4) o[E4] = MFMA16(img_tr_frag_acc(VI, lane, 4 * eh + E4, s), bfr, o[E4]); }
    float ss = 0.f;
#pragma unroll
    for (int E4 = 0; E4 < 4; ++E4) ss += (o[E4].x * o[E4].x + o[E4].y * o[E4].y) + (o[E4].z * o[E4].z + o[E4].w * o[E4].w);
    ss += __shfl_xor(ss, 16); ss += __shfl_xor(ss, 32);
    LAS float* red = (LAS float*)lds;
    if (g == 0) red[eh * 64 + iloc] = ss;
    __syncthreads();
    const float rn = rsqrtf((red[iloc] + red[64 + iloc]) * (1.0f / 128.0f) + EPS);
    const size_t row = (size_t)rowbase + iloc;
    const bf16_t* gp = (const bf16_t*)(ws + WS_P) + row * LDP + PC_GG + h * 128 + 64 * eh + 4 * g;
    const float* nw = a.in[I_GNW] + l * 512 + h * 128 + 64 * eh + 4 * g;
    bf16_t* op = (bf16_t*)(ws + WS_H) + row * D + 1536 + h * 128 + 64 * eh + 4 * g;
#pragma unroll
    for (int E4 = 0; E4 < 4; ++E4) { const u32x2 gr = *(const u32x2*)(gp + 16 * E4); const f32x4 nv = *(const f32x4*)(nw + 16 * E4);
        u32x2 ov; ov.x = pk2(o[E4].x * rn * nv.x * siluf_(bflo(gr.x)), o[E4].y * rn * nv.y * siluf_(bfhi(gr.x)));
        ov.y = pk2(o[E4].z * rn * nv.z * siluf_(bflo(gr.y)), o[E4].w * rn * nv.w * siluf_(bfhi(gr.y)));
        *(u32x2*)(op + 16 * E4) = ov; }
}
constexpr int SNCH = 68;
constexpr size_t WS_S5ST = WS_OB + (size_t)4 * OBSZ * 2;
constexpr size_t WS_S5BTB = WS_S5BT;
constexpr size_t WS_S5CPB = WS_S5BT + 524288;
constexpr size_t WS_S5A64 = WS_S5BT + 1048576;

__device__ __forceinline__ void prep_s5b(const DArgs& a, unsigned char* ws, int it, int tid) {
    const int idx = it * 512 + tid;
    const int gi = idx >> 6, p = idx & 63;
    const float a_re = a.in[I_S5ARE][idx], a_im = a.in[I_S5AIM][idx], ldt = a.in[I_S5LDT][gi];
    const float dt = expf(ldt), mag = expf(a_re * dt);
    float sn, cs; sincosf(a_im * dt, &sn, &cs);
    const float ab_re = mag * cs, ab_im = mag * sn, den = a_re * a_re + a_im * a_im, nr = ab_re - 1.0f;
    const float co_re = (nr * a_re + ab_im * a_im) / den, co_im = (ab_im * a_re - nr * a_im) / den;
    ((f32x2*)(ws + WS_S5AB))[idx] = (f32x2){ab_re, ab_im};
    float pr = ab_re, pi = ab_im;
#pragma unroll
    for (int q = 0; q < 6; ++q) { const float nr2 = pr * pr - pi * pi, ni2 = 2.0f * pr * pi; pr = nr2; pi = ni2; }
    ((f32x2*)(ws + WS_S5A64))[idx] = (f32x2){pr, pi};
    const float* bre = a.in[I_S5BRE] + (size_t)idx * 16; const float* bim = a.in[I_S5BIM] + (size_t)idx * 16;
    float tr[16], ti[16];
#pragma unroll
    for (int i = 0; i < 16; ++i) { const float br = bre[i], bi = bim[i]; tr[i] = co_re * br - co_im * bi; ti[i] = co_re * bi + co_im * br; }
    bf16_t* btb = (bf16_t*)(ws + WS_S5BTB) + (size_t)gi * 128 * 16;
#pragma unroll
    for (int hlf = 0; hlf < 2; ++hlf) { u32x4 w0, w1; const float* s = hlf ? ti : tr;
        w0.x = pk2(s[0], s[1]); w0.y = pk2(s[2], s[3]); w0.z = pk2(s[4], s[5]); w0.w = pk2(s[6], s[7]); w1.x = pk2(s[8], s[9]); w1.y = pk2(s[10], s[11]); w1.z = pk2(s[12], s[13]); w1.w = pk2(s[14], s[15]);
        *(u32x4*)(btb + (size_t)(64 * hlf + p) * 16) = w0; *(u32x4*)(btb + (size_t)(64 * hlf + p) * 16 + 8) = w1; }
    bf16_t* cpb = (bf16_t*)(ws + WS_S5CPB) + (size_t)gi * 16 * 128;
    const float* cre = a.in[I_S5CRE] + (size_t)gi * 1024; const float* cim = a.in[I_S5CIM] + (size_t)gi * 1024;
#pragma unroll
    for (int i = 0; i < 16; ++i) { cpb[i * 128 + p] = (bf16_t)f2bf(cre[i * 64 + p]); cpb[i * 128 + 64 + p] = (bf16_t)f2bf(-cim[i * 64 + p]); }
}

template <bool PASSC> __device__ __forceinline__ void s5_item(const DArgs& a, unsigned char* ws, LAS unsigned char* lds, int l, int item, int tid) {
    const int b = item / (SNCH * 2), rem = item % (SNCH * 2), cs = rem >> 1, half = rem & 1;
    const int lane = tid & 63, w = tid >> 6, g = lane >> 4, il = lane & 15;
    const int rowbase = gla_rowbase(b, cs);
    LAS float* BU = (LAS float*)(lds + w * 14336); LAS unsigned char* HW = lds + w * 14336 + 10240;
    const bf16_t* P = (const bf16_t*)(ws + WS_P);
    f32x2* ST = (f32x2*)(ws + WS_S5ST);
    const bf16x8 zero8 = {0, 0, 0, 0, 0, 0, 0, 0};
#pragma unroll 1
    for (int gg = 0; gg < 2; ++gg) {
        const int grp = 16 * half + 8 * gg + w;
        f32x4 yacc[4];
#pragma unroll
        for (int q = 0; q < 4; ++q) yacc[q] = (f32x4){0.f, 0.f, 0.f, 0.f};
#pragma unroll
        for (int dir = 0; dir < 2; ++dir) {
            const int gi = (l * 2 + dir) * 32 + grp;
            const f32x2 ab = ((const f32x2*)(ws + WS_S5AB))[gi * 64 + lane];
            const size_t sidx = ((size_t)(b * SNCH + cs) * 2 + dir) * 2048 + grp * 64 + lane;
            f32x2 h = PASSC ? ST[sidx] : (f32x2){0.f, 0.f};
            bf16x8 btf[8], cpf[4];
            { const bf16_t* bt = (const bf16_t*)(ws + WS_S5BTB) + (size_t)gi * 128 * 16 + (size_t)il * 16 + 8 * (g & 1);
#pragma unroll
              for (int Pt = 0; Pt < 8; ++Pt) { const bf16x8 v = *(const bf16x8*)(bt + Pt * 256); btf[Pt] = g < 2 ? v : zero8; } }
            if (PASSC) { const bf16_t* cp = (const bf16_t*)(ws + WS_S5CPB) + (size_t)gi * 16 * 128 + (size_t)il * 128 + 8 * g;
#pragma unroll
              for (int ks = 0; ks < 4; ++ks) cpf[ks] = *(const bf16x8*)(cp + 32 * ks); }
#pragma unroll
            for (int wi = 0; wi < 4; ++wi) {
                const int Tt = dir ? 3 - wi : wi;
                bf16x8 uf; { const bf16x8 v = *(const bf16x8*)(P + (size_t)(rowbase + 16 * Tt + il) * LDP + PC_S5U + grp * 16 + 8 * (g & 1)); uf = g < 2 ? v : zero8; }
#pragma unroll
                for (int Pt = 0; Pt < 8; ++Pt) { const f32x4 d = MFMA16(btf[Pt], uf, ((f32x4){0.f, 0.f, 0.f, 0.f}));
#pragma unroll
                    for (int r = 0; r < 4; ++r) BU[(16 * Pt + 4 * g + r) * 20 + il] = d[r]; }
                asm volatile("" ::: "memory");
                f32x4 br[4], bi[4];
#pragma unroll
                for (int q = 0; q < 4; ++q) { br[q] = *(const LAS f32x4*)(BU + lane * 20 + 4 * q); bi[q] = *(const LAS f32x4*)(BU + (64 + lane) * 20 + 4 * q); }
#pragma unroll
                for (int s = 0; s < 16; ++s) { const int tt = dir ? 15 - s : s;
                    const float hr = ab.x * h.x - ab.y * h.y + br[tt >> 2][tt & 3], hi = ab.x * h.y + ab.y * h.x + bi[tt >> 2][tt & 3];
                    h = (f32x2){hr, hi};
                    if (PASSC) { *(LAS bf16_t*)(HW + off_b(tt, lane >> 3) + (lane & 7) * 2) = (bf16_t)f2bf(hr); *(LAS bf16_t*)(HW + off_b(tt, 8 + (lane >> 3)) + (lane & 7) * 2) = (bf16_t)f2bf(hi); } }
                asm volatile("" ::: "memory");
                if (PASSC) {
#pragma unroll
                    for (int ks = 0; ks < 4; ++ks) yacc[Tt] = MFMA16(cpf[ks], img_row_frag(HW, lane, 0, ks), yacc[Tt]); }
                asm volatile("" ::: "memory");
            }
            if (!PASSC) ST[sidx] = h;
        }
        if (PASSC) {
            const f32x4 dsk = *(const f32x4*)(a.in[I_S5D] + l * 512 + grp * 16 + 4 * g);
            bf16_t* G5 = (bf16_t*)(ws + WS_KF);
#pragma unroll
            for (int Tt = 0; Tt < 4; ++Tt) { const size_t row = (size_t)rowbase + 16 * Tt + il;
                const u32x2 ur = *(const u32x2*)(P + row * LDP + PC_S5U + grp * 16 + 4 * g);
                u32x2 ov; ov.x = pk2(gelu_tanh(yacc[Tt].x + bflo(ur.x) * dsk.x), gelu_tanh(yacc[Tt].y + bfhi(ur.x) * dsk.y));
                ov.y = pk2(gelu_tanh(yacc[Tt].z + bflo(ur.y) * dsk.z), gelu_tanh(yacc[Tt].w + bfhi(ur.y) * dsk.w));
                *(u32x2*)(G5 + row * 512 + grp * 16 + 4 * g) = ov; }
        }
    }
}
__device__ __forceinline__ void s5_passB(unsigned char* ws, int l, int gt) {
    const int p = gt & 63, grp = (gt >> 6) & 31, dir = (gt >> 11) & 1, b = gt >> 12;
    const f32x2 a64 = ((const f32x2*)(ws + WS_S5A64))[((l * 2 + dir) * 32 + grp) * 64 + p];
    f32x2* ST = (f32x2*)(ws + WS_S5ST);
    f32x2 acc = {0.f, 0.f};
#pragma unroll 1
    for (int s0 = 0; s0 < SNCH; s0 += 34) {
        f32x2 ev[34];
#pragma unroll
        for (int j = 0; j < 34; ++j) { const int s = s0 + j; const int cs = dir == 0 ? s : (s < 4 ? 3 - s : 71 - s); ev[j] = ST[((size_t)(b * SNCH + cs) * 2 + dir) * 2048 + grp * 64 + p]; }
#pragma unroll
        for (int j = 0; j < 34; ++j) { const int s = s0 + j; const int cs = dir == 0 ? s : (s < 4 ? 3 - s : 71 - s);
            ST[((size_t)(b * SNCH + cs) * 2 + dir) * 2048 + grp * 64 + p] = acc;
            acc = (f32x2){a64.x * acc.x - a64.y * acc.y + ev[j].x, a64.x * acc.y + a64.y * acc.x + ev[j].y}; }
    }
}
constexpr int FFT_PHYS = 9216;
__device__ __forceinline__ int fphys(int i) { return i + (i >> 3); }
__device__ __forceinline__ f32x2 cmulf(const f32x2 a, const f32x2 b) { return (f32x2){a.x * b.x - a.y * b.y, a.x * b.y + a.y * b.x}; }
__device__ __forceinline__ f32x2 cmulcf(const f32x2 a, const f32x2 b) { return (f32x2){a.x * b.x + a.y * b.y, a.y * b.x - a.x * b.y}; }
template <int RL> __device__ __forceinline__ void dft_fwd_const(f32x2 (&e)[1 << RL]) {
#pragma unroll
    for (int s = 0; s < RL; ++s) { const int h = 1 << (RL - 1 - s);
#pragma unroll
        for (int m = 0; m < (1 << RL); ++m) { if (m & h) continue;
            const int mp = m & (h - 1); const f32x2 a_ = e[m], b_ = e[m | h]; const f32x2 d = a_ - b_; e[m] = a_ + b_;
            if (mp == 0) e[m | h] = d;
            else if (2 * mp == h) e[m | h] = (f32x2){d.y, -d.x};
            else { const float ang = -3.14159265358979323846f * (float)mp / (float)h; const f32x2 c = {__builtin_cosf(ang), __builtin_sinf(ang)}; e[m | h] = cmulf(d, c); } } }
}
template <int RL> __device__ __forceinline__ void dft_inv_const(f32x2 (&e)[1 << RL]) {
#pragma unroll
    for (int ss = 0; ss < RL; ++ss) { const int s = RL - 1 - ss; const int h = 1 << (RL - 1 - s);
#pragma unroll
        for (int m = 0; m < (1 << RL); ++m) { if (m & h) continue;
            const int mp = m & (h - 1); const f32x2 a_ = e[m], b_ = e[m | h]; f32x2 t;
            if (mp == 0) t = b_;
            else if (2 * mp == h) t = (f32x2){-b_.y, b_.x};
            else { const float ang = -3.14159265358979323846f * (float)mp / (float)h; const f32x2 c = {__builtin_cosf(ang), __builtin_sinf(ang)}; t = cmulcf(b_, c); }
            e[m] = a_ + t; e[m | h] = a_ - t; } }
}
template <int RL> __device__ __forceinline__ constexpr int brev_c(int m) { int r = 0; for (int i = 0; i < RL; ++i) r |= ((m >> i) & 1) << (RL - 1 - i); return r; }
template <int RL, bool CONJ> __device__ __forceinline__ void apply_tw(f32x2 (&e)[1 << RL], const f32x2 w1) {
    f32x2 tw[1 << RL];
    tw[0] = (f32x2){1.f, 0.f}; tw[1] = w1;
    if (RL >= 2) { tw[2] = cmulf(w1, w1); tw[3] = cmulf(tw[2], w1); }
    if (RL >= 3) { tw[4] = cmulf(tw[2], tw[2]); tw[5] = cmulf(tw[4], tw[1]); tw[6] = cmulf(tw[4], tw[2]); tw[7] = cmulf(tw[4], tw[3]); }
    if (RL >= 4) { tw[8] = cmulf(tw[4], tw[4]);
#pragma unroll
        for (int k = 1; k < 8; ++k) tw[8 + k] = cmulf(tw[8], tw[k]); }
#pragma unroll
    for (int m = 1; m < (1 << RL); ++m) e[m] = CONJ ? cmulcf(e[m], tw[brev_c<RL>(m)]) : cmulf(e[m], tw[brev_c<RL>(m)]);
}
template <int RL, int BETA, bool INV> __device__ __forceinline__ void fft2_pass(LAS f32x2* X, const LAS f32x2* W, int tid) {
    constexpr int LOW = BETA - RL + 1, NG = FFTN >> RL, STR = (1 << LOW) + (1 << (LOW - 3));
#pragma unroll 1
    for (int gi = tid; gi < NG; gi += NT) {
        const int base = ((gi >> LOW) << (BETA + 1)) | (gi & ((1 << LOW) - 1));
        LAS f32x2* p = X + fphys(base);
        f32x2 e[1 << RL];
#pragma unroll
        for (int m = 0; m < (1 << RL); ++m) e[m] = p[m * STR];
        const f32x2 w1 = W[(base & ((1 << LOW) - 1)) << (12 - BETA)];
        if (!INV) { dft_fwd_const<RL>(e); apply_tw<RL, false>(e, w1); }
        else { apply_tw<RL, true>(e, w1); dft_inv_const<RL>(e); }
#pragma unroll
        for (int m = 0; m < (1 << RL); ++m) p[m * STR] = e[m];
    }
}
__device__ __forceinline__ void fft2_fwd_ABC(LAS f32x2* X, const LAS f32x2* W, int tid) {
    fft2_pass<4, 12, false>(X, W, tid); __syncthreads(); fft2_pass<3, 8, false>(X, W, tid); __syncthreads(); fft2_pass<3, 5, false>(X, W, tid); __syncthreads();
}
__device__ __forceinline__ void fft2_inv_CBA(LAS f32x2* X, const LAS f32x2* W, int tid) {
    fft2_pass<3, 5, true>(X, W, tid); __syncthreads(); fft2_pass<3, 8, true>(X, W, tid); __syncthreads(); fft2_pass<4, 12, true>(X, W, tid); __syncthreads();
}
__device__ __forceinline__ void fft2_mid_mul(LAS f32x2* X, const f32x2* KF, int tid) {
#pragma unroll 1
    for (int gi = tid; gi < 1024; gi += NT) {
        LAS f32x2* p = X + 9 * gi;
        f32x2 e[8]; f32x4 kf[4];
#pragma unroll
        for (int q = 0; q < 4; ++q) kf[q] = *(const f32x4*)(KF + 8 * gi + 2 * q);
#pragma unroll
        for (int m = 0; m < 8; ++m) e[m] = p[m];
        dft_fwd_const<3>(e);
#pragma unroll
        for (int q = 0; q < 4; ++q) { e[2 * q] = cmulf(e[2 * q], (f32x2){kf[q].x, kf[q].y}); e[2 * q + 1] = cmulf(e[2 * q + 1], (f32x2){kf[q].z, kf[q].w}); }
        dft_inv_const<3>(e);
#pragma unroll
        for (int m = 0; m < 8; ++m) p[m] = e[m];
    }
}
__device__ __forceinline__ void fft2_fwd_D(LAS f32x2* X, int tid) {
#pragma unroll 1
    for (int gi = tid; gi < 1024; gi += NT) { LAS f32x2* p = X + 9 * gi; f32x2 e[8];
#pragma unroll
        for (int m = 0; m < 8; ++m) e[m] = p[m];
        dft_fwd_const<3>(e);
#pragma unroll
        for (int m = 0; m < 8; ++m) p[m] = e[m]; }
}

__device__ __forceinline__ void filt_item2(const DArgs& a, unsigned char* ws, LAS unsigned char* lds, int l, int c, int tid) {
    LAS f32x2* X = (LAS f32x2*)lds; LAS f32x2* W = (LAS f32x2*)(lds + FFT_PHYS * 8); LAS float* w4s = (LAS float*)(lds + FFT_PHYS * 8 + 32768); LAS float* red = w4s + 256;
    fft_twiddles(W, tid);
    if (tid < 256) { const int cc = tid >> 6, f = tid & 63; w4s[tid] = a.in[I_HW4][(size_t)l * 64 * 2048 + (size_t)f * 2048 + (cc >> 1) * 1024 + (cc & 1) * 512 + c]; }
    if (tid == 0) { float z0; asm volatile("v_mov_b32 %0, 0" : "=v"(z0)); X[fphys(4096)] = (f32x2){z0, z0}; }
    __syncthreads();
    const float dl = fabsf(HY_D0 + (HY_D1 - HY_D0) * ((float)c / 511.0f));
    const float* H3 = (const float*)(ws + WS_H3) + (size_t)l * 4096 * 64;
    float ss0 = 0.f, ss1 = 0.f;
#pragma unroll 1
    for (int j = 0; j < 8; ++j) {
        const int t = tid + 512 * j;
        const f32x4* hr = (const f32x4*)(H3 + (size_t)t * 64);
        float f0 = 0.f, f1 = 0.f, b0 = 0.f, b1 = 0.f;
#pragma unroll 4
        for (int q = 0; q < 16; ++q) { const f32x4 hv = hr[q];
            const f32x4 w0 = ((const LAS f32x4*)(w4s))[q], w1 = ((const LAS f32x4*)(w4s + 64))[q], w2 = ((const LAS f32x4*)(w4s + 128))[q], w3 = ((const LAS f32x4*)(w4s + 192))[q];
            f0 += (hv.x * w0.x + hv.y * w0.y) + (hv.z * w0.z + hv.w * w0.w); f1 += (hv.x * w1.x + hv.y * w1.y) + (hv.z * w1.z + hv.w * w1.w);
            b0 += (hv.x * w2.x + hv.y * w2.y) + (hv.z * w2.z + hv.w * w2.w); b1 += (hv.x * w3.x + hv.y * w3.y) + (hv.z * w3.z + hv.w * w3.w); }
        const float dec = expf(-((float)t / 4095.0f) * dl); f0 *= dec; f1 *= dec; b0 *= dec; b1 *= dec;
        X[fphys(t)] = (f32x2){f0, f1}; ss0 += f0 * f0; ss1 += f1 * f1;
        if (t > 0) { X[fphys(8192 - t)] = (f32x2){b0, b1}; ss0 += b0 * b0; ss1 += b1 * b1; }
    }
    const float rs0 = rsqrtf(block_sum(ss0, red, tid) + EPS), rs1 = rsqrtf(block_sum(ss1, red, tid) + EPS);
#pragma unroll 4
    for (int j = 0; j < 16; ++j) { const int n = fphys(tid + 512 * j); const f32x2 x = X[n]; X[n] = (f32x2){x.x * rs0, x.y * rs1}; }
    __syncthreads(); fft2_fwd_ABC(X, W, tid); fft2_fwd_D(X, tid); __syncthreads();
    f32x2* KF0 = (f32x2*)(ws + WS_KF) + (size_t)(0 * 512 + c) * FFTN; f32x2* KF1 = (f32x2*)(ws + WS_KF) + (size_t)(1 * 512 + c) * FFTN;
#pragma unroll 4
    for (int j = 0; j < 16; ++j) { const int pos = tid + 512 * j; const int k = (int)(__brev((unsigned)pos) >> 19); const int pp = (int)(__brev((unsigned)((8192 - k) & 8191)) >> 19);
        const f32x2 za = X[fphys(pos)], zb = X[fphys(pp)];
        KF0[pos] = (f32x2){0.5f * (za.x + zb.x), 0.5f * (za.y - zb.y)};
        KF1[pos] = (f32x2){0.5f * (za.y + zb.y), 0.5f * (zb.x - za.x)}; }
    __syncthreads();
}

struct Raw8 { u32x4 mid; bf16_t lf, rt; };
__device__ __forceinline__ Raw8 ld_raw8(const bf16_t* p, int t0, int Lx) { Raw8 r; r.mid = *(const u32x4*)(p + t0); r.lf = t0 > 0 ? p[t0 - 1] : (bf16_t)0; r.rt = t0 + 8 < Lx ? p[t0 + 8] : (bf16_t)0; return r; }
__device__ __forceinline__ void sconv8(const Raw8& r, float w0, float w1, float w2, float cb, float (&o)[8]) {
    float x[10]; x[0] = bf2f(r.lf); x[9] = bf2f(r.rt);
    x[1] = bflo(r.mid.x); x[2] = bfhi(r.mid.x); x[3] = bflo(r.mid.y); x[4] = bfhi(r.mid.y); x[5] = bflo(r.mid.z); x[6] = bfhi(r.mid.z); x[7] = bflo(r.mid.w); x[8] = bfhi(r.mid.w);
#pragma unroll
    for (int i = 0; i < 8; ++i) o[i] = w0 * x[i] + w1 * x[i + 1] + w2 * x[i + 2] + cb;
}
__device__ __forceinline__ void hyena_item2(const DArgs& a, unsigned char* ws, LAS unsigned char* lds, int l, int c, int tid) {
    LAS f32x2* X = (LAS f32x2*)lds; LAS f32x2* W = (LAS f32x2*)(lds + FFT_PHYS * 8);
    fft_twiddles(W, tid);
    const float* cw = a.in[I_HCW] + (size_t)l * 3 * 1536; const float* cbp = a.in[I_HCB] + (size_t)l * 1536;
    const float wv0 = cw[c], wv1 = cw[1536 + c], wv2 = cw[3072 + c], bv = cbp[c];
    const float wa0 = cw[512 + c], wa1 = cw[1536 + 512 + c], wa2 = cw[3072 + 512 + c], ba = cbp[512 + c];
    const float wb0 = cw[1024 + c], wb1 = cw[1536 + 1024 + c], wb2 = cw[3072 + 1024 + c], bb = cbp[1024 + c];
    const float bias0 = a.in[I_HBIAS][(l * 2 + 0) * 512 + c], bias1 = a.in[I_HBIAS][(l * 2 + 1) * 512 + c];
    const bf16_t* PT = (const bf16_t*)(ws + WS_PT);
    const bf16_t* pv = PT + (size_t)(PT_V + c) * MR; const bf16_t* pg1 = PT + (size_t)(PT_G1 + c) * MR; const bf16_t* pg2 = PT + (size_t)(PT_G2 + c) * MR; const bf16_t* phg = PT + (size_t)(PT_HG + c) * MR;
    const f32x2* KF0 = (const f32x2*)(ws + WS_KF) + (size_t)(0 * 512 + c) * FFTN; const f32x2* KF1 = (const f32x2*)(ws + WS_KF) + (size_t)(1 * 512 + c) * FFTN;
    bf16_t* GATED = (bf16_t*)(ws + WS_H);
    const int t0 = 8 * tid;
    LAS f32x2* px = X + 9 * tid;
    __syncthreads();
    for (int bp = 0; bp < 2; ++bp) {
        const int r0 = (2 * bp) * SEQL, r1 = (2 * bp + 1) * SEQL;
        const Raw8 v0 = ld_raw8(pv + r0, t0, SEQL), v1 = ld_raw8(pv + r1, t0, SEQL);
        const Raw8 g10 = ld_raw8(pg1 + r0, t0, SEQL), g11 = ld_raw8(pg1 + r1, t0, SEQL);
        float zr[8], zi[8];
        sconv8(v0, wv0, wv1, wv2, bv, zr); sconv8(v1, wv0, wv1, wv2, bv, zi);
#pragma unroll
        for (int x = 0; x < 8; ++x) { px[x] = (f32x2){zr[x], zi[x]}; px[4608 + x] = (f32x2){0.f, 0.f}; }
        __syncthreads(); fft2_fwd_ABC(X, W, tid); fft2_mid_mul(X, KF0, tid); __syncthreads(); fft2_inv_CBA(X, W, tid);
        { float gr[8], gi[8]; sconv8(g10, wa0, wa1, wa2, ba, gr); sconv8(g11, wa0, wa1, wa2, ba, gi);
#pragma unroll
          for (int x = 0; x < 8; ++x) { const f32x2 cv = px[x] * (1.0f / 8192.0f); zr[x] = gr[x] * (cv.x + bias0 * zr[x]); zi[x] = gi[x] * (cv.y + bias0 * zi[x]); } }
        __syncthreads();
        const Raw8 g20 = ld_raw8(pg2 + r0, t0, SEQL), g21 = ld_raw8(pg2 + r1, t0, SEQL);
        const u32x4 hgr0 = *(const u32x4*)(phg + r0 + t0), hgr1 = *(const u32x4*)(phg + r1 + t0);
#pragma unroll
        for (int x = 0; x < 8; ++x) { px[x] = (f32x2){zr[x], zi[x]}; px[4608 + x] = (f32x2){0.f, 0.f}; }
        __syncthreads(); fft2_fwd_ABC(X, W, tid); fft2_mid_mul(X, KF1, tid); __syncthreads(); fft2_inv_CBA(X, W, tid);
        { float gr[8], gi[8], h0[8], h1[8]; sconv8(g20, wb0, wb1, wb2, bb, gr); sconv8(g21, wb0, wb1, wb2, bb, gi); unpack8(hgr0, h0); unpack8(hgr1, h1);
#pragma unroll
          for (int x = 0; x < 8; ++x) { const f32x2 cv = px[x] * (1.0f / 8192.0f);
              const float z2r = gr[x] * (cv.x + bias1 * zr[x]), z2i = gi[x] * (cv.y + bias1 * zi[x]);
              GATED[(size_t)(r0 + t0 + x) * D + 512 + c] = (bf16_t)f2bf(z2r * siluf_(h0[x])); GATED[(size_t)(r1 + t0 + x) * D + 512 + c] = (bf16_t)f2bf(z2i * siluf_(h1[x])); } }
        __syncthreads();
    }
}
#ifndef MK_EN
#define MK_EN 0xffff
#endif
#define EN(x) ((MK_EN >> (x)) & 1)
constexpr int PH_PREP = 0, PH_PER_LAYER = 8, PH_FNORM = 1 + 2 * PH_PER_LAYER, N_PHASES = PH_FNORM + 1;

__global__ void __launch_bounds__(NT, 2) fwd_kernel(Args ka) {
    extern __shared__ __attribute__((aligned(16))) unsigned char lds_raw[];
    LAS unsigned char* lds = (LAS unsigned char*)lds_raw;
    const int G = gridDim.x;
    volatile LAS unsigned* bst = (volatile LAS unsigned*)(lds + LDS_CTL_OFF);
    if (threadIdx.x < 16) bst[threadIdx.x] = 0u;
    if (threadIdx.x == 0) { LAS unsigned long long* tab = (LAS unsigned long long*)(lds + LDS_PTR_OFF);
#pragma unroll
        for (int i = 0; i < N_IN; ++i) tab[i] = (unsigned long long)ka.in[i]; }
    __syncthreads();
    DArgs a; a.in.t = (const LAS unsigned long long*)(lds + LDS_PTR_OFF); a.out = ka.out;
    XcdBarrier gbar; gbar.bar = (unsigned*)(ka.ws + WS_CTL); gbar.x = 0; gbar.st = bst;
    if (ka.ph_hi - ka.ph_lo > 1) gbar = xcd_barrier_post((unsigned*)(ka.ws + WS_CTL), bst);

#ifdef REP_SUB
    int repmask = 0;
#endif
    for (int ph = ka.ph_lo; ph < ka.ph_hi; ++ph) {
        int tid = threadIdx.x; asm volatile("" : "+v"(tid));
        int bid = blockIdx.x; asm volatile("" : "+s"(bid));
        const int lane = tid & 63, wave = __builtin_amdgcn_readfirstlane(tid >> 6);
        unsigned char* ws = ka.ws; asm volatile("" : "+s"(ws));
        float* MOD = (float*)(ws + WS_MOD);
        if (EN(0) && ph == PH_PREP) {
            for (int it = bid; it < 1840; it += G) {
                int tid = threadIdx.x; asm volatile("" : "+v"(tid));
                __syncthreads();
                if (it < 768) prep_adaln(a.in[I_C], a.in[I_CCTX], a.in[I_ADAW], a.in[I_ADAB], MOD, it, (LAS float*)lds, tid);
                else if (it < 784) prep_s5b(a, ws, it - 768, tid);
                else { const bool big = it < 1808; const int r = big ? it - 784 : it - 1808, l = big ? (r >> 9) : 0, t0 = (big ? (r & 511) : r) * 8;
                    float* H3o = big ? (float*)(ws + WS_H3) + (size_t)l * 4096 * 64 : (float*)(ws + WS_H3C);
                    prep_hymlp(a, H3o, l, big ? 4096 : 256, t0, (LAS float*)lds, (LAS float*)(lds + 2048), (LAS float*)(lds + 4096), tid); }
            }
        } else if (EN(1) && ph == PH_FNORM) {
            const float* fw = a.in[I_FNW];
            for (int row = bid * NWAVES + wave; row < NLAT; row += G * NWAVES) {
                float* xr = a.out + (size_t)row * D; f32x4 v[8]; float ss = 0.f;
#pragma unroll
                for (int j = 0; j < 8; ++j) { v[j] = ((const f32x4*)xr)[lane + 64 * j]; ss += (v[j].x * v[j].x + v[j].y * v[j].y) + (v[j].z * v[j].z + v[j].w * v[j].w); }
                const float rstd = rsqrtf(wave_sum(ss) * (1.0f / D) + EPS);
#pragma unroll
                for (int j = 0; j < 8; ++j) { const f32x4 w = *(const f32x4*)(fw + 4 * (lane + 64 * j)); ((f32x4*)xr)[lane + 64 * j] = v[j] * rstd * w; }
            }
        } else {
            const int l = (ph - 1) / PH_PER_LAYER, sub = (ph - 1) % PH_PER_LAYER;

            const bool ctx_out = (l == 0);
            const int Mrows = ctx_out ? MR : NLAT;
            if (EN(2) && sub == 0) {
                LAS float* scr = (LAS float*)(lds + wave * 8704);
                const int gw = bid * NWAVES + wave, NGW = G * NWAVES;
                constexpr int I_W1 = 32 * (NPAD / 32), I_W2 = 32 * 64, I_W3 = 8 * 16;
                for (int it = gw; it < I_W1 + I_W2 + I_W3; it += NGW) {
                    int r = it;
                    if (r < I_W1) { const int kb = r / (NPAD / 32), nb = r % (NPAD / 32); transpose_item(a.in[I_WIN] + (size_t)l * D * INW, INW, win_srccol(nb * 32), kb * 64, (bf16_t*)(ws + WS_WIN), D, nb * 32, scr, lane); continue; }
                    r -= I_W1;
                    if (r < I_W2) { const int kb = r / 64, nb = r % 64; transpose_item(a.in[I_WOUT] + (size_t)l * D * D, D, nb * 32, kb * 64, (bf16_t*)(ws + WS_WOUT), D, nb * 32, scr, lane); continue; }
                    r -= I_W2;
                    { const int kb = r / 16, nb = r % 16; transpose_item(a.in[I_GLUW] + (size_t)l * 512 * 512, 512, nb * 32, kb * 64, (bf16_t*)(ws + WS_GLUW), 512, nb * 32, scr, lane); }
                }
                const float* nw = a.in[I_NORMW] + (size_t)l * D;
                for (int row = gw; row < MR; row += NGW) {
                    const float* xr; int v;
                    if (row < NLAT) { xr = (l == 0 ? a.in[I_X] : a.out) + (size_t)row * D; v = row >> 12; }
                    else { xr = (l == 0 ? a.in[I_CTX] : (const float*)(ws + WS_XC1)) + (size_t)(row - NLAT) * D; v = 4; }
                    norm_row(xr, nw, MOD + (size_t)(l * 5 + v) * ADA, (bf16_t*)(ws + WS_H) + (size_t)row * D, lane);
                }
                __syncthreads();
                const int nfilt = ctx_out ? 1024 : 512;
                for (int it = bid; it < nfilt; it += G) { int tid = threadIdx.x; asm volatile("" : "+v"(tid)); __syncthreads(); if (it < 512) filt_item2(a, ws, lds, l, it, tid); else filt_ctx_item(a, ws, lds, it - 512, tid);
#if defined(REP_ITEM) && REP_ITEM == 10
                    __syncthreads(); if (it < 512) filt_item2(a, ws, lds, l, it, tid);
#endif
                }
            } else if (EN(3) && sub == 1) {
                pg8::Gemm g{(const bf16_t*)(ws + WS_H), (const bf16_t*)(ws + WS_WIN), MR, NPAD, D}; pg8::StaticOrder S; S.init(MR, NPAD, G, bid);
                EpiInProj E{(bf16_t*)(ws + WS_P), (bf16_t*)(ws + WS_PT), (float*)(ws + WS_LR)};
                pg8::gemm_phase<EpiInProj, pg8::StaticOrder>(lds, g, S, E, tid);
            } else if (EN(4) && sub == 2) {
                for (int row = bid * NWAVES + wave; row < MR; row += G * NWAVES) rope_row(a, ws, l, row, lane);
            } else if (EN(5) && sub == 3) {
                const int nit = ctx_out ? 3200 : 2688;
                for (int it = bid; it < nit; it += G) {
                    int tid = threadIdx.x; asm volatile("" : "+v"(tid));
                    __syncthreads();
#ifdef REP_ITEM
                    for (int rep_ = 0; rep_ < 2; ++rep_) { const int ty_ = it < 544 ? 0 : it < 1088 ? 1 : it < 2176 ? 2 : it < 2688 ? 3 : 4; if (rep_ && ty_ != REP_ITEM) break; if (rep_) __syncthreads(); asm volatile("" : "+v"(tid));
#endif
                    if (it < 544) s5_item<false>(a, ws, lds, l, it, tid);
                    else if (it < 1088) ret_passA(ws, lds, it - 544, tid);
                    else if (it < 2176) gla_passA(a, ws, lds, l, it - 1088, tid);
                    else if (it < 2688) hyena_item2(a, ws, lds, l, it - 2176, tid);
                    else hyena_ctx_item(a, ws, lds, it - 2688, tid);
#ifdef REP_ITEM
                    }
#endif
                }
            } else if (EN(9) && sub == 4) {
                for (int it = bid; it < 224; it += G) { int tid = threadIdx.x; asm volatile("" : "+v"(tid)); __syncthreads();
                    if (it < 128) ret_passB(ws, it * NT + tid);
                    else if (it < 192) gla_passB(ws, lds, it - 128, tid);
                    else s5_passB(ws, l, (it - 192) * NT + tid); }
            } else if (EN(6) && sub == 5) {
                const int nsc = ctx_out ? 544 : 512, nrc = ctx_out ? 16 * RNCH : 16 * 32, ngc = ctx_out ? 16 * GNCH : 16 * 64;
                for (int it = bid; it < nsc + nrc + ngc; it += G) { int tid = threadIdx.x; asm volatile("" : "+v"(tid)); __syncthreads();
                    if (it < nsc) { const int item = ctx_out ? it : (it >> 7) * (SNCH * 2) + 8 + (it & 127); s5_item<true>(a, ws, lds, l, item, tid); }
                    else if (it < nsc + nrc) { const int r = it - nsc; const int item = ctx_out ? r : (r >> 5) * RNCH + 2 + (r & 31); ret_passC(a, ws, lds, l, item, tid); }
                    else { const int r = it - nsc - nrc; const int item = ctx_out ? r : (r >> 6) * GNCH + 4 + (r & 63); gla_passC(a, ws, lds, l, item, tid); } }
            } else if (EN(7) && sub == 6) {
                pg8::Gemm g{(const bf16_t*)(ws + WS_KF), (const bf16_t*)(ws + WS_GLUW), Mrows, 512, 512}; pg8::StaticOrder S; S.init(Mrows, 512, G, bid);
                EpiGlu E{(const bf16_t*)(ws + WS_KF), (const bf16_t*)(ws + WS_P), (bf16_t*)(ws + WS_H), a.in[I_GLUB] + (size_t)l * 512};
                pg8::gemm_phase<EpiGlu, pg8::StaticOrder>(lds, g, S, E, tid);
            } else if (EN(8)) {
                pg8::Gemm g{(const bf16_t*)(ws + WS_H), (const bf16_t*)(ws + WS_WOUT), Mrows, D, D}; pg8::StaticOrder S; S.init(Mrows, D, G, bid);
                EpiOut E{l == 0 ? a.in[I_X] : a.out, a.in[I_CTX], a.out, (float*)(ws + WS_XC1), MOD + (size_t)l * 5 * ADA};
                pg8::gemm_phase<EpiOut, pg8::StaticOrder>(lds, g, S, E, tid);
            }
        }
#ifdef REP_SUB
        if (ph != PH_PREP && ph != PH_FNORM && ((ph - 1) % PH_PER_LAYER) == REP_SUB && !((repmask >> ((ph - 1) / PH_PER_LAYER)) & 1)) { repmask |= 1 << ((ph - 1) / PH_PER_LAYER); xcd_barrier(gbar); --ph; continue; }
#endif
        if (ph + 1 < ka.ph_hi) xcd_barrier(gbar);
    }
}

#ifndef MK_LAUNCH_PER_PHASE
#define MK_LAUNCH_PER_PHASE 0
#endif
extern "C" void kernel_launch(void* const* d_in, const int* in_sizes, int n_in, void* d_out, int out_size, void* d_ws, size_t ws_size, hipStream_t stream) {
    static int grid = 0;
    if (grid == 0) {
        if (n_in != N_IN || out_size != NLAT * D || ws_size < WS_END2) { fprintf(stderr, "kernel_launch: unexpected shapes (n_in %d, out %d, ws %zu < %zu); nothing launched\n", n_in, out_size, ws_size, (size_t)WS_END2); grid = -1; return; }
        int dev = 0, cus = 0, per_cu = 0;
        if (hipGetDevice(&dev) != hipSuccess || hipDeviceGetAttribute(&cus, hipDeviceAttributeMultiprocessorCount, dev) != hipSuccess) { grid = -1; return; }
        if (hipFuncSetAttribute((const void*)fwd_kernel, hipFuncAttributeMaxDynamicSharedMemorySize, LDS_BYTES) != hipSuccess) { fprintf(stderr, "kernel_launch: hipFuncSetAttribute failed\n"); grid = -1; return; }
        if (hipOccupancyMaxActiveBlocksPerMultiprocessor(&per_cu, (const void*)fwd_kernel, NT, LDS_BYTES) != hipSuccess || per_cu < 1) { fprintf(stderr, "kernel_launch: occupancy query says %d blocks per CU\n", per_cu); per_cu = 1; }
        (void)hipGetLastError();
        grid = cus;
    }
    if (grid < 0) return;
    (void)hipMemsetAsync((char*)d_ws + WS_CTL, 0, WS_ZERO_BYTES, stream);
    Args a{};
    for (int i = 0; i < N_IN; ++i) a.in[i] = (const float*)d_in[i];
    a.out = (float*)d_out; a.ws = (unsigned char*)d_ws;
#if MK_LAUNCH_PER_PHASE
    for (int ph = 0; ph < N_PHASES; ++ph) {
        a.ph_lo = ph; a.ph_hi = ph + 1;
        hipLaunchKernelGGL(fwd_kernel, dim3(grid), dim3(NT), LDS_BYTES, stream, a);
    }
#else
    a.ph_lo = 0; a.ph_hi = N_PHASES;
    void* args[] = {&a};
    hipError_t e = hipLaunchCooperativeKernel((const void*)fwd_kernel, dim3(grid), dim3(NT), args, LDS_BYTES, stream);
    if (e != hipSuccess) fprintf(stderr, "kernel_launch: cooperative launch failed: %s (grid %d)\n", hipGetErrorString(e), grid);
#endif
}
```

```cpp
#include <hip/hip_runtime.h>
#include <hip/hip_cooperative_groups.h>
#include <cstdio>
#include <cstdint>
namespace cg = cooperative_groups;

#define LAS __attribute__((address_space(3)))
typedef unsigned short bf16_t;
typedef float f32x4 __attribute__((ext_vector_type(4)));
typedef float f32x2 __attribute__((ext_vector_type(2)));
typedef unsigned u32x4 __attribute__((ext_vector_type(4)));
typedef unsigned u32x2 __attribute__((ext_vector_type(2)));

constexpr int D = 2048, NB = 4, SEQL = 4096, LC = 256, NLAT = NB * SEQL, NCTX = NB * LC, MR = NLAT + NCTX;
constexpr int BR = 512, INW = 6688, NPAD = 6912, LDP = 4608, ADA = 3 * D;
constexpr int NT = 512, NWAVES = 8;
constexpr float EPS = 1e-6f;
constexpr int PC_S5U = 0, PC_S5G = 512, PC_RQ = 1024, PC_RK = 1536, PC_RV = 2048, PC_RG = 2560, PC_GQ = 3072, PC_GK = 3328, PC_GV = 3584, PC_GG = 4096;
constexpr int PT_V = 0, PT_G1 = 512, PT_G2 = 1024, PT_HG = 1536;
constexpr int FFTN = 8192;

enum { I_X = 0, I_C, I_CTX, I_CCTX, I_NORMW, I_ADAW, I_ADAB, I_WIN, I_WOUT, I_S5ARE, I_S5AIM, I_S5LDT, I_S5BRE, I_S5BIM, I_S5CRE, I_S5CIM,
       I_S5D, I_GLUW, I_GLUB, I_HCW, I_HCB, I_HW1, I_HB1, I_HF1, I_HW2, I_HB2, I_HF2, I_HW3, I_HB3, I_HF3, I_HW4, I_HBIAS, I_RNW, I_GGW, I_GGB, I_GNW, I_FNW, N_IN };

constexpr size_t al256(size_t x) { return (x + 255) & ~(size_t)255; }
constexpr size_t WS_CTL  = 0;
constexpr size_t WS_MOD  = WS_CTL + 65536;
constexpr size_t WS_ZERO_BYTES = 65536 + al256((size_t)2 * 5 * ADA * 4);
constexpr size_t WS_S5AB = WS_MOD + al256((size_t)2 * 5 * ADA * 4);
constexpr size_t WS_S5BT = WS_S5AB + (size_t)2 * 2 * 32 * 64 * 8;
constexpr size_t WS_H3   = WS_S5BT + (size_t)1048576 + 65536;
constexpr size_t WS_H3C  = WS_H3 + (size_t)2 * 4096 * 64 * 4;
constexpr size_t WS_KC   = WS_H3C + (size_t)256 * 64 * 4;
constexpr size_t WS_LR   = WS_KC + (size_t)2 * 512 * 512 * 4;
constexpr size_t WS_XC1  = WS_LR + (size_t)MR * 32 * 4;
constexpr size_t WS_WOUT = WS_XC1 + (size_t)NCTX * D * 4;
constexpr size_t WS_GLUW = WS_WOUT + (size_t)D * D * 2;
constexpr size_t WS_WIN  = WS_GLUW + (size_t)512 * 512 * 2;
constexpr size_t WS_H    = WS_WIN + (size_t)NPAD * D * 2;
constexpr size_t WS_P    = WS_H + (size_t)MR * D * 2;
constexpr size_t WS_PT   = WS_P + (size_t)MR * LDP * 2;
constexpr size_t WS_KF   = WS_PT + (size_t)2048 * MR * 2;
constexpr size_t WS_OB   = WS_KF + (size_t)2 * 512 * FFTN * 8;
constexpr size_t WS_END  = WS_OB + (size_t)6 * MR * 512 * 2;
constexpr size_t OBSZ = (size_t)MR * 512;

constexpr int LDS_CTL_OFF = 131072 + 2048;
constexpr int LDS_PTR_OFF = LDS_CTL_OFF + 64;
constexpr int LDS_BYTES = LDS_PTR_OFF + 320;

typedef __bf16 hwbf16x2 __attribute__((ext_vector_type(2)));
__device__ __forceinline__ unsigned pk2(float lo, float hi) { const f32x2 v = {lo, hi}; return __builtin_bit_cast(unsigned, __builtin_convertvector(v, hwbf16x2)); }
__device__ __forceinline__ unsigned f2bf(float f) { return pk2(f, 0.f) & 0xffffu; }
__device__ __forceinline__ float bf2f(bf16_t b) { return __uint_as_float((unsigned)b << 16); }
__device__ __forceinline__ float bflo(unsigned w) { return __uint_as_float(w << 16); }
__device__ __forceinline__ float bfhi(unsigned w) { return __uint_as_float(w & 0xffff0000u); }
__device__ __forceinline__ void unpack8(const u32x4 r, float (&f)[8]) { f[0] = bflo(r.x); f[1] = bfhi(r.x); f[2] = bflo(r.y); f[3] = bfhi(r.y); f[4] = bflo(r.z); f[5] = bfhi(r.z); f[6] = bflo(r.w); f[7] = bfhi(r.w); }
__device__ __forceinline__ u32x4 pack8(const float (&f)[8]) { u32x4 o; o.x = pk2(f[0], f[1]); o.y = pk2(f[2], f[3]); o.z = pk2(f[4], f[5]); o.w = pk2(f[6], f[7]); return o; }
__device__ __forceinline__ float sigmoidf_(float x) { return 1.0f / (1.0f + __expf(-x)); }
__device__ __forceinline__ float siluf_(float x) { return x * sigmoidf_(x); }
__device__ __forceinline__ float gelu_tanh(float x) { const float u = 0.7978845608028654f * (x + 0.044715f * x * x * x); return 0.5f * x * (1.0f + tanhf(u)); }
__device__ __forceinline__ float wave_sum(float v) {
#pragma unroll
    for (int o = 1; o < 64; o <<= 1) v += __shfl_xor(v, o);
    return v;
}
#define LDS_WAIT() asm volatile("s_waitcnt lgkmcnt(0)" ::: "memory")

struct Args { const float* in[N_IN]; float* out; unsigned char* ws; int ph_lo, ph_hi; };
struct InTab { const LAS unsigned long long* t;
    __device__ __forceinline__ const float* operator[](int i) const { const unsigned long long v = t[i];
        const unsigned lo = __builtin_amdgcn_readfirstlane((unsigned)v), hi = __builtin_amdgcn_readfirstlane((unsigned)(v >> 32)); return (const float*)(((unsigned long long)hi << 32) | lo); } };
struct DArgs { InTab in; float* out; };

#define XB_TMO      128
#define XB_XCNT(j)  (256  + 64 * (j))
#define XB_XSUB(j)  (1280 + 64 * (j))
#define XB_XGEN(j)  (2304 + 64 * (j))
#define XB_TOP      3328
#define XB_TOPGEN   3392
#define XCD_BAR_WORDS 3456
#define XB_SPIN_CAP (1u << 22)
__device__ __forceinline__ unsigned xb_ld(unsigned* p)              { return __hip_atomic_load(p, __ATOMIC_RELAXED, __HIP_MEMORY_SCOPE_AGENT); }
__device__ __forceinline__ unsigned xb_add(unsigned* p, unsigned v) { return __hip_atomic_fetch_add(p, v, __ATOMIC_RELAXED, __HIP_MEMORY_SCOPE_AGENT); }
__device__ __forceinline__ unsigned xb_xcc_id() { return (unsigned)__builtin_amdgcn_s_getreg((3 << 11) | 20) & 0xFu; }
#define XB_SPIN(cond, bar) do { unsigned _sp = 0; while (cond) { __builtin_amdgcn_s_sleep(1); \
    if ((++_sp & 255u) == 0u) { if (xb_ld(&(bar)[XB_TMO])) break; if (_sp > XB_SPIN_CAP) { atomicAdd(&(bar)[XB_TMO], 1u); break; } } } } while (0)
struct XcdBarrier { unsigned* bar; unsigned x; volatile LAS unsigned* st; };
__device__ __forceinline__ XcdBarrier xcd_barrier_post(unsigned* bar, volatile LAS unsigned* st) {
    XcdBarrier b; b.bar = bar; b.x = xb_xcc_id(); b.st = st;
    if (threadIdx.x == 0) (void)xb_add(&bar[XB_XCNT(b.x)], 1u);
    return b;
}
__device__ __forceinline__ void xcd_barrier_complete(unsigned* bar, unsigned x, unsigned& nloc, unsigned& nx) {
    const unsigned G = gridDim.x * gridDim.y * gridDim.z;
    unsigned sum, cnt, mine, sp = 0u;
    for (;;) {
        sum = 0u; cnt = 0u; mine = 0u;
#pragma unroll
        for (unsigned j = 0; j < 16; ++j) { const unsigned c = xb_ld(&bar[XB_XCNT(j)]); sum += c; cnt += (c > 0u) ? 1u : 0u; mine = (j == x) ? c : mine; }
        if (sum == G) break;
        __builtin_amdgcn_s_sleep(1);
        if ((++sp & 255u) == 0u) { if (xb_ld(&bar[XB_TMO])) break; if (sp > XB_SPIN_CAP) { atomicAdd(&bar[XB_TMO], 1u); break; } }
    }
    nloc = mine > 0u ? mine : 1u; nx = cnt > 0u ? cnt : 1u;
}
__device__ __forceinline__ void xcd_barrier(const XcdBarrier& b) {
    asm volatile("s_waitcnt vmcnt(0)" ::: "memory");
    __syncthreads();
    if (threadIdx.x == 0) {
        unsigned* bar = b.bar;
        __builtin_amdgcn_s_waitcnt(0);
        unsigned nloc = b.st[0], nx = b.st[1];
        if (nloc == 0u) { xcd_barrier_complete(bar, b.x, nloc, nx); b.st[0] = nloc; b.st[1] = nx; }
        const unsigned old = xb_add(&bar[XB_XSUB(b.x)], 1u);
        const unsigned gen = old / nloc;
        if (old + 1u == (gen + 1u) * nloc) {
            __builtin_amdgcn_fence(__ATOMIC_RELEASE, "agent");
            asm volatile("s_waitcnt vmcnt(0)" ::: "memory");
            const unsigned og = xb_add(&bar[XB_TOP], 1u);
            const unsigned tg = og / nx;
            if (og + 1u == (tg + 1u) * nx) xb_add(&bar[XB_TOPGEN], 1u);
            else XB_SPIN(xb_ld(&bar[XB_TOPGEN]) == tg, bar);
            __builtin_amdgcn_fence(__ATOMIC_ACQUIRE, "agent");
            xb_add(&bar[XB_XGEN(b.x)], 1u);
            asm volatile("s_waitcnt vmcnt(0)" ::: "memory");
        } else {
            XB_SPIN(xb_ld(&bar[XB_XGEN(b.x)]) == gen, bar);
            __builtin_amdgcn_fence(__ATOMIC_ACQUIRE, "agent");
            asm volatile("s_waitcnt vmcnt(0)" ::: "memory");
        }
    }
    __syncthreads();
}
namespace pg8 {
#define PG8_LAS __attribute__((address_space(3)))
typedef unsigned short bf16_t;
typedef short bf16x8 __attribute__((ext_vector_type(8)));
typedef float f32x4 __attribute__((ext_vector_type(4)));
typedef unsigned u32x4 __attribute__((ext_vector_type(4)));
constexpr int BM = 256, BK = 64, HALF = 128, HTB = HALF * BK * 2, STAGE_BYTES = 8 * HTB, NXCD = 8, WGM = 8;

__host__ __device__ __forceinline__ int lds_byte(int r, int c) { const int st = (r >> 4) * 2 + (c >> 5), rr = r & 15, cc = c & 31, ob = rr * 64 + cc * 2; return st * 1024 + (ob ^ (((ob >> 9) & 1) << 5)); }
__host__ __device__ __forceinline__ void stage_rc(int b, int& R, int& C) { const int st = b / 1024, sb = b % 1024, swz = sb ^ (((sb >> 9) & 1) << 5); R = (st >> 1) * 16 + swz / 64; C = (st & 1) * 32 + (swz % 64) / 2; }
__host__ __device__ __forceinline__ int perm32(int rho) { const int n = rho >> 4, i = rho & 15; return 8 * (i >> 2) + 4 * n + (i & 3); }

struct Unit { int pm, pn; };
struct Gemm { const bf16_t* A; const bf16_t* Bt; int M, N, K; };

struct StaticOrder {
    int nM, nN, nwg, G, c;
    __host__ __device__ void init(int M, int N, int G_, int c_) { nM = M / BM; nN = N / BM; nwg = nM * nN; G = G_; c = c_; }
    __host__ __device__ bool next(int i, Unit& u) const {
        const long L = (long)i * G + c; if (L >= nwg) return false;
        int wgid = (int)L; { const int q = nwg / NXCD, r = nwg % NXCD, xcd = wgid % NXCD, off = wgid / NXCD; wgid = (xcd < r ? xcd * (q + 1) : r * (q + 1) + (xcd - r) * q) + off; }
        const int nig = WGM * nN, gid = wgid / nig, fm = gid * WGM, gsz = (nM - fm) < WGM ? (nM - fm) : WGM;
        u.pm = fm + ((wgid % nig) % gsz); u.pn = (wgid % nig) / gsz; return true;
    }
    __device__ __forceinline__ void a_ready(const Unit&) const {}
    __device__ __forceinline__ void done(const Unit&) const {}
};

template <class Epi, class Sched, bool ALIGN_EPI = false, bool SP2 = false>
__device__ __forceinline__ void gemm_phase(PG8_LAS unsigned char* lds, const Gemm g, const Sched& S, const Epi& E, const int tid) {
    const int wid = __builtin_amdgcn_readfirstlane(tid >> 6), lane = tid & 63, wr = wid >> 2, wc = wid & 3, fr = lane & 15, fq = lane >> 4;
    const int K = g.K, nt = K / BK;
    unsigned voffA[2], voffB[2];
#pragma unroll
    for (int i = 0; i < 2; ++i) { int R, C; stage_rc(tid * 16 + i * 8192, R, C); const int Rb = Epi::PERM ? ((R & ~31) + perm32(R & 31)) : R;
        voffA[i] = (unsigned)(R * K + C) * 2u; voffB[i] = (unsigned)(Rb * K + C) * 2u; }
    const size_t kstep = (size_t)(BK * 2);
    const size_t hstep = (size_t)HALF * K * 2;
    const size_t tstep = 2 * hstep;
    const unsigned ldsw = (unsigned)wid * 1024u;
    const int aoff = lds_byte(wr * 64 + fr, fq * 8), boff = lds_byte(wc * 32 + fr, fq * 8);
#define PG8_SA(b, h) (((b) * 2 + (h)) * HTB)
#define PG8_SB(b, h) ((4 + (b) * 2 + (h)) * HTB)
#define PG8_STAGE(bufoff, gbase, voff) do { _Pragma("unroll") for (int _i = 0; _i < 2; ++_i) \
        __builtin_amdgcn_global_load_lds((const unsigned*)((const char*)(gbase) + (voff)[_i]), (PG8_LAS unsigned*)(lds + (bufoff) + ldsw + _i * 8192), 16, 0, 0); } while (0)
#define PG8_LDA(dst, b, h) do { _Pragma("unroll") for (int m = 0; m < 4; ++m) _Pragma("unroll") for (int k = 0; k < 2; ++k) dst[m][k] = *(const PG8_LAS bf16x8*)(lds + PG8_SA(b, h) + aoff + m * 2048 + k * 1024); } while (0)
#define PG8_LDB(dst, b, h) do { _Pragma("unroll") for (int n = 0; n < 2; ++n) _Pragma("unroll") for (int k = 0; k < 2; ++k) dst[n][k] = *(const PG8_LAS bf16x8*)(lds + PG8_SB(b, h) + boff + n * 2048 + k * 1024); } while (0)
#define PG8_MMA(ai, bj, At, Bt) do { __builtin_amdgcn_s_setprio(1); _Pragma("unroll") for (int m = 0; m < 4; ++m) _Pragma("unroll") for (int n = 0; n < 2; ++n) _Pragma("unroll") for (int k = 0; k < 2; ++k) \
        acc[ai][bj][m][n] = __builtin_amdgcn_mfma_f32_16x16x32_bf16(Bt[n][k], At[m][k], acc[ai][bj][m][n], 0, 0, 0); __builtin_amdgcn_s_setprio(0); } while (0)
#define PG8_WAIT_V(n) asm volatile("s_waitcnt vmcnt(" #n ")" ::: "memory")
#define PG8_WAIT_L(n) asm volatile("s_waitcnt lgkmcnt(" #n ")" ::: "memory")
#define PG8_BAR __builtin_amdgcn_s_barrier()
#define PG8_SCHED __builtin_amdgcn_sched_barrier(0)
    Unit cur, nxt; int ui = 0;
    if (!S.next(0, cur)) return;
    f32x4 acc[2][2][4][2];
#pragma unroll
    for (int a = 0; a < 2; ++a)
#pragma unroll
        for (int b = 0; b < 2; ++b)
#pragma unroll
            for (int m = 0; m < 4; ++m)
#pragma unroll
                for (int n = 0; n < 2; ++n) acc[a][b][m][n] = (f32x4){0.f, 0.f, 0.f, 0.f};
    bf16x8 At[4][2], B0[2][2], B1[2][2];
    const char* cA = (const char*)g.A + (size_t)cur.pm * tstep; const char* cB = (const char*)g.Bt + (size_t)cur.pn * tstep;
    S.a_ready(cur);
    if constexpr (SP2) {
        PG8_STAGE(PG8_SB(0, 0), cB, voffB); PG8_STAGE(PG8_SB(0, 1), cB + hstep, voffB); PG8_STAGE(PG8_SA(0, 0), cA, voffA); PG8_STAGE(PG8_SA(0, 1), cA + hstep, voffA);
        if (wr == 1) PG8_BAR;
        PG8_WAIT_V(2); PG8_BAR;
        PG8_STAGE(PG8_SB(1, 0), cB + kstep, voffB); PG8_STAGE(PG8_SA(1, 0), cA + kstep, voffA); PG8_STAGE(PG8_SB(1, 1), cB + hstep + kstep, voffB);
        PG8_WAIT_V(6); PG8_BAR;
    } else {
        PG8_STAGE(PG8_SB(0, 0), cB, voffB); PG8_STAGE(PG8_SA(0, 0), cA, voffA); PG8_STAGE(PG8_SB(0, 1), cB + hstep, voffB); PG8_STAGE(PG8_SA(0, 1), cA + hstep, voffA);
        if (wr == 1) PG8_BAR;
        PG8_WAIT_V(4); PG8_BAR;
        PG8_STAGE(PG8_SB(1, 0), cB + kstep, voffB); PG8_STAGE(PG8_SA(1, 0), cA + kstep, voffA); PG8_STAGE(PG8_SB(1, 1), cB + hstep + kstep, voffB);
        PG8_WAIT_V(6); PG8_BAR;
    }
    for (;;) {
        const bool has_next = S.next(ui + 1, nxt);
        const char* nA = has_next ? (const char*)g.A + (size_t)nxt.pm * tstep : cA; const char* nB = has_next ? (const char*)g.Bt + (size_t)nxt.pn * tstep : cB;
        for (int t = 0; t < nt; t += 2) {
            const bool last = (t == nt - 2);
            const char* a1 = cA + (size_t)(t + 1) * kstep;
            const char* a2 = last ? nA : cA + (size_t)(t + 2) * kstep; const char* b2 = last ? nB : cB + (size_t)(t + 2) * kstep;
            const char* a3 = a2 + kstep; const char* b3 = b2 + kstep;
            if (last && has_next) S.a_ready(nxt);
            if constexpr (SP2) {
            PG8_LDB(B0, 0, 0); PG8_LDB(B1, 0, 1); PG8_SCHED; PG8_LDA(At, 0, 0); PG8_STAGE(PG8_SA(1, 1), a1 + hstep, voffA);
            PG8_WAIT_V(8); PG8_WAIT_L(0); PG8_BAR; PG8_MMA(0, 0, At, B0); PG8_MMA(0, 1, At, B1); PG8_BAR; PG8_SCHED;
            PG8_LDA(At, 0, 1); PG8_STAGE(PG8_SB(0, 0), b2, voffB); PG8_STAGE(PG8_SB(0, 1), b2 + hstep, voffB); PG8_STAGE(PG8_SA(0, 0), a2, voffA);
            PG8_WAIT_V(8); PG8_WAIT_L(0); PG8_BAR; PG8_MMA(1, 0, At, B0); PG8_MMA(1, 1, At, B1); PG8_BAR; PG8_SCHED;
            PG8_LDB(B0, 1, 0); PG8_LDB(B1, 1, 1); PG8_SCHED; PG8_LDA(At, 1, 0); PG8_STAGE(PG8_SA(0, 1), a2 + hstep, voffA);
            PG8_WAIT_V(8); PG8_WAIT_L(0); PG8_BAR; PG8_MMA(0, 0, At, B0); PG8_MMA(0, 1, At, B1); PG8_BAR; PG8_SCHED;
            PG8_LDA(At, 1, 1); PG8_STAGE(PG8_SB(1, 0), b3, voffB); PG8_STAGE(PG8_SB(1, 1), b3 + hstep, voffB); PG8_STAGE(PG8_SA(1, 0), a3, voffA);
            PG8_WAIT_V(8); PG8_WAIT_L(0); PG8_BAR; PG8_MMA(1, 0, At, B0); PG8_MMA(1, 1, At, B1); PG8_BAR; PG8_SCHED;
            } else {
            PG8_LDB(B0, 0, 0); PG8_SCHED; PG8_LDA(At, 0, 0); PG8_STAGE(PG8_SA(1, 1), a1 + hstep, voffA);
            PG8_WAIT_L(8); PG8_BAR; PG8_WAIT_L(0); PG8_MMA(0, 0, At, B0); PG8_BAR; PG8_SCHED;
            PG8_LDB(B1, 0, 1); PG8_STAGE(PG8_SB(0, 0), b2, voffB);
            PG8_BAR; PG8_WAIT_L(0); PG8_MMA(0, 1, At, B1); PG8_BAR;
            PG8_LDA(At, 0, 1); PG8_STAGE(PG8_SA(0, 0), a2, voffA);
            PG8_BAR; PG8_WAIT_L(0); PG8_MMA(1, 0, At, B0); PG8_BAR; PG8_SCHED;
            PG8_STAGE(PG8_SB(0, 1), b2 + hstep, voffB);
            PG8_WAIT_V(6); PG8_BAR; PG8_MMA(1, 1, At, B1); PG8_BAR;
            PG8_LDB(B0, 1, 0); PG8_SCHED; PG8_LDA(At, 1, 0); PG8_STAGE(PG8_SA(0, 1), a2 + hstep, voffA);
            PG8_WAIT_L(8); PG8_BAR; PG8_WAIT_L(0); PG8_MMA(0, 0, At, B0); PG8_BAR; PG8_SCHED;
            PG8_LDB(B1, 1, 1); PG8_STAGE(PG8_SB(1, 0), b3, voffB);
            PG8_BAR; PG8_WAIT_L(0); PG8_MMA(0, 1, At, B1); PG8_BAR;
            PG8_LDA(At, 1, 1); PG8_STAGE(PG8_SA(1, 0), a3, voffA);
            PG8_BAR; PG8_WAIT_L(0); PG8_MMA(1, 0, At, B0); PG8_BAR; PG8_SCHED;
            PG8_STAGE(PG8_SB(1, 1), b3 + hstep, voffB);
            PG8_WAIT_V(6); PG8_BAR; PG8_MMA(1, 1, At, B1); PG8_BAR;
            }
        }
        if constexpr (ALIGN_EPI) { if (wr == 0) PG8_BAR; }
        E(acc, cur, wr, wc, fr, fq); S.done(cur);
        if (!has_next) break;
#pragma unroll
        for (int a = 0; a < 2; ++a)
#pragma unroll
            for (int b = 0; b < 2; ++b)
#pragma unroll
                for (int m = 0; m < 4; ++m)
#pragma unroll
                    for (int n = 0; n < 2; ++n) acc[a][b][m][n] = (f32x4){0.f, 0.f, 0.f, 0.f};
        cur = nxt; cA = nA; cB = nB; ++ui;
        if constexpr (ALIGN_EPI) { if (wr == 1) PG8_BAR; }
    }
    PG8_WAIT_V(0);
    if constexpr (!ALIGN_EPI) { if (wr == 0) PG8_BAR; }
    PG8_BAR;
#undef PG8_SA
#undef PG8_SB
#undef PG8_STAGE
#undef PG8_LDA
#undef PG8_LDB
#undef PG8_MMA
#undef PG8_WAIT_V
#undef PG8_WAIT_L
#undef PG8_BAR
#undef PG8_SCHED
}
}
__device__ __forceinline__ void prep_adaln(const float* c, const float* cctx, const float* adaw, const float* adab, float* MOD, int it, LAS float* sv, int tid) {
    const int l = it / 384, r = it % 384, ntile = r >> 5, ks = r & 31, k0 = ks * 64;
    if (tid < 320) { const int v = tid >> 6, k = tid & 63; const float cv = v < 4 ? c[v * D + k0 + k] : cctx[k0 + k]; sv[tid] = cv / (1.0f + expf(-cv)); }
    __syncthreads();
    const int n = ntile * 512 + tid; const float* w = adaw + (size_t)l * D * ADA + (size_t)k0 * ADA + n;
    float acc[5] = {0.f, 0.f, 0.f, 0.f, 0.f};
#pragma unroll 8
    for (int k = 0; k < 64; ++k) { const float wv = w[(size_t)k * ADA];
#pragma unroll
        for (int v = 0; v < 5; ++v) acc[v] += sv[v * 64 + k] * wv; }
    if (ks == 0) { const float bb = adab[l * ADA + n];
#pragma unroll
        for (int v = 0; v < 5; ++v) acc[v] += bb; }
#pragma unroll
    for (int v = 0; v < 5; ++v) atomicAdd(MOD + (size_t)(l * 5 + v) * ADA + n, acc[v]);
    __syncthreads();
}

__device__ __forceinline__ void prep_s5(const DArgs& a, unsigned char* ws, int it, int tid) {
    const int idx = it * 512 + tid;
    const float a_re = a.in[I_S5ARE][idx], a_im = a.in[I_S5AIM][idx], ldt = a.in[I_S5LDT][idx >> 6];
    const float dt = expf(ldt), mag = expf(a_re * dt);
    float sn, cs; sincosf(a_im * dt, &sn, &cs);
    const float ab_re = mag * cs, ab_im = mag * sn, den = a_re * a_re + a_im * a_im, nr = ab_re - 1.0f;
    const float co_re = (nr * a_re + ab_im * a_im) / den, co_im = (ab_im * a_re - nr * a_im) / den;
    ((f32x2*)(ws + WS_S5AB))[idx] = (f32x2){ab_re, ab_im};
    const float* bre = a.in[I_S5BRE] + (size_t)idx * 16; const float* bim = a.in[I_S5BIM] + (size_t)idx * 16;
    f32x2* bt = (f32x2*)(ws + WS_S5BT) + (size_t)idx * 16;
#pragma unroll
    for (int i = 0; i < 16; ++i) { const float br = bre[i], bi = bim[i]; bt[i] = (f32x2){co_re * br - co_im * bi, co_re * bi + co_im * br}; }
}

__device__ __forceinline__ void prep_hymlp(const DArgs& a, float* H3out, bf16_t* H3b, int l, int Lx, int t0, LAS unsigned char* lds, int tid) {
    LAS float* zs = (LAS float*)lds;
    LAS float* h1 = (LAS float*)(lds + 4608);
    LAS float* h2 = (LAS float*)(lds + 4608 + 8192);
    LAS float* w1s = (LAS float*)(lds + 24576);
    LAS float* w2s = w1s + 33 * 64;
    LAS float* w3s = w2s + 64 * 64;
    { const float* w1 = a.in[I_HW1] + (size_t)l * 33 * 64; const float* w2 = a.in[I_HW2] + (size_t)l * 64 * 64; const float* w3 = a.in[I_HW3] + (size_t)l * 64 * 64;
      for (int i = tid; i < 33 * 64; i += NT) w1s[i] = w1[i];
      for (int i = tid; i < 64 * 64; i += NT) { w2s[i] = w2[i]; w3s[i] = w3[i]; } }
    for (int i = tid; i < 32 * 33; i += NT) { const int pos = i / 33, f = i % 33, t = t0 + pos;
        float z;
        if (f == 0) z = (float)t / (float)(Lx - 1);
        else { const int j = (f - 1) & 15; const float fj = 1e-4f + (float)j * ((15.0f - 1e-4f) / 15.0f); const float wpos = (6.283185307179586f * (float)t) / (float)Lx; const float arg = fj * wpos;
               z = (f <= 16) ? cosf(arg) : -sinf(arg); }
        zs[pos * 36 + f] = z; }
    __syncthreads();
    const int pos = tid >> 4, f4 = (tid & 15) * 4, t = t0 + pos;
    f32x4 s = *(const f32x4*)(a.in[I_HB1] + l * 64 + f4);
#pragma unroll 3
    for (int j = 0; j < 33; ++j) s += zs[pos * 36 + j] * *(const LAS f32x4*)(w1s + j * 64 + f4);
    { const f32x4 fr = *(const f32x4*)(a.in[I_HF1] + l * 64 + f4); *(LAS f32x4*)(h1 + pos * 64 + f4) = (f32x4){sinf(fr.x * s.x), sinf(fr.y * s.y), sinf(fr.z * s.z), sinf(fr.w * s.w)}; }
    __syncthreads();
    s = *(const f32x4*)(a.in[I_HB2] + l * 64 + f4);
#pragma unroll 4
    for (int j = 0; j < 64; ++j) s += h1[pos * 64 + j] * *(const LAS f32x4*)(w2s + j * 64 + f4);
    { const f32x4 fr = *(const f32x4*)(a.in[I_HF2] + l * 64 + f4); *(LAS f32x4*)(h2 + pos * 64 + f4) = (f32x4){sinf(fr.x * s.x), sinf(fr.y * s.y), sinf(fr.z * s.z), sinf(fr.w * s.w)}; }
    __syncthreads();
    s = *(const f32x4*)(a.in[I_HB3] + l * 64 + f4);
#pragma unroll 4
    for (int j = 0; j < 64; ++j) s += h2[pos * 64 + j] * *(const LAS f32x4*)(w3s + j * 64 + f4);
    { const f32x4 fr = *(const f32x4*)(a.in[I_HF3] + l * 64 + f4); const f32x4 hv = (f32x4){sinf(fr.x * s.x), sinf(fr.y * s.y), sinf(fr.z * s.z), sinf(fr.w * s.w)}; *(f32x4*)(H3out + (size_t)t * 64 + f4) = hv;
      if (H3b) { u32x2 pk; pk.x = pk2(hv.x, hv.y); pk.y = pk2(hv.z, hv.w); *(u32x2*)(H3b + (size_t)t * 64 + f4) = pk; } }
    __syncthreads();
}

__device__ __forceinline__ void transpose_item(const float* W, int ldw, int srccol_lane  , int k0, bf16_t* WT, int K, int dstrow0, LAS float* scr, int lane) {
#pragma unroll 8
    for (int i = 0; i < 32; ++i) { const int kk = 2 * i + (lane >> 5); scr[kk * 33 + (lane & 31)] = srccol_lane >= 0 ? W[(size_t)(k0 + kk) * ldw + srccol_lane] : 0.f; }
    LDS_WAIT();
    const int c = lane & 7;
#pragma unroll
    for (int j = 0; j < 4; ++j) { const int n = (lane >> 3) + 8 * j; const LAS float* s = scr + (8 * c) * 33 + n;
        u32x4 o; o.x = pk2(s[0 * 33], s[1 * 33]); o.y = pk2(s[2 * 33], s[3 * 33]); o.z = pk2(s[4 * 33], s[5 * 33]); o.w = pk2(s[6 * 33], s[7 * 33]);
        *(u32x4*)(WT + (size_t)(dstrow0 + n) * K + k0 + 8 * c) = o; }
    LDS_WAIT();
}
__device__ __forceinline__ int win_srccol(int n) {
    if (n >= 3072 && n < 4096) { const int u = (n - 3072) & 127, grp = u >> 3, e = u & 7; return (n & ~127) + (e < 4 ? 4 * grp + e : 64 + 4 * grp + (e - 4)); }
    return n < 6144 ? n : (n < 6656 ? n + 32 : (n < 6688 ? n - 512 : -1));
}

__device__ __forceinline__ void norm_row(const float* xrow, const float* nw, const float* mod, bf16_t* hrow, int lane) {
    f32x4 v[8]; float ss = 0.f;
#pragma unroll
    for (int j = 0; j < 8; ++j) { v[j] = ((const f32x4*)xrow)[lane + 64 * j]; ss += (v[j].x * v[j].x + v[j].y * v[j].y) + (v[j].z * v[j].z + v[j].w * v[j].w); }
    const float rstd = rsqrtf(wave_sum(ss) * (1.0f / D) + EPS);
#pragma unroll
    for (int j = 0; j < 8; ++j) { const int k = 4 * (lane + 64 * j);
        const f32x4 w = *(const f32x4*)(nw + k), sh = *(const f32x4*)(mod + k), sc = *(const f32x4*)(mod + D + k);
        const f32x4 o = v[j] * rstd * w * (sc + 1.0f) + sh;
        u32x2 pk; pk.x = pk2(o.x, o.y); pk.y = pk2(o.z, o.w);
        *(u32x2*)(hrow + k) = pk; }
}

__device__ __forceinline__ void fft_twiddles(LAS f32x2* W, int tid) {
    for (int j = tid; j < 4096; j += NT) { float s, c; sincospif(-(float)j * (1.0f / 4096.0f), &s, &c); W[j] = (f32x2){c, s}; }
}
template <int R, int BETA, bool INV> __device__ __forceinline__ void fft_pass(LAS f32x2* X, const LAS f32x2* W, int tid) {
    constexpr int LOW = BETA - R + 1, NG = FFTN >> R;
    for (int gi = tid; gi < NG; gi += NT) {
        const int base = ((gi >> LOW) << (BETA + 1)) | (gi & ((1 << LOW) - 1));
        f32x2 e[1 << R];
#pragma unroll
        for (int m = 0; m < (1 << R); ++m) e[m] = X[base + (m << LOW)];
#pragma unroll
        for (int ss = 0; ss < R; ++ss) {
            const int s = INV ? (R - 1 - ss) : ss; const int bit = BETA - s, h = 1 << (R - 1 - s);
#pragma unroll
            for (int m = 0; m < (1 << R); ++m) {
                if (m & h) continue;
                const int idx = base + (m << LOW); const int ex = (idx & ((1 << bit) - 1)) << (12 - bit);
                const f32x2 w = W[ex]; const f32x2 a_ = e[m], b_ = e[m | h];
                if (!INV) { const f32x2 d = a_ - b_; e[m] = a_ + b_; e[m | h] = (f32x2){d.x * w.x - d.y * w.y, d.x * w.y + d.y * w.x}; }
                else { const f32x2 t = (f32x2){b_.x * w.x + b_.y * w.y, b_.y * w.x - b_.x * w.y}; e[m] = a_ + t; e[m | h] = a_ - t; }
            }
        }
#pragma unroll
        for (int m = 0; m < (1 << R); ++m) X[base + (m << LOW)] = e[m];
    }
}
__device__ __forceinline__ void fft_forward(LAS f32x2* X, const LAS f32x2* W, int tid) {
    fft_pass<4, 12, false>(X, W, tid); __syncthreads(); fft_pass<3, 8, false>(X, W, tid); __syncthreads();
    fft_pass<3, 5, false>(X, W, tid); __syncthreads(); fft_pass<3, 2, false>(X, W, tid); __syncthreads();
}
__device__ __forceinline__ void fft_inverse(LAS f32x2* X, const LAS f32x2* W, int tid) {
    fft_pass<3, 2, true>(X, W, tid); __syncthreads(); fft_pass<3, 5, true>(X, W, tid); __syncthreads();
    fft_pass<3, 8, true>(X, W, tid); __syncthreads(); fft_pass<4, 12, true>(X, W, tid); __syncthreads();
}
__device__ __forceinline__ float block_sum(float v, LAS float* red, int tid) {
    v = wave_sum(v);
    if ((tid & 63) == 0) red[tid >> 6] = v;
    __syncthreads();
    float t = 0.f;
#pragma unroll
    for (int i = 0; i < NWAVES; ++i) t += red[i];
    __syncthreads();
    return t;
}
constexpr float HY_D0 = -3.0701134573253945f  , HY_D1 = -15.350567286626973f  ;

__device__ __forceinline__ void filt_item(const DArgs& a, unsigned char* ws, LAS unsigned char* lds, int l, int c, int tid) {
    LAS f32x2* X = (LAS f32x2*)lds; LAS f32x2* W = (LAS f32x2*)(lds + 65536); LAS float* w4s = (LAS float*)(lds + 98304); LAS float* red = (LAS float*)(lds + 98304 + 1024);
    LAS float* k1b = (LAS float*)(lds + 100352);
    fft_twiddles(W, tid);
    if (tid < 256) { const int cc = tid >> 6, f = tid & 63; w4s[tid] = a.in[I_HW4][(size_t)l * 64 * 2048 + (size_t)f * 2048 + (cc >> 1) * 1024 + (cc & 1) * 512 + c]; }
    __syncthreads();
    const float dl = fabsf(HY_D0 + (HY_D1 - HY_D0) * ((float)c / 511.0f));
    const float* H3 = (const float*)(ws + WS_H3) + (size_t)l * 4096 * 64;
    float ss0 = 0.f, ss1 = 0.f;
#pragma unroll 1
    for (int j = 0; j < 16; ++j) {
        const int n = tid + 512 * j; const int dir = j >= 8 ? 1 : 0; const int t = dir ? (8192 - n) : n;
        float s0 = 0.f, s1 = 0.f;
        if (n != 4096) {
            const f32x4* hr = (const f32x4*)(H3 + (size_t)t * 64);
#pragma unroll
            for (int q = 0; q < 16; ++q) { const f32x4 hv = hr[q]; const f32x4 wa = ((const LAS f32x4*)(w4s + (dir * 2 + 0) * 64))[q], wb = ((const LAS f32x4*)(w4s + (dir * 2 + 1) * 64))[q];
                s0 += (hv.x * wa.x + hv.y * wa.y) + (hv.z * wa.z + hv.w * wa.w); s1 += (hv.x * wb.x + hv.y * wb.y) + (hv.z * wb.z + hv.w * wb.w); }
            const float dec = expf(-((float)t / 4095.0f) * dl); s0 *= dec; s1 *= dec;
        }
        X[n] = (f32x2){s0, 0.f}; k1b[n] = s1; ss0 += s0 * s0; ss1 += s1 * s1;
    }
    const float rs0 = rsqrtf(block_sum(ss0, red, tid) + EPS), rs1 = rsqrtf(block_sum(ss1, red, tid) + EPS);
    f32x2* KF0 = (f32x2*)(ws + WS_KF) + (size_t)(0 * 512 + c) * FFTN; f32x2* KF1 = (f32x2*)(ws + WS_KF) + (size_t)(1 * 512 + c) * FFTN;
#pragma unroll 4
    for (int j = 0; j < 16; ++j) { const f32x2 x = X[tid + 512 * j]; X[tid + 512 * j] = (f32x2){x.x * rs0, 0.f}; }
    __syncthreads(); fft_forward(X, W, tid);
#pragma unroll 4
    for (int j = 0; j < 16; ++j) KF0[tid + 512 * j] = X[tid + 512 * j];
    __syncthreads();
#pragma unroll 4
    for (int j = 0; j < 16; ++j) X[tid + 512 * j] = (f32x2){k1b[tid + 512 * j] * rs1, 0.f};
    __syncthreads(); fft_forward(X, W, tid);
#pragma unroll 4
    for (int j = 0; j < 16; ++j) KF1[tid + 512 * j] = X[tid + 512 * j];
    __syncthreads();
}
__device__ __forceinline__ void filt_ctx_item(const DArgs& a, unsigned char* ws, LAS unsigned char* lds, int c, int tid) {
    LAS float* w4s = (LAS float*)lds; LAS float* red = (LAS float*)(lds + 1024);
    if (tid < 256) { const int cc = tid >> 6, f = tid & 63; w4s[tid] = a.in[I_HW4][(size_t)f * 2048 + (cc >> 1) * 1024 + (cc & 1) * 512 + c]; }
    __syncthreads();
    const float dl = fabsf(HY_D0 + (HY_D1 - HY_D0) * ((float)c / 511.0f));
    const float* H3C = (const float*)(ws + WS_H3C);
    const int n = tid, dir = n >= 256 ? 1 : 0, t = dir ? (512 - n) : n;
    float s0 = 0.f, s1 = 0.f;
    if (n != 256) {
        const f32x4* hr = (const f32x4*)(H3C + (size_t)t * 64);
#pragma unroll
        for (int q = 0; q < 16; ++q) { const f32x4 hv = hr[q]; const f32x4 wa = ((const LAS f32x4*)(w4s + (dir * 2 + 0) * 64))[q], wb = ((const LAS f32x4*)(w4s + (dir * 2 + 1) * 64))[q];
            s0 += (hv.x * wa.x + hv.y * wa.y) + (hv.z * wa.z + hv.w * wa.w); s1 += (hv.x * wb.x + hv.y * wb.y) + (hv.z * wb.z + hv.w * wb.w); }
        const float dec = expf(-((float)t / 255.0f) * dl); s0 *= dec; s1 *= dec;
    }
    const float rs0 = rsqrtf(block_sum(s0 * s0, red, tid) + EPS), rs1 = rsqrtf(block_sum(s1 * s1, red, tid) + EPS);
    float* KC = (float*)(ws + WS_KC);
    KC[(size_t)(0 * 512 + c) * 512 + n] = s0 * rs0; KC[(size_t)(1 * 512 + c) * 512 + n] = s1 * rs1;
    __syncthreads();
}

__device__ __forceinline__ void prep_rope(f32x2* RT, int it, int tid) {
    const int idx = it * NT + tid, pos = idx >> 6, j = idx & 63;
    float ang;
    if (pos < SEQL) { const float inv = exp2f(-(float)(j & 31) * (13.287712379549449f / 32.0f)); ang = (float)(j < 32 ? (pos >> 6) : (pos & 63)) * inv; }
    else { const float inv = exp2f(-(float)j * (13.287712379549449f / 64.0f)); ang = (float)(pos - SEQL) * inv; }
    float sn, cs; sincosf(ang, &sn, &cs);
    RT[idx] = (f32x2){cs, sn};
}

__device__ __forceinline__ void ret_chain(const bf16_t* P, bf16_t* O, int b, int h, int dir, bool ctx_out, int wave, int lane) {
    const int e = wave * 16 + (lane & 15), dq = lane >> 4;
    const float gamma = 1.0f - exp2f(-5.0f - (float)h);
    constexpr int TB = 2;
    float S[32];
#pragma unroll
    for (int i = 0; i < 32; ++i) S[i] = 0.f;
    for (int seg = 0; seg < 2; ++seg) {
        const int n = seg ? SEQL : LC, rowbase = seg ? b * SEQL : NLAT + b * LC; const bool wr_out = seg || ctx_out;
        for (int i0 = 0; i0 < n; i0 += TB) {
            u32x4 q[TB][4], k[TB][4]; bf16_t v[TB];
#pragma unroll
            for (int tb = 0; tb < TB; ++tb) { const int row = rowbase + (dir ? n - 1 - (i0 + tb) : i0 + tb); const bf16_t* pr = P + (size_t)row * LDP;
#pragma unroll
                for (int c4 = 0; c4 < 4; ++c4) { q[tb][c4] = ((const u32x4*)(pr + PC_RQ + h * 128 + dq * 32))[c4]; k[tb][c4] = ((const u32x4*)(pr + PC_RK + h * 128 + dq * 32))[c4]; }
                v[tb] = pr[PC_RV + h * 128 + e]; }
#pragma unroll
            for (int tb = 0; tb < TB; ++tb) {
                const int row = rowbase + (dir ? n - 1 - (i0 + tb) : i0 + tb);
                const float vf = bf2f(v[tb]); float o = 0.f;
#pragma unroll
                for (int c4 = 0; c4 < 4; ++c4) { float qf[8], kf[8]; unpack8(q[tb][c4], qf); unpack8(k[tb][c4], kf);
#pragma unroll
                    for (int x = 0; x < 8; ++x) { const int ix = c4 * 8 + x; S[ix] = gamma * S[ix] + kf[x] * vf; o += qf[x] * S[ix]; } }
                o += __shfl_xor(o, 16); o += __shfl_xor(o, 32);
                if (wr_out && dq == 0) O[(size_t)row * 512 + h * 128 + e] = (bf16_t)f2bf(o);
            }
        }
    }
}
__device__ __forceinline__ void gla_chain(const bf16_t* P, const bf16_t* GLGd, bf16_t* O, int b, int h, int dir, bool ctx_out, int wave, int lane) {
    const int e = wave * 16 + (lane & 15), dq = lane >> 4;
    constexpr int TB = 4;
    float S[16];
#pragma unroll
    for (int i = 0; i < 16; ++i) S[i] = 0.f;
    for (int seg = 0; seg < 2; ++seg) {
        const int n = seg ? SEQL : LC, rowbase = seg ? b * SEQL : NLAT + b * LC; const bool wr_out = seg || ctx_out;
        for (int i0 = 0; i0 < n; i0 += TB) {
            u32x4 q[TB][2], k[TB][2], g[TB][2]; bf16_t v[TB];
#pragma unroll
            for (int tb = 0; tb < TB; ++tb) { const int row = rowbase + (dir ? n - 1 - (i0 + tb) : i0 + tb); const bf16_t* pr = P + (size_t)row * LDP; const bf16_t* gr = GLGd + (size_t)row * 256 + h * 64 + dq * 16;
#pragma unroll
                for (int c4 = 0; c4 < 2; ++c4) { q[tb][c4] = ((const u32x4*)(pr + PC_GQ + h * 64 + dq * 16))[c4]; k[tb][c4] = ((const u32x4*)(pr + PC_GK + h * 64 + dq * 16))[c4]; g[tb][c4] = ((const u32x4*)gr)[c4]; }
                v[tb] = pr[PC_GV + h * 128 + e]; }
#pragma unroll
            for (int tb = 0; tb < TB; ++tb) {
                const int row = rowbase + (dir ? n - 1 - (i0 + tb) : i0 + tb);
                const float vf = bf2f(v[tb]); float o = 0.f;
#pragma unroll
                for (int c4 = 0; c4 < 2; ++c4) { float qf[8], kf[8], gf[8]; unpack8(q[tb][c4], qf); unpack8(k[tb][c4], kf); unpack8(g[tb][c4], gf);
#pragma unroll
                    for (int x = 0; x < 8; ++x) { const int ix = c4 * 8 + x; S[ix] = __expf(gf[x]) * S[ix] + kf[x] * vf; o += qf[x] * S[ix]; } }
                o += __shfl_xor(o, 16); o += __shfl_xor(o, 32);
                if (wr_out && dq == 0) O[(size_t)row * 512 + h * 128 + e] = (bf16_t)f2bf(o * 0.125f);
            }
        }
    }
}
__device__ __forceinline__ void s5_chain(const DArgs& a, unsigned char* ws, LAS unsigned char* lds, int l, int b, int g, int dir, bool ctx_out, int tid) {
    LAS f32x2* cs = (LAS f32x2*)lds; LAS f32x2* hs = (LAS f32x2*)(lds + 16 * 65 * 8); LAS float* us = (LAS float*)(lds + 2 * 16 * 65 * 8);
    const int wave = tid >> 6, lane = tid & 63;
    const int gi = (l * 2 + dir) * 32 + g;
    const float* cre = a.in[I_S5CRE] + (size_t)gi * 1024; const float* cim = a.in[I_S5CIM] + (size_t)gi * 1024;
    for (int idx = tid; idx < 1024; idx += NT) { const int i = idx >> 6, p = idx & 63; cs[i * 65 + p] = (f32x2){cre[idx], cim[idx]}; }
    f32x2 ab = {0.f, 0.f}; f32x2 bt[16]; f32x2 hst = {0.f, 0.f};
    if (wave == 0) { ab = ((const f32x2*)(ws + WS_S5AB))[gi * 64 + lane]; const f32x2* bp = (const f32x2*)(ws + WS_S5BT) + (size_t)(gi * 64 + lane) * 16;
#pragma unroll
        for (int i = 0; i < 16; ++i) bt[i] = bp[i]; }
    else {
#pragma unroll
        for (int i = 0; i < 16; ++i) bt[i] = (f32x2){0.f, 0.f}; }
    const bf16_t* P = (const bf16_t*)(ws + WS_P);
    bf16_t* Y = (bf16_t*)(ws + WS_OB) + (size_t)(4 + dir) * OBSZ;
    const int tt = tid >> 4, i = tid & 15;
    for (int seg = 0; seg < 2; ++seg) {
        const int n = seg ? SEQL : LC, rowbase = seg ? b * SEQL : NLAT + b * LC; const bool wr_out = seg || ctx_out;
        __syncthreads();
        if (tid < 256) us[tid] = bf2f(P[(size_t)(rowbase + (dir ? n - 1 - tt : tt)) * LDP + PC_S5U + g * 16 + i]);
        for (int bt0 = 0; bt0 < n; bt0 += 16) {
            const int ii = bt0 + tt; const int row = rowbase + (dir ? n - 1 - ii : ii);
            bf16_t unext = 0;
            if (tid < 256 && bt0 + 16 < n) { const int iin = ii + 16; unext = P[(size_t)(rowbase + (dir ? n - 1 - iin : iin)) * LDP + PC_S5U + g * 16 + i]; }
            __syncthreads();
            if (wave == 0) {
#pragma unroll 4
                for (int t2 = 0; t2 < 16; ++t2) {
                    float bur = 0.f, bui = 0.f;
#pragma unroll
                    for (int q = 0; q < 4; ++q) { const f32x4 u = ((const LAS f32x4*)(us + t2 * 16))[q];
                        bur += bt[4 * q].x * u.x + bt[4 * q + 1].x * u.y + bt[4 * q + 2].x * u.z + bt[4 * q + 3].x * u.w;
                        bui += bt[4 * q].y * u.x + bt[4 * q + 1].y * u.y + bt[4 * q + 2].y * u.z + bt[4 * q + 3].y * u.w; }
                    const float hr = ab.x * hst.x - ab.y * hst.y + bur, hi = ab.x * hst.y + ab.y * hst.x + bui;
                    hst = (f32x2){hr, hi};
                    hs[t2 * 65 + lane] = hst;
                }
            }
            __syncthreads();
            if (tid < 256) {
                us[tid] = bf2f(unext);
                float y = 0.f;
#pragma unroll 8
                for (int p = 0; p < 64; ++p) { const f32x2 cv = cs[i * 65 + p], hv = hs[tt * 65 + p]; y += cv.x * hv.x - cv.y * hv.y; }
                if (wr_out) Y[(size_t)row * 512 + g * 16 + i] = (bf16_t)f2bf(y);
            }
        }
    }
    __syncthreads();
}

__device__ __forceinline__ float sconv3(const bf16_t* p, int t, int Lx, float w0, float w1, float w2, float cb) {
    const float x0 = t > 0 ? bf2f(p[t - 1]) : 0.f, x1 = bf2f(p[t]), x2 = t < Lx - 1 ? bf2f(p[t + 1]) : 0.f;
    return w0 * x0 + w1 * x1 + w2 * x2 + cb;
}
__device__ __forceinline__ void hyena_item(const DArgs& a, unsigned char* ws, LAS unsigned char* lds, int l, int c, int tid) {
    LAS f32x2* X = (LAS f32x2*)lds; LAS f32x2* W = (LAS f32x2*)(lds + 65536);
    fft_twiddles(W, tid);
    const float* cw = a.in[I_HCW] + (size_t)l * 3 * 1536; const float* cbp = a.in[I_HCB] + (size_t)l * 1536;
    const float wv0 = cw[c], wv1 = cw[1536 + c], wv2 = cw[3072 + c], bv = cbp[c];
    const float wa0 = cw[512 + c], wa1 = cw[1536 + 512 + c], wa2 = cw[3072 + 512 + c], ba = cbp[512 + c];
    const float wb0 = cw[1024 + c], wb1 = cw[1536 + 1024 + c], wb2 = cw[3072 + 1024 + c], bb = cbp[1024 + c];
    const float bias0 = a.in[I_HBIAS][(l * 2 + 0) * 512 + c], bias1 = a.in[I_HBIAS][(l * 2 + 1) * 512 + c];
    const bf16_t* PT = (const bf16_t*)(ws + WS_PT);
    const bf16_t* pv = PT + (size_t)(PT_V + c) * MR; const bf16_t* pg1 = PT + (size_t)(PT_G1 + c) * MR; const bf16_t* pg2 = PT + (size_t)(PT_G2 + c) * MR; const bf16_t* phg = PT + (size_t)(PT_HG + c) * MR;
    const f32x2* KF0 = (const f32x2*)(ws + WS_KF) + (size_t)(0 * 512 + c) * FFTN; const f32x2* KF1 = (const f32x2*)(ws + WS_KF) + (size_t)(1 * 512 + c) * FFTN;
    bf16_t* GATED = (bf16_t*)(ws + WS_H);
    __syncthreads();
    for (int bp = 0; bp < 2; ++bp) {
        const int r0 = (2 * bp) * SEQL, r1 = (2 * bp + 1) * SEQL;
        float zr[8], zi[8];
#pragma unroll
        for (int j = 0; j < 8; ++j) { const int t = tid + 512 * j; zr[j] = sconv3(pv + r0, t, SEQL, wv0, wv1, wv2, bv); zi[j] = sconv3(pv + r1, t, SEQL, wv0, wv1, wv2, bv);
            X[t] = (f32x2){zr[j], zi[j]}; X[4096 + t] = (f32x2){0.f, 0.f}; if (j & 1) asm volatile("" ::: "memory"); }
        __syncthreads(); fft_forward(X, W, tid);
#pragma unroll 4
        for (int j = 0; j < 16; ++j) { const int pos = tid + 512 * j; const f32x2 x = X[pos], k = KF0[pos]; X[pos] = (f32x2){x.x * k.x - x.y * k.y, x.x * k.y + x.y * k.x}; }
        __syncthreads(); fft_inverse(X, W, tid);
#pragma unroll
        for (int j = 0; j < 8; ++j) { const int t = tid + 512 * j; const f32x2 cv = X[t] * (1.0f / 8192.0f);
            const float g1r = sconv3(pg1 + r0, t, SEQL, wa0, wa1, wa2, ba), g1i = sconv3(pg1 + r1, t, SEQL, wa0, wa1, wa2, ba);
            zr[j] = g1r * (cv.x + bias0 * zr[j]); zi[j] = g1i * (cv.y + bias0 * zi[j]); if (j & 1) asm volatile("" ::: "memory"); }
        __syncthreads();
#pragma unroll
        for (int j = 0; j < 8; ++j) { const int t = tid + 512 * j; X[t] = (f32x2){zr[j], zi[j]}; X[4096 + t] = (f32x2){0.f, 0.f}; }
        __syncthreads(); fft_forward(X, W, tid);
#pragma unroll 4
        for (int j = 0; j < 16; ++j) { const int pos = tid + 512 * j; const f32x2 x = X[pos], k = KF1[pos]; X[pos] = (f32x2){x.x * k.x - x.y * k.y, x.x * k.y + x.y * k.x}; }
        __syncthreads(); fft_inverse(X, W, tid);
#pragma unroll
        for (int j = 0; j < 8; ++j) { const int t = tid + 512 * j; const f32x2 cv = X[t] * (1.0f / 8192.0f);
            const float g2r = sconv3(pg2 + r0, t, SEQL, wb0, wb1, wb2, bb), g2i = sconv3(pg2 + r1, t, SEQL, wb0, wb1, wb2, bb);
            const float z2r = g2r * (cv.x + bias1 * zr[j]), z2i = g2i * (cv.y + bias1 * zi[j]);
            const float hg0 = bf2f(phg[r0 + t]), hg1 = bf2f(phg[r1 + t]);
            GATED[(size_t)(r0 + t) * D + 512 + c] = (bf16_t)f2bf(z2r * siluf_(hg0)); GATED[(size_t)(r1 + t) * D + 512 + c] = (bf16_t)f2bf(z2i * siluf_(hg1)); if (j & 1) asm volatile("" ::: "memory"); }
        __syncthreads();
    }
}
__device__ __forceinline__ void hyena_ctx_item(const DArgs& a, unsigned char* ws, LAS unsigned char* lds, int c, int tid) {
    LAS float* kc = (LAS float*)lds; LAS float* za = (LAS float*)(lds + 4096); LAS float* zb = (LAS float*)(lds + 8192);
    const float* KC = (const float*)(ws + WS_KC);
    kc[tid] = KC[(size_t)(0 * 512 + c) * 512 + tid]; kc[512 + tid] = KC[(size_t)(1 * 512 + c) * 512 + tid];
    const float* cw = a.in[I_HCW]; const float* cbp = a.in[I_HCB];
    const float wv0 = cw[c], wv1 = cw[1536 + c], wv2 = cw[3072 + c], bv = cbp[c];
    const float wa0 = cw[512 + c], wa1 = cw[1536 + 512 + c], wa2 = cw[3072 + 512 + c], ba = cbp[512 + c];
    const float wb0 = cw[1024 + c], wb1 = cw[1536 + 1024 + c], wb2 = cw[3072 + 1024 + c], bb = cbp[1024 + c];
    const float bias0 = a.in[I_HBIAS][0 * 512 + c], bias1 = a.in[I_HBIAS][1 * 512 + c];
    const bf16_t* PT = (const bf16_t*)(ws + WS_PT);
    const int b = tid >> 7, tt = tid & 127; const int rb = NLAT + b * LC;
    const bf16_t* pv = PT + (size_t)(PT_V + c) * MR + rb; const bf16_t* pg1 = PT + (size_t)(PT_G1 + c) * MR + rb; const bf16_t* pg2 = PT + (size_t)(PT_G2 + c) * MR + rb; const bf16_t* phg = PT + (size_t)(PT_HG + c) * MR + rb;
    bf16_t* GATED = (bf16_t*)(ws + WS_H);
    float z0[2], z1[2];
#pragma unroll
    for (int q = 0; q < 2; ++q) { const int t = tt + 128 * q; z0[q] = sconv3(pv, t, LC, wv0, wv1, wv2, bv); za[b * 256 + t] = z0[q]; }
    __syncthreads();
#pragma unroll
    for (int q = 0; q < 2; ++q) { const int t = tt + 128 * q; float s = 0.f;
        for (int sidx = 0; sidx < 256; ++sidx) s += kc[(t - sidx) & 511] * za[b * 256 + sidx];
        z1[q] = sconv3(pg1, t, LC, wa0, wa1, wa2, ba) * (s + bias0 * z0[q]); zb[b * 256 + t] = z1[q]; }
    __syncthreads();
#pragma unroll
    for (int q = 0; q < 2; ++q) { const int t = tt + 128 * q; float s = 0.f;
        for (int sidx = 0; sidx < 256; ++sidx) s += kc[512 + ((t - sidx) & 511)] * zb[b * 256 + sidx];
        const float z2 = sconv3(pg2, t, LC, wb0, wb1, wb2, bb) * (s + bias1 * z1[q]);
        GATED[(size_t)(rb + t) * D + 512 + c] = (bf16_t)f2bf(z2 * siluf_(bf2f(phg[t]))); }
    __syncthreads();
}

__device__ __forceinline__ void merge_row(const DArgs& a, unsigned char* ws, int l, int row, int lane) {
    const int col = 8 * lane;
    const bf16_t* OB = (const bf16_t*)(ws + WS_OB); const bf16_t* P = (const bf16_t*)(ws + WS_P) + (size_t)row * LDP;
    bf16_t* GATED = (bf16_t*)(ws + WS_H) + (size_t)row * D; bf16_t* G5 = (bf16_t*)(ws + WS_KF) + (size_t)row * 512;
    { float yf[8], yb[8], u[8], res[8];
      unpack8(*(const u32x4*)(OB + (size_t)4 * OBSZ + (size_t)row * 512 + col), yf); unpack8(*(const u32x4*)(OB + (size_t)5 * OBSZ + (size_t)row * 512 + col), yb);
      unpack8(*(const u32x4*)(P + PC_S5U + col), u);
      const float* dsk = a.in[I_S5D] + l * 512 + col;
#pragma unroll
      for (int x = 0; x < 8; ++x) res[x] = gelu_tanh(yf[x] + yb[x] + u[x] * dsk[x]);
      *(u32x4*)(G5 + col) = pack8(res); }
}

struct EpiInProj {
    static constexpr bool PERM = true, AFTER_DRAIN = false;
    bf16_t* P; bf16_t* PT; float* LR; const float* RT;
    __device__ __forceinline__ void operator()(const pg8::f32x4 (&acc)[2][2][4][2], const pg8::Unit& u, int wr, int wc, int fr, int fq) const {
        const int row0 = u.pm * 256 + wr * 64 + fr, pn = u.pn;
        if (pn >= 12 && pn < 16) {
            const int colbase = pn * 256 - 2048 + wc * 32 + 8 * fq; const int j0 = 4 * (4 * wc + fq); const float ksc = pn >= 14 ? 0.08838834764831845f : 1.0f;
#pragma unroll
            for (int ai = 0; ai < 2; ++ai)
#pragma unroll
                for (int m = 0; m < 4; ++m) { const int row = row0 + ai * 128 + m * 16; const int pos = row < NLAT ? (row & (SEQL - 1)) : SEQL + ((row - NLAT) & (LC - 1));
                    const pg8::f32x4 t0 = *(const pg8::f32x4*)(RT + ((size_t)pos * 64 + j0) * 2), t1 = *(const pg8::f32x4*)(RT + ((size_t)pos * 64 + j0) * 2 + 4);
                    bf16_t* rowp = P + (size_t)row * LDP + colbase;
#pragma unroll
                    for (int bj = 0; bj < 2; ++bj) { const pg8::f32x4 x1 = acc[ai][bj][m][0] * ksc, x2 = acc[ai][bj][m][1] * ksc;
                        u32x4 w; w.x = pk2(x1[0] * t0[0] - x2[0] * t0[1], x1[1] * t0[2] - x2[1] * t0[3]); w.y = pk2(x1[2] * t1[0] - x2[2] * t1[1], x1[3] * t1[2] - x2[3] * t1[3]);
                        w.z = pk2(x1[0] * t0[1] + x2[0] * t0[0], x1[1] * t0[3] + x2[1] * t0[2]); w.w = pk2(x1[2] * t1[1] + x2[2] * t1[0], x1[3] * t1[3] + x2[3] * t1[2]);
                        *(u32x4*)(rowp + bj * 128) = w; } }
        } else if (pn < 4 || (pn >= 16 && pn < 26)) {
            const int colbase = (pn < 4 ? pn * 256 : pn * 256 - 2048) + wc * 32 + 8 * fq;
#pragma unroll
            for (int ai = 0; ai < 2; ++ai)
#pragma unroll
                for (int m = 0; m < 4; ++m) { bf16_t* rowp = P + (size_t)(row0 + ai * 128 + m * 16) * LDP + colbase;
#pragma unroll
                    for (int bj = 0; bj < 2; ++bj) { const pg8::f32x4 v0 = acc[ai][bj][m][0], v1 = acc[ai][bj][m][1];
                        u32x4 w; w.x = pk2(v0[0], v0[1]); w.y = pk2(v0[2], v0[3]); w.z = pk2(v1[0], v1[1]); w.w = pk2(v1[2], v1[3]);
                        *(u32x4*)(rowp + bj * 128) = w; } }
        } else if (pn < 12) {
            const int colbase = (pn - 4) * 256 + wc * 32 + 8 * fq;
#pragma unroll
            for (int bj = 0; bj < 2; ++bj)
#pragma unroll
                for (int n = 0; n < 2; ++n)
#pragma unroll
                    for (int j = 0; j < 4; ++j) { bf16_t* cp = PT + (size_t)(colbase + bj * 128 + 4 * n + j) * MR + row0;
#pragma unroll
                        for (int ai = 0; ai < 2; ++ai)
#pragma unroll
                            for (int m = 0; m < 4; ++m) cp[ai * 128 + m * 16] = (bf16_t)f2bf(acc[ai][bj][m][n][j]);
                        asm volatile("" ::: "memory"); }
        } else {
            if (wc == 0) {
#pragma unroll
                for (int ai = 0; ai < 2; ++ai)
#pragma unroll
                    for (int m = 0; m < 4; ++m) { float* rowp = LR + (size_t)(row0 + ai * 128 + m * 16) * 32 + 8 * fq;
                        *(pg8::f32x4*)(rowp) = acc[ai][0][m][0]; *(pg8::f32x4*)(rowp + 4) = acc[ai][0][m][1]; }
            }
        }
    }
};
struct EpiGlu {
    static constexpr bool PERM = true, AFTER_DRAIN = false;
    const bf16_t* G5; const bf16_t* P; bf16_t* GATED; const float* bias;
    __device__ __forceinline__ void operator()(const pg8::f32x4 (&acc)[2][2][4][2], const pg8::Unit& u, int wr, int wc, int fr, int fq) const {
        const int row0 = u.pm * 256 + wr * 64 + fr, col0 = u.pn * 256 + wc * 32 + 8 * fq;
#pragma unroll
        for (int ai = 0; ai < 2; ++ai)
#pragma unroll
            for (int m = 0; m < 4; ++m) { const size_t row = (size_t)(row0 + ai * 128 + m * 16);
#pragma unroll
                for (int bj = 0; bj < 2; ++bj) { const int col = col0 + bj * 128;
                    float g[8], sg[8], res[8]; unpack8(*(const u32x4*)(G5 + row * 512 + col), g); unpack8(*(const u32x4*)(P + row * LDP + PC_S5G + col), sg);
                    const pg8::f32x4 b0 = *(const pg8::f32x4*)(bias + col), b1 = *(const pg8::f32x4*)(bias + col + 4);
#pragma unroll
                    for (int j = 0; j < 4; ++j) { res[j] = g[j] * sigmoidf_(acc[ai][bj][m][0][j] + b0[j]) * siluf_(sg[j]); res[4 + j] = g[4 + j] * sigmoidf_(acc[ai][bj][m][1][j] + b1[j]) * siluf_(sg[4 + j]); }
                    *(u32x4*)(GATED + row * D + col) = pack8(res); } }
    }
};
struct EpiOut {
    static constexpr bool PERM = false, AFTER_DRAIN = false;
    const float* xl_old; const float* xc_old; float* xl_new; float* xc_new; const float* mod;
    __device__ __forceinline__ void operator()(const pg8::f32x4 (&acc)[2][2][4][2], const pg8::Unit& u, int wr, int wc, int fr, int fq) const {
        const int row0 = u.pm * 256 + wr * 64 + fr, col0 = u.pn * 256 + wc * 32 + 4 * fq;
        const bool lat = u.pm < 64;
        const float* xo = lat ? xl_old : xc_old - (size_t)NLAT * D; float* xn = lat ? xl_new : xc_new - (size_t)NLAT * D;
#pragma unroll
        for (int ai = 0; ai < 2; ++ai) {
            const int v = lat ? ((u.pm * 256 + ai * 128) >> 12) : 4;
            const float* gt = mod + (size_t)v * ADA + 2 * D;
#pragma unroll
            for (int m = 0; m < 4; ++m) { const size_t off = (size_t)(row0 + ai * 128 + m * 16) * D + col0;
#pragma unroll
                for (int bj = 0; bj < 2; ++bj)
#pragma unroll
                    for (int n = 0; n < 2; ++n) { const int cc = bj * 128 + n * 16; const pg8::f32x4 gv = *(const pg8::f32x4*)(gt + col0 + cc), xv = *(const pg8::f32x4*)(xo + off + cc);
                        *(pg8::f32x4*)(xn + off + cc) = xv + gv * acc[ai][bj][m][n]; } }
        }
    }
};
typedef short bf16x8 __attribute__((ext_vector_type(8)));
typedef short bf16x4 __attribute__((ext_vector_type(4)));
__device__ __forceinline__ unsigned off_b(unsigned row, unsigned ch) { return 256u * row + 16u * (ch ^ (((row & 3) << 2) | ((row >> 2) & 3))); }
__device__ __forceinline__ bf16x8 img_row_frag(const LAS unsigned char* img, unsigned lane, unsigned rb, unsigned s) { return *(const LAS bf16x8*)(img + off_b((lane & 15) + 16 * rb, 4 * s + (lane >> 4))); }
__device__ __forceinline__ bf16x4 img_tr4(const LAS unsigned char* img, unsigned lane, unsigned c, unsigned row0) {
    const unsigned q = (lane & 15) >> 2, p = lane & 3;
    return __builtin_amdgcn_ds_read_tr16_b64_v4i16((LAS bf16x4*)(img + off_b(row0 + q, 2 * c + (p >> 1)) + 8 * (p & 1)));
}
__device__ __forceinline__ bf16x8 img_tr_frag(const LAS unsigned char* img, unsigned lane, unsigned c, unsigned ks) {
    const unsigned g = lane >> 4; const bf16x4 lo = img_tr4(img, lane, c, 32 * ks + 8 * g), hi = img_tr4(img, lane, c, 32 * ks + 8 * g + 4);
    return __builtin_shufflevector(lo, hi, 0, 1, 2, 3, 4, 5, 6, 7);
}
__device__ __forceinline__ bf16x8 img_tr_frag_acc(const LAS unsigned char* img, unsigned lane, unsigned c, unsigned ks) {
    const unsigned g = lane >> 4; const bf16x4 lo = img_tr4(img, lane, c, 32 * ks + 4 * g), hi = img_tr4(img, lane, c, 32 * ks + 16 + 4 * g);
    return __builtin_shufflevector(lo, hi, 0, 1, 2, 3, 4, 5, 6, 7);
}
__device__ __forceinline__ bf16x8 acc_pair_frag(const f32x4 a0, const f32x4 a1) {
    u32x4 w; w.x = pk2(a0.x, a0.y); w.y = pk2(a0.z, a0.w); w.z = pk2(a1.x, a1.y); w.w = pk2(a1.z, a1.w);
    return __builtin_bit_cast(bf16x8, w);
}
#define MFMA16(A_, B_, C_) __builtin_amdgcn_mfma_f32_16x16x32_bf16((A_), (B_), (C_), 0, 0, 0)
__device__ __forceinline__ void stage_tile128(LAS unsigned char* img, const bf16_t* g, size_t ld, int tid) {
#pragma unroll
    for (int i = 0; i < 4; ++i) { const int n = tid + NT * i, row = n >> 4, ch = n & 15; *(LAS u32x4*)(img + off_b(row, ch)) = *(const u32x4*)(g + (size_t)row * ld + ch * 8); }
}

constexpr int RCH = 128, RNCH = 34;
constexpr size_t WS_RST = WS_OB;
__device__ __forceinline__ int ret_rowbase(int b, int cc) { return cc < 2 ? NLAT + b * LC + cc * RCH : b * SEQL + (cc - 2) * RCH; }
__device__ __forceinline__ float ret_log2g(int h) { return log2f(1.0f - exp2f(-5.0f - (float)h)); }

__device__ __forceinline__ void ret_passA(unsigned char* ws, LAS unsigned char* lds, int item, int tid) {
    const int bh = item / RNCH, cc = item % RNCH, b = bh >> 2, h = bh & 3;
    const int lane = tid & 63, w = tid >> 6, g = lane >> 4;
    LAS unsigned char* KF = lds; LAS unsigned char* KB = lds + 32768; LAS unsigned char* VI = lds + 65536;
    const bf16_t* P = (const bf16_t*)(ws + WS_P) + (size_t)ret_rowbase(b, cc) * LDP;
    const float l2g = ret_log2g(h);
    __syncthreads();
#pragma unroll
    for (int i = 0; i < 4; ++i) { const int n = tid + NT * i, row = n >> 4, ch = n & 15;
        const u32x4 kr = *(const u32x4*)(P + (size_t)row * LDP + PC_RK + h * 128 + ch * 8);
        float kf[8], a[8], c[8]; unpack8(kr, kf);
        const float sf = exp2f(l2g * (float)(RCH - 1 - row)), sb = exp2f(l2g * (float)row);
#pragma unroll
        for (int x = 0; x < 8; ++x) { a[x] = kf[x] * sf; c[x] = kf[x] * sb; }
        *(LAS u32x4*)(KF + off_b(row, ch)) = pack8(a); *(LAS u32x4*)(KB + off_b(row, ch)) = pack8(c);
        *(LAS u32x4*)(VI + off_b(row, ch)) = *(const u32x4*)(P + (size_t)row * LDP + PC_RV + h * 128 + ch * 8); }
    __syncthreads();
    bf16x8 af[4], ab[4];
#pragma unroll
    for (int ks = 0; ks < 4; ++ks) { af[ks] = img_tr_frag(KF, lane, w, ks); ab[ks] = img_tr_frag(KB, lane, w, ks); }
    bf16_t* ST = (bf16_t*)(ws + WS_RST) + ((size_t)(bh * 2) * RNCH + cc) * (128 * 128);
#pragma unroll 2
    for (int E = 0; E < 8; ++E) {
        f32x4 cf = {0.f, 0.f, 0.f, 0.f}, cb = {0.f, 0.f, 0.f, 0.f};
#pragma unroll
        for (int ks = 0; ks < 4; ++ks) { const bf16x8 vb = img_tr_frag(VI, lane, E, ks); cf = MFMA16(af[ks], vb, cf); cb = MFMA16(ab[ks], vb, cb); }
        const int e = 16 * E + (lane & 15), d0 = 16 * w + 4 * g;
        u32x2 o; o.x = pk2(cf.x, cf.y); o.y = pk2(cf.z, cf.w); *(u32x2*)(ST + (size_t)e * 128 + d0) = o;
        o.x = pk2(cb.x, cb.y); o.y = pk2(cb.z, cb.w); *(u32x2*)(ST + (size_t)RNCH * 128 * 128 + (size_t)e * 128 + d0) = o;
    }
}
__device__ __forceinline__ void ret_passB(unsigned char* ws, int gt  ) {
    const int el = gt & 2047, bd = gt >> 11, bh = bd >> 1, dir = bd & 1, h = bh & 3;
    const float gC = exp2f(ret_log2g(h) * (float)RCH);
    bf16_t* base = (bf16_t*)(ws + WS_RST) + (size_t)bd * RNCH * (128 * 128) + (size_t)el * 8;
    float acc[8];
#pragma unroll
    for (int x = 0; x < 8; ++x) acc[x] = 0.f;
#pragma unroll 1
    for (int s0 = 0; s0 < RNCH; s0 += 17) {
        u32x4 kvr[17];
#pragma unroll
        for (int j = 0; j < 17; ++j) { const int s = s0 + j; const int cc = dir == 0 ? s : (s < 2 ? 1 - s : 35 - s); kvr[j] = *(const u32x4*)(base + (size_t)cc * (128 * 128)); }
#pragma unroll
        for (int j = 0; j < 17; ++j) { const int s = s0 + j; const int cc = dir == 0 ? s : (s < 2 ? 1 - s : 35 - s);
            float kv[8]; unpack8(kvr[j], kv);
            *(u32x4*)(base + (size_t)cc * (128 * 128)) = pack8(acc);
#pragma unroll
            for (int x = 0; x < 8; ++x) acc[x] = gC * acc[x] + kv[x]; }
    }
}
__device__ __forceinline__ void ret_passC(const DArgs& a, unsigned char* ws, LAS unsigned char* lds, int l, int item, int tid) {
    const int bh = item / RNCH, cc = item % RNCH, b = bh >> 2, h = bh & 3;
    const int lane = tid & 63, w = tid >> 6, g = lane >> 4, il = lane & 15;
    LAS unsigned char* KI = lds; LAS unsigned char* VI = lds + 32768; LAS unsigned char* SF = lds + 65536; LAS unsigned char* SB = lds + 98304;
    const int rowbase = ret_rowbase(b, cc);
    const bf16_t* P = (const bf16_t*)(ws + WS_P) + (size_t)rowbase * LDP;
    const bf16_t* STf = (const bf16_t*)(ws + WS_RST) + ((size_t)(bh * 2) * RNCH + cc) * (128 * 128);
    const bf16_t* STb = STf + (size_t)RNCH * 128 * 128;
    __syncthreads();
    stage_tile128(KI, P + PC_RK + h * 128, LDP, tid); stage_tile128(VI, P + PC_RV + h * 128, LDP, tid);
    stage_tile128(SF, STf, 128, tid); stage_tile128(SB, STb, 128, tid);
    bf16x8 qf[4];
    { const bf16_t* qr = P + (size_t)(16 * w + il) * LDP + PC_RQ + h * 128 + 8 * g;
#pragma unroll
      for (int ks = 0; ks < 4; ++ks) qf[ks] = *(const bf16x8*)(qr + 32 * ks); }
    __syncthreads();
    const float l2g = ret_log2g(h);
    const int iloc = 16 * w + il;
    f32x4 o[8];
    { const float sf = exp2f(l2g * (float)(iloc + 1)), sb = exp2f(l2g * (float)(RCH - iloc));
#pragma unroll
      for (int E = 0; E < 8; ++E) { f32x4 rf = {0.f, 0.f, 0.f, 0.f}, rb = {0.f, 0.f, 0.f, 0.f};
#pragma unroll
          for (int ks = 0; ks < 4; ++ks) { rf = MFMA16(img_row_frag(SF, lane, E, ks), qf[ks], rf); rb = MFMA16(img_row_frag(SB, lane, E, ks), qf[ks], rb); }
          o[E] = rf * sf + rb * sb; } }
    f32x4 at[8];
#pragma unroll
    for (int T = 0; T < 8; ++T) { f32x4 c = {0.f, 0.f, 0.f, 0.f};
#pragma unroll
        for (int ks = 0; ks < 4; ++ks) c = MFMA16(img_row_frag(KI, lane, T, ks), qf[ks], c);
#pragma unroll
        for (int r = 0; r < 4; ++r) { const int j = 16 * T + 4 * g + r; const int dd = iloc > j ? iloc - j : j - iloc; c[r] *= (dd == 0 ? 2.0f : exp2f(l2g * (float)dd)); }
        at[T] = c; }
#pragma unroll
    for (int s = 0; s < 4; ++s) { const bf16x8 bfr = acc_pair_frag(at[2 * s], at[2 * s + 1]);
#pragma unroll
        for (int E = 0; E < 8; ++E) o[E] = MFMA16(img_tr_frag_acc(VI, lane, E, s), bfr, o[E]); }
    float ss = 0.f;
#pragma unroll
    for (int E = 0; E < 8; ++E) ss += (o[E].x * o[E].x + o[E].y * o[E].y) + (o[E].z * o[E].z + o[E].w * o[E].w);
    ss += __shfl_xor(ss, 16); ss += __shfl_xor(ss, 32);
    const float rn = rsqrtf(ss * (1.0f / 128.0f) + EPS);
    const size_t row = (size_t)rowbase + iloc;
    const bf16_t* gp = (const bf16_t*)(ws + WS_P) + row * LDP + PC_RG + h * 128 + 4 * g;
    const float* nw = a.in[I_RNW] + l * 512 + h * 128 + 4 * g;
    bf16_t* op = (bf16_t*)(ws + WS_H) + row * D + 1024 + h * 128 + 4 * g;
#pragma unroll
    for (int E = 0; E < 8; ++E) { const u32x2 gr = *(const u32x2*)(gp + 16 * E); const f32x4 nv = *(const f32x4*)(nw + 16 * E);
        u32x2 ov; ov.x = pk2(o[E].x * rn * nv.x * siluf_(bflo(gr.x)), o[E].y * rn * nv.y * siluf_(bfhi(gr.x)));
        ov.y = pk2(o[E].z * rn * nv.z * siluf_(bflo(gr.y)), o[E].w * rn * nv.w * siluf_(bfhi(gr.y)));
        *(u32x2*)(op + 16 * E) = ov; }
}
constexpr int GCH = 64, GNCH = 68;
constexpr size_t WS_GST = WS_OB + (size_t)2 * OBSZ * 2;
constexpr size_t WS_GDEC = WS_END;
constexpr size_t WS_H3B = WS_GDEC + (size_t)16 * 2 * GNCH * 64 * 4;
constexpr size_t WS_ROPE = WS_H3B + (size_t)2 * 4096 * 64 * 2;
constexpr size_t WS_END2 = WS_ROPE + (size_t)(SEQL + LC) * 64 * 8;
__device__ __forceinline__ int gla_rowbase(int b, int cg) { return cg < 4 ? NLAT + b * LC + cg * GCH : b * SEQL + (cg - 4) * GCH; }

constexpr int GLS = 68;
__device__ __forceinline__ void gla_gates_compute(const DArgs& a, unsigned char* ws, LAS float* BF, LAS float* BB, LAS float* GW  , int l, int h, int rowbase, int tid) {
    const int t = tid >> 3, d8 = tid & 7;
    const float* lr = (const float*)(ws + WS_LR) + (size_t)(rowbase + t) * 32;
    f32x4 lv[8];
#pragma unroll
    for (int q = 0; q < 8; ++q) lv[q] = ((const f32x4*)lr)[q];
    { const int dir = tid >> 8, r = (tid >> 4) & 15, c4 = (tid & 15) * 4;
      *(LAS f32x4*)(GW + (dir * 17 + r) * 64 + c4) = *(const f32x4*)(a.in[I_GGW] + (size_t)(l * 2 + dir) * 16 * 256 + r * 256 + h * 64 + c4);
      if (tid < 32) { const int dd = tid >> 4; *(LAS f32x4*)(GW + (dd * 17 + 16) * 64 + c4) = *(const f32x4*)(a.in[I_GGB] + (size_t)(l * 2 + dd) * 256 + h * 64 + c4); } }
    __syncthreads();
    bf16_t* GLG = (bf16_t*)(ws + WS_WIN);
#pragma unroll
    for (int dir = 0; dir < 2; ++dir) {
        const LAS float* gw = GW + dir * 17 * 64 + 8 * d8;
        f32x4 s0 = *(const LAS f32x4*)(gw + 16 * 64), s1 = *(const LAS f32x4*)(gw + 16 * 64 + 4);
#pragma unroll
        for (int j = 0; j < 16; ++j) { const float lj = lv[dir * 4 + (j >> 2)][j & 3]; s0 += lj * *(const LAS f32x4*)(gw + j * 64); s1 += lj * *(const LAS f32x4*)(gw + j * 64 + 4); }
        LAS float* dst = (dir ? BB : BF) + t * GLS + 8 * d8;
        float la[8];
#pragma unroll
        for (int x = 0; x < 8; ++x) { const float s = x < 4 ? s0[x] : s1[x - 4]; const float e = __expf(-fabsf(s)); const float ls = fminf(s, 0.f) - __logf(1.0f + e); la[x] = ls * (1.0f / 16.0f); }
        const u32x4 pk = pack8(la);
        *(u32x4*)(GLG + ((size_t)dir * MR + rowbase + t) * 256 + h * 64 + 8 * d8) = pk;
        float lq[8]; unpack8(pk, lq);
        *(LAS f32x4*)dst = (f32x4){lq[0], lq[1], lq[2], lq[3]}; *(LAS f32x4*)(dst + 4) = (f32x4){lq[4], lq[5], lq[6], lq[7]};
    }
}
__device__ __forceinline__ void gla_gates_load(unsigned char* ws, LAS float* BF, LAS float* BB, int h, int rowbase, int tid) {
    const int t = tid >> 3, d8 = tid & 7;
    const bf16_t* GLG = (const bf16_t*)(ws + WS_WIN);
#pragma unroll
    for (int dir = 0; dir < 2; ++dir) { float lq[8]; unpack8(*(const u32x4*)(GLG + ((size_t)dir * MR + rowbase + t) * 256 + h * 64 + 8 * d8), lq);
        LAS float* dst = (dir ? BB : BF) + t * GLS + 8 * d8;
        *(LAS f32x4*)dst = (f32x4){lq[0], lq[1], lq[2], lq[3]}; *(LAS f32x4*)(dst + 4) = (f32x4){lq[4], lq[5], lq[6], lq[7]}; }
}
__device__ __forceinline__ void gla_scan(LAS float* BF, LAS float* BB, int tid) {
    const int lane = tid & 63, w = tid >> 6;
    __syncthreads();
#pragma unroll 4
    for (int c = 0; c < 16; ++c) { const int col = 16 * w + c; const int dir = col >> 6, d = col & 63;
        LAS float* p = (dir ? BB : BF) + (dir ? 63 - lane : lane) * GLS + d;
        float v = *p;
#pragma unroll
        for (int off = 1; off < 64; off <<= 1) { const float u = __shfl_up(v, off); if (lane >= off) v += u; }
        *p = v; }
    __syncthreads();
}

__device__ __forceinline__ void gla_passA(const DArgs& a, unsigned char* ws, LAS unsigned char* lds, int l, int item, int tid) {
    const int bh = item / GNCH, cg = item % GNCH, b = bh >> 2, h = bh & 3;
    const int lane = tid & 63, w = tid >> 6, g = lane >> 4;
    LAS float* BF = (LAS float*)lds; LAS float* BB = (LAS float*)(lds + 17408); LAS unsigned char* KH = lds + 34816; LAS unsigned char* VI = lds + 34816 + 16384;
    const int rowbase = gla_rowbase(b, cg);
    const bf16_t* P = (const bf16_t*)(ws + WS_P) + (size_t)rowbase * LDP;
    const int t = tid >> 3, d8 = tid & 7;
    const u32x4 kraw = *(const u32x4*)(P + (size_t)t * LDP + PC_GK + h * 64 + 8 * d8);
    u32x4 vraw[2];
#pragma unroll
    for (int i = 0; i < 2; ++i) { const int n = tid + NT * i; vraw[i] = *(const u32x4*)(P + (size_t)(n >> 4) * LDP + PC_GV + h * 128 + (n & 15) * 8); }
    gla_gates_compute(a, ws, BF, BB, (LAS float*)(lds + 34816 + 32768), l, h, rowbase, tid);
    gla_scan(BF, BB, tid);
    { float kf[8], x0[8], x1[8]; unpack8(kraw, kf);
#pragma unroll
      for (int x = 0; x < 8; ++x) { const int d = 8 * d8 + x; x0[x] = kf[x] * __expf(BF[63 * GLS + d] - BF[t * GLS + d]); x1[x] = kf[x] * __expf(BB[d] - BB[t * GLS + d]); }
      *(LAS u32x4*)(KH + off_b(t, d8)) = pack8(x0); *(LAS u32x4*)(KH + off_b(t, 8 + d8)) = pack8(x1);
#pragma unroll
      for (int i = 0; i < 2; ++i) { const int n = tid + NT * i; *(LAS u32x4*)(VI + off_b(n >> 4, n & 15)) = vraw[i]; }
      if (tid < 128) { const int dir = tid >> 6, d = tid & 63; ((float*)(ws + WS_GDEC))[((size_t)(bh * 2 + dir) * GNCH + cg) * 64 + d] = __expf(dir ? BB[d] : BF[63 * GLS + d]); } }
    __syncthreads();
    const int dir = w >> 2, Dt = w & 3;
    bf16x8 af[2];
#pragma unroll
    for (int ks = 0; ks < 2; ++ks) af[ks] = img_tr_frag(KH, lane, dir * 4 + Dt, ks);
    bf16_t* ST = (bf16_t*)(ws + WS_GST) + ((size_t)(bh * 2 + dir) * GNCH + cg) * (128 * 64);
#pragma unroll 2
    for (int E = 0; E < 8; ++E) {
        f32x4 c = {0.f, 0.f, 0.f, 0.f};
#pragma unroll
        for (int ks = 0; ks < 2; ++ks) c = MFMA16(af[ks], img_tr_frag(VI, lane, E, ks), c);
        u32x2 o; o.x = pk2(c.x, c.y); o.y = pk2(c.z, c.w);
        *(u32x2*)(ST + (size_t)(16 * E + (lane & 15)) * 64 + 16 * Dt + 4 * g) = o;
    }
}
__device__ __forceinline__ void gla_passB(unsigned char* ws, LAS unsigned char* lds, int blk, int tid) {
    const int bd = blk >> 1, dir = bd & 1, el = (blk & 1) * 512 + tid;
    LAS float* decs = (LAS float*)lds;
    { const float* dsrc = (const float*)(ws + WS_GDEC) + (size_t)bd * GNCH * 64;
      for (int i = tid; i < GNCH * 64; i += NT) decs[i] = dsrc[i]; }
    __syncthreads();
    bf16_t* base = (bf16_t*)(ws + WS_GST) + (size_t)bd * GNCH * (128 * 64) + (size_t)el * 8;
    const int d0 = (el & 7) * 8;
    float acc[8];
#pragma unroll
    for (int x = 0; x < 8; ++x) acc[x] = 0.f;
#pragma unroll 1
    for (int s0 = 0; s0 < GNCH; s0 += 17) {
        u32x4 kvr[17];
#pragma unroll
        for (int j = 0; j < 17; ++j) { const int s = s0 + j; const int cg = dir == 0 ? s : (s < 4 ? 3 - s : 71 - s); kvr[j] = *(const u32x4*)(base + (size_t)cg * (128 * 64)); }
#pragma unroll
        for (int j = 0; j < 17; ++j) { const int s = s0 + j; const int cg = dir == 0 ? s : (s < 4 ? 3 - s : 71 - s);
            float kv[8]; unpack8(kvr[j], kv);
            const f32x4 q0 = *(const LAS f32x4*)(decs + cg * 64 + d0), q1 = *(const LAS f32x4*)(decs + cg * 64 + d0 + 4);
            *(u32x4*)(base + (size_t)cg * (128 * 64)) = pack8(acc);
#pragma unroll
            for (int x = 0; x < 8; ++x) acc[x] = (x < 4 ? q0[x] : q1[x - 4]) * acc[x] + kv[x]; }
    }
    __syncthreads();
}
__device__ __forceinline__ void gla_passC(const DArgs& a, unsigned char* ws, LAS unsigned char* lds, int l, int item, int tid) {
    const int bh = item / GNCH, cg = item % GNCH, b = bh >> 2, h = bh & 3;
    const int lane = tid & 63, w = tid >> 6, g = lane >> 4, il = lane & 15;
    LAS float* BF = (LAS float*)lds; LAS float* BB = (LAS float*)(lds + 17408);
    LAS unsigned char* QKF = lds + 34816; LAS unsigned char* QKB = QKF + 16384; LAS unsigned char* QH = QKB + 16384; LAS unsigned char* VI = QH + 16384; LAS unsigned char* SI = VI + 16384;
    const int rowbase = gla_rowbase(b, cg);
    const bf16_t* P = (const bf16_t*)(ws + WS_P) + (size_t)rowbase * LDP;
    const int t = tid >> 3, d8 = tid & 7;
    const u32x4 qraw = *(const u32x4*)(P + (size_t)t * LDP + PC_GQ + h * 64 + 8 * d8), kraw = *(const u32x4*)(P + (size_t)t * LDP + PC_GK + h * 64 + 8 * d8);
    u32x4 vraw[2], sraw[4];
#pragma unroll
    for (int i = 0; i < 2; ++i) { const int n = tid + NT * i; vraw[i] = *(const u32x4*)(P + (size_t)(n >> 4) * LDP + PC_GV + h * 128 + (n & 15) * 8); }
    { const bf16_t* STf = (const bf16_t*)(ws + WS_GST) + ((size_t)(bh * 2) * GNCH + cg) * (128 * 64); const bf16_t* STb = STf + (size_t)GNCH * 128 * 64;
#pragma unroll
      for (int i = 0; i < 4; ++i) { const int n = tid + NT * i, row = n >> 4, ch = n & 15; sraw[i] = *(const u32x4*)((ch < 8 ? STf : STb) + (size_t)row * 64 + (ch & 7) * 8); } }
    gla_gates_load(ws, BF, BB, h, rowbase, tid);
    gla_scan(BF, BB, tid);
    { float qf[8], kf[8], o0[8], o1[8], o2[8], o3[8], o4[8], o5[8];
      unpack8(qraw, qf); unpack8(kraw, kf);
#pragma unroll
      for (int x = 0; x < 8; ++x) { const int d = 8 * d8 + x; const float bf = BF[t * GLS + d], bb = BB[t * GLS + d], rf = BF[31 * GLS + d], rb = BB[32 * GLS + d]; const float q = qf[x] * 0.125f;
          o0[x] = q * __expf(bf - rf); o1[x] = kf[x] * __expf(rf - bf); o2[x] = q * __expf(bb - rb); o3[x] = kf[x] * __expf(rb - bb); o4[x] = q * __expf(bf); o5[x] = q * __expf(bb); }
      *(LAS u32x4*)(QKF + off_b(t, d8)) = pack8(o0); *(LAS u32x4*)(QKF + off_b(t, 8 + d8)) = pack8(o1);
      *(LAS u32x4*)(QKB + off_b(t, d8)) = pack8(o2); *(LAS u32x4*)(QKB + off_b(t, 8 + d8)) = pack8(o3);
      *(LAS u32x4*)(QH + off_b(t, d8)) = pack8(o4); *(LAS u32x4*)(QH + off_b(t, 8 + d8)) = pack8(o5);
#pragma unroll
      for (int i = 0; i < 2; ++i) { const int n = tid + NT * i; *(LAS u32x4*)(VI + off_b(n >> 4, n & 15)) = vraw[i]; }
#pragma unroll
      for (int i = 0; i < 4; ++i) { const int n = tid + NT * i; *(LAS u32x4*)(SI + off_b(n >> 4, n & 15)) = sraw[i]; } }
    __syncthreads();
    const int ib = w & 3, eh = w >> 2, iloc = 16 * ib + il;
    f32x4 at[4];
    { bf16x8 qff[2], qfb[2];
#pragma unroll
      for (int ks = 0; ks < 2; ++ks) { qff[ks] = img_row_frag(QKF, lane, ib, ks); qfb[ks] = img_row_frag(QKB, lane, ib, ks); }
#pragma unroll
      for (int T = 0; T < 4; ++T) { f32x4 cf = {0.f, 0.f, 0.f, 0.f}, cb = {0.f, 0.f, 0.f, 0.f};
#pragma unroll
          for (int ks = 0; ks < 2; ++ks) { cf = MFMA16(img_row_frag(QKF, lane, T, 2 + ks), qff[ks], cf); cb = MFMA16(img_row_frag(QKB, lane, T, 2 + ks), qfb[ks], cb); }
#pragma unroll
          for (int r = 0; r < 4; ++r) { const int j = 16 * T + 4 * g + r; cf[r] = (j <= iloc ? cf[r] : 0.f) + (j >= iloc ? cb[r] : 0.f); }
          at[T] = cf; } }
    f32x4 o[4];
    { bf16x8 hf[2], hb[2];
#pragma unroll
      for (int ks = 0; ks < 2; ++ks) { hf[ks] = img_row_frag(QH, lane, ib, ks); hb[ks] = img_row_frag(QH, lane, ib, 2 + ks); }
#pragma unroll
      for (int E4 = 0; E4 < 4; ++E4) { const int E = 4 * eh + E4; f32x4 c = {0.f, 0.f, 0.f, 0.f};
#pragma unroll
          for (int ks = 0; ks < 2; ++ks) { c = MFMA16(img_row_frag(SI, lane, E, ks), hf[ks], c); c = MFMA16(img_row_frag(SI, lane, E, 2 + ks), hb[ks], c); }
          o[E4] = c; } }
#pragma unroll
    for (int s = 0; s < 2; ++s) { const bf16x8 bfr = acc_pair_frag(at[2 * s], at[2 * s + 1]);
#pragma unroll
        for (int E4 = 0; E4 < 4; ++E4) o[E4] = MFMA16(img_tr_frag_acc(VI, lane, 4 * eh + E4, s), bfr, o[E4]); }
    float ss = 0.f;
#pragma unroll
    for (int E4 = 0; E4 < 4; ++E4) ss += (o[E4].x * o[E4].x + o[E4].y * o[E4].y) + (o[E4].z * o[E4].z + o[E4].w * o[E4].w);
    ss += __shfl_xor(ss, 16); ss += __shfl_xor(ss, 32);
    LAS float* red = (LAS float*)lds;
    if (g == 0) red[eh * 64 + iloc] = ss;
    __syncthreads();
    const float rn = rsqrtf((red[iloc] + red[64 + iloc]) * (1.0f / 128.0f) + EPS);
    const size_t row = (size_t)rowbase + iloc;
    const bf16_t* gp = (const bf16_t*)(ws + WS_P) + row * LDP + PC_GG + h * 128 + 64 * eh + 4 * g;
    const float* nw = a.in[I_GNW] + l * 512 + h * 128 + 64 * eh + 4 * g;
    bf16_t* op = (bf16_t*)(ws + WS_H) + row * D + 1536 + h * 128 + 64 * eh + 4 * g;
#pragma unroll
    for (int E4 = 0; E4 < 4; ++E4) { const u32x2 gr = *(const u32x2*)(gp + 16 * E4); const f32x4 nv = *(const f32x4*)(nw + 16 * E4);
        u32x2 ov; ov.x = pk2(o[E4].x * rn * nv.x * siluf_(bflo(gr.x)), o[E4].y * rn * nv.y * siluf_(bfhi(gr.x)));
        ov.y = pk2(o[E4].z * rn * nv.z * siluf_(bflo(gr.y)), o[E4].w * rn * nv.w * siluf_(bfhi(gr.y)));
        *(u32x2*)(op + 16 * E4) = ov; }
}
constexpr int SNCH = 68;
constexpr size_t WS_S5ST = WS_OB + (size_t)4 * OBSZ * 2;
constexpr size_t WS_S5BTB = WS_S5BT;
constexpr size_t WS_S5CPB = WS_S5BT + 524288;
constexpr size_t WS_S5A64 = WS_S5BT + 1048576;

__device__ __forceinline__ void prep_s5b(const DArgs& a, unsigned char* ws, int it, int tid) {
    const int idx = it * 512 + tid;
    const int gi = idx >> 6, p = idx & 63;
    const float a_re = a.in[I_S5ARE][idx], a_im = a.in[I_S5AIM][idx], ldt = a.in[I_S5LDT][gi];
    const float dt = expf(ldt), mag = expf(a_re * dt);
    float sn, cs; sincosf(a_im * dt, &sn, &cs);
    const float ab_re = mag * cs, ab_im = mag * sn, den = a_re * a_re + a_im * a_im, nr = ab_re - 1.0f;
    const float co_re = (nr * a_re + ab_im * a_im) / den, co_im = (ab_im * a_re - nr * a_im) / den;
    ((f32x2*)(ws + WS_S5AB))[idx] = (f32x2){ab_re, ab_im};
    float pr = ab_re, pi = ab_im;
#pragma unroll
    for (int q = 0; q < 6; ++q) { const float nr2 = pr * pr - pi * pi, ni2 = 2.0f * pr * pi; pr = nr2; pi = ni2; }
    ((f32x2*)(ws + WS_S5A64))[idx] = (f32x2){pr, pi};
    const float* bre = a.in[I_S5BRE] + (size_t)idx * 16; const float* bim = a.in[I_S5BIM] + (size_t)idx * 16;
    float tr[16], ti[16];
#pragma unroll
    for (int i = 0; i < 16; ++i) { const float br = bre[i], bi = bim[i]; tr[i] = co_re * br - co_im * bi; ti[i] = co_re * bi + co_im * br; }
    bf16_t* btb = (bf16_t*)(ws + WS_S5BTB) + (size_t)gi * 128 * 16;
#pragma unroll
    for (int hlf = 0; hlf < 2; ++hlf) { u32x4 w0, w1; const float* s = hlf ? ti : tr;
        w0.x = pk2(s[0], s[1]); w0.y = pk2(s[2], s[3]); w0.z = pk2(s[4], s[5]); w0.w = pk2(s[6], s[7]); w1.x = pk2(s[8], s[9]); w1.y = pk2(s[10], s[11]); w1.z = pk2(s[12], s[13]); w1.w = pk2(s[14], s[15]);
        *(u32x4*)(btb + (size_t)(64 * hlf + p) * 16) = w0; *(u32x4*)(btb + (size_t)(64 * hlf + p) * 16 + 8) = w1; }
    bf16_t* cpb = (bf16_t*)(ws + WS_S5CPB) + (size_t)gi * 16 * 128;
    const float* cre = a.in[I_S5CRE] + (size_t)gi * 1024; const float* cim = a.in[I_S5CIM] + (size_t)gi * 1024;
#pragma unroll
    for (int i = 0; i < 16; ++i) *(unsigned*)(cpb + i * 128 + 2 * p) = pk2(cre[i * 64 + p], -cim[i * 64 + p]);
}

struct S5Unit { bf16x8 btf[8]; f32x2 ab; f32x2 h; const bf16_t* cp; };
template <bool PASSC> __device__ __forceinline__ void s5_load_unit(S5Unit& U, unsigned char* ws, const bf16_t* P, const f32x2* ST, int l, int b, int cs, int rowbase, int grp, int dir, int lane) {
    const int g = lane >> 4, il = lane & 15;
    const bf16x8 zero8 = {0, 0, 0, 0, 0, 0, 0, 0};
    const int gi = (l * 2 + dir) * 32 + grp;
    U.ab = ((const f32x2*)(ws + WS_S5AB))[gi * 64 + lane];
    const size_t sidx = ((size_t)(b * SNCH + cs) * 2 + dir) * 2048 + grp * 64 + lane;
    U.h = PASSC ? ST[sidx] : (f32x2){0.f, 0.f};
    const bf16_t* bt = (const bf16_t*)(ws + WS_S5BTB) + (size_t)gi * 128 * 16 + (size_t)il * 16 + 8 * (g & 1);
#pragma unroll
    for (int Pt = 0; Pt < 8; ++Pt) { const bf16x8 v = *(const bf16x8*)(bt + Pt * 256); U.btf[Pt] = g < 2 ? v : zero8; }
    U.cp = (const bf16_t*)(ws + WS_S5CPB) + (size_t)gi * 16 * 128 + (size_t)il * 128 + 8 * g;
}
__device__ __forceinline__ void s5_load_u(bf16x8 (&ufa)[4], const bf16_t* P, int rowbase, int grp, int lane) {
    const int g = lane >> 4, il = lane & 15; const bf16x8 zero8 = {0, 0, 0, 0, 0, 0, 0, 0};
#pragma unroll
    for (int Tt = 0; Tt < 4; ++Tt) { const bf16x8 v = *(const bf16x8*)(P + (size_t)(rowbase + 16 * Tt + il) * LDP + PC_S5U + grp * 16 + 8 * (g & 1)); ufa[Tt] = g < 2 ? v : zero8; }
}
template <bool PASSC, int DIR> __device__ __forceinline__ void s5_run_unit(const S5Unit& U, const bf16x8 (&ufa)[4], f32x4 (&yacc)[4], f32x2& hout, LAS float* BU, LAS unsigned char* HW, int lane) {
    const int g = lane >> 4, il = lane & 15;
    f32x2 h = U.h; const f32x2 ab = U.ab;
    bf16x8 cpf[4];
    if (PASSC) {
#pragma unroll
        for (int ks = 0; ks < 4; ++ks) cpf[ks] = *(const bf16x8*)(U.cp + 32 * ks); }
#pragma unroll
    for (int wi = 0; wi < 4; ++wi) {
        const int Tt = DIR ? 3 - wi : wi;
#pragma unroll
        for (int Pt = 0; Pt < 8; ++Pt) { const f32x4 d = MFMA16(U.btf[Pt], ufa[Tt], ((f32x4){0.f, 0.f, 0.f, 0.f}));
#pragma unroll
            for (int r = 0; r < 4; ++r) BU[(16 * Pt + 4 * g + r) * 20 + il] = d[r]; }
        asm volatile("" ::: "memory");
        f32x4 br[4], bi[4];
#pragma unroll
        for (int q = 0; q < 4; ++q) { br[q] = *(const LAS f32x4*)(BU + lane * 20 + 4 * q); bi[q] = *(const LAS f32x4*)(BU + (64 + lane) * 20 + 4 * q); }
#pragma unroll
        for (int s = 0; s < 16; ++s) { const int tt = DIR ? 15 - s : s;
            const float hr = ab.x * h.x - ab.y * h.y + br[tt >> 2][tt & 3], hi = ab.x * h.y + ab.y * h.x + bi[tt >> 2][tt & 3];
            h = (f32x2){hr, hi};
            if (PASSC) *(LAS unsigned*)(HW + off_b(tt, lane >> 2) + (lane & 3) * 4) = pk2(hr, hi); }
        asm volatile("" ::: "memory");
        if (PASSC) {
#pragma unroll
            for (int ks = 0; ks < 4; ++ks) yacc[Tt] = MFMA16(cpf[ks], img_row_frag(HW, lane, 0, ks), yacc[Tt]); }
        asm volatile("" ::: "memory");
    }
    hout = h;
}
template <bool PASSC> __device__ __forceinline__ void s5_item(const DArgs& a, unsigned char* ws, LAS unsigned char* lds, int l, int item, int tid) {
    const int b = item / (SNCH * 2), rem = item % (SNCH * 2), cs = rem >> 1, half = rem & 1;
    const int lane = tid & 63, w = tid >> 6, g = lane >> 4, il = lane & 15;
    const int rowbase = gla_rowbase(b, cs);
    LAS float* BU = (LAS float*)(lds + w * 14336); LAS unsigned char* HW = lds + w * 14336 + 10240;
    const bf16_t* P = (const bf16_t*)(ws + WS_P);
    f32x2* ST = (f32x2*)(ws + WS_S5ST);
    const int grp0 = 16 * half + w, grp1 = grp0 + 8;
    S5Unit UA; bf16x8 ufa[4];
#pragma unroll 1
    for (int gg = 0; gg < 2; ++gg) {
        const int grp = gg ? grp1 : grp0;
        f32x4 yacc[4];
#pragma unroll
        for (int q = 0; q < 4; ++q) yacc[q] = (f32x4){0.f, 0.f, 0.f, 0.f};
        f32x2 hend;
        s5_load_unit<PASSC>(UA, ws, P, ST, l, b, cs, rowbase, grp, 0, lane); s5_load_u(ufa, P, rowbase, grp, lane);
        s5_run_unit<PASSC, 0>(UA, ufa, yacc, hend, BU, HW, lane);
        if (!PASSC) ST[((size_t)(b * SNCH + cs) * 2 + 0) * 2048 + grp * 64 + lane] = hend;
        s5_load_unit<PASSC>(UA, ws, P, ST, l, b, cs, rowbase, grp, 1, lane);
        s5_run_unit<PASSC, 1>(UA, ufa, yacc, hend, BU, HW, lane);
        if (!PASSC) ST[((size_t)(b * SNCH + cs) * 2 + 1) * 2048 + grp * 64 + lane] = hend;
        if (PASSC) {
            const f32x4 dsk = *(const f32x4*)(a.in[I_S5D] + l * 512 + grp * 16 + 4 * g);
            bf16_t* G5 = (bf16_t*)(ws + WS_KF);
#pragma unroll
            for (int Tt = 0; Tt < 4; ++Tt) { const size_t row = (size_t)rowbase + 16 * Tt + il;
                const u32x2 ur = *(const u32x2*)(P + row * LDP + PC_S5U + grp * 16 + 4 * g);
                u32x2 ov; ov.x = pk2(gelu_tanh(yacc[Tt].x + bflo(ur.x) * dsk.x), gelu_tanh(yacc[Tt].y + bfhi(ur.x) * dsk.y));
                ov.y = pk2(gelu_tanh(yacc[Tt].z + bflo(ur.y) * dsk.z), gelu_tanh(yacc[Tt].w + bfhi(ur.y) * dsk.w));
                *(u32x2*)(G5 + row * 512 + grp * 16 + 4 * g) = ov; }
        }
    }
}
__device__ __forceinline__ void s5_passB(unsigned char* ws, int l, int gt) {
    const int p = gt & 63, grp = (gt >> 6) & 31, dir = (gt >> 11) & 1, b = gt >> 12;
    const f32x2 a64 = ((const f32x2*)(ws + WS_S5A64))[((l * 2 + dir) * 32 + grp) * 64 + p];
    f32x2* ST = (f32x2*)(ws + WS_S5ST);
    f32x2 acc = {0.f, 0.f};
#pragma unroll 1
    for (int s0 = 0; s0 < SNCH; s0 += 34) {
        f32x2 ev[34];
#pragma unroll
        for (int j = 0; j < 34; ++j) { const int s = s0 + j; const int cs = dir == 0 ? s : (s < 4 ? 3 - s : 71 - s); ev[j] = ST[((size_t)(b * SNCH + cs) * 2 + dir) * 2048 + grp * 64 + p]; }
#pragma unroll
        for (int j = 0; j < 34; ++j) { const int s = s0 + j; const int cs = dir == 0 ? s : (s < 4 ? 3 - s : 71 - s);
            ST[((size_t)(b * SNCH + cs) * 2 + dir) * 2048 + grp * 64 + p] = acc;
            acc = (f32x2){a64.x * acc.x - a64.y * acc.y + ev[j].x, a64.x * acc.y + a64.y * acc.x + ev[j].y}; }
    }
}
constexpr int FFT_PHYS = 9216;
__device__ __forceinline__ int fphys(int i) { return i + (i >> 3); }
__device__ __forceinline__ f32x2 cmulf(const f32x2 a, const f32x2 b) { return (f32x2){a.x * b.x - a.y * b.y, a.x * b.y + a.y * b.x}; }
__device__ __forceinline__ f32x2 cmulcf(const f32x2 a, const f32x2 b) { return (f32x2){a.x * b.x + a.y * b.y, a.y * b.x - a.x * b.y}; }
template <int RL> __device__ __forceinline__ void dft_fwd_const(f32x2 (&e)[1 << RL]) {
#pragma unroll
    for (int s = 0; s < RL; ++s) { const int h = 1 << (RL - 1 - s);
#pragma unroll
        for (int m = 0; m < (1 << RL); ++m) { if (m & h) continue;
            const int mp = m & (h - 1); const f32x2 a_ = e[m], b_ = e[m | h]; const f32x2 d = a_ - b_; e[m] = a_ + b_;
            if (mp == 0) e[m | h] = d;
            else if (2 * mp == h) e[m | h] = (f32x2){d.y, -d.x};
            else { const float ang = -3.14159265358979323846f * (float)mp / (float)h; const f32x2 c = {__builtin_cosf(ang), __builtin_sinf(ang)}; e[m | h] = cmulf(d, c); } } }
}
template <int RL> __device__ __forceinline__ void dft_inv_const(f32x2 (&e)[1 << RL]) {
#pragma unroll
    for (int ss = 0; ss < RL; ++ss) { const int s = RL - 1 - ss; const int h = 1 << (RL - 1 - s);
#pragma unroll
        for (int m = 0; m < (1 << RL); ++m) { if (m & h) continue;
            const int mp = m & (h - 1); const f32x2 a_ = e[m], b_ = e[m | h]; f32x2 t;
            if (mp == 0) t = b_;
            else if (2 * mp == h) t = (f32x2){-b_.y, b_.x};
            else { const float ang = -3.14159265358979323846f * (float)mp / (float)h; const f32x2 c = {__builtin_cosf(ang), __builtin_sinf(ang)}; t = cmulcf(b_, c); }
            e[m] = a_ + t; e[m | h] = a_ - t; } }
}
template <int RL> __device__ __forceinline__ constexpr int brev_c(int m) { int r = 0; for (int i = 0; i < RL; ++i) r |= ((m >> i) & 1) << (RL - 1 - i); return r; }
template <int RL, bool CONJ> __device__ __forceinline__ void apply_tw(f32x2 (&e)[1 << RL], const f32x2 w1) {
    f32x2 tw[1 << RL];
    tw[0] = (f32x2){1.f, 0.f}; tw[1] = w1;
    if (RL >= 2) { tw[2] = cmulf(w1, w1); tw[3] = cmulf(tw[2], w1); }
    if (RL >= 3) { tw[4] = cmulf(tw[2], tw[2]); tw[5] = cmulf(tw[4], tw[1]); tw[6] = cmulf(tw[4], tw[2]); tw[7] = cmulf(tw[4], tw[3]); }
    if (RL >= 4) { tw[8] = cmulf(tw[4], tw[4]);
#pragma unroll
        for (int k = 1; k < 8; ++k) tw[8 + k] = cmulf(tw[8], tw[k]); }
#pragma unroll
    for (int m = 1; m < (1 << RL); ++m) e[m] = CONJ ? cmulcf(e[m], tw[brev_c<RL>(m)]) : cmulf(e[m], tw[brev_c<RL>(m)]);
}
template <int RL, int BETA, bool INV> __device__ __forceinline__ void fft2_pass(LAS f32x2* X, const LAS f32x2* W, int tid) {
    constexpr int LOW = BETA - RL + 1, NG = FFTN >> RL, STR = (1 << LOW) + (1 << (LOW - 3));
#pragma unroll 1
    for (int gi = tid; gi < NG; gi += NT) {
        const int base = ((gi >> LOW) << (BETA + 1)) | (gi & ((1 << LOW) - 1));
        LAS f32x2* p = X + fphys(base);
        f32x2 e[1 << RL];
#pragma unroll
        for (int m = 0; m < (1 << RL); ++m) e[m] = p[m * STR];
        const f32x2 w1 = W[(base & ((1 << LOW) - 1)) << (12 - BETA)];
        if (!INV) { dft_fwd_const<RL>(e); apply_tw<RL, false>(e, w1); }
        else { apply_tw<RL, true>(e, w1); dft_inv_const<RL>(e); }
#pragma unroll
        for (int m = 0; m < (1 << RL); ++m) p[m * STR] = e[m];
    }
}
__device__ __forceinline__ void fft2_fwd_ABC(LAS f32x2* X, const LAS f32x2* W, int tid) {
    fft2_pass<4, 12, false>(X, W, tid); __syncthreads(); fft2_pass<3, 8, false>(X, W, tid); __syncthreads(); fft2_pass<3, 5, false>(X, W, tid); __syncthreads();
}
__device__ __forceinline__ void fft2_inv_CBA(LAS f32x2* X, const LAS f32x2* W, int tid) {
    fft2_pass<3, 5, true>(X, W, tid); __syncthreads(); fft2_pass<3, 8, true>(X, W, tid); __syncthreads(); fft2_pass<4, 12, true>(X, W, tid); __syncthreads();
}
__device__ __forceinline__ void fft2_mid_mul(LAS f32x2* X, const f32x2* KF, int tid) {
#pragma unroll 1
    for (int gi = tid; gi < 1024; gi += NT) {
        LAS f32x2* p = X + 9 * gi;
        f32x2 e[8]; f32x4 kf[4];
#pragma unroll
        for (int q = 0; q < 4; ++q) kf[q] = *(const f32x4*)(KF + 8 * gi + 2 * q);
#pragma unroll
        for (int m = 0; m < 8; ++m) e[m] = p[m];
        dft_fwd_const<3>(e);
#pragma unroll
        for (int q = 0; q < 4; ++q) { e[2 * q] = cmulf(e[2 * q], (f32x2){kf[q].x, kf[q].y}); e[2 * q + 1] = cmulf(e[2 * q + 1], (f32x2){kf[q].z, kf[q].w}); }
        dft_inv_const<3>(e);
#pragma unroll
        for (int m = 0; m < 8; ++m) p[m] = e[m];
    }
}
__device__ __forceinline__ void fft2_fwd_D(LAS f32x2* X, int tid) {
#pragma unroll 1
    for (int gi = tid; gi < 1024; gi += NT) { LAS f32x2* p = X + 9 * gi; f32x2 e[8];
#pragma unroll
        for (int m = 0; m < 8; ++m) e[m] = p[m];
        dft_fwd_const<3>(e);
#pragma unroll
        for (int m = 0; m < 8; ++m) p[m] = e[m]; }
}

__device__ __forceinline__ void filt_item2(const DArgs& a, unsigned char* ws, LAS unsigned char* lds, int l, int c, int tid) {
    LAS f32x2* X = (LAS f32x2*)lds; LAS f32x2* W = (LAS f32x2*)(lds + FFT_PHYS * 8); LAS float* w4s = (LAS float*)(lds + FFT_PHYS * 8 + 32768); LAS float* red = w4s + 256;
    fft_twiddles(W, tid);
    if (tid < 128) { const int cc = tid >> 5, pr = tid & 31; const float* wsrc = a.in[I_HW4] + (size_t)l * 64 * 2048 + (cc >> 1) * 1024 + (cc & 1) * 512 + c;
        ((LAS unsigned*)w4s)[pr * 4 + cc] = pk2(wsrc[(size_t)(2 * pr) * 2048], wsrc[(size_t)(2 * pr + 1) * 2048]); }
    if (tid == 0) { float z0; asm volatile("v_mov_b32 %0, 0" : "=v"(z0)); X[fphys(4096)] = (f32x2){z0, z0}; }
    __syncthreads();
    const float dl = fabsf(HY_D0 + (HY_D1 - HY_D0) * ((float)c / 511.0f));
    const bf16_t* H3 = (const bf16_t*)(ws + WS_H3B) + (size_t)l * 4096 * 64;
    float ss0 = 0.f, ss1 = 0.f;
#pragma unroll 1
    for (int j = 0; j < 8; ++j) {
        const int t = tid + 512 * j;
        const u32x4* hr = (const u32x4*)(H3 + (size_t)t * 64);
        u32x4 hraw[8];
#pragma unroll
        for (int q = 0; q < 8; ++q) hraw[q] = hr[q];
        asm volatile("" ::: "memory");
        float f0 = 0.f, f1 = 0.f, b0 = 0.f, b1 = 0.f;
        typedef __bf16 bfp2 __attribute__((ext_vector_type(2)));
#pragma unroll
        for (int q = 0; q < 8; ++q) {
#pragma unroll
            for (int e = 0; e < 4; ++e) { const u32x4 wq = ((const LAS u32x4*)w4s)[4 * q + e]; const unsigned hx = hraw[q][e];
                f0 += bflo(hx) * bflo(wq.x) + bfhi(hx) * bfhi(wq.x); f1 += bflo(hx) * bflo(wq.y) + bfhi(hx) * bfhi(wq.y);
                b0 += bflo(hx) * bflo(wq.z) + bfhi(hx) * bfhi(wq.z); b1 += bflo(hx) * bflo(wq.w) + bfhi(hx) * bfhi(wq.w); } }
        const float dec = expf(-((float)t / 4095.0f) * dl); f0 *= dec; f1 *= dec; b0 *= dec; b1 *= dec;
        X[fphys(t)] = (f32x2){f0, f1}; ss0 += f0 * f0; ss1 += f1 * f1;
        if (t > 0) { X[fphys(8192 - t)] = (f32x2){b0, b1}; ss0 += b0 * b0; ss1 += b1 * b1; }
    }
    const float rs0 = rsqrtf(block_sum(ss0, red, tid) + EPS), rs1 = rsqrtf(block_sum(ss1, red, tid) + EPS);
#pragma unroll 4
    for (int j = 0; j < 16; ++j) { const int n = fphys(tid + 512 * j); const f32x2 x = X[n]; X[n] = (f32x2){x.x * rs0, x.y * rs1}; }
    __syncthreads(); fft2_fwd_ABC(X, W, tid); fft2_fwd_D(X, tid); __syncthreads();
    f32x2* KF0 = (f32x2*)(ws + WS_KF) + (size_t)(0 * 512 + c) * FFTN; f32x2* KF1 = (f32x2*)(ws + WS_KF) + (size_t)(1 * 512 + c) * FFTN;
#pragma unroll 4
    for (int j = 0; j < 16; ++j) { const int pos = tid + 512 * j; const int k = (int)(__brev((unsigned)pos) >> 19); const int pp = (int)(__brev((unsigned)((8192 - k) & 8191)) >> 19);
        const f32x2 za = X[fphys(pos)], zb = X[fphys(pp)];
        KF0[pos] = (f32x2){0.5f * (za.x + zb.x), 0.5f * (za.y - zb.y)};
        KF1[pos] = (f32x2){0.5f * (za.y + zb.y), 0.5f * (zb.x - za.x)}; }
    __syncthreads();
}

struct Raw8 { u32x4 mid; bf16_t lf, rt; };
__device__ __forceinline__ Raw8 ld_raw8(const bf16_t* p, int t0, int Lx) { Raw8 r; r.mid = *(const u32x4*)(p + t0); r.lf = t0 > 0 ? p[t0 - 1] : (bf16_t)0; r.rt = t0 + 8 < Lx ? p[t0 + 8] : (bf16_t)0; return r; }
__device__ __forceinline__ void sconv8(const Raw8& r, float w0, float w1, float w2, float cb, float (&o)[8]) {
    float x[10]; x[0] = bf2f(r.lf); x[9] = bf2f(r.rt);
    x[1] = bflo(r.mid.x); x[2] = bfhi(r.mid.x); x[3] = bflo(r.mid.y); x[4] = bfhi(r.mid.y); x[5] = bflo(r.mid.z); x[6] = bfhi(r.mid.z); x[7] = bflo(r.mid.w); x[8] = bfhi(r.mid.w);
#pragma unroll
    for (int i = 0; i < 8; ++i) o[i] = w0 * x[i] + w1 * x[i + 1] + w2 * x[i + 2] + cb;
}
__device__ __forceinline__ void hyena_item2(const DArgs& a, unsigned char* ws, LAS unsigned char* lds, int l, int c, int tid) {
    LAS f32x2* X = (LAS f32x2*)lds; LAS f32x2* W = (LAS f32x2*)(lds + FFT_PHYS * 8);
    fft_twiddles(W, tid);
    const float* cw = a.in[I_HCW] + (size_t)l * 3 * 1536; const float* cbp = a.in[I_HCB] + (size_t)l * 1536;
    const float wv0 = cw[c], wv1 = cw[1536 + c], wv2 = cw[3072 + c], bv = cbp[c];
    const float wa0 = cw[512 + c], wa1 = cw[1536 + 512 + c], wa2 = cw[3072 + 512 + c], ba = cbp[512 + c];
    const float wb0 = cw[1024 + c], wb1 = cw[1536 + 1024 + c], wb2 = cw[3072 + 1024 + c], bb = cbp[1024 + c];
    const float bias0 = a.in[I_HBIAS][(l * 2 + 0) * 512 + c], bias1 = a.in[I_HBIAS][(l * 2 + 1) * 512 + c];
    const bf16_t* PT = (const bf16_t*)(ws + WS_PT);
    const bf16_t* pv = PT + (size_t)(PT_V + c) * MR; const bf16_t* pg1 = PT + (size_t)(PT_G1 + c) * MR; const bf16_t* pg2 = PT + (size_t)(PT_G2 + c) * MR; const bf16_t* phg = PT + (size_t)(PT_HG + c) * MR;
    const f32x2* KF0 = (const f32x2*)(ws + WS_KF) + (size_t)(0 * 512 + c) * FFTN; const f32x2* KF1 = (const f32x2*)(ws + WS_KF) + (size_t)(1 * 512 + c) * FFTN;
    bf16_t* GATED = (bf16_t*)(ws + WS_H);
    const int t0 = 8 * tid;
    LAS f32x2* px = X + 9 * tid;
    __syncthreads();
    for (int bp = 0; bp < 2; ++bp) {
        const int r0 = (2 * bp) * SEQL, r1 = (2 * bp + 1) * SEQL;
        const Raw8 v0 = ld_raw8(pv + r0, t0, SEQL), v1 = ld_raw8(pv + r1, t0, SEQL);
        const Raw8 g10 = ld_raw8(pg1 + r0, t0, SEQL), g11 = ld_raw8(pg1 + r1, t0, SEQL);
        float zr[8], zi[8];
        sconv8(v0, wv0, wv1, wv2, bv, zr); sconv8(v1, wv0, wv1, wv2, bv, zi);
#pragma unroll
        for (int x = 0; x < 8; ++x) { px[x] = (f32x2){zr[x], zi[x]}; px[4608 + x] = (f32x2){0.f, 0.f}; }
        __syncthreads(); fft2_fwd_ABC(X, W, tid); fft2_mid_mul(X, KF0, tid); __syncthreads(); fft2_inv_CBA(X, W, tid);
        { float gr[8], gi[8]; sconv8(g10, wa0, wa1, wa2, ba, gr); sconv8(g11, wa0, wa1, wa2, ba, gi);
#pragma unroll
          for (int x = 0; x < 8; ++x) { const f32x2 cv = px[x] * (1.0f / 8192.0f); zr[x] = gr[x] * (cv.x + bias0 * zr[x]); zi[x] = gi[x] * (cv.y + bias0 * zi[x]); } }
        __syncthreads();
        const Raw8 g20 = ld_raw8(pg2 + r0, t0, SEQL), g21 = ld_raw8(pg2 + r1, t0, SEQL);
        const u32x4 hgr0 = *(const u32x4*)(phg + r0 + t0), hgr1 = *(const u32x4*)(phg + r1 + t0);
#pragma unroll
        for (int x = 0; x < 8; ++x) { px[x] = (f32x2){zr[x], zi[x]}; px[4608 + x] = (f32x2){0.f, 0.f}; }
        __syncthreads(); fft2_fwd_ABC(X, W, tid); fft2_mid_mul(X, KF1, tid); __syncthreads(); fft2_inv_CBA(X, W, tid);
        { float gr[8], gi[8], h0[8], h1[8]; sconv8(g20, wb0, wb1, wb2, bb, gr); sconv8(g21, wb0, wb1, wb2, bb, gi); unpack8(hgr0, h0); unpack8(hgr1, h1);
#pragma unroll
          for (int x = 0; x < 8; ++x) { const f32x2 cv = px[x] * (1.0f / 8192.0f);
              const float z2r = gr[x] * (cv.x + bias1 * zr[x]), z2i = gi[x] * (cv.y + bias1 * zi[x]);
              gr[x] = z2r * siluf_(h0[x]); gi[x] = z2i * siluf_(h1[x]); }
          bf16_t* pvw = (bf16_t*)(ws + WS_PT) + (size_t)(PT_V + c) * MR;
          *(u32x4*)(pvw + r0 + t0) = pack8(gr); *(u32x4*)(pvw + r1 + t0) = pack8(gi); }
        __syncthreads();
    }
}

__device__ __forceinline__ void hy_transpose_item(unsigned char* ws, LAS unsigned char* lds, int item, int tid, int nrows) {
    const int lane = tid & 63, w = tid >> 6;
    const int wi = item * 8 + w;
    const int nrb = nrows / 64;
    if (wi >= nrb * 8) return;
    const int rb = wi >> 3, cb = wi & 7;
    LAS bf16_t* T = (LAS bf16_t*)(lds + w * 8704);
    const bf16_t* src = (const bf16_t*)(ws + WS_PT) + (size_t)(PT_V + cb * 64) * MR + (size_t)rb * 64;
#pragma unroll 4
    for (int i = 0; i < 8; ++i) { const int c = 8 * i + (lane >> 3), r8 = (lane & 7) * 8;
        const u32x4 v = *(const u32x4*)(src + (size_t)c * MR + r8);
        LAS unsigned* d = (LAS unsigned*)(T + c * 66 + r8); d[0] = v.x; d[1] = v.y; d[2] = v.z; d[3] = v.w; }
    asm volatile("s_waitcnt lgkmcnt(0)" ::: "memory");
    bf16_t* dst = (bf16_t*)(ws + WS_H) + (size_t)(rb * 64) * D + 512 + cb * 64;
#pragma unroll 4
    for (int i = 0; i < 8; ++i) { const int r = 8 * i + (lane >> 3), c8 = (lane & 7) * 8;
        unsigned short e[8];
#pragma unroll
        for (int x = 0; x < 8; ++x) e[x] = T[(c8 + x) * 66 + r];
        u32x4 o; o.x = e[0] | ((unsigned)e[1] << 16); o.y = e[2] | ((unsigned)e[3] << 16); o.z = e[4] | ((unsigned)e[5] << 16); o.w = e[6] | ((unsigned)e[7] << 16);
        *(u32x4*)(dst + (size_t)r * D + c8) = o; }
    asm volatile("s_waitcnt lgkmcnt(0)" ::: "memory");
}
#ifndef MK_EN
#define MK_EN 0xffff
#endif
#define EN(x) ((MK_EN >> (x)) & 1)
constexpr int PH_PREP = 0, PH_PER_LAYER = 7, PH_FNORM = 1 + 2 * PH_PER_LAYER, N_PHASES = PH_FNORM + 1;

__global__ void __launch_bounds__(NT, 2) fwd_kernel(Args ka) {
    extern __shared__ __attribute__((aligned(16))) unsigned char lds_raw[];
    LAS unsigned char* lds = (LAS unsigned char*)lds_raw;
    const int G = gridDim.x;
    volatile LAS unsigned* bst = (volatile LAS unsigned*)(lds + LDS_CTL_OFF);
    if (threadIdx.x < 16) bst[threadIdx.x] = 0u;
    if (threadIdx.x == 0) { LAS unsigned long long* tab = (LAS unsigned long long*)(lds + LDS_PTR_OFF);
#pragma unroll
        for (int i = 0; i < N_IN; ++i) tab[i] = (unsigned long long)ka.in[i]; }
    __syncthreads();

    XcdBarrier gbar; gbar.bar = (unsigned*)(ka.ws + WS_CTL); gbar.x = 0; gbar.st = bst;
    if (ka.ph_hi - ka.ph_lo > 1) gbar = xcd_barrier_post((unsigned*)(ka.ws + WS_CTL), bst);

#ifdef REP_SUB
    int repmask = 0;
#endif
    for (int ph = ka.ph_lo; ph < ka.ph_hi; ++ph) {
        int tid = threadIdx.x; asm volatile("" : "+v"(tid));
        int bid = blockIdx.x; asm volatile("" : "+s"(bid));
#define LANE_WAVE() int tid2_ = threadIdx.x; asm volatile("" : "+v"(tid2_)); const int lane = tid2_ & 63, wave = __builtin_amdgcn_readfirstlane(tid2_ >> 6)
        unsigned char* ws = ka.ws; asm volatile("" : "+s"(ws));
        float* outp_ = ka.out; asm volatile("" : "+s"(outp_));
        DArgs a; a.in.t = (const LAS unsigned long long*)(lds + LDS_PTR_OFF); a.out = outp_;
        float* MOD = (float*)(ws + WS_MOD);
        if (EN(0) && ph == PH_PREP) {
            for (int it = bid; it < 1048 + 544; it += G) {
                int tid = threadIdx.x; asm volatile("" : "+v"(tid));
                __syncthreads();
                if (it < 768) prep_adaln(a.in[I_C], a.in[I_CCTX], a.in[I_ADAW], a.in[I_ADAB], MOD, it, (LAS float*)lds, tid);
                else if (it < 784) prep_s5b(a, ws, it - 768, tid);
                else if (it >= 1048) prep_rope((f32x2*)(ws + WS_ROPE), it - 1048, tid);
                else { const bool big = it < 1040; const int r = big ? it - 784 : it - 1040, l = big ? (r >> 7) : 0, t0 = (big ? (r & 127) : r) * 32;
                    float* H3o = big ? (float*)(ws + WS_H3) + (size_t)l * 4096 * 64 : (float*)(ws + WS_H3C);
                    bf16_t* H3b = big ? (bf16_t*)(ws + WS_H3B) + (size_t)l * 4096 * 64 : (bf16_t*)nullptr;
                    prep_hymlp(a, H3o, H3b, l, big ? 4096 : 256, t0, lds, tid); }
            }
        } else if (EN(1) && ph == PH_FNORM) {
            const float* fw = a.in[I_FNW]; LANE_WAVE();
            for (int row = bid * NWAVES + wave; row < NLAT; row += G * NWAVES) {
                float* xr = a.out + (size_t)row * D; f32x4 v[8]; float ss = 0.f;
#pragma unroll
                for (int j = 0; j < 8; ++j) { v[j] = ((const f32x4*)xr)[lane + 64 * j]; ss += (v[j].x * v[j].x + v[j].y * v[j].y) + (v[j].z * v[j].z + v[j].w * v[j].w); }
                const float rstd = rsqrtf(wave_sum(ss) * (1.0f / D) + EPS);
#pragma unroll
                for (int j = 0; j < 8; ++j) { const f32x4 w = *(const f32x4*)(fw + 4 * (lane + 64 * j)); ((f32x4*)xr)[lane + 64 * j] = v[j] * rstd * w; }
            }
        } else {
            const int l = (ph - 1) / PH_PER_LAYER, sub = (ph - 1) % PH_PER_LAYER;

            const bool ctx_out = (l == 0);
            const int Mrows = ctx_out ? MR : NLAT;
            if (EN(2) && sub == 0) {
                LANE_WAVE();
                LAS float* scr = (LAS float*)(lds + wave * 8704);
                const int gw = bid * NWAVES + wave, NGW = G * NWAVES;
                constexpr int I_W1 = 32 * (NPAD / 32), I_W2 = 32 * 64, I_W3 = 8 * 16;
                for (int it = gw; it < I_W1 + I_W2 + I_W3; it += NGW) {
                    int r = it;
                    if (r < I_W1) { const int kb = r / (NPAD / 32), nb = r % (NPAD / 32); transpose_item(a.in[I_WIN] + (size_t)l * D * INW, INW, win_srccol(nb * 32 + (lane & 31)), kb * 64, (bf16_t*)(ws + WS_WIN), D, nb * 32, scr, lane); continue; }
                    r -= I_W1;
                    if (r < I_W2) { const int kb = r / 64, nb = r % 64; transpose_item(a.in[I_WOUT] + (size_t)l * D * D, D, nb * 32 + (lane & 31), kb * 64, (bf16_t*)(ws + WS_WOUT), D, nb * 32, scr, lane); continue; }
                    r -= I_W2;
                    { const int kb = r / 16, nb = r % 16; transpose_item(a.in[I_GLUW] + (size_t)l * 512 * 512, 512, nb * 32 + (lane & 31), kb * 64, (bf16_t*)(ws + WS_GLUW), 512, nb * 32, scr, lane); }
                }
                const float* nw = a.in[I_NORMW] + (size_t)l * D;
                for (int row = gw; row < MR; row += NGW) {
                    const float* xr; int v;
                    if (row < NLAT) { xr = (l == 0 ? a.in[I_X] : a.out) + (size_t)row * D; v = row >> 12; }
                    else { xr = (l == 0 ? a.in[I_CTX] : (const float*)(ws + WS_XC1)) + (size_t)(row - NLAT) * D; v = 4; }
                    norm_row(xr, nw, MOD + (size_t)(l * 5 + v) * ADA, (bf16_t*)(ws + WS_H) + (size_t)row * D, lane);
                }
                __syncthreads();
                const int nfilt = ctx_out ? 1024 : 512;
                for (int it = bid; it < nfilt; it += G) { int tid = threadIdx.x; asm volatile("" : "+v"(tid)); __syncthreads(); if (it < 512) filt_item2(a, ws, lds, l, it, tid); else filt_ctx_item(a, ws, lds, it - 512, tid);
#if defined(REP_ITEM) && REP_ITEM == 10
                    __syncthreads(); if (it < 512) filt_item2(a, ws, lds, l, it, tid);
#endif
                }
            } else if (EN(3) && sub == 1) {
                pg8::Gemm g{(const bf16_t*)(ws + WS_H), (const bf16_t*)(ws + WS_WIN), MR, NPAD, D}; pg8::StaticOrder S; S.init(MR, NPAD, G, bid);
                EpiInProj E{(bf16_t*)(ws + WS_P), (bf16_t*)(ws + WS_PT), (float*)(ws + WS_LR), (const float*)(ws + WS_ROPE)};
                pg8::gemm_phase<EpiInProj, pg8::StaticOrder, true, true>(lds, g, S, E, tid);
            } else if (EN(5) && sub == 2) {
                const int nit = ctx_out ? 3200 : 2688;
                for (int it = bid; it < nit; it += G) {
                    int tid = threadIdx.x; asm volatile("" : "+v"(tid));
                    __syncthreads();
#ifdef REP_ITEM
                    for (int rep_ = 0; rep_ < 2; ++rep_) { const int ty_ = it < 544 ? 0 : it < 1088 ? 1 : it < 2176 ? 2 : it < 2688 ? 3 : 4; if (rep_ && ty_ != REP_ITEM) break; if (rep_) __syncthreads(); asm volatile("" : "+v"(tid));
#endif
                    if (it < 544) s5_item<false>(a, ws, lds, l, it, tid);
                    else if (it < 1088) ret_passA(ws, lds, it - 544, tid);
                    else if (it < 2176) gla_passA(a, ws, lds, l, it - 1088, tid);
                    else if (it < 2688) hyena_item2(a, ws, lds, l, it - 2176, tid);
                    else hyena_ctx_item(a, ws, lds, it - 2688, tid);
#ifdef REP_ITEM
                    }
#endif
                }
            } else if (EN(9) && sub == 3) {
                for (int it = bid; it < 256; it += G) { int tid = threadIdx.x; asm volatile("" : "+v"(tid)); __syncthreads(); hy_transpose_item(ws, lds, it, tid, NLAT); }
                for (int it = bid; it < 224; it += G) { int tid = threadIdx.x; asm volatile("" : "+v"(tid)); __syncthreads();
                    if (it < 128) ret_passB(ws, it * NT + tid);
                    else if (it < 192) gla_passB(ws, lds, it - 128, tid);
                    else s5_passB(ws, l, (it - 192) * NT + tid); }
            } else if (EN(6) && sub == 4) {
                const int nsc = ctx_out ? 544 : 512, nrc = ctx_out ? 16 * RNCH : 16 * 32, ngc = ctx_out ? 16 * GNCH : 16 * 64;
                for (int it = bid; it < nsc + nrc + ngc; it += G) { int tid = threadIdx.x; asm volatile("" : "+v"(tid)); __syncthreads();
#ifdef REP_ITEM
                    for (int rep_ = 0; rep_ < 2; ++rep_) { const int ty_ = it < nsc ? 20 : it < nsc + nrc ? 21 : 22; if (rep_ && ty_ != REP_ITEM) break; if (rep_) __syncthreads(); asm volatile("" : "+v"(tid));
#endif
                    if (it < nsc) { const int item = ctx_out ? it : (it >> 7) * (SNCH * 2) + 8 + (it & 127); s5_item<true>(a, ws, lds, l, item, tid); }
                    else if (it < nsc + nrc) { const int r = it - nsc; const int item = ctx_out ? r : (r >> 5) * RNCH + 2 + (r & 31); ret_passC(a, ws, lds, l, item, tid); }
                    else { const int r = it - nsc - nrc; const int item = ctx_out ? r : (r >> 6) * GNCH + 4 + (r & 63); gla_passC(a, ws, lds, l, item, tid); }
#ifdef REP_ITEM
                    }
#endif
                }
            } else if (EN(7) && sub == 5) {
                pg8::Gemm g{(const bf16_t*)(ws + WS_KF), (const bf16_t*)(ws + WS_GLUW), Mrows, 512, 512}; pg8::StaticOrder S; S.init(Mrows, 512, G, bid);
                EpiGlu E{(const bf16_t*)(ws + WS_KF), (const bf16_t*)(ws + WS_P), (bf16_t*)(ws + WS_H), a.in[I_GLUB] + (size_t)l * 512};
                pg8::gemm_phase<EpiGlu, pg8::StaticOrder, true, true>(lds, g, S, E, tid);
            } else if (EN(8)) {
                pg8::Gemm g{(const bf16_t*)(ws + WS_H), (const bf16_t*)(ws + WS_WOUT), Mrows, D, D}; pg8::StaticOrder S; S.init(Mrows, D, G, bid);
                EpiOut E{l == 0 ? a.in[I_X] : a.out, a.in[I_CTX], a.out, (float*)(ws + WS_XC1), MOD + (size_t)l * 5 * ADA};
                pg8::gemm_phase<EpiOut, pg8::StaticOrder, true, true>(lds, g, S, E, tid);
            }
        }
#ifdef REP_SUB
        if (ph != PH_PREP && ph != PH_FNORM && ((ph - 1) % PH_PER_LAYER) == REP_SUB && !((repmask >> ((ph - 1) / PH_PER_LAYER)) & 1)) { repmask |= 1 << ((ph - 1) / PH_PER_LAYER); xcd_barrier(gbar); --ph; continue; }
#endif
        if (ph + 1 < ka.ph_hi) xcd_barrier(gbar);
    }
}

#ifndef MK_LAUNCH_PER_PHASE
#define MK_LAUNCH_PER_PHASE 0
#endif
extern "C" void kernel_launch(void* const* d_in, const int* in_sizes, int n_in, void* d_out, int out_size, void* d_ws, size_t ws_size, hipStream_t stream) {
    static int grid = 0;
    if (grid == 0) {
        if (n_in != N_IN || out_size != NLAT * D || ws_size < WS_END2) { fprintf(stderr, "kernel_launch: unexpected shapes (n_in %d, out %d, ws %zu < %zu); nothing launched\n", n_in, out_size, ws_size, (size_t)WS_END2); grid = -1; return; }
        int dev = 0, cus = 0, per_cu = 0;
        if (hipGetDevice(&dev) != hipSuccess || hipDeviceGetAttribute(&cus, hipDeviceAttributeMultiprocessorCount, dev) != hipSuccess) { grid = -1; return; }
        if (hipFuncSetAttribute((const void*)fwd_kernel, hipFuncAttributeMaxDynamicSharedMemorySize, LDS_BYTES) != hipSuccess) { fprintf(stderr, "kernel_launch: hipFuncSetAttribute failed\n"); grid = -1; return; }
        if (hipOccupancyMaxActiveBlocksPerMultiprocessor(&per_cu, (const void*)fwd_kernel, NT, LDS_BYTES) != hipSuccess || per_cu < 1) { fprintf(stderr, "kernel_launch: occupancy query says %d blocks per CU\n", per_cu); per_cu = 1; }
        (void)hipGetLastError();
        grid = cus;
    }
    if (grid < 0) return;
    (void)hipMemsetAsync((char*)d_ws + WS_CTL, 0, WS_ZERO_BYTES, stream);
    Args a{};
    for (int i = 0; i < N_IN; ++i) a.in[i] = (const float*)d_in[i];
    a.out = (float*)d_out; a.ws = (unsigned char*)d_ws;
#if MK_LAUNCH_PER_PHASE
    for (int ph = 0; ph < N_PHASES; ++ph) {
        a.ph_lo = ph; a.ph_hi = ph + 1;
        hipLaunchKernelGGL(fwd_kernel, dim3(grid), dim3(NT), LDS_BYTES, stream, a);
    }
#else
    a.ph_lo = 0; a.ph_hi = N_PHASES;
    void* args[] = {&a};
    hipError_t e = hipLaunchCooperativeKernel((const void*)fwd_kernel, dim3(grid), dim3(NT), args, LDS_BYTES, stream);
    if (e != hipSuccess) fprintf(stderr, "kernel_launch: cooperative launch failed: %s (grid %d)\n", hipGetErrorString(e), grid);
#endif
}
```

```cpp
#include <hip/hip_runtime.h>
#include <hip/hip_cooperative_groups.h>
#include <cstdio>
#include <cstdint>
namespace cg = cooperative_groups;

#define LAS __attribute__((address_space(3)))
typedef unsigned short bf16_t;
typedef float f32x4 __attribute__((ext_vector_type(4)));
typedef float f32x2 __attribute__((ext_vector_type(2)));
typedef unsigned u32x4 __attribute__((ext_vector_type(4)));
typedef unsigned u32x2 __attribute__((ext_vector_type(2)));

constexpr int D = 2048, NB = 4, SEQL = 4096, LC = 256, NLAT = NB * SEQL, NCTX = NB * LC, MR = NLAT + NCTX;
constexpr int BR = 512, INW = 6688, NPAD = 6912, LDP = 4608, ADA = 3 * D;
constexpr int NT = 512, NWAVES = 8;
constexpr float EPS = 1e-6f;
constexpr int PC_S5U = 0, PC_S5G = 512, PC_RQ = 1024, PC_RK = 1536, PC_RV = 2048, PC_RG = 2560, PC_GQ = 3072, PC_GK = 3328, PC_GV = 3584, PC_GG = 4096;
constexpr int PT_V = 0, PT_G1 = 512, PT_G2 = 1024, PT_HG = 1536;
constexpr int FFTN = 8192;

enum { I_X = 0, I_C, I_CTX, I_CCTX, I_NORMW, I_ADAW, I_ADAB, I_WIN, I_WOUT, I_S5ARE, I_S5AIM, I_S5LDT, I_S5BRE, I_S5BIM, I_S5CRE, I_S5CIM,
       I_S5D, I_GLUW, I_GLUB, I_HCW, I_HCB, I_HW1, I_HB1, I_HF1, I_HW2, I_HB2, I_HF2, I_HW3, I_HB3, I_HF3, I_HW4, I_HBIAS, I_RNW, I_GGW, I_GGB, I_GNW, I_FNW, N_IN };

constexpr size_t al256(size_t x) { return (x + 255) & ~(size_t)255; }
constexpr size_t WS_CTL  = 0;
constexpr size_t WS_MOD  = WS_CTL + 65536;
constexpr size_t WS_ZERO_BYTES = 65536 + al256((size_t)2 * 5 * ADA * 4);
constexpr size_t WS_S5AB = WS_MOD + al256((size_t)2 * 5 * ADA * 4);
constexpr size_t WS_S5BT = WS_S5AB + (size_t)2 * 2 * 32 * 64 * 8;
constexpr size_t WS_H3   = WS_S5BT + (size_t)1048576 + 65536;
constexpr size_t WS_H3C  = WS_H3 + (size_t)2 * 4096 * 64 * 4;
constexpr size_t WS_KC   = WS_H3C + (size_t)256 * 64 * 4;
constexpr size_t WS_LR   = WS_KC + (size_t)2 * 512 * 512 * 4;
constexpr size_t WS_XC1  = WS_LR + (size_t)MR * 32 * 4;
constexpr size_t WS_WOUT = WS_XC1 + (size_t)NCTX * D * 4;
constexpr size_t WS_GLUW = WS_WOUT + (size_t)D * D * 2;
constexpr size_t WS_WIN  = WS_GLUW + (size_t)512 * 512 * 2;
constexpr size_t WS_H    = WS_WIN + (size_t)NPAD * D * 2;
constexpr size_t WS_P    = WS_H + (size_t)MR * D * 2;
constexpr size_t WS_PT   = WS_P + (size_t)MR * LDP * 2;
constexpr size_t WS_KF   = WS_PT + (size_t)2048 * MR * 2;
constexpr size_t WS_OB   = WS_KF + (size_t)2 * 512 * FFTN * 8;
constexpr size_t WS_END  = WS_OB + (size_t)6 * MR * 512 * 2;
constexpr size_t OBSZ = (size_t)MR * 512;

constexpr int LDS_CTL_OFF = 131072 + 2048;
constexpr int LDS_PTR_OFF = LDS_CTL_OFF + 64;
constexpr int LDS_BYTES = LDS_PTR_OFF + 320;

typedef __bf16 hwbf16x2 __attribute__((ext_vector_type(2)));
__device__ __forceinline__ unsigned pk2(float lo, float hi) { const f32x2 v = {lo, hi}; return __builtin_bit_cast(unsigned, __builtin_convertvector(v, hwbf16x2)); }
__device__ __forceinline__ unsigned f2bf(float f) { return pk2(f, 0.f) & 0xffffu; }
__device__ __forceinline__ float bf2f(bf16_t b) { return __uint_as_float((unsigned)b << 16); }
__device__ __forceinline__ float bflo(unsigned w) { return __uint_as_float(w << 16); }
__device__ __forceinline__ float bfhi(unsigned w) { return __uint_as_float(w & 0xffff0000u); }
__device__ __forceinline__ void unpack8(const u32x4 r, float (&f)[8]) { f[0] = bflo(r.x); f[1] = bfhi(r.x); f[2] = bflo(r.y); f[3] = bfhi(r.y); f[4] = bflo(r.z); f[5] = bfhi(r.z); f[6] = bflo(r.w); f[7] = bfhi(r.w); }
__device__ __forceinline__ u32x4 pack8(const float (&f)[8]) { u32x4 o; o.x = pk2(f[0], f[1]); o.y = pk2(f[2], f[3]); o.z = pk2(f[4], f[5]); o.w = pk2(f[6], f[7]); return o; }
__device__ __forceinline__ float sigmoidf_(float x) { return 1.0f / (1.0f + __expf(-x)); }
__device__ __forceinline__ float siluf_(float x) { return x * sigmoidf_(x); }
__device__ __forceinline__ float gelu_tanh(float x) { const float u = 0.7978845608028654f * (x + 0.044715f * x * x * x); return 0.5f * x * (1.0f + tanhf(u)); }
__device__ __forceinline__ float wave_sum(float v) {
#pragma unroll
    for (int o = 1; o < 64; o <<= 1) v += __shfl_xor(v, o);
    return v;
}
#define LDS_WAIT() asm volatile("s_waitcnt lgkmcnt(0)" ::: "memory")

struct Args { const float* in[N_IN]; float* out; unsigned char* ws; int ph_lo, ph_hi; };
struct InTab { const LAS unsigned long long* t;
    __device__ __forceinline__ const float* operator[](int i) const { const unsigned long long v = t[i];
        const unsigned lo = __builtin_amdgcn_readfirstlane((unsigned)v), hi = __builtin_amdgcn_readfirstlane((unsigned)(v >> 32)); return (const float*)(((unsigned long long)hi << 32) | lo); } };
struct DArgs { InTab in; float* out; };

#define XB_TMO      128
#define XB_XCNT(j)  (256  + 64 * (j))
#define XB_XSUB(j)  (1280 + 64 * (j))
#define XB_XGEN(j)  (2304 + 64 * (j))
#define XB_TOP      3328
#define XB_TOPGEN   3392
#define XCD_BAR_WORDS 3456
#define XB_SPIN_CAP (1u << 22)
__device__ __forceinline__ unsigned xb_ld(unsigned* p)              { return __hip_atomic_load(p, __ATOMIC_RELAXED, __HIP_MEMORY_SCOPE_AGENT); }
__device__ __forceinline__ unsigned xb_add(unsigned* p, unsigned v) { return __hip_atomic_fetch_add(p, v, __ATOMIC_RELAXED, __HIP_MEMORY_SCOPE_AGENT); }
__device__ __forceinline__ unsigned xb_xcc_id() { return (unsigned)__builtin_amdgcn_s_getreg((3 << 11) | 20) & 0xFu; }
#define XB_SPIN(cond, bar) do { unsigned _sp = 0; while (cond) { __builtin_amdgcn_s_sleep(1); \
    if ((++_sp & 255u) == 0u) { if (xb_ld(&(bar)[XB_TMO])) break; if (_sp > XB_SPIN_CAP) { atomicAdd(&(bar)[XB_TMO], 1u); break; } } } } while (0)
struct XcdBarrier { unsigned* bar; unsigned x; volatile LAS unsigned* st; };
__device__ __forceinline__ XcdBarrier xcd_barrier_post(unsigned* bar, volatile LAS unsigned* st) {
    XcdBarrier b; b.bar = bar; b.x = xb_xcc_id(); b.st = st;
    if (threadIdx.x == 0) (void)xb_add(&bar[XB_XCNT(b.x)], 1u);
    return b;
}
__device__ __forceinline__ void xcd_barrier_complete(unsigned* bar, unsigned x, unsigned& nloc, unsigned& nx) {
    const unsigned G = gridDim.x * gridDim.y * gridDim.z;
    unsigned sum, cnt, mine, sp = 0u;
    for (;;) {
        sum = 0u; cnt = 0u; mine = 0u;
#pragma unroll
        for (unsigned j = 0; j < 16; ++j) { const unsigned c = xb_ld(&bar[XB_XCNT(j)]); sum += c; cnt += (c > 0u) ? 1u : 0u; mine = (j == x) ? c : mine; }
        if (sum == G) break;
        __builtin_amdgcn_s_sleep(1);
        if ((++sp & 255u) == 0u) { if (xb_ld(&bar[XB_TMO])) break; if (sp > XB_SPIN_CAP) { atomicAdd(&bar[XB_TMO], 1u); break; } }
    }
    nloc = mine > 0u ? mine : 1u; nx = cnt > 0u ? cnt : 1u;
}
__device__ __forceinline__ void xcd_barrier(const XcdBarrier& b) {
    asm volatile("s_waitcnt vmcnt(0)" ::: "memory");
    __syncthreads();
    if (threadIdx.x == 0) {
        unsigned* bar = b.bar;
        __builtin_amdgcn_s_waitcnt(0);
        unsigned nloc = b.st[0], nx = b.st[1];
        if (nloc == 0u) { xcd_barrier_complete(bar, b.x, nloc, nx); b.st[0] = nloc; b.st[1] = nx; }
        const unsigned old = xb_add(&bar[XB_XSUB(b.x)], 1u);
        const unsigned gen = old / nloc;
        if (old + 1u == (gen + 1u) * nloc) {
            __builtin_amdgcn_fence(__ATOMIC_RELEASE, "agent");
            asm volatile("s_waitcnt vmcnt(0)" ::: "memory");
            const unsigned og = xb_add(&bar[XB_TOP], 1u);
            const unsigned tg = og / nx;
            if (og + 1u == (tg + 1u) * nx) xb_add(&bar[XB_TOPGEN], 1u);
            else XB_SPIN(xb_ld(&bar[XB_TOPGEN]) == tg, bar);
            __builtin_amdgcn_fence(__ATOMIC_ACQUIRE, "agent");
            xb_add(&bar[XB_XGEN(b.x)], 1u);
            asm volatile("s_waitcnt vmcnt(0)" ::: "memory");
        } else {
            XB_SPIN(xb_ld(&bar[XB_XGEN(b.x)]) == gen, bar);
            __builtin_amdgcn_fence(__ATOMIC_ACQUIRE, "agent");
            asm volatile("s_waitcnt vmcnt(0)" ::: "memory");
        }
    }
    __syncthreads();
}
namespace pg8 {
#define PG8_LAS __attribute__((address_space(3)))
typedef unsigned short bf16_t;
typedef short bf16x8 __attribute__((ext_vector_type(8)));
typedef float f32x4 __attribute__((ext_vector_type(4)));
typedef unsigned u32x4 __attribute__((ext_vector_type(4)));
constexpr int BM = 256, BK = 64, HALF = 128, HTB = HALF * BK * 2, STAGE_BYTES = 8 * HTB, NXCD = 8, WGM = 8;

__host__ __device__ __forceinline__ int lds_byte(int r, int c) { const int st = (r >> 4) * 2 + (c >> 5), rr = r & 15, cc = c & 31, ob = rr * 64 + cc * 2; return st * 1024 + (ob ^ (((ob >> 9) & 1) << 5)); }
__host__ __device__ __forceinline__ void stage_rc(int b, int& R, int& C) { const int st = b / 1024, sb = b % 1024, swz = sb ^ (((sb >> 9) & 1) << 5); R = (st >> 1) * 16 + swz / 64; C = (st & 1) * 32 + (swz % 64) / 2; }
__host__ __device__ __forceinline__ int perm32(int rho) { const int n = rho >> 4, i = rho & 15; return 8 * (i >> 2) + 4 * n + (i & 3); }

struct Unit { int pm, pn; };
struct Gemm { const bf16_t* A; const bf16_t* Bt; int M, N, K; };

struct StaticOrder {
    int nM, nN, nwg, G, c;
    __host__ __device__ void init(int M, int N, int G_, int c_) { nM = M / BM; nN = N / BM; nwg = nM * nN; G = G_; c = c_; }
    __host__ __device__ bool next(int i, Unit& u) const {
        const long L = (long)i * G + c; if (L >= nwg) return false;
        int wgid = (int)L; { const int q = nwg / NXCD, r = nwg % NXCD, xcd = wgid % NXCD, off = wgid / NXCD; wgid = (xcd < r ? xcd * (q + 1) : r * (q + 1) + (xcd - r) * q) + off; }
        const int nig = WGM * nN, gid = wgid / nig, fm = gid * WGM, gsz = (nM - fm) < WGM ? (nM - fm) : WGM;
        u.pm = fm + ((wgid % nig) % gsz); u.pn = (wgid % nig) / gsz; return true;
    }
    __device__ __forceinline__ void a_ready(const Unit&) const {}
    __device__ __forceinline__ void done(const Unit&) const {}
};


struct InProjOrder {
    StaticOrder base; int G, c, last;
    __host__ __device__ void init(int last_, int G_, int c_) { last = last_; base.init((last_ ? 64 : 68) * 256, 27 * 256, G_, c_); G = G_; c = c_; }
    __host__ __device__ bool next(int i, Unit& u) const {
        const long L = (long)i * G + c;
        if (!last || L < 1728) return base.next(i, u);
        if (L >= 1768) return false;
        const int k = (int)L - 1728, j = k % 10; u.pm = 64 + k / 10;
        u.pn = j == 0 ? 0 : j == 1 ? 1 : j == 2 ? 14 : j == 3 ? 15 : j == 4 ? 16 : j == 5 ? 17 : j == 6 ? 21 : j == 7 ? 22 : j == 8 ? 23 : 26;
        return true;
    }
    __device__ __forceinline__ void a_ready(const Unit&) const {}
    __device__ __forceinline__ void done(const Unit&) const {}
};
template <class Epi, class Sched, bool ALIGN_EPI = false, bool SP2 = false>
__device__ __forceinline__ void gemm_phase(PG8_LAS unsigned char* lds, const Gemm g, const Sched& S, const Epi& E, const int tid) {
    const int wid = __builtin_amdgcn_readfirstlane(tid >> 6), lane = tid & 63, wr = wid >> 2, wc = wid & 3, fr = lane & 15, fq = lane >> 4;
    const int K = g.K, nt = K / BK;
    unsigned voffA[2], voffB[2];
#pragma unroll
    for (int i = 0; i < 2; ++i) { int R, C; stage_rc(tid * 16 + i * 8192, R, C); const int Rb = Epi::PERM ? ((R & ~31) + perm32(R & 31)) : R;
        voffA[i] = (unsigned)(R * K + C) * 2u; voffB[i] = (unsigned)(Rb * K + C) * 2u; }
    const size_t kstep = (size_t)(BK * 2);
    const size_t hstep = (size_t)HALF * K * 2;
    const size_t tstep = 2 * hstep;
    const unsigned ldsw = (unsigned)wid * 1024u;
    const int aoff = lds_byte(wr * 64 + fr, fq * 8), boff = lds_byte(wc * 32 + fr, fq * 8);
#define PG8_SA(b, h) (((b) * 2 + (h)) * HTB)
#define PG8_SB(b, h) ((4 + (b) * 2 + (h)) * HTB)
#define PG8_STAGE(bufoff, gbase, voff) do { _Pragma("unroll") for (int _i = 0; _i < 2; ++_i) \
        __builtin_amdgcn_global_load_lds((const unsigned*)((const char*)(gbase) + (voff)[_i]), (PG8_LAS unsigned*)(lds + (bufoff) + ldsw + _i * 8192), 16, 0, 0); } while (0)
#define PG8_LDA(dst, b, h) do { _Pragma("unroll") for (int m = 0; m < 4; ++m) _Pragma("unroll") for (int k = 0; k < 2; ++k) dst[m][k] = *(const PG8_LAS bf16x8*)(lds + PG8_SA(b, h) + aoff + m * 2048 + k * 1024); } while (0)
#define PG8_LDB(dst, b, h) do { _Pragma("unroll") for (int n = 0; n < 2; ++n) _Pragma("unroll") for (int k = 0; k < 2; ++k) dst[n][k] = *(const PG8_LAS bf16x8*)(lds + PG8_SB(b, h) + boff + n * 2048 + k * 1024); } while (0)
#define PG8_MMA(ai, bj, At, Bt) do { __builtin_amdgcn_s_setprio(1); _Pragma("unroll") for (int m = 0; m < 4; ++m) _Pragma("unroll") for (int n = 0; n < 2; ++n) _Pragma("unroll") for (int k = 0; k < 2; ++k) \
        acc[ai][bj][m][n] = __builtin_amdgcn_mfma_f32_16x16x32_bf16(Bt[n][k], At[m][k], acc[ai][bj][m][n], 0, 0, 0); __builtin_amdgcn_s_setprio(0); } while (0)
#define PG8_WAIT_V(n) asm volatile("s_waitcnt vmcnt(" #n ")" ::: "memory")
#define PG8_WAIT_L(n) asm volatile("s_waitcnt lgkmcnt(" #n ")" ::: "memory")
#define PG8_BAR __builtin_amdgcn_s_barrier()
#define PG8_SCHED __builtin_amdgcn_sched_barrier(0)
    Unit cur, nxt; int ui = 0;
    if (!S.next(0, cur)) return;
    f32x4 acc[2][2][4][2];
#pragma unroll
    for (int a = 0; a < 2; ++a)
#pragma unroll
        for (int b = 0; b < 2; ++b)
#pragma unroll
            for (int m = 0; m < 4; ++m)
#pragma unroll
                for (int n = 0; n < 2; ++n) acc[a][b][m][n] = (f32x4){0.f, 0.f, 0.f, 0.f};
    bf16x8 At[4][2], B0[2][2], B1[2][2];
    const char* cA = (const char*)g.A + (size_t)cur.pm * tstep; const char* cB = (const char*)g.Bt + (size_t)cur.pn * tstep;
    S.a_ready(cur);
    if constexpr (SP2) {
        PG8_STAGE(PG8_SB(0, 0), cB, voffB); PG8_STAGE(PG8_SB(0, 1), cB + hstep, voffB); PG8_STAGE(PG8_SA(0, 0), cA, voffA); PG8_STAGE(PG8_SA(0, 1), cA + hstep, voffA);
        if (wr == 1) PG8_BAR;
        PG8_WAIT_V(2); PG8_BAR;
        PG8_STAGE(PG8_SB(1, 0), cB + kstep, voffB); PG8_STAGE(PG8_SA(1, 0), cA + kstep, voffA); PG8_STAGE(PG8_SB(1, 1), cB + hstep + kstep, voffB);
        PG8_WAIT_V(6); PG8_BAR;
    } else {
        PG8_STAGE(PG8_SB(0, 0), cB, voffB); PG8_STAGE(PG8_SA(0, 0), cA, voffA); PG8_STAGE(PG8_SB(0, 1), cB + hstep, voffB); PG8_STAGE(PG8_SA(0, 1), cA + hstep, voffA);
        if (wr == 1) PG8_BAR;
        PG8_WAIT_V(4); PG8_BAR;
        PG8_STAGE(PG8_SB(1, 0), cB + kstep, voffB); PG8_STAGE(PG8_SA(1, 0), cA + kstep, voffA); PG8_STAGE(PG8_SB(1, 1), cB + hstep + kstep, voffB);
        PG8_WAIT_V(6); PG8_BAR;
    }
    for (;;) {
        const bool has_next = S.next(ui + 1, nxt);
        const char* nA = has_next ? (const char*)g.A + (size_t)nxt.pm * tstep : cA; const char* nB = has_next ? (const char*)g.Bt + (size_t)nxt.pn * tstep : cB;
        for (int t = 0; t < nt; t += 2) {
            const bool last = (t == nt - 2);
            const char* a1 = cA + (size_t)(t + 1) * kstep;
            const char* a2 = last ? nA : cA + (size_t)(t + 2) * kstep; const char* b2 = last ? nB : cB + (size_t)(t + 2) * kstep;
            const char* a3 = a2 + kstep; const char* b3 = b2 + kstep;
            if (last && has_next) S.a_ready(nxt);
            if constexpr (SP2) {
            PG8_LDB(B0, 0, 0); PG8_LDB(B1, 0, 1); PG8_SCHED; PG8_LDA(At, 0, 0); PG8_STAGE(PG8_SA(1, 1), a1 + hstep, voffA);
            PG8_WAIT_V(8); PG8_WAIT_L(0); PG8_BAR; PG8_MMA(0, 0, At, B0); PG8_MMA(0, 1, At, B1); PG8_BAR; PG8_SCHED;
            PG8_LDA(At, 0, 1); PG8_STAGE(PG8_SB(0, 0), b2, voffB); PG8_STAGE(PG8_SB(0, 1), b2 + hstep, voffB); PG8_STAGE(PG8_SA(0, 0), a2, voffA);
            PG8_WAIT_V(8); PG8_WAIT_L(0); PG8_BAR; PG8_MMA(1, 0, At, B0); PG8_MMA(1, 1, At, B1); PG8_BAR; PG8_SCHED;
            PG8_LDB(B0, 1, 0); PG8_LDB(B1, 1, 1); PG8_SCHED; PG8_LDA(At, 1, 0); PG8_STAGE(PG8_SA(0, 1), a2 + hstep, voffA);
            PG8_WAIT_V(8); PG8_WAIT_L(0); PG8_BAR; PG8_MMA(0, 0, At, B0); PG8_MMA(0, 1, At, B1); PG8_BAR; PG8_SCHED;
            PG8_LDA(At, 1, 1); PG8_STAGE(PG8_SB(1, 0), b3, voffB); PG8_STAGE(PG8_SB(1, 1), b3 + hstep, voffB); PG8_STAGE(PG8_SA(1, 0), a3, voffA);
            PG8_WAIT_V(8); PG8_WAIT_L(0); PG8_BAR; PG8_MMA(1, 0, At, B0); PG8_MMA(1, 1, At, B1); PG8_BAR; PG8_SCHED;
            } else {
            PG8_LDB(B0, 0, 0); PG8_SCHED; PG8_LDA(At, 0, 0); PG8_STAGE(PG8_SA(1, 1), a1 + hstep, voffA);
            PG8_WAIT_L(8); PG8_BAR; PG8_WAIT_L(0); PG8_MMA(0, 0, At, B0); PG8_BAR; PG8_SCHED;
            PG8_LDB(B1, 0, 1); PG8_STAGE(PG8_SB(0, 0), b2, voffB);
            PG8_BAR; PG8_WAIT_L(0); PG8_MMA(0, 1, At, B1); PG8_BAR;
            PG8_LDA(At, 0, 1); PG8_STAGE(PG8_SA(0, 0), a2, voffA);
            PG8_BAR; PG8_WAIT_L(0); PG8_MMA(1, 0, At, B0); PG8_BAR; PG8_SCHED;
            PG8_STAGE(PG8_SB(0, 1), b2 + hstep, voffB);
            PG8_WAIT_V(6); PG8_BAR; PG8_MMA(1, 1, At, B1); PG8_BAR;
            PG8_LDB(B0, 1, 0); PG8_SCHED; PG8_LDA(At, 1, 0); PG8_STAGE(PG8_SA(0, 1), a2 + hstep, voffA);
            PG8_WAIT_L(8); PG8_BAR; PG8_WAIT_L(0); PG8_MMA(0, 0, At, B0); PG8_BAR; PG8_SCHED;
            PG8_LDB(B1, 1, 1); PG8_STAGE(PG8_SB(1, 0), b3, voffB);
            PG8_BAR; PG8_WAIT_L(0); PG8_MMA(0, 1, At, B1); PG8_BAR;
            PG8_LDA(At, 1, 1); PG8_STAGE(PG8_SA(1, 0), a3, voffA);
            PG8_BAR; PG8_WAIT_L(0); PG8_MMA(1, 0, At, B0); PG8_BAR; PG8_SCHED;
            PG8_STAGE(PG8_SB(1, 1), b3 + hstep, voffB);
            PG8_WAIT_V(6); PG8_BAR; PG8_MMA(1, 1, At, B1); PG8_BAR;
            }
        }
        if constexpr (ALIGN_EPI) { if (wr == 0) PG8_BAR; }
        { int fr_ = fr, fq_ = fq; asm volatile("" : "+v"(fr_), "+v"(fq_));
          E(acc, cur, wr, wc, fr_, fq_); } S.done(cur);
        if (!has_next) break;
#pragma unroll
        for (int a = 0; a < 2; ++a)
#pragma unroll
            for (int b = 0; b < 2; ++b)
#pragma unroll
                for (int m = 0; m < 4; ++m)
#pragma unroll
                    for (int n = 0; n < 2; ++n) acc[a][b][m][n] = (f32x4){0.f, 0.f, 0.f, 0.f};
        cur = nxt; cA = nA; cB = nB; ++ui;
        if constexpr (ALIGN_EPI) { if (wr == 1) PG8_BAR; }
    }
    PG8_WAIT_V(0);
    if constexpr (!ALIGN_EPI) { if (wr == 0) PG8_BAR; }
    PG8_BAR;
#undef PG8_SA
#undef PG8_SB
#undef PG8_STAGE
#undef PG8_LDA
#undef PG8_LDB
#undef PG8_MMA
#undef PG8_WAIT_V
#undef PG8_WAIT_L
#undef PG8_BAR
#undef PG8_SCHED
}
}
__device__ __forceinline__ void prep_adaln(const float* c, const float* cctx, const float* adaw, const float* adab, float* MOD, int it, LAS float* sv, int tid) {
    const int l = it / 384, r = it % 384, ntile = r >> 5, ks = r & 31, k0 = ks * 64;
    if (tid < 320) { const int v = tid >> 6, k = tid & 63; const float cv = v < 4 ? c[v * D + k0 + k] : cctx[k0 + k]; sv[tid] = cv / (1.0f + expf(-cv)); }
    __syncthreads();
    const int n = ntile * 512 + tid; const float* w = adaw + (size_t)l * D * ADA + (size_t)k0 * ADA + n;
    float acc[5] = {0.f, 0.f, 0.f, 0.f, 0.f};
#pragma unroll 1
    for (int k0_ = 0; k0_ < 64; k0_ += 32) {
        float wv[32];
#pragma unroll
        for (int k = 0; k < 32; ++k) wv[k] = w[(size_t)(k0_ + k) * ADA];
#pragma unroll
        for (int k = 0; k < 32; ++k) {
#pragma unroll
            for (int v = 0; v < 5; ++v) acc[v] += sv[v * 64 + k0_ + k] * wv[k]; } }
    if (ks == 0) { const float bb = adab[l * ADA + n];
#pragma unroll
        for (int v = 0; v < 5; ++v) acc[v] += bb; }
#pragma unroll
    for (int v = 0; v < 5; ++v) atomicAdd(MOD + (size_t)(l * 5 + v) * ADA + n, acc[v]);
    __syncthreads();
}

__device__ __forceinline__ void prep_s5(const DArgs& a, unsigned char* ws, int it, int tid) {
    const int idx = it * 512 + tid;
    const float a_re = a.in[I_S5ARE][idx], a_im = a.in[I_S5AIM][idx], ldt = a.in[I_S5LDT][idx >> 6];
    const float dt = expf(ldt), mag = expf(a_re * dt);
    float sn, cs; sincosf(a_im * dt, &sn, &cs);
    const float ab_re = mag * cs, ab_im = mag * sn, den = a_re * a_re + a_im * a_im, nr = ab_re - 1.0f;
    const float co_re = (nr * a_re + ab_im * a_im) / den, co_im = (ab_im * a_re - nr * a_im) / den;
    ((f32x2*)(ws + WS_S5AB))[idx] = (f32x2){ab_re, ab_im};
    const float* bre = a.in[I_S5BRE] + (size_t)idx * 16; const float* bim = a.in[I_S5BIM] + (size_t)idx * 16;
    f32x2* bt = (f32x2*)(ws + WS_S5BT) + (size_t)idx * 16;
#pragma unroll
    for (int i = 0; i < 16; ++i) { const float br = bre[i], bi = bim[i]; bt[i] = (f32x2){co_re * br - co_im * bi, co_re * bi + co_im * br}; }
}

__device__ __forceinline__ void prep_hymlp(const DArgs& a, float* H3out, bf16_t* H3b, int l, int Lx, int t0, LAS unsigned char* lds, int tid) {
    LAS float* zs = (LAS float*)lds;
    LAS float* h1 = (LAS float*)(lds + 4608);
    LAS float* h2 = (LAS float*)(lds + 4608 + 8192);
    LAS float* w1s = (LAS float*)(lds + 24576);
    LAS float* w2s = w1s + 33 * 64;
    LAS float* w3s = w2s + 64 * 64;
    { const float* w1 = a.in[I_HW1] + (size_t)l * 33 * 64; const float* w2 = a.in[I_HW2] + (size_t)l * 64 * 64; const float* w3 = a.in[I_HW3] + (size_t)l * 64 * 64;
      for (int i = tid; i < 33 * 64; i += NT) w1s[i] = w1[i];
      for (int i = tid; i < 64 * 64; i += NT) { w2s[i] = w2[i]; w3s[i] = w3[i]; } }
    for (int i = tid; i < 32 * 33; i += NT) { const int pos = i / 33, f = i % 33, t = t0 + pos;
        float z;
        if (f == 0) z = (float)t / (float)(Lx - 1);
        else { const int j = (f - 1) & 15; const float fj = 1e-4f + (float)j * ((15.0f - 1e-4f) / 15.0f); const float wpos = (6.283185307179586f * (float)t) / (float)Lx; const float arg = fj * wpos;
               z = (f <= 16) ? cosf(arg) : -sinf(arg); }
        zs[pos * 36 + f] = z; }
    __syncthreads();
    const int pos = tid >> 4, f4 = (tid & 15) * 4, t = t0 + pos;
    f32x4 s = *(const f32x4*)(a.in[I_HB1] + l * 64 + f4);
#pragma unroll 3
    for (int j = 0; j < 33; ++j) s += zs[pos * 36 + j] * *(const LAS f32x4*)(w1s + j * 64 + f4);
    { const f32x4 fr = *(const f32x4*)(a.in[I_HF1] + l * 64 + f4); *(LAS f32x4*)(h1 + pos * 64 + f4) = (f32x4){sinf(fr.x * s.x), sinf(fr.y * s.y), sinf(fr.z * s.z), sinf(fr.w * s.w)}; }
    __syncthreads();
    s = *(const f32x4*)(a.in[I_HB2] + l * 64 + f4);
#pragma unroll 4
    for (int j = 0; j < 64; ++j) s += h1[pos * 64 + j] * *(const LAS f32x4*)(w2s + j * 64 + f4);
    { const f32x4 fr = *(const f32x4*)(a.in[I_HF2] + l * 64 + f4); *(LAS f32x4*)(h2 + pos * 64 + f4) = (f32x4){sinf(fr.x * s.x), sinf(fr.y * s.y), sinf(fr.z * s.z), sinf(fr.w * s.w)}; }
    __syncthreads();
    s = *(const f32x4*)(a.in[I_HB3] + l * 64 + f4);
#pragma unroll 4
    for (int j = 0; j < 64; ++j) s += h2[pos * 64 + j] * *(const LAS f32x4*)(w3s + j * 64 + f4);
    { const f32x4 fr = *(const f32x4*)(a.in[I_HF3] + l * 64 + f4); const f32x4 hv = (f32x4){sinf(fr.x * s.x), sinf(fr.y * s.y), sinf(fr.z * s.z), sinf(fr.w * s.w)}; *(f32x4*)(H3out + (size_t)t * 64 + f4) = hv;
      if (H3b) { u32x2 pk; pk.x = pk2(hv.x, hv.y); pk.y = pk2(hv.z, hv.w); *(u32x2*)(H3b + (size_t)t * 64 + f4) = pk; } }
    __syncthreads();
}

__device__ __forceinline__ void transpose_item(const float* W, int ldw, int srccol_lane  , int k0, bf16_t* WT, int K, int dstrow0, LAS float* scr, int lane) {
    float wv[32];
#pragma unroll
    for (int i = 0; i < 32; ++i) { const int kk = 2 * i + (lane >> 5); wv[i] = srccol_lane >= 0 ? W[(size_t)(k0 + kk) * ldw + srccol_lane] : 0.f; }
#pragma unroll
    for (int i = 0; i < 32; ++i) { const int kk = 2 * i + (lane >> 5); scr[kk * 33 + (lane & 31)] = wv[i]; }
    LDS_WAIT();
    const int c = lane & 7;
#pragma unroll
    for (int j = 0; j < 4; ++j) { const int n = (lane >> 3) + 8 * j; const LAS float* s = scr + (8 * c) * 33 + n;
        u32x4 o; o.x = pk2(s[0 * 33], s[1 * 33]); o.y = pk2(s[2 * 33], s[3 * 33]); o.z = pk2(s[4 * 33], s[5 * 33]); o.w = pk2(s[6 * 33], s[7 * 33]);
        *(u32x4*)(WT + (size_t)(dstrow0 + n) * K + k0 + 8 * c) = o; }
    LDS_WAIT();
}
__device__ __forceinline__ int win_srccol(int n) {
    if (n >= 3072 && n < 4096) { const int u = (n - 3072) & 127, grp = u >> 3, e = u & 7; return (n & ~127) + (e < 4 ? 4 * grp + e : 64 + 4 * grp + (e - 4)); }
    return n < 6144 ? n : (n < 6656 ? n + 32 : (n < 6688 ? n - 512 : -1));
}

__device__ __forceinline__ void norm_row(const float* xrow, const float* nw, const float* mod, bf16_t* hrow, int lane) {
    f32x4 v[8]; float ss = 0.f;
#pragma unroll
    for (int j = 0; j < 8; ++j) { v[j] = ((const f32x4*)xrow)[lane + 64 * j]; ss += (v[j].x * v[j].x + v[j].y * v[j].y) + (v[j].z * v[j].z + v[j].w * v[j].w); }
    const float rstd = rsqrtf(wave_sum(ss) * (1.0f / D) + EPS);
#pragma unroll
    for (int j = 0; j < 8; ++j) { const int k = 4 * (lane + 64 * j);
        const f32x4 w = *(const f32x4*)(nw + k), sh = *(const f32x4*)(mod + k), sc = *(const f32x4*)(mod + D + k);
        const f32x4 o = v[j] * rstd * w * (sc + 1.0f) + sh;
        u32x2 pk; pk.x = pk2(o.x, o.y); pk.y = pk2(o.z, o.w);
        *(u32x2*)(hrow + k) = pk; }
}

__device__ __forceinline__ void fft_twiddles(LAS f32x2* W, int tid) {
    for (int j = tid; j < 4096; j += NT) { float s, c; sincospif(-(float)j * (1.0f / 4096.0f), &s, &c); W[j] = (f32x2){c, s}; }
}
template <int R, int BETA, bool INV> __device__ __forceinline__ void fft_pass(LAS f32x2* X, const LAS f32x2* W, int tid) {
    constexpr int LOW = BETA - R + 1, NG = FFTN >> R;
    for (int gi = tid; gi < NG; gi += NT) {
        const int base = ((gi >> LOW) << (BETA + 1)) | (gi & ((1 << LOW) - 1));
        f32x2 e[1 << R];
#pragma unroll
        for (int m = 0; m < (1 << R); ++m) e[m] = X[base + (m << LOW)];
#pragma unroll
        for (int ss = 0; ss < R; ++ss) {
            const int s = INV ? (R - 1 - ss) : ss; const int bit = BETA - s, h = 1 << (R - 1 - s);
#pragma unroll
            for (int m = 0; m < (1 << R); ++m) {
                if (m & h) continue;
                const int idx = base + (m << LOW); const int ex = (idx & ((1 << bit) - 1)) << (12 - bit);
                const f32x2 w = W[ex]; const f32x2 a_ = e[m], b_ = e[m | h];
                if (!INV) { const f32x2 d = a_ - b_; e[m] = a_ + b_; e[m | h] = (f32x2){d.x * w.x - d.y * w.y, d.x * w.y + d.y * w.x}; }
                else { const f32x2 t = (f32x2){b_.x * w.x + b_.y * w.y, b_.y * w.x - b_.x * w.y}; e[m] = a_ + t; e[m | h] = a_ - t; }
            }
        }
#pragma unroll
        for (int m = 0; m < (1 << R); ++m) X[base + (m << LOW)] = e[m];
    }
}
__device__ __forceinline__ void fft_forward(LAS f32x2* X, const LAS f32x2* W, int tid) {
    fft_pass<4, 12, false>(X, W, tid); __syncthreads(); fft_pass<3, 8, false>(X, W, tid); __syncthreads();
    fft_pass<3, 5, false>(X, W, tid); __syncthreads(); fft_pass<3, 2, false>(X, W, tid); __syncthreads();
}
__device__ __forceinline__ void fft_inverse(LAS f32x2* X, const LAS f32x2* W, int tid) {
    fft_pass<3, 2, true>(X, W, tid); __syncthreads(); fft_pass<3, 5, true>(X, W, tid); __syncthreads();
    fft_pass<3, 8, true>(X, W, tid); __syncthreads(); fft_pass<4, 12, true>(X, W, tid); __syncthreads();
}
__device__ __forceinline__ float block_sum(float v, LAS float* red, int tid) {
    v = wave_sum(v);
    if ((tid & 63) == 0) red[tid >> 6] = v;
    __syncthreads();
    float t = 0.f;
#pragma unroll
    for (int i = 0; i < NWAVES; ++i) t += red[i];
    __syncthreads();
    return t;
}
constexpr float HY_D0 = -3.0701134573253945f  , HY_D1 = -15.350567286626973f  ;

__device__ __forceinline__ void filt_item(const DArgs& a, unsigned char* ws, LAS unsigned char* lds, int l, int c, int tid) {
    LAS f32x2* X = (LAS f32x2*)lds; LAS f32x2* W = (LAS f32x2*)(lds + 65536); LAS float* w4s = (LAS float*)(lds + 98304); LAS float* red = (LAS float*)(lds + 98304 + 1024);
    LAS float* k1b = (LAS float*)(lds + 100352);
    fft_twiddles(W, tid);
    if (tid < 256) { const int cc = tid >> 6, f = tid & 63; w4s[tid] = a.in[I_HW4][(size_t)l * 64 * 2048 + (size_t)f * 2048 + (cc >> 1) * 1024 + (cc & 1) * 512 + c]; }
    __syncthreads();
    const float dl = fabsf(HY_D0 + (HY_D1 - HY_D0) * ((float)c / 511.0f));
    const float* H3 = (const float*)(ws + WS_H3) + (size_t)l * 4096 * 64;
    float ss0 = 0.f, ss1 = 0.f;
#pragma unroll 1
    for (int j = 0; j < 16; ++j) {
        const int n = tid + 512 * j; const int dir = j >= 8 ? 1 : 0; const int t = dir ? (8192 - n) : n;
        float s0 = 0.f, s1 = 0.f;
        if (n != 4096) {
            const f32x4* hr = (const f32x4*)(H3 + (size_t)t * 64);
#pragma unroll
            for (int q = 0; q < 16; ++q) { const f32x4 hv = hr[q]; const f32x4 wa = ((const LAS f32x4*)(w4s + (dir * 2 + 0) * 64))[q], wb = ((const LAS f32x4*)(w4s + (dir * 2 + 1) * 64))[q];
                s0 += (hv.x * wa.x + hv.y * wa.y) + (hv.z * wa.z + hv.w * wa.w); s1 += (hv.x * wb.x + hv.y * wb.y) + (hv.z * wb.z + hv.w * wb.w); }
            const float dec = expf(-((float)t / 4095.0f) * dl); s0 *= dec; s1 *= dec;
        }
        X[n] = (f32x2){s0, 0.f}; k1b[n] = s1; ss0 += s0 * s0; ss1 += s1 * s1;
    }
    const float rs0 = rsqrtf(block_sum(ss0, red, tid) + EPS), rs1 = rsqrtf(block_sum(ss1, red, tid) + EPS);
    f32x2* KF0 = (f32x2*)(ws + WS_KF) + (size_t)(0 * 512 + c) * FFTN; f32x2* KF1 = (f32x2*)(ws + WS_KF) + (size_t)(1 * 512 + c) * FFTN;
#pragma unroll 4
    for (int j = 0; j < 16; ++j) { const f32x2 x = X[tid + 512 * j]; X[tid + 512 * j] = (f32x2){x.x * rs0, 0.f}; }
    __syncthreads(); fft_forward(X, W, tid);
#pragma unroll 4
    for (int j = 0; j < 16; ++j) KF0[tid + 512 * j] = X[tid + 512 * j];
    __syncthreads();
#pragma unroll 4
    for (int j = 0; j < 16; ++j) X[tid + 512 * j] = (f32x2){k1b[tid + 512 * j] * rs1, 0.f};
    __syncthreads(); fft_forward(X, W, tid);
#pragma unroll 4
    for (int j = 0; j < 16; ++j) KF1[tid + 512 * j] = X[tid + 512 * j];
    __syncthreads();
}
__device__ __forceinline__ void filt_ctx_item(const DArgs& a, unsigned char* ws, LAS unsigned char* lds, int c, int tid) {
    LAS float* w4s = (LAS float*)lds; LAS float* red = (LAS float*)(lds + 1024);
    if (tid < 256) { const int cc = tid >> 6, f = tid & 63; w4s[tid] = a.in[I_HW4][(size_t)f * 2048 + (cc >> 1) * 1024 + (cc & 1) * 512 + c]; }
    __syncthreads();
    const float dl = fabsf(HY_D0 + (HY_D1 - HY_D0) * ((float)c / 511.0f));
    const float* H3C = (const float*)(ws + WS_H3C);
    const int n = tid, dir = n >= 256 ? 1 : 0, t = dir ? (512 - n) : n;
    float s0 = 0.f, s1 = 0.f;
    if (n != 256) {
        const f32x4* hr = (const f32x4*)(H3C + (size_t)t * 64);
#pragma unroll
        for (int q = 0; q < 16; ++q) { const f32x4 hv = hr[q]; const f32x4 wa = ((const LAS f32x4*)(w4s + (dir * 2 + 0) * 64))[q], wb = ((const LAS f32x4*)(w4s + (dir * 2 + 1) * 64))[q];
            s0 += (hv.x * wa.x + hv.y * wa.y) + (hv.z * wa.z + hv.w * wa.w); s1 += (hv.x * wb.x + hv.y * wb.y) + (hv.z * wb.z + hv.w * wb.w); }
        const float dec = expf(-((float)t / 255.0f) * dl); s0 *= dec; s1 *= dec;
    }
    const float rs0 = rsqrtf(block_sum(s0 * s0, red, tid) + EPS), rs1 = rsqrtf(block_sum(s1 * s1, red, tid) + EPS);
    float* KC = (float*)(ws + WS_KC);
    KC[(size_t)(0 * 512 + c) * 512 + n] = s0 * rs0; KC[(size_t)(1 * 512 + c) * 512 + n] = s1 * rs1;
    __syncthreads();
}

__device__ __forceinline__ void prep_rope(f32x2* RT, int it, int tid) {
    const int idx = it * NT + tid, pos = idx >> 6, j = idx & 63;
    float ang;
    if (pos < SEQL) { const float inv = exp2f(-(float)(j & 31) * (13.287712379549449f / 32.0f)); ang = (float)(j < 32 ? (pos >> 6) : (pos & 63)) * inv; }
    else { const float inv = exp2f(-(float)j * (13.287712379549449f / 64.0f)); ang = (float)(pos - SEQL) * inv; }
    float sn, cs; sincosf(ang, &sn, &cs);
    RT[idx] = (f32x2){cs, sn};
}

__device__ __forceinline__ void ret_chain(const bf16_t* P, bf16_t* O, int b, int h, int dir, bool ctx_out, int wave, int lane) {
    const int e = wave * 16 + (lane & 15), dq = lane >> 4;
    const float gamma = 1.0f - exp2f(-5.0f - (float)h);
    constexpr int TB = 2;
    float S[32];
#pragma unroll
    for (int i = 0; i < 32; ++i) S[i] = 0.f;
    for (int seg = 0; seg < 2; ++seg) {
        const int n = seg ? SEQL : LC, rowbase = seg ? b * SEQL : NLAT + b * LC; const bool wr_out = seg || ctx_out;
        for (int i0 = 0; i0 < n; i0 += TB) {
            u32x4 q[TB][4], k[TB][4]; bf16_t v[TB];
#pragma unroll
            for (int tb = 0; tb < TB; ++tb) { const int row = rowbase + (dir ? n - 1 - (i0 + tb) : i0 + tb); const bf16_t* pr = P + (size_t)row * LDP;
#pragma unroll
                for (int c4 = 0; c4 < 4; ++c4) { q[tb][c4] = ((const u32x4*)(pr + PC_RQ + h * 128 + dq * 32))[c4]; k[tb][c4] = ((const u32x4*)(pr + PC_RK + h * 128 + dq * 32))[c4]; }
                v[tb] = pr[PC_RV + h * 128 + e]; }
#pragma unroll
            for (int tb = 0; tb < TB; ++tb) {
                const int row = rowbase + (dir ? n - 1 - (i0 + tb) : i0 + tb);
                const float vf = bf2f(v[tb]); float o = 0.f;
#pragma unroll
                for (int c4 = 0; c4 < 4; ++c4) { float qf[8], kf[8]; unpack8(q[tb][c4], qf); unpack8(k[tb][c4], kf);
#pragma unroll
                    for (int x = 0; x < 8; ++x) { const int ix = c4 * 8 + x; S[ix] = gamma * S[ix] + kf[x] * vf; o += qf[x] * S[ix]; } }
                o += __shfl_xor(o, 16); o += __shfl_xor(o, 32);
                if (wr_out && dq == 0) O[(size_t)row * 512 + h * 128 + e] = (bf16_t)f2bf(o);
            }
        }
    }
}
__device__ __forceinline__ void gla_chain(const bf16_t* P, const bf16_t* GLGd, bf16_t* O, int b, int h, int dir, bool ctx_out, int wave, int lane) {
    const int e = wave * 16 + (lane & 15), dq = lane >> 4;
    constexpr int TB = 4;
    float S[16];
#pragma unroll
    for (int i = 0; i < 16; ++i) S[i] = 0.f;
    for (int seg = 0; seg < 2; ++seg) {
        const int n = seg ? SEQL : LC, rowbase = seg ? b * SEQL : NLAT + b * LC; const bool wr_out = seg || ctx_out;
        for (int i0 = 0; i0 < n; i0 += TB) {
            u32x4 q[TB][2], k[TB][2], g[TB][2]; bf16_t v[TB];
#pragma unroll
            for (int tb = 0; tb < TB; ++tb) { const int row = rowbase + (dir ? n - 1 - (i0 + tb) : i0 + tb); const bf16_t* pr = P + (size_t)row * LDP; const bf16_t* gr = GLGd + (size_t)row * 256 + h * 64 + dq * 16;
#pragma unroll
                for (int c4 = 0; c4 < 2; ++c4) { q[tb][c4] = ((const u32x4*)(pr + PC_GQ + h * 64 + dq * 16))[c4]; k[tb][c4] = ((const u32x4*)(pr + PC_GK + h * 64 + dq * 16))[c4]; g[tb][c4] = ((const u32x4*)gr)[c4]; }
                v[tb] = pr[PC_GV + h * 128 + e]; }
#pragma unroll
            for (int tb = 0; tb < TB; ++tb) {
                const int row = rowbase + (dir ? n - 1 - (i0 + tb) : i0 + tb);
                const float vf = bf2f(v[tb]); float o = 0.f;
#pragma unroll
                for (int c4 = 0; c4 < 2; ++c4) { float qf[8], kf[8], gf[8]; unpack8(q[tb][c4], qf); unpack8(k[tb][c4], kf); unpack8(g[tb][c4], gf);
#pragma unroll
                    for (int x = 0; x < 8; ++x) { const int ix = c4 * 8 + x; S[ix] = __expf(gf[x]) * S[ix] + kf[x] * vf; o += qf[x] * S[ix]; } }
                o += __shfl_xor(o, 16); o += __shfl_xor(o, 32);
                if (wr_out && dq == 0) O[(size_t)row * 512 + h * 128 + e] = (bf16_t)f2bf(o * 0.125f);
            }
        }
    }
}
__device__ __forceinline__ void s5_chain(const DArgs& a, unsigned char* ws, LAS unsigned char* lds, int l, int b, int g, int dir, bool ctx_out, int tid) {
    LAS f32x2* cs = (LAS f32x2*)lds; LAS f32x2* hs = (LAS f32x2*)(lds + 16 * 65 * 8); LAS float* us = (LAS float*)(lds + 2 * 16 * 65 * 8);
    const int wave = tid >> 6, lane = tid & 63;
    const int gi = (l * 2 + dir) * 32 + g;
    const float* cre = a.in[I_S5CRE] + (size_t)gi * 1024; const float* cim = a.in[I_S5CIM] + (size_t)gi * 1024;
    for (int idx = tid; idx < 1024; idx += NT) { const int i = idx >> 6, p = idx & 63; cs[i * 65 + p] = (f32x2){cre[idx], cim[idx]}; }
    f32x2 ab = {0.f, 0.f}; f32x2 bt[16]; f32x2 hst = {0.f, 0.f};
    if (wave == 0) { ab = ((const f32x2*)(ws + WS_S5AB))[gi * 64 + lane]; const f32x2* bp = (const f32x2*)(ws + WS_S5BT) + (size_t)(gi * 64 + lane) * 16;
#pragma unroll
        for (int i = 0; i < 16; ++i) bt[i] = bp[i]; }
    else {
#pragma unroll
        for (int i = 0; i < 16; ++i) bt[i] = (f32x2){0.f, 0.f}; }
    const bf16_t* P = (const bf16_t*)(ws + WS_P);
    bf16_t* Y = (bf16_t*)(ws + WS_OB) + (size_t)(4 + dir) * OBSZ;
    const int tt = tid >> 4, i = tid & 15;
    for (int seg = 0; seg < 2; ++seg) {
        const int n = seg ? SEQL : LC, rowbase = seg ? b * SEQL : NLAT + b * LC; const bool wr_out = seg || ctx_out;
        __syncthreads();
        if (tid < 256) us[tid] = bf2f(P[(size_t)(rowbase + (dir ? n - 1 - tt : tt)) * LDP + PC_S5U + g * 16 + i]);
        for (int bt0 = 0; bt0 < n; bt0 += 16) {
            const int ii = bt0 + tt; const int row = rowbase + (dir ? n - 1 - ii : ii);
            bf16_t unext = 0;
            if (tid < 256 && bt0 + 16 < n) { const int iin = ii + 16; unext = P[(size_t)(rowbase + (dir ? n - 1 - iin : iin)) * LDP + PC_S5U + g * 16 + i]; }
            __syncthreads();
            if (wave == 0) {
#pragma unroll 4
                for (int t2 = 0; t2 < 16; ++t2) {
                    float bur = 0.f, bui = 0.f;
#pragma unroll
                    for (int q = 0; q < 4; ++q) { const f32x4 u = ((const LAS f32x4*)(us + t2 * 16))[q];
                        bur += bt[4 * q].x * u.x + bt[4 * q + 1].x * u.y + bt[4 * q + 2].x * u.z + bt[4 * q + 3].x * u.w;
                        bui += bt[4 * q].y * u.x + bt[4 * q + 1].y * u.y + bt[4 * q + 2].y * u.z + bt[4 * q + 3].y * u.w; }
                    const float hr = ab.x * hst.x - ab.y * hst.y + bur, hi = ab.x * hst.y + ab.y * hst.x + bui;
                    hst = (f32x2){hr, hi};
                    hs[t2 * 65 + lane] = hst;
                }
            }
            __syncthreads();
            if (tid < 256) {
                us[tid] = bf2f(unext);
                float y = 0.f;
#pragma unroll 8
                for (int p = 0; p < 64; ++p) { const f32x2 cv = cs[i * 65 + p], hv = hs[tt * 65 + p]; y += cv.x * hv.x - cv.y * hv.y; }
                if (wr_out) Y[(size_t)row * 512 + g * 16 + i] = (bf16_t)f2bf(y);
            }
        }
    }
    __syncthreads();
}

__device__ __forceinline__ float sconv3(const bf16_t* p, int t, int Lx, float w0, float w1, float w2, float cb) {
    const float x0 = t > 0 ? bf2f(p[t - 1]) : 0.f, x1 = bf2f(p[t]), x2 = t < Lx - 1 ? bf2f(p[t + 1]) : 0.f;
    return w0 * x0 + w1 * x1 + w2 * x2 + cb;
}
__device__ __forceinline__ void hyena_item(const DArgs& a, unsigned char* ws, LAS unsigned char* lds, int l, int c, int tid) {
    LAS f32x2* X = (LAS f32x2*)lds; LAS f32x2* W = (LAS f32x2*)(lds + 65536);
    fft_twiddles(W, tid);
    const float* cw = a.in[I_HCW] + (size_t)l * 3 * 1536; const float* cbp = a.in[I_HCB] + (size_t)l * 1536;
    const float wv0 = cw[c], wv1 = cw[1536 + c], wv2 = cw[3072 + c], bv = cbp[c];
    const float wa0 = cw[512 + c], wa1 = cw[1536 + 512 + c], wa2 = cw[3072 + 512 + c], ba = cbp[512 + c];
    const float wb0 = cw[1024 + c], wb1 = cw[1536 + 1024 + c], wb2 = cw[3072 + 1024 + c], bb = cbp[1024 + c];
    const float bias0 = a.in[I_HBIAS][(l * 2 + 0) * 512 + c], bias1 = a.in[I_HBIAS][(l * 2 + 1) * 512 + c];
    const bf16_t* PT = (const bf16_t*)(ws + WS_PT);
    const bf16_t* pv = PT + (size_t)(PT_V + c) * MR; const bf16_t* pg1 = PT + (size_t)(PT_G1 + c) * MR; const bf16_t* pg2 = PT + (size_t)(PT_G2 + c) * MR; const bf16_t* phg = PT + (size_t)(PT_HG + c) * MR;
    const f32x2* KF0 = (const f32x2*)(ws + WS_KF) + (size_t)(0 * 512 + c) * FFTN; const f32x2* KF1 = (const f32x2*)(ws + WS_KF) + (size_t)(1 * 512 + c) * FFTN;
    bf16_t* GATED = (bf16_t*)(ws + WS_H);
    __syncthreads();
    for (int bp = 0; bp < 2; ++bp) {
        const int r0 = (2 * bp) * SEQL, r1 = (2 * bp + 1) * SEQL;
        float zr[8], zi[8];
#pragma unroll
        for (int j = 0; j < 8; ++j) { const int t = tid + 512 * j; zr[j] = sconv3(pv + r0, t, SEQL, wv0, wv1, wv2, bv); zi[j] = sconv3(pv + r1, t, SEQL, wv0, wv1, wv2, bv);
            X[t] = (f32x2){zr[j], zi[j]}; X[4096 + t] = (f32x2){0.f, 0.f}; if (j & 1) asm volatile("" ::: "memory"); }
        __syncthreads(); fft_forward(X, W, tid);
#pragma unroll 4
        for (int j = 0; j < 16; ++j) { const int pos = tid + 512 * j; const f32x2 x = X[pos], k = KF0[pos]; X[pos] = (f32x2){x.x * k.x - x.y * k.y, x.x * k.y + x.y * k.x}; }
        __syncthreads(); fft_inverse(X, W, tid);
#pragma unroll
        for (int j = 0; j < 8; ++j) { const int t = tid + 512 * j; const f32x2 cv = X[t] * (1.0f / 8192.0f);
            const float g1r = sconv3(pg1 + r0, t, SEQL, wa0, wa1, wa2, ba), g1i = sconv3(pg1 + r1, t, SEQL, wa0, wa1, wa2, ba);
            zr[j] = g1r * (cv.x + bias0 * zr[j]); zi[j] = g1i * (cv.y + bias0 * zi[j]); if (j & 1) asm volatile("" ::: "memory"); }
        __syncthreads();
#pragma unroll
        for (int j = 0; j < 8; ++j) { const int t = tid + 512 * j; X[t] = (f32x2){zr[j], zi[j]}; X[4096 + t] = (f32x2){0.f, 0.f}; }
        __syncthreads(); fft_forward(X, W, tid);
#pragma unroll 4
        for (int j = 0; j < 16; ++j) { const int pos = tid + 512 * j; const f32x2 x = X[pos], k = KF1[pos]; X[pos] = (f32x2){x.x * k.x - x.y * k.y, x.x * k.y + x.y * k.x}; }
        __syncthreads(); fft_inverse(X, W, tid);
#pragma unroll
        for (int j = 0; j < 8; ++j) { const int t = tid + 512 * j; const f32x2 cv = X[t] * (1.0f / 8192.0f);
            const float g2r = sconv3(pg2 + r0, t, SEQL, wb0, wb1, wb2, bb), g2i = sconv3(pg2 + r1, t, SEQL, wb0, wb1, wb2, bb);
            const float z2r = g2r * (cv.x + bias1 * zr[j]), z2i = g2i * (cv.y + bias1 * zi[j]);
            const float hg0 = bf2f(phg[r0 + t]), hg1 = bf2f(phg[r1 + t]);
            GATED[(size_t)(r0 + t) * D + 512 + c] = (bf16_t)f2bf(z2r * siluf_(hg0)); GATED[(size_t)(r1 + t) * D + 512 + c] = (bf16_t)f2bf(z2i * siluf_(hg1)); if (j & 1) asm volatile("" ::: "memory"); }
        __syncthreads();
    }
}
__device__ __forceinline__ void hyena_ctx_item(const DArgs& a, unsigned char* ws, LAS unsigned char* lds, int c, int tid) {
    LAS float* kc = (LAS float*)lds; LAS float* za = (LAS float*)(lds + 4096); LAS float* zb = (LAS float*)(lds + 8192);
    const float* KC = (const float*)(ws + WS_KC);
    kc[tid] = KC[(size_t)(0 * 512 + c) * 512 + tid]; kc[512 + tid] = KC[(size_t)(1 * 512 + c) * 512 + tid];
    const float* cw = a.in[I_HCW]; const float* cbp = a.in[I_HCB];
    const float wv0 = cw[c], wv1 = cw[1536 + c], wv2 = cw[3072 + c], bv = cbp[c];
    const float wa0 = cw[512 + c], wa1 = cw[1536 + 512 + c], wa2 = cw[3072 + 512 + c], ba = cbp[512 + c];
    const float wb0 = cw[1024 + c], wb1 = cw[1536 + 1024 + c], wb2 = cw[3072 + 1024 + c], bb = cbp[1024 + c];
    const float bias0 = a.in[I_HBIAS][0 * 512 + c], bias1 = a.in[I_HBIAS][1 * 512 + c];
    const bf16_t* PT = (const bf16_t*)(ws + WS_PT);
    const int b = tid >> 7, tt = tid & 127; const int rb = NLAT + b * LC;
    const bf16_t* pv = PT + (size_t)(PT_V + c) * MR + rb; const bf16_t* pg1 = PT + (size_t)(PT_G1 + c) * MR + rb; const bf16_t* pg2 = PT + (size_t)(PT_G2 + c) * MR + rb; const bf16_t* phg = PT + (size_t)(PT_HG + c) * MR + rb;
    bf16_t* GATED = (bf16_t*)(ws + WS_H);
    float z0[2], z1[2];
#pragma unroll
    for (int q = 0; q < 2; ++q) { const int t = tt + 128 * q; z0[q] = sconv3(pv, t, LC, wv0, wv1, wv2, bv); za[b * 256 + t] = z0[q]; }
    __syncthreads();
#pragma unroll
    for (int q = 0; q < 2; ++q) { const int t = tt + 128 * q; float s = 0.f;
        for (int sidx = 0; sidx < 256; ++sidx) s += kc[(t - sidx) & 511] * za[b * 256 + sidx];
        z1[q] = sconv3(pg1, t, LC, wa0, wa1, wa2, ba) * (s + bias0 * z0[q]); zb[b * 256 + t] = z1[q]; }
    __syncthreads();
#pragma unroll
    for (int q = 0; q < 2; ++q) { const int t = tt + 128 * q; float s = 0.f;
        for (int sidx = 0; sidx < 256; ++sidx) s += kc[512 + ((t - sidx) & 511)] * zb[b * 256 + sidx];
        const float z2 = sconv3(pg2, t, LC, wb0, wb1, wb2, bb) * (s + bias1 * z1[q]);
        GATED[(size_t)(rb + t) * D + 512 + c] = (bf16_t)f2bf(z2 * siluf_(bf2f(phg[t]))); }
    __syncthreads();
}

__device__ __forceinline__ void merge_row(const DArgs& a, unsigned char* ws, int l, int row, int lane) {
    const int col = 8 * lane;
    const bf16_t* OB = (const bf16_t*)(ws + WS_OB); const bf16_t* P = (const bf16_t*)(ws + WS_P) + (size_t)row * LDP;
    bf16_t* GATED = (bf16_t*)(ws + WS_H) + (size_t)row * D; bf16_t* G5 = (bf16_t*)(ws + WS_KF) + (size_t)row * 512;
    { float yf[8], yb[8], u[8], res[8];
      unpack8(*(const u32x4*)(OB + (size_t)4 * OBSZ + (size_t)row * 512 + col), yf); unpack8(*(const u32x4*)(OB + (size_t)5 * OBSZ + (size_t)row * 512 + col), yb);
      unpack8(*(const u32x4*)(P + PC_S5U + col), u);
      const float* dsk = a.in[I_S5D] + l * 512 + col;
#pragma unroll
      for (int x = 0; x < 8; ++x) res[x] = gelu_tanh(yf[x] + yb[x] + u[x] * dsk[x]);
      *(u32x4*)(G5 + col) = pack8(res); }
}

struct EpiInProj {
    static constexpr bool PERM = true, AFTER_DRAIN = false;
    bf16_t* P; bf16_t* PT; float* LR; const float* RT;
    __device__ __forceinline__ void operator()(const pg8::f32x4 (&acc)[2][2][4][2], const pg8::Unit& u, int wr, int wc, int fr, int fq) const {
        const int row0 = u.pm * 256 + wr * 64 + fr, pn = u.pn;
        if (pn >= 12 && pn < 16) {
            const int colbase = pn * 256 - 2048 + wc * 32 + 8 * fq; const int j0 = 4 * (4 * wc + fq); const float ksc = pn >= 14 ? 0.08838834764831845f : 1.0f;
#pragma unroll
            for (int ai = 0; ai < 2; ++ai)
#pragma unroll
                for (int m = 0; m < 4; ++m) { const int row = row0 + ai * 128 + m * 16; const int pos = row < NLAT ? (row & (SEQL - 1)) : SEQL + ((row - NLAT) & (LC - 1));
                    const pg8::f32x4 t0 = *(const pg8::f32x4*)(RT + ((size_t)pos * 64 + j0) * 2), t1 = *(const pg8::f32x4*)(RT + ((size_t)pos * 64 + j0) * 2 + 4);
                    bf16_t* rowp = P + (size_t)row * LDP + colbase;
#pragma unroll
                    for (int bj = 0; bj < 2; ++bj) { const pg8::f32x4 x1 = acc[ai][bj][m][0] * ksc, x2 = acc[ai][bj][m][1] * ksc;
                        u32x4 w; w.x = pk2(x1[0] * t0[0] - x2[0] * t0[1], x1[1] * t0[2] - x2[1] * t0[3]); w.y = pk2(x1[2] * t1[0] - x2[2] * t1[1], x1[3] * t1[2] - x2[3] * t1[3]);
                        w.z = pk2(x1[0] * t0[1] + x2[0] * t0[0], x1[1] * t0[3] + x2[1] * t0[2]); w.w = pk2(x1[2] * t1[1] + x2[2] * t1[0], x1[3] * t1[3] + x2[3] * t1[2]);
                        *(u32x4*)(rowp + bj * 128) = w; } }
        } else if (pn < 4 || (pn >= 16 && pn < 26)) {
            const int colbase = (pn < 4 ? pn * 256 : pn * 256 - 2048) + wc * 32 + 8 * fq;
#pragma unroll
            for (int ai = 0; ai < 2; ++ai)
#pragma unroll
                for (int m = 0; m < 4; ++m) { bf16_t* rowp = P + (size_t)(row0 + ai * 128 + m * 16) * LDP + colbase;
#pragma unroll
                    for (int bj = 0; bj < 2; ++bj) { const pg8::f32x4 v0 = acc[ai][bj][m][0], v1 = acc[ai][bj][m][1];
                        u32x4 w; w.x = pk2(v0[0], v0[1]); w.y = pk2(v0[2], v0[3]); w.z = pk2(v1[0], v1[1]); w.w = pk2(v1[2], v1[3]);
                        *(u32x4*)(rowp + bj * 128) = w; } }
        } else if (pn < 12) {
            const int colbase = (pn - 4) * 256 + wc * 32 + 8 * fq;
#pragma unroll
            for (int bj = 0; bj < 2; ++bj)
#pragma unroll
                for (int n = 0; n < 2; ++n)
#pragma unroll
                    for (int j = 0; j < 4; ++j) { bf16_t* cp = PT + (size_t)(colbase + bj * 128 + 4 * n + j) * MR + row0;
#pragma unroll
                        for (int ai = 0; ai < 2; ++ai)
#pragma unroll
                            for (int m = 0; m < 4; ++m) cp[ai * 128 + m * 16] = (bf16_t)f2bf(acc[ai][bj][m][n][j]);
                        asm volatile("" ::: "memory"); }
        } else {
            if (wc == 0) {
#pragma unroll
                for (int ai = 0; ai < 2; ++ai)
#pragma unroll
                    for (int m = 0; m < 4; ++m) { float* rowp = LR + (size_t)(row0 + ai * 128 + m * 16) * 32 + 8 * fq;
                        *(pg8::f32x4*)(rowp) = acc[ai][0][m][0]; *(pg8::f32x4*)(rowp + 4) = acc[ai][0][m][1]; }
            }
        }
    }
};
struct EpiGlu {
    static constexpr bool PERM = true, AFTER_DRAIN = false;
    const bf16_t* GG; bf16_t* GATED; const float* bias;
    __device__ __forceinline__ void operator()(const pg8::f32x4 (&acc)[2][2][4][2], const pg8::Unit& u, int wr, int wc, int fr, int fq) const {
        const int row0 = u.pm * 256 + wr * 64 + fr, col0 = u.pn * 256 + wc * 32 + 8 * fq;
        pg8::f32x4 b0[2], b1[2];
#pragma unroll
        for (int bj = 0; bj < 2; ++bj) { b0[bj] = *(const pg8::f32x4*)(bias + col0 + bj * 128); b1[bj] = *(const pg8::f32x4*)(bias + col0 + bj * 128 + 4); }
#pragma unroll
        for (int ai = 0; ai < 2; ++ai) {
            u32x4 gg[4][2];
#pragma unroll
            for (int m = 0; m < 4; ++m)
#pragma unroll
                for (int bj = 0; bj < 2; ++bj) gg[m][bj] = *(const u32x4*)(GG + (size_t)(row0 + ai * 128 + m * 16) * 512 + col0 + bj * 128);
#pragma unroll
            for (int m = 0; m < 4; ++m) { const size_t row = (size_t)(row0 + ai * 128 + m * 16);
#pragma unroll
                for (int bj = 0; bj < 2; ++bj) { float g[8], res[8]; unpack8(gg[m][bj], g);
#pragma unroll
                    for (int j = 0; j < 4; ++j) { res[j] = g[j] * sigmoidf_(acc[ai][bj][m][0][j] + b0[bj][j]); res[4 + j] = g[4 + j] * sigmoidf_(acc[ai][bj][m][1][j] + b1[bj][j]); }
                    *(u32x4*)(GATED + row * D + col0 + bj * 128) = pack8(res); } }
            asm volatile("" ::: "memory");
        }
    }
};
struct EpiOut {
    static constexpr bool PERM = false, AFTER_DRAIN = false;
    const float* xl_old; const float* xc_old; float* xl_new; float* xc_new; const float* mod;
    __device__ __forceinline__ void operator()(const pg8::f32x4 (&acc)[2][2][4][2], const pg8::Unit& u, int wr, int wc, int fr, int fq) const {
        const int row0 = u.pm * 256 + wr * 64 + fr, col0 = u.pn * 256 + wc * 32 + 4 * fq;
        const bool lat = u.pm < 64;
        const float* xo = lat ? xl_old : xc_old - (size_t)NLAT * D; float* xn = lat ? xl_new : xc_new - (size_t)NLAT * D;
#pragma unroll
        for (int ai = 0; ai < 2; ++ai) {
            const int v = lat ? ((u.pm * 256 + ai * 128) >> 12) : 4;
            const float* gt = mod + (size_t)v * ADA + 2 * D;
#pragma unroll
            for (int m = 0; m < 4; ++m) { const size_t off = (size_t)(row0 + ai * 128 + m * 16) * D + col0;
#pragma unroll
                for (int bj = 0; bj < 2; ++bj)
#pragma unroll
                    for (int n = 0; n < 2; ++n) { const int cc = bj * 128 + n * 16; const pg8::f32x4 gv = *(const pg8::f32x4*)(gt + col0 + cc), xv = *(const pg8::f32x4*)(xo + off + cc);
                        *(pg8::f32x4*)(xn + off + cc) = xv + gv * acc[ai][bj][m][n]; } }
        }
    }
};
typedef short bf16x8 __attribute__((ext_vector_type(8)));
typedef short bf16x4 __attribute__((ext_vector_type(4)));
__device__ __forceinline__ unsigned off_b(unsigned row, unsigned ch) { return 256u * row + 16u * (ch ^ (((row & 3) << 2) | ((row >> 2) & 3))); }
__device__ __forceinline__ bf16x8 img_row_frag(const LAS unsigned char* img, unsigned lane, unsigned rb, unsigned s) { return *(const LAS bf16x8*)(img + off_b((lane & 15) + 16 * rb, 4 * s + (lane >> 4))); }
__device__ __forceinline__ bf16x4 img_tr4(const LAS unsigned char* img, unsigned lane, unsigned c, unsigned row0) {
    const unsigned q = (lane & 15) >> 2, p = lane & 3;
    return __builtin_amdgcn_ds_read_tr16_b64_v4i16((LAS bf16x4*)(img + off_b(row0 + q, 2 * c + (p >> 1)) + 8 * (p & 1)));
}
__device__ __forceinline__ bf16x8 img_tr_frag(const LAS unsigned char* img, unsigned lane, unsigned c, unsigned ks) {
    const unsigned g = lane >> 4; const bf16x4 lo = img_tr4(img, lane, c, 32 * ks + 8 * g), hi = img_tr4(img, lane, c, 32 * ks + 8 * g + 4);
    return __builtin_shufflevector(lo, hi, 0, 1, 2, 3, 4, 5, 6, 7);
}
__device__ __forceinline__ bf16x8 img_tr_frag_acc(const LAS unsigned char* img, unsigned lane, unsigned c, unsigned ks) {
    const unsigned g = lane >> 4; const bf16x4 lo = img_tr4(img, lane, c, 32 * ks + 4 * g), hi = img_tr4(img, lane, c, 32 * ks + 16 + 4 * g);
    return __builtin_shufflevector(lo, hi, 0, 1, 2, 3, 4, 5, 6, 7);
}
__device__ __forceinline__ bf16x8 acc_pair_frag(const f32x4 a0, const f32x4 a1) {
    u32x4 w; w.x = pk2(a0.x, a0.y); w.y = pk2(a0.z, a0.w); w.z = pk2(a1.x, a1.y); w.w = pk2(a1.z, a1.w);
    return __builtin_bit_cast(bf16x8, w);
}
#define MFMA16(A_, B_, C_) __builtin_amdgcn_mfma_f32_16x16x32_bf16((A_), (B_), (C_), 0, 0, 0)
__device__ __forceinline__ void stage_tile128(LAS unsigned char* img, const bf16_t* g, size_t ld, int tid) {
#pragma unroll
    for (int i = 0; i < 4; ++i) { const int n = tid + NT * i, row = n >> 4, ch = n & 15; *(LAS u32x4*)(img + off_b(row, ch)) = *(const u32x4*)(g + (size_t)row * ld + ch * 8); }
}

constexpr int RCH = 128, RNCH = 34;
constexpr size_t WS_RST = WS_OB;
__device__ __forceinline__ int ret_rowbase(int b, int cc) { return cc < 2 ? NLAT + b * LC + cc * RCH : b * SEQL + (cc - 2) * RCH; }
__device__ __forceinline__ float ret_log2g(int h) { return log2f(1.0f - exp2f(-5.0f - (float)h)); }

__device__ __forceinline__ void ret_passA(unsigned char* ws, LAS unsigned char* lds, int item, int tid) {
    const int bh = item / RNCH, cc = item % RNCH, b = bh >> 2, h = bh & 3;
    const int lane = tid & 63, w = tid >> 6, g = lane >> 4;
    LAS unsigned char* KF = lds; LAS unsigned char* KB = lds + 32768; LAS unsigned char* VI = lds + 65536;
    const bf16_t* P = (const bf16_t*)(ws + WS_P) + (size_t)ret_rowbase(b, cc) * LDP;
    const float l2g = ret_log2g(h);
    __syncthreads();
#pragma unroll
    for (int i = 0; i < 4; ++i) { const int n = tid + NT * i, row = n >> 4, ch = n & 15;
        const u32x4 kr = *(const u32x4*)(P + (size_t)row * LDP + PC_RK + h * 128 + ch * 8);
        float kf[8], a[8], c[8]; unpack8(kr, kf);
        const float sf = exp2f(l2g * (float)(RCH - 1 - row)), sb = exp2f(l2g * (float)row);
#pragma unroll
        for (int x = 0; x < 8; ++x) { a[x] = kf[x] * sf; c[x] = kf[x] * sb; }
        *(LAS u32x4*)(KF + off_b(row, ch)) = pack8(a); *(LAS u32x4*)(KB + off_b(row, ch)) = pack8(c);
        *(LAS u32x4*)(VI + off_b(row, ch)) = *(const u32x4*)(P + (size_t)row * LDP + PC_RV + h * 128 + ch * 8); }
    __syncthreads();
    bf16x8 af[4], ab[4];
#pragma unroll
    for (int ks = 0; ks < 4; ++ks) { af[ks] = img_tr_frag(KF, lane, w, ks); ab[ks] = img_tr_frag(KB, lane, w, ks); }
    bf16_t* ST = (bf16_t*)(ws + WS_RST) + ((size_t)(bh * 2) * RNCH + cc) * (128 * 128);
#pragma unroll 2
    for (int E = 0; E < 8; ++E) {
        f32x4 cf = {0.f, 0.f, 0.f, 0.f}, cb = {0.f, 0.f, 0.f, 0.f};
#pragma unroll
        for (int ks = 0; ks < 4; ++ks) { const bf16x8 vb = img_tr_frag(VI, lane, E, ks); cf = MFMA16(af[ks], vb, cf); cb = MFMA16(ab[ks], vb, cb); }
        const int e = 16 * E + (lane & 15), d0 = 16 * w + 4 * g;
        u32x2 o; o.x = pk2(cf.x, cf.y); o.y = pk2(cf.z, cf.w); *(u32x2*)(ST + (size_t)e * 128 + d0) = o;
        o.x = pk2(cb.x, cb.y); o.y = pk2(cb.z, cb.w); *(u32x2*)(ST + (size_t)RNCH * 128 * 128 + (size_t)e * 128 + d0) = o;
    }
}
__device__ __forceinline__ void ret_passB(unsigned char* ws, int gt  ) {
    const int el = gt & 2047, bd = gt >> 11, bh = bd >> 1, dir = bd & 1, h = bh & 3;
    const float gC = exp2f(ret_log2g(h) * (float)RCH);
    bf16_t* base = (bf16_t*)(ws + WS_RST) + (size_t)bd * RNCH * (128 * 128) + (size_t)el * 8;
    float acc[8];
#pragma unroll
    for (int x = 0; x < 8; ++x) acc[x] = 0.f;
#pragma unroll 1
    for (int s0 = 0; s0 < RNCH; s0 += 17) {
        u32x4 kvr[17];
#pragma unroll
        for (int j = 0; j < 17; ++j) { const int s = s0 + j; const int cc = dir == 0 ? s : (s < 2 ? 1 - s : 35 - s); kvr[j] = *(const u32x4*)(base + (size_t)cc * (128 * 128)); }
#pragma unroll
        for (int j = 0; j < 17; ++j) { const int s = s0 + j; const int cc = dir == 0 ? s : (s < 2 ? 1 - s : 35 - s);
            float kv[8]; unpack8(kvr[j], kv);
            *(u32x4*)(base + (size_t)cc * (128 * 128)) = pack8(acc);
#pragma unroll
            for (int x = 0; x < 8; ++x) acc[x] = gC * acc[x] + kv[x]; }
    }
}
__device__ __forceinline__ void ret_passC(const DArgs& a, unsigned char* ws, LAS unsigned char* lds, int l, int item, int tid) {
    const int bh = item / RNCH, cc = item % RNCH, b = bh >> 2, h = bh & 3;
    const int lane = tid & 63, w = tid >> 6, g = lane >> 4, il = lane & 15;
    LAS unsigned char* KI = lds; LAS unsigned char* VI = lds + 32768; LAS unsigned char* SF = lds + 65536; LAS unsigned char* SB = lds + 98304;
    const int rowbase = ret_rowbase(b, cc);
    const bf16_t* P = (const bf16_t*)(ws + WS_P) + (size_t)rowbase * LDP;
    const bf16_t* STf = (const bf16_t*)(ws + WS_RST) + ((size_t)(bh * 2) * RNCH + cc) * (128 * 128);
    const bf16_t* STb = STf + (size_t)RNCH * 128 * 128;
    __syncthreads();
    stage_tile128(KI, P + PC_RK + h * 128, LDP, tid); stage_tile128(VI, P + PC_RV + h * 128, LDP, tid);
    stage_tile128(SF, STf, 128, tid); stage_tile128(SB, STb, 128, tid);
    bf16x8 qf[4];
    { const bf16_t* qr = P + (size_t)(16 * w + il) * LDP + PC_RQ + h * 128 + 8 * g;
#pragma unroll
      for (int ks = 0; ks < 4; ++ks) qf[ks] = *(const bf16x8*)(qr + 32 * ks); }
    __syncthreads();
    const float l2g = ret_log2g(h);
    const int iloc = 16 * w + il;
    f32x4 o[8];
    { const float sf = exp2f(l2g * (float)(iloc + 1)), sb = exp2f(l2g * (float)(RCH - iloc));
#pragma unroll
      for (int E = 0; E < 8; ++E) { f32x4 rf = {0.f, 0.f, 0.f, 0.f}, rb = {0.f, 0.f, 0.f, 0.f};
#pragma unroll
          for (int ks = 0; ks < 4; ++ks) { rf = MFMA16(img_row_frag(SF, lane, E, ks), qf[ks], rf); rb = MFMA16(img_row_frag(SB, lane, E, ks), qf[ks], rb); }
          o[E] = rf * sf + rb * sb; } }
    f32x4 at[8];
#pragma unroll
    for (int T = 0; T < 8; ++T) { f32x4 c = {0.f, 0.f, 0.f, 0.f};
#pragma unroll
        for (int ks = 0; ks < 4; ++ks) c = MFMA16(img_row_frag(KI, lane, T, ks), qf[ks], c);
#pragma unroll
        for (int r = 0; r < 4; ++r) { const int j = 16 * T + 4 * g + r; const int dd = iloc > j ? iloc - j : j - iloc; c[r] *= (dd == 0 ? 2.0f : exp2f(l2g * (float)dd)); }
        at[T] = c; }
#pragma unroll
    for (int s = 0; s < 4; ++s) { const bf16x8 bfr = acc_pair_frag(at[2 * s], at[2 * s + 1]);
#pragma unroll
        for (int E = 0; E < 8; ++E) o[E] = MFMA16(img_tr_frag_acc(VI, lane, E, s), bfr, o[E]); }
    float ss = 0.f;
#pragma unroll
    for (int E = 0; E < 8; ++E) ss += (o[E].x * o[E].x + o[E].y * o[E].y) + (o[E].z * o[E].z + o[E].w * o[E].w);
    ss += __shfl_xor(ss, 16); ss += __shfl_xor(ss, 32);
    const float rn = rsqrtf(ss * (1.0f / 128.0f) + EPS);
    const size_t row = (size_t)rowbase + iloc;
    const bf16_t* gp = (const bf16_t*)(ws + WS_P) + row * LDP + PC_RG + h * 128 + 4 * g;
    const float* nw = a.in[I_RNW] + l * 512 + h * 128 + 4 * g;
    bf16_t* op = (bf16_t*)(ws + WS_H) + row * D + 1024 + h * 128 + 4 * g;
#pragma unroll
    for (int E = 0; E < 8; ++E) { const u32x2 gr = *(const u32x2*)(gp + 16 * E); const f32x4 nv = *(const f32x4*)(nw + 16 * E);
        u32x2 ov; ov.x = pk2(o[E].x * rn * nv.x * siluf_(bflo(gr.x)), o[E].y * rn * nv.y * siluf_(bfhi(gr.x)));
        ov.y = pk2(o[E].z * rn * nv.z * siluf_(bflo(gr.y)), o[E].w * rn * nv.w * siluf_(bfhi(gr.y)));
        *(u32x2*)(op + 16 * E) = ov; }
}
constexpr int GCH = 64, GNCH = 68;
constexpr size_t WS_GST = WS_OB + (size_t)2 * OBSZ * 2;
constexpr size_t WS_GDEC = WS_END;
constexpr size_t WS_H3B = WS_GDEC + (size_t)16 * 2 * GNCH * 64 * 4;
constexpr size_t WS_ROPE = WS_H3B + (size_t)2 * 4096 * 64 * 2;
constexpr size_t WS_END2 = WS_ROPE + (size_t)(SEQL + LC) * 64 * 8;
__device__ __forceinline__ int gla_rowbase(int b, int cg) { return cg < 4 ? NLAT + b * LC + cg * GCH : b * SEQL + (cg - 4) * GCH; }

constexpr int GLS = 68;
__device__ __forceinline__ void gla_gates_compute(const DArgs& a, unsigned char* ws, LAS float* BF, LAS float* BB, LAS float* GW  , int l, int h, int rowbase, int tid) {
    const int t = tid >> 3, d8 = tid & 7;
    const float* lr = (const float*)(ws + WS_LR) + (size_t)(rowbase + t) * 32;
    f32x4 lv[8];
#pragma unroll
    for (int q = 0; q < 8; ++q) lv[q] = ((const f32x4*)lr)[q];
    { const int dir = tid >> 8, r = (tid >> 4) & 15, c4 = (tid & 15) * 4;
      *(LAS f32x4*)(GW + (dir * 17 + r) * 64 + c4) = *(const f32x4*)(a.in[I_GGW] + (size_t)(l * 2 + dir) * 16 * 256 + r * 256 + h * 64 + c4);
      if (tid < 32) { const int dd = tid >> 4; *(LAS f32x4*)(GW + (dd * 17 + 16) * 64 + c4) = *(const f32x4*)(a.in[I_GGB] + (size_t)(l * 2 + dd) * 256 + h * 64 + c4); } }
    __syncthreads();
    bf16_t* GLG = (bf16_t*)(ws + WS_WIN);
#pragma unroll
    for (int dir = 0; dir < 2; ++dir) {
        const LAS float* gw = GW + dir * 17 * 64 + 8 * d8;
        f32x4 s0 = *(const LAS f32x4*)(gw + 16 * 64), s1 = *(const LAS f32x4*)(gw + 16 * 64 + 4);
#pragma unroll
        for (int j = 0; j < 16; ++j) { const float lj = lv[dir * 4 + (j >> 2)][j & 3]; s0 += lj * *(const LAS f32x4*)(gw + j * 64); s1 += lj * *(const LAS f32x4*)(gw + j * 64 + 4); }
        LAS float* dst = (dir ? BB : BF) + t * GLS + 8 * d8;
        float la[8];
#pragma unroll
        for (int x = 0; x < 8; ++x) { const float s = x < 4 ? s0[x] : s1[x - 4]; const float e = __expf(-fabsf(s)); const float ls = fminf(s, 0.f) - __logf(1.0f + e); la[x] = ls * (1.0f / 16.0f); }
        const u32x4 pk = pack8(la);
        *(u32x4*)(GLG + ((size_t)dir * MR + rowbase + t) * 256 + h * 64 + 8 * d8) = pk;
        float lq[8]; unpack8(pk, lq);
        *(LAS f32x4*)dst = (f32x4){lq[0], lq[1], lq[2], lq[3]}; *(LAS f32x4*)(dst + 4) = (f32x4){lq[4], lq[5], lq[6], lq[7]};
    }
}
__device__ __forceinline__ void gla_gates_load(unsigned char* ws, LAS float* BF, LAS float* BB, int h, int rowbase, int tid) {
    const int t = tid >> 3, d8 = tid & 7;
    const bf16_t* GLG = (const bf16_t*)(ws + WS_WIN);
#pragma unroll
    for (int dir = 0; dir < 2; ++dir) { float lq[8]; unpack8(*(const u32x4*)(GLG + ((size_t)dir * MR + rowbase + t) * 256 + h * 64 + 8 * d8), lq);
        LAS float* dst = (dir ? BB : BF) + t * GLS + 8 * d8;
        *(LAS f32x4*)dst = (f32x4){lq[0], lq[1], lq[2], lq[3]}; *(LAS f32x4*)(dst + 4) = (f32x4){lq[4], lq[5], lq[6], lq[7]}; }
}
__device__ __forceinline__ void gla_scan(LAS float* BF, LAS float* BB, int tid) {
    const int lane = tid & 63, w = tid >> 6;
    __syncthreads();
#pragma unroll 4
    for (int c = 0; c < 16; ++c) { const int col = 16 * w + c; const int dir = col >> 6, d = col & 63;
        LAS float* p = (dir ? BB : BF) + (dir ? 63 - lane : lane) * GLS + d;
        float v = *p;
#pragma unroll
        for (int off = 1; off < 64; off <<= 1) { const float u = __shfl_up(v, off); if (lane >= off) v += u; }
        *p = v; }
    __syncthreads();
}

__device__ __forceinline__ void gla_passA(const DArgs& a, unsigned char* ws, LAS unsigned char* lds, int l, int item, int tid) {
    const int bh = item / GNCH, cg = item % GNCH, b = bh >> 2, h = bh & 3;
    const int lane = tid & 63, w = tid >> 6, g = lane >> 4;
    LAS float* BF = (LAS float*)lds; LAS float* BB = (LAS float*)(lds + 17408); LAS unsigned char* KH = lds + 34816; LAS unsigned char* VI = lds + 34816 + 16384;
    const int rowbase = gla_rowbase(b, cg);
    const bf16_t* P = (const bf16_t*)(ws + WS_P) + (size_t)rowbase * LDP;
    const int t = tid >> 3, d8 = tid & 7;
    const u32x4 kraw = *(const u32x4*)(P + (size_t)t * LDP + PC_GK + h * 64 + 8 * d8);
    u32x4 vraw[2];
#pragma unroll
    for (int i = 0; i < 2; ++i) { const int n = tid + NT * i; vraw[i] = *(const u32x4*)(P + (size_t)(n >> 4) * LDP + PC_GV + h * 128 + (n & 15) * 8); }
    gla_gates_compute(a, ws, BF, BB, (LAS float*)(lds + 34816 + 32768), l, h, rowbase, tid);
    gla_scan(BF, BB, tid);
    { float kf[8], x0[8], x1[8]; unpack8(kraw, kf);
#pragma unroll
      for (int x = 0; x < 8; ++x) { const int d = 8 * d8 + x; x0[x] = kf[x] * __expf(BF[63 * GLS + d] - BF[t * GLS + d]); x1[x] = kf[x] * __expf(BB[d] - BB[t * GLS + d]); }
      *(LAS u32x4*)(KH + off_b(t, d8)) = pack8(x0); *(LAS u32x4*)(KH + off_b(t, 8 + d8)) = pack8(x1);
#pragma unroll
      for (int i = 0; i < 2; ++i) { const int n = tid + NT * i; *(LAS u32x4*)(VI + off_b(n >> 4, n & 15)) = vraw[i]; }
      if (tid < 128) { const int dir = tid >> 6, d = tid & 63; ((float*)(ws + WS_GDEC))[((size_t)(bh * 2 + dir) * GNCH + cg) * 64 + d] = __expf(dir ? BB[d] : BF[63 * GLS + d]); } }
    __syncthreads();
    const int dir = w >> 2, Dt = w & 3;
    bf16x8 af[2];
#pragma unroll
    for (int ks = 0; ks < 2; ++ks) af[ks] = img_tr_frag(KH, lane, dir * 4 + Dt, ks);
    bf16_t* ST = (bf16_t*)(ws + WS_GST) + ((size_t)(bh * 2 + dir) * GNCH + cg) * (128 * 64);
#pragma unroll 2
    for (int E = 0; E < 8; ++E) {
        f32x4 c = {0.f, 0.f, 0.f, 0.f};
#pragma unroll
        for (int ks = 0; ks < 2; ++ks) c = MFMA16(af[ks], img_tr_frag(VI, lane, E, ks), c);
        u32x2 o; o.x = pk2(c.x, c.y); o.y = pk2(c.z, c.w);
        *(u32x2*)(ST + (size_t)(16 * E + (lane & 15)) * 64 + 16 * Dt + 4 * g) = o;
    }
}
__device__ __forceinline__ void gla_passB(unsigned char* ws, LAS unsigned char* lds, int blk, int tid) {
    const int bd = blk >> 1, dir = bd & 1, el = (blk & 1) * 512 + tid;
    LAS float* decs = (LAS float*)lds;
    { const float* dsrc = (const float*)(ws + WS_GDEC) + (size_t)bd * GNCH * 64;
      for (int i = tid; i < GNCH * 64; i += NT) decs[i] = dsrc[i]; }
    __syncthreads();
    bf16_t* base = (bf16_t*)(ws + WS_GST) + (size_t)bd * GNCH * (128 * 64) + (size_t)el * 8;
    const int d0 = (el & 7) * 8;
    float acc[8];
#pragma unroll
    for (int x = 0; x < 8; ++x) acc[x] = 0.f;
#pragma unroll 1
    for (int s0 = 0; s0 < GNCH; s0 += 17) {
        u32x4 kvr[17];
#pragma unroll
        for (int j = 0; j < 17; ++j) { const int s = s0 + j; const int cg = dir == 0 ? s : (s < 4 ? 3 - s : 71 - s); kvr[j] = *(const u32x4*)(base + (size_t)cg * (128 * 64)); }
#pragma unroll
        for (int j = 0; j < 17; ++j) { const int s = s0 + j; const int cg = dir == 0 ? s : (s < 4 ? 3 - s : 71 - s);
            float kv[8]; unpack8(kvr[j], kv);
            const f32x4 q0 = *(const LAS f32x4*)(decs + cg * 64 + d0), q1 = *(const LAS f32x4*)(decs + cg * 64 + d0 + 4);
            *(u32x4*)(base + (size_t)cg * (128 * 64)) = pack8(acc);
#pragma unroll
            for (int x = 0; x < 8; ++x) acc[x] = (x < 4 ? q0[x] : q1[x - 4]) * acc[x] + kv[x]; }
    }
    __syncthreads();
}
__device__ __forceinline__ void gla_passC(const DArgs& a, unsigned char* ws, LAS unsigned char* lds, int l, int item, int tid) {
    const int bh = item / GNCH, cg = item % GNCH, b = bh >> 2, h = bh & 3;
    const int lane = tid & 63, w = tid >> 6, g = lane >> 4, il = lane & 15;
    LAS float* BF = (LAS float*)lds; LAS float* BB = (LAS float*)(lds + 17408);
    LAS unsigned char* QKF = lds + 34816; LAS unsigned char* QKB = QKF + 16384; LAS unsigned char* QH = QKB + 16384; LAS unsigned char* VI = QH + 16384; LAS unsigned char* SI = VI + 16384;
    const int rowbase = gla_rowbase(b, cg);
    const bf16_t* P = (const bf16_t*)(ws + WS_P) + (size_t)rowbase * LDP;
    const int t = tid >> 3, d8 = tid & 7;
    const u32x4 qraw = *(const u32x4*)(P + (size_t)t * LDP + PC_GQ + h * 64 + 8 * d8), kraw = *(const u32x4*)(P + (size_t)t * LDP + PC_GK + h * 64 + 8 * d8);
    u32x4 vraw[2], sraw[4];
#pragma unroll
    for (int i = 0; i < 2; ++i) { const int n = tid + NT * i; vraw[i] = *(const u32x4*)(P + (size_t)(n >> 4) * LDP + PC_GV + h * 128 + (n & 15) * 8); }
    { const bf16_t* STf = (const bf16_t*)(ws + WS_GST) + ((size_t)(bh * 2) * GNCH + cg) * (128 * 64); const bf16_t* STb = STf + (size_t)GNCH * 128 * 64;
#pragma unroll
      for (int i = 0; i < 4; ++i) { const int n = tid + NT * i, row = n >> 4, ch = n & 15; sraw[i] = *(const u32x4*)((ch < 8 ? STf : STb) + (size_t)row * 64 + (ch & 7) * 8); } }
    gla_gates_load(ws, BF, BB, h, rowbase, tid);
    gla_scan(BF, BB, tid);
    { float qf[8], kf[8], o0[8], o1[8], o2[8], o3[8], o4[8], o5[8];
      unpack8(qraw, qf); unpack8(kraw, kf);
#pragma unroll
      for (int x = 0; x < 8; ++x) { const int d = 8 * d8 + x; const float bf = BF[t * GLS + d], bb = BB[t * GLS + d], rf = BF[31 * GLS + d], rb = BB[32 * GLS + d]; const float q = qf[x] * 0.125f;
          o0[x] = q * __expf(bf - rf); o1[x] = kf[x] * __expf(rf - bf); o2[x] = q * __expf(bb - rb); o3[x] = kf[x] * __expf(rb - bb); o4[x] = q * __expf(bf); o5[x] = q * __expf(bb); }
      *(LAS u32x4*)(QKF + off_b(t, d8)) = pack8(o0); *(LAS u32x4*)(QKF + off_b(t, 8 + d8)) = pack8(o1);
      *(LAS u32x4*)(QKB + off_b(t, d8)) = pack8(o2); *(LAS u32x4*)(QKB + off_b(t, 8 + d8)) = pack8(o3);
      *(LAS u32x4*)(QH + off_b(t, d8)) = pack8(o4); *(LAS u32x4*)(QH + off_b(t, 8 + d8)) = pack8(o5);
#pragma unroll
      for (int i = 0; i < 2; ++i) { const int n = tid + NT * i; *(LAS u32x4*)(VI + off_b(n >> 4, n & 15)) = vraw[i]; }
#pragma unroll
      for (int i = 0; i < 4; ++i) { const int n = tid + NT * i; *(LAS u32x4*)(SI + off_b(n >> 4, n & 15)) = sraw[i]; } }
    __syncthreads();
    const int ib = w & 3, eh = w >> 2, iloc = 16 * ib + il;
    f32x4 at[4];
    { bf16x8 qff[2], qfb[2];
#pragma unroll
      for (int ks = 0; ks < 2; ++ks) { qff[ks] = img_row_frag(QKF, lane, ib, ks); qfb[ks] = img_row_frag(QKB, lane, ib, ks); }
#pragma unroll
      for (int T = 0; T < 4; ++T) { f32x4 cf = {0.f, 0.f, 0.f, 0.f}, cb = {0.f, 0.f, 0.f, 0.f};
#pragma unroll
          for (int ks = 0; ks < 2; ++ks) { cf = MFMA16(img_row_frag(QKF, lane, T, 2 + ks), qff[ks], cf); cb = MFMA16(img_row_frag(QKB, lane, T, 2 + ks), qfb[ks], cb); }
#pragma unroll
          for (int r = 0; r < 4; ++r) { const int j = 16 * T + 4 * g + r; cf[r] = (j <= iloc ? cf[r] : 0.f) + (j >= iloc ? cb[r] : 0.f); }
          at[T] = cf; } }
    f32x4 o[4];
    { bf16x8 hf[2], hb[2];
#pragma unroll
      for (int ks = 0; ks < 2; ++ks) { hf[ks] = img_row_frag(QH, lane, ib, ks); hb[ks] = img_row_frag(QH, lane, ib, 2 + ks); }
#pragma unroll
      for (int E4 = 0; E4 < 4; ++E4) { const int E = 4 * eh + E4; f32x4 c = {0.f, 0.f, 0.f, 0.f};
#pragma unroll
          for (int ks = 0; ks < 2; ++ks) { c = MFMA16(img_row_frag(SI, lane, E, ks), hf[ks], c); c = MFMA16(img_row_frag(SI, lane, E, 2 + ks), hb[ks], c); }
          o[E4] = c; } }
#pragma unroll
    for (int s = 0; s < 2; ++s) { const bf16x8 bfr = acc_pair_frag(at[2 * s], at[2 * s + 1]);
#pragma unroll
        for (int E4 = 0; E4 < 4; ++E4) o[E4] = MFMA16(img_tr_frag_acc(VI, lane, 4 * eh + E4, s), bfr, o[E4]); }
    float ss = 0.f;
#pragma unroll
    for (int E4 = 0; E4 < 4; ++E4) ss += (o[E4].x * o[E4].x + o[E4].y * o[E4].y) + (o[E4].z * o[E4].z + o[E4].w * o[E4].w);
    ss += __shfl_xor(ss, 16); ss += __shfl_xor(ss, 32);
    LAS float* red = (LAS float*)lds;
    if (g == 0) red[eh * 64 + iloc] = ss;
    __syncthreads();
    const float rn = rsqrtf((red[iloc] + red[64 + iloc]) * (1.0f / 128.0f) + EPS);
    const size_t row = (size_t)rowbase + iloc;
    const bf16_t* gp = (const bf16_t*)(ws + WS_P) + row * LDP + PC_GG + h * 128 + 64 * eh + 4 * g;
    const float* nw = a.in[I_GNW] + l * 512 + h * 128 + 64 * eh + 4 * g;
    bf16_t* op = (bf16_t*)(ws + WS_H) + row * D + 1536 + h * 128 + 64 * eh + 4 * g;
#pragma unroll
    for (int E4 = 0; E4 < 4; ++E4) { const u32x2 gr = *(const u32x2*)(gp + 16 * E4); const f32x4 nv = *(const f32x4*)(nw + 16 * E4);
        u32x2 ov; ov.x = pk2(o[E4].x * rn * nv.x * siluf_(bflo(gr.x)), o[E4].y * rn * nv.y * siluf_(bfhi(gr.x)));
        ov.y = pk2(o[E4].z * rn * nv.z * siluf_(bflo(gr.y)), o[E4].w * rn * nv.w * siluf_(bfhi(gr.y)));
        *(u32x2*)(op + 16 * E4) = ov; }
}
constexpr int SNCH = 68;
constexpr size_t WS_S5ST = WS_OB + (size_t)4 * OBSZ * 2;
constexpr size_t WS_S5BTB = WS_S5BT;
constexpr size_t WS_S5CPB = WS_S5BT + 524288;
constexpr size_t WS_S5A64 = WS_S5BT + 1048576;

__device__ __forceinline__ void prep_s5b(const DArgs& a, unsigned char* ws, int it, int tid) {
    const int idx = it * 512 + tid;
    const int gi = idx >> 6, p = idx & 63;
    const float a_re = a.in[I_S5ARE][idx], a_im = a.in[I_S5AIM][idx], ldt = a.in[I_S5LDT][gi];
    const float dt = expf(ldt), mag = expf(a_re * dt);
    float sn, cs; sincosf(a_im * dt, &sn, &cs);
    const float ab_re = mag * cs, ab_im = mag * sn, den = a_re * a_re + a_im * a_im, nr = ab_re - 1.0f;
    const float co_re = (nr * a_re + ab_im * a_im) / den, co_im = (ab_im * a_re - nr * a_im) / den;
    ((f32x2*)(ws + WS_S5AB))[idx] = (f32x2){ab_re, ab_im};
    float pr = ab_re, pi = ab_im;
#pragma unroll
    for (int q = 0; q < 6; ++q) { const float nr2 = pr * pr - pi * pi, ni2 = 2.0f * pr * pi; pr = nr2; pi = ni2; }
    ((f32x2*)(ws + WS_S5A64))[idx] = (f32x2){pr, pi};
    const float* bre = a.in[I_S5BRE] + (size_t)idx * 16; const float* bim = a.in[I_S5BIM] + (size_t)idx * 16;
    float tr[16], ti[16];
#pragma unroll
    for (int i = 0; i < 16; ++i) { const float br = bre[i], bi = bim[i]; tr[i] = co_re * br - co_im * bi; ti[i] = co_re * bi + co_im * br; }
    bf16_t* btb = (bf16_t*)(ws + WS_S5BTB) + (size_t)gi * 128 * 16;
#pragma unroll
    for (int hlf = 0; hlf < 2; ++hlf) { u32x4 w0, w1; const float* s = hlf ? ti : tr;
        w0.x = pk2(s[0], s[1]); w0.y = pk2(s[2], s[3]); w0.z = pk2(s[4], s[5]); w0.w = pk2(s[6], s[7]); w1.x = pk2(s[8], s[9]); w1.y = pk2(s[10], s[11]); w1.z = pk2(s[12], s[13]); w1.w = pk2(s[14], s[15]);
        *(u32x4*)(btb + (size_t)(64 * hlf + p) * 16) = w0; *(u32x4*)(btb + (size_t)(64 * hlf + p) * 16 + 8) = w1; }
    bf16_t* cpb = (bf16_t*)(ws + WS_S5CPB) + (size_t)gi * 16 * 128;
    const float* cre = a.in[I_S5CRE] + (size_t)gi * 1024; const float* cim = a.in[I_S5CIM] + (size_t)gi * 1024;
#pragma unroll
    for (int i = 0; i < 16; ++i) *(unsigned*)(cpb + i * 128 + 2 * p) = pk2(cre[i * 64 + p], -cim[i * 64 + p]);
}

struct S5Unit { bf16x8 btf[8]; f32x2 ab; f32x2 h; const bf16_t* cp; };
template <bool PASSC> __device__ __forceinline__ void s5_load_unit(S5Unit& U, unsigned char* ws, const bf16_t* P, const f32x2* ST, int l, int b, int cs, int rowbase, int grp, int dir, int lane) {
    const int g = lane >> 4, il = lane & 15;
    const bf16x8 zero8 = {0, 0, 0, 0, 0, 0, 0, 0};
    const int gi = (l * 2 + dir) * 32 + grp;
    U.ab = ((const f32x2*)(ws + WS_S5AB))[gi * 64 + lane];
    const size_t sidx = ((size_t)(b * SNCH + cs) * 2 + dir) * 2048 + grp * 64 + lane;
    U.h = PASSC ? ST[sidx] : (f32x2){0.f, 0.f};
    const bf16_t* bt = (const bf16_t*)(ws + WS_S5BTB) + (size_t)gi * 128 * 16 + (size_t)il * 16 + 8 * (g & 1);
#pragma unroll
    for (int Pt = 0; Pt < 8; ++Pt) { const bf16x8 v = *(const bf16x8*)(bt + Pt * 256); U.btf[Pt] = g < 2 ? v : zero8; }
    U.cp = (const bf16_t*)(ws + WS_S5CPB) + (size_t)gi * 16 * 128 + (size_t)il * 128 + 8 * g;
}
__device__ __forceinline__ void s5_load_u(bf16x8 (&ufa)[4], const bf16_t* P, int rowbase, int grp, int lane) {
    const int g = lane >> 4, il = lane & 15; const bf16x8 zero8 = {0, 0, 0, 0, 0, 0, 0, 0};
#pragma unroll
    for (int Tt = 0; Tt < 4; ++Tt) { const bf16x8 v = *(const bf16x8*)(P + (size_t)(rowbase + 16 * Tt + il) * LDP + PC_S5U + grp * 16 + 8 * (g & 1)); ufa[Tt] = g < 2 ? v : zero8; }
}
template <bool PASSC, int DIR> __device__ __forceinline__ void s5_run_unit(const S5Unit& U, const bf16x8 (&ufa)[4], f32x4 (&yacc)[4], f32x2& hout, LAS float* BU, LAS unsigned char* HW, int lane) {
    const int g = lane >> 4, il = lane & 15;
    f32x2 h = U.h; const f32x2 ab = U.ab;
    bf16x8 cpf[4];
    if (PASSC) {
#pragma unroll
        for (int ks = 0; ks < 4; ++ks) cpf[ks] = *(const bf16x8*)(U.cp + 32 * ks); }
#pragma unroll
    for (int wi = 0; wi < 4; ++wi) {
        const int Tt = DIR ? 3 - wi : wi;
#pragma unroll
        for (int Pt = 0; Pt < 8; ++Pt) { const f32x4 d = MFMA16(U.btf[Pt], ufa[Tt], ((f32x4){0.f, 0.f, 0.f, 0.f}));
#pragma unroll
            for (int r = 0; r < 4; ++r) BU[(16 * Pt + 4 * g + r) * 20 + il] = d[r]; }
        asm volatile("" ::: "memory");
        f32x4 br[4], bi[4];
#pragma unroll
        for (int q = 0; q < 4; ++q) { br[q] = *(const LAS f32x4*)(BU + lane * 20 + 4 * q); bi[q] = *(const LAS f32x4*)(BU + (64 + lane) * 20 + 4 * q); }
#pragma unroll
        for (int s = 0; s < 16; ++s) { const int tt = DIR ? 15 - s : s;
            const float hr = ab.x * h.x - ab.y * h.y + br[tt >> 2][tt & 3], hi = ab.x * h.y + ab.y * h.x + bi[tt >> 2][tt & 3];
            h = (f32x2){hr, hi};
            if (PASSC) *(LAS unsigned*)(HW + off_b(tt, lane >> 2) + (lane & 3) * 4) = pk2(hr, hi); }
        asm volatile("" ::: "memory");
        if (PASSC) {
#pragma unroll
            for (int ks = 0; ks < 4; ++ks) yacc[Tt] = MFMA16(cpf[ks], img_row_frag(HW, lane, 0, ks), yacc[Tt]); }
        asm volatile("" ::: "memory");
    }
    hout = h;
}
template <bool PASSC> __device__ __forceinline__ void s5_item(const DArgs& a, unsigned char* ws, LAS unsigned char* lds, int l, int item, int tid) {
    const int b = item / (SNCH * 2), rem = item % (SNCH * 2), cs = rem >> 1, half = rem & 1;
    const int lane = tid & 63, w = tid >> 6, g = lane >> 4, il = lane & 15;
    const int rowbase = gla_rowbase(b, cs);
    LAS float* BU = (LAS float*)(lds + w * 14336); LAS unsigned char* HW = lds + w * 14336 + 10240;
    const bf16_t* P = (const bf16_t*)(ws + WS_P);
    f32x2* ST = (f32x2*)(ws + WS_S5ST);
    const int grp0 = 16 * half + w, grp1 = grp0 + 8;
    S5Unit UA; bf16x8 ufa[4];
#pragma unroll 1
    for (int gg = 0; gg < 2; ++gg) {
        const int grp = gg ? grp1 : grp0;
        f32x4 yacc[4];
#pragma unroll
        for (int q = 0; q < 4; ++q) yacc[q] = (f32x4){0.f, 0.f, 0.f, 0.f};
        f32x2 hend;
        s5_load_unit<PASSC>(UA, ws, P, ST, l, b, cs, rowbase, grp, 0, lane); s5_load_u(ufa, P, rowbase, grp, lane);
        s5_run_unit<PASSC, 0>(UA, ufa, yacc, hend, BU, HW, lane);
        if (!PASSC) ST[((size_t)(b * SNCH + cs) * 2 + 0) * 2048 + grp * 64 + lane] = hend;
        s5_load_unit<PASSC>(UA, ws, P, ST, l, b, cs, rowbase, grp, 1, lane);
        s5_run_unit<PASSC, 1>(UA, ufa, yacc, hend, BU, HW, lane);
        if (!PASSC) ST[((size_t)(b * SNCH + cs) * 2 + 1) * 2048 + grp * 64 + lane] = hend;
        if (PASSC) {
            const f32x4 dsk = *(const f32x4*)(a.in[I_S5D] + l * 512 + grp * 16 + 4 * g);
            bf16_t* G5 = (bf16_t*)(ws + WS_KF);
#pragma unroll
            for (int Tt = 0; Tt < 4; ++Tt) { const size_t row = (size_t)rowbase + 16 * Tt + il;
                const u32x2 ur = *(const u32x2*)(P + row * LDP + PC_S5U + grp * 16 + 4 * g), sg = *(const u32x2*)(P + row * LDP + PC_S5G + grp * 16 + 4 * g);
                const float g0 = gelu_tanh(yacc[Tt].x + bflo(ur.x) * dsk.x), g1 = gelu_tanh(yacc[Tt].y + bfhi(ur.x) * dsk.y), g2 = gelu_tanh(yacc[Tt].z + bflo(ur.y) * dsk.z), g3 = gelu_tanh(yacc[Tt].w + bfhi(ur.y) * dsk.w);
                u32x2 ov; ov.x = pk2(g0, g1); ov.y = pk2(g2, g3);
                *(u32x2*)(G5 + row * 512 + grp * 16 + 4 * g) = ov;
                ov.x = pk2(g0 * siluf_(bflo(sg.x)), g1 * siluf_(bfhi(sg.x))); ov.y = pk2(g2 * siluf_(bflo(sg.y)), g3 * siluf_(bfhi(sg.y)));
                *(u32x2*)(G5 + OBSZ + row * 512 + grp * 16 + 4 * g) = ov; }
        }
    }
}
__device__ __forceinline__ void s5_passB(unsigned char* ws, int l, int gt) {
    const int p = gt & 63, grp = (gt >> 6) & 31, dir = (gt >> 11) & 1, b = gt >> 12;
    const f32x2 a64 = ((const f32x2*)(ws + WS_S5A64))[((l * 2 + dir) * 32 + grp) * 64 + p];
    f32x2* ST = (f32x2*)(ws + WS_S5ST);
    f32x2 acc = {0.f, 0.f};
#pragma unroll 1
    for (int s0 = 0; s0 < SNCH; s0 += 34) {
        f32x2 ev[34];
#pragma unroll
        for (int j = 0; j < 34; ++j) { const int s = s0 + j; const int cs = dir == 0 ? s : (s < 4 ? 3 - s : 71 - s); ev[j] = ST[((size_t)(b * SNCH + cs) * 2 + dir) * 2048 + grp * 64 + p]; }
#pragma unroll
        for (int j = 0; j < 34; ++j) { const int s = s0 + j; const int cs = dir == 0 ? s : (s < 4 ? 3 - s : 71 - s);
            ST[((size_t)(b * SNCH + cs) * 2 + dir) * 2048 + grp * 64 + p] = acc;
            acc = (f32x2){a64.x * acc.x - a64.y * acc.y + ev[j].x, a64.x * acc.y + a64.y * acc.x + ev[j].y}; }
    }
}
constexpr int FFT_PHYS = 9216;
__device__ __forceinline__ int fphys(int i) { return i + (i >> 3); }
__device__ __forceinline__ f32x2 cmulf(const f32x2 a, const f32x2 b) { return (f32x2){a.x * b.x - a.y * b.y, a.x * b.y + a.y * b.x}; }
__device__ __forceinline__ f32x2 cmulcf(const f32x2 a, const f32x2 b) { return (f32x2){a.x * b.x + a.y * b.y, a.y * b.x - a.x * b.y}; }
template <int RL> __device__ __forceinline__ void dft_fwd_const(f32x2 (&e)[1 << RL]) {
#pragma unroll
    for (int s = 0; s < RL; ++s) { const int h = 1 << (RL - 1 - s);
#pragma unroll
        for (int m = 0; m < (1 << RL); ++m) { if (m & h) continue;
            const int mp = m & (h - 1); const f32x2 a_ = e[m], b_ = e[m | h]; const f32x2 d = a_ - b_; e[m] = a_ + b_;
            if (mp == 0) e[m | h] = d;
            else if (2 * mp == h) e[m | h] = (f32x2){d.y, -d.x};
            else { const float ang = -3.14159265358979323846f * (float)mp / (float)h; const f32x2 c = {__builtin_cosf(ang), __builtin_sinf(ang)}; e[m | h] = cmulf(d, c); } } }
}
template <int RL> __device__ __forceinline__ void dft_inv_const(f32x2 (&e)[1 << RL]) {
#pragma unroll
    for (int ss = 0; ss < RL; ++ss) { const int s = RL - 1 - ss; const int h = 1 << (RL - 1 - s);
#pragma unroll
        for (int m = 0; m < (1 << RL); ++m) { if (m & h) continue;
            const int mp = m & (h - 1); const f32x2 a_ = e[m], b_ = e[m | h]; f32x2 t;
            if (mp == 0) t = b_;
            else if (2 * mp == h) t = (f32x2){-b_.y, b_.x};
            else { const float ang = -3.14159265358979323846f * (float)mp / (float)h; const f32x2 c = {__builtin_cosf(ang), __builtin_sinf(ang)}; t = cmulcf(b_, c); }
            e[m] = a_ + t; e[m | h] = a_ - t; } }
}
template <int RL> __device__ __forceinline__ constexpr int brev_c(int m) { int r = 0; for (int i = 0; i < RL; ++i) r |= ((m >> i) & 1) << (RL - 1 - i); return r; }
template <int RL, bool CONJ> __device__ __forceinline__ void apply_tw(f32x2 (&e)[1 << RL], const f32x2 w1) {
    f32x2 tw[1 << RL];
    tw[0] = (f32x2){1.f, 0.f}; tw[1] = w1;
    if (RL >= 2) { tw[2] = cmulf(w1, w1); tw[3] = cmulf(tw[2], w1); }
    if (RL >= 3) { tw[4] = cmulf(tw[2], tw[2]); tw[5] = cmulf(tw[4], tw[1]); tw[6] = cmulf(tw[4], tw[2]); tw[7] = cmulf(tw[4], tw[3]); }
    if (RL >= 4) { tw[8] = cmulf(tw[4], tw[4]);
#pragma unroll
        for (int k = 1; k < 8; ++k) tw[8 + k] = cmulf(tw[8], tw[k]); }
#pragma unroll
    for (int m = 1; m < (1 << RL); ++m) e[m] = CONJ ? cmulcf(e[m], tw[brev_c<RL>(m)]) : cmulf(e[m], tw[brev_c<RL>(m)]);
}
template <int RL, int BETA, bool INV> __device__ __forceinline__ void fft2_pass(LAS f32x2* X, const LAS f32x2* W, int tid) {
    constexpr int LOW = BETA - RL + 1, NG = FFTN >> RL, STR = (1 << LOW) + (1 << (LOW - 3));
#pragma unroll 1
    for (int gi = tid; gi < NG; gi += NT) {
        const int base = ((gi >> LOW) << (BETA + 1)) | (gi & ((1 << LOW) - 1));
        LAS f32x2* p = X + fphys(base);
        f32x2 e[1 << RL];
#pragma unroll
        for (int m = 0; m < (1 << RL); ++m) e[m] = p[m * STR];
        const f32x2 w1 = W[(base & ((1 << LOW) - 1)) << (12 - BETA)];
        if (!INV) { dft_fwd_const<RL>(e); apply_tw<RL, false>(e, w1); }
        else { apply_tw<RL, true>(e, w1); dft_inv_const<RL>(e); }
#pragma unroll
        for (int m = 0; m < (1 << RL); ++m) p[m * STR] = e[m];
    }
}
__device__ __forceinline__ void fft2_fwd_ABC(LAS f32x2* X, const LAS f32x2* W, int tid) {
    fft2_pass<4, 12, false>(X, W, tid); __syncthreads(); fft2_pass<3, 8, false>(X, W, tid); __syncthreads(); fft2_pass<3, 5, false>(X, W, tid); __syncthreads();
}
__device__ __forceinline__ void fft2_inv_CBA(LAS f32x2* X, const LAS f32x2* W, int tid) {
    fft2_pass<3, 5, true>(X, W, tid); __syncthreads(); fft2_pass<3, 8, true>(X, W, tid); __syncthreads(); fft2_pass<4, 12, true>(X, W, tid); __syncthreads();
}
__device__ __forceinline__ void fft2_mid_mul(LAS f32x2* X, const f32x2* KF, int tid) {
#pragma unroll 1
    for (int gi = tid; gi < 1024; gi += NT) {
        LAS f32x2* p = X + 9 * gi;
        f32x2 e[8]; f32x4 kf[4];
#pragma unroll
        for (int q = 0; q < 4; ++q) kf[q] = *(const f32x4*)(KF + 8 * gi + 2 * q);
#pragma unroll
        for (int m = 0; m < 8; ++m) e[m] = p[m];
        dft_fwd_const<3>(e);
#pragma unroll
        for (int q = 0; q < 4; ++q) { e[2 * q] = cmulf(e[2 * q], (f32x2){kf[q].x, kf[q].y}); e[2 * q + 1] = cmulf(e[2 * q + 1], (f32x2){kf[q].z, kf[q].w}); }
        dft_inv_const<3>(e);
#pragma unroll
        for (int m = 0; m < 8; ++m) p[m] = e[m];
    }
}
__device__ __forceinline__ void fft2_fwd_D(LAS f32x2* X, int tid) {
#pragma unroll 1
    for (int gi = tid; gi < 1024; gi += NT) { LAS f32x2* p = X + 9 * gi; f32x2 e[8];
#pragma unroll
        for (int m = 0; m < 8; ++m) e[m] = p[m];
        dft_fwd_const<3>(e);
#pragma unroll
        for (int m = 0; m < 8; ++m) p[m] = e[m]; }
}

__device__ __forceinline__ void filt_item2(const DArgs& a, unsigned char* ws, LAS unsigned char* lds, int l, int c, int tid) {
    LAS f32x2* X = (LAS f32x2*)lds; LAS f32x2* W = (LAS f32x2*)(lds + FFT_PHYS * 8); LAS float* w4s = (LAS float*)(lds + FFT_PHYS * 8 + 32768); LAS float* red = w4s + 256;
    fft_twiddles(W, tid);
    if (tid < 128) { const int cc = tid >> 5, pr = tid & 31; const float* wsrc = a.in[I_HW4] + (size_t)l * 64 * 2048 + (cc >> 1) * 1024 + (cc & 1) * 512 + c;
        ((LAS unsigned*)w4s)[pr * 4 + cc] = pk2(wsrc[(size_t)(2 * pr) * 2048], wsrc[(size_t)(2 * pr + 1) * 2048]); }
    if (tid == 0) { float z0; asm volatile("v_mov_b32 %0, 0" : "=v"(z0)); X[fphys(4096)] = (f32x2){z0, z0}; }
    __syncthreads();
    const float dl = fabsf(HY_D0 + (HY_D1 - HY_D0) * ((float)c / 511.0f));
    const bf16_t* H3 = (const bf16_t*)(ws + WS_H3B) + (size_t)l * 4096 * 64;
    float ss0 = 0.f, ss1 = 0.f;
#pragma unroll 1
    for (int j = 0; j < 8; ++j) {
        const int t = tid + 512 * j;
        const u32x4* hr = (const u32x4*)(H3 + (size_t)t * 64);
        u32x4 hraw[8];
#pragma unroll
        for (int q = 0; q < 8; ++q) hraw[q] = hr[q];
        asm volatile("" ::: "memory");
        float f0 = 0.f, f1 = 0.f, b0 = 0.f, b1 = 0.f;
        typedef __bf16 bfp2 __attribute__((ext_vector_type(2)));
#pragma unroll
        for (int q = 0; q < 8; ++q) {
#pragma unroll
            for (int e = 0; e < 4; ++e) { const u32x4 wq = ((const LAS u32x4*)w4s)[4 * q + e]; const unsigned hx = hraw[q][e];
                f0 += bflo(hx) * bflo(wq.x) + bfhi(hx) * bfhi(wq.x); f1 += bflo(hx) * bflo(wq.y) + bfhi(hx) * bfhi(wq.y);
                b0 += bflo(hx) * bflo(wq.z) + bfhi(hx) * bfhi(wq.z); b1 += bflo(hx) * bflo(wq.w) + bfhi(hx) * bfhi(wq.w); } }
        const float dec = expf(-((float)t / 4095.0f) * dl); f0 *= dec; f1 *= dec; b0 *= dec; b1 *= dec;
        X[fphys(t)] = (f32x2){f0, f1}; ss0 += f0 * f0; ss1 += f1 * f1;
        if (t > 0) { X[fphys(8192 - t)] = (f32x2){b0, b1}; ss0 += b0 * b0; ss1 += b1 * b1; }
    }
    const float rs0 = rsqrtf(block_sum(ss0, red, tid) + EPS), rs1 = rsqrtf(block_sum(ss1, red, tid) + EPS);
#pragma unroll 4
    for (int j = 0; j < 16; ++j) { const int n = fphys(tid + 512 * j); const f32x2 x = X[n]; X[n] = (f32x2){x.x * rs0, x.y * rs1}; }
    __syncthreads(); fft2_fwd_ABC(X, W, tid); fft2_fwd_D(X, tid); __syncthreads();
    f32x2* KF0 = (f32x2*)(ws + WS_KF) + (size_t)(0 * 512 + c) * FFTN; f32x2* KF1 = (f32x2*)(ws + WS_KF) + (size_t)(1 * 512 + c) * FFTN;
#pragma unroll 4
    for (int j = 0; j < 16; ++j) { const int pos = tid + 512 * j; const int k = (int)(__brev((unsigned)pos) >> 19); const int pp = (int)(__brev((unsigned)((8192 - k) & 8191)) >> 19);
        const f32x2 za = X[fphys(pos)], zb = X[fphys(pp)];
        KF0[pos] = (f32x2){0.5f * (za.x + zb.x), 0.5f * (za.y - zb.y)};
        KF1[pos] = (f32x2){0.5f * (za.y + zb.y), 0.5f * (zb.x - za.x)}; }
    __syncthreads();
}

struct Raw8 { u32x4 mid; bf16_t lf, rt; };
__device__ __forceinline__ Raw8 ld_raw8(const bf16_t* p, int t0, int Lx) { Raw8 r; r.mid = *(const u32x4*)(p + t0); r.lf = t0 > 0 ? p[t0 - 1] : (bf16_t)0; r.rt = t0 + 8 < Lx ? p[t0 + 8] : (bf16_t)0; return r; }
__device__ __forceinline__ void sconv8(const Raw8& r, float w0, float w1, float w2, float cb, float (&o)[8]) {
    float x[10]; x[0] = bf2f(r.lf); x[9] = bf2f(r.rt);
    x[1] = bflo(r.mid.x); x[2] = bfhi(r.mid.x); x[3] = bflo(r.mid.y); x[4] = bfhi(r.mid.y); x[5] = bflo(r.mid.z); x[6] = bfhi(r.mid.z); x[7] = bflo(r.mid.w); x[8] = bfhi(r.mid.w);
#pragma unroll
    for (int i = 0; i < 8; ++i) o[i] = w0 * x[i] + w1 * x[i + 1] + w2 * x[i + 2] + cb;
}
__device__ __forceinline__ void hyena_item2(const DArgs& a, unsigned char* ws, LAS unsigned char* lds, int l, int c, int tid) {
    LAS f32x2* X = (LAS f32x2*)lds; LAS f32x2* W = (LAS f32x2*)(lds + FFT_PHYS * 8);
    fft_twiddles(W, tid);
    const float* cw = a.in[I_HCW] + (size_t)l * 3 * 1536; const float* cbp = a.in[I_HCB] + (size_t)l * 1536;
    const float wv0 = cw[c], wv1 = cw[1536 + c], wv2 = cw[3072 + c], bv = cbp[c];
    const float wa0 = cw[512 + c], wa1 = cw[1536 + 512 + c], wa2 = cw[3072 + 512 + c], ba = cbp[512 + c];
    const float wb0 = cw[1024 + c], wb1 = cw[1536 + 1024 + c], wb2 = cw[3072 + 1024 + c], bb = cbp[1024 + c];
    const float bias0 = a.in[I_HBIAS][(l * 2 + 0) * 512 + c], bias1 = a.in[I_HBIAS][(l * 2 + 1) * 512 + c];
    const bf16_t* PT = (const bf16_t*)(ws + WS_PT);
    const bf16_t* pv = PT + (size_t)(PT_V + c) * MR; const bf16_t* pg1 = PT + (size_t)(PT_G1 + c) * MR; const bf16_t* pg2 = PT + (size_t)(PT_G2 + c) * MR; const bf16_t* phg = PT + (size_t)(PT_HG + c) * MR;
    const f32x2* KF0 = (const f32x2*)(ws + WS_KF) + (size_t)(0 * 512 + c) * FFTN; const f32x2* KF1 = (const f32x2*)(ws + WS_KF) + (size_t)(1 * 512 + c) * FFTN;
    bf16_t* GATED = (bf16_t*)(ws + WS_H);
    const int t0 = 8 * tid;
    LAS f32x2* px = X + 9 * tid;
    __syncthreads();
    for (int bp = 0; bp < 2; ++bp) {
        const int r0 = (2 * bp) * SEQL, r1 = (2 * bp + 1) * SEQL;
        const Raw8 v0 = ld_raw8(pv + r0, t0, SEQL), v1 = ld_raw8(pv + r1, t0, SEQL);
        const Raw8 g10 = ld_raw8(pg1 + r0, t0, SEQL), g11 = ld_raw8(pg1 + r1, t0, SEQL);
        float zr[8], zi[8];
        sconv8(v0, wv0, wv1, wv2, bv, zr); sconv8(v1, wv0, wv1, wv2, bv, zi);
#pragma unroll
        for (int x = 0; x < 8; ++x) { px[x] = (f32x2){zr[x], zi[x]}; px[4608 + x] = (f32x2){0.f, 0.f}; }
        __syncthreads(); fft2_fwd_ABC(X, W, tid); fft2_mid_mul(X, KF0, tid); __syncthreads(); fft2_inv_CBA(X, W, tid);
        { float gr[8], gi[8]; sconv8(g10, wa0, wa1, wa2, ba, gr); sconv8(g11, wa0, wa1, wa2, ba, gi);
#pragma unroll
          for (int x = 0; x < 8; ++x) { const f32x2 cv = px[x] * (1.0f / 8192.0f); zr[x] = gr[x] * (cv.x + bias0 * zr[x]); zi[x] = gi[x] * (cv.y + bias0 * zi[x]); } }
        __syncthreads();
        const Raw8 g20 = ld_raw8(pg2 + r0, t0, SEQL), g21 = ld_raw8(pg2 + r1, t0, SEQL);
        const u32x4 hgr0 = *(const u32x4*)(phg + r0 + t0), hgr1 = *(const u32x4*)(phg + r1 + t0);
#pragma unroll
        for (int x = 0; x < 8; ++x) { px[x] = (f32x2){zr[x], zi[x]}; px[4608 + x] = (f32x2){0.f, 0.f}; }
        __syncthreads(); fft2_fwd_ABC(X, W, tid); fft2_mid_mul(X, KF1, tid); __syncthreads(); fft2_inv_CBA(X, W, tid);
        { float gr[8], gi[8], h0[8], h1[8]; sconv8(g20, wb0, wb1, wb2, bb, gr); sconv8(g21, wb0, wb1, wb2, bb, gi); unpack8(hgr0, h0); unpack8(hgr1, h1);
#pragma unroll
          for (int x = 0; x < 8; ++x) { const f32x2 cv = px[x] * (1.0f / 8192.0f);
              const float z2r = gr[x] * (cv.x + bias1 * zr[x]), z2i = gi[x] * (cv.y + bias1 * zi[x]);
              gr[x] = z2r * siluf_(h0[x]); gi[x] = z2i * siluf_(h1[x]); }
          bf16_t* pvw = (bf16_t*)(ws + WS_PT) + (size_t)(PT_V + c) * MR;
          *(u32x4*)(pvw + r0 + t0) = pack8(gr); *(u32x4*)(pvw + r1 + t0) = pack8(gi); }
        __syncthreads();
    }
}

__device__ __forceinline__ void hy_transpose_item(unsigned char* ws, LAS unsigned char* lds, int item, int tid, int nrows) {
    const int lane = tid & 63, w = tid >> 6;
    const int wi = item * 8 + w;
    const int nrb = nrows / 64;
    if (wi >= nrb * 8) return;
    const int rb = wi >> 3, cb = wi & 7;
    LAS bf16_t* T = (LAS bf16_t*)(lds + w * 8704);
    const bf16_t* src = (const bf16_t*)(ws + WS_PT) + (size_t)(PT_V + cb * 64) * MR + (size_t)rb * 64;
    u32x4 tv[8];
#pragma unroll
    for (int i = 0; i < 8; ++i) { const int c = 8 * i + (lane >> 3), r8 = (lane & 7) * 8; tv[i] = *(const u32x4*)(src + (size_t)c * MR + r8); }
#pragma unroll
    for (int i = 0; i < 8; ++i) { const int c = 8 * i + (lane >> 3), r8 = (lane & 7) * 8;
        LAS unsigned* d = (LAS unsigned*)(T + c * 66 + r8); d[0] = tv[i].x; d[1] = tv[i].y; d[2] = tv[i].z; d[3] = tv[i].w; }
    asm volatile("s_waitcnt lgkmcnt(0)" ::: "memory");
    bf16_t* dst = (bf16_t*)(ws + WS_H) + (size_t)(rb * 64) * D + 512 + cb * 64;
#pragma unroll 4
    for (int i = 0; i < 8; ++i) { const int r = 8 * i + (lane >> 3), c8 = (lane & 7) * 8;
        unsigned short e[8];
#pragma unroll
        for (int x = 0; x < 8; ++x) e[x] = T[(c8 + x) * 66 + r];
        u32x4 o; o.x = e[0] | ((unsigned)e[1] << 16); o.y = e[2] | ((unsigned)e[3] << 16); o.z = e[4] | ((unsigned)e[5] << 16); o.w = e[6] | ((unsigned)e[7] << 16);
        *(u32x4*)(dst + (size_t)r * D + c8) = o; }
    asm volatile("s_waitcnt lgkmcnt(0)" ::: "memory");
}
#ifndef MK_EN
#define MK_EN 0xffff
#endif
#define EN(x) ((MK_EN >> (x)) & 1)
constexpr int PH_PREP = 0, PH_PER_LAYER = 7, PH_FNORM = 1 + 2 * PH_PER_LAYER, N_PHASES = PH_FNORM + 1;

__global__ void __launch_bounds__(NT, 2) fwd_kernel(Args ka) {
    extern __shared__ __attribute__((aligned(16))) unsigned char lds_raw[];
    LAS unsigned char* lds = (LAS unsigned char*)lds_raw;
    const int G = gridDim.x;
    volatile LAS unsigned* bst = (volatile LAS unsigned*)(lds + LDS_CTL_OFF);
    if (threadIdx.x < 16) bst[threadIdx.x] = 0u;
    if (threadIdx.x == 0) { LAS unsigned long long* tab = (LAS unsigned long long*)(lds + LDS_PTR_OFF);
#pragma unroll
        for (int i = 0; i < N_IN; ++i) tab[i] = (unsigned long long)ka.in[i]; }
    __syncthreads();

    XcdBarrier gbar; gbar.bar = (unsigned*)(ka.ws + WS_CTL); gbar.x = 0; gbar.st = bst;
    if (ka.ph_hi - ka.ph_lo > 1) gbar = xcd_barrier_post((unsigned*)(ka.ws + WS_CTL), bst);

#ifdef REP_SUB
    int repmask = 0;
#endif
    for (int ph = ka.ph_lo; ph < ka.ph_hi; ++ph) {
        int tid = threadIdx.x; asm volatile("" : "+v"(tid));
        int bid = blockIdx.x; asm volatile("" : "+s"(bid));
#define LANE_WAVE() int tid2_ = threadIdx.x; asm volatile("" : "+v"(tid2_)); const int lane = tid2_ & 63, wave = __builtin_amdgcn_readfirstlane(tid2_ >> 6)
        unsigned char* ws = ka.ws; asm volatile("" : "+s"(ws));
        float* outp_ = ka.out; asm volatile("" : "+s"(outp_));
        DArgs a; a.in.t = (const LAS unsigned long long*)(lds + LDS_PTR_OFF); a.out = outp_;
        float* MOD = (float*)(ws + WS_MOD);
        if (EN(0) && ph == PH_PREP) {
            for (int it = bid; it < 1048 + 544; it += G) {
                int tid = threadIdx.x; asm volatile("" : "+v"(tid));
                __syncthreads();
                if (it < 768) prep_adaln(a.in[I_C], a.in[I_CCTX], a.in[I_ADAW], a.in[I_ADAB], MOD, it, (LAS float*)lds, tid);
                else if (it < 784) prep_s5b(a, ws, it - 768, tid);
                else if (it >= 1048) prep_rope((f32x2*)(ws + WS_ROPE), it - 1048, tid);
                else { const bool big = it < 1040; const int r = big ? it - 784 : it - 1040, l = big ? (r >> 7) : 0, t0 = (big ? (r & 127) : r) * 32;
                    float* H3o = big ? (float*)(ws + WS_H3) + (size_t)l * 4096 * 64 : (float*)(ws + WS_H3C);
                    bf16_t* H3b = big ? (bf16_t*)(ws + WS_H3B) + (size_t)l * 4096 * 64 : (bf16_t*)nullptr;
                    prep_hymlp(a, H3o, H3b, l, big ? 4096 : 256, t0, lds, tid); }
            }
        } else if (EN(1) && ph == PH_FNORM) {
            const float* fw = a.in[I_FNW]; LANE_WAVE();
            for (int row = bid * NWAVES + wave; row < NLAT; row += G * NWAVES) {
                float* xr = a.out + (size_t)row * D; f32x4 v[8]; float ss = 0.f;
#pragma unroll
                for (int j = 0; j < 8; ++j) { v[j] = ((const f32x4*)xr)[lane + 64 * j]; ss += (v[j].x * v[j].x + v[j].y * v[j].y) + (v[j].z * v[j].z + v[j].w * v[j].w); }
                const float rstd = rsqrtf(wave_sum(ss) * (1.0f / D) + EPS);
#pragma unroll
                for (int j = 0; j < 8; ++j) { const f32x4 w = *(const f32x4*)(fw + 4 * (lane + 64 * j)); ((f32x4*)xr)[lane + 64 * j] = v[j] * rstd * w; }
            }
        } else {
            const int l = (ph - 1) / PH_PER_LAYER, sub = (ph - 1) % PH_PER_LAYER;

            const bool ctx_out = (l == 0);
            const int Mrows = ctx_out ? MR : NLAT;
            if (EN(2) && sub == 0) {
                LANE_WAVE();
                LAS float* scr = (LAS float*)(lds + wave * 8704);
                const int gw = bid * NWAVES + wave, NGW = G * NWAVES;
                constexpr int I_W1 = 32 * (NPAD / 32), I_W2 = 32 * 64, I_W3 = 8 * 16;
                for (int it = (l == 0 ? gw : gw + I_W1); it < I_W1 + I_W2 + I_W3; it += NGW) {
                    int r = it;
                    if (r < I_W1) { const int kb = r / (NPAD / 32), nb = r % (NPAD / 32); transpose_item(a.in[I_WIN] + (size_t)l * D * INW, INW, win_srccol(nb * 32 + (lane & 31)), kb * 64, (bf16_t*)(ws + WS_WIN), D, nb * 32, scr, lane); continue; }
                    r -= I_W1;
                    if (r < I_W2) { const int kb = r / 64, nb = r % 64; transpose_item(a.in[I_WOUT] + (size_t)l * D * D, D, nb * 32 + (lane & 31), kb * 64, (bf16_t*)(ws + WS_WOUT), D, nb * 32, scr, lane); continue; }
                    r -= I_W2;
                    { const int kb = r / 16, nb = r % 16; transpose_item(a.in[I_GLUW] + (size_t)l * 512 * 512, 512, nb * 32 + (lane & 31), kb * 64, (bf16_t*)(ws + WS_GLUW), 512, nb * 32, scr, lane); }
                }
                const float* nw = a.in[I_NORMW] + (size_t)l * D;
                for (int row = gw; row < MR; row += NGW) {
                    const float* xr; int v;
                    if (row < NLAT) { xr = (l == 0 ? a.in[I_X] : a.out) + (size_t)row * D; v = row >> 12; }
                    else { xr = (l == 0 ? a.in[I_CTX] : (const float*)(ws + WS_XC1)) + (size_t)(row - NLAT) * D; v = 4; }
                    norm_row(xr, nw, MOD + (size_t)(l * 5 + v) * ADA, (bf16_t*)(ws + WS_H) + (size_t)row * D, lane);
                }
                __syncthreads();
                const int nfilt = ctx_out ? 1024 : 0;
                for (int it = bid; it < nfilt; it += G) { int tid = threadIdx.x; asm volatile("" : "+v"(tid)); __syncthreads(); if (it < 512) filt_item2(a, ws, lds, l, it, tid); else filt_ctx_item(a, ws, lds, it - 512, tid);
#if defined(REP_ITEM) && REP_ITEM == 10
                    __syncthreads(); if (it < 512) filt_item2(a, ws, lds, l, it, tid);
#endif
                }
            } else if (EN(3) && sub == 1) {
                pg8::Gemm g{(const bf16_t*)(ws + WS_H), (const bf16_t*)(ws + WS_WIN), MR, NPAD, D}; pg8::StaticOrder S; S.init(MR, NPAD, G, bid);
                EpiInProj E{(bf16_t*)(ws + WS_P), (bf16_t*)(ws + WS_PT), (float*)(ws + WS_LR), (const float*)(ws + WS_ROPE)};
                { pg8::InProjOrder S1; S1.init(ctx_out ? 0 : 1, G, bid); pg8::gemm_phase<EpiInProj, pg8::InProjOrder, true, true>(lds, g, S1, E, tid); }
            } else if (EN(5) && sub == 2) {
                const int nit = ctx_out ? 3200 : 2688;
                for (int it = bid; it < nit; it += G) {
                    int tid = threadIdx.x; asm volatile("" : "+v"(tid));
                    __syncthreads();
#ifdef REP_ITEM
                    for (int rep_ = 0; rep_ < 2; ++rep_) { const int ty_ = it < 544 ? 0 : it < 1088 ? 1 : it < 2176 ? 2 : it < 2688 ? 3 : 4; if (rep_ && ty_ != REP_ITEM) break; if (rep_) __syncthreads(); asm volatile("" : "+v"(tid));
#endif
                    if (it < 544) s5_item<false>(a, ws, lds, l, it, tid);
                    else if (it < 1088) ret_passA(ws, lds, it - 544, tid);
                    else if (it < 2176) gla_passA(a, ws, lds, l, it - 1088, tid);
                    else if (it < 2688) hyena_item2(a, ws, lds, l, it - 2176, tid);
                    else hyena_ctx_item(a, ws, lds, it - 2688, tid);
#ifdef REP_ITEM
                    }
#endif
                }
            } else if (EN(9) && sub == 3) {
                for (int it = bid; it < 256; it += G) { int tid = threadIdx.x; asm volatile("" : "+v"(tid)); __syncthreads(); hy_transpose_item(ws, lds, it, tid, NLAT); }
                for (int it = bid; it < 224; it += G) { int tid = threadIdx.x; asm volatile("" : "+v"(tid)); __syncthreads();
                    if (it < 128) ret_passB(ws, it * NT + tid);
                    else if (it < 192) gla_passB(ws, lds, it - 128, tid);
                    else s5_passB(ws, l, (it - 192) * NT + tid); }
            } else if (EN(6) && sub == 4) {
                const int nsc = ctx_out ? 544 : 512, nrc = ctx_out ? 16 * RNCH : 16 * 32, ngc = ctx_out ? 16 * GNCH : 16 * 64;
                for (int it = bid; it < nsc + nrc + ngc; it += G) { int tid = threadIdx.x; asm volatile("" : "+v"(tid)); __syncthreads();
#ifdef REP_ITEM
                    for (int rep_ = 0; rep_ < 2; ++rep_) { const int ty_ = it < nsc ? 20 : it < nsc + nrc ? 21 : 22; if (rep_ && ty_ != REP_ITEM) break; if (rep_) __syncthreads(); asm volatile("" : "+v"(tid));
#endif
                    if (it < nsc) { const int item = ctx_out ? it : (it >> 7) * (SNCH * 2) + 8 + (it & 127); s5_item<true>(a, ws, lds, l, item, tid); }
                    else if (it < nsc + nrc) { const int r = it - nsc; const int item = ctx_out ? r : (r >> 5) * RNCH + 2 + (r & 31); ret_passC(a, ws, lds, l, item, tid); }
                    else { const int r = it - nsc - nrc; const int item = ctx_out ? r : (r >> 6) * GNCH + 4 + (r & 63); gla_passC(a, ws, lds, l, item, tid); }
#ifdef REP_ITEM
                    }
#endif
                }
            } else if (EN(7) && sub == 5) {
                pg8::Gemm g{(const bf16_t*)(ws + WS_KF), (const bf16_t*)(ws + WS_GLUW), Mrows, 512, 512}; pg8::StaticOrder S; S.init(Mrows, 512, G, bid);
                EpiGlu E{(const bf16_t*)(ws + WS_KF) + OBSZ, (bf16_t*)(ws + WS_H), a.in[I_GLUB] + (size_t)l * 512};
                pg8::gemm_phase<EpiGlu, pg8::StaticOrder, true, true>(lds, g, S, E, tid);
                if (l == 0 && bid >= 136) {
                    LANE_WAVE(); LAS float* scr = (LAS float*)(lds + wave * 8704);
                    for (int r = (bid - 136) * NWAVES + wave; r < 32 * (NPAD / 32); r += (G - 136) * NWAVES) { const int kb = r / (NPAD / 32), nb = r % (NPAD / 32);
                        transpose_item(a.in[I_WIN] + (size_t)1 * D * INW, INW, win_srccol(nb * 32 + (lane & 31)), kb * 64, (bf16_t*)(ws + WS_WIN), D, nb * 32, scr, lane); }
                }
            } else if (EN(8)) {
                pg8::Gemm g{(const bf16_t*)(ws + WS_H), (const bf16_t*)(ws + WS_WOUT), Mrows, D, D}; pg8::StaticOrder S; S.init(Mrows, D, G, bid);
                EpiOut E{l == 0 ? a.in[I_X] : a.out, a.in[I_CTX], a.out, (float*)(ws + WS_XC1), MOD + (size_t)l * 5 * ADA};
                pg8::gemm_phase<EpiOut, pg8::StaticOrder, true, true>(lds, g, S, E, tid);
                if (l == 0 && bid >= 32) {
                    for (int it = bid - 32; it < 512; it += G - 32) { int tid2 = threadIdx.x; asm volatile("" : "+v"(tid2)); __syncthreads(); filt_item2(a, ws, lds, 1, it, tid2); }
                }
            }
        }
#ifdef REP_SUB
        if (ph != PH_PREP && ph != PH_FNORM && ((ph - 1) % PH_PER_LAYER) == REP_SUB && !((repmask >> ((ph - 1) / PH_PER_LAYER)) & 1)) { repmask |= 1 << ((ph - 1) / PH_PER_LAYER); xcd_barrier(gbar); --ph; continue; }
#endif
        if (ph + 1 < ka.ph_hi) xcd_barrier(gbar);
    }
}

#ifndef MK_LAUNCH_PER_PHASE
#define MK_LAUNCH_PER_PHASE 0
#endif
extern "C" void kernel_launch(void* const* d_in, const int* in_sizes, int n_in, void* d_out, int out_size, void* d_ws, size_t ws_size, hipStream_t stream) {
    static int grid = 0;
    if (grid == 0) {
        if (n_in != N_IN || out_size != NLAT * D || ws_size < WS_END2) { fprintf(stderr, "kernel_launch: unexpected shapes (n_in %d, out %d, ws %zu < %zu); nothing launched\n", n_in, out_size, ws_size, (size_t)WS_END2); grid = -1; return; }
        int dev = 0, cus = 0, per_cu = 0;
        if (hipGetDevice(&dev) != hipSuccess || hipDeviceGetAttribute(&cus, hipDeviceAttributeMultiprocessorCount, dev) != hipSuccess) { grid = -1; return; }
        if (hipFuncSetAttribute((const void*)fwd_kernel, hipFuncAttributeMaxDynamicSharedMemorySize, LDS_BYTES) != hipSuccess) { fprintf(stderr, "kernel_launch: hipFuncSetAttribute failed\n"); grid = -1; return; }
        if (hipOccupancyMaxActiveBlocksPerMultiprocessor(&per_cu, (const void*)fwd_kernel, NT, LDS_BYTES) != hipSuccess || per_cu < 1) { fprintf(stderr, "kernel_launch: occupancy query says %d blocks per CU\n", per_cu); per_cu = 1; }
        (void)hipGetLastError();
        grid = cus;
    }
    if (grid < 0) return;
    (void)hipMemsetAsync((char*)d_ws + WS_CTL, 0, WS_ZERO_BYTES, stream);
    Args a{};
    for (int i = 0; i < N_IN; ++i) a.in[i] = (const float*)d_in[i];
    a.out = (float*)d_out; a.ws = (unsigned char*)d_ws;
#if MK_LAUNCH_PER_PHASE
    for (int ph = 0; ph < N_PHASES; ++ph) {
        a.ph_lo = ph; a.ph_hi = ph + 1;
        hipLaunchKernelGGL(fwd_kernel, dim3(grid), dim3(NT), LDS_BYTES, stream, a);
    }
#else
    a.ph_lo = 0; a.ph_hi = N_PHASES;
    void* args[] = {&a};
    hipError_t e = hipLaunchCooperativeKernel((const void*)fwd_kernel, dim3(grid), dim3(NT), args, LDS_BYTES, stream);
    if (e != hipSuccess) fprintf(stderr, "kernel_launch: cooperative launch failed: %s (grid %d)\n", hipGetErrorString(e), grid);
#endif
}
```

```cpp
#include <hip/hip_runtime.h>
#include <hip/hip_cooperative_groups.h>
#include <cstdio>
#include <cstdint>
namespace cg = cooperative_groups;

#define LAS __attribute__((address_space(3)))
typedef unsigned short bf16_t;
typedef float f32x4 __attribute__((ext_vector_type(4)));
typedef float f32x2 __attribute__((ext_vector_type(2)));
typedef unsigned u32x4 __attribute__((ext_vector_type(4)));
typedef unsigned u32x2 __attribute__((ext_vector_type(2)));

constexpr int D = 2048, NB = 4, SEQL = 4096, LC = 256, NLAT = NB * SEQL, NCTX = NB * LC, MR = NLAT + NCTX;
constexpr int BR = 512, INW = 6688, NPAD = 6912, LDP = 4608, ADA = 3 * D;
constexpr int NT = 512, NWAVES = 8;
constexpr float EPS = 1e-6f;
constexpr int PC_S5U = 0, PC_S5G = 512, PC_RQ = 1024, PC_RK = 1536, PC_RV = 2048, PC_RG = 2560, PC_GQ = 3072, PC_GK = 3328, PC_GV = 3584, PC_GG = 4096;
constexpr int PT_V = 0, PT_G1 = 512, PT_G2 = 1024, PT_HG = 1536;
constexpr int FFTN = 8192;

enum { I_X = 0, I_C, I_CTX, I_CCTX, I_NORMW, I_ADAW, I_ADAB, I_WIN, I_WOUT, I_S5ARE, I_S5AIM, I_S5LDT, I_S5BRE, I_S5BIM, I_S5CRE, I_S5CIM,
       I_S5D, I_GLUW, I_GLUB, I_HCW, I_HCB, I_HW1, I_HB1, I_HF1, I_HW2, I_HB2, I_HF2, I_HW3, I_HB3, I_HF3, I_HW4, I_HBIAS, I_RNW, I_GGW, I_GGB, I_GNW, I_FNW, N_IN };

constexpr size_t al256(size_t x) { return (x + 255) & ~(size_t)255; }
constexpr size_t WS_CTL  = 0;
constexpr size_t WS_MOD  = WS_CTL + 65536;
constexpr size_t WS_ZERO_BYTES = 65536 + al256((size_t)2 * 5 * ADA * 4);
constexpr size_t WS_S5AB = WS_MOD + al256((size_t)2 * 5 * ADA * 4);
constexpr size_t WS_S5BT = WS_S5AB + (size_t)2 * 2 * 32 * 64 * 8;
constexpr size_t WS_H3   = WS_S5BT + (size_t)1048576 + 65536;
constexpr size_t WS_H3C  = WS_H3 + (size_t)2 * 4096 * 64 * 4;
constexpr size_t WS_KC   = WS_H3C + (size_t)256 * 64 * 4;
constexpr size_t WS_LR   = WS_KC + (size_t)2 * 512 * 512 * 4;
constexpr size_t WS_XC1  = WS_LR + (size_t)MR * 32 * 4;
constexpr size_t WS_WOUT = WS_XC1 + (size_t)NCTX * D * 4;
constexpr size_t WS_GLUW = WS_WOUT + (size_t)D * D * 2;
constexpr size_t WS_WIN  = WS_GLUW + (size_t)512 * 512 * 2;
constexpr size_t WS_H    = WS_WIN + (size_t)NPAD * D * 2;
constexpr size_t WS_P    = WS_H + (size_t)MR * D * 2;
constexpr size_t WS_PT   = WS_P + (size_t)MR * LDP * 2;
constexpr size_t WS_KF   = WS_PT + (size_t)2048 * MR * 2;
constexpr size_t WS_OB   = WS_KF + (size_t)2 * 512 * FFTN * 8;
constexpr size_t WS_END  = WS_OB + (size_t)6 * MR * 512 * 2;
constexpr size_t OBSZ = (size_t)MR * 512;

constexpr int LDS_CTL_OFF = 131072 + 2048;
constexpr int LDS_PTR_OFF = LDS_CTL_OFF + 64;
constexpr int LDS_BYTES = LDS_PTR_OFF + 320;

typedef __bf16 hwbf16x2 __attribute__((ext_vector_type(2)));
__device__ __forceinline__ unsigned pk2(float lo, float hi) { const f32x2 v = {lo, hi}; return __builtin_bit_cast(unsigned, __builtin_convertvector(v, hwbf16x2)); }
__device__ __forceinline__ unsigned f2bf(float f) { return pk2(f, 0.f) & 0xffffu; }
__device__ __forceinline__ float bf2f(bf16_t b) { return __uint_as_float((unsigned)b << 16); }
__device__ __forceinline__ float bflo(unsigned w) { return __uint_as_float(w << 16); }
__device__ __forceinline__ float bfhi(unsigned w) { return __uint_as_float(w & 0xffff0000u); }
__device__ __forceinline__ void unpack8(const u32x4 r, float (&f)[8]) { f[0] = bflo(r.x); f[1] = bfhi(r.x); f[2] = bflo(r.y); f[3] = bfhi(r.y); f[4] = bflo(r.z); f[5] = bfhi(r.z); f[6] = bflo(r.w); f[7] = bfhi(r.w); }
__device__ __forceinline__ u32x4 pack8(const float (&f)[8]) { u32x4 o; o.x = pk2(f[0], f[1]); o.y = pk2(f[2], f[3]); o.z = pk2(f[4], f[5]); o.w = pk2(f[6], f[7]); return o; }
__device__ __forceinline__ float sigmoidf_(float x) { return 1.0f / (1.0f + __expf(-x)); }
__device__ __forceinline__ float siluf_(float x) { return x * sigmoidf_(x); }
__device__ __forceinline__ float gelu_tanh(float x) { const float u = 0.7978845608028654f * (x + 0.044715f * x * x * x); return 0.5f * x * (1.0f + tanhf(u)); }
__device__ __forceinline__ float wave_sum(float v) {
#pragma unroll
    for (int o = 1; o < 64; o <<= 1) v += __shfl_xor(v, o);
    return v;
}
#define LDS_WAIT() asm volatile("s_waitcnt lgkmcnt(0)" ::: "memory")

struct Args { const float* in[N_IN]; float* out; unsigned char* ws; int ph_lo, ph_hi; };
struct InTab { const LAS unsigned long long* t;
    __device__ __forceinline__ const float* operator[](int i) const { const unsigned long long v = t[i];
        const unsigned lo = __builtin_amdgcn_readfirstlane((unsigned)v), hi = __builtin_amdgcn_readfirstlane((unsigned)(v >> 32)); return (const float*)(__attribute__((address_space(1))) const float*)(((unsigned long long)hi << 32) | lo); } };
struct DArgs { InTab in; float* out; };

#define XB_TMO      128
#define XB_XCNT(j)  (256  + 64 * (j))
#define XB_XSUB(j)  (1280 + 64 * (j))
#define XB_XGEN(j)  (2304 + 64 * (j))
#define XB_TOP      3328
#define XB_TOPGEN   3392
#define XCD_BAR_WORDS 3456
#define XB_SPIN_CAP (1u << 22)
__device__ __forceinline__ unsigned xb_ld(unsigned* p)              { return __hip_atomic_load(p, __ATOMIC_RELAXED, __HIP_MEMORY_SCOPE_AGENT); }
__device__ __forceinline__ unsigned xb_add(unsigned* p, unsigned v) { return __hip_atomic_fetch_add(p, v, __ATOMIC_RELAXED, __HIP_MEMORY_SCOPE_AGENT); }
__device__ __forceinline__ unsigned xb_xcc_id() { return (unsigned)__builtin_amdgcn_s_getreg((3 << 11) | 20) & 0xFu; }
#define XB_SPIN(cond, bar) do { unsigned _sp = 0; while (cond) { __builtin_amdgcn_s_sleep(1); \
    if ((++_sp & 255u) == 0u) { if (xb_ld(&(bar)[XB_TMO])) break; if (_sp > XB_SPIN_CAP) { atomicAdd(&(bar)[XB_TMO], 1u); break; } } } } while (0)
struct XcdBarrier { unsigned* bar; unsigned x; volatile LAS unsigned* st; };
__device__ __forceinline__ XcdBarrier xcd_barrier_post(unsigned* bar, volatile LAS unsigned* st) {
    XcdBarrier b; b.bar = bar; b.x = xb_xcc_id(); b.st = st;
    if (threadIdx.x == 0) (void)xb_add(&bar[XB_XCNT(b.x)], 1u);
    return b;
}
__device__ __forceinline__ void xcd_barrier_complete(unsigned* bar, unsigned x, unsigned& nloc, unsigned& nx) {
    const unsigned G = gridDim.x * gridDim.y * gridDim.z;
    unsigned sum, cnt, mine, sp = 0u;
    for (;;) {
        sum = 0u; cnt = 0u; mine = 0u;
#pragma unroll
        for (unsigned j = 0; j < 16; ++j) { const unsigned c = xb_ld(&bar[XB_XCNT(j)]); sum += c; cnt += (c > 0u) ? 1u : 0u; mine = (j == x) ? c : mine; }
        if (sum == G) break;
        __builtin_amdgcn_s_sleep(1);
        if ((++sp & 255u) == 0u) { if (xb_ld(&bar[XB_TMO])) break; if (sp > XB_SPIN_CAP) { atomicAdd(&bar[XB_TMO], 1u); break; } }
    }
    nloc = mine > 0u ? mine : 1u; nx = cnt > 0u ? cnt : 1u;
}
__device__ __forceinline__ void xcd_barrier(const XcdBarrier& b) {
    asm volatile("s_waitcnt vmcnt(0)" ::: "memory");
    __syncthreads();
    if (threadIdx.x == 0) {
        unsigned* bar = b.bar;
        __builtin_amdgcn_s_waitcnt(0);
        unsigned nloc = b.st[0], nx = b.st[1];
        if (nloc == 0u) { xcd_barrier_complete(bar, b.x, nloc, nx); b.st[0] = nloc; b.st[1] = nx; }
        const unsigned old = xb_add(&bar[XB_XSUB(b.x)], 1u);
        const unsigned gen = old / nloc;
        if (old + 1u == (gen + 1u) * nloc) {
            __builtin_amdgcn_fence(__ATOMIC_RELEASE, "agent");
            asm volatile("s_waitcnt vmcnt(0)" ::: "memory");
            const unsigned og = xb_add(&bar[XB_TOP], 1u);
            const unsigned tg = og / nx;
            if (og + 1u == (tg + 1u) * nx) xb_add(&bar[XB_TOPGEN], 1u);
            else XB_SPIN(xb_ld(&bar[XB_TOPGEN]) == tg, bar);
            __builtin_amdgcn_fence(__ATOMIC_ACQUIRE, "agent");
            xb_add(&bar[XB_XGEN(b.x)], 1u);
            asm volatile("s_waitcnt vmcnt(0)" ::: "memory");
        } else {
            XB_SPIN(xb_ld(&bar[XB_XGEN(b.x)]) == gen, bar);
            __builtin_amdgcn_fence(__ATOMIC_ACQUIRE, "agent");
            asm volatile("s_waitcnt vmcnt(0)" ::: "memory");
        }
    }
    __syncthreads();
}
namespace pg8 {
#define PG8_LAS __attribute__((address_space(3)))
typedef unsigned short bf16_t;
typedef short bf16x8 __attribute__((ext_vector_type(8)));
typedef float f32x4 __attribute__((ext_vector_type(4)));
typedef unsigned u32x4 __attribute__((ext_vector_type(4)));
constexpr int BM = 256, BK = 64, HALF = 128, HTB = HALF * BK * 2, STAGE_BYTES = 8 * HTB, NXCD = 8, WGM = 8;

__host__ __device__ __forceinline__ int lds_byte(int r, int c) { const int st = (r >> 4) * 2 + (c >> 5), rr = r & 15, cc = c & 31, ob = rr * 64 + cc * 2; return st * 1024 + (ob ^ (((ob >> 9) & 1) << 5)); }
__host__ __device__ __forceinline__ void stage_rc(int b, int& R, int& C) { const int st = b / 1024, sb = b % 1024, swz = sb ^ (((sb >> 9) & 1) << 5); R = (st >> 1) * 16 + swz / 64; C = (st & 1) * 32 + (swz % 64) / 2; }
__host__ __device__ __forceinline__ int perm32(int rho) { const int n = rho >> 4, i = rho & 15; return 8 * (i >> 2) + 4 * n + (i & 3); }

struct Unit { int pm, pn; };
struct Gemm { const bf16_t* A; const bf16_t* Bt; int M, N, K; };

struct StaticOrder {
    int nM, nN, nwg, G, c;
    __host__ __device__ void init(int M, int N, int G_, int c_) { nM = M / BM; nN = N / BM; nwg = nM * nN; G = G_; c = c_; }
    __host__ __device__ bool next(int i, Unit& u) const {
        const long L = (long)i * G + c; if (L >= nwg) return false;
        int wgid = (int)L; { const int q = nwg / NXCD, r = nwg % NXCD, xcd = wgid % NXCD, off = wgid / NXCD; wgid = (xcd < r ? xcd * (q + 1) : r * (q + 1) + (xcd - r) * q) + off; }
        const int nig = WGM * nN, gid = wgid / nig, fm = gid * WGM, gsz = (nM - fm) < WGM ? (nM - fm) : WGM;
        u.pm = fm + ((wgid % nig) % gsz); u.pn = (wgid % nig) / gsz; return true;
    }
    __device__ __forceinline__ void a_ready(const Unit&) const {}
    __device__ __forceinline__ void done(const Unit&) const {}
};


struct InProjOrder {
    StaticOrder base; int G, c, last;
    __host__ __device__ void init(int last_, int G_, int c_) { last = last_; base.init((last_ ? 64 : 68) * 256, 27 * 256, G_, c_); G = G_; c = c_; }
    __host__ __device__ bool next(int i, Unit& u) const {
        const long L = (long)i * G + c;
        if (!last || L < 1728) return base.next(i, u);
        if (L >= 1768) return false;
        const int k = (int)L - 1728, j = k % 10; u.pm = 64 + k / 10;
        u.pn = j == 0 ? 0 : j == 1 ? 1 : j == 2 ? 14 : j == 3 ? 15 : j == 4 ? 16 : j == 5 ? 17 : j == 6 ? 21 : j == 7 ? 22 : j == 8 ? 23 : 26;
        return true;
    }
    __device__ __forceinline__ void a_ready(const Unit&) const {}
    __device__ __forceinline__ void done(const Unit&) const {}
};
template <class Epi, class Sched, bool ALIGN_EPI = false, bool SP2 = false>
__device__ __forceinline__ void gemm_phase(PG8_LAS unsigned char* lds, const Gemm g, const Sched& S, const Epi& E, const int tid) {
    const int wid = __builtin_amdgcn_readfirstlane(tid >> 6), lane = tid & 63, wr = wid >> 2, wc = wid & 3, fr = lane & 15, fq = lane >> 4;
    const int K = g.K, nt = K / BK;
    unsigned voffA[2], voffB[2];
#pragma unroll
    for (int i = 0; i < 2; ++i) { int R, C; stage_rc(tid * 16 + i * 8192, R, C); const int Rb = Epi::PERM ? ((R & ~31) + perm32(R & 31)) : R;
        voffA[i] = (unsigned)(R * K + C) * 2u; voffB[i] = (unsigned)(Rb * K + C) * 2u; }
    const size_t kstep = (size_t)(BK * 2);
    const size_t hstep = (size_t)HALF * K * 2;
    const size_t tstep = 2 * hstep;
    const unsigned ldsw = (unsigned)wid * 1024u;
    const int aoff = lds_byte(wr * 64 + fr, fq * 8), boff = lds_byte(wc * 32 + fr, fq * 8);
#define PG8_SA(b, h) (((b) * 2 + (h)) * HTB)
#define PG8_SB(b, h) ((4 + (b) * 2 + (h)) * HTB)
#define PG8_STAGE(bufoff, gbase, voff) do { _Pragma("unroll") for (int _i = 0; _i < 2; ++_i) \
        __builtin_amdgcn_global_load_lds((const unsigned*)((const char*)(gbase) + (voff)[_i]), (PG8_LAS unsigned*)(lds + (bufoff) + ldsw + _i * 8192), 16, 0, 0); } while (0)
#define PG8_LDA(dst, b, h) do { _Pragma("unroll") for (int m = 0; m < 4; ++m) _Pragma("unroll") for (int k = 0; k < 2; ++k) dst[m][k] = *(const PG8_LAS bf16x8*)(lds + PG8_SA(b, h) + aoff + m * 2048 + k * 1024); } while (0)
#define PG8_LDB(dst, b, h) do { _Pragma("unroll") for (int n = 0; n < 2; ++n) _Pragma("unroll") for (int k = 0; k < 2; ++k) dst[n][k] = *(const PG8_LAS bf16x8*)(lds + PG8_SB(b, h) + boff + n * 2048 + k * 1024); } while (0)
#define PG8_MMA(ai, bj, At, Bt) do { __builtin_amdgcn_s_setprio(1); _Pragma("unroll") for (int m = 0; m < 4; ++m) _Pragma("unroll") for (int n = 0; n < 2; ++n) _Pragma("unroll") for (int k = 0; k < 2; ++k) \
        acc[ai][bj][m][n] = __builtin_amdgcn_mfma_f32_16x16x32_bf16(Bt[n][k], At[m][k], acc[ai][bj][m][n], 0, 0, 0); __builtin_amdgcn_s_setprio(0); } while (0)
#define PG8_WAIT_V(n) asm volatile("s_waitcnt vmcnt(" #n ")" ::: "memory")
#define PG8_WAIT_L(n) asm volatile("s_waitcnt lgkmcnt(" #n ")" ::: "memory")
#define PG8_BAR __builtin_amdgcn_s_barrier()
#define PG8_SCHED __builtin_amdgcn_sched_barrier(0)
    Unit cur, nxt; int ui = 0;
    if (!S.next(0, cur)) return;
    f32x4 acc[2][2][4][2];
#pragma unroll
    for (int a = 0; a < 2; ++a)
#pragma unroll
        for (int b = 0; b < 2; ++b)
#pragma unroll
            for (int m = 0; m < 4; ++m)
#pragma unroll
                for (int n = 0; n < 2; ++n) acc[a][b][m][n] = (f32x4){0.f, 0.f, 0.f, 0.f};
    bf16x8 At[4][2], B0[2][2], B1[2][2];
    const char* cA = (const char*)g.A + (size_t)cur.pm * tstep; const char* cB = (const char*)g.Bt + (size_t)cur.pn * tstep;
    S.a_ready(cur);
    if constexpr (SP2) {
        PG8_STAGE(PG8_SB(0, 0), cB, voffB); PG8_STAGE(PG8_SB(0, 1), cB + hstep, voffB); PG8_STAGE(PG8_SA(0, 0), cA, voffA); PG8_STAGE(PG8_SA(0, 1), cA + hstep, voffA);
        if (wr == 1) PG8_BAR;
        PG8_WAIT_V(2); PG8_BAR;
        PG8_STAGE(PG8_SB(1, 0), cB + kstep, voffB); PG8_STAGE(PG8_SA(1, 0), cA + kstep, voffA); PG8_STAGE(PG8_SB(1, 1), cB + hstep + kstep, voffB);
        PG8_WAIT_V(6); PG8_BAR;
    } else {
        PG8_STAGE(PG8_SB(0, 0), cB, voffB); PG8_STAGE(PG8_SA(0, 0), cA, voffA); PG8_STAGE(PG8_SB(0, 1), cB + hstep, voffB); PG8_STAGE(PG8_SA(0, 1), cA + hstep, voffA);
        if (wr == 1) PG8_BAR;
        PG8_WAIT_V(4); PG8_BAR;
        PG8_STAGE(PG8_SB(1, 0), cB + kstep, voffB); PG8_STAGE(PG8_SA(1, 0), cA + kstep, voffA); PG8_STAGE(PG8_SB(1, 1), cB + hstep + kstep, voffB);
        PG8_WAIT_V(6); PG8_BAR;
    }
    for (;;) {
        const bool has_next = S.next(ui + 1, nxt);
        const char* nA = has_next ? (const char*)g.A + (size_t)nxt.pm * tstep : cA; const char* nB = has_next ? (const char*)g.Bt + (size_t)nxt.pn * tstep : cB;
        for (int t = 0; t < nt; t += 2) {
            const bool last = (t == nt - 2);
            const char* a1 = cA + (size_t)(t + 1) * kstep;
            const char* a2 = last ? nA : cA + (size_t)(t + 2) * kstep; const char* b2 = last ? nB : cB + (size_t)(t + 2) * kstep;
            const char* a3 = a2 + kstep; const char* b3 = b2 + kstep;
            if (last && has_next) S.a_ready(nxt);
            if constexpr (SP2) {
            PG8_LDB(B0, 0, 0); PG8_LDB(B1, 0, 1); PG8_SCHED; PG8_LDA(At, 0, 0); PG8_STAGE(PG8_SA(1, 1), a1 + hstep, voffA);
            PG8_WAIT_V(8); PG8_WAIT_L(0); PG8_BAR; PG8_MMA(0, 0, At, B0); PG8_MMA(0, 1, At, B1); PG8_BAR; PG8_SCHED;
            PG8_LDA(At, 0, 1); PG8_STAGE(PG8_SB(0, 0), b2, voffB); PG8_STAGE(PG8_SB(0, 1), b2 + hstep, voffB); PG8_STAGE(PG8_SA(0, 0), a2, voffA);
            PG8_WAIT_V(8); PG8_WAIT_L(0); PG8_BAR; PG8_MMA(1, 0, At, B0); PG8_MMA(1, 1, At, B1); PG8_BAR; PG8_SCHED;
            PG8_LDB(B0, 1, 0); PG8_LDB(B1, 1, 1); PG8_SCHED; PG8_LDA(At, 1, 0); PG8_STAGE(PG8_SA(0, 1), a2 + hstep, voffA);
            PG8_WAIT_V(8); PG8_WAIT_L(0); PG8_BAR; PG8_MMA(0, 0, At, B0); PG8_MMA(0, 1, At, B1); PG8_BAR; PG8_SCHED;
            PG8_LDA(At, 1, 1); PG8_STAGE(PG8_SB(1, 0), b3, voffB); PG8_STAGE(PG8_SB(1, 1), b3 + hstep, voffB); PG8_STAGE(PG8_SA(1, 0), a3, voffA);
            PG8_WAIT_V(8); PG8_WAIT_L(0); PG8_BAR; PG8_MMA(1, 0, At, B0); PG8_MMA(1, 1, At, B1); PG8_BAR; PG8_SCHED;
            } else {
            PG8_LDB(B0, 0, 0); PG8_SCHED; PG8_LDA(At, 0, 0); PG8_STAGE(PG8_SA(1, 1), a1 + hstep, voffA);
            PG8_WAIT_L(8); PG8_BAR; PG8_WAIT_L(0); PG8_MMA(0, 0, At, B0); PG8_BAR; PG8_SCHED;
            PG8_LDB(B1, 0, 1); PG8_STAGE(PG8_SB(0, 0), b2, voffB);
            PG8_BAR; PG8_WAIT_L(0); PG8_MMA(0, 1, At, B1); PG8_BAR;
            PG8_LDA(At, 0, 1); PG8_STAGE(PG8_SA(0, 0), a2, voffA);
            PG8_BAR; PG8_WAIT_L(0); PG8_MMA(1, 0, At, B0); PG8_BAR; PG8_SCHED;
            PG8_STAGE(PG8_SB(0, 1), b2 + hstep, voffB);
            PG8_WAIT_V(6); PG8_BAR; PG8_MMA(1, 1, At, B1); PG8_BAR;
            PG8_LDB(B0, 1, 0); PG8_SCHED; PG8_LDA(At, 1, 0); PG8_STAGE(PG8_SA(0, 1), a2 + hstep, voffA);
            PG8_WAIT_L(8); PG8_BAR; PG8_WAIT_L(0); PG8_MMA(0, 0, At, B0); PG8_BAR; PG8_SCHED;
            PG8_LDB(B1, 1, 1); PG8_STAGE(PG8_SB(1, 0), b3, voffB);
            PG8_BAR; PG8_WAIT_L(0); PG8_MMA(0, 1, At, B1); PG8_BAR;
            PG8_LDA(At, 1, 1); PG8_STAGE(PG8_SA(1, 0), a3, voffA);
            PG8_BAR; PG8_WAIT_L(0); PG8_MMA(1, 0, At, B0); PG8_BAR; PG8_SCHED;
            PG8_STAGE(PG8_SB(1, 1), b3 + hstep, voffB);
            PG8_WAIT_V(6); PG8_BAR; PG8_MMA(1, 1, At, B1); PG8_BAR;
            }
        }
        if constexpr (ALIGN_EPI) { if (wr == 0) PG8_BAR; }
        { int fr_ = fr, fq_ = fq; asm volatile("" : "+v"(fr_), "+v"(fq_));
          E(acc, cur, wr, wc, fr_, fq_); } S.done(cur);
        if (!has_next) break;
#pragma unroll
        for (int a = 0; a < 2; ++a)
#pragma unroll
            for (int b = 0; b < 2; ++b)
#pragma unroll
                for (int m = 0; m < 4; ++m)
#pragma unroll
                    for (int n = 0; n < 2; ++n) acc[a][b][m][n] = (f32x4){0.f, 0.f, 0.f, 0.f};
        cur = nxt; cA = nA; cB = nB; ++ui;
        if constexpr (ALIGN_EPI) { if (wr == 1) PG8_BAR; }
    }
    PG8_WAIT_V(0);
    if constexpr (!ALIGN_EPI) { if (wr == 0) PG8_BAR; }
    PG8_BAR;
#undef PG8_SA
#undef PG8_SB
#undef PG8_STAGE
#undef PG8_LDA
#undef PG8_LDB
#undef PG8_MMA
#undef PG8_WAIT_V
#undef PG8_WAIT_L
#undef PG8_BAR
#undef PG8_SCHED
}
}
__device__ __forceinline__ void prep_adaln(const float* c, const float* cctx, const float* adaw, const float* adab, float* MOD, int it, LAS float* sv, int tid) {
    const int l = it / 384, r = it % 384, ntile = r >> 5, ks = r & 31, k0 = ks * 64;
    if (tid < 320) { const int v = tid >> 6, k = tid & 63; const float cv = v < 4 ? c[v * D + k0 + k] : cctx[k0 + k]; sv[tid] = cv / (1.0f + expf(-cv)); }
    __syncthreads();
    const int n = ntile * 512 + tid; const float* w = adaw + (size_t)l * D * ADA + (size_t)k0 * ADA + n;
    float acc[5] = {0.f, 0.f, 0.f, 0.f, 0.f};
#pragma unroll 1
    for (int k0_ = 0; k0_ < 64; k0_ += 32) {
        float wv[32];
#pragma unroll
        for (int k = 0; k < 32; ++k) wv[k] = w[(size_t)(k0_ + k) * ADA];
#pragma unroll
        for (int k = 0; k < 32; ++k) {
#pragma unroll
            for (int v = 0; v < 5; ++v) acc[v] += sv[v * 64 + k0_ + k] * wv[k]; } }
    if (ks == 0) { const float bb = adab[l * ADA + n];
#pragma unroll
        for (int v = 0; v < 5; ++v) acc[v] += bb; }
#pragma unroll
    for (int v = 0; v < 5; ++v) atomicAdd(MOD + (size_t)(l * 5 + v) * ADA + n, acc[v]);
    __syncthreads();
}

__device__ __forceinline__ void prep_s5(const DArgs& a, unsigned char* ws, int it, int tid) {
    const int idx = it * 512 + tid;
    const float a_re = a.in[I_S5ARE][idx], a_im = a.in[I_S5AIM][idx], ldt = a.in[I_S5LDT][idx >> 6];
    const float dt = expf(ldt), mag = expf(a_re * dt);
    float sn, cs; sincosf(a_im * dt, &sn, &cs);
    const float ab_re = mag * cs, ab_im = mag * sn, den = a_re * a_re + a_im * a_im, nr = ab_re - 1.0f;
    const float co_re = (nr * a_re + ab_im * a_im) / den, co_im = (ab_im * a_re - nr * a_im) / den;
    ((f32x2*)(ws + WS_S5AB))[idx] = (f32x2){ab_re, ab_im};
    const float* bre = a.in[I_S5BRE] + (size_t)idx * 16; const float* bim = a.in[I_S5BIM] + (size_t)idx * 16;
    f32x2* bt = (f32x2*)(ws + WS_S5BT) + (size_t)idx * 16;
#pragma unroll
    for (int i = 0; i < 16; ++i) { const float br = bre[i], bi = bim[i]; bt[i] = (f32x2){co_re * br - co_im * bi, co_re * bi + co_im * br}; }
}

__device__ __forceinline__ void prep_hymlp(const DArgs& a, float* H3out, bf16_t* H3b, int l, int Lx, int t0, LAS unsigned char* lds, int tid) {
    LAS float* zs = (LAS float*)lds;
    LAS float* h1 = (LAS float*)(lds + 4608);
    LAS float* h2 = (LAS float*)(lds + 4608 + 8192);
    LAS float* w1s = (LAS float*)(lds + 24576);
    LAS float* w2s = w1s + 33 * 64;
    LAS float* w3s = w2s + 64 * 64;
    { const float* w1 = a.in[I_HW1] + (size_t)l * 33 * 64; const float* w2 = a.in[I_HW2] + (size_t)l * 64 * 64; const float* w3 = a.in[I_HW3] + (size_t)l * 64 * 64;
      for (int i = tid; i < 33 * 64; i += NT) w1s[i] = w1[i];
      for (int i = tid; i < 64 * 64; i += NT) { w2s[i] = w2[i]; w3s[i] = w3[i]; } }
    for (int i = tid; i < 32 * 33; i += NT) { const int pos = i / 33, f = i % 33, t = t0 + pos;
        float z;
        if (f == 0) z = (float)t / (float)(Lx - 1);
        else { const int j = (f - 1) & 15; const float fj = 1e-4f + (float)j * ((15.0f - 1e-4f) / 15.0f); const float wpos = (6.283185307179586f * (float)t) / (float)Lx; const float arg = fj * wpos;
               z = (f <= 16) ? cosf(arg) : -sinf(arg); }
        zs[pos * 36 + f] = z; }
    __syncthreads();
    const int pos = tid >> 4, f4 = (tid & 15) * 4, t = t0 + pos;
    f32x4 s = *(const f32x4*)(a.in[I_HB1] + l * 64 + f4);
#pragma unroll 3
    for (int j = 0; j < 33; ++j) s += zs[pos * 36 + j] * *(const LAS f32x4*)(w1s + j * 64 + f4);
    { const f32x4 fr = *(const f32x4*)(a.in[I_HF1] + l * 64 + f4); *(LAS f32x4*)(h1 + pos * 64 + f4) = (f32x4){sinf(fr.x * s.x), sinf(fr.y * s.y), sinf(fr.z * s.z), sinf(fr.w * s.w)}; }
    __syncthreads();
    s = *(const f32x4*)(a.in[I_HB2] + l * 64 + f4);
#pragma unroll 4
    for (int j = 0; j < 64; ++j) s += h1[pos * 64 + j] * *(const LAS f32x4*)(w2s + j * 64 + f4);
    { const f32x4 fr = *(const f32x4*)(a.in[I_HF2] + l * 64 + f4); *(LAS f32x4*)(h2 + pos * 64 + f4) = (f32x4){sinf(fr.x * s.x), sinf(fr.y * s.y), sinf(fr.z * s.z), sinf(fr.w * s.w)}; }
    __syncthreads();
    s = *(const f32x4*)(a.in[I_HB3] + l * 64 + f4);
#pragma unroll 4
    for (int j = 0; j < 64; ++j) s += h2[pos * 64 + j] * *(const LAS f32x4*)(w3s + j * 64 + f4);
    { const f32x4 fr = *(const f32x4*)(a.in[I_HF3] + l * 64 + f4); const f32x4 hv = (f32x4){sinf(fr.x * s.x), sinf(fr.y * s.y), sinf(fr.z * s.z), sinf(fr.w * s.w)}; *(f32x4*)(H3out + (size_t)t * 64 + f4) = hv;
      if (H3b) { u32x2 pk; pk.x = pk2(hv.x, hv.y); pk.y = pk2(hv.z, hv.w); *(u32x2*)(H3b + (size_t)t * 64 + f4) = pk; } }
    __syncthreads();
}

__device__ __forceinline__ void transpose_item(const float* W, int ldw, int srccol_lane  , int k0, bf16_t* WT, int K, int dstrow0, LAS float* scr, int lane) {
    float wv[32];
#pragma unroll
    for (int i = 0; i < 32; ++i) { const int kk = 2 * i + (lane >> 5); wv[i] = srccol_lane >= 0 ? W[(size_t)(k0 + kk) * ldw + srccol_lane] : 0.f; }
#pragma unroll
    for (int i = 0; i < 32; ++i) { const int kk = 2 * i + (lane >> 5); scr[kk * 33 + (lane & 31)] = wv[i]; }
    LDS_WAIT();
    const int c = lane & 7;
#pragma unroll
    for (int j = 0; j < 4; ++j) { const int n = (lane >> 3) + 8 * j; const LAS float* s = scr + (8 * c) * 33 + n;
        u32x4 o; o.x = pk2(s[0 * 33], s[1 * 33]); o.y = pk2(s[2 * 33], s[3 * 33]); o.z = pk2(s[4 * 33], s[5 * 33]); o.w = pk2(s[6 * 33], s[7 * 33]);
        *(u32x4*)(WT + (size_t)(dstrow0 + n) * K + k0 + 8 * c) = o; }
    LDS_WAIT();
}
__device__ __forceinline__ int win_srccol(int n) {
    if (n >= 3072 && n < 4096) { const int u = (n - 3072) & 127, grp = u >> 3, e = u & 7; return (n & ~127) + (e < 4 ? 4 * grp + e : 64 + 4 * grp + (e - 4)); }
    return n < 6144 ? n : (n < 6656 ? n + 32 : (n < 6688 ? n - 512 : -1));
}

__device__ __forceinline__ void norm_row(const float* xrow, const float* nw, const float* mod, bf16_t* hrow, int lane) {
    f32x4 v[8]; float ss = 0.f;
#pragma unroll
    for (int j = 0; j < 8; ++j) { v[j] = ((const f32x4*)xrow)[lane + 64 * j]; ss += (v[j].x * v[j].x + v[j].y * v[j].y) + (v[j].z * v[j].z + v[j].w * v[j].w); }
    const float rstd = rsqrtf(wave_sum(ss) * (1.0f / D) + EPS);
#pragma unroll
    for (int j = 0; j < 8; ++j) { const int k = 4 * (lane + 64 * j);
        const f32x4 w = *(const f32x4*)(nw + k), sh = *(const f32x4*)(mod + k), sc = *(const f32x4*)(mod + D + k);
        const f32x4 o = v[j] * rstd * w * (sc + 1.0f) + sh;
        u32x2 pk; pk.x = pk2(o.x, o.y); pk.y = pk2(o.z, o.w);
        *(u32x2*)(hrow + k) = pk; }
}

__device__ __forceinline__ void fft_twiddles(LAS f32x2* W, int tid) {
    for (int j = tid; j < 4096; j += NT) { float s, c; sincospif(-(float)j * (1.0f / 4096.0f), &s, &c); W[j] = (f32x2){c, s}; }
}
template <int R, int BETA, bool INV> __device__ __forceinline__ void fft_pass(LAS f32x2* X, const LAS f32x2* W, int tid) {
    constexpr int LOW = BETA - R + 1, NG = FFTN >> R;
    for (int gi = tid; gi < NG; gi += NT) {
        const int base = ((gi >> LOW) << (BETA + 1)) | (gi & ((1 << LOW) - 1));
        f32x2 e[1 << R];
#pragma unroll
        for (int m = 0; m < (1 << R); ++m) e[m] = X[base + (m << LOW)];
#pragma unroll
        for (int ss = 0; ss < R; ++ss) {
            const int s = INV ? (R - 1 - ss) : ss; const int bit = BETA - s, h = 1 << (R - 1 - s);
#pragma unroll
            for (int m = 0; m < (1 << R); ++m) {
                if (m & h) continue;
                const int idx = base + (m << LOW); const int ex = (idx & ((1 << bit) - 1)) << (12 - bit);
                const f32x2 w = W[ex]; const f32x2 a_ = e[m], b_ = e[m | h];
                if (!INV) { const f32x2 d = a_ - b_; e[m] = a_ + b_; e[m | h] = (f32x2){d.x * w.x - d.y * w.y, d.x * w.y + d.y * w.x}; }
                else { const f32x2 t = (f32x2){b_.x * w.x + b_.y * w.y, b_.y * w.x - b_.x * w.y}; e[m] = a_ + t; e[m | h] = a_ - t; }
            }
        }
#pragma unroll
        for (int m = 0; m < (1 << R); ++m) X[base + (m << LOW)] = e[m];
    }
}
__device__ __forceinline__ void fft_forward(LAS f32x2* X, const LAS f32x2* W, int tid) {
    fft_pass<4, 12, false>(X, W, tid); __syncthreads(); fft_pass<3, 8, false>(X, W, tid); __syncthreads();
    fft_pass<3, 5, false>(X, W, tid); __syncthreads(); fft_pass<3, 2, false>(X, W, tid); __syncthreads();
}
__device__ __forceinline__ void fft_inverse(LAS f32x2* X, const LAS f32x2* W, int tid) {
    fft_pass<3, 2, true>(X, W, tid); __syncthreads(); fft_pass<3, 5, true>(X, W, tid); __syncthreads();
    fft_pass<3, 8, true>(X, W, tid); __syncthreads(); fft_pass<4, 12, true>(X, W, tid); __syncthreads();
}
__device__ __forceinline__ float block_sum(float v, LAS float* red, int tid) {
    v = wave_sum(v);
    if ((tid & 63) == 0) red[tid >> 6] = v;
    __syncthreads();
    float t = 0.f;
#pragma unroll
    for (int i = 0; i < NWAVES; ++i) t += red[i];
    __syncthreads();
    return t;
}
constexpr float HY_D0 = -3.0701134573253945f  , HY_D1 = -15.350567286626973f  ;

__device__ __forceinline__ void filt_item(const DArgs& a, unsigned char* ws, LAS unsigned char* lds, int l, int c, int tid) {
    LAS f32x2* X = (LAS f32x2*)lds; LAS f32x2* W = (LAS f32x2*)(lds + 65536); LAS float* w4s = (LAS float*)(lds + 98304); LAS float* red = (LAS float*)(lds + 98304 + 1024);
    LAS float* k1b = (LAS float*)(lds + 100352);
    fft_twiddles(W, tid);
    if (tid < 256) { const int cc = tid >> 6, f = tid & 63; w4s[tid] = a.in[I_HW4][(size_t)l * 64 * 2048 + (size_t)f * 2048 + (cc >> 1) * 1024 + (cc & 1) * 512 + c]; }
    __syncthreads();
    const float dl = fabsf(HY_D0 + (HY_D1 - HY_D0) * ((float)c / 511.0f));
    const float* H3 = (const float*)(ws + WS_H3) + (size_t)l * 4096 * 64;
    float ss0 = 0.f, ss1 = 0.f;
#pragma unroll 1
    for (int j = 0; j < 16; ++j) {
        const int n = tid + 512 * j; const int dir = j >= 8 ? 1 : 0; const int t = dir ? (8192 - n) : n;
        float s0 = 0.f, s1 = 0.f;
        if (n != 4096) {
            const f32x4* hr = (const f32x4*)(H3 + (size_t)t * 64);
#pragma unroll
            for (int q = 0; q < 16; ++q) { const f32x4 hv = hr[q]; const f32x4 wa = ((const LAS f32x4*)(w4s + (dir * 2 + 0) * 64))[q], wb = ((const LAS f32x4*)(w4s + (dir * 2 + 1) * 64))[q];
                s0 += (hv.x * wa.x + hv.y * wa.y) + (hv.z * wa.z + hv.w * wa.w); s1 += (hv.x * wb.x + hv.y * wb.y) + (hv.z * wb.z + hv.w * wb.w); }
            const float dec = expf(-((float)t / 4095.0f) * dl); s0 *= dec; s1 *= dec;
        }
        X[n] = (f32x2){s0, 0.f}; k1b[n] = s1; ss0 += s0 * s0; ss1 += s1 * s1;
    }
    const float rs0 = rsqrtf(block_sum(ss0, red, tid) + EPS), rs1 = rsqrtf(block_sum(ss1, red, tid) + EPS);
    f32x2* KF0 = (f32x2*)(ws + WS_KF) + (size_t)(0 * 512 + c) * FFTN; f32x2* KF1 = (f32x2*)(ws + WS_KF) + (size_t)(1 * 512 + c) * FFTN;
#pragma unroll 4
    for (int j = 0; j < 16; ++j) { const f32x2 x = X[tid + 512 * j]; X[tid + 512 * j] = (f32x2){x.x * rs0, 0.f}; }
    __syncthreads(); fft_forward(X, W, tid);
#pragma unroll 4
    for (int j = 0; j < 16; ++j) KF0[tid + 512 * j] = X[tid + 512 * j];
    __syncthreads();
#pragma unroll 4
    for (int j = 0; j < 16; ++j) X[tid + 512 * j] = (f32x2){k1b[tid + 512 * j] * rs1, 0.f};
    __syncthreads(); fft_forward(X, W, tid);
#pragma unroll 4
    for (int j = 0; j < 16; ++j) KF1[tid + 512 * j] = X[tid + 512 * j];
    __syncthreads();
}
__device__ __forceinline__ void filt_ctx_item(const DArgs& a, unsigned char* ws, LAS unsigned char* lds, int c, int tid) {
    LAS float* w4s = (LAS float*)lds; LAS float* red = (LAS float*)(lds + 1024);
    if (tid < 256) { const int cc = tid >> 6, f = tid & 63; w4s[tid] = a.in[I_HW4][(size_t)f * 2048 + (cc >> 1) * 1024 + (cc & 1) * 512 + c]; }
    __syncthreads();
    const float dl = fabsf(HY_D0 + (HY_D1 - HY_D0) * ((float)c / 511.0f));
    const float* H3C = (const float*)(ws + WS_H3C);
    const int n = tid, dir = n >= 256 ? 1 : 0, t = dir ? (512 - n) : n;
    float s0 = 0.f, s1 = 0.f;
    if (n != 256) {
        const f32x4* hr = (const f32x4*)(H3C + (size_t)t * 64);
#pragma unroll
        for (int q = 0; q < 16; ++q) { const f32x4 hv = hr[q]; const f32x4 wa = ((const LAS f32x4*)(w4s + (dir * 2 + 0) * 64))[q], wb = ((const LAS f32x4*)(w4s + (dir * 2 + 1) * 64))[q];
            s0 += (hv.x * wa.x + hv.y * wa.y) + (hv.z * wa.z + hv.w * wa.w); s1 += (hv.x * wb.x + hv.y * wb.y) + (hv.z * wb.z + hv.w * wb.w); }
        const float dec = expf(-((float)t / 255.0f) * dl); s0 *= dec; s1 *= dec;
    }
    const float rs0 = rsqrtf(block_sum(s0 * s0, red, tid) + EPS), rs1 = rsqrtf(block_sum(s1 * s1, red, tid) + EPS);
    float* KC = (float*)(ws + WS_KC);
    KC[(size_t)(0 * 512 + c) * 512 + n] = s0 * rs0; KC[(size_t)(1 * 512 + c) * 512 + n] = s1 * rs1;
    __syncthreads();
}

__device__ __forceinline__ void prep_rope(f32x2* RT, int it, int tid) {
    const int idx = it * NT + tid, pos = idx >> 6, j = idx & 63;
    float ang;
    if (pos < SEQL) { const float inv = exp2f(-(float)(j & 31) * (13.287712379549449f / 32.0f)); ang = (float)(j < 32 ? (pos >> 6) : (pos & 63)) * inv; }
    else { const float inv = exp2f(-(float)j * (13.287712379549449f / 64.0f)); ang = (float)(pos - SEQL) * inv; }
    float sn, cs; sincosf(ang, &sn, &cs);
    RT[idx] = (f32x2){cs, sn};
}

__device__ __forceinline__ void ret_chain(const bf16_t* P, bf16_t* O, int b, int h, int dir, bool ctx_out, int wave, int lane) {
    const int e = wave * 16 + (lane & 15), dq = lane >> 4;
    const float gamma = 1.0f - exp2f(-5.0f - (float)h);
    constexpr int TB = 2;
    float S[32];
#pragma unroll
    for (int i = 0; i < 32; ++i) S[i] = 0.f;
    for (int seg = 0; seg < 2; ++seg) {
        const int n = seg ? SEQL : LC, rowbase = seg ? b * SEQL : NLAT + b * LC; const bool wr_out = seg || ctx_out;
        for (int i0 = 0; i0 < n; i0 += TB) {
            u32x4 q[TB][4], k[TB][4]; bf16_t v[TB];
#pragma unroll
            for (int tb = 0; tb < TB; ++tb) { const int row = rowbase + (dir ? n - 1 - (i0 + tb) : i0 + tb); const bf16_t* pr = P + (size_t)row * LDP;
#pragma unroll
                for (int c4 = 0; c4 < 4; ++c4) { q[tb][c4] = ((const u32x4*)(pr + PC_RQ + h * 128 + dq * 32))[c4]; k[tb][c4] = ((const u32x4*)(pr + PC_RK + h * 128 + dq * 32))[c4]; }
                v[tb] = pr[PC_RV + h * 128 + e]; }
#pragma unroll
            for (int tb = 0; tb < TB; ++tb) {
                const int row = rowbase + (dir ? n - 1 - (i0 + tb) : i0 + tb);
                const float vf = bf2f(v[tb]); float o = 0.f;
#pragma unroll
                for (int c4 = 0; c4 < 4; ++c4) { float qf[8], kf[8]; unpack8(q[tb][c4], qf); unpack8(k[tb][c4], kf);
#pragma unroll
                    for (int x = 0; x < 8; ++x) { const int ix = c4 * 8 + x; S[ix] = gamma * S[ix] + kf[x] * vf; o += qf[x] * S[ix]; } }
                o += __shfl_xor(o, 16); o += __shfl_xor(o, 32);
                if (wr_out && dq == 0) O[(size_t)row * 512 + h * 128 + e] = (bf16_t)f2bf(o);
            }
        }
    }
}
__device__ __forceinline__ void gla_chain(const bf16_t* P, const bf16_t* GLGd, bf16_t* O, int b, int h, int dir, bool ctx_out, int wave, int lane) {
    const int e = wave * 16 + (lane & 15), dq = lane >> 4;
    constexpr int TB = 4;
    float S[16];
#pragma unroll
    for (int i = 0; i < 16; ++i) S[i] = 0.f;
    for (int seg = 0; seg < 2; ++seg) {
        const int n = seg ? SEQL : LC, rowbase = seg ? b * SEQL : NLAT + b * LC; const bool wr_out = seg || ctx_out;
        for (int i0 = 0; i0 < n; i0 += TB) {
            u32x4 q[TB][2], k[TB][2], g[TB][2]; bf16_t v[TB];
#pragma unroll
            for (int tb = 0; tb < TB; ++tb) { const int row = rowbase + (dir ? n - 1 - (i0 + tb) : i0 + tb); const bf16_t* pr = P + (size_t)row * LDP; const bf16_t* gr = GLGd + (size_t)row * 256 + h * 64 + dq * 16;
#pragma unroll
                for (int c4 = 0; c4 < 2; ++c4) { q[tb][c4] = ((const u32x4*)(pr + PC_GQ + h * 64 + dq * 16))[c4]; k[tb][c4] = ((const u32x4*)(pr + PC_GK + h * 64 + dq * 16))[c4]; g[tb][c4] = ((const u32x4*)gr)[c4]; }
                v[tb] = pr[PC_GV + h * 128 + e]; }
#pragma unroll
            for (int tb = 0; tb < TB; ++tb) {
                const int row = rowbase + (dir ? n - 1 - (i0 + tb) : i0 + tb);
                const float vf = bf2f(v[tb]); float o = 0.f;
#pragma unroll
                for (int c4 = 0; c4 < 2; ++c4) { float qf[8], kf[8], gf[8]; unpack8(q[tb][c4], qf); unpack8(k[tb][c4], kf); unpack8(g[tb][c4], gf);
#pragma unroll
                    for (int x = 0; x < 8; ++x) { const int ix = c4 * 8 + x; S[ix] = __expf(gf[x]) * S[ix] + kf[x] * vf; o += qf[x] * S[ix]; } }
                o += __shfl_xor(o, 16); o += __shfl_xor(o, 32);
                if (wr_out && dq == 0) O[(size_t)row * 512 + h * 128 + e] = (bf16_t)f2bf(o * 0.125f);
            }
        }
    }
}
__device__ __forceinline__ void s5_chain(const DArgs& a, unsigned char* ws, LAS unsigned char* lds, int l, int b, int g, int dir, bool ctx_out, int tid) {
    LAS f32x2* cs = (LAS f32x2*)lds; LAS f32x2* hs = (LAS f32x2*)(lds + 16 * 65 * 8); LAS float* us = (LAS float*)(lds + 2 * 16 * 65 * 8);
    const int wave = tid >> 6, lane = tid & 63;
    const int gi = (l * 2 + dir) * 32 + g;
    const float* cre = a.in[I_S5CRE] + (size_t)gi * 1024; const float* cim = a.in[I_S5CIM] + (size_t)gi * 1024;
    for (int idx = tid; idx < 1024; idx += NT) { const int i = idx >> 6, p = idx & 63; cs[i * 65 + p] = (f32x2){cre[idx], cim[idx]}; }
    f32x2 ab = {0.f, 0.f}; f32x2 bt[16]; f32x2 hst = {0.f, 0.f};
    if (wave == 0) { ab = ((const f32x2*)(ws + WS_S5AB))[gi * 64 + lane]; const f32x2* bp = (const f32x2*)(ws + WS_S5BT) + (size_t)(gi * 64 + lane) * 16;
#pragma unroll
        for (int i = 0; i < 16; ++i) bt[i] = bp[i]; }
    else {
#pragma unroll
        for (int i = 0; i < 16; ++i) bt[i] = (f32x2){0.f, 0.f}; }
    const bf16_t* P = (const bf16_t*)(ws + WS_P);
    bf16_t* Y = (bf16_t*)(ws + WS_OB) + (size_t)(4 + dir) * OBSZ;
    const int tt = tid >> 4, i = tid & 15;
    for (int seg = 0; seg < 2; ++seg) {
        const int n = seg ? SEQL : LC, rowbase = seg ? b * SEQL : NLAT + b * LC; const bool wr_out = seg || ctx_out;
        __syncthreads();
        if (tid < 256) us[tid] = bf2f(P[(size_t)(rowbase + (dir ? n - 1 - tt : tt)) * LDP + PC_S5U + g * 16 + i]);
        for (int bt0 = 0; bt0 < n; bt0 += 16) {
            const int ii = bt0 + tt; const int row = rowbase + (dir ? n - 1 - ii : ii);
            bf16_t unext = 0;
            if (tid < 256 && bt0 + 16 < n) { const int iin = ii + 16; unext = P[(size_t)(rowbase + (dir ? n - 1 - iin : iin)) * LDP + PC_S5U + g * 16 + i]; }
            __syncthreads();
            if (wave == 0) {
#pragma unroll 4
                for (int t2 = 0; t2 < 16; ++t2) {
                    float bur = 0.f, bui = 0.f;
#pragma unroll
                    for (int q = 0; q < 4; ++q) { const f32x4 u = ((const LAS f32x4*)(us + t2 * 16))[q];
                        bur += bt[4 * q].x * u.x + bt[4 * q + 1].x * u.y + bt[4 * q + 2].x * u.z + bt[4 * q + 3].x * u.w;
                        bui += bt[4 * q].y * u.x + bt[4 * q + 1].y * u.y + bt[4 * q + 2].y * u.z + bt[4 * q + 3].y * u.w; }
                    const float hr = ab.x * hst.x - ab.y * hst.y + bur, hi = ab.x * hst.y + ab.y * hst.x + bui;
                    hst = (f32x2){hr, hi};
                    hs[t2 * 65 + lane] = hst;
                }
            }
            __syncthreads();
            if (tid < 256) {
                us[tid] = bf2f(unext);
                float y = 0.f;
#pragma unroll 8
                for (int p = 0; p < 64; ++p) { const f32x2 cv = cs[i * 65 + p], hv = hs[tt * 65 + p]; y += cv.x * hv.x - cv.y * hv.y; }
                if (wr_out) Y[(size_t)row * 512 + g * 16 + i] = (bf16_t)f2bf(y);
            }
        }
    }
    __syncthreads();
}

__device__ __forceinline__ float sconv3(const bf16_t* p, int t, int Lx, float w0, float w1, float w2, float cb) {
    const float x0 = t > 0 ? bf2f(p[t - 1]) : 0.f, x1 = bf2f(p[t]), x2 = t < Lx - 1 ? bf2f(p[t + 1]) : 0.f;
    return w0 * x0 + w1 * x1 + w2 * x2 + cb;
}
__device__ __forceinline__ void hyena_item(const DArgs& a, unsigned char* ws, LAS unsigned char* lds, int l, int c, int tid) {
    LAS f32x2* X = (LAS f32x2*)lds; LAS f32x2* W = (LAS f32x2*)(lds + 65536);
    fft_twiddles(W, tid);
    const float* cw = a.in[I_HCW] + (size_t)l * 3 * 1536; const float* cbp = a.in[I_HCB] + (size_t)l * 1536;
    const float wv0 = cw[c], wv1 = cw[1536 + c], wv2 = cw[3072 + c], bv = cbp[c];
    const float wa0 = cw[512 + c], wa1 = cw[1536 + 512 + c], wa2 = cw[3072 + 512 + c], ba = cbp[512 + c];
    const float wb0 = cw[1024 + c], wb1 = cw[1536 + 1024 + c], wb2 = cw[3072 + 1024 + c], bb = cbp[1024 + c];
    const float bias0 = a.in[I_HBIAS][(l * 2 + 0) * 512 + c], bias1 = a.in[I_HBIAS][(l * 2 + 1) * 512 + c];
    const bf16_t* PT = (const bf16_t*)(ws + WS_PT);
    const bf16_t* pv = PT + (size_t)(PT_V + c) * MR; const bf16_t* pg1 = PT + (size_t)(PT_G1 + c) * MR; const bf16_t* pg2 = PT + (size_t)(PT_G2 + c) * MR; const bf16_t* phg = PT + (size_t)(PT_HG + c) * MR;
    const f32x2* KF0 = (const f32x2*)(ws + WS_KF) + (size_t)(0 * 512 + c) * FFTN; const f32x2* KF1 = (const f32x2*)(ws + WS_KF) + (size_t)(1 * 512 + c) * FFTN;
    bf16_t* GATED = (bf16_t*)(ws + WS_H);
    __syncthreads();
    for (int bp = 0; bp < 2; ++bp) {
        const int r0 = (2 * bp) * SEQL, r1 = (2 * bp + 1) * SEQL;
        float zr[8], zi[8];
#pragma unroll
        for (int j = 0; j < 8; ++j) { const int t = tid + 512 * j; zr[j] = sconv3(pv + r0, t, SEQL, wv0, wv1, wv2, bv); zi[j] = sconv3(pv + r1, t, SEQL, wv0, wv1, wv2, bv);
            X[t] = (f32x2){zr[j], zi[j]}; X[4096 + t] = (f32x2){0.f, 0.f}; if (j & 1) asm volatile("" ::: "memory"); }
        __syncthreads(); fft_forward(X, W, tid);
#pragma unroll 4
        for (int j = 0; j < 16; ++j) { const int pos = tid + 512 * j; const f32x2 x = X[pos], k = KF0[pos]; X[pos] = (f32x2){x.x * k.x - x.y * k.y, x.x * k.y + x.y * k.x}; }
        __syncthreads(); fft_inverse(X, W, tid);
#pragma unroll
        for (int j = 0; j < 8; ++j) { const int t = tid + 512 * j; const f32x2 cv = X[t] * (1.0f / 8192.0f);
            const float g1r = sconv3(pg1 + r0, t, SEQL, wa0, wa1, wa2, ba), g1i = sconv3(pg1 + r1, t, SEQL, wa0, wa1, wa2, ba);
            zr[j] = g1r * (cv.x + bias0 * zr[j]); zi[j] = g1i * (cv.y + bias0 * zi[j]); if (j & 1) asm volatile("" ::: "memory"); }
        __syncthreads();
#pragma unroll
        for (int j = 0; j < 8; ++j) { const int t = tid + 512 * j; X[t] = (f32x2){zr[j], zi[j]}; X[4096 + t] = (f32x2){0.f, 0.f}; }
        __syncthreads(); fft_forward(X, W, tid);
#pragma unroll 4
        for (int j = 0; j < 16; ++j) { const int pos = tid + 512 * j; const f32x2 x = X[pos], k = KF1[pos]; X[pos] = (f32x2){x.x * k.x - x.y * k.y, x.x * k.y + x.y * k.x}; }
        __syncthreads(); fft_inverse(X, W, tid);
#pragma unroll
        for (int j = 0; j < 8; ++j) { const int t = tid + 512 * j; const f32x2 cv = X[t] * (1.0f / 8192.0f);
            const float g2r = sconv3(pg2 + r0, t, SEQL, wb0, wb1, wb2, bb), g2i = sconv3(pg2 + r1, t, SEQL, wb0, wb1, wb2, bb);
            const float z2r = g2r * (cv.x + bias1 * zr[j]), z2i = g2i * (cv.y + bias1 * zi[j]);
            const float hg0 = bf2f(phg[r0 + t]), hg1 = bf2f(phg[r1 + t]);
            GATED[(size_t)(r0 + t) * D + 512 + c] = (bf16_t)f2bf(z2r * siluf_(hg0)); GATED[(size_t)(r1 + t) * D + 512 + c] = (bf16_t)f2bf(z2i * siluf_(hg1)); if (j & 1) asm volatile("" ::: "memory"); }
        __syncthreads();
    }
}
__device__ __forceinline__ void ctx_conv256(const LAS float* kc, const LAS float* z, int b, int t4, int half, float (&o)[4]) {
    o[0] = o[1] = o[2] = o[3] = 0.f;
#pragma unroll 4
    for (int s4 = 0; s4 < 32; ++s4) { const int s = 128 * half + 4 * s4, d = 4 * t4 - s;
        const f32x4 zv = *(const LAS f32x4*)(z + b * 256 + s);
        const f32x4 wl = *(const LAS f32x4*)(kc + ((d - 4) & 511)), wh = *(const LAS f32x4*)(kc + (d & 511));
        const float w[8] = {wl.x, wl.y, wl.z, wl.w, wh.x, wh.y, wh.z, wh.w};
        const float zz[4] = {zv.x, zv.y, zv.z, zv.w};
#pragma unroll
        for (int j = 0; j < 4; ++j)
#pragma unroll
            for (int i = 0; i < 4; ++i) o[j] += w[4 + j - i] * zz[i]; }
}
__device__ __forceinline__ void hyena_ctx_item(const DArgs& a, unsigned char* ws, LAS unsigned char* lds, int c, int tid) {
    LAS float* kc = (LAS float*)lds; LAS float* za = (LAS float*)(lds + 4096); LAS float* zb = (LAS float*)(lds + 8192); LAS float* part = (LAS float*)(lds + 12288);
    const float* KC = (const float*)(ws + WS_KC);
    kc[tid] = KC[(size_t)(0 * 512 + c) * 512 + tid]; kc[512 + tid] = KC[(size_t)(1 * 512 + c) * 512 + tid];
    const float* cw = a.in[I_HCW]; const float* cbp = a.in[I_HCB];
    const float wv0 = cw[c], wv1 = cw[1536 + c], wv2 = cw[3072 + c], bv = cbp[c];
    const float wa0 = cw[512 + c], wa1 = cw[1536 + 512 + c], wa2 = cw[3072 + 512 + c], ba = cbp[512 + c];
    const float wb0 = cw[1024 + c], wb1 = cw[1536 + 1024 + c], wb2 = cw[3072 + 1024 + c], bb = cbp[1024 + c];
    const float bias0 = a.in[I_HBIAS][0 * 512 + c], bias1 = a.in[I_HBIAS][1 * 512 + c];
    const bf16_t* PT = (const bf16_t*)(ws + WS_PT);
    const int half = tid >> 8, b = (tid >> 6) & 3, t4 = tid & 63; const int rb = NLAT + b * LC;
    const bf16_t* pv = PT + (size_t)(PT_V + c) * MR + rb; const bf16_t* pg1 = PT + (size_t)(PT_G1 + c) * MR + rb; const bf16_t* pg2 = PT + (size_t)(PT_G2 + c) * MR + rb; const bf16_t* phg = PT + (size_t)(PT_HG + c) * MR + rb;
    bf16_t* GATED = (bf16_t*)(ws + WS_H);
    float z0[4], z1[4], o[4];
#pragma unroll
    for (int j = 0; j < 4; ++j) { z0[j] = sconv3(pv, 4 * t4 + j, LC, wv0, wv1, wv2, bv); }
    if (half == 0) *(LAS f32x4*)(za + b * 256 + 4 * t4) = (f32x4){z0[0], z0[1], z0[2], z0[3]};
    __syncthreads();
    ctx_conv256(kc, za, b, t4, half, o);
    if (half == 1) *(LAS f32x4*)(part + b * 256 + 4 * t4) = (f32x4){o[0], o[1], o[2], o[3]};
    __syncthreads();
    if (half == 0) { const f32x4 pp = *(const LAS f32x4*)(part + b * 256 + 4 * t4); const float ps[4] = {pp.x, pp.y, pp.z, pp.w};
#pragma unroll
        for (int j = 0; j < 4; ++j) z1[j] = sconv3(pg1, 4 * t4 + j, LC, wa0, wa1, wa2, ba) * (o[j] + ps[j] + bias0 * z0[j]);
        *(LAS f32x4*)(zb + b * 256 + 4 * t4) = (f32x4){z1[0], z1[1], z1[2], z1[3]}; }
    __syncthreads();
    ctx_conv256(kc + 512, zb, b, t4, half, o);
    if (half == 1) *(LAS f32x4*)(part + b * 256 + 4 * t4) = (f32x4){o[0], o[1], o[2], o[3]};
    __syncthreads();
    if (half == 0) { const f32x4 pp = *(const LAS f32x4*)(part + b * 256 + 4 * t4); const float ps[4] = {pp.x, pp.y, pp.z, pp.w};
#pragma unroll
        for (int j = 0; j < 4; ++j) { const int t = 4 * t4 + j; const float z2 = sconv3(pg2, t, LC, wb0, wb1, wb2, bb) * (o[j] + ps[j] + bias1 * z1[j]);
            GATED[(size_t)(rb + t) * D + 512 + c] = (bf16_t)f2bf(z2 * siluf_(bf2f(phg[t]))); } }
    __syncthreads();
}

__device__ __forceinline__ void merge_row(const DArgs& a, unsigned char* ws, int l, int row, int lane) {
    const int col = 8 * lane;
    const bf16_t* OB = (const bf16_t*)(ws + WS_OB); const bf16_t* P = (const bf16_t*)(ws + WS_P) + (size_t)row * LDP;
    bf16_t* GATED = (bf16_t*)(ws + WS_H) + (size_t)row * D; bf16_t* G5 = (bf16_t*)(ws + WS_KF) + (size_t)row * 512;
    { float yf[8], yb[8], u[8], res[8];
      unpack8(*(const u32x4*)(OB + (size_t)4 * OBSZ + (size_t)row * 512 + col), yf); unpack8(*(const u32x4*)(OB + (size_t)5 * OBSZ + (size_t)row * 512 + col), yb);
      unpack8(*(const u32x4*)(P + PC_S5U + col), u);
      const float* dsk = a.in[I_S5D] + l * 512 + col;
#pragma unroll
      for (int x = 0; x < 8; ++x) res[x] = gelu_tanh(yf[x] + yb[x] + u[x] * dsk[x]);
      *(u32x4*)(G5 + col) = pack8(res); }
}

struct EpiInProj {
    static constexpr bool PERM = true, AFTER_DRAIN = false;
    bf16_t* P; bf16_t* PT; float* LR; const float* RT;
    __device__ __forceinline__ void operator()(const pg8::f32x4 (&acc)[2][2][4][2], const pg8::Unit& u, int wr, int wc, int fr, int fq) const {
        const int row0 = u.pm * 256 + wr * 64 + fr, pn = u.pn;
        if (pn >= 12 && pn < 16) {
            const int colbase = pn * 256 - 2048 + wc * 32 + 8 * fq; const int j0 = 4 * (4 * wc + fq); const float ksc = pn >= 14 ? 0.08838834764831845f : 1.0f;
#pragma unroll
            for (int ai = 0; ai < 2; ++ai)
#pragma unroll
                for (int m = 0; m < 4; ++m) { const int row = row0 + ai * 128 + m * 16; const int pos = row < NLAT ? (row & (SEQL - 1)) : SEQL + ((row - NLAT) & (LC - 1));
                    const pg8::f32x4 t0 = *(const pg8::f32x4*)(RT + ((size_t)pos * 64 + j0) * 2), t1 = *(const pg8::f32x4*)(RT + ((size_t)pos * 64 + j0) * 2 + 4);
                    bf16_t* rowp = P + (size_t)row * LDP + colbase;
#pragma unroll
                    for (int bj = 0; bj < 2; ++bj) { const pg8::f32x4 x1 = acc[ai][bj][m][0] * ksc, x2 = acc[ai][bj][m][1] * ksc;
                        u32x4 w; w.x = pk2(x1[0] * t0[0] - x2[0] * t0[1], x1[1] * t0[2] - x2[1] * t0[3]); w.y = pk2(x1[2] * t1[0] - x2[2] * t1[1], x1[3] * t1[2] - x2[3] * t1[3]);
                        w.z = pk2(x1[0] * t0[1] + x2[0] * t0[0], x1[1] * t0[3] + x2[1] * t0[2]); w.w = pk2(x1[2] * t1[1] + x2[2] * t1[0], x1[3] * t1[3] + x2[3] * t1[2]);
                        *(u32x4*)(rowp + bj * 128) = w; } }
        } else if (pn < 4 || (pn >= 16 && pn < 26)) {
            const int colbase = (pn < 4 ? pn * 256 : pn * 256 - 2048) + wc * 32 + 8 * fq;
#pragma unroll
            for (int ai = 0; ai < 2; ++ai)
#pragma unroll
                for (int m = 0; m < 4; ++m) { bf16_t* rowp = P + (size_t)(row0 + ai * 128 + m * 16) * LDP + colbase;
#pragma unroll
                    for (int bj = 0; bj < 2; ++bj) { const pg8::f32x4 v0 = acc[ai][bj][m][0], v1 = acc[ai][bj][m][1];
                        u32x4 w; w.x = pk2(v0[0], v0[1]); w.y = pk2(v0[2], v0[3]); w.z = pk2(v1[0], v1[1]); w.w = pk2(v1[2], v1[3]);
                        *(u32x4*)(rowp + bj * 128) = w; } }
        } else if (pn < 12) {
            const int colbase = (pn - 4) * 256 + wc * 32 + 8 * fq;
#pragma unroll
            for (int bj = 0; bj < 2; ++bj)
#pragma unroll
                for (int n = 0; n < 2; ++n)
#pragma unroll
                    for (int j = 0; j < 4; ++j) { bf16_t* cp = PT + (size_t)(colbase + bj * 128 + 4 * n + j) * MR + row0;
#pragma unroll
                        for (int ai = 0; ai < 2; ++ai)
#pragma unroll
                            for (int m = 0; m < 4; ++m) cp[ai * 128 + m * 16] = (bf16_t)f2bf(acc[ai][bj][m][n][j]);
                        asm volatile("" ::: "memory"); }
        } else {
            if (wc == 0) {
#pragma unroll
                for (int ai = 0; ai < 2; ++ai)
#pragma unroll
                    for (int m = 0; m < 4; ++m) { float* rowp = LR + (size_t)(row0 + ai * 128 + m * 16) * 32 + 8 * fq;
                        *(pg8::f32x4*)(rowp) = acc[ai][0][m][0]; *(pg8::f32x4*)(rowp + 4) = acc[ai][0][m][1]; }
            }
        }
    }
};
struct EpiGlu {
    static constexpr bool PERM = true, AFTER_DRAIN = false;
    const bf16_t* GG; bf16_t* GATED; const float* bias;
    __device__ __forceinline__ void operator()(const pg8::f32x4 (&acc)[2][2][4][2], const pg8::Unit& u, int wr, int wc, int fr, int fq) const {
        const int row0 = u.pm * 256 + wr * 64 + fr, col0 = u.pn * 256 + wc * 32 + 8 * fq;
        pg8::f32x4 b0[2], b1[2];
#pragma unroll
        for (int bj = 0; bj < 2; ++bj) { b0[bj] = *(const pg8::f32x4*)(bias + col0 + bj * 128); b1[bj] = *(const pg8::f32x4*)(bias + col0 + bj * 128 + 4); }
#pragma unroll
        for (int ai = 0; ai < 2; ++ai) {
            u32x4 gg[4][2];
#pragma unroll
            for (int m = 0; m < 4; ++m)
#pragma unroll
                for (int bj = 0; bj < 2; ++bj) gg[m][bj] = *(const u32x4*)(GG + (size_t)(row0 + ai * 128 + m * 16) * 512 + col0 + bj * 128);
#pragma unroll
            for (int m = 0; m < 4; ++m) { const size_t row = (size_t)(row0 + ai * 128 + m * 16);
#pragma unroll
                for (int bj = 0; bj < 2; ++bj) { float g[8], res[8]; unpack8(gg[m][bj], g);
#pragma unroll
                    for (int j = 0; j < 4; ++j) { res[j] = g[j] * sigmoidf_(acc[ai][bj][m][0][j] + b0[bj][j]); res[4 + j] = g[4 + j] * sigmoidf_(acc[ai][bj][m][1][j] + b1[bj][j]); }
                    *(u32x4*)(GATED + row * D + col0 + bj * 128) = pack8(res); } }
            asm volatile("" ::: "memory");
        }
    }
};
struct EpiOut {
    static constexpr bool PERM = false, AFTER_DRAIN = false;
    const float* xl_old; const float* xc_old; float* xl_new; float* xc_new; const float* mod;
    __device__ __forceinline__ void operator()(const pg8::f32x4 (&acc)[2][2][4][2], const pg8::Unit& u, int wr, int wc, int fr, int fq) const {
        const int row0 = u.pm * 256 + wr * 64 + fr, col0 = u.pn * 256 + wc * 32 + 4 * fq;
        const bool lat = u.pm < 64;
        const float* xo = lat ? xl_old : xc_old - (size_t)NLAT * D; float* xn = lat ? xl_new : xc_new - (size_t)NLAT * D;
#pragma unroll
        for (int ai = 0; ai < 2; ++ai) {
            const int v = lat ? ((u.pm * 256 + ai * 128) >> 12) : 4;
            const float* gt = mod + (size_t)v * ADA + 2 * D;
#pragma unroll
            for (int m = 0; m < 4; ++m) { const size_t off = (size_t)(row0 + ai * 128 + m * 16) * D + col0;
#pragma unroll
                for (int bj = 0; bj < 2; ++bj)
#pragma unroll
                    for (int n = 0; n < 2; ++n) { const int cc = bj * 128 + n * 16; const pg8::f32x4 gv = *(const pg8::f32x4*)(gt + col0 + cc), xv = *(const pg8::f32x4*)(xo + off + cc);
                        *(pg8::f32x4*)(xn + off + cc) = xv + gv * acc[ai][bj][m][n]; } }
        }
    }
};
typedef short bf16x8 __attribute__((ext_vector_type(8)));
typedef short bf16x4 __attribute__((ext_vector_type(4)));
__device__ __forceinline__ unsigned off_b(unsigned row, unsigned ch) { return 256u * row + 16u * (ch ^ (((row & 3) << 2) | ((row >> 2) & 3))); }
__device__ __forceinline__ bf16x8 img_row_frag(const LAS unsigned char* img, unsigned lane, unsigned rb, unsigned s) { return *(const LAS bf16x8*)(img + off_b((lane & 15) + 16 * rb, 4 * s + (lane >> 4))); }
__device__ __forceinline__ bf16x4 img_tr4(const LAS unsigned char* img, unsigned lane, unsigned c, unsigned row0) {
    const unsigned q = (lane & 15) >> 2, p = lane & 3;
    return __builtin_amdgcn_ds_read_tr16_b64_v4i16((LAS bf16x4*)(img + off_b(row0 + q, 2 * c + (p >> 1)) + 8 * (p & 1)));
}
__device__ __forceinline__ bf16x8 img_tr_frag(const LAS unsigned char* img, unsigned lane, unsigned c, unsigned ks) {
    const unsigned g = lane >> 4; const bf16x4 lo = img_tr4(img, lane, c, 32 * ks + 8 * g), hi = img_tr4(img, lane, c, 32 * ks + 8 * g + 4);
    return __builtin_shufflevector(lo, hi, 0, 1, 2, 3, 4, 5, 6, 7);
}
__device__ __forceinline__ bf16x8 img_tr_frag_acc(const LAS unsigned char* img, unsigned lane, unsigned c, unsigned ks) {
    const unsigned g = lane >> 4; const bf16x4 lo = img_tr4(img, lane, c, 32 * ks + 4 * g), hi = img_tr4(img, lane, c, 32 * ks + 16 + 4 * g);
    return __builtin_shufflevector(lo, hi, 0, 1, 2, 3, 4, 5, 6, 7);
}
__device__ __forceinline__ bf16x8 acc_pair_frag(const f32x4 a0, const f32x4 a1) {
    u32x4 w; w.x = pk2(a0.x, a0.y); w.y = pk2(a0.z, a0.w); w.z = pk2(a1.x, a1.y); w.w = pk2(a1.z, a1.w);
    return __builtin_bit_cast(bf16x8, w);
}
#define MFMA16(A_, B_, C_) __builtin_amdgcn_mfma_f32_16x16x32_bf16((A_), (B_), (C_), 0, 0, 0)
__device__ __forceinline__ void stage_tile128(LAS unsigned char* img, const bf16_t* g, size_t ld, int tid) {
#pragma unroll
    for (int i = 0; i < 4; ++i) { const int n = tid + NT * i, row = n >> 4, ch = n & 15; *(LAS u32x4*)(img + off_b(row, ch)) = *(const u32x4*)(g + (size_t)row * ld + ch * 8); }
}

constexpr int RCH = 128, RNCH = 34;
constexpr size_t WS_RST = WS_OB;
__device__ __forceinline__ int ret_rowbase(int b, int cc) { return cc < 2 ? NLAT + b * LC + cc * RCH : b * SEQL + (cc - 2) * RCH; }
__device__ __forceinline__ float ret_log2g(int h) { return log2f(1.0f - exp2f(-5.0f - (float)h)); }

__device__ __forceinline__ void ret_passA(unsigned char* ws, LAS unsigned char* lds, int item, int tid) {
    const int bh = item / RNCH, cc = item % RNCH, b = bh >> 2, h = bh & 3;
    const int lane = tid & 63, w = tid >> 6, g = lane >> 4;
    LAS unsigned char* KF = lds; LAS unsigned char* KB = lds + 32768; LAS unsigned char* VI = lds + 65536;
    const bf16_t* P = (const bf16_t*)(ws + WS_P) + (size_t)ret_rowbase(b, cc) * LDP;
    const float l2g = ret_log2g(h);
    __syncthreads();
#pragma unroll
    for (int i = 0; i < 4; ++i) { const int n = tid + NT * i, row = n >> 4, ch = n & 15;
        const u32x4 kr = *(const u32x4*)(P + (size_t)row * LDP + PC_RK + h * 128 + ch * 8);
        float kf[8], a[8], c[8]; unpack8(kr, kf);
        const float sf = exp2f(l2g * (float)(RCH - 1 - row)), sb = exp2f(l2g * (float)row);
#pragma unroll
        for (int x = 0; x < 8; ++x) { a[x] = kf[x] * sf; c[x] = kf[x] * sb; }
        *(LAS u32x4*)(KF + off_b(row, ch)) = pack8(a); *(LAS u32x4*)(KB + off_b(row, ch)) = pack8(c);
        *(LAS u32x4*)(VI + off_b(row, ch)) = *(const u32x4*)(P + (size_t)row * LDP + PC_RV + h * 128 + ch * 8); }
    __syncthreads();
    bf16x8 af[4], ab[4];
#pragma unroll
    for (int ks = 0; ks < 4; ++ks) { af[ks] = img_tr_frag(KF, lane, w, ks); ab[ks] = img_tr_frag(KB, lane, w, ks); }
    bf16_t* ST = (bf16_t*)(ws + WS_RST) + ((size_t)(bh * 2) * RNCH + cc) * (128 * 128);
#pragma unroll 2
    for (int E = 0; E < 8; ++E) {
        f32x4 cf = {0.f, 0.f, 0.f, 0.f}, cb = {0.f, 0.f, 0.f, 0.f};
#pragma unroll
        for (int ks = 0; ks < 4; ++ks) { const bf16x8 vb = img_tr_frag(VI, lane, E, ks); cf = MFMA16(af[ks], vb, cf); cb = MFMA16(ab[ks], vb, cb); }
        const int e = 16 * E + (lane & 15), d0 = 16 * w + 4 * g;
        u32x2 o; o.x = pk2(cf.x, cf.y); o.y = pk2(cf.z, cf.w); *(u32x2*)(ST + (size_t)e * 128 + d0) = o;
        o.x = pk2(cb.x, cb.y); o.y = pk2(cb.z, cb.w); *(u32x2*)(ST + (size_t)RNCH * 128 * 128 + (size_t)e * 128 + d0) = o;
    }
}
__device__ __forceinline__ void ret_passB(unsigned char* ws, int gt  ) {
    const int el = gt & 2047, bd = gt >> 11, bh = bd >> 1, dir = bd & 1, h = bh & 3;
    const float gC = exp2f(ret_log2g(h) * (float)RCH);
    bf16_t* base = (bf16_t*)(ws + WS_RST) + (size_t)bd * RNCH * (128 * 128) + (size_t)el * 8;
    float acc[8];
#pragma unroll
    for (int x = 0; x < 8; ++x) acc[x] = 0.f;
#pragma unroll 1
    for (int s0 = 0; s0 < RNCH; s0 += 17) {
        u32x4 kvr[17];
#pragma unroll
        for (int j = 0; j < 17; ++j) { const int s = s0 + j; const int cc = dir == 0 ? s : (s < 2 ? 1 - s : 35 - s); kvr[j] = *(const u32x4*)(base + (size_t)cc * (128 * 128)); }
#pragma unroll
        for (int j = 0; j < 17; ++j) { const int s = s0 + j; const int cc = dir == 0 ? s : (s < 2 ? 1 - s : 35 - s);
            float kv[8]; unpack8(kvr[j], kv);
            *(u32x4*)(base + (size_t)cc * (128 * 128)) = pack8(acc);
#pragma unroll
            for (int x = 0; x < 8; ++x) acc[x] = gC * acc[x] + kv[x]; }
    }
}
__device__ __forceinline__ void ret_passC(const DArgs& a, unsigned char* ws, LAS unsigned char* lds, int l, int item, int tid) {
    const int bh = item / RNCH, cc = item % RNCH, b = bh >> 2, h = bh & 3;
    const int lane = tid & 63, w = tid >> 6, g = lane >> 4, il = lane & 15;
    LAS unsigned char* KI = lds; LAS unsigned char* VI = lds + 32768; LAS unsigned char* SF = lds + 65536; LAS unsigned char* SB = lds + 98304;
    const int rowbase = ret_rowbase(b, cc);
    const bf16_t* P = (const bf16_t*)(ws + WS_P) + (size_t)rowbase * LDP;
    const bf16_t* STf = (const bf16_t*)(ws + WS_RST) + ((size_t)(bh * 2) * RNCH + cc) * (128 * 128);
    const bf16_t* STb = STf + (size_t)RNCH * 128 * 128;
    __syncthreads();
    stage_tile128(KI, P + PC_RK + h * 128, LDP, tid); stage_tile128(VI, P + PC_RV + h * 128, LDP, tid);
    stage_tile128(SF, STf, 128, tid); stage_tile128(SB, STb, 128, tid);
    bf16x8 qf[4];
    { const bf16_t* qr = P + (size_t)(16 * w + il) * LDP + PC_RQ + h * 128 + 8 * g;
#pragma unroll
      for (int ks = 0; ks < 4; ++ks) qf[ks] = *(const bf16x8*)(qr + 32 * ks); }
    __syncthreads();
    const float l2g = ret_log2g(h);
    const int iloc = 16 * w + il;
    f32x4 o[8];
    { const float sf = exp2f(l2g * (float)(iloc + 1)), sb = exp2f(l2g * (float)(RCH - iloc));
#pragma unroll
      for (int E = 0; E < 8; ++E) { f32x4 rf = {0.f, 0.f, 0.f, 0.f}, rb = {0.f, 0.f, 0.f, 0.f};
#pragma unroll
          for (int ks = 0; ks < 4; ++ks) { rf = MFMA16(img_row_frag(SF, lane, E, ks), qf[ks], rf); rb = MFMA16(img_row_frag(SB, lane, E, ks), qf[ks], rb); }
          o[E] = rf * sf + rb * sb; } }
    f32x4 at[8];
#pragma unroll
    for (int T = 0; T < 8; ++T) { f32x4 c = {0.f, 0.f, 0.f, 0.f};
#pragma unroll
        for (int ks = 0; ks < 4; ++ks) c = MFMA16(img_row_frag(KI, lane, T, ks), qf[ks], c);
#pragma unroll
        for (int r = 0; r < 4; ++r) { const int j = 16 * T + 4 * g + r; const int dd = iloc > j ? iloc - j : j - iloc; c[r] *= (dd == 0 ? 2.0f : exp2f(l2g * (float)dd)); }
        at[T] = c; }
#pragma unroll
    for (int s = 0; s < 4; ++s) { const bf16x8 bfr = acc_pair_frag(at[2 * s], at[2 * s + 1]);
#pragma unroll
        for (int E = 0; E < 8; ++E) o[E] = MFMA16(img_tr_frag_acc(VI, lane, E, s), bfr, o[E]); }
    float ss = 0.f;
#pragma unroll
    for (int E = 0; E < 8; ++E) ss += (o[E].x * o[E].x + o[E].y * o[E].y) + (o[E].z * o[E].z + o[E].w * o[E].w);
    ss += __shfl_xor(ss, 16); ss += __shfl_xor(ss, 32);
    const float rn = rsqrtf(ss * (1.0f / 128.0f) + EPS);
    const size_t row = (size_t)rowbase + iloc;
    const bf16_t* gp = (const bf16_t*)(ws + WS_P) + row * LDP + PC_RG + h * 128 + 4 * g;
    const float* nw = a.in[I_RNW] + l * 512 + h * 128 + 4 * g;
    bf16_t* op = (bf16_t*)(ws + WS_H) + row * D + 1024 + h * 128 + 4 * g;
#pragma unroll
    for (int E = 0; E < 8; ++E) { const u32x2 gr = *(const u32x2*)(gp + 16 * E); const f32x4 nv = *(const f32x4*)(nw + 16 * E);
        u32x2 ov; ov.x = pk2(o[E].x * rn * nv.x * siluf_(bflo(gr.x)), o[E].y * rn * nv.y * siluf_(bfhi(gr.x)));
        ov.y = pk2(o[E].z * rn * nv.z * siluf_(bflo(gr.y)), o[E].w * rn * nv.w * siluf_(bfhi(gr.y)));
        *(u32x2*)(op + 16 * E) = ov; }
}
constexpr int GCH = 64, GNCH = 68;
constexpr size_t WS_GST = WS_OB + (size_t)2 * OBSZ * 2;
constexpr size_t WS_GDEC = WS_END;
constexpr size_t WS_H3B = WS_GDEC + (size_t)16 * 2 * GNCH * 64 * 4;
constexpr size_t WS_ROPE = WS_H3B + (size_t)2 * 4096 * 64 * 2;
constexpr size_t WS_END2 = WS_ROPE + (size_t)(SEQL + LC) * 64 * 8;
__device__ __forceinline__ int gla_rowbase(int b, int cg) { return cg < 4 ? NLAT + b * LC + cg * GCH : b * SEQL + (cg - 4) * GCH; }

constexpr int GLS = 68;
__device__ __forceinline__ void gla_gates_compute(const DArgs& a, unsigned char* ws, LAS float* BF, LAS float* BB, LAS float* GW  , int l, int h, int rowbase, int tid) {
    const int t = tid >> 3, d8 = tid & 7;
    const float* lr = (const float*)(ws + WS_LR) + (size_t)(rowbase + t) * 32;
    f32x4 lv[8];
#pragma unroll
    for (int q = 0; q < 8; ++q) lv[q] = ((const f32x4*)lr)[q];
    { const int dir = tid >> 8, r = (tid >> 4) & 15, c4 = (tid & 15) * 4;
      *(LAS f32x4*)(GW + (dir * 17 + r) * 64 + c4) = *(const f32x4*)(a.in[I_GGW] + (size_t)(l * 2 + dir) * 16 * 256 + r * 256 + h * 64 + c4);
      if (tid < 32) { const int dd = tid >> 4; *(LAS f32x4*)(GW + (dd * 17 + 16) * 64 + c4) = *(const f32x4*)(a.in[I_GGB] + (size_t)(l * 2 + dd) * 256 + h * 64 + c4); } }
    __syncthreads();
    bf16_t* GLG = (bf16_t*)(ws + WS_WIN);
#pragma unroll
    for (int dir = 0; dir < 2; ++dir) {
        const LAS float* gw = GW + dir * 17 * 64 + 8 * d8;
        f32x4 s0 = *(const LAS f32x4*)(gw + 16 * 64), s1 = *(const LAS f32x4*)(gw + 16 * 64 + 4);
#pragma unroll
        for (int j = 0; j < 16; ++j) { const float lj = lv[dir * 4 + (j >> 2)][j & 3]; s0 += lj * *(const LAS f32x4*)(gw + j * 64); s1 += lj * *(const LAS f32x4*)(gw + j * 64 + 4); }
        LAS float* dst = (dir ? BB : BF) + t * GLS + 8 * d8;
        float la[8];
#pragma unroll
        for (int x = 0; x < 8; ++x) { const float s = x < 4 ? s0[x] : s1[x - 4]; const float e = __expf(-fabsf(s)); const float ls = fminf(s, 0.f) - __logf(1.0f + e); la[x] = ls * (1.0f / 16.0f); }
        const u32x4 pk = pack8(la);
        *(u32x4*)(GLG + ((size_t)dir * MR + rowbase + t) * 256 + h * 64 + 8 * d8) = pk;
        float lq[8]; unpack8(pk, lq);
        *(LAS f32x4*)dst = (f32x4){lq[0], lq[1], lq[2], lq[3]}; *(LAS f32x4*)(dst + 4) = (f32x4){lq[4], lq[5], lq[6], lq[7]};
    }
}
__device__ __forceinline__ void gla_gates_load(unsigned char* ws, LAS float* BF, LAS float* BB, int h, int rowbase, int tid) {
    const int t = tid >> 3, d8 = tid & 7;
    const bf16_t* GLG = (const bf16_t*)(ws + WS_WIN);
#pragma unroll
    for (int dir = 0; dir < 2; ++dir) { float lq[8]; unpack8(*(const u32x4*)(GLG + ((size_t)dir * MR + rowbase + t) * 256 + h * 64 + 8 * d8), lq);
        LAS float* dst = (dir ? BB : BF) + t * GLS + 8 * d8;
        *(LAS f32x4*)dst = (f32x4){lq[0], lq[1], lq[2], lq[3]}; *(LAS f32x4*)(dst + 4) = (f32x4){lq[4], lq[5], lq[6], lq[7]}; }
}
__device__ __forceinline__ void gla_scan(LAS float* BF, LAS float* BB, int tid) {
    const int lane = tid & 63, w = tid >> 6;
    __syncthreads();
#pragma unroll 4
    for (int c = 0; c < 16; ++c) { const int col = 16 * w + c; const int dir = col >> 6, d = col & 63;
        LAS float* p = (dir ? BB : BF) + (dir ? 63 - lane : lane) * GLS + d;
        float v = *p;
#pragma unroll
        for (int off = 1; off < 64; off <<= 1) { const float u = __shfl_up(v, off); if (lane >= off) v += u; }
        *p = v; }
    __syncthreads();
}

__device__ __forceinline__ void gla_passA(const DArgs& a, unsigned char* ws, LAS unsigned char* lds, int l, int item, int tid) {
    const int bh = item / GNCH, cg = item % GNCH, b = bh >> 2, h = bh & 3;
    const int lane = tid & 63, w = tid >> 6, g = lane >> 4;
    LAS float* BF = (LAS float*)lds; LAS float* BB = (LAS float*)(lds + 17408); LAS unsigned char* KH = lds + 34816; LAS unsigned char* VI = lds + 34816 + 16384;
    const int rowbase = gla_rowbase(b, cg);
    const bf16_t* P = (const bf16_t*)(ws + WS_P) + (size_t)rowbase * LDP;
    const int t = tid >> 3, d8 = tid & 7;
    const u32x4 kraw = *(const u32x4*)(P + (size_t)t * LDP + PC_GK + h * 64 + 8 * d8);
    u32x4 vraw[2];
#pragma unroll
    for (int i = 0; i < 2; ++i) { const int n = tid + NT * i; vraw[i] = *(const u32x4*)(P + (size_t)(n >> 4) * LDP + PC_GV + h * 128 + (n & 15) * 8); }
    gla_gates_compute(a, ws, BF, BB, (LAS float*)(lds + 34816 + 32768), l, h, rowbase, tid);
    gla_scan(BF, BB, tid);
    { float kf[8], x0[8], x1[8]; unpack8(kraw, kf);
#pragma unroll
      for (int x = 0; x < 8; ++x) { const int d = 8 * d8 + x; x0[x] = kf[x] * __expf(BF[63 * GLS + d] - BF[t * GLS + d]); x1[x] = kf[x] * __expf(BB[d] - BB[t * GLS + d]); }
      *(LAS u32x4*)(KH + off_b(t, d8)) = pack8(x0); *(LAS u32x4*)(KH + off_b(t, 8 + d8)) = pack8(x1);
#pragma unroll
      for (int i = 0; i < 2; ++i) { const int n = tid + NT * i; *(LAS u32x4*)(VI + off_b(n >> 4, n & 15)) = vraw[i]; }
      if (tid < 128) { const int dir = tid >> 6, d = tid & 63; ((float*)(ws + WS_GDEC))[((size_t)(bh * 2 + dir) * GNCH + cg) * 64 + d] = __expf(dir ? BB[d] : BF[63 * GLS + d]); } }
    __syncthreads();
    const int dir = w >> 2, Dt = w & 3;
    bf16x8 af[2];
#pragma unroll
    for (int ks = 0; ks < 2; ++ks) af[ks] = img_tr_frag(KH, lane, dir * 4 + Dt, ks);
    bf16_t* ST = (bf16_t*)(ws + WS_GST) + ((size_t)(bh * 2 + dir) * GNCH + cg) * (128 * 64);
#pragma unroll 2
    for (int E = 0; E < 8; ++E) {
        f32x4 c = {0.f, 0.f, 0.f, 0.f};
#pragma unroll
        for (int ks = 0; ks < 2; ++ks) c = MFMA16(af[ks], img_tr_frag(VI, lane, E, ks), c);
        u32x2 o; o.x = pk2(c.x, c.y); o.y = pk2(c.z, c.w);
        *(u32x2*)(ST + (size_t)(16 * E + (lane & 15)) * 64 + 16 * Dt + 4 * g) = o;
    }
}
__device__ __forceinline__ void gla_passB(unsigned char* ws, LAS unsigned char* lds, int blk, int tid) {
    const int bd = blk >> 1, dir = bd & 1, el = (blk & 1) * 512 + tid;
    LAS float* decs = (LAS float*)lds;
    { const float* dsrc = (const float*)(ws + WS_GDEC) + (size_t)bd * GNCH * 64;
      for (int i = tid; i < GNCH * 64; i += NT) decs[i] = dsrc[i]; }
    __syncthreads();
    bf16_t* base = (bf16_t*)(ws + WS_GST) + (size_t)bd * GNCH * (128 * 64) + (size_t)el * 8;
    const int d0 = (el & 7) * 8;
    float acc[8];
#pragma unroll
    for (int x = 0; x < 8; ++x) acc[x] = 0.f;
#pragma unroll 1
    for (int s0 = 0; s0 < GNCH; s0 += 17) {
        u32x4 kvr[17];
#pragma unroll
        for (int j = 0; j < 17; ++j) { const int s = s0 + j; const int cg = dir == 0 ? s : (s < 4 ? 3 - s : 71 - s); kvr[j] = *(const u32x4*)(base + (size_t)cg * (128 * 64)); }
#pragma unroll
        for (int j = 0; j < 17; ++j) { const int s = s0 + j; const int cg = dir == 0 ? s : (s < 4 ? 3 - s : 71 - s);
            float kv[8]; unpack8(kvr[j], kv);
            const f32x4 q0 = *(const LAS f32x4*)(decs + cg * 64 + d0), q1 = *(const LAS f32x4*)(decs + cg * 64 + d0 + 4);
            *(u32x4*)(base + (size_t)cg * (128 * 64)) = pack8(acc);
#pragma unroll
            for (int x = 0; x < 8; ++x) acc[x] = (x < 4 ? q0[x] : q1[x - 4]) * acc[x] + kv[x]; }
    }
    __syncthreads();
}
__device__ __forceinline__ void gla_passC(const DArgs& a, unsigned char* ws, LAS unsigned char* lds, int l, int item, int tid) {
    const int bh = item / GNCH, cg = item % GNCH, b = bh >> 2, h = bh & 3;
    const int lane = tid & 63, w = tid >> 6, g = lane >> 4, il = lane & 15;
    LAS float* BF = (LAS float*)lds; LAS float* BB = (LAS float*)(lds + 17408);
    LAS unsigned char* QKF = lds + 34816; LAS unsigned char* QKB = QKF + 16384; LAS unsigned char* QH = QKB + 16384; LAS unsigned char* VI = QH + 16384; LAS unsigned char* SI = VI + 16384;
    const int rowbase = gla_rowbase(b, cg);
    const bf16_t* P = (const bf16_t*)(ws + WS_P) + (size_t)rowbase * LDP;
    const int t = tid >> 3, d8 = tid & 7;
    const u32x4 qraw = *(const u32x4*)(P + (size_t)t * LDP + PC_GQ + h * 64 + 8 * d8), kraw = *(const u32x4*)(P + (size_t)t * LDP + PC_GK + h * 64 + 8 * d8);
    u32x4 vraw[2], sraw[4];
#pragma unroll
    for (int i = 0; i < 2; ++i) { const int n = tid + NT * i; vraw[i] = *(const u32x4*)(P + (size_t)(n >> 4) * LDP + PC_GV + h * 128 + (n & 15) * 8); }
    { const bf16_t* STf = (const bf16_t*)(ws + WS_GST) + ((size_t)(bh * 2) * GNCH + cg) * (128 * 64); const bf16_t* STb = STf + (size_t)GNCH * 128 * 64;
#pragma unroll
      for (int i = 0; i < 4; ++i) { const int n = tid + NT * i, row = n >> 4, ch = n & 15; sraw[i] = *(const u32x4*)((ch < 8 ? STf : STb) + (size_t)row * 64 + (ch & 7) * 8); } }
    gla_gates_load(ws, BF, BB, h, rowbase, tid);
    gla_scan(BF, BB, tid);
    { float qf[8], kf[8], o0[8], o1[8], o2[8], o3[8], o4[8], o5[8];
      unpack8(qraw, qf); unpack8(kraw, kf);
#pragma unroll
      for (int x = 0; x < 8; ++x) { const int d = 8 * d8 + x; const float bf = BF[t * GLS + d], bb = BB[t * GLS + d], rf = BF[31 * GLS + d], rb = BB[32 * GLS + d]; const float q = qf[x] * 0.125f;
          o0[x] = q * __expf(bf - rf); o1[x] = kf[x] * __expf(rf - bf); o2[x] = q * __expf(bb - rb); o3[x] = kf[x] * __expf(rb - bb); o4[x] = q * __expf(bf); o5[x] = q * __expf(bb); }
      *(LAS u32x4*)(QKF + off_b(t, d8)) = pack8(o0); *(LAS u32x4*)(QKF + off_b(t, 8 + d8)) = pack8(o1);
      *(LAS u32x4*)(QKB + off_b(t, d8)) = pack8(o2); *(LAS u32x4*)(QKB + off_b(t, 8 + d8)) = pack8(o3);
      *(LAS u32x4*)(QH + off_b(t, d8)) = pack8(o4); *(LAS u32x4*)(QH + off_b(t, 8 + d8)) = pack8(o5);
#pragma unroll
      for (int i = 0; i < 2; ++i) { const int n = tid + NT * i; *(LAS u32x4*)(VI + off_b(n >> 4, n & 15)) = vraw[i]; }
#pragma unroll
      for (int i = 0; i < 4; ++i) { const int n = tid + NT * i; *(LAS u32x4*)(SI + off_b(n >> 4, n & 15)) = sraw[i]; } }
    __syncthreads();
    const int ib = w & 3, eh = w >> 2, iloc = 16 * ib + il;
    f32x4 at[4];
    { bf16x8 qff[2], qfb[2];
#pragma unroll
      for (int ks = 0; ks < 2; ++ks) { qff[ks] = img_row_frag(QKF, lane, ib, ks); qfb[ks] = img_row_frag(QKB, lane, ib, ks); }
#pragma unroll
      for (int T = 0; T < 4; ++T) { f32x4 cf = {0.f, 0.f, 0.f, 0.f}, cb = {0.f, 0.f, 0.f, 0.f};
#pragma unroll
          for (int ks = 0; ks < 2; ++ks) { cf = MFMA16(img_row_frag(QKF, lane, T, 2 + ks), qff[ks], cf); cb = MFMA16(img_row_frag(QKB, lane, T, 2 + ks), qfb[ks], cb); }
#pragma unroll
          for (int r = 0; r < 4; ++r) { const int j = 16 * T + 4 * g + r; cf[r] = (j <= iloc ? cf[r] : 0.f) + (j >= iloc ? cb[r] : 0.f); }
          at[T] = cf; } }
    f32x4 o[4];
    { bf16x8 hf[2], hb[2];
#pragma unroll
      for (int ks = 0; ks < 2; ++ks) { hf[ks] = img_row_frag(QH, lane, ib, ks); hb[ks] = img_row_frag(QH, lane, ib, 2 + ks); }
#pragma unroll
      for (int E4 = 0; E4 < 4; ++E4) { const int E = 4 * eh + E4; f32x4 c = {0.f, 0.f, 0.f, 0.f};
#pragma unroll
          for (int ks = 0; ks < 2; ++ks) { c = MFMA16(img_row_frag(SI, lane, E, ks), hf[ks], c); c = MFMA16(img_row_frag(SI, lane, E, 2 + ks), hb[ks], c); }
          o[E4] = c; } }
#pragma unroll
    for (int s = 0; s < 2; ++s) { const bf16x8 bfr = acc_pair_frag(at[2 * s], at[2 * s + 1]);
#pragma unroll
        for (int E4 = 0; E4 < 4; ++E4) o[E4] = MFMA16(img_tr_frag_acc(VI, lane, 4 * eh + E4, s), bfr, o[E4]); }
    float ss = 0.f;
#pragma unroll
    for (int E4 = 0; E4 < 4; ++E4) ss += (o[E4].x * o[E4].x + o[E4].y * o[E4].y) + (o[E4].z * o[E4].z + o[E4].w * o[E4].w);
    ss += __shfl_xor(ss, 16); ss += __shfl_xor(ss, 32);
    LAS float* red = (LAS float*)lds;
    if (g == 0) red[eh * 64 + iloc] = ss;
    __syncthreads();
    const float rn = rsqrtf((red[iloc] + red[64 + iloc]) * (1.0f / 128.0f) + EPS);
    const size_t row = (size_t)rowbase + iloc;
    const bf16_t* gp = (const bf16_t*)(ws + WS_P) + row * LDP + PC_GG + h * 128 + 64 * eh + 4 * g;
    const float* nw = a.in[I_GNW] + l * 512 + h * 128 + 64 * eh + 4 * g;
    bf16_t* op = (bf16_t*)(ws + WS_H) + row * D + 1536 + h * 128 + 64 * eh + 4 * g;
#pragma unroll
    for (int E4 = 0; E4 < 4; ++E4) { const u32x2 gr = *(const u32x2*)(gp + 16 * E4); const f32x4 nv = *(const f32x4*)(nw + 16 * E4);
        u32x2 ov; ov.x = pk2(o[E4].x * rn * nv.x * siluf_(bflo(gr.x)), o[E4].y * rn * nv.y * siluf_(bfhi(gr.x)));
        ov.y = pk2(o[E4].z * rn * nv.z * siluf_(bflo(gr.y)), o[E4].w * rn * nv.w * siluf_(bfhi(gr.y)));
        *(u32x2*)(op + 16 * E4) = ov; }
}
constexpr int SNCH = 68;
constexpr size_t WS_S5ST = WS_OB + (size_t)4 * OBSZ * 2;
constexpr size_t WS_S5BTB = WS_S5BT;
constexpr size_t WS_S5CPB = WS_S5BT + 524288;
constexpr size_t WS_S5A64 = WS_S5BT + 1048576;

__device__ __forceinline__ void prep_s5b(const DArgs& a, unsigned char* ws, int it, int tid) {
    const int idx = it * 512 + tid;
    const int gi = idx >> 6, p = idx & 63;
    const float a_re = a.in[I_S5ARE][idx], a_im = a.in[I_S5AIM][idx], ldt = a.in[I_S5LDT][gi];
    const float dt = expf(ldt), mag = expf(a_re * dt);
    float sn, cs; sincosf(a_im * dt, &sn, &cs);
    const float ab_re = mag * cs, ab_im = mag * sn, den = a_re * a_re + a_im * a_im, nr = ab_re - 1.0f;
    const float co_re = (nr * a_re + ab_im * a_im) / den, co_im = (ab_im * a_re - nr * a_im) / den;
    ((f32x2*)(ws + WS_S5AB))[idx] = (f32x2){ab_re, ab_im};
    float pr = ab_re, pi = ab_im;
#pragma unroll
    for (int q = 0; q < 6; ++q) { const float nr2 = pr * pr - pi * pi, ni2 = 2.0f * pr * pi; pr = nr2; pi = ni2; }
    ((f32x2*)(ws + WS_S5A64))[idx] = (f32x2){pr, pi};
    const float* bre = a.in[I_S5BRE] + (size_t)idx * 16; const float* bim = a.in[I_S5BIM] + (size_t)idx * 16;
    float tr[16], ti[16];
#pragma unroll
    for (int i = 0; i < 16; ++i) { const float br = bre[i], bi = bim[i]; tr[i] = co_re * br - co_im * bi; ti[i] = co_re * bi + co_im * br; }
    bf16_t* btb = (bf16_t*)(ws + WS_S5BTB) + (size_t)gi * 128 * 16;
#pragma unroll
    for (int hlf = 0; hlf < 2; ++hlf) { u32x4 w0, w1; const float* s = hlf ? ti : tr;
        w0.x = pk2(s[0], s[1]); w0.y = pk2(s[2], s[3]); w0.z = pk2(s[4], s[5]); w0.w = pk2(s[6], s[7]); w1.x = pk2(s[8], s[9]); w1.y = pk2(s[10], s[11]); w1.z = pk2(s[12], s[13]); w1.w = pk2(s[14], s[15]);
        *(u32x4*)(btb + (size_t)(64 * hlf + p) * 16) = w0; *(u32x4*)(btb + (size_t)(64 * hlf + p) * 16 + 8) = w1; }
    bf16_t* cpb = (bf16_t*)(ws + WS_S5CPB) + (size_t)gi * 16 * 128;
    const float* cre = a.in[I_S5CRE] + (size_t)gi * 1024; const float* cim = a.in[I_S5CIM] + (size_t)gi * 1024;
#pragma unroll
    for (int i = 0; i < 16; ++i) *(unsigned*)(cpb + i * 128 + 2 * p) = pk2(cre[i * 64 + p], -cim[i * 64 + p]);
}

struct S5Unit { bf16x8 btf[8]; f32x2 ab; f32x2 h; const bf16_t* cp; };
template <bool PASSC> __device__ __forceinline__ void s5_load_unit(S5Unit& U, unsigned char* ws, const bf16_t* P, const f32x2* ST, int l, int b, int cs, int rowbase, int grp, int dir, int lane) {
    const int g = lane >> 4, il = lane & 15;
    const bf16x8 zero8 = {0, 0, 0, 0, 0, 0, 0, 0};
    const int gi = (l * 2 + dir) * 32 + grp;
    U.ab = ((const f32x2*)(ws + WS_S5AB))[gi * 64 + lane];
    const size_t sidx = ((size_t)(b * SNCH + cs) * 2 + dir) * 2048 + grp * 64 + lane;
    U.h = PASSC ? ST[sidx] : (f32x2){0.f, 0.f};
    const bf16_t* bt = (const bf16_t*)(ws + WS_S5BTB) + (size_t)gi * 128 * 16 + (size_t)il * 16 + 8 * (g & 1);
#pragma unroll
    for (int Pt = 0; Pt < 8; ++Pt) { const bf16x8 v = *(const bf16x8*)(bt + Pt * 256); U.btf[Pt] = g < 2 ? v : zero8; }
    U.cp = (const bf16_t*)(ws + WS_S5CPB) + (size_t)gi * 16 * 128 + (size_t)il * 128 + 8 * g;
}
__device__ __forceinline__ void s5_load_u(bf16x8 (&ufa)[4], const bf16_t* P, int rowbase, int grp, int lane) {
    const int g = lane >> 4, il = lane & 15; const bf16x8 zero8 = {0, 0, 0, 0, 0, 0, 0, 0};
#pragma unroll
    for (int Tt = 0; Tt < 4; ++Tt) { const bf16x8 v = *(const bf16x8*)(P + (size_t)(rowbase + 16 * Tt + il) * LDP + PC_S5U + grp * 16 + 8 * (g & 1)); ufa[Tt] = g < 2 ? v : zero8; }
}
template <bool PASSC, int DIR> __device__ __forceinline__ void s5_run_unit(const S5Unit& U, const bf16x8 (&ufa)[4], f32x4 (&yacc)[4], f32x2& hout, LAS float* BU, LAS unsigned char* HW, int lane) {
    const int g = lane >> 4, il = lane & 15;
    f32x2 h = U.h; const f32x2 ab = U.ab;
    bf16x8 cpf[4];
    if (PASSC) {
#pragma unroll
        for (int ks = 0; ks < 4; ++ks) cpf[ks] = *(const bf16x8*)(U.cp + 32 * ks); }
    f32x4 d[8];
#pragma unroll
    for (int Pt = 0; Pt < 8; ++Pt) d[Pt] = MFMA16(U.btf[Pt], ufa[DIR ? 3 : 0], ((f32x4){0.f, 0.f, 0.f, 0.f}));
#pragma unroll
    for (int wi = 0; wi < 4; ++wi) {
        const int Tt = DIR ? 3 - wi : wi;
#pragma unroll
        for (int Pt = 0; Pt < 8; ++Pt) {
#pragma unroll
            for (int r = 0; r < 4; ++r) BU[(16 * Pt + 4 * g + r) * 20 + il] = d[Pt][r]; }
        asm volatile("" ::: "memory");
        f32x4 br[4], bi[4];
#pragma unroll
        for (int q = 0; q < 4; ++q) { br[q] = *(const LAS f32x4*)(BU + lane * 20 + 4 * q); bi[q] = *(const LAS f32x4*)(BU + (64 + lane) * 20 + 4 * q); }
        if (wi < 3) {
#pragma unroll
            for (int Pt = 0; Pt < 8; ++Pt) d[Pt] = MFMA16(U.btf[Pt], ufa[DIR ? 2 - wi : wi + 1], ((f32x4){0.f, 0.f, 0.f, 0.f})); }
#pragma unroll
        for (int s = 0; s < 16; ++s) { const int tt = DIR ? 15 - s : s;
            const float hr = ab.x * h.x - ab.y * h.y + br[tt >> 2][tt & 3], hi = ab.x * h.y + ab.y * h.x + bi[tt >> 2][tt & 3];
            h = (f32x2){hr, hi};
            if (PASSC) *(LAS unsigned*)(HW + off_b(tt, lane >> 2) + (lane & 3) * 4) = pk2(hr, hi); }
        asm volatile("" ::: "memory");
        if (PASSC) {
            bf16x8 hf[4];
#pragma unroll
            for (int ks = 0; ks < 4; ++ks) hf[ks] = img_row_frag(HW, lane, 0, ks);
#pragma unroll
            for (int ks = 0; ks < 4; ++ks) yacc[Tt] = MFMA16(cpf[ks], hf[ks], yacc[Tt]); }
        asm volatile("" ::: "memory");
    }
    hout = h;
}
template <bool PASSC> __device__ __forceinline__ void s5_item(const DArgs& a, unsigned char* ws, LAS unsigned char* lds, int l, int item, int tid) {
    const int b = item / (SNCH * 2), rem = item % (SNCH * 2), cs = rem >> 1, half = rem & 1;
    const int lane = tid & 63, w = tid >> 6, g = lane >> 4, il = lane & 15;
    const int rowbase = gla_rowbase(b, cs);
    LAS float* BU = (LAS float*)(lds + w * 14336); LAS unsigned char* HW = lds + w * 14336 + 10240;
    const bf16_t* P = (const bf16_t*)(ws + WS_P);
    f32x2* ST = (f32x2*)(ws + WS_S5ST);
    const int grp0 = 16 * half + w, grp1 = grp0 + 8;
    S5Unit UA; bf16x8 ufa[4];
#pragma unroll 1
    for (int gg = 0; gg < 2; ++gg) {
        const int grp = gg ? grp1 : grp0;
        f32x4 yacc[4];
#pragma unroll
        for (int q = 0; q < 4; ++q) yacc[q] = (f32x4){0.f, 0.f, 0.f, 0.f};
        f32x2 hend;
        s5_load_unit<PASSC>(UA, ws, P, ST, l, b, cs, rowbase, grp, 0, lane); s5_load_u(ufa, P, rowbase, grp, lane);
        s5_run_unit<PASSC, 0>(UA, ufa, yacc, hend, BU, HW, lane);
        if (!PASSC) ST[((size_t)(b * SNCH + cs) * 2 + 0) * 2048 + grp * 64 + lane] = hend;
        s5_load_unit<PASSC>(UA, ws, P, ST, l, b, cs, rowbase, grp, 1, lane);
        s5_run_unit<PASSC, 1>(UA, ufa, yacc, hend, BU, HW, lane);
        if (!PASSC) ST[((size_t)(b * SNCH + cs) * 2 + 1) * 2048 + grp * 64 + lane] = hend;
        if (PASSC) {
            const f32x4 dsk = *(const f32x4*)(a.in[I_S5D] + l * 512 + grp * 16 + 4 * g);
            bf16_t* G5 = (bf16_t*)(ws + WS_KF);
#pragma unroll
            for (int Tt = 0; Tt < 4; ++Tt) { const size_t row = (size_t)rowbase + 16 * Tt + il;
                const u32x2 ur = *(const u32x2*)(P + row * LDP + PC_S5U + grp * 16 + 4 * g), sg = *(const u32x2*)(P + row * LDP + PC_S5G + grp * 16 + 4 * g);
                const float g0 = gelu_tanh(yacc[Tt].x + bflo(ur.x) * dsk.x), g1 = gelu_tanh(yacc[Tt].y + bfhi(ur.x) * dsk.y), g2 = gelu_tanh(yacc[Tt].z + bflo(ur.y) * dsk.z), g3 = gelu_tanh(yacc[Tt].w + bfhi(ur.y) * dsk.w);
                u32x2 ov; ov.x = pk2(g0, g1); ov.y = pk2(g2, g3);
                *(u32x2*)(G5 + row * 512 + grp * 16 + 4 * g) = ov;
                ov.x = pk2(g0 * siluf_(bflo(sg.x)), g1 * siluf_(bfhi(sg.x))); ov.y = pk2(g2 * siluf_(bflo(sg.y)), g3 * siluf_(bfhi(sg.y)));
                *(u32x2*)(G5 + OBSZ + row * 512 + grp * 16 + 4 * g) = ov; }
        }
    }
}
__device__ __forceinline__ void s5_passB(unsigned char* ws, int l, int gt) {
    const int p = gt & 63, grp = (gt >> 6) & 31, dir = (gt >> 11) & 1, b = gt >> 12;
    const f32x2 a64 = ((const f32x2*)(ws + WS_S5A64))[((l * 2 + dir) * 32 + grp) * 64 + p];
    f32x2* ST = (f32x2*)(ws + WS_S5ST);
    f32x2 acc = {0.f, 0.f};
#pragma unroll 1
    for (int s0 = 0; s0 < SNCH; s0 += 34) {
        f32x2 ev[34];
#pragma unroll
        for (int j = 0; j < 34; ++j) { const int s = s0 + j; const int cs = dir == 0 ? s : (s < 4 ? 3 - s : 71 - s); ev[j] = ST[((size_t)(b * SNCH + cs) * 2 + dir) * 2048 + grp * 64 + p]; }
#pragma unroll
        for (int j = 0; j < 34; ++j) { const int s = s0 + j; const int cs = dir == 0 ? s : (s < 4 ? 3 - s : 71 - s);
            ST[((size_t)(b * SNCH + cs) * 2 + dir) * 2048 + grp * 64 + p] = acc;
            acc = (f32x2){a64.x * acc.x - a64.y * acc.y + ev[j].x, a64.x * acc.y + a64.y * acc.x + ev[j].y}; }
    }
}
constexpr int FFT_PHYS = 9216;
__device__ __forceinline__ int fphys(int i) { return i + (i >> 3); }
__device__ __forceinline__ f32x2 cmulf(const f32x2 a, const f32x2 b) { return (f32x2){a.x * b.x - a.y * b.y, a.x * b.y + a.y * b.x}; }
__device__ __forceinline__ f32x2 cmulcf(const f32x2 a, const f32x2 b) { return (f32x2){a.x * b.x + a.y * b.y, a.y * b.x - a.x * b.y}; }
template <int RL> __device__ __forceinline__ void dft_fwd_const(f32x2 (&e)[1 << RL]) {
#pragma unroll
    for (int s = 0; s < RL; ++s) { const int h = 1 << (RL - 1 - s);
#pragma unroll
        for (int m = 0; m < (1 << RL); ++m) { if (m & h) continue;
            const int mp = m & (h - 1); const f32x2 a_ = e[m], b_ = e[m | h]; const f32x2 d = a_ - b_; e[m] = a_ + b_;
            if (mp == 0) e[m | h] = d;
            else if (2 * mp == h) e[m | h] = (f32x2){d.y, -d.x};
            else { const float ang = -3.14159265358979323846f * (float)mp / (float)h; const f32x2 c = {__builtin_cosf(ang), __builtin_sinf(ang)}; e[m | h] = cmulf(d, c); } } }
}
template <int RL> __device__ __forceinline__ void dft_inv_const(f32x2 (&e)[1 << RL]) {
#pragma unroll
    for (int ss = 0; ss < RL; ++ss) { const int s = RL - 1 - ss; const int h = 1 << (RL - 1 - s);
#pragma unroll
        for (int m = 0; m < (1 << RL); ++m) { if (m & h) continue;
            const int mp = m & (h - 1); const f32x2 a_ = e[m], b_ = e[m | h]; f32x2 t;
            if (mp == 0) t = b_;
            else if (2 * mp == h) t = (f32x2){-b_.y, b_.x};
            else { const float ang = -3.14159265358979323846f * (float)mp / (float)h; const f32x2 c = {__builtin_cosf(ang), __builtin_sinf(ang)}; t = cmulcf(b_, c); }
            e[m] = a_ + t; e[m | h] = a_ - t; } }
}
template <int RL> __device__ __forceinline__ constexpr int brev_c(int m) { int r = 0; for (int i = 0; i < RL; ++i) r |= ((m >> i) & 1) << (RL - 1 - i); return r; }
template <int RL, bool CONJ> __device__ __forceinline__ void apply_tw(f32x2 (&e)[1 << RL], const f32x2 w1) {
    f32x2 tw[1 << RL];
    tw[0] = (f32x2){1.f, 0.f}; tw[1] = w1;
    if (RL >= 2) { tw[2] = cmulf(w1, w1); tw[3] = cmulf(tw[2], w1); }
    if (RL >= 3) { tw[4] = cmulf(tw[2], tw[2]); tw[5] = cmulf(tw[4], tw[1]); tw[6] = cmulf(tw[4], tw[2]); tw[7] = cmulf(tw[4], tw[3]); }
    if (RL >= 4) { tw[8] = cmulf(tw[4], tw[4]);
#pragma unroll
        for (int k = 1; k < 8; ++k) tw[8 + k] = cmulf(tw[8], tw[k]); }
#pragma unroll
    for (int m = 1; m < (1 << RL); ++m) e[m] = CONJ ? cmulcf(e[m], tw[brev_c<RL>(m)]) : cmulf(e[m], tw[brev_c<RL>(m)]);
}
template <int RL, int BETA, bool INV> __device__ __forceinline__ void fft2_pass(LAS f32x2* X, const LAS f32x2* W, int tid) {
    constexpr int LOW = BETA - RL + 1, NG = FFTN >> RL, STR = (1 << LOW) + (1 << (LOW - 3));
#pragma unroll 1
    for (int gi = tid; gi < NG; gi += NT) {
        const int base = ((gi >> LOW) << (BETA + 1)) | (gi & ((1 << LOW) - 1));
        LAS f32x2* p = X + fphys(base);
        f32x2 e[1 << RL];
#pragma unroll
        for (int m = 0; m < (1 << RL); ++m) e[m] = p[m * STR];
        const f32x2 w1 = W[(base & ((1 << LOW) - 1)) << (12 - BETA)];
        if (!INV) { dft_fwd_const<RL>(e); apply_tw<RL, false>(e, w1); }
        else { apply_tw<RL, true>(e, w1); dft_inv_const<RL>(e); }
#pragma unroll
        for (int m = 0; m < (1 << RL); ++m) p[m * STR] = e[m];
    }
}
__device__ __forceinline__ void fft2_fwd_ABC(LAS f32x2* X, const LAS f32x2* W, int tid) {
    fft2_pass<4, 12, false>(X, W, tid); __syncthreads(); fft2_pass<3, 8, false>(X, W, tid); __syncthreads(); fft2_pass<3, 5, false>(X, W, tid); __syncthreads();
}
__device__ __forceinline__ void fft2_inv_CBA(LAS f32x2* X, const LAS f32x2* W, int tid) {
    fft2_pass<3, 5, true>(X, W, tid); __syncthreads(); fft2_pass<3, 8, true>(X, W, tid); __syncthreads(); fft2_pass<4, 12, true>(X, W, tid); __syncthreads();
}
__device__ __forceinline__ void fft2_mid_mul(LAS f32x2* X, const f32x2* KF, int tid) {
#pragma unroll 1
    for (int gi = tid; gi < 1024; gi += NT) {
        LAS f32x2* p = X + 9 * gi;
        f32x2 e[8]; f32x4 kf[4];
#pragma unroll
        for (int q = 0; q < 4; ++q) kf[q] = *(const f32x4*)(KF + 8 * gi + 2 * q);
#pragma unroll
        for (int m = 0; m < 8; ++m) e[m] = p[m];
        dft_fwd_const<3>(e);
#pragma unroll
        for (int q = 0; q < 4; ++q) { e[2 * q] = cmulf(e[2 * q], (f32x2){kf[q].x, kf[q].y}); e[2 * q + 1] = cmulf(e[2 * q + 1], (f32x2){kf[q].z, kf[q].w}); }
        dft_inv_const<3>(e);
#pragma unroll
        for (int m = 0; m < 8; ++m) p[m] = e[m];
    }
}
__device__ __forceinline__ void fft2_fwd_D(LAS f32x2* X, int tid) {
#pragma unroll 1
    for (int gi = tid; gi < 1024; gi += NT) { LAS f32x2* p = X + 9 * gi; f32x2 e[8];
#pragma unroll
        for (int m = 0; m < 8; ++m) e[m] = p[m];
        dft_fwd_const<3>(e);
#pragma unroll
        for (int m = 0; m < 8; ++m) p[m] = e[m]; }
}

__device__ __forceinline__ void filt_item2(const DArgs& a, unsigned char* ws, LAS unsigned char* lds, int l, int c, int tid) {
    LAS f32x2* X = (LAS f32x2*)lds; LAS f32x2* W = (LAS f32x2*)(lds + FFT_PHYS * 8); LAS float* w4s = (LAS float*)(lds + FFT_PHYS * 8 + 32768); LAS float* red = w4s + 256;
    fft_twiddles(W, tid);
    if (tid < 128) { const int cc = tid >> 5, pr = tid & 31; const float* wsrc = a.in[I_HW4] + (size_t)l * 64 * 2048 + (cc >> 1) * 1024 + (cc & 1) * 512 + c;
        ((LAS unsigned*)w4s)[pr * 4 + cc] = pk2(wsrc[(size_t)(2 * pr) * 2048], wsrc[(size_t)(2 * pr + 1) * 2048]); }
    if (tid == 0) { float z0; asm volatile("v_mov_b32 %0, 0" : "=v"(z0)); X[fphys(4096)] = (f32x2){z0, z0}; }
    __syncthreads();
    const float dl = fabsf(HY_D0 + (HY_D1 - HY_D0) * ((float)c / 511.0f));
    const bf16_t* H3 = (const bf16_t*)(ws + WS_H3B) + (size_t)l * 4096 * 64;
    float ss0 = 0.f, ss1 = 0.f;
#pragma unroll 1
    for (int j = 0; j < 8; ++j) {
        const int t = tid + 512 * j;
        const u32x4* hr = (const u32x4*)(H3 + (size_t)t * 64);
        u32x4 hraw[8];
#pragma unroll
        for (int q = 0; q < 8; ++q) hraw[q] = hr[q];
        asm volatile("" ::: "memory");
        float f0 = 0.f, f1 = 0.f, b0 = 0.f, b1 = 0.f;
        typedef __bf16 bfp2 __attribute__((ext_vector_type(2)));
#pragma unroll
        for (int q = 0; q < 8; ++q) {
#pragma unroll
            for (int e = 0; e < 4; ++e) { const u32x4 wq = ((const LAS u32x4*)w4s)[4 * q + e]; const unsigned hx = hraw[q][e];
                f0 += bflo(hx) * bflo(wq.x) + bfhi(hx) * bfhi(wq.x); f1 += bflo(hx) * bflo(wq.y) + bfhi(hx) * bfhi(wq.y);
                b0 += bflo(hx) * bflo(wq.z) + bfhi(hx) * bfhi(wq.z); b1 += bflo(hx) * bflo(wq.w) + bfhi(hx) * bfhi(wq.w); } }
        const float dec = expf(-((float)t / 4095.0f) * dl); f0 *= dec; f1 *= dec; b0 *= dec; b1 *= dec;
        X[fphys(t)] = (f32x2){f0, f1}; ss0 += f0 * f0; ss1 += f1 * f1;
        if (t > 0) { X[fphys(8192 - t)] = (f32x2){b0, b1}; ss0 += b0 * b0; ss1 += b1 * b1; }
    }
    const float rs0 = rsqrtf(block_sum(ss0, red, tid) + EPS), rs1 = rsqrtf(block_sum(ss1, red, tid) + EPS);
#pragma unroll 4
    for (int j = 0; j < 16; ++j) { const int n = fphys(tid + 512 * j); const f32x2 x = X[n]; X[n] = (f32x2){x.x * rs0, x.y * rs1}; }
    __syncthreads(); fft2_fwd_ABC(X, W, tid); fft2_fwd_D(X, tid); __syncthreads();
    f32x2* KF0 = (f32x2*)(ws + WS_KF) + (size_t)(0 * 512 + c) * FFTN; f32x2* KF1 = (f32x2*)(ws + WS_KF) + (size_t)(1 * 512 + c) * FFTN;
#pragma unroll 4
    for (int j = 0; j < 16; ++j) { const int pos = tid + 512 * j; const int k = (int)(__brev((unsigned)pos) >> 19); const int pp = (int)(__brev((unsigned)((8192 - k) & 8191)) >> 19);
        const f32x2 za = X[fphys(pos)], zb = X[fphys(pp)];
        KF0[pos] = (f32x2){0.5f * (za.x + zb.x), 0.5f * (za.y - zb.y)};
        KF1[pos] = (f32x2){0.5f * (za.y + zb.y), 0.5f * (zb.x - za.x)}; }
    __syncthreads();
}

struct Raw8 { u32x4 mid; bf16_t lf, rt; };
__device__ __forceinline__ Raw8 ld_raw8(const bf16_t* p, int t0, int Lx) { Raw8 r; r.mid = *(const u32x4*)(p + t0); r.lf = t0 > 0 ? p[t0 - 1] : (bf16_t)0; r.rt = t0 + 8 < Lx ? p[t0 + 8] : (bf16_t)0; return r; }
__device__ __forceinline__ void sconv8(const Raw8& r, float w0, float w1, float w2, float cb, float (&o)[8]) {
    float x[10]; x[0] = bf2f(r.lf); x[9] = bf2f(r.rt);
    x[1] = bflo(r.mid.x); x[2] = bfhi(r.mid.x); x[3] = bflo(r.mid.y); x[4] = bfhi(r.mid.y); x[5] = bflo(r.mid.z); x[6] = bfhi(r.mid.z); x[7] = bflo(r.mid.w); x[8] = bfhi(r.mid.w);
#pragma unroll
    for (int i = 0; i < 8; ++i) o[i] = w0 * x[i] + w1 * x[i + 1] + w2 * x[i + 2] + cb;
}
__device__ __forceinline__ void hyena_item2(const DArgs& a, unsigned char* ws, LAS unsigned char* lds, int l, int c, int tid) {
    LAS f32x2* X = (LAS f32x2*)lds; LAS f32x2* W = (LAS f32x2*)(lds + FFT_PHYS * 8);
    fft_twiddles(W, tid);
    const float* cw = a.in[I_HCW] + (size_t)l * 3 * 1536; const float* cbp = a.in[I_HCB] + (size_t)l * 1536;
    const float wv0 = cw[c], wv1 = cw[1536 + c], wv2 = cw[3072 + c], bv = cbp[c];
    const float wa0 = cw[512 + c], wa1 = cw[1536 + 512 + c], wa2 = cw[3072 + 512 + c], ba = cbp[512 + c];
    const float wb0 = cw[1024 + c], wb1 = cw[1536 + 1024 + c], wb2 = cw[3072 + 1024 + c], bb = cbp[1024 + c];
    const float bias0 = a.in[I_HBIAS][(l * 2 + 0) * 512 + c], bias1 = a.in[I_HBIAS][(l * 2 + 1) * 512 + c];
    const bf16_t* PT = (const bf16_t*)(ws + WS_PT);
    const bf16_t* pv = PT + (size_t)(PT_V + c) * MR; const bf16_t* pg1 = PT + (size_t)(PT_G1 + c) * MR; const bf16_t* pg2 = PT + (size_t)(PT_G2 + c) * MR; const bf16_t* phg = PT + (size_t)(PT_HG + c) * MR;
    const f32x2* KF0 = (const f32x2*)(ws + WS_KF) + (size_t)(0 * 512 + c) * FFTN; const f32x2* KF1 = (const f32x2*)(ws + WS_KF) + (size_t)(1 * 512 + c) * FFTN;
    bf16_t* GATED = (bf16_t*)(ws + WS_H);
    const int t0 = 8 * tid;
    LAS f32x2* px = X + 9 * tid;
    __syncthreads();
    for (int bp = 0; bp < 2; ++bp) {
        const int r0 = (2 * bp) * SEQL, r1 = (2 * bp + 1) * SEQL;
        const Raw8 v0 = ld_raw8(pv + r0, t0, SEQL), v1 = ld_raw8(pv + r1, t0, SEQL);
        const Raw8 g10 = ld_raw8(pg1 + r0, t0, SEQL), g11 = ld_raw8(pg1 + r1, t0, SEQL);
        float zr[8], zi[8];
        sconv8(v0, wv0, wv1, wv2, bv, zr); sconv8(v1, wv0, wv1, wv2, bv, zi);
#pragma unroll
        for (int x = 0; x < 8; ++x) { px[x] = (f32x2){zr[x], zi[x]}; px[4608 + x] = (f32x2){0.f, 0.f}; }
        __syncthreads(); fft2_fwd_ABC(X, W, tid); fft2_mid_mul(X, KF0, tid); __syncthreads(); fft2_inv_CBA(X, W, tid);
        { float gr[8], gi[8]; sconv8(g10, wa0, wa1, wa2, ba, gr); sconv8(g11, wa0, wa1, wa2, ba, gi);
#pragma unroll
          for (int x = 0; x < 8; ++x) { const f32x2 cv = px[x] * (1.0f / 8192.0f); zr[x] = gr[x] * (cv.x + bias0 * zr[x]); zi[x] = gi[x] * (cv.y + bias0 * zi[x]); } }
        __syncthreads();
        const Raw8 g20 = ld_raw8(pg2 + r0, t0, SEQL), g21 = ld_raw8(pg2 + r1, t0, SEQL);
        const u32x4 hgr0 = *(const u32x4*)(phg + r0 + t0), hgr1 = *(const u32x4*)(phg + r1 + t0);
#pragma unroll
        for (int x = 0; x < 8; ++x) { px[x] = (f32x2){zr[x], zi[x]}; px[4608 + x] = (f32x2){0.f, 0.f}; }
        __syncthreads(); fft2_fwd_ABC(X, W, tid); fft2_mid_mul(X, KF1, tid); __syncthreads(); fft2_inv_CBA(X, W, tid);
        { float gr[8], gi[8], h0[8], h1[8]; sconv8(g20, wb0, wb1, wb2, bb, gr); sconv8(g21, wb0, wb1, wb2, bb, gi); unpack8(hgr0, h0); unpack8(hgr1, h1);
#pragma unroll
          for (int x = 0; x < 8; ++x) { const f32x2 cv = px[x] * (1.0f / 8192.0f);
              const float z2r = gr[x] * (cv.x + bias1 * zr[x]), z2i = gi[x] * (cv.y + bias1 * zi[x]);
              gr[x] = z2r * siluf_(h0[x]); gi[x] = z2i * siluf_(h1[x]); }
          bf16_t* pvw = (bf16_t*)(ws + WS_PT) + (size_t)(PT_V + c) * MR;
          *(u32x4*)(pvw + r0 + t0) = pack8(gr); *(u32x4*)(pvw + r1 + t0) = pack8(gi); }
        __syncthreads();
    }
}

__device__ __forceinline__ void hy_transpose_item(unsigned char* ws, LAS unsigned char* lds, int item, int tid, int nrows) {
    const int lane = tid & 63, w = tid >> 6;
    const int wi = item * 8 + w;
    const int nrb = nrows / 64;
    if (wi >= nrb * 8) return;
    const int rb = wi >> 3, cb = wi & 7;
    LAS bf16_t* T = (LAS bf16_t*)(lds + w * 8704);
    const bf16_t* src = (const bf16_t*)(ws + WS_PT) + (size_t)(PT_V + cb * 64) * MR + (size_t)rb * 64;
    u32x4 tv[8];
#pragma unroll
    for (int i = 0; i < 8; ++i) { const int c = 8 * i + (lane >> 3), r8 = (lane & 7) * 8; tv[i] = *(const u32x4*)(src + (size_t)c * MR + r8); }
#pragma unroll
    for (int i = 0; i < 8; ++i) { const int c = 8 * i + (lane >> 3), r8 = (lane & 7) * 8;
        LAS unsigned* d = (LAS unsigned*)(T + c * 66 + r8); d[0] = tv[i].x; d[1] = tv[i].y; d[2] = tv[i].z; d[3] = tv[i].w; }
    asm volatile("s_waitcnt lgkmcnt(0)" ::: "memory");
    bf16_t* dst = (bf16_t*)(ws + WS_H) + (size_t)(rb * 64) * D + 512 + cb * 64;
#pragma unroll 4
    for (int i = 0; i < 8; ++i) { const int r = 8 * i + (lane >> 3), c8 = (lane & 7) * 8;
        unsigned short e[8];
#pragma unroll
        for (int x = 0; x < 8; ++x) e[x] = T[(c8 + x) * 66 + r];
        u32x4 o; o.x = e[0] | ((unsigned)e[1] << 16); o.y = e[2] | ((unsigned)e[3] << 16); o.z = e[4] | ((unsigned)e[5] << 16); o.w = e[6] | ((unsigned)e[7] << 16);
        *(u32x4*)(dst + (size_t)r * D + c8) = o; }
    asm volatile("s_waitcnt lgkmcnt(0)" ::: "memory");
}
#ifndef MK_EN
#define MK_EN 0xffff
#endif
#define EN(x) ((MK_EN >> (x)) & 1)
constexpr int PH_PREP = 0, PH_PER_LAYER = 7, PH_FNORM = 1 + 2 * PH_PER_LAYER, N_PHASES = PH_FNORM + 1;

__global__ void __launch_bounds__(NT, 2) fwd_kernel(Args ka) {
    extern __shared__ __attribute__((aligned(16))) unsigned char lds_raw[];
    LAS unsigned char* lds = (LAS unsigned char*)lds_raw;
    const int G = gridDim.x;
    volatile LAS unsigned* bst = (volatile LAS unsigned*)(lds + LDS_CTL_OFF);
    if (threadIdx.x < 16) bst[threadIdx.x] = 0u;
    if (threadIdx.x == 0) { LAS unsigned long long* tab = (LAS unsigned long long*)(lds + LDS_PTR_OFF);
#pragma unroll
        for (int i = 0; i < N_IN; ++i) tab[i] = (unsigned long long)ka.in[i]; }
    __syncthreads();

    XcdBarrier gbar; gbar.bar = (unsigned*)(ka.ws + WS_CTL); gbar.x = 0; gbar.st = bst;
    if (ka.ph_hi - ka.ph_lo > 1) gbar = xcd_barrier_post((unsigned*)(ka.ws + WS_CTL), bst);

#ifdef REP_SUB
    int repmask = 0;
#endif
    for (int ph = ka.ph_lo; ph < ka.ph_hi; ++ph) {
        int tid = threadIdx.x; asm volatile("" : "+v"(tid));
        int bid = blockIdx.x; asm volatile("" : "+s"(bid));
#define LANE_WAVE() int tid2_ = threadIdx.x; asm volatile("" : "+v"(tid2_)); const int lane = tid2_ & 63, wave = __builtin_amdgcn_readfirstlane(tid2_ >> 6)
        __attribute__((address_space(1))) unsigned char* wsg_ = (__attribute__((address_space(1))) unsigned char*)ka.ws; asm volatile("" : "+s"(wsg_)); unsigned char* ws = (unsigned char*)wsg_;
        __attribute__((address_space(1))) float* outg_ = (__attribute__((address_space(1))) float*)ka.out; asm volatile("" : "+s"(outg_)); float* outp_ = (float*)outg_;
        DArgs a; a.in.t = (const LAS unsigned long long*)(lds + LDS_PTR_OFF); a.out = outp_;
        float* MOD = (float*)(ws + WS_MOD);
        if (EN(0) && ph == PH_PREP) {
            for (int it = bid; it < 1048 + 544; it += G) {
                int tid = threadIdx.x; asm volatile("" : "+v"(tid));
                __syncthreads();
                if (it < 768) prep_adaln(a.in[I_C], a.in[I_CCTX], a.in[I_ADAW], a.in[I_ADAB], MOD, it, (LAS float*)lds, tid);
                else if (it < 784) prep_s5b(a, ws, it - 768, tid);
                else if (it >= 1048) prep_rope((f32x2*)(ws + WS_ROPE), it - 1048, tid);
                else { const bool big = it < 1040; const int r = big ? it - 784 : it - 1040, l = big ? (r >> 7) : 0, t0 = (big ? (r & 127) : r) * 32;
                    float* H3o = big ? (float*)(ws + WS_H3) + (size_t)l * 4096 * 64 : (float*)(ws + WS_H3C);
                    bf16_t* H3b = big ? (bf16_t*)(ws + WS_H3B) + (size_t)l * 4096 * 64 : (bf16_t*)nullptr;
                    prep_hymlp(a, H3o, H3b, l, big ? 4096 : 256, t0, lds, tid); }
            }
        } else if (EN(1) && ph == PH_FNORM) {
            const float* fw = a.in[I_FNW]; LANE_WAVE();
            for (int row = bid * NWAVES + wave; row < NLAT; row += G * NWAVES) {
                float* xr = a.out + (size_t)row * D; f32x4 v[8]; float ss = 0.f;
#pragma unroll
                for (int j = 0; j < 8; ++j) { v[j] = ((const f32x4*)xr)[lane + 64 * j]; ss += (v[j].x * v[j].x + v[j].y * v[j].y) + (v[j].z * v[j].z + v[j].w * v[j].w); }
                const float rstd = rsqrtf(wave_sum(ss) * (1.0f / D) + EPS);
#pragma unroll
                for (int j = 0; j < 8; ++j) { const f32x4 w = *(const f32x4*)(fw + 4 * (lane + 64 * j)); ((f32x4*)xr)[lane + 64 * j] = v[j] * rstd * w; }
            }
        } else {
            const int l = (ph - 1) / PH_PER_LAYER, sub = (ph - 1) % PH_PER_LAYER;

            const bool ctx_out = (l == 0);
            const int Mrows = ctx_out ? MR : NLAT;
            if (EN(2) && sub == 0) {
                LANE_WAVE();
                LAS float* scr = (LAS float*)(lds + wave * 8704);
                const int gw = bid * NWAVES + wave, NGW = G * NWAVES;
                constexpr int I_W1 = 32 * (NPAD / 32), I_W2 = 32 * 64, I_W3 = 8 * 16;
                for (int it = (l == 0 ? gw : gw + I_W1); it < I_W1 + I_W2 + I_W3; it += NGW) {
                    int r = it;
                    if (r < I_W1) { const int kb = r / (NPAD / 32), nb = r % (NPAD / 32); transpose_item(a.in[I_WIN] + (size_t)l * D * INW, INW, win_srccol(nb * 32 + (lane & 31)), kb * 64, (bf16_t*)(ws + WS_WIN), D, nb * 32, scr, lane); continue; }
                    r -= I_W1;
                    if (r < I_W2) { const int kb = r / 64, nb = r % 64; transpose_item(a.in[I_WOUT] + (size_t)l * D * D, D, nb * 32 + (lane & 31), kb * 64, (bf16_t*)(ws + WS_WOUT), D, nb * 32, scr, lane); continue; }
                    r -= I_W2;
                    { const int kb = r / 16, nb = r % 16; transpose_item(a.in[I_GLUW] + (size_t)l * 512 * 512, 512, nb * 32 + (lane & 31), kb * 64, (bf16_t*)(ws + WS_GLUW), 512, nb * 32, scr, lane); }
                }
                const float* nw = a.in[I_NORMW] + (size_t)l * D;
                for (int row = gw; row < MR; row += NGW) {
                    const float* xr; int v;
                    if (row < NLAT) { xr = (l == 0 ? a.in[I_X] : a.out) + (size_t)row * D; v = row >> 12; }
                    else { xr = (l == 0 ? a.in[I_CTX] : (const float*)(ws + WS_XC1)) + (size_t)(row - NLAT) * D; v = 4; }
                    norm_row(xr, nw, MOD + (size_t)(l * 5 + v) * ADA, (bf16_t*)(ws + WS_H) + (size_t)row * D, lane);
                }
                __syncthreads();
                const int nfilt = ctx_out ? 1024 : 0;
                for (int it = bid; it < nfilt; it += G) { int tid = threadIdx.x; asm volatile("" : "+v"(tid)); __syncthreads(); if (it < 512) filt_item2(a, ws, lds, l, it, tid); else filt_ctx_item(a, ws, lds, it - 512, tid);
#if defined(REP_ITEM) && REP_ITEM == 10
                    __syncthreads(); if (it < 512) filt_item2(a, ws, lds, l, it, tid);
#endif
                }
            } else if (EN(3) && sub == 1) {
                pg8::Gemm g{(const bf16_t*)(ws + WS_H), (const bf16_t*)(ws + WS_WIN), MR, NPAD, D}; pg8::StaticOrder S; S.init(MR, NPAD, G, bid);
                EpiInProj E{(bf16_t*)(ws + WS_P), (bf16_t*)(ws + WS_PT), (float*)(ws + WS_LR), (const float*)(ws + WS_ROPE)};
                { pg8::InProjOrder S1; S1.init(ctx_out ? 0 : 1, G, bid); pg8::gemm_phase<EpiInProj, pg8::InProjOrder, true, true>(lds, g, S1, E, tid); }
            } else if (EN(5) && sub == 2) {
                const int nit = ctx_out ? 3200 : 2688;
                for (int it = bid; it < nit; it += G) {
                    int tid = threadIdx.x; asm volatile("" : "+v"(tid));
                    __syncthreads();
#ifdef REP_ITEM
                    for (int rep_ = 0; rep_ < 2; ++rep_) { const int ty_ = it < 544 ? 0 : it < 1088 ? 1 : it < 2176 ? 2 : it < 2688 ? 3 : 4; if (rep_ && ty_ != REP_ITEM) break; if (rep_) __syncthreads(); asm volatile("" : "+v"(tid));
#endif
                    if (it < 544) s5_item<false>(a, ws, lds, l, it, tid);
                    else if (it < 1088) ret_passA(ws, lds, it - 544, tid);
                    else if (it < 2176) gla_passA(a, ws, lds, l, it - 1088, tid);
                    else if (it < 2688) hyena_item2(a, ws, lds, l, it - 2176, tid);
                    else hyena_ctx_item(a, ws, lds, it - 2688, tid);
#ifdef REP_ITEM
                    }
#endif
                }
            } else if (EN(9) && sub == 3) {
                for (int it = bid; it < 256; it += G) { int tid = threadIdx.x; asm volatile("" : "+v"(tid)); __syncthreads(); hy_transpose_item(ws, lds, it, tid, NLAT); }
                for (int it = bid; it < 224; it += G) { int tid = threadIdx.x; asm volatile("" : "+v"(tid)); __syncthreads();
                    if (it < 128) ret_passB(ws, it * NT + tid);
                    else if (it < 192) gla_passB(ws, lds, it - 128, tid);
                    else s5_passB(ws, l, (it - 192) * NT + tid); }
            } else if (EN(6) && sub == 4) {
                const int nsc = ctx_out ? 544 : 512, nrc = ctx_out ? 16 * RNCH : 16 * 32, ngc = ctx_out ? 16 * GNCH : 16 * 64;
                for (int it = bid; it < nsc + nrc + ngc; it += G) { int tid = threadIdx.x; asm volatile("" : "+v"(tid)); __syncthreads();
#ifdef REP_ITEM
                    for (int rep_ = 0; rep_ < 2; ++rep_) { const int ty_ = it < nsc ? 20 : it < nsc + nrc ? 21 : 22; if (rep_ && ty_ != REP_ITEM) break; if (rep_) __syncthreads(); asm volatile("" : "+v"(tid));
#endif
                    if (it < nsc) { const int item = ctx_out ? it : (it >> 7) * (SNCH * 2) + 8 + (it & 127); s5_item<true>(a, ws, lds, l, item, tid); }
                    else if (it < nsc + nrc) { const int r = it - nsc; const int item = ctx_out ? r : (r >> 5) * RNCH + 2 + (r & 31); ret_passC(a, ws, lds, l, item, tid); }
                    else { const int r = it - nsc - nrc; const int item = ctx_out ? r : (r >> 6) * GNCH + 4 + (r & 63); gla_passC(a, ws, lds, l, item, tid); }
#ifdef REP_ITEM
                    }
#endif
                }
            } else if (EN(7) && sub == 5) {
                pg8::Gemm g{(const bf16_t*)(ws + WS_KF), (const bf16_t*)(ws + WS_GLUW), Mrows, 512, 512}; pg8::StaticOrder S; S.init(Mrows, 512, G, bid);
                EpiGlu E{(const bf16_t*)(ws + WS_KF) + OBSZ, (bf16_t*)(ws + WS_H), a.in[I_GLUB] + (size_t)l * 512};
                pg8::gemm_phase<EpiGlu, pg8::StaticOrder, true, true>(lds, g, S, E, tid);
                if (l == 0 && bid >= 136) {
                    LANE_WAVE(); LAS float* scr = (LAS float*)(lds + wave * 8704);
                    for (int r = (bid - 136) * NWAVES + wave; r < 32 * (NPAD / 32); r += (G - 136) * NWAVES) { const int kb = r / (NPAD / 32), nb = r % (NPAD / 32);
                        transpose_item(a.in[I_WIN] + (size_t)1 * D * INW, INW, win_srccol(nb * 32 + (lane & 31)), kb * 64, (bf16_t*)(ws + WS_WIN), D, nb * 32, scr, lane); }
                }
            } else if (EN(8)) {
                pg8::Gemm g{(const bf16_t*)(ws + WS_H), (const bf16_t*)(ws + WS_WOUT), Mrows, D, D}; pg8::StaticOrder S; S.init(Mrows, D, G, bid);
                EpiOut E{l == 0 ? a.in[I_X] : a.out, a.in[I_CTX], a.out, (float*)(ws + WS_XC1), MOD + (size_t)l * 5 * ADA};
                pg8::gemm_phase<EpiOut, pg8::StaticOrder, true, true>(lds, g, S, E, tid);
                if (l == 0 && bid >= 32) {
                    for (int it = bid - 32; it < 512; it += G - 32) { int tid2 = threadIdx.x; asm volatile("" : "+v"(tid2)); __syncthreads(); filt_item2(a, ws, lds, 1, it, tid2); }
                }
            }
        }
#ifdef REP_SUB
        if (ph != PH_PREP && ph != PH_FNORM && ((ph - 1) % PH_PER_LAYER) == REP_SUB && !((repmask >> ((ph - 1) / PH_PER_LAYER)) & 1)) { repmask |= 1 << ((ph - 1) / PH_PER_LAYER); xcd_barrier(gbar); --ph; continue; }
#endif
        if (ph + 1 < ka.ph_hi) xcd_barrier(gbar);
    }
}

#ifndef MK_LAUNCH_PER_PHASE
#define MK_LAUNCH_PER_PHASE 0
#endif
extern "C" void kernel_launch(void* const* d_in, const int* in_sizes, int n_in, void* d_out, int out_size, void* d_ws, size_t ws_size, hipStream_t stream) {
    static int grid = 0;
    if (grid == 0) {
        if (n_in != N_IN || out_size != NLAT * D || ws_size < WS_END2) { fprintf(stderr, "kernel_launch: unexpected shapes (n_in %d, out %d, ws %zu < %zu); nothing launched\n", n_in, out_size, ws_size, (size_t)WS_END2); grid = -1; return; }
        int dev = 0, cus = 0, per_cu = 0;
        if (hipGetDevice(&dev) != hipSuccess || hipDeviceGetAttribute(&cus, hipDeviceAttributeMultiprocessorCount, dev) != hipSuccess) { grid = -1; return; }
        if (hipFuncSetAttribute((const void*)fwd_kernel, hipFuncAttributeMaxDynamicSharedMemorySize, LDS_BYTES) != hipSuccess) { fprintf(stderr, "kernel_launch: hipFuncSetAttribute failed\n"); grid = -1; return; }
        if (hipOccupancyMaxActiveBlocksPerMultiprocessor(&per_cu, (const void*)fwd_kernel, NT, LDS_BYTES) != hipSuccess || per_cu < 1) { fprintf(stderr, "kernel_launch: occupancy query says %d blocks per CU\n", per_cu); per_cu = 1; }
        (void)hipGetLastError();
        grid = cus;
    }
    if (grid < 0) return;
    (void)hipMemsetAsync((char*)d_ws + WS_CTL, 0, WS_ZERO_BYTES, stream);
    Args a{};
    for (int i = 0; i < N_IN; ++i) a.in[i] = (const float*)d_in[i];
    a.out = (float*)d_out; a.ws = (unsigned char*)d_ws;
#if MK_LAUNCH_PER_PHASE
    for (int ph = 0; ph < N_PHASES; ++ph) {
        a.ph_lo = ph; a.ph_hi = ph + 1;
        hipLaunchKernelGGL(fwd_kernel, dim3(grid), dim3(NT), LDS_BYTES, stream, a);
    }
#else
    a.ph_lo = 0; a.ph_hi = N_PHASES;
    void* args[] = {&a};
    hipError_t e = hipLaunchCooperativeKernel((const void*)fwd_kernel, dim3(grid), dim3(NT), args, LDS_BYTES, stream);
    if (e != hipSuccess) fprintf(stderr, "kernel_launch: cooperative launch failed: %s (grid %d)\n", hipGetErrorString(e), grid);
#endif
}
```

```cpp
#include <hip/hip_runtime.h>
#include <hip/hip_cooperative_groups.h>
#include <cstdio>
#include <cstdint>
namespace cg = cooperative_groups;

#define LAS __attribute__((address_space(3)))
typedef unsigned short bf16_t;
typedef float f32x4 __attribute__((ext_vector_type(4)));
typedef float f32x2 __attribute__((ext_vector_type(2)));
typedef unsigned u32x4 __attribute__((ext_vector_type(4)));
typedef unsigned u32x2 __attribute__((ext_vector_type(2)));

constexpr int D = 2048, NB = 4, SEQL = 4096, LC = 256, NLAT = NB * SEQL, NCTX = NB * LC, MR = NLAT + NCTX;
constexpr int BR = 512, INW = 6688, NPAD = 6912, LDP = 4608, ADA = 3 * D;
constexpr int NT = 512, NWAVES = 8;
constexpr float EPS = 1e-6f;
constexpr int PC_S5U = 0, PC_S5G = 512, PC_RQ = 1024, PC_RK = 1536, PC_RV = 2048, PC_RG = 2560, PC_GQ = 3072, PC_GK = 3328, PC_GV = 3584, PC_GG = 4096;
constexpr int PT_V = 0, PT_G1 = 512, PT_G2 = 1024, PT_HG = 1536;
constexpr int FFTN = 8192;

enum { I_X = 0, I_C, I_CTX, I_CCTX, I_NORMW, I_ADAW, I_ADAB, I_WIN, I_WOUT, I_S5ARE, I_S5AIM, I_S5LDT, I_S5BRE, I_S5BIM, I_S5CRE, I_S5CIM,
       I_S5D, I_GLUW, I_GLUB, I_HCW, I_HCB, I_HW1, I_HB1, I_HF1, I_HW2, I_HB2, I_HF2, I_HW3, I_HB3, I_HF3, I_HW4, I_HBIAS, I_RNW, I_GGW, I_GGB, I_GNW, I_FNW, N_IN };

constexpr size_t al256(size_t x) { return (x + 255) & ~(size_t)255; }
constexpr size_t WS_CTL  = 0;
constexpr size_t WS_MOD  = WS_CTL + 65536;
constexpr size_t WS_ZERO_BYTES = 65536 + al256((size_t)2 * 5 * ADA * 4);
constexpr size_t WS_S5AB = WS_MOD + al256((size_t)2 * 5 * ADA * 4);
constexpr size_t WS_S5BT = WS_S5AB + (size_t)2 * 2 * 32 * 64 * 8;
constexpr size_t WS_H3   = WS_S5BT + (size_t)1048576 + 65536;
constexpr size_t WS_H3C  = WS_H3 + (size_t)2 * 4096 * 64 * 4;
constexpr size_t WS_KC   = WS_H3C + (size_t)256 * 64 * 4;
constexpr size_t WS_LR   = WS_KC + (size_t)2 * 512 * 512 * 4;
constexpr size_t WS_XC1  = WS_LR + (size_t)MR * 32 * 4;
constexpr size_t WS_WOUT = WS_XC1 + (size_t)NCTX * D * 4;
constexpr size_t WS_GLUW = WS_WOUT + (size_t)D * D * 2;
constexpr size_t WS_WIN  = WS_GLUW + (size_t)512 * 512 * 2;
constexpr size_t WS_H    = WS_WIN + (size_t)NPAD * D * 2;
constexpr size_t WS_P    = WS_H + (size_t)MR * D * 2;
constexpr size_t WS_PT   = WS_P + (size_t)MR * LDP * 2;
constexpr size_t WS_KF   = WS_PT + (size_t)2048 * MR * 2;
constexpr size_t WS_OB   = WS_KF + (size_t)2 * 512 * FFTN * 8;
constexpr size_t WS_END  = WS_OB + (size_t)6 * MR * 512 * 2;
constexpr size_t OBSZ = (size_t)MR * 512;

constexpr int LDS_CTL_OFF = 131072 + 2048;
constexpr int LDS_PTR_OFF = LDS_CTL_OFF + 64;
constexpr int LDS_BYTES = LDS_PTR_OFF + 320;

typedef __bf16 hwbf16x2 __attribute__((ext_vector_type(2)));
__device__ __forceinline__ unsigned pk2(float lo, float hi) { const f32x2 v = {lo, hi}; return __builtin_bit_cast(unsigned, __builtin_convertvector(v, hwbf16x2)); }
__device__ __forceinline__ unsigned f2bf(float f) { return pk2(f, 0.f) & 0xffffu; }
__device__ __forceinline__ float bf2f(bf16_t b) { return __uint_as_float((unsigned)b << 16); }
__device__ __forceinline__ float bflo(unsigned w) { return __uint_as_float(w << 16); }
__device__ __forceinline__ float bfhi(unsigned w) { return __uint_as_float(w & 0xffff0000u); }
__device__ __forceinline__ void unpack8(const u32x4 r, float (&f)[8]) { f[0] = bflo(r.x); f[1] = bfhi(r.x); f[2] = bflo(r.y); f[3] = bfhi(r.y); f[4] = bflo(r.z); f[5] = bfhi(r.z); f[6] = bflo(r.w); f[7] = bfhi(r.w); }
__device__ __forceinline__ u32x4 pack8(const float (&f)[8]) { u32x4 o; o.x = pk2(f[0], f[1]); o.y = pk2(f[2], f[3]); o.z = pk2(f[4], f[5]); o.w = pk2(f[6], f[7]); return o; }
__device__ __forceinline__ float sigmoidf_(float x) { return __builtin_amdgcn_rcpf(1.0f + __expf(-x)); }
__device__ __forceinline__ float siluf_(float x) { return x * sigmoidf_(x); }
__device__ __forceinline__ float gelu_tanh(float x) { const float u2 = 1.5957691216057308f * (x + 0.044715f * x * x * x); return x * sigmoidf_(u2); }
__device__ __forceinline__ float wave_sum(float v) {
#pragma unroll
    for (int o = 1; o < 64; o <<= 1) v += __shfl_xor(v, o);
    return v;
}
#define LDS_WAIT() asm volatile("s_waitcnt lgkmcnt(0)" ::: "memory")

struct Args { const float* in[N_IN]; float* out; unsigned char* ws; int ph_lo, ph_hi; };
struct InTab { const LAS unsigned long long* t;
    __device__ __forceinline__ const float* operator[](int i) const { const unsigned long long v = t[i];
        const unsigned lo = __builtin_amdgcn_readfirstlane((unsigned)v), hi = __builtin_amdgcn_readfirstlane((unsigned)(v >> 32)); return (const float*)(__attribute__((address_space(1))) const float*)(((unsigned long long)hi << 32) | lo); } };
struct DArgs { InTab in; float* out; };

#define XB_TMO      128
#define XB_XCNT(j)  (256  + 64 * (j))
#define XB_XSUB(j)  (1280 + 64 * (j))
#define XB_XGEN(j)  (2304 + 64 * (j))
#define XB_TOP      3328
#define XB_TOPGEN   3392
#define XCD_BAR_WORDS 3456
#define XB_SPIN_CAP (1u << 22)
__device__ __forceinline__ unsigned xb_ld(unsigned* p)              { return __hip_atomic_load(p, __ATOMIC_RELAXED, __HIP_MEMORY_SCOPE_AGENT); }
__device__ __forceinline__ unsigned xb_add(unsigned* p, unsigned v) { return __hip_atomic_fetch_add(p, v, __ATOMIC_RELAXED, __HIP_MEMORY_SCOPE_AGENT); }
__device__ __forceinline__ unsigned xb_xcc_id() { return (unsigned)__builtin_amdgcn_s_getreg((3 << 11) | 20) & 0xFu; }
#define XB_SPIN(cond, bar) do { unsigned _sp = 0; while (cond) { __builtin_amdgcn_s_sleep(1); \
    if ((++_sp & 255u) == 0u) { if (xb_ld(&(bar)[XB_TMO])) break; if (_sp > XB_SPIN_CAP) { atomicAdd(&(bar)[XB_TMO], 1u); break; } } } } while (0)
struct XcdBarrier { unsigned* bar; unsigned x; volatile LAS unsigned* st; };
__device__ __forceinline__ XcdBarrier xcd_barrier_post(unsigned* bar, volatile LAS unsigned* st) {
    XcdBarrier b; b.bar = bar; b.x = xb_xcc_id(); b.st = st;
    if (threadIdx.x == 0) (void)xb_add(&bar[XB_XCNT(b.x)], 1u);
    return b;
}
__device__ __forceinline__ void xcd_barrier_complete(unsigned* bar, unsigned x, unsigned& nloc, unsigned& nx) {
    const unsigned G = gridDim.x * gridDim.y * gridDim.z;
    unsigned sum, cnt, mine, sp = 0u;
    for (;;) {
        sum = 0u; cnt = 0u; mine = 0u;
#pragma unroll
        for (unsigned j = 0; j < 16; ++j) { const unsigned c = xb_ld(&bar[XB_XCNT(j)]); sum += c; cnt += (c > 0u) ? 1u : 0u; mine = (j == x) ? c : mine; }
        if (sum == G) break;
        __builtin_amdgcn_s_sleep(1);
        if ((++sp & 255u) == 0u) { if (xb_ld(&bar[XB_TMO])) break; if (sp > XB_SPIN_CAP) { atomicAdd(&bar[XB_TMO], 1u); break; } }
    }
    nloc = mine > 0u ? mine : 1u; nx = cnt > 0u ? cnt : 1u;
}
__device__ __forceinline__ void xcd_barrier(const XcdBarrier& b) {
    asm volatile("s_waitcnt vmcnt(0)" ::: "memory");
    __syncthreads();
    if (threadIdx.x == 0) {
        unsigned* bar = b.bar;
        __builtin_amdgcn_s_waitcnt(0);
        unsigned nloc = b.st[0], nx = b.st[1];
        if (nloc == 0u) { xcd_barrier_complete(bar, b.x, nloc, nx); b.st[0] = nloc; b.st[1] = nx; }
        const unsigned old = xb_add(&bar[XB_XSUB(b.x)], 1u);
        const unsigned gen = old / nloc;
        if (old + 1u == (gen + 1u) * nloc) {
            __builtin_amdgcn_fence(__ATOMIC_RELEASE, "agent");
            asm volatile("s_waitcnt vmcnt(0)" ::: "memory");
            const unsigned og = xb_add(&bar[XB_TOP], 1u);
            const unsigned tg = og / nx;
            if (og + 1u == (tg + 1u) * nx) xb_add(&bar[XB_TOPGEN], 1u);
            else XB_SPIN(xb_ld(&bar[XB_TOPGEN]) == tg, bar);
            __builtin_amdgcn_fence(__ATOMIC_ACQUIRE, "agent");
            xb_add(&bar[XB_XGEN(b.x)], 1u);
            asm volatile("s_waitcnt vmcnt(0)" ::: "memory");
        } else {
            XB_SPIN(xb_ld(&bar[XB_XGEN(b.x)]) == gen, bar);
            __builtin_amdgcn_fence(__ATOMIC_ACQUIRE, "agent");
            asm volatile("s_waitcnt vmcnt(0)" ::: "memory");
        }
    }
    __syncthreads();
}
namespace pg8 {
#define PG8_LAS __attribute__((address_space(3)))
typedef unsigned short bf16_t;
typedef short bf16x8 __attribute__((ext_vector_type(8)));
typedef float f32x4 __attribute__((ext_vector_type(4)));
typedef unsigned u32x4 __attribute__((ext_vector_type(4)));
constexpr int BM = 256, BK = 64, HALF = 128, HTB = HALF * BK * 2, STAGE_BYTES = 8 * HTB, NXCD = 8, WGM = 8;

__host__ __device__ __forceinline__ int lds_byte(int r, int c) { const int st = (r >> 4) * 2 + (c >> 5), rr = r & 15, cc = c & 31, ob = rr * 64 + cc * 2; return st * 1024 + (ob ^ (((ob >> 9) & 1) << 5)); }
__host__ __device__ __forceinline__ void stage_rc(int b, int& R, int& C) { const int st = b / 1024, sb = b % 1024, swz = sb ^ (((sb >> 9) & 1) << 5); R = (st >> 1) * 16 + swz / 64; C = (st & 1) * 32 + (swz % 64) / 2; }
__host__ __device__ __forceinline__ int perm32(int rho) { const int n = rho >> 4, i = rho & 15; return 8 * (i >> 2) + 4 * n + (i & 3); }

struct Unit { int pm, pn; };
struct Gemm { const bf16_t* A; const bf16_t* Bt; int M, N, K; };

struct StaticOrder {
    int nM, nN, nwg, G, c;
    __host__ __device__ void init(int M, int N, int G_, int c_) { nM = M / BM; nN = N / BM; nwg = nM * nN; G = G_; c = c_; }
    __host__ __device__ bool next(int i, Unit& u) const {
        const long L = (long)i * G + c; if (L >= nwg) return false;
        int wgid = (int)L; { const int q = nwg / NXCD, r = nwg % NXCD, xcd = wgid % NXCD, off = wgid / NXCD; wgid = (xcd < r ? xcd * (q + 1) : r * (q + 1) + (xcd - r) * q) + off; }
        const int nig = WGM * nN, gid = wgid / nig, fm = gid * WGM, gsz = (nM - fm) < WGM ? (nM - fm) : WGM;
        u.pm = fm + ((wgid % nig) % gsz); u.pn = (wgid % nig) / gsz; return true;
    }
    __device__ __forceinline__ void a_ready(const Unit&) const {}
    __device__ __forceinline__ void done(const Unit&) const {}
};


struct InProjOrder {
    StaticOrder base; int G, c, last;
    __host__ __device__ void init(int last_, int G_, int c_) { last = last_; base.init((last_ ? 64 : 68) * 256, 27 * 256, G_, c_); G = G_; c = c_; }
    __host__ __device__ bool next(int i, Unit& u) const {
        const long L = (long)i * G + c;
        if (!last || L < 1728) return base.next(i, u);
        if (L >= 1768) return false;
        const int k = (int)L - 1728, j = k % 10; u.pm = 64 + k / 10;
        u.pn = j == 0 ? 0 : j == 1 ? 1 : j == 2 ? 14 : j == 3 ? 15 : j == 4 ? 16 : j == 5 ? 17 : j == 6 ? 21 : j == 7 ? 22 : j == 8 ? 23 : 26;
        return true;
    }
    __device__ __forceinline__ void a_ready(const Unit&) const {}
    __device__ __forceinline__ void done(const Unit&) const {}
};
template <class Epi, class Sched, bool ALIGN_EPI = false, bool SP2 = false>
__device__ __forceinline__ void gemm_phase(PG8_LAS unsigned char* lds, const Gemm g, const Sched& S, const Epi& E, const int tid) {
    const int wid = __builtin_amdgcn_readfirstlane(tid >> 6), lane = tid & 63, wr = wid >> 2, wc = wid & 3, fr = lane & 15, fq = lane >> 4;
    const int K = g.K, nt = K / BK;
    unsigned voffA[2], voffB[2];
#pragma unroll
    for (int i = 0; i < 2; ++i) { int R, C; stage_rc(tid * 16 + i * 8192, R, C); const int Rb = Epi::PERM ? ((R & ~31) + perm32(R & 31)) : R;
        voffA[i] = (unsigned)(R * K + C) * 2u; voffB[i] = (unsigned)(Rb * K + C) * 2u; }
    const size_t kstep = (size_t)(BK * 2);
    const size_t hstep = (size_t)HALF * K * 2;
    const size_t tstep = 2 * hstep;
    const unsigned ldsw = (unsigned)wid * 1024u;
    const int aoff = lds_byte(wr * 64 + fr, fq * 8), boff = lds_byte(wc * 32 + fr, fq * 8);
#define PG8_SA(b, h) (((b) * 2 + (h)) * HTB)
#define PG8_SB(b, h) ((4 + (b) * 2 + (h)) * HTB)
#define PG8_STAGE(bufoff, gbase, voff) do { _Pragma("unroll") for (int _i = 0; _i < 2; ++_i) \
        __builtin_amdgcn_global_load_lds((const unsigned*)((const char*)(gbase) + (voff)[_i]), (PG8_LAS unsigned*)(lds + (bufoff) + ldsw + _i * 8192), 16, 0, 0); } while (0)
#define PG8_LDA(dst, b, h) do { _Pragma("unroll") for (int m = 0; m < 4; ++m) _Pragma("unroll") for (int k = 0; k < 2; ++k) dst[m][k] = *(const PG8_LAS bf16x8*)(lds + PG8_SA(b, h) + aoff + m * 2048 + k * 1024); } while (0)
#define PG8_LDB(dst, b, h) do { _Pragma("unroll") for (int n = 0; n < 2; ++n) _Pragma("unroll") for (int k = 0; k < 2; ++k) dst[n][k] = *(const PG8_LAS bf16x8*)(lds + PG8_SB(b, h) + boff + n * 2048 + k * 1024); } while (0)
#define PG8_MMA(ai, bj, At, Bt) do { __builtin_amdgcn_s_setprio(1); _Pragma("unroll") for (int m = 0; m < 4; ++m) _Pragma("unroll") for (int n = 0; n < 2; ++n) _Pragma("unroll") for (int k = 0; k < 2; ++k) \
        acc[ai][bj][m][n] = __builtin_amdgcn_mfma_f32_16x16x32_bf16(Bt[n][k], At[m][k], acc[ai][bj][m][n], 0, 0, 0); __builtin_amdgcn_s_setprio(0); } while (0)
#define PG8_WAIT_V(n) asm volatile("s_waitcnt vmcnt(" #n ")" ::: "memory")
#define PG8_WAIT_L(n) asm volatile("s_waitcnt lgkmcnt(" #n ")" ::: "memory")
#define PG8_BAR __builtin_amdgcn_s_barrier()
#define PG8_SCHED __builtin_amdgcn_sched_barrier(0)
    Unit cur, nxt; int ui = 0;
    if (!S.next(0, cur)) return;
    f32x4 acc[2][2][4][2];
#pragma unroll
    for (int a = 0; a < 2; ++a)
#pragma unroll
        for (int b = 0; b < 2; ++b)
#pragma unroll
            for (int m = 0; m < 4; ++m)
#pragma unroll
                for (int n = 0; n < 2; ++n) acc[a][b][m][n] = (f32x4){0.f, 0.f, 0.f, 0.f};
    bf16x8 At[4][2], B0[2][2], B1[2][2];
    const char* cA = (const char*)g.A + (size_t)cur.pm * tstep; const char* cB = (const char*)g.Bt + (size_t)cur.pn * tstep;
    S.a_ready(cur);
    if constexpr (SP2) {
        PG8_STAGE(PG8_SB(0, 0), cB, voffB); PG8_STAGE(PG8_SB(0, 1), cB + hstep, voffB); PG8_STAGE(PG8_SA(0, 0), cA, voffA); PG8_STAGE(PG8_SA(0, 1), cA + hstep, voffA);
        if (wr == 1) PG8_BAR;
        PG8_WAIT_V(2); PG8_BAR;
        PG8_STAGE(PG8_SB(1, 0), cB + kstep, voffB); PG8_STAGE(PG8_SA(1, 0), cA + kstep, voffA); PG8_STAGE(PG8_SB(1, 1), cB + hstep + kstep, voffB);
        PG8_WAIT_V(6); PG8_BAR;
    } else {
        PG8_STAGE(PG8_SB(0, 0), cB, voffB); PG8_STAGE(PG8_SA(0, 0), cA, voffA); PG8_STAGE(PG8_SB(0, 1), cB + hstep, voffB); PG8_STAGE(PG8_SA(0, 1), cA + hstep, voffA);
        if (wr == 1) PG8_BAR;
        PG8_WAIT_V(4); PG8_BAR;
        PG8_STAGE(PG8_SB(1, 0), cB + kstep, voffB); PG8_STAGE(PG8_SA(1, 0), cA + kstep, voffA); PG8_STAGE(PG8_SB(1, 1), cB + hstep + kstep, voffB);
        PG8_WAIT_V(6); PG8_BAR;
    }
    for (;;) {
        const bool has_next = S.next(ui + 1, nxt);
        const char* nA = has_next ? (const char*)g.A + (size_t)nxt.pm * tstep : cA; const char* nB = has_next ? (const char*)g.Bt + (size_t)nxt.pn * tstep : cB;
        for (int t = 0; t < nt; t += 2) {
            const bool last = (t == nt - 2);
            const char* a1 = cA + (size_t)(t + 1) * kstep;
            const char* a2 = last ? nA : cA + (size_t)(t + 2) * kstep; const char* b2 = last ? nB : cB + (size_t)(t + 2) * kstep;
            const char* a3 = a2 + kstep; const char* b3 = b2 + kstep;
            if (last && has_next) S.a_ready(nxt);
            if constexpr (SP2) {
            PG8_LDB(B0, 0, 0); PG8_LDB(B1, 0, 1); PG8_SCHED; PG8_LDA(At, 0, 0); PG8_STAGE(PG8_SA(1, 1), a1 + hstep, voffA);
            PG8_WAIT_V(8); PG8_WAIT_L(0); PG8_BAR; PG8_MMA(0, 0, At, B0); PG8_MMA(0, 1, At, B1); PG8_BAR; PG8_SCHED;
            PG8_LDA(At, 0, 1); PG8_STAGE(PG8_SB(0, 0), b2, voffB); PG8_STAGE(PG8_SB(0, 1), b2 + hstep, voffB); PG8_STAGE(PG8_SA(0, 0), a2, voffA);
            PG8_WAIT_V(8); PG8_WAIT_L(0); PG8_BAR; PG8_MMA(1, 0, At, B0); PG8_MMA(1, 1, At, B1); PG8_BAR; PG8_SCHED;
            PG8_LDB(B0, 1, 0); PG8_LDB(B1, 1, 1); PG8_SCHED; PG8_LDA(At, 1, 0); PG8_STAGE(PG8_SA(0, 1), a2 + hstep, voffA);
            PG8_WAIT_V(8); PG8_WAIT_L(0); PG8_BAR; PG8_MMA(0, 0, At, B0); PG8_MMA(0, 1, At, B1); PG8_BAR; PG8_SCHED;
            PG8_LDA(At, 1, 1); PG8_STAGE(PG8_SB(1, 0), b3, voffB); PG8_STAGE(PG8_SB(1, 1), b3 + hstep, voffB); PG8_STAGE(PG8_SA(1, 0), a3, voffA);
            PG8_WAIT_V(8); PG8_WAIT_L(0); PG8_BAR; PG8_MMA(1, 0, At, B0); PG8_MMA(1, 1, At, B1); PG8_BAR; PG8_SCHED;
            } else {
            PG8_LDB(B0, 0, 0); PG8_SCHED; PG8_LDA(At, 0, 0); PG8_STAGE(PG8_SA(1, 1), a1 + hstep, voffA);
            PG8_WAIT_L(8); PG8_BAR; PG8_WAIT_L(0); PG8_MMA(0, 0, At, B0); PG8_BAR; PG8_SCHED;
            PG8_LDB(B1, 0, 1); PG8_STAGE(PG8_SB(0, 0), b2, voffB);
            PG8_BAR; PG8_WAIT_L(0); PG8_MMA(0, 1, At, B1); PG8_BAR;
            PG8_LDA(At, 0, 1); PG8_STAGE(PG8_SA(0, 0), a2, voffA);
            PG8_BAR; PG8_WAIT_L(0); PG8_MMA(1, 0, At, B0); PG8_BAR; PG8_SCHED;
            PG8_STAGE(PG8_SB(0, 1), b2 + hstep, voffB);
            PG8_WAIT_V(6); PG8_BAR; PG8_MMA(1, 1, At, B1); PG8_BAR;
            PG8_LDB(B0, 1, 0); PG8_SCHED; PG8_LDA(At, 1, 0); PG8_STAGE(PG8_SA(0, 1), a2 + hstep, voffA);
            PG8_WAIT_L(8); PG8_BAR; PG8_WAIT_L(0); PG8_MMA(0, 0, At, B0); PG8_BAR; PG8_SCHED;
            PG8_LDB(B1, 1, 1); PG8_STAGE(PG8_SB(1, 0), b3, voffB);
            PG8_BAR; PG8_WAIT_L(0); PG8_MMA(0, 1, At, B1); PG8_BAR;
            PG8_LDA(At, 1, 1); PG8_STAGE(PG8_SA(1, 0), a3, voffA);
            PG8_BAR; PG8_WAIT_L(0); PG8_MMA(1, 0, At, B0); PG8_BAR; PG8_SCHED;
            PG8_STAGE(PG8_SB(1, 1), b3 + hstep, voffB);
            PG8_WAIT_V(6); PG8_BAR; PG8_MMA(1, 1, At, B1); PG8_BAR;
            }
        }
        if constexpr (ALIGN_EPI) { if (wr == 0) PG8_BAR; }
        { int fr_ = fr, fq_ = fq; asm volatile("" : "+v"(fr_), "+v"(fq_));
          E(acc, cur, wr, wc, fr_, fq_); } S.done(cur);
        if (!has_next) break;
#pragma unroll
        for (int a = 0; a < 2; ++a)
#pragma unroll
            for (int b = 0; b < 2; ++b)
#pragma unroll
                for (int m = 0; m < 4; ++m)
#pragma unroll
                    for (int n = 0; n < 2; ++n) acc[a][b][m][n] = (f32x4){0.f, 0.f, 0.f, 0.f};
        cur = nxt; cA = nA; cB = nB; ++ui;
        if constexpr (ALIGN_EPI) { if (wr == 1) PG8_BAR; }
    }
    PG8_WAIT_V(0);
    if constexpr (!ALIGN_EPI) { if (wr == 0) PG8_BAR; }
    PG8_BAR;
#undef PG8_SA
#undef PG8_SB
#undef PG8_STAGE
#undef PG8_LDA
#undef PG8_LDB
#undef PG8_MMA
#undef PG8_WAIT_V
#undef PG8_WAIT_L
#undef PG8_BAR
#undef PG8_SCHED
}
}
__device__ __forceinline__ void prep_adaln(const float* c, const float* cctx, const float* adaw, const float* adab, float* MOD, int it, LAS float* sv, int tid) {
    const int l = it / 384, r = it % 384, ntile = r >> 5, ks = r & 31, k0 = ks * 64;
    if (tid < 320) { const int v = tid >> 6, k = tid & 63; const float cv = v < 4 ? c[v * D + k0 + k] : cctx[k0 + k]; sv[tid] = cv / (1.0f + expf(-cv)); }
    __syncthreads();
    const int n = ntile * 512 + tid; const float* w = adaw + (size_t)l * D * ADA + (size_t)k0 * ADA + n;
    float acc[5] = {0.f, 0.f, 0.f, 0.f, 0.f};
#pragma unroll 1
    for (int k0_ = 0; k0_ < 64; k0_ += 32) {
        float wv[32];
#pragma unroll
        for (int k = 0; k < 32; ++k) wv[k] = w[(size_t)(k0_ + k) * ADA];
#pragma unroll
        for (int k = 0; k < 32; ++k) {
#pragma unroll
            for (int v = 0; v < 5; ++v) acc[v] += sv[v * 64 + k0_ + k] * wv[k]; } }
    if (ks == 0) { const float bb = adab[l * ADA + n];
#pragma unroll
        for (int v = 0; v < 5; ++v) acc[v] += bb; }
#pragma unroll
    for (int v = 0; v < 5; ++v) atomicAdd(MOD + (size_t)(l * 5 + v) * ADA + n, acc[v]);
    __syncthreads();
}

__device__ __forceinline__ void prep_s5(const DArgs& a, unsigned char* ws, int it, int tid) {
    const int idx = it * 512 + tid;
    const float a_re = a.in[I_S5ARE][idx], a_im = a.in[I_S5AIM][idx], ldt = a.in[I_S5LDT][idx >> 6];
    const float dt = expf(ldt), mag = expf(a_re * dt);
    float sn, cs; sincosf(a_im * dt, &sn, &cs);
    const float ab_re = mag * cs, ab_im = mag * sn, den = a_re * a_re + a_im * a_im, nr = ab_re - 1.0f;
    const float co_re = (nr * a_re + ab_im * a_im) / den, co_im = (ab_im * a_re - nr * a_im) / den;
    ((f32x2*)(ws + WS_S5AB))[idx] = (f32x2){ab_re, ab_im};
    const float* bre = a.in[I_S5BRE] + (size_t)idx * 16; const float* bim = a.in[I_S5BIM] + (size_t)idx * 16;
    f32x2* bt = (f32x2*)(ws + WS_S5BT) + (size_t)idx * 16;
#pragma unroll
    for (int i = 0; i < 16; ++i) { const float br = bre[i], bi = bim[i]; bt[i] = (f32x2){co_re * br - co_im * bi, co_re * bi + co_im * br}; }
}

__device__ __forceinline__ void prep_hymlp(const DArgs& a, float* H3out, bf16_t* H3b, int l, int Lx, int t0, LAS unsigned char* lds, int tid) {
    LAS float* zs = (LAS float*)lds;
    LAS float* h1 = (LAS float*)(lds + 4608);
    LAS float* h2 = (LAS float*)(lds + 4608 + 8192);
    LAS float* w1s = (LAS float*)(lds + 24576);
    LAS float* w2s = w1s + 33 * 64;
    LAS float* w3s = w2s + 64 * 64;
    { const float* w1 = a.in[I_HW1] + (size_t)l * 33 * 64; const float* w2 = a.in[I_HW2] + (size_t)l * 64 * 64; const float* w3 = a.in[I_HW3] + (size_t)l * 64 * 64;
      for (int i = tid; i < 33 * 64; i += NT) w1s[i] = w1[i];
      for (int i = tid; i < 64 * 64; i += NT) { w2s[i] = w2[i]; w3s[i] = w3[i]; } }
    for (int i = tid; i < 32 * 33; i += NT) { const int pos = i / 33, f = i % 33, t = t0 + pos;
        float z;
        if (f == 0) z = (float)t / (float)(Lx - 1);
        else { const int j = (f - 1) & 15; const float fj = 1e-4f + (float)j * ((15.0f - 1e-4f) / 15.0f); const float wpos = (6.283185307179586f * (float)t) / (float)Lx; const float arg = fj * wpos;
               z = (f <= 16) ? cosf(arg) : -sinf(arg); }
        zs[pos * 36 + f] = z; }
    __syncthreads();
    const int pos = tid >> 4, f4 = (tid & 15) * 4, t = t0 + pos;
    f32x4 s = *(const f32x4*)(a.in[I_HB1] + l * 64 + f4);
#pragma unroll 3
    for (int j = 0; j < 33; ++j) s += zs[pos * 36 + j] * *(const LAS f32x4*)(w1s + j * 64 + f4);
    { const f32x4 fr = *(const f32x4*)(a.in[I_HF1] + l * 64 + f4); *(LAS f32x4*)(h1 + pos * 64 + f4) = (f32x4){sinf(fr.x * s.x), sinf(fr.y * s.y), sinf(fr.z * s.z), sinf(fr.w * s.w)}; }
    __syncthreads();
    s = *(const f32x4*)(a.in[I_HB2] + l * 64 + f4);
#pragma unroll 4
    for (int j = 0; j < 64; ++j) s += h1[pos * 64 + j] * *(const LAS f32x4*)(w2s + j * 64 + f4);
    { const f32x4 fr = *(const f32x4*)(a.in[I_HF2] + l * 64 + f4); *(LAS f32x4*)(h2 + pos * 64 + f4) = (f32x4){sinf(fr.x * s.x), sinf(fr.y * s.y), sinf(fr.z * s.z), sinf(fr.w * s.w)}; }
    __syncthreads();
    s = *(const f32x4*)(a.in[I_HB3] + l * 64 + f4);
#pragma unroll 4
    for (int j = 0; j < 64; ++j) s += h2[pos * 64 + j] * *(const LAS f32x4*)(w3s + j * 64 + f4);
    { const f32x4 fr = *(const f32x4*)(a.in[I_HF3] + l * 64 + f4); const f32x4 hv = (f32x4){sinf(fr.x * s.x), sinf(fr.y * s.y), sinf(fr.z * s.z), sinf(fr.w * s.w)}; *(f32x4*)(H3out + (size_t)t * 64 + f4) = hv;
      if (H3b) { u32x2 pk; pk.x = pk2(hv.x, hv.y); pk.y = pk2(hv.z, hv.w); *(u32x2*)(H3b + (size_t)t * 64 + f4) = pk; } }
    __syncthreads();
}

__device__ __forceinline__ void transpose_item(const float* W, int ldw, int srccol_lane  , int k0, bf16_t* WT, int K, int dstrow0, LAS float* scr, int lane) {
    float wv[32];
#pragma unroll
    for (int i = 0; i < 32; ++i) { const int kk = 2 * i + (lane >> 5); wv[i] = srccol_lane >= 0 ? W[(size_t)(k0 + kk) * ldw + srccol_lane] : 0.f; }
#pragma unroll
    for (int i = 0; i < 32; ++i) { const int kk = 2 * i + (lane >> 5); scr[kk * 33 + (lane & 31)] = wv[i]; }
    LDS_WAIT();
    const int c = lane & 7;
#pragma unroll
    for (int j = 0; j < 4; ++j) { const int n = (lane >> 3) + 8 * j; const LAS float* s = scr + (8 * c) * 33 + n;
        u32x4 o; o.x = pk2(s[0 * 33], s[1 * 33]); o.y = pk2(s[2 * 33], s[3 * 33]); o.z = pk2(s[4 * 33], s[5 * 33]); o.w = pk2(s[6 * 33], s[7 * 33]);
        *(u32x4*)(WT + (size_t)(dstrow0 + n) * K + k0 + 8 * c) = o; }
    LDS_WAIT();
}
__device__ __forceinline__ int win_srccol(int n) {
    if (n >= 3072 && n < 4096) { const int u = (n - 3072) & 127, grp = u >> 3, e = u & 7; return (n & ~127) + (e < 4 ? 4 * grp + e : 64 + 4 * grp + (e - 4)); }
    return n < 6144 ? n : (n < 6656 ? n + 32 : (n < 6688 ? n - 512 : -1));
}

__device__ __forceinline__ void norm_row(const float* xrow, const float* nw, const float* mod, bf16_t* hrow, int lane) {
    f32x4 v[8]; float ss = 0.f;
#pragma unroll
    for (int j = 0; j < 8; ++j) { v[j] = ((const f32x4*)xrow)[lane + 64 * j]; ss += (v[j].x * v[j].x + v[j].y * v[j].y) + (v[j].z * v[j].z + v[j].w * v[j].w); }
    const float rstd = rsqrtf(wave_sum(ss) * (1.0f / D) + EPS);
#pragma unroll
    for (int j = 0; j < 8; ++j) { const int k = 4 * (lane + 64 * j);
        const f32x4 w = *(const f32x4*)(nw + k), sh = *(const f32x4*)(mod + k), sc = *(const f32x4*)(mod + D + k);
        const f32x4 o = v[j] * rstd * w * (sc + 1.0f) + sh;
        u32x2 pk; pk.x = pk2(o.x, o.y); pk.y = pk2(o.z, o.w);
        *(u32x2*)(hrow + k) = pk; }
}

__device__ __forceinline__ void fft_twiddles(LAS f32x2* W, int tid) {
    for (int j = tid; j < 4096; j += NT) { float s, c; sincospif(-(float)j * (1.0f / 4096.0f), &s, &c); W[j] = (f32x2){c, s}; }
}
template <int R, int BETA, bool INV> __device__ __forceinline__ void fft_pass(LAS f32x2* X, const LAS f32x2* W, int tid) {
    constexpr int LOW = BETA - R + 1, NG = FFTN >> R;
    for (int gi = tid; gi < NG; gi += NT) {
        const int base = ((gi >> LOW) << (BETA + 1)) | (gi & ((1 << LOW) - 1));
        f32x2 e[1 << R];
#pragma unroll
        for (int m = 0; m < (1 << R); ++m) e[m] = X[base + (m << LOW)];
#pragma unroll
        for (int ss = 0; ss < R; ++ss) {
            const int s = INV ? (R - 1 - ss) : ss; const int bit = BETA - s, h = 1 << (R - 1 - s);
#pragma unroll
            for (int m = 0; m < (1 << R); ++m) {
                if (m & h) continue;
                const int idx = base + (m << LOW); const int ex = (idx & ((1 << bit) - 1)) << (12 - bit);
                const f32x2 w = W[ex]; const f32x2 a_ = e[m], b_ = e[m | h];
                if (!INV) { const f32x2 d = a_ - b_; e[m] = a_ + b_; e[m | h] = (f32x2){d.x * w.x - d.y * w.y, d.x * w.y + d.y * w.x}; }
                else { const f32x2 t = (f32x2){b_.x * w.x + b_.y * w.y, b_.y * w.x - b_.x * w.y}; e[m] = a_ + t; e[m | h] = a_ - t; }
            }
        }
#pragma unroll
        for (int m = 0; m < (1 << R); ++m) X[base + (m << LOW)] = e[m];
    }
}
__device__ __forceinline__ void fft_forward(LAS f32x2* X, const LAS f32x2* W, int tid) {
    fft_pass<4, 12, false>(X, W, tid); __syncthreads(); fft_pass<3, 8, false>(X, W, tid); __syncthreads();
    fft_pass<3, 5, false>(X, W, tid); __syncthreads(); fft_pass<3, 2, false>(X, W, tid); __syncthreads();
}
__device__ __forceinline__ void fft_inverse(LAS f32x2* X, const LAS f32x2* W, int tid) {
    fft_pass<3, 2, true>(X, W, tid); __syncthreads(); fft_pass<3, 5, true>(X, W, tid); __syncthreads();
    fft_pass<3, 8, true>(X, W, tid); __syncthreads(); fft_pass<4, 12, true>(X, W, tid); __syncthreads();
}
__device__ __forceinline__ float block_sum(float v, LAS float* red, int tid) {
    v = wave_sum(v);
    if ((tid & 63) == 0) red[tid >> 6] = v;
    __syncthreads();
    float t = 0.f;
#pragma unroll
    for (int i = 0; i < NWAVES; ++i) t += red[i];
    __syncthreads();
    return t;
}
constexpr float HY_D0 = -3.0701134573253945f  , HY_D1 = -15.350567286626973f  ;

__device__ __forceinline__ void filt_item(const DArgs& a, unsigned char* ws, LAS unsigned char* lds, int l, int c, int tid) {
    LAS f32x2* X = (LAS f32x2*)lds; LAS f32x2* W = (LAS f32x2*)(lds + 65536); LAS float* w4s = (LAS float*)(lds + 98304); LAS float* red = (LAS float*)(lds + 98304 + 1024);
    LAS float* k1b = (LAS float*)(lds + 100352);
    fft_twiddles(W, tid);
    if (tid < 256) { const int cc = tid >> 6, f = tid & 63; w4s[tid] = a.in[I_HW4][(size_t)l * 64 * 2048 + (size_t)f * 2048 + (cc >> 1) * 1024 + (cc & 1) * 512 + c]; }
    __syncthreads();
    const float dl = fabsf(HY_D0 + (HY_D1 - HY_D0) * ((float)c / 511.0f));
    const float* H3 = (const float*)(ws + WS_H3) + (size_t)l * 4096 * 64;
    float ss0 = 0.f, ss1 = 0.f;
#pragma unroll 1
    for (int j = 0; j < 16; ++j) {
        const int n = tid + 512 * j; const int dir = j >= 8 ? 1 : 0; const int t = dir ? (8192 - n) : n;
        float s0 = 0.f, s1 = 0.f;
        if (n != 4096) {
            const f32x4* hr = (const f32x4*)(H3 + (size_t)t * 64);
#pragma unroll
            for (int q = 0; q < 16; ++q) { const f32x4 hv = hr[q]; const f32x4 wa = ((const LAS f32x4*)(w4s + (dir * 2 + 0) * 64))[q], wb = ((const LAS f32x4*)(w4s + (dir * 2 + 1) * 64))[q];
                s0 += (hv.x * wa.x + hv.y * wa.y) + (hv.z * wa.z + hv.w * wa.w); s1 += (hv.x * wb.x + hv.y * wb.y) + (hv.z * wb.z + hv.w * wb.w); }
            const float dec = expf(-((float)t / 4095.0f) * dl); s0 *= dec; s1 *= dec;
        }
        X[n] = (f32x2){s0, 0.f}; k1b[n] = s1; ss0 += s0 * s0; ss1 += s1 * s1;
    }
    const float rs0 = rsqrtf(block_sum(ss0, red, tid) + EPS), rs1 = rsqrtf(block_sum(ss1, red, tid) + EPS);
    f32x2* KF0 = (f32x2*)(ws + WS_KF) + (size_t)(0 * 512 + c) * FFTN; f32x2* KF1 = (f32x2*)(ws + WS_KF) + (size_t)(1 * 512 + c) * FFTN;
#pragma unroll 4
    for (int j = 0; j < 16; ++j) { const f32x2 x = X[tid + 512 * j]; X[tid + 512 * j] = (f32x2){x.x * rs0, 0.f}; }
    __syncthreads(); fft_forward(X, W, tid);
#pragma unroll 4
    for (int j = 0; j < 16; ++j) KF0[tid + 512 * j] = X[tid + 512 * j];
    __syncthreads();
#pragma unroll 4
    for (int j = 0; j < 16; ++j) X[tid + 512 * j] = (f32x2){k1b[tid + 512 * j] * rs1, 0.f};
    __syncthreads(); fft_forward(X, W, tid);
#pragma unroll 4
    for (int j = 0; j < 16; ++j) KF1[tid + 512 * j] = X[tid + 512 * j];
    __syncthreads();
}
__device__ __forceinline__ void filt_ctx_item(const DArgs& a, unsigned char* ws, LAS unsigned char* lds, int c, int tid) {
    LAS float* w4s = (LAS float*)lds; LAS float* red = (LAS float*)(lds + 1024);
    if (tid < 256) { const int cc = tid >> 6, f = tid & 63; w4s[tid] = a.in[I_HW4][(size_t)f * 2048 + (cc >> 1) * 1024 + (cc & 1) * 512 + c]; }
    __syncthreads();
    const float dl = fabsf(HY_D0 + (HY_D1 - HY_D0) * ((float)c / 511.0f));
    const float* H3C = (const float*)(ws + WS_H3C);
    const int n = tid, dir = n >= 256 ? 1 : 0, t = dir ? (512 - n) : n;
    float s0 = 0.f, s1 = 0.f;
    if (n != 256) {
        const f32x4* hr = (const f32x4*)(H3C + (size_t)t * 64);
#pragma unroll
        for (int q = 0; q < 16; ++q) { const f32x4 hv = hr[q]; const f32x4 wa = ((const LAS f32x4*)(w4s + (dir * 2 + 0) * 64))[q], wb = ((const LAS f32x4*)(w4s + (dir * 2 + 1) * 64))[q];
            s0 += (hv.x * wa.x + hv.y * wa.y) + (hv.z * wa.z + hv.w * wa.w); s1 += (hv.x * wb.x + hv.y * wb.y) + (hv.z * wb.z + hv.w * wb.w); }
        const float dec = expf(-((float)t / 255.0f) * dl); s0 *= dec; s1 *= dec;
    }
    const float rs0 = rsqrtf(block_sum(s0 * s0, red, tid) + EPS), rs1 = rsqrtf(block_sum(s1 * s1, red, tid) + EPS);
    float* KC = (float*)(ws + WS_KC);
    KC[(size_t)(0 * 512 + c) * 512 + n] = s0 * rs0; KC[(size_t)(1 * 512 + c) * 512 + n] = s1 * rs1;
    __syncthreads();
}

__device__ __forceinline__ void prep_rope(f32x2* RT, int it, int tid) {
    const int idx = it * NT + tid, pos = idx >> 6, j = idx & 63;
    float ang;
    if (pos < SEQL) { const float inv = exp2f(-(float)(j & 31) * (13.287712379549449f / 32.0f)); ang = (float)(j < 32 ? (pos >> 6) : (pos & 63)) * inv; }
    else { const float inv = exp2f(-(float)j * (13.287712379549449f / 64.0f)); ang = (float)(pos - SEQL) * inv; }
    float sn, cs; sincosf(ang, &sn, &cs);
    RT[idx] = (f32x2){cs, sn};
}

__device__ __forceinline__ void ret_chain(const bf16_t* P, bf16_t* O, int b, int h, int dir, bool ctx_out, int wave, int lane) {
    const int e = wave * 16 + (lane & 15), dq = lane >> 4;
    const float gamma = 1.0f - exp2f(-5.0f - (float)h);
    constexpr int TB = 2;
    float S[32];
#pragma unroll
    for (int i = 0; i < 32; ++i) S[i] = 0.f;
    for (int seg = 0; seg < 2; ++seg) {
        const int n = seg ? SEQL : LC, rowbase = seg ? b * SEQL : NLAT + b * LC; const bool wr_out = seg || ctx_out;
        for (int i0 = 0; i0 < n; i0 += TB) {
            u32x4 q[TB][4], k[TB][4]; bf16_t v[TB];
#pragma unroll
            for (int tb = 0; tb < TB; ++tb) { const int row = rowbase + (dir ? n - 1 - (i0 + tb) : i0 + tb); const bf16_t* pr = P + (size_t)row * LDP;
#pragma unroll
                for (int c4 = 0; c4 < 4; ++c4) { q[tb][c4] = ((const u32x4*)(pr + PC_RQ + h * 128 + dq * 32))[c4]; k[tb][c4] = ((const u32x4*)(pr + PC_RK + h * 128 + dq * 32))[c4]; }
                v[tb] = pr[PC_RV + h * 128 + e]; }
#pragma unroll
            for (int tb = 0; tb < TB; ++tb) {
                const int row = rowbase + (dir ? n - 1 - (i0 + tb) : i0 + tb);
                const float vf = bf2f(v[tb]); float o = 0.f;
#pragma unroll
                for (int c4 = 0; c4 < 4; ++c4) { float qf[8], kf[8]; unpack8(q[tb][c4], qf); unpack8(k[tb][c4], kf);
#pragma unroll
                    for (int x = 0; x < 8; ++x) { const int ix = c4 * 8 + x; S[ix] = gamma * S[ix] + kf[x] * vf; o += qf[x] * S[ix]; } }
                o += __shfl_xor(o, 16); o += __shfl_xor(o, 32);
                if (wr_out && dq == 0) O[(size_t)row * 512 + h * 128 + e] = (bf16_t)f2bf(o);
            }
        }
    }
}
__device__ __forceinline__ void gla_chain(const bf16_t* P, const bf16_t* GLGd, bf16_t* O, int b, int h, int dir, bool ctx_out, int wave, int lane) {
    const int e = wave * 16 + (lane & 15), dq = lane >> 4;
    constexpr int TB = 4;
    float S[16];
#pragma unroll
    for (int i = 0; i < 16; ++i) S[i] = 0.f;
    for (int seg = 0; seg < 2; ++seg) {
        const int n = seg ? SEQL : LC, rowbase = seg ? b * SEQL : NLAT + b * LC; const bool wr_out = seg || ctx_out;
        for (int i0 = 0; i0 < n; i0 += TB) {
            u32x4 q[TB][2], k[TB][2], g[TB][2]; bf16_t v[TB];
#pragma unroll
            for (int tb = 0; tb < TB; ++tb) { const int row = rowbase + (dir ? n - 1 - (i0 + tb) : i0 + tb); const bf16_t* pr = P + (size_t)row * LDP; const bf16_t* gr = GLGd + (size_t)row * 256 + h * 64 + dq * 16;
#pragma unroll
                for (int c4 = 0; c4 < 2; ++c4) { q[tb][c4] = ((const u32x4*)(pr + PC_GQ + h * 64 + dq * 16))[c4]; k[tb][c4] = ((const u32x4*)(pr + PC_GK + h * 64 + dq * 16))[c4]; g[tb][c4] = ((const u32x4*)gr)[c4]; }
                v[tb] = pr[PC_GV + h * 128 + e]; }
#pragma unroll
            for (int tb = 0; tb < TB; ++tb) {
                const int row = rowbase + (dir ? n - 1 - (i0 + tb) : i0 + tb);
                const float vf = bf2f(v[tb]); float o = 0.f;
#pragma unroll
                for (int c4 = 0; c4 < 2; ++c4) { float qf[8], kf[8], gf[8]; unpack8(q[tb][c4], qf); unpack8(k[tb][c4], kf); unpack8(g[tb][c4], gf);
#pragma unroll
                    for (int x = 0; x < 8; ++x) { const int ix = c4 * 8 + x; S[ix] = __expf(gf[x]) * S[ix] + kf[x] * vf; o += qf[x] * S[ix]; } }
                o += __shfl_xor(o, 16); o += __shfl_xor(o, 32);
                if (wr_out && dq == 0) O[(size_t)row * 512 + h * 128 + e] = (bf16_t)f2bf(o * 0.125f);
            }
        }
    }
}
__device__ __forceinline__ void s5_chain(const DArgs& a, unsigned char* ws, LAS unsigned char* lds, int l, int b, int g, int dir, bool ctx_out, int tid) {
    LAS f32x2* cs = (LAS f32x2*)lds; LAS f32x2* hs = (LAS f32x2*)(lds + 16 * 65 * 8); LAS float* us = (LAS float*)(lds + 2 * 16 * 65 * 8);
    const int wave = tid >> 6, lane = tid & 63;
    const int gi = (l * 2 + dir) * 32 + g;
    const float* cre = a.in[I_S5CRE] + (size_t)gi * 1024; const float* cim = a.in[I_S5CIM] + (size_t)gi * 1024;
    for (int idx = tid; idx < 1024; idx += NT) { const int i = idx >> 6, p = idx & 63; cs[i * 65 + p] = (f32x2){cre[idx], cim[idx]}; }
    f32x2 ab = {0.f, 0.f}; f32x2 bt[16]; f32x2 hst = {0.f, 0.f};
    if (wave == 0) { ab = ((const f32x2*)(ws + WS_S5AB))[gi * 64 + lane]; const f32x2* bp = (const f32x2*)(ws + WS_S5BT) + (size_t)(gi * 64 + lane) * 16;
#pragma unroll
        for (int i = 0; i < 16; ++i) bt[i] = bp[i]; }
    else {
#pragma unroll
        for (int i = 0; i < 16; ++i) bt[i] = (f32x2){0.f, 0.f}; }
    const bf16_t* P = (const bf16_t*)(ws + WS_P);
    bf16_t* Y = (bf16_t*)(ws + WS_OB) + (size_t)(4 + dir) * OBSZ;
    const int tt = tid >> 4, i = tid & 15;
    for (int seg = 0; seg < 2; ++seg) {
        const int n = seg ? SEQL : LC, rowbase = seg ? b * SEQL : NLAT + b * LC; const bool wr_out = seg || ctx_out;
        __syncthreads();
        if (tid < 256) us[tid] = bf2f(P[(size_t)(rowbase + (dir ? n - 1 - tt : tt)) * LDP + PC_S5U + g * 16 + i]);
        for (int bt0 = 0; bt0 < n; bt0 += 16) {
            const int ii = bt0 + tt; const int row = rowbase + (dir ? n - 1 - ii : ii);
            bf16_t unext = 0;
            if (tid < 256 && bt0 + 16 < n) { const int iin = ii + 16; unext = P[(size_t)(rowbase + (dir ? n - 1 - iin : iin)) * LDP + PC_S5U + g * 16 + i]; }
            __syncthreads();
            if (wave == 0) {
#pragma unroll 4
                for (int t2 = 0; t2 < 16; ++t2) {
                    float bur = 0.f, bui = 0.f;
#pragma unroll
                    for (int q = 0; q < 4; ++q) { const f32x4 u = ((const LAS f32x4*)(us + t2 * 16))[q];
                        bur += bt[4 * q].x * u.x + bt[4 * q + 1].x * u.y + bt[4 * q + 2].x * u.z + bt[4 * q + 3].x * u.w;
                        bui += bt[4 * q].y * u.x + bt[4 * q + 1].y * u.y + bt[4 * q + 2].y * u.z + bt[4 * q + 3].y * u.w; }
                    const float hr = ab.x * hst.x - ab.y * hst.y + bur, hi = ab.x * hst.y + ab.y * hst.x + bui;
                    hst = (f32x2){hr, hi};
                    hs[t2 * 65 + lane] = hst;
                }
            }
            __syncthreads();
            if (tid < 256) {
                us[tid] = bf2f(unext);
                float y = 0.f;
#pragma unroll 8
                for (int p = 0; p < 64; ++p) { const f32x2 cv = cs[i * 65 + p], hv = hs[tt * 65 + p]; y += cv.x * hv.x - cv.y * hv.y; }
                if (wr_out) Y[(size_t)row * 512 + g * 16 + i] = (bf16_t)f2bf(y);
            }
        }
    }
    __syncthreads();
}

__device__ __forceinline__ float sconv3(const bf16_t* p, int t, int Lx, float w0, float w1, float w2, float cb) {
    const float x0 = t > 0 ? bf2f(p[t - 1]) : 0.f, x1 = bf2f(p[t]), x2 = t < Lx - 1 ? bf2f(p[t + 1]) : 0.f;
    return w0 * x0 + w1 * x1 + w2 * x2 + cb;
}
__device__ __forceinline__ void hyena_item(const DArgs& a, unsigned char* ws, LAS unsigned char* lds, int l, int c, int tid) {
    LAS f32x2* X = (LAS f32x2*)lds; LAS f32x2* W = (LAS f32x2*)(lds + 65536);
    fft_twiddles(W, tid);
    const float* cw = a.in[I_HCW] + (size_t)l * 3 * 1536; const float* cbp = a.in[I_HCB] + (size_t)l * 1536;
    const float wv0 = cw[c], wv1 = cw[1536 + c], wv2 = cw[3072 + c], bv = cbp[c];
    const float wa0 = cw[512 + c], wa1 = cw[1536 + 512 + c], wa2 = cw[3072 + 512 + c], ba = cbp[512 + c];
    const float wb0 = cw[1024 + c], wb1 = cw[1536 + 1024 + c], wb2 = cw[3072 + 1024 + c], bb = cbp[1024 + c];
    const float bias0 = a.in[I_HBIAS][(l * 2 + 0) * 512 + c], bias1 = a.in[I_HBIAS][(l * 2 + 1) * 512 + c];
    const bf16_t* PT = (const bf16_t*)(ws + WS_PT);
    const bf16_t* pv = PT + (size_t)(PT_V + c) * MR; const bf16_t* pg1 = PT + (size_t)(PT_G1 + c) * MR; const bf16_t* pg2 = PT + (size_t)(PT_G2 + c) * MR; const bf16_t* phg = PT + (size_t)(PT_HG + c) * MR;
    const f32x2* KF0 = (const f32x2*)(ws + WS_KF) + (size_t)(0 * 512 + c) * FFTN; const f32x2* KF1 = (const f32x2*)(ws + WS_KF) + (size_t)(1 * 512 + c) * FFTN;
    bf16_t* GATED = (bf16_t*)(ws + WS_H);
    __syncthreads();
    for (int bp = 0; bp < 2; ++bp) {
        const int r0 = (2 * bp) * SEQL, r1 = (2 * bp + 1) * SEQL;
        float zr[8], zi[8];
#pragma unroll
        for (int j = 0; j < 8; ++j) { const int t = tid + 512 * j; zr[j] = sconv3(pv + r0, t, SEQL, wv0, wv1, wv2, bv); zi[j] = sconv3(pv + r1, t, SEQL, wv0, wv1, wv2, bv);
            X[t] = (f32x2){zr[j], zi[j]}; X[4096 + t] = (f32x2){0.f, 0.f}; if (j & 1) asm volatile("" ::: "memory"); }
        __syncthreads(); fft_forward(X, W, tid);
#pragma unroll 4
        for (int j = 0; j < 16; ++j) { const int pos = tid + 512 * j; const f32x2 x = X[pos], k = KF0[pos]; X[pos] = (f32x2){x.x * k.x - x.y * k.y, x.x * k.y + x.y * k.x}; }
        __syncthreads(); fft_inverse(X, W, tid);
#pragma unroll
        for (int j = 0; j < 8; ++j) { const int t = tid + 512 * j; const f32x2 cv = X[t] * (1.0f / 8192.0f);
            const float g1r = sconv3(pg1 + r0, t, SEQL, wa0, wa1, wa2, ba), g1i = sconv3(pg1 + r1, t, SEQL, wa0, wa1, wa2, ba);
            zr[j] = g1r * (cv.x + bias0 * zr[j]); zi[j] = g1i * (cv.y + bias0 * zi[j]); if (j & 1) asm volatile("" ::: "memory"); }
        __syncthreads();
#pragma unroll
        for (int j = 0; j < 8; ++j) { const int t = tid + 512 * j; X[t] = (f32x2){zr[j], zi[j]}; X[4096 + t] = (f32x2){0.f, 0.f}; }
        __syncthreads(); fft_forward(X, W, tid);
#pragma unroll 4
        for (int j = 0; j < 16; ++j) { const int pos = tid + 512 * j; const f32x2 x = X[pos], k = KF1[pos]; X[pos] = (f32x2){x.x * k.x - x.y * k.y, x.x * k.y + x.y * k.x}; }
        __syncthreads(); fft_inverse(X, W, tid);
#pragma unroll
        for (int j = 0; j < 8; ++j) { const int t = tid + 512 * j; const f32x2 cv = X[t] * (1.0f / 8192.0f);
            const float g2r = sconv3(pg2 + r0, t, SEQL, wb0, wb1, wb2, bb), g2i = sconv3(pg2 + r1, t, SEQL, wb0, wb1, wb2, bb);
            const float z2r = g2r * (cv.x + bias1 * zr[j]), z2i = g2i * (cv.y + bias1 * zi[j]);
            const float hg0 = bf2f(phg[r0 + t]), hg1 = bf2f(phg[r1 + t]);
            GATED[(size_t)(r0 + t) * D + 512 + c] = (bf16_t)f2bf(z2r * siluf_(hg0)); GATED[(size_t)(r1 + t) * D + 512 + c] = (bf16_t)f2bf(z2i * siluf_(hg1)); if (j & 1) asm volatile("" ::: "memory"); }
        __syncthreads();
    }
}
__device__ __forceinline__ void ctx_conv256(const LAS float* kc, const LAS float* z, int b, int t4, int half, float (&o)[4]) {
    o[0] = o[1] = o[2] = o[3] = 0.f;
#pragma unroll 4
    for (int s4 = 0; s4 < 32; ++s4) { const int s = 128 * half + 4 * s4, d = 4 * t4 - s;
        const f32x4 zv = *(const LAS f32x4*)(z + b * 256 + s);
        const f32x4 wl = *(const LAS f32x4*)(kc + ((d - 4) & 511)), wh = *(const LAS f32x4*)(kc + (d & 511));
        const float w[8] = {wl.x, wl.y, wl.z, wl.w, wh.x, wh.y, wh.z, wh.w};
        const float zz[4] = {zv.x, zv.y, zv.z, zv.w};
#pragma unroll
        for (int j = 0; j < 4; ++j)
#pragma unroll
            for (int i = 0; i < 4; ++i) o[j] += w[4 + j - i] * zz[i]; }
}
__device__ __forceinline__ void hyena_ctx_item(const DArgs& a, unsigned char* ws, LAS unsigned char* lds, int c, int tid) {
    LAS float* kc = (LAS float*)lds; LAS float* za = (LAS float*)(lds + 4096); LAS float* zb = (LAS float*)(lds + 8192); LAS float* part = (LAS float*)(lds + 12288);
    const float* KC = (const float*)(ws + WS_KC);
    kc[tid] = KC[(size_t)(0 * 512 + c) * 512 + tid]; kc[512 + tid] = KC[(size_t)(1 * 512 + c) * 512 + tid];
    const float* cw = a.in[I_HCW]; const float* cbp = a.in[I_HCB];
    const float wv0 = cw[c], wv1 = cw[1536 + c], wv2 = cw[3072 + c], bv = cbp[c];
    const float wa0 = cw[512 + c], wa1 = cw[1536 + 512 + c], wa2 = cw[3072 + 512 + c], ba = cbp[512 + c];
    const float wb0 = cw[1024 + c], wb1 = cw[1536 + 1024 + c], wb2 = cw[3072 + 1024 + c], bb = cbp[1024 + c];
    const float bias0 = a.in[I_HBIAS][0 * 512 + c], bias1 = a.in[I_HBIAS][1 * 512 + c];
    const bf16_t* PT = (const bf16_t*)(ws + WS_PT);
    const int half = tid >> 8, b = (tid >> 6) & 3, t4 = tid & 63; const int rb = NLAT + b * LC;
    const bf16_t* pv = PT + (size_t)(PT_V + c) * MR + rb; const bf16_t* pg1 = PT + (size_t)(PT_G1 + c) * MR + rb; const bf16_t* pg2 = PT + (size_t)(PT_G2 + c) * MR + rb; const bf16_t* phg = PT + (size_t)(PT_HG + c) * MR + rb;
    bf16_t* GATED = (bf16_t*)(ws + WS_H);
    float z0[4], z1[4], o[4];
#pragma unroll
    for (int j = 0; j < 4; ++j) { z0[j] = sconv3(pv, 4 * t4 + j, LC, wv0, wv1, wv2, bv); }
    if (half == 0) *(LAS f32x4*)(za + b * 256 + 4 * t4) = (f32x4){z0[0], z0[1], z0[2], z0[3]};
    __syncthreads();
    ctx_conv256(kc, za, b, t4, half, o);
    if (half == 1) *(LAS f32x4*)(part + b * 256 + 4 * t4) = (f32x4){o[0], o[1], o[2], o[3]};
    __syncthreads();
    if (half == 0) { const f32x4 pp = *(const LAS f32x4*)(part + b * 256 + 4 * t4); const float ps[4] = {pp.x, pp.y, pp.z, pp.w};
#pragma unroll
        for (int j = 0; j < 4; ++j) z1[j] = sconv3(pg1, 4 * t4 + j, LC, wa0, wa1, wa2, ba) * (o[j] + ps[j] + bias0 * z0[j]);
        *(LAS f32x4*)(zb + b * 256 + 4 * t4) = (f32x4){z1[0], z1[1], z1[2], z1[3]}; }
    __syncthreads();
    ctx_conv256(kc + 512, zb, b, t4, half, o);
    if (half == 1) *(LAS f32x4*)(part + b * 256 + 4 * t4) = (f32x4){o[0], o[1], o[2], o[3]};
    __syncthreads();
    if (half == 0) { const f32x4 pp = *(const LAS f32x4*)(part + b * 256 + 4 * t4); const float ps[4] = {pp.x, pp.y, pp.z, pp.w};
#pragma unroll
        for (int j = 0; j < 4; ++j) { const int t = 4 * t4 + j; const float z2 = sconv3(pg2, t, LC, wb0, wb1, wb2, bb) * (o[j] + ps[j] + bias1 * z1[j]);
            GATED[(size_t)(rb + t) * D + 512 + c] = (bf16_t)f2bf(z2 * siluf_(bf2f(phg[t]))); } }
    __syncthreads();
}

__device__ __forceinline__ void merge_row(const DArgs& a, unsigned char* ws, int l, int row, int lane) {
    const int col = 8 * lane;
    const bf16_t* OB = (const bf16_t*)(ws + WS_OB); const bf16_t* P = (const bf16_t*)(ws + WS_P) + (size_t)row * LDP;
    bf16_t* GATED = (bf16_t*)(ws + WS_H) + (size_t)row * D; bf16_t* G5 = (bf16_t*)(ws + WS_KF) + (size_t)row * 512;
    { float yf[8], yb[8], u[8], res[8];
      unpack8(*(const u32x4*)(OB + (size_t)4 * OBSZ + (size_t)row * 512 + col), yf); unpack8(*(const u32x4*)(OB + (size_t)5 * OBSZ + (size_t)row * 512 + col), yb);
      unpack8(*(const u32x4*)(P + PC_S5U + col), u);
      const float* dsk = a.in[I_S5D] + l * 512 + col;
#pragma unroll
      for (int x = 0; x < 8; ++x) res[x] = gelu_tanh(yf[x] + yb[x] + u[x] * dsk[x]);
      *(u32x4*)(G5 + col) = pack8(res); }
}

struct EpiInProj {
    static constexpr bool PERM = true, AFTER_DRAIN = false;
    bf16_t* P; bf16_t* PT; float* LR; const float* RT;
    __device__ __forceinline__ void operator()(const pg8::f32x4 (&acc)[2][2][4][2], const pg8::Unit& u, int wr, int wc, int fr, int fq) const {
        const int row0 = u.pm * 256 + wr * 64 + fr, pn = u.pn;
        if (pn >= 12 && pn < 16) {
            const int colbase = pn * 256 - 2048 + wc * 32 + 8 * fq; const int j0 = 4 * (4 * wc + fq); const float ksc = pn >= 14 ? 0.08838834764831845f : 1.0f;
#pragma unroll
            for (int ai = 0; ai < 2; ++ai)
#pragma unroll
                for (int m = 0; m < 4; ++m) { const int row = row0 + ai * 128 + m * 16; const int pos = row < NLAT ? (row & (SEQL - 1)) : SEQL + ((row - NLAT) & (LC - 1));
                    const pg8::f32x4 t0 = *(const pg8::f32x4*)(RT + ((size_t)pos * 64 + j0) * 2), t1 = *(const pg8::f32x4*)(RT + ((size_t)pos * 64 + j0) * 2 + 4);
                    bf16_t* rowp = P + (size_t)row * LDP + colbase;
#pragma unroll
                    for (int bj = 0; bj < 2; ++bj) { const pg8::f32x4 x1 = acc[ai][bj][m][0] * ksc, x2 = acc[ai][bj][m][1] * ksc;
                        u32x4 w; w.x = pk2(x1[0] * t0[0] - x2[0] * t0[1], x1[1] * t0[2] - x2[1] * t0[3]); w.y = pk2(x1[2] * t1[0] - x2[2] * t1[1], x1[3] * t1[2] - x2[3] * t1[3]);
                        w.z = pk2(x1[0] * t0[1] + x2[0] * t0[0], x1[1] * t0[3] + x2[1] * t0[2]); w.w = pk2(x1[2] * t1[1] + x2[2] * t1[0], x1[3] * t1[3] + x2[3] * t1[2]);
                        *(u32x4*)(rowp + bj * 128) = w; } }
        } else if (pn < 4 || (pn >= 16 && pn < 26)) {
            const int colbase = (pn < 4 ? pn * 256 : pn * 256 - 2048) + wc * 32 + 8 * fq;
#pragma unroll
            for (int ai = 0; ai < 2; ++ai)
#pragma unroll
                for (int m = 0; m < 4; ++m) { bf16_t* rowp = P + (size_t)(row0 + ai * 128 + m * 16) * LDP + colbase;
#pragma unroll
                    for (int bj = 0; bj < 2; ++bj) { const pg8::f32x4 v0 = acc[ai][bj][m][0], v1 = acc[ai][bj][m][1];
                        u32x4 w; w.x = pk2(v0[0], v0[1]); w.y = pk2(v0[2], v0[3]); w.z = pk2(v1[0], v1[1]); w.w = pk2(v1[2], v1[3]);
                        *(u32x4*)(rowp + bj * 128) = w; } }
        } else if (pn < 12) {
            const int colbase = (pn - 4) * 256 + wc * 32 + 8 * fq;
#pragma unroll
            for (int bj = 0; bj < 2; ++bj)
#pragma unroll
                for (int n = 0; n < 2; ++n)
#pragma unroll
                    for (int j = 0; j < 4; ++j) { bf16_t* cp = PT + (size_t)(colbase + bj * 128 + 4 * n + j) * MR + row0;
#pragma unroll
                        for (int ai = 0; ai < 2; ++ai)
#pragma unroll
                            for (int m = 0; m < 4; ++m) cp[ai * 128 + m * 16] = (bf16_t)f2bf(acc[ai][bj][m][n][j]);
                        asm volatile("" ::: "memory"); }
        } else {
            if (wc == 0) {
#pragma unroll
                for (int ai = 0; ai < 2; ++ai)
#pragma unroll
                    for (int m = 0; m < 4; ++m) { float* rowp = LR + (size_t)(row0 + ai * 128 + m * 16) * 32 + 8 * fq;
                        *(pg8::f32x4*)(rowp) = acc[ai][0][m][0]; *(pg8::f32x4*)(rowp + 4) = acc[ai][0][m][1]; }
            }
        }
    }
};
struct EpiGlu {
    static constexpr bool PERM = true, AFTER_DRAIN = false;
    const bf16_t* GG; bf16_t* GATED; const float* bias;
    __device__ __forceinline__ void operator()(const pg8::f32x4 (&acc)[2][2][4][2], const pg8::Unit& u, int wr, int wc, int fr, int fq) const {
        const int row0 = u.pm * 256 + wr * 64 + fr, col0 = u.pn * 256 + wc * 32 + 8 * fq;
        pg8::f32x4 b0[2], b1[2];
#pragma unroll
        for (int bj = 0; bj < 2; ++bj) { b0[bj] = *(const pg8::f32x4*)(bias + col0 + bj * 128); b1[bj] = *(const pg8::f32x4*)(bias + col0 + bj * 128 + 4); }
#pragma unroll
        for (int ai = 0; ai < 2; ++ai) {
            u32x4 gg[4][2];
#pragma unroll
            for (int m = 0; m < 4; ++m)
#pragma unroll
                for (int bj = 0; bj < 2; ++bj) gg[m][bj] = *(const u32x4*)(GG + (size_t)(row0 + ai * 128 + m * 16) * 512 + col0 + bj * 128);
#pragma unroll
            for (int m = 0; m < 4; ++m) { const size_t row = (size_t)(row0 + ai * 128 + m * 16);
#pragma unroll
                for (int bj = 0; bj < 2; ++bj) { float g[8], res[8]; unpack8(gg[m][bj], g);
#pragma unroll
                    for (int j = 0; j < 4; ++j) { res[j] = g[j] * sigmoidf_(acc[ai][bj][m][0][j] + b0[bj][j]); res[4 + j] = g[4 + j] * sigmoidf_(acc[ai][bj][m][1][j] + b1[bj][j]); }
                    *(u32x4*)(GATED + row * D + col0 + bj * 128) = pack8(res); } }
            asm volatile("" ::: "memory");
        }
    }
};
struct EpiOut {
    static constexpr bool PERM = false, AFTER_DRAIN = false;
    const float* xl_old; const float* xc_old; float* xl_new; float* xc_new; const float* mod;
    __device__ __forceinline__ void operator()(const pg8::f32x4 (&acc)[2][2][4][2], const pg8::Unit& u, int wr, int wc, int fr, int fq) const {
        const int row0 = u.pm * 256 + wr * 64 + fr, col0 = u.pn * 256 + wc * 32 + 4 * fq;
        const bool lat = u.pm < 64;
        const float* xo = lat ? xl_old : xc_old - (size_t)NLAT * D; float* xn = lat ? xl_new : xc_new - (size_t)NLAT * D;
#pragma unroll
        for (int ai = 0; ai < 2; ++ai) {
            const int v = lat ? ((u.pm * 256 + ai * 128) >> 12) : 4;
            const float* gt = mod + (size_t)v * ADA + 2 * D;
#pragma unroll
            for (int m = 0; m < 4; ++m) { const size_t off = (size_t)(row0 + ai * 128 + m * 16) * D + col0;
#pragma unroll
                for (int bj = 0; bj < 2; ++bj)
#pragma unroll
                    for (int n = 0; n < 2; ++n) { const int cc = bj * 128 + n * 16; const pg8::f32x4 gv = *(const pg8::f32x4*)(gt + col0 + cc), xv = *(const pg8::f32x4*)(xo + off + cc);
                        *(pg8::f32x4*)(xn + off + cc) = xv + gv * acc[ai][bj][m][n]; } }
        }
    }
};
typedef short bf16x8 __attribute__((ext_vector_type(8)));
typedef short bf16x4 __attribute__((ext_vector_type(4)));
__device__ __forceinline__ unsigned off_b(unsigned row, unsigned ch) { return 256u * row + 16u * (ch ^ (((row & 3) << 2) | ((row >> 2) & 3))); }
__device__ __forceinline__ bf16x8 img_row_frag(const LAS unsigned char* img, unsigned lane, unsigned rb, unsigned s) { return *(const LAS bf16x8*)(img + off_b((lane & 15) + 16 * rb, 4 * s + (lane >> 4))); }
__device__ __forceinline__ bf16x4 img_tr4(const LAS unsigned char* img, unsigned lane, unsigned c, unsigned row0) {
    const unsigned q = (lane & 15) >> 2, p = lane & 3;
    return __builtin_amdgcn_ds_read_tr16_b64_v4i16((LAS bf16x4*)(img + off_b(row0 + q, 2 * c + (p >> 1)) + 8 * (p & 1)));
}
__device__ __forceinline__ bf16x8 img_tr_frag(const LAS unsigned char* img, unsigned lane, unsigned c, unsigned ks) {
    const unsigned g = lane >> 4; const bf16x4 lo = img_tr4(img, lane, c, 32 * ks + 8 * g), hi = img_tr4(img, lane, c, 32 * ks + 8 * g + 4);
    return __builtin_shufflevector(lo, hi, 0, 1, 2, 3, 4, 5, 6, 7);
}
__device__ __forceinline__ bf16x8 img_tr_frag_acc(const LAS unsigned char* img, unsigned lane, unsigned c, unsigned ks) {
    const unsigned g = lane >> 4; const bf16x4 lo = img_tr4(img, lane, c, 32 * ks + 4 * g), hi = img_tr4(img, lane, c, 32 * ks + 16 + 4 * g);
    return __builtin_shufflevector(lo, hi, 0, 1, 2, 3, 4, 5, 6, 7);
}
__device__ __forceinline__ bf16x8 acc_pair_frag(const f32x4 a0, const f32x4 a1) {
    u32x4 w; w.x = pk2(a0.x, a0.y); w.y = pk2(a0.z, a0.w); w.z = pk2(a1.x, a1.y); w.w = pk2(a1.z, a1.w);
    return __builtin_bit_cast(bf16x8, w);
}
#define MFMA16(A_, B_, C_) __builtin_amdgcn_mfma_f32_16x16x32_bf16((A_), (B_), (C_), 0, 0, 0)
__device__ __forceinline__ void stage_tile128(LAS unsigned char* img, const bf16_t* g, size_t ld, int tid) {
#pragma unroll
    for (int i = 0; i < 4; ++i) { const int n = tid + NT * i, row = n >> 4, ch = n & 15; *(LAS u32x4*)(img + off_b(row, ch)) = *(const u32x4*)(g + (size_t)row * ld + ch * 8); }
}

constexpr int RCH = 128, RNCH = 34;
constexpr size_t WS_RST = WS_OB;
__device__ __forceinline__ int ret_rowbase(int b, int cc) { return cc < 2 ? NLAT + b * LC + cc * RCH : b * SEQL + (cc - 2) * RCH; }
__device__ __forceinline__ float ret_log2g(int h) { return log2f(1.0f - exp2f(-5.0f - (float)h)); }

__device__ __forceinline__ void ret_passA(unsigned char* ws, LAS unsigned char* lds, int item, int tid) {
    const int bh = item / RNCH, cc = item % RNCH, b = bh >> 2, h = bh & 3;
    const int lane = tid & 63, w = tid >> 6, g = lane >> 4;
    LAS unsigned char* KF = lds; LAS unsigned char* KB = lds + 32768; LAS unsigned char* VI = lds + 65536;
    const bf16_t* P = (const bf16_t*)(ws + WS_P) + (size_t)ret_rowbase(b, cc) * LDP;
    const float l2g = ret_log2g(h);
    __syncthreads();
#pragma unroll
    for (int i = 0; i < 4; ++i) { const int n = tid + NT * i, row = n >> 4, ch = n & 15;
        const u32x4 kr = *(const u32x4*)(P + (size_t)row * LDP + PC_RK + h * 128 + ch * 8);
        float kf[8], a[8], c[8]; unpack8(kr, kf);
        const float sf = exp2f(l2g * (float)(RCH - 1 - row)), sb = exp2f(l2g * (float)row);
#pragma unroll
        for (int x = 0; x < 8; ++x) { a[x] = kf[x] * sf; c[x] = kf[x] * sb; }
        *(LAS u32x4*)(KF + off_b(row, ch)) = pack8(a); *(LAS u32x4*)(KB + off_b(row, ch)) = pack8(c);
        *(LAS u32x4*)(VI + off_b(row, ch)) = *(const u32x4*)(P + (size_t)row * LDP + PC_RV + h * 128 + ch * 8); }
    __syncthreads();
    bf16x8 af[4], ab[4];
#pragma unroll
    for (int ks = 0; ks < 4; ++ks) { af[ks] = img_tr_frag(KF, lane, w, ks); ab[ks] = img_tr_frag(KB, lane, w, ks); }
    bf16_t* ST = (bf16_t*)(ws + WS_RST) + ((size_t)(bh * 2) * RNCH + cc) * (128 * 128);
#pragma unroll 2
    for (int E = 0; E < 8; ++E) {
        f32x4 cf = {0.f, 0.f, 0.f, 0.f}, cb = {0.f, 0.f, 0.f, 0.f};
#pragma unroll
        for (int ks = 0; ks < 4; ++ks) { const bf16x8 vb = img_tr_frag(VI, lane, E, ks); cf = MFMA16(af[ks], vb, cf); cb = MFMA16(ab[ks], vb, cb); }
        const int e = 16 * E + (lane & 15), d0 = 16 * w + 4 * g;
        u32x2 o; o.x = pk2(cf.x, cf.y); o.y = pk2(cf.z, cf.w); *(u32x2*)(ST + (size_t)e * 128 + d0) = o;
        o.x = pk2(cb.x, cb.y); o.y = pk2(cb.z, cb.w); *(u32x2*)(ST + (size_t)RNCH * 128 * 128 + (size_t)e * 128 + d0) = o;
    }
}
__device__ __forceinline__ void ret_passB(unsigned char* ws, int gt  ) {
    const int el = gt & 2047, bd = gt >> 11, bh = bd >> 1, dir = bd & 1, h = bh & 3;
    const float gC = exp2f(ret_log2g(h) * (float)RCH);
    bf16_t* base = (bf16_t*)(ws + WS_RST) + (size_t)bd * RNCH * (128 * 128) + (size_t)el * 8;
    float acc[8];
#pragma unroll
    for (int x = 0; x < 8; ++x) acc[x] = 0.f;
#pragma unroll 1
    for (int s0 = 0; s0 < RNCH; s0 += 17) {
        u32x4 kvr[17];
#pragma unroll
        for (int j = 0; j < 17; ++j) { const int s = s0 + j; const int cc = dir == 0 ? s : (s < 2 ? 1 - s : 35 - s); kvr[j] = *(const u32x4*)(base + (size_t)cc * (128 * 128)); }
#pragma unroll
        for (int j = 0; j < 17; ++j) { const int s = s0 + j; const int cc = dir == 0 ? s : (s < 2 ? 1 - s : 35 - s);
            float kv[8]; unpack8(kvr[j], kv);
            *(u32x4*)(base + (size_t)cc * (128 * 128)) = pack8(acc);
#pragma unroll
            for (int x = 0; x < 8; ++x) acc[x] = gC * acc[x] + kv[x]; }
    }
}
__device__ __forceinline__ void ret_passC(const DArgs& a, unsigned char* ws, LAS unsigned char* lds, int l, int item, int tid) {
    const int bh = item / RNCH, cc = item % RNCH, b = bh >> 2, h = bh & 3;
    const int lane = tid & 63, w = tid >> 6, g = lane >> 4, il = lane & 15;
    LAS unsigned char* KI = lds; LAS unsigned char* VI = lds + 32768; LAS unsigned char* SF = lds + 65536; LAS unsigned char* SB = lds + 98304;
    const int rowbase = ret_rowbase(b, cc);
    const bf16_t* P = (const bf16_t*)(ws + WS_P) + (size_t)rowbase * LDP;
    const bf16_t* STf = (const bf16_t*)(ws + WS_RST) + ((size_t)(bh * 2) * RNCH + cc) * (128 * 128);
    const bf16_t* STb = STf + (size_t)RNCH * 128 * 128;
    __syncthreads();
    stage_tile128(KI, P + PC_RK + h * 128, LDP, tid); stage_tile128(VI, P + PC_RV + h * 128, LDP, tid);
    stage_tile128(SF, STf, 128, tid); stage_tile128(SB, STb, 128, tid);
    bf16x8 qf[4];
    { const bf16_t* qr = P + (size_t)(16 * w + il) * LDP + PC_RQ + h * 128 + 8 * g;
#pragma unroll
      for (int ks = 0; ks < 4; ++ks) qf[ks] = *(const bf16x8*)(qr + 32 * ks); }
    __syncthreads();
    const float l2g = ret_log2g(h);
    const int iloc = 16 * w + il;
    f32x4 o[8];
    { const float sf = exp2f(l2g * (float)(iloc + 1)), sb = exp2f(l2g * (float)(RCH - iloc));
#pragma unroll
      for (int E = 0; E < 8; ++E) { f32x4 rf = {0.f, 0.f, 0.f, 0.f}, rb = {0.f, 0.f, 0.f, 0.f};
#pragma unroll
          for (int ks = 0; ks < 4; ++ks) { rf = MFMA16(img_row_frag(SF, lane, E, ks), qf[ks], rf); rb = MFMA16(img_row_frag(SB, lane, E, ks), qf[ks], rb); }
          o[E] = rf * sf + rb * sb; } }
    f32x4 at[8];
#pragma unroll
    for (int T = 0; T < 8; ++T) { f32x4 c = {0.f, 0.f, 0.f, 0.f};
#pragma unroll
        for (int ks = 0; ks < 4; ++ks) c = MFMA16(img_row_frag(KI, lane, T, ks), qf[ks], c);
#pragma unroll
        for (int r = 0; r < 4; ++r) { const int j = 16 * T + 4 * g + r; const int dd = iloc > j ? iloc - j : j - iloc; c[r] *= (dd == 0 ? 2.0f : exp2f(l2g * (float)dd)); }
        at[T] = c; }
#pragma unroll
    for (int s = 0; s < 4; ++s) { const bf16x8 bfr = acc_pair_frag(at[2 * s], at[2 * s + 1]);
#pragma unroll
        for (int E = 0; E < 8; ++E) o[E] = MFMA16(img_tr_frag_acc(VI, lane, E, s), bfr, o[E]); }
    float ss = 0.f;
#pragma unroll
    for (int E = 0; E < 8; ++E) ss += (o[E].x * o[E].x + o[E].y * o[E].y) + (o[E].z * o[E].z + o[E].w * o[E].w);
    ss += __shfl_xor(ss, 16); ss += __shfl_xor(ss, 32);
    const float rn = rsqrtf(ss * (1.0f / 128.0f) + EPS);
    const size_t row = (size_t)rowbase + iloc;
    const bf16_t* gp = (const bf16_t*)(ws + WS_P) + row * LDP + PC_RG + h * 128 + 4 * g;
    const float* nw = a.in[I_RNW] + l * 512 + h * 128 + 4 * g;
    bf16_t* op = (bf16_t*)(ws + WS_H) + row * D + 1024 + h * 128 + 4 * g;
#pragma unroll
    for (int E = 0; E < 8; ++E) { const u32x2 gr = *(const u32x2*)(gp + 16 * E); const f32x4 nv = *(const f32x4*)(nw + 16 * E);
        u32x2 ov; ov.x = pk2(o[E].x * rn * nv.x * siluf_(bflo(gr.x)), o[E].y * rn * nv.y * siluf_(bfhi(gr.x)));
        ov.y = pk2(o[E].z * rn * nv.z * siluf_(bflo(gr.y)), o[E].w * rn * nv.w * siluf_(bfhi(gr.y)));
        *(u32x2*)(op + 16 * E) = ov; }
}
constexpr int GCH = 64, GNCH = 68;
constexpr size_t WS_GST = WS_OB + (size_t)2 * OBSZ * 2;
constexpr size_t WS_GDEC = WS_END;
constexpr size_t WS_H3B = WS_GDEC + (size_t)16 * 2 * GNCH * 64 * 4;
constexpr size_t WS_ROPE = WS_H3B + (size_t)2 * 4096 * 64 * 2;
constexpr size_t WS_END2 = WS_ROPE + (size_t)(SEQL + LC) * 64 * 8;
__device__ __forceinline__ int gla_rowbase(int b, int cg) { return cg < 4 ? NLAT + b * LC + cg * GCH : b * SEQL + (cg - 4) * GCH; }

constexpr int GLS = 68;
__device__ __forceinline__ void gla_gates_compute(const DArgs& a, unsigned char* ws, LAS float* BF, LAS float* BB, LAS float* GW  , int l, int h, int rowbase, int tid) {
    const int t = tid >> 3, d8 = tid & 7;
    const float* lr = (const float*)(ws + WS_LR) + (size_t)(rowbase + t) * 32;
    f32x4 lv[8];
#pragma unroll
    for (int q = 0; q < 8; ++q) lv[q] = ((const f32x4*)lr)[q];
    { const int dir = tid >> 8, r = (tid >> 4) & 15, c4 = (tid & 15) * 4;
      *(LAS f32x4*)(GW + (dir * 17 + r) * 64 + c4) = *(const f32x4*)(a.in[I_GGW] + (size_t)(l * 2 + dir) * 16 * 256 + r * 256 + h * 64 + c4);
      if (tid < 32) { const int dd = tid >> 4; *(LAS f32x4*)(GW + (dd * 17 + 16) * 64 + c4) = *(const f32x4*)(a.in[I_GGB] + (size_t)(l * 2 + dd) * 256 + h * 64 + c4); } }
    __syncthreads();
    bf16_t* GLG = (bf16_t*)(ws + WS_WIN);
#pragma unroll
    for (int dir = 0; dir < 2; ++dir) {
        const LAS float* gw = GW + dir * 17 * 64 + 8 * d8;
        f32x4 s0 = *(const LAS f32x4*)(gw + 16 * 64), s1 = *(const LAS f32x4*)(gw + 16 * 64 + 4);
#pragma unroll
        for (int j = 0; j < 16; ++j) { const float lj = lv[dir * 4 + (j >> 2)][j & 3]; s0 += lj * *(const LAS f32x4*)(gw + j * 64); s1 += lj * *(const LAS f32x4*)(gw + j * 64 + 4); }
        LAS float* dst = (dir ? BB : BF) + t * GLS + 8 * d8;
        float la[8];
#pragma unroll
        for (int x = 0; x < 8; ++x) { const float s = x < 4 ? s0[x] : s1[x - 4]; const float e = __expf(-fabsf(s)); const float ls = fminf(s, 0.f) - __logf(1.0f + e); la[x] = ls * (1.0f / 16.0f); }
        const u32x4 pk = pack8(la);
        *(u32x4*)(GLG + ((size_t)dir * MR + rowbase + t) * 256 + h * 64 + 8 * d8) = pk;
        float lq[8]; unpack8(pk, lq);
        *(LAS f32x4*)dst = (f32x4){lq[0], lq[1], lq[2], lq[3]}; *(LAS f32x4*)(dst + 4) = (f32x4){lq[4], lq[5], lq[6], lq[7]};
    }
}
__device__ __forceinline__ void gla_gates_load(unsigned char* ws, LAS float* BF, LAS float* BB, int h, int rowbase, int tid) {
    const int t = tid >> 3, d8 = tid & 7;
    const bf16_t* GLG = (const bf16_t*)(ws + WS_WIN);
#pragma unroll
    for (int dir = 0; dir < 2; ++dir) { float lq[8]; unpack8(*(const u32x4*)(GLG + ((size_t)dir * MR + rowbase + t) * 256 + h * 64 + 8 * d8), lq);
        LAS float* dst = (dir ? BB : BF) + t * GLS + 8 * d8;
        *(LAS f32x4*)dst = (f32x4){lq[0], lq[1], lq[2], lq[3]}; *(LAS f32x4*)(dst + 4) = (f32x4){lq[4], lq[5], lq[6], lq[7]}; }
}
__device__ __forceinline__ void gla_scan(LAS float* BF, LAS float* BB, int tid) {
    const int lane = tid & 63, w = tid >> 6;
    __syncthreads();
#pragma unroll 4
    for (int c = 0; c < 16; ++c) { const int col = 16 * w + c; const int dir = col >> 6, d = col & 63;
        LAS float* p = (dir ? BB : BF) + (dir ? 63 - lane : lane) * GLS + d;
        float v = *p;
#pragma unroll
        for (int off = 1; off < 64; off <<= 1) { const float u = __shfl_up(v, off); if (lane >= off) v += u; }
        *p = v; }
    __syncthreads();
}

__device__ __forceinline__ void gla_passA(const DArgs& a, unsigned char* ws, LAS unsigned char* lds, int l, int item, int tid) {
    const int bh = item / GNCH, cg = item % GNCH, b = bh >> 2, h = bh & 3;
    const int lane = tid & 63, w = tid >> 6, g = lane >> 4;
    LAS float* BF = (LAS float*)lds; LAS float* BB = (LAS float*)(lds + 17408); LAS unsigned char* KH = lds + 34816; LAS unsigned char* VI = lds + 34816 + 16384;
    const int rowbase = gla_rowbase(b, cg);
    const bf16_t* P = (const bf16_t*)(ws + WS_P) + (size_t)rowbase * LDP;
    const int t = tid >> 3, d8 = tid & 7;
    const u32x4 kraw = *(const u32x4*)(P + (size_t)t * LDP + PC_GK + h * 64 + 8 * d8);
    u32x4 vraw[2];
#pragma unroll
    for (int i = 0; i < 2; ++i) { const int n = tid + NT * i; vraw[i] = *(const u32x4*)(P + (size_t)(n >> 4) * LDP + PC_GV + h * 128 + (n & 15) * 8); }
    gla_gates_compute(a, ws, BF, BB, (LAS float*)(lds + 34816 + 32768), l, h, rowbase, tid);
    gla_scan(BF, BB, tid);
    { float kf[8], x0[8], x1[8]; unpack8(kraw, kf);
#pragma unroll
      for (int x = 0; x < 8; ++x) { const int d = 8 * d8 + x; x0[x] = kf[x] * __expf(BF[63 * GLS + d] - BF[t * GLS + d]); x1[x] = kf[x] * __expf(BB[d] - BB[t * GLS + d]); }
      *(LAS u32x4*)(KH + off_b(t, d8)) = pack8(x0); *(LAS u32x4*)(KH + off_b(t, 8 + d8)) = pack8(x1);
#pragma unroll
      for (int i = 0; i < 2; ++i) { const int n = tid + NT * i; *(LAS u32x4*)(VI + off_b(n >> 4, n & 15)) = vraw[i]; }
      if (tid < 128) { const int dir = tid >> 6, d = tid & 63; ((float*)(ws + WS_GDEC))[((size_t)(bh * 2 + dir) * GNCH + cg) * 64 + d] = __expf(dir ? BB[d] : BF[63 * GLS + d]); } }
    __syncthreads();
    const int dir = w >> 2, Dt = w & 3;
    bf16x8 af[2];
#pragma unroll
    for (int ks = 0; ks < 2; ++ks) af[ks] = img_tr_frag(KH, lane, dir * 4 + Dt, ks);
    bf16_t* ST = (bf16_t*)(ws + WS_GST) + ((size_t)(bh * 2 + dir) * GNCH + cg) * (128 * 64);
#pragma unroll 2
    for (int E = 0; E < 8; ++E) {
        f32x4 c = {0.f, 0.f, 0.f, 0.f};
#pragma unroll
        for (int ks = 0; ks < 2; ++ks) c = MFMA16(af[ks], img_tr_frag(VI, lane, E, ks), c);
        u32x2 o; o.x = pk2(c.x, c.y); o.y = pk2(c.z, c.w);
        *(u32x2*)(ST + (size_t)(16 * E + (lane & 15)) * 64 + 16 * Dt + 4 * g) = o;
    }
}
__device__ __forceinline__ void gla_passB(unsigned char* ws, LAS unsigned char* lds, int blk, int tid) {
    const int bd = blk >> 1, dir = bd & 1, el = (blk & 1) * 512 + tid;
    LAS float* decs = (LAS float*)lds;
    { const float* dsrc = (const float*)(ws + WS_GDEC) + (size_t)bd * GNCH * 64;
      for (int i = tid; i < GNCH * 64; i += NT) decs[i] = dsrc[i]; }
    __syncthreads();
    bf16_t* base = (bf16_t*)(ws + WS_GST) + (size_t)bd * GNCH * (128 * 64) + (size_t)el * 8;
    const int d0 = (el & 7) * 8;
    float acc[8];
#pragma unroll
    for (int x = 0; x < 8; ++x) acc[x] = 0.f;
#pragma unroll 1
    for (int s0 = 0; s0 < GNCH; s0 += 17) {
        u32x4 kvr[17];
#pragma unroll
        for (int j = 0; j < 17; ++j) { const int s = s0 + j; const int cg = dir == 0 ? s : (s < 4 ? 3 - s : 71 - s); kvr[j] = *(const u32x4*)(base + (size_t)cg * (128 * 64)); }
#pragma unroll
        for (int j = 0; j < 17; ++j) { const int s = s0 + j; const int cg = dir == 0 ? s : (s < 4 ? 3 - s : 71 - s);
            float kv[8]; unpack8(kvr[j], kv);
            const f32x4 q0 = *(const LAS f32x4*)(decs + cg * 64 + d0), q1 = *(const LAS f32x4*)(decs + cg * 64 + d0 + 4);
            *(u32x4*)(base + (size_t)cg * (128 * 64)) = pack8(acc);
#pragma unroll
            for (int x = 0; x < 8; ++x) acc[x] = (x < 4 ? q0[x] : q1[x - 4]) * acc[x] + kv[x]; }
    }
    __syncthreads();
}
__device__ __forceinline__ void gla_passC(const DArgs& a, unsigned char* ws, LAS unsigned char* lds, int l, int item, int tid) {
    const int bh = item / GNCH, cg = item % GNCH, b = bh >> 2, h = bh & 3;
    const int lane = tid & 63, w = tid >> 6, g = lane >> 4, il = lane & 15;
    LAS float* BF = (LAS float*)lds; LAS float* BB = (LAS float*)(lds + 17408);
    LAS unsigned char* QKF = lds + 34816; LAS unsigned char* QKB = QKF + 16384; LAS unsigned char* QH = QKB + 16384; LAS unsigned char* VI = QH + 16384; LAS unsigned char* SI = VI + 16384;
    const int rowbase = gla_rowbase(b, cg);
    const bf16_t* P = (const bf16_t*)(ws + WS_P) + (size_t)rowbase * LDP;
    const int t = tid >> 3, d8 = tid & 7;
    const u32x4 qraw = *(const u32x4*)(P + (size_t)t * LDP + PC_GQ + h * 64 + 8 * d8), kraw = *(const u32x4*)(P + (size_t)t * LDP + PC_GK + h * 64 + 8 * d8);
    u32x4 vraw[2], sraw[4];
#pragma unroll
    for (int i = 0; i < 2; ++i) { const int n = tid + NT * i; vraw[i] = *(const u32x4*)(P + (size_t)(n >> 4) * LDP + PC_GV + h * 128 + (n & 15) * 8); }
    { const bf16_t* STf = (const bf16_t*)(ws + WS_GST) + ((size_t)(bh * 2) * GNCH + cg) * (128 * 64); const bf16_t* STb = STf + (size_t)GNCH * 128 * 64;
#pragma unroll
      for (int i = 0; i < 4; ++i) { const int n = tid + NT * i, row = n >> 4, ch = n & 15; sraw[i] = *(const u32x4*)((ch < 8 ? STf : STb) + (size_t)row * 64 + (ch & 7) * 8); } }
    gla_gates_load(ws, BF, BB, h, rowbase, tid);
    gla_scan(BF, BB, tid);
    { float qf[8], kf[8], o0[8], o1[8], o2[8], o3[8], o4[8], o5[8];
      unpack8(qraw, qf); unpack8(kraw, kf);
#pragma unroll
      for (int x = 0; x < 8; ++x) { const int d = 8 * d8 + x; const float bf = BF[t * GLS + d], bb = BB[t * GLS + d], rf = BF[31 * GLS + d], rb = BB[32 * GLS + d]; const float q = qf[x] * 0.125f;
          o0[x] = q * __expf(bf - rf); o1[x] = kf[x] * __expf(rf - bf); o2[x] = q * __expf(bb - rb); o3[x] = kf[x] * __expf(rb - bb); o4[x] = q * __expf(bf); o5[x] = q * __expf(bb); }
      *(LAS u32x4*)(QKF + off_b(t, d8)) = pack8(o0); *(LAS u32x4*)(QKF + off_b(t, 8 + d8)) = pack8(o1);
      *(LAS u32x4*)(QKB + off_b(t, d8)) = pack8(o2); *(LAS u32x4*)(QKB + off_b(t, 8 + d8)) = pack8(o3);
      *(LAS u32x4*)(QH + off_b(t, d8)) = pack8(o4); *(LAS u32x4*)(QH + off_b(t, 8 + d8)) = pack8(o5);
#pragma unroll
      for (int i = 0; i < 2; ++i) { const int n = tid + NT * i; *(LAS u32x4*)(VI + off_b(n >> 4, n & 15)) = vraw[i]; }
#pragma unroll
      for (int i = 0; i < 4; ++i) { const int n = tid + NT * i; *(LAS u32x4*)(SI + off_b(n >> 4, n & 15)) = sraw[i]; } }
    __syncthreads();
    const int ib = w & 3, eh = w >> 2, iloc = 16 * ib + il;
    f32x4 at[4];
    { bf16x8 qff[2], qfb[2];
#pragma unroll
      for (int ks = 0; ks < 2; ++ks) { qff[ks] = img_row_frag(QKF, lane, ib, ks); qfb[ks] = img_row_frag(QKB, lane, ib, ks); }
#pragma unroll
      for (int T = 0; T < 4; ++T) { f32x4 cf = {0.f, 0.f, 0.f, 0.f}, cb = {0.f, 0.f, 0.f, 0.f};
#pragma unroll
          for (int ks = 0; ks < 2; ++ks) { cf = MFMA16(img_row_frag(QKF, lane, T, 2 + ks), qff[ks], cf); cb = MFMA16(img_row_frag(QKB, lane, T, 2 + ks), qfb[ks], cb); }
#pragma unroll
          for (int r = 0; r < 4; ++r) { const int j = 16 * T + 4 * g + r; cf[r] = (j <= iloc ? cf[r] : 0.f) + (j >= iloc ? cb[r] : 0.f); }
          at[T] = cf; } }
    f32x4 o[4];
    { bf16x8 hf[2], hb[2];
#pragma unroll
      for (int ks = 0; ks < 2; ++ks) { hf[ks] = img_row_frag(QH, lane, ib, ks); hb[ks] = img_row_frag(QH, lane, ib, 2 + ks); }
#pragma unroll
      for (int E4 = 0; E4 < 4; ++E4) { const int E = 4 * eh + E4; f32x4 c = {0.f, 0.f, 0.f, 0.f};
#pragma unroll
          for (int ks = 0; ks < 2; ++ks) { c = MFMA16(img_row_frag(SI, lane, E, ks), hf[ks], c); c = MFMA16(img_row_frag(SI, lane, E, 2 + ks), hb[ks], c); }
          o[E4] = c; } }
#pragma unroll
    for (int s = 0; s < 2; ++s) { const bf16x8 bfr = acc_pair_frag(at[2 * s], at[2 * s + 1]);
#pragma unroll
        for (int E4 = 0; E4 < 4; ++E4) o[E4] = MFMA16(img_tr_frag_acc(VI, lane, 4 * eh + E4, s), bfr, o[E4]); }
    float ss = 0.f;
#pragma unroll
    for (int E4 = 0; E4 < 4; ++E4) ss += (o[E4].x * o[E4].x + o[E4].y * o[E4].y) + (o[E4].z * o[E4].z + o[E4].w * o[E4].w);
    ss += __shfl_xor(ss, 16); ss += __shfl_xor(ss, 32);
    LAS float* red = (LAS float*)lds;
    if (g == 0) red[eh * 64 + iloc] = ss;
    __syncthreads();
    const float rn = rsqrtf((red[iloc] + red[64 + iloc]) * (1.0f / 128.0f) + EPS);
    const size_t row = (size_t)rowbase + iloc;
    const bf16_t* gp = (const bf16_t*)(ws + WS_P) + row * LDP + PC_GG + h * 128 + 64 * eh + 4 * g;
    const float* nw = a.in[I_GNW] + l * 512 + h * 128 + 64 * eh + 4 * g;
    bf16_t* op = (bf16_t*)(ws + WS_H) + row * D + 1536 + h * 128 + 64 * eh + 4 * g;
#pragma unroll
    for (int E4 = 0; E4 < 4; ++E4) { const u32x2 gr = *(const u32x2*)(gp + 16 * E4); const f32x4 nv = *(const f32x4*)(nw + 16 * E4);
        u32x2 ov; ov.x = pk2(o[E4].x * rn * nv.x * siluf_(bflo(gr.x)), o[E4].y * rn * nv.y * siluf_(bfhi(gr.x)));
        ov.y = pk2(o[E4].z * rn * nv.z * siluf_(bflo(gr.y)), o[E4].w * rn * nv.w * siluf_(bfhi(gr.y)));
        *(u32x2*)(op + 16 * E4) = ov; }
}
constexpr int SNCH = 68;
constexpr size_t WS_S5ST = WS_OB + (size_t)4 * OBSZ * 2;
constexpr size_t WS_S5BTB = WS_S5BT;
constexpr size_t WS_S5CPB = WS_S5BT + 524288;
constexpr size_t WS_S5A64 = WS_S5BT + 1048576;

__device__ __forceinline__ void prep_s5b(const DArgs& a, unsigned char* ws, int it, int tid) {
    const int idx = it * 512 + tid;
    const int gi = idx >> 6, p = idx & 63;
    const float a_re = a.in[I_S5ARE][idx], a_im = a.in[I_S5AIM][idx], ldt = a.in[I_S5LDT][gi];
    const float dt = expf(ldt), mag = expf(a_re * dt);
    float sn, cs; sincosf(a_im * dt, &sn, &cs);
    const float ab_re = mag * cs, ab_im = mag * sn, den = a_re * a_re + a_im * a_im, nr = ab_re - 1.0f;
    const float co_re = (nr * a_re + ab_im * a_im) / den, co_im = (ab_im * a_re - nr * a_im) / den;
    ((f32x2*)(ws + WS_S5AB))[idx] = (f32x2){ab_re, ab_im};
    float pr = ab_re, pi = ab_im;
#pragma unroll
    for (int q = 0; q < 6; ++q) { const float nr2 = pr * pr - pi * pi, ni2 = 2.0f * pr * pi; pr = nr2; pi = ni2; }
    ((f32x2*)(ws + WS_S5A64))[idx] = (f32x2){pr, pi};
    const float* bre = a.in[I_S5BRE] + (size_t)idx * 16; const float* bim = a.in[I_S5BIM] + (size_t)idx * 16;
    float tr[16], ti[16];
#pragma unroll
    for (int i = 0; i < 16; ++i) { const float br = bre[i], bi = bim[i]; tr[i] = co_re * br - co_im * bi; ti[i] = co_re * bi + co_im * br; }
    bf16_t* btb = (bf16_t*)(ws + WS_S5BTB) + (size_t)gi * 128 * 16;
#pragma unroll
    for (int hlf = 0; hlf < 2; ++hlf) { u32x4 w0, w1; const float* s = hlf ? ti : tr;
        w0.x = pk2(s[0], s[1]); w0.y = pk2(s[2], s[3]); w0.z = pk2(s[4], s[5]); w0.w = pk2(s[6], s[7]); w1.x = pk2(s[8], s[9]); w1.y = pk2(s[10], s[11]); w1.z = pk2(s[12], s[13]); w1.w = pk2(s[14], s[15]);
        *(u32x4*)(btb + (size_t)(64 * hlf + p) * 16) = w0; *(u32x4*)(btb + (size_t)(64 * hlf + p) * 16 + 8) = w1; }
    bf16_t* cpb = (bf16_t*)(ws + WS_S5CPB) + (size_t)gi * 16 * 128;
    const float* cre = a.in[I_S5CRE] + (size_t)gi * 1024; const float* cim = a.in[I_S5CIM] + (size_t)gi * 1024;
#pragma unroll
    for (int i = 0; i < 16; ++i) *(unsigned*)(cpb + i * 128 + 2 * p) = pk2(cre[i * 64 + p], -cim[i * 64 + p]);
}

struct S5Unit { bf16x8 btf[8]; f32x2 ab; f32x2 h; const bf16_t* cp; };
template <bool PASSC> __device__ __forceinline__ void s5_load_unit(S5Unit& U, unsigned char* ws, const bf16_t* P, const f32x2* ST, int l, int b, int cs, int rowbase, int grp, int dir, int lane) {
    const int g = lane >> 4, il = lane & 15;
    const bf16x8 zero8 = {0, 0, 0, 0, 0, 0, 0, 0};
    const int gi = (l * 2 + dir) * 32 + grp;
    U.ab = ((const f32x2*)(ws + WS_S5AB))[gi * 64 + lane];
    const size_t sidx = ((size_t)(b * SNCH + cs) * 2 + dir) * 2048 + grp * 64 + lane;
    U.h = PASSC ? ST[sidx] : (f32x2){0.f, 0.f};
    const bf16_t* bt = (const bf16_t*)(ws + WS_S5BTB) + (size_t)gi * 128 * 16 + (size_t)il * 16 + 8 * (g & 1);
#pragma unroll
    for (int Pt = 0; Pt < 8; ++Pt) { const bf16x8 v = *(const bf16x8*)(bt + Pt * 256); U.btf[Pt] = g < 2 ? v : zero8; }
    U.cp = (const bf16_t*)(ws + WS_S5CPB) + (size_t)gi * 16 * 128 + (size_t)il * 128 + 8 * g;
}
__device__ __forceinline__ void s5_load_u(bf16x8 (&ufa)[4], const bf16_t* P, int rowbase, int grp, int lane) {
    const int g = lane >> 4, il = lane & 15; const bf16x8 zero8 = {0, 0, 0, 0, 0, 0, 0, 0};
#pragma unroll
    for (int Tt = 0; Tt < 4; ++Tt) { const bf16x8 v = *(const bf16x8*)(P + (size_t)(rowbase + 16 * Tt + il) * LDP + PC_S5U + grp * 16 + 8 * (g & 1)); ufa[Tt] = g < 2 ? v : zero8; }
}
template <bool PASSC, int DIR> __device__ __forceinline__ void s5_run_unit(const S5Unit& U, const bf16x8 (&ufa)[4], f32x4 (&yacc)[4], f32x2& hout, LAS float* BU, LAS unsigned char* HW, int lane) {
    const int g = lane >> 4, il = lane & 15;
    f32x2 h = U.h; const f32x2 ab = U.ab;
    bf16x8 cpf[4];
    if (PASSC) {
#pragma unroll
        for (int ks = 0; ks < 4; ++ks) cpf[ks] = *(const bf16x8*)(U.cp + 32 * ks); }
    f32x4 d[8];
#pragma unroll
    for (int Pt = 0; Pt < 8; ++Pt) d[Pt] = MFMA16(U.btf[Pt], ufa[DIR ? 3 : 0], ((f32x4){0.f, 0.f, 0.f, 0.f}));
#pragma unroll
    for (int wi = 0; wi < 4; ++wi) {
        const int Tt = DIR ? 3 - wi : wi;
#pragma unroll
        for (int Pt = 0; Pt < 8; ++Pt) {
#pragma unroll
            for (int r = 0; r < 4; ++r) BU[(16 * Pt + 4 * g + r) * 20 + il] = d[Pt][r]; }
        asm volatile("" ::: "memory");
        if (!PASSC) {
            f32x4 br[4], bi[4];
#pragma unroll
            for (int q = 0; q < 4; ++q) { br[q] = *(const LAS f32x4*)(BU + lane * 20 + 4 * q); bi[q] = *(const LAS f32x4*)(BU + (64 + lane) * 20 + 4 * q); }
            if (wi < 3) {
#pragma unroll
                for (int Pt = 0; Pt < 8; ++Pt) d[Pt] = MFMA16(U.btf[Pt], ufa[DIR ? 2 - wi : wi + 1], ((f32x4){0.f, 0.f, 0.f, 0.f})); }
#pragma unroll
            for (int s = 0; s < 16; ++s) { const int tt = DIR ? 15 - s : s;
                const float hr = ab.x * h.x - ab.y * h.y + br[tt >> 2][tt & 3], hi = ab.x * h.y + ab.y * h.x + bi[tt >> 2][tt & 3];
                h = (f32x2){hr, hi}; }
        } else {
#pragma unroll
            for (int hf2 = 0; hf2 < 2; ++hf2) { const int q0 = DIR ? 2 - 2 * hf2 : 2 * hf2;
                f32x4 br[2], bi[2];
#pragma unroll
                for (int q = 0; q < 2; ++q) { br[q] = *(const LAS f32x4*)(BU + lane * 20 + 4 * (q0 + q)); bi[q] = *(const LAS f32x4*)(BU + (64 + lane) * 20 + 4 * (q0 + q)); }
#pragma unroll
                for (int s = 0; s < 8; ++s) { const int t8 = DIR ? 7 - s : s; const int tt = 4 * q0 + t8;
                    const float hr = ab.x * h.x - ab.y * h.y + br[t8 >> 2][t8 & 3], hi = ab.x * h.y + ab.y * h.x + bi[t8 >> 2][t8 & 3];
                    h = (f32x2){hr, hi};
                    *(LAS unsigned*)(HW + off_b(tt, lane >> 2) + (lane & 3) * 4) = pk2(hr, hi); }
            }
        }
        asm volatile("" ::: "memory");
        if (PASSC) {
            bf16x8 hf[4];
#pragma unroll
            for (int ks = 0; ks < 4; ++ks) hf[ks] = img_row_frag(HW, lane, 0, ks);
#pragma unroll
            for (int ks = 0; ks < 4; ++ks) yacc[Tt] = MFMA16(cpf[ks], hf[ks], yacc[Tt]); }
        asm volatile("" ::: "memory");
        if (PASSC && wi < 3) {
#pragma unroll
            for (int Pt = 0; Pt < 8; ++Pt) d[Pt] = MFMA16(U.btf[Pt], ufa[DIR ? 2 - wi : wi + 1], ((f32x4){0.f, 0.f, 0.f, 0.f})); }
    }
    hout = h;
}
template <bool PASSC> __device__ __forceinline__ void s5_item(const DArgs& a, unsigned char* ws, LAS unsigned char* lds, int l, int item, int tid) {
    const int b = item / (SNCH * 2), rem = item % (SNCH * 2), cs = rem >> 1, half = rem & 1;
    const int lane = tid & 63, w = tid >> 6, g = lane >> 4, il = lane & 15;
    const int rowbase = gla_rowbase(b, cs);
    LAS float* BU = (LAS float*)(lds + w * 14336); LAS unsigned char* HW = lds + w * 14336 + 10240;
    const bf16_t* P = (const bf16_t*)(ws + WS_P);
    f32x2* ST = (f32x2*)(ws + WS_S5ST);
    const int grp0 = 16 * half + w, grp1 = grp0 + 8;
    S5Unit UA; bf16x8 ufa[4];
#pragma unroll 1
    for (int gg = 0; gg < 2; ++gg) {
        const int grp = gg ? grp1 : grp0;
        f32x4 yacc[4];
#pragma unroll
        for (int q = 0; q < 4; ++q) yacc[q] = (f32x4){0.f, 0.f, 0.f, 0.f};
        f32x2 hend;
        s5_load_unit<PASSC>(UA, ws, P, ST, l, b, cs, rowbase, grp, 0, lane); s5_load_u(ufa, P, rowbase, grp, lane);
        s5_run_unit<PASSC, 0>(UA, ufa, yacc, hend, BU, HW, lane);
        if (!PASSC) ST[((size_t)(b * SNCH + cs) * 2 + 0) * 2048 + grp * 64 + lane] = hend;
        s5_load_unit<PASSC>(UA, ws, P, ST, l, b, cs, rowbase, grp, 1, lane);
        s5_run_unit<PASSC, 1>(UA, ufa, yacc, hend, BU, HW, lane);
        if (!PASSC) ST[((size_t)(b * SNCH + cs) * 2 + 1) * 2048 + grp * 64 + lane] = hend;
        if (PASSC) {
            const f32x4 dsk = *(const f32x4*)(a.in[I_S5D] + l * 512 + grp * 16 + 4 * g);
            bf16_t* G5 = (bf16_t*)(ws + WS_KF);
#pragma unroll
            for (int Tt = 0; Tt < 4; ++Tt) { const size_t row = (size_t)rowbase + 16 * Tt + il;
                const u32x2 ur = *(const u32x2*)(P + row * LDP + PC_S5U + grp * 16 + 4 * g), sg = *(const u32x2*)(P + row * LDP + PC_S5G + grp * 16 + 4 * g);
                const float g0 = gelu_tanh(yacc[Tt].x + bflo(ur.x) * dsk.x), g1 = gelu_tanh(yacc[Tt].y + bfhi(ur.x) * dsk.y), g2 = gelu_tanh(yacc[Tt].z + bflo(ur.y) * dsk.z), g3 = gelu_tanh(yacc[Tt].w + bfhi(ur.y) * dsk.w);
                u32x2 ov; ov.x = pk2(g0, g1); ov.y = pk2(g2, g3);
                *(u32x2*)(G5 + row * 512 + grp * 16 + 4 * g) = ov;
                ov.x = pk2(g0 * siluf_(bflo(sg.x)), g1 * siluf_(bfhi(sg.x))); ov.y = pk2(g2 * siluf_(bflo(sg.y)), g3 * siluf_(bfhi(sg.y)));
                *(u32x2*)(G5 + OBSZ + row * 512 + grp * 16 + 4 * g) = ov; }
        }
    }
}
__device__ __forceinline__ void s5_passB(unsigned char* ws, int l, int gt) {
    const int p = gt & 63, grp = (gt >> 6) & 31, dir = (gt >> 11) & 1, b = gt >> 12;
    const f32x2 a64 = ((const f32x2*)(ws + WS_S5A64))[((l * 2 + dir) * 32 + grp) * 64 + p];
    f32x2* ST = (f32x2*)(ws + WS_S5ST);
    f32x2 acc = {0.f, 0.f};
#pragma unroll 1
    for (int s0 = 0; s0 < SNCH; s0 += 34) {
        f32x2 ev[34];
#pragma unroll
        for (int j = 0; j < 34; ++j) { const int s = s0 + j; const int cs = dir == 0 ? s : (s < 4 ? 3 - s : 71 - s); ev[j] = ST[((size_t)(b * SNCH + cs) * 2 + dir) * 2048 + grp * 64 + p]; }
#pragma unroll
        for (int j = 0; j < 34; ++j) { const int s = s0 + j; const int cs = dir == 0 ? s : (s < 4 ? 3 - s : 71 - s);
            ST[((size_t)(b * SNCH + cs) * 2 + dir) * 2048 + grp * 64 + p] = acc;
            acc = (f32x2){a64.x * acc.x - a64.y * acc.y + ev[j].x, a64.x * acc.y + a64.y * acc.x + ev[j].y}; }
    }
}
constexpr int FFT_PHYS = 9216;
__device__ __forceinline__ int fphys(int i) { return i + (i >> 3); }
__device__ __forceinline__ f32x2 cmulf(const f32x2 a, const f32x2 b) { return (f32x2){a.x * b.x - a.y * b.y, a.x * b.y + a.y * b.x}; }
__device__ __forceinline__ f32x2 cmulcf(const f32x2 a, const f32x2 b) { return (f32x2){a.x * b.x + a.y * b.y, a.y * b.x - a.x * b.y}; }
template <int RL> __device__ __forceinline__ void dft_fwd_const(f32x2 (&e)[1 << RL]) {
#pragma unroll
    for (int s = 0; s < RL; ++s) { const int h = 1 << (RL - 1 - s);
#pragma unroll
        for (int m = 0; m < (1 << RL); ++m) { if (m & h) continue;
            const int mp = m & (h - 1); const f32x2 a_ = e[m], b_ = e[m | h]; const f32x2 d = a_ - b_; e[m] = a_ + b_;
            if (mp == 0) e[m | h] = d;
            else if (2 * mp == h) e[m | h] = (f32x2){d.y, -d.x};
            else { const float ang = -3.14159265358979323846f * (float)mp / (float)h; const f32x2 c = {__builtin_cosf(ang), __builtin_sinf(ang)}; e[m | h] = cmulf(d, c); } } }
}
template <int RL> __device__ __forceinline__ void dft_inv_const(f32x2 (&e)[1 << RL]) {
#pragma unroll
    for (int ss = 0; ss < RL; ++ss) { const int s = RL - 1 - ss; const int h = 1 << (RL - 1 - s);
#pragma unroll
        for (int m = 0; m < (1 << RL); ++m) { if (m & h) continue;
            const int mp = m & (h - 1); const f32x2 a_ = e[m], b_ = e[m | h]; f32x2 t;
            if (mp == 0) t = b_;
            else if (2 * mp == h) t = (f32x2){-b_.y, b_.x};
            else { const float ang = -3.14159265358979323846f * (float)mp / (float)h; const f32x2 c = {__builtin_cosf(ang), __builtin_sinf(ang)}; t = cmulcf(b_, c); }
            e[m] = a_ + t; e[m | h] = a_ - t; } }
}
template <int RL> __device__ __forceinline__ constexpr int brev_c(int m) { int r = 0; for (int i = 0; i < RL; ++i) r |= ((m >> i) & 1) << (RL - 1 - i); return r; }
template <int RL, bool CONJ> __device__ __forceinline__ void apply_tw(f32x2 (&e)[1 << RL], const f32x2 w1) {
    f32x2 tw[1 << RL];
    tw[0] = (f32x2){1.f, 0.f}; tw[1] = w1;
    if (RL >= 2) { tw[2] = cmulf(w1, w1); tw[3] = cmulf(tw[2], w1); }
    if (RL >= 3) { tw[4] = cmulf(tw[2], tw[2]); tw[5] = cmulf(tw[4], tw[1]); tw[6] = cmulf(tw[4], tw[2]); tw[7] = cmulf(tw[4], tw[3]); }
    if (RL >= 4) { tw[8] = cmulf(tw[4], tw[4]);
#pragma unroll
        for (int k = 1; k < 8; ++k) tw[8 + k] = cmulf(tw[8], tw[k]); }
#pragma unroll
    for (int m = 1; m < (1 << RL); ++m) e[m] = CONJ ? cmulcf(e[m], tw[brev_c<RL>(m)]) : cmulf(e[m], tw[brev_c<RL>(m)]);
}
template <int RL, int BETA, bool INV> __device__ __forceinline__ void fft2_pass(LAS f32x2* X, const LAS f32x2* W, int tid) {
    constexpr int LOW = BETA - RL + 1, NG = FFTN >> RL, STR = (1 << LOW) + (1 << (LOW - 3));
#pragma unroll 1
    for (int gi = tid; gi < NG; gi += NT) {
        const int base = ((gi >> LOW) << (BETA + 1)) | (gi & ((1 << LOW) - 1));
        volatile LAS f32x2* p = X + fphys(base);
        f32x2 e[1 << RL];
#pragma unroll
        for (int m = 0; m < (1 << RL); ++m) e[m] = p[m * STR];
        const f32x2 w1 = W[(base & ((1 << LOW) - 1)) << (12 - BETA)];
        if (!INV) { dft_fwd_const<RL>(e); apply_tw<RL, false>(e, w1); }
        else { apply_tw<RL, true>(e, w1); dft_inv_const<RL>(e); }
#pragma unroll
        for (int m = 0; m < (1 << RL); ++m) p[m * STR] = e[m];
    }
}
__device__ __forceinline__ void fft2_fwd_ABC(LAS f32x2* X, const LAS f32x2* W, int tid) {
    fft2_pass<4, 12, false>(X, W, tid); __syncthreads(); fft2_pass<3, 8, false>(X, W, tid); __syncthreads(); fft2_pass<3, 5, false>(X, W, tid); __syncthreads();
}
__device__ __forceinline__ void fft2_inv_CBA(LAS f32x2* X, const LAS f32x2* W, int tid) {
    fft2_pass<3, 5, true>(X, W, tid); __syncthreads(); fft2_pass<3, 8, true>(X, W, tid); __syncthreads(); fft2_pass<4, 12, true>(X, W, tid); __syncthreads();
}
__device__ __forceinline__ void fft2_mid_mul(LAS f32x2* X, const f32x2* KF, int tid) {
#pragma unroll 1
    for (int gi = tid; gi < 1024; gi += NT) {
        volatile LAS f32x2* p = X + 9 * gi;
        f32x2 e[8]; f32x4 kf[4];
#pragma unroll
        for (int q = 0; q < 4; ++q) kf[q] = *(const f32x4*)(KF + 8 * gi + 2 * q);
#pragma unroll
        for (int m = 0; m < 8; ++m) e[m] = p[m];
        dft_fwd_const<3>(e);
#pragma unroll
        for (int q = 0; q < 4; ++q) { e[2 * q] = cmulf(e[2 * q], (f32x2){kf[q].x, kf[q].y}); e[2 * q + 1] = cmulf(e[2 * q + 1], (f32x2){kf[q].z, kf[q].w}); }
        dft_inv_const<3>(e);
#pragma unroll
        for (int m = 0; m < 8; ++m) p[m] = e[m];
    }
}
__device__ __forceinline__ void fft2_fwd_D(LAS f32x2* X, int tid) {
#pragma unroll 1
    for (int gi = tid; gi < 1024; gi += NT) { volatile LAS f32x2* p = X + 9 * gi; f32x2 e[8];
#pragma unroll
        for (int m = 0; m < 8; ++m) e[m] = p[m];
        dft_fwd_const<3>(e);
#pragma unroll
        for (int m = 0; m < 8; ++m) p[m] = e[m]; }
}

__device__ __forceinline__ void filt_item2(const DArgs& a, unsigned char* ws, LAS unsigned char* lds, int l, int c, int tid) {
    LAS f32x2* X = (LAS f32x2*)lds; LAS f32x2* W = (LAS f32x2*)(lds + FFT_PHYS * 8); LAS float* w4s = (LAS float*)(lds + FFT_PHYS * 8 + 32768); LAS float* red = w4s + 256;
    fft_twiddles(W, tid);
    if (tid < 128) { const int cc = tid >> 5, pr = tid & 31; const float* wsrc = a.in[I_HW4] + (size_t)l * 64 * 2048 + (cc >> 1) * 1024 + (cc & 1) * 512 + c;
        ((LAS unsigned*)w4s)[pr * 4 + cc] = pk2(wsrc[(size_t)(2 * pr) * 2048], wsrc[(size_t)(2 * pr + 1) * 2048]); }
    if (tid == 0) { float z0; asm volatile("v_mov_b32 %0, 0" : "=v"(z0)); X[fphys(4096)] = (f32x2){z0, z0}; }
    __syncthreads();
    const float dl = fabsf(HY_D0 + (HY_D1 - HY_D0) * ((float)c / 511.0f));
    const bf16_t* H3 = (const bf16_t*)(ws + WS_H3B) + (size_t)l * 4096 * 64;
    float ss0 = 0.f, ss1 = 0.f;
#pragma unroll 1
    for (int j = 0; j < 8; ++j) {
        const int t = tid + 512 * j;
        const u32x4* hr = (const u32x4*)(H3 + (size_t)t * 64);
        u32x4 hraw[8];
#pragma unroll
        for (int q = 0; q < 8; ++q) hraw[q] = hr[q];
        asm volatile("" ::: "memory");
        float f0 = 0.f, f1 = 0.f, b0 = 0.f, b1 = 0.f;
        typedef __bf16 bfp2 __attribute__((ext_vector_type(2)));
#pragma unroll
        for (int q = 0; q < 8; ++q) {
#pragma unroll
            for (int e = 0; e < 4; ++e) { const u32x4 wq = ((const LAS u32x4*)w4s)[4 * q + e]; const unsigned hx = hraw[q][e];
                f0 += bflo(hx) * bflo(wq.x) + bfhi(hx) * bfhi(wq.x); f1 += bflo(hx) * bflo(wq.y) + bfhi(hx) * bfhi(wq.y);
                b0 += bflo(hx) * bflo(wq.z) + bfhi(hx) * bfhi(wq.z); b1 += bflo(hx) * bflo(wq.w) + bfhi(hx) * bfhi(wq.w); } }
        const float dec = expf(-((float)t / 4095.0f) * dl); f0 *= dec; f1 *= dec; b0 *= dec; b1 *= dec;
        X[fphys(t)] = (f32x2){f0, f1}; ss0 += f0 * f0; ss1 += f1 * f1;
        if (t > 0) { X[fphys(8192 - t)] = (f32x2){b0, b1}; ss0 += b0 * b0; ss1 += b1 * b1; }
    }
    const float rs0 = rsqrtf(block_sum(ss0, red, tid) + EPS), rs1 = rsqrtf(block_sum(ss1, red, tid) + EPS);
#pragma unroll 4
    for (int j = 0; j < 16; ++j) { const int n = fphys(tid + 512 * j); const f32x2 x = X[n]; X[n] = (f32x2){x.x * rs0, x.y * rs1}; }
    __syncthreads(); fft2_fwd_ABC(X, W, tid); fft2_fwd_D(X, tid); __syncthreads();
    f32x2* KF0 = (f32x2*)(ws + WS_KF) + (size_t)(0 * 512 + c) * FFTN; f32x2* KF1 = (f32x2*)(ws + WS_KF) + (size_t)(1 * 512 + c) * FFTN;
#pragma unroll 4
    for (int j = 0; j < 16; ++j) { const int pos = tid + 512 * j; const int k = (int)(__brev((unsigned)pos) >> 19); const int pp = (int)(__brev((unsigned)((8192 - k) & 8191)) >> 19);
        const f32x2 za = X[fphys(pos)], zb = X[fphys(pp)];
        KF0[pos] = (f32x2){0.5f * (za.x + zb.x), 0.5f * (za.y - zb.y)};
        KF1[pos] = (f32x2){0.5f * (za.y + zb.y), 0.5f * (zb.x - za.x)}; }
    __syncthreads();
}

struct Raw8 { u32x4 mid; bf16_t lf, rt; };
__device__ __forceinline__ Raw8 ld_raw8(const bf16_t* p, int t0, int Lx) { Raw8 r; r.mid = *(const u32x4*)(p + t0); r.lf = t0 > 0 ? p[t0 - 1] : (bf16_t)0; r.rt = t0 + 8 < Lx ? p[t0 + 8] : (bf16_t)0; return r; }
__device__ __forceinline__ void sconv8(const Raw8& r, float w0, float w1, float w2, float cb, float (&o)[8]) {
    float x[10]; x[0] = bf2f(r.lf); x[9] = bf2f(r.rt);
    x[1] = bflo(r.mid.x); x[2] = bfhi(r.mid.x); x[3] = bflo(r.mid.y); x[4] = bfhi(r.mid.y); x[5] = bflo(r.mid.z); x[6] = bfhi(r.mid.z); x[7] = bflo(r.mid.w); x[8] = bfhi(r.mid.w);
#pragma unroll
    for (int i = 0; i < 8; ++i) o[i] = w0 * x[i] + w1 * x[i + 1] + w2 * x[i + 2] + cb;
}
__device__ __forceinline__ void hyena_item2(const DArgs& a, unsigned char* ws, LAS unsigned char* lds, int l, int c, int tid) {
    LAS f32x2* X = (LAS f32x2*)lds; LAS f32x2* W = (LAS f32x2*)(lds + FFT_PHYS * 8);
    fft_twiddles(W, tid);
    const float* cw = a.in[I_HCW] + (size_t)l * 3 * 1536; const float* cbp = a.in[I_HCB] + (size_t)l * 1536;
    const float wv0 = cw[c], wv1 = cw[1536 + c], wv2 = cw[3072 + c], bv = cbp[c];
    const float wa0 = cw[512 + c], wa1 = cw[1536 + 512 + c], wa2 = cw[3072 + 512 + c], ba = cbp[512 + c];
    const float wb0 = cw[1024 + c], wb1 = cw[1536 + 1024 + c], wb2 = cw[3072 + 1024 + c], bb = cbp[1024 + c];
    const float bias0 = a.in[I_HBIAS][(l * 2 + 0) * 512 + c], bias1 = a.in[I_HBIAS][(l * 2 + 1) * 512 + c];
    const bf16_t* PT = (const bf16_t*)(ws + WS_PT);
    const bf16_t* pv = PT + (size_t)(PT_V + c) * MR; const bf16_t* pg1 = PT + (size_t)(PT_G1 + c) * MR; const bf16_t* pg2 = PT + (size_t)(PT_G2 + c) * MR; const bf16_t* phg = PT + (size_t)(PT_HG + c) * MR;
    const f32x2* KF0 = (const f32x2*)(ws + WS_KF) + (size_t)(0 * 512 + c) * FFTN; const f32x2* KF1 = (const f32x2*)(ws + WS_KF) + (size_t)(1 * 512 + c) * FFTN;
    bf16_t* GATED = (bf16_t*)(ws + WS_H);
    const int t0 = 8 * tid;
    LAS f32x2* px = X + 9 * tid;
    __syncthreads();
    for (int bp = 0; bp < 2; ++bp) {
        const int r0 = (2 * bp) * SEQL, r1 = (2 * bp + 1) * SEQL;
        const Raw8 v0 = ld_raw8(pv + r0, t0, SEQL), v1 = ld_raw8(pv + r1, t0, SEQL);
        const Raw8 g10 = ld_raw8(pg1 + r0, t0, SEQL), g11 = ld_raw8(pg1 + r1, t0, SEQL);
        float zr[8], zi[8];
        sconv8(v0, wv0, wv1, wv2, bv, zr); sconv8(v1, wv0, wv1, wv2, bv, zi);
#pragma unroll
        for (int x = 0; x < 8; ++x) { px[x] = (f32x2){zr[x], zi[x]}; px[4608 + x] = (f32x2){0.f, 0.f}; }
        __syncthreads(); fft2_fwd_ABC(X, W, tid); fft2_mid_mul(X, KF0, tid); __syncthreads(); fft2_inv_CBA(X, W, tid);
        { float gr[8], gi[8]; sconv8(g10, wa0, wa1, wa2, ba, gr); sconv8(g11, wa0, wa1, wa2, ba, gi);
#pragma unroll
          for (int x = 0; x < 8; ++x) { const f32x2 cv = px[x] * (1.0f / 8192.0f); zr[x] = gr[x] * (cv.x + bias0 * zr[x]); zi[x] = gi[x] * (cv.y + bias0 * zi[x]); } }
        __syncthreads();
        const Raw8 g20 = ld_raw8(pg2 + r0, t0, SEQL), g21 = ld_raw8(pg2 + r1, t0, SEQL);
        const u32x4 hgr0 = *(const u32x4*)(phg + r0 + t0), hgr1 = *(const u32x4*)(phg + r1 + t0);
#pragma unroll
        for (int x = 0; x < 8; ++x) { px[x] = (f32x2){zr[x], zi[x]}; px[4608 + x] = (f32x2){0.f, 0.f}; }
        __syncthreads(); fft2_fwd_ABC(X, W, tid); fft2_mid_mul(X, KF1, tid); __syncthreads(); fft2_inv_CBA(X, W, tid);
        { float gr[8], gi[8], h0[8], h1[8]; sconv8(g20, wb0, wb1, wb2, bb, gr); sconv8(g21, wb0, wb1, wb2, bb, gi); unpack8(hgr0, h0); unpack8(hgr1, h1);
#pragma unroll
          for (int x = 0; x < 8; ++x) { const f32x2 cv = px[x] * (1.0f / 8192.0f);
              const float z2r = gr[x] * (cv.x + bias1 * zr[x]), z2i = gi[x] * (cv.y + bias1 * zi[x]);
              gr[x] = z2r * siluf_(h0[x]); gi[x] = z2i * siluf_(h1[x]); }
          bf16_t* pvw = (bf16_t*)(ws + WS_PT) + (size_t)(PT_V + c) * MR;
          *(u32x4*)(pvw + r0 + t0) = pack8(gr); *(u32x4*)(pvw + r1 + t0) = pack8(gi); }
        __syncthreads();
    }
}

__device__ __forceinline__ void hy_transpose_item(unsigned char* ws, LAS unsigned char* lds, int item, int tid, int nrows) {
    const int lane = tid & 63, w = tid >> 6;
    const int wi = item * 8 + w;
    const int nrb = nrows / 64;
    if (wi >= nrb * 8) return;
    const int rb = wi >> 3, cb = wi & 7;
    LAS bf16_t* T = (LAS bf16_t*)(lds + w * 8704);
    const bf16_t* src = (const bf16_t*)(ws + WS_PT) + (size_t)(PT_V + cb * 64) * MR + (size_t)rb * 64;
    u32x4 tv[8];
#pragma unroll
    for (int i = 0; i < 8; ++i) { const int c = 8 * i + (lane >> 3), r8 = (lane & 7) * 8; tv[i] = *(const u32x4*)(src + (size_t)c * MR + r8); }
#pragma unroll
    for (int i = 0; i < 8; ++i) { const int c = 8 * i + (lane >> 3), r8 = (lane & 7) * 8;
        LAS unsigned* d = (LAS unsigned*)(T + c * 66 + r8); d[0] = tv[i].x; d[1] = tv[i].y; d[2] = tv[i].z; d[3] = tv[i].w; }
    asm volatile("s_waitcnt lgkmcnt(0)" ::: "memory");
    bf16_t* dst = (bf16_t*)(ws + WS_H) + (size_t)(rb * 64) * D + 512 + cb * 64;
#pragma unroll 4
    for (int i = 0; i < 8; ++i) { const int r = 8 * i + (lane >> 3), c8 = (lane & 7) * 8;
        unsigned short e[8];
#pragma unroll
        for (int x = 0; x < 8; ++x) e[x] = T[(c8 + x) * 66 + r];
        u32x4 o; o.x = e[0] | ((unsigned)e[1] << 16); o.y = e[2] | ((unsigned)e[3] << 16); o.z = e[4] | ((unsigned)e[5] << 16); o.w = e[6] | ((unsigned)e[7] << 16);
        *(u32x4*)(dst + (size_t)r * D + c8) = o; }
    asm volatile("s_waitcnt lgkmcnt(0)" ::: "memory");
}
#ifndef MK_EN
#define MK_EN 0xffff
#endif
#define EN(x) ((MK_EN >> (x)) & 1)
constexpr int PH_PREP = 0, PH_PER_LAYER = 7, PH_FNORM = 1 + 2 * PH_PER_LAYER, N_PHASES = PH_FNORM + 1;

__global__ void __launch_bounds__(NT, 2) fwd_kernel(Args ka) {
    extern __shared__ __attribute__((aligned(16))) unsigned char lds_raw[];
    LAS unsigned char* lds = (LAS unsigned char*)lds_raw;
    const int G = gridDim.x;
    volatile LAS unsigned* bst = (volatile LAS unsigned*)(lds + LDS_CTL_OFF);
    if (threadIdx.x < 16) bst[threadIdx.x] = 0u;
    if (threadIdx.x == 0) { LAS unsigned long long* tab = (LAS unsigned long long*)(lds + LDS_PTR_OFF);
#pragma unroll
        for (int i = 0; i < N_IN; ++i) tab[i] = (unsigned long long)ka.in[i]; }
    __syncthreads();

    XcdBarrier gbar; gbar.bar = (unsigned*)(ka.ws + WS_CTL); gbar.x = 0; gbar.st = bst;
    if (ka.ph_hi - ka.ph_lo > 1) gbar = xcd_barrier_post((unsigned*)(ka.ws + WS_CTL), bst);

#ifdef REP_SUB
    int repmask = 0;
#endif
    for (int ph = ka.ph_lo; ph < ka.ph_hi; ++ph) {
        int tid = threadIdx.x; asm volatile("" : "+v"(tid));
        int bid = blockIdx.x; asm volatile("" : "+s"(bid));
#define LANE_WAVE() int tid2_ = threadIdx.x; asm volatile("" : "+v"(tid2_)); const int lane = tid2_ & 63, wave = __builtin_amdgcn_readfirstlane(tid2_ >> 6)
        __attribute__((address_space(1))) unsigned char* wsg_ = (__attribute__((address_space(1))) unsigned char*)ka.ws; asm volatile("" : "+s"(wsg_)); unsigned char* ws = (unsigned char*)wsg_;
        __attribute__((address_space(1))) float* outg_ = (__attribute__((address_space(1))) float*)ka.out; asm volatile("" : "+s"(outg_)); float* outp_ = (float*)outg_;
        DArgs a; a.in.t = (const LAS unsigned long long*)(lds + LDS_PTR_OFF); a.out = outp_;
        float* MOD = (float*)(ws + WS_MOD);
        if (EN(0) && ph == PH_PREP) {
            for (int it = bid; it < 1048 + 544; it += G) {
                int tid = threadIdx.x; asm volatile("" : "+v"(tid));
                __syncthreads();
                if (it < 768) prep_adaln(a.in[I_C], a.in[I_CCTX], a.in[I_ADAW], a.in[I_ADAB], MOD, it, (LAS float*)lds, tid);
                else if (it < 784) prep_s5b(a, ws, it - 768, tid);
                else if (it >= 1048) prep_rope((f32x2*)(ws + WS_ROPE), it - 1048, tid);
                else { const bool big = it < 1040; const int r = big ? it - 784 : it - 1040, l = big ? (r >> 7) : 0, t0 = (big ? (r & 127) : r) * 32;
                    float* H3o = big ? (float*)(ws + WS_H3) + (size_t)l * 4096 * 64 : (float*)(ws + WS_H3C);
                    bf16_t* H3b = big ? (bf16_t*)(ws + WS_H3B) + (size_t)l * 4096 * 64 : (bf16_t*)nullptr;
                    prep_hymlp(a, H3o, H3b, l, big ? 4096 : 256, t0, lds, tid); }
            }
        } else if (EN(1) && ph == PH_FNORM) {
            const float* fw = a.in[I_FNW]; LANE_WAVE();
            for (int row = bid * NWAVES + wave; row < NLAT; row += G * NWAVES) {
                float* xr = a.out + (size_t)row * D; f32x4 v[8]; float ss = 0.f;
#pragma unroll
                for (int j = 0; j < 8; ++j) { v[j] = ((const f32x4*)xr)[lane + 64 * j]; ss += (v[j].x * v[j].x + v[j].y * v[j].y) + (v[j].z * v[j].z + v[j].w * v[j].w); }
                const float rstd = rsqrtf(wave_sum(ss) * (1.0f / D) + EPS);
#pragma unroll
                for (int j = 0; j < 8; ++j) { const f32x4 w = *(const f32x4*)(fw + 4 * (lane + 64 * j)); ((f32x4*)xr)[lane + 64 * j] = v[j] * rstd * w; }
            }
        } else {
            const int l = (ph - 1) / PH_PER_LAYER, sub = (ph - 1) % PH_PER_LAYER;

            const bool ctx_out = (l == 0);
            const int Mrows = ctx_out ? MR : NLAT;
            if (EN(2) && sub == 0) {
                LANE_WAVE();
                LAS float* scr = (LAS float*)(lds + wave * 8704);
                const int gw = bid * NWAVES + wave, NGW = G * NWAVES;
                constexpr int I_W1 = 32 * (NPAD / 32), I_W2 = 32 * 64, I_W3 = 8 * 16;
                for (int it = (l == 0 ? gw : gw + I_W1); it < I_W1 + I_W2 + I_W3; it += NGW) {
                    int r = it;
                    if (r < I_W1) { const int kb = r / (NPAD / 32), nb = r % (NPAD / 32); transpose_item(a.in[I_WIN] + (size_t)l * D * INW, INW, win_srccol(nb * 32 + (lane & 31)), kb * 64, (bf16_t*)(ws + WS_WIN), D, nb * 32, scr, lane); continue; }
                    r -= I_W1;
                    if (r < I_W2) { const int kb = r / 64, nb = r % 64; transpose_item(a.in[I_WOUT] + (size_t)l * D * D, D, nb * 32 + (lane & 31), kb * 64, (bf16_t*)(ws + WS_WOUT), D, nb * 32, scr, lane); continue; }
                    r -= I_W2;
                    { const int kb = r / 16, nb = r % 16; transpose_item(a.in[I_GLUW] + (size_t)l * 512 * 512, 512, nb * 32 + (lane & 31), kb * 64, (bf16_t*)(ws + WS_GLUW), 512, nb * 32, scr, lane); }
                }
                const float* nw = a.in[I_NORMW] + (size_t)l * D;
                for (int row = gw; row < MR; row += NGW) {
                    const float* xr; int v;
                    if (row < NLAT) { xr = (l == 0 ? a.in[I_X] : a.out) + (size_t)row * D; v = row >> 12; }
                    else { xr = (l == 0 ? a.in[I_CTX] : (const float*)(ws + WS_XC1)) + (size_t)(row - NLAT) * D; v = 4; }
                    norm_row(xr, nw, MOD + (size_t)(l * 5 + v) * ADA, (bf16_t*)(ws + WS_H) + (size_t)row * D, lane);
                }
                __syncthreads();
                const int nfilt = ctx_out ? 1024 : 0;
                for (int it = bid; it < nfilt; it += G) { int tid = threadIdx.x; asm volatile("" : "+v"(tid)); __syncthreads(); if (it < 512) filt_item2(a, ws, lds, l, it, tid); else filt_ctx_item(a, ws, lds, it - 512, tid);
#if defined(REP_ITEM) && REP_ITEM == 10
                    __syncthreads(); if (it < 512) filt_item2(a, ws, lds, l, it, tid);
#endif
                }
            } else if (EN(3) && sub == 1) {
                pg8::Gemm g{(const bf16_t*)(ws + WS_H), (const bf16_t*)(ws + WS_WIN), MR, NPAD, D}; pg8::StaticOrder S; S.init(MR, NPAD, G, bid);
                EpiInProj E{(bf16_t*)(ws + WS_P), (bf16_t*)(ws + WS_PT), (float*)(ws + WS_LR), (const float*)(ws + WS_ROPE)};
                { pg8::InProjOrder S1; S1.init(ctx_out ? 0 : 1, G, bid); pg8::gemm_phase<EpiInProj, pg8::InProjOrder, true, true>(lds, g, S1, E, tid); }
            } else if (EN(5) && sub == 2) {
                const int nit = ctx_out ? 3200 : 2688;
                for (int it = bid; it < nit; it += G) {
                    int tid = threadIdx.x; asm volatile("" : "+v"(tid));
                    __syncthreads();
#ifdef REP_ITEM
                    for (int rep_ = 0; rep_ < 2; ++rep_) { const int ty_ = it < 544 ? 0 : it < 1088 ? 1 : it < 2176 ? 2 : it < 2688 ? 3 : 4; if (rep_ && ty_ != REP_ITEM) break; if (rep_) __syncthreads(); asm volatile("" : "+v"(tid));
#endif
                    if (it < 544) s5_item<false>(a, ws, lds, l, it, tid);
                    else if (it < 1088) ret_passA(ws, lds, it - 544, tid);
                    else if (it < 2176) gla_passA(a, ws, lds, l, it - 1088, tid);
                    else if (it < 2688) hyena_item2(a, ws, lds, l, it - 2176, tid);
                    else hyena_ctx_item(a, ws, lds, it - 2688, tid);
#ifdef REP_ITEM
                    }
#endif
                }
            } else if (EN(9) && sub == 3) {
                for (int it = bid; it < 256; it += G) { int tid = threadIdx.x; asm volatile("" : "+v"(tid)); __syncthreads(); hy_transpose_item(ws, lds, it, tid, NLAT); }
                for (int it = bid; it < 224; it += G) { int tid = threadIdx.x; asm volatile("" : "+v"(tid)); __syncthreads();
                    if (it < 128) ret_passB(ws, it * NT + tid);
                    else if (it < 192) gla_passB(ws, lds, it - 128, tid);
                    else s5_passB(ws, l, (it - 192) * NT + tid); }
            } else if (EN(6) && sub == 4) {
                const int nsc = ctx_out ? 544 : 512, nrc = ctx_out ? 16 * RNCH : 16 * 32, ngc = ctx_out ? 16 * GNCH : 16 * 64;
                for (int it = bid; it < nsc; it += G) { int tid = threadIdx.x; asm volatile("" : "+v"(tid)); __syncthreads();
                    const int item = ctx_out ? it : (it >> 7) * (SNCH * 2) + 8 + (it & 127); s5_item<true>(a, ws, lds, l, item, tid); }
                for (int it = (bid + 64) % G; it < nrc; it += G) { int tid = threadIdx.x; asm volatile("" : "+v"(tid)); __syncthreads();
                    const int item = ctx_out ? it : (it >> 5) * RNCH + 2 + (it & 31); ret_passC(a, ws, lds, l, item, tid); }
                for (int it = (bid + 128) % G; it < ngc; it += G) { int tid = threadIdx.x; asm volatile("" : "+v"(tid)); __syncthreads();
                    const int item = ctx_out ? it : (it >> 6) * GNCH + 4 + (it & 63); gla_passC(a, ws, lds, l, item, tid); }
            } else if (EN(7) && sub == 5) {
                pg8::Gemm g{(const bf16_t*)(ws + WS_KF), (const bf16_t*)(ws + WS_GLUW), Mrows, 512, 512}; pg8::StaticOrder S; S.init(Mrows, 512, G, bid);
                EpiGlu E{(const bf16_t*)(ws + WS_KF) + OBSZ, (bf16_t*)(ws + WS_H), a.in[I_GLUB] + (size_t)l * 512};
                pg8::gemm_phase<EpiGlu, pg8::StaticOrder, true, true>(lds, g, S, E, tid);
                if (l == 0 && bid >= 136) {
                    LANE_WAVE(); LAS float* scr = (LAS float*)(lds + wave * 8704);
                    for (int r = (bid - 136) * NWAVES + wave; r < 32 * (NPAD / 32); r += (G - 136) * NWAVES) { const int kb = r / (NPAD / 32), nb = r % (NPAD / 32);
                        transpose_item(a.in[I_WIN] + (size_t)1 * D * INW, INW, win_srccol(nb * 32 + (lane & 31)), kb * 64, (bf16_t*)(ws + WS_WIN), D, nb * 32, scr, lane); }
                }
            } else if (EN(8)) {
                pg8::Gemm g{(const bf16_t*)(ws + WS_H), (const bf16_t*)(ws + WS_WOUT), Mrows, D, D}; pg8::StaticOrder S; S.init(Mrows, D, G, bid);
                EpiOut E{l == 0 ? a.in[I_X] : a.out, a.in[I_CTX], a.out, (float*)(ws + WS_XC1), MOD + (size_t)l * 5 * ADA};
                pg8::gemm_phase<EpiOut, pg8::StaticOrder, true, true>(lds, g, S, E, tid);
                if (l == 0 && bid >= 32) {
                    for (int it = bid - 32; it < 512; it += G - 32) { int tid2 = threadIdx.x; asm volatile("" : "+v"(tid2)); __syncthreads(); filt_item2(a, ws, lds, 1, it, tid2); }
                }
            }
        }
#ifdef REP_SUB
        if (ph != PH_PREP && ph != PH_FNORM && ((ph - 1) % PH_PER_LAYER) == REP_SUB && !((repmask >> ((ph - 1) / PH_PER_LAYER)) & 1)) { repmask |= 1 << ((ph - 1) / PH_PER_LAYER); xcd_barrier(gbar); --ph; continue; }
#endif
        if (ph + 1 < ka.ph_hi) xcd_barrier(gbar);
    }
}

#ifndef MK_LAUNCH_PER_PHASE
#define MK_LAUNCH_PER_PHASE 0
#endif
extern "C" void kernel_launch(void* const* d_in, const int* in_sizes, int n_in, void* d_out, int out_size, void* d_ws, size_t ws_size, hipStream_t stream) {
    static int grid = 0;
    if (grid == 0) {
        if (n_in != N_IN || out_size != NLAT * D || ws_size < WS_END2) { fprintf(stderr, "kernel_launch: unexpected shapes (n_in %d, out %d, ws %zu < %zu); nothing launched\n", n_in, out_size, ws_size, (size_t)WS_END2); grid = -1; return; }
        int dev = 0, cus = 0, per_cu = 0;
        if (hipGetDevice(&dev) != hipSuccess || hipDeviceGetAttribute(&cus, hipDeviceAttributeMultiprocessorCount, dev) != hipSuccess) { grid = -1; return; }
        if (hipFuncSetAttribute((const void*)fwd_kernel, hipFuncAttributeMaxDynamicSharedMemorySize, LDS_BYTES) != hipSuccess) { fprintf(stderr, "kernel_launch: hipFuncSetAttribute failed\n"); grid = -1; return; }
        if (hipOccupancyMaxActiveBlocksPerMultiprocessor(&per_cu, (const void*)fwd_kernel, NT, LDS_BYTES) != hipSuccess || per_cu < 1) { fprintf(stderr, "kernel_launch: occupancy query says %d blocks per CU\n", per_cu); per_cu = 1; }
        (void)hipGetLastError();
        grid = cus;
    }
    if (grid < 0) return;
    (void)hipMemsetAsync((char*)d_ws + WS_CTL, 0, WS_ZERO_BYTES, stream);
    Args a{};
    for (int i = 0; i < N_IN; ++i) a.in[i] = (const float*)d_in[i];
    a.out = (float*)d_out; a.ws = (unsigned char*)d_ws;
#if MK_LAUNCH_PER_PHASE
    for (int ph = 0; ph < N_PHASES; ++ph) {
        a.ph_lo = ph; a.ph_hi = ph + 1;
        hipLaunchKernelGGL(fwd_kernel, dim3(grid), dim3(NT), LDS_BYTES, stream, a);
    }
#else
    a.ph_lo = 0; a.ph_hi = N_PHASES;
    void* args[] = {&a};
    hipError_t e = hipLaunchCooperativeKernel((const void*)fwd_kernel, dim3(grid), dim3(NT), args, LDS_BYTES, stream);
    if (e != hipSuccess) fprintf(stderr, "kernel_launch: cooperative launch failed: %s (grid %d)\n", hipGetErrorString(e), grid);
#endif
}
```

```cpp
#include <hip/hip_runtime.h>
#include <hip/hip_cooperative_groups.h>
#include <cstdio>
#include <cstdint>
namespace cg = cooperative_groups;

#define LAS __attribute__((address_space(3)))
typedef unsigned short bf16_t;
typedef float f32x4 __attribute__((ext_vector_type(4)));
typedef float f32x2 __attribute__((ext_vector_type(2)));
typedef unsigned u32x4 __attribute__((ext_vector_type(4)));
typedef unsigned u32x2 __attribute__((ext_vector_type(2)));

constexpr int D = 2048, NB = 4, SEQL = 4096, LC = 256, NLAT = NB * SEQL, NCTX = NB * LC, MR = NLAT + NCTX;
constexpr int BR = 512, INW = 6688, NPAD = 6912, LDP = 4608, ADA = 3 * D;
constexpr int NT = 512, NWAVES = 8;
constexpr float EPS = 1e-6f;
constexpr int PC_S5U = 0, PC_S5G = 512, PC_RQ = 1024, PC_RK = 1536, PC_RV = 2048, PC_RG = 2560, PC_GQ = 3072, PC_GK = 3328, PC_GV = 3584, PC_GG = 4096;
constexpr int PT_V = 0, PT_G1 = 512, PT_G2 = 1024, PT_HG = 1536;
constexpr int FFTN = 8192;

enum { I_X = 0, I_C, I_CTX, I_CCTX, I_NORMW, I_ADAW, I_ADAB, I_WIN, I_WOUT, I_S5ARE, I_S5AIM, I_S5LDT, I_S5BRE, I_S5BIM, I_S5CRE, I_S5CIM,
       I_S5D, I_GLUW, I_GLUB, I_HCW, I_HCB, I_HW1, I_HB1, I_HF1, I_HW2, I_HB2, I_HF2, I_HW3, I_HB3, I_HF3, I_HW4, I_HBIAS, I_RNW, I_GGW, I_GGB, I_GNW, I_FNW, N_IN };

constexpr size_t al256(size_t x) { return (x + 255) & ~(size_t)255; }
constexpr size_t WS_CTL  = 0;
constexpr size_t WS_MOD  = WS_CTL + 65536;
constexpr size_t WS_ZERO_BYTES = 65536 + al256((size_t)2 * 5 * ADA * 4);
constexpr size_t WS_S5AB = WS_MOD + al256((size_t)2 * 5 * ADA * 4);
constexpr size_t WS_S5BT = WS_S5AB + (size_t)2 * 2 * 32 * 64 * 8;
constexpr size_t WS_H3   = WS_S5BT + (size_t)1048576 + 65536;
constexpr size_t WS_H3C  = WS_H3 + (size_t)2 * 4096 * 64 * 4;
constexpr size_t WS_KC   = WS_H3C + (size_t)256 * 64 * 4;
constexpr size_t WS_LR   = WS_KC + (size_t)2 * 512 * 512 * 4;
constexpr size_t WS_XC1  = WS_LR + (size_t)MR * 32 * 4;
constexpr size_t WS_WOUT = WS_XC1 + (size_t)NCTX * D * 4;
constexpr size_t WS_GLUW = WS_WOUT + (size_t)D * D * 2;
constexpr size_t WS_WIN  = WS_GLUW + (size_t)512 * 512 * 2;
constexpr size_t WS_H    = WS_WIN + (size_t)NPAD * D * 2;
constexpr size_t WS_P    = WS_H + (size_t)MR * D * 2;
constexpr size_t WS_PT   = WS_P + (size_t)MR * LDP * 2;
constexpr size_t WS_KF   = WS_PT + (size_t)2048 * MR * 2;
constexpr size_t WS_OB   = WS_KF + (size_t)2 * 512 * FFTN * 8;
constexpr size_t WS_END  = WS_OB + (size_t)6 * MR * 512 * 2;
constexpr size_t OBSZ = (size_t)MR * 512;

constexpr int LDS_CTL_OFF = 131072 + 2048;
constexpr int LDS_PTR_OFF = LDS_CTL_OFF + 64;
constexpr int LDS_BYTES = LDS_PTR_OFF + 320;

typedef __bf16 hwbf16x2 __attribute__((ext_vector_type(2)));
__device__ __forceinline__ unsigned pk2(float lo, float hi) { const f32x2 v = {lo, hi}; return __builtin_bit_cast(unsigned, __builtin_convertvector(v, hwbf16x2)); }
__device__ __forceinline__ unsigned f2bf(float f) { return pk2(f, 0.f) & 0xffffu; }
__device__ __forceinline__ float bf2f(bf16_t b) { return __uint_as_float((unsigned)b << 16); }
__device__ __forceinline__ float bflo(unsigned w) { return __uint_as_float(w << 16); }
__device__ __forceinline__ float bfhi(unsigned w) { return __uint_as_float(w & 0xffff0000u); }
__device__ __forceinline__ void unpack8(const u32x4 r, float (&f)[8]) { f[0] = bflo(r.x); f[1] = bfhi(r.x); f[2] = bflo(r.y); f[3] = bfhi(r.y); f[4] = bflo(r.z); f[5] = bfhi(r.z); f[6] = bflo(r.w); f[7] = bfhi(r.w); }
__device__ __forceinline__ u32x4 pack8(const float (&f)[8]) { u32x4 o; o.x = pk2(f[0], f[1]); o.y = pk2(f[2], f[3]); o.z = pk2(f[4], f[5]); o.w = pk2(f[6], f[7]); return o; }
__device__ __forceinline__ float sigmoidf_(float x) { return __builtin_amdgcn_rcpf(1.0f + __expf(-x)); }
__device__ __forceinline__ float siluf_(float x) { return x * sigmoidf_(x); }
__device__ __forceinline__ float gelu_tanh(float x) { const float u2 = 1.5957691216057308f * (x + 0.044715f * x * x * x); return x * sigmoidf_(u2); }
__device__ __forceinline__ float wave_sum(float v) {
#pragma unroll
    for (int o = 1; o < 64; o <<= 1) v += __shfl_xor(v, o);
    return v;
}
#define LDS_WAIT() asm volatile("s_waitcnt lgkmcnt(0)" ::: "memory")

struct Args { const float* in[N_IN]; float* out; unsigned char* ws; int ph_lo, ph_hi; };
struct InTab { const LAS unsigned long long* t;
    __device__ __forceinline__ const float* operator[](int i) const { const unsigned long long v = t[i];
        const unsigned lo = __builtin_amdgcn_readfirstlane((unsigned)v), hi = __builtin_amdgcn_readfirstlane((unsigned)(v >> 32)); return (const float*)(__attribute__((address_space(1))) const float*)(((unsigned long long)hi << 32) | lo); } };
struct DArgs { InTab in; float* out; };

#define XB_TMO      128
#define XB_XCNT(j)  (256  + 64 * (j))
#define XB_XSUB(j)  (1280 + 64 * (j))
#define XB_XGEN(j)  (2304 + 64 * (j))
#define XB_TOP      3328
#define XB_TOPGEN   3392
#define XCD_BAR_WORDS 3456
#define XB_SPIN_CAP (1u << 22)
__device__ __forceinline__ unsigned xb_ld(unsigned* p)              { return __hip_atomic_load(p, __ATOMIC_RELAXED, __HIP_MEMORY_SCOPE_AGENT); }
__device__ __forceinline__ unsigned xb_add(unsigned* p, unsigned v) { return __hip_atomic_fetch_add(p, v, __ATOMIC_RELAXED, __HIP_MEMORY_SCOPE_AGENT); }
__device__ __forceinline__ unsigned xb_xcc_id() { return (unsigned)__builtin_amdgcn_s_getreg((3 << 11) | 20) & 0xFu; }
#define XB_SPIN(cond, bar) do { unsigned _sp = 0; while (cond) { __builtin_amdgcn_s_sleep(1); \
    if ((++_sp & 255u) == 0u) { if (xb_ld(&(bar)[XB_TMO])) break; if (_sp > XB_SPIN_CAP) { atomicAdd(&(bar)[XB_TMO], 1u); break; } } } } while (0)
struct XcdBarrier { unsigned* bar; unsigned x; volatile LAS unsigned* st; };
__device__ __forceinline__ XcdBarrier xcd_barrier_post(unsigned* bar, volatile LAS unsigned* st) {
    XcdBarrier b; b.bar = bar; b.x = xb_xcc_id(); b.st = st;
    if (threadIdx.x == 0) (void)xb_add(&bar[XB_XCNT(b.x)], 1u);
    return b;
}
__device__ __forceinline__ void xcd_barrier_complete(unsigned* bar, unsigned x, unsigned& nloc, unsigned& nx) {
    const unsigned G = gridDim.x * gridDim.y * gridDim.z;
    unsigned sum, cnt, mine, sp = 0u;
    for (;;) {
        sum = 0u; cnt = 0u; mine = 0u;
#pragma unroll
        for (unsigned j = 0; j < 16; ++j) { const unsigned c = xb_ld(&bar[XB_XCNT(j)]); sum += c; cnt += (c > 0u) ? 1u : 0u; mine = (j == x) ? c : mine; }
        if (sum == G) break;
        __builtin_amdgcn_s_sleep(1);
        if ((++sp & 255u) == 0u) { if (xb_ld(&bar[XB_TMO])) break; if (sp > XB_SPIN_CAP) { atomicAdd(&bar[XB_TMO], 1u); break; } }
    }
    nloc = mine > 0u ? mine : 1u; nx = cnt > 0u ? cnt : 1u;
}
__device__ __forceinline__ void xcd_barrier(const XcdBarrier& b) {
    asm volatile("s_waitcnt vmcnt(0)" ::: "memory");
    __syncthreads();
    if (threadIdx.x == 0) {
        unsigned* bar = b.bar;
        __builtin_amdgcn_s_waitcnt(0);
        unsigned nloc = b.st[0], nx = b.st[1];
        if (nloc == 0u) { xcd_barrier_complete(bar, b.x, nloc, nx); b.st[0] = nloc; b.st[1] = nx; }
        const unsigned old = xb_add(&bar[XB_XSUB(b.x)], 1u);
        const unsigned gen = old / nloc;
        if (old + 1u == (gen + 1u) * nloc) {
            __builtin_amdgcn_fence(__ATOMIC_RELEASE, "agent");
            asm volatile("s_waitcnt vmcnt(0)" ::: "memory");
            const unsigned og = xb_add(&bar[XB_TOP], 1u);
            const unsigned tg = og / nx;
            if (og + 1u == (tg + 1u) * nx) xb_add(&bar[XB_TOPGEN], 1u);
            else XB_SPIN(xb_ld(&bar[XB_TOPGEN]) == tg, bar);
            __builtin_amdgcn_fence(__ATOMIC_ACQUIRE, "agent");
            xb_add(&bar[XB_XGEN(b.x)], 1u);
            asm volatile("s_waitcnt vmcnt(0)" ::: "memory");
        } else {
            XB_SPIN(xb_ld(&bar[XB_XGEN(b.x)]) == gen, bar);
            __builtin_amdgcn_fence(__ATOMIC_ACQUIRE, "agent");
            asm volatile("s_waitcnt vmcnt(0)" ::: "memory");
        }
    }
    __syncthreads();
}
namespace pg8 {
#define PG8_LAS __attribute__((address_space(3)))
typedef unsigned short bf16_t;
typedef short bf16x8 __attribute__((ext_vector_type(8)));
typedef float f32x4 __attribute__((ext_vector_type(4)));
typedef unsigned u32x4 __attribute__((ext_vector_type(4)));
constexpr int BM = 256, BK = 64, HALF = 128, HTB = HALF * BK * 2, STAGE_BYTES = 8 * HTB, NXCD = 8, WGM = 8;

__host__ __device__ __forceinline__ int lds_byte(int r, int c) { const int st = (r >> 4) * 2 + (c >> 5), rr = r & 15, cc = c & 31, ob = rr * 64 + cc * 2; return st * 1024 + (ob ^ (((ob >> 9) & 1) << 5)); }
__host__ __device__ __forceinline__ void stage_rc(int b, int& R, int& C) { const int st = b / 1024, sb = b % 1024, swz = sb ^ (((sb >> 9) & 1) << 5); R = (st >> 1) * 16 + swz / 64; C = (st & 1) * 32 + (swz % 64) / 2; }
__host__ __device__ __forceinline__ int perm32(int rho) { const int n = rho >> 4, i = rho & 15; return 8 * (i >> 2) + 4 * n + (i & 3); }

struct Unit { int pm, pn; };
struct Gemm { const bf16_t* A; const bf16_t* Bt; int M, N, K; };

struct StaticOrder {
    int nM, nN, nwg, G, c;
    __host__ __device__ void init(int M, int N, int G_, int c_) { nM = M / BM; nN = N / BM; nwg = nM * nN; G = G_; c = c_; }
    __host__ __device__ bool next(int i, Unit& u) const {
        const long L = (long)i * G + c; if (L >= nwg) return false;
        int wgid = (int)L; { const int q = nwg / NXCD, r = nwg % NXCD, xcd = wgid % NXCD, off = wgid / NXCD; wgid = (xcd < r ? xcd * (q + 1) : r * (q + 1) + (xcd - r) * q) + off; }
        const int nig = WGM * nN, gid = wgid / nig, fm = gid * WGM, gsz = (nM - fm) < WGM ? (nM - fm) : WGM;
        u.pm = fm + ((wgid % nig) % gsz); u.pn = (wgid % nig) / gsz; return true;
    }
    __device__ __forceinline__ void a_ready(const Unit&) const {}
    __device__ __forceinline__ void done(const Unit&) const {}
};


struct InProjOrder {
    StaticOrder base; int G, c, last;
    __host__ __device__ void init(int last_, int G_, int c_) { last = last_; base.init((last_ ? 64 : 68) * 256, 27 * 256, G_, c_); G = G_; c = c_; }
    __host__ __device__ bool next(int i, Unit& u) const {
        const long L = (long)i * G + c;
        if (!last || L < 1728) return base.next(i, u);
        if (L >= 1768) return false;
        const int k = (int)L - 1728, j = k % 10; u.pm = 64 + k / 10;
        u.pn = j == 0 ? 0 : j == 1 ? 1 : j == 2 ? 14 : j == 3 ? 15 : j == 4 ? 16 : j == 5 ? 17 : j == 6 ? 21 : j == 7 ? 22 : j == 8 ? 23 : 26;
        return true;
    }
    __device__ __forceinline__ void a_ready(const Unit&) const {}
    __device__ __forceinline__ void done(const Unit&) const {}
};
template <class Epi, class Sched, bool ALIGN_EPI = false, bool SP2 = false>
__device__ __forceinline__ void gemm_phase(PG8_LAS unsigned char* lds, const Gemm g, const Sched& S, const Epi& E, const int tid) {
    const int wid = __builtin_amdgcn_readfirstlane(tid >> 6), lane = tid & 63, wr = wid >> 2, wc = wid & 3, fr = lane & 15, fq = lane >> 4;
    const int K = g.K, nt = K / BK;
    unsigned voffA[2], voffB[2];
#pragma unroll
    for (int i = 0; i < 2; ++i) { int R, C; stage_rc(tid * 16 + i * 8192, R, C); const int Rb = Epi::PERM ? ((R & ~31) + perm32(R & 31)) : R;
        voffA[i] = (unsigned)(R * K + C) * 2u; voffB[i] = (unsigned)(Rb * K + C) * 2u; }
    const size_t kstep = (size_t)(BK * 2);
    const size_t hstep = (size_t)HALF * K * 2;
    const size_t tstep = 2 * hstep;
    const unsigned ldsw = (unsigned)wid * 1024u;
    const int aoff = lds_byte(wr * 64 + fr, fq * 8), boff = lds_byte(wc * 32 + fr, fq * 8);
#define PG8_SA(b, h) (((b) * 2 + (h)) * HTB)
#define PG8_SB(b, h) ((4 + (b) * 2 + (h)) * HTB)
#define PG8_STAGE(bufoff, gbase, voff) do { _Pragma("unroll") for (int _i = 0; _i < 2; ++_i) \
        __builtin_amdgcn_global_load_lds((const unsigned*)((const char*)(gbase) + (voff)[_i]), (PG8_LAS unsigned*)(lds + (bufoff) + ldsw + _i * 8192), 16, 0, 0); } while (0)
#define PG8_LDA(dst, b, h) do { _Pragma("unroll") for (int m = 0; m < 4; ++m) _Pragma("unroll") for (int k = 0; k < 2; ++k) dst[m][k] = *(const PG8_LAS bf16x8*)(lds + PG8_SA(b, h) + aoff + m * 2048 + k * 1024); } while (0)
#define PG8_LDB(dst, b, h) do { _Pragma("unroll") for (int n = 0; n < 2; ++n) _Pragma("unroll") for (int k = 0; k < 2; ++k) dst[n][k] = *(const PG8_LAS bf16x8*)(lds + PG8_SB(b, h) + boff + n * 2048 + k * 1024); } while (0)
#define PG8_MMA(ai, bj, At, Bt) do { __builtin_amdgcn_s_setprio(1); _Pragma("unroll") for (int m = 0; m < 4; ++m) _Pragma("unroll") for (int n = 0; n < 2; ++n) _Pragma("unroll") for (int k = 0; k < 2; ++k) \
        acc[ai][bj][m][n] = __builtin_amdgcn_mfma_f32_16x16x32_bf16(Bt[n][k], At[m][k], acc[ai][bj][m][n], 0, 0, 0); __builtin_amdgcn_s_setprio(0); } while (0)
#define PG8_WAIT_V(n) asm volatile("s_waitcnt vmcnt(" #n ")" ::: "memory")
#define PG8_WAIT_L(n) asm volatile("s_waitcnt lgkmcnt(" #n ")" ::: "memory")
#define PG8_BAR __builtin_amdgcn_s_barrier()
#define PG8_SCHED __builtin_amdgcn_sched_barrier(0)
    Unit cur, nxt; int ui = 0;
    if (!S.next(0, cur)) return;
    f32x4 acc[2][2][4][2];
#pragma unroll
    for (int a = 0; a < 2; ++a)
#pragma unroll
        for (int b = 0; b < 2; ++b)
#pragma unroll
            for (int m = 0; m < 4; ++m)
#pragma unroll
                for (int n = 0; n < 2; ++n) acc[a][b][m][n] = (f32x4){0.f, 0.f, 0.f, 0.f};
    bf16x8 At[4][2], B0[2][2], B1[2][2];
    const char* cA = (const char*)g.A + (size_t)cur.pm * tstep; const char* cB = (const char*)g.Bt + (size_t)cur.pn * tstep;
    S.a_ready(cur);
    if constexpr (SP2) {
        PG8_STAGE(PG8_SB(0, 0), cB, voffB); PG8_STAGE(PG8_SB(0, 1), cB + hstep, voffB); PG8_STAGE(PG8_SA(0, 0), cA, voffA); PG8_STAGE(PG8_SA(0, 1), cA + hstep, voffA);
        if (wr == 1) PG8_BAR;
        PG8_WAIT_V(2); PG8_BAR;
        PG8_STAGE(PG8_SB(1, 0), cB + kstep, voffB); PG8_STAGE(PG8_SA(1, 0), cA + kstep, voffA); PG8_STAGE(PG8_SB(1, 1), cB + hstep + kstep, voffB);
        PG8_WAIT_V(6); PG8_BAR;
    } else {
        PG8_STAGE(PG8_SB(0, 0), cB, voffB); PG8_STAGE(PG8_SA(0, 0), cA, voffA); PG8_STAGE(PG8_SB(0, 1), cB + hstep, voffB); PG8_STAGE(PG8_SA(0, 1), cA + hstep, voffA);
        if (wr == 1) PG8_BAR;
        PG8_WAIT_V(4); PG8_BAR;
        PG8_STAGE(PG8_SB(1, 0), cB + kstep, voffB); PG8_STAGE(PG8_SA(1, 0), cA + kstep, voffA); PG8_STAGE(PG8_SB(1, 1), cB + hstep + kstep, voffB);
        PG8_WAIT_V(6); PG8_BAR;
    }
    for (;;) {
        const bool has_next = S.next(ui + 1, nxt);
        const char* nA = has_next ? (const char*)g.A + (size_t)nxt.pm * tstep : cA; const char* nB = has_next ? (const char*)g.Bt + (size_t)nxt.pn * tstep : cB;
        for (int t = 0; t < nt; t += 2) {
            const bool last = (t == nt - 2);
            const char* a1 = cA + (size_t)(t + 1) * kstep;
            const char* a2 = last ? nA : cA + (size_t)(t + 2) * kstep; const char* b2 = last ? nB : cB + (size_t)(t + 2) * kstep;
            const char* a3 = a2 + kstep; const char* b3 = b2 + kstep;
            if (last && has_next) S.a_ready(nxt);
            if constexpr (SP2) {
            PG8_LDB(B0, 0, 0); PG8_LDB(B1, 0, 1); PG8_SCHED; PG8_LDA(At, 0, 0); PG8_STAGE(PG8_SA(1, 1), a1 + hstep, voffA);
            PG8_WAIT_V(8); PG8_WAIT_L(0); PG8_BAR; PG8_MMA(0, 0, At, B0); PG8_MMA(0, 1, At, B1); PG8_BAR; PG8_SCHED;
            PG8_LDA(At, 0, 1); PG8_STAGE(PG8_SB(0, 0), b2, voffB); PG8_STAGE(PG8_SB(0, 1), b2 + hstep, voffB); PG8_STAGE(PG8_SA(0, 0), a2, voffA);
            PG8_WAIT_V(8); PG8_WAIT_L(0); PG8_BAR; PG8_MMA(1, 0, At, B0); PG8_MMA(1, 1, At, B1); PG8_BAR; PG8_SCHED;
            PG8_LDB(B0, 1, 0); PG8_LDB(B1, 1, 1); PG8_SCHED; PG8_LDA(At, 1, 0); PG8_STAGE(PG8_SA(0, 1), a2 + hstep, voffA);
            PG8_WAIT_V(8); PG8_WAIT_L(0); PG8_BAR; PG8_MMA(0, 0, At, B0); PG8_MMA(0, 1, At, B1); PG8_BAR; PG8_SCHED;
            PG8_LDA(At, 1, 1); PG8_STAGE(PG8_SB(1, 0), b3, voffB); PG8_STAGE(PG8_SB(1, 1), b3 + hstep, voffB); PG8_STAGE(PG8_SA(1, 0), a3, voffA);
            PG8_WAIT_V(8); PG8_WAIT_L(0); PG8_BAR; PG8_MMA(1, 0, At, B0); PG8_MMA(1, 1, At, B1); PG8_BAR; PG8_SCHED;
            } else {
            PG8_LDB(B0, 0, 0); PG8_SCHED; PG8_LDA(At, 0, 0); PG8_STAGE(PG8_SA(1, 1), a1 + hstep, voffA);
            PG8_WAIT_L(8); PG8_BAR; PG8_WAIT_L(0); PG8_MMA(0, 0, At, B0); PG8_BAR; PG8_SCHED;
            PG8_LDB(B1, 0, 1); PG8_STAGE(PG8_SB(0, 0), b2, voffB);
            PG8_BAR; PG8_WAIT_L(0); PG8_MMA(0, 1, At, B1); PG8_BAR;
            PG8_LDA(At, 0, 1); PG8_STAGE(PG8_SA(0, 0), a2, voffA);
            PG8_BAR; PG8_WAIT_L(0); PG8_MMA(1, 0, At, B0); PG8_BAR; PG8_SCHED;
            PG8_STAGE(PG8_SB(0, 1), b2 + hstep, voffB);
            PG8_WAIT_V(6); PG8_BAR; PG8_MMA(1, 1, At, B1); PG8_BAR;
            PG8_LDB(B0, 1, 0); PG8_SCHED; PG8_LDA(At, 1, 0); PG8_STAGE(PG8_SA(0, 1), a2 + hstep, voffA);
            PG8_WAIT_L(8); PG8_BAR; PG8_WAIT_L(0); PG8_MMA(0, 0, At, B0); PG8_BAR; PG8_SCHED;
            PG8_LDB(B1, 1, 1); PG8_STAGE(PG8_SB(1, 0), b3, voffB);
            PG8_BAR; PG8_WAIT_L(0); PG8_MMA(0, 1, At, B1); PG8_BAR;
            PG8_LDA(At, 1, 1); PG8_STAGE(PG8_SA(1, 0), a3, voffA);
            PG8_BAR; PG8_WAIT_L(0); PG8_MMA(1, 0, At, B0); PG8_BAR; PG8_SCHED;
            PG8_STAGE(PG8_SB(1, 1), b3 + hstep, voffB);
            PG8_WAIT_V(6); PG8_BAR; PG8_MMA(1, 1, At, B1); PG8_BAR;
            }
        }
        if constexpr (ALIGN_EPI) { if (wr == 0) PG8_BAR; }
        { int fr_ = fr, fq_ = fq; asm volatile("" : "+v"(fr_), "+v"(fq_));
          E(acc, cur, wr, wc, fr_, fq_); } S.done(cur);
        if (!has_next) break;
#pragma unroll
        for (int a = 0; a < 2; ++a)
#pragma unroll
            for (int b = 0; b < 2; ++b)
#pragma unroll
                for (int m = 0; m < 4; ++m)
#pragma unroll
                    for (int n = 0; n < 2; ++n) acc[a][b][m][n] = (f32x4){0.f, 0.f, 0.f, 0.f};
        cur = nxt; cA = nA; cB = nB; ++ui;
        if constexpr (ALIGN_EPI) { if (wr == 1) PG8_BAR; }
    }
    PG8_WAIT_V(0);
    if constexpr (!ALIGN_EPI) { if (wr == 0) PG8_BAR; }
    PG8_BAR;
#undef PG8_SA
#undef PG8_SB
#undef PG8_STAGE
#undef PG8_LDA
#undef PG8_LDB
#undef PG8_MMA
#undef PG8_WAIT_V
#undef PG8_WAIT_L
#undef PG8_BAR
#undef PG8_SCHED
}
}
__device__ __forceinline__ void prep_adaln(const float* c, const float* cctx, const float* adaw, const float* adab, float* MOD, int it, LAS float* sv, int tid) {
    const int l = it / 384, r = it % 384, ntile = r >> 5, ks = r & 31, k0 = ks * 64;
    if (tid < 320) { const int v = tid >> 6, k = tid & 63; const float cv = v < 4 ? c[v * D + k0 + k] : cctx[k0 + k]; sv[tid] = cv / (1.0f + expf(-cv)); }
    __syncthreads();
    const int n = ntile * 512 + tid; const float* w = adaw + (size_t)l * D * ADA + (size_t)k0 * ADA + n;
    float acc[5] = {0.f, 0.f, 0.f, 0.f, 0.f};
#pragma unroll 1
    for (int k0_ = 0; k0_ < 64; k0_ += 32) {
        float wv[32];
#pragma unroll
        for (int k = 0; k < 32; ++k) wv[k] = w[(size_t)(k0_ + k) * ADA];
#pragma unroll
        for (int k = 0; k < 32; ++k) {
#pragma unroll
            for (int v = 0; v < 5; ++v) acc[v] += sv[v * 64 + k0_ + k] * wv[k]; } }
    if (ks == 0) { const float bb = adab[l * ADA + n];
#pragma unroll
        for (int v = 0; v < 5; ++v) acc[v] += bb; }
#pragma unroll
    for (int v = 0; v < 5; ++v) atomicAdd(MOD + (size_t)(l * 5 + v) * ADA + n, acc[v]);
    __syncthreads();
}

__device__ __forceinline__ void prep_s5(const DArgs& a, unsigned char* ws, int it, int tid) {
    const int idx = it * 512 + tid;
    const float a_re = a.in[I_S5ARE][idx], a_im = a.in[I_S5AIM][idx], ldt = a.in[I_S5LDT][idx >> 6];
    const float dt = expf(ldt), mag = expf(a_re * dt);
    float sn, cs; sincosf(a_im * dt, &sn, &cs);
    const float ab_re = mag * cs, ab_im = mag * sn, den = a_re * a_re + a_im * a_im, nr = ab_re - 1.0f;
    const float co_re = (nr * a_re + ab_im * a_im) / den, co_im = (ab_im * a_re - nr * a_im) / den;
    ((f32x2*)(ws + WS_S5AB))[idx] = (f32x2){ab_re, ab_im};
    const float* bre = a.in[I_S5BRE] + (size_t)idx * 16; const float* bim = a.in[I_S5BIM] + (size_t)idx * 16;
    f32x2* bt = (f32x2*)(ws + WS_S5BT) + (size_t)idx * 16;
#pragma unroll
    for (int i = 0; i < 16; ++i) { const float br = bre[i], bi = bim[i]; bt[i] = (f32x2){co_re * br - co_im * bi, co_re * bi + co_im * br}; }
}

__device__ __forceinline__ void prep_hymlp(const DArgs& a, float* H3out, bf16_t* H3b, int l, int Lx, int t0, LAS unsigned char* lds, int tid) {
    LAS float* zs = (LAS float*)lds;
    LAS float* h1 = (LAS float*)(lds + 4608);
    LAS float* h2 = (LAS float*)(lds + 4608 + 8192);
    LAS float* w1s = (LAS float*)(lds + 24576);
    LAS float* w2s = w1s + 33 * 64;
    LAS float* w3s = w2s + 64 * 64;
    { const float* w1 = a.in[I_HW1] + (size_t)l * 33 * 64; const float* w2 = a.in[I_HW2] + (size_t)l * 64 * 64; const float* w3 = a.in[I_HW3] + (size_t)l * 64 * 64;
      for (int i = tid; i < 33 * 64; i += NT) w1s[i] = w1[i];
      for (int i = tid; i < 64 * 64; i += NT) { w2s[i] = w2[i]; w3s[i] = w3[i]; } }
    for (int i = tid; i < 32 * 33; i += NT) { const int pos = i / 33, f = i % 33, t = t0 + pos;
        float z;
        if (f == 0) z = (float)t / (float)(Lx - 1);
        else { const int j = (f - 1) & 15; const float fj = 1e-4f + (float)j * ((15.0f - 1e-4f) / 15.0f); const float wpos = (6.283185307179586f * (float)t) / (float)Lx; const float arg = fj * wpos;
               z = (f <= 16) ? cosf(arg) : -sinf(arg); }
        zs[pos * 36 + f] = z; }
    __syncthreads();
    const int pos = tid >> 4, f4 = (tid & 15) * 4, t = t0 + pos;
    f32x4 s = *(const f32x4*)(a.in[I_HB1] + l * 64 + f4);
#pragma unroll 3
    for (int j = 0; j < 33; ++j) s += zs[pos * 36 + j] * *(const LAS f32x4*)(w1s + j * 64 + f4);
    { const f32x4 fr = *(const f32x4*)(a.in[I_HF1] + l * 64 + f4); *(LAS f32x4*)(h1 + pos * 64 + f4) = (f32x4){sinf(fr.x * s.x), sinf(fr.y * s.y), sinf(fr.z * s.z), sinf(fr.w * s.w)}; }
    __syncthreads();
    s = *(const f32x4*)(a.in[I_HB2] + l * 64 + f4);
#pragma unroll 4
    for (int j = 0; j < 64; ++j) s += h1[pos * 64 + j] * *(const LAS f32x4*)(w2s + j * 64 + f4);
    { const f32x4 fr = *(const f32x4*)(a.in[I_HF2] + l * 64 + f4); *(LAS f32x4*)(h2 + pos * 64 + f4) = (f32x4){sinf(fr.x * s.x), sinf(fr.y * s.y), sinf(fr.z * s.z), sinf(fr.w * s.w)}; }
    __syncthreads();
    s = *(const f32x4*)(a.in[I_HB3] + l * 64 + f4);
#pragma unroll 4
    for (int j = 0; j < 64; ++j) s += h2[pos * 64 + j] * *(const LAS f32x4*)(w3s + j * 64 + f4);
    { const f32x4 fr = *(const f32x4*)(a.in[I_HF3] + l * 64 + f4); const f32x4 hv = (f32x4){sinf(fr.x * s.x), sinf(fr.y * s.y), sinf(fr.z * s.z), sinf(fr.w * s.w)}; *(f32x4*)(H3out + (size_t)t * 64 + f4) = hv;
      if (H3b) { u32x2 pk; pk.x = pk2(hv.x, hv.y); pk.y = pk2(hv.z, hv.w); *(u32x2*)(H3b + (size_t)t * 64 + f4) = pk; } }
    __syncthreads();
}

__device__ __forceinline__ void transpose_item(const float* W, int ldw, int srccol_lane  , int k0, bf16_t* WT, int K, int dstrow0, LAS float* scr, int lane) {
    float wv[32];
#pragma unroll
    for (int i = 0; i < 32; ++i) { const int kk = 2 * i + (lane >> 5); wv[i] = srccol_lane >= 0 ? W[(size_t)(k0 + kk) * ldw + srccol_lane] : 0.f; }
#pragma unroll
    for (int i = 0; i < 32; ++i) { const int kk = 2 * i + (lane >> 5); scr[kk * 33 + (lane & 31)] = wv[i]; }
    LDS_WAIT();
    const int c = lane & 7;
#pragma unroll
    for (int j = 0; j < 4; ++j) { const int n = (lane >> 3) + 8 * j; const LAS float* s = scr + (8 * c) * 33 + n;
        u32x4 o; o.x = pk2(s[0 * 33], s[1 * 33]); o.y = pk2(s[2 * 33], s[3 * 33]); o.z = pk2(s[4 * 33], s[5 * 33]); o.w = pk2(s[6 * 33], s[7 * 33]);
        *(u32x4*)(WT + (size_t)(dstrow0 + n) * K + k0 + 8 * c) = o; }
    LDS_WAIT();
}
__device__ __forceinline__ int win_srccol(int n) {
    if (n >= 3072 && n < 4096) { const int u = (n - 3072) & 127, grp = u >> 3, e = u & 7; return (n & ~127) + (e < 4 ? 4 * grp + e : 64 + 4 * grp + (e - 4)); }
    return n < 6144 ? n : (n < 6656 ? n + 32 : (n < 6688 ? n - 512 : -1));
}

__device__ __forceinline__ void norm_row(const float* xrow, const float* nw, const float* mod, bf16_t* hrow, int lane) {
    f32x4 v[8]; float ss = 0.f;
#pragma unroll
    for (int j = 0; j < 8; ++j) { v[j] = ((const f32x4*)xrow)[lane + 64 * j]; ss += (v[j].x * v[j].x + v[j].y * v[j].y) + (v[j].z * v[j].z + v[j].w * v[j].w); }
    const float rstd = rsqrtf(wave_sum(ss) * (1.0f / D) + EPS);
#pragma unroll
    for (int j = 0; j < 8; ++j) { const int k = 4 * (lane + 64 * j);
        const f32x4 w = *(const f32x4*)(nw + k), sh = *(const f32x4*)(mod + k), sc = *(const f32x4*)(mod + D + k);
        const f32x4 o = v[j] * rstd * w * (sc + 1.0f) + sh;
        u32x2 pk; pk.x = pk2(o.x, o.y); pk.y = pk2(o.z, o.w);
        *(u32x2*)(hrow + k) = pk; }
}

__device__ __forceinline__ void fft_twiddles(LAS f32x2* W, int tid) {
    for (int j = tid; j < 4096; j += NT) { float s, c; sincospif(-(float)j * (1.0f / 4096.0f), &s, &c); W[j] = (f32x2){c, s}; }
}
template <int R, int BETA, bool INV> __device__ __forceinline__ void fft_pass(LAS f32x2* X, const LAS f32x2* W, int tid) {
    constexpr int LOW = BETA - R + 1, NG = FFTN >> R;
    for (int gi = tid; gi < NG; gi += NT) {
        const int base = ((gi >> LOW) << (BETA + 1)) | (gi & ((1 << LOW) - 1));
        f32x2 e[1 << R];
#pragma unroll
        for (int m = 0; m < (1 << R); ++m) e[m] = X[base + (m << LOW)];
#pragma unroll
        for (int ss = 0; ss < R; ++ss) {
            const int s = INV ? (R - 1 - ss) : ss; const int bit = BETA - s, h = 1 << (R - 1 - s);
#pragma unroll
            for (int m = 0; m < (1 << R); ++m) {
                if (m & h) continue;
                const int idx = base + (m << LOW); const int ex = (idx & ((1 << bit) - 1)) << (12 - bit);
                const f32x2 w = W[ex]; const f32x2 a_ = e[m], b_ = e[m | h];
                if (!INV) { const f32x2 d = a_ - b_; e[m] = a_ + b_; e[m | h] = (f32x2){d.x * w.x - d.y * w.y, d.x * w.y + d.y * w.x}; }
                else { const f32x2 t = (f32x2){b_.x * w.x + b_.y * w.y, b_.y * w.x - b_.x * w.y}; e[m] = a_ + t; e[m | h] = a_ - t; }
            }
        }
#pragma unroll
        for (int m = 0; m < (1 << R); ++m) X[base + (m << LOW)] = e[m];
    }
}
__device__ __forceinline__ void fft_forward(LAS f32x2* X, const LAS f32x2* W, int tid) {
    fft_pass<4, 12, false>(X, W, tid); __syncthreads(); fft_pass<3, 8, false>(X, W, tid); __syncthreads();
    fft_pass<3, 5, false>(X, W, tid); __syncthreads(); fft_pass<3, 2, false>(X, W, tid); __syncthreads();
}
__device__ __forceinline__ void fft_inverse(LAS f32x2* X, const LAS f32x2* W, int tid) {
    fft_pass<3, 2, true>(X, W, tid); __syncthreads(); fft_pass<3, 5, true>(X, W, tid); __syncthreads();
    fft_pass<3, 8, true>(X, W, tid); __syncthreads(); fft_pass<4, 12, true>(X, W, tid); __syncthreads();
}
__device__ __forceinline__ float block_sum(float v, LAS float* red, int tid) {
    v = wave_sum(v);
    if ((tid & 63) == 0) red[tid >> 6] = v;
    __syncthreads();
    float t = 0.f;
#pragma unroll
    for (int i = 0; i < NWAVES; ++i) t += red[i];
    __syncthreads();
    return t;
}
constexpr float HY_D0 = -3.0701134573253945f  , HY_D1 = -15.350567286626973f  ;

__device__ __forceinline__ void filt_item(const DArgs& a, unsigned char* ws, LAS unsigned char* lds, int l, int c, int tid) {
    LAS f32x2* X = (LAS f32x2*)lds; LAS f32x2* W = (LAS f32x2*)(lds + 65536); LAS float* w4s = (LAS float*)(lds + 98304); LAS float* red = (LAS float*)(lds + 98304 + 1024);
    LAS float* k1b = (LAS float*)(lds + 100352);
    fft_twiddles(W, tid);
    if (tid < 256) { const int cc = tid >> 6, f = tid & 63; w4s[tid] = a.in[I_HW4][(size_t)l * 64 * 2048 + (size_t)f * 2048 + (cc >> 1) * 1024 + (cc & 1) * 512 + c]; }
    __syncthreads();
    const float dl = fabsf(HY_D0 + (HY_D1 - HY_D0) * ((float)c / 511.0f));
    const float* H3 = (const float*)(ws + WS_H3) + (size_t)l * 4096 * 64;
    float ss0 = 0.f, ss1 = 0.f;
#pragma unroll 1
    for (int j = 0; j < 16; ++j) {
        const int n = tid + 512 * j; const int dir = j >= 8 ? 1 : 0; const int t = dir ? (8192 - n) : n;
        float s0 = 0.f, s1 = 0.f;
        if (n != 4096) {
            const f32x4* hr = (const f32x4*)(H3 + (size_t)t * 64);
#pragma unroll
            for (int q = 0; q < 16; ++q) { const f32x4 hv = hr[q]; const f32x4 wa = ((const LAS f32x4*)(w4s + (dir * 2 + 0) * 64))[q], wb = ((const LAS f32x4*)(w4s + (dir * 2 + 1) * 64))[q];
                s0 += (hv.x * wa.x + hv.y * wa.y) + (hv.z * wa.z + hv.w * wa.w); s1 += (hv.x * wb.x + hv.y * wb.y) + (hv.z * wb.z + hv.w * wb.w); }
            const float dec = expf(-((float)t / 4095.0f) * dl); s0 *= dec; s1 *= dec;
        }
        X[n] = (f32x2){s0, 0.f}; k1b[n] = s1; ss0 += s0 * s0; ss1 += s1 * s1;
    }
    const float rs0 = rsqrtf(block_sum(ss0, red, tid) + EPS), rs1 = rsqrtf(block_sum(ss1, red, tid) + EPS);
    f32x2* KF0 = (f32x2*)(ws + WS_KF) + (size_t)(0 * 512 + c) * FFTN; f32x2* KF1 = (f32x2*)(ws + WS_KF) + (size_t)(1 * 512 + c) * FFTN;
#pragma unroll 4
    for (int j = 0; j < 16; ++j) { const f32x2 x = X[tid + 512 * j]; X[tid + 512 * j] = (f32x2){x.x * rs0, 0.f}; }
    __syncthreads(); fft_forward(X, W, tid);
#pragma unroll 4
    for (int j = 0; j < 16; ++j) KF0[tid + 512 * j] = X[tid + 512 * j];
    __syncthreads();
#pragma unroll 4
    for (int j = 0; j < 16; ++j) X[tid + 512 * j] = (f32x2){k1b[tid + 512 * j] * rs1, 0.f};
    __syncthreads(); fft_forward(X, W, tid);
#pragma unroll 4
    for (int j = 0; j < 16; ++j) KF1[tid + 512 * j] = X[tid + 512 * j];
    __syncthreads();
}
__device__ __forceinline__ void filt_ctx_item(const DArgs& a, unsigned char* ws, LAS unsigned char* lds, int c, int tid) {
    LAS float* w4s = (LAS float*)lds; LAS float* red = (LAS float*)(lds + 1024);
    if (tid < 256) { const int cc = tid >> 6, f = tid & 63; w4s[tid] = a.in[I_HW4][(size_t)f * 2048 + (cc >> 1) * 1024 + (cc & 1) * 512 + c]; }
    __syncthreads();
    const float dl = fabsf(HY_D0 + (HY_D1 - HY_D0) * ((float)c / 511.0f));
    const float* H3C = (const float*)(ws + WS_H3C);
    const int n = tid, dir = n >= 256 ? 1 : 0, t = dir ? (512 - n) : n;
    float s0 = 0.f, s1 = 0.f;
    if (n != 256) {
        const f32x4* hr = (const f32x4*)(H3C + (size_t)t * 64);
#pragma unroll
        for (int q = 0; q < 16; ++q) { const f32x4 hv = hr[q]; const f32x4 wa = ((const LAS f32x4*)(w4s + (dir * 2 + 0) * 64))[q], wb = ((const LAS f32x4*)(w4s + (dir * 2 + 1) * 64))[q];
            s0 += (hv.x * wa.x + hv.y * wa.y) + (hv.z * wa.z + hv.w * wa.w); s1 += (hv.x * wb.x + hv.y * wb.y) + (hv.z * wb.z + hv.w * wb.w); }
        const float dec = expf(-((float)t / 255.0f) * dl); s0 *= dec; s1 *= dec;
    }
    const float rs0 = rsqrtf(block_sum(s0 * s0, red, tid) + EPS), rs1 = rsqrtf(block_sum(s1 * s1, red, tid) + EPS);
    float* KC = (float*)(ws + WS_KC);
    KC[(size_t)(0 * 512 + c) * 512 + n] = s0 * rs0; KC[(size_t)(1 * 512 + c) * 512 + n] = s1 * rs1;
    __syncthreads();
}

__device__ __forceinline__ void prep_rope(f32x2* RT, int it, int tid) {
    const int idx = it * NT + tid, pos = idx >> 6, j = idx & 63;
    float ang;
    if (pos < SEQL) { const float inv = exp2f(-(float)(j & 31) * (13.287712379549449f / 32.0f)); ang = (float)(j < 32 ? (pos >> 6) : (pos & 63)) * inv; }
    else { const float inv = exp2f(-(float)j * (13.287712379549449f / 64.0f)); ang = (float)(pos - SEQL) * inv; }
    float sn, cs; sincosf(ang, &sn, &cs);
    RT[idx] = (f32x2){cs, sn};
}

__device__ __forceinline__ void ret_chain(const bf16_t* P, bf16_t* O, int b, int h, int dir, bool ctx_out, int wave, int lane) {
    const int e = wave * 16 + (lane & 15), dq = lane >> 4;
    const float gamma = 1.0f - exp2f(-5.0f - (float)h);
    constexpr int TB = 2;
    float S[32];
#pragma unroll
    for (int i = 0; i < 32; ++i) S[i] = 0.f;
    for (int seg = 0; seg < 2; ++seg) {
        const int n = seg ? SEQL : LC, rowbase = seg ? b * SEQL : NLAT + b * LC; const bool wr_out = seg || ctx_out;
        for (int i0 = 0; i0 < n; i0 += TB) {
            u32x4 q[TB][4], k[TB][4]; bf16_t v[TB];
#pragma unroll
            for (int tb = 0; tb < TB; ++tb) { const int row = rowbase + (dir ? n - 1 - (i0 + tb) : i0 + tb); const bf16_t* pr = P + (size_t)row * LDP;
#pragma unroll
                for (int c4 = 0; c4 < 4; ++c4) { q[tb][c4] = ((const u32x4*)(pr + PC_RQ + h * 128 + dq * 32))[c4]; k[tb][c4] = ((const u32x4*)(pr + PC_RK + h * 128 + dq * 32))[c4]; }
                v[tb] = pr[PC_RV + h * 128 + e]; }
#pragma unroll
            for (int tb = 0; tb < TB; ++tb) {
                const int row = rowbase + (dir ? n - 1 - (i0 + tb) : i0 + tb);
                const float vf = bf2f(v[tb]); float o = 0.f;
#pragma unroll
                for (int c4 = 0; c4 < 4; ++c4) { float qf[8], kf[8]; unpack8(q[tb][c4], qf); unpack8(k[tb][c4], kf);
#pragma unroll
                    for (int x = 0; x < 8; ++x) { const int ix = c4 * 8 + x; S[ix] = gamma * S[ix] + kf[x] * vf; o += qf[x] * S[ix]; } }
                o += __shfl_xor(o, 16); o += __shfl_xor(o, 32);
                if (wr_out && dq == 0) O[(size_t)row * 512 + h * 128 + e] = (bf16_t)f2bf(o);
            }
        }
    }
}
__device__ __forceinline__ void gla_chain(const bf16_t* P, const bf16_t* GLGd, bf16_t* O, int b, int h, int dir, bool ctx_out, int wave, int lane) {
    const int e = wave * 16 + (lane & 15), dq = lane >> 4;
    constexpr int TB = 4;
    float S[16];
#pragma unroll
    for (int i = 0; i < 16; ++i) S[i] = 0.f;
    for (int seg = 0; seg < 2; ++seg) {
        const int n = seg ? SEQL : LC, rowbase = seg ? b * SEQL : NLAT + b * LC; const bool wr_out = seg || ctx_out;
        for (int i0 = 0; i0 < n; i0 += TB) {
            u32x4 q[TB][2], k[TB][2], g[TB][2]; bf16_t v[TB];
#pragma unroll
            for (int tb = 0; tb < TB; ++tb) { const int row = rowbase + (dir ? n - 1 - (i0 + tb) : i0 + tb); const bf16_t* pr = P + (size_t)row * LDP; const bf16_t* gr = GLGd + (size_t)row * 256 + h * 64 + dq * 16;
#pragma unroll
                for (int c4 = 0; c4 < 2; ++c4) { q[tb][c4] = ((const u32x4*)(pr + PC_GQ + h * 64 + dq * 16))[c4]; k[tb][c4] = ((const u32x4*)(pr + PC_GK + h * 64 + dq * 16))[c4]; g[tb][c4] = ((const u32x4*)gr)[c4]; }
                v[tb] = pr[PC_GV + h * 128 + e]; }
#pragma unroll
            for (int tb = 0; tb < TB; ++tb) {
                const int row = rowbase + (dir ? n - 1 - (i0 + tb) : i0 + tb);
                const float vf = bf2f(v[tb]); float o = 0.f;
#pragma unroll
                for (int c4 = 0; c4 < 2; ++c4) { float qf[8], kf[8], gf[8]; unpack8(q[tb][c4], qf); unpack8(k[tb][c4], kf); unpack8(g[tb][c4], gf);
#pragma unroll
                    for (int x = 0; x < 8; ++x) { const int ix = c4 * 8 + x; S[ix] = __expf(gf[x]) * S[ix] + kf[x] * vf; o += qf[x] * S[ix]; } }
                o += __shfl_xor(o, 16); o += __shfl_xor(o, 32);
                if (wr_out && dq == 0) O[(size_t)row * 512 + h * 128 + e] = (bf16_t)f2bf(o * 0.125f);
            }
        }
    }
}
__device__ __forceinline__ void s5_chain(const DArgs& a, unsigned char* ws, LAS unsigned char* lds, int l, int b, int g, int dir, bool ctx_out, int tid) {
    LAS f32x2* cs = (LAS f32x2*)lds; LAS f32x2* hs = (LAS f32x2*)(lds + 16 * 65 * 8); LAS float* us = (LAS float*)(lds + 2 * 16 * 65 * 8);
    const int wave = tid >> 6, lane = tid & 63;
    const int gi = (l * 2 + dir) * 32 + g;
    const float* cre = a.in[I_S5CRE] + (size_t)gi * 1024; const float* cim = a.in[I_S5CIM] + (size_t)gi * 1024;
    for (int idx = tid; idx < 1024; idx += NT) { const int i = idx >> 6, p = idx & 63; cs[i * 65 + p] = (f32x2){cre[idx], cim[idx]}; }
    f32x2 ab = {0.f, 0.f}; f32x2 bt[16]; f32x2 hst = {0.f, 0.f};
    if (wave == 0) { ab = ((const f32x2*)(ws + WS_S5AB))[gi * 64 + lane]; const f32x2* bp = (const f32x2*)(ws + WS_S5BT) + (size_t)(gi * 64 + lane) * 16;
#pragma unroll
        for (int i = 0; i < 16; ++i) bt[i] = bp[i]; }
    else {
#pragma unroll
        for (int i = 0; i < 16; ++i) bt[i] = (f32x2){0.f, 0.f}; }
    const bf16_t* P = (const bf16_t*)(ws + WS_P);
    bf16_t* Y = (bf16_t*)(ws + WS_OB) + (size_t)(4 + dir) * OBSZ;
    const int tt = tid >> 4, i = tid & 15;
    for (int seg = 0; seg < 2; ++seg) {
        const int n = seg ? SEQL : LC, rowbase = seg ? b * SEQL : NLAT + b * LC; const bool wr_out = seg || ctx_out;
        __syncthreads();
        if (tid < 256) us[tid] = bf2f(P[(size_t)(rowbase + (dir ? n - 1 - tt : tt)) * LDP + PC_S5U + g * 16 + i]);
        for (int bt0 = 0; bt0 < n; bt0 += 16) {
            const int ii = bt0 + tt; const int row = rowbase + (dir ? n - 1 - ii : ii);
            bf16_t unext = 0;
            if (tid < 256 && bt0 + 16 < n) { const int iin = ii + 16; unext = P[(size_t)(rowbase + (dir ? n - 1 - iin : iin)) * LDP + PC_S5U + g * 16 + i]; }
            __syncthreads();
            if (wave == 0) {
#pragma unroll 4
                for (int t2 = 0; t2 < 16; ++t2) {
                    float bur = 0.f, bui = 0.f;
#pragma unroll
                    for (int q = 0; q < 4; ++q) { const f32x4 u = ((const LAS f32x4*)(us + t2 * 16))[q];
                        bur += bt[4 * q].x * u.x + bt[4 * q + 1].x * u.y + bt[4 * q + 2].x * u.z + bt[4 * q + 3].x * u.w;
                        bui += bt[4 * q].y * u.x + bt[4 * q + 1].y * u.y + bt[4 * q + 2].y * u.z + bt[4 * q + 3].y * u.w; }
                    const float hr = ab.x * hst.x - ab.y * hst.y + bur, hi = ab.x * hst.y + ab.y * hst.x + bui;
                    hst = (f32x2){hr, hi};
                    hs[t2 * 65 + lane] = hst;
                }
            }
            __syncthreads();
            if (tid < 256) {
                us[tid] = bf2f(unext);
                float y = 0.f;
#pragma unroll 8
                for (int p = 0; p < 64; ++p) { const f32x2 cv = cs[i * 65 + p], hv = hs[tt * 65 + p]; y += cv.x * hv.x - cv.y * hv.y; }
                if (wr_out) Y[(size_t)row * 512 + g * 16 + i] = (bf16_t)f2bf(y);
            }
        }
    }
    __syncthreads();
}

__device__ __forceinline__ float sconv3(const bf16_t* p, int t, int Lx, float w0, float w1, float w2, float cb) {
    const float x0 = t > 0 ? bf2f(p[t - 1]) : 0.f, x1 = bf2f(p[t]), x2 = t < Lx - 1 ? bf2f(p[t + 1]) : 0.f;
    return w0 * x0 + w1 * x1 + w2 * x2 + cb;
}
__device__ __forceinline__ void hyena_item(const DArgs& a, unsigned char* ws, LAS unsigned char* lds, int l, int c, int tid) {
    LAS f32x2* X = (LAS f32x2*)lds; LAS f32x2* W = (LAS f32x2*)(lds + 65536);
    fft_twiddles(W, tid);
    const float* cw = a.in[I_HCW] + (size_t)l * 3 * 1536; const float* cbp = a.in[I_HCB] + (size_t)l * 1536;
    const float wv0 = cw[c], wv1 = cw[1536 + c], wv2 = cw[3072 + c], bv = cbp[c];
    const float wa0 = cw[512 + c], wa1 = cw[1536 + 512 + c], wa2 = cw[3072 + 512 + c], ba = cbp[512 + c];
    const float wb0 = cw[1024 + c], wb1 = cw[1536 + 1024 + c], wb2 = cw[3072 + 1024 + c], bb = cbp[1024 + c];
    const float bias0 = a.in[I_HBIAS][(l * 2 + 0) * 512 + c], bias1 = a.in[I_HBIAS][(l * 2 + 1) * 512 + c];
    const bf16_t* PT = (const bf16_t*)(ws + WS_PT);
    const bf16_t* pv = PT + (size_t)(PT_V + c) * MR; const bf16_t* pg1 = PT + (size_t)(PT_G1 + c) * MR; const bf16_t* pg2 = PT + (size_t)(PT_G2 + c) * MR; const bf16_t* phg = PT + (size_t)(PT_HG + c) * MR;
    const f32x2* KF0 = (const f32x2*)(ws + WS_KF) + (size_t)(0 * 512 + c) * FFTN; const f32x2* KF1 = (const f32x2*)(ws + WS_KF) + (size_t)(1 * 512 + c) * FFTN;
    bf16_t* GATED = (bf16_t*)(ws + WS_H);
    __syncthreads();
    for (int bp = 0; bp < 2; ++bp) {
        const int r0 = (2 * bp) * SEQL, r1 = (2 * bp + 1) * SEQL;
        float zr[8], zi[8];
#pragma unroll
        for (int j = 0; j < 8; ++j) { const int t = tid + 512 * j; zr[j] = sconv3(pv + r0, t, SEQL, wv0, wv1, wv2, bv); zi[j] = sconv3(pv + r1, t, SEQL, wv0, wv1, wv2, bv);
            X[t] = (f32x2){zr[j], zi[j]}; X[4096 + t] = (f32x2){0.f, 0.f}; if (j & 1) asm volatile("" ::: "memory"); }
        __syncthreads(); fft_forward(X, W, tid);
#pragma unroll 4
        for (int j = 0; j < 16; ++j) { const int pos = tid + 512 * j; const f32x2 x = X[pos], k = KF0[pos]; X[pos] = (f32x2){x.x * k.x - x.y * k.y, x.x * k.y + x.y * k.x}; }
        __syncthreads(); fft_inverse(X, W, tid);
#pragma unroll
        for (int j = 0; j < 8; ++j) { const int t = tid + 512 * j; const f32x2 cv = X[t] * (1.0f / 8192.0f);
            const float g1r = sconv3(pg1 + r0, t, SEQL, wa0, wa1, wa2, ba), g1i = sconv3(pg1 + r1, t, SEQL, wa0, wa1, wa2, ba);
            zr[j] = g1r * (cv.x + bias0 * zr[j]); zi[j] = g1i * (cv.y + bias0 * zi[j]); if (j & 1) asm volatile("" ::: "memory"); }
        __syncthreads();
#pragma unroll
        for (int j = 0; j < 8; ++j) { const int t = tid + 512 * j; X[t] = (f32x2){zr[j], zi[j]}; X[4096 + t] = (f32x2){0.f, 0.f}; }
        __syncthreads(); fft_forward(X, W, tid);
#pragma unroll 4
        for (int j = 0; j < 16; ++j) { const int pos = tid + 512 * j; const f32x2 x = X[pos], k = KF1[pos]; X[pos] = (f32x2){x.x * k.x - x.y * k.y, x.x * k.y + x.y * k.x}; }
        __syncthreads(); fft_inverse(X, W, tid);
#pragma unroll
        for (int j = 0; j < 8; ++j) { const int t = tid + 512 * j; const f32x2 cv = X[t] * (1.0f / 8192.0f);
            const float g2r = sconv3(pg2 + r0, t, SEQL, wb0, wb1, wb2, bb), g2i = sconv3(pg2 + r1, t, SEQL, wb0, wb1, wb2, bb);
            const float z2r = g2r * (cv.x + bias1 * zr[j]), z2i = g2i * (cv.y + bias1 * zi[j]);
            const float hg0 = bf2f(phg[r0 + t]), hg1 = bf2f(phg[r1 + t]);
            GATED[(size_t)(r0 + t) * D + 512 + c] = (bf16_t)f2bf(z2r * siluf_(hg0)); GATED[(size_t)(r1 + t) * D + 512 + c] = (bf16_t)f2bf(z2i * siluf_(hg1)); if (j & 1) asm volatile("" ::: "memory"); }
        __syncthreads();
    }
}
__device__ __forceinline__ void ctx_conv256(const LAS float* kc, const LAS float* z, int b, int t4, int half, float (&o)[4]) {
    o[0] = o[1] = o[2] = o[3] = 0.f;
#pragma unroll 4
    for (int s4 = 0; s4 < 32; ++s4) { const int s = 128 * half + 4 * s4, d = 4 * t4 - s;
        const f32x4 zv = *(const LAS f32x4*)(z + b * 256 + s);
        const f32x4 wl = *(const LAS f32x4*)(kc + ((d - 4) & 511)), wh = *(const LAS f32x4*)(kc + (d & 511));
        const float w[8] = {wl.x, wl.y, wl.z, wl.w, wh.x, wh.y, wh.z, wh.w};
        const float zz[4] = {zv.x, zv.y, zv.z, zv.w};
#pragma unroll
        for (int j = 0; j < 4; ++j)
#pragma unroll
            for (int i = 0; i < 4; ++i) o[j] += w[4 + j - i] * zz[i]; }
}
__device__ __forceinline__ void hyena_ctx_item(const DArgs& a, unsigned char* ws, LAS unsigned char* lds, int c, int tid) {
    LAS float* kc = (LAS float*)lds; LAS float* za = (LAS float*)(lds + 4096); LAS float* zb = (LAS float*)(lds + 8192); LAS float* part = (LAS float*)(lds + 12288);
    const float* KC = (const float*)(ws + WS_KC);
    kc[tid] = KC[(size_t)(0 * 512 + c) * 512 + tid]; kc[512 + tid] = KC[(size_t)(1 * 512 + c) * 512 + tid];
    const float* cw = a.in[I_HCW]; const float* cbp = a.in[I_HCB];
    const float wv0 = cw[c], wv1 = cw[1536 + c], wv2 = cw[3072 + c], bv = cbp[c];
    const float wa0 = cw[512 + c], wa1 = cw[1536 + 512 + c], wa2 = cw[3072 + 512 + c], ba = cbp[512 + c];
    const float wb0 = cw[1024 + c], wb1 = cw[1536 + 1024 + c], wb2 = cw[3072 + 1024 + c], bb = cbp[1024 + c];
    const float bias0 = a.in[I_HBIAS][0 * 512 + c], bias1 = a.in[I_HBIAS][1 * 512 + c];
    const bf16_t* PT = (const bf16_t*)(ws + WS_PT);
    const int half = tid >> 8, b = (tid >> 6) & 3, t4 = tid & 63; const int rb = NLAT + b * LC;
    const bf16_t* pv = PT + (size_t)(PT_V + c) * MR + rb; const bf16_t* pg1 = PT + (size_t)(PT_G1 + c) * MR + rb; const bf16_t* pg2 = PT + (size_t)(PT_G2 + c) * MR + rb; const bf16_t* phg = PT + (size_t)(PT_HG + c) * MR + rb;
    bf16_t* GATED = (bf16_t*)(ws + WS_H);
    float z0[4], z1[4], o[4];
#pragma unroll
    for (int j = 0; j < 4; ++j) { z0[j] = sconv3(pv, 4 * t4 + j, LC, wv0, wv1, wv2, bv); }
    if (half == 0) *(LAS f32x4*)(za + b * 256 + 4 * t4) = (f32x4){z0[0], z0[1], z0[2], z0[3]};
    __syncthreads();
    ctx_conv256(kc, za, b, t4, half, o);
    if (half == 1) *(LAS f32x4*)(part + b * 256 + 4 * t4) = (f32x4){o[0], o[1], o[2], o[3]};
    __syncthreads();
    if (half == 0) { const f32x4 pp = *(const LAS f32x4*)(part + b * 256 + 4 * t4); const float ps[4] = {pp.x, pp.y, pp.z, pp.w};
#pragma unroll
        for (int j = 0; j < 4; ++j) z1[j] = sconv3(pg1, 4 * t4 + j, LC, wa0, wa1, wa2, ba) * (o[j] + ps[j] + bias0 * z0[j]);
        *(LAS f32x4*)(zb + b * 256 + 4 * t4) = (f32x4){z1[0], z1[1], z1[2], z1[3]}; }
    __syncthreads();
    ctx_conv256(kc + 512, zb, b, t4, half, o);
    if (half == 1) *(LAS f32x4*)(part + b * 256 + 4 * t4) = (f32x4){o[0], o[1], o[2], o[3]};
    __syncthreads();
    if (half == 0) { const f32x4 pp = *(const LAS f32x4*)(part + b * 256 + 4 * t4); const float ps[4] = {pp.x, pp.y, pp.z, pp.w};
#pragma unroll
        for (int j = 0; j < 4; ++j) { const int t = 4 * t4 + j; const float z2 = sconv3(pg2, t, LC, wb0, wb1, wb2, bb) * (o[j] + ps[j] + bias1 * z1[j]);
            GATED[(size_t)(rb + t) * D + 512 + c] = (bf16_t)f2bf(z2 * siluf_(bf2f(phg[t]))); } }
    __syncthreads();
}

__device__ __forceinline__ void merge_row(const DArgs& a, unsigned char* ws, int l, int row, int lane) {
    const int col = 8 * lane;
    const bf16_t* OB = (const bf16_t*)(ws + WS_OB); const bf16_t* P = (const bf16_t*)(ws + WS_P) + (size_t)row * LDP;
    bf16_t* GATED = (bf16_t*)(ws + WS_H) + (size_t)row * D; bf16_t* G5 = (bf16_t*)(ws + WS_KF) + (size_t)row * 512;
    { float yf[8], yb[8], u[8], res[8];
      unpack8(*(const u32x4*)(OB + (size_t)4 * OBSZ + (size_t)row * 512 + col), yf); unpack8(*(const u32x4*)(OB + (size_t)5 * OBSZ + (size_t)row * 512 + col), yb);
      unpack8(*(const u32x4*)(P + PC_S5U + col), u);
      const float* dsk = a.in[I_S5D] + l * 512 + col;
#pragma unroll
      for (int x = 0; x < 8; ++x) res[x] = gelu_tanh(yf[x] + yb[x] + u[x] * dsk[x]);
      *(u32x4*)(G5 + col) = pack8(res); }
}

struct EpiInProj {
    static constexpr bool PERM = true, AFTER_DRAIN = false;
    bf16_t* P; bf16_t* PT; float* LR; const float* RT;
    __device__ __forceinline__ void operator()(const pg8::f32x4 (&acc)[2][2][4][2], const pg8::Unit& u, int wr, int wc, int fr, int fq) const {
        const int row0 = u.pm * 256 + wr * 64 + fr, pn = u.pn;
        if (pn >= 12 && pn < 16) {
            const int colbase = pn * 256 - 2048 + wc * 32 + 8 * fq; const int j0 = 4 * (4 * wc + fq); const float ksc = pn >= 14 ? 0.08838834764831845f : 1.0f;
#pragma unroll
            for (int ai = 0; ai < 2; ++ai)
#pragma unroll
                for (int m = 0; m < 4; ++m) { const int row = row0 + ai * 128 + m * 16; const int pos = row < NLAT ? (row & (SEQL - 1)) : SEQL + ((row - NLAT) & (LC - 1));
                    const pg8::f32x4 t0 = *(const pg8::f32x4*)(RT + ((size_t)pos * 64 + j0) * 2), t1 = *(const pg8::f32x4*)(RT + ((size_t)pos * 64 + j0) * 2 + 4);
                    bf16_t* rowp = P + (size_t)row * LDP + colbase;
#pragma unroll
                    for (int bj = 0; bj < 2; ++bj) { const pg8::f32x4 x1 = acc[ai][bj][m][0] * ksc, x2 = acc[ai][bj][m][1] * ksc;
                        u32x4 w; w.x = pk2(x1[0] * t0[0] - x2[0] * t0[1], x1[1] * t0[2] - x2[1] * t0[3]); w.y = pk2(x1[2] * t1[0] - x2[2] * t1[1], x1[3] * t1[2] - x2[3] * t1[3]);
                        w.z = pk2(x1[0] * t0[1] + x2[0] * t0[0], x1[1] * t0[3] + x2[1] * t0[2]); w.w = pk2(x1[2] * t1[1] + x2[2] * t1[0], x1[3] * t1[3] + x2[3] * t1[2]);
                        *(u32x4*)(rowp + bj * 128) = w; } }
        } else if (pn < 4 || (pn >= 16 && pn < 26)) {
            const int colbase = (pn < 4 ? pn * 256 : pn * 256 - 2048) + wc * 32 + 8 * fq;
#pragma unroll
            for (int ai = 0; ai < 2; ++ai)
#pragma unroll
                for (int m = 0; m < 4; ++m) { bf16_t* rowp = P + (size_t)(row0 + ai * 128 + m * 16) * LDP + colbase;
#pragma unroll
                    for (int bj = 0; bj < 2; ++bj) { const pg8::f32x4 v0 = acc[ai][bj][m][0], v1 = acc[ai][bj][m][1];
                        u32x4 w; w.x = pk2(v0[0], v0[1]); w.y = pk2(v0[2], v0[3]); w.z = pk2(v1[0], v1[1]); w.w = pk2(v1[2], v1[3]);
                        *(u32x4*)(rowp + bj * 128) = w; } }
        } else if (pn < 12) {
            const int colbase = (pn - 4) * 256 + wc * 32 + 8 * fq;
#pragma unroll
            for (int bj = 0; bj < 2; ++bj)
#pragma unroll
                for (int n = 0; n < 2; ++n)
#pragma unroll
                    for (int j = 0; j < 4; ++j) { bf16_t* cp = PT + (size_t)(colbase + bj * 128 + 4 * n + j) * MR + row0;
#pragma unroll
                        for (int ai = 0; ai < 2; ++ai)
#pragma unroll
                            for (int m = 0; m < 4; ++m) cp[ai * 128 + m * 16] = (bf16_t)f2bf(acc[ai][bj][m][n][j]);
                        asm volatile("" ::: "memory"); }
        } else {
            if (wc == 0) {
#pragma unroll
                for (int ai = 0; ai < 2; ++ai)
#pragma unroll
                    for (int m = 0; m < 4; ++m) { float* rowp = LR + (size_t)(row0 + ai * 128 + m * 16) * 32 + 8 * fq;
                        *(pg8::f32x4*)(rowp) = acc[ai][0][m][0]; *(pg8::f32x4*)(rowp + 4) = acc[ai][0][m][1]; }
            }
        }
    }
};
struct EpiGlu {
    static constexpr bool PERM = true, AFTER_DRAIN = false;
    const bf16_t* GG; bf16_t* GATED; const float* bias;
    __device__ __forceinline__ void operator()(const pg8::f32x4 (&acc)[2][2][4][2], const pg8::Unit& u, int wr, int wc, int fr, int fq) const {
        const int row0 = u.pm * 256 + wr * 64 + fr, col0 = u.pn * 256 + wc * 32 + 8 * fq;
        pg8::f32x4 b0[2], b1[2];
#pragma unroll
        for (int bj = 0; bj < 2; ++bj) { b0[bj] = *(const pg8::f32x4*)(bias + col0 + bj * 128); b1[bj] = *(const pg8::f32x4*)(bias + col0 + bj * 128 + 4); }
#pragma unroll
        for (int ai = 0; ai < 2; ++ai) {
            u32x4 gg[4][2];
#pragma unroll
            for (int m = 0; m < 4; ++m)
#pragma unroll
                for (int bj = 0; bj < 2; ++bj) gg[m][bj] = *(const u32x4*)(GG + (size_t)(row0 + ai * 128 + m * 16) * 512 + col0 + bj * 128);
#pragma unroll
            for (int m = 0; m < 4; ++m) { const size_t row = (size_t)(row0 + ai * 128 + m * 16);
#pragma unroll
                for (int bj = 0; bj < 2; ++bj) { float g[8], res[8]; unpack8(gg[m][bj], g);
#pragma unroll
                    for (int j = 0; j < 4; ++j) { res[j] = g[j] * sigmoidf_(acc[ai][bj][m][0][j] + b0[bj][j]); res[4 + j] = g[4 + j] * sigmoidf_(acc[ai][bj][m][1][j] + b1[bj][j]); }
                    *(u32x4*)(GATED + row * D + col0 + bj * 128) = pack8(res); } }
            asm volatile("" ::: "memory");
        }
    }
};
struct EpiOut {
    static constexpr bool PERM = false, AFTER_DRAIN = false;
    const float* xl_old; const float* xc_old; float* xl_new; float* xc_new; const float* mod;
    __device__ __forceinline__ void operator()(const pg8::f32x4 (&acc)[2][2][4][2], const pg8::Unit& u, int wr, int wc, int fr, int fq) const {
        const int row0 = u.pm * 256 + wr * 64 + fr, col0 = u.pn * 256 + wc * 32 + 4 * fq;
        const bool lat = u.pm < 64;
        const float* xo = lat ? xl_old : xc_old - (size_t)NLAT * D; float* xn = lat ? xl_new : xc_new - (size_t)NLAT * D;
#pragma unroll
        for (int ai = 0; ai < 2; ++ai) {
            const int v = lat ? ((u.pm * 256 + ai * 128) >> 12) : 4;
            const float* gt = mod + (size_t)v * ADA + 2 * D;
#pragma unroll
            for (int m = 0; m < 4; ++m) { const size_t off = (size_t)(row0 + ai * 128 + m * 16) * D + col0;
#pragma unroll
                for (int bj = 0; bj < 2; ++bj)
#pragma unroll
                    for (int n = 0; n < 2; ++n) { const int cc = bj * 128 + n * 16; const pg8::f32x4 gv = *(const pg8::f32x4*)(gt + col0 + cc), xv = *(const pg8::f32x4*)(xo + off + cc);
                        *(pg8::f32x4*)(xn + off + cc) = xv + gv * acc[ai][bj][m][n]; } }
        }
    }
};
typedef short bf16x8 __attribute__((ext_vector_type(8)));
typedef short bf16x4 __attribute__((ext_vector_type(4)));
__device__ __forceinline__ unsigned off_b(unsigned row, unsigned ch) { return 256u * row + 16u * (ch ^ (((row & 3) << 2) | ((row >> 2) & 3))); }
__device__ __forceinline__ bf16x8 img_row_frag(const LAS unsigned char* img, unsigned lane, unsigned rb, unsigned s) { return *(const LAS bf16x8*)(img + off_b((lane & 15) + 16 * rb, 4 * s + (lane >> 4))); }
__device__ __forceinline__ bf16x4 img_tr4(const LAS unsigned char* img, unsigned lane, unsigned c, unsigned row0) {
    const unsigned q = (lane & 15) >> 2, p = lane & 3;
    return __builtin_amdgcn_ds_read_tr16_b64_v4i16((LAS bf16x4*)(img + off_b(row0 + q, 2 * c + (p >> 1)) + 8 * (p & 1)));
}
__device__ __forceinline__ bf16x8 img_tr_frag(const LAS unsigned char* img, unsigned lane, unsigned c, unsigned ks) {
    const unsigned g = lane >> 4; const bf16x4 lo = img_tr4(img, lane, c, 32 * ks + 8 * g), hi = img_tr4(img, lane, c, 32 * ks + 8 * g + 4);
    return __builtin_shufflevector(lo, hi, 0, 1, 2, 3, 4, 5, 6, 7);
}
__device__ __forceinline__ bf16x8 img_tr_frag_acc(const LAS unsigned char* img, unsigned lane, unsigned c, unsigned ks) {
    const unsigned g = lane >> 4; const bf16x4 lo = img_tr4(img, lane, c, 32 * ks + 4 * g), hi = img_tr4(img, lane, c, 32 * ks + 16 + 4 * g);
    return __builtin_shufflevector(lo, hi, 0, 1, 2, 3, 4, 5, 6, 7);
}
__device__ __forceinline__ bf16x8 acc_pair_frag(const f32x4 a0, const f32x4 a1) {
    u32x4 w; w.x = pk2(a0.x, a0.y); w.y = pk2(a0.z, a0.w); w.z = pk2(a1.x, a1.y); w.w = pk2(a1.z, a1.w);
    return __builtin_bit_cast(bf16x8, w);
}
#define MFMA16(A_, B_, C_) __builtin_amdgcn_mfma_f32_16x16x32_bf16((A_), (B_), (C_), 0, 0, 0)
__device__ __forceinline__ void stage_tile128(LAS unsigned char* img, const bf16_t* g, size_t ld, int tid) {
#pragma unroll
    for (int i = 0; i < 4; ++i) { const int n = tid + NT * i, row = n >> 4, ch = n & 15; *(LAS u32x4*)(img + off_b(row, ch)) = *(const u32x4*)(g + (size_t)row * ld + ch * 8); }
}

constexpr int RCH = 128, RNCH = 34;
constexpr size_t WS_RST = WS_OB;
__device__ __forceinline__ int ret_rowbase(int b, int cc) { return cc < 2 ? NLAT + b * LC + cc * RCH : b * SEQL + (cc - 2) * RCH; }
__device__ __forceinline__ float ret_log2g(int h) { return log2f(1.0f - exp2f(-5.0f - (float)h)); }

__device__ __forceinline__ void ret_passA(unsigned char* ws, LAS unsigned char* lds, int item, int tid) {
    const int bh = item / RNCH, cc = item % RNCH, b = bh >> 2, h = bh & 3;
    const int lane = tid & 63, w = tid >> 6, g = lane >> 4;
    LAS unsigned char* KF = lds; LAS unsigned char* KB = lds + 32768; LAS unsigned char* VI = lds + 65536;
    const bf16_t* P = (const bf16_t*)(ws + WS_P) + (size_t)ret_rowbase(b, cc) * LDP;
    const float l2g = ret_log2g(h);
    __syncthreads();
#pragma unroll
    for (int i = 0; i < 4; ++i) { const int n = tid + NT * i, row = n >> 4, ch = n & 15;
        const u32x4 kr = *(const u32x4*)(P + (size_t)row * LDP + PC_RK + h * 128 + ch * 8);
        float kf[8], a[8], c[8]; unpack8(kr, kf);
        const float sf = exp2f(l2g * (float)(RCH - 1 - row)), sb = exp2f(l2g * (float)row);
#pragma unroll
        for (int x = 0; x < 8; ++x) { a[x] = kf[x] * sf; c[x] = kf[x] * sb; }
        *(LAS u32x4*)(KF + off_b(row, ch)) = pack8(a); *(LAS u32x4*)(KB + off_b(row, ch)) = pack8(c);
        *(LAS u32x4*)(VI + off_b(row, ch)) = *(const u32x4*)(P + (size_t)row * LDP + PC_RV + h * 128 + ch * 8); }
    __syncthreads();
    bf16x8 af[4], ab[4];
#pragma unroll
    for (int ks = 0; ks < 4; ++ks) { af[ks] = img_tr_frag(KF, lane, w, ks); ab[ks] = img_tr_frag(KB, lane, w, ks); }
    bf16_t* ST = (bf16_t*)(ws + WS_RST) + ((size_t)(bh * 2) * RNCH + cc) * (128 * 128);
#pragma unroll 2
    for (int E = 0; E < 8; ++E) {
        f32x4 cf = {0.f, 0.f, 0.f, 0.f}, cb = {0.f, 0.f, 0.f, 0.f};
#pragma unroll
        for (int ks = 0; ks < 4; ++ks) { const bf16x8 vb = img_tr_frag(VI, lane, E, ks); cf = MFMA16(af[ks], vb, cf); cb = MFMA16(ab[ks], vb, cb); }
        const int e = 16 * E + (lane & 15), d0 = 16 * w + 4 * g;
        u32x2 o; o.x = pk2(cf.x, cf.y); o.y = pk2(cf.z, cf.w); *(u32x2*)(ST + (size_t)e * 128 + d0) = o;
        o.x = pk2(cb.x, cb.y); o.y = pk2(cb.z, cb.w); *(u32x2*)(ST + (size_t)RNCH * 128 * 128 + (size_t)e * 128 + d0) = o;
    }
}
__device__ __forceinline__ void ret_passB(unsigned char* ws, int gt  ) {
    const int el = gt & 2047, bd = gt >> 11, bh = bd >> 1, dir = bd & 1, h = bh & 3;
    const float gC = exp2f(ret_log2g(h) * (float)RCH);
    bf16_t* base = (bf16_t*)(ws + WS_RST) + (size_t)bd * RNCH * (128 * 128) + (size_t)el * 8;
    float acc[8];
#pragma unroll
    for (int x = 0; x < 8; ++x) acc[x] = 0.f;
#pragma unroll 1
    for (int s0 = 0; s0 < RNCH; s0 += 17) {
        u32x4 kvr[17];
#pragma unroll
        for (int j = 0; j < 17; ++j) { const int s = s0 + j; const int cc = dir == 0 ? s : (s < 2 ? 1 - s : 35 - s); kvr[j] = *(const u32x4*)(base + (size_t)cc * (128 * 128)); }
#pragma unroll
        for (int j = 0; j < 17; ++j) { const int s = s0 + j; const int cc = dir == 0 ? s : (s < 2 ? 1 - s : 35 - s);
            float kv[8]; unpack8(kvr[j], kv);
            *(u32x4*)(base + (size_t)cc * (128 * 128)) = pack8(acc);
#pragma unroll
            for (int x = 0; x < 8; ++x) acc[x] = gC * acc[x] + kv[x]; }
    }
}
__device__ __forceinline__ void ret_passC(const DArgs& a, unsigned char* ws, LAS unsigned char* lds, int l, int item, int tid) {
    const int bh = item / RNCH, cc = item % RNCH, b = bh >> 2, h = bh & 3;
    const int lane = tid & 63, w = tid >> 6, g = lane >> 4, il = lane & 15;
    LAS unsigned char* KI = lds; LAS unsigned char* VI = lds + 32768; LAS unsigned char* SF = lds + 65536; LAS unsigned char* SB = lds + 98304;
    const int rowbase = ret_rowbase(b, cc);
    const bf16_t* P = (const bf16_t*)(ws + WS_P) + (size_t)rowbase * LDP;
    const bf16_t* STf = (const bf16_t*)(ws + WS_RST) + ((size_t)(bh * 2) * RNCH + cc) * (128 * 128);
    const bf16_t* STb = STf + (size_t)RNCH * 128 * 128;
    __syncthreads();
    stage_tile128(KI, P + PC_RK + h * 128, LDP, tid); stage_tile128(VI, P + PC_RV + h * 128, LDP, tid);
    stage_tile128(SF, STf, 128, tid); stage_tile128(SB, STb, 128, tid);
    bf16x8 qf[4];
    { const bf16_t* qr = P + (size_t)(16 * w + il) * LDP + PC_RQ + h * 128 + 8 * g;
#pragma unroll
      for (int ks = 0; ks < 4; ++ks) qf[ks] = *(const bf16x8*)(qr + 32 * ks); }
    __syncthreads();
    const float l2g = ret_log2g(h);
    const int iloc = 16 * w + il;
    f32x4 o[8];
    { const float sf = exp2f(l2g * (float)(iloc + 1)), sb = exp2f(l2g * (float)(RCH - iloc));
#pragma unroll
      for (int E = 0; E < 8; ++E) { f32x4 rf = {0.f, 0.f, 0.f, 0.f}, rb = {0.f, 0.f, 0.f, 0.f};
#pragma unroll
          for (int ks = 0; ks < 4; ++ks) { rf = MFMA16(img_row_frag(SF, lane, E, ks), qf[ks], rf); rb = MFMA16(img_row_frag(SB, lane, E, ks), qf[ks], rb); }
          o[E] = rf * sf + rb * sb; } }
    f32x4 at[8];
#pragma unroll
    for (int T = 0; T < 8; ++T) { f32x4 c = {0.f, 0.f, 0.f, 0.f};
#pragma unroll
        for (int ks = 0; ks < 4; ++ks) c = MFMA16(img_row_frag(KI, lane, T, ks), qf[ks], c);
#pragma unroll
        for (int r = 0; r < 4; ++r) { const int j = 16 * T + 4 * g + r; const int dd = iloc > j ? iloc - j : j - iloc; c[r] *= (dd == 0 ? 2.0f : exp2f(l2g * (float)dd)); }
        at[T] = c; }
#pragma unroll
    for (int s = 0; s < 4; ++s) { const bf16x8 bfr = acc_pair_frag(at[2 * s], at[2 * s + 1]);
#pragma unroll
        for (int E = 0; E < 8; ++E) o[E] = MFMA16(img_tr_frag_acc(VI, lane, E, s), bfr, o[E]); }
    float ss = 0.f;
#pragma unroll
    for (int E = 0; E < 8; ++E) ss += (o[E].x * o[E].x + o[E].y * o[E].y) + (o[E].z * o[E].z + o[E].w * o[E].w);
    ss += __shfl_xor(ss, 16); ss += __shfl_xor(ss, 32);
    const float rn = rsqrtf(ss * (1.0f / 128.0f) + EPS);
    const size_t row = (size_t)rowbase + iloc;
    const bf16_t* gp = (const bf16_t*)(ws + WS_P) + row * LDP + PC_RG + h * 128 + 4 * g;
    const float* nw = a.in[I_RNW] + l * 512 + h * 128 + 4 * g;
    bf16_t* op = (bf16_t*)(ws + WS_H) + row * D + 1024 + h * 128 + 4 * g;
#pragma unroll
    for (int E = 0; E < 8; ++E) { const u32x2 gr = *(const u32x2*)(gp + 16 * E); const f32x4 nv = *(const f32x4*)(nw + 16 * E);
        u32x2 ov; ov.x = pk2(o[E].x * rn * nv.x * siluf_(bflo(gr.x)), o[E].y * rn * nv.y * siluf_(bfhi(gr.x)));
        ov.y = pk2(o[E].z * rn * nv.z * siluf_(bflo(gr.y)), o[E].w * rn * nv.w * siluf_(bfhi(gr.y)));
        *(u32x2*)(op + 16 * E) = ov; }
}
constexpr int GCH = 64, GNCH = 68;
constexpr size_t WS_GST = WS_OB + (size_t)2 * OBSZ * 2;
constexpr size_t WS_GDEC = WS_END;
constexpr size_t WS_H3B = WS_GDEC + (size_t)16 * 2 * GNCH * 64 * 4;
constexpr size_t WS_ROPE = WS_H3B + (size_t)2 * 4096 * 64 * 2;
constexpr size_t WS_TWID = WS_ROPE + (size_t)(SEQL + LC) * 64 * 8;
constexpr size_t WS_END2 = WS_TWID + 4096 * 8;
__device__ __forceinline__ int gla_rowbase(int b, int cg) { return cg < 4 ? NLAT + b * LC + cg * GCH : b * SEQL + (cg - 4) * GCH; }

constexpr int GLS = 68;
__device__ __forceinline__ void gla_gates_compute(const DArgs& a, unsigned char* ws, LAS float* BF, LAS float* BB, LAS float* GW  , int l, int h, int rowbase, int tid) {
    const int t = tid >> 3, d8 = tid & 7;
    const float* lr = (const float*)(ws + WS_LR) + (size_t)(rowbase + t) * 32;
    f32x4 lv[8];
#pragma unroll
    for (int q = 0; q < 8; ++q) lv[q] = ((const f32x4*)lr)[q];
    { const int dir = tid >> 8, r = (tid >> 4) & 15, c4 = (tid & 15) * 4;
      *(LAS f32x4*)(GW + (dir * 17 + r) * 64 + c4) = *(const f32x4*)(a.in[I_GGW] + (size_t)(l * 2 + dir) * 16 * 256 + r * 256 + h * 64 + c4);
      if (tid < 32) { const int dd = tid >> 4; *(LAS f32x4*)(GW + (dd * 17 + 16) * 64 + c4) = *(const f32x4*)(a.in[I_GGB] + (size_t)(l * 2 + dd) * 256 + h * 64 + c4); } }
    __syncthreads();
    bf16_t* GLG = (bf16_t*)(ws + WS_WIN);
#pragma unroll
    for (int dir = 0; dir < 2; ++dir) {
        const LAS float* gw = GW + dir * 17 * 64 + 8 * d8;
        f32x4 s0 = *(const LAS f32x4*)(gw + 16 * 64), s1 = *(const LAS f32x4*)(gw + 16 * 64 + 4);
#pragma unroll
        for (int j = 0; j < 16; ++j) { const float lj = lv[dir * 4 + (j >> 2)][j & 3]; s0 += lj * *(const LAS f32x4*)(gw + j * 64); s1 += lj * *(const LAS f32x4*)(gw + j * 64 + 4); }
        LAS float* dst = (dir ? BB : BF) + t * GLS + 8 * d8;
        float la[8];
#pragma unroll
        for (int x = 0; x < 8; ++x) { const float s = x < 4 ? s0[x] : s1[x - 4]; const float e = __expf(-fabsf(s)); const float ls = fminf(s, 0.f) - __logf(1.0f + e); la[x] = ls * (1.0f / 16.0f); }
        const u32x4 pk = pack8(la);
        *(u32x4*)(GLG + ((size_t)dir * MR + rowbase + t) * 256 + h * 64 + 8 * d8) = pk;
        float lq[8]; unpack8(pk, lq);
        *(LAS f32x4*)dst = (f32x4){lq[0], lq[1], lq[2], lq[3]}; *(LAS f32x4*)(dst + 4) = (f32x4){lq[4], lq[5], lq[6], lq[7]};
    }
}
__device__ __forceinline__ void gla_gates_load(unsigned char* ws, LAS float* BF, LAS float* BB, int h, int rowbase, int tid) {
    const int t = tid >> 3, d8 = tid & 7;
    const bf16_t* GLG = (const bf16_t*)(ws + WS_WIN);
#pragma unroll
    for (int dir = 0; dir < 2; ++dir) { float lq[8]; unpack8(*(const u32x4*)(GLG + ((size_t)dir * MR + rowbase + t) * 256 + h * 64 + 8 * d8), lq);
        LAS float* dst = (dir ? BB : BF) + t * GLS + 8 * d8;
        *(LAS f32x4*)dst = (f32x4){lq[0], lq[1], lq[2], lq[3]}; *(LAS f32x4*)(dst + 4) = (f32x4){lq[4], lq[5], lq[6], lq[7]}; }
}
__device__ __forceinline__ void gla_scan(LAS float* BF, LAS float* BB, int tid) {
    const int lane = tid & 63, w = tid >> 6;
    __syncthreads();
#pragma unroll 4
    for (int c = 0; c < 16; ++c) { const int col = 16 * w + c; const int dir = col >> 6, d = col & 63;
        LAS float* p = (dir ? BB : BF) + (dir ? 63 - lane : lane) * GLS + d;
        float v = *p;
#pragma unroll
        for (int off = 1; off < 64; off <<= 1) { const float u = __shfl_up(v, off); if (lane >= off) v += u; }
        *p = v; }
    __syncthreads();
}

__device__ __forceinline__ void gla_passA(const DArgs& a, unsigned char* ws, LAS unsigned char* lds, int l, int item, int tid) {
    const int bh = item / GNCH, cg = item % GNCH, b = bh >> 2, h = bh & 3;
    const int lane = tid & 63, w = tid >> 6, g = lane >> 4;
    LAS float* BF = (LAS float*)lds; LAS float* BB = (LAS float*)(lds + 17408); LAS unsigned char* KH = lds + 34816; LAS unsigned char* VI = lds + 34816 + 16384;
    const int rowbase = gla_rowbase(b, cg);
    const bf16_t* P = (const bf16_t*)(ws + WS_P) + (size_t)rowbase * LDP;
    const int t = tid >> 3, d8 = tid & 7;
    const u32x4 kraw = *(const u32x4*)(P + (size_t)t * LDP + PC_GK + h * 64 + 8 * d8);
    u32x4 vraw[2];
#pragma unroll
    for (int i = 0; i < 2; ++i) { const int n = tid + NT * i; vraw[i] = *(const u32x4*)(P + (size_t)(n >> 4) * LDP + PC_GV + h * 128 + (n & 15) * 8); }
    gla_gates_compute(a, ws, BF, BB, (LAS float*)(lds + 34816 + 32768), l, h, rowbase, tid);
    gla_scan(BF, BB, tid);
    { float kf[8], x0[8], x1[8]; unpack8(kraw, kf);
#pragma unroll
      for (int x = 0; x < 8; ++x) { const int d = 8 * d8 + x; x0[x] = kf[x] * __expf(BF[63 * GLS + d] - BF[t * GLS + d]); x1[x] = kf[x] * __expf(BB[d] - BB[t * GLS + d]); }
      *(LAS u32x4*)(KH + off_b(t, d8)) = pack8(x0); *(LAS u32x4*)(KH + off_b(t, 8 + d8)) = pack8(x1);
#pragma unroll
      for (int i = 0; i < 2; ++i) { const int n = tid + NT * i; *(LAS u32x4*)(VI + off_b(n >> 4, n & 15)) = vraw[i]; }
      if (tid < 128) { const int dir = tid >> 6, d = tid & 63; ((float*)(ws + WS_GDEC))[((size_t)(bh * 2 + dir) * GNCH + cg) * 64 + d] = __expf(dir ? BB[d] : BF[63 * GLS + d]); } }
    __syncthreads();
    const int dir = w >> 2, Dt = w & 3;
    bf16x8 af[2];
#pragma unroll
    for (int ks = 0; ks < 2; ++ks) af[ks] = img_tr_frag(KH, lane, dir * 4 + Dt, ks);
    bf16_t* ST = (bf16_t*)(ws + WS_GST) + ((size_t)(bh * 2 + dir) * GNCH + cg) * (128 * 64);
#pragma unroll 2
    for (int E = 0; E < 8; ++E) {
        f32x4 c = {0.f, 0.f, 0.f, 0.f};
#pragma unroll
        for (int ks = 0; ks < 2; ++ks) c = MFMA16(af[ks], img_tr_frag(VI, lane, E, ks), c);
        u32x2 o; o.x = pk2(c.x, c.y); o.y = pk2(c.z, c.w);
        *(u32x2*)(ST + (size_t)(16 * E + (lane & 15)) * 64 + 16 * Dt + 4 * g) = o;
    }
}
__device__ __forceinline__ void gla_passB(unsigned char* ws, LAS unsigned char* lds, int blk, int tid) {
    const int bd = blk >> 1, dir = bd & 1, el = (blk & 1) * 512 + tid;
    LAS float* decs = (LAS float*)lds;
    { const float* dsrc = (const float*)(ws + WS_GDEC) + (size_t)bd * GNCH * 64;
      for (int i = tid; i < GNCH * 64; i += NT) decs[i] = dsrc[i]; }
    __syncthreads();
    bf16_t* base = (bf16_t*)(ws + WS_GST) + (size_t)bd * GNCH * (128 * 64) + (size_t)el * 8;
    const int d0 = (el & 7) * 8;
    float acc[8];
#pragma unroll
    for (int x = 0; x < 8; ++x) acc[x] = 0.f;
#pragma unroll 1
    for (int s0 = 0; s0 < GNCH; s0 += 17) {
        u32x4 kvr[17];
#pragma unroll
        for (int j = 0; j < 17; ++j) { const int s = s0 + j; const int cg = dir == 0 ? s : (s < 4 ? 3 - s : 71 - s); kvr[j] = *(const u32x4*)(base + (size_t)cg * (128 * 64)); }
#pragma unroll
        for (int j = 0; j < 17; ++j) { const int s = s0 + j; const int cg = dir == 0 ? s : (s < 4 ? 3 - s : 71 - s);
            float kv[8]; unpack8(kvr[j], kv);
            const f32x4 q0 = *(const LAS f32x4*)(decs + cg * 64 + d0), q1 = *(const LAS f32x4*)(decs + cg * 64 + d0 + 4);
            *(u32x4*)(base + (size_t)cg * (128 * 64)) = pack8(acc);
#pragma unroll
            for (int x = 0; x < 8; ++x) acc[x] = (x < 4 ? q0[x] : q1[x - 4]) * acc[x] + kv[x]; }
    }
    __syncthreads();
}
__device__ __forceinline__ void gla_passC(const DArgs& a, unsigned char* ws, LAS unsigned char* lds, int l, int item, int tid) {
    const int bh = item / GNCH, cg = item % GNCH, b = bh >> 2, h = bh & 3;
    const int lane = tid & 63, w = tid >> 6, g = lane >> 4, il = lane & 15;
    LAS float* BF = (LAS float*)lds; LAS float* BB = (LAS float*)(lds + 17408);
    LAS unsigned char* QKF = lds + 34816; LAS unsigned char* QKB = QKF + 16384; LAS unsigned char* QH = QKB + 16384; LAS unsigned char* VI = QH + 16384; LAS unsigned char* SI = VI + 16384;
    const int rowbase = gla_rowbase(b, cg);
    const bf16_t* P = (const bf16_t*)(ws + WS_P) + (size_t)rowbase * LDP;
    const int t = tid >> 3, d8 = tid & 7;
    const u32x4 qraw = *(const u32x4*)(P + (size_t)t * LDP + PC_GQ + h * 64 + 8 * d8), kraw = *(const u32x4*)(P + (size_t)t * LDP + PC_GK + h * 64 + 8 * d8);
    u32x4 vraw[2], sraw[4];
#pragma unroll
    for (int i = 0; i < 2; ++i) { const int n = tid + NT * i; vraw[i] = *(const u32x4*)(P + (size_t)(n >> 4) * LDP + PC_GV + h * 128 + (n & 15) * 8); }
    { const bf16_t* STf = (const bf16_t*)(ws + WS_GST) + ((size_t)(bh * 2) * GNCH + cg) * (128 * 64); const bf16_t* STb = STf + (size_t)GNCH * 128 * 64;
#pragma unroll
      for (int i = 0; i < 4; ++i) { const int n = tid + NT * i, row = n >> 4, ch = n & 15; sraw[i] = *(const u32x4*)((ch < 8 ? STf : STb) + (size_t)row * 64 + (ch & 7) * 8); } }
    gla_gates_load(ws, BF, BB, h, rowbase, tid);
    gla_scan(BF, BB, tid);
    { float qf[8], kf[8], o0[8], o1[8], o2[8], o3[8], o4[8], o5[8];
      unpack8(qraw, qf); unpack8(kraw, kf);
#pragma unroll
      for (int x = 0; x < 8; ++x) { const int d = 8 * d8 + x; const float bf = BF[t * GLS + d], bb = BB[t * GLS + d], rf = BF[31 * GLS + d], rb = BB[32 * GLS + d]; const float q = qf[x] * 0.125f;
          o0[x] = q * __expf(bf - rf); o1[x] = kf[x] * __expf(rf - bf); o2[x] = q * __expf(bb - rb); o3[x] = kf[x] * __expf(rb - bb); o4[x] = q * __expf(bf); o5[x] = q * __expf(bb); }
      *(LAS u32x4*)(QKF + off_b(t, d8)) = pack8(o0); *(LAS u32x4*)(QKF + off_b(t, 8 + d8)) = pack8(o1);
      *(LAS u32x4*)(QKB + off_b(t, d8)) = pack8(o2); *(LAS u32x4*)(QKB + off_b(t, 8 + d8)) = pack8(o3);
      *(LAS u32x4*)(QH + off_b(t, d8)) = pack8(o4); *(LAS u32x4*)(QH + off_b(t, 8 + d8)) = pack8(o5);
#pragma unroll
      for (int i = 0; i < 2; ++i) { const int n = tid + NT * i; *(LAS u32x4*)(VI + off_b(n >> 4, n & 15)) = vraw[i]; }
#pragma unroll
      for (int i = 0; i < 4; ++i) { const int n = tid + NT * i; *(LAS u32x4*)(SI + off_b(n >> 4, n & 15)) = sraw[i]; } }
    __syncthreads();
    const int ib = w & 3, eh = w >> 2, iloc = 16 * ib + il;
    f32x4 at[4];
    { bf16x8 qff[2], qfb[2];
#pragma unroll
      for (int ks = 0; ks < 2; ++ks) { qff[ks] = img_row_frag(QKF, lane, ib, ks); qfb[ks] = img_row_frag(QKB, lane, ib, ks); }
#pragma unroll
      for (int T = 0; T < 4; ++T) { f32x4 cf = {0.f, 0.f, 0.f, 0.f}, cb = {0.f, 0.f, 0.f, 0.f};
#pragma unroll
          for (int ks = 0; ks < 2; ++ks) { cf = MFMA16(img_row_frag(QKF, lane, T, 2 + ks), qff[ks], cf); cb = MFMA16(img_row_frag(QKB, lane, T, 2 + ks), qfb[ks], cb); }
#pragma unroll
          for (int r = 0; r < 4; ++r) { const int j = 16 * T + 4 * g + r; cf[r] = (j <= iloc ? cf[r] : 0.f) + (j >= iloc ? cb[r] : 0.f); }
          at[T] = cf; } }
    f32x4 o[4];
    { bf16x8 hf[2], hb[2];
#pragma unroll
      for (int ks = 0; ks < 2; ++ks) { hf[ks] = img_row_frag(QH, lane, ib, ks); hb[ks] = img_row_frag(QH, lane, ib, 2 + ks); }
#pragma unroll
      for (int E4 = 0; E4 < 4; ++E4) { const int E = 4 * eh + E4; f32x4 c = {0.f, 0.f, 0.f, 0.f};
#pragma unroll
          for (int ks = 0; ks < 2; ++ks) { c = MFMA16(img_row_frag(SI, lane, E, ks), hf[ks], c); c = MFMA16(img_row_frag(SI, lane, E, 2 + ks), hb[ks], c); }
          o[E4] = c; } }
#pragma unroll
    for (int s = 0; s < 2; ++s) { const bf16x8 bfr = acc_pair_frag(at[2 * s], at[2 * s + 1]);
#pragma unroll
        for (int E4 = 0; E4 < 4; ++E4) o[E4] = MFMA16(img_tr_frag_acc(VI, lane, 4 * eh + E4, s), bfr, o[E4]); }
    float ss = 0.f;
#pragma unroll
    for (int E4 = 0; E4 < 4; ++E4) ss += (o[E4].x * o[E4].x + o[E4].y * o[E4].y) + (o[E4].z * o[E4].z + o[E4].w * o[E4].w);
    ss += __shfl_xor(ss, 16); ss += __shfl_xor(ss, 32);
    LAS float* red = (LAS float*)lds;
    if (g == 0) red[eh * 64 + iloc] = ss;
    __syncthreads();
    const float rn = rsqrtf((red[iloc] + red[64 + iloc]) * (1.0f / 128.0f) + EPS);
    const size_t row = (size_t)rowbase + iloc;
    const bf16_t* gp = (const bf16_t*)(ws + WS_P) + row * LDP + PC_GG + h * 128 + 64 * eh + 4 * g;
    const float* nw = a.in[I_GNW] + l * 512 + h * 128 + 64 * eh + 4 * g;
    bf16_t* op = (bf16_t*)(ws + WS_H) + row * D + 1536 + h * 128 + 64 * eh + 4 * g;
#pragma unroll
    for (int E4 = 0; E4 < 4; ++E4) { const u32x2 gr = *(const u32x2*)(gp + 16 * E4); const f32x4 nv = *(const f32x4*)(nw + 16 * E4);
        u32x2 ov; ov.x = pk2(o[E4].x * rn * nv.x * siluf_(bflo(gr.x)), o[E4].y * rn * nv.y * siluf_(bfhi(gr.x)));
        ov.y = pk2(o[E4].z * rn * nv.z * siluf_(bflo(gr.y)), o[E4].w * rn * nv.w * siluf_(bfhi(gr.y)));
        *(u32x2*)(op + 16 * E4) = ov; }
}
constexpr int SNCH = 68;
constexpr size_t WS_S5ST = WS_OB + (size_t)4 * OBSZ * 2;
constexpr size_t WS_S5BTB = WS_S5BT;
constexpr size_t WS_S5CPB = WS_S5BT + 524288;
constexpr size_t WS_S5A64 = WS_S5BT + 1048576;

__device__ __forceinline__ void prep_s5b(const DArgs& a, unsigned char* ws, int it, int tid) {
    const int idx = it * 512 + tid;
    const int gi = idx >> 6, p = idx & 63;
    const float a_re = a.in[I_S5ARE][idx], a_im = a.in[I_S5AIM][idx], ldt = a.in[I_S5LDT][gi];
    const float dt = expf(ldt), mag = expf(a_re * dt);
    float sn, cs; sincosf(a_im * dt, &sn, &cs);
    const float ab_re = mag * cs, ab_im = mag * sn, den = a_re * a_re + a_im * a_im, nr = ab_re - 1.0f;
    const float co_re = (nr * a_re + ab_im * a_im) / den, co_im = (ab_im * a_re - nr * a_im) / den;
    ((f32x2*)(ws + WS_S5AB))[idx] = (f32x2){ab_re, ab_im};
    float pr = ab_re, pi = ab_im;
#pragma unroll
    for (int q = 0; q < 6; ++q) { const float nr2 = pr * pr - pi * pi, ni2 = 2.0f * pr * pi; pr = nr2; pi = ni2; }
    ((f32x2*)(ws + WS_S5A64))[idx] = (f32x2){pr, pi};
    const float* bre = a.in[I_S5BRE] + (size_t)idx * 16; const float* bim = a.in[I_S5BIM] + (size_t)idx * 16;
    float tr[16], ti[16];
#pragma unroll
    for (int i = 0; i < 16; ++i) { const float br = bre[i], bi = bim[i]; tr[i] = co_re * br - co_im * bi; ti[i] = co_re * bi + co_im * br; }
    bf16_t* btb = (bf16_t*)(ws + WS_S5BTB) + (size_t)gi * 128 * 16;
#pragma unroll
    for (int hlf = 0; hlf < 2; ++hlf) { u32x4 w0, w1; const float* s = hlf ? ti : tr;
        w0.x = pk2(s[0], s[1]); w0.y = pk2(s[2], s[3]); w0.z = pk2(s[4], s[5]); w0.w = pk2(s[6], s[7]); w1.x = pk2(s[8], s[9]); w1.y = pk2(s[10], s[11]); w1.z = pk2(s[12], s[13]); w1.w = pk2(s[14], s[15]);
        *(u32x4*)(btb + (size_t)(64 * hlf + p) * 16) = w0; *(u32x4*)(btb + (size_t)(64 * hlf + p) * 16 + 8) = w1; }
    bf16_t* cpb = (bf16_t*)(ws + WS_S5CPB) + (size_t)gi * 16 * 128;
    const float* cre = a.in[I_S5CRE] + (size_t)gi * 1024; const float* cim = a.in[I_S5CIM] + (size_t)gi * 1024;
#pragma unroll
    for (int i = 0; i < 16; ++i) *(unsigned*)(cpb + i * 128 + 2 * p) = pk2(cre[i * 64 + p], -cim[i * 64 + p]);
}

struct S5Unit { bf16x8 btf[8]; f32x2 ab; f32x2 h; const bf16_t* cp; };
template <bool PASSC> __device__ __forceinline__ void s5_load_unit(S5Unit& U, unsigned char* ws, const bf16_t* P, const f32x2* ST, int l, int b, int cs, int rowbase, int grp, int dir, int lane) {
    const int g = lane >> 4, il = lane & 15;
    const bf16x8 zero8 = {0, 0, 0, 0, 0, 0, 0, 0};
    const int gi = (l * 2 + dir) * 32 + grp;
    U.ab = ((const f32x2*)(ws + WS_S5AB))[gi * 64 + lane];
    const size_t sidx = ((size_t)(b * SNCH + cs) * 2 + dir) * 2048 + grp * 64 + lane;
    U.h = PASSC ? ST[sidx] : (f32x2){0.f, 0.f};
    const bf16_t* bt = (const bf16_t*)(ws + WS_S5BTB) + (size_t)gi * 128 * 16 + (size_t)il * 16 + 8 * (g & 1);
#pragma unroll
    for (int Pt = 0; Pt < 8; ++Pt) { const bf16x8 v = *(const bf16x8*)(bt + Pt * 256); U.btf[Pt] = g < 2 ? v : zero8; }
    U.cp = (const bf16_t*)(ws + WS_S5CPB) + (size_t)gi * 16 * 128 + (size_t)il * 128 + 8 * g;
}
__device__ __forceinline__ void s5_load_u(bf16x8 (&ufa)[4], const bf16_t* P, int rowbase, int grp, int lane) {
    const int g = lane >> 4, il = lane & 15; const bf16x8 zero8 = {0, 0, 0, 0, 0, 0, 0, 0};
#pragma unroll
    for (int Tt = 0; Tt < 4; ++Tt) { const bf16x8 v = *(const bf16x8*)(P + (size_t)(rowbase + 16 * Tt + il) * LDP + PC_S5U + grp * 16 + 8 * (g & 1)); ufa[Tt] = g < 2 ? v : zero8; }
}
template <bool PASSC, int DIR> __device__ __forceinline__ void s5_run_unit(const S5Unit& U, const bf16x8 (&ufa)[4], f32x4 (&yacc)[4], f32x2& hout, LAS float* BU, LAS unsigned char* HW, int lane) {
    const int g = lane >> 4, il = lane & 15;
    f32x2 h = U.h; const f32x2 ab = U.ab;
    bf16x8 cpf[4];
    if (PASSC) {
#pragma unroll
        for (int ks = 0; ks < 4; ++ks) cpf[ks] = *(const bf16x8*)(U.cp + 32 * ks); }
    f32x4 d[8];
#pragma unroll
    for (int Pt = 0; Pt < 8; ++Pt) d[Pt] = MFMA16(U.btf[Pt], ufa[DIR ? 3 : 0], ((f32x4){0.f, 0.f, 0.f, 0.f}));
#pragma unroll
    for (int wi = 0; wi < 4; ++wi) {
        const int Tt = DIR ? 3 - wi : wi;
#pragma unroll
        for (int Pt = 0; Pt < 8; ++Pt) {
#pragma unroll
            for (int r = 0; r < 4; ++r) BU[(16 * Pt + 4 * g + r) * 20 + il] = d[Pt][r]; }
        asm volatile("" ::: "memory");
        if (!PASSC) {
            f32x4 br[4], bi[4];
#pragma unroll
            for (int q = 0; q < 4; ++q) { br[q] = *(const LAS f32x4*)(BU + lane * 20 + 4 * q); bi[q] = *(const LAS f32x4*)(BU + (64 + lane) * 20 + 4 * q); }
            if (wi < 3) {
#pragma unroll
                for (int Pt = 0; Pt < 8; ++Pt) d[Pt] = MFMA16(U.btf[Pt], ufa[DIR ? 2 - wi : wi + 1], ((f32x4){0.f, 0.f, 0.f, 0.f})); }
#pragma unroll
            for (int s = 0; s < 16; ++s) { const int tt = DIR ? 15 - s : s;
                const float hr = __builtin_fmaf(ab.x, h.x, __builtin_fmaf(-ab.y, h.y, br[tt >> 2][tt & 3])), hi = __builtin_fmaf(ab.x, h.y, __builtin_fmaf(ab.y, h.x, bi[tt >> 2][tt & 3]));
                h = (f32x2){hr, hi}; }
        } else {
#pragma unroll
            for (int hf2 = 0; hf2 < 2; ++hf2) { const int q0 = DIR ? 2 - 2 * hf2 : 2 * hf2;
                f32x4 br[2], bi[2];
#pragma unroll
                for (int q = 0; q < 2; ++q) { br[q] = *(const LAS f32x4*)(BU + lane * 20 + 4 * (q0 + q)); bi[q] = *(const LAS f32x4*)(BU + (64 + lane) * 20 + 4 * (q0 + q)); }
#pragma unroll
                for (int s = 0; s < 8; ++s) { const int t8 = DIR ? 7 - s : s; const int tt = 4 * q0 + t8;
                    const float hr = __builtin_fmaf(ab.x, h.x, __builtin_fmaf(-ab.y, h.y, br[t8 >> 2][t8 & 3])), hi = __builtin_fmaf(ab.x, h.y, __builtin_fmaf(ab.y, h.x, bi[t8 >> 2][t8 & 3]));
                    h = (f32x2){hr, hi};
                    *(LAS unsigned*)(HW + off_b(tt, lane >> 2) + (lane & 3) * 4) = pk2(hr, hi); }
            }
        }
        asm volatile("" ::: "memory");
        if (PASSC) {
            bf16x8 hf[4];
#pragma unroll
            for (int ks = 0; ks < 4; ++ks) hf[ks] = img_row_frag(HW, lane, 0, ks);
#pragma unroll
            for (int ks = 0; ks < 4; ++ks) yacc[Tt] = MFMA16(cpf[ks], hf[ks], yacc[Tt]); }
        asm volatile("" ::: "memory");
        if (PASSC && wi < 3) {
#pragma unroll
            for (int Pt = 0; Pt < 8; ++Pt) d[Pt] = MFMA16(U.btf[Pt], ufa[DIR ? 2 - wi : wi + 1], ((f32x4){0.f, 0.f, 0.f, 0.f})); }
    }
    hout = h;
}
template <bool PASSC> __device__ __forceinline__ void s5_item(const DArgs& a, unsigned char* ws, LAS unsigned char* lds, int l, int item, int tid) {
    const int b = item / (SNCH * 2), rem = item % (SNCH * 2), cs = rem >> 1, half = rem & 1;
    const int lane = tid & 63, w = tid >> 6, g = lane >> 4, il = lane & 15;
    const int rowbase = gla_rowbase(b, cs);
    LAS float* BU = (LAS float*)(lds + w * 14336); LAS unsigned char* HW = lds + w * 14336 + 10240;
    const bf16_t* P = (const bf16_t*)(ws + WS_P);
    f32x2* ST = (f32x2*)(ws + WS_S5ST);
    const int grp0 = 16 * half + w, grp1 = grp0 + 8;
    S5Unit UA; bf16x8 ufa[4];
#pragma unroll 1
    for (int gg = 0; gg < 2; ++gg) {
        const int grp = gg ? grp1 : grp0;
        f32x4 yacc[4];
#pragma unroll
        for (int q = 0; q < 4; ++q) yacc[q] = (f32x4){0.f, 0.f, 0.f, 0.f};
        f32x2 hend;
        s5_load_unit<PASSC>(UA, ws, P, ST, l, b, cs, rowbase, grp, 0, lane); s5_load_u(ufa, P, rowbase, grp, lane);
        s5_run_unit<PASSC, 0>(UA, ufa, yacc, hend, BU, HW, lane);
        if (!PASSC) ST[((size_t)(b * SNCH + cs) * 2 + 0) * 2048 + grp * 64 + lane] = hend;
        s5_load_unit<PASSC>(UA, ws, P, ST, l, b, cs, rowbase, grp, 1, lane);
        s5_run_unit<PASSC, 1>(UA, ufa, yacc, hend, BU, HW, lane);
        if (!PASSC) ST[((size_t)(b * SNCH + cs) * 2 + 1) * 2048 + grp * 64 + lane] = hend;
        if (PASSC) {
            const f32x4 dsk = *(const f32x4*)(a.in[I_S5D] + l * 512 + grp * 16 + 4 * g);
            bf16_t* G5 = (bf16_t*)(ws + WS_KF);
#pragma unroll
            for (int Tt = 0; Tt < 4; ++Tt) { const size_t row = (size_t)rowbase + 16 * Tt + il;
                const u32x2 ur = *(const u32x2*)(P + row * LDP + PC_S5U + grp * 16 + 4 * g), sg = *(const u32x2*)(P + row * LDP + PC_S5G + grp * 16 + 4 * g);
                const float g0 = gelu_tanh(yacc[Tt].x + bflo(ur.x) * dsk.x), g1 = gelu_tanh(yacc[Tt].y + bfhi(ur.x) * dsk.y), g2 = gelu_tanh(yacc[Tt].z + bflo(ur.y) * dsk.z), g3 = gelu_tanh(yacc[Tt].w + bfhi(ur.y) * dsk.w);
                u32x2 ov; ov.x = pk2(g0, g1); ov.y = pk2(g2, g3);
                *(u32x2*)(G5 + row * 512 + grp * 16 + 4 * g) = ov;
                ov.x = pk2(g0 * siluf_(bflo(sg.x)), g1 * siluf_(bfhi(sg.x))); ov.y = pk2(g2 * siluf_(bflo(sg.y)), g3 * siluf_(bfhi(sg.y)));
                *(u32x2*)(G5 + OBSZ + row * 512 + grp * 16 + 4 * g) = ov; }
        }
    }
}
__device__ __forceinline__ void s5_passB(unsigned char* ws, int l, int gt) {
    const int p = gt & 63, grp = (gt >> 6) & 31, dir = (gt >> 11) & 1, b = gt >> 12;
    const f32x2 a64 = ((const f32x2*)(ws + WS_S5A64))[((l * 2 + dir) * 32 + grp) * 64 + p];
    f32x2* ST = (f32x2*)(ws + WS_S5ST);
    f32x2 acc = {0.f, 0.f};
#pragma unroll 1
    for (int s0 = 0; s0 < SNCH; s0 += 34) {
        f32x2 ev[34];
#pragma unroll
        for (int j = 0; j < 34; ++j) { const int s = s0 + j; const int cs = dir == 0 ? s : (s < 4 ? 3 - s : 71 - s); ev[j] = ST[((size_t)(b * SNCH + cs) * 2 + dir) * 2048 + grp * 64 + p]; }
#pragma unroll
        for (int j = 0; j < 34; ++j) { const int s = s0 + j; const int cs = dir == 0 ? s : (s < 4 ? 3 - s : 71 - s);
            ST[((size_t)(b * SNCH + cs) * 2 + dir) * 2048 + grp * 64 + p] = acc;
            acc = (f32x2){a64.x * acc.x - a64.y * acc.y + ev[j].x, a64.x * acc.y + a64.y * acc.x + ev[j].y}; }
    }
}
constexpr int FFT_PHYS = 8448;
__device__ __forceinline__ void fft_twiddles_g(LAS f32x2* W, const f32x2* Wg, int tid) {
#pragma unroll
    for (int j = 0; j < 8; ++j) W[tid + NT * j] = Wg[tid + NT * j];
}
__device__ __forceinline__ int fphys(int i) { return i + (i >> 5); }
__device__ __forceinline__ f32x2 cmulf(const f32x2 a, const f32x2 b) { return (f32x2){a.x * b.x - a.y * b.y, a.x * b.y + a.y * b.x}; }
__device__ __forceinline__ f32x2 cmulcf(const f32x2 a, const f32x2 b) { return (f32x2){a.x * b.x + a.y * b.y, a.y * b.x - a.x * b.y}; }
template <int RL> __device__ __forceinline__ void dft_fwd_const(f32x2 (&e)[1 << RL]) {
#pragma unroll
    for (int s = 0; s < RL; ++s) { const int h = 1 << (RL - 1 - s);
#pragma unroll
        for (int m = 0; m < (1 << RL); ++m) { if (m & h) continue;
            const int mp = m & (h - 1); const f32x2 a_ = e[m], b_ = e[m | h]; const f32x2 d = a_ - b_; e[m] = a_ + b_;
            if (mp == 0) e[m | h] = d;
            else if (2 * mp == h) e[m | h] = (f32x2){d.y, -d.x};
            else { const float ang = -3.14159265358979323846f * (float)mp / (float)h; const f32x2 c = {__builtin_cosf(ang), __builtin_sinf(ang)}; e[m | h] = cmulf(d, c); } } }
}
template <int RL> __device__ __forceinline__ void dft_inv_const(f32x2 (&e)[1 << RL]) {
#pragma unroll
    for (int ss = 0; ss < RL; ++ss) { const int s = RL - 1 - ss; const int h = 1 << (RL - 1 - s);
#pragma unroll
        for (int m = 0; m < (1 << RL); ++m) { if (m & h) continue;
            const int mp = m & (h - 1); const f32x2 a_ = e[m], b_ = e[m | h]; f32x2 t;
            if (mp == 0) t = b_;
            else if (2 * mp == h) t = (f32x2){-b_.y, b_.x};
            else { const float ang = -3.14159265358979323846f * (float)mp / (float)h; const f32x2 c = {__builtin_cosf(ang), __builtin_sinf(ang)}; t = cmulcf(b_, c); }
            e[m] = a_ + t; e[m | h] = a_ - t; } }
}
template <int RL> __device__ __forceinline__ constexpr int brev_c(int m) { int r = 0; for (int i = 0; i < RL; ++i) r |= ((m >> i) & 1) << (RL - 1 - i); return r; }
template <int RL, bool CONJ> __device__ __forceinline__ void apply_tw(f32x2 (&e)[1 << RL], const f32x2 w1) {
    f32x2 tw[1 << RL];
    tw[0] = (f32x2){1.f, 0.f}; tw[1] = w1;
    if (RL >= 2) { tw[2] = cmulf(w1, w1); tw[3] = cmulf(tw[2], w1); }
    if (RL >= 3) { tw[4] = cmulf(tw[2], tw[2]); tw[5] = cmulf(tw[4], tw[1]); tw[6] = cmulf(tw[4], tw[2]); tw[7] = cmulf(tw[4], tw[3]); }
    if (RL >= 4) { tw[8] = cmulf(tw[4], tw[4]);
#pragma unroll
        for (int k = 1; k < 8; ++k) tw[8 + k] = cmulf(tw[8], tw[k]); }
#pragma unroll
    for (int m = 1; m < (1 << RL); ++m) e[m] = CONJ ? cmulcf(e[m], tw[brev_c<RL>(m)]) : cmulf(e[m], tw[brev_c<RL>(m)]);
}
template <int RL, int BETA, bool INV> __device__ __forceinline__ void fft2_pass(LAS f32x2* X, const LAS f32x2* W, int tid) {
    constexpr int LOW = BETA - RL + 1, NG = FFTN >> RL, STR = (1 << LOW) + (1 << (LOW - 5));
#pragma unroll 1
    for (int gi = tid; gi < NG; gi += NT) {
        const int base = ((gi >> LOW) << (BETA + 1)) | (gi & ((1 << LOW) - 1));
        volatile LAS f32x2* p = X + fphys(base);
        f32x2 e[1 << RL];
#pragma unroll
        for (int m = 0; m < (1 << RL); ++m) e[m] = p[m * STR];
        const f32x2 w1 = W[(base & ((1 << LOW) - 1)) << (12 - BETA)];
        if (!INV) { dft_fwd_const<RL>(e); apply_tw<RL, false>(e, w1); }
        else { apply_tw<RL, true>(e, w1); dft_inv_const<RL>(e); }
#pragma unroll
        for (int m = 0; m < (1 << RL); ++m) p[m * STR] = e[m];
    }
}
__device__ __forceinline__ void fft2_fwd_ABC(LAS f32x2* X, const LAS f32x2* W, int tid) {
    fft2_pass<4, 12, false>(X, W, tid); __syncthreads(); fft2_pass<4, 8, false>(X, W, tid); __syncthreads();
}
__device__ __forceinline__ void fft2_inv_CBA(LAS f32x2* X, const LAS f32x2* W, int tid) {
    fft2_pass<4, 8, true>(X, W, tid); __syncthreads(); fft2_pass<4, 12, true>(X, W, tid); __syncthreads();
}
__device__ __forceinline__ void fft2_mid_mul(LAS f32x2* X, const f32x2* KF, int tid) {
    if (tid < 256) {
        volatile LAS f32x2* p = X + 33 * tid;
        f32x2 e[32];
#pragma unroll
        for (int m = 0; m < 32; ++m) e[m] = p[m];
        dft_fwd_const<5>(e);
#pragma unroll
        for (int q4 = 0; q4 < 4; ++q4) { f32x4 kf[4];
#pragma unroll
            for (int q = 0; q < 4; ++q) kf[q] = *(const f32x4*)(KF + 32 * tid + 8 * q4 + 2 * q);
#pragma unroll
            for (int q = 0; q < 4; ++q) { const int m = 8 * q4 + 2 * q; e[m] = cmulf(e[m], (f32x2){kf[q].x, kf[q].y}); e[m + 1] = cmulf(e[m + 1], (f32x2){kf[q].z, kf[q].w}); } }
        dft_inv_const<5>(e);
#pragma unroll
        for (int m = 0; m < 32; ++m) p[m] = e[m];
    }
}
__device__ __forceinline__ void fft2_fwd_D(LAS f32x2* X, int tid) {
    if (tid < 256) { volatile LAS f32x2* p = X + 33 * tid; f32x2 e[32];
#pragma unroll
        for (int m = 0; m < 32; ++m) e[m] = p[m];
        dft_fwd_const<5>(e);
#pragma unroll
        for (int m = 0; m < 32; ++m) p[m] = e[m]; }
}

__device__ __forceinline__ void filt_item2(const DArgs& a, unsigned char* ws, LAS unsigned char* lds, int l, int c, int tid) {
    LAS f32x2* X = (LAS f32x2*)lds; LAS f32x2* W = (LAS f32x2*)(lds + FFT_PHYS * 8); LAS float* w4s = (LAS float*)(lds + FFT_PHYS * 8 + 32768); LAS float* red = w4s + 256;
    fft_twiddles_g(W, (const f32x2*)(ws + WS_TWID), tid);
    if (tid < 128) { const int cc = tid >> 5, pr = tid & 31; const float* wsrc = a.in[I_HW4] + (size_t)l * 64 * 2048 + (cc >> 1) * 1024 + (cc & 1) * 512 + c;
        ((LAS unsigned*)w4s)[pr * 4 + cc] = pk2(wsrc[(size_t)(2 * pr) * 2048], wsrc[(size_t)(2 * pr + 1) * 2048]); }
    if (tid == 0) { float z0; asm volatile("v_mov_b32 %0, 0" : "=v"(z0)); X[fphys(4096)] = (f32x2){z0, z0}; }
    __syncthreads();
    const float dl = fabsf(HY_D0 + (HY_D1 - HY_D0) * ((float)c / 511.0f));
    const bf16_t* H3 = (const bf16_t*)(ws + WS_H3B) + (size_t)l * 4096 * 64;
    float ss0 = 0.f, ss1 = 0.f;
#pragma unroll 1
    for (int j = 0; j < 8; ++j) {
        const int t = tid + 512 * j;
        const u32x4* hr = (const u32x4*)(H3 + (size_t)t * 64);
        u32x4 hraw[8];
#pragma unroll
        for (int q = 0; q < 8; ++q) hraw[q] = hr[q];
        asm volatile("" ::: "memory");
        float f0 = 0.f, f1 = 0.f, b0 = 0.f, b1 = 0.f;
        typedef __bf16 bfp2 __attribute__((ext_vector_type(2)));
#pragma unroll
        for (int q = 0; q < 8; ++q) {
#pragma unroll
            for (int e = 0; e < 4; ++e) { const u32x4 wq = ((const LAS u32x4*)w4s)[4 * q + e]; const unsigned hx = hraw[q][e];
                f0 += bflo(hx) * bflo(wq.x) + bfhi(hx) * bfhi(wq.x); f1 += bflo(hx) * bflo(wq.y) + bfhi(hx) * bfhi(wq.y);
                b0 += bflo(hx) * bflo(wq.z) + bfhi(hx) * bfhi(wq.z); b1 += bflo(hx) * bflo(wq.w) + bfhi(hx) * bfhi(wq.w); } }
        const float dec = expf(-((float)t / 4095.0f) * dl); f0 *= dec; f1 *= dec; b0 *= dec; b1 *= dec;
        X[fphys(t)] = (f32x2){f0, f1}; ss0 += f0 * f0; ss1 += f1 * f1;
        if (t > 0) { X[fphys(8192 - t)] = (f32x2){b0, b1}; ss0 += b0 * b0; ss1 += b1 * b1; }
    }
    const float rs0 = rsqrtf(block_sum(ss0, red, tid) + EPS), rs1 = rsqrtf(block_sum(ss1, red, tid) + EPS);
#pragma unroll 4
    for (int j = 0; j < 16; ++j) { const int n = fphys(tid + 512 * j); const f32x2 x = X[n]; X[n] = (f32x2){x.x * rs0, x.y * rs1}; }
    __syncthreads(); fft2_fwd_ABC(X, W, tid); fft2_fwd_D(X, tid); __syncthreads();
    f32x2* KF0 = (f32x2*)(ws + WS_KF) + (size_t)(0 * 512 + c) * FFTN; f32x2* KF1 = (f32x2*)(ws + WS_KF) + (size_t)(1 * 512 + c) * FFTN;
#pragma unroll 4
    for (int j = 0; j < 16; ++j) { const int pos = tid + 512 * j; const int k = (int)(__brev((unsigned)pos) >> 19); const int pp = (int)(__brev((unsigned)((8192 - k) & 8191)) >> 19);
        const f32x2 za = X[fphys(pos)], zb = X[fphys(pp)];
        KF0[pos] = (f32x2){0.5f * (za.x + zb.x), 0.5f * (za.y - zb.y)};
        KF1[pos] = (f32x2){0.5f * (za.y + zb.y), 0.5f * (zb.x - za.x)}; }
    __syncthreads();
}

struct Raw8 { u32x4 mid; bf16_t lf, rt; };
__device__ __forceinline__ Raw8 ld_raw8(const bf16_t* p, int t0, int Lx) { Raw8 r; r.mid = *(const u32x4*)(p + t0); r.lf = t0 > 0 ? p[t0 - 1] : (bf16_t)0; r.rt = t0 + 8 < Lx ? p[t0 + 8] : (bf16_t)0; return r; }
__device__ __forceinline__ void sconv8(const Raw8& r, float w0, float w1, float w2, float cb, float (&o)[8]) {
    float x[10]; x[0] = bf2f(r.lf); x[9] = bf2f(r.rt);
    x[1] = bflo(r.mid.x); x[2] = bfhi(r.mid.x); x[3] = bflo(r.mid.y); x[4] = bfhi(r.mid.y); x[5] = bflo(r.mid.z); x[6] = bfhi(r.mid.z); x[7] = bflo(r.mid.w); x[8] = bfhi(r.mid.w);
#pragma unroll
    for (int i = 0; i < 8; ++i) o[i] = w0 * x[i] + w1 * x[i + 1] + w2 * x[i + 2] + cb;
}
__device__ __forceinline__ void hyena_item2(const DArgs& a, unsigned char* ws, LAS unsigned char* lds, int l, int c, int tid) {
    LAS f32x2* X = (LAS f32x2*)lds; LAS f32x2* W = (LAS f32x2*)(lds + FFT_PHYS * 8);
    fft_twiddles_g(W, (const f32x2*)(ws + WS_TWID), tid);
    const float* cw = a.in[I_HCW] + (size_t)l * 3 * 1536; const float* cbp = a.in[I_HCB] + (size_t)l * 1536;
    const float wv0 = cw[c], wv1 = cw[1536 + c], wv2 = cw[3072 + c], bv = cbp[c];
    const float wa0 = cw[512 + c], wa1 = cw[1536 + 512 + c], wa2 = cw[3072 + 512 + c], ba = cbp[512 + c];
    const float wb0 = cw[1024 + c], wb1 = cw[1536 + 1024 + c], wb2 = cw[3072 + 1024 + c], bb = cbp[1024 + c];
    const float bias0 = a.in[I_HBIAS][(l * 2 + 0) * 512 + c], bias1 = a.in[I_HBIAS][(l * 2 + 1) * 512 + c];
    const bf16_t* PT = (const bf16_t*)(ws + WS_PT);
    const bf16_t* pv = PT + (size_t)(PT_V + c) * MR; const bf16_t* pg1 = PT + (size_t)(PT_G1 + c) * MR; const bf16_t* pg2 = PT + (size_t)(PT_G2 + c) * MR; const bf16_t* phg = PT + (size_t)(PT_HG + c) * MR;
    const f32x2* KF0 = (const f32x2*)(ws + WS_KF) + (size_t)(0 * 512 + c) * FFTN; const f32x2* KF1 = (const f32x2*)(ws + WS_KF) + (size_t)(1 * 512 + c) * FFTN;
    bf16_t* GATED = (bf16_t*)(ws + WS_H);
    const int t0 = 8 * tid;
    LAS f32x2* px = X + 8 * tid + (tid >> 2);
    __syncthreads();
    for (int bp = 0; bp < 2; ++bp) {
        const int r0 = (2 * bp) * SEQL, r1 = (2 * bp + 1) * SEQL;
        const Raw8 v0 = ld_raw8(pv + r0, t0, SEQL), v1 = ld_raw8(pv + r1, t0, SEQL);
        const Raw8 g10 = ld_raw8(pg1 + r0, t0, SEQL), g11 = ld_raw8(pg1 + r1, t0, SEQL);
        float zr[8], zi[8];
        sconv8(v0, wv0, wv1, wv2, bv, zr); sconv8(v1, wv0, wv1, wv2, bv, zi);
#pragma unroll
        for (int x = 0; x < 8; ++x) { px[x] = (f32x2){zr[x], zi[x]}; px[4224 + x] = (f32x2){0.f, 0.f}; }
        __syncthreads(); fft2_fwd_ABC(X, W, tid); fft2_mid_mul(X, KF0, tid); __syncthreads(); fft2_inv_CBA(X, W, tid);
        { float gr[8], gi[8]; sconv8(g10, wa0, wa1, wa2, ba, gr); sconv8(g11, wa0, wa1, wa2, ba, gi);
#pragma unroll
          for (int x = 0; x < 8; ++x) { const f32x2 cv = px[x] * (1.0f / 8192.0f); zr[x] = gr[x] * (cv.x + bias0 * zr[x]); zi[x] = gi[x] * (cv.y + bias0 * zi[x]); } }
        __syncthreads();
        const Raw8 g20 = ld_raw8(pg2 + r0, t0, SEQL), g21 = ld_raw8(pg2 + r1, t0, SEQL);
        const u32x4 hgr0 = *(const u32x4*)(phg + r0 + t0), hgr1 = *(const u32x4*)(phg + r1 + t0);
#pragma unroll
        for (int x = 0; x < 8; ++x) { px[x] = (f32x2){zr[x], zi[x]}; px[4224 + x] = (f32x2){0.f, 0.f}; }
        __syncthreads(); fft2_fwd_ABC(X, W, tid); fft2_mid_mul(X, KF1, tid); __syncthreads(); fft2_inv_CBA(X, W, tid);
        { float gr[8], gi[8], h0[8], h1[8]; sconv8(g20, wb0, wb1, wb2, bb, gr); sconv8(g21, wb0, wb1, wb2, bb, gi); unpack8(hgr0, h0); unpack8(hgr1, h1);
#pragma unroll
          for (int x = 0; x < 8; ++x) { const f32x2 cv = px[x] * (1.0f / 8192.0f);
              const float z2r = gr[x] * (cv.x + bias1 * zr[x]), z2i = gi[x] * (cv.y + bias1 * zi[x]);
              gr[x] = z2r * siluf_(h0[x]); gi[x] = z2i * siluf_(h1[x]); }
          bf16_t* pvw = (bf16_t*)(ws + WS_PT) + (size_t)(PT_V + c) * MR;
          *(u32x4*)(pvw + r0 + t0) = pack8(gr); *(u32x4*)(pvw + r1 + t0) = pack8(gi); }
        __syncthreads();
    }
}

__device__ __forceinline__ void hy_transpose_item(unsigned char* ws, LAS unsigned char* lds, int item, int tid, int nrows) {
    const int lane = tid & 63, w = tid >> 6;
    const int wi = item * 8 + w;
    const int nrb = nrows / 64;
    if (wi >= nrb * 8) return;
    const int rb = wi >> 3, cb = wi & 7;
    LAS bf16_t* T = (LAS bf16_t*)(lds + w * 8704);
    const bf16_t* src = (const bf16_t*)(ws + WS_PT) + (size_t)(PT_V + cb * 64) * MR + (size_t)rb * 64;
    u32x4 tv[8];
#pragma unroll
    for (int i = 0; i < 8; ++i) { const int c = 8 * i + (lane >> 3), r8 = (lane & 7) * 8; tv[i] = *(const u32x4*)(src + (size_t)c * MR + r8); }
#pragma unroll
    for (int i = 0; i < 8; ++i) { const int c = 8 * i + (lane >> 3), r8 = (lane & 7) * 8;
        LAS unsigned* d = (LAS unsigned*)(T + c * 66 + r8); d[0] = tv[i].x; d[1] = tv[i].y; d[2] = tv[i].z; d[3] = tv[i].w; }
    asm volatile("s_waitcnt lgkmcnt(0)" ::: "memory");
    bf16_t* dst = (bf16_t*)(ws + WS_H) + (size_t)(rb * 64) * D + 512 + cb * 64;
#pragma unroll 4
    for (int i = 0; i < 8; ++i) { const int r = 8 * i + (lane >> 3), c8 = (lane & 7) * 8;
        unsigned short e[8];
#pragma unroll
        for (int x = 0; x < 8; ++x) e[x] = T[(c8 + x) * 66 + r];
        u32x4 o; o.x = e[0] | ((unsigned)e[1] << 16); o.y = e[2] | ((unsigned)e[3] << 16); o.z = e[4] | ((unsigned)e[5] << 16); o.w = e[6] | ((unsigned)e[7] << 16);
        *(u32x4*)(dst + (size_t)r * D + c8) = o; }
    asm volatile("s_waitcnt lgkmcnt(0)" ::: "memory");
}
#ifndef MK_EN
#define MK_EN 0xffff
#endif
#define EN(x) ((MK_EN >> (x)) & 1)
constexpr int PH_PREP = 0, PH_PER_LAYER = 7, PH_FNORM = 1 + 2 * PH_PER_LAYER, N_PHASES = PH_FNORM + 1;

__global__ void __launch_bounds__(NT, 2) fwd_kernel(Args ka) {
    extern __shared__ __attribute__((aligned(16))) unsigned char lds_raw[];
    LAS unsigned char* lds = (LAS unsigned char*)lds_raw;
    const int G = gridDim.x;
    volatile LAS unsigned* bst = (volatile LAS unsigned*)(lds + LDS_CTL_OFF);
    if (threadIdx.x < 16) bst[threadIdx.x] = 0u;
    if (threadIdx.x == 0) { LAS unsigned long long* tab = (LAS unsigned long long*)(lds + LDS_PTR_OFF);
#pragma unroll
        for (int i = 0; i < N_IN; ++i) tab[i] = (unsigned long long)ka.in[i]; }
    __syncthreads();

    XcdBarrier gbar; gbar.bar = (unsigned*)(ka.ws + WS_CTL); gbar.x = 0; gbar.st = bst;
    if (ka.ph_hi - ka.ph_lo > 1) gbar = xcd_barrier_post((unsigned*)(ka.ws + WS_CTL), bst);

#ifdef REP_SUB
    int repmask = 0;
#endif
    for (int ph = ka.ph_lo; ph < ka.ph_hi; ++ph) {
        int tid = threadIdx.x; asm volatile("" : "+v"(tid));
        int bid = blockIdx.x; asm volatile("" : "+s"(bid));
#define LANE_WAVE() int tid2_ = threadIdx.x; asm volatile("" : "+v"(tid2_)); const int lane = tid2_ & 63, wave = __builtin_amdgcn_readfirstlane(tid2_ >> 6)
        __attribute__((address_space(1))) unsigned char* wsg_ = (__attribute__((address_space(1))) unsigned char*)ka.ws; asm volatile("" : "+s"(wsg_)); unsigned char* ws = (unsigned char*)wsg_;
        __attribute__((address_space(1))) float* outg_ = (__attribute__((address_space(1))) float*)ka.out; asm volatile("" : "+s"(outg_)); float* outp_ = (float*)outg_;
        DArgs a; a.in.t = (const LAS unsigned long long*)(lds + LDS_PTR_OFF); a.out = outp_;
        float* MOD = (float*)(ws + WS_MOD);
        if (EN(0) && ph == PH_PREP) {
            for (int it = bid; it < 1048 + 544 + 8; it += G) {
                int tid = threadIdx.x; asm volatile("" : "+v"(tid));
                __syncthreads();
                if (it < 768) prep_adaln(a.in[I_C], a.in[I_CCTX], a.in[I_ADAW], a.in[I_ADAB], MOD, it, (LAS float*)lds, tid);
                else if (it < 784) prep_s5b(a, ws, it - 768, tid);
                else if (it >= 1048 + 544) { const int j = (it - 1592) * NT + tid; float sn, cs; sincospif(-(float)j * (1.0f / 4096.0f), &sn, &cs); ((f32x2*)(ws + WS_TWID))[j] = (f32x2){cs, sn}; }
                else if (it >= 1048) prep_rope((f32x2*)(ws + WS_ROPE), it - 1048, tid);
                else { const bool big = it < 1040; const int r = big ? it - 784 : it - 1040, l = big ? (r >> 7) : 0, t0 = (big ? (r & 127) : r) * 32;
                    float* H3o = big ? (float*)(ws + WS_H3) + (size_t)l * 4096 * 64 : (float*)(ws + WS_H3C);
                    bf16_t* H3b = big ? (bf16_t*)(ws + WS_H3B) + (size_t)l * 4096 * 64 : (bf16_t*)nullptr;
                    prep_hymlp(a, H3o, H3b, l, big ? 4096 : 256, t0, lds, tid); }
            }
        } else if (EN(1) && ph == PH_FNORM) {
            const float* fw = a.in[I_FNW]; LANE_WAVE();
            for (int row = bid * NWAVES + wave; row < NLAT; row += G * NWAVES) {
                float* xr = a.out + (size_t)row * D; f32x4 v[8]; float ss = 0.f;
#pragma unroll
                for (int j = 0; j < 8; ++j) { v[j] = ((const f32x4*)xr)[lane + 64 * j]; ss += (v[j].x * v[j].x + v[j].y * v[j].y) + (v[j].z * v[j].z + v[j].w * v[j].w); }
                const float rstd = rsqrtf(wave_sum(ss) * (1.0f / D) + EPS);
#pragma unroll
                for (int j = 0; j < 8; ++j) { const f32x4 w = *(const f32x4*)(fw + 4 * (lane + 64 * j)); ((f32x4*)xr)[lane + 64 * j] = v[j] * rstd * w; }
            }
        } else {
            const int l = (ph - 1) / PH_PER_LAYER, sub = (ph - 1) % PH_PER_LAYER;

            const bool ctx_out = (l == 0);
            const int Mrows = ctx_out ? MR : NLAT;
            if (EN(2) && sub == 0) {
                LANE_WAVE();
                LAS float* scr = (LAS float*)(lds + wave * 8704);
                const int gw = bid * NWAVES + wave, NGW = G * NWAVES;
                constexpr int I_W1 = 32 * (NPAD / 32), I_W2 = 32 * 64, I_W3 = 8 * 16;
                for (int it = (l == 0 ? gw : gw + I_W1); it < I_W1 + I_W2 + I_W3; it += NGW) {
                    int r = it;
                    if (r < I_W1) { const int kb = r / (NPAD / 32), nb = r % (NPAD / 32); transpose_item(a.in[I_WIN] + (size_t)l * D * INW, INW, win_srccol(nb * 32 + (lane & 31)), kb * 64, (bf16_t*)(ws + WS_WIN), D, nb * 32, scr, lane); continue; }
                    r -= I_W1;
                    if (r < I_W2) { const int kb = r / 64, nb = r % 64; transpose_item(a.in[I_WOUT] + (size_t)l * D * D, D, nb * 32 + (lane & 31), kb * 64, (bf16_t*)(ws + WS_WOUT), D, nb * 32, scr, lane); continue; }
                    r -= I_W2;
                    { const int kb = r / 16, nb = r % 16; transpose_item(a.in[I_GLUW] + (size_t)l * 512 * 512, 512, nb * 32 + (lane & 31), kb * 64, (bf16_t*)(ws + WS_GLUW), 512, nb * 32, scr, lane); }
                }
                const float* nw = a.in[I_NORMW] + (size_t)l * D;
                for (int row = gw; row < MR; row += NGW) {
                    const float* xr; int v;
                    if (row < NLAT) { xr = (l == 0 ? a.in[I_X] : a.out) + (size_t)row * D; v = row >> 12; }
                    else { xr = (l == 0 ? a.in[I_CTX] : (const float*)(ws + WS_XC1)) + (size_t)(row - NLAT) * D; v = 4; }
                    norm_row(xr, nw, MOD + (size_t)(l * 5 + v) * ADA, (bf16_t*)(ws + WS_H) + (size_t)row * D, lane);
                }
                __syncthreads();
                const int nfilt = ctx_out ? 1024 : 0;
                for (int it = bid; it < nfilt; it += G) { int tid = threadIdx.x; asm volatile("" : "+v"(tid)); __syncthreads(); if (it < 512) filt_item2(a, ws, lds, l, it, tid); else filt_ctx_item(a, ws, lds, it - 512, tid);
#if defined(REP_ITEM) && REP_ITEM == 10
                    __syncthreads(); if (it < 512) filt_item2(a, ws, lds, l, it, tid);
#endif
                }
            } else if (EN(3) && sub == 1) {
                pg8::Gemm g{(const bf16_t*)(ws + WS_H), (const bf16_t*)(ws + WS_WIN), MR, NPAD, D}; pg8::StaticOrder S; S.init(MR, NPAD, G, bid);
                EpiInProj E{(bf16_t*)(ws + WS_P), (bf16_t*)(ws + WS_PT), (float*)(ws + WS_LR), (const float*)(ws + WS_ROPE)};
                { pg8::InProjOrder S1; S1.init(ctx_out ? 0 : 1, G, bid); pg8::gemm_phase<EpiInProj, pg8::InProjOrder, true, true>(lds, g, S1, E, tid); }
            } else if (EN(5) && sub == 2) {
                const int nit = ctx_out ? 3200 : 2688;
                for (int it = bid; it < nit; it += G) {
                    int tid = threadIdx.x; asm volatile("" : "+v"(tid));
                    __syncthreads();
#ifdef REP_ITEM
                    for (int rep_ = 0; rep_ < 2; ++rep_) { const int ty_ = it < 544 ? 0 : it < 1088 ? 1 : it < 2176 ? 2 : it < 2688 ? 3 : 4; if (rep_ && ty_ != REP_ITEM) break; if (rep_) __syncthreads(); asm volatile("" : "+v"(tid));
#endif
                    if (it < 544) s5_item<false>(a, ws, lds, l, it, tid);
                    else if (it < 1088) ret_passA(ws, lds, it - 544, tid);
                    else if (it < 2176) gla_passA(a, ws, lds, l, it - 1088, tid);
                    else if (it < 2688) hyena_item2(a, ws, lds, l, it - 2176, tid);
                    else hyena_ctx_item(a, ws, lds, it - 2688, tid);
#ifdef REP_ITEM
                    }
#endif
                }
            } else if (EN(9) && sub == 3) {
                for (int it = bid; it < 256; it += G) { int tid = threadIdx.x; asm volatile("" : "+v"(tid)); __syncthreads(); hy_transpose_item(ws, lds, it, tid, NLAT); }
                for (int it = bid; it < 224; it += G) { int tid = threadIdx.x; asm volatile("" : "+v"(tid)); __syncthreads();
                    if (it < 128) ret_passB(ws, it * NT + tid);
                    else if (it < 192) gla_passB(ws, lds, it - 128, tid);
                    else s5_passB(ws, l, (it - 192) * NT + tid); }
            } else if (EN(6) && sub == 4) {
                const int nsc = ctx_out ? 544 : 512, nrc = ctx_out ? 16 * RNCH : 16 * 32, ngc = ctx_out ? 16 * GNCH : 16 * 64;
                for (int it = bid; it < nsc; it += G) { int tid = threadIdx.x; asm volatile("" : "+v"(tid)); __syncthreads();
                    const int item = ctx_out ? it : (it >> 7) * (SNCH * 2) + 8 + (it & 127); s5_item<true>(a, ws, lds, l, item, tid); }
                for (int it = (bid + 64) % G; it < nrc; it += G) { int tid = threadIdx.x; asm volatile("" : "+v"(tid)); __syncthreads();
                    const int item = ctx_out ? it : (it >> 5) * RNCH + 2 + (it & 31); ret_passC(a, ws, lds, l, item, tid); }
                for (int it = (bid + 128) % G; it < ngc; it += G) { int tid = threadIdx.x; asm volatile("" : "+v"(tid)); __syncthreads();
                    const int item = ctx_out ? it : (it >> 6) * GNCH + 4 + (it & 63); gla_passC(a, ws, lds, l, item, tid); }
            } else if (EN(7) && sub == 5) {
                pg8::Gemm g{(const bf16_t*)(ws + WS_KF), (const bf16_t*)(ws + WS_GLUW), Mrows, 512, 512}; pg8::StaticOrder S; S.init(Mrows, 512, G, bid);
                EpiGlu E{(const bf16_t*)(ws + WS_KF) + OBSZ, (bf16_t*)(ws + WS_H), a.in[I_GLUB] + (size_t)l * 512};
                pg8::gemm_phase<EpiGlu, pg8::StaticOrder, true, true>(lds, g, S, E, tid);
                if (l == 0 && bid >= 136) {
                    LANE_WAVE(); LAS float* scr = (LAS float*)(lds + wave * 8704);
                    for (int r = (bid - 136) * NWAVES + wave; r < 32 * (NPAD / 32); r += (G - 136) * NWAVES) { const int kb = r / (NPAD / 32), nb = r % (NPAD / 32);
                        transpose_item(a.in[I_WIN] + (size_t)1 * D * INW, INW, win_srccol(nb * 32 + (lane & 31)), kb * 64, (bf16_t*)(ws + WS_WIN), D, nb * 32, scr, lane); }
                }
            } else if (EN(8)) {
                pg8::Gemm g{(const bf16_t*)(ws + WS_H), (const bf16_t*)(ws + WS_WOUT), Mrows, D, D}; pg8::StaticOrder S; S.init(Mrows, D, G, bid);
                EpiOut E{l == 0 ? a.in[I_X] : a.out, a.in[I_CTX], a.out, (float*)(ws + WS_XC1), MOD + (size_t)l * 5 * ADA};
                pg8::gemm_phase<EpiOut, pg8::StaticOrder, true, true>(lds, g, S, E, tid);
                if (l == 0 && bid >= 32) {
                    for (int it = bid - 32; it < 512; it += G - 32) { int tid2 = threadIdx.x; asm volatile("" : "+v"(tid2)); __syncthreads(); filt_item2(a, ws, lds, 1, it, tid2); }
                }
            }
        }
#ifdef REP_SUB
        if (ph != PH_PREP && ph != PH_FNORM && ((ph - 1) % PH_PER_LAYER) == REP_SUB && !((repmask >> ((ph - 1) / PH_PER_LAYER)) & 1)) { repmask |= 1 << ((ph - 1) / PH_PER_LAYER); xcd_barrier(gbar); --ph; continue; }
#endif
        if (ph + 1 < ka.ph_hi) xcd_barrier(gbar);
    }
}

#ifndef MK_LAUNCH_PER_PHASE
#define MK_LAUNCH_PER_PHASE 0
#endif
extern "C" void kernel_launch(void* const* d_in, const int* in_sizes, int n_in, void* d_out, int out_size, void* d_ws, size_t ws_size, hipStream_t stream) {
    static int grid = 0;
    if (grid == 0) {
        if (n_in != N_IN || out_size != NLAT * D || ws_size < WS_END2) { fprintf(stderr, "kernel_launch: unexpected shapes (n_in %d, out %d, ws %zu < %zu); nothing launched\n", n_in, out_size, ws_size, (size_t)WS_END2); grid = -1; return; }
        int dev = 0, cus = 0, per_cu = 0;
        if (hipGetDevice(&dev) != hipSuccess || hipDeviceGetAttribute(&cus, hipDeviceAttributeMultiprocessorCount, dev) != hipSuccess) { grid = -1; return; }
        if (hipFuncSetAttribute((const void*)fwd_kernel, hipFuncAttributeMaxDynamicSharedMemorySize, LDS_BYTES) != hipSuccess) { fprintf(stderr, "kernel_launch: hipFuncSetAttribute failed\n"); grid = -1; return; }
        if (hipOccupancyMaxActiveBlocksPerMultiprocessor(&per_cu, (const void*)fwd_kernel, NT, LDS_BYTES) != hipSuccess || per_cu < 1) { fprintf(stderr, "kernel_launch: occupancy query says %d blocks per CU\n", per_cu); per_cu = 1; }
        (void)hipGetLastError();
        grid = cus;
    }
    if (grid < 0) return;
    (void)hipMemsetAsync((char*)d_ws + WS_CTL, 0, WS_ZERO_BYTES, stream);
    Args a{};
    for (int i = 0; i < N_IN; ++i) a.in[i] = (const float*)d_in[i];
    a.out = (float*)d_out; a.ws = (unsigned char*)d_ws;
#if MK_LAUNCH_PER_PHASE
    for (int ph = 0; ph < N_PHASES; ++ph) {
        a.ph_lo = ph; a.ph_hi = ph + 1;
        hipLaunchKernelGGL(fwd_kernel, dim3(grid), dim3(NT), LDS_BYTES, stream, a);
    }
#else
    a.ph_lo = 0; a.ph_hi = N_PHASES;
    void* args[] = {&a};
    hipError_t e = hipLaunchCooperativeKernel((const void*)fwd_kernel, dim3(grid), dim3(NT), args, LDS_BYTES, stream);
    if (e != hipSuccess) fprintf(stderr, "kernel_launch: cooperative launch failed: %s (grid %d)\n", hipGetErrorString(e), grid);
#endif
}
```

```cpp
#include <hip/hip_runtime.h>
#include <hip/hip_cooperative_groups.h>
#include <cstdio>
#include <cstdint>
namespace cg = cooperative_groups;

#define LAS __attribute__((address_space(3)))
typedef unsigned short bf16_t;
typedef float f32x4 __attribute__((ext_vector_type(4)));
typedef float f32x2 __attribute__((ext_vector_type(2)));
typedef unsigned u32x4 __attribute__((ext_vector_type(4)));
typedef unsigned u32x2 __attribute__((ext_vector_type(2)));

constexpr int D = 2048, NB = 4, SEQL = 4096, LC = 256, NLAT = NB * SEQL, NCTX = NB * LC, MR = NLAT + NCTX;
constexpr int BR = 512, INW = 6688, NPAD = 6912, LDP = 4608, ADA = 3 * D;
constexpr int NT = 512, NWAVES = 8;
constexpr float EPS = 1e-6f;
constexpr int PC_S5U = 0, PC_S5G = 512, PC_RQ = 1024, PC_RK = 1536, PC_RV = 2048, PC_RG = 2560, PC_GQ = 3072, PC_GK = 3328, PC_GV = 3584, PC_GG = 4096;
constexpr int PT_V = 0, PT_G1 = 512, PT_G2 = 1024, PT_HG = 1536;
constexpr int FFTN = 8192;

enum { I_X = 0, I_C, I_CTX, I_CCTX, I_NORMW, I_ADAW, I_ADAB, I_WIN, I_WOUT, I_S5ARE, I_S5AIM, I_S5LDT, I_S5BRE, I_S5BIM, I_S5CRE, I_S5CIM,
       I_S5D, I_GLUW, I_GLUB, I_HCW, I_HCB, I_HW1, I_HB1, I_HF1, I_HW2, I_HB2, I_HF2, I_HW3, I_HB3, I_HF3, I_HW4, I_HBIAS, I_RNW, I_GGW, I_GGB, I_GNW, I_FNW, N_IN };

constexpr size_t al256(size_t x) { return (x + 255) & ~(size_t)255; }
constexpr size_t WS_CTL  = 0;
constexpr size_t WS_MOD  = WS_CTL + 65536;
constexpr size_t WS_ZERO_BYTES = 65536 + al256((size_t)2 * 5 * ADA * 4);
constexpr size_t WS_S5AB = WS_MOD + al256((size_t)2 * 5 * ADA * 4);
constexpr size_t WS_S5BT = WS_S5AB + (size_t)2 * 2 * 32 * 64 * 8;
constexpr size_t WS_H3   = WS_S5BT + (size_t)1048576 + 65536;
constexpr size_t WS_H3C  = WS_H3 + (size_t)2 * 4096 * 64 * 4;
constexpr size_t WS_KC   = WS_H3C + (size_t)256 * 64 * 4;
constexpr size_t WS_LR   = WS_KC + (size_t)2 * 512 * 512 * 4;
constexpr size_t WS_XC1  = WS_LR + (size_t)MR * 32 * 4;
constexpr size_t WS_WOUT = WS_XC1 + (size_t)NCTX * D * 4;
constexpr size_t WS_GLUW = WS_WOUT + (size_t)D * D * 2;
constexpr size_t WS_WIN  = WS_GLUW + (size_t)512 * 512 * 2;
constexpr size_t WS_H    = WS_WIN + (size_t)NPAD * D * 2;
constexpr size_t WS_P    = WS_H + (size_t)MR * D * 2;
constexpr size_t WS_PT   = WS_P + (size_t)MR * LDP * 2;
constexpr size_t WS_KF   = WS_PT + (size_t)2048 * MR * 2;
constexpr size_t WS_OB   = WS_KF + (size_t)2 * 512 * FFTN * 8;
constexpr size_t WS_END  = WS_OB + (size_t)6 * MR * 512 * 2;
constexpr size_t OBSZ = (size_t)MR * 512;

constexpr int LDS_CTL_OFF = 131072 + 2048;
constexpr int LDS_PTR_OFF = LDS_CTL_OFF + 64;
constexpr int LDS_BYTES = LDS_PTR_OFF + 320;

typedef __bf16 hwbf16x2 __attribute__((ext_vector_type(2)));
__device__ __forceinline__ unsigned pk2(float lo, float hi) { const f32x2 v = {lo, hi}; return __builtin_bit_cast(unsigned, __builtin_convertvector(v, hwbf16x2)); }
__device__ __forceinline__ unsigned f2bf(float f) { return pk2(f, 0.f) & 0xffffu; }
__device__ __forceinline__ float bf2f(bf16_t b) { return __uint_as_float((unsigned)b << 16); }
__device__ __forceinline__ float bflo(unsigned w) { return __uint_as_float(w << 16); }
__device__ __forceinline__ float bfhi(unsigned w) { return __uint_as_float(w & 0xffff0000u); }
__device__ __forceinline__ void unpack8(const u32x4 r, float (&f)[8]) { f[0] = bflo(r.x); f[1] = bfhi(r.x); f[2] = bflo(r.y); f[3] = bfhi(r.y); f[4] = bflo(r.z); f[5] = bfhi(r.z); f[6] = bflo(r.w); f[7] = bfhi(r.w); }
__device__ __forceinline__ u32x4 pack8(const float (&f)[8]) { u32x4 o; o.x = pk2(f[0], f[1]); o.y = pk2(f[2], f[3]); o.z = pk2(f[4], f[5]); o.w = pk2(f[6], f[7]); return o; }
__device__ __forceinline__ float sigmoidf_(float x) { return __builtin_amdgcn_rcpf(1.0f + __expf(-x)); }
__device__ __forceinline__ float siluf_(float x) { return x * sigmoidf_(x); }
__device__ __forceinline__ float gelu_tanh(float x) { const float u2 = 1.5957691216057308f * (x + 0.044715f * x * x * x); return x * sigmoidf_(u2); }
__device__ __forceinline__ float wave_sum(float v) {
#pragma unroll
    for (int o = 1; o < 64; o <<= 1) v += __shfl_xor(v, o);
    return v;
}
#define LDS_WAIT() asm volatile("s_waitcnt lgkmcnt(0)" ::: "memory")

struct Args { const float* in[N_IN]; float* out; unsigned char* ws; int ph_lo, ph_hi; };
struct InTab { const LAS unsigned long long* t;
    __device__ __forceinline__ const float* operator[](int i) const { const unsigned long long v = t[i];
        const unsigned lo = __builtin_amdgcn_readfirstlane((unsigned)v), hi = __builtin_amdgcn_readfirstlane((unsigned)(v >> 32)); return (const float*)(__attribute__((address_space(1))) const float*)(((unsigned long long)hi << 32) | lo); } };
struct DArgs { InTab in; float* out; };

#define XB_TMO      128
#define XB_XCNT(j)  (256  + 64 * (j))
#define XB_XSUB(j)  (1280 + 64 * (j))
#define XB_XGEN(j)  (2304 + 64 * (j))
#define XB_TOP      3328
#define XB_TOPGEN   3392
#define XCD_BAR_WORDS 3456
#define XB_SPIN_CAP (1u << 22)
__device__ __forceinline__ unsigned xb_ld(unsigned* p)              { return __hip_atomic_load(p, __ATOMIC_RELAXED, __HIP_MEMORY_SCOPE_AGENT); }
__device__ __forceinline__ unsigned xb_add(unsigned* p, unsigned v) { return __hip_atomic_fetch_add(p, v, __ATOMIC_RELAXED, __HIP_MEMORY_SCOPE_AGENT); }
__device__ __forceinline__ unsigned xb_xcc_id() { return (unsigned)__builtin_amdgcn_s_getreg((3 << 11) | 20) & 0xFu; }
#define XB_SPIN(cond, bar) do { unsigned _sp = 0; while (cond) { __builtin_amdgcn_s_sleep(1); \
    if ((++_sp & 255u) == 0u) { if (xb_ld(&(bar)[XB_TMO])) break; if (_sp > XB_SPIN_CAP) { atomicAdd(&(bar)[XB_TMO], 1u); break; } } } } while (0)
struct XcdBarrier { unsigned* bar; unsigned x; volatile LAS unsigned* st; };
__device__ __forceinline__ XcdBarrier xcd_barrier_post(unsigned* bar, volatile LAS unsigned* st) {
    XcdBarrier b; b.bar = bar; b.x = xb_xcc_id(); b.st = st;
    if (threadIdx.x == 0) (void)xb_add(&bar[XB_XCNT(b.x)], 1u);
    return b;
}
__device__ __forceinline__ void xcd_barrier_complete(unsigned* bar, unsigned x, unsigned& nloc, unsigned& nx) {
    const unsigned G = gridDim.x * gridDim.y * gridDim.z;
    unsigned sum, cnt, mine, sp = 0u;
    for (;;) {
        sum = 0u; cnt = 0u; mine = 0u;
#pragma unroll
        for (unsigned j = 0; j < 16; ++j) { const unsigned c = xb_ld(&bar[XB_XCNT(j)]); sum += c; cnt += (c > 0u) ? 1u : 0u; mine = (j == x) ? c : mine; }
        if (sum == G) break;
        __builtin_amdgcn_s_sleep(1);
        if ((++sp & 255u) == 0u) { if (xb_ld(&bar[XB_TMO])) break; if (sp > XB_SPIN_CAP) { atomicAdd(&bar[XB_TMO], 1u); break; } }
    }
    nloc = mine > 0u ? mine : 1u; nx = cnt > 0u ? cnt : 1u;
}
__device__ __forceinline__ void xcd_barrier(const XcdBarrier& b) {
    asm volatile("s_waitcnt vmcnt(0)" ::: "memory");
    __syncthreads();
    if (threadIdx.x == 0) {
        unsigned* bar = b.bar;
        __builtin_amdgcn_s_waitcnt(0);
        unsigned nloc = b.st[0], nx = b.st[1];
        if (nloc == 0u) { xcd_barrier_complete(bar, b.x, nloc, nx); b.st[0] = nloc; b.st[1] = nx; }
        const unsigned old = xb_add(&bar[XB_XSUB(b.x)], 1u);
        const unsigned gen = old / nloc;
        if (old + 1u == (gen + 1u) * nloc) {
            __builtin_amdgcn_fence(__ATOMIC_RELEASE, "agent");
            asm volatile("s_waitcnt vmcnt(0)" ::: "memory");
            const unsigned og = xb_add(&bar[XB_TOP], 1u);
            const unsigned tg = og / nx;
            if (og + 1u == (tg + 1u) * nx) xb_add(&bar[XB_TOPGEN], 1u);
            else XB_SPIN(xb_ld(&bar[XB_TOPGEN]) == tg, bar);
            __builtin_amdgcn_fence(__ATOMIC_ACQUIRE, "agent");
            xb_add(&bar[XB_XGEN(b.x)], 1u);
            asm volatile("s_waitcnt vmcnt(0)" ::: "memory");
        } else {
            XB_SPIN(xb_ld(&bar[XB_XGEN(b.x)]) == gen, bar);
            __builtin_amdgcn_fence(__ATOMIC_ACQUIRE, "agent");
            asm volatile("s_waitcnt vmcnt(0)" ::: "memory");
        }
    }
    __syncthreads();
}
namespace pg8 {
#define PG8_LAS __attribute__((address_space(3)))
typedef unsigned short bf16_t;
typedef short bf16x8 __attribute__((ext_vector_type(8)));
typedef float f32x4 __attribute__((ext_vector_type(4)));
typedef unsigned u32x4 __attribute__((ext_vector_type(4)));
constexpr int BM = 256, BK = 64, HALF = 128, HTB = HALF * BK * 2, STAGE_BYTES = 8 * HTB, NXCD = 8, WGM = 8;

__host__ __device__ __forceinline__ int lds_byte(int r, int c) { const int st = (r >> 4) * 2 + (c >> 5), rr = r & 15, cc = c & 31, ob = rr * 64 + cc * 2; return st * 1024 + (ob ^ (((ob >> 9) & 1) << 5)); }
__host__ __device__ __forceinline__ void stage_rc(int b, int& R, int& C) { const int st = b / 1024, sb = b % 1024, swz = sb ^ (((sb >> 9) & 1) << 5); R = (st >> 1) * 16 + swz / 64; C = (st & 1) * 32 + (swz % 64) / 2; }
__host__ __device__ __forceinline__ int perm32(int rho) { const int n = rho >> 4, i = rho & 15; return 8 * (i >> 2) + 4 * n + (i & 3); }

struct Unit { int pm, pn; };
struct Gemm { const bf16_t* A; const bf16_t* Bt; int M, N, K; };

struct StaticOrder {
    int nM, nN, nwg, G, c;
    __host__ __device__ void init(int M, int N, int G_, int c_) { nM = M / BM; nN = N / BM; nwg = nM * nN; G = G_; c = c_; }
    __host__ __device__ bool next(int i, Unit& u) const {
        const long L = (long)i * G + c; if (L >= nwg) return false;
        int wgid = (int)L; { const int q = nwg / NXCD, r = nwg % NXCD, xcd = wgid % NXCD, off = wgid / NXCD; wgid = (xcd < r ? xcd * (q + 1) : r * (q + 1) + (xcd - r) * q) + off; }
        const int nig = WGM * nN, gid = wgid / nig, fm = gid * WGM, gsz = (nM - fm) < WGM ? (nM - fm) : WGM;
        u.pm = fm + ((wgid % nig) % gsz); u.pn = (wgid % nig) / gsz; return true;
    }
    __device__ __forceinline__ void a_ready(const Unit&) const {}
    __device__ __forceinline__ void done(const Unit&) const {}
};


struct InProjOrder {
    StaticOrder base; int G, c, last;
    __host__ __device__ void init(int last_, int G_, int c_) { last = last_; base.init((last_ ? 64 : 68) * 256, 27 * 256, G_, c_); G = G_; c = c_; }
    __host__ __device__ bool next(int i, Unit& u) const {
        const long L = (long)i * G + c;
        if (!last || L < 1728) return base.next(i, u);
        if (L >= 1768) return false;
        const int k = (int)L - 1728, j = k % 10; u.pm = 64 + k / 10;
        u.pn = j == 0 ? 0 : j == 1 ? 1 : j == 2 ? 14 : j == 3 ? 15 : j == 4 ? 16 : j == 5 ? 17 : j == 6 ? 21 : j == 7 ? 22 : j == 8 ? 23 : 26;
        return true;
    }
    __device__ __forceinline__ void a_ready(const Unit&) const {}
    __device__ __forceinline__ void done(const Unit&) const {}
};
template <class Epi, class Sched, bool ALIGN_EPI = false, bool SP2 = false>
__device__ __forceinline__ void gemm_phase(PG8_LAS unsigned char* lds, const Gemm g, const Sched& S, const Epi& E, const int tid) {
    const int wid = __builtin_amdgcn_readfirstlane(tid >> 6), lane = tid & 63, wr = wid >> 2, wc = wid & 3, fr = lane & 15, fq = lane >> 4;
    const int K = g.K, nt = K / BK;
    unsigned voffA[2], voffB[2];
#pragma unroll
    for (int i = 0; i < 2; ++i) { int R, C; stage_rc(tid * 16 + i * 8192, R, C); const int Rb = Epi::PERM ? ((R & ~31) + perm32(R & 31)) : R;
        voffA[i] = (unsigned)(R * K + C) * 2u; voffB[i] = (unsigned)(Rb * K + C) * 2u; }
    const size_t kstep = (size_t)(BK * 2);
    const size_t hstep = (size_t)HALF * K * 2;
    const size_t tstep = 2 * hstep;
    const unsigned ldsw = (unsigned)wid * 1024u;
    const int aoff = lds_byte(wr * 64 + fr, fq * 8), boff = lds_byte(wc * 32 + fr, fq * 8);
#define PG8_SA(b, h) (((b) * 2 + (h)) * HTB)
#define PG8_SB(b, h) ((4 + (b) * 2 + (h)) * HTB)
#define PG8_STAGE(bufoff, gbase, voff) do { _Pragma("unroll") for (int _i = 0; _i < 2; ++_i) \
        __builtin_amdgcn_global_load_lds((const unsigned*)((const char*)(gbase) + (voff)[_i]), (PG8_LAS unsigned*)(lds + (bufoff) + ldsw + _i * 8192), 16, 0, 0); } while (0)
#define PG8_LDA(dst, b, h) do { _Pragma("unroll") for (int m = 0; m < 4; ++m) _Pragma("unroll") for (int k = 0; k < 2; ++k) dst[m][k] = *(const PG8_LAS bf16x8*)(lds + PG8_SA(b, h) + aoff + m * 2048 + k * 1024); } while (0)
#define PG8_LDB(dst, b, h) do { _Pragma("unroll") for (int n = 0; n < 2; ++n) _Pragma("unroll") for (int k = 0; k < 2; ++k) dst[n][k] = *(const PG8_LAS bf16x8*)(lds + PG8_SB(b, h) + boff + n * 2048 + k * 1024); } while (0)
#define PG8_MMA(ai, bj, At, Bt) do { __builtin_amdgcn_s_setprio(1); _Pragma("unroll") for (int m = 0; m < 4; ++m) _Pragma("unroll") for (int n = 0; n < 2; ++n) _Pragma("unroll") for (int k = 0; k < 2; ++k) \
        acc[ai][bj][m][n] = __builtin_amdgcn_mfma_f32_16x16x32_bf16(Bt[n][k], At[m][k], acc[ai][bj][m][n], 0, 0, 0); __builtin_amdgcn_s_setprio(0); } while (0)
#define PG8_WAIT_V(n) asm volatile("s_waitcnt vmcnt(" #n ")" ::: "memory")
#define PG8_WAIT_L(n) asm volatile("s_waitcnt lgkmcnt(" #n ")" ::: "memory")
#define PG8_BAR __builtin_amdgcn_s_barrier()
#define PG8_SCHED __builtin_amdgcn_sched_barrier(0)
    Unit cur, nxt; int ui = 0;
    if (!S.next(0, cur)) return;
    f32x4 acc[2][2][4][2];
#pragma unroll
    for (int a = 0; a < 2; ++a)
#pragma unroll
        for (int b = 0; b < 2; ++b)
#pragma unroll
            for (int m = 0; m < 4; ++m)
#pragma unroll
                for (int n = 0; n < 2; ++n) acc[a][b][m][n] = (f32x4){0.f, 0.f, 0.f, 0.f};
    bf16x8 At[4][2], B0[2][2], B1[2][2];
    const char* cA = (const char*)g.A + (size_t)cur.pm * tstep; const char* cB = (const char*)g.Bt + (size_t)cur.pn * tstep;
    S.a_ready(cur);
    if constexpr (SP2) {
        PG8_STAGE(PG8_SB(0, 0), cB, voffB); PG8_STAGE(PG8_SB(0, 1), cB + hstep, voffB); PG8_STAGE(PG8_SA(0, 0), cA, voffA); PG8_STAGE(PG8_SA(0, 1), cA + hstep, voffA);
        if (wr == 1) PG8_BAR;
        PG8_WAIT_V(2); PG8_BAR;
        PG8_STAGE(PG8_SB(1, 0), cB + kstep, voffB); PG8_STAGE(PG8_SA(1, 0), cA + kstep, voffA); PG8_STAGE(PG8_SB(1, 1), cB + hstep + kstep, voffB);
        PG8_WAIT_V(6); PG8_BAR;
    } else {
        PG8_STAGE(PG8_SB(0, 0), cB, voffB); PG8_STAGE(PG8_SA(0, 0), cA, voffA); PG8_STAGE(PG8_SB(0, 1), cB + hstep, voffB); PG8_STAGE(PG8_SA(0, 1), cA + hstep, voffA);
        if (wr == 1) PG8_BAR;
        PG8_WAIT_V(4); PG8_BAR;
        PG8_STAGE(PG8_SB(1, 0), cB + kstep, voffB); PG8_STAGE(PG8_SA(1, 0), cA + kstep, voffA); PG8_STAGE(PG8_SB(1, 1), cB + hstep + kstep, voffB);
        PG8_WAIT_V(6); PG8_BAR;
    }
    for (;;) {
        const bool has_next = S.next(ui + 1, nxt);
        const char* nA = has_next ? (const char*)g.A + (size_t)nxt.pm * tstep : cA; const char* nB = has_next ? (const char*)g.Bt + (size_t)nxt.pn * tstep : cB;
        for (int t = 0; t < nt; t += 2) {
            const bool last = (t == nt - 2);
            const char* a1 = cA + (size_t)(t + 1) * kstep;
            const char* a2 = last ? nA : cA + (size_t)(t + 2) * kstep; const char* b2 = last ? nB : cB + (size_t)(t + 2) * kstep;
            const char* a3 = a2 + kstep; const char* b3 = b2 + kstep;
            if (last && has_next) S.a_ready(nxt);
            if constexpr (SP2) {
            PG8_LDB(B0, 0, 0); PG8_LDB(B1, 0, 1); PG8_SCHED; PG8_LDA(At, 0, 0); PG8_STAGE(PG8_SA(1, 1), a1 + hstep, voffA);
            PG8_WAIT_V(8); PG8_WAIT_L(0); PG8_BAR; PG8_MMA(0, 0, At, B0); PG8_MMA(0, 1, At, B1); PG8_BAR; PG8_SCHED;
            PG8_LDA(At, 0, 1); PG8_STAGE(PG8_SB(0, 0), b2, voffB); PG8_STAGE(PG8_SB(0, 1), b2 + hstep, voffB); PG8_STAGE(PG8_SA(0, 0), a2, voffA);
            PG8_WAIT_V(8); PG8_WAIT_L(0); PG8_BAR; PG8_MMA(1, 0, At, B0); PG8_MMA(1, 1, At, B1); PG8_BAR; PG8_SCHED;
            PG8_LDB(B0, 1, 0); PG8_LDB(B1, 1, 1); PG8_SCHED; PG8_LDA(At, 1, 0); PG8_STAGE(PG8_SA(0, 1), a2 + hstep, voffA);
            PG8_WAIT_V(8); PG8_WAIT_L(0); PG8_BAR; PG8_MMA(0, 0, At, B0); PG8_MMA(0, 1, At, B1); PG8_BAR; PG8_SCHED;
            PG8_LDA(At, 1, 1); PG8_STAGE(PG8_SB(1, 0), b3, voffB); PG8_STAGE(PG8_SB(1, 1), b3 + hstep, voffB); PG8_STAGE(PG8_SA(1, 0), a3, voffA);
            PG8_WAIT_V(8); PG8_WAIT_L(0); PG8_BAR; PG8_MMA(1, 0, At, B0); PG8_MMA(1, 1, At, B1); PG8_BAR; PG8_SCHED;
            } else {
            PG8_LDB(B0, 0, 0); PG8_SCHED; PG8_LDA(At, 0, 0); PG8_STAGE(PG8_SA(1, 1), a1 + hstep, voffA);
            PG8_WAIT_L(8); PG8_BAR; PG8_WAIT_L(0); PG8_MMA(0, 0, At, B0); PG8_BAR; PG8_SCHED;
            PG8_LDB(B1, 0, 1); PG8_STAGE(PG8_SB(0, 0), b2, voffB);
            PG8_BAR; PG8_WAIT_L(0); PG8_MMA(0, 1, At, B1); PG8_BAR;
            PG8_LDA(At, 0, 1); PG8_STAGE(PG8_SA(0, 0), a2, voffA);
            PG8_BAR; PG8_WAIT_L(0); PG8_MMA(1, 0, At, B0); PG8_BAR; PG8_SCHED;
            PG8_STAGE(PG8_SB(0, 1), b2 + hstep, voffB);
            PG8_WAIT_V(6); PG8_BAR; PG8_MMA(1, 1, At, B1); PG8_BAR;
            PG8_LDB(B0, 1, 0); PG8_SCHED; PG8_LDA(At, 1, 0); PG8_STAGE(PG8_SA(0, 1), a2 + hstep, voffA);
            PG8_WAIT_L(8); PG8_BAR; PG8_WAIT_L(0); PG8_MMA(0, 0, At, B0); PG8_BAR; PG8_SCHED;
            PG8_LDB(B1, 1, 1); PG8_STAGE(PG8_SB(1, 0), b3, voffB);
            PG8_BAR; PG8_WAIT_L(0); PG8_MMA(0, 1, At, B1); PG8_BAR;
            PG8_LDA(At, 1, 1); PG8_STAGE(PG8_SA(1, 0), a3, voffA);
            PG8_BAR; PG8_WAIT_L(0); PG8_MMA(1, 0, At, B0); PG8_BAR; PG8_SCHED;
            PG8_STAGE(PG8_SB(1, 1), b3 + hstep, voffB);
            PG8_WAIT_V(6); PG8_BAR; PG8_MMA(1, 1, At, B1); PG8_BAR;
            }
        }
        if constexpr (ALIGN_EPI) { if (wr == 0) PG8_BAR; }
        { int fr_ = fr, fq_ = fq; asm volatile("" : "+v"(fr_), "+v"(fq_));
          E(acc, cur, wr, wc, fr_, fq_); } S.done(cur);
        if (!has_next) break;
#pragma unroll
        for (int a = 0; a < 2; ++a)
#pragma unroll
            for (int b = 0; b < 2; ++b)
#pragma unroll
                for (int m = 0; m < 4; ++m)
#pragma unroll
                    for (int n = 0; n < 2; ++n) acc[a][b][m][n] = (f32x4){0.f, 0.f, 0.f, 0.f};
        cur = nxt; cA = nA; cB = nB; ++ui;
        if constexpr (ALIGN_EPI) { if (wr == 1) PG8_BAR; }
    }
    PG8_WAIT_V(0);
    if constexpr (!ALIGN_EPI) { if (wr == 0) PG8_BAR; }
    PG8_BAR;
#undef PG8_SA
#undef PG8_SB
#undef PG8_STAGE
#undef PG8_LDA
#undef PG8_LDB
#undef PG8_MMA
#undef PG8_WAIT_V
#undef PG8_WAIT_L
#undef PG8_BAR
#undef PG8_SCHED
}
}
__device__ __forceinline__ void prep_adaln(const float* c, const float* cctx, const float* adaw, const float* adab, float* MOD, int it, LAS float* sv, int tid) {
    const int l = it / 384, r = it % 384, ntile = r >> 5, ks = r & 31, k0 = ks * 64;
    if (tid < 320) { const int v = tid >> 6, k = tid & 63; const float cv = v < 4 ? c[v * D + k0 + k] : cctx[k0 + k]; sv[tid] = cv / (1.0f + expf(-cv)); }
    __syncthreads();
    const int n = ntile * 512 + tid; const float* w = adaw + (size_t)l * D * ADA + (size_t)k0 * ADA + n;
    float acc[5] = {0.f, 0.f, 0.f, 0.f, 0.f};
#pragma unroll 1
    for (int k0_ = 0; k0_ < 64; k0_ += 32) {
        float wv[32];
#pragma unroll
        for (int k = 0; k < 32; ++k) wv[k] = w[(size_t)(k0_ + k) * ADA];
#pragma unroll
        for (int k = 0; k < 32; ++k) {
#pragma unroll
            for (int v = 0; v < 5; ++v) acc[v] += sv[v * 64 + k0_ + k] * wv[k]; } }
    if (ks == 0) { const float bb = adab[l * ADA + n];
#pragma unroll
        for (int v = 0; v < 5; ++v) acc[v] += bb; }
#pragma unroll
    for (int v = 0; v < 5; ++v) atomicAdd(MOD + (size_t)(l * 5 + v) * ADA + n, acc[v]);
    __syncthreads();
}

__device__ __forceinline__ void prep_hymlp(const DArgs& a, float* H3out, bf16_t* H3b, int l, int Lx, int t0, LAS unsigned char* lds, int tid) {
    LAS float* zs = (LAS float*)lds;
    LAS float* h1 = (LAS float*)(lds + 4608);
    LAS float* h2 = (LAS float*)(lds + 4608 + 8192);
    LAS float* w1s = (LAS float*)(lds + 24576);
    LAS float* w2s = w1s + 33 * 64;
    LAS float* w3s = w2s + 64 * 64;
    { const float* w1 = a.in[I_HW1] + (size_t)l * 33 * 64; const float* w2 = a.in[I_HW2] + (size_t)l * 64 * 64; const float* w3 = a.in[I_HW3] + (size_t)l * 64 * 64;
      for (int i = tid; i < 33 * 64; i += NT) w1s[i] = w1[i];
      for (int i = tid; i < 64 * 64; i += NT) { w2s[i] = w2[i]; w3s[i] = w3[i]; } }
    for (int i = tid; i < 32 * 33; i += NT) { const int pos = i / 33, f = i % 33, t = t0 + pos;
        float z;
        if (f == 0) z = (float)t / (float)(Lx - 1);
        else { const int j = (f - 1) & 15; const float fj = 1e-4f + (float)j * ((15.0f - 1e-4f) / 15.0f); const float wpos = (6.283185307179586f * (float)t) / (float)Lx; const float arg = fj * wpos;
               z = (f <= 16) ? cosf(arg) : -sinf(arg); }
        zs[pos * 36 + f] = z; }
    __syncthreads();
    const int pos = tid >> 4, f4 = (tid & 15) * 4, t = t0 + pos;
    f32x4 s = *(const f32x4*)(a.in[I_HB1] + l * 64 + f4);
#pragma unroll 3
    for (int j = 0; j < 33; ++j) s += zs[pos * 36 + j] * *(const LAS f32x4*)(w1s + j * 64 + f4);
    { const f32x4 fr = *(const f32x4*)(a.in[I_HF1] + l * 64 + f4); *(LAS f32x4*)(h1 + pos * 64 + f4) = (f32x4){sinf(fr.x * s.x), sinf(fr.y * s.y), sinf(fr.z * s.z), sinf(fr.w * s.w)}; }
    __syncthreads();
    s = *(const f32x4*)(a.in[I_HB2] + l * 64 + f4);
#pragma unroll 4
    for (int j = 0; j < 64; ++j) s += h1[pos * 64 + j] * *(const LAS f32x4*)(w2s + j * 64 + f4);
    { const f32x4 fr = *(const f32x4*)(a.in[I_HF2] + l * 64 + f4); *(LAS f32x4*)(h2 + pos * 64 + f4) = (f32x4){sinf(fr.x * s.x), sinf(fr.y * s.y), sinf(fr.z * s.z), sinf(fr.w * s.w)}; }
    __syncthreads();
    s = *(const f32x4*)(a.in[I_HB3] + l * 64 + f4);
#pragma unroll 4
    for (int j = 0; j < 64; ++j) s += h2[pos * 64 + j] * *(const LAS f32x4*)(w3s + j * 64 + f4);
    { const f32x4 fr = *(const f32x4*)(a.in[I_HF3] + l * 64 + f4); const f32x4 hv = (f32x4){sinf(fr.x * s.x), sinf(fr.y * s.y), sinf(fr.z * s.z), sinf(fr.w * s.w)}; *(f32x4*)(H3out + (size_t)t * 64 + f4) = hv;
      if (H3b) { u32x2 pk; pk.x = pk2(hv.x, hv.y); pk.y = pk2(hv.z, hv.w); *(u32x2*)(H3b + (size_t)t * 64 + f4) = pk; } }
    __syncthreads();
}

__device__ __forceinline__ void transpose_item(const float* W, int ldw, int srccol_lane  , int k0, bf16_t* WT, int K, int dstrow0, LAS float* scr, int lane) {
    float wv[32];
#pragma unroll
    for (int i = 0; i < 32; ++i) { const int kk = 2 * i + (lane >> 5); wv[i] = srccol_lane >= 0 ? W[(size_t)(k0 + kk) * ldw + srccol_lane] : 0.f; }
#pragma unroll
    for (int i = 0; i < 32; ++i) { const int kk = 2 * i + (lane >> 5); scr[kk * 33 + (lane & 31)] = wv[i]; }
    LDS_WAIT();
    const int c = lane & 7;
#pragma unroll
    for (int j = 0; j < 4; ++j) { const int n = (lane >> 3) + 8 * j; const LAS float* s = scr + (8 * c) * 33 + n;
        u32x4 o; o.x = pk2(s[0 * 33], s[1 * 33]); o.y = pk2(s[2 * 33], s[3 * 33]); o.z = pk2(s[4 * 33], s[5 * 33]); o.w = pk2(s[6 * 33], s[7 * 33]);
        *(u32x4*)(WT + (size_t)(dstrow0 + n) * K + k0 + 8 * c) = o; }
    LDS_WAIT();
}
__device__ __forceinline__ int win_srccol(int n) {
    if (n >= 3072 && n < 4096) { const int u = (n - 3072) & 127, grp = u >> 3, e = u & 7; return (n & ~127) + (e < 4 ? 4 * grp + e : 64 + 4 * grp + (e - 4)); }
    return n < 6144 ? n : (n < 6656 ? n + 32 : (n < 6688 ? n - 512 : -1));
}

__device__ __forceinline__ void norm_row(const float* xrow, const float* nw, const float* mod, bf16_t* hrow, int lane) {
    f32x4 v[8]; float ss = 0.f;
#pragma unroll
    for (int j = 0; j < 8; ++j) { v[j] = ((const f32x4*)xrow)[lane + 64 * j]; ss += (v[j].x * v[j].x + v[j].y * v[j].y) + (v[j].z * v[j].z + v[j].w * v[j].w); }
    const float rstd = rsqrtf(wave_sum(ss) * (1.0f / D) + EPS);
#pragma unroll
    for (int j = 0; j < 8; ++j) { const int k = 4 * (lane + 64 * j);
        const f32x4 w = *(const f32x4*)(nw + k), sh = *(const f32x4*)(mod + k), sc = *(const f32x4*)(mod + D + k);
        const f32x4 o = v[j] * rstd * w * (sc + 1.0f) + sh;
        u32x2 pk; pk.x = pk2(o.x, o.y); pk.y = pk2(o.z, o.w);
        *(u32x2*)(hrow + k) = pk; }
}

__device__ __forceinline__ float block_sum(float v, LAS float* red, int tid) {
    v = wave_sum(v);
    if ((tid & 63) == 0) red[tid >> 6] = v;
    __syncthreads();
    float t = 0.f;
#pragma unroll
    for (int i = 0; i < NWAVES; ++i) t += red[i];
    __syncthreads();
    return t;
}
constexpr float HY_D0 = -3.0701134573253945f  , HY_D1 = -15.350567286626973f  ;

__device__ __forceinline__ void filt_ctx_item(const DArgs& a, unsigned char* ws, LAS unsigned char* lds, int c, int tid) {
    LAS float* w4s = (LAS float*)lds; LAS float* red = (LAS float*)(lds + 1024);
    if (tid < 256) { const int cc = tid >> 6, f = tid & 63; w4s[tid] = a.in[I_HW4][(size_t)f * 2048 + (cc >> 1) * 1024 + (cc & 1) * 512 + c]; }
    __syncthreads();
    const float dl = fabsf(HY_D0 + (HY_D1 - HY_D0) * ((float)c / 511.0f));
    const float* H3C = (const float*)(ws + WS_H3C);
    const int n = tid, dir = n >= 256 ? 1 : 0, t = dir ? (512 - n) : n;
    float s0 = 0.f, s1 = 0.f;
    if (n != 256) {
        const f32x4* hr = (const f32x4*)(H3C + (size_t)t * 64);
#pragma unroll
        for (int q = 0; q < 16; ++q) { const f32x4 hv = hr[q]; const f32x4 wa = ((const LAS f32x4*)(w4s + (dir * 2 + 0) * 64))[q], wb = ((const LAS f32x4*)(w4s + (dir * 2 + 1) * 64))[q];
            s0 += (hv.x * wa.x + hv.y * wa.y) + (hv.z * wa.z + hv.w * wa.w); s1 += (hv.x * wb.x + hv.y * wb.y) + (hv.z * wb.z + hv.w * wb.w); }
        const float dec = expf(-((float)t / 255.0f) * dl); s0 *= dec; s1 *= dec;
    }
    const float rs0 = rsqrtf(block_sum(s0 * s0, red, tid) + EPS), rs1 = rsqrtf(block_sum(s1 * s1, red, tid) + EPS);
    float* KC = (float*)(ws + WS_KC);
    KC[(size_t)(0 * 512 + c) * 512 + n] = s0 * rs0; KC[(size_t)(1 * 512 + c) * 512 + n] = s1 * rs1;
    __syncthreads();
}

__device__ __forceinline__ void prep_rope(f32x2* RT, int it, int tid) {
    const int idx = it * NT + tid, pos = idx >> 6, j = idx & 63;
    float ang;
    if (pos < SEQL) { const float inv = exp2f(-(float)(j & 31) * (13.287712379549449f / 32.0f)); ang = (float)(j < 32 ? (pos >> 6) : (pos & 63)) * inv; }
    else { const float inv = exp2f(-(float)j * (13.287712379549449f / 64.0f)); ang = (float)(pos - SEQL) * inv; }
    float sn, cs; sincosf(ang, &sn, &cs);
    RT[idx] = (f32x2){cs, sn};
}

__device__ __forceinline__ float sconv3(const bf16_t* p, int t, int Lx, float w0, float w1, float w2, float cb) {
    const float x0 = t > 0 ? bf2f(p[t - 1]) : 0.f, x1 = bf2f(p[t]), x2 = t < Lx - 1 ? bf2f(p[t + 1]) : 0.f;
    return w0 * x0 + w1 * x1 + w2 * x2 + cb;
}
__device__ __forceinline__ void ctx_conv256(const LAS float* kc, const LAS float* z, int b, int t4, int half, float (&o)[4]) {
    o[0] = o[1] = o[2] = o[3] = 0.f;
#pragma unroll 4
    for (int s4 = 0; s4 < 32; ++s4) { const int s = 128 * half + 4 * s4, d = 4 * t4 - s;
        const f32x4 zv = *(const LAS f32x4*)(z + b * 256 + s);
        const f32x4 wl = *(const LAS f32x4*)(kc + ((d - 4) & 511)), wh = *(const LAS f32x4*)(kc + (d & 511));
        const float w[8] = {wl.x, wl.y, wl.z, wl.w, wh.x, wh.y, wh.z, wh.w};
        const float zz[4] = {zv.x, zv.y, zv.z, zv.w};
#pragma unroll
        for (int j = 0; j < 4; ++j)
#pragma unroll
            for (int i = 0; i < 4; ++i) o[j] += w[4 + j - i] * zz[i]; }
}
__device__ __forceinline__ void hyena_ctx_item(const DArgs& a, unsigned char* ws, LAS unsigned char* lds, int c, int tid) {
    LAS float* kc = (LAS float*)lds; LAS float* za = (LAS float*)(lds + 4096); LAS float* zb = (LAS float*)(lds + 8192); LAS float* part = (LAS float*)(lds + 12288);
    const float* KC = (const float*)(ws + WS_KC);
    kc[tid] = KC[(size_t)(0 * 512 + c) * 512 + tid]; kc[512 + tid] = KC[(size_t)(1 * 512 + c) * 512 + tid];
    const float* cw = a.in[I_HCW]; const float* cbp = a.in[I_HCB];
    const float wv0 = cw[c], wv1 = cw[1536 + c], wv2 = cw[3072 + c], bv = cbp[c];
    const float wa0 = cw[512 + c], wa1 = cw[1536 + 512 + c], wa2 = cw[3072 + 512 + c], ba = cbp[512 + c];
    const float wb0 = cw[1024 + c], wb1 = cw[1536 + 1024 + c], wb2 = cw[3072 + 1024 + c], bb = cbp[1024 + c];
    const float bias0 = a.in[I_HBIAS][0 * 512 + c], bias1 = a.in[I_HBIAS][1 * 512 + c];
    const bf16_t* PT = (const bf16_t*)(ws + WS_PT);
    const int half = tid >> 8, b = (tid >> 6) & 3, t4 = tid & 63; const int rb = NLAT + b * LC;
    const bf16_t* pv = PT + (size_t)(PT_V + c) * MR + rb; const bf16_t* pg1 = PT + (size_t)(PT_G1 + c) * MR + rb; const bf16_t* pg2 = PT + (size_t)(PT_G2 + c) * MR + rb; const bf16_t* phg = PT + (size_t)(PT_HG + c) * MR + rb;
    bf16_t* GATED = (bf16_t*)(ws + WS_H);
    float z0[4], z1[4], o[4];
#pragma unroll
    for (int j = 0; j < 4; ++j) { z0[j] = sconv3(pv, 4 * t4 + j, LC, wv0, wv1, wv2, bv); }
    if (half == 0) *(LAS f32x4*)(za + b * 256 + 4 * t4) = (f32x4){z0[0], z0[1], z0[2], z0[3]};
    __syncthreads();
    ctx_conv256(kc, za, b, t4, half, o);
    if (half == 1) *(LAS f32x4*)(part + b * 256 + 4 * t4) = (f32x4){o[0], o[1], o[2], o[3]};
    __syncthreads();
    if (half == 0) { const f32x4 pp = *(const LAS f32x4*)(part + b * 256 + 4 * t4); const float ps[4] = {pp.x, pp.y, pp.z, pp.w};
#pragma unroll
        for (int j = 0; j < 4; ++j) z1[j] = sconv3(pg1, 4 * t4 + j, LC, wa0, wa1, wa2, ba) * (o[j] + ps[j] + bias0 * z0[j]);
        *(LAS f32x4*)(zb + b * 256 + 4 * t4) = (f32x4){z1[0], z1[1], z1[2], z1[3]}; }
    __syncthreads();
    ctx_conv256(kc + 512, zb, b, t4, half, o);
    if (half == 1) *(LAS f32x4*)(part + b * 256 + 4 * t4) = (f32x4){o[0], o[1], o[2], o[3]};
    __syncthreads();
    if (half == 0) { const f32x4 pp = *(const LAS f32x4*)(part + b * 256 + 4 * t4); const float ps[4] = {pp.x, pp.y, pp.z, pp.w};
#pragma unroll
        for (int j = 0; j < 4; ++j) { const int t = 4 * t4 + j; const float z2 = sconv3(pg2, t, LC, wb0, wb1, wb2, bb) * (o[j] + ps[j] + bias1 * z1[j]);
            GATED[(size_t)(rb + t) * D + 512 + c] = (bf16_t)f2bf(z2 * siluf_(bf2f(phg[t]))); } }
    __syncthreads();
}

struct EpiInProj {
    static constexpr bool PERM = true, AFTER_DRAIN = false;
    bf16_t* P; bf16_t* PT; float* LR; const float* RT;
    __device__ __forceinline__ void operator()(const pg8::f32x4 (&acc)[2][2][4][2], const pg8::Unit& u, int wr, int wc, int fr, int fq) const {
        const int row0 = u.pm * 256 + wr * 64 + fr, pn = u.pn;
        if (pn >= 12 && pn < 16) {
            const int colbase = pn * 256 - 2048 + wc * 32 + 8 * fq; const int j0 = 4 * (4 * wc + fq); const float ksc = pn >= 14 ? 0.08838834764831845f : 1.0f;
#pragma unroll
            for (int ai = 0; ai < 2; ++ai)
#pragma unroll
                for (int m = 0; m < 4; ++m) { const int row = row0 + ai * 128 + m * 16; const int pos = row < NLAT ? (row & (SEQL - 1)) : SEQL + ((row - NLAT) & (LC - 1));
                    const pg8::f32x4 t0 = *(const pg8::f32x4*)(RT + ((size_t)pos * 64 + j0) * 2), t1 = *(const pg8::f32x4*)(RT + ((size_t)pos * 64 + j0) * 2 + 4);
                    bf16_t* rowp = P + (size_t)row * LDP + colbase;
#pragma unroll
                    for (int bj = 0; bj < 2; ++bj) { const pg8::f32x4 x1 = acc[ai][bj][m][0] * ksc, x2 = acc[ai][bj][m][1] * ksc;
                        u32x4 w; w.x = pk2(x1[0] * t0[0] - x2[0] * t0[1], x1[1] * t0[2] - x2[1] * t0[3]); w.y = pk2(x1[2] * t1[0] - x2[2] * t1[1], x1[3] * t1[2] - x2[3] * t1[3]);
                        w.z = pk2(x1[0] * t0[1] + x2[0] * t0[0], x1[1] * t0[3] + x2[1] * t0[2]); w.w = pk2(x1[2] * t1[1] + x2[2] * t1[0], x1[3] * t1[3] + x2[3] * t1[2]);
                        *(u32x4*)(rowp + bj * 128) = w; } }
        } else if (pn < 4 || (pn >= 16 && pn < 26)) {
            const int colbase = (pn < 4 ? pn * 256 : pn * 256 - 2048) + wc * 32 + 8 * fq;
#pragma unroll
            for (int ai = 0; ai < 2; ++ai)
#pragma unroll
                for (int m = 0; m < 4; ++m) { bf16_t* rowp = P + (size_t)(row0 + ai * 128 + m * 16) * LDP + colbase;
#pragma unroll
                    for (int bj = 0; bj < 2; ++bj) { const pg8::f32x4 v0 = acc[ai][bj][m][0], v1 = acc[ai][bj][m][1];
                        u32x4 w; w.x = pk2(v0[0], v0[1]); w.y = pk2(v0[2], v0[3]); w.z = pk2(v1[0], v1[1]); w.w = pk2(v1[2], v1[3]);
                        *(u32x4*)(rowp + bj * 128) = w; } }
        } else if (pn < 12) {
            const int colbase = (pn - 4) * 256 + wc * 32 + 8 * fq;
#pragma unroll
            for (int bj = 0; bj < 2; ++bj)
#pragma unroll
                for (int n = 0; n < 2; ++n)
#pragma unroll
                    for (int j = 0; j < 4; ++j) { bf16_t* cp = PT + (size_t)(colbase + bj * 128 + 4 * n + j) * MR + row0;
#pragma unroll
                        for (int ai = 0; ai < 2; ++ai)
#pragma unroll
                            for (int m = 0; m < 4; ++m) cp[ai * 128 + m * 16] = (bf16_t)f2bf(acc[ai][bj][m][n][j]);
                        asm volatile("" ::: "memory"); }
        } else {
            if (wc == 0) {
#pragma unroll
                for (int ai = 0; ai < 2; ++ai)
#pragma unroll
                    for (int m = 0; m < 4; ++m) { float* rowp = LR + (size_t)(row0 + ai * 128 + m * 16) * 32 + 8 * fq;
                        *(pg8::f32x4*)(rowp) = acc[ai][0][m][0]; *(pg8::f32x4*)(rowp + 4) = acc[ai][0][m][1]; }
            }
        }
    }
};
struct EpiGlu {
    static constexpr bool PERM = true, AFTER_DRAIN = false;
    const bf16_t* GG; bf16_t* GATED; const float* bias;
    __device__ __forceinline__ void operator()(const pg8::f32x4 (&acc)[2][2][4][2], const pg8::Unit& u, int wr, int wc, int fr, int fq) const {
        const int row0 = u.pm * 256 + wr * 64 + fr, col0 = u.pn * 256 + wc * 32 + 8 * fq;
        pg8::f32x4 b0[2], b1[2];
#pragma unroll
        for (int bj = 0; bj < 2; ++bj) { b0[bj] = *(const pg8::f32x4*)(bias + col0 + bj * 128); b1[bj] = *(const pg8::f32x4*)(bias + col0 + bj * 128 + 4); }
#pragma unroll
        for (int ai = 0; ai < 2; ++ai) {
            u32x4 gg[4][2];
#pragma unroll
            for (int m = 0; m < 4; ++m)
#pragma unroll
                for (int bj = 0; bj < 2; ++bj) gg[m][bj] = *(const u32x4*)(GG + (size_t)(row0 + ai * 128 + m * 16) * 512 + col0 + bj * 128);
#pragma unroll
            for (int m = 0; m < 4; ++m) { const size_t row = (size_t)(row0 + ai * 128 + m * 16);
#pragma unroll
                for (int bj = 0; bj < 2; ++bj) { float g[8], res[8]; unpack8(gg[m][bj], g);
#pragma unroll
                    for (int j = 0; j < 4; ++j) { res[j] = g[j] * sigmoidf_(acc[ai][bj][m][0][j] + b0[bj][j]); res[4 + j] = g[4 + j] * sigmoidf_(acc[ai][bj][m][1][j] + b1[bj][j]); }
                    *(u32x4*)(GATED + row * D + col0 + bj * 128) = pack8(res); } }
            asm volatile("" ::: "memory");
        }
    }
};
struct EpiOut {
    static constexpr bool PERM = false, AFTER_DRAIN = false;
    const float* xl_old; const float* xc_old; float* xl_new; float* xc_new; const float* mod;
    __device__ __forceinline__ void operator()(const pg8::f32x4 (&acc)[2][2][4][2], const pg8::Unit& u, int wr, int wc, int fr, int fq) const {
        const int row0 = u.pm * 256 + wr * 64 + fr, col0 = u.pn * 256 + wc * 32 + 4 * fq;
        const bool lat = u.pm < 64;
        const float* xo = lat ? xl_old : xc_old - (size_t)NLAT * D; float* xn = lat ? xl_new : xc_new - (size_t)NLAT * D;
#pragma unroll
        for (int ai = 0; ai < 2; ++ai) {
            const int v = lat ? ((u.pm * 256 + ai * 128) >> 12) : 4;
            const float* gt = mod + (size_t)v * ADA + 2 * D;
#pragma unroll
            for (int m = 0; m < 4; ++m) { const size_t off = (size_t)(row0 + ai * 128 + m * 16) * D + col0;
#pragma unroll
                for (int bj = 0; bj < 2; ++bj)
#pragma unroll
                    for (int n = 0; n < 2; ++n) { const int cc = bj * 128 + n * 16; const pg8::f32x4 gv = *(const pg8::f32x4*)(gt + col0 + cc), xv = *(const pg8::f32x4*)(xo + off + cc);
                        *(pg8::f32x4*)(xn + off + cc) = xv + gv * acc[ai][bj][m][n]; } }
        }
    }
};
typedef short bf16x8 __attribute__((ext_vector_type(8)));
typedef short bf16x4 __attribute__((ext_vector_type(4)));
__device__ __forceinline__ unsigned off_b(unsigned row, unsigned ch) { return 256u * row + 16u * (ch ^ (((row & 3) << 2) | ((row >> 2) & 3))); }
__device__ __forceinline__ bf16x8 img_row_frag(const LAS unsigned char* img, unsigned lane, unsigned rb, unsigned s) { return *(const LAS bf16x8*)(img + off_b((lane & 15) + 16 * rb, 4 * s + (lane >> 4))); }
__device__ __forceinline__ bf16x4 img_tr4(const LAS unsigned char* img, unsigned lane, unsigned c, unsigned row0) {
    const unsigned q = (lane & 15) >> 2, p = lane & 3;
    return __builtin_amdgcn_ds_read_tr16_b64_v4i16((LAS bf16x4*)(img + off_b(row0 + q, 2 * c + (p >> 1)) + 8 * (p & 1)));
}
__device__ __forceinline__ bf16x8 img_tr_frag(const LAS unsigned char* img, unsigned lane, unsigned c, unsigned ks) {
    const unsigned g = lane >> 4; const bf16x4 lo = img_tr4(img, lane, c, 32 * ks + 8 * g), hi = img_tr4(img, lane, c, 32 * ks + 8 * g + 4);
    return __builtin_shufflevector(lo, hi, 0, 1, 2, 3, 4, 5, 6, 7);
}
__device__ __forceinline__ bf16x8 img_tr_frag_acc(const LAS unsigned char* img, unsigned lane, unsigned c, unsigned ks) {
    const unsigned g = lane >> 4; const bf16x4 lo = img_tr4(img, lane, c, 32 * ks + 4 * g), hi = img_tr4(img, lane, c, 32 * ks + 16 + 4 * g);
    return __builtin_shufflevector(lo, hi, 0, 1, 2, 3, 4, 5, 6, 7);
}
__device__ __forceinline__ bf16x8 acc_pair_frag(const f32x4 a0, const f32x4 a1) {
    u32x4 w; w.x = pk2(a0.x, a0.y); w.y = pk2(a0.z, a0.w); w.z = pk2(a1.x, a1.y); w.w = pk2(a1.z, a1.w);
    return __builtin_bit_cast(bf16x8, w);
}
#define MFMA16(A_, B_, C_) __builtin_amdgcn_mfma_f32_16x16x32_bf16((A_), (B_), (C_), 0, 0, 0)
__device__ __forceinline__ void stage_tile128(LAS unsigned char* img, const bf16_t* g, size_t ld, int tid) {
#pragma unroll
    for (int i = 0; i < 4; ++i) { const int n = tid + NT * i, row = n >> 4, ch = n & 15; *(LAS u32x4*)(img + off_b(row, ch)) = *(const u32x4*)(g + (size_t)row * ld + ch * 8); }
}

constexpr int RCH = 128, RNCH = 34;
constexpr size_t WS_RST = WS_OB;
__device__ __forceinline__ int ret_rowbase(int b, int cc) { return cc < 2 ? NLAT + b * LC + cc * RCH : b * SEQL + (cc - 2) * RCH; }
__device__ __forceinline__ float ret_log2g(int h) { return log2f(1.0f - exp2f(-5.0f - (float)h)); }

__device__ __forceinline__ void ret_passA(unsigned char* ws, LAS unsigned char* lds, int item, int tid) {
    const int bh = item / RNCH, cc = item % RNCH, b = bh >> 2, h = bh & 3;
    const int lane = tid & 63, w = tid >> 6, g = lane >> 4;
    LAS unsigned char* KF = lds; LAS unsigned char* KB = lds + 32768; LAS unsigned char* VI = lds + 65536;
    const bf16_t* P = (const bf16_t*)(ws + WS_P) + (size_t)ret_rowbase(b, cc) * LDP;
    const float l2g = ret_log2g(h);
    __syncthreads();
#pragma unroll
    for (int i = 0; i < 4; ++i) { const int n = tid + NT * i, row = n >> 4, ch = n & 15;
        const u32x4 kr = *(const u32x4*)(P + (size_t)row * LDP + PC_RK + h * 128 + ch * 8);
        float kf[8], a[8], c[8]; unpack8(kr, kf);
        const float sf = exp2f(l2g * (float)(RCH - 1 - row)), sb = exp2f(l2g * (float)row);
#pragma unroll
        for (int x = 0; x < 8; ++x) { a[x] = kf[x] * sf; c[x] = kf[x] * sb; }
        *(LAS u32x4*)(KF + off_b(row, ch)) = pack8(a); *(LAS u32x4*)(KB + off_b(row, ch)) = pack8(c);
        *(LAS u32x4*)(VI + off_b(row, ch)) = *(const u32x4*)(P + (size_t)row * LDP + PC_RV + h * 128 + ch * 8); }
    __syncthreads();
    bf16x8 af[4], ab[4];
#pragma unroll
    for (int ks = 0; ks < 4; ++ks) { af[ks] = img_tr_frag(KF, lane, w, ks); ab[ks] = img_tr_frag(KB, lane, w, ks); }
    bf16_t* ST = (bf16_t*)(ws + WS_RST) + ((size_t)(bh * 2) * RNCH + cc) * (128 * 128);
#pragma unroll 2
    for (int E = 0; E < 8; ++E) {
        f32x4 cf = {0.f, 0.f, 0.f, 0.f}, cb = {0.f, 0.f, 0.f, 0.f};
#pragma unroll
        for (int ks = 0; ks < 4; ++ks) { const bf16x8 vb = img_tr_frag(VI, lane, E, ks); cf = MFMA16(af[ks], vb, cf); cb = MFMA16(ab[ks], vb, cb); }
        const int e = 16 * E + (lane & 15), d0 = 16 * w + 4 * g;
        u32x2 o; o.x = pk2(cf.x, cf.y); o.y = pk2(cf.z, cf.w); *(u32x2*)(ST + (size_t)e * 128 + d0) = o;
        o.x = pk2(cb.x, cb.y); o.y = pk2(cb.z, cb.w); *(u32x2*)(ST + (size_t)RNCH * 128 * 128 + (size_t)e * 128 + d0) = o;
    }
}
__device__ __forceinline__ void ret_passB(unsigned char* ws, int gt  ) {
    const int el = gt & 2047, bd = gt >> 11, bh = bd >> 1, dir = bd & 1, h = bh & 3;
    const float gC = exp2f(ret_log2g(h) * (float)RCH);
    bf16_t* base = (bf16_t*)(ws + WS_RST) + (size_t)bd * RNCH * (128 * 128) + (size_t)el * 8;
    float acc[8];
#pragma unroll
    for (int x = 0; x < 8; ++x) acc[x] = 0.f;
#pragma unroll 1
    for (int s0 = 0; s0 < RNCH; s0 += 17) {
        u32x4 kvr[17];
#pragma unroll
        for (int j = 0; j < 17; ++j) { const int s = s0 + j; const int cc = dir == 0 ? s : (s < 2 ? 1 - s : 35 - s); kvr[j] = *(const u32x4*)(base + (size_t)cc * (128 * 128)); }
#pragma unroll
        for (int j = 0; j < 17; ++j) { const int s = s0 + j; const int cc = dir == 0 ? s : (s < 2 ? 1 - s : 35 - s);
            float kv[8]; unpack8(kvr[j], kv);
            *(u32x4*)(base + (size_t)cc * (128 * 128)) = pack8(acc);
#pragma unroll
            for (int x = 0; x < 8; ++x) acc[x] = gC * acc[x] + kv[x]; }
    }
}
__device__ __forceinline__ void ret_passC(const DArgs& a, unsigned char* ws, LAS unsigned char* lds, int l, int item, int tid) {
    const int bh = item / RNCH, cc = item % RNCH, b = bh >> 2, h = bh & 3;
    const int lane = tid & 63, w = tid >> 6, g = lane >> 4, il = lane & 15;
    LAS unsigned char* KI = lds; LAS unsigned char* VI = lds + 32768; LAS unsigned char* SF = lds + 65536; LAS unsigned char* SB = lds + 98304;
    const int rowbase = ret_rowbase(b, cc);
    const bf16_t* P = (const bf16_t*)(ws + WS_P) + (size_t)rowbase * LDP;
    const bf16_t* STf = (const bf16_t*)(ws + WS_RST) + ((size_t)(bh * 2) * RNCH + cc) * (128 * 128);
    const bf16_t* STb = STf + (size_t)RNCH * 128 * 128;
    __syncthreads();
    stage_tile128(KI, P + PC_RK + h * 128, LDP, tid); stage_tile128(VI, P + PC_RV + h * 128, LDP, tid);
    stage_tile128(SF, STf, 128, tid); stage_tile128(SB, STb, 128, tid);
    bf16x8 qf[4];
    { const bf16_t* qr = P + (size_t)(16 * w + il) * LDP + PC_RQ + h * 128 + 8 * g;
#pragma unroll
      for (int ks = 0; ks < 4; ++ks) qf[ks] = *(const bf16x8*)(qr + 32 * ks); }
    __syncthreads();
    const float l2g = ret_log2g(h);
    const int iloc = 16 * w + il;
    f32x4 o[8];
    { const float sf = exp2f(l2g * (float)(iloc + 1)), sb = exp2f(l2g * (float)(RCH - iloc));
#pragma unroll
      for (int E = 0; E < 8; ++E) { f32x4 rf = {0.f, 0.f, 0.f, 0.f}, rb = {0.f, 0.f, 0.f, 0.f};
#pragma unroll
          for (int ks = 0; ks < 4; ++ks) { rf = MFMA16(img_row_frag(SF, lane, E, ks), qf[ks], rf); rb = MFMA16(img_row_frag(SB, lane, E, ks), qf[ks], rb); }
          o[E] = rf * sf + rb * sb; } }
    f32x4 at[8];
#pragma unroll
    for (int T = 0; T < 8; ++T) { f32x4 c = {0.f, 0.f, 0.f, 0.f};
#pragma unroll
        for (int ks = 0; ks < 4; ++ks) c = MFMA16(img_row_frag(KI, lane, T, ks), qf[ks], c);
#pragma unroll
        for (int r = 0; r < 4; ++r) { const int j = 16 * T + 4 * g + r; const int dd = iloc > j ? iloc - j : j - iloc; c[r] *= (dd == 0 ? 2.0f : exp2f(l2g * (float)dd)); }
        at[T] = c; }
#pragma unroll
    for (int s = 0; s < 4; ++s) { const bf16x8 bfr = acc_pair_frag(at[2 * s], at[2 * s + 1]);
#pragma unroll
        for (int E = 0; E < 8; ++E) o[E] = MFMA16(img_tr_frag_acc(VI, lane, E, s), bfr, o[E]); }
    float ss = 0.f;
#pragma unroll
    for (int E = 0; E < 8; ++E) ss += (o[E].x * o[E].x + o[E].y * o[E].y) + (o[E].z * o[E].z + o[E].w * o[E].w);
    ss += __shfl_xor(ss, 16); ss += __shfl_xor(ss, 32);
    const float rn = rsqrtf(ss * (1.0f / 128.0f) + EPS);
    const size_t row = (size_t)rowbase + iloc;
    const bf16_t* gp = (const bf16_t*)(ws + WS_P) + row * LDP + PC_RG + h * 128 + 4 * g;
    const float* nw = a.in[I_RNW] + l * 512 + h * 128 + 4 * g;
    bf16_t* op = (bf16_t*)(ws + WS_H) + row * D + 1024 + h * 128 + 4 * g;
#pragma unroll
    for (int E = 0; E < 8; ++E) { const u32x2 gr = *(const u32x2*)(gp + 16 * E); const f32x4 nv = *(const f32x4*)(nw + 16 * E);
        u32x2 ov; ov.x = pk2(o[E].x * rn * nv.x * siluf_(bflo(gr.x)), o[E].y * rn * nv.y * siluf_(bfhi(gr.x)));
        ov.y = pk2(o[E].z * rn * nv.z * siluf_(bflo(gr.y)), o[E].w * rn * nv.w * siluf_(bfhi(gr.y)));
        *(u32x2*)(op + 16 * E) = ov; }
}
constexpr int GCH = 64, GNCH = 68;
constexpr size_t WS_GST = WS_OB + (size_t)2 * OBSZ * 2;
constexpr size_t WS_GDEC = WS_END;
constexpr size_t WS_H3B = WS_GDEC + (size_t)16 * 2 * GNCH * 64 * 4;
constexpr size_t WS_ROPE = WS_H3B + (size_t)2 * 4096 * 64 * 2;
constexpr size_t WS_TWID = WS_ROPE + (size_t)(SEQL + LC) * 64 * 8;
constexpr size_t WS_END2 = WS_TWID + 4096 * 8;
__device__ __forceinline__ int gla_rowbase(int b, int cg) { return cg < 4 ? NLAT + b * LC + cg * GCH : b * SEQL + (cg - 4) * GCH; }

constexpr int GLS = 68;
__device__ __forceinline__ void gla_gates_compute(const DArgs& a, unsigned char* ws, LAS float* BF, LAS float* BB, LAS float* GW  , int l, int h, int rowbase, int tid) {
    const int t = tid >> 3, d8 = tid & 7;
    const float* lr = (const float*)(ws + WS_LR) + (size_t)(rowbase + t) * 32;
    f32x4 lv[8];
#pragma unroll
    for (int q = 0; q < 8; ++q) lv[q] = ((const f32x4*)lr)[q];
    { const int dir = tid >> 8, r = (tid >> 4) & 15, c4 = (tid & 15) * 4;
      *(LAS f32x4*)(GW + (dir * 17 + r) * 64 + c4) = *(const f32x4*)(a.in[I_GGW] + (size_t)(l * 2 + dir) * 16 * 256 + r * 256 + h * 64 + c4);
      if (tid < 32) { const int dd = tid >> 4; *(LAS f32x4*)(GW + (dd * 17 + 16) * 64 + c4) = *(const f32x4*)(a.in[I_GGB] + (size_t)(l * 2 + dd) * 256 + h * 64 + c4); } }
    __syncthreads();
    bf16_t* GLG = (bf16_t*)(ws + WS_WIN);
#pragma unroll
    for (int dir = 0; dir < 2; ++dir) {
        const LAS float* gw = GW + dir * 17 * 64 + 8 * d8;
        f32x4 s0 = *(const LAS f32x4*)(gw + 16 * 64), s1 = *(const LAS f32x4*)(gw + 16 * 64 + 4);
#pragma unroll
        for (int j = 0; j < 16; ++j) { const float lj = lv[dir * 4 + (j >> 2)][j & 3]; s0 += lj * *(const LAS f32x4*)(gw + j * 64); s1 += lj * *(const LAS f32x4*)(gw + j * 64 + 4); }
        LAS float* dst = (dir ? BB : BF) + t * GLS + 8 * d8;
        float la[8];
#pragma unroll
        for (int x = 0; x < 8; ++x) { const float s = x < 4 ? s0[x] : s1[x - 4]; const float e = __expf(-fabsf(s)); const float ls = fminf(s, 0.f) - __logf(1.0f + e); la[x] = ls * (1.0f / 16.0f); }
        const u32x4 pk = pack8(la);
        *(u32x4*)(GLG + ((size_t)dir * MR + rowbase + t) * 256 + h * 64 + 8 * d8) = pk;
        float lq[8]; unpack8(pk, lq);
        *(LAS f32x4*)dst = (f32x4){lq[0], lq[1], lq[2], lq[3]}; *(LAS f32x4*)(dst + 4) = (f32x4){lq[4], lq[5], lq[6], lq[7]};
    }
}
__device__ __forceinline__ void gla_gates_load(unsigned char* ws, LAS float* BF, LAS float* BB, int h, int rowbase, int tid) {
    const int t = tid >> 3, d8 = tid & 7;
    const bf16_t* GLG = (const bf16_t*)(ws + WS_WIN);
#pragma unroll
    for (int dir = 0; dir < 2; ++dir) { float lq[8]; unpack8(*(const u32x4*)(GLG + ((size_t)dir * MR + rowbase + t) * 256 + h * 64 + 8 * d8), lq);
        LAS float* dst = (dir ? BB : BF) + t * GLS + 8 * d8;
        *(LAS f32x4*)dst = (f32x4){lq[0], lq[1], lq[2], lq[3]}; *(LAS f32x4*)(dst + 4) = (f32x4){lq[4], lq[5], lq[6], lq[7]}; }
}
__device__ __forceinline__ void gla_scan(LAS float* BF, LAS float* BB, int tid) {
    const int lane = tid & 63, w = tid >> 6;
    __syncthreads();
#pragma unroll 4
    for (int c = 0; c < 16; ++c) { const int col = 16 * w + c; const int dir = col >> 6, d = col & 63;
        LAS float* p = (dir ? BB : BF) + (dir ? 63 - lane : lane) * GLS + d;
        float v = *p;
#pragma unroll
        for (int off = 1; off < 64; off <<= 1) { const float u = __shfl_up(v, off); if (lane >= off) v += u; }
        *p = v; }
    __syncthreads();
}

__device__ __forceinline__ void gla_passA(const DArgs& a, unsigned char* ws, LAS unsigned char* lds, int l, int item, int tid) {
    const int bh = item / GNCH, cg = item % GNCH, b = bh >> 2, h = bh & 3;
    const int lane = tid & 63, w = tid >> 6, g = lane >> 4;
    LAS float* BF = (LAS float*)lds; LAS float* BB = (LAS float*)(lds + 17408); LAS unsigned char* KH = lds + 34816; LAS unsigned char* VI = lds + 34816 + 16384;
    const int rowbase = gla_rowbase(b, cg);
    const bf16_t* P = (const bf16_t*)(ws + WS_P) + (size_t)rowbase * LDP;
    const int t = tid >> 3, d8 = tid & 7;
    const u32x4 kraw = *(const u32x4*)(P + (size_t)t * LDP + PC_GK + h * 64 + 8 * d8);
    u32x4 vraw[2];
#pragma unroll
    for (int i = 0; i < 2; ++i) { const int n = tid + NT * i; vraw[i] = *(const u32x4*)(P + (size_t)(n >> 4) * LDP + PC_GV + h * 128 + (n & 15) * 8); }
    gla_gates_compute(a, ws, BF, BB, (LAS float*)(lds + 34816 + 32768), l, h, rowbase, tid);
    gla_scan(BF, BB, tid);
    { float kf[8], x0[8], x1[8]; unpack8(kraw, kf);
#pragma unroll
      for (int x = 0; x < 8; ++x) { const int d = 8 * d8 + x; x0[x] = kf[x] * __expf(BF[63 * GLS + d] - BF[t * GLS + d]); x1[x] = kf[x] * __expf(BB[d] - BB[t * GLS + d]); }
      *(LAS u32x4*)(KH + off_b(t, d8)) = pack8(x0); *(LAS u32x4*)(KH + off_b(t, 8 + d8)) = pack8(x1);
#pragma unroll
      for (int i = 0; i < 2; ++i) { const int n = tid + NT * i; *(LAS u32x4*)(VI + off_b(n >> 4, n & 15)) = vraw[i]; }
      if (tid < 128) { const int dir = tid >> 6, d = tid & 63; ((float*)(ws + WS_GDEC))[((size_t)(bh * 2 + dir) * GNCH + cg) * 64 + d] = __expf(dir ? BB[d] : BF[63 * GLS + d]); } }
    __syncthreads();
    const int dir = w >> 2, Dt = w & 3;
    bf16x8 af[2];
#pragma unroll
    for (int ks = 0; ks < 2; ++ks) af[ks] = img_tr_frag(KH, lane, dir * 4 + Dt, ks);
    bf16_t* ST = (bf16_t*)(ws + WS_GST) + ((size_t)(bh * 2 + dir) * GNCH + cg) * (128 * 64);
#pragma unroll 2
    for (int E = 0; E < 8; ++E) {
        f32x4 c = {0.f, 0.f, 0.f, 0.f};
#pragma unroll
        for (int ks = 0; ks < 2; ++ks) c = MFMA16(af[ks], img_tr_frag(VI, lane, E, ks), c);
        u32x2 o; o.x = pk2(c.x, c.y); o.y = pk2(c.z, c.w);
        *(u32x2*)(ST + (size_t)(16 * E + (lane & 15)) * 64 + 16 * Dt + 4 * g) = o;
    }
}
__device__ __forceinline__ void gla_passB(unsigned char* ws, LAS unsigned char* lds, int blk, int tid) {
    const int bd = blk >> 1, dir = bd & 1, el = (blk & 1) * 512 + tid;
    LAS float* decs = (LAS float*)lds;
    { const float* dsrc = (const float*)(ws + WS_GDEC) + (size_t)bd * GNCH * 64;
      for (int i = tid; i < GNCH * 64; i += NT) decs[i] = dsrc[i]; }
    __syncthreads();
    bf16_t* base = (bf16_t*)(ws + WS_GST) + (size_t)bd * GNCH * (128 * 64) + (size_t)el * 8;
    const int d0 = (el & 7) * 8;
    float acc[8];
#pragma unroll
    for (int x = 0; x < 8; ++x) acc[x] = 0.f;
#pragma unroll 1
    for (int s0 = 0; s0 < GNCH; s0 += 17) {
        u32x4 kvr[17];
#pragma unroll
        for (int j = 0; j < 17; ++j) { const int s = s0 + j; const int cg = dir == 0 ? s : (s < 4 ? 3 - s : 71 - s); kvr[j] = *(const u32x4*)(base + (size_t)cg * (128 * 64)); }
#pragma unroll
        for (int j = 0; j < 17; ++j) { const int s = s0 + j; const int cg = dir == 0 ? s : (s < 4 ? 3 - s : 71 - s);
            float kv[8]; unpack8(kvr[j], kv);
            const f32x4 q0 = *(const LAS f32x4*)(decs + cg * 64 + d0), q1 = *(const LAS f32x4*)(decs + cg * 64 + d0 + 4);
            *(u32x4*)(base + (size_t)cg * (128 * 64)) = pack8(acc);
#pragma unroll
            for (int x = 0; x < 8; ++x) acc[x] = (x < 4 ? q0[x] : q1[x - 4]) * acc[x] + kv[x]; }
    }
    __syncthreads();
}
__device__ __forceinline__ void gla_passC(const DArgs& a, unsigned char* ws, LAS unsigned char* lds, int l, int item, int tid) {
    const int bh = item / GNCH, cg = item % GNCH, b = bh >> 2, h = bh & 3;
    const int lane = tid & 63, w = tid >> 6, g = lane >> 4, il = lane & 15;
    LAS float* BF = (LAS float*)lds; LAS float* BB = (LAS float*)(lds + 17408);
    LAS unsigned char* QKF = lds + 34816; LAS unsigned char* QKB = QKF + 16384; LAS unsigned char* QH = QKB + 16384; LAS unsigned char* VI = QH + 16384; LAS unsigned char* SI = VI + 16384;
    const int rowbase = gla_rowbase(b, cg);
    const bf16_t* P = (const bf16_t*)(ws + WS_P) + (size_t)rowbase * LDP;
    const int t = tid >> 3, d8 = tid & 7;
    const u32x4 qraw = *(const u32x4*)(P + (size_t)t * LDP + PC_GQ + h * 64 + 8 * d8), kraw = *(const u32x4*)(P + (size_t)t * LDP + PC_GK + h * 64 + 8 * d8);
    u32x4 vraw[2], sraw[4];
#pragma unroll
    for (int i = 0; i < 2; ++i) { const int n = tid + NT * i; vraw[i] = *(const u32x4*)(P + (size_t)(n >> 4) * LDP + PC_GV + h * 128 + (n & 15) * 8); }
    { const bf16_t* STf = (const bf16_t*)(ws + WS_GST) + ((size_t)(bh * 2) * GNCH + cg) * (128 * 64); const bf16_t* STb = STf + (size_t)GNCH * 128 * 64;
#pragma unroll
      for (int i = 0; i < 4; ++i) { const int n = tid + NT * i, row = n >> 4, ch = n & 15; sraw[i] = *(const u32x4*)((ch < 8 ? STf : STb) + (size_t)row * 64 + (ch & 7) * 8); } }
    gla_gates_load(ws, BF, BB, h, rowbase, tid);
    gla_scan(BF, BB, tid);
    { float qf[8], kf[8], o0[8], o1[8], o2[8], o3[8], o4[8], o5[8];
      unpack8(qraw, qf); unpack8(kraw, kf);
#pragma unroll
      for (int x = 0; x < 8; ++x) { const int d = 8 * d8 + x; const float bf = BF[t * GLS + d], bb = BB[t * GLS + d], rf = BF[31 * GLS + d], rb = BB[32 * GLS + d]; const float q = qf[x] * 0.125f;
          o0[x] = q * __expf(bf - rf); o1[x] = kf[x] * __expf(rf - bf); o2[x] = q * __expf(bb - rb); o3[x] = kf[x] * __expf(rb - bb); o4[x] = q * __expf(bf); o5[x] = q * __expf(bb); }
      *(LAS u32x4*)(QKF + off_b(t, d8)) = pack8(o0); *(LAS u32x4*)(QKF + off_b(t, 8 + d8)) = pack8(o1);
      *(LAS u32x4*)(QKB + off_b(t, d8)) = pack8(o2); *(LAS u32x4*)(QKB + off_b(t, 8 + d8)) = pack8(o3);
      *(LAS u32x4*)(QH + off_b(t, d8)) = pack8(o4); *(LAS u32x4*)(QH + off_b(t, 8 + d8)) = pack8(o5);
#pragma unroll
      for (int i = 0; i < 2; ++i) { const int n = tid + NT * i; *(LAS u32x4*)(VI + off_b(n >> 4, n & 15)) = vraw[i]; }
#pragma unroll
      for (int i = 0; i < 4; ++i) { const int n = tid + NT * i; *(LAS u32x4*)(SI + off_b(n >> 4, n & 15)) = sraw[i]; } }
    __syncthreads();
    const int ib = w & 3, eh = w >> 2, iloc = 16 * ib + il;
    f32x4 at[4];
    { bf16x8 qff[2], qfb[2];
#pragma unroll
      for (int ks = 0; ks < 2; ++ks) { qff[ks] = img_row_frag(QKF, lane, ib, ks); qfb[ks] = img_row_frag(QKB, lane, ib, ks); }
#pragma unroll
      for (int T = 0; T < 4; ++T) { f32x4 cf = {0.f, 0.f, 0.f, 0.f}, cb = {0.f, 0.f, 0.f, 0.f};
#pragma unroll
          for (int ks = 0; ks < 2; ++ks) { cf = MFMA16(img_row_frag(QKF, lane, T, 2 + ks), qff[ks], cf); cb = MFMA16(img_row_frag(QKB, lane, T, 2 + ks), qfb[ks], cb); }
#pragma unroll
          for (int r = 0; r < 4; ++r) { const int j = 16 * T + 4 * g + r; cf[r] = (j <= iloc ? cf[r] : 0.f) + (j >= iloc ? cb[r] : 0.f); }
          at[T] = cf; } }
    f32x4 o[4];
    { bf16x8 hf[2], hb[2];
#pragma unroll
      for (int ks = 0; ks < 2; ++ks) { hf[ks] = img_row_frag(QH, lane, ib, ks); hb[ks] = img_row_frag(QH, lane, ib, 2 + ks); }
#pragma unroll
      for (int E4 = 0; E4 < 4; ++E4) { const int E = 4 * eh + E4; f32x4 c = {0.f, 0.f, 0.f, 0.f};
#pragma unroll
          for (int ks = 0; ks < 2; ++ks) { c = MFMA16(img_row_frag(SI, lane, E, ks), hf[ks], c); c = MFMA16(img_row_frag(SI, lane, E, 2 + ks), hb[ks], c); }
          o[E4] = c; } }
#pragma unroll
    for (int s = 0; s < 2; ++s) { const bf16x8 bfr = acc_pair_frag(at[2 * s], at[2 * s + 1]);
#pragma unroll
        for (int E4 = 0; E4 < 4; ++E4) o[E4] = MFMA16(img_tr_frag_acc(VI, lane, 4 * eh + E4, s), bfr, o[E4]); }
    float ss = 0.f;
#pragma unroll
    for (int E4 = 0; E4 < 4; ++E4) ss += (o[E4].x * o[E4].x + o[E4].y * o[E4].y) + (o[E4].z * o[E4].z + o[E4].w * o[E4].w);
    ss += __shfl_xor(ss, 16); ss += __shfl_xor(ss, 32);
    LAS float* red = (LAS float*)lds;
    if (g == 0) red[eh * 64 + iloc] = ss;
    __syncthreads();
    const float rn = rsqrtf((red[iloc] + red[64 + iloc]) * (1.0f / 128.0f) + EPS);
    const size_t row = (size_t)rowbase + iloc;
    const bf16_t* gp = (const bf16_t*)(ws + WS_P) + row * LDP + PC_GG + h * 128 + 64 * eh + 4 * g;
    const float* nw = a.in[I_GNW] + l * 512 + h * 128 + 64 * eh + 4 * g;
    bf16_t* op = (bf16_t*)(ws + WS_H) + row * D + 1536 + h * 128 + 64 * eh + 4 * g;
#pragma unroll
    for (int E4 = 0; E4 < 4; ++E4) { const u32x2 gr = *(const u32x2*)(gp + 16 * E4); const f32x4 nv = *(const f32x4*)(nw + 16 * E4);
        u32x2 ov; ov.x = pk2(o[E4].x * rn * nv.x * siluf_(bflo(gr.x)), o[E4].y * rn * nv.y * siluf_(bfhi(gr.x)));
        ov.y = pk2(o[E4].z * rn * nv.z * siluf_(bflo(gr.y)), o[E4].w * rn * nv.w * siluf_(bfhi(gr.y)));
        *(u32x2*)(op + 16 * E4) = ov; }
}
constexpr int SNCH = 68;
constexpr size_t WS_S5ST = WS_OB + (size_t)4 * OBSZ * 2;
constexpr size_t WS_S5BTB = WS_S5BT;
constexpr size_t WS_S5CPB = WS_S5BT + 524288;
constexpr size_t WS_S5A64 = WS_S5BT + 1048576;

__device__ __forceinline__ void prep_s5b(const DArgs& a, unsigned char* ws, int it, int tid) {
    const int idx = it * 512 + tid;
    const int gi = idx >> 6, p = idx & 63;
    const float a_re = a.in[I_S5ARE][idx], a_im = a.in[I_S5AIM][idx], ldt = a.in[I_S5LDT][gi];
    const float dt = expf(ldt), mag = expf(a_re * dt);
    float sn, cs; sincosf(a_im * dt, &sn, &cs);
    const float ab_re = mag * cs, ab_im = mag * sn, den = a_re * a_re + a_im * a_im, nr = ab_re - 1.0f;
    const float co_re = (nr * a_re + ab_im * a_im) / den, co_im = (ab_im * a_re - nr * a_im) / den;
    ((f32x2*)(ws + WS_S5AB))[idx] = (f32x2){ab_re, ab_im};
    float pr = ab_re, pi = ab_im;
#pragma unroll
    for (int q = 0; q < 6; ++q) { const float nr2 = pr * pr - pi * pi, ni2 = 2.0f * pr * pi; pr = nr2; pi = ni2; }
    ((f32x2*)(ws + WS_S5A64))[idx] = (f32x2){pr, pi};
    const float* bre = a.in[I_S5BRE] + (size_t)idx * 16; const float* bim = a.in[I_S5BIM] + (size_t)idx * 16;
    float tr[16], ti[16];
#pragma unroll
    for (int i = 0; i < 16; ++i) { const float br = bre[i], bi = bim[i]; tr[i] = co_re * br - co_im * bi; ti[i] = co_re * bi + co_im * br; }
    bf16_t* btb = (bf16_t*)(ws + WS_S5BTB) + (size_t)gi * 128 * 16;
#pragma unroll
    for (int hlf = 0; hlf < 2; ++hlf) { u32x4 w0, w1; const float* s = hlf ? ti : tr;
        w0.x = pk2(s[0], s[1]); w0.y = pk2(s[2], s[3]); w0.z = pk2(s[4], s[5]); w0.w = pk2(s[6], s[7]); w1.x = pk2(s[8], s[9]); w1.y = pk2(s[10], s[11]); w1.z = pk2(s[12], s[13]); w1.w = pk2(s[14], s[15]);
        *(u32x4*)(btb + (size_t)(64 * hlf + p) * 16) = w0; *(u32x4*)(btb + (size_t)(64 * hlf + p) * 16 + 8) = w1; }
    bf16_t* cpb = (bf16_t*)(ws + WS_S5CPB) + (size_t)gi * 16 * 128;
    const float* cre = a.in[I_S5CRE] + (size_t)gi * 1024; const float* cim = a.in[I_S5CIM] + (size_t)gi * 1024;
#pragma unroll
    for (int i = 0; i < 16; ++i) *(unsigned*)(cpb + i * 128 + 2 * p) = pk2(cre[i * 64 + p], -cim[i * 64 + p]);
}

struct S5Unit { bf16x8 btf[8]; f32x2 ab; f32x2 h; const bf16_t* cp; };
template <bool PASSC> __device__ __forceinline__ void s5_load_unit(S5Unit& U, unsigned char* ws, const bf16_t* P, const f32x2* ST, int l, int b, int cs, int rowbase, int grp, int dir, int lane) {
    const int g = lane >> 4, il = lane & 15;
    const bf16x8 zero8 = {0, 0, 0, 0, 0, 0, 0, 0};
    const int gi = (l * 2 + dir) * 32 + grp;
    U.ab = ((const f32x2*)(ws + WS_S5AB))[gi * 64 + lane];
    const size_t sidx = ((size_t)(b * SNCH + cs) * 2 + dir) * 2048 + grp * 64 + lane;
    U.h = PASSC ? ST[sidx] : (f32x2){0.f, 0.f};
    const bf16_t* bt = (const bf16_t*)(ws + WS_S5BTB) + (size_t)gi * 128 * 16 + (size_t)il * 16 + 8 * (g & 1);
#pragma unroll
    for (int Pt = 0; Pt < 8; ++Pt) { const bf16x8 v = *(const bf16x8*)(bt + Pt * 256); U.btf[Pt] = g < 2 ? v : zero8; }
    U.cp = (const bf16_t*)(ws + WS_S5CPB) + (size_t)gi * 16 * 128 + (size_t)il * 128 + 8 * g;
}
__device__ __forceinline__ void s5_load_u(bf16x8 (&ufa)[4], const bf16_t* P, int rowbase, int grp, int lane) {
    const int g = lane >> 4, il = lane & 15; const bf16x8 zero8 = {0, 0, 0, 0, 0, 0, 0, 0};
#pragma unroll
    for (int Tt = 0; Tt < 4; ++Tt) { const bf16x8 v = *(const bf16x8*)(P + (size_t)(rowbase + 16 * Tt + il) * LDP + PC_S5U + grp * 16 + 8 * (g & 1)); ufa[Tt] = g < 2 ? v : zero8; }
}
template <bool PASSC, int DIR> __device__ __forceinline__ void s5_run_unit(const S5Unit& U, const bf16x8 (&ufa)[4], f32x4 (&yacc)[4], f32x2& hout, LAS float* BU, LAS unsigned char* HW, int lane) {
    const int g = lane >> 4, il = lane & 15;
    f32x2 h = U.h; const f32x2 ab = U.ab;
    bf16x8 cpf[4];
    if (PASSC) {
#pragma unroll
        for (int ks = 0; ks < 4; ++ks) cpf[ks] = *(const bf16x8*)(U.cp + 32 * ks); }
    f32x4 d[8];
#pragma unroll
    for (int Pt = 0; Pt < 8; ++Pt) d[Pt] = MFMA16(U.btf[Pt], ufa[DIR ? 3 : 0], ((f32x4){0.f, 0.f, 0.f, 0.f}));
#pragma unroll
    for (int wi = 0; wi < 4; ++wi) {
        const int Tt = DIR ? 3 - wi : wi;
#pragma unroll
        for (int Pt = 0; Pt < 8; ++Pt) {
#pragma unroll
            for (int r = 0; r < 4; ++r) BU[(16 * Pt + 4 * g + r) * 20 + il] = d[Pt][r]; }
        asm volatile("" ::: "memory");
        if (!PASSC) {
            f32x4 br[4], bi[4];
#pragma unroll
            for (int q = 0; q < 4; ++q) { br[q] = *(const LAS f32x4*)(BU + lane * 20 + 4 * q); bi[q] = *(const LAS f32x4*)(BU + (64 + lane) * 20 + 4 * q); }
            if (wi < 3) {
#pragma unroll
                for (int Pt = 0; Pt < 8; ++Pt) d[Pt] = MFMA16(U.btf[Pt], ufa[DIR ? 2 - wi : wi + 1], ((f32x4){0.f, 0.f, 0.f, 0.f})); }
#pragma unroll
            for (int s = 0; s < 16; ++s) { const int tt = DIR ? 15 - s : s;
                const float hr = __builtin_fmaf(ab.x, h.x, __builtin_fmaf(-ab.y, h.y, br[tt >> 2][tt & 3])), hi = __builtin_fmaf(ab.x, h.y, __builtin_fmaf(ab.y, h.x, bi[tt >> 2][tt & 3]));
                h = (f32x2){hr, hi}; }
        } else {
#pragma unroll
            for (int hf2 = 0; hf2 < 2; ++hf2) { const int q0 = DIR ? 2 - 2 * hf2 : 2 * hf2;
                f32x4 br[2], bi[2];
#pragma unroll
                for (int q = 0; q < 2; ++q) { br[q] = *(const LAS f32x4*)(BU + lane * 20 + 4 * (q0 + q)); bi[q] = *(const LAS f32x4*)(BU + (64 + lane) * 20 + 4 * (q0 + q)); }
#pragma unroll
                for (int s = 0; s < 8; ++s) { const int t8 = DIR ? 7 - s : s; const int tt = 4 * q0 + t8;
                    const float hr = __builtin_fmaf(ab.x, h.x, __builtin_fmaf(-ab.y, h.y, br[t8 >> 2][t8 & 3])), hi = __builtin_fmaf(ab.x, h.y, __builtin_fmaf(ab.y, h.x, bi[t8 >> 2][t8 & 3]));
                    h = (f32x2){hr, hi};
                    *(LAS unsigned*)(HW + off_b(tt, lane >> 2) + (lane & 3) * 4) = pk2(hr, hi); }
            }
        }
        asm volatile("" ::: "memory");
        if (PASSC) {
            bf16x8 hf[4];
#pragma unroll
            for (int ks = 0; ks < 4; ++ks) hf[ks] = img_row_frag(HW, lane, 0, ks);
#pragma unroll
            for (int ks = 0; ks < 4; ++ks) yacc[Tt] = MFMA16(cpf[ks], hf[ks], yacc[Tt]);
            }
        asm volatile("" ::: "memory");
        if (PASSC && wi < 3) {
#pragma unroll
            for (int Pt = 0; Pt < 8; ++Pt) d[Pt] = MFMA16(U.btf[Pt], ufa[DIR ? 2 - wi : wi + 1], ((f32x4){0.f, 0.f, 0.f, 0.f})); }
    }
    hout = h;
}
template <bool PASSC> __device__ __forceinline__ void s5_item(const DArgs& a, unsigned char* ws, LAS unsigned char* lds, int l, int item, int ggsel, int tid) {
    const int b = item / (SNCH * 2), rem = item % (SNCH * 2), cs = rem >> 1, half = rem & 1;
    const int lane = tid & 63, w = tid >> 6, g = lane >> 4, il = lane & 15;
    const int rowbase = gla_rowbase(b, cs);
    LAS float* BU = (LAS float*)(lds + w * 14336); LAS unsigned char* HW = lds + w * 14336 + 10240;
    const bf16_t* P = (const bf16_t*)(ws + WS_P);
    f32x2* ST = (f32x2*)(ws + WS_S5ST);
    const int grp0 = 16 * half + w, grp1 = grp0 + 8;
    S5Unit UA; bf16x8 ufa[4];
    { const int gg = ggsel;
        const int grp = gg ? grp1 : grp0;
        f32x4 yacc[4];
#pragma unroll
        for (int q = 0; q < 4; ++q) yacc[q] = (f32x4){0.f, 0.f, 0.f, 0.f};
        f32x2 hend;
        s5_load_unit<PASSC>(UA, ws, P, ST, l, b, cs, rowbase, grp, 0, lane); s5_load_u(ufa, P, rowbase, grp, lane);
        s5_run_unit<PASSC, 0>(UA, ufa, yacc, hend, BU, HW, lane);
        if (!PASSC) ST[((size_t)(b * SNCH + cs) * 2 + 0) * 2048 + grp * 64 + lane] = hend;
        s5_load_unit<PASSC>(UA, ws, P, ST, l, b, cs, rowbase, grp, 1, lane);
        s5_run_unit<PASSC, 1>(UA, ufa, yacc, hend, BU, HW, lane);
        if (!PASSC) ST[((size_t)(b * SNCH + cs) * 2 + 1) * 2048 + grp * 64 + lane] = hend;
        if (PASSC) {
            const f32x4 dsk = *(const f32x4*)(a.in[I_S5D] + l * 512 + grp * 16 + 4 * g);
            bf16_t* G5 = (bf16_t*)(ws + WS_KF);
#pragma unroll
            for (int Tt = 0; Tt < 4; ++Tt) { const size_t row = (size_t)rowbase + 16 * Tt + il;
                const u32x2 ur = *(const u32x2*)(P + row * LDP + PC_S5U + grp * 16 + 4 * g), sg = *(const u32x2*)(P + row * LDP + PC_S5G + grp * 16 + 4 * g);
                const float g0 = gelu_tanh(yacc[Tt].x + bflo(ur.x) * dsk.x), g1 = gelu_tanh(yacc[Tt].y + bfhi(ur.x) * dsk.y), g2 = gelu_tanh(yacc[Tt].z + bflo(ur.y) * dsk.z), g3 = gelu_tanh(yacc[Tt].w + bfhi(ur.y) * dsk.w);
                u32x2 ov; ov.x = pk2(g0, g1); ov.y = pk2(g2, g3);
                *(u32x2*)(G5 + row * 512 + grp * 16 + 4 * g) = ov;
                ov.x = pk2(g0 * siluf_(bflo(sg.x)), g1 * siluf_(bfhi(sg.x))); ov.y = pk2(g2 * siluf_(bflo(sg.y)), g3 * siluf_(bfhi(sg.y)));
                *(u32x2*)(G5 + OBSZ + row * 512 + grp * 16 + 4 * g) = ov; }
        }
    }
}
__device__ __forceinline__ void s5_passB(unsigned char* ws, int l, int gt) {
    const int p = gt & 63, grp = (gt >> 6) & 31, dir = (gt >> 11) & 1, b = gt >> 12;
    const f32x2 a64 = ((const f32x2*)(ws + WS_S5A64))[((l * 2 + dir) * 32 + grp) * 64 + p];
    f32x2* ST = (f32x2*)(ws + WS_S5ST);
    f32x2 acc = {0.f, 0.f};
#pragma unroll 1
    for (int s0 = 0; s0 < SNCH; s0 += 34) {
        f32x2 ev[34];
#pragma unroll
        for (int j = 0; j < 34; ++j) { const int s = s0 + j; const int cs = dir == 0 ? s : (s < 4 ? 3 - s : 71 - s); ev[j] = ST[((size_t)(b * SNCH + cs) * 2 + dir) * 2048 + grp * 64 + p]; }
#pragma unroll
        for (int j = 0; j < 34; ++j) { const int s = s0 + j; const int cs = dir == 0 ? s : (s < 4 ? 3 - s : 71 - s);
            ST[((size_t)(b * SNCH + cs) * 2 + dir) * 2048 + grp * 64 + p] = acc;
            acc = (f32x2){a64.x * acc.x - a64.y * acc.y + ev[j].x, a64.x * acc.y + a64.y * acc.x + ev[j].y}; }
    }
}
constexpr int FFT_PHYS = 8448;
__device__ __forceinline__ void fft_twiddles_g(LAS f32x2* W, const f32x2* Wg, int tid) {
#pragma unroll
    for (int j = 0; j < 8; ++j) W[tid + NT * j] = Wg[tid + NT * j];
}
__device__ __forceinline__ int fphys(int i) { return i + (i >> 5); }
__device__ __forceinline__ f32x2 cmulf(const f32x2 a, const f32x2 b) { return (f32x2){a.x * b.x - a.y * b.y, a.x * b.y + a.y * b.x}; }
__device__ __forceinline__ f32x2 cmulcf(const f32x2 a, const f32x2 b) { return (f32x2){a.x * b.x + a.y * b.y, a.y * b.x - a.x * b.y}; }
template <int RL> __device__ __forceinline__ void dft_fwd_const(f32x2 (&e)[1 << RL]) {
#pragma unroll
    for (int s = 0; s < RL; ++s) { const int h = 1 << (RL - 1 - s);
#pragma unroll
        for (int m = 0; m < (1 << RL); ++m) { if (m & h) continue;
            const int mp = m & (h - 1); const f32x2 a_ = e[m], b_ = e[m | h]; const f32x2 d = a_ - b_; e[m] = a_ + b_;
            if (mp == 0) e[m | h] = d;
            else if (2 * mp == h) e[m | h] = (f32x2){d.y, -d.x};
            else { const float ang = -3.14159265358979323846f * (float)mp / (float)h; const f32x2 c = {__builtin_cosf(ang), __builtin_sinf(ang)}; e[m | h] = cmulf(d, c); } } }
}
template <int RL> __device__ __forceinline__ void dft_inv_const(f32x2 (&e)[1 << RL]) {
#pragma unroll
    for (int ss = 0; ss < RL; ++ss) { const int s = RL - 1 - ss; const int h = 1 << (RL - 1 - s);
#pragma unroll
        for (int m = 0; m < (1 << RL); ++m) { if (m & h) continue;
            const int mp = m & (h - 1); const f32x2 a_ = e[m], b_ = e[m | h]; f32x2 t;
            if (mp == 0) t = b_;
            else if (2 * mp == h) t = (f32x2){-b_.y, b_.x};
            else { const float ang = -3.14159265358979323846f * (float)mp / (float)h; const f32x2 c = {__builtin_cosf(ang), __builtin_sinf(ang)}; t = cmulcf(b_, c); }
            e[m] = a_ + t; e[m | h] = a_ - t; } }
}
template <int RL> __device__ __forceinline__ constexpr int brev_c(int m) { int r = 0; for (int i = 0; i < RL; ++i) r |= ((m >> i) & 1) << (RL - 1 - i); return r; }
template <int RL, bool CONJ> __device__ __forceinline__ void apply_tw(f32x2 (&e)[1 << RL], const f32x2 w1) {
    f32x2 tw[1 << RL];
    tw[0] = (f32x2){1.f, 0.f}; tw[1] = w1;
    if (RL >= 2) { tw[2] = cmulf(w1, w1); tw[3] = cmulf(tw[2], w1); }
    if (RL >= 3) { tw[4] = cmulf(tw[2], tw[2]); tw[5] = cmulf(tw[4], tw[1]); tw[6] = cmulf(tw[4], tw[2]); tw[7] = cmulf(tw[4], tw[3]); }
    if (RL >= 4) { tw[8] = cmulf(tw[4], tw[4]);
#pragma unroll
        for (int k = 1; k < 8; ++k) tw[8 + k] = cmulf(tw[8], tw[k]); }
#pragma unroll
    for (int m = 1; m < (1 << RL); ++m) e[m] = CONJ ? cmulcf(e[m], tw[brev_c<RL>(m)]) : cmulf(e[m], tw[brev_c<RL>(m)]);
}
template <int RL, int BETA, bool INV> __device__ __forceinline__ void fft2_pass(LAS f32x2* X, const LAS f32x2* W, int tid) {
    constexpr int LOW = BETA - RL + 1, NG = FFTN >> RL, STR = (1 << LOW) + (1 << (LOW - 5));
#pragma unroll 1
    for (int gi = tid; gi < NG; gi += NT) {
        const int base = ((gi >> LOW) << (BETA + 1)) | (gi & ((1 << LOW) - 1));
        volatile LAS f32x2* p = X + fphys(base);
        f32x2 e[1 << RL];
#pragma unroll
        for (int m = 0; m < (1 << RL); ++m) e[m] = p[m * STR];
        const f32x2 w1 = W[(base & ((1 << LOW) - 1)) << (12 - BETA)];
        if (!INV) { dft_fwd_const<RL>(e); apply_tw<RL, false>(e, w1); }
        else { apply_tw<RL, true>(e, w1); dft_inv_const<RL>(e); }
#pragma unroll
        for (int m = 0; m < (1 << RL); ++m) p[m * STR] = e[m];
    }
}
__device__ __forceinline__ void fft2_fwd_ABC(LAS f32x2* X, const LAS f32x2* W, int tid) {
    fft2_pass<4, 12, false>(X, W, tid); __syncthreads(); fft2_pass<4, 8, false>(X, W, tid); __syncthreads();
}
__device__ __forceinline__ void fft2_inv_CBA(LAS f32x2* X, const LAS f32x2* W, int tid) {
    fft2_pass<4, 8, true>(X, W, tid); __syncthreads(); fft2_pass<4, 12, true>(X, W, tid); __syncthreads();
}
__device__ __forceinline__ void fft2_mid_mul(LAS f32x2* X, const f32x2* KF, int tid) {
    if (tid < 256) {
        volatile LAS f32x2* p = X + 33 * tid;
        f32x2 e[32];
#pragma unroll
        for (int m = 0; m < 32; ++m) e[m] = p[m];
        dft_fwd_const<5>(e);
#pragma unroll
        for (int q4 = 0; q4 < 4; ++q4) { f32x4 kf[4];
#pragma unroll
            for (int q = 0; q < 4; ++q) kf[q] = *(const f32x4*)(KF + 32 * tid + 8 * q4 + 2 * q);
#pragma unroll
            for (int q = 0; q < 4; ++q) { const int m = 8 * q4 + 2 * q; e[m] = cmulf(e[m], (f32x2){kf[q].x, kf[q].y}); e[m + 1] = cmulf(e[m + 1], (f32x2){kf[q].z, kf[q].w}); } }
        dft_inv_const<5>(e);
#pragma unroll
        for (int m = 0; m < 32; ++m) p[m] = e[m];
    }
}
__device__ __forceinline__ void fft2_fwd_D(LAS f32x2* X, int tid) {
    if (tid < 256) { volatile LAS f32x2* p = X + 33 * tid; f32x2 e[32];
#pragma unroll
        for (int m = 0; m < 32; ++m) e[m] = p[m];
        dft_fwd_const<5>(e);
#pragma unroll
        for (int m = 0; m < 32; ++m) p[m] = e[m]; }
}

__device__ __forceinline__ void filt_item2(const DArgs& a, unsigned char* ws, LAS unsigned char* lds, int l, int c, int tid) {
    LAS f32x2* X = (LAS f32x2*)lds; LAS f32x2* W = (LAS f32x2*)(lds + FFT_PHYS * 8); LAS float* w4s = (LAS float*)(lds + FFT_PHYS * 8 + 32768); LAS float* red = w4s + 256;
    fft_twiddles_g(W, (const f32x2*)(ws + WS_TWID), tid);
    if (tid < 128) { const int cc = tid >> 5, pr = tid & 31; const float* wsrc = a.in[I_HW4] + (size_t)l * 64 * 2048 + (cc >> 1) * 1024 + (cc & 1) * 512 + c;
        ((LAS unsigned*)w4s)[pr * 4 + cc] = pk2(wsrc[(size_t)(2 * pr) * 2048], wsrc[(size_t)(2 * pr + 1) * 2048]); }
    if (tid == 0) { float z0; asm volatile("v_mov_b32 %0, 0" : "=v"(z0)); X[fphys(4096)] = (f32x2){z0, z0}; }
    __syncthreads();
    const float dl = fabsf(HY_D0 + (HY_D1 - HY_D0) * ((float)c / 511.0f));
    const bf16_t* H3 = (const bf16_t*)(ws + WS_H3B) + (size_t)l * 4096 * 64;
    float ss0 = 0.f, ss1 = 0.f;
#pragma unroll 1
    for (int j = 0; j < 8; ++j) {
        const int t = tid + 512 * j;
        const u32x4* hr = (const u32x4*)(H3 + (size_t)t * 64);
        u32x4 hraw[8];
#pragma unroll
        for (int q = 0; q < 8; ++q) hraw[q] = hr[q];
        asm volatile("" ::: "memory");
        float f0 = 0.f, f1 = 0.f, b0 = 0.f, b1 = 0.f;
        typedef __bf16 bfp2 __attribute__((ext_vector_type(2)));
#pragma unroll
        for (int q = 0; q < 8; ++q) {
#pragma unroll
            for (int e = 0; e < 4; ++e) { const u32x4 wq = ((const LAS u32x4*)w4s)[4 * q + e]; const unsigned hx = hraw[q][e];
                f0 += bflo(hx) * bflo(wq.x) + bfhi(hx) * bfhi(wq.x); f1 += bflo(hx) * bflo(wq.y) + bfhi(hx) * bfhi(wq.y);
                b0 += bflo(hx) * bflo(wq.z) + bfhi(hx) * bfhi(wq.z); b1 += bflo(hx) * bflo(wq.w) + bfhi(hx) * bfhi(wq.w); } }
        const float dec = expf(-((float)t / 4095.0f) * dl); f0 *= dec; f1 *= dec; b0 *= dec; b1 *= dec;
        X[fphys(t)] = (f32x2){f0, f1}; ss0 += f0 * f0; ss1 += f1 * f1;
        if (t > 0) { X[fphys(8192 - t)] = (f32x2){b0, b1}; ss0 += b0 * b0; ss1 += b1 * b1; }
    }
    const float rs0 = rsqrtf(block_sum(ss0, red, tid) + EPS), rs1 = rsqrtf(block_sum(ss1, red, tid) + EPS);
#pragma unroll 4
    for (int j = 0; j < 16; ++j) { const int n = fphys(tid + 512 * j); const f32x2 x = X[n]; X[n] = (f32x2){x.x * rs0, x.y * rs1}; }
    __syncthreads(); fft2_fwd_ABC(X, W, tid); fft2_fwd_D(X, tid); __syncthreads();
    f32x2* KF0 = (f32x2*)(ws + WS_KF) + (size_t)(0 * 512 + c) * FFTN; f32x2* KF1 = (f32x2*)(ws + WS_KF) + (size_t)(1 * 512 + c) * FFTN;
#pragma unroll 4
    for (int j = 0; j < 16; ++j) { const int pos = tid + 512 * j; const int k = (int)(__brev((unsigned)pos) >> 19); const int pp = (int)(__brev((unsigned)((8192 - k) & 8191)) >> 19);
        const f32x2 za = X[fphys(pos)], zb = X[fphys(pp)];
        KF0[pos] = (f32x2){0.5f * (za.x + zb.x), 0.5f * (za.y - zb.y)};
        KF1[pos] = (f32x2){0.5f * (za.y + zb.y), 0.5f * (zb.x - za.x)}; }
    __syncthreads();
}

struct Raw8 { u32x4 mid; bf16_t lf, rt; };
__device__ __forceinline__ Raw8 ld_raw8(const bf16_t* p, int t0, int Lx) { Raw8 r; r.mid = *(const u32x4*)(p + t0); r.lf = t0 > 0 ? p[t0 - 1] : (bf16_t)0; r.rt = t0 + 8 < Lx ? p[t0 + 8] : (bf16_t)0; return r; }
__device__ __forceinline__ void sconv8(const Raw8& r, float w0, float w1, float w2, float cb, float (&o)[8]) {
    float x[10]; x[0] = bf2f(r.lf); x[9] = bf2f(r.rt);
    x[1] = bflo(r.mid.x); x[2] = bfhi(r.mid.x); x[3] = bflo(r.mid.y); x[4] = bfhi(r.mid.y); x[5] = bflo(r.mid.z); x[6] = bfhi(r.mid.z); x[7] = bflo(r.mid.w); x[8] = bfhi(r.mid.w);
#pragma unroll
    for (int i = 0; i < 8; ++i) o[i] = w0 * x[i] + w1 * x[i + 1] + w2 * x[i + 2] + cb;
}
__device__ __forceinline__ void hyena_item2(const DArgs& a, unsigned char* ws, LAS unsigned char* lds, int l, int c, int tid) {
    LAS f32x2* X = (LAS f32x2*)lds; LAS f32x2* W = (LAS f32x2*)(lds + FFT_PHYS * 8);
    fft_twiddles_g(W, (const f32x2*)(ws + WS_TWID), tid);
    const float* cw = a.in[I_HCW] + (size_t)l * 3 * 1536; const float* cbp = a.in[I_HCB] + (size_t)l * 1536;
    const float wv0 = cw[c], wv1 = cw[1536 + c], wv2 = cw[3072 + c], bv = cbp[c];
    const float wa0 = cw[512 + c], wa1 = cw[1536 + 512 + c], wa2 = cw[3072 + 512 + c], ba = cbp[512 + c];
    const float wb0 = cw[1024 + c], wb1 = cw[1536 + 1024 + c], wb2 = cw[3072 + 1024 + c], bb = cbp[1024 + c];
    const float bias0 = a.in[I_HBIAS][(l * 2 + 0) * 512 + c], bias1 = a.in[I_HBIAS][(l * 2 + 1) * 512 + c];
    const bf16_t* PT = (const bf16_t*)(ws + WS_PT);
    const bf16_t* pv = PT + (size_t)(PT_V + c) * MR; const bf16_t* pg1 = PT + (size_t)(PT_G1 + c) * MR; const bf16_t* pg2 = PT + (size_t)(PT_G2 + c) * MR; const bf16_t* phg = PT + (size_t)(PT_HG + c) * MR;
    const f32x2* KF0 = (const f32x2*)(ws + WS_KF) + (size_t)(0 * 512 + c) * FFTN; const f32x2* KF1 = (const f32x2*)(ws + WS_KF) + (size_t)(1 * 512 + c) * FFTN;
    bf16_t* GATED = (bf16_t*)(ws + WS_H);
    const int t0 = 8 * tid;
    LAS f32x2* px = X + 8 * tid + (tid >> 2);
    __syncthreads();
    for (int bp = 0; bp < 2; ++bp) {
        const int r0 = (2 * bp) * SEQL, r1 = (2 * bp + 1) * SEQL;
        const Raw8 v0 = ld_raw8(pv + r0, t0, SEQL), v1 = ld_raw8(pv + r1, t0, SEQL);
        const Raw8 g10 = ld_raw8(pg1 + r0, t0, SEQL), g11 = ld_raw8(pg1 + r1, t0, SEQL);
        float zr[8], zi[8];
        sconv8(v0, wv0, wv1, wv2, bv, zr); sconv8(v1, wv0, wv1, wv2, bv, zi);
#pragma unroll
        for (int x = 0; x < 8; ++x) { px[x] = (f32x2){zr[x], zi[x]}; px[4224 + x] = (f32x2){0.f, 0.f}; }
        __syncthreads(); fft2_fwd_ABC(X, W, tid); fft2_mid_mul(X, KF0, tid); __syncthreads(); fft2_inv_CBA(X, W, tid);
        { float gr[8], gi[8]; sconv8(g10, wa0, wa1, wa2, ba, gr); sconv8(g11, wa0, wa1, wa2, ba, gi);
#pragma unroll
          for (int x = 0; x < 8; ++x) { const f32x2 cv = px[x] * (1.0f / 8192.0f); zr[x] = gr[x] * (cv.x + bias0 * zr[x]); zi[x] = gi[x] * (cv.y + bias0 * zi[x]); } }
        __syncthreads();
        const Raw8 g20 = ld_raw8(pg2 + r0, t0, SEQL), g21 = ld_raw8(pg2 + r1, t0, SEQL);
        const u32x4 hgr0 = *(const u32x4*)(phg + r0 + t0), hgr1 = *(const u32x4*)(phg + r1 + t0);
#pragma unroll
        for (int x = 0; x < 8; ++x) { px[x] = (f32x2){zr[x], zi[x]}; px[4224 + x] = (f32x2){0.f, 0.f}; }
        __syncthreads(); fft2_fwd_ABC(X, W, tid); fft2_mid_mul(X, KF1, tid); __syncthreads(); fft2_inv_CBA(X, W, tid);
        { float gr[8], gi[8], h0[8], h1[8]; sconv8(g20, wb0, wb1, wb2, bb, gr); sconv8(g21, wb0, wb1, wb2, bb, gi); unpack8(hgr0, h0); unpack8(hgr1, h1);
#pragma unroll
          for (int x = 0; x < 8; ++x) { const f32x2 cv = px[x] * (1.0f / 8192.0f);
              const float z2r = gr[x] * (cv.x + bias1 * zr[x]), z2i = gi[x] * (cv.y + bias1 * zi[x]);
              gr[x] = z2r * siluf_(h0[x]); gi[x] = z2i * siluf_(h1[x]); }
          bf16_t* pvw = (bf16_t*)(ws + WS_PT) + (size_t)(PT_V + c) * MR;
          *(u32x4*)(pvw + r0 + t0) = pack8(gr); *(u32x4*)(pvw + r1 + t0) = pack8(gi); }
        __syncthreads();
    }
}

__device__ __forceinline__ void hy_transpose_item(unsigned char* ws, LAS unsigned char* lds, int item, int tid, int nrows) {
    const int lane = tid & 63, w = tid >> 6;
    const int wi = item * 8 + w;
    const int nrb = nrows / 64;
    if (wi >= nrb * 8) return;
    const int rb = wi >> 3, cb = wi & 7;
    LAS bf16_t* T = (LAS bf16_t*)(lds + w * 8704);
    const bf16_t* src = (const bf16_t*)(ws + WS_PT) + (size_t)(PT_V + cb * 64) * MR + (size_t)rb * 64;
    u32x4 tv[8];
#pragma unroll
    for (int i = 0; i < 8; ++i) { const int c = 8 * i + (lane >> 3), r8 = (lane & 7) * 8; tv[i] = *(const u32x4*)(src + (size_t)c * MR + r8); }
#pragma unroll
    for (int i = 0; i < 8; ++i) { const int c = 8 * i + (lane >> 3), r8 = (lane & 7) * 8;
        LAS unsigned* d = (LAS unsigned*)(T + c * 66 + r8); d[0] = tv[i].x; d[1] = tv[i].y; d[2] = tv[i].z; d[3] = tv[i].w; }
    asm volatile("s_waitcnt lgkmcnt(0)" ::: "memory");
    bf16_t* dst = (bf16_t*)(ws + WS_H) + (size_t)(rb * 64) * D + 512 + cb * 64;
#pragma unroll 4
    for (int i = 0; i < 8; ++i) { const int r = 8 * i + (lane >> 3), c8 = (lane & 7) * 8;
        unsigned short e[8];
#pragma unroll
        for (int x = 0; x < 8; ++x) e[x] = T[(c8 + x) * 66 + r];
        u32x4 o; o.x = e[0] | ((unsigned)e[1] << 16); o.y = e[2] | ((unsigned)e[3] << 16); o.z = e[4] | ((unsigned)e[5] << 16); o.w = e[6] | ((unsigned)e[7] << 16);
        *(u32x4*)(dst + (size_t)r * D + c8) = o; }
    asm volatile("s_waitcnt lgkmcnt(0)" ::: "memory");
}
#ifndef MK_EN
#define MK_EN 0xffff
#endif
#define EN(x) ((MK_EN >> (x)) & 1)
constexpr int PH_PREP = 0, PH_PER_LAYER = 7, PH_FNORM = 1 + 2 * PH_PER_LAYER, N_PHASES = PH_FNORM + 1;

__global__ void __launch_bounds__(NT, 2) fwd_kernel(Args ka) {
    extern __shared__ __attribute__((aligned(16))) unsigned char lds_raw[];
    LAS unsigned char* lds = (LAS unsigned char*)lds_raw;
    const int G = gridDim.x;
    volatile LAS unsigned* bst = (volatile LAS unsigned*)(lds + LDS_CTL_OFF);
    if (threadIdx.x < 16) bst[threadIdx.x] = 0u;
    if (threadIdx.x == 0) { LAS unsigned long long* tab = (LAS unsigned long long*)(lds + LDS_PTR_OFF);
#pragma unroll
        for (int i = 0; i < N_IN; ++i) tab[i] = (unsigned long long)ka.in[i]; }
    __syncthreads();

    XcdBarrier gbar; gbar.bar = (unsigned*)(ka.ws + WS_CTL); gbar.x = 0; gbar.st = bst;
    if (ka.ph_hi - ka.ph_lo > 1) gbar = xcd_barrier_post((unsigned*)(ka.ws + WS_CTL), bst);

#ifdef REP_SUB
    int repmask = 0;
#endif
    for (int ph = ka.ph_lo; ph < ka.ph_hi; ++ph) {
        int tid = threadIdx.x; asm volatile("" : "+v"(tid));
        int bid = blockIdx.x; asm volatile("" : "+s"(bid));
#define LANE_WAVE() int tid2_ = threadIdx.x; asm volatile("" : "+v"(tid2_)); const int lane = tid2_ & 63, wave = __builtin_amdgcn_readfirstlane(tid2_ >> 6)
        __attribute__((address_space(1))) unsigned char* wsg_ = (__attribute__((address_space(1))) unsigned char*)ka.ws; asm volatile("" : "+s"(wsg_)); unsigned char* ws = (unsigned char*)wsg_;
        __attribute__((address_space(1))) float* outg_ = (__attribute__((address_space(1))) float*)ka.out; asm volatile("" : "+s"(outg_)); float* outp_ = (float*)outg_;
        DArgs a; a.in.t = (const LAS unsigned long long*)(lds + LDS_PTR_OFF); a.out = outp_;
        float* MOD = (float*)(ws + WS_MOD);
        if (EN(0) && ph == PH_PREP) {
            for (int it = bid; it < 1048 + 544 + 8; it += G) {
                int tid = threadIdx.x; asm volatile("" : "+v"(tid));
                __syncthreads();
                if (it < 768) prep_adaln(a.in[I_C], a.in[I_CCTX], a.in[I_ADAW], a.in[I_ADAB], MOD, it, (LAS float*)lds, tid);
                else if (it < 784) prep_s5b(a, ws, it - 768, tid);
                else if (it >= 1048 + 544) { const int j = (it - 1592) * NT + tid; float sn, cs; sincospif(-(float)j * (1.0f / 4096.0f), &sn, &cs); ((f32x2*)(ws + WS_TWID))[j] = (f32x2){cs, sn}; }
                else if (it >= 1048) prep_rope((f32x2*)(ws + WS_ROPE), it - 1048, tid);
                else { const bool big = it < 1040; const int r = big ? it - 784 : it - 1040, l = big ? (r >> 7) : 0, t0 = (big ? (r & 127) : r) * 32;
                    float* H3o = big ? (float*)(ws + WS_H3) + (size_t)l * 4096 * 64 : (float*)(ws + WS_H3C);
                    bf16_t* H3b = big ? (bf16_t*)(ws + WS_H3B) + (size_t)l * 4096 * 64 : (bf16_t*)nullptr;
                    prep_hymlp(a, H3o, H3b, l, big ? 4096 : 256, t0, lds, tid); }
            }
        } else if (EN(1) && ph == PH_FNORM) {
            const float* fw = a.in[I_FNW]; LANE_WAVE();
            for (int row = bid * NWAVES + wave; row < NLAT; row += G * NWAVES) {
                float* xr = a.out + (size_t)row * D; f32x4 v[8]; float ss = 0.f;
#pragma unroll
                for (int j = 0; j < 8; ++j) { v[j] = ((const f32x4*)xr)[lane + 64 * j]; ss += (v[j].x * v[j].x + v[j].y * v[j].y) + (v[j].z * v[j].z + v[j].w * v[j].w); }
                const float rstd = rsqrtf(wave_sum(ss) * (1.0f / D) + EPS);
#pragma unroll
                for (int j = 0; j < 8; ++j) { const f32x4 w = *(const f32x4*)(fw + 4 * (lane + 64 * j)); ((f32x4*)xr)[lane + 64 * j] = v[j] * rstd * w; }
            }
        } else {
            const int l = (ph - 1) / PH_PER_LAYER, sub = (ph - 1) % PH_PER_LAYER;

            const bool ctx_out = (l == 0);
            const int Mrows = ctx_out ? MR : NLAT;
            if (EN(2) && sub == 0) {
                LANE_WAVE();
                LAS float* scr = (LAS float*)(lds + wave * 8704);
                const int gw = bid * NWAVES + wave, NGW = G * NWAVES;
                constexpr int I_W1 = 32 * (NPAD / 32), I_W2 = 32 * 64, I_W3 = 8 * 16;
                for (int it = (l == 0 ? gw : gw + I_W1); it < I_W1 + I_W2 + I_W3; it += NGW) {
                    int r = it;
                    if (r < I_W1) { const int kb = r / (NPAD / 32), nb = r % (NPAD / 32); transpose_item(a.in[I_WIN] + (size_t)l * D * INW, INW, win_srccol(nb * 32 + (lane & 31)), kb * 64, (bf16_t*)(ws + WS_WIN), D, nb * 32, scr, lane); continue; }
                    r -= I_W1;
                    if (r < I_W2) { const int kb = r / 64, nb = r % 64; transpose_item(a.in[I_WOUT] + (size_t)l * D * D, D, nb * 32 + (lane & 31), kb * 64, (bf16_t*)(ws + WS_WOUT), D, nb * 32, scr, lane); continue; }
                    r -= I_W2;
                    { const int kb = r / 16, nb = r % 16; transpose_item(a.in[I_GLUW] + (size_t)l * 512 * 512, 512, nb * 32 + (lane & 31), kb * 64, (bf16_t*)(ws + WS_GLUW), 512, nb * 32, scr, lane); }
                }
                const float* nw = a.in[I_NORMW] + (size_t)l * D;
                for (int row = gw; row < MR; row += NGW) {
                    const float* xr; int v;
                    if (row < NLAT) { xr = (l == 0 ? a.in[I_X] : a.out) + (size_t)row * D; v = row >> 12; }
                    else { xr = (l == 0 ? a.in[I_CTX] : (const float*)(ws + WS_XC1)) + (size_t)(row - NLAT) * D; v = 4; }
                    norm_row(xr, nw, MOD + (size_t)(l * 5 + v) * ADA, (bf16_t*)(ws + WS_H) + (size_t)row * D, lane);
                }
                __syncthreads();
                const int nfilt = ctx_out ? 1024 : 0;
                for (int it = bid; it < nfilt; it += G) { int tid = threadIdx.x; asm volatile("" : "+v"(tid)); __syncthreads(); if (it < 512) filt_item2(a, ws, lds, l, it, tid); else filt_ctx_item(a, ws, lds, it - 512, tid);
#if defined(REP_ITEM) && REP_ITEM == 10
                    __syncthreads(); if (it < 512) filt_item2(a, ws, lds, l, it, tid);
#endif
                }
            } else if (EN(3) && sub == 1) {
                pg8::Gemm g{(const bf16_t*)(ws + WS_H), (const bf16_t*)(ws + WS_WIN), MR, NPAD, D}; pg8::StaticOrder S; S.init(MR, NPAD, G, bid);
                EpiInProj E{(bf16_t*)(ws + WS_P), (bf16_t*)(ws + WS_PT), (float*)(ws + WS_LR), (const float*)(ws + WS_ROPE)};
                { pg8::InProjOrder S1; S1.init(ctx_out ? 0 : 1, G, bid); pg8::gemm_phase<EpiInProj, pg8::InProjOrder, true, true>(lds, g, S1, E, tid); }
            } else if (EN(5) && sub == 2) {
                const int nit = ctx_out ? 3744 : 3232;
                for (int it = bid; it < nit; it += G) {
                    int tid = threadIdx.x; asm volatile("" : "+v"(tid));
                    __syncthreads();
#ifdef REP_ITEM
                    for (int rep_ = 0; rep_ < 2; ++rep_) { const int ty_ = it < 1088 ? 0 : it < 1632 ? 1 : it < 2720 ? 2 : it < 3232 ? 3 : 4; if (rep_ && ty_ != REP_ITEM) break; if (rep_) __syncthreads(); asm volatile("" : "+v"(tid));
#endif
                    if (it < 1088) s5_item<false>(a, ws, lds, l, it >> 1, it & 1, tid);
                    else if (it < 1632) ret_passA(ws, lds, it - 1088, tid);
                    else if (it < 2720) gla_passA(a, ws, lds, l, it - 1632, tid);
                    else if (it < 3232) hyena_item2(a, ws, lds, l, it - 2720, tid);
                    else hyena_ctx_item(a, ws, lds, it - 3232, tid);
#ifdef REP_ITEM
                    }
#endif
                }
            } else if (EN(9) && sub == 3) {
                for (int it = bid; it < 256; it += G) { int tid = threadIdx.x; asm volatile("" : "+v"(tid)); __syncthreads(); hy_transpose_item(ws, lds, it, tid, NLAT); }
                for (int it = bid; it < 224; it += G) { int tid = threadIdx.x; asm volatile("" : "+v"(tid)); __syncthreads();
                    if (it < 128) ret_passB(ws, it * NT + tid);
                    else if (it < 192) gla_passB(ws, lds, it - 128, tid);
                    else s5_passB(ws, l, (it - 192) * NT + tid); }
            } else if (EN(6) && sub == 4) {
                const int nsc = ctx_out ? 1088 : 1024, nrc = ctx_out ? 16 * RNCH : 16 * 32, ngc = ctx_out ? 16 * GNCH : 16 * 64;
                for (int it = bid; it < nsc; it += G) { int tid = threadIdx.x; asm volatile("" : "+v"(tid)); __syncthreads();
                    const int i2 = it >> 1; const int item = ctx_out ? i2 : (i2 >> 7) * (SNCH * 2) + 8 + (i2 & 127); s5_item<true>(a, ws, lds, l, item, it & 1, tid); }
                for (int it = (bid + 64) % G; it < nrc; it += G) { int tid = threadIdx.x; asm volatile("" : "+v"(tid)); __syncthreads();
                    const int item = ctx_out ? it : (it >> 5) * RNCH + 2 + (it & 31); ret_passC(a, ws, lds, l, item, tid); }
                for (int it = (bid + 128) % G; it < ngc; it += G) { int tid = threadIdx.x; asm volatile("" : "+v"(tid)); __syncthreads();
                    const int item = ctx_out ? it : (it >> 6) * GNCH + 4 + (it & 63); gla_passC(a, ws, lds, l, item, tid); }
            } else if (EN(7) && sub == 5) {
                pg8::Gemm g{(const bf16_t*)(ws + WS_KF), (const bf16_t*)(ws + WS_GLUW), Mrows, 512, 512}; pg8::StaticOrder S; S.init(Mrows, 512, G, bid);
                EpiGlu E{(const bf16_t*)(ws + WS_KF) + OBSZ, (bf16_t*)(ws + WS_H), a.in[I_GLUB] + (size_t)l * 512};
                pg8::gemm_phase<EpiGlu, pg8::StaticOrder, true, true>(lds, g, S, E, tid);
                if (l == 0 && bid >= 136) {
                    LANE_WAVE(); LAS float* scr = (LAS float*)(lds + wave * 8704);
                    for (int r = (bid - 136) * NWAVES + wave; r < 32 * (NPAD / 32); r += (G - 136) * NWAVES) { const int kb = r / (NPAD / 32), nb = r % (NPAD / 32);
                        transpose_item(a.in[I_WIN] + (size_t)1 * D * INW, INW, win_srccol(nb * 32 + (lane & 31)), kb * 64, (bf16_t*)(ws + WS_WIN), D, nb * 32, scr, lane); }
                }
            } else if (EN(8)) {
                pg8::Gemm g{(const bf16_t*)(ws + WS_H), (const bf16_t*)(ws + WS_WOUT), Mrows, D, D}; pg8::StaticOrder S; S.init(Mrows, D, G, bid);
                EpiOut E{l == 0 ? a.in[I_X] : a.out, a.in[I_CTX], a.out, (float*)(ws + WS_XC1), MOD + (size_t)l * 5 * ADA};
                pg8::gemm_phase<EpiOut, pg8::StaticOrder, true, true>(lds, g, S, E, tid);
                if (l == 0 && bid >= 32) {
                    for (int it = bid - 32; it < 512; it += G - 32) { int tid2 = threadIdx.x; asm volatile("" : "+v"(tid2)); __syncthreads(); filt_item2(a, ws, lds, 1, it, tid2); }
                }
            }
        }
#ifdef REP_SUB
        if (ph != PH_PREP && ph != PH_FNORM && ((ph - 1) % PH_PER_LAYER) == REP_SUB && !((repmask >> ((ph - 1) / PH_PER_LAYER)) & 1)) { repmask |= 1 << ((ph - 1) / PH_PER_LAYER); xcd_barrier(gbar); --ph; continue; }
#endif
        if (ph + 1 < ka.ph_hi) xcd_barrier(gbar);
    }
}

#ifndef MK_LAUNCH_PER_PHASE
#define MK_LAUNCH_PER_PHASE 0
#endif
extern "C" void kernel_launch(void* const* d_in, const int* in_sizes, int n_in, void* d_out, int out_size, void* d_ws, size_t ws_size, hipStream_t stream) {
    static int grid = 0;
    if (grid == 0) {
        if (n_in != N_IN || out_size != NLAT * D || ws_size < WS_END2) { fprintf(stderr, "kernel_launch: unexpected shapes (n_in %d, out %d, ws %zu < %zu); nothing launched\n", n_in, out_size, ws_size, (size_t)WS_END2); grid = -1; return; }
        int dev = 0, cus = 0, per_cu = 0;
        if (hipGetDevice(&dev) != hipSuccess || hipDeviceGetAttribute(&cus, hipDeviceAttributeMultiprocessorCount, dev) != hipSuccess) { grid = -1; return; }
        if (hipFuncSetAttribute((const void*)fwd_kernel, hipFuncAttributeMaxDynamicSharedMemorySize, LDS_BYTES) != hipSuccess) { fprintf(stderr, "kernel_launch: hipFuncSetAttribute failed\n"); grid = -1; return; }
        if (hipOccupancyMaxActiveBlocksPerMultiprocessor(&per_cu, (const void*)fwd_kernel, NT, LDS_BYTES) != hipSuccess || per_cu < 1) { fprintf(stderr, "kernel_launch: occupancy query says %d blocks per CU\n", per_cu); per_cu = 1; }
        (void)hipGetLastError();
        grid = cus;
    }
    if (grid < 0) return;
    (void)hipMemsetAsync((char*)d_ws + WS_CTL, 0, WS_ZERO_BYTES, stream);
    Args a{};
    for (int i = 0; i < N_IN; ++i) a.in[i] = (const float*)d_in[i];
    a.out = (float*)d_out; a.ws = (unsigned char*)d_ws;
#if MK_LAUNCH_PER_PHASE
    for (int ph = 0; ph < N_PHASES; ++ph) {
        a.ph_lo = ph; a.ph_hi = ph + 1;
        hipLaunchKernelGGL(fwd_kernel, dim3(grid), dim3(NT), LDS_BYTES, stream, a);
    }
#else
    a.ph_lo = 0; a.ph_hi = N_PHASES;
    void* args[] = {&a};
    hipError_t e = hipLaunchCooperativeKernel((const void*)fwd_kernel, dim3(grid), dim3(NT), args, LDS_BYTES, stream);
    if (e != hipSuccess) fprintf(stderr, "kernel_launch: cooperative launch failed: %s (grid %d)\n", hipGetErrorString(e), grid);
#endif
}
```

```cpp
#include <hip/hip_runtime.h>
#include <hip/hip_cooperative_groups.h>
#include <cstdio>
#include <cstdint>
namespace cg = cooperative_groups;

#define LAS __attribute__((address_space(3)))
typedef unsigned short bf16_t;
typedef float f32x4 __attribute__((ext_vector_type(4)));
typedef float f32x2 __attribute__((ext_vector_type(2)));
typedef unsigned u32x4 __attribute__((ext_vector_type(4)));
typedef unsigned u32x2 __attribute__((ext_vector_type(2)));

constexpr int D = 2048, NB = 4, SEQL = 4096, LC = 256, NLAT = NB * SEQL, NCTX = NB * LC, MR = NLAT + NCTX;
constexpr int BR = 512, INW = 6688, NPAD = 6912, LDP = 4608, ADA = 3 * D;
constexpr int NT = 512, NWAVES = 8;
constexpr float EPS = 1e-6f;
constexpr int PC_S5U = 0, PC_S5G = 512, PC_RQ = 1024, PC_RK = 1536, PC_RV = 2048, PC_RG = 2560, PC_GQ = 3072, PC_GK = 3328, PC_GV = 3584, PC_GG = 4096;
constexpr int PT_V = 0, PT_G1 = 512, PT_G2 = 1024, PT_HG = 1536;
constexpr int FFTN = 8192;

enum { I_X = 0, I_C, I_CTX, I_CCTX, I_NORMW, I_ADAW, I_ADAB, I_WIN, I_WOUT, I_S5ARE, I_S5AIM, I_S5LDT, I_S5BRE, I_S5BIM, I_S5CRE, I_S5CIM,
       I_S5D, I_GLUW, I_GLUB, I_HCW, I_HCB, I_HW1, I_HB1, I_HF1, I_HW2, I_HB2, I_HF2, I_HW3, I_HB3, I_HF3, I_HW4, I_HBIAS, I_RNW, I_GGW, I_GGB, I_GNW, I_FNW, N_IN };

constexpr size_t al256(size_t x) { return (x + 255) & ~(size_t)255; }
constexpr size_t WS_CTL  = 0;
constexpr size_t WS_MOD  = WS_CTL + 65536;
constexpr size_t WS_ZERO_BYTES = 65536 + al256((size_t)2 * 5 * ADA * 4);
constexpr size_t WS_S5AB = WS_MOD + al256((size_t)2 * 5 * ADA * 4);
constexpr size_t WS_S5BT = WS_S5AB + (size_t)2 * 2 * 32 * 64 * 8;
constexpr size_t WS_H3   = WS_S5BT + (size_t)1048576 + 65536;
constexpr size_t WS_H3C  = WS_H3 + (size_t)2 * 4096 * 64 * 4;
constexpr size_t WS_KC   = WS_H3C + (size_t)256 * 64 * 4;
constexpr size_t WS_LR   = WS_KC + (size_t)2 * 512 * 512 * 4;
constexpr size_t WS_XC1  = WS_LR + (size_t)MR * 32 * 4;
constexpr size_t WS_WOUT = WS_XC1 + (size_t)NCTX * D * 4;
constexpr size_t WS_GLUW = WS_WOUT + (size_t)D * D * 2;
constexpr size_t WS_WIN  = WS_GLUW + (size_t)512 * 512 * 2;
constexpr size_t WS_H    = WS_WIN + (size_t)NPAD * D * 2;
constexpr size_t WS_P    = WS_H + (size_t)MR * D * 2;
constexpr size_t WS_PT   = WS_P + (size_t)MR * LDP * 2;
constexpr size_t WS_KF   = WS_PT + (size_t)2048 * MR * 2;
constexpr size_t WS_OB   = WS_KF + (size_t)2 * 512 * FFTN * 8;
constexpr size_t WS_END  = WS_OB + (size_t)6 * MR * 512 * 2;
constexpr size_t OBSZ = (size_t)MR * 512;

constexpr int LDS_CTL_OFF = 135168 + 1024;
constexpr int LDS_PTR_OFF = LDS_CTL_OFF + 64;
constexpr int LDS_BYTES = LDS_PTR_OFF + 320;

typedef __bf16 hwbf16x2 __attribute__((ext_vector_type(2)));
__device__ __forceinline__ unsigned pk2(float lo, float hi) { const f32x2 v = {lo, hi}; return __builtin_bit_cast(unsigned, __builtin_convertvector(v, hwbf16x2)); }
__device__ __forceinline__ unsigned f2bf(float f) { return pk2(f, 0.f) & 0xffffu; }
__device__ __forceinline__ float bf2f(bf16_t b) { return __uint_as_float((unsigned)b << 16); }
__device__ __forceinline__ float bflo(unsigned w) { return __uint_as_float(w << 16); }
__device__ __forceinline__ float bfhi(unsigned w) { return __uint_as_float(w & 0xffff0000u); }
__device__ __forceinline__ void unpack8(const u32x4 r, float (&f)[8]) { f[0] = bflo(r.x); f[1] = bfhi(r.x); f[2] = bflo(r.y); f[3] = bfhi(r.y); f[4] = bflo(r.z); f[5] = bfhi(r.z); f[6] = bflo(r.w); f[7] = bfhi(r.w); }
__device__ __forceinline__ u32x4 pack8(const float (&f)[8]) { u32x4 o; o.x = pk2(f[0], f[1]); o.y = pk2(f[2], f[3]); o.z = pk2(f[4], f[5]); o.w = pk2(f[6], f[7]); return o; }
__device__ __forceinline__ float sigmoidf_(float x) { return __builtin_amdgcn_rcpf(1.0f + __expf(-x)); }
__device__ __forceinline__ float siluf_(float x) { return x * sigmoidf_(x); }
__device__ __forceinline__ float gelu_tanh(float x) { const float u2 = 1.5957691216057308f * (x + 0.044715f * x * x * x); return x * sigmoidf_(u2); }
__device__ __forceinline__ float wave_sum(float v) {
#pragma unroll
    for (int o = 1; o < 64; o <<= 1) v += __shfl_xor(v, o);
    return v;
}
#define LDS_WAIT() asm volatile("s_waitcnt lgkmcnt(0)" ::: "memory")

struct Args { const float* in[N_IN]; float* out; unsigned char* ws; int ph_lo, ph_hi; };
struct InTab { const LAS unsigned long long* t;
    __device__ __forceinline__ const float* operator[](int i) const { const unsigned long long v = t[i];
        const unsigned lo = __builtin_amdgcn_readfirstlane((unsigned)v), hi = __builtin_amdgcn_readfirstlane((unsigned)(v >> 32)); return (const float*)(__attribute__((address_space(1))) const float*)(((unsigned long long)hi << 32) | lo); } };
struct DArgs { InTab in; float* out; };

#define XB_TMO      128
#define XB_XCNT(j)  (256  + 64 * (j))
#define XB_XSUB(j)  (1280 + 64 * (j))
#define XB_XGEN(j)  (2304 + 64 * (j))
#define XB_TOP      3328
#define XB_TOPGEN   3392
#define XCD_BAR_WORDS 3456
#define XB_SPIN_CAP (1u << 22)
__device__ __forceinline__ unsigned xb_ld(unsigned* p)              { return __hip_atomic_load(p, __ATOMIC_RELAXED, __HIP_MEMORY_SCOPE_AGENT); }
__device__ __forceinline__ unsigned xb_add(unsigned* p, unsigned v) { return __hip_atomic_fetch_add(p, v, __ATOMIC_RELAXED, __HIP_MEMORY_SCOPE_AGENT); }
__device__ __forceinline__ unsigned xb_xcc_id() { return (unsigned)__builtin_amdgcn_s_getreg((3 << 11) | 20) & 0xFu; }
#define XB_SPIN(cond, bar) do { unsigned _sp = 0; while (cond) { __builtin_amdgcn_s_sleep(1); \
    if ((++_sp & 255u) == 0u) { if (xb_ld(&(bar)[XB_TMO])) break; if (_sp > XB_SPIN_CAP) { atomicAdd(&(bar)[XB_TMO], 1u); break; } } } } while (0)
struct XcdBarrier { unsigned* bar; unsigned x; volatile LAS unsigned* st; };
__device__ __forceinline__ XcdBarrier xcd_barrier_post(unsigned* bar, volatile LAS unsigned* st) {
    XcdBarrier b; b.bar = bar; b.x = xb_xcc_id(); b.st = st;
    if (threadIdx.x == 0) (void)xb_add(&bar[XB_XCNT(b.x)], 1u);
    return b;
}
__device__ __forceinline__ void xcd_barrier_complete(unsigned* bar, unsigned x, unsigned& nloc, unsigned& nx) {
    const unsigned G = gridDim.x * gridDim.y * gridDim.z;
    unsigned sum, cnt, mine, sp = 0u;
    for (;;) {
        sum = 0u; cnt = 0u; mine = 0u;
#pragma unroll
        for (unsigned j = 0; j < 16; ++j) { const unsigned c = xb_ld(&bar[XB_XCNT(j)]); sum += c; cnt += (c > 0u) ? 1u : 0u; mine = (j == x) ? c : mine; }
        if (sum == G) break;
        __builtin_amdgcn_s_sleep(1);
        if ((++sp & 255u) == 0u) { if (xb_ld(&bar[XB_TMO])) break; if (sp > XB_SPIN_CAP) { atomicAdd(&bar[XB_TMO], 1u); break; } }
    }
    nloc = mine > 0u ? mine : 1u; nx = cnt > 0u ? cnt : 1u;
}
__device__ __forceinline__ void xcd_barrier(const XcdBarrier& b) {
    asm volatile("s_waitcnt vmcnt(0)" ::: "memory");
    __syncthreads();
    if (threadIdx.x == 0) {
        unsigned* bar = b.bar;
        __builtin_amdgcn_s_waitcnt(0);
        unsigned nloc = b.st[0], nx = b.st[1];
        if (nloc == 0u) { xcd_barrier_complete(bar, b.x, nloc, nx); b.st[0] = nloc; b.st[1] = nx; }
        const unsigned old = xb_add(&bar[XB_XSUB(b.x)], 1u);
        const unsigned gen = old / nloc;
        if (old + 1u == (gen + 1u) * nloc) {
            __builtin_amdgcn_fence(__ATOMIC_RELEASE, "agent");
            asm volatile("s_waitcnt vmcnt(0)" ::: "memory");
            const unsigned og = xb_add(&bar[XB_TOP], 1u);
            const unsigned tg = og / nx;
            if (og + 1u == (tg + 1u) * nx) xb_add(&bar[XB_TOPGEN], 1u);
            else XB_SPIN(xb_ld(&bar[XB_TOPGEN]) == tg, bar);
            __builtin_amdgcn_fence(__ATOMIC_ACQUIRE, "agent");
            xb_add(&bar[XB_XGEN(b.x)], 1u);
            asm volatile("s_waitcnt vmcnt(0)" ::: "memory");
        } else {
            XB_SPIN(xb_ld(&bar[XB_XGEN(b.x)]) == gen, bar);
            __builtin_amdgcn_fence(__ATOMIC_ACQUIRE, "agent");
            asm volatile("s_waitcnt vmcnt(0)" ::: "memory");
        }
    }
    __syncthreads();
}
namespace pg8 {
#define PG8_LAS __attribute__((address_space(3)))
typedef unsigned short bf16_t;
typedef short bf16x8 __attribute__((ext_vector_type(8)));
typedef float f32x4 __attribute__((ext_vector_type(4)));
typedef unsigned u32x4 __attribute__((ext_vector_type(4)));
constexpr int BM = 256, BK = 64, HALF = 128, HTB = HALF * BK * 2, STAGE_BYTES = 8 * HTB, NXCD = 8, WGM = 8;

__host__ __device__ __forceinline__ int lds_byte(int r, int c) { const int st = (r >> 4) * 2 + (c >> 5), rr = r & 15, cc = c & 31, ob = rr * 64 + cc * 2; return st * 1024 + (ob ^ (((ob >> 9) & 1) << 5)); }
__host__ __device__ __forceinline__ void stage_rc(int b, int& R, int& C) { const int st = b / 1024, sb = b % 1024, swz = sb ^ (((sb >> 9) & 1) << 5); R = (st >> 1) * 16 + swz / 64; C = (st & 1) * 32 + (swz % 64) / 2; }
__host__ __device__ __forceinline__ int perm32(int rho) { const int n = rho >> 4, i = rho & 15; return 8 * (i >> 2) + 4 * n + (i & 3); }

struct Unit { int pm, pn; };
struct Gemm { const bf16_t* A; const bf16_t* Bt; int M, N, K; };

struct StaticOrder {
    int nM, nN, nwg, G, c;
    __host__ __device__ void init(int M, int N, int G_, int c_) { nM = M / BM; nN = N / BM; nwg = nM * nN; G = G_; c = c_; }
    __host__ __device__ bool next(int i, Unit& u) const {
        const long L = (long)i * G + c; if (L >= nwg) return false;
        int wgid = (int)L; { const int q = nwg / NXCD, r = nwg % NXCD, xcd = wgid % NXCD, off = wgid / NXCD; wgid = (xcd < r ? xcd * (q + 1) : r * (q + 1) + (xcd - r) * q) + off; }
        const int nig = WGM * nN, gid = wgid / nig, fm = gid * WGM, gsz = (nM - fm) < WGM ? (nM - fm) : WGM;
        u.pm = fm + ((wgid % nig) % gsz); u.pn = (wgid % nig) / gsz; return true;
    }
    __device__ __forceinline__ void a_ready(const Unit&) const {}
    __device__ __forceinline__ void done(const Unit&) const {}
};


struct InProjOrder {
    StaticOrder base; int G, c, last;
    __host__ __device__ void init(int last_, int G_, int c_) { last = last_; base.init((last_ ? 64 : 68) * 256, 27 * 256, G_, c_); G = G_; c = c_; }
    __host__ __device__ bool next(int i, Unit& u) const {
        const long L = (long)i * G + c;
        if (!last || L < 1728) return base.next(i, u);
        if (L >= 1768) return false;
        const int k = (int)L - 1728, j = k % 10; u.pm = 64 + k / 10;
        u.pn = j == 0 ? 0 : j == 1 ? 1 : j == 2 ? 14 : j == 3 ? 15 : j == 4 ? 16 : j == 5 ? 17 : j == 6 ? 21 : j == 7 ? 22 : j == 8 ? 23 : 26;
        return true;
    }
    __device__ __forceinline__ void a_ready(const Unit&) const {}
    __device__ __forceinline__ void done(const Unit&) const {}
};
template <class Epi, class Sched, bool ALIGN_EPI = false, bool SP2 = false>
__device__ __forceinline__ void gemm_phase(PG8_LAS unsigned char* lds, const Gemm g, const Sched& S, const Epi& E, const int tid) {
    const int wid = __builtin_amdgcn_readfirstlane(tid >> 6), lane = tid & 63, wr = wid >> 2, wc = wid & 3, fr = lane & 15, fq = lane >> 4;
    const int K = g.K, nt = K / BK;
    unsigned voffA[2], voffB[2];
#pragma unroll
    for (int i = 0; i < 2; ++i) { int R, C; stage_rc(tid * 16 + i * 8192, R, C); const int Rb = Epi::PERM ? ((R & ~31) + perm32(R & 31)) : R;
        voffA[i] = (unsigned)(R * K + C) * 2u; voffB[i] = (unsigned)(Rb * K + C) * 2u; }
    const size_t kstep = (size_t)(BK * 2);
    const size_t hstep = (size_t)HALF * K * 2;
    const size_t tstep = 2 * hstep;
    const unsigned ldsw = (unsigned)wid * 1024u;
    const int aoff = lds_byte(wr * 64 + fr, fq * 8), boff = lds_byte(wc * 32 + fr, fq * 8);
#define PG8_SA(b, h) (((b) * 2 + (h)) * HTB)
#define PG8_SB(b, h) ((4 + (b) * 2 + (h)) * HTB)
#define PG8_STAGE(bufoff, gbase, voff) do { _Pragma("unroll") for (int _i = 0; _i < 2; ++_i) \
        __builtin_amdgcn_global_load_lds((const unsigned*)((const char*)(gbase) + (voff)[_i]), (PG8_LAS unsigned*)(lds + (bufoff) + ldsw + _i * 8192), 16, 0, 0); } while (0)
#define PG8_LDA(dst, b, h) do { _Pragma("unroll") for (int m = 0; m < 4; ++m) _Pragma("unroll") for (int k = 0; k < 2; ++k) dst[m][k] = *(const PG8_LAS bf16x8*)(lds + PG8_SA(b, h) + aoff + m * 2048 + k * 1024); } while (0)
#define PG8_LDB(dst, b, h) do { _Pragma("unroll") for (int n = 0; n < 2; ++n) _Pragma("unroll") for (int k = 0; k < 2; ++k) dst[n][k] = *(const PG8_LAS bf16x8*)(lds + PG8_SB(b, h) + boff + n * 2048 + k * 1024); } while (0)
#define PG8_MMA(ai, bj, At, Bt) do { __builtin_amdgcn_s_setprio(1); _Pragma("unroll") for (int m = 0; m < 4; ++m) _Pragma("unroll") for (int n = 0; n < 2; ++n) _Pragma("unroll") for (int k = 0; k < 2; ++k) \
        acc[ai][bj][m][n] = __builtin_amdgcn_mfma_f32_16x16x32_bf16(Bt[n][k], At[m][k], acc[ai][bj][m][n], 0, 0, 0); __builtin_amdgcn_s_setprio(0); } while (0)
#define PG8_WAIT_V(n) asm volatile("s_waitcnt vmcnt(" #n ")" ::: "memory")
#define PG8_WAIT_L(n) asm volatile("s_waitcnt lgkmcnt(" #n ")" ::: "memory")
#define PG8_BAR __builtin_amdgcn_s_barrier()
#define PG8_SCHED __builtin_amdgcn_sched_barrier(0)
    Unit cur, nxt; int ui = 0;
    if (!S.next(0, cur)) return;
    f32x4 acc[2][2][4][2];
#pragma unroll
    for (int a = 0; a < 2; ++a)
#pragma unroll
        for (int b = 0; b < 2; ++b)
#pragma unroll
            for (int m = 0; m < 4; ++m)
#pragma unroll
                for (int n = 0; n < 2; ++n) acc[a][b][m][n] = (f32x4){0.f, 0.f, 0.f, 0.f};
    bf16x8 At[4][2], B0[2][2], B1[2][2];
    const char* cA = (const char*)g.A + (size_t)cur.pm * tstep; const char* cB = (const char*)g.Bt + (size_t)cur.pn * tstep;
    S.a_ready(cur);
    if constexpr (SP2) {
        PG8_STAGE(PG8_SB(0, 0), cB, voffB); PG8_STAGE(PG8_SB(0, 1), cB + hstep, voffB); PG8_STAGE(PG8_SA(0, 0), cA, voffA); PG8_STAGE(PG8_SA(0, 1), cA + hstep, voffA);
        if (wr == 1) PG8_BAR;
        PG8_WAIT_V(2); PG8_BAR;
        PG8_STAGE(PG8_SB(1, 0), cB + kstep, voffB); PG8_STAGE(PG8_SA(1, 0), cA + kstep, voffA); PG8_STAGE(PG8_SB(1, 1), cB + hstep + kstep, voffB);
        PG8_WAIT_V(6); PG8_BAR;
    } else {
        PG8_STAGE(PG8_SB(0, 0), cB, voffB); PG8_STAGE(PG8_SA(0, 0), cA, voffA); PG8_STAGE(PG8_SB(0, 1), cB + hstep, voffB); PG8_STAGE(PG8_SA(0, 1), cA + hstep, voffA);
        if (wr == 1) PG8_BAR;
        PG8_WAIT_V(4); PG8_BAR;
        PG8_STAGE(PG8_SB(1, 0), cB + kstep, voffB); PG8_STAGE(PG8_SA(1, 0), cA + kstep, voffA); PG8_STAGE(PG8_SB(1, 1), cB + hstep + kstep, voffB);
        PG8_WAIT_V(6); PG8_BAR;
    }
    for (;;) {
        const bool has_next = S.next(ui + 1, nxt);
        const char* nA = has_next ? (const char*)g.A + (size_t)nxt.pm * tstep : cA; const char* nB = has_next ? (const char*)g.Bt + (size_t)nxt.pn * tstep : cB;
        for (int t = 0; t < nt; t += 2) {
            const bool last = (t == nt - 2);
            const char* a1 = cA + (size_t)(t + 1) * kstep;
            const char* a2 = last ? nA : cA + (size_t)(t + 2) * kstep; const char* b2 = last ? nB : cB + (size_t)(t + 2) * kstep;
            const char* a3 = a2 + kstep; const char* b3 = b2 + kstep;
            if (last && has_next) S.a_ready(nxt);
            if constexpr (SP2) {
            PG8_LDB(B0, 0, 0); PG8_LDB(B1, 0, 1); PG8_SCHED; PG8_LDA(At, 0, 0); PG8_STAGE(PG8_SA(1, 1), a1 + hstep, voffA);
            PG8_WAIT_V(8); PG8_WAIT_L(0); PG8_BAR; PG8_MMA(0, 0, At, B0); PG8_MMA(0, 1, At, B1); PG8_BAR; PG8_SCHED;
            PG8_LDA(At, 0, 1); PG8_STAGE(PG8_SB(0, 0), b2, voffB); PG8_STAGE(PG8_SB(0, 1), b2 + hstep, voffB); PG8_STAGE(PG8_SA(0, 0), a2, voffA);
            PG8_WAIT_V(8); PG8_WAIT_L(0); PG8_BAR; PG8_MMA(1, 0, At, B0); PG8_MMA(1, 1, At, B1); PG8_BAR; PG8_SCHED;
            PG8_LDB(B0, 1, 0); PG8_LDB(B1, 1, 1); PG8_SCHED; PG8_LDA(At, 1, 0); PG8_STAGE(PG8_SA(0, 1), a2 + hstep, voffA);
            PG8_WAIT_V(8); PG8_WAIT_L(0); PG8_BAR; PG8_MMA(0, 0, At, B0); PG8_MMA(0, 1, At, B1); PG8_BAR; PG8_SCHED;
            PG8_LDA(At, 1, 1); PG8_STAGE(PG8_SB(1, 0), b3, voffB); PG8_STAGE(PG8_SB(1, 1), b3 + hstep, voffB); PG8_STAGE(PG8_SA(1, 0), a3, voffA);
            PG8_WAIT_V(8); PG8_WAIT_L(0); PG8_BAR; PG8_MMA(1, 0, At, B0); PG8_MMA(1, 1, At, B1); PG8_BAR; PG8_SCHED;
            } else {
            PG8_LDB(B0, 0, 0); PG8_SCHED; PG8_LDA(At, 0, 0); PG8_STAGE(PG8_SA(1, 1), a1 + hstep, voffA);
            PG8_WAIT_L(8); PG8_BAR; PG8_WAIT_L(0); PG8_MMA(0, 0, At, B0); PG8_BAR; PG8_SCHED;
            PG8_LDB(B1, 0, 1); PG8_STAGE(PG8_SB(0, 0), b2, voffB);
            PG8_BAR; PG8_WAIT_L(0); PG8_MMA(0, 1, At, B1); PG8_BAR;
            PG8_LDA(At, 0, 1); PG8_STAGE(PG8_SA(0, 0), a2, voffA);
            PG8_BAR; PG8_WAIT_L(0); PG8_MMA(1, 0, At, B0); PG8_BAR; PG8_SCHED;
            PG8_STAGE(PG8_SB(0, 1), b2 + hstep, voffB);
            PG8_WAIT_V(6); PG8_BAR; PG8_MMA(1, 1, At, B1); PG8_BAR;
            PG8_LDB(B0, 1, 0); PG8_SCHED; PG8_LDA(At, 1, 0); PG8_STAGE(PG8_SA(0, 1), a2 + hstep, voffA);
            PG8_WAIT_L(8); PG8_BAR; PG8_WAIT_L(0); PG8_MMA(0, 0, At, B0); PG8_BAR; PG8_SCHED;
            PG8_LDB(B1, 1, 1); PG8_STAGE(PG8_SB(1, 0), b3, voffB);
            PG8_BAR; PG8_WAIT_L(0); PG8_MMA(0, 1, At, B1); PG8_BAR;
            PG8_LDA(At, 1, 1); PG8_STAGE(PG8_SA(1, 0), a3, voffA);
            PG8_BAR; PG8_WAIT_L(0); PG8_MMA(1, 0, At, B0); PG8_BAR; PG8_SCHED;
            PG8_STAGE(PG8_SB(1, 1), b3 + hstep, voffB);
            PG8_WAIT_V(6); PG8_BAR; PG8_MMA(1, 1, At, B1); PG8_BAR;
            }
        }
        if constexpr (ALIGN_EPI) { if (wr == 0) PG8_BAR; }
        { int fr_ = fr, fq_ = fq; asm volatile("" : "+v"(fr_), "+v"(fq_));
          E(acc, cur, wr, wc, fr_, fq_); } S.done(cur);
        if (!has_next) break;
#pragma unroll
        for (int a = 0; a < 2; ++a)
#pragma unroll
            for (int b = 0; b < 2; ++b)
#pragma unroll
                for (int m = 0; m < 4; ++m)
#pragma unroll
                    for (int n = 0; n < 2; ++n) acc[a][b][m][n] = (f32x4){0.f, 0.f, 0.f, 0.f};
        cur = nxt; cA = nA; cB = nB; ++ui;
        if constexpr (ALIGN_EPI) { if (wr == 1) PG8_BAR; }
    }
    PG8_WAIT_V(0);
    if constexpr (!ALIGN_EPI) { if (wr == 0) PG8_BAR; }
    PG8_BAR;
#undef PG8_SA
#undef PG8_SB
#undef PG8_STAGE
#undef PG8_LDA
#undef PG8_LDB
#undef PG8_MMA
#undef PG8_WAIT_V
#undef PG8_WAIT_L
#undef PG8_BAR
#undef PG8_SCHED
}
}
__device__ __forceinline__ void prep_adaln(const float* c, const float* cctx, const float* adaw, const float* adab, float* MOD, int it, LAS float* sv, int tid) {
    const int l = it / 384, r = it % 384, ntile = r >> 5, ks = r & 31, k0 = ks * 64;
    if (tid < 320) { const int v = tid >> 6, k = tid & 63; const float cv = v < 4 ? c[v * D + k0 + k] : cctx[k0 + k]; sv[tid] = cv / (1.0f + expf(-cv)); }
    __syncthreads();
    const int n = ntile * 512 + tid; const float* w = adaw + (size_t)l * D * ADA + (size_t)k0 * ADA + n;
    float acc[5] = {0.f, 0.f, 0.f, 0.f, 0.f};
#pragma unroll 1
    for (int k0_ = 0; k0_ < 64; k0_ += 32) {
        float wv[32];
#pragma unroll
        for (int k = 0; k < 32; ++k) wv[k] = w[(size_t)(k0_ + k) * ADA];
#pragma unroll
        for (int k = 0; k < 32; ++k) {
#pragma unroll
            for (int v = 0; v < 5; ++v) acc[v] += sv[v * 64 + k0_ + k] * wv[k]; } }
    if (ks == 0) { const float bb = adab[l * ADA + n];
#pragma unroll
        for (int v = 0; v < 5; ++v) acc[v] += bb; }
#pragma unroll
    for (int v = 0; v < 5; ++v) atomicAdd(MOD + (size_t)(l * 5 + v) * ADA + n, acc[v]);
    __syncthreads();
}

__device__ __forceinline__ void prep_hymlp(const DArgs& a, float* H3out, bf16_t* H3b, int l, int Lx, int t0, LAS unsigned char* lds, int tid) {
    LAS float* zs = (LAS float*)lds;
    LAS float* h1 = (LAS float*)(lds + 4608);
    LAS float* h2 = (LAS float*)(lds + 4608 + 8192);
    LAS float* w1s = (LAS float*)(lds + 24576);
    LAS float* w2s = w1s + 33 * 64;
    LAS float* w3s = w2s + 64 * 64;
    { const float* w1 = a.in[I_HW1] + (size_t)l * 33 * 64; const float* w2 = a.in[I_HW2] + (size_t)l * 64 * 64; const float* w3 = a.in[I_HW3] + (size_t)l * 64 * 64;
      for (int i = tid; i < 33 * 64; i += NT) w1s[i] = w1[i];
      for (int i = tid; i < 64 * 64; i += NT) { w2s[i] = w2[i]; w3s[i] = w3[i]; } }
    for (int i = tid; i < 32 * 33; i += NT) { const int pos = i / 33, f = i % 33, t = t0 + pos;
        float z;
        if (f == 0) z = (float)t / (float)(Lx - 1);
        else { const int j = (f - 1) & 15; const float fj = 1e-4f + (float)j * ((15.0f - 1e-4f) / 15.0f); const float wpos = (6.283185307179586f * (float)t) / (float)Lx; const float arg = fj * wpos;
               z = (f <= 16) ? cosf(arg) : -sinf(arg); }
        zs[pos * 36 + f] = z; }
    __syncthreads();
    const int pos = tid >> 4, f4 = (tid & 15) * 4, t = t0 + pos;
    f32x4 s = *(const f32x4*)(a.in[I_HB1] + l * 64 + f4);
#pragma unroll 3
    for (int j = 0; j < 33; ++j) s += zs[pos * 36 + j] * *(const LAS f32x4*)(w1s + j * 64 + f4);
    { const f32x4 fr = *(const f32x4*)(a.in[I_HF1] + l * 64 + f4); *(LAS f32x4*)(h1 + pos * 64 + f4) = (f32x4){sinf(fr.x * s.x), sinf(fr.y * s.y), sinf(fr.z * s.z), sinf(fr.w * s.w)}; }
    __syncthreads();
    s = *(const f32x4*)(a.in[I_HB2] + l * 64 + f4);
#pragma unroll 4
    for (int j = 0; j < 64; ++j) s += h1[pos * 64 + j] * *(const LAS f32x4*)(w2s + j * 64 + f4);
    { const f32x4 fr = *(const f32x4*)(a.in[I_HF2] + l * 64 + f4); *(LAS f32x4*)(h2 + pos * 64 + f4) = (f32x4){sinf(fr.x * s.x), sinf(fr.y * s.y), sinf(fr.z * s.z), sinf(fr.w * s.w)}; }
    __syncthreads();
    s = *(const f32x4*)(a.in[I_HB3] + l * 64 + f4);
#pragma unroll 4
    for (int j = 0; j < 64; ++j) s += h2[pos * 64 + j] * *(const LAS f32x4*)(w3s + j * 64 + f4);
    { const f32x4 fr = *(const f32x4*)(a.in[I_HF3] + l * 64 + f4); const f32x4 hv = (f32x4){sinf(fr.x * s.x), sinf(fr.y * s.y), sinf(fr.z * s.z), sinf(fr.w * s.w)}; *(f32x4*)(H3out + (size_t)t * 64 + f4) = hv;
      if (H3b) { u32x2 pk; pk.x = pk2(hv.x, hv.y); pk.y = pk2(hv.z, hv.w); *(u32x2*)(H3b + (size_t)t * 64 + f4) = pk; } }
    __syncthreads();
}

__device__ __forceinline__ void transpose_item(const float* W, int ldw, int srccol_lane  , int k0, bf16_t* WT, int K, int dstrow0, LAS float* scr, int lane) {
    float wv[32];
#pragma unroll
    for (int i = 0; i < 32; ++i) { const int kk = 2 * i + (lane >> 5); wv[i] = srccol_lane >= 0 ? W[(size_t)(k0 + kk) * ldw + srccol_lane] : 0.f; }
#pragma unroll
    for (int i = 0; i < 32; ++i) { const int kk = 2 * i + (lane >> 5); scr[kk * 33 + (lane & 31)] = wv[i]; }
    LDS_WAIT();
    const int c = lane & 7;
#pragma unroll
    for (int j = 0; j < 4; ++j) { const int n = (lane >> 3) + 8 * j; const LAS float* s = scr + (8 * c) * 33 + n;
        u32x4 o; o.x = pk2(s[0 * 33], s[1 * 33]); o.y = pk2(s[2 * 33], s[3 * 33]); o.z = pk2(s[4 * 33], s[5 * 33]); o.w = pk2(s[6 * 33], s[7 * 33]);
        *(u32x4*)(WT + (size_t)(dstrow0 + n) * K + k0 + 8 * c) = o; }
    LDS_WAIT();
}
__device__ __forceinline__ int win_srccol(int n) {
    if (n >= 3072 && n < 4096) { const int u = (n - 3072) & 127, grp = u >> 3, e = u & 7; return (n & ~127) + (e < 4 ? 4 * grp + e : 64 + 4 * grp + (e - 4)); }
    return n < 6144 ? n : (n < 6656 ? n + 32 : (n < 6688 ? n - 512 : -1));
}

__device__ __forceinline__ void norm_row(const float* xrow, const float* nw, const float* mod, bf16_t* hrow, int lane) {
    f32x4 v[8]; float ss = 0.f;
#pragma unroll
    for (int j = 0; j < 8; ++j) { v[j] = ((const f32x4*)xrow)[lane + 64 * j]; ss += (v[j].x * v[j].x + v[j].y * v[j].y) + (v[j].z * v[j].z + v[j].w * v[j].w); }
    const float rstd = rsqrtf(wave_sum(ss) * (1.0f / D) + EPS);
#pragma unroll
    for (int j = 0; j < 8; ++j) { const int k = 4 * (lane + 64 * j);
        const f32x4 w = *(const f32x4*)(nw + k), sh = *(const f32x4*)(mod + k), sc = *(const f32x4*)(mod + D + k);
        const f32x4 o = v[j] * rstd * w * (sc + 1.0f) + sh;
        u32x2 pk; pk.x = pk2(o.x, o.y); pk.y = pk2(o.z, o.w);
        *(u32x2*)(hrow + k) = pk; }
}

__device__ __forceinline__ float block_sum(float v, LAS float* red, int tid) {
    v = wave_sum(v);
    if ((tid & 63) == 0) red[tid >> 6] = v;
    __syncthreads();
    float t = 0.f;
#pragma unroll
    for (int i = 0; i < NWAVES; ++i) t += red[i];
    __syncthreads();
    return t;
}
constexpr float HY_D0 = -3.0701134573253945f  , HY_D1 = -15.350567286626973f  ;

__device__ __forceinline__ void filt_ctx_item(const DArgs& a, unsigned char* ws, LAS unsigned char* lds, int c, int tid) {
    LAS float* w4s = (LAS float*)lds; LAS float* red = (LAS float*)(lds + 1024);
    if (tid < 256) { const int cc = tid >> 6, f = tid & 63; w4s[tid] = a.in[I_HW4][(size_t)f * 2048 + (cc >> 1) * 1024 + (cc & 1) * 512 + c]; }
    __syncthreads();
    const float dl = fabsf(HY_D0 + (HY_D1 - HY_D0) * ((float)c / 511.0f));
    const float* H3C = (const float*)(ws + WS_H3C);
    const int n = tid, dir = n >= 256 ? 1 : 0, t = dir ? (512 - n) : n;
    float s0 = 0.f, s1 = 0.f;
    if (n != 256) {
        const f32x4* hr = (const f32x4*)(H3C + (size_t)t * 64);
#pragma unroll
        for (int q = 0; q < 16; ++q) { const f32x4 hv = hr[q]; const f32x4 wa = ((const LAS f32x4*)(w4s + (dir * 2 + 0) * 64))[q], wb = ((const LAS f32x4*)(w4s + (dir * 2 + 1) * 64))[q];
            s0 += (hv.x * wa.x + hv.y * wa.y) + (hv.z * wa.z + hv.w * wa.w); s1 += (hv.x * wb.x + hv.y * wb.y) + (hv.z * wb.z + hv.w * wb.w); }
        const float dec = expf(-((float)t / 255.0f) * dl); s0 *= dec; s1 *= dec;
    }
    const float rs0 = rsqrtf(block_sum(s0 * s0, red, tid) + EPS), rs1 = rsqrtf(block_sum(s1 * s1, red, tid) + EPS);
    float* KC = (float*)(ws + WS_KC);
    KC[(size_t)(0 * 512 + c) * 512 + n] = s0 * rs0; KC[(size_t)(1 * 512 + c) * 512 + n] = s1 * rs1;
    __syncthreads();
}

__device__ __forceinline__ void prep_rope(f32x2* RT, int it, int tid) {
    const int idx = it * NT + tid, pos = idx >> 6, j = idx & 63;
    float ang;
    if (pos < SEQL) { const float inv = exp2f(-(float)(j & 31) * (13.287712379549449f / 32.0f)); ang = (float)(j < 32 ? (pos >> 6) : (pos & 63)) * inv; }
    else { const float inv = exp2f(-(float)j * (13.287712379549449f / 64.0f)); ang = (float)(pos - SEQL) * inv; }
    float sn, cs; sincosf(ang, &sn, &cs);
    RT[idx] = (f32x2){cs, sn};
}

__device__ __forceinline__ float sconv3(const bf16_t* p, int t, int Lx, float w0, float w1, float w2, float cb) {
    const float x0 = t > 0 ? bf2f(p[t - 1]) : 0.f, x1 = bf2f(p[t]), x2 = t < Lx - 1 ? bf2f(p[t + 1]) : 0.f;
    return w0 * x0 + w1 * x1 + w2 * x2 + cb;
}
__device__ __forceinline__ void ctx_conv256(const LAS float* kc, const LAS float* z, int b, int t4, int half, float (&o)[4]) {
    o[0] = o[1] = o[2] = o[3] = 0.f;
#pragma unroll 4
    for (int s4 = 0; s4 < 32; ++s4) { const int s = 128 * half + 4 * s4, d = 4 * t4 - s;
        const f32x4 zv = *(const LAS f32x4*)(z + b * 256 + s);
        const f32x4 wl = *(const LAS f32x4*)(kc + ((d - 4) & 511)), wh = *(const LAS f32x4*)(kc + (d & 511));
        const float w[8] = {wl.x, wl.y, wl.z, wl.w, wh.x, wh.y, wh.z, wh.w};
        const float zz[4] = {zv.x, zv.y, zv.z, zv.w};
#pragma unroll
        for (int j = 0; j < 4; ++j)
#pragma unroll
            for (int i = 0; i < 4; ++i) o[j] += w[4 + j - i] * zz[i]; }
}
__device__ __forceinline__ void hyena_ctx_item(const DArgs& a, unsigned char* ws, LAS unsigned char* lds, int c, int tid) {
    LAS float* kc = (LAS float*)lds; LAS float* za = (LAS float*)(lds + 4096); LAS float* zb = (LAS float*)(lds + 8192); LAS float* part = (LAS float*)(lds + 12288);
    const float* KC = (const float*)(ws + WS_KC);
    kc[tid] = KC[(size_t)(0 * 512 + c) * 512 + tid]; kc[512 + tid] = KC[(size_t)(1 * 512 + c) * 512 + tid];
    const float* cw = a.in[I_HCW]; const float* cbp = a.in[I_HCB];
    const float wv0 = cw[c], wv1 = cw[1536 + c], wv2 = cw[3072 + c], bv = cbp[c];
    const float wa0 = cw[512 + c], wa1 = cw[1536 + 512 + c], wa2 = cw[3072 + 512 + c], ba = cbp[512 + c];
    const float wb0 = cw[1024 + c], wb1 = cw[1536 + 1024 + c], wb2 = cw[3072 + 1024 + c], bb = cbp[1024 + c];
    const float bias0 = a.in[I_HBIAS][0 * 512 + c], bias1 = a.in[I_HBIAS][1 * 512 + c];
    const bf16_t* PT = (const bf16_t*)(ws + WS_PT);
    const int half = tid >> 8, b = (tid >> 6) & 3, t4 = tid & 63; const int rb = NLAT + b * LC;
    const bf16_t* pv = PT + (size_t)(PT_V + c) * MR + rb; const bf16_t* pg1 = PT + (size_t)(PT_G1 + c) * MR + rb; const bf16_t* pg2 = PT + (size_t)(PT_G2 + c) * MR + rb; const bf16_t* phg = PT + (size_t)(PT_HG + c) * MR + rb;
    bf16_t* GATED = (bf16_t*)(ws + WS_H);
    float z0[4], z1[4], o[4];
#pragma unroll
    for (int j = 0; j < 4; ++j) { z0[j] = sconv3(pv, 4 * t4 + j, LC, wv0, wv1, wv2, bv); }
    if (half == 0) *(LAS f32x4*)(za + b * 256 + 4 * t4) = (f32x4){z0[0], z0[1], z0[2], z0[3]};
    __syncthreads();
    ctx_conv256(kc, za, b, t4, half, o);
    if (half == 1) *(LAS f32x4*)(part + b * 256 + 4 * t4) = (f32x4){o[0], o[1], o[2], o[3]};
    __syncthreads();
    if (half == 0) { const f32x4 pp = *(const LAS f32x4*)(part + b * 256 + 4 * t4); const float ps[4] = {pp.x, pp.y, pp.z, pp.w};
#pragma unroll
        for (int j = 0; j < 4; ++j) z1[j] = sconv3(pg1, 4 * t4 + j, LC, wa0, wa1, wa2, ba) * (o[j] + ps[j] + bias0 * z0[j]);
        *(LAS f32x4*)(zb + b * 256 + 4 * t4) = (f32x4){z1[0], z1[1], z1[2], z1[3]}; }
    __syncthreads();
    ctx_conv256(kc + 512, zb, b, t4, half, o);
    if (half == 1) *(LAS f32x4*)(part + b * 256 + 4 * t4) = (f32x4){o[0], o[1], o[2], o[3]};
    __syncthreads();
    if (half == 0) { const f32x4 pp = *(const LAS f32x4*)(part + b * 256 + 4 * t4); const float ps[4] = {pp.x, pp.y, pp.z, pp.w};
#pragma unroll
        for (int j = 0; j < 4; ++j) { const int t = 4 * t4 + j; const float z2 = sconv3(pg2, t, LC, wb0, wb1, wb2, bb) * (o[j] + ps[j] + bias1 * z1[j]);
            GATED[(size_t)(rb + t) * D + 512 + c] = (bf16_t)f2bf(z2 * siluf_(bf2f(phg[t]))); } }
    __syncthreads();
}

struct EpiInProj {
    static constexpr bool PERM = true, AFTER_DRAIN = false;
    bf16_t* P; bf16_t* PT; float* LR; const float* RT;
    __device__ __forceinline__ void operator()(const pg8::f32x4 (&acc)[2][2][4][2], const pg8::Unit& u, int wr, int wc, int fr, int fq) const {
        const int row0 = u.pm * 256 + wr * 64 + fr, pn = u.pn;
        if (pn >= 12 && pn < 16) {
            const int colbase = pn * 256 - 2048 + wc * 32 + 8 * fq; const int j0 = 4 * (4 * wc + fq); const float ksc = pn >= 14 ? 0.08838834764831845f : 1.0f;
#pragma unroll
            for (int ai = 0; ai < 2; ++ai)
#pragma unroll
                for (int m = 0; m < 4; ++m) { const int row = row0 + ai * 128 + m * 16; const int pos = row < NLAT ? (row & (SEQL - 1)) : SEQL + ((row - NLAT) & (LC - 1));
                    const pg8::f32x4 t0 = *(const pg8::f32x4*)(RT + ((size_t)pos * 64 + j0) * 2), t1 = *(const pg8::f32x4*)(RT + ((size_t)pos * 64 + j0) * 2 + 4);
                    bf16_t* rowp = P + (size_t)row * LDP + colbase;
#pragma unroll
                    for (int bj = 0; bj < 2; ++bj) { const pg8::f32x4 x1 = acc[ai][bj][m][0] * ksc, x2 = acc[ai][bj][m][1] * ksc;
                        u32x4 w; w.x = pk2(x1[0] * t0[0] - x2[0] * t0[1], x1[1] * t0[2] - x2[1] * t0[3]); w.y = pk2(x1[2] * t1[0] - x2[2] * t1[1], x1[3] * t1[2] - x2[3] * t1[3]);
                        w.z = pk2(x1[0] * t0[1] + x2[0] * t0[0], x1[1] * t0[3] + x2[1] * t0[2]); w.w = pk2(x1[2] * t1[1] + x2[2] * t1[0], x1[3] * t1[3] + x2[3] * t1[2]);
                        *(u32x4*)(rowp + bj * 128) = w; } }
        } else if (pn < 4 || (pn >= 16 && pn < 26)) {
            const int colbase = (pn < 4 ? pn * 256 : pn * 256 - 2048) + wc * 32 + 8 * fq;
#pragma unroll
            for (int ai = 0; ai < 2; ++ai)
#pragma unroll
                for (int m = 0; m < 4; ++m) { bf16_t* rowp = P + (size_t)(row0 + ai * 128 + m * 16) * LDP + colbase;
#pragma unroll
                    for (int bj = 0; bj < 2; ++bj) { const pg8::f32x4 v0 = acc[ai][bj][m][0], v1 = acc[ai][bj][m][1];
                        u32x4 w; w.x = pk2(v0[0], v0[1]); w.y = pk2(v0[2], v0[3]); w.z = pk2(v1[0], v1[1]); w.w = pk2(v1[2], v1[3]);
                        *(u32x4*)(rowp + bj * 128) = w; } }
        } else if (pn < 12) {
            const int colbase = (pn - 4) * 256 + wc * 32 + 8 * fq;
#pragma unroll
            for (int bj = 0; bj < 2; ++bj)
#pragma unroll
                for (int n = 0; n < 2; ++n)
#pragma unroll
                    for (int j = 0; j < 4; ++j) { bf16_t* cp = PT + (size_t)(colbase + bj * 128 + 4 * n + j) * MR + row0;
#pragma unroll
                        for (int ai = 0; ai < 2; ++ai)
#pragma unroll
                            for (int m = 0; m < 4; ++m) cp[ai * 128 + m * 16] = (bf16_t)f2bf(acc[ai][bj][m][n][j]);
                        asm volatile("" ::: "memory"); }
        } else {
            if (wc == 0) {
#pragma unroll
                for (int ai = 0; ai < 2; ++ai)
#pragma unroll
                    for (int m = 0; m < 4; ++m) { float* rowp = LR + (size_t)(row0 + ai * 128 + m * 16) * 32 + 8 * fq;
                        *(pg8::f32x4*)(rowp) = acc[ai][0][m][0]; *(pg8::f32x4*)(rowp + 4) = acc[ai][0][m][1]; }
            }
        }
    }
};
struct EpiGlu {
    static constexpr bool PERM = true, AFTER_DRAIN = false;
    const bf16_t* GG; bf16_t* GATED; const float* bias;
    __device__ __forceinline__ void operator()(const pg8::f32x4 (&acc)[2][2][4][2], const pg8::Unit& u, int wr, int wc, int fr, int fq) const {
        const int row0 = u.pm * 256 + wr * 64 + fr, col0 = u.pn * 256 + wc * 32 + 8 * fq;
        pg8::f32x4 b0[2], b1[2];
#pragma unroll
        for (int bj = 0; bj < 2; ++bj) { b0[bj] = *(const pg8::f32x4*)(bias + col0 + bj * 128); b1[bj] = *(const pg8::f32x4*)(bias + col0 + bj * 128 + 4); }
#pragma unroll
        for (int ai = 0; ai < 2; ++ai) {
            u32x4 gg[4][2];
#pragma unroll
            for (int m = 0; m < 4; ++m)
#pragma unroll
                for (int bj = 0; bj < 2; ++bj) gg[m][bj] = *(const u32x4*)(GG + (size_t)(row0 + ai * 128 + m * 16) * 512 + col0 + bj * 128);
#pragma unroll
            for (int m = 0; m < 4; ++m) { const size_t row = (size_t)(row0 + ai * 128 + m * 16);
#pragma unroll
                for (int bj = 0; bj < 2; ++bj) { float g[8], res[8]; unpack8(gg[m][bj], g);
#pragma unroll
                    for (int j = 0; j < 4; ++j) { res[j] = g[j] * sigmoidf_(acc[ai][bj][m][0][j] + b0[bj][j]); res[4 + j] = g[4 + j] * sigmoidf_(acc[ai][bj][m][1][j] + b1[bj][j]); }
                    *(u32x4*)(GATED + row * D + col0 + bj * 128) = pack8(res); } }
            asm volatile("" ::: "memory");
        }
    }
};
struct EpiOut {
    static constexpr bool PERM = false, AFTER_DRAIN = false;
    const float* xl_old; const float* xc_old; float* xl_new; float* xc_new; const float* mod;
    __device__ __forceinline__ void operator()(const pg8::f32x4 (&acc)[2][2][4][2], const pg8::Unit& u, int wr, int wc, int fr, int fq) const {
        const int row0 = u.pm * 256 + wr * 64 + fr, col0 = u.pn * 256 + wc * 32 + 4 * fq;
        const bool lat = u.pm < 64;
        const float* xo = lat ? xl_old : xc_old - (size_t)NLAT * D; float* xn = lat ? xl_new : xc_new - (size_t)NLAT * D;
#pragma unroll
        for (int ai = 0; ai < 2; ++ai) {
            const int v = lat ? ((u.pm * 256 + ai * 128) >> 12) : 4;
            const float* gt = mod + (size_t)v * ADA + 2 * D;
#pragma unroll
            for (int m = 0; m < 4; ++m) { const size_t off = (size_t)(row0 + ai * 128 + m * 16) * D + col0;
#pragma unroll
                for (int bj = 0; bj < 2; ++bj)
#pragma unroll
                    for (int n = 0; n < 2; ++n) { const int cc = bj * 128 + n * 16; const pg8::f32x4 gv = *(const pg8::f32x4*)(gt + col0 + cc), xv = *(const pg8::f32x4*)(xo + off + cc);
                        *(pg8::f32x4*)(xn + off + cc) = xv + gv * acc[ai][bj][m][n]; } }
        }
    }
};
typedef short bf16x8 __attribute__((ext_vector_type(8)));
typedef short bf16x4 __attribute__((ext_vector_type(4)));
__device__ __forceinline__ unsigned off_b(unsigned row, unsigned ch) { return 256u * row + 16u * (ch ^ (((row & 3) << 2) | ((row >> 2) & 3))); }
__device__ __forceinline__ bf16x8 img_row_frag(const LAS unsigned char* img, unsigned lane, unsigned rb, unsigned s) { return *(const LAS bf16x8*)(img + off_b((lane & 15) + 16 * rb, 4 * s + (lane >> 4))); }
__device__ __forceinline__ bf16x4 img_tr4(const LAS unsigned char* img, unsigned lane, unsigned c, unsigned row0) {
    const unsigned q = (lane & 15) >> 2, p = lane & 3;
    return __builtin_amdgcn_ds_read_tr16_b64_v4i16((LAS bf16x4*)(img + off_b(row0 + q, 2 * c + (p >> 1)) + 8 * (p & 1)));
}
__device__ __forceinline__ bf16x8 img_tr_frag(const LAS unsigned char* img, unsigned lane, unsigned c, unsigned ks) {
    const unsigned g = lane >> 4; const bf16x4 lo = img_tr4(img, lane, c, 32 * ks + 8 * g), hi = img_tr4(img, lane, c, 32 * ks + 8 * g + 4);
    return __builtin_shufflevector(lo, hi, 0, 1, 2, 3, 4, 5, 6, 7);
}
__device__ __forceinline__ bf16x8 img_tr_frag_acc(const LAS unsigned char* img, unsigned lane, unsigned c, unsigned ks) {
    const unsigned g = lane >> 4; const bf16x4 lo = img_tr4(img, lane, c, 32 * ks + 4 * g), hi = img_tr4(img, lane, c, 32 * ks + 16 + 4 * g);
    return __builtin_shufflevector(lo, hi, 0, 1, 2, 3, 4, 5, 6, 7);
}
__device__ __forceinline__ bf16x8 acc_pair_frag(const f32x4 a0, const f32x4 a1) {
    u32x4 w; w.x = pk2(a0.x, a0.y); w.y = pk2(a0.z, a0.w); w.z = pk2(a1.x, a1.y); w.w = pk2(a1.z, a1.w);
    return __builtin_bit_cast(bf16x8, w);
}
#define MFMA16(A_, B_, C_) __builtin_amdgcn_mfma_f32_16x16x32_bf16((A_), (B_), (C_), 0, 0, 0)
__device__ __forceinline__ void stage_tile128(LAS unsigned char* img, const bf16_t* g, size_t ld, int tid) {
#pragma unroll
    for (int i = 0; i < 4; ++i) { const int n = tid + NT * i, row = n >> 4, ch = n & 15; *(LAS u32x4*)(img + off_b(row, ch)) = *(const u32x4*)(g + (size_t)row * ld + ch * 8); }
}

constexpr int RCH = 128, RNCH = 34;
constexpr size_t WS_RST = WS_OB;
__device__ __forceinline__ int ret_rowbase(int b, int cc) { return cc < 2 ? NLAT + b * LC + cc * RCH : b * SEQL + (cc - 2) * RCH; }
__device__ __forceinline__ float ret_log2g(int h) { return log2f(1.0f - exp2f(-5.0f - (float)h)); }

__device__ __forceinline__ void ret_passA(unsigned char* ws, LAS unsigned char* lds, int item, int tid) {
    const int bh = item / RNCH, cc = item % RNCH, b = bh >> 2, h = bh & 3;
    const int lane = tid & 63, w = tid >> 6, g = lane >> 4;
    LAS unsigned char* KF = lds; LAS unsigned char* KB = lds + 32768; LAS unsigned char* VI = lds + 65536;
    const bf16_t* P = (const bf16_t*)(ws + WS_P) + (size_t)ret_rowbase(b, cc) * LDP;
    const float l2g = ret_log2g(h);
    __syncthreads();
#pragma unroll
    for (int i = 0; i < 4; ++i) { const int n = tid + NT * i, row = n >> 4, ch = n & 15;
        const u32x4 kr = *(const u32x4*)(P + (size_t)row * LDP + PC_RK + h * 128 + ch * 8);
        float kf[8], a[8], c[8]; unpack8(kr, kf);
        const float sf = exp2f(l2g * (float)(RCH - 1 - row)), sb = exp2f(l2g * (float)row);
#pragma unroll
        for (int x = 0; x < 8; ++x) { a[x] = kf[x] * sf; c[x] = kf[x] * sb; }
        *(LAS u32x4*)(KF + off_b(row, ch)) = pack8(a); *(LAS u32x4*)(KB + off_b(row, ch)) = pack8(c);
        *(LAS u32x4*)(VI + off_b(row, ch)) = *(const u32x4*)(P + (size_t)row * LDP + PC_RV + h * 128 + ch * 8); }
    __syncthreads();
    bf16x8 af[4], ab[4];
#pragma unroll
    for (int ks = 0; ks < 4; ++ks) { af[ks] = img_tr_frag(KF, lane, w, ks); ab[ks] = img_tr_frag(KB, lane, w, ks); }
    bf16_t* ST = (bf16_t*)(ws + WS_RST) + ((size_t)(bh * 2) * RNCH + cc) * (128 * 128);
#pragma unroll 2
    for (int E = 0; E < 8; ++E) {
        f32x4 cf = {0.f, 0.f, 0.f, 0.f}, cb = {0.f, 0.f, 0.f, 0.f};
#pragma unroll
        for (int ks = 0; ks < 4; ++ks) { const bf16x8 vb = img_tr_frag(VI, lane, E, ks); cf = MFMA16(af[ks], vb, cf); cb = MFMA16(ab[ks], vb, cb); }
        const int e = 16 * E + (lane & 15), d0 = 16 * w + 4 * g;
        u32x2 o; o.x = pk2(cf.x, cf.y); o.y = pk2(cf.z, cf.w); *(u32x2*)(ST + (size_t)e * 128 + d0) = o;
        o.x = pk2(cb.x, cb.y); o.y = pk2(cb.z, cb.w); *(u32x2*)(ST + (size_t)RNCH * 128 * 128 + (size_t)e * 128 + d0) = o;
    }
}
__device__ __forceinline__ void ret_passB(unsigned char* ws, int gt  ) {
    const int el = gt & 2047, bd = gt >> 11, bh = bd >> 1, dir = bd & 1, h = bh & 3;
    const float gC = exp2f(ret_log2g(h) * (float)RCH);
    bf16_t* base = (bf16_t*)(ws + WS_RST) + (size_t)bd * RNCH * (128 * 128) + (size_t)el * 8;
    float acc[8];
#pragma unroll
    for (int x = 0; x < 8; ++x) acc[x] = 0.f;
#pragma unroll 1
    for (int s0 = 0; s0 < RNCH; s0 += 17) {
        u32x4 kvr[17];
#pragma unroll
        for (int j = 0; j < 17; ++j) { const int s = s0 + j; const int cc = dir == 0 ? s : (s < 2 ? 1 - s : 35 - s); kvr[j] = *(const u32x4*)(base + (size_t)cc * (128 * 128)); }
#pragma unroll
        for (int j = 0; j < 17; ++j) { const int s = s0 + j; const int cc = dir == 0 ? s : (s < 2 ? 1 - s : 35 - s);
            float kv[8]; unpack8(kvr[j], kv);
            *(u32x4*)(base + (size_t)cc * (128 * 128)) = pack8(acc);
#pragma unroll
            for (int x = 0; x < 8; ++x) acc[x] = gC * acc[x] + kv[x]; }
    }
}
__device__ __forceinline__ void ret_passC(const DArgs& a, unsigned char* ws, LAS unsigned char* lds, int l, int item, int tid) {
    const int bh = item / RNCH, cc = item % RNCH, b = bh >> 2, h = bh & 3;
    const int lane = tid & 63, w = tid >> 6, g = lane >> 4, il = lane & 15;
    LAS unsigned char* KI = lds; LAS unsigned char* VI = lds + 32768; LAS unsigned char* SF = lds + 65536; LAS unsigned char* SB = lds + 98304;
    const int rowbase = ret_rowbase(b, cc);
    const bf16_t* P = (const bf16_t*)(ws + WS_P) + (size_t)rowbase * LDP;
    const bf16_t* STf = (const bf16_t*)(ws + WS_RST) + ((size_t)(bh * 2) * RNCH + cc) * (128 * 128);
    const bf16_t* STb = STf + (size_t)RNCH * 128 * 128;
    __syncthreads();
    stage_tile128(KI, P + PC_RK + h * 128, LDP, tid); stage_tile128(VI, P + PC_RV + h * 128, LDP, tid);
    stage_tile128(SF, STf, 128, tid); stage_tile128(SB, STb, 128, tid);
    bf16x8 qf[4];
    { const bf16_t* qr = P + (size_t)(16 * w + il) * LDP + PC_RQ + h * 128 + 8 * g;
#pragma unroll
      for (int ks = 0; ks < 4; ++ks) qf[ks] = *(const bf16x8*)(qr + 32 * ks); }
    __syncthreads();
    const float l2g = ret_log2g(h);
    const int iloc = 16 * w + il;
    f32x4 o[8];
    { const float sf = exp2f(l2g * (float)(iloc + 1)), sb = exp2f(l2g * (float)(RCH - iloc));
#pragma unroll
      for (int E = 0; E < 8; ++E) { f32x4 rf = {0.f, 0.f, 0.f, 0.f}, rb = {0.f, 0.f, 0.f, 0.f};
#pragma unroll
          for (int ks = 0; ks < 4; ++ks) { rf = MFMA16(img_row_frag(SF, lane, E, ks), qf[ks], rf); rb = MFMA16(img_row_frag(SB, lane, E, ks), qf[ks], rb); }
          o[E] = rf * sf + rb * sb; } }
    f32x4 at[8];
#pragma unroll
    for (int T = 0; T < 8; ++T) { f32x4 c = {0.f, 0.f, 0.f, 0.f};
#pragma unroll
        for (int ks = 0; ks < 4; ++ks) c = MFMA16(img_row_frag(KI, lane, T, ks), qf[ks], c);
#pragma unroll
        for (int r = 0; r < 4; ++r) { const int j = 16 * T + 4 * g + r; const int dd = iloc > j ? iloc - j : j - iloc; c[r] *= (dd == 0 ? 2.0f : exp2f(l2g * (float)dd)); }
        at[T] = c; }
#pragma unroll
    for (int s = 0; s < 4; ++s) { const bf16x8 bfr = acc_pair_frag(at[2 * s], at[2 * s + 1]);
#pragma unroll
        for (int E = 0; E < 8; ++E) o[E] = MFMA16(img_tr_frag_acc(VI, lane, E, s), bfr, o[E]); }
    float ss = 0.f;
#pragma unroll
    for (int E = 0; E < 8; ++E) ss += (o[E].x * o[E].x + o[E].y * o[E].y) + (o[E].z * o[E].z + o[E].w * o[E].w);
    ss += __shfl_xor(ss, 16); ss += __shfl_xor(ss, 32);
    const float rn = rsqrtf(ss * (1.0f / 128.0f) + EPS);
    const size_t row = (size_t)rowbase + iloc;
    const bf16_t* gp = (const bf16_t*)(ws + WS_P) + row * LDP + PC_RG + h * 128 + 4 * g;
    const float* nw = a.in[I_RNW] + l * 512 + h * 128 + 4 * g;
    bf16_t* op = (bf16_t*)(ws + WS_H) + row * D + 1024 + h * 128 + 4 * g;
#pragma unroll
    for (int E = 0; E < 8; ++E) { const u32x2 gr = *(const u32x2*)(gp + 16 * E); const f32x4 nv = *(const f32x4*)(nw + 16 * E);
        u32x2 ov; ov.x = pk2(o[E].x * rn * nv.x * siluf_(bflo(gr.x)), o[E].y * rn * nv.y * siluf_(bfhi(gr.x)));
        ov.y = pk2(o[E].z * rn * nv.z * siluf_(bflo(gr.y)), o[E].w * rn * nv.w * siluf_(bfhi(gr.y)));
        *(u32x2*)(op + 16 * E) = ov; }
}
constexpr int GCH = 64, GNCH = 68;
constexpr size_t WS_GST = WS_OB + (size_t)2 * OBSZ * 2;
constexpr size_t WS_GDEC = WS_END;
constexpr size_t WS_H3B = WS_GDEC + (size_t)16 * 2 * GNCH * 64 * 4;
constexpr size_t WS_ROPE = WS_H3B + (size_t)2 * 4096 * 64 * 2;
constexpr size_t WS_TWID = WS_ROPE + (size_t)(SEQL + LC) * 64 * 8;
constexpr size_t WS_END2 = WS_TWID + 4096 * 8;
__device__ __forceinline__ int gla_rowbase(int b, int cg) { return cg < 4 ? NLAT + b * LC + cg * GCH : b * SEQL + (cg - 4) * GCH; }

constexpr int GLS = 68;
__device__ __forceinline__ void gla_gates_compute(const DArgs& a, unsigned char* ws, LAS float* BF, LAS float* BB, LAS float* GW  , int l, int h, int rowbase, int tid) {
    const int t = tid >> 3, d8 = tid & 7;
    const float* lr = (const float*)(ws + WS_LR) + (size_t)(rowbase + t) * 32;
    f32x4 lv[8];
#pragma unroll
    for (int q = 0; q < 8; ++q) lv[q] = ((const f32x4*)lr)[q];
    { const int dir = tid >> 8, r = (tid >> 4) & 15, c4 = (tid & 15) * 4;
      *(LAS f32x4*)(GW + (dir * 17 + r) * 64 + c4) = *(const f32x4*)(a.in[I_GGW] + (size_t)(l * 2 + dir) * 16 * 256 + r * 256 + h * 64 + c4);
      if (tid < 32) { const int dd = tid >> 4; *(LAS f32x4*)(GW + (dd * 17 + 16) * 64 + c4) = *(const f32x4*)(a.in[I_GGB] + (size_t)(l * 2 + dd) * 256 + h * 64 + c4); } }
    __syncthreads();
    bf16_t* GLG = (bf16_t*)(ws + WS_WIN);
#pragma unroll
    for (int dir = 0; dir < 2; ++dir) {
        const LAS float* gw = GW + dir * 17 * 64 + 8 * d8;
        f32x4 s0 = *(const LAS f32x4*)(gw + 16 * 64), s1 = *(const LAS f32x4*)(gw + 16 * 64 + 4);
#pragma unroll
        for (int j = 0; j < 16; ++j) { const float lj = lv[dir * 4 + (j >> 2)][j & 3]; s0 += lj * *(const LAS f32x4*)(gw + j * 64); s1 += lj * *(const LAS f32x4*)(gw + j * 64 + 4); }
        LAS float* dst = (dir ? BB : BF) + t * GLS + 8 * d8;
        float la[8];
#pragma unroll
        for (int x = 0; x < 8; ++x) { const float s = x < 4 ? s0[x] : s1[x - 4]; const float e = __expf(-fabsf(s)); const float ls = fminf(s, 0.f) - __logf(1.0f + e); la[x] = ls * (1.0f / 16.0f); }
        const u32x4 pk = pack8(la);
        *(u32x4*)(GLG + ((size_t)dir * MR + rowbase + t) * 256 + h * 64 + 8 * d8) = pk;
        float lq[8]; unpack8(pk, lq);
        *(LAS f32x4*)dst = (f32x4){lq[0], lq[1], lq[2], lq[3]}; *(LAS f32x4*)(dst + 4) = (f32x4){lq[4], lq[5], lq[6], lq[7]};
    }
}
__device__ __forceinline__ void gla_gates_load(unsigned char* ws, LAS float* BF, LAS float* BB, int h, int rowbase, int tid) {
    const int t = tid >> 3, d8 = tid & 7;
    const bf16_t* GLG = (const bf16_t*)(ws + WS_WIN);
#pragma unroll
    for (int dir = 0; dir < 2; ++dir) { float lq[8]; unpack8(*(const u32x4*)(GLG + ((size_t)dir * MR + rowbase + t) * 256 + h * 64 + 8 * d8), lq);
        LAS float* dst = (dir ? BB : BF) + t * GLS + 8 * d8;
        *(LAS f32x4*)dst = (f32x4){lq[0], lq[1], lq[2], lq[3]}; *(LAS f32x4*)(dst + 4) = (f32x4){lq[4], lq[5], lq[6], lq[7]}; }
}
__device__ __forceinline__ void gla_scan(LAS float* BF, LAS float* BB, int tid) {
    const int lane = tid & 63, w = tid >> 6;
    __syncthreads();
#pragma unroll 4
    for (int c = 0; c < 16; ++c) { const int col = 16 * w + c; const int dir = col >> 6, d = col & 63;
        LAS float* p = (dir ? BB : BF) + (dir ? 63 - lane : lane) * GLS + d;
        float v = *p;
#pragma unroll
        for (int off = 1; off < 64; off <<= 1) { const float u = __shfl_up(v, off); if (lane >= off) v += u; }
        *p = v; }
    __syncthreads();
}

__device__ __forceinline__ void gla_passA(const DArgs& a, unsigned char* ws, LAS unsigned char* lds, int l, int item, int tid) {
    const int bh = item / GNCH, cg = item % GNCH, b = bh >> 2, h = bh & 3;
    const int lane = tid & 63, w = tid >> 6, g = lane >> 4;
    LAS float* BF = (LAS float*)lds; LAS float* BB = (LAS float*)(lds + 17408); LAS unsigned char* KH = lds + 34816; LAS unsigned char* VI = lds + 34816 + 16384;
    const int rowbase = gla_rowbase(b, cg);
    const bf16_t* P = (const bf16_t*)(ws + WS_P) + (size_t)rowbase * LDP;
    const int t = tid >> 3, d8 = tid & 7;
    const u32x4 kraw = *(const u32x4*)(P + (size_t)t * LDP + PC_GK + h * 64 + 8 * d8);
    u32x4 vraw[2];
#pragma unroll
    for (int i = 0; i < 2; ++i) { const int n = tid + NT * i; vraw[i] = *(const u32x4*)(P + (size_t)(n >> 4) * LDP + PC_GV + h * 128 + (n & 15) * 8); }
    gla_gates_compute(a, ws, BF, BB, (LAS float*)(lds + 34816 + 32768), l, h, rowbase, tid);
    gla_scan(BF, BB, tid);
    { float kf[8], x0[8], x1[8]; unpack8(kraw, kf);
#pragma unroll
      for (int x = 0; x < 8; ++x) { const int d = 8 * d8 + x; x0[x] = kf[x] * __expf(BF[63 * GLS + d] - BF[t * GLS + d]); x1[x] = kf[x] * __expf(BB[d] - BB[t * GLS + d]); }
      *(LAS u32x4*)(KH + off_b(t, d8)) = pack8(x0); *(LAS u32x4*)(KH + off_b(t, 8 + d8)) = pack8(x1);
#pragma unroll
      for (int i = 0; i < 2; ++i) { const int n = tid + NT * i; *(LAS u32x4*)(VI + off_b(n >> 4, n & 15)) = vraw[i]; }
      if (tid < 128) { const int dir = tid >> 6, d = tid & 63; ((float*)(ws + WS_GDEC))[((size_t)(bh * 2 + dir) * GNCH + cg) * 64 + d] = __expf(dir ? BB[d] : BF[63 * GLS + d]); } }
    __syncthreads();
    const int dir = w >> 2, Dt = w & 3;
    bf16x8 af[2];
#pragma unroll
    for (int ks = 0; ks < 2; ++ks) af[ks] = img_tr_frag(KH, lane, dir * 4 + Dt, ks);
    bf16_t* ST = (bf16_t*)(ws + WS_GST) + ((size_t)(bh * 2 + dir) * GNCH + cg) * (128 * 64);
#pragma unroll 2
    for (int E = 0; E < 8; ++E) {
        f32x4 c = {0.f, 0.f, 0.f, 0.f};
#pragma unroll
        for (int ks = 0; ks < 2; ++ks) c = MFMA16(af[ks], img_tr_frag(VI, lane, E, ks), c);
        u32x2 o; o.x = pk2(c.x, c.y); o.y = pk2(c.z, c.w);
        *(u32x2*)(ST + (size_t)(16 * E + (lane & 15)) * 64 + 16 * Dt + 4 * g) = o;
    }
}
__device__ __forceinline__ void gla_passB(unsigned char* ws, LAS unsigned char* lds, int blk, int tid) {
    const int bd = blk >> 1, dir = bd & 1, el = (blk & 1) * 512 + tid;
    LAS float* decs = (LAS float*)lds;
    { const float* dsrc = (const float*)(ws + WS_GDEC) + (size_t)bd * GNCH * 64;
      for (int i = tid; i < GNCH * 64; i += NT) decs[i] = dsrc[i]; }
    __syncthreads();
    bf16_t* base = (bf16_t*)(ws + WS_GST) + (size_t)bd * GNCH * (128 * 64) + (size_t)el * 8;
    const int d0 = (el & 7) * 8;
    float acc[8];
#pragma unroll
    for (int x = 0; x < 8; ++x) acc[x] = 0.f;
#pragma unroll 1
    for (int s0 = 0; s0 < GNCH; s0 += 17) {
        u32x4 kvr[17];
#pragma unroll
        for (int j = 0; j < 17; ++j) { const int s = s0 + j; const int cg = dir == 0 ? s : (s < 4 ? 3 - s : 71 - s); kvr[j] = *(const u32x4*)(base + (size_t)cg * (128 * 64)); }
#pragma unroll
        for (int j = 0; j < 17; ++j) { const int s = s0 + j; const int cg = dir == 0 ? s : (s < 4 ? 3 - s : 71 - s);
            float kv[8]; unpack8(kvr[j], kv);
            const f32x4 q0 = *(const LAS f32x4*)(decs + cg * 64 + d0), q1 = *(const LAS f32x4*)(decs + cg * 64 + d0 + 4);
            *(u32x4*)(base + (size_t)cg * (128 * 64)) = pack8(acc);
#pragma unroll
            for (int x = 0; x < 8; ++x) acc[x] = (x < 4 ? q0[x] : q1[x - 4]) * acc[x] + kv[x]; }
    }
    __syncthreads();
}
__device__ __forceinline__ void gla_passC(const DArgs& a, unsigned char* ws, LAS unsigned char* lds, int l, int item, int tid) {
    const int bh = item / GNCH, cg = item % GNCH, b = bh >> 2, h = bh & 3;
    const int lane = tid & 63, w = tid >> 6, g = lane >> 4, il = lane & 15;
    LAS float* BF = (LAS float*)lds; LAS float* BB = (LAS float*)(lds + 17408);
    LAS unsigned char* QKF = lds + 34816; LAS unsigned char* QKB = QKF + 16384; LAS unsigned char* QH = QKB + 16384; LAS unsigned char* VI = QH + 16384; LAS unsigned char* SI = VI + 16384;
    const int rowbase = gla_rowbase(b, cg);
    const bf16_t* P = (const bf16_t*)(ws + WS_P) + (size_t)rowbase * LDP;
    const int t = tid >> 3, d8 = tid & 7;
    const u32x4 qraw = *(const u32x4*)(P + (size_t)t * LDP + PC_GQ + h * 64 + 8 * d8), kraw = *(const u32x4*)(P + (size_t)t * LDP + PC_GK + h * 64 + 8 * d8);
    u32x4 vraw[2], sraw[4];
#pragma unroll
    for (int i = 0; i < 2; ++i) { const int n = tid + NT * i; vraw[i] = *(const u32x4*)(P + (size_t)(n >> 4) * LDP + PC_GV + h * 128 + (n & 15) * 8); }
    { const bf16_t* STf = (const bf16_t*)(ws + WS_GST) + ((size_t)(bh * 2) * GNCH + cg) * (128 * 64); const bf16_t* STb = STf + (size_t)GNCH * 128 * 64;
#pragma unroll
      for (int i = 0; i < 4; ++i) { const int n = tid + NT * i, row = n >> 4, ch = n & 15; sraw[i] = *(const u32x4*)((ch < 8 ? STf : STb) + (size_t)row * 64 + (ch & 7) * 8); } }
    gla_gates_load(ws, BF, BB, h, rowbase, tid);
    gla_scan(BF, BB, tid);
    { float qf[8], kf[8], o0[8], o1[8], o2[8], o3[8], o4[8], o5[8];
      unpack8(qraw, qf); unpack8(kraw, kf);
#pragma unroll
      for (int x = 0; x < 8; ++x) { const int d = 8 * d8 + x; const float bf = BF[t * GLS + d], bb = BB[t * GLS + d], rf = BF[31 * GLS + d], rb = BB[32 * GLS + d]; const float q = qf[x] * 0.125f;
          o0[x] = q * __expf(bf - rf); o1[x] = kf[x] * __expf(rf - bf); o2[x] = q * __expf(bb - rb); o3[x] = kf[x] * __expf(rb - bb); o4[x] = q * __expf(bf); o5[x] = q * __expf(bb); }
      *(LAS u32x4*)(QKF + off_b(t, d8)) = pack8(o0); *(LAS u32x4*)(QKF + off_b(t, 8 + d8)) = pack8(o1);
      *(LAS u32x4*)(QKB + off_b(t, d8)) = pack8(o2); *(LAS u32x4*)(QKB + off_b(t, 8 + d8)) = pack8(o3);
      *(LAS u32x4*)(QH + off_b(t, d8)) = pack8(o4); *(LAS u32x4*)(QH + off_b(t, 8 + d8)) = pack8(o5);
#pragma unroll
      for (int i = 0; i < 2; ++i) { const int n = tid + NT * i; *(LAS u32x4*)(VI + off_b(n >> 4, n & 15)) = vraw[i]; }
#pragma unroll
      for (int i = 0; i < 4; ++i) { const int n = tid + NT * i; *(LAS u32x4*)(SI + off_b(n >> 4, n & 15)) = sraw[i]; } }
    __syncthreads();
    const int ib = w & 3, eh = w >> 2, iloc = 16 * ib + il;
    f32x4 at[4];
    { bf16x8 qff[2], qfb[2];
#pragma unroll
      for (int ks = 0; ks < 2; ++ks) { qff[ks] = img_row_frag(QKF, lane, ib, ks); qfb[ks] = img_row_frag(QKB, lane, ib, ks); }
#pragma unroll
      for (int T = 0; T < 4; ++T) { f32x4 cf = {0.f, 0.f, 0.f, 0.f}, cb = {0.f, 0.f, 0.f, 0.f};
#pragma unroll
          for (int ks = 0; ks < 2; ++ks) { cf = MFMA16(img_row_frag(QKF, lane, T, 2 + ks), qff[ks], cf); cb = MFMA16(img_row_frag(QKB, lane, T, 2 + ks), qfb[ks], cb); }
#pragma unroll
          for (int r = 0; r < 4; ++r) { const int j = 16 * T + 4 * g + r; cf[r] = (j <= iloc ? cf[r] : 0.f) + (j >= iloc ? cb[r] : 0.f); }
          at[T] = cf; } }
    f32x4 o[4];
    { bf16x8 hf[2], hb[2];
#pragma unroll
      for (int ks = 0; ks < 2; ++ks) { hf[ks] = img_row_frag(QH, lane, ib, ks); hb[ks] = img_row_frag(QH, lane, ib, 2 + ks); }
#pragma unroll
      for (int E4 = 0; E4 < 4; ++E4) { const int E = 4 * eh + E4; f32x4 c = {0.f, 0.f, 0.f, 0.f};
#pragma unroll
          for (int ks = 0; ks < 2; ++ks) { c = MFMA16(img_row_frag(SI, lane, E, ks), hf[ks], c); c = MFMA16(img_row_frag(SI, lane, E, 2 + ks), hb[ks], c); }
          o[E4] = c; } }
#pragma unroll
    for (int s = 0; s < 2; ++s) { const bf16x8 bfr = acc_pair_frag(at[2 * s], at[2 * s + 1]);
#pragma unroll
        for (int E4 = 0; E4 < 4; ++E4) o[E4] = MFMA16(img_tr_frag_acc(VI, lane, 4 * eh + E4, s), bfr, o[E4]); }
    float ss = 0.f;
#pragma unroll
    for (int E4 = 0; E4 < 4; ++E4) ss += (o[E4].x * o[E4].x + o[E4].y * o[E4].y) + (o[E4].z * o[E4].z + o[E4].w * o[E4].w);
    ss += __shfl_xor(ss, 16); ss += __shfl_xor(ss, 32);
    LAS float* red = (LAS float*)lds;
    if (g == 0) red[eh * 64 + iloc] = ss;
    __syncthreads();
    const float rn = rsqrtf((red[iloc] + red[64 + iloc]) * (1.0f / 128.0f) + EPS);
    const size_t row = (size_t)rowbase + iloc;
    const bf16_t* gp = (const bf16_t*)(ws + WS_P) + row * LDP + PC_GG + h * 128 + 64 * eh + 4 * g;
    const float* nw = a.in[I_GNW] + l * 512 + h * 128 + 64 * eh + 4 * g;
    bf16_t* op = (bf16_t*)(ws + WS_H) + row * D + 1536 + h * 128 + 64 * eh + 4 * g;
#pragma unroll
    for (int E4 = 0; E4 < 4; ++E4) { const u32x2 gr = *(const u32x2*)(gp + 16 * E4); const f32x4 nv = *(const f32x4*)(nw + 16 * E4);
        u32x2 ov; ov.x = pk2(o[E4].x * rn * nv.x * siluf_(bflo(gr.x)), o[E4].y * rn * nv.y * siluf_(bfhi(gr.x)));
        ov.y = pk2(o[E4].z * rn * nv.z * siluf_(bflo(gr.y)), o[E4].w * rn * nv.w * siluf_(bfhi(gr.y)));
        *(u32x2*)(op + 16 * E4) = ov; }
}
constexpr int SNCH = 68;
constexpr size_t WS_S5ST = WS_OB + (size_t)4 * OBSZ * 2;
constexpr size_t WS_S5BTB = WS_S5BT;
constexpr size_t WS_S5CPB = WS_S5BT + 524288;
constexpr size_t WS_S5A64 = WS_S5BT + 1048576;

__device__ __forceinline__ void prep_s5b(const DArgs& a, unsigned char* ws, int it, int tid) {
    const int idx = it * 512 + tid;
    const int gi = idx >> 6, p = idx & 63;
    const float a_re = a.in[I_S5ARE][idx], a_im = a.in[I_S5AIM][idx], ldt = a.in[I_S5LDT][gi];
    const float dt = expf(ldt), mag = expf(a_re * dt);
    float sn, cs; sincosf(a_im * dt, &sn, &cs);
    const float ab_re = mag * cs, ab_im = mag * sn, den = a_re * a_re + a_im * a_im, nr = ab_re - 1.0f;
    const float co_re = (nr * a_re + ab_im * a_im) / den, co_im = (ab_im * a_re - nr * a_im) / den;
    ((f32x2*)(ws + WS_S5AB))[idx] = (f32x2){ab_re, ab_im};
    float pr = ab_re, pi = ab_im;
#pragma unroll
    for (int q = 0; q < 6; ++q) { const float nr2 = pr * pr - pi * pi, ni2 = 2.0f * pr * pi; pr = nr2; pi = ni2; }
    ((f32x2*)(ws + WS_S5A64))[idx] = (f32x2){pr, pi};
    const float* bre = a.in[I_S5BRE] + (size_t)idx * 16; const float* bim = a.in[I_S5BIM] + (size_t)idx * 16;
    float tr[16], ti[16];
#pragma unroll
    for (int i = 0; i < 16; ++i) { const float br = bre[i], bi = bim[i]; tr[i] = co_re * br - co_im * bi; ti[i] = co_re * bi + co_im * br; }
    bf16_t* btb = (bf16_t*)(ws + WS_S5BTB) + (size_t)gi * 128 * 16;
#pragma unroll
    for (int hlf = 0; hlf < 2; ++hlf) { u32x4 w0, w1; const float* s = hlf ? ti : tr;
        w0.x = pk2(s[0], s[1]); w0.y = pk2(s[2], s[3]); w0.z = pk2(s[4], s[5]); w0.w = pk2(s[6], s[7]); w1.x = pk2(s[8], s[9]); w1.y = pk2(s[10], s[11]); w1.z = pk2(s[12], s[13]); w1.w = pk2(s[14], s[15]);
        *(u32x4*)(btb + (size_t)(64 * hlf + p) * 16) = w0; *(u32x4*)(btb + (size_t)(64 * hlf + p) * 16 + 8) = w1; }
    bf16_t* cpb = (bf16_t*)(ws + WS_S5CPB) + (size_t)gi * 16 * 128;
    const float* cre = a.in[I_S5CRE] + (size_t)gi * 1024; const float* cim = a.in[I_S5CIM] + (size_t)gi * 1024;
#pragma unroll
    for (int i = 0; i < 16; ++i) *(unsigned*)(cpb + i * 128 + 2 * p) = pk2(cre[i * 64 + p], -cim[i * 64 + p]);
}

struct S5Unit { bf16x8 btf[8]; f32x2 ab; f32x2 h; const bf16_t* cp; };
template <bool PASSC> __device__ __forceinline__ void s5_load_unit(S5Unit& U, unsigned char* ws, const bf16_t* P, const f32x2* ST, int l, int b, int cs, int rowbase, int grp, int dir, int lane) {
    const int g = lane >> 4, il = lane & 15;
    const bf16x8 zero8 = {0, 0, 0, 0, 0, 0, 0, 0};
    const int gi = (l * 2 + dir) * 32 + grp;
    U.ab = ((const f32x2*)(ws + WS_S5AB))[gi * 64 + lane];
    const size_t sidx = ((size_t)(b * SNCH + cs) * 2 + dir) * 2048 + grp * 64 + lane;
    U.h = PASSC ? ST[sidx] : (f32x2){0.f, 0.f};
    const bf16_t* bt = (const bf16_t*)(ws + WS_S5BTB) + (size_t)gi * 128 * 16 + (size_t)il * 16 + 8 * (g & 1);
#pragma unroll
    for (int Pt = 0; Pt < 8; ++Pt) { const bf16x8 v = *(const bf16x8*)(bt + Pt * 256); U.btf[Pt] = g < 2 ? v : zero8; }
    U.cp = (const bf16_t*)(ws + WS_S5CPB) + (size_t)gi * 16 * 128 + (size_t)il * 128 + 8 * g;
}
__device__ __forceinline__ void s5_load_u(bf16x8 (&ufa)[4], const bf16_t* P, int rowbase, int grp, int lane) {
    const int g = lane >> 4, il = lane & 15; const bf16x8 zero8 = {0, 0, 0, 0, 0, 0, 0, 0};
#pragma unroll
    for (int Tt = 0; Tt < 4; ++Tt) { const bf16x8 v = *(const bf16x8*)(P + (size_t)(rowbase + 16 * Tt + il) * LDP + PC_S5U + grp * 16 + 8 * (g & 1)); ufa[Tt] = g < 2 ? v : zero8; }
}
template <bool PASSC, int DIR> __device__ __forceinline__ void s5_run_unit(const S5Unit& U, const bf16x8 (&ufa)[4], f32x4 (&yacc)[4], f32x2& hout, LAS float* BU, LAS unsigned char* HW, int lane) {
    const int g = lane >> 4, il = lane & 15;
    f32x2 h = U.h; const f32x2 ab = U.ab;
    bf16x8 cpf[4];
    if (PASSC) {
#pragma unroll
        for (int ks = 0; ks < 4; ++ks) cpf[ks] = *(const bf16x8*)(U.cp + 32 * ks); }
    f32x4 d[8];
#pragma unroll
    for (int Pt = 0; Pt < 8; ++Pt) d[Pt] = MFMA16(U.btf[Pt], ufa[DIR ? 3 : 0], ((f32x4){0.f, 0.f, 0.f, 0.f}));
#pragma unroll
    for (int wi = 0; wi < 4; ++wi) {
        const int Tt = DIR ? 3 - wi : wi;
#pragma unroll
        for (int Pt = 0; Pt < 8; ++Pt) {
#pragma unroll
            for (int r = 0; r < 4; ++r) BU[(16 * Pt + 4 * g + r) * 20 + il] = d[Pt][r]; }
        asm volatile("" ::: "memory");
        if (!PASSC) {
            f32x4 br[4], bi[4];
#pragma unroll
            for (int q = 0; q < 4; ++q) { br[q] = *(const LAS f32x4*)(BU + lane * 20 + 4 * q); bi[q] = *(const LAS f32x4*)(BU + (64 + lane) * 20 + 4 * q); }
            if (wi < 3) {
#pragma unroll
                for (int Pt = 0; Pt < 8; ++Pt) d[Pt] = MFMA16(U.btf[Pt], ufa[DIR ? 2 - wi : wi + 1], ((f32x4){0.f, 0.f, 0.f, 0.f})); }
#pragma unroll
            for (int s = 0; s < 16; ++s) { const int tt = DIR ? 15 - s : s;
                const float hr = __builtin_fmaf(ab.x, h.x, __builtin_fmaf(-ab.y, h.y, br[tt >> 2][tt & 3])), hi = __builtin_fmaf(ab.x, h.y, __builtin_fmaf(ab.y, h.x, bi[tt >> 2][tt & 3]));
                h = (f32x2){hr, hi}; }
        } else {
#pragma unroll
            for (int hf2 = 0; hf2 < 2; ++hf2) { const int q0 = DIR ? 2 - 2 * hf2 : 2 * hf2;
                f32x4 br[2], bi[2];
#pragma unroll
                for (int q = 0; q < 2; ++q) { br[q] = *(const LAS f32x4*)(BU + lane * 20 + 4 * (q0 + q)); bi[q] = *(const LAS f32x4*)(BU + (64 + lane) * 20 + 4 * (q0 + q)); }
#pragma unroll
                for (int s = 0; s < 8; ++s) { const int t8 = DIR ? 7 - s : s; const int tt = 4 * q0 + t8;
                    const float hr = __builtin_fmaf(ab.x, h.x, __builtin_fmaf(-ab.y, h.y, br[t8 >> 2][t8 & 3])), hi = __builtin_fmaf(ab.x, h.y, __builtin_fmaf(ab.y, h.x, bi[t8 >> 2][t8 & 3]));
                    h = (f32x2){hr, hi};
                    *(LAS unsigned*)(HW + off_b(tt, lane >> 2) + (lane & 3) * 4) = pk2(hr, hi); }
            }
        }
        asm volatile("" ::: "memory");
        if (PASSC) {
            bf16x8 hf[4];
#pragma unroll
            for (int ks = 0; ks < 4; ++ks) hf[ks] = img_row_frag(HW, lane, 0, ks);
#pragma unroll
            for (int ks = 0; ks < 4; ++ks) yacc[Tt] = MFMA16(cpf[ks], hf[ks], yacc[Tt]);
            }
        asm volatile("" ::: "memory");
        if (PASSC && wi < 3) {
#pragma unroll
            for (int Pt = 0; Pt < 8; ++Pt) d[Pt] = MFMA16(U.btf[Pt], ufa[DIR ? 2 - wi : wi + 1], ((f32x4){0.f, 0.f, 0.f, 0.f})); }
    }
    hout = h;
}
template <bool PASSC> __device__ __forceinline__ void s5_item(const DArgs& a, unsigned char* ws, LAS unsigned char* lds, int l, int item, int ggsel, int tid) {
    const int b = item / (SNCH * 2), rem = item % (SNCH * 2), cs = rem >> 1, half = rem & 1;
    const int lane = tid & 63, w = tid >> 6, g = lane >> 4, il = lane & 15;
    const int rowbase = gla_rowbase(b, cs);
    LAS float* BU = (LAS float*)(lds + w * 14336); LAS unsigned char* HW = lds + w * 14336 + 10240;
    const bf16_t* P = (const bf16_t*)(ws + WS_P);
    f32x2* ST = (f32x2*)(ws + WS_S5ST);
    const int grp0 = 16 * half + w, grp1 = grp0 + 8;
    S5Unit UA; bf16x8 ufa[4];
    { const int gg = ggsel;
        const int grp = gg ? grp1 : grp0;
        f32x4 yacc[4];
#pragma unroll
        for (int q = 0; q < 4; ++q) yacc[q] = (f32x4){0.f, 0.f, 0.f, 0.f};
        f32x2 hend;
        s5_load_unit<PASSC>(UA, ws, P, ST, l, b, cs, rowbase, grp, 0, lane); s5_load_u(ufa, P, rowbase, grp, lane);
        s5_run_unit<PASSC, 0>(UA, ufa, yacc, hend, BU, HW, lane);
        if (!PASSC) ST[((size_t)(b * SNCH + cs) * 2 + 0) * 2048 + grp * 64 + lane] = hend;
        s5_load_unit<PASSC>(UA, ws, P, ST, l, b, cs, rowbase, grp, 1, lane);
        s5_run_unit<PASSC, 1>(UA, ufa, yacc, hend, BU, HW, lane);
        if (!PASSC) ST[((size_t)(b * SNCH + cs) * 2 + 1) * 2048 + grp * 64 + lane] = hend;
        if (PASSC) {
            const f32x4 dsk = *(const f32x4*)(a.in[I_S5D] + l * 512 + grp * 16 + 4 * g);
            bf16_t* G5 = (bf16_t*)(ws + WS_KF);
#pragma unroll
            for (int Tt = 0; Tt < 4; ++Tt) { const size_t row = (size_t)rowbase + 16 * Tt + il;
                const u32x2 ur = *(const u32x2*)(P + row * LDP + PC_S5U + grp * 16 + 4 * g), sg = *(const u32x2*)(P + row * LDP + PC_S5G + grp * 16 + 4 * g);
                const float g0 = gelu_tanh(yacc[Tt].x + bflo(ur.x) * dsk.x), g1 = gelu_tanh(yacc[Tt].y + bfhi(ur.x) * dsk.y), g2 = gelu_tanh(yacc[Tt].z + bflo(ur.y) * dsk.z), g3 = gelu_tanh(yacc[Tt].w + bfhi(ur.y) * dsk.w);
                u32x2 ov; ov.x = pk2(g0, g1); ov.y = pk2(g2, g3);
                *(u32x2*)(G5 + row * 512 + grp * 16 + 4 * g) = ov;
                ov.x = pk2(g0 * siluf_(bflo(sg.x)), g1 * siluf_(bfhi(sg.x))); ov.y = pk2(g2 * siluf_(bflo(sg.y)), g3 * siluf_(bfhi(sg.y)));
                *(u32x2*)(G5 + OBSZ + row * 512 + grp * 16 + 4 * g) = ov; }
        }
    }
}
__device__ __forceinline__ void s5_passB(unsigned char* ws, int l, int gt) {
    const int p = gt & 63, grp = (gt >> 6) & 31, dir = (gt >> 11) & 1, b = gt >> 12;
    const f32x2 a64 = ((const f32x2*)(ws + WS_S5A64))[((l * 2 + dir) * 32 + grp) * 64 + p];
    f32x2* ST = (f32x2*)(ws + WS_S5ST);
    f32x2 acc = {0.f, 0.f};
#pragma unroll 1
    for (int s0 = 0; s0 < SNCH; s0 += 34) {
        f32x2 ev[34];
#pragma unroll
        for (int j = 0; j < 34; ++j) { const int s = s0 + j; const int cs = dir == 0 ? s : (s < 4 ? 3 - s : 71 - s); ev[j] = ST[((size_t)(b * SNCH + cs) * 2 + dir) * 2048 + grp * 64 + p]; }
#pragma unroll
        for (int j = 0; j < 34; ++j) { const int s = s0 + j; const int cs = dir == 0 ? s : (s < 4 ? 3 - s : 71 - s);
            ST[((size_t)(b * SNCH + cs) * 2 + dir) * 2048 + grp * 64 + p] = acc;
            acc = (f32x2){a64.x * acc.x - a64.y * acc.y + ev[j].x, a64.x * acc.y + a64.y * acc.x + ev[j].y}; }
    }
}
constexpr int FFT_PHYS = 8448;
__device__ __forceinline__ void fft_twiddles_g(LAS f32x2* W, const f32x2* Wg, int tid) {
#pragma unroll
    for (int j = 0; j < 8; ++j) W[tid + NT * j] = Wg[tid + NT * j];
}
__device__ __forceinline__ int fphys(int i) { return i + (i >> 5); }
__device__ __forceinline__ f32x2 cmulf(const f32x2 a, const f32x2 b) { return (f32x2){a.x * b.x - a.y * b.y, a.x * b.y + a.y * b.x}; }
__device__ __forceinline__ f32x2 cmulcf(const f32x2 a, const f32x2 b) { return (f32x2){a.x * b.x + a.y * b.y, a.y * b.x - a.x * b.y}; }
template <int RL> __device__ __forceinline__ void dft_fwd_const(f32x2 (&e)[1 << RL]) {
#pragma unroll
    for (int s = 0; s < RL; ++s) { const int h = 1 << (RL - 1 - s);
#pragma unroll
        for (int m = 0; m < (1 << RL); ++m) { if (m & h) continue;
            const int mp = m & (h - 1); const f32x2 a_ = e[m], b_ = e[m | h]; const f32x2 d = a_ - b_; e[m] = a_ + b_;
            if (mp == 0) e[m | h] = d;
            else if (2 * mp == h) e[m | h] = (f32x2){d.y, -d.x};
            else { const float ang = -3.14159265358979323846f * (float)mp / (float)h; const f32x2 c = {__builtin_cosf(ang), __builtin_sinf(ang)}; e[m | h] = cmulf(d, c); } } }
}
template <int RL> __device__ __forceinline__ void dft_inv_const(f32x2 (&e)[1 << RL]) {
#pragma unroll
    for (int ss = 0; ss < RL; ++ss) { const int s = RL - 1 - ss; const int h = 1 << (RL - 1 - s);
#pragma unroll
        for (int m = 0; m < (1 << RL); ++m) { if (m & h) continue;
            const int mp = m & (h - 1); const f32x2 a_ = e[m], b_ = e[m | h]; f32x2 t;
            if (mp == 0) t = b_;
            else if (2 * mp == h) t = (f32x2){-b_.y, b_.x};
            else { const float ang = -3.14159265358979323846f * (float)mp / (float)h; const f32x2 c = {__builtin_cosf(ang), __builtin_sinf(ang)}; t = cmulcf(b_, c); }
            e[m] = a_ + t; e[m | h] = a_ - t; } }
}
template <int RL> __device__ __forceinline__ constexpr int brev_c(int m) { int r = 0; for (int i = 0; i < RL; ++i) r |= ((m >> i) & 1) << (RL - 1 - i); return r; }
template <int RL, bool CONJ> __device__ __forceinline__ void apply_tw(f32x2 (&e)[1 << RL], const f32x2 w1) {
    f32x2 tw[1 << RL];
    tw[0] = (f32x2){1.f, 0.f}; tw[1] = w1;
    if (RL >= 2) { tw[2] = cmulf(w1, w1); tw[3] = cmulf(tw[2], w1); }
    if (RL >= 3) { tw[4] = cmulf(tw[2], tw[2]); tw[5] = cmulf(tw[4], tw[1]); tw[6] = cmulf(tw[4], tw[2]); tw[7] = cmulf(tw[4], tw[3]); }
    if (RL >= 4) { tw[8] = cmulf(tw[4], tw[4]);
#pragma unroll
        for (int k = 1; k < 8; ++k) tw[8 + k] = cmulf(tw[8], tw[k]); }
#pragma unroll
    for (int m = 1; m < (1 << RL); ++m) e[m] = CONJ ? cmulcf(e[m], tw[brev_c<RL>(m)]) : cmulf(e[m], tw[brev_c<RL>(m)]);
}
template <int RL, int BETA, bool INV, class WP> __device__ __forceinline__ void fft2_pass(LAS f32x2* X, WP W, int tid) {
    constexpr int LOW = BETA - RL + 1, NG = FFTN >> RL, STR = (1 << LOW) + (1 << (LOW - 5));
#pragma unroll 1
    for (int gi = tid; gi < NG; gi += NT) {
        const int base = ((gi >> LOW) << (BETA + 1)) | (gi & ((1 << LOW) - 1));
        volatile LAS f32x2* p = X + fphys(base);
        f32x2 e[1 << RL];
#pragma unroll
        for (int m = 0; m < (1 << RL); ++m) e[m] = p[m * STR];
        const f32x2 w1 = W[(base & ((1 << LOW) - 1)) << (12 - BETA)];
        if (!INV) { dft_fwd_const<RL>(e); apply_tw<RL, false>(e, w1); }
        else { apply_tw<RL, true>(e, w1); dft_inv_const<RL>(e); }
#pragma unroll
        for (int m = 0; m < (1 << RL); ++m) p[m * STR] = e[m];
    }
}
template <class WP> __device__ __forceinline__ void fft2_fwd_ABC(LAS f32x2* X, WP W, int tid) {
    fft2_pass<4, 12, false>(X, W, tid); __syncthreads(); fft2_pass<4, 8, false>(X, W, tid); __syncthreads();
}
template <class WP> __device__ __forceinline__ void fft2_inv_CBA(LAS f32x2* X, WP W, int tid) {
    fft2_pass<4, 8, true>(X, W, tid); __syncthreads(); fft2_pass<4, 12, true>(X, W, tid); __syncthreads();
}
__device__ __forceinline__ void fft2_mid_mul(LAS f32x2* X, const f32x2* KF, int tid) {
    if (tid < 256) {
        volatile LAS f32x2* p = X + 33 * tid;
        f32x2 e[32];
#pragma unroll
        for (int m = 0; m < 32; ++m) e[m] = p[m];
        dft_fwd_const<5>(e);
#pragma unroll
        for (int q4 = 0; q4 < 4; ++q4) { f32x4 kf[4];
#pragma unroll
            for (int q = 0; q < 4; ++q) kf[q] = *(const f32x4*)(KF + 32 * tid + 8 * q4 + 2 * q);
#pragma unroll
            for (int q = 0; q < 4; ++q) { const int m = 8 * q4 + 2 * q; e[m] = cmulf(e[m], (f32x2){kf[q].x, kf[q].y}); e[m + 1] = cmulf(e[m + 1], (f32x2){kf[q].z, kf[q].w}); } }
        dft_inv_const<5>(e);
#pragma unroll
        for (int m = 0; m < 32; ++m) p[m] = e[m];
    }
}
__device__ __forceinline__ void fft2_fwd_D(LAS f32x2* X, int tid) {
    if (tid < 256) { volatile LAS f32x2* p = X + 33 * tid; f32x2 e[32];
#pragma unroll
        for (int m = 0; m < 32; ++m) e[m] = p[m];
        dft_fwd_const<5>(e);
#pragma unroll
        for (int m = 0; m < 32; ++m) p[m] = e[m]; }
}

__device__ __forceinline__ void filt_item2(const DArgs& a, unsigned char* ws, LAS unsigned char* lds, int l, int c, int tid) {
    LAS f32x2* X = (LAS f32x2*)lds; LAS f32x2* W = (LAS f32x2*)(lds + FFT_PHYS * 8); LAS float* w4s = (LAS float*)(lds + FFT_PHYS * 8 + 32768); LAS float* red = w4s + 256;
    fft_twiddles_g(W, (const f32x2*)(ws + WS_TWID), tid);
    if (tid < 128) { const int cc = tid >> 5, pr = tid & 31; const float* wsrc = a.in[I_HW4] + (size_t)l * 64 * 2048 + (cc >> 1) * 1024 + (cc & 1) * 512 + c;
        ((LAS unsigned*)w4s)[pr * 4 + cc] = pk2(wsrc[(size_t)(2 * pr) * 2048], wsrc[(size_t)(2 * pr + 1) * 2048]); }
    if (tid == 0) { float z0; asm volatile("v_mov_b32 %0, 0" : "=v"(z0)); X[fphys(4096)] = (f32x2){z0, z0}; }
    __syncthreads();
    const float dl = fabsf(HY_D0 + (HY_D1 - HY_D0) * ((float)c / 511.0f));
    const bf16_t* H3 = (const bf16_t*)(ws + WS_H3B) + (size_t)l * 4096 * 64;
    float ss0 = 0.f, ss1 = 0.f;
#pragma unroll 1
    for (int j = 0; j < 8; ++j) {
        const int t = tid + 512 * j;
        const u32x4* hr = (const u32x4*)(H3 + (size_t)t * 64);
        u32x4 hraw[8];
#pragma unroll
        for (int q = 0; q < 8; ++q) hraw[q] = hr[q];
        asm volatile("" ::: "memory");
        float f0 = 0.f, f1 = 0.f, b0 = 0.f, b1 = 0.f;
        typedef __bf16 bfp2 __attribute__((ext_vector_type(2)));
#pragma unroll
        for (int q = 0; q < 8; ++q) {
#pragma unroll
            for (int e = 0; e < 4; ++e) { const u32x4 wq = ((const LAS u32x4*)w4s)[4 * q + e]; const unsigned hx = hraw[q][e];
                f0 += bflo(hx) * bflo(wq.x) + bfhi(hx) * bfhi(wq.x); f1 += bflo(hx) * bflo(wq.y) + bfhi(hx) * bfhi(wq.y);
                b0 += bflo(hx) * bflo(wq.z) + bfhi(hx) * bfhi(wq.z); b1 += bflo(hx) * bflo(wq.w) + bfhi(hx) * bfhi(wq.w); } }
        const float dec = expf(-((float)t / 4095.0f) * dl); f0 *= dec; f1 *= dec; b0 *= dec; b1 *= dec;
        X[fphys(t)] = (f32x2){f0, f1}; ss0 += f0 * f0; ss1 += f1 * f1;
        if (t > 0) { X[fphys(8192 - t)] = (f32x2){b0, b1}; ss0 += b0 * b0; ss1 += b1 * b1; }
    }
    const float rs0 = rsqrtf(block_sum(ss0, red, tid) + EPS), rs1 = rsqrtf(block_sum(ss1, red, tid) + EPS);
#pragma unroll 4
    for (int j = 0; j < 16; ++j) { const int n = fphys(tid + 512 * j); const f32x2 x = X[n]; X[n] = (f32x2){x.x * rs0, x.y * rs1}; }
    __syncthreads(); fft2_fwd_ABC(X, W, tid); fft2_fwd_D(X, tid); __syncthreads();
    f32x2* KF0 = (f32x2*)(ws + WS_KF) + (size_t)(0 * 512 + c) * FFTN; f32x2* KF1 = (f32x2*)(ws + WS_KF) + (size_t)(1 * 512 + c) * FFTN;
#pragma unroll 4
    for (int j = 0; j < 16; ++j) { const int pos = tid + 512 * j; const int k = (int)(__brev((unsigned)pos) >> 19); const int pp = (int)(__brev((unsigned)((8192 - k) & 8191)) >> 19);
        const f32x2 za = X[fphys(pos)], zb = X[fphys(pp)];
        KF0[pos] = (f32x2){0.5f * (za.x + zb.x), 0.5f * (za.y - zb.y)};
        KF1[pos] = (f32x2){0.5f * (za.y + zb.y), 0.5f * (zb.x - za.x)}; }
    __syncthreads();
}

struct Raw8 { u32x4 mid; bf16_t lf, rt; };
__device__ __forceinline__ Raw8 ld_raw8(const bf16_t* p, int t0, int Lx) { Raw8 r; r.mid = *(const u32x4*)(p + t0); r.lf = t0 > 0 ? p[t0 - 1] : (bf16_t)0; r.rt = t0 + 8 < Lx ? p[t0 + 8] : (bf16_t)0; return r; }
__device__ __forceinline__ void sconv8(const Raw8& r, float w0, float w1, float w2, float cb, float (&o)[8]) {
    float x[10]; x[0] = bf2f(r.lf); x[9] = bf2f(r.rt);
    x[1] = bflo(r.mid.x); x[2] = bfhi(r.mid.x); x[3] = bflo(r.mid.y); x[4] = bfhi(r.mid.y); x[5] = bflo(r.mid.z); x[6] = bfhi(r.mid.z); x[7] = bflo(r.mid.w); x[8] = bfhi(r.mid.w);
#pragma unroll
    for (int i = 0; i < 8; ++i) o[i] = w0 * x[i] + w1 * x[i + 1] + w2 * x[i + 2] + cb;
}
__device__ __forceinline__ void hyena_item2(const DArgs& a, unsigned char* ws, LAS unsigned char* lds, int l, int c, int tid) {
    LAS f32x2* X = (LAS f32x2*)lds; LAS f32x2* X2 = (LAS f32x2*)(lds + FFT_PHYS * 8);
    const f32x2* Wg = (const f32x2*)(ws + WS_TWID);
    const float* cw = a.in[I_HCW] + (size_t)l * 3 * 1536; const float* cbp = a.in[I_HCB] + (size_t)l * 1536;
    const float wv0 = cw[c], wv1 = cw[1536 + c], wv2 = cw[3072 + c], bv = cbp[c];
    const float wa0 = cw[512 + c], wa1 = cw[1536 + 512 + c], wa2 = cw[3072 + 512 + c], ba = cbp[512 + c];
    const float wb0 = cw[1024 + c], wb1 = cw[1536 + 1024 + c], wb2 = cw[3072 + 1024 + c], bb = cbp[1024 + c];
    const float bias0 = a.in[I_HBIAS][(l * 2 + 0) * 512 + c], bias1 = a.in[I_HBIAS][(l * 2 + 1) * 512 + c];
    const bf16_t* PT = (const bf16_t*)(ws + WS_PT);
    const bf16_t* pv = PT + (size_t)(PT_V + c) * MR; const bf16_t* pg1 = PT + (size_t)(PT_G1 + c) * MR; const bf16_t* pg2 = PT + (size_t)(PT_G2 + c) * MR; const bf16_t* phg = PT + (size_t)(PT_HG + c) * MR;
    const f32x2* KF0 = (const f32x2*)(ws + WS_KF) + (size_t)(0 * 512 + c) * FFTN; const f32x2* KF1 = (const f32x2*)(ws + WS_KF) + (size_t)(1 * 512 + c) * FFTN;
    const int t0 = 8 * tid;
    const int po = 8 * tid + (tid >> 2);
    LAS f32x2* px = X + po; LAS f32x2* py = X2 + po;
    float z[4][8];
    { Raw8 v[4];
#pragma unroll
      for (int b = 0; b < 4; ++b) v[b] = ld_raw8(pv + b * SEQL, t0, SEQL);
#pragma unroll
      for (int b = 0; b < 4; ++b) sconv8(v[b], wv0, wv1, wv2, bv, z[b]); }
    Raw8 g1r[4];
#pragma unroll
    for (int b = 0; b < 4; ++b) g1r[b] = ld_raw8(pg1 + b * SEQL, t0, SEQL);
#pragma unroll
    for (int x = 0; x < 8; ++x) { px[x] = (f32x2){z[0][x], z[1][x]}; px[4224 + x] = (f32x2){0.f, 0.f}; py[x] = (f32x2){z[2][x], z[3][x]}; py[4224 + x] = (f32x2){0.f, 0.f}; }
    __syncthreads();
#define HY_CONV(KFp) do { \
        fft2_pass<4, 12, false>(X, Wg, tid); fft2_pass<4, 12, false>(X2, Wg, tid); __syncthreads(); \
        fft2_pass<4, 8, false>(X, Wg, tid); fft2_pass<4, 8, false>(X2, Wg, tid); __syncthreads(); \
        fft2_mid_mul(tid < 256 ? X : X2, KFp, tid & 255); __syncthreads(); \
        fft2_pass<4, 8, true>(X, Wg, tid); fft2_pass<4, 8, true>(X2, Wg, tid); __syncthreads(); \
        fft2_pass<4, 12, true>(X, Wg, tid); fft2_pass<4, 12, true>(X2, Wg, tid); __syncthreads(); } while (0)
    HY_CONV(KF0);
    { float g[4][8];
#pragma unroll
      for (int b = 0; b < 4; ++b) sconv8(g1r[b], wa0, wa1, wa2, ba, g[b]);
#pragma unroll
      for (int x = 0; x < 8; ++x) { const f32x2 c0 = px[x] * (1.0f / 8192.0f), c1 = py[x] * (1.0f / 8192.0f);
          z[0][x] = g[0][x] * (c0.x + bias0 * z[0][x]); z[1][x] = g[1][x] * (c0.y + bias0 * z[1][x]); z[2][x] = g[2][x] * (c1.x + bias0 * z[2][x]); z[3][x] = g[3][x] * (c1.y + bias0 * z[3][x]); } }
    Raw8 g2r[4]; u32x4 hgr[4];
#pragma unroll
    for (int b = 0; b < 4; ++b) { g2r[b] = ld_raw8(pg2 + b * SEQL, t0, SEQL); hgr[b] = *(const u32x4*)(phg + b * SEQL + t0); }
    __syncthreads();
#pragma unroll
    for (int x = 0; x < 8; ++x) { px[x] = (f32x2){z[0][x], z[1][x]}; px[4224 + x] = (f32x2){0.f, 0.f}; py[x] = (f32x2){z[2][x], z[3][x]}; py[4224 + x] = (f32x2){0.f, 0.f}; }
    __syncthreads();
    HY_CONV(KF1);
#undef HY_CONV
    bf16_t* pvw = (bf16_t*)(ws + WS_PT) + (size_t)(PT_V + c) * MR;
#pragma unroll
    for (int b = 0; b < 4; ++b) { float g[8], hh[8], o[8]; sconv8(g2r[b], wb0, wb1, wb2, bb, g); unpack8(hgr[b], hh);
#pragma unroll
        for (int x = 0; x < 8; ++x) { const f32x2 cv = ((b < 2) ? px[x] : py[x]) * (1.0f / 8192.0f); const float cvv = (b & 1) ? cv.y : cv.x;
            o[x] = g[x] * (cvv + bias1 * z[b][x]) * siluf_(hh[x]); }
        *(u32x4*)(pvw + b * SEQL + t0) = pack8(o); }
    __syncthreads();
}
__device__ __forceinline__ void hy_transpose_item(unsigned char* ws, LAS unsigned char* lds, int item, int tid, int nrows) {
    const int lane = tid & 63, w = tid >> 6;
    const int wi = item * 8 + w;
    const int nrb = nrows / 64;
    if (wi >= nrb * 8) return;
    const int rb = wi >> 3, cb = wi & 7;
    LAS bf16_t* T = (LAS bf16_t*)(lds + w * 8704);
    const bf16_t* src = (const bf16_t*)(ws + WS_PT) + (size_t)(PT_V + cb * 64) * MR + (size_t)rb * 64;
    u32x4 tv[8];
#pragma unroll
    for (int i = 0; i < 8; ++i) { const int c = 8 * i + (lane >> 3), r8 = (lane & 7) * 8; tv[i] = *(const u32x4*)(src + (size_t)c * MR + r8); }
#pragma unroll
    for (int i = 0; i < 8; ++i) { const int c = 8 * i + (lane >> 3), r8 = (lane & 7) * 8;
        LAS unsigned* d = (LAS unsigned*)(T + c * 66 + r8); d[0] = tv[i].x; d[1] = tv[i].y; d[2] = tv[i].z; d[3] = tv[i].w; }
    asm volatile("s_waitcnt lgkmcnt(0)" ::: "memory");
    bf16_t* dst = (bf16_t*)(ws + WS_H) + (size_t)(rb * 64) * D + 512 + cb * 64;
#pragma unroll 4
    for (int i = 0; i < 8; ++i) { const int r = 8 * i + (lane >> 3), c8 = (lane & 7) * 8;
        unsigned short e[8];
#pragma unroll
        for (int x = 0; x < 8; ++x) e[x] = T[(c8 + x) * 66 + r];
        u32x4 o; o.x = e[0] | ((unsigned)e[1] << 16); o.y = e[2] | ((unsigned)e[3] << 16); o.z = e[4] | ((unsigned)e[5] << 16); o.w = e[6] | ((unsigned)e[7] << 16);
        *(u32x4*)(dst + (size_t)r * D + c8) = o; }
    asm volatile("s_waitcnt lgkmcnt(0)" ::: "memory");
}
#ifndef MK_EN
#define MK_EN 0xffff
#endif
#define EN(x) ((MK_EN >> (x)) & 1)
constexpr int PH_PREP = 0, PH_PER_LAYER = 7, PH_FNORM = 1 + 2 * PH_PER_LAYER, N_PHASES = PH_FNORM + 1;

__global__ void __launch_bounds__(NT, 2) fwd_kernel(Args ka) {
    extern __shared__ __attribute__((aligned(16))) unsigned char lds_raw[];
    LAS unsigned char* lds = (LAS unsigned char*)lds_raw;
    const int G = gridDim.x;
    volatile LAS unsigned* bst = (volatile LAS unsigned*)(lds + LDS_CTL_OFF);
    if (threadIdx.x < 16) bst[threadIdx.x] = 0u;
    if (threadIdx.x == 0) { LAS unsigned long long* tab = (LAS unsigned long long*)(lds + LDS_PTR_OFF);
#pragma unroll
        for (int i = 0; i < N_IN; ++i) tab[i] = (unsigned long long)ka.in[i]; }
    __syncthreads();

    XcdBarrier gbar; gbar.bar = (unsigned*)(ka.ws + WS_CTL); gbar.x = 0; gbar.st = bst;
    if (ka.ph_hi - ka.ph_lo > 1) gbar = xcd_barrier_post((unsigned*)(ka.ws + WS_CTL), bst);

#ifdef REP_SUB
    int repmask = 0;
#endif
    for (int ph = ka.ph_lo; ph < ka.ph_hi; ++ph) {
        int tid = threadIdx.x; asm volatile("" : "+v"(tid));
        int bid = blockIdx.x; asm volatile("" : "+s"(bid));
#define LANE_WAVE() int tid2_ = threadIdx.x; asm volatile("" : "+v"(tid2_)); const int lane = tid2_ & 63, wave = __builtin_amdgcn_readfirstlane(tid2_ >> 6)
        __attribute__((address_space(1))) unsigned char* wsg_ = (__attribute__((address_space(1))) unsigned char*)ka.ws; asm volatile("" : "+s"(wsg_)); unsigned char* ws = (unsigned char*)wsg_;
        __attribute__((address_space(1))) float* outg_ = (__attribute__((address_space(1))) float*)ka.out; asm volatile("" : "+s"(outg_)); float* outp_ = (float*)outg_;
        DArgs a; a.in.t = (const LAS unsigned long long*)(lds + LDS_PTR_OFF); a.out = outp_;
        float* MOD = (float*)(ws + WS_MOD);
        if (EN(0) && ph == PH_PREP) {
            for (int it = bid; it < 1048 + 544 + 8; it += G) {
                int tid = threadIdx.x; asm volatile("" : "+v"(tid));
                __syncthreads();
                if (it < 768) prep_adaln(a.in[I_C], a.in[I_CCTX], a.in[I_ADAW], a.in[I_ADAB], MOD, it, (LAS float*)lds, tid);
                else if (it < 784) prep_s5b(a, ws, it - 768, tid);
                else if (it >= 1048 + 544) { const int j = (it - 1592) * NT + tid; float sn, cs; sincospif(-(float)j * (1.0f / 4096.0f), &sn, &cs); ((f32x2*)(ws + WS_TWID))[j] = (f32x2){cs, sn}; }
                else if (it >= 1048) prep_rope((f32x2*)(ws + WS_ROPE), it - 1048, tid);
                else { const bool big = it < 1040; const int r = big ? it - 784 : it - 1040, l = big ? (r >> 7) : 0, t0 = (big ? (r & 127) : r) * 32;
                    float* H3o = big ? (float*)(ws + WS_H3) + (size_t)l * 4096 * 64 : (float*)(ws + WS_H3C);
                    bf16_t* H3b = big ? (bf16_t*)(ws + WS_H3B) + (size_t)l * 4096 * 64 : (bf16_t*)nullptr;
                    prep_hymlp(a, H3o, H3b, l, big ? 4096 : 256, t0, lds, tid); }
            }
        } else if (EN(1) && ph == PH_FNORM) {
            const float* fw = a.in[I_FNW]; LANE_WAVE();
            for (int row = bid * NWAVES + wave; row < NLAT; row += G * NWAVES) {
                float* xr = a.out + (size_t)row * D; f32x4 v[8]; float ss = 0.f;
#pragma unroll
                for (int j = 0; j < 8; ++j) { v[j] = ((const f32x4*)xr)[lane + 64 * j]; ss += (v[j].x * v[j].x + v[j].y * v[j].y) + (v[j].z * v[j].z + v[j].w * v[j].w); }
                const float rstd = rsqrtf(wave_sum(ss) * (1.0f / D) + EPS);
#pragma unroll
                for (int j = 0; j < 8; ++j) { const f32x4 w = *(const f32x4*)(fw + 4 * (lane + 64 * j)); ((f32x4*)xr)[lane + 64 * j] = v[j] * rstd * w; }
            }
        } else {
            const int l = (ph - 1) / PH_PER_LAYER, sub = (ph - 1) % PH_PER_LAYER;

            const bool ctx_out = (l == 0);
            const int Mrows = ctx_out ? MR : NLAT;
            if (EN(2) && sub == 0) {
                LANE_WAVE();
                LAS float* scr = (LAS float*)(lds + wave * 8704);
                const int gw = bid * NWAVES + wave, NGW = G * NWAVES;
                constexpr int I_W1 = 32 * (NPAD / 32), I_W2 = 32 * 64, I_W3 = 8 * 16;
                for (int it = (l == 0 ? gw : gw + I_W1); it < I_W1 + I_W2 + I_W3; it += NGW) {
                    int r = it;
                    if (r < I_W1) { const int kb = r / (NPAD / 32), nb = r % (NPAD / 32); transpose_item(a.in[I_WIN] + (size_t)l * D * INW, INW, win_srccol(nb * 32 + (lane & 31)), kb * 64, (bf16_t*)(ws + WS_WIN), D, nb * 32, scr, lane); continue; }
                    r -= I_W1;
                    if (r < I_W2) { const int kb = r / 64, nb = r % 64; transpose_item(a.in[I_WOUT] + (size_t)l * D * D, D, nb * 32 + (lane & 31), kb * 64, (bf16_t*)(ws + WS_WOUT), D, nb * 32, scr, lane); continue; }
                    r -= I_W2;
                    { const int kb = r / 16, nb = r % 16; transpose_item(a.in[I_GLUW] + (size_t)l * 512 * 512, 512, nb * 32 + (lane & 31), kb * 64, (bf16_t*)(ws + WS_GLUW), 512, nb * 32, scr, lane); }
                }
                const float* nw = a.in[I_NORMW] + (size_t)l * D;
                for (int row = gw; row < MR; row += NGW) {
                    const float* xr; int v;
                    if (row < NLAT) { xr = (l == 0 ? a.in[I_X] : a.out) + (size_t)row * D; v = row >> 12; }
                    else { xr = (l == 0 ? a.in[I_CTX] : (const float*)(ws + WS_XC1)) + (size_t)(row - NLAT) * D; v = 4; }
                    norm_row(xr, nw, MOD + (size_t)(l * 5 + v) * ADA, (bf16_t*)(ws + WS_H) + (size_t)row * D, lane);
                }
                __syncthreads();
                const int nfilt = ctx_out ? 1024 : 0;
                for (int it = bid; it < nfilt; it += G) { int tid = threadIdx.x; asm volatile("" : "+v"(tid)); __syncthreads(); if (it < 512) filt_item2(a, ws, lds, l, it, tid); else filt_ctx_item(a, ws, lds, it - 512, tid);
#if defined(REP_ITEM) && REP_ITEM == 10
                    __syncthreads(); if (it < 512) filt_item2(a, ws, lds, l, it, tid);
#endif
                }
            } else if (EN(3) && sub == 1) {
                pg8::Gemm g{(const bf16_t*)(ws + WS_H), (const bf16_t*)(ws + WS_WIN), MR, NPAD, D}; pg8::StaticOrder S; S.init(MR, NPAD, G, bid);
                EpiInProj E{(bf16_t*)(ws + WS_P), (bf16_t*)(ws + WS_PT), (float*)(ws + WS_LR), (const float*)(ws + WS_ROPE)};
                { pg8::InProjOrder S1; S1.init(ctx_out ? 0 : 1, G, bid); pg8::gemm_phase<EpiInProj, pg8::InProjOrder, true, true>(lds, g, S1, E, tid); }
            } else if (EN(5) && sub == 2) {
                const int nit = ctx_out ? 3744 : 3232;
                for (int it = bid; it < nit; it += G) {
                    int tid = threadIdx.x; asm volatile("" : "+v"(tid));
                    __syncthreads();
#ifdef REP_ITEM
                    for (int rep_ = 0; rep_ < 2; ++rep_) { const int ty_ = it < 1088 ? 0 : it < 1632 ? 1 : it < 2720 ? 2 : it < 3232 ? 3 : 4; if (rep_ && ty_ != REP_ITEM) break; if (rep_) __syncthreads(); asm volatile("" : "+v"(tid));
#endif
                    if (it < 1088) s5_item<false>(a, ws, lds, l, it >> 1, it & 1, tid);
                    else if (it < 1632) ret_passA(ws, lds, it - 1088, tid);
                    else if (it < 2720) gla_passA(a, ws, lds, l, it - 1632, tid);
                    else if (it < 3232) hyena_item2(a, ws, lds, l, it - 2720, tid);
                    else hyena_ctx_item(a, ws, lds, it - 3232, tid);
#ifdef REP_ITEM
                    }
#endif
                }
            } else if (EN(9) && sub == 3) {
                for (int it = bid; it < 256; it += G) { int tid = threadIdx.x; asm volatile("" : "+v"(tid)); __syncthreads(); hy_transpose_item(ws, lds, it, tid, NLAT); }
                for (int it = bid; it < 224; it += G) { int tid = threadIdx.x; asm volatile("" : "+v"(tid)); __syncthreads();
                    if (it < 128) ret_passB(ws, it * NT + tid);
                    else if (it < 192) gla_passB(ws, lds, it - 128, tid);
                    else s5_passB(ws, l, (it - 192) * NT + tid); }
            } else if (EN(6) && sub == 4) {
                const int nsc = ctx_out ? 1088 : 1024, nrc = ctx_out ? 16 * RNCH : 16 * 32, ngc = ctx_out ? 16 * GNCH : 16 * 64;
                for (int it = bid; it < nsc; it += G) { int tid = threadIdx.x; asm volatile("" : "+v"(tid)); __syncthreads();
                    const int i2 = it >> 1; const int item = ctx_out ? i2 : (i2 >> 7) * (SNCH * 2) + 8 + (i2 & 127); s5_item<true>(a, ws, lds, l, item, it & 1, tid); }
                for (int it = (bid + 64) % G; it < nrc; it += G) { int tid = threadIdx.x; asm volatile("" : "+v"(tid)); __syncthreads();
                    const int item = ctx_out ? it : (it >> 5) * RNCH + 2 + (it & 31); ret_passC(a, ws, lds, l, item, tid); }
                for (int it = (bid + 128) % G; it < ngc; it += G) { int tid = threadIdx.x; asm volatile("" : "+v"(tid)); __syncthreads();
                    const int item = ctx_out ? it : (it >> 6) * GNCH + 4 + (it & 63); gla_passC(a, ws, lds, l, item, tid); }
            } else if (EN(7) && sub == 5) {
                pg8::Gemm g{(const bf16_t*)(ws + WS_KF), (const bf16_t*)(ws + WS_GLUW), Mrows, 512, 512}; pg8::StaticOrder S; S.init(Mrows, 512, G, bid);
                EpiGlu E{(const bf16_t*)(ws + WS_KF) + OBSZ, (bf16_t*)(ws + WS_H), a.in[I_GLUB] + (size_t)l * 512};
                pg8::gemm_phase<EpiGlu, pg8::StaticOrder, true, true>(lds, g, S, E, tid);
                if (l == 0 && bid >= 136) {
                    LANE_WAVE(); LAS float* scr = (LAS float*)(lds + wave * 8704);
                    for (int r = (bid - 136) * NWAVES + wave; r < 32 * (NPAD / 32); r += (G - 136) * NWAVES) { const int kb = r / (NPAD / 32), nb = r % (NPAD / 32);
                        transpose_item(a.in[I_WIN] + (size_t)1 * D * INW, INW, win_srccol(nb * 32 + (lane & 31)), kb * 64, (bf16_t*)(ws + WS_WIN), D, nb * 32, scr, lane); }
                }
            } else if (EN(8)) {
                pg8::Gemm g{(const bf16_t*)(ws + WS_H), (const bf16_t*)(ws + WS_WOUT), Mrows, D, D}; pg8::StaticOrder S; S.init(Mrows, D, G, bid);
                EpiOut E{l == 0 ? a.in[I_X] : a.out, a.in[I_CTX], a.out, (float*)(ws + WS_XC1), MOD + (size_t)l * 5 * ADA};
                pg8::gemm_phase<EpiOut, pg8::StaticOrder, true, true>(lds, g, S, E, tid);
                if (l == 0 && bid >= 32) {
                    for (int it = bid - 32; it < 512; it += G - 32) { int tid2 = threadIdx.x; asm volatile("" : "+v"(tid2)); __syncthreads(); filt_item2(a, ws, lds, 1, it, tid2); }
                }
            }
        }
#ifdef REP_SUB
        if (ph != PH_PREP && ph != PH_FNORM && ((ph - 1) % PH_PER_LAYER) == REP_SUB && !((repmask >> ((ph - 1) / PH_PER_LAYER)) & 1)) { repmask |= 1 << ((ph - 1) / PH_PER_LAYER); xcd_barrier(gbar); --ph; continue; }
#endif
        if (ph + 1 < ka.ph_hi) xcd_barrier(gbar);
    }
}

#ifndef MK_LAUNCH_PER_PHASE
#define MK_LAUNCH_PER_PHASE 0
#endif
extern "C" void kernel_launch(void* const* d_in, const int* in_sizes, int n_in, void* d_out, int out_size, void* d_ws, size_t ws_size, hipStream_t stream) {
    static int grid = 0;
    if (grid == 0) {
        if (n_in != N_IN || out_size != NLAT * D || ws_size < WS_END2) { fprintf(stderr, "kernel_launch: unexpected shapes (n_in %d, out %d, ws %zu < %zu); nothing launched\n", n_in, out_size, ws_size, (size_t)WS_END2); grid = -1; return; }
        int dev = 0, cus = 0, per_cu = 0;
        if (hipGetDevice(&dev) != hipSuccess || hipDeviceGetAttribute(&cus, hipDeviceAttributeMultiprocessorCount, dev) != hipSuccess) { grid = -1; return; }
        if (hipFuncSetAttribute((const void*)fwd_kernel, hipFuncAttributeMaxDynamicSharedMemorySize, LDS_BYTES) != hipSuccess) { fprintf(stderr, "kernel_launch: hipFuncSetAttribute failed\n"); grid = -1; return; }
        if (hipOccupancyMaxActiveBlocksPerMultiprocessor(&per_cu, (const void*)fwd_kernel, NT, LDS_BYTES) != hipSuccess || per_cu < 1) { fprintf(stderr, "kernel_launch: occupancy query says %d blocks per CU\n", per_cu); per_cu = 1; }
        (void)hipGetLastError();
        grid = cus;
    }
    if (grid < 0) return;
    (void)hipMemsetAsync((char*)d_ws + WS_CTL, 0, WS_ZERO_BYTES, stream);
    Args a{};
    for (int i = 0; i < N_IN; ++i) a.in[i] = (const float*)d_in[i];
    a.out = (float*)d_out; a.ws = (unsigned char*)d_ws;
#if MK_LAUNCH_PER_PHASE
    for (int ph = 0; ph < N_PHASES; ++ph) {
        a.ph_lo = ph; a.ph_hi = ph + 1;
        hipLaunchKernelGGL(fwd_kernel, dim3(grid), dim3(NT), LDS_BYTES, stream, a);
    }
#else
    a.ph_lo = 0; a.ph_hi = N_PHASES;
    void* args[] = {&a};
    hipError_t e = hipLaunchCooperativeKernel((const void*)fwd_kernel, dim3(grid), dim3(NT), args, LDS_BYTES, stream);
    if (e != hipSuccess) fprintf(stderr, "kernel_launch: cooperative launch failed: %s (grid %d)\n", hipGetErrorString(e), grid);
#endif
}
```

```cpp
#include <hip/hip_runtime.h>
#include <hip/hip_cooperative_groups.h>
#include <cstdio>
#include <cstdint>
namespace cg = cooperative_groups;

#define LAS __attribute__((address_space(3)))
typedef unsigned short bf16_t;
typedef float f32x4 __attribute__((ext_vector_type(4)));
typedef float f32x2 __attribute__((ext_vector_type(2)));
typedef unsigned u32x4 __attribute__((ext_vector_type(4)));
typedef unsigned u32x2 __attribute__((ext_vector_type(2)));

constexpr int D = 2048, NB = 4, SEQL = 4096, LC = 256, NLAT = NB * SEQL, NCTX = NB * LC, MR = NLAT + NCTX;
constexpr int BR = 512, INW = 6688, NPAD = 6912, LDP = 4608, ADA = 3 * D;
constexpr int NT = 512, NWAVES = 8;
constexpr float EPS = 1e-6f;
constexpr int PC_S5U = 0, PC_S5G = 512, PC_RQ = 1024, PC_RK = 1536, PC_RV = 2048, PC_RG = 2560, PC_GQ = 3072, PC_GK = 3328, PC_GV = 3584, PC_GG = 4096;
constexpr int PT_V = 0, PT_G1 = 512, PT_G2 = 1024, PT_HG = 1536;
constexpr int FFTN = 8192;

enum { I_X = 0, I_C, I_CTX, I_CCTX, I_NORMW, I_ADAW, I_ADAB, I_WIN, I_WOUT, I_S5ARE, I_S5AIM, I_S5LDT, I_S5BRE, I_S5BIM, I_S5CRE, I_S5CIM,
       I_S5D, I_GLUW, I_GLUB, I_HCW, I_HCB, I_HW1, I_HB1, I_HF1, I_HW2, I_HB2, I_HF2, I_HW3, I_HB3, I_HF3, I_HW4, I_HBIAS, I_RNW, I_GGW, I_GGB, I_GNW, I_FNW, N_IN };

constexpr size_t al256(size_t x) { return (x + 255) & ~(size_t)255; }
constexpr size_t WS_CTL  = 0;
constexpr size_t WS_MOD  = WS_CTL + 65536;
constexpr size_t WS_ZERO_BYTES = 65536 + al256((size_t)2 * 5 * ADA * 4);
constexpr size_t WS_S5AB = WS_MOD + al256((size_t)2 * 5 * ADA * 4);
constexpr size_t WS_S5BT = WS_S5AB + (size_t)2 * 2 * 32 * 64 * 8;
constexpr size_t WS_H3   = WS_S5BT + (size_t)1048576 + 65536;
constexpr size_t WS_H3C  = WS_H3 + (size_t)2 * 4096 * 64 * 4;
constexpr size_t WS_KC   = WS_H3C + (size_t)256 * 64 * 4;
constexpr size_t WS_LR   = WS_KC + (size_t)2 * 512 * 512 * 4;
constexpr size_t WS_XC1  = WS_LR + (size_t)MR * 32 * 4;
constexpr size_t WS_WOUT = WS_XC1 + (size_t)NCTX * D * 4;
constexpr size_t WS_GLUW = WS_WOUT + (size_t)D * D * 2;
constexpr size_t WS_WIN  = WS_GLUW + (size_t)512 * 512 * 2;
constexpr size_t WS_H    = WS_WIN + (size_t)NPAD * D * 2;
constexpr size_t WS_P    = WS_H + (size_t)MR * D * 2;
constexpr size_t WS_PT   = WS_P + (size_t)MR * LDP * 2;
constexpr size_t WS_KF   = WS_PT + (size_t)2048 * MR * 2;
constexpr size_t WS_OB   = WS_KF + (size_t)2 * 512 * FFTN * 8;
constexpr size_t WS_END  = WS_OB + (size_t)6 * MR * 512 * 2;
constexpr size_t OBSZ = (size_t)MR * 512;

constexpr int LDS_CTL_OFF = 135168 + 1024;
constexpr int LDS_PTR_OFF = LDS_CTL_OFF + 64;
constexpr int LDS_BYTES = LDS_PTR_OFF + 320;

typedef __bf16 hwbf16x2 __attribute__((ext_vector_type(2)));
__device__ __forceinline__ unsigned pk2(float lo, float hi) { const f32x2 v = {lo, hi}; return __builtin_bit_cast(unsigned, __builtin_convertvector(v, hwbf16x2)); }
__device__ __forceinline__ unsigned f2bf(float f) { return pk2(f, 0.f) & 0xffffu; }
__device__ __forceinline__ float bf2f(bf16_t b) { return __uint_as_float((unsigned)b << 16); }
__device__ __forceinline__ float bflo(unsigned w) { return __uint_as_float(w << 16); }
__device__ __forceinline__ float bfhi(unsigned w) { return __uint_as_float(w & 0xffff0000u); }
__device__ __forceinline__ void unpack8(const u32x4 r, float (&f)[8]) { f[0] = bflo(r.x); f[1] = bfhi(r.x); f[2] = bflo(r.y); f[3] = bfhi(r.y); f[4] = bflo(r.z); f[5] = bfhi(r.z); f[6] = bflo(r.w); f[7] = bfhi(r.w); }
__device__ __forceinline__ u32x4 pack8(const float (&f)[8]) { u32x4 o; o.x = pk2(f[0], f[1]); o.y = pk2(f[2], f[3]); o.z = pk2(f[4], f[5]); o.w = pk2(f[6], f[7]); return o; }
__device__ __forceinline__ float sigmoidf_(float x) { return __builtin_amdgcn_rcpf(1.0f + __expf(-x)); }
__device__ __forceinline__ float siluf_(float x) { return x * sigmoidf_(x); }
__device__ __forceinline__ float gelu_tanh(float x) { const float u2 = 1.5957691216057308f * (x + 0.044715f * x * x * x); return x * sigmoidf_(u2); }
__device__ __forceinline__ float wave_sum(float v) {
#pragma unroll
    for (int o = 1; o < 64; o <<= 1) v += __shfl_xor(v, o);
    return v;
}
#define LDS_WAIT() asm volatile("s_waitcnt lgkmcnt(0)" ::: "memory")

struct Args { const float* in[N_IN]; float* out; unsigned char* ws; int ph_lo, ph_hi; };
struct InTab { const LAS unsigned long long* t;
    __device__ __forceinline__ const float* operator[](int i) const { const unsigned long long v = t[i];
        const unsigned lo = __builtin_amdgcn_readfirstlane((unsigned)v), hi = __builtin_amdgcn_readfirstlane((unsigned)(v >> 32)); return (const float*)(__attribute__((address_space(1))) const float*)(((unsigned long long)hi << 32) | lo); } };
struct DArgs { InTab in; float* out; };

#define XB_TMO      128
#define XB_XCNT(j)  (256  + 64 * (j))
#define XB_XSUB(j)  (1280 + 64 * (j))
#define XB_XGEN(j)  (2304 + 64 * (j))
#define XB_TOP      3328
#define XB_TOPGEN   3392
#define XCD_BAR_WORDS 3456
#define XB_SPIN_CAP (1u << 22)
__device__ __forceinline__ unsigned xb_ld(unsigned* p)              { return __hip_atomic_load(p, __ATOMIC_RELAXED, __HIP_MEMORY_SCOPE_AGENT); }
__device__ __forceinline__ unsigned xb_add(unsigned* p, unsigned v) { return __hip_atomic_fetch_add(p, v, __ATOMIC_RELAXED, __HIP_MEMORY_SCOPE_AGENT); }
__device__ __forceinline__ unsigned xb_xcc_id() { return (unsigned)__builtin_amdgcn_s_getreg((3 << 11) | 20) & 0xFu; }
#define XB_SPIN(cond, bar) do { unsigned _sp = 0; while (cond) { __builtin_amdgcn_s_sleep(1); \
    if ((++_sp & 255u) == 0u) { if (xb_ld(&(bar)[XB_TMO])) break; if (_sp > XB_SPIN_CAP) { atomicAdd(&(bar)[XB_TMO], 1u); break; } } } } while (0)
struct XcdBarrier { unsigned* bar; unsigned x; volatile LAS unsigned* st; };
__device__ __forceinline__ XcdBarrier xcd_barrier_post(unsigned* bar, volatile LAS unsigned* st) {
    XcdBarrier b; b.bar = bar; b.x = xb_xcc_id(); b.st = st;
    if (threadIdx.x == 0) (void)xb_add(&bar[XB_XCNT(b.x)], 1u);
    return b;
}
__device__ __forceinline__ void xcd_barrier_complete(unsigned* bar, unsigned x, unsigned& nloc, unsigned& nx) {
    const unsigned G = gridDim.x * gridDim.y * gridDim.z;
    unsigned sum, cnt, mine, sp = 0u;
    for (;;) {
        sum = 0u; cnt = 0u; mine = 0u;
#pragma unroll
        for (unsigned j = 0; j < 16; ++j) { const unsigned c = xb_ld(&bar[XB_XCNT(j)]); sum += c; cnt += (c > 0u) ? 1u : 0u; mine = (j == x) ? c : mine; }
        if (sum == G) break;
        __builtin_amdgcn_s_sleep(1);
        if ((++sp & 255u) == 0u) { if (xb_ld(&bar[XB_TMO])) break; if (sp > XB_SPIN_CAP) { atomicAdd(&bar[XB_TMO], 1u); break; } }
    }
    nloc = mine > 0u ? mine : 1u; nx = cnt > 0u ? cnt : 1u;
}
__device__ __forceinline__ void xcd_barrier(const XcdBarrier& b) {
    asm volatile("s_waitcnt vmcnt(0)" ::: "memory");
    __syncthreads();
    if (threadIdx.x == 0) {
        unsigned* bar = b.bar;
        __builtin_amdgcn_s_waitcnt(0);
        unsigned nloc = b.st[0], nx = b.st[1];
        if (nloc == 0u) { xcd_barrier_complete(bar, b.x, nloc, nx); b.st[0] = nloc; b.st[1] = nx; }
        const unsigned old = xb_add(&bar[XB_XSUB(b.x)], 1u);
        const unsigned gen = old / nloc;
        if (old + 1u == (gen + 1u) * nloc) {
            __builtin_amdgcn_fence(__ATOMIC_RELEASE, "agent");
            asm volatile("s_waitcnt vmcnt(0)" ::: "memory");
            const unsigned og = xb_add(&bar[XB_TOP], 1u);
            const unsigned tg = og / nx;
            if (og + 1u == (tg + 1u) * nx) xb_add(&bar[XB_TOPGEN], 1u);
            else XB_SPIN(xb_ld(&bar[XB_TOPGEN]) == tg, bar);
            __builtin_amdgcn_fence(__ATOMIC_ACQUIRE, "agent");
            xb_add(&bar[XB_XGEN(b.x)], 1u);
            asm volatile("s_waitcnt vmcnt(0)" ::: "memory");
        } else {
            XB_SPIN(xb_ld(&bar[XB_XGEN(b.x)]) == gen, bar);
            __builtin_amdgcn_fence(__ATOMIC_ACQUIRE, "agent");
            asm volatile("s_waitcnt vmcnt(0)" ::: "memory");
        }
    }
    __syncthreads();
}
namespace pg8 {
#define PG8_LAS __attribute__((address_space(3)))
typedef unsigned short bf16_t;
typedef short bf16x8 __attribute__((ext_vector_type(8)));
typedef float f32x4 __attribute__((ext_vector_type(4)));
typedef unsigned u32x4 __attribute__((ext_vector_type(4)));
constexpr int BM = 256, BK = 64, HALF = 128, HTB = HALF * BK * 2, STAGE_BYTES = 8 * HTB, NXCD = 8, WGM = 8;

__host__ __device__ __forceinline__ int lds_byte(int r, int c) { const int st = (r >> 4) * 2 + (c >> 5), rr = r & 15, cc = c & 31, ob = rr * 64 + cc * 2; return st * 1024 + (ob ^ (((ob >> 9) & 1) << 5)); }
__host__ __device__ __forceinline__ void stage_rc(int b, int& R, int& C) { const int st = b / 1024, sb = b % 1024, swz = sb ^ (((sb >> 9) & 1) << 5); R = (st >> 1) * 16 + swz / 64; C = (st & 1) * 32 + (swz % 64) / 2; }
__host__ __device__ __forceinline__ int perm32(int rho) { const int n = rho >> 4, i = rho & 15; return 8 * (i >> 2) + 4 * n + (i & 3); }

struct Unit { int pm, pn; };
struct Gemm { const bf16_t* A; const bf16_t* Bt; int M, N, K; };

struct StaticOrder {
    int nM, nN, nwg, G, c;
    __host__ __device__ void init(int M, int N, int G_, int c_) { nM = M / BM; nN = N / BM; nwg = nM * nN; G = G_; c = c_; }
    __host__ __device__ bool next(int i, Unit& u) const {
        const long L = (long)i * G + c; if (L >= nwg) return false;
        int wgid = (int)L; { const int q = nwg / NXCD, r = nwg % NXCD, xcd = wgid % NXCD, off = wgid / NXCD; wgid = (xcd < r ? xcd * (q + 1) : r * (q + 1) + (xcd - r) * q) + off; }
        const int nig = WGM * nN, gid = wgid / nig, fm = gid * WGM, gsz = (nM - fm) < WGM ? (nM - fm) : WGM;
        u.pm = fm + ((wgid % nig) % gsz); u.pn = (wgid % nig) / gsz; return true;
    }
    __device__ __forceinline__ void a_ready(const Unit&) const {}
    __device__ __forceinline__ void done(const Unit&) const {}
};


struct InProjOrder {
    StaticOrder base; int G, c, last;
    __host__ __device__ void init(int last_, int G_, int c_) { last = last_; base.init((last_ ? 64 : 68) * 256, 27 * 256, G_, c_); G = G_; c = c_; }
    __host__ __device__ bool next(int i, Unit& u) const {
        const long L = (long)i * G + c;
        if (!last || L < 1728) return base.next(i, u);
        if (L >= 1768) return false;
        const int k = (int)L - 1728, j = k % 10; u.pm = 64 + k / 10;
        u.pn = j == 0 ? 0 : j == 1 ? 1 : j == 2 ? 14 : j == 3 ? 15 : j == 4 ? 16 : j == 5 ? 17 : j == 6 ? 21 : j == 7 ? 22 : j == 8 ? 23 : 26;
        return true;
    }
    __device__ __forceinline__ void a_ready(const Unit&) const {}
    __device__ __forceinline__ void done(const Unit&) const {}
};
template <class Epi, class Sched, bool ALIGN_EPI = false, bool SP2 = false>
__device__ __forceinline__ void gemm_phase(PG8_LAS unsigned char* lds, const Gemm g, const Sched& S, const Epi& E, const int tid) {
    const int wid = __builtin_amdgcn_readfirstlane(tid >> 6), lane = tid & 63, wr = wid >> 2, wc = wid & 3, fr = lane & 15, fq = lane >> 4;
    const int K = g.K, nt = K / BK;
    unsigned voffA[2], voffB[2];
#pragma unroll
    for (int i = 0; i < 2; ++i) { int R, C; stage_rc(tid * 16 + i * 8192, R, C); const int Rb = Epi::PERM ? ((R & ~31) + perm32(R & 31)) : R;
        voffA[i] = (unsigned)(R * K + C) * 2u; voffB[i] = (unsigned)(Rb * K + C) * 2u; }
    const size_t kstep = (size_t)(BK * 2);
    const size_t hstep = (size_t)HALF * K * 2;
    const size_t tstep = 2 * hstep;
    const unsigned ldsw = (unsigned)wid * 1024u;
    const int aoff = lds_byte(wr * 64 + fr, fq * 8), boff = lds_byte(wc * 32 + fr, fq * 8);
#define PG8_SA(b, h) (((b) * 2 + (h)) * HTB)
#define PG8_SB(b, h) ((4 + (b) * 2 + (h)) * HTB)
#define PG8_STAGE(bufoff, gbase, voff) do { _Pragma("unroll") for (int _i = 0; _i < 2; ++_i) \
        __builtin_amdgcn_global_load_lds((const unsigned*)((const char*)(gbase) + (voff)[_i]), (PG8_LAS unsigned*)(lds + (bufoff) + ldsw + _i * 8192), 16, 0, 0); } while (0)
#define PG8_LDA(dst, b, h) do { _Pragma("unroll") for (int m = 0; m < 4; ++m) _Pragma("unroll") for (int k = 0; k < 2; ++k) dst[m][k] = *(const PG8_LAS bf16x8*)(lds + PG8_SA(b, h) + aoff + m * 2048 + k * 1024); } while (0)
#define PG8_LDB(dst, b, h) do { _Pragma("unroll") for (int n = 0; n < 2; ++n) _Pragma("unroll") for (int k = 0; k < 2; ++k) dst[n][k] = *(const PG8_LAS bf16x8*)(lds + PG8_SB(b, h) + boff + n * 2048 + k * 1024); } while (0)
#define PG8_MMA(ai, bj, At, Bt) do { __builtin_amdgcn_s_setprio(1); _Pragma("unroll") for (int m = 0; m < 4; ++m) _Pragma("unroll") for (int n = 0; n < 2; ++n) _Pragma("unroll") for (int k = 0; k < 2; ++k) \
        acc[ai][bj][m][n] = __builtin_amdgcn_mfma_f32_16x16x32_bf16(Bt[n][k], At[m][k], acc[ai][bj][m][n], 0, 0, 0); __builtin_amdgcn_s_setprio(0); } while (0)
#define PG8_WAIT_V(n) asm volatile("s_waitcnt vmcnt(" #n ")" ::: "memory")
#define PG8_WAIT_L(n) asm volatile("s_waitcnt lgkmcnt(" #n ")" ::: "memory")
#define PG8_BAR __builtin_amdgcn_s_barrier()
#define PG8_SCHED __builtin_amdgcn_sched_barrier(0)
    Unit cur, nxt; int ui = 0;
    if (!S.next(0, cur)) return;
    f32x4 acc[2][2][4][2];
#pragma unroll
    for (int a = 0; a < 2; ++a)
#pragma unroll
        for (int b = 0; b < 2; ++b)
#pragma unroll
            for (int m = 0; m < 4; ++m)
#pragma unroll
                for (int n = 0; n < 2; ++n) acc[a][b][m][n] = (f32x4){0.f, 0.f, 0.f, 0.f};
    bf16x8 At[4][2], B0[2][2], B1[2][2];
    const char* cA = (const char*)g.A + (size_t)cur.pm * tstep; const char* cB = (const char*)g.Bt + (size_t)cur.pn * tstep;
    S.a_ready(cur);
    if constexpr (SP2) {
        PG8_STAGE(PG8_SB(0, 0), cB, voffB); PG8_STAGE(PG8_SB(0, 1), cB + hstep, voffB); PG8_STAGE(PG8_SA(0, 0), cA, voffA); PG8_STAGE(PG8_SA(0, 1), cA + hstep, voffA);
        if (wr == 1) PG8_BAR;
        PG8_WAIT_V(2); PG8_BAR;
        PG8_STAGE(PG8_SB(1, 0), cB + kstep, voffB); PG8_STAGE(PG8_SA(1, 0), cA + kstep, voffA); PG8_STAGE(PG8_SB(1, 1), cB + hstep + kstep, voffB);
        PG8_WAIT_V(6); PG8_BAR;
    } else {
        PG8_STAGE(PG8_SB(0, 0), cB, voffB); PG8_STAGE(PG8_SA(0, 0), cA, voffA); PG8_STAGE(PG8_SB(0, 1), cB + hstep, voffB); PG8_STAGE(PG8_SA(0, 1), cA + hstep, voffA);
        if (wr == 1) PG8_BAR;
        PG8_WAIT_V(4); PG8_BAR;
        PG8_STAGE(PG8_SB(1, 0), cB + kstep, voffB); PG8_STAGE(PG8_SA(1, 0), cA + kstep, voffA); PG8_STAGE(PG8_SB(1, 1), cB + hstep + kstep, voffB);
        PG8_WAIT_V(6); PG8_BAR;
    }
    for (;;) {
        const bool has_next = S.next(ui + 1, nxt);
        const char* nA = has_next ? (const char*)g.A + (size_t)nxt.pm * tstep : cA; const char* nB = has_next ? (const char*)g.Bt + (size_t)nxt.pn * tstep : cB;
        for (int t = 0; t < nt; t += 2) {
            const bool last = (t == nt - 2);
            const char* a1 = cA + (size_t)(t + 1) * kstep;
            const char* a2 = last ? nA : cA + (size_t)(t + 2) * kstep; const char* b2 = last ? nB : cB + (size_t)(t + 2) * kstep;
            const char* a3 = a2 + kstep; const char* b3 = b2 + kstep;
            if (last && has_next) S.a_ready(nxt);
            if constexpr (SP2) {
            PG8_LDB(B0, 0, 0); PG8_LDB(B1, 0, 1); PG8_SCHED; PG8_LDA(At, 0, 0); PG8_STAGE(PG8_SA(1, 1), a1 + hstep, voffA);
            PG8_WAIT_V(8); PG8_WAIT_L(0); PG8_BAR; PG8_MMA(0, 0, At, B0); PG8_MMA(0, 1, At, B1); PG8_BAR; PG8_SCHED;
            PG8_LDA(At, 0, 1); PG8_STAGE(PG8_SB(0, 0), b2, voffB); PG8_STAGE(PG8_SB(0, 1), b2 + hstep, voffB); PG8_STAGE(PG8_SA(0, 0), a2, voffA);
            PG8_WAIT_V(8); PG8_WAIT_L(0); PG8_BAR; PG8_MMA(1, 0, At, B0); PG8_MMA(1, 1, At, B1); PG8_BAR; PG8_SCHED;
            PG8_LDB(B0, 1, 0); PG8_LDB(B1, 1, 1); PG8_SCHED; PG8_LDA(At, 1, 0); PG8_STAGE(PG8_SA(0, 1), a2 + hstep, voffA);
            PG8_WAIT_V(8); PG8_WAIT_L(0); PG8_BAR; PG8_MMA(0, 0, At, B0); PG8_MMA(0, 1, At, B1); PG8_BAR; PG8_SCHED;
            PG8_LDA(At, 1, 1); PG8_STAGE(PG8_SB(1, 0), b3, voffB); PG8_STAGE(PG8_SB(1, 1), b3 + hstep, voffB); PG8_STAGE(PG8_SA(1, 0), a3, voffA);
            PG8_WAIT_V(8); PG8_WAIT_L(0); PG8_BAR; PG8_MMA(1, 0, At, B0); PG8_MMA(1, 1, At, B1); PG8_BAR; PG8_SCHED;
            } else {
            PG8_LDB(B0, 0, 0); PG8_SCHED; PG8_LDA(At, 0, 0); PG8_STAGE(PG8_SA(1, 1), a1 + hstep, voffA);
            PG8_WAIT_L(8); PG8_BAR; PG8_WAIT_L(0); PG8_MMA(0, 0, At, B0); PG8_BAR; PG8_SCHED;
            PG8_LDB(B1, 0, 1); PG8_STAGE(PG8_SB(0, 0), b2, voffB);
            PG8_BAR; PG8_WAIT_L(0); PG8_MMA(0, 1, At, B1); PG8_BAR;
            PG8_LDA(At, 0, 1); PG8_STAGE(PG8_SA(0, 0), a2, voffA);
            PG8_BAR; PG8_WAIT_L(0); PG8_MMA(1, 0, At, B0); PG8_BAR; PG8_SCHED;
            PG8_STAGE(PG8_SB(0, 1), b2 + hstep, voffB);
            PG8_WAIT_V(6); PG8_BAR; PG8_MMA(1, 1, At, B1); PG8_BAR;
            PG8_LDB(B0, 1, 0); PG8_SCHED; PG8_LDA(At, 1, 0); PG8_STAGE(PG8_SA(0, 1), a2 + hstep, voffA);
            PG8_WAIT_L(8); PG8_BAR; PG8_WAIT_L(0); PG8_MMA(0, 0, At, B0); PG8_BAR; PG8_SCHED;
            PG8_LDB(B1, 1, 1); PG8_STAGE(PG8_SB(1, 0), b3, voffB);
            PG8_BAR; PG8_WAIT_L(0); PG8_MMA(0, 1, At, B1); PG8_BAR;
            PG8_LDA(At, 1, 1); PG8_STAGE(PG8_SA(1, 0), a3, voffA);
            PG8_BAR; PG8_WAIT_L(0); PG8_MMA(1, 0, At, B0); PG8_BAR; PG8_SCHED;
            PG8_STAGE(PG8_SB(1, 1), b3 + hstep, voffB);
            PG8_WAIT_V(6); PG8_BAR; PG8_MMA(1, 1, At, B1); PG8_BAR;
            }
        }
        if constexpr (ALIGN_EPI) { if (wr == 0) PG8_BAR; }
        { int fr_ = fr, fq_ = fq; asm volatile("" : "+v"(fr_), "+v"(fq_));
          E(acc, cur, wr, wc, fr_, fq_); } S.done(cur);
        if (!has_next) break;
#pragma unroll
        for (int a = 0; a < 2; ++a)
#pragma unroll
            for (int b = 0; b < 2; ++b)
#pragma unroll
                for (int m = 0; m < 4; ++m)
#pragma unroll
                    for (int n = 0; n < 2; ++n) acc[a][b][m][n] = (f32x4){0.f, 0.f, 0.f, 0.f};
        cur = nxt; cA = nA; cB = nB; ++ui;
        if constexpr (ALIGN_EPI) { if (wr == 1) PG8_BAR; }
    }
    PG8_WAIT_V(0);
    if constexpr (!ALIGN_EPI) { if (wr == 0) PG8_BAR; }
    PG8_BAR;
#undef PG8_SA
#undef PG8_SB
#undef PG8_STAGE
#undef PG8_LDA
#undef PG8_LDB
#undef PG8_MMA
#undef PG8_WAIT_V
#undef PG8_WAIT_L
#undef PG8_BAR
#undef PG8_SCHED
}
}
__device__ __forceinline__ void prep_adaln(const float* c, const float* cctx, const float* adaw, const float* adab, float* MOD, int it, LAS float* sv, int tid) {
    const int l = it / 384, r = it % 384, ntile = r >> 5, ks = r & 31, k0 = ks * 64;
    if (tid < 320) { const int v = tid >> 6, k = tid & 63; const float cv = v < 4 ? c[v * D + k0 + k] : cctx[k0 + k]; sv[tid] = cv / (1.0f + expf(-cv)); }
    __syncthreads();
    const int n = ntile * 512 + tid; const float* w = adaw + (size_t)l * D * ADA + (size_t)k0 * ADA + n;
    float acc[5] = {0.f, 0.f, 0.f, 0.f, 0.f};
#pragma unroll 1
    for (int k0_ = 0; k0_ < 64; k0_ += 32) {
        float wv[32];
#pragma unroll
        for (int k = 0; k < 32; ++k) wv[k] = w[(size_t)(k0_ + k) * ADA];
#pragma unroll
        for (int k = 0; k < 32; ++k) {
#pragma unroll
            for (int v = 0; v < 5; ++v) acc[v] += sv[v * 64 + k0_ + k] * wv[k]; } }
    if (ks == 0) { const float bb = adab[l * ADA + n];
#pragma unroll
        for (int v = 0; v < 5; ++v) acc[v] += bb; }
#pragma unroll
    for (int v = 0; v < 5; ++v) atomicAdd(MOD + (size_t)(l * 5 + v) * ADA + n, acc[v]);
    __syncthreads();
}

__device__ __forceinline__ void prep_hymlp(const DArgs& a, float* H3out, bf16_t* H3b, int l, int Lx, int t0, LAS unsigned char* lds, int tid) {
    LAS float* zs = (LAS float*)lds;
    LAS float* h1 = (LAS float*)(lds + 4608);
    LAS float* h2 = (LAS float*)(lds + 4608 + 8192);
    LAS float* w1s = (LAS float*)(lds + 24576);
    LAS float* w2s = w1s + 33 * 64;
    LAS float* w3s = w2s + 64 * 64;
    { const float* w1 = a.in[I_HW1] + (size_t)l * 33 * 64; const float* w2 = a.in[I_HW2] + (size_t)l * 64 * 64; const float* w3 = a.in[I_HW3] + (size_t)l * 64 * 64;
      for (int i = tid; i < 33 * 64; i += NT) w1s[i] = w1[i];
      for (int i = tid; i < 64 * 64; i += NT) { w2s[i] = w2[i]; w3s[i] = w3[i]; } }
    for (int i = tid; i < 32 * 33; i += NT) { const int pos = i / 33, f = i % 33, t = t0 + pos;
        float z;
        if (f == 0) z = (float)t / (float)(Lx - 1);
        else { const int j = (f - 1) & 15; const float fj = 1e-4f + (float)j * ((15.0f - 1e-4f) / 15.0f); const float wpos = (6.283185307179586f * (float)t) / (float)Lx; const float arg = fj * wpos;
               z = (f <= 16) ? cosf(arg) : -sinf(arg); }
        zs[pos * 36 + f] = z; }
    __syncthreads();
    const int pos = tid >> 4, f4 = (tid & 15) * 4, t = t0 + pos;
    f32x4 s = *(const f32x4*)(a.in[I_HB1] + l * 64 + f4);
#pragma unroll 3
    for (int j = 0; j < 33; ++j) s += zs[pos * 36 + j] * *(const LAS f32x4*)(w1s + j * 64 + f4);
    { const f32x4 fr = *(const f32x4*)(a.in[I_HF1] + l * 64 + f4); *(LAS f32x4*)(h1 + pos * 64 + f4) = (f32x4){sinf(fr.x * s.x), sinf(fr.y * s.y), sinf(fr.z * s.z), sinf(fr.w * s.w)}; }
    __syncthreads();
    s = *(const f32x4*)(a.in[I_HB2] + l * 64 + f4);
#pragma unroll 4
    for (int j = 0; j < 64; ++j) s += h1[pos * 64 + j] * *(const LAS f32x4*)(w2s + j * 64 + f4);
    { const f32x4 fr = *(const f32x4*)(a.in[I_HF2] + l * 64 + f4); *(LAS f32x4*)(h2 + pos * 64 + f4) = (f32x4){sinf(fr.x * s.x), sinf(fr.y * s.y), sinf(fr.z * s.z), sinf(fr.w * s.w)}; }
    __syncthreads();
    s = *(const f32x4*)(a.in[I_HB3] + l * 64 + f4);
#pragma unroll 4
    for (int j = 0; j < 64; ++j) s += h2[pos * 64 + j] * *(const LAS f32x4*)(w3s + j * 64 + f4);
    { const f32x4 fr = *(const f32x4*)(a.in[I_HF3] + l * 64 + f4); const f32x4 hv = (f32x4){sinf(fr.x * s.x), sinf(fr.y * s.y), sinf(fr.z * s.z), sinf(fr.w * s.w)}; *(f32x4*)(H3out + (size_t)t * 64 + f4) = hv;
      if (H3b) { u32x2 pk; pk.x = pk2(hv.x, hv.y); pk.y = pk2(hv.z, hv.w); *(u32x2*)(H3b + (size_t)t * 64 + f4) = pk; } }
    __syncthreads();
}

__device__ __forceinline__ void transpose_item(const float* W, int ldw, int srccol_lane  , int k0, bf16_t* WT, int K, int dstrow0, LAS float* scr, int lane) {
    float wv[32];
#pragma unroll
    for (int i = 0; i < 32; ++i) { const int kk = 2 * i + (lane >> 5); wv[i] = srccol_lane >= 0 ? W[(size_t)(k0 + kk) * ldw + srccol_lane] : 0.f; }
#pragma unroll
    for (int i = 0; i < 32; ++i) { const int kk = 2 * i + (lane >> 5); scr[kk * 33 + (lane & 31)] = wv[i]; }
    LDS_WAIT();
    const int c = lane & 7;
#pragma unroll
    for (int j = 0; j < 4; ++j) { const int n = (lane >> 3) + 8 * j; const LAS float* s = scr + (8 * c) * 33 + n;
        u32x4 o; o.x = pk2(s[0 * 33], s[1 * 33]); o.y = pk2(s[2 * 33], s[3 * 33]); o.z = pk2(s[4 * 33], s[5 * 33]); o.w = pk2(s[6 * 33], s[7 * 33]);
        *(u32x4*)(WT + (size_t)(dstrow0 + n) * K + k0 + 8 * c) = o; }
    LDS_WAIT();
}
__device__ __forceinline__ int win_srccol(int n) {
    if (n >= 3072 && n < 4096) { const int u = (n - 3072) & 127, grp = u >> 3, e = u & 7; return (n & ~127) + (e < 4 ? 4 * grp + e : 64 + 4 * grp + (e - 4)); }
    return n < 6144 ? n : (n < 6656 ? n + 32 : (n < 6688 ? n - 512 : -1));
}

__device__ __forceinline__ void norm_row(const float* xrow, const float* nw, const float* mod, bf16_t* hrow, int lane) {
    f32x4 v[8]; float ss = 0.f;
#pragma unroll
    for (int j = 0; j < 8; ++j) { v[j] = ((const f32x4*)xrow)[lane + 64 * j]; ss += (v[j].x * v[j].x + v[j].y * v[j].y) + (v[j].z * v[j].z + v[j].w * v[j].w); }
    const float rstd = rsqrtf(wave_sum(ss) * (1.0f / D) + EPS);
#pragma unroll
    for (int j = 0; j < 8; ++j) { const int k = 4 * (lane + 64 * j);
        const f32x4 w = *(const f32x4*)(nw + k), sh = *(const f32x4*)(mod + k), sc = *(const f32x4*)(mod + D + k);
        const f32x4 o = v[j] * rstd * w * (sc + 1.0f) + sh;
        u32x2 pk; pk.x = pk2(o.x, o.y); pk.y = pk2(o.z, o.w);
        *(u32x2*)(hrow + k) = pk; }
}

__device__ __forceinline__ float block_sum(float v, LAS float* red, int tid) {
    v = wave_sum(v);
    if ((tid & 63) == 0) red[tid >> 6] = v;
    __syncthreads();
    float t = 0.f;
#pragma unroll
    for (int i = 0; i < NWAVES; ++i) t += red[i];
    __syncthreads();
    return t;
}
constexpr float HY_D0 = -3.0701134573253945f  , HY_D1 = -15.350567286626973f  ;

__device__ __forceinline__ void filt_ctx_item(const DArgs& a, unsigned char* ws, LAS unsigned char* lds, int c, int tid) {
    LAS float* w4s = (LAS float*)lds; LAS float* red = (LAS float*)(lds + 1024);
    if (tid < 256) { const int cc = tid >> 6, f = tid & 63; w4s[tid] = a.in[I_HW4][(size_t)f * 2048 + (cc >> 1) * 1024 + (cc & 1) * 512 + c]; }
    __syncthreads();
    const float dl = fabsf(HY_D0 + (HY_D1 - HY_D0) * ((float)c / 511.0f));
    const float* H3C = (const float*)(ws + WS_H3C);
    const int n = tid, dir = n >= 256 ? 1 : 0, t = dir ? (512 - n) : n;
    float s0 = 0.f, s1 = 0.f;
    if (n != 256) {
        const f32x4* hr = (const f32x4*)(H3C + (size_t)t * 64);
#pragma unroll
        for (int q = 0; q < 16; ++q) { const f32x4 hv = hr[q]; const f32x4 wa = ((const LAS f32x4*)(w4s + (dir * 2 + 0) * 64))[q], wb = ((const LAS f32x4*)(w4s + (dir * 2 + 1) * 64))[q];
            s0 += (hv.x * wa.x + hv.y * wa.y) + (hv.z * wa.z + hv.w * wa.w); s1 += (hv.x * wb.x + hv.y * wb.y) + (hv.z * wb.z + hv.w * wb.w); }
        const float dec = expf(-((float)t / 255.0f) * dl); s0 *= dec; s1 *= dec;
    }
    const float rs0 = rsqrtf(block_sum(s0 * s0, red, tid) + EPS), rs1 = rsqrtf(block_sum(s1 * s1, red, tid) + EPS);
    float* KC = (float*)(ws + WS_KC);
    KC[(size_t)(0 * 512 + c) * 512 + n] = s0 * rs0; KC[(size_t)(1 * 512 + c) * 512 + n] = s1 * rs1;
    __syncthreads();
}

__device__ __forceinline__ void prep_rope(f32x2* RT, int it, int tid) {
    const int idx = it * NT + tid, pos = idx >> 6, j = idx & 63;
    float ang;
    if (pos < SEQL) { const float inv = exp2f(-(float)(j & 31) * (13.287712379549449f / 32.0f)); ang = (float)(j < 32 ? (pos >> 6) : (pos & 63)) * inv; }
    else { const float inv = exp2f(-(float)j * (13.287712379549449f / 64.0f)); ang = (float)(pos - SEQL) * inv; }
    float sn, cs; sincosf(ang, &sn, &cs);
    RT[idx] = (f32x2){cs, sn};
}

__device__ __forceinline__ float sconv3(const bf16_t* p, int t, int Lx, float w0, float w1, float w2, float cb) {
    const float x0 = t > 0 ? bf2f(p[t - 1]) : 0.f, x1 = bf2f(p[t]), x2 = t < Lx - 1 ? bf2f(p[t + 1]) : 0.f;
    return w0 * x0 + w1 * x1 + w2 * x2 + cb;
}
__device__ __forceinline__ void ctx_conv256(const LAS float* kc, const LAS float* z, int b, int t4, int half, float (&o)[4]) {
    o[0] = o[1] = o[2] = o[3] = 0.f;
#pragma unroll 4
    for (int s4 = 0; s4 < 32; ++s4) { const int s = 128 * half + 4 * s4, d = 4 * t4 - s;
        const f32x4 zv = *(const LAS f32x4*)(z + b * 256 + s);
        const f32x4 wl = *(const LAS f32x4*)(kc + ((d - 4) & 511)), wh = *(const LAS f32x4*)(kc + (d & 511));
        const float w[8] = {wl.x, wl.y, wl.z, wl.w, wh.x, wh.y, wh.z, wh.w};
        const float zz[4] = {zv.x, zv.y, zv.z, zv.w};
#pragma unroll
        for (int j = 0; j < 4; ++j)
#pragma unroll
            for (int i = 0; i < 4; ++i) o[j] += w[4 + j - i] * zz[i]; }
}
__device__ __forceinline__ void hyena_ctx_item(const DArgs& a, unsigned char* ws, LAS unsigned char* lds, int c, int tid) {
    LAS float* kc = (LAS float*)lds; LAS float* za = (LAS float*)(lds + 4096); LAS float* zb = (LAS float*)(lds + 8192); LAS float* part = (LAS float*)(lds + 12288);
    const float* KC = (const float*)(ws + WS_KC);
    kc[tid] = KC[(size_t)(0 * 512 + c) * 512 + tid]; kc[512 + tid] = KC[(size_t)(1 * 512 + c) * 512 + tid];
    const float* cw = a.in[I_HCW]; const float* cbp = a.in[I_HCB];
    const float wv0 = cw[c], wv1 = cw[1536 + c], wv2 = cw[3072 + c], bv = cbp[c];
    const float wa0 = cw[512 + c], wa1 = cw[1536 + 512 + c], wa2 = cw[3072 + 512 + c], ba = cbp[512 + c];
    const float wb0 = cw[1024 + c], wb1 = cw[1536 + 1024 + c], wb2 = cw[3072 + 1024 + c], bb = cbp[1024 + c];
    const float bias0 = a.in[I_HBIAS][0 * 512 + c], bias1 = a.in[I_HBIAS][1 * 512 + c];
    const bf16_t* PT = (const bf16_t*)(ws + WS_PT);
    const int half = tid >> 8, b = (tid >> 6) & 3, t4 = tid & 63; const int rb = NLAT + b * LC;
    const bf16_t* pv = PT + (size_t)(PT_V + c) * MR + rb; const bf16_t* pg1 = PT + (size_t)(PT_G1 + c) * MR + rb; const bf16_t* pg2 = PT + (size_t)(PT_G2 + c) * MR + rb; const bf16_t* phg = PT + (size_t)(PT_HG + c) * MR + rb;
    bf16_t* GATED = (bf16_t*)(ws + WS_H);
    float z0[4], z1[4], o[4];
#pragma unroll
    for (int j = 0; j < 4; ++j) { z0[j] = sconv3(pv, 4 * t4 + j, LC, wv0, wv1, wv2, bv); }
    if (half == 0) *(LAS f32x4*)(za + b * 256 + 4 * t4) = (f32x4){z0[0], z0[1], z0[2], z0[3]};
    __syncthreads();
    ctx_conv256(kc, za, b, t4, half, o);
    if (half == 1) *(LAS f32x4*)(part + b * 256 + 4 * t4) = (f32x4){o[0], o[1], o[2], o[3]};
    __syncthreads();
    if (half == 0) { const f32x4 pp = *(const LAS f32x4*)(part + b * 256 + 4 * t4); const float ps[4] = {pp.x, pp.y, pp.z, pp.w};
#pragma unroll
        for (int j = 0; j < 4; ++j) z1[j] = sconv3(pg1, 4 * t4 + j, LC, wa0, wa1, wa2, ba) * (o[j] + ps[j] + bias0 * z0[j]);
        *(LAS f32x4*)(zb + b * 256 + 4 * t4) = (f32x4){z1[0], z1[1], z1[2], z1[3]}; }
    __syncthreads();
    ctx_conv256(kc + 512, zb, b, t4, half, o);
    if (half == 1) *(LAS f32x4*)(part + b * 256 + 4 * t4) = (f32x4){o[0], o[1], o[2], o[3]};
    __syncthreads();
    if (half == 0) { const f32x4 pp = *(const LAS f32x4*)(part + b * 256 + 4 * t4); const float ps[4] = {pp.x, pp.y, pp.z, pp.w};
#pragma unroll
        for (int j = 0; j < 4; ++j) { const int t = 4 * t4 + j; const float z2 = sconv3(pg2, t, LC, wb0, wb1, wb2, bb) * (o[j] + ps[j] + bias1 * z1[j]);
            GATED[(size_t)(rb + t) * D + 512 + c] = (bf16_t)f2bf(z2 * siluf_(bf2f(phg[t]))); } }
    __syncthreads();
}

struct EpiInProj {
    static constexpr bool PERM = true, AFTER_DRAIN = false;
    bf16_t* P; bf16_t* PT; float* LR; const float* RT;
    __device__ __forceinline__ void operator()(const pg8::f32x4 (&acc)[2][2][4][2], const pg8::Unit& u, int wr, int wc, int fr, int fq) const {
        const int row0 = u.pm * 256 + wr * 64 + fr, pn = u.pn;
        if (pn >= 12 && pn < 16) {
            const int colbase = pn * 256 - 2048 + wc * 32 + 8 * fq; const int j0 = 4 * (4 * wc + fq); const float ksc = pn >= 14 ? 0.08838834764831845f : 1.0f;
#pragma unroll
            for (int ai = 0; ai < 2; ++ai)
#pragma unroll
                for (int m = 0; m < 4; ++m) { const int row = row0 + ai * 128 + m * 16; const int pos = row < NLAT ? (row & (SEQL - 1)) : SEQL + ((row - NLAT) & (LC - 1));
                    const pg8::f32x4 t0 = *(const pg8::f32x4*)(RT + ((size_t)pos * 64 + j0) * 2), t1 = *(const pg8::f32x4*)(RT + ((size_t)pos * 64 + j0) * 2 + 4);
                    bf16_t* rowp = P + (size_t)row * LDP + colbase;
#pragma unroll
                    for (int bj = 0; bj < 2; ++bj) { const pg8::f32x4 x1 = acc[ai][bj][m][0] * ksc, x2 = acc[ai][bj][m][1] * ksc;
                        u32x4 w; w.x = pk2(x1[0] * t0[0] - x2[0] * t0[1], x1[1] * t0[2] - x2[1] * t0[3]); w.y = pk2(x1[2] * t1[0] - x2[2] * t1[1], x1[3] * t1[2] - x2[3] * t1[3]);
                        w.z = pk2(x1[0] * t0[1] + x2[0] * t0[0], x1[1] * t0[3] + x2[1] * t0[2]); w.w = pk2(x1[2] * t1[1] + x2[2] * t1[0], x1[3] * t1[3] + x2[3] * t1[2]);
                        *(u32x4*)(rowp + bj * 128) = w; } }
        } else if (pn < 4 || (pn >= 16 && pn < 26)) {
            const int colbase = (pn < 4 ? pn * 256 : pn * 256 - 2048) + wc * 32 + 8 * fq;
#pragma unroll
            for (int ai = 0; ai < 2; ++ai)
#pragma unroll
                for (int m = 0; m < 4; ++m) { bf16_t* rowp = P + (size_t)(row0 + ai * 128 + m * 16) * LDP + colbase;
#pragma unroll
                    for (int bj = 0; bj < 2; ++bj) { const pg8::f32x4 v0 = acc[ai][bj][m][0], v1 = acc[ai][bj][m][1];
                        u32x4 w; w.x = pk2(v0[0], v0[1]); w.y = pk2(v0[2], v0[3]); w.z = pk2(v1[0], v1[1]); w.w = pk2(v1[2], v1[3]);
                        *(u32x4*)(rowp + bj * 128) = w; } }
        } else if (pn < 12) {
            const int colbase = (pn - 4) * 256 + wc * 32 + 8 * fq;
#pragma unroll
            for (int bj = 0; bj < 2; ++bj)
#pragma unroll
                for (int n = 0; n < 2; ++n)
#pragma unroll
                    for (int j = 0; j < 4; ++j) { bf16_t* cp = PT + (size_t)(colbase + bj * 128 + 4 * n + j) * MR + row0;
#pragma unroll
                        for (int ai = 0; ai < 2; ++ai)
#pragma unroll
                            for (int m = 0; m < 4; ++m) cp[ai * 128 + m * 16] = (bf16_t)f2bf(acc[ai][bj][m][n][j]);
                        asm volatile("" ::: "memory"); }
        } else {
            if (wc == 0) {
#pragma unroll
                for (int ai = 0; ai < 2; ++ai)
#pragma unroll
                    for (int m = 0; m < 4; ++m) { float* rowp = LR + (size_t)(row0 + ai * 128 + m * 16) * 32 + 8 * fq;
                        *(pg8::f32x4*)(rowp) = acc[ai][0][m][0]; *(pg8::f32x4*)(rowp + 4) = acc[ai][0][m][1]; }
            }
        }
    }
};
struct EpiGlu {
    static constexpr bool PERM = true, AFTER_DRAIN = false;
    const bf16_t* GG; bf16_t* GATED; const float* bias;
    __device__ __forceinline__ void operator()(const pg8::f32x4 (&acc)[2][2][4][2], const pg8::Unit& u, int wr, int wc, int fr, int fq) const {
        const int row0 = u.pm * 256 + wr * 64 + fr, col0 = u.pn * 256 + wc * 32 + 8 * fq;
        pg8::f32x4 b0[2], b1[2];
#pragma unroll
        for (int bj = 0; bj < 2; ++bj) { b0[bj] = *(const pg8::f32x4*)(bias + col0 + bj * 128); b1[bj] = *(const pg8::f32x4*)(bias + col0 + bj * 128 + 4); }
#pragma unroll
        for (int ai = 0; ai < 2; ++ai) {
            u32x4 gg[4][2];
#pragma unroll
            for (int m = 0; m < 4; ++m)
#pragma unroll
                for (int bj = 0; bj < 2; ++bj) gg[m][bj] = *(const u32x4*)(GG + (size_t)(row0 + ai * 128 + m * 16) * 512 + col0 + bj * 128);
#pragma unroll
            for (int m = 0; m < 4; ++m) { const size_t row = (size_t)(row0 + ai * 128 + m * 16);
#pragma unroll
                for (int bj = 0; bj < 2; ++bj) { float g[8], res[8]; unpack8(gg[m][bj], g);
#pragma unroll
                    for (int j = 0; j < 4; ++j) { res[j] = g[j] * sigmoidf_(acc[ai][bj][m][0][j] + b0[bj][j]); res[4 + j] = g[4 + j] * sigmoidf_(acc[ai][bj][m][1][j] + b1[bj][j]); }
                    *(u32x4*)(GATED + row * D + col0 + bj * 128) = pack8(res); } }
            asm volatile("" ::: "memory");
        }
    }
};
struct EpiOut {
    static constexpr bool PERM = false, AFTER_DRAIN = false;
    const float* xl_old; const float* xc_old; float* xl_new; float* xc_new; const float* mod;
    __device__ __forceinline__ void operator()(const pg8::f32x4 (&acc)[2][2][4][2], const pg8::Unit& u, int wr, int wc, int fr, int fq) const {
        const int row0 = u.pm * 256 + wr * 64 + fr, col0 = u.pn * 256 + wc * 32 + 4 * fq;
        const bool lat = u.pm < 64;
        const float* xo = lat ? xl_old : xc_old - (size_t)NLAT * D; float* xn = lat ? xl_new : xc_new - (size_t)NLAT * D;
#pragma unroll
        for (int ai = 0; ai < 2; ++ai) {
            const int v = lat ? ((u.pm * 256 + ai * 128) >> 12) : 4;
            const float* gt = mod + (size_t)v * ADA + 2 * D;
#pragma unroll
            for (int m = 0; m < 4; ++m) { const size_t off = (size_t)(row0 + ai * 128 + m * 16) * D + col0;
#pragma unroll
                for (int bj = 0; bj < 2; ++bj)
#pragma unroll
                    for (int n = 0; n < 2; ++n) { const int cc = bj * 128 + n * 16; const pg8::f32x4 gv = *(const pg8::f32x4*)(gt + col0 + cc), xv = *(const pg8::f32x4*)(xo + off + cc);
                        *(pg8::f32x4*)(xn + off + cc) = xv + gv * acc[ai][bj][m][n]; } }
        }
    }
};
typedef short bf16x8 __attribute__((ext_vector_type(8)));
typedef short bf16x4 __attribute__((ext_vector_type(4)));
__device__ __forceinline__ unsigned off_b(unsigned row, unsigned ch) { return 256u * row + 16u * (ch ^ (((row & 3) << 2) | ((row >> 2) & 3))); }
__device__ __forceinline__ bf16x8 img_row_frag(const LAS unsigned char* img, unsigned lane, unsigned rb, unsigned s) { return *(const LAS bf16x8*)(img + off_b((lane & 15) + 16 * rb, 4 * s + (lane >> 4))); }
__device__ __forceinline__ bf16x4 img_tr4(const LAS unsigned char* img, unsigned lane, unsigned c, unsigned row0) {
    const unsigned q = (lane & 15) >> 2, p = lane & 3;
    return __builtin_amdgcn_ds_read_tr16_b64_v4i16((LAS bf16x4*)(img + off_b(row0 + q, 2 * c + (p >> 1)) + 8 * (p & 1)));
}
__device__ __forceinline__ bf16x8 img_tr_frag(const LAS unsigned char* img, unsigned lane, unsigned c, unsigned ks) {
    const unsigned g = lane >> 4; const bf16x4 lo = img_tr4(img, lane, c, 32 * ks + 8 * g), hi = img_tr4(img, lane, c, 32 * ks + 8 * g + 4);
    return __builtin_shufflevector(lo, hi, 0, 1, 2, 3, 4, 5, 6, 7);
}
__device__ __forceinline__ bf16x8 img_tr_frag_acc(const LAS unsigned char* img, unsigned lane, unsigned c, unsigned ks) {
    const unsigned g = lane >> 4; const bf16x4 lo = img_tr4(img, lane, c, 32 * ks + 4 * g), hi = img_tr4(img, lane, c, 32 * ks + 16 + 4 * g);
    return __builtin_shufflevector(lo, hi, 0, 1, 2, 3, 4, 5, 6, 7);
}
__device__ __forceinline__ bf16x8 acc_pair_frag(const f32x4 a0, const f32x4 a1) {
    u32x4 w; w.x = pk2(a0.x, a0.y); w.y = pk2(a0.z, a0.w); w.z = pk2(a1.x, a1.y); w.w = pk2(a1.z, a1.w);
    return __builtin_bit_cast(bf16x8, w);
}
#define MFMA16(A_, B_, C_) __builtin_amdgcn_mfma_f32_16x16x32_bf16((A_), (B_), (C_), 0, 0, 0)
__device__ __forceinline__ void stage_tile128(LAS unsigned char* img, const bf16_t* g, size_t ld, int tid) {
#pragma unroll
    for (int i = 0; i < 4; ++i) { const int n = tid + NT * i, row = n >> 4, ch = n & 15; *(LAS u32x4*)(img + off_b(row, ch)) = *(const u32x4*)(g + (size_t)row * ld + ch * 8); }
}

constexpr int RCH = 128, RNCH = 34;
constexpr size_t WS_RST = WS_OB;
__device__ __forceinline__ int ret_rowbase(int b, int cc) { return cc < 2 ? NLAT + b * LC + cc * RCH : b * SEQL + (cc - 2) * RCH; }
__device__ __forceinline__ float ret_log2g(int h) { return log2f(1.0f - exp2f(-5.0f - (float)h)); }

__device__ __forceinline__ void ret_passA(unsigned char* ws, LAS unsigned char* lds, int item, int tid) {
    const int bh = item / RNCH, cc = item % RNCH, b = bh >> 2, h = bh & 3;
    const int lane = tid & 63, w = tid >> 6, g = lane >> 4;
    LAS unsigned char* KF = lds; LAS unsigned char* KB = lds + 32768; LAS unsigned char* VI = lds + 65536;
    const bf16_t* P = (const bf16_t*)(ws + WS_P) + (size_t)ret_rowbase(b, cc) * LDP;
    const float l2g = ret_log2g(h);
    __syncthreads();
#pragma unroll
    for (int i = 0; i < 4; ++i) { const int n = tid + NT * i, row = n >> 4, ch = n & 15;
        const u32x4 kr = *(const u32x4*)(P + (size_t)row * LDP + PC_RK + h * 128 + ch * 8);
        float kf[8], a[8], c[8]; unpack8(kr, kf);
        const float sf = exp2f(l2g * (float)(RCH - 1 - row)), sb = exp2f(l2g * (float)row);
#pragma unroll
        for (int x = 0; x < 8; ++x) { a[x] = kf[x] * sf; c[x] = kf[x] * sb; }
        *(LAS u32x4*)(KF + off_b(row, ch)) = pack8(a); *(LAS u32x4*)(KB + off_b(row, ch)) = pack8(c);
        *(LAS u32x4*)(VI + off_b(row, ch)) = *(const u32x4*)(P + (size_t)row * LDP + PC_RV + h * 128 + ch * 8); }
    __syncthreads();
    bf16x8 af[4], ab[4];
#pragma unroll
    for (int ks = 0; ks < 4; ++ks) { af[ks] = img_tr_frag(KF, lane, w, ks); ab[ks] = img_tr_frag(KB, lane, w, ks); }
    bf16_t* ST = (bf16_t*)(ws + WS_RST) + ((size_t)(bh * 2) * RNCH + cc) * (128 * 128);
#pragma unroll 2
    for (int E = 0; E < 8; ++E) {
        f32x4 cf = {0.f, 0.f, 0.f, 0.f}, cb = {0.f, 0.f, 0.f, 0.f};
#pragma unroll
        for (int ks = 0; ks < 4; ++ks) { const bf16x8 vb = img_tr_frag(VI, lane, E, ks); cf = MFMA16(af[ks], vb, cf); cb = MFMA16(ab[ks], vb, cb); }
        const int e = 16 * E + (lane & 15), d0 = 16 * w + 4 * g;
        u32x2 o; o.x = pk2(cf.x, cf.y); o.y = pk2(cf.z, cf.w); *(u32x2*)(ST + (size_t)e * 128 + d0) = o;
        o.x = pk2(cb.x, cb.y); o.y = pk2(cb.z, cb.w); *(u32x2*)(ST + (size_t)RNCH * 128 * 128 + (size_t)e * 128 + d0) = o;
    }
}
__device__ __forceinline__ void ret_passB(unsigned char* ws, int gt  ) {
    const int el = gt & 2047, bd = gt >> 11, bh = bd >> 1, dir = bd & 1, h = bh & 3;
    const float gC = exp2f(ret_log2g(h) * (float)RCH);
    bf16_t* base = (bf16_t*)(ws + WS_RST) + (size_t)bd * RNCH * (128 * 128) + (size_t)el * 8;
    float acc[8];
#pragma unroll
    for (int x = 0; x < 8; ++x) acc[x] = 0.f;
#pragma unroll 1
    for (int s0 = 0; s0 < RNCH; s0 += 17) {
        u32x4 kvr[17];
#pragma unroll
        for (int j = 0; j < 17; ++j) { const int s = s0 + j; const int cc = dir == 0 ? s : (s < 2 ? 1 - s : 35 - s); kvr[j] = *(const u32x4*)(base + (size_t)cc * (128 * 128)); }
#pragma unroll
        for (int j = 0; j < 17; ++j) { const int s = s0 + j; const int cc = dir == 0 ? s : (s < 2 ? 1 - s : 35 - s);
            float kv[8]; unpack8(kvr[j], kv);
            *(u32x4*)(base + (size_t)cc * (128 * 128)) = pack8(acc);
#pragma unroll
            for (int x = 0; x < 8; ++x) acc[x] = gC * acc[x] + kv[x]; }
    }
}
__device__ __forceinline__ void ret_passC(const DArgs& a, unsigned char* ws, LAS unsigned char* lds, int l, int item, int tid) {
    const int bh = item / RNCH, cc = item % RNCH, b = bh >> 2, h = bh & 3;
    const int lane = tid & 63, w = tid >> 6, g = lane >> 4, il = lane & 15;
    LAS unsigned char* KI = lds; LAS unsigned char* VI = lds + 32768; LAS unsigned char* SF = lds + 65536; LAS unsigned char* SB = lds + 98304;
    const int rowbase = ret_rowbase(b, cc);
    const bf16_t* P = (const bf16_t*)(ws + WS_P) + (size_t)rowbase * LDP;
    const bf16_t* STf = (const bf16_t*)(ws + WS_RST) + ((size_t)(bh * 2) * RNCH + cc) * (128 * 128);
    const bf16_t* STb = STf + (size_t)RNCH * 128 * 128;
    __syncthreads();
    stage_tile128(KI, P + PC_RK + h * 128, LDP, tid); stage_tile128(VI, P + PC_RV + h * 128, LDP, tid);
    stage_tile128(SF, STf, 128, tid); stage_tile128(SB, STb, 128, tid);
    bf16x8 qf[4];
    { const bf16_t* qr = P + (size_t)(16 * w + il) * LDP + PC_RQ + h * 128 + 8 * g;
#pragma unroll
      for (int ks = 0; ks < 4; ++ks) qf[ks] = *(const bf16x8*)(qr + 32 * ks); }
    __syncthreads();
    const float l2g = ret_log2g(h);
    const int iloc = 16 * w + il;
    f32x4 o[8];
    { const float sf = exp2f(l2g * (float)(iloc + 1)), sb = exp2f(l2g * (float)(RCH - iloc));
#pragma unroll
      for (int E = 0; E < 8; ++E) { f32x4 rf = {0.f, 0.f, 0.f, 0.f}, rb = {0.f, 0.f, 0.f, 0.f};
#pragma unroll
          for (int ks = 0; ks < 4; ++ks) { rf = MFMA16(img_row_frag(SF, lane, E, ks), qf[ks], rf); rb = MFMA16(img_row_frag(SB, lane, E, ks), qf[ks], rb); }
          o[E] = rf * sf + rb * sb; } }
    f32x4 at[8];
#pragma unroll
    for (int T = 0; T < 8; ++T) { f32x4 c = {0.f, 0.f, 0.f, 0.f};
#pragma unroll
        for (int ks = 0; ks < 4; ++ks) c = MFMA16(img_row_frag(KI, lane, T, ks), qf[ks], c);
#pragma unroll
        for (int r = 0; r < 4; ++r) { const int j = 16 * T + 4 * g + r; const int dd = iloc > j ? iloc - j : j - iloc; c[r] *= (dd == 0 ? 2.0f : exp2f(l2g * (float)dd)); }
        at[T] = c; }
#pragma unroll
    for (int s = 0; s < 4; ++s) { const bf16x8 bfr = acc_pair_frag(at[2 * s], at[2 * s + 1]);
#pragma unroll
        for (int E = 0; E < 8; ++E) o[E] = MFMA16(img_tr_frag_acc(VI, lane, E, s), bfr, o[E]); }
    float ss = 0.f;
#pragma unroll
    for (int E = 0; E < 8; ++E) ss += (o[E].x * o[E].x + o[E].y * o[E].y) + (o[E].z * o[E].z + o[E].w * o[E].w);
    ss += __shfl_xor(ss, 16); ss += __shfl_xor(ss, 32);
    const float rn = rsqrtf(ss * (1.0f / 128.0f) + EPS);
    const size_t row = (size_t)rowbase + iloc;
    const bf16_t* gp = (const bf16_t*)(ws + WS_P) + row * LDP + PC_RG + h * 128 + 4 * g;
    const float* nw = a.in[I_RNW] + l * 512 + h * 128 + 4 * g;
    bf16_t* op = (bf16_t*)(ws + WS_H) + row * D + 1024 + h * 128 + 4 * g;
#pragma unroll
    for (int E = 0; E < 8; ++E) { const u32x2 gr = *(const u32x2*)(gp + 16 * E); const f32x4 nv = *(const f32x4*)(nw + 16 * E);
        u32x2 ov; ov.x = pk2(o[E].x * rn * nv.x * siluf_(bflo(gr.x)), o[E].y * rn * nv.y * siluf_(bfhi(gr.x)));
        ov.y = pk2(o[E].z * rn * nv.z * siluf_(bflo(gr.y)), o[E].w * rn * nv.w * siluf_(bfhi(gr.y)));
        *(u32x2*)(op + 16 * E) = ov; }
}
constexpr int GCH = 64, GNCH = 68;
constexpr size_t WS_GST = WS_OB + (size_t)2 * OBSZ * 2;
constexpr size_t WS_GDEC = WS_END;
constexpr size_t WS_H3B = WS_GDEC + (size_t)16 * 2 * GNCH * 64 * 4;
constexpr size_t WS_ROPE = WS_H3B + (size_t)2 * 4096 * 64 * 2;
constexpr size_t WS_TWID = WS_ROPE + (size_t)(SEQL + LC) * 64 * 8;
constexpr size_t WS_END2 = WS_TWID + 4096 * 8;
__device__ __forceinline__ int gla_rowbase(int b, int cg) { return cg < 4 ? NLAT + b * LC + cg * GCH : b * SEQL + (cg - 4) * GCH; }

constexpr int GLS = 68;
__device__ __forceinline__ void gla_gates_compute(const DArgs& a, unsigned char* ws, LAS float* BF, LAS float* BB, LAS float* GW  , int l, int h, int rowbase, int tid) {
    const int t = tid >> 3, d8 = tid & 7;
    const float* lr = (const float*)(ws + WS_LR) + (size_t)(rowbase + t) * 32;
    f32x4 lv[8];
#pragma unroll
    for (int q = 0; q < 8; ++q) lv[q] = ((const f32x4*)lr)[q];
    { const int dir = tid >> 8, r = (tid >> 4) & 15, c4 = (tid & 15) * 4;
      *(LAS f32x4*)(GW + (dir * 17 + r) * 64 + c4) = *(const f32x4*)(a.in[I_GGW] + (size_t)(l * 2 + dir) * 16 * 256 + r * 256 + h * 64 + c4);
      if (tid < 32) { const int dd = tid >> 4; *(LAS f32x4*)(GW + (dd * 17 + 16) * 64 + c4) = *(const f32x4*)(a.in[I_GGB] + (size_t)(l * 2 + dd) * 256 + h * 64 + c4); } }
    __syncthreads();
    bf16_t* GLG = (bf16_t*)(ws + WS_WIN);
#pragma unroll
    for (int dir = 0; dir < 2; ++dir) {
        const LAS float* gw = GW + dir * 17 * 64 + 8 * d8;
        f32x4 s0 = *(const LAS f32x4*)(gw + 16 * 64), s1 = *(const LAS f32x4*)(gw + 16 * 64 + 4);
#pragma unroll
        for (int j = 0; j < 16; ++j) { const float lj = lv[dir * 4 + (j >> 2)][j & 3]; s0 += lj * *(const LAS f32x4*)(gw + j * 64); s1 += lj * *(const LAS f32x4*)(gw + j * 64 + 4); }
        LAS float* dst = (dir ? BB : BF) + t * GLS + 8 * d8;
        float la[8];
#pragma unroll
        for (int x = 0; x < 8; ++x) { const float s = x < 4 ? s0[x] : s1[x - 4]; const float e = __expf(-fabsf(s)); const float ls = fminf(s, 0.f) - __logf(1.0f + e); la[x] = ls * (1.0f / 16.0f); }
        const u32x4 pk = pack8(la);
        *(u32x4*)(GLG + ((size_t)dir * MR + rowbase + t) * 256 + h * 64 + 8 * d8) = pk;
        float lq[8]; unpack8(pk, lq);
        *(LAS f32x4*)dst = (f32x4){lq[0], lq[1], lq[2], lq[3]}; *(LAS f32x4*)(dst + 4) = (f32x4){lq[4], lq[5], lq[6], lq[7]};
    }
}
__device__ __forceinline__ void gla_gates_load(unsigned char* ws, LAS float* BF, LAS float* BB, int h, int rowbase, int tid) {
    const int t = tid >> 3, d8 = tid & 7;
    const bf16_t* GLG = (const bf16_t*)(ws + WS_WIN);
#pragma unroll
    for (int dir = 0; dir < 2; ++dir) { float lq[8]; unpack8(*(const u32x4*)(GLG + ((size_t)dir * MR + rowbase + t) * 256 + h * 64 + 8 * d8), lq);
        LAS float* dst = (dir ? BB : BF) + t * GLS + 8 * d8;
        *(LAS f32x4*)dst = (f32x4){lq[0], lq[1], lq[2], lq[3]}; *(LAS f32x4*)(dst + 4) = (f32x4){lq[4], lq[5], lq[6], lq[7]}; }
}
__device__ __forceinline__ void gla_scan(LAS float* BF, LAS float* BB, int tid) {
    const int lane = tid & 63, w = tid >> 6;
    __syncthreads();
#pragma unroll 4
    for (int c = 0; c < 16; ++c) { const int col = 16 * w + c; const int dir = col >> 6, d = col & 63;
        LAS float* p = (dir ? BB : BF) + (dir ? 63 - lane : lane) * GLS + d;
        float v = *p;
#pragma unroll
        for (int off = 1; off < 64; off <<= 1) { const float u = __shfl_up(v, off); if (lane >= off) v += u; }
        *p = v; }
    __syncthreads();
}

__device__ __forceinline__ void gla_passA(const DArgs& a, unsigned char* ws, LAS unsigned char* lds, int l, int item, int tid) {
    const int bh = item / GNCH, cg = item % GNCH, b = bh >> 2, h = bh & 3;
    const int lane = tid & 63, w = tid >> 6, g = lane >> 4;
    LAS float* BF = (LAS float*)lds; LAS float* BB = (LAS float*)(lds + 17408); LAS unsigned char* KH = lds + 34816; LAS unsigned char* VI = lds + 34816 + 16384;
    const int rowbase = gla_rowbase(b, cg);
    const bf16_t* P = (const bf16_t*)(ws + WS_P) + (size_t)rowbase * LDP;
    const int t = tid >> 3, d8 = tid & 7;
    const u32x4 kraw = *(const u32x4*)(P + (size_t)t * LDP + PC_GK + h * 64 + 8 * d8);
    u32x4 vraw[2];
#pragma unroll
    for (int i = 0; i < 2; ++i) { const int n = tid + NT * i; vraw[i] = *(const u32x4*)(P + (size_t)(n >> 4) * LDP + PC_GV + h * 128 + (n & 15) * 8); }
    gla_gates_compute(a, ws, BF, BB, (LAS float*)(lds + 34816 + 32768), l, h, rowbase, tid);
    gla_scan(BF, BB, tid);
    { float kf[8], x0[8], x1[8]; unpack8(kraw, kf);
#pragma unroll
      for (int x = 0; x < 8; ++x) { const int d = 8 * d8 + x; x0[x] = kf[x] * __expf(BF[63 * GLS + d] - BF[t * GLS + d]); x1[x] = kf[x] * __expf(BB[d] - BB[t * GLS + d]); }
      *(LAS u32x4*)(KH + off_b(t, d8)) = pack8(x0); *(LAS u32x4*)(KH + off_b(t, 8 + d8)) = pack8(x1);
#pragma unroll
      for (int i = 0; i < 2; ++i) { const int n = tid + NT * i; *(LAS u32x4*)(VI + off_b(n >> 4, n & 15)) = vraw[i]; }
      if (tid < 128) { const int dir = tid >> 6, d = tid & 63; ((float*)(ws + WS_GDEC))[((size_t)(bh * 2 + dir) * GNCH + cg) * 64 + d] = __expf(dir ? BB[d] : BF[63 * GLS + d]); } }
    __syncthreads();
    const int dir = w >> 2, Dt = w & 3;
    bf16x8 af[2];
#pragma unroll
    for (int ks = 0; ks < 2; ++ks) af[ks] = img_tr_frag(KH, lane, dir * 4 + Dt, ks);
    bf16_t* ST = (bf16_t*)(ws + WS_GST) + ((size_t)(bh * 2 + dir) * GNCH + cg) * (128 * 64);
#pragma unroll 2
    for (int E = 0; E < 8; ++E) {
        f32x4 c = {0.f, 0.f, 0.f, 0.f};
#pragma unroll
        for (int ks = 0; ks < 2; ++ks) c = MFMA16(af[ks], img_tr_frag(VI, lane, E, ks), c);
        u32x2 o; o.x = pk2(c.x, c.y); o.y = pk2(c.z, c.w);
        *(u32x2*)(ST + (size_t)(16 * E + (lane & 15)) * 64 + 16 * Dt + 4 * g) = o;
    }
}
__device__ __forceinline__ void gla_passB(unsigned char* ws, LAS unsigned char* lds, int blk, int tid) {
    const int bd = blk >> 1, dir = bd & 1, el = (blk & 1) * 512 + tid;
    LAS float* decs = (LAS float*)lds;
    { const float* dsrc = (const float*)(ws + WS_GDEC) + (size_t)bd * GNCH * 64;
      for (int i = tid; i < GNCH * 64; i += NT) decs[i] = dsrc[i]; }
    __syncthreads();
    bf16_t* base = (bf16_t*)(ws + WS_GST) + (size_t)bd * GNCH * (128 * 64) + (size_t)el * 8;
    const int d0 = (el & 7) * 8;
    float acc[8];
#pragma unroll
    for (int x = 0; x < 8; ++x) acc[x] = 0.f;
#pragma unroll 1
    for (int s0 = 0; s0 < GNCH; s0 += 17) {
        u32x4 kvr[17];
#pragma unroll
        for (int j = 0; j < 17; ++j) { const int s = s0 + j; const int cg = dir == 0 ? s : (s < 4 ? 3 - s : 71 - s); kvr[j] = *(const u32x4*)(base + (size_t)cg * (128 * 64)); }
#pragma unroll
        for (int j = 0; j < 17; ++j) { const int s = s0 + j; const int cg = dir == 0 ? s : (s < 4 ? 3 - s : 71 - s);
            float kv[8]; unpack8(kvr[j], kv);
            const f32x4 q0 = *(const LAS f32x4*)(decs + cg * 64 + d0), q1 = *(const LAS f32x4*)(decs + cg * 64 + d0 + 4);
            *(u32x4*)(base + (size_t)cg * (128 * 64)) = pack8(acc);
#pragma unroll
            for (int x = 0; x < 8; ++x) acc[x] = (x < 4 ? q0[x] : q1[x - 4]) * acc[x] + kv[x]; }
    }
    __syncthreads();
}
__device__ __forceinline__ void gla_passC(const DArgs& a, unsigned char* ws, LAS unsigned char* lds, int l, int item, int tid) {
    const int bh = item / GNCH, cg = item % GNCH, b = bh >> 2, h = bh & 3;
    const int lane = tid & 63, w = tid >> 6, g = lane >> 4, il = lane & 15;
    LAS float* BF = (LAS float*)lds; LAS float* BB = (LAS float*)(lds + 17408);
    LAS unsigned char* QKF = lds + 34816; LAS unsigned char* QKB = QKF + 16384; LAS unsigned char* QH = QKB + 16384; LAS unsigned char* VI = QH + 16384; LAS unsigned char* SI = VI + 16384;
    const int rowbase = gla_rowbase(b, cg);
    const bf16_t* P = (const bf16_t*)(ws + WS_P) + (size_t)rowbase * LDP;
    const int t = tid >> 3, d8 = tid & 7;
    const u32x4 qraw = *(const u32x4*)(P + (size_t)t * LDP + PC_GQ + h * 64 + 8 * d8), kraw = *(const u32x4*)(P + (size_t)t * LDP + PC_GK + h * 64 + 8 * d8);
    u32x4 vraw[2], sraw[4];
#pragma unroll
    for (int i = 0; i < 2; ++i) { const int n = tid + NT * i; vraw[i] = *(const u32x4*)(P + (size_t)(n >> 4) * LDP + PC_GV + h * 128 + (n & 15) * 8); }
    { const bf16_t* STf = (const bf16_t*)(ws + WS_GST) + ((size_t)(bh * 2) * GNCH + cg) * (128 * 64); const bf16_t* STb = STf + (size_t)GNCH * 128 * 64;
#pragma unroll
      for (int i = 0; i < 4; ++i) { const int n = tid + NT * i, row = n >> 4, ch = n & 15; sraw[i] = *(const u32x4*)((ch < 8 ? STf : STb) + (size_t)row * 64 + (ch & 7) * 8); } }
    gla_gates_load(ws, BF, BB, h, rowbase, tid);
    gla_scan(BF, BB, tid);
    { float qf[8], kf[8], o0[8], o1[8], o2[8], o3[8], o4[8], o5[8];
      unpack8(qraw, qf); unpack8(kraw, kf);
#pragma unroll
      for (int x = 0; x < 8; ++x) { const int d = 8 * d8 + x; const float bf = BF[t * GLS + d], bb = BB[t * GLS + d], rf = BF[31 * GLS + d], rb = BB[32 * GLS + d]; const float q = qf[x] * 0.125f;
          o0[x] = q * __expf(bf - rf); o1[x] = kf[x] * __expf(rf - bf); o2[x] = q * __expf(bb - rb); o3[x] = kf[x] * __expf(rb - bb); o4[x] = q * __expf(bf); o5[x] = q * __expf(bb); }
      *(LAS u32x4*)(QKF + off_b(t, d8)) = pack8(o0); *(LAS u32x4*)(QKF + off_b(t, 8 + d8)) = pack8(o1);
      *(LAS u32x4*)(QKB + off_b(t, d8)) = pack8(o2); *(LAS u32x4*)(QKB + off_b(t, 8 + d8)) = pack8(o3);
      *(LAS u32x4*)(QH + off_b(t, d8)) = pack8(o4); *(LAS u32x4*)(QH + off_b(t, 8 + d8)) = pack8(o5);
#pragma unroll
      for (int i = 0; i < 2; ++i) { const int n = tid + NT * i; *(LAS u32x4*)(VI + off_b(n >> 4, n & 15)) = vraw[i]; }
#pragma unroll
      for (int i = 0; i < 4; ++i) { const int n = tid + NT * i; *(LAS u32x4*)(SI + off_b(n >> 4, n & 15)) = sraw[i]; } }
    __syncthreads();
    const int ib = w & 3, eh = w >> 2, iloc = 16 * ib + il;
    f32x4 at[4];
    { bf16x8 qff[2], qfb[2];
#pragma unroll
      for (int ks = 0; ks < 2; ++ks) { qff[ks] = img_row_frag(QKF, lane, ib, ks); qfb[ks] = img_row_frag(QKB, lane, ib, ks); }
#pragma unroll
      for (int T = 0; T < 4; ++T) { f32x4 cf = {0.f, 0.f, 0.f, 0.f}, cb = {0.f, 0.f, 0.f, 0.f};
#pragma unroll
          for (int ks = 0; ks < 2; ++ks) { cf = MFMA16(img_row_frag(QKF, lane, T, 2 + ks), qff[ks], cf); cb = MFMA16(img_row_frag(QKB, lane, T, 2 + ks), qfb[ks], cb); }
#pragma unroll
          for (int r = 0; r < 4; ++r) { const int j = 16 * T + 4 * g + r; cf[r] = (j <= iloc ? cf[r] : 0.f) + (j >= iloc ? cb[r] : 0.f); }
          at[T] = cf; } }
    f32x4 o[4];
    { bf16x8 hf[2], hb[2];
#pragma unroll
      for (int ks = 0; ks < 2; ++ks) { hf[ks] = img_row_frag(QH, lane, ib, ks); hb[ks] = img_row_frag(QH, lane, ib, 2 + ks); }
#pragma unroll
      for (int E4 = 0; E4 < 4; ++E4) { const int E = 4 * eh + E4; f32x4 c = {0.f, 0.f, 0.f, 0.f};
#pragma unroll
          for (int ks = 0; ks < 2; ++ks) { c = MFMA16(img_row_frag(SI, lane, E, ks), hf[ks], c); c = MFMA16(img_row_frag(SI, lane, E, 2 + ks), hb[ks], c); }
          o[E4] = c; } }
#pragma unroll
    for (int s = 0; s < 2; ++s) { const bf16x8 bfr = acc_pair_frag(at[2 * s], at[2 * s + 1]);
#pragma unroll
        for (int E4 = 0; E4 < 4; ++E4) o[E4] = MFMA16(img_tr_frag_acc(VI, lane, 4 * eh + E4, s), bfr, o[E4]); }
    float ss = 0.f;
#pragma unroll
    for (int E4 = 0; E4 < 4; ++E4) ss += (o[E4].x * o[E4].x + o[E4].y * o[E4].y) + (o[E4].z * o[E4].z + o[E4].w * o[E4].w);
    ss += __shfl_xor(ss, 16); ss += __shfl_xor(ss, 32);
    LAS float* red = (LAS float*)lds;
    if (g == 0) red[eh * 64 + iloc] = ss;
    __syncthreads();
    const float rn = rsqrtf((red[iloc] + red[64 + iloc]) * (1.0f / 128.0f) + EPS);
    const size_t row = (size_t)rowbase + iloc;
    const bf16_t* gp = (const bf16_t*)(ws + WS_P) + row * LDP + PC_GG + h * 128 + 64 * eh + 4 * g;
    const float* nw = a.in[I_GNW] + l * 512 + h * 128 + 64 * eh + 4 * g;
    bf16_t* op = (bf16_t*)(ws + WS_H) + row * D + 1536 + h * 128 + 64 * eh + 4 * g;
#pragma unroll
    for (int E4 = 0; E4 < 4; ++E4) { const u32x2 gr = *(const u32x2*)(gp + 16 * E4); const f32x4 nv = *(const f32x4*)(nw + 16 * E4);
        u32x2 ov; ov.x = pk2(o[E4].x * rn * nv.x * siluf_(bflo(gr.x)), o[E4].y * rn * nv.y * siluf_(bfhi(gr.x)));
        ov.y = pk2(o[E4].z * rn * nv.z * siluf_(bflo(gr.y)), o[E4].w * rn * nv.w * siluf_(bfhi(gr.y)));
        *(u32x2*)(op + 16 * E4) = ov; }
}
constexpr int SNCH = 68;
constexpr size_t WS_S5ST = WS_OB + (size_t)4 * OBSZ * 2;
constexpr size_t WS_S5BTB = WS_S5BT;
constexpr size_t WS_S5CPB = WS_S5BT + 524288;
constexpr size_t WS_S5A64 = WS_S5BT + 1048576;

__device__ __forceinline__ void prep_s5b(const DArgs& a, unsigned char* ws, int it, int tid) {
    const int idx = it * 512 + tid;
    const int gi = idx >> 6, p = idx & 63;
    const float a_re = a.in[I_S5ARE][idx], a_im = a.in[I_S5AIM][idx], ldt = a.in[I_S5LDT][gi];
    const float dt = expf(ldt), mag = expf(a_re * dt);
    float sn, cs; sincosf(a_im * dt, &sn, &cs);
    const float ab_re = mag * cs, ab_im = mag * sn, den = a_re * a_re + a_im * a_im, nr = ab_re - 1.0f;
    const float co_re = (nr * a_re + ab_im * a_im) / den, co_im = (ab_im * a_re - nr * a_im) / den;
    ((f32x2*)(ws + WS_S5AB))[idx] = (f32x2){ab_re, ab_im};
    float pr = ab_re, pi = ab_im;
#pragma unroll
    for (int q = 0; q < 6; ++q) { const float nr2 = pr * pr - pi * pi, ni2 = 2.0f * pr * pi; pr = nr2; pi = ni2; }
    ((f32x2*)(ws + WS_S5A64))[idx] = (f32x2){pr, pi};
    const float* bre = a.in[I_S5BRE] + (size_t)idx * 16; const float* bim = a.in[I_S5BIM] + (size_t)idx * 16;
    float tr[16], ti[16];
#pragma unroll
    for (int i = 0; i < 16; ++i) { const float br = bre[i], bi = bim[i]; tr[i] = co_re * br - co_im * bi; ti[i] = co_re * bi + co_im * br; }
    bf16_t* btb = (bf16_t*)(ws + WS_S5BTB) + (size_t)gi * 128 * 16;
#pragma unroll
    for (int hlf = 0; hlf < 2; ++hlf) { u32x4 w0, w1; const float* s = hlf ? ti : tr;
        w0.x = pk2(s[0], s[1]); w0.y = pk2(s[2], s[3]); w0.z = pk2(s[4], s[5]); w0.w = pk2(s[6], s[7]); w1.x = pk2(s[8], s[9]); w1.y = pk2(s[10], s[11]); w1.z = pk2(s[12], s[13]); w1.w = pk2(s[14], s[15]);
        *(u32x4*)(btb + (size_t)(64 * hlf + p) * 16) = w0; *(u32x4*)(btb + (size_t)(64 * hlf + p) * 16 + 8) = w1; }
    bf16_t* cpb = (bf16_t*)(ws + WS_S5CPB) + (size_t)gi * 16 * 128;
    const float* cre = a.in[I_S5CRE] + (size_t)gi * 1024; const float* cim = a.in[I_S5CIM] + (size_t)gi * 1024;
#pragma unroll
    for (int i = 0; i < 16; ++i) *(unsigned*)(cpb + i * 128 + 2 * p) = pk2(cre[i * 64 + p], -cim[i * 64 + p]);
}

struct S5Unit { bf16x8 btf[8]; f32x2 ab; f32x2 h; const bf16_t* cp; };
template <bool PASSC> __device__ __forceinline__ void s5_load_unit(S5Unit& U, unsigned char* ws, const bf16_t* P, const f32x2* ST, int l, int b, int cs, int rowbase, int grp, int dir, int lane) {
    const int g = lane >> 4, il = lane & 15;
    const bf16x8 zero8 = {0, 0, 0, 0, 0, 0, 0, 0};
    const int gi = (l * 2 + dir) * 32 + grp;
    U.ab = ((const f32x2*)(ws + WS_S5AB))[gi * 64 + lane];
    const size_t sidx = ((size_t)(b * SNCH + cs) * 2 + dir) * 2048 + grp * 64 + lane;
    U.h = PASSC ? ST[sidx] : (f32x2){0.f, 0.f};
    const bf16_t* bt = (const bf16_t*)(ws + WS_S5BTB) + (size_t)gi * 128 * 16 + (size_t)il * 16 + 8 * (g & 1);
#pragma unroll
    for (int Pt = 0; Pt < 8; ++Pt) { const bf16x8 v = *(const bf16x8*)(bt + Pt * 256); U.btf[Pt] = g < 2 ? v : zero8; }
    U.cp = (const bf16_t*)(ws + WS_S5CPB) + (size_t)gi * 16 * 128 + (size_t)il * 128 + 8 * g;
}
__device__ __forceinline__ void s5_load_u(bf16x8 (&ufa)[4], const bf16_t* P, int rowbase, int grp, int lane) {
    const int g = lane >> 4, il = lane & 15; const bf16x8 zero8 = {0, 0, 0, 0, 0, 0, 0, 0};
#pragma unroll
    for (int Tt = 0; Tt < 4; ++Tt) { const bf16x8 v = *(const bf16x8*)(P + (size_t)(rowbase + 16 * Tt + il) * LDP + PC_S5U + grp * 16 + 8 * (g & 1)); ufa[Tt] = g < 2 ? v : zero8; }
}
template <bool PASSC, int DIR> __device__ __forceinline__ void s5_run_unit(const S5Unit& U, const bf16x8 (&ufa)[4], f32x4 (&yacc)[4], f32x2& hout, LAS float* BU, LAS unsigned char* HW, int lane) {
    const int g = lane >> 4, il = lane & 15;
    f32x2 h = U.h; const f32x2 ab = U.ab;
    bf16x8 cpf[4];
    if (PASSC) {
#pragma unroll
        for (int ks = 0; ks < 4; ++ks) cpf[ks] = *(const bf16x8*)(U.cp + 32 * ks); }
    f32x4 d[8];
#pragma unroll
    for (int Pt = 0; Pt < 8; ++Pt) d[Pt] = MFMA16(U.btf[Pt], ufa[DIR ? 3 : 0], ((f32x4){0.f, 0.f, 0.f, 0.f}));
#pragma unroll
    for (int wi = 0; wi < 4; ++wi) {
        const int Tt = DIR ? 3 - wi : wi;
#pragma unroll
        for (int Pt = 0; Pt < 8; ++Pt) {
#pragma unroll
            for (int r = 0; r < 4; ++r) BU[(16 * Pt + 4 * g + r) * 20 + il] = d[Pt][r]; }
        asm volatile("" ::: "memory");
        if (!PASSC) {
            f32x4 br[4], bi[4];
#pragma unroll
            for (int q = 0; q < 4; ++q) { br[q] = *(const LAS f32x4*)(BU + lane * 20 + 4 * q); bi[q] = *(const LAS f32x4*)(BU + (64 + lane) * 20 + 4 * q); }
            if (wi < 3) {
#pragma unroll
                for (int Pt = 0; Pt < 8; ++Pt) d[Pt] = MFMA16(U.btf[Pt], ufa[DIR ? 2 - wi : wi + 1], ((f32x4){0.f, 0.f, 0.f, 0.f})); }
#pragma unroll
            for (int s = 0; s < 16; ++s) { const int tt = DIR ? 15 - s : s;
                const float hr = __builtin_fmaf(ab.x, h.x, __builtin_fmaf(-ab.y, h.y, br[tt >> 2][tt & 3])), hi = __builtin_fmaf(ab.x, h.y, __builtin_fmaf(ab.y, h.x, bi[tt >> 2][tt & 3]));
                h = (f32x2){hr, hi}; }
        } else {
#pragma unroll
            for (int hf2 = 0; hf2 < 2; ++hf2) { const int q0 = DIR ? 2 - 2 * hf2 : 2 * hf2;
                f32x4 br[2], bi[2];
#pragma unroll
                for (int q = 0; q < 2; ++q) { br[q] = *(const LAS f32x4*)(BU + lane * 20 + 4 * (q0 + q)); bi[q] = *(const LAS f32x4*)(BU + (64 + lane) * 20 + 4 * (q0 + q)); }
#pragma unroll
                for (int s = 0; s < 8; ++s) { const int t8 = DIR ? 7 - s : s; const int tt = 4 * q0 + t8;
                    const float hr = __builtin_fmaf(ab.x, h.x, __builtin_fmaf(-ab.y, h.y, br[t8 >> 2][t8 & 3])), hi = __builtin_fmaf(ab.x, h.y, __builtin_fmaf(ab.y, h.x, bi[t8 >> 2][t8 & 3]));
                    h = (f32x2){hr, hi};
                    *(LAS unsigned*)(HW + off_b(tt, lane >> 2) + (lane & 3) * 4) = pk2(hr, hi); }
            }
        }
        asm volatile("" ::: "memory");
        if (PASSC) {
            bf16x8 hf[4];
#pragma unroll
            for (int ks = 0; ks < 4; ++ks) hf[ks] = img_row_frag(HW, lane, 0, ks);
#pragma unroll
            for (int ks = 0; ks < 4; ++ks) yacc[Tt] = MFMA16(cpf[ks], hf[ks], yacc[Tt]);
            }
        asm volatile("" ::: "memory");
        if (PASSC && wi < 3) {
#pragma unroll
            for (int Pt = 0; Pt < 8; ++Pt) d[Pt] = MFMA16(U.btf[Pt], ufa[DIR ? 2 - wi : wi + 1], ((f32x4){0.f, 0.f, 0.f, 0.f})); }
    }
    hout = h;
}
template <bool PASSC> __device__ __forceinline__ void s5_item(const DArgs& a, unsigned char* ws, LAS unsigned char* lds, int l, int item, int ggsel, int tid) {
    const int b = item / (SNCH * 2), rem = item % (SNCH * 2), cs = rem >> 1, half = rem & 1;
    const int lane = tid & 63, w = tid >> 6, g = lane >> 4, il = lane & 15;
    const int rowbase = gla_rowbase(b, cs);
    LAS float* BU = (LAS float*)(lds + w * 14336); LAS unsigned char* HW = lds + w * 14336 + 10240;
    const bf16_t* P = (const bf16_t*)(ws + WS_P);
    f32x2* ST = (f32x2*)(ws + WS_S5ST);
    const int grp0 = 16 * half + w, grp1 = grp0 + 8;
    S5Unit UA; bf16x8 ufa[4];
    { const int gg = ggsel;
        const int grp = gg ? grp1 : grp0;
        f32x4 yacc[4];
#pragma unroll
        for (int q = 0; q < 4; ++q) yacc[q] = (f32x4){0.f, 0.f, 0.f, 0.f};
        f32x2 hend;
        s5_load_unit<PASSC>(UA, ws, P, ST, l, b, cs, rowbase, grp, 0, lane); s5_load_u(ufa, P, rowbase, grp, lane);
        s5_run_unit<PASSC, 0>(UA, ufa, yacc, hend, BU, HW, lane);
        if (!PASSC) ST[((size_t)(b * SNCH + cs) * 2 + 0) * 2048 + grp * 64 + lane] = hend;
        s5_load_unit<PASSC>(UA, ws, P, ST, l, b, cs, rowbase, grp, 1, lane);
        s5_run_unit<PASSC, 1>(UA, ufa, yacc, hend, BU, HW, lane);
        if (!PASSC) ST[((size_t)(b * SNCH + cs) * 2 + 1) * 2048 + grp * 64 + lane] = hend;
        if (PASSC) {
            const f32x4 dsk = *(const f32x4*)(a.in[I_S5D] + l * 512 + grp * 16 + 4 * g);
            bf16_t* G5 = (bf16_t*)(ws + WS_KF);
#pragma unroll
            for (int Tt = 0; Tt < 4; ++Tt) { const size_t row = (size_t)rowbase + 16 * Tt + il;
                const u32x2 ur = *(const u32x2*)(P + row * LDP + PC_S5U + grp * 16 + 4 * g), sg = *(const u32x2*)(P + row * LDP + PC_S5G + grp * 16 + 4 * g);
                const float g0 = gelu_tanh(yacc[Tt].x + bflo(ur.x) * dsk.x), g1 = gelu_tanh(yacc[Tt].y + bfhi(ur.x) * dsk.y), g2 = gelu_tanh(yacc[Tt].z + bflo(ur.y) * dsk.z), g3 = gelu_tanh(yacc[Tt].w + bfhi(ur.y) * dsk.w);
                u32x2 ov; ov.x = pk2(g0, g1); ov.y = pk2(g2, g3);
                *(u32x2*)(G5 + row * 512 + grp * 16 + 4 * g) = ov;
                ov.x = pk2(g0 * siluf_(bflo(sg.x)), g1 * siluf_(bfhi(sg.x))); ov.y = pk2(g2 * siluf_(bflo(sg.y)), g3 * siluf_(bfhi(sg.y)));
                *(u32x2*)(G5 + OBSZ + row * 512 + grp * 16 + 4 * g) = ov; }
        }
    }
}
__device__ __forceinline__ void s5_passB(unsigned char* ws, int l, int gt) {
    const int p = gt & 63, grp = (gt >> 6) & 31, dir = (gt >> 11) & 1, b = gt >> 12;
    const f32x2 a64 = ((const f32x2*)(ws + WS_S5A64))[((l * 2 + dir) * 32 + grp) * 64 + p];
    f32x2* ST = (f32x2*)(ws + WS_S5ST);
    f32x2 acc = {0.f, 0.f};
#pragma unroll 1
    for (int s0 = 0; s0 < SNCH; s0 += 34) {
        f32x2 ev[34];
#pragma unroll
        for (int j = 0; j < 34; ++j) { const int s = s0 + j; const int cs = dir == 0 ? s : (s < 4 ? 3 - s : 71 - s); ev[j] = ST[((size_t)(b * SNCH + cs) * 2 + dir) * 2048 + grp * 64 + p]; }
#pragma unroll
        for (int j = 0; j < 34; ++j) { const int s = s0 + j; const int cs = dir == 0 ? s : (s < 4 ? 3 - s : 71 - s);
            ST[((size_t)(b * SNCH + cs) * 2 + dir) * 2048 + grp * 64 + p] = acc;
            acc = (f32x2){a64.x * acc.x - a64.y * acc.y + ev[j].x, a64.x * acc.y + a64.y * acc.x + ev[j].y}; }
    }
}
constexpr int FFT_PHYS = 8448;
__device__ __forceinline__ void fft_twiddles_g(LAS f32x2* W, const f32x2* Wg, int tid) {
#pragma unroll
    for (int j = 0; j < 8; ++j) W[tid + NT * j] = Wg[tid + NT * j];
}
__device__ __forceinline__ int fphys(int i) { return i + (i >> 5); }
__device__ __forceinline__ f32x2 cmulf(const f32x2 a, const f32x2 b) { return (f32x2){a.x * b.x - a.y * b.y, a.x * b.y + a.y * b.x}; }
__device__ __forceinline__ f32x2 cmulcf(const f32x2 a, const f32x2 b) { return (f32x2){a.x * b.x + a.y * b.y, a.y * b.x - a.x * b.y}; }
template <int RL> __device__ __forceinline__ void dft_fwd_const(f32x2 (&e)[1 << RL]) {
#pragma unroll
    for (int s = 0; s < RL; ++s) { const int h = 1 << (RL - 1 - s);
#pragma unroll
        for (int m = 0; m < (1 << RL); ++m) { if (m & h) continue;
            const int mp = m & (h - 1); const f32x2 a_ = e[m], b_ = e[m | h]; const f32x2 d = a_ - b_; e[m] = a_ + b_;
            if (mp == 0) e[m | h] = d;
            else if (2 * mp == h) e[m | h] = (f32x2){d.y, -d.x};
            else { const float ang = -3.14159265358979323846f * (float)mp / (float)h; const f32x2 c = {__builtin_cosf(ang), __builtin_sinf(ang)}; e[m | h] = cmulf(d, c); } } }
}
template <int RL> __device__ __forceinline__ void dft_inv_const(f32x2 (&e)[1 << RL]) {
#pragma unroll
    for (int ss = 0; ss < RL; ++ss) { const int s = RL - 1 - ss; const int h = 1 << (RL - 1 - s);
#pragma unroll
        for (int m = 0; m < (1 << RL); ++m) { if (m & h) continue;
            const int mp = m & (h - 1); const f32x2 a_ = e[m], b_ = e[m | h]; f32x2 t;
            if (mp == 0) t = b_;
            else if (2 * mp == h) t = (f32x2){-b_.y, b_.x};
            else { const float ang = -3.14159265358979323846f * (float)mp / (float)h; const f32x2 c = {__builtin_cosf(ang), __builtin_sinf(ang)}; t = cmulcf(b_, c); }
            e[m] = a_ + t; e[m | h] = a_ - t; } }
}
template <int RL> __device__ __forceinline__ constexpr int brev_c(int m) { int r = 0; for (int i = 0; i < RL; ++i) r |= ((m >> i) & 1) << (RL - 1 - i); return r; }
template <int RL, bool CONJ> __device__ __forceinline__ void apply_tw(f32x2 (&e)[1 << RL], const f32x2 w1) {
    f32x2 tw[1 << RL];
    tw[0] = (f32x2){1.f, 0.f}; tw[1] = w1;
    if (RL >= 2) { tw[2] = cmulf(w1, w1); tw[3] = cmulf(tw[2], w1); }
    if (RL >= 3) { tw[4] = cmulf(tw[2], tw[2]); tw[5] = cmulf(tw[4], tw[1]); tw[6] = cmulf(tw[4], tw[2]); tw[7] = cmulf(tw[4], tw[3]); }
    if (RL >= 4) { tw[8] = cmulf(tw[4], tw[4]);
#pragma unroll
        for (int k = 1; k < 8; ++k) tw[8 + k] = cmulf(tw[8], tw[k]); }
#pragma unroll
    for (int m = 1; m < (1 << RL); ++m) e[m] = CONJ ? cmulcf(e[m], tw[brev_c<RL>(m)]) : cmulf(e[m], tw[brev_c<RL>(m)]);
}
template <int RL, int BETA, bool INV, class WP> __device__ __forceinline__ void fft2_pass(LAS f32x2* X, WP W, int tid) {
    constexpr int LOW = BETA - RL + 1, NG = FFTN >> RL, STR = (1 << LOW) + (1 << (LOW - 5));
#pragma unroll 1
    for (int gi = tid; gi < NG; gi += NT) {
        const int base = ((gi >> LOW) << (BETA + 1)) | (gi & ((1 << LOW) - 1));
        volatile LAS f32x2* p = X + fphys(base);
        f32x2 e[1 << RL];
#pragma unroll
        for (int m = 0; m < (1 << RL); ++m) e[m] = p[m * STR];
        const f32x2 w1 = W[(base & ((1 << LOW) - 1)) << (12 - BETA)];
        if (!INV) { dft_fwd_const<RL>(e); apply_tw<RL, false>(e, w1); }
        else { apply_tw<RL, true>(e, w1); dft_inv_const<RL>(e); }
#pragma unroll
        for (int m = 0; m < (1 << RL); ++m) p[m * STR] = e[m];
    }
}
template <class WP> __device__ __forceinline__ void fft2_fwd_ABC(LAS f32x2* X, WP W, int tid) {
    fft2_pass<4, 12, false>(X, W, tid); __syncthreads(); fft2_pass<4, 8, false>(X, W, tid); __syncthreads();
}
template <class WP> __device__ __forceinline__ void fft2_inv_CBA(LAS f32x2* X, WP W, int tid) {
    fft2_pass<4, 8, true>(X, W, tid); __syncthreads(); fft2_pass<4, 12, true>(X, W, tid); __syncthreads();
}
__device__ __forceinline__ void fft2_mid_mul(LAS f32x2* X, const f32x2* KF, int tid) {
    if (tid < 256) {
        volatile LAS f32x2* p = X + 33 * tid;
        f32x2 e[32];
#pragma unroll
        for (int m = 0; m < 32; ++m) e[m] = p[m];
        dft_fwd_const<5>(e);
#pragma unroll
        for (int q4 = 0; q4 < 4; ++q4) { f32x4 kf[4];
#pragma unroll
            for (int q = 0; q < 4; ++q) kf[q] = *(const f32x4*)(KF + 32 * tid + 8 * q4 + 2 * q);
#pragma unroll
            for (int q = 0; q < 4; ++q) { const int m = 8 * q4 + 2 * q; e[m] = cmulf(e[m], (f32x2){kf[q].x, kf[q].y}); e[m + 1] = cmulf(e[m + 1], (f32x2){kf[q].z, kf[q].w}); } }
        dft_inv_const<5>(e);
#pragma unroll
        for (int m = 0; m < 32; ++m) p[m] = e[m];
    }
}
__device__ __forceinline__ void fft2_fwd_D(LAS f32x2* X, int tid) {
    if (tid < 256) { volatile LAS f32x2* p = X + 33 * tid; f32x2 e[32];
#pragma unroll
        for (int m = 0; m < 32; ++m) e[m] = p[m];
        dft_fwd_const<5>(e);
#pragma unroll
        for (int m = 0; m < 32; ++m) p[m] = e[m]; }
}

__device__ __forceinline__ void filt_item2(const DArgs& a, unsigned char* ws, LAS unsigned char* lds, int l, int c, int tid) {
    LAS f32x2* X = (LAS f32x2*)lds; LAS f32x2* W = (LAS f32x2*)(lds + FFT_PHYS * 8); LAS float* w4s = (LAS float*)(lds + FFT_PHYS * 8 + 32768); LAS float* red = w4s + 256;
    fft_twiddles_g(W, (const f32x2*)(ws + WS_TWID), tid);
    if (tid < 128) { const int cc = tid >> 5, pr = tid & 31; const float* wsrc = a.in[I_HW4] + (size_t)l * 64 * 2048 + (cc >> 1) * 1024 + (cc & 1) * 512 + c;
        ((LAS unsigned*)w4s)[pr * 4 + cc] = pk2(wsrc[(size_t)(2 * pr) * 2048], wsrc[(size_t)(2 * pr + 1) * 2048]); }
    if (tid == 0) { float z0; asm volatile("v_mov_b32 %0, 0" : "=v"(z0)); X[fphys(4096)] = (f32x2){z0, z0}; }
    __syncthreads();
    const float dl = fabsf(HY_D0 + (HY_D1 - HY_D0) * ((float)c / 511.0f));
    const bf16_t* H3 = (const bf16_t*)(ws + WS_H3B) + (size_t)l * 4096 * 64;
    float ss0 = 0.f, ss1 = 0.f;
#pragma unroll 1
    for (int j = 0; j < 8; ++j) {
        const int t = tid + 512 * j;
        const u32x4* hr = (const u32x4*)(H3 + (size_t)t * 64);
        u32x4 hraw[8];
#pragma unroll
        for (int q = 0; q < 8; ++q) hraw[q] = hr[q];
        asm volatile("" ::: "memory");
        float f0 = 0.f, f1 = 0.f, b0 = 0.f, b1 = 0.f;
        typedef __bf16 bfp2 __attribute__((ext_vector_type(2)));
#pragma unroll
        for (int q = 0; q < 8; ++q) {
#pragma unroll
            for (int e = 0; e < 4; ++e) { const u32x4 wq = ((const LAS u32x4*)w4s)[4 * q + e]; const unsigned hx = hraw[q][e];
                f0 += bflo(hx) * bflo(wq.x) + bfhi(hx) * bfhi(wq.x); f1 += bflo(hx) * bflo(wq.y) + bfhi(hx) * bfhi(wq.y);
                b0 += bflo(hx) * bflo(wq.z) + bfhi(hx) * bfhi(wq.z); b1 += bflo(hx) * bflo(wq.w) + bfhi(hx) * bfhi(wq.w); } }
        const float dec = expf(-((float)t / 4095.0f) * dl); f0 *= dec; f1 *= dec; b0 *= dec; b1 *= dec;
        X[fphys(t)] = (f32x2){f0, f1}; ss0 += f0 * f0; ss1 += f1 * f1;
        if (t > 0) { X[fphys(8192 - t)] = (f32x2){b0, b1}; ss0 += b0 * b0; ss1 += b1 * b1; }
    }
    const float rs0 = rsqrtf(block_sum(ss0, red, tid) + EPS), rs1 = rsqrtf(block_sum(ss1, red, tid) + EPS);
#pragma unroll 4
    for (int j = 0; j < 16; ++j) { const int n = fphys(tid + 512 * j); const f32x2 x = X[n]; X[n] = (f32x2){x.x * rs0, x.y * rs1}; }
    __syncthreads(); fft2_fwd_ABC(X, W, tid); fft2_fwd_D(X, tid); __syncthreads();
    f32x2* KF0 = (f32x2*)(ws + WS_KF) + (size_t)(0 * 512 + c) * FFTN; f32x2* KF1 = (f32x2*)(ws + WS_KF) + (size_t)(1 * 512 + c) * FFTN;
#pragma unroll 4
    for (int j = 0; j < 16; ++j) { const int pos = tid + 512 * j; const int k = (int)(__brev((unsigned)pos) >> 19); const int pp = (int)(__brev((unsigned)((8192 - k) & 8191)) >> 19);
        const f32x2 za = X[fphys(pos)], zb = X[fphys(pp)];
        KF0[pos] = (f32x2){0.5f * (za.x + zb.x), 0.5f * (za.y - zb.y)};
        KF1[pos] = (f32x2){0.5f * (za.y + zb.y), 0.5f * (zb.x - za.x)}; }
    __syncthreads();
}

struct Raw8 { u32x4 mid; bf16_t lf, rt; };
__device__ __forceinline__ Raw8 ld_raw8(const bf16_t* p, int t0, int Lx) { Raw8 r; r.mid = *(const u32x4*)(p + t0); r.lf = t0 > 0 ? p[t0 - 1] : (bf16_t)0; r.rt = t0 + 8 < Lx ? p[t0 + 8] : (bf16_t)0; return r; }
__device__ __forceinline__ void sconv8(const Raw8& r, float w0, float w1, float w2, float cb, float (&o)[8]) {
    float x[10]; x[0] = bf2f(r.lf); x[9] = bf2f(r.rt);
    x[1] = bflo(r.mid.x); x[2] = bfhi(r.mid.x); x[3] = bflo(r.mid.y); x[4] = bfhi(r.mid.y); x[5] = bflo(r.mid.z); x[6] = bfhi(r.mid.z); x[7] = bflo(r.mid.w); x[8] = bfhi(r.mid.w);
#pragma unroll
    for (int i = 0; i < 8; ++i) o[i] = w0 * x[i] + w1 * x[i + 1] + w2 * x[i + 2] + cb;
}
__device__ __forceinline__ void hyena_item2(const DArgs& a, unsigned char* ws, LAS unsigned char* lds, int l, int c, int tid) {
    LAS f32x2* X = (LAS f32x2*)lds; LAS f32x2* X2 = (LAS f32x2*)(lds + FFT_PHYS * 8);
    const f32x2* Wg = (const f32x2*)(ws + WS_TWID);
    const float* cw = a.in[I_HCW] + (size_t)l * 3 * 1536; const float* cbp = a.in[I_HCB] + (size_t)l * 1536;
    const float wv0 = cw[c], wv1 = cw[1536 + c], wv2 = cw[3072 + c], bv = cbp[c];
    const float wa0 = cw[512 + c], wa1 = cw[1536 + 512 + c], wa2 = cw[3072 + 512 + c], ba = cbp[512 + c];
    const float wb0 = cw[1024 + c], wb1 = cw[1536 + 1024 + c], wb2 = cw[3072 + 1024 + c], bb = cbp[1024 + c];
    const float bias0 = a.in[I_HBIAS][(l * 2 + 0) * 512 + c], bias1 = a.in[I_HBIAS][(l * 2 + 1) * 512 + c];
    const bf16_t* PT = (const bf16_t*)(ws + WS_PT);
    const bf16_t* pv = PT + (size_t)(PT_V + c) * MR; const bf16_t* pg1 = PT + (size_t)(PT_G1 + c) * MR; const bf16_t* pg2 = PT + (size_t)(PT_G2 + c) * MR; const bf16_t* phg = PT + (size_t)(PT_HG + c) * MR;
    const f32x2* KF0 = (const f32x2*)(ws + WS_KF) + (size_t)(0 * 512 + c) * FFTN; const f32x2* KF1 = (const f32x2*)(ws + WS_KF) + (size_t)(1 * 512 + c) * FFTN;
    const int t0 = 8 * tid;
    const int po = 8 * tid + (tid >> 2);
    LAS f32x2* px = X + po; LAS f32x2* py = X2 + po;
    float z[4][8];
    { Raw8 v[4];
#pragma unroll
      for (int b = 0; b < 4; ++b) v[b] = ld_raw8(pv + b * SEQL, t0, SEQL);
#pragma unroll
      for (int b = 0; b < 4; ++b) sconv8(v[b], wv0, wv1, wv2, bv, z[b]); }
    Raw8 g1r[4];
#pragma unroll
    for (int b = 0; b < 4; ++b) g1r[b] = ld_raw8(pg1 + b * SEQL, t0, SEQL);
#pragma unroll
    for (int x = 0; x < 8; ++x) { px[x] = (f32x2){z[0][x], z[1][x]}; px[4224 + x] = (f32x2){0.f, 0.f}; py[x] = (f32x2){z[2][x], z[3][x]}; py[4224 + x] = (f32x2){0.f, 0.f}; }
    __syncthreads();
#define HY_CONV(KFp) do { \
        fft2_pass<4, 12, false>(X, Wg, tid); fft2_pass<4, 12, false>(X2, Wg, tid); __syncthreads(); \
        fft2_pass<4, 8, false>(X, Wg, tid); fft2_pass<4, 8, false>(X2, Wg, tid); __syncthreads(); \
        fft2_mid_mul(tid < 256 ? X : X2, KFp, tid & 255); __syncthreads(); \
        fft2_pass<4, 8, true>(X, Wg, tid); fft2_pass<4, 8, true>(X2, Wg, tid); __syncthreads(); \
        fft2_pass<4, 12, true>(X, Wg, tid); fft2_pass<4, 12, true>(X2, Wg, tid); __syncthreads(); } while (0)
    HY_CONV(KF0);
    { float g[4][8];
#pragma unroll
      for (int b = 0; b < 4; ++b) sconv8(g1r[b], wa0, wa1, wa2, ba, g[b]);
#pragma unroll
      for (int x = 0; x < 8; ++x) { const f32x2 c0 = px[x] * (1.0f / 8192.0f), c1 = py[x] * (1.0f / 8192.0f);
          z[0][x] = g[0][x] * (c0.x + bias0 * z[0][x]); z[1][x] = g[1][x] * (c0.y + bias0 * z[1][x]); z[2][x] = g[2][x] * (c1.x + bias0 * z[2][x]); z[3][x] = g[3][x] * (c1.y + bias0 * z[3][x]); } }
    Raw8 g2r[4]; u32x4 hgr[4];
#pragma unroll
    for (int b = 0; b < 4; ++b) { g2r[b] = ld_raw8(pg2 + b * SEQL, t0, SEQL); hgr[b] = *(const u32x4*)(phg + b * SEQL + t0); }
    __syncthreads();
#pragma unroll
    for (int x = 0; x < 8; ++x) { px[x] = (f32x2){z[0][x], z[1][x]}; px[4224 + x] = (f32x2){0.f, 0.f}; py[x] = (f32x2){z[2][x], z[3][x]}; py[4224 + x] = (f32x2){0.f, 0.f}; }
    __syncthreads();
    HY_CONV(KF1);
#undef HY_CONV
    bf16_t* pvw = (bf16_t*)(ws + WS_PT) + (size_t)(PT_V + c) * MR;
#pragma unroll
    for (int b = 0; b < 4; ++b) { float g[8], hh[8], o[8]; sconv8(g2r[b], wb0, wb1, wb2, bb, g); unpack8(hgr[b], hh);
#pragma unroll
        for (int x = 0; x < 8; ++x) { const f32x2 cv = ((b < 2) ? px[x] : py[x]) * (1.0f / 8192.0f); const float cvv = (b & 1) ? cv.y : cv.x;
            o[x] = g[x] * (cvv + bias1 * z[b][x]) * siluf_(hh[x]); }
        *(u32x4*)(pvw + b * SEQL + t0) = pack8(o); }
    __syncthreads();
}
__device__ __forceinline__ void hy_transpose_item(unsigned char* ws, LAS unsigned char* lds, int item, int tid, int nrows) {
    const int lane = tid & 63, w = tid >> 6;
    const int wi = item * 8 + w;
    const int nrb = nrows / 64;
    if (wi >= nrb * 8) return;
    const int rb = wi >> 3, cb = wi & 7;
    LAS bf16_t* T = (LAS bf16_t*)(lds + w * 8704);
    const bf16_t* src = (const bf16_t*)(ws + WS_PT) + (size_t)(PT_V + cb * 64) * MR + (size_t)rb * 64;
    u32x4 tv[8];
#pragma unroll
    for (int i = 0; i < 8; ++i) { const int c = 8 * i + (lane >> 3), r8 = (lane & 7) * 8; tv[i] = *(const u32x4*)(src + (size_t)c * MR + r8); }
#pragma unroll
    for (int i = 0; i < 8; ++i) { const int c = 8 * i + (lane >> 3), r8 = (lane & 7) * 8;
        LAS unsigned* d = (LAS unsigned*)(T + c * 66 + r8); d[0] = tv[i].x; d[1] = tv[i].y; d[2] = tv[i].z; d[3] = tv[i].w; }
    asm volatile("s_waitcnt lgkmcnt(0)" ::: "memory");
    bf16_t* dst = (bf16_t*)(ws + WS_H) + (size_t)(rb * 64) * D + 512 + cb * 64;
#pragma unroll 4
    for (int i = 0; i < 8; ++i) { const int r = 8 * i + (lane >> 3), c8 = (lane & 7) * 8;
        unsigned short e[8];
#pragma unroll
        for (int x = 0; x < 8; ++x) e[x] = T[(c8 + x) * 66 + r];
        u32x4 o; o.x = e[0] | ((unsigned)e[1] << 16); o.y = e[2] | ((unsigned)e[3] << 16); o.z = e[4] | ((unsigned)e[5] << 16); o.w = e[6] | ((unsigned)e[7] << 16);
        *(u32x4*)(dst + (size_t)r * D + c8) = o; }
    asm volatile("s_waitcnt lgkmcnt(0)" ::: "memory");
}
#ifndef MK_EN
#define MK_EN 0xffff
#endif
#define EN(x) ((MK_EN >> (x)) & 1)
constexpr int PH_PREP = 0, PH_PER_LAYER = 7, PH_FNORM = 1 + 2 * PH_PER_LAYER, N_PHASES = PH_FNORM + 1;

__global__ void __launch_bounds__(NT, 2) fwd_kernel(Args ka) {
    extern __shared__ __attribute__((aligned(16))) unsigned char lds_raw[];
    LAS unsigned char* lds = (LAS unsigned char*)lds_raw;
    const int G = gridDim.x;
    volatile LAS unsigned* bst = (volatile LAS unsigned*)(lds + LDS_CTL_OFF);
    if (threadIdx.x < 16) bst[threadIdx.x] = 0u;
    if (threadIdx.x == 0) { LAS unsigned long long* tab = (LAS unsigned long long*)(lds + LDS_PTR_OFF);
#pragma unroll
        for (int i = 0; i < N_IN; ++i) tab[i] = (unsigned long long)ka.in[i]; }
    __syncthreads();

    XcdBarrier gbar; gbar.bar = (unsigned*)(ka.ws + WS_CTL); gbar.x = 0; gbar.st = bst;
    if (ka.ph_hi - ka.ph_lo > 1) gbar = xcd_barrier_post((unsigned*)(ka.ws + WS_CTL), bst);

#ifdef REP_SUB
    int repmask = 0;
#endif
    for (int ph = ka.ph_lo; ph < ka.ph_hi; ++ph) {
        int tid = threadIdx.x; asm volatile("" : "+v"(tid));
        int bid = blockIdx.x; asm volatile("" : "+s"(bid));
#define LANE_WAVE() int tid2_ = threadIdx.x; asm volatile("" : "+v"(tid2_)); const int lane = tid2_ & 63, wave = __builtin_amdgcn_readfirstlane(tid2_ >> 6)
        __attribute__((address_space(1))) unsigned char* wsg_ = (__attribute__((address_space(1))) unsigned char*)ka.ws; asm volatile("" : "+s"(wsg_)); unsigned char* ws = (unsigned char*)wsg_;
        __attribute__((address_space(1))) float* outg_ = (__attribute__((address_space(1))) float*)ka.out; asm volatile("" : "+s"(outg_)); float* outp_ = (float*)outg_;
        DArgs a; a.in.t = (const LAS unsigned long long*)(lds + LDS_PTR_OFF); a.out = outp_;
        float* MOD = (float*)(ws + WS_MOD);
        if (EN(0) && ph == PH_PREP) {
            for (int it = bid; it < 1048 + 544 + 8; it += G) {
                int tid = threadIdx.x; asm volatile("" : "+v"(tid));
                __syncthreads();
                if (it < 768) prep_adaln(a.in[I_C], a.in[I_CCTX], a.in[I_ADAW], a.in[I_ADAB], MOD, it, (LAS float*)lds, tid);
                else if (it < 784) prep_s5b(a, ws, it - 768, tid);
                else if (it >= 1048 + 544) { const int j = (it - 1592) * NT + tid; float sn, cs; sincospif(-(float)j * (1.0f / 4096.0f), &sn, &cs); ((f32x2*)(ws + WS_TWID))[j] = (f32x2){cs, sn}; }
                else if (it >= 1048) prep_rope((f32x2*)(ws + WS_ROPE), it - 1048, tid);
                else { const bool big = it < 1040; const int r = big ? it - 784 : it - 1040, l = big ? (r >> 7) : 0, t0 = (big ? (r & 127) : r) * 32;
                    float* H3o = big ? (float*)(ws + WS_H3) + (size_t)l * 4096 * 64 : (float*)(ws + WS_H3C);
                    bf16_t* H3b = big ? (bf16_t*)(ws + WS_H3B) + (size_t)l * 4096 * 64 : (bf16_t*)nullptr;
                    prep_hymlp(a, H3o, H3b, l, big ? 4096 : 256, t0, lds, tid); }
            }
        } else if (EN(1) && ph == PH_FNORM) {
            const float* fw = a.in[I_FNW]; LANE_WAVE();
            for (int row = bid * NWAVES + wave; row < NLAT; row += G * NWAVES) {
                float* xr = a.out + (size_t)row * D; f32x4 v[8]; float ss = 0.f;
#pragma unroll
                for (int j = 0; j < 8; ++j) { v[j] = ((const f32x4*)xr)[lane + 64 * j]; ss += (v[j].x * v[j].x + v[j].y * v[j].y) + (v[j].z * v[j].z + v[j].w * v[j].w); }
                const float rstd = rsqrtf(wave_sum(ss) * (1.0f / D) + EPS);
#pragma unroll
                for (int j = 0; j < 8; ++j) { const f32x4 w = *(const f32x4*)(fw + 4 * (lane + 64 * j)); ((f32x4*)xr)[lane + 64 * j] = v[j] * rstd * w; }
            }
        } else {
            const int l = (ph - 1) / PH_PER_LAYER, sub = (ph - 1) % PH_PER_LAYER;

            const bool ctx_out = (l == 0);
            const int Mrows = ctx_out ? MR : NLAT;
            if (EN(2) && sub == 0) {
                LANE_WAVE();
                LAS float* scr = (LAS float*)(lds + wave * 8704);
                const int gw = bid * NWAVES + wave, NGW = G * NWAVES;
                constexpr int I_W1 = 32 * (NPAD / 32), I_W2 = 32 * 64, I_W3 = 8 * 16;
                for (int it = (l == 0 ? gw : gw + I_W1); it < I_W1 + I_W2 + I_W3; it += NGW) {
                    int r = it;
                    if (r < I_W1) { const int kb = r / (NPAD / 32), nb = r % (NPAD / 32); transpose_item(a.in[I_WIN] + (size_t)l * D * INW, INW, win_srccol(nb * 32 + (lane & 31)), kb * 64, (bf16_t*)(ws + WS_WIN), D, nb * 32, scr, lane); continue; }
                    r -= I_W1;
                    if (r < I_W2) { const int kb = r / 64, nb = r % 64; transpose_item(a.in[I_WOUT] + (size_t)l * D * D, D, nb * 32 + (lane & 31), kb * 64, (bf16_t*)(ws + WS_WOUT), D, nb * 32, scr, lane); continue; }
                    r -= I_W2;
                    { const int kb = r / 16, nb = r % 16; transpose_item(a.in[I_GLUW] + (size_t)l * 512 * 512, 512, nb * 32 + (lane & 31), kb * 64, (bf16_t*)(ws + WS_GLUW), 512, nb * 32, scr, lane); }
                }
                const float* nw = a.in[I_NORMW] + (size_t)l * D;
                for (int row = gw; row < MR; row += NGW) {
                    const float* xr; int v;
                    if (row < NLAT) { xr = (l == 0 ? a.in[I_X] : a.out) + (size_t)row * D; v = row >> 12; }
                    else { xr = (l == 0 ? a.in[I_CTX] : (const float*)(ws + WS_XC1)) + (size_t)(row - NLAT) * D; v = 4; }
                    norm_row(xr, nw, MOD + (size_t)(l * 5 + v) * ADA, (bf16_t*)(ws + WS_H) + (size_t)row * D, lane);
                }
                __syncthreads();
                const int nfilt = ctx_out ? 1024 : 0;
                for (int it = bid; it < nfilt; it += G) { int tid = threadIdx.x; asm volatile("" : "+v"(tid)); __syncthreads(); if (it < 512) filt_item2(a, ws, lds, l, it, tid); else filt_ctx_item(a, ws, lds, it - 512, tid);
#if defined(REP_ITEM) && REP_ITEM == 10
                    __syncthreads(); if (it < 512) filt_item2(a, ws, lds, l, it, tid);
#endif
                }
            } else if (EN(3) && sub == 1) {
                pg8::Gemm g{(const bf16_t*)(ws + WS_H), (const bf16_t*)(ws + WS_WIN), MR, NPAD, D}; pg8::StaticOrder S; S.init(MR, NPAD, G, bid);
                EpiInProj E{(bf16_t*)(ws + WS_P), (bf16_t*)(ws + WS_PT), (float*)(ws + WS_LR), (const float*)(ws + WS_ROPE)};
                { pg8::InProjOrder S1; S1.init(ctx_out ? 0 : 1, G, bid); pg8::gemm_phase<EpiInProj, pg8::InProjOrder, true, true>(lds, g, S1, E, tid); }
            } else if (EN(5) && sub == 2) {
                const int nit = ctx_out ? 3744 : 3232;
                for (int it = bid; it < nit; it += G) {
                    int tid = threadIdx.x; asm volatile("" : "+v"(tid));
                    __syncthreads();
                    if (it < 512) hyena_item2(a, ws, lds, l, it, tid);
                    else if (it < 1600) s5_item<false>(a, ws, lds, l, (it - 512) >> 1, (it - 512) & 1, tid);
                    else if (it < 2144) ret_passA(ws, lds, it - 1600, tid);
                    else if (it < 3232) gla_passA(a, ws, lds, l, it - 2144, tid);
                    else hyena_ctx_item(a, ws, lds, it - 3232, tid);
                }
            } else if (EN(9) && sub == 3) {
                for (int it = bid; it < 256; it += G) { int tid = threadIdx.x; asm volatile("" : "+v"(tid)); __syncthreads(); hy_transpose_item(ws, lds, it, tid, NLAT); }
                for (int it = bid; it < 224; it += G) { int tid = threadIdx.x; asm volatile("" : "+v"(tid)); __syncthreads();
                    if (it < 128) ret_passB(ws, it * NT + tid);
                    else if (it < 192) gla_passB(ws, lds, it - 128, tid);
                    else s5_passB(ws, l, (it - 192) * NT + tid); }
            } else if (EN(6) && sub == 4) {
                const int nsc = ctx_out ? 1088 : 1024, nrc = ctx_out ? 16 * RNCH : 16 * 32, ngc = ctx_out ? 16 * GNCH : 16 * 64;
                for (int it = bid; it < nsc; it += G) { int tid = threadIdx.x; asm volatile("" : "+v"(tid)); __syncthreads();
                    const int i2 = it >> 1; const int item = ctx_out ? i2 : (i2 >> 7) * (SNCH * 2) + 8 + (i2 & 127); s5_item<true>(a, ws, lds, l, item, it & 1, tid); }
                for (int it = (bid + 64) % G; it < nrc; it += G) { int tid = threadIdx.x; asm volatile("" : "+v"(tid)); __syncthreads();
                    const int item = ctx_out ? it : (it >> 5) * RNCH + 2 + (it & 31); ret_passC(a, ws, lds, l, item, tid); }
                for (int it = (bid + 128) % G; it < ngc; it += G) { int tid = threadIdx.x; asm volatile("" : "+v"(tid)); __syncthreads();
                    const int item = ctx_out ? it : (it >> 6) * GNCH + 4 + (it & 63); gla_passC(a, ws, lds, l, item, tid); }
            } else if (EN(7) && sub == 5) {
                pg8::Gemm g{(const bf16_t*)(ws + WS_KF), (const bf16_t*)(ws + WS_GLUW), Mrows, 512, 512}; pg8::StaticOrder S; S.init(Mrows, 512, G, bid);
                EpiGlu E{(const bf16_t*)(ws + WS_KF) + OBSZ, (bf16_t*)(ws + WS_H), a.in[I_GLUB] + (size_t)l * 512};
                pg8::gemm_phase<EpiGlu, pg8::StaticOrder, true, true>(lds, g, S, E, tid);
                if (l == 0 && bid >= 136) {
                    LANE_WAVE(); LAS float* scr = (LAS float*)(lds + wave * 8704);
                    for (int r = (bid - 136) * NWAVES + wave; r < 32 * (NPAD / 32); r += (G - 136) * NWAVES) { const int kb = r / (NPAD / 32), nb = r % (NPAD / 32);
                        transpose_item(a.in[I_WIN] + (size_t)1 * D * INW, INW, win_srccol(nb * 32 + (lane & 31)), kb * 64, (bf16_t*)(ws + WS_WIN), D, nb * 32, scr, lane); }
                }
            } else if (EN(8)) {
                pg8::Gemm g{(const bf16_t*)(ws + WS_H), (const bf16_t*)(ws + WS_WOUT), Mrows, D, D}; pg8::StaticOrder S; S.init(Mrows, D, G, bid);
                EpiOut E{l == 0 ? a.in[I_X] : a.out, a.in[I_CTX], a.out, (float*)(ws + WS_XC1), MOD + (size_t)l * 5 * ADA};
                pg8::gemm_phase<EpiOut, pg8::StaticOrder, true, true>(lds, g, S, E, tid);
                if (l == 0 && bid >= 32) {
                    for (int it = bid - 32; it < 512; it += G - 32) { int tid2 = threadIdx.x; asm volatile("" : "+v"(tid2)); __syncthreads(); filt_item2(a, ws, lds, 1, it, tid2); }
                }
            }
        }
#ifdef REP_SUB
        if (ph != PH_PREP && ph != PH_FNORM && ((ph - 1) % PH_PER_LAYER) == REP_SUB && !((repmask >> ((ph - 1) / PH_PER_LAYER)) & 1)) { repmask |= 1 << ((ph - 1) / PH_PER_LAYER); xcd_barrier(gbar); --ph; continue; }
#endif
        if (ph + 1 < ka.ph_hi) xcd_barrier(gbar);
    }
}

#ifndef MK_LAUNCH_PER_PHASE
#define MK_LAUNCH_PER_PHASE 0
#endif
extern "C" void kernel_launch(void* const* d_in, const int* in_sizes, int n_in, void* d_out, int out_size, void* d_ws, size_t ws_size, hipStream_t stream) {
    static int grid = 0;
    if (grid == 0) {
        if (n_in != N_IN || out_size != NLAT * D || ws_size < WS_END2) { fprintf(stderr, "kernel_launch: unexpected shapes (n_in %d, out %d, ws %zu < %zu); nothing launched\n", n_in, out_size, ws_size, (size_t)WS_END2); grid = -1; return; }
        int dev = 0, cus = 0, per_cu = 0;
        if (hipGetDevice(&dev) != hipSuccess || hipDeviceGetAttribute(&cus, hipDeviceAttributeMultiprocessorCount, dev) != hipSuccess) { grid = -1; return; }
        if (hipFuncSetAttribute((const void*)fwd_kernel, hipFuncAttributeMaxDynamicSharedMemorySize, LDS_BYTES) != hipSuccess) { fprintf(stderr, "kernel_launch: hipFuncSetAttribute failed\n"); grid = -1; return; }
        if (hipOccupancyMaxActiveBlocksPerMultiprocessor(&per_cu, (const void*)fwd_kernel, NT, LDS_BYTES) != hipSuccess || per_cu < 1) { fprintf(stderr, "kernel_launch: occupancy query says %d blocks per CU\n", per_cu); per_cu = 1; }
        (void)hipGetLastError();
        grid = cus;
    }
    if (grid < 0) return;
    (void)hipMemsetAsync((char*)d_ws + WS_CTL, 0, WS_ZERO_BYTES, stream);
    Args a{};
    for (int i = 0; i < N_IN; ++i) a.in[i] = (const float*)d_in[i];
    a.out = (float*)d_out; a.ws = (unsigned char*)d_ws;
#if MK_LAUNCH_PER_PHASE
    for (int ph = 0; ph < N_PHASES; ++ph) {
        a.ph_lo = ph; a.ph_hi = ph + 1;
        hipLaunchKernelGGL(fwd_kernel, dim3(grid), dim3(NT), LDS_BYTES, stream, a);
    }
#else
    a.ph_lo = 0; a.ph_hi = N_PHASES;
    void* args[] = {&a};
    hipError_t e = hipLaunchCooperativeKernel((const void*)fwd_kernel, dim3(grid), dim3(NT), args, LDS_BYTES, stream);
    if (e != hipSuccess) fprintf(stderr, "kernel_launch: cooperative launch failed: %s (grid %d)\n", hipGetErrorString(e), grid);
#endif
}
```

```cpp
#include <hip/hip_runtime.h>
#include <hip/hip_cooperative_groups.h>
#include <cstdio>
#include <cstdint>
namespace cg = cooperative_groups;

#define LAS __attribute__((address_space(3)))
typedef unsigned short bf16_t;
typedef float f32x4 __attribute__((ext_vector_type(4)));
typedef float f32x2 __attribute__((ext_vector_type(2)));
typedef unsigned u32x4 __attribute__((ext_vector_type(4)));
typedef unsigned u32x2 __attribute__((ext_vector_type(2)));

constexpr int D = 2048, NB = 4, SEQL = 4096, LC = 256, NLAT = NB * SEQL, NCTX = NB * LC, MR = NLAT + NCTX;
constexpr int BR = 512, INW = 6688, NPAD = 6912, LDP = 4608, ADA = 3 * D;
constexpr int NT = 512, NWAVES = 8;
constexpr float EPS = 1e-6f;
constexpr int PC_S5U = 0, PC_S5G = 512, PC_RQ = 1024, PC_RK = 1536, PC_RV = 2048, PC_RG = 2560, PC_GQ = 3072, PC_GK = 3328, PC_GV = 3584, PC_GG = 4096;
constexpr int PT_V = 0, PT_G1 = 512, PT_G2 = 1024, PT_HG = 1536;
constexpr int FFTN = 8192;

enum { I_X = 0, I_C, I_CTX, I_CCTX, I_NORMW, I_ADAW, I_ADAB, I_WIN, I_WOUT, I_S5ARE, I_S5AIM, I_S5LDT, I_S5BRE, I_S5BIM, I_S5CRE, I_S5CIM,
       I_S5D, I_GLUW, I_GLUB, I_HCW, I_HCB, I_HW1, I_HB1, I_HF1, I_HW2, I_HB2, I_HF2, I_HW3, I_HB3, I_HF3, I_HW4, I_HBIAS, I_RNW, I_GGW, I_GGB, I_GNW, I_FNW, N_IN };

constexpr size_t al256(size_t x) { return (x + 255) & ~(size_t)255; }
constexpr size_t WS_CTL  = 0;
constexpr size_t WS_MOD  = WS_CTL + 65536;
constexpr size_t WS_ZERO_BYTES = 65536 + al256((size_t)2 * 5 * ADA * 4);
constexpr size_t WS_S5AB = WS_MOD + al256((size_t)2 * 5 * ADA * 4);
constexpr size_t WS_S5BT = WS_S5AB + (size_t)2 * 2 * 32 * 64 * 8;
constexpr size_t WS_H3   = WS_S5BT + (size_t)1048576 + 65536;
constexpr size_t WS_H3C  = WS_H3 + (size_t)2 * 4096 * 64 * 4;
constexpr size_t WS_KC   = WS_H3C + (size_t)256 * 64 * 4;
constexpr size_t WS_LR   = WS_KC + (size_t)2 * 512 * 512 * 4;
constexpr size_t WS_XC1  = WS_LR + (size_t)MR * 32 * 4;
constexpr size_t WS_WOUT = WS_XC1 + (size_t)NCTX * D * 4;
constexpr size_t WS_GLUW = WS_WOUT + (size_t)D * D * 2;
constexpr size_t WS_WIN  = WS_GLUW + (size_t)512 * 512 * 2;
constexpr size_t WS_H    = WS_WIN + (size_t)NPAD * D * 2;
constexpr size_t WS_P    = WS_H + (size_t)MR * D * 2;
constexpr size_t WS_PT   = WS_P + (size_t)MR * LDP * 2;
constexpr size_t WS_KF   = WS_PT + (size_t)2048 * MR * 2;
constexpr size_t WS_OB   = WS_KF + (size_t)2 * 512 * FFTN * 8;
constexpr size_t WS_END  = WS_OB + (size_t)6 * MR * 512 * 2;
constexpr size_t OBSZ = (size_t)MR * 512;

constexpr int LDS_CTL_OFF = 135168 + 1024;
constexpr int LDS_PTR_OFF = LDS_CTL_OFF + 64;
constexpr int LDS_BYTES = LDS_PTR_OFF + 320;

typedef __bf16 hwbf16x2 __attribute__((ext_vector_type(2)));
__device__ __forceinline__ unsigned pk2(float lo, float hi) { const f32x2 v = {lo, hi}; return __builtin_bit_cast(unsigned, __builtin_convertvector(v, hwbf16x2)); }
__device__ __forceinline__ unsigned f2bf(float f) { return pk2(f, 0.f) & 0xffffu; }
__device__ __forceinline__ float bf2f(bf16_t b) { return __uint_as_float((unsigned)b << 16); }
__device__ __forceinline__ float bflo(unsigned w) { return __uint_as_float(w << 16); }
__device__ __forceinline__ float bfhi(unsigned w) { return __uint_as_float(w & 0xffff0000u); }
__device__ __forceinline__ void unpack8(const u32x4 r, float (&f)[8]) { f[0] = bflo(r.x); f[1] = bfhi(r.x); f[2] = bflo(r.y); f[3] = bfhi(r.y); f[4] = bflo(r.z); f[5] = bfhi(r.z); f[6] = bflo(r.w); f[7] = bfhi(r.w); }
__device__ __forceinline__ u32x4 pack8(const float (&f)[8]) { u32x4 o; o.x = pk2(f[0], f[1]); o.y = pk2(f[2], f[3]); o.z = pk2(f[4], f[5]); o.w = pk2(f[6], f[7]); return o; }
__device__ __forceinline__ float sigmoidf_(float x) { return __builtin_amdgcn_rcpf(1.0f + __expf(-x)); }
__device__ __forceinline__ float siluf_(float x) { return x * sigmoidf_(x); }
__device__ __forceinline__ float gelu_tanh(float x) { const float u2 = 1.5957691216057308f * (x + 0.044715f * x * x * x); return x * sigmoidf_(u2); }
__device__ __forceinline__ float wave_sum(float v) {
#pragma unroll
    for (int o = 1; o < 64; o <<= 1) v += __shfl_xor(v, o);
    return v;
}
#define LDS_WAIT() asm volatile("s_waitcnt lgkmcnt(0)" ::: "memory")

struct Args { const float* in[N_IN]; float* out; unsigned char* ws; int ph_lo, ph_hi; };
struct InTab { const LAS unsigned long long* t;
    __device__ __forceinline__ const float* operator[](int i) const { const unsigned long long v = t[i];
        const unsigned lo = __builtin_amdgcn_readfirstlane((unsigned)v), hi = __builtin_amdgcn_readfirstlane((unsigned)(v >> 32)); return (const float*)(__attribute__((address_space(1))) const float*)(((unsigned long long)hi << 32) | lo); } };
struct DArgs { InTab in; float* out; };

#define XB_TMO      128
#define XB_XCNT(j)  (256  + 64 * (j))
#define XB_XSUB(j)  (1280 + 64 * (j))
#define XB_XGEN(j)  (2304 + 64 * (j))
#define XB_TOP      3328
#define XB_TOPGEN   3392
#define XCD_BAR_WORDS 3456
#define XB_SPIN_CAP (1u << 22)
__device__ __forceinline__ unsigned xb_ld(unsigned* p)              { return __hip_atomic_load(p, __ATOMIC_RELAXED, __HIP_MEMORY_SCOPE_AGENT); }
__device__ __forceinline__ unsigned xb_add(unsigned* p, unsigned v) { return __hip_atomic_fetch_add(p, v, __ATOMIC_RELAXED, __HIP_MEMORY_SCOPE_AGENT); }
__device__ __forceinline__ unsigned xb_xcc_id() { return (unsigned)__builtin_amdgcn_s_getreg((3 << 11) | 20) & 0xFu; }
#define XB_SPIN(cond, bar) do { unsigned _sp = 0; while (cond) { __builtin_amdgcn_s_sleep(1); \
    if ((++_sp & 255u) == 0u) { if (xb_ld(&(bar)[XB_TMO])) break; if (_sp > XB_SPIN_CAP) { atomicAdd(&(bar)[XB_TMO], 1u); break; } } } } while (0)
struct XcdBarrier { unsigned* bar; unsigned x; volatile LAS unsigned* st; };
__device__ __forceinline__ XcdBarrier xcd_barrier_post(unsigned* bar, volatile LAS unsigned* st) {
    XcdBarrier b; b.bar = bar; b.x = xb_xcc_id(); b.st = st;
    if (threadIdx.x == 0) (void)xb_add(&bar[XB_XCNT(b.x)], 1u);
    return b;
}
__device__ __forceinline__ void xcd_barrier_complete(unsigned* bar, unsigned x, unsigned& nloc, unsigned& nx) {
    const unsigned G = gridDim.x * gridDim.y * gridDim.z;
    unsigned sum, cnt, mine, sp = 0u;
    for (;;) {
        sum = 0u; cnt = 0u; mine = 0u;
#pragma unroll
        for (unsigned j = 0; j < 16; ++j) { const unsigned c = xb_ld(&bar[XB_XCNT(j)]); sum += c; cnt += (c > 0u) ? 1u : 0u; mine = (j == x) ? c : mine; }
        if (sum == G) break;
        __builtin_amdgcn_s_sleep(1);
        if ((++sp & 255u) == 0u) { if (xb_ld(&bar[XB_TMO])) break; if (sp > XB_SPIN_CAP) { atomicAdd(&bar[XB_TMO], 1u); break; } }
    }
    nloc = mine > 0u ? mine : 1u; nx = cnt > 0u ? cnt : 1u;
}
__device__ __forceinline__ void xcd_barrier(const XcdBarrier& b) {
    asm volatile("s_waitcnt vmcnt(0)" ::: "memory");
    __syncthreads();
    if (threadIdx.x == 0) {
        unsigned* bar = b.bar;
        __builtin_amdgcn_s_waitcnt(0);
        unsigned nloc = b.st[0], nx = b.st[1];
        if (nloc == 0u) { xcd_barrier_complete(bar, b.x, nloc, nx); b.st[0] = nloc; b.st[1] = nx; }
        const unsigned old = xb_add(&bar[XB_XSUB(b.x)], 1u);
        const unsigned gen = old / nloc;
        if (old + 1u == (gen + 1u) * nloc) {
            __builtin_amdgcn_fence(__ATOMIC_RELEASE, "agent");
            asm volatile("s_waitcnt vmcnt(0)" ::: "memory");
            const unsigned og = xb_add(&bar[XB_TOP], 1u);
            const unsigned tg = og / nx;
            if (og + 1u == (tg + 1u) * nx) xb_add(&bar[XB_TOPGEN], 1u);
            else XB_SPIN(xb_ld(&bar[XB_TOPGEN]) == tg, bar);
            __builtin_amdgcn_fence(__ATOMIC_ACQUIRE, "agent");
            xb_add(&bar[XB_XGEN(b.x)], 1u);
            asm volatile("s_waitcnt vmcnt(0)" ::: "memory");
        } else {
            XB_SPIN(xb_ld(&bar[XB_XGEN(b.x)]) == gen, bar);
            __builtin_amdgcn_fence(__ATOMIC_ACQUIRE, "agent");
            asm volatile("s_waitcnt vmcnt(0)" ::: "memory");
        }
    }
    __syncthreads();
}
namespace pg8 {
#define PG8_LAS __attribute__((address_space(3)))
typedef unsigned short bf16_t;
typedef short bf16x8 __attribute__((ext_vector_type(8)));
typedef float f32x4 __attribute__((ext_vector_type(4)));
typedef unsigned u32x4 __attribute__((ext_vector_type(4)));
constexpr int BM = 256, BK = 64, HALF = 128, HTB = HALF * BK * 2, STAGE_BYTES = 8 * HTB, NXCD = 8, WGM = 8;

__host__ __device__ __forceinline__ int lds_byte(int r, int c) { const int st = (r >> 4) * 2 + (c >> 5), rr = r & 15, cc = c & 31, ob = rr * 64 + cc * 2; return st * 1024 + (ob ^ (((ob >> 9) & 1) << 5)); }
__host__ __device__ __forceinline__ void stage_rc(int b, int& R, int& C) { const int st = b / 1024, sb = b % 1024, swz = sb ^ (((sb >> 9) & 1) << 5); R = (st >> 1) * 16 + swz / 64; C = (st & 1) * 32 + (swz % 64) / 2; }
__host__ __device__ __forceinline__ int perm32(int rho) { const int n = rho >> 4, i = rho & 15; return 8 * (i >> 2) + 4 * n + (i & 3); }

struct Unit { int pm, pn; };
struct Gemm { const bf16_t* A; const bf16_t* Bt; int M, N, K; };

struct StaticOrder {
    int nM, nN, nwg, G, c;
    __host__ __device__ void init(int M, int N, int G_, int c_) { nM = M / BM; nN = N / BM; nwg = nM * nN; G = G_; c = c_; }
    __host__ __device__ bool next(int i, Unit& u) const {
        const long L = (long)i * G + c; if (L >= nwg) return false;
        int wgid = (int)L; { const int q = nwg / NXCD, r = nwg % NXCD, xcd = wgid % NXCD, off = wgid / NXCD; wgid = (xcd < r ? xcd * (q + 1) : r * (q + 1) + (xcd - r) * q) + off; }
        const int nig = WGM * nN, gid = wgid / nig, fm = gid * WGM, gsz = (nM - fm) < WGM ? (nM - fm) : WGM;
        u.pm = fm + ((wgid % nig) % gsz); u.pn = (wgid % nig) / gsz; return true;
    }
    __device__ __forceinline__ void a_ready(const Unit&) const {}
    __device__ __forceinline__ void done(const Unit&) const {}
};


struct InProjOrder {
    StaticOrder base; int G, c, last;
    __host__ __device__ void init(int last_, int G_, int c_) { last = last_; base.init((last_ ? 64 : 68) * 256, 27 * 256, G_, c_); G = G_; c = c_; }
    __host__ __device__ bool next(int i, Unit& u) const {
        const long L = (long)i * G + c;
        if (!last || L < 1728) return base.next(i, u);
        if (L >= 1768) return false;
        const int k = (int)L - 1728, j = k % 10; u.pm = 64 + k / 10;
        u.pn = j == 0 ? 0 : j == 1 ? 1 : j == 2 ? 14 : j == 3 ? 15 : j == 4 ? 16 : j == 5 ? 17 : j == 6 ? 21 : j == 7 ? 22 : j == 8 ? 23 : 26;
        return true;
    }
    __device__ __forceinline__ void a_ready(const Unit&) const {}
    __device__ __forceinline__ void done(const Unit&) const {}
};
template <class Epi, class Sched, bool ALIGN_EPI = false, bool SP2 = false>
__device__ __forceinline__ void gemm_phase(PG8_LAS unsigned char* lds, const Gemm g, const Sched& S, const Epi& E, const int tid) {
    const int wid = __builtin_amdgcn_readfirstlane(tid >> 6), lane = tid & 63, wr = wid >> 2, wc = wid & 3, fr = lane & 15, fq = lane >> 4;
    const int K = g.K, nt = K / BK;
    unsigned voffA[2], voffB[2];
#pragma unroll
    for (int i = 0; i < 2; ++i) { int R, C; stage_rc(tid * 16 + i * 8192, R, C); const int Rb = Epi::PERM ? ((R & ~31) + perm32(R & 31)) : R;
        voffA[i] = (unsigned)(R * K + C) * 2u; voffB[i] = (unsigned)(Rb * K + C) * 2u; }
    const size_t kstep = (size_t)(BK * 2);
    const size_t hstep = (size_t)HALF * K * 2;
    const size_t tstep = 2 * hstep;
    const unsigned ldsw = (unsigned)wid * 1024u;
    const int aoff = lds_byte(wr * 64 + fr, fq * 8), boff = lds_byte(wc * 32 + fr, fq * 8);
#define PG8_SA(b, h) (((b) * 2 + (h)) * HTB)
#define PG8_SB(b, h) ((4 + (b) * 2 + (h)) * HTB)
#define PG8_STAGE(bufoff, gbase, voff) do { _Pragma("unroll") for (int _i = 0; _i < 2; ++_i) \
        __builtin_amdgcn_global_load_lds((const unsigned*)((const char*)(gbase) + (voff)[_i]), (PG8_LAS unsigned*)(lds + (bufoff) + ldsw + _i * 8192), 16, 0, 0); } while (0)
#define PG8_LDA(dst, b, h) do { _Pragma("unroll") for (int m = 0; m < 4; ++m) _Pragma("unroll") for (int k = 0; k < 2; ++k) dst[m][k] = *(const PG8_LAS bf16x8*)(lds + PG8_SA(b, h) + aoff + m * 2048 + k * 1024); } while (0)
#define PG8_LDB(dst, b, h) do { _Pragma("unroll") for (int n = 0; n < 2; ++n) _Pragma("unroll") for (int k = 0; k < 2; ++k) dst[n][k] = *(const PG8_LAS bf16x8*)(lds + PG8_SB(b, h) + boff + n * 2048 + k * 1024); } while (0)
#define PG8_MMA(ai, bj, At, Bt) do { __builtin_amdgcn_s_setprio(1); _Pragma("unroll") for (int m = 0; m < 4; ++m) _Pragma("unroll") for (int n = 0; n < 2; ++n) _Pragma("unroll") for (int k = 0; k < 2; ++k) \
        acc[ai][bj][m][n] = __builtin_amdgcn_mfma_f32_16x16x32_bf16(Bt[n][k], At[m][k], acc[ai][bj][m][n], 0, 0, 0); __builtin_amdgcn_s_setprio(0); } while (0)
#define PG8_WAIT_V(n) asm volatile("s_waitcnt vmcnt(" #n ")" ::: "memory")
#define PG8_WAIT_L(n) asm volatile("s_waitcnt lgkmcnt(" #n ")" ::: "memory")
#define PG8_BAR __builtin_amdgcn_s_barrier()
#define PG8_SCHED __builtin_amdgcn_sched_barrier(0)
    Unit cur, nxt; int ui = 0;
    if (!S.next(0, cur)) return;
    f32x4 acc[2][2][4][2];
#pragma unroll
    for (int a = 0; a < 2; ++a)
#pragma unroll
        for (int b = 0; b < 2; ++b)
#pragma unroll
            for (int m = 0; m < 4; ++m)
#pragma unroll
                for (int n = 0; n < 2; ++n) acc[a][b][m][n] = (f32x4){0.f, 0.f, 0.f, 0.f};
    bf16x8 At[4][2], B0[2][2], B1[2][2];
    const char* cA = (const char*)g.A + (size_t)cur.pm * tstep; const char* cB = (const char*)g.Bt + (size_t)cur.pn * tstep;
    S.a_ready(cur);
    if constexpr (SP2) {
        PG8_STAGE(PG8_SB(0, 0), cB, voffB); PG8_STAGE(PG8_SB(0, 1), cB + hstep, voffB); PG8_STAGE(PG8_SA(0, 0), cA, voffA); PG8_STAGE(PG8_SA(0, 1), cA + hstep, voffA);
        if (wr == 1) PG8_BAR;
        PG8_WAIT_V(2); PG8_BAR;
        PG8_STAGE(PG8_SB(1, 0), cB + kstep, voffB); PG8_STAGE(PG8_SA(1, 0), cA + kstep, voffA); PG8_STAGE(PG8_SB(1, 1), cB + hstep + kstep, voffB);
        PG8_WAIT_V(6); PG8_BAR;
    } else {
        PG8_STAGE(PG8_SB(0, 0), cB, voffB); PG8_STAGE(PG8_SA(0, 0), cA, voffA); PG8_STAGE(PG8_SB(0, 1), cB + hstep, voffB); PG8_STAGE(PG8_SA(0, 1), cA + hstep, voffA);
        if (wr == 1) PG8_BAR;
        PG8_WAIT_V(4); PG8_BAR;
        PG8_STAGE(PG8_SB(1, 0), cB + kstep, voffB); PG8_STAGE(PG8_SA(1, 0), cA + kstep, voffA); PG8_STAGE(PG8_SB(1, 1), cB + hstep + kstep, voffB);
        PG8_WAIT_V(6); PG8_BAR;
    }
    for (;;) {
        const bool has_next = S.next(ui + 1, nxt);
        const char* nA = has_next ? (const char*)g.A + (size_t)nxt.pm * tstep : cA; const char* nB = has_next ? (const char*)g.Bt + (size_t)nxt.pn * tstep : cB;
        for (int t = 0; t < nt; t += 2) {
            const bool last = (t == nt - 2);
            const char* a1 = cA + (size_t)(t + 1) * kstep;
            const char* a2 = last ? nA : cA + (size_t)(t + 2) * kstep; const char* b2 = last ? nB : cB + (size_t)(t + 2) * kstep;
            const char* a3 = a2 + kstep; const char* b3 = b2 + kstep;
            if (last && has_next) S.a_ready(nxt);
            if constexpr (SP2) {
            PG8_LDB(B0, 0, 0); PG8_LDB(B1, 0, 1); PG8_SCHED; PG8_LDA(At, 0, 0); PG8_STAGE(PG8_SA(1, 1), a1 + hstep, voffA);
            PG8_WAIT_V(8); PG8_WAIT_L(0); PG8_BAR; PG8_MMA(0, 0, At, B0); PG8_MMA(0, 1, At, B1); PG8_BAR; PG8_SCHED;
            PG8_LDA(At, 0, 1); PG8_STAGE(PG8_SB(0, 0), b2, voffB); PG8_STAGE(PG8_SB(0, 1), b2 + hstep, voffB); PG8_STAGE(PG8_SA(0, 0), a2, voffA);
            PG8_WAIT_V(8); PG8_WAIT_L(0); PG8_BAR; PG8_MMA(1, 0, At, B0); PG8_MMA(1, 1, At, B1); PG8_BAR; PG8_SCHED;
            PG8_LDB(B0, 1, 0); PG8_LDB(B1, 1, 1); PG8_SCHED; PG8_LDA(At, 1, 0); PG8_STAGE(PG8_SA(0, 1), a2 + hstep, voffA);
            PG8_WAIT_V(8); PG8_WAIT_L(0); PG8_BAR; PG8_MMA(0, 0, At, B0); PG8_MMA(0, 1, At, B1); PG8_BAR; PG8_SCHED;
            PG8_LDA(At, 1, 1); PG8_STAGE(PG8_SB(1, 0), b3, voffB); PG8_STAGE(PG8_SB(1, 1), b3 + hstep, voffB); PG8_STAGE(PG8_SA(1, 0), a3, voffA);
            PG8_WAIT_V(8); PG8_WAIT_L(0); PG8_BAR; PG8_MMA(1, 0, At, B0); PG8_MMA(1, 1, At, B1); PG8_BAR; PG8_SCHED;
            } else {
            PG8_LDB(B0, 0, 0); PG8_SCHED; PG8_LDA(At, 0, 0); PG8_STAGE(PG8_SA(1, 1), a1 + hstep, voffA);
            PG8_WAIT_L(8); PG8_BAR; PG8_WAIT_L(0); PG8_MMA(0, 0, At, B0); PG8_BAR; PG8_SCHED;
            PG8_LDB(B1, 0, 1); PG8_STAGE(PG8_SB(0, 0), b2, voffB);
            PG8_BAR; PG8_WAIT_L(0); PG8_MMA(0, 1, At, B1); PG8_BAR;
            PG8_LDA(At, 0, 1); PG8_STAGE(PG8_SA(0, 0), a2, voffA);
            PG8_BAR; PG8_WAIT_L(0); PG8_MMA(1, 0, At, B0); PG8_BAR; PG8_SCHED;
            PG8_STAGE(PG8_SB(0, 1), b2 + hstep, voffB);
            PG8_WAIT_V(6); PG8_BAR; PG8_MMA(1, 1, At, B1); PG8_BAR;
            PG8_LDB(B0, 1, 0); PG8_SCHED; PG8_LDA(At, 1, 0); PG8_STAGE(PG8_SA(0, 1), a2 + hstep, voffA);
            PG8_WAIT_L(8); PG8_BAR; PG8_WAIT_L(0); PG8_MMA(0, 0, At, B0); PG8_BAR; PG8_SCHED;
            PG8_LDB(B1, 1, 1); PG8_STAGE(PG8_SB(1, 0), b3, voffB);
            PG8_BAR; PG8_WAIT_L(0); PG8_MMA(0, 1, At, B1); PG8_BAR;
            PG8_LDA(At, 1, 1); PG8_STAGE(PG8_SA(1, 0), a3, voffA);
            PG8_BAR; PG8_WAIT_L(0); PG8_MMA(1, 0, At, B0); PG8_BAR; PG8_SCHED;
            PG8_STAGE(PG8_SB(1, 1), b3 + hstep, voffB);
            PG8_WAIT_V(6); PG8_BAR; PG8_MMA(1, 1, At, B1); PG8_BAR;
            }
        }
        if constexpr (ALIGN_EPI) { if (wr == 0) PG8_BAR; }
        { int fr_ = fr, fq_ = fq; asm volatile("" : "+v"(fr_), "+v"(fq_));
          E(acc, cur, wr, wc, fr_, fq_); } S.done(cur);
        if (!has_next) break;
#pragma unroll
        for (int a = 0; a < 2; ++a)
#pragma unroll
            for (int b = 0; b < 2; ++b)
#pragma unroll
                for (int m = 0; m < 4; ++m)
#pragma unroll
                    for (int n = 0; n < 2; ++n) acc[a][b][m][n] = (f32x4){0.f, 0.f, 0.f, 0.f};
        cur = nxt; cA = nA; cB = nB; ++ui;
        if constexpr (ALIGN_EPI) { if (wr == 1) PG8_BAR; }
    }
    PG8_WAIT_V(0);
    if constexpr (!ALIGN_EPI) { if (wr == 0) PG8_BAR; }
    PG8_BAR;
#undef PG8_SA
#undef PG8_SB
#undef PG8_STAGE
#undef PG8_LDA
#undef PG8_LDB
#undef PG8_MMA
#undef PG8_WAIT_V
#undef PG8_WAIT_L
#undef PG8_BAR
#undef PG8_SCHED
}
}
__device__ __forceinline__ void prep_adaln(const float* c, const float* cctx, const float* adaw, const float* adab, float* MOD, int it, LAS float* sv, int tid) {
    const int l = it / 384, r = it % 384, ntile = r >> 5, ks = r & 31, k0 = ks * 64;
    if (tid < 320) { const int v = tid >> 6, k = tid & 63; const float cv = v < 4 ? c[v * D + k0 + k] : cctx[k0 + k]; sv[tid] = cv / (1.0f + expf(-cv)); }
    __syncthreads();
    const int n = ntile * 512 + tid; const float* w = adaw + (size_t)l * D * ADA + (size_t)k0 * ADA + n;
    float acc[5] = {0.f, 0.f, 0.f, 0.f, 0.f};
#pragma unroll 1
    for (int k0_ = 0; k0_ < 64; k0_ += 32) {
        float wv[32];
#pragma unroll
        for (int k = 0; k < 32; ++k) wv[k] = w[(size_t)(k0_ + k) * ADA];
#pragma unroll
        for (int k = 0; k < 32; ++k) {
#pragma unroll
            for (int v = 0; v < 5; ++v) acc[v] += sv[v * 64 + k0_ + k] * wv[k]; } }
    if (ks == 0) { const float bb = adab[l * ADA + n];
#pragma unroll
        for (int v = 0; v < 5; ++v) acc[v] += bb; }
#pragma unroll
    for (int v = 0; v < 5; ++v) atomicAdd(MOD + (size_t)(l * 5 + v) * ADA + n, acc[v]);
    __syncthreads();
}

__device__ __forceinline__ void prep_hymlp(const DArgs& a, float* H3out, bf16_t* H3b, int l, int Lx, int t0, LAS unsigned char* lds, int tid) {
    LAS float* zs = (LAS float*)lds;
    LAS float* h1 = (LAS float*)(lds + 4608);
    LAS float* h2 = (LAS float*)(lds + 4608 + 8192);
    LAS float* w1s = (LAS float*)(lds + 24576);
    LAS float* w2s = w1s + 33 * 64;
    LAS float* w3s = w2s + 64 * 64;
    { const float* w1 = a.in[I_HW1] + (size_t)l * 33 * 64; const float* w2 = a.in[I_HW2] + (size_t)l * 64 * 64; const float* w3 = a.in[I_HW3] + (size_t)l * 64 * 64;
      for (int i = tid; i < 33 * 64; i += NT) w1s[i] = w1[i];
      for (int i = tid; i < 64 * 64; i += NT) { w2s[i] = w2[i]; w3s[i] = w3[i]; } }
    for (int i = tid; i < 32 * 33; i += NT) { const int pos = i / 33, f = i % 33, t = t0 + pos;
        float z;
        if (f == 0) z = (float)t / (float)(Lx - 1);
        else { const int j = (f - 1) & 15; const float fj = 1e-4f + (float)j * ((15.0f - 1e-4f) / 15.0f); const float wpos = (6.283185307179586f * (float)t) / (float)Lx; const float arg = fj * wpos;
               z = (f <= 16) ? cosf(arg) : -sinf(arg); }
        zs[pos * 36 + f] = z; }
    __syncthreads();
    const int pos = tid >> 4, f4 = (tid & 15) * 4, t = t0 + pos;
    f32x4 s = *(const f32x4*)(a.in[I_HB1] + l * 64 + f4);
#pragma unroll 3
    for (int j = 0; j < 33; ++j) s += zs[pos * 36 + j] * *(const LAS f32x4*)(w1s + j * 64 + f4);
    { const f32x4 fr = *(const f32x4*)(a.in[I_HF1] + l * 64 + f4); *(LAS f32x4*)(h1 + pos * 64 + f4) = (f32x4){sinf(fr.x * s.x), sinf(fr.y * s.y), sinf(fr.z * s.z), sinf(fr.w * s.w)}; }
    __syncthreads();
    s = *(const f32x4*)(a.in[I_HB2] + l * 64 + f4);
#pragma unroll 4
    for (int j = 0; j < 64; ++j) s += h1[pos * 64 + j] * *(const LAS f32x4*)(w2s + j * 64 + f4);
    { const f32x4 fr = *(const f32x4*)(a.in[I_HF2] + l * 64 + f4); *(LAS f32x4*)(h2 + pos * 64 + f4) = (f32x4){sinf(fr.x * s.x), sinf(fr.y * s.y), sinf(fr.z * s.z), sinf(fr.w * s.w)}; }
    __syncthreads();
    s = *(const f32x4*)(a.in[I_HB3] + l * 64 + f4);
#pragma unroll 4
    for (int j = 0; j < 64; ++j) s += h2[pos * 64 + j] * *(const LAS f32x4*)(w3s + j * 64 + f4);
    { const f32x4 fr = *(const f32x4*)(a.in[I_HF3] + l * 64 + f4); const f32x4 hv = (f32x4){sinf(fr.x * s.x), sinf(fr.y * s.y), sinf(fr.z * s.z), sinf(fr.w * s.w)}; *(f32x4*)(H3out + (size_t)t * 64 + f4) = hv;
      if (H3b) { u32x2 pk; pk.x = pk2(hv.x, hv.y); pk.y = pk2(hv.z, hv.w); *(u32x2*)(H3b + (size_t)t * 64 + f4) = pk; } }
    __syncthreads();
}

__device__ __forceinline__ void transpose_item(const float* W, int ldw, int srccol_lane  , int k0, bf16_t* WT, int K, int dstrow0, LAS float* scr, int lane) {
    float wv[32];
#pragma unroll
    for (int i = 0; i < 32; ++i) { const int kk = 2 * i + (lane >> 5); wv[i] = srccol_lane >= 0 ? W[(size_t)(k0 + kk) * ldw + srccol_lane] : 0.f; }
#pragma unroll
    for (int i = 0; i < 32; ++i) { const int kk = 2 * i + (lane >> 5); scr[kk * 33 + (lane & 31)] = wv[i]; }
    LDS_WAIT();
    const int c = lane & 7;
#pragma unroll
    for (int j = 0; j < 4; ++j) { const int n = (lane >> 3) + 8 * j; const LAS float* s = scr + (8 * c) * 33 + n;
        u32x4 o; o.x = pk2(s[0 * 33], s[1 * 33]); o.y = pk2(s[2 * 33], s[3 * 33]); o.z = pk2(s[4 * 33], s[5 * 33]); o.w = pk2(s[6 * 33], s[7 * 33]);
        *(u32x4*)(WT + (size_t)(dstrow0 + n) * K + k0 + 8 * c) = o; }
    LDS_WAIT();
}
__device__ __forceinline__ int win_srccol(int n) {
    if (n >= 3072 && n < 4096) { const int u = (n - 3072) & 127, grp = u >> 3, e = u & 7; return (n & ~127) + (e < 4 ? 4 * grp + e : 64 + 4 * grp + (e - 4)); }
    return n < 6144 ? n : (n < 6656 ? n + 32 : (n < 6688 ? n - 512 : -1));
}

__device__ __forceinline__ void norm_row(const float* xrow, const float* nw, const float* mod, bf16_t* hrow, int lane) {
    f32x4 v[8]; float ss = 0.f;
#pragma unroll
    for (int j = 0; j < 8; ++j) { v[j] = ((const f32x4*)xrow)[lane + 64 * j]; ss += (v[j].x * v[j].x + v[j].y * v[j].y) + (v[j].z * v[j].z + v[j].w * v[j].w); }
    const float rstd = rsqrtf(wave_sum(ss) * (1.0f / D) + EPS);
#pragma unroll
    for (int j = 0; j < 8; ++j) { const int k = 4 * (lane + 64 * j);
        const f32x4 w = *(const f32x4*)(nw + k), sh = *(const f32x4*)(mod + k), sc = *(const f32x4*)(mod + D + k);
        const f32x4 o = v[j] * rstd * w * (sc + 1.0f) + sh;
        u32x2 pk; pk.x = pk2(o.x, o.y); pk.y = pk2(o.z, o.w);
        *(u32x2*)(hrow + k) = pk; }
}

__device__ __forceinline__ float block_sum(float v, LAS float* red, int tid) {
    v = wave_sum(v);
    if ((tid & 63) == 0) red[tid >> 6] = v;
    __syncthreads();
    float t = 0.f;
#pragma unroll
    for (int i = 0; i < NWAVES; ++i) t += red[i];
    __syncthreads();
    return t;
}
constexpr float HY_D0 = -3.0701134573253945f  , HY_D1 = -15.350567286626973f  ;

__device__ __forceinline__ void filt_ctx_item(const DArgs& a, unsigned char* ws, LAS unsigned char* lds, int c, int tid) {
    LAS float* w4s = (LAS float*)lds; LAS float* red = (LAS float*)(lds + 1024);
    if (tid < 256) { const int cc = tid >> 6, f = tid & 63; w4s[tid] = a.in[I_HW4][(size_t)f * 2048 + (cc >> 1) * 1024 + (cc & 1) * 512 + c]; }
    __syncthreads();
    const float dl = fabsf(HY_D0 + (HY_D1 - HY_D0) * ((float)c / 511.0f));
    const float* H3C = (const float*)(ws + WS_H3C);
    const int n = tid, dir = n >= 256 ? 1 : 0, t = dir ? (512 - n) : n;
    float s0 = 0.f, s1 = 0.f;
    if (n != 256) {
        const f32x4* hr = (const f32x4*)(H3C + (size_t)t * 64);
#pragma unroll
        for (int q = 0; q < 16; ++q) { const f32x4 hv = hr[q]; const f32x4 wa = ((const LAS f32x4*)(w4s + (dir * 2 + 0) * 64))[q], wb = ((const LAS f32x4*)(w4s + (dir * 2 + 1) * 64))[q];
            s0 += (hv.x * wa.x + hv.y * wa.y) + (hv.z * wa.z + hv.w * wa.w); s1 += (hv.x * wb.x + hv.y * wb.y) + (hv.z * wb.z + hv.w * wb.w); }
        const float dec = expf(-((float)t / 255.0f) * dl); s0 *= dec; s1 *= dec;
    }
    const float rs0 = rsqrtf(block_sum(s0 * s0, red, tid) + EPS), rs1 = rsqrtf(block_sum(s1 * s1, red, tid) + EPS);
    float* KC = (float*)(ws + WS_KC);
    KC[(size_t)(0 * 512 + c) * 512 + n] = s0 * rs0; KC[(size_t)(1 * 512 + c) * 512 + n] = s1 * rs1;
    __syncthreads();
}

__device__ __forceinline__ void prep_rope(f32x2* RT, int it, int tid) {
    const int idx = it * NT + tid, pos = idx >> 6, j = idx & 63;
    float ang;
    if (pos < SEQL) { const float inv = exp2f(-(float)(j & 31) * (13.287712379549449f / 32.0f)); ang = (float)(j < 32 ? (pos >> 6) : (pos & 63)) * inv; }
    else { const float inv = exp2f(-(float)j * (13.287712379549449f / 64.0f)); ang = (float)(pos - SEQL) * inv; }
    float sn, cs; sincosf(ang, &sn, &cs);
    RT[idx] = (f32x2){cs, sn};
}

__device__ __forceinline__ float sconv3(const bf16_t* p, int t, int Lx, float w0, float w1, float w2, float cb) {
    const float x0 = t > 0 ? bf2f(p[t - 1]) : 0.f, x1 = bf2f(p[t]), x2 = t < Lx - 1 ? bf2f(p[t + 1]) : 0.f;
    return w0 * x0 + w1 * x1 + w2 * x2 + cb;
}
__device__ __forceinline__ void ctx_conv256(const LAS float* kc, const LAS float* z, int b, int t4, int half, float (&o)[4]) {
    o[0] = o[1] = o[2] = o[3] = 0.f;
#pragma unroll 4
    for (int s4 = 0; s4 < 32; ++s4) { const int s = 128 * half + 4 * s4, d = 4 * t4 - s;
        const f32x4 zv = *(const LAS f32x4*)(z + b * 256 + s);
        const f32x4 wl = *(const LAS f32x4*)(kc + ((d - 4) & 511)), wh = *(const LAS f32x4*)(kc + (d & 511));
        const float w[8] = {wl.x, wl.y, wl.z, wl.w, wh.x, wh.y, wh.z, wh.w};
        const float zz[4] = {zv.x, zv.y, zv.z, zv.w};
#pragma unroll
        for (int j = 0; j < 4; ++j)
#pragma unroll
            for (int i = 0; i < 4; ++i) o[j] += w[4 + j - i] * zz[i]; }
}
__device__ __forceinline__ void hyena_ctx_item(const DArgs& a, unsigned char* ws, LAS unsigned char* lds, int c, int tid) {
    LAS float* kc = (LAS float*)lds; LAS float* za = (LAS float*)(lds + 4096); LAS float* zb = (LAS float*)(lds + 8192); LAS float* part = (LAS float*)(lds + 12288);
    const float* KC = (const float*)(ws + WS_KC);
    kc[tid] = KC[(size_t)(0 * 512 + c) * 512 + tid]; kc[512 + tid] = KC[(size_t)(1 * 512 + c) * 512 + tid];
    const float* cw = a.in[I_HCW]; const float* cbp = a.in[I_HCB];
    const float wv0 = cw[c], wv1 = cw[1536 + c], wv2 = cw[3072 + c], bv = cbp[c];
    const float wa0 = cw[512 + c], wa1 = cw[1536 + 512 + c], wa2 = cw[3072 + 512 + c], ba = cbp[512 + c];
    const float wb0 = cw[1024 + c], wb1 = cw[1536 + 1024 + c], wb2 = cw[3072 + 1024 + c], bb = cbp[1024 + c];
    const float bias0 = a.in[I_HBIAS][0 * 512 + c], bias1 = a.in[I_HBIAS][1 * 512 + c];
    const bf16_t* PT = (const bf16_t*)(ws + WS_PT);
    const int half = tid >> 8, b = (tid >> 6) & 3, t4 = tid & 63; const int rb = NLAT + b * LC;
    const bf16_t* pv = PT + (size_t)(PT_V + c) * MR + rb; const bf16_t* pg1 = PT + (size_t)(PT_G1 + c) * MR + rb; const bf16_t* pg2 = PT + (size_t)(PT_G2 + c) * MR + rb; const bf16_t* phg = PT + (size_t)(PT_HG + c) * MR + rb;
    bf16_t* GATED = (bf16_t*)(ws + WS_H);
    float z0[4], z1[4], o[4], g1v[4], g2v[4], hgv[4];
#pragma unroll
    for (int j = 0; j < 4; ++j) { z0[j] = sconv3(pv, 4 * t4 + j, LC, wv0, wv1, wv2, bv); g1v[j] = sconv3(pg1, 4 * t4 + j, LC, wa0, wa1, wa2, ba); g2v[j] = sconv3(pg2, 4 * t4 + j, LC, wb0, wb1, wb2, bb); hgv[j] = bf2f(phg[4 * t4 + j]); }
    if (half == 0) *(LAS f32x4*)(za + b * 256 + 4 * t4) = (f32x4){z0[0], z0[1], z0[2], z0[3]};
    __syncthreads();
    ctx_conv256(kc, za, b, t4, half, o);
    if (half == 1) *(LAS f32x4*)(part + b * 256 + 4 * t4) = (f32x4){o[0], o[1], o[2], o[3]};
    __syncthreads();
    if (half == 0) { const f32x4 pp = *(const LAS f32x4*)(part + b * 256 + 4 * t4); const float ps[4] = {pp.x, pp.y, pp.z, pp.w};
#pragma unroll
        for (int j = 0; j < 4; ++j) z1[j] = g1v[j] * (o[j] + ps[j] + bias0 * z0[j]);
        *(LAS f32x4*)(zb + b * 256 + 4 * t4) = (f32x4){z1[0], z1[1], z1[2], z1[3]}; }
    __syncthreads();
    ctx_conv256(kc + 512, zb, b, t4, half, o);
    if (half == 1) *(LAS f32x4*)(part + b * 256 + 4 * t4) = (f32x4){o[0], o[1], o[2], o[3]};
    __syncthreads();
    if (half == 0) { const f32x4 pp = *(const LAS f32x4*)(part + b * 256 + 4 * t4); const float ps[4] = {pp.x, pp.y, pp.z, pp.w};
#pragma unroll
        for (int j = 0; j < 4; ++j) { const int t = 4 * t4 + j; const float z2 = g2v[j] * (o[j] + ps[j] + bias1 * z1[j]);
            GATED[(size_t)(rb + t) * D + 512 + c] = (bf16_t)f2bf(z2 * siluf_(hgv[j])); } }
    __syncthreads();
}

struct EpiInProj {
    static constexpr bool PERM = true, AFTER_DRAIN = false;
    bf16_t* P; bf16_t* PT; float* LR; const float* RT;
    __device__ __forceinline__ void operator()(const pg8::f32x4 (&acc)[2][2][4][2], const pg8::Unit& u, int wr, int wc, int fr, int fq) const {
        const int row0 = u.pm * 256 + wr * 64 + fr, pn = u.pn;
        if (pn >= 12 && pn < 16) {
            const int colbase = pn * 256 - 2048 + wc * 32 + 8 * fq; const int j0 = 4 * (4 * wc + fq); const float ksc = pn >= 14 ? 0.08838834764831845f : 1.0f;
#pragma unroll
            for (int ai = 0; ai < 2; ++ai)
#pragma unroll
                for (int m = 0; m < 4; ++m) { const int row = row0 + ai * 128 + m * 16; const int pos = row < NLAT ? (row & (SEQL - 1)) : SEQL + ((row - NLAT) & (LC - 1));
                    const pg8::f32x4 t0 = *(const pg8::f32x4*)(RT + ((size_t)pos * 64 + j0) * 2), t1 = *(const pg8::f32x4*)(RT + ((size_t)pos * 64 + j0) * 2 + 4);
                    bf16_t* rowp = P + (size_t)row * LDP + colbase;
#pragma unroll
                    for (int bj = 0; bj < 2; ++bj) { const pg8::f32x4 x1 = acc[ai][bj][m][0] * ksc, x2 = acc[ai][bj][m][1] * ksc;
                        u32x4 w; w.x = pk2(x1[0] * t0[0] - x2[0] * t0[1], x1[1] * t0[2] - x2[1] * t0[3]); w.y = pk2(x1[2] * t1[0] - x2[2] * t1[1], x1[3] * t1[2] - x2[3] * t1[3]);
                        w.z = pk2(x1[0] * t0[1] + x2[0] * t0[0], x1[1] * t0[3] + x2[1] * t0[2]); w.w = pk2(x1[2] * t1[1] + x2[2] * t1[0], x1[3] * t1[3] + x2[3] * t1[2]);
                        *(u32x4*)(rowp + bj * 128) = w; } }
        } else if (pn < 4 || (pn >= 16 && pn < 26)) {
            const int colbase = (pn < 4 ? pn * 256 : pn * 256 - 2048) + wc * 32 + 8 * fq;
#pragma unroll
            for (int ai = 0; ai < 2; ++ai)
#pragma unroll
                for (int m = 0; m < 4; ++m) { bf16_t* rowp = P + (size_t)(row0 + ai * 128 + m * 16) * LDP + colbase;
#pragma unroll
                    for (int bj = 0; bj < 2; ++bj) { const pg8::f32x4 v0 = acc[ai][bj][m][0], v1 = acc[ai][bj][m][1];
                        u32x4 w; w.x = pk2(v0[0], v0[1]); w.y = pk2(v0[2], v0[3]); w.z = pk2(v1[0], v1[1]); w.w = pk2(v1[2], v1[3]);
                        *(u32x4*)(rowp + bj * 128) = w; } }
        } else if (pn < 12) {
            const int colbase = (pn - 4) * 256 + wc * 32 + 8 * fq;
#pragma unroll
            for (int bj = 0; bj < 2; ++bj)
#pragma unroll
                for (int n = 0; n < 2; ++n)
#pragma unroll
                    for (int j = 0; j < 4; ++j) { bf16_t* cp = PT + (size_t)(colbase + bj * 128 + 4 * n + j) * MR + row0;
#pragma unroll
                        for (int ai = 0; ai < 2; ++ai)
#pragma unroll
                            for (int m = 0; m < 4; ++m) cp[ai * 128 + m * 16] = (bf16_t)f2bf(acc[ai][bj][m][n][j]);
                        asm volatile("" ::: "memory"); }
        } else {
            if (wc == 0) {
#pragma unroll
                for (int ai = 0; ai < 2; ++ai)
#pragma unroll
                    for (int m = 0; m < 4; ++m) { float* rowp = LR + (size_t)(row0 + ai * 128 + m * 16) * 32 + 8 * fq;
                        *(pg8::f32x4*)(rowp) = acc[ai][0][m][0]; *(pg8::f32x4*)(rowp + 4) = acc[ai][0][m][1]; }
            }
        }
    }
};
struct EpiGlu {
    static constexpr bool PERM = true, AFTER_DRAIN = false;
    const bf16_t* GG; bf16_t* GATED; const float* bias;
    __device__ __forceinline__ void operator()(const pg8::f32x4 (&acc)[2][2][4][2], const pg8::Unit& u, int wr, int wc, int fr, int fq) const {
        const int row0 = u.pm * 256 + wr * 64 + fr, col0 = u.pn * 256 + wc * 32 + 8 * fq;
        pg8::f32x4 b0[2], b1[2];
#pragma unroll
        for (int bj = 0; bj < 2; ++bj) { b0[bj] = *(const pg8::f32x4*)(bias + col0 + bj * 128); b1[bj] = *(const pg8::f32x4*)(bias + col0 + bj * 128 + 4); }
#pragma unroll
        for (int ai = 0; ai < 2; ++ai) {
            u32x4 gg[4][2];
#pragma unroll
            for (int m = 0; m < 4; ++m)
#pragma unroll
                for (int bj = 0; bj < 2; ++bj) gg[m][bj] = *(const u32x4*)(GG + (size_t)(row0 + ai * 128 + m * 16) * 512 + col0 + bj * 128);
#pragma unroll
            for (int m = 0; m < 4; ++m) { const size_t row = (size_t)(row0 + ai * 128 + m * 16);
#pragma unroll
                for (int bj = 0; bj < 2; ++bj) { float g[8], res[8]; unpack8(gg[m][bj], g);
#pragma unroll
                    for (int j = 0; j < 4; ++j) { res[j] = g[j] * sigmoidf_(acc[ai][bj][m][0][j] + b0[bj][j]); res[4 + j] = g[4 + j] * sigmoidf_(acc[ai][bj][m][1][j] + b1[bj][j]); }
                    *(u32x4*)(GATED + row * D + col0 + bj * 128) = pack8(res); } }
            asm volatile("" ::: "memory");
        }
    }
};
struct EpiOut {
    static constexpr bool PERM = false, AFTER_DRAIN = false;
    const float* xl_old; const float* xc_old; float* xl_new; float* xc_new; const float* mod;
    __device__ __forceinline__ void operator()(const pg8::f32x4 (&acc)[2][2][4][2], const pg8::Unit& u, int wr, int wc, int fr, int fq) const {
        const int row0 = u.pm * 256 + wr * 64 + fr, col0 = u.pn * 256 + wc * 32 + 4 * fq;
        const bool lat = u.pm < 64;
        const float* xo = lat ? xl_old : xc_old - (size_t)NLAT * D; float* xn = lat ? xl_new : xc_new - (size_t)NLAT * D;
#pragma unroll
        for (int ai = 0; ai < 2; ++ai) {
            const int v = lat ? ((u.pm * 256 + ai * 128) >> 12) : 4;
            const float* gt = mod + (size_t)v * ADA + 2 * D;
#pragma unroll
            for (int m = 0; m < 4; ++m) { const size_t off = (size_t)(row0 + ai * 128 + m * 16) * D + col0;
#pragma unroll
                for (int bj = 0; bj < 2; ++bj)
#pragma unroll
                    for (int n = 0; n < 2; ++n) { const int cc = bj * 128 + n * 16; const pg8::f32x4 gv = *(const pg8::f32x4*)(gt + col0 + cc), xv = *(const pg8::f32x4*)(xo + off + cc);
                        *(pg8::f32x4*)(xn + off + cc) = xv + gv * acc[ai][bj][m][n]; } }
        }
    }
};
typedef short bf16x8 __attribute__((ext_vector_type(8)));
typedef short bf16x4 __attribute__((ext_vector_type(4)));
__device__ __forceinline__ unsigned off_b(unsigned row, unsigned ch) { return 256u * row + 16u * (ch ^ (((row & 3) << 2) | ((row >> 2) & 3))); }
__device__ __forceinline__ bf16x8 img_row_frag(const LAS unsigned char* img, unsigned lane, unsigned rb, unsigned s) { return *(const LAS bf16x8*)(img + off_b((lane & 15) + 16 * rb, 4 * s + (lane >> 4))); }
__device__ __forceinline__ bf16x4 img_tr4(const LAS unsigned char* img, unsigned lane, unsigned c, unsigned row0) {
    const unsigned q = (lane & 15) >> 2, p = lane & 3;
    return __builtin_amdgcn_ds_read_tr16_b64_v4i16((LAS bf16x4*)(img + off_b(row0 + q, 2 * c + (p >> 1)) + 8 * (p & 1)));
}
__device__ __forceinline__ bf16x8 img_tr_frag(const LAS unsigned char* img, unsigned lane, unsigned c, unsigned ks) {
    const unsigned g = lane >> 4; const bf16x4 lo = img_tr4(img, lane, c, 32 * ks + 8 * g), hi = img_tr4(img, lane, c, 32 * ks + 8 * g + 4);
    return __builtin_shufflevector(lo, hi, 0, 1, 2, 3, 4, 5, 6, 7);
}
__device__ __forceinline__ bf16x8 img_tr_frag_acc(const LAS unsigned char* img, unsigned lane, unsigned c, unsigned ks) {
    const unsigned g = lane >> 4; const bf16x4 lo = img_tr4(img, lane, c, 32 * ks + 4 * g), hi = img_tr4(img, lane, c, 32 * ks + 16 + 4 * g);
    return __builtin_shufflevector(lo, hi, 0, 1, 2, 3, 4, 5, 6, 7);
}
__device__ __forceinline__ bf16x8 acc_pair_frag(const f32x4 a0, const f32x4 a1) {
    u32x4 w; w.x = pk2(a0.x, a0.y); w.y = pk2(a0.z, a0.w); w.z = pk2(a1.x, a1.y); w.w = pk2(a1.z, a1.w);
    return __builtin_bit_cast(bf16x8, w);
}
#define MFMA16(A_, B_, C_) __builtin_amdgcn_mfma_f32_16x16x32_bf16((A_), (B_), (C_), 0, 0, 0)
__device__ __forceinline__ void stage_tile128(LAS unsigned char* img, const bf16_t* g, size_t ld, int tid) {
#pragma unroll
    for (int i = 0; i < 4; ++i) { const int n = tid + NT * i, row = n >> 4, ch = n & 15; *(LAS u32x4*)(img + off_b(row, ch)) = *(const u32x4*)(g + (size_t)row * ld + ch * 8); }
}

constexpr int RCH = 128, RNCH = 34;
constexpr size_t WS_RST = WS_OB;
__device__ __forceinline__ int ret_rowbase(int b, int cc) { return cc < 2 ? NLAT + b * LC + cc * RCH : b * SEQL + (cc - 2) * RCH; }
__device__ __forceinline__ float ret_log2g(int h) { return log2f(1.0f - exp2f(-5.0f - (float)h)); }

__device__ __forceinline__ void ret_passA(unsigned char* ws, LAS unsigned char* lds, int item, int tid) {
    const int bh = item / RNCH, cc = item % RNCH, b = bh >> 2, h = bh & 3;
    const int lane = tid & 63, w = tid >> 6, g = lane >> 4;
    LAS unsigned char* KF = lds; LAS unsigned char* KB = lds + 32768; LAS unsigned char* VI = lds + 65536;
    const bf16_t* P = (const bf16_t*)(ws + WS_P) + (size_t)ret_rowbase(b, cc) * LDP;
    const float l2g = ret_log2g(h);
    __syncthreads();
#pragma unroll
    for (int i = 0; i < 4; ++i) { const int n = tid + NT * i, row = n >> 4, ch = n & 15;
        const u32x4 kr = *(const u32x4*)(P + (size_t)row * LDP + PC_RK + h * 128 + ch * 8);
        float kf[8], a[8], c[8]; unpack8(kr, kf);
        const float sf = exp2f(l2g * (float)(RCH - 1 - row)), sb = exp2f(l2g * (float)row);
#pragma unroll
        for (int x = 0; x < 8; ++x) { a[x] = kf[x] * sf; c[x] = kf[x] * sb; }
        *(LAS u32x4*)(KF + off_b(row, ch)) = pack8(a); *(LAS u32x4*)(KB + off_b(row, ch)) = pack8(c);
        *(LAS u32x4*)(VI + off_b(row, ch)) = *(const u32x4*)(P + (size_t)row * LDP + PC_RV + h * 128 + ch * 8); }
    __syncthreads();
    bf16x8 af[4], ab[4];
#pragma unroll
    for (int ks = 0; ks < 4; ++ks) { af[ks] = img_tr_frag(KF, lane, w, ks); ab[ks] = img_tr_frag(KB, lane, w, ks); }
    bf16_t* ST = (bf16_t*)(ws + WS_RST) + ((size_t)(bh * 2) * RNCH + cc) * (128 * 128);
#pragma unroll 2
    for (int E = 0; E < 8; ++E) {
        f32x4 cf = {0.f, 0.f, 0.f, 0.f}, cb = {0.f, 0.f, 0.f, 0.f};
#pragma unroll
        for (int ks = 0; ks < 4; ++ks) { const bf16x8 vb = img_tr_frag(VI, lane, E, ks); cf = MFMA16(af[ks], vb, cf); cb = MFMA16(ab[ks], vb, cb); }
        const int e = 16 * E + (lane & 15), d0 = 16 * w + 4 * g;
        u32x2 o; o.x = pk2(cf.x, cf.y); o.y = pk2(cf.z, cf.w); *(u32x2*)(ST + (size_t)e * 128 + d0) = o;
        o.x = pk2(cb.x, cb.y); o.y = pk2(cb.z, cb.w); *(u32x2*)(ST + (size_t)RNCH * 128 * 128 + (size_t)e * 128 + d0) = o;
    }
}
__device__ __forceinline__ void ret_passB(unsigned char* ws, int gt  ) {
    const int el = gt & 2047, bd = gt >> 11, bh = bd >> 1, dir = bd & 1, h = bh & 3;
    const float gC = exp2f(ret_log2g(h) * (float)RCH);
    bf16_t* base = (bf16_t*)(ws + WS_RST) + (size_t)bd * RNCH * (128 * 128) + (size_t)el * 8;
    float acc[8];
#pragma unroll
    for (int x = 0; x < 8; ++x) acc[x] = 0.f;
#pragma unroll 1
    for (int s0 = 0; s0 < RNCH; s0 += 17) {
        u32x4 kvr[17];
#pragma unroll
        for (int j = 0; j < 17; ++j) { const int s = s0 + j; const int cc = dir == 0 ? s : (s < 2 ? 1 - s : 35 - s); kvr[j] = *(const u32x4*)(base + (size_t)cc * (128 * 128)); }
#pragma unroll
        for (int j = 0; j < 17; ++j) { const int s = s0 + j; const int cc = dir == 0 ? s : (s < 2 ? 1 - s : 35 - s);
            float kv[8]; unpack8(kvr[j], kv);
            *(u32x4*)(base + (size_t)cc * (128 * 128)) = pack8(acc);
#pragma unroll
            for (int x = 0; x < 8; ++x) acc[x] = gC * acc[x] + kv[x]; }
    }
}
__device__ __forceinline__ void ret_passC(const DArgs& a, unsigned char* ws, LAS unsigned char* lds, int l, int item, int tid) {
    const int bh = item / RNCH, cc = item % RNCH, b = bh >> 2, h = bh & 3;
    const int lane = tid & 63, w = tid >> 6, g = lane >> 4, il = lane & 15;
    LAS unsigned char* KI = lds; LAS unsigned char* VI = lds + 32768; LAS unsigned char* SF = lds + 65536; LAS unsigned char* SB = lds + 98304;
    const int rowbase = ret_rowbase(b, cc);
    const bf16_t* P = (const bf16_t*)(ws + WS_P) + (size_t)rowbase * LDP;
    const bf16_t* STf = (const bf16_t*)(ws + WS_RST) + ((size_t)(bh * 2) * RNCH + cc) * (128 * 128);
    const bf16_t* STb = STf + (size_t)RNCH * 128 * 128;
    __syncthreads();
    stage_tile128(KI, P + PC_RK + h * 128, LDP, tid); stage_tile128(VI, P + PC_RV + h * 128, LDP, tid);
    stage_tile128(SF, STf, 128, tid); stage_tile128(SB, STb, 128, tid);
    bf16x8 qf[4];
    { const bf16_t* qr = P + (size_t)(16 * w + il) * LDP + PC_RQ + h * 128 + 8 * g;
#pragma unroll
      for (int ks = 0; ks < 4; ++ks) qf[ks] = *(const bf16x8*)(qr + 32 * ks); }
    const int iloc = 16 * w + il;
    u32x2 grv[8]; f32x4 nvv[8];
    { const bf16_t* gp0 = (const bf16_t*)(ws + WS_P) + ((size_t)rowbase + iloc) * LDP + PC_RG + h * 128 + 4 * g; const float* nw0 = a.in[I_RNW] + l * 512 + h * 128 + 4 * g;
#pragma unroll
      for (int E = 0; E < 8; ++E) { grv[E] = *(const u32x2*)(gp0 + 16 * E); nvv[E] = *(const f32x4*)(nw0 + 16 * E); } }
    __syncthreads();
    const float l2g = ret_log2g(h);
    f32x4 o[8];
    { const float sf = exp2f(l2g * (float)(iloc + 1)), sb = exp2f(l2g * (float)(RCH - iloc));
#pragma unroll
      for (int E = 0; E < 8; ++E) { f32x4 rf = {0.f, 0.f, 0.f, 0.f}, rb = {0.f, 0.f, 0.f, 0.f};
#pragma unroll
          for (int ks = 0; ks < 4; ++ks) { rf = MFMA16(img_row_frag(SF, lane, E, ks), qf[ks], rf); rb = MFMA16(img_row_frag(SB, lane, E, ks), qf[ks], rb); }
          o[E] = rf * sf + rb * sb; } }
    f32x4 at[8];
#pragma unroll
    for (int T = 0; T < 8; ++T) { f32x4 c = {0.f, 0.f, 0.f, 0.f};
#pragma unroll
        for (int ks = 0; ks < 4; ++ks) c = MFMA16(img_row_frag(KI, lane, T, ks), qf[ks], c);
#pragma unroll
        for (int r = 0; r < 4; ++r) { const int j = 16 * T + 4 * g + r; const int dd = iloc > j ? iloc - j : j - iloc; c[r] *= (dd == 0 ? 2.0f : exp2f(l2g * (float)dd)); }
        at[T] = c; }
#pragma unroll
    for (int s = 0; s < 4; ++s) { const bf16x8 bfr = acc_pair_frag(at[2 * s], at[2 * s + 1]);
#pragma unroll
        for (int E = 0; E < 8; ++E) o[E] = MFMA16(img_tr_frag_acc(VI, lane, E, s), bfr, o[E]); }
    float ss = 0.f;
#pragma unroll
    for (int E = 0; E < 8; ++E) ss += (o[E].x * o[E].x + o[E].y * o[E].y) + (o[E].z * o[E].z + o[E].w * o[E].w);
    ss += __shfl_xor(ss, 16); ss += __shfl_xor(ss, 32);
    const float rn = rsqrtf(ss * (1.0f / 128.0f) + EPS);
    const size_t row = (size_t)rowbase + iloc;
    const bf16_t* gp = (const bf16_t*)(ws + WS_P) + row * LDP + PC_RG + h * 128 + 4 * g;
    const float* nw = a.in[I_RNW] + l * 512 + h * 128 + 4 * g;
    bf16_t* op = (bf16_t*)(ws + WS_H) + row * D + 1024 + h * 128 + 4 * g;
#pragma unroll
    for (int E = 0; E < 8; ++E) { const u32x2 gr = grv[E]; const f32x4 nv = nvv[E];
        u32x2 ov; ov.x = pk2(o[E].x * rn * nv.x * siluf_(bflo(gr.x)), o[E].y * rn * nv.y * siluf_(bfhi(gr.x)));
        ov.y = pk2(o[E].z * rn * nv.z * siluf_(bflo(gr.y)), o[E].w * rn * nv.w * siluf_(bfhi(gr.y)));
        *(u32x2*)(op + 16 * E) = ov; }
}
constexpr int GCH = 64, GNCH = 68;
constexpr size_t WS_GST = WS_OB + (size_t)2 * OBSZ * 2;
constexpr size_t WS_GDEC = WS_END;
constexpr size_t WS_H3B = WS_GDEC + (size_t)16 * 2 * GNCH * 64 * 4;
constexpr size_t WS_ROPE = WS_H3B + (size_t)2 * 4096 * 64 * 2;
constexpr size_t WS_TWID = WS_ROPE + (size_t)(SEQL + LC) * 64 * 8;
constexpr size_t WS_END2 = WS_TWID + 4096 * 8;
__device__ __forceinline__ int gla_rowbase(int b, int cg) { return cg < 4 ? NLAT + b * LC + cg * GCH : b * SEQL + (cg - 4) * GCH; }

constexpr int GLS = 68;
__device__ __forceinline__ void gla_gates_compute(const DArgs& a, unsigned char* ws, LAS float* BF, LAS float* BB, LAS float* GW  , int l, int h, int rowbase, int tid) {
    const int t = tid >> 3, d8 = tid & 7;
    const float* lr = (const float*)(ws + WS_LR) + (size_t)(rowbase + t) * 32;
    f32x4 lv[8];
#pragma unroll
    for (int q = 0; q < 8; ++q) lv[q] = ((const f32x4*)lr)[q];
    { const int dir = tid >> 8, r = (tid >> 4) & 15, c4 = (tid & 15) * 4;
      *(LAS f32x4*)(GW + (dir * 17 + r) * 64 + c4) = *(const f32x4*)(a.in[I_GGW] + (size_t)(l * 2 + dir) * 16 * 256 + r * 256 + h * 64 + c4);
      if (tid < 32) { const int dd = tid >> 4; *(LAS f32x4*)(GW + (dd * 17 + 16) * 64 + c4) = *(const f32x4*)(a.in[I_GGB] + (size_t)(l * 2 + dd) * 256 + h * 64 + c4); } }
    __syncthreads();
    bf16_t* GLG = (bf16_t*)(ws + WS_WIN);
#pragma unroll
    for (int dir = 0; dir < 2; ++dir) {
        const LAS float* gw = GW + dir * 17 * 64 + 8 * d8;
        f32x4 s0 = *(const LAS f32x4*)(gw + 16 * 64), s1 = *(const LAS f32x4*)(gw + 16 * 64 + 4);
#pragma unroll
        for (int j = 0; j < 16; ++j) { const float lj = lv[dir * 4 + (j >> 2)][j & 3]; s0 += lj * *(const LAS f32x4*)(gw + j * 64); s1 += lj * *(const LAS f32x4*)(gw + j * 64 + 4); }
        LAS float* dst = (dir ? BB : BF) + t * GLS + 8 * d8;
        float la[8];
#pragma unroll
        for (int x = 0; x < 8; ++x) { const float s = x < 4 ? s0[x] : s1[x - 4]; const float e = __expf(-fabsf(s)); const float ls = fminf(s, 0.f) - __logf(1.0f + e); la[x] = ls * (1.0f / 16.0f); }
        const u32x4 pk = pack8(la);
        *(u32x4*)(GLG + ((size_t)dir * MR + rowbase + t) * 256 + h * 64 + 8 * d8) = pk;
        float lq[8]; unpack8(pk, lq);
        *(LAS f32x4*)dst = (f32x4){lq[0], lq[1], lq[2], lq[3]}; *(LAS f32x4*)(dst + 4) = (f32x4){lq[4], lq[5], lq[6], lq[7]};
    }
}
__device__ __forceinline__ void gla_gates_load(unsigned char* ws, LAS float* BF, LAS float* BB, int h, int rowbase, int tid) {
    const int t = tid >> 3, d8 = tid & 7;
    const bf16_t* GLG = (const bf16_t*)(ws + WS_WIN);
#pragma unroll
    for (int dir = 0; dir < 2; ++dir) { float lq[8]; unpack8(*(const u32x4*)(GLG + ((size_t)dir * MR + rowbase + t) * 256 + h * 64 + 8 * d8), lq);
        LAS float* dst = (dir ? BB : BF) + t * GLS + 8 * d8;
        *(LAS f32x4*)dst = (f32x4){lq[0], lq[1], lq[2], lq[3]}; *(LAS f32x4*)(dst + 4) = (f32x4){lq[4], lq[5], lq[6], lq[7]}; }
}
__device__ __forceinline__ void gla_scan(LAS float* BF, LAS float* BB, int tid) {
    const int lane = tid & 63, w = tid >> 6;
    __syncthreads();
#pragma unroll 4
    for (int c = 0; c < 16; ++c) { const int col = 16 * w + c; const int dir = col >> 6, d = col & 63;
        LAS float* p = (dir ? BB : BF) + (dir ? 63 - lane : lane) * GLS + d;
        float v = *p;
#pragma unroll
        for (int off = 1; off < 64; off <<= 1) { const float u = __shfl_up(v, off); if (lane >= off) v += u; }
        *p = v; }
    __syncthreads();
}

__device__ __forceinline__ void gla_passA(const DArgs& a, unsigned char* ws, LAS unsigned char* lds, int l, int item, int tid) {
    const int bh = item / GNCH, cg = item % GNCH, b = bh >> 2, h = bh & 3;
    const int lane = tid & 63, w = tid >> 6, g = lane >> 4;
    LAS float* BF = (LAS float*)lds; LAS float* BB = (LAS float*)(lds + 17408); LAS unsigned char* KH = lds + 34816; LAS unsigned char* VI = lds + 34816 + 16384;
    const int rowbase = gla_rowbase(b, cg);
    const bf16_t* P = (const bf16_t*)(ws + WS_P) + (size_t)rowbase * LDP;
    const int t = tid >> 3, d8 = tid & 7;
    const u32x4 kraw = *(const u32x4*)(P + (size_t)t * LDP + PC_GK + h * 64 + 8 * d8);
    u32x4 vraw[2];
#pragma unroll
    for (int i = 0; i < 2; ++i) { const int n = tid + NT * i; vraw[i] = *(const u32x4*)(P + (size_t)(n >> 4) * LDP + PC_GV + h * 128 + (n & 15) * 8); }
    gla_gates_compute(a, ws, BF, BB, (LAS float*)(lds + 34816 + 32768), l, h, rowbase, tid);
    gla_scan(BF, BB, tid);
    { float kf[8], x0[8], x1[8]; unpack8(kraw, kf);
#pragma unroll
      for (int x = 0; x < 8; ++x) { const int d = 8 * d8 + x; x0[x] = kf[x] * __expf(BF[63 * GLS + d] - BF[t * GLS + d]); x1[x] = kf[x] * __expf(BB[d] - BB[t * GLS + d]); }
      *(LAS u32x4*)(KH + off_b(t, d8)) = pack8(x0); *(LAS u32x4*)(KH + off_b(t, 8 + d8)) = pack8(x1);
#pragma unroll
      for (int i = 0; i < 2; ++i) { const int n = tid + NT * i; *(LAS u32x4*)(VI + off_b(n >> 4, n & 15)) = vraw[i]; }
      if (tid < 128) { const int dir = tid >> 6, d = tid & 63; ((float*)(ws + WS_GDEC))[((size_t)(bh * 2 + dir) * GNCH + cg) * 64 + d] = __expf(dir ? BB[d] : BF[63 * GLS + d]); } }
    __syncthreads();
    const int dir = w >> 2, Dt = w & 3;
    bf16x8 af[2];
#pragma unroll
    for (int ks = 0; ks < 2; ++ks) af[ks] = img_tr_frag(KH, lane, dir * 4 + Dt, ks);
    bf16_t* ST = (bf16_t*)(ws + WS_GST) + ((size_t)(bh * 2 + dir) * GNCH + cg) * (128 * 64);
#pragma unroll 2
    for (int E = 0; E < 8; ++E) {
        f32x4 c = {0.f, 0.f, 0.f, 0.f};
#pragma unroll
        for (int ks = 0; ks < 2; ++ks) c = MFMA16(af[ks], img_tr_frag(VI, lane, E, ks), c);
        u32x2 o; o.x = pk2(c.x, c.y); o.y = pk2(c.z, c.w);
        *(u32x2*)(ST + (size_t)(16 * E + (lane & 15)) * 64 + 16 * Dt + 4 * g) = o;
    }
}
__device__ __forceinline__ void gla_passB(unsigned char* ws, LAS unsigned char* lds, int blk, int tid) {
    const int bd = blk >> 1, dir = bd & 1, el = (blk & 1) * 512 + tid;
    LAS float* decs = (LAS float*)lds;
    { const float* dsrc = (const float*)(ws + WS_GDEC) + (size_t)bd * GNCH * 64;
      for (int i = tid; i < GNCH * 64; i += NT) decs[i] = dsrc[i]; }
    __syncthreads();
    bf16_t* base = (bf16_t*)(ws + WS_GST) + (size_t)bd * GNCH * (128 * 64) + (size_t)el * 8;
    const int d0 = (el & 7) * 8;
    float acc[8];
#pragma unroll
    for (int x = 0; x < 8; ++x) acc[x] = 0.f;
#pragma unroll 1
    for (int s0 = 0; s0 < GNCH; s0 += 17) {
        u32x4 kvr[17];
#pragma unroll
        for (int j = 0; j < 17; ++j) { const int s = s0 + j; const int cg = dir == 0 ? s : (s < 4 ? 3 - s : 71 - s); kvr[j] = *(const u32x4*)(base + (size_t)cg * (128 * 64)); }
#pragma unroll
        for (int j = 0; j < 17; ++j) { const int s = s0 + j; const int cg = dir == 0 ? s : (s < 4 ? 3 - s : 71 - s);
            float kv[8]; unpack8(kvr[j], kv);
            const f32x4 q0 = *(const LAS f32x4*)(decs + cg * 64 + d0), q1 = *(const LAS f32x4*)(decs + cg * 64 + d0 + 4);
            *(u32x4*)(base + (size_t)cg * (128 * 64)) = pack8(acc);
#pragma unroll
            for (int x = 0; x < 8; ++x) acc[x] = (x < 4 ? q0[x] : q1[x - 4]) * acc[x] + kv[x]; }
    }
    __syncthreads();
}
__device__ __forceinline__ void gla_passC(const DArgs& a, unsigned char* ws, LAS unsigned char* lds, int l, int item, int tid) {
    const int bh = item / GNCH, cg = item % GNCH, b = bh >> 2, h = bh & 3;
    const int lane = tid & 63, w = tid >> 6, g = lane >> 4, il = lane & 15;
    LAS float* BF = (LAS float*)lds; LAS float* BB = (LAS float*)(lds + 17408);
    LAS unsigned char* QKF = lds + 34816; LAS unsigned char* QKB = QKF + 16384; LAS unsigned char* QH = QKB + 16384; LAS unsigned char* VI = QH + 16384; LAS unsigned char* SI = VI + 16384;
    const int rowbase = gla_rowbase(b, cg);
    const bf16_t* P = (const bf16_t*)(ws + WS_P) + (size_t)rowbase * LDP;
    const int t = tid >> 3, d8 = tid & 7;
    const u32x4 qraw = *(const u32x4*)(P + (size_t)t * LDP + PC_GQ + h * 64 + 8 * d8), kraw = *(const u32x4*)(P + (size_t)t * LDP + PC_GK + h * 64 + 8 * d8);
    u32x4 vraw[2], sraw[4];
#pragma unroll
    for (int i = 0; i < 2; ++i) { const int n = tid + NT * i; vraw[i] = *(const u32x4*)(P + (size_t)(n >> 4) * LDP + PC_GV + h * 128 + (n & 15) * 8); }
    { const bf16_t* STf = (const bf16_t*)(ws + WS_GST) + ((size_t)(bh * 2) * GNCH + cg) * (128 * 64); const bf16_t* STb = STf + (size_t)GNCH * 128 * 64;
#pragma unroll
      for (int i = 0; i < 4; ++i) { const int n = tid + NT * i, row = n >> 4, ch = n & 15; sraw[i] = *(const u32x4*)((ch < 8 ? STf : STb) + (size_t)row * 64 + (ch & 7) * 8); } }
    gla_gates_load(ws, BF, BB, h, rowbase, tid);
    gla_scan(BF, BB, tid);
    { float qf[8], kf[8], o0[8], o1[8], o2[8], o3[8], o4[8], o5[8];
      unpack8(qraw, qf); unpack8(kraw, kf);
#pragma unroll
      for (int x = 0; x < 8; ++x) { const int d = 8 * d8 + x; const float bf = BF[t * GLS + d], bb = BB[t * GLS + d], rf = BF[31 * GLS + d], rb = BB[32 * GLS + d]; const float q = qf[x] * 0.125f;
          o0[x] = q * __expf(bf - rf); o1[x] = kf[x] * __expf(rf - bf); o2[x] = q * __expf(bb - rb); o3[x] = kf[x] * __expf(rb - bb); o4[x] = q * __expf(bf); o5[x] = q * __expf(bb); }
      *(LAS u32x4*)(QKF + off_b(t, d8)) = pack8(o0); *(LAS u32x4*)(QKF + off_b(t, 8 + d8)) = pack8(o1);
      *(LAS u32x4*)(QKB + off_b(t, d8)) = pack8(o2); *(LAS u32x4*)(QKB + off_b(t, 8 + d8)) = pack8(o3);
      *(LAS u32x4*)(QH + off_b(t, d8)) = pack8(o4); *(LAS u32x4*)(QH + off_b(t, 8 + d8)) = pack8(o5);
#pragma unroll
      for (int i = 0; i < 2; ++i) { const int n = tid + NT * i; *(LAS u32x4*)(VI + off_b(n >> 4, n & 15)) = vraw[i]; }
#pragma unroll
      for (int i = 0; i < 4; ++i) { const int n = tid + NT * i; *(LAS u32x4*)(SI + off_b(n >> 4, n & 15)) = sraw[i]; } }
    const int ib = w & 3, eh = w >> 2, iloc = 16 * ib + il;
    u32x2 grv[4]; f32x4 nvv[4];
    { const bf16_t* gp0 = (const bf16_t*)(ws + WS_P) + ((size_t)rowbase + iloc) * LDP + PC_GG + h * 128 + 64 * eh + 4 * g; const float* nw0 = a.in[I_GNW] + l * 512 + h * 128 + 64 * eh + 4 * g;
#pragma unroll
      for (int E4 = 0; E4 < 4; ++E4) { grv[E4] = *(const u32x2*)(gp0 + 16 * E4); nvv[E4] = *(const f32x4*)(nw0 + 16 * E4); } }
    __syncthreads();
    f32x4 at[4];
    { bf16x8 qff[2], qfb[2];
#pragma unroll
      for (int ks = 0; ks < 2; ++ks) { qff[ks] = img_row_frag(QKF, lane, ib, ks); qfb[ks] = img_row_frag(QKB, lane, ib, ks); }
#pragma unroll
      for (int T = 0; T < 4; ++T) { f32x4 cf = {0.f, 0.f, 0.f, 0.f}, cb = {0.f, 0.f, 0.f, 0.f};
#pragma unroll
          for (int ks = 0; ks < 2; ++ks) { cf = MFMA16(img_row_frag(QKF, lane, T, 2 + ks), qff[ks], cf); cb = MFMA16(img_row_frag(QKB, lane, T, 2 + ks), qfb[ks], cb); }
#pragma unroll
          for (int r = 0; r < 4; ++r) { const int j = 16 * T + 4 * g + r; cf[r] = (j <= iloc ? cf[r] : 0.f) + (j >= iloc ? cb[r] : 0.f); }
          at[T] = cf; } }
    f32x4 o[4];
    { bf16x8 hf[2], hb[2];
#pragma unroll
      for (int ks = 0; ks < 2; ++ks) { hf[ks] = img_row_frag(QH, lane, ib, ks); hb[ks] = img_row_frag(QH, lane, ib, 2 + ks); }
#pragma unroll
      for (int E4 = 0; E4 < 4; ++E4) { const int E = 4 * eh + E4; f32x4 c = {0.f, 0.f, 0.f, 0.f};
#pragma unroll
          for (int ks = 0; ks < 2; ++ks) { c = MFMA16(img_row_frag(SI, lane, E, ks), hf[ks], c); c = MFMA16(img_row_frag(SI, lane, E, 2 + ks), hb[ks], c); }
          o[E4] = c; } }
#pragma unroll
    for (int s = 0; s < 2; ++s) { const bf16x8 bfr = acc_pair_frag(at[2 * s], at[2 * s + 1]);
#pragma unroll
        for (int E4 = 0; E4 < 4; ++E4) o[E4] = MFMA16(img_tr_frag_acc(VI, lane, 4 * eh + E4, s), bfr, o[E4]); }
    float ss = 0.f;
#pragma unroll
    for (int E4 = 0; E4 < 4; ++E4) ss += (o[E4].x * o[E4].x + o[E4].y * o[E4].y) + (o[E4].z * o[E4].z + o[E4].w * o[E4].w);
    ss += __shfl_xor(ss, 16); ss += __shfl_xor(ss, 32);
    LAS float* red = (LAS float*)lds;
    if (g == 0) red[eh * 64 + iloc] = ss;
    __syncthreads();
    const float rn = rsqrtf((red[iloc] + red[64 + iloc]) * (1.0f / 128.0f) + EPS);
    const size_t row = (size_t)rowbase + iloc;
    const bf16_t* gp = (const bf16_t*)(ws + WS_P) + row * LDP + PC_GG + h * 128 + 64 * eh + 4 * g;
    const float* nw = a.in[I_GNW] + l * 512 + h * 128 + 64 * eh + 4 * g;
    bf16_t* op = (bf16_t*)(ws + WS_H) + row * D + 1536 + h * 128 + 64 * eh + 4 * g;
#pragma unroll
    for (int E4 = 0; E4 < 4; ++E4) { const u32x2 gr = grv[E4]; const f32x4 nv = nvv[E4];
        u32x2 ov; ov.x = pk2(o[E4].x * rn * nv.x * siluf_(bflo(gr.x)), o[E4].y * rn * nv.y * siluf_(bfhi(gr.x)));
        ov.y = pk2(o[E4].z * rn * nv.z * siluf_(bflo(gr.y)), o[E4].w * rn * nv.w * siluf_(bfhi(gr.y)));
        *(u32x2*)(op + 16 * E4) = ov; }
}
constexpr int SNCH = 68;
constexpr size_t WS_S5ST = WS_OB + (size_t)4 * OBSZ * 2;
constexpr size_t WS_S5BTB = WS_S5BT;
constexpr size_t WS_S5CPB = WS_S5BT + 524288;
constexpr size_t WS_S5A64 = WS_S5BT + 1048576;

__device__ __forceinline__ void prep_s5b(const DArgs& a, unsigned char* ws, int it, int tid) {
    const int idx = it * 512 + tid;
    const int gi = idx >> 6, p = idx & 63;
    const float a_re = a.in[I_S5ARE][idx], a_im = a.in[I_S5AIM][idx], ldt = a.in[I_S5LDT][gi];
    const float dt = expf(ldt), mag = expf(a_re * dt);
    float sn, cs; sincosf(a_im * dt, &sn, &cs);
    const float ab_re = mag * cs, ab_im = mag * sn, den = a_re * a_re + a_im * a_im, nr = ab_re - 1.0f;
    const float co_re = (nr * a_re + ab_im * a_im) / den, co_im = (ab_im * a_re - nr * a_im) / den;
    ((f32x2*)(ws + WS_S5AB))[idx] = (f32x2){ab_re, ab_im};
    float pr = ab_re, pi = ab_im;
#pragma unroll
    for (int q = 0; q < 6; ++q) { const float nr2 = pr * pr - pi * pi, ni2 = 2.0f * pr * pi; pr = nr2; pi = ni2; }
    ((f32x2*)(ws + WS_S5A64))[idx] = (f32x2){pr, pi};
    const float* bre = a.in[I_S5BRE] + (size_t)idx * 16; const float* bim = a.in[I_S5BIM] + (size_t)idx * 16;
    float tr[16], ti[16];
#pragma unroll
    for (int i = 0; i < 16; ++i) { const float br = bre[i], bi = bim[i]; tr[i] = co_re * br - co_im * bi; ti[i] = co_re * bi + co_im * br; }
    bf16_t* btb = (bf16_t*)(ws + WS_S5BTB) + (size_t)gi * 128 * 16;
#pragma unroll
    for (int hlf = 0; hlf < 2; ++hlf) { u32x4 w0, w1; const float* s = hlf ? ti : tr;
        w0.x = pk2(s[0], s[1]); w0.y = pk2(s[2], s[3]); w0.z = pk2(s[4], s[5]); w0.w = pk2(s[6], s[7]); w1.x = pk2(s[8], s[9]); w1.y = pk2(s[10], s[11]); w1.z = pk2(s[12], s[13]); w1.w = pk2(s[14], s[15]);
        *(u32x4*)(btb + (size_t)(64 * hlf + p) * 16) = w0; *(u32x4*)(btb + (size_t)(64 * hlf + p) * 16 + 8) = w1; }
    bf16_t* cpb = (bf16_t*)(ws + WS_S5CPB) + (size_t)gi * 16 * 128;
    const float* cre = a.in[I_S5CRE] + (size_t)gi * 1024; const float* cim = a.in[I_S5CIM] + (size_t)gi * 1024;
#pragma unroll
    for (int i = 0; i < 16; ++i) *(unsigned*)(cpb + i * 128 + 2 * p) = pk2(cre[i * 64 + p], -cim[i * 64 + p]);
}

struct S5Unit { bf16x8 btf[8]; f32x2 ab; f32x2 h; const bf16_t* cp; };
template <bool PASSC> __device__ __forceinline__ void s5_load_unit(S5Unit& U, unsigned char* ws, const bf16_t* P, const f32x2* ST, int l, int b, int cs, int rowbase, int grp, int dir, int lane) {
    const int g = lane >> 4, il = lane & 15;
    const bf16x8 zero8 = {0, 0, 0, 0, 0, 0, 0, 0};
    const int gi = (l * 2 + dir) * 32 + grp;
    U.ab = ((const f32x2*)(ws + WS_S5AB))[gi * 64 + lane];
    const size_t sidx = ((size_t)(b * SNCH + cs) * 2 + dir) * 2048 + grp * 64 + lane;
    U.h = PASSC ? ST[sidx] : (f32x2){0.f, 0.f};
    const bf16_t* bt = (const bf16_t*)(ws + WS_S5BTB) + (size_t)gi * 128 * 16 + (size_t)il * 16 + 8 * (g & 1);
#pragma unroll
    for (int Pt = 0; Pt < 8; ++Pt) { const bf16x8 v = *(const bf16x8*)(bt + Pt * 256); U.btf[Pt] = g < 2 ? v : zero8; }
    U.cp = (const bf16_t*)(ws + WS_S5CPB) + (size_t)gi * 16 * 128 + (size_t)il * 128 + 8 * g;
}
__device__ __forceinline__ void s5_load_u(bf16x8 (&ufa)[4], const bf16_t* P, int rowbase, int grp, int lane) {
    const int g = lane >> 4, il = lane & 15; const bf16x8 zero8 = {0, 0, 0, 0, 0, 0, 0, 0};
#pragma unroll
    for (int Tt = 0; Tt < 4; ++Tt) { const bf16x8 v = *(const bf16x8*)(P + (size_t)(rowbase + 16 * Tt + il) * LDP + PC_S5U + grp * 16 + 8 * (g & 1)); ufa[Tt] = g < 2 ? v : zero8; }
}
template <bool PASSC, int DIR> __device__ __forceinline__ void s5_run_unit(const S5Unit& U, const bf16x8 (&ufa)[4], f32x4 (&yacc)[4], f32x2& hout, LAS float* BU, LAS unsigned char* HW, int lane) {
    const int g = lane >> 4, il = lane & 15;
    f32x2 h = U.h; const f32x2 ab = U.ab;
    bf16x8 cpf[4];
    if (PASSC) {
#pragma unroll
        for (int ks = 0; ks < 4; ++ks) cpf[ks] = *(const bf16x8*)(U.cp + 32 * ks); }
    f32x4 d[8];
#pragma unroll
    for (int Pt = 0; Pt < 8; ++Pt) d[Pt] = MFMA16(U.btf[Pt], ufa[DIR ? 3 : 0], ((f32x4){0.f, 0.f, 0.f, 0.f}));
#pragma unroll
    for (int wi = 0; wi < 4; ++wi) {
        const int Tt = DIR ? 3 - wi : wi;
#pragma unroll
        for (int Pt = 0; Pt < 8; ++Pt) {
#pragma unroll
            for (int r = 0; r < 4; ++r) BU[(16 * Pt + 4 * g + r) * 20 + il] = d[Pt][r]; }
        asm volatile("" ::: "memory");
        if (!PASSC) {
            f32x4 br[4], bi[4];
#pragma unroll
            for (int q = 0; q < 4; ++q) { br[q] = *(const LAS f32x4*)(BU + lane * 20 + 4 * q); bi[q] = *(const LAS f32x4*)(BU + (64 + lane) * 20 + 4 * q); }
            if (wi < 3) {
#pragma unroll
                for (int Pt = 0; Pt < 8; ++Pt) d[Pt] = MFMA16(U.btf[Pt], ufa[DIR ? 2 - wi : wi + 1], ((f32x4){0.f, 0.f, 0.f, 0.f})); }
#pragma unroll
            for (int s = 0; s < 16; ++s) { const int tt = DIR ? 15 - s : s;
                const float hr = __builtin_fmaf(ab.x, h.x, __builtin_fmaf(-ab.y, h.y, br[tt >> 2][tt & 3])), hi = __builtin_fmaf(ab.x, h.y, __builtin_fmaf(ab.y, h.x, bi[tt >> 2][tt & 3]));
                h = (f32x2){hr, hi}; }
        } else {
#pragma unroll
            for (int hf2 = 0; hf2 < 2; ++hf2) { const int q0 = DIR ? 2 - 2 * hf2 : 2 * hf2;
                f32x4 br[2], bi[2];
#pragma unroll
                for (int q = 0; q < 2; ++q) { br[q] = *(const LAS f32x4*)(BU + lane * 20 + 4 * (q0 + q)); bi[q] = *(const LAS f32x4*)(BU + (64 + lane) * 20 + 4 * (q0 + q)); }
#pragma unroll
                for (int s = 0; s < 8; ++s) { const int t8 = DIR ? 7 - s : s; const int tt = 4 * q0 + t8;
                    const float hr = __builtin_fmaf(ab.x, h.x, __builtin_fmaf(-ab.y, h.y, br[t8 >> 2][t8 & 3])), hi = __builtin_fmaf(ab.x, h.y, __builtin_fmaf(ab.y, h.x, bi[t8 >> 2][t8 & 3]));
                    h = (f32x2){hr, hi};
                    *(LAS unsigned*)(HW + off_b(tt, lane >> 2) + (lane & 3) * 4) = pk2(hr, hi); }
            }
        }
        asm volatile("" ::: "memory");
        if (PASSC) {
            bf16x8 hf[4];
#pragma unroll
            for (int ks = 0; ks < 4; ++ks) hf[ks] = img_row_frag(HW, lane, 0, ks);
#pragma unroll
            for (int ks = 0; ks < 4; ++ks) yacc[Tt] = MFMA16(cpf[ks], hf[ks], yacc[Tt]);
            }
        asm volatile("" ::: "memory");
        if (PASSC && wi < 3) {
#pragma unroll
            for (int Pt = 0; Pt < 8; ++Pt) d[Pt] = MFMA16(U.btf[Pt], ufa[DIR ? 2 - wi : wi + 1], ((f32x4){0.f, 0.f, 0.f, 0.f})); }
    }
    hout = h;
}
template <bool PASSC> __device__ __forceinline__ void s5_item(const DArgs& a, unsigned char* ws, LAS unsigned char* lds, int l, int item, int ggsel, int tid) {
    const int b = item / (SNCH * 2), rem = item % (SNCH * 2), cs = rem >> 1, half = rem & 1;
    const int lane = tid & 63, w = tid >> 6, g = lane >> 4, il = lane & 15;
    const int rowbase = gla_rowbase(b, cs);
    LAS float* BU = (LAS float*)(lds + w * 14336); LAS unsigned char* HW = lds + w * 14336 + 10240;
    const bf16_t* P = (const bf16_t*)(ws + WS_P);
    f32x2* ST = (f32x2*)(ws + WS_S5ST);
    const int grp0 = 16 * half + w, grp1 = grp0 + 8;
    S5Unit UA; bf16x8 ufa[4];
    { const int gg = ggsel;
        const int grp = gg ? grp1 : grp0;
        f32x4 yacc[4];
#pragma unroll
        for (int q = 0; q < 4; ++q) yacc[q] = (f32x4){0.f, 0.f, 0.f, 0.f};
        f32x2 hend;
        u32x2 urv[4], sgv[4]; f32x4 dskv = {0.f, 0.f, 0.f, 0.f};
        if (PASSC) { dskv = *(const f32x4*)(a.in[I_S5D] + l * 512 + grp * 16 + 4 * g);
#pragma unroll
            for (int Tt = 0; Tt < 4; ++Tt) { const size_t row = (size_t)rowbase + 16 * Tt + il; urv[Tt] = *(const u32x2*)(P + row * LDP + PC_S5U + grp * 16 + 4 * g); sgv[Tt] = *(const u32x2*)(P + row * LDP + PC_S5G + grp * 16 + 4 * g); } }
        s5_load_unit<PASSC>(UA, ws, P, ST, l, b, cs, rowbase, grp, 0, lane); s5_load_u(ufa, P, rowbase, grp, lane);
        s5_run_unit<PASSC, 0>(UA, ufa, yacc, hend, BU, HW, lane);
        if (!PASSC) ST[((size_t)(b * SNCH + cs) * 2 + 0) * 2048 + grp * 64 + lane] = hend;
        s5_load_unit<PASSC>(UA, ws, P, ST, l, b, cs, rowbase, grp, 1, lane);
        s5_run_unit<PASSC, 1>(UA, ufa, yacc, hend, BU, HW, lane);
        if (!PASSC) ST[((size_t)(b * SNCH + cs) * 2 + 1) * 2048 + grp * 64 + lane] = hend;
        if (PASSC) {
            const f32x4 dsk = dskv;
            bf16_t* G5 = (bf16_t*)(ws + WS_KF);
#pragma unroll
            for (int Tt = 0; Tt < 4; ++Tt) { const size_t row = (size_t)rowbase + 16 * Tt + il;
                const u32x2 ur = urv[Tt], sg = sgv[Tt];
                const float g0 = gelu_tanh(yacc[Tt].x + bflo(ur.x) * dsk.x), g1 = gelu_tanh(yacc[Tt].y + bfhi(ur.x) * dsk.y), g2 = gelu_tanh(yacc[Tt].z + bflo(ur.y) * dsk.z), g3 = gelu_tanh(yacc[Tt].w + bfhi(ur.y) * dsk.w);
                u32x2 ov; ov.x = pk2(g0, g1); ov.y = pk2(g2, g3);
                *(u32x2*)(G5 + row * 512 + grp * 16 + 4 * g) = ov;
                ov.x = pk2(g0 * siluf_(bflo(sg.x)), g1 * siluf_(bfhi(sg.x))); ov.y = pk2(g2 * siluf_(bflo(sg.y)), g3 * siluf_(bfhi(sg.y)));
                *(u32x2*)(G5 + OBSZ + row * 512 + grp * 16 + 4 * g) = ov; }
        }
    }
}
__device__ __forceinline__ void s5_passB(unsigned char* ws, int l, int gt) {
    const int p = gt & 63, grp = (gt >> 6) & 31, dir = (gt >> 11) & 1, b = gt >> 12;
    const f32x2 a64 = ((const f32x2*)(ws + WS_S5A64))[((l * 2 + dir) * 32 + grp) * 64 + p];
    f32x2* ST = (f32x2*)(ws + WS_S5ST);
    f32x2 acc = {0.f, 0.f};
#pragma unroll 1
    for (int s0 = 0; s0 < SNCH; s0 += 34) {
        f32x2 ev[34];
#pragma unroll
        for (int j = 0; j < 34; ++j) { const int s = s0 + j; const int cs = dir == 0 ? s : (s < 4 ? 3 - s : 71 - s); ev[j] = ST[((size_t)(b * SNCH + cs) * 2 + dir) * 2048 + grp * 64 + p]; }
#pragma unroll
        for (int j = 0; j < 34; ++j) { const int s = s0 + j; const int cs = dir == 0 ? s : (s < 4 ? 3 - s : 71 - s);
            ST[((size_t)(b * SNCH + cs) * 2 + dir) * 2048 + grp * 64 + p] = acc;
            acc = (f32x2){a64.x * acc.x - a64.y * acc.y + ev[j].x, a64.x * acc.y + a64.y * acc.x + ev[j].y}; }
    }
}
constexpr int FFT_PHYS = 8448;
__device__ __forceinline__ void fft_twiddles_g(LAS f32x2* W, const f32x2* Wg, int tid) {
#pragma unroll
    for (int j = 0; j < 8; ++j) W[tid + NT * j] = Wg[tid + NT * j];
}
__device__ __forceinline__ int fphys(int i) { return i + (i >> 5); }
__device__ __forceinline__ f32x2 cmulf(const f32x2 a, const f32x2 b) { return (f32x2){a.x * b.x - a.y * b.y, a.x * b.y + a.y * b.x}; }
__device__ __forceinline__ f32x2 cmulcf(const f32x2 a, const f32x2 b) { return (f32x2){a.x * b.x + a.y * b.y, a.y * b.x - a.x * b.y}; }
template <int RL> __device__ __forceinline__ void dft_fwd_const(f32x2 (&e)[1 << RL]) {
#pragma unroll
    for (int s = 0; s < RL; ++s) { const int h = 1 << (RL - 1 - s);
#pragma unroll
        for (int m = 0; m < (1 << RL); ++m) { if (m & h) continue;
            const int mp = m & (h - 1); const f32x2 a_ = e[m], b_ = e[m | h]; const f32x2 d = a_ - b_; e[m] = a_ + b_;
            if (mp == 0) e[m | h] = d;
            else if (2 * mp == h) e[m | h] = (f32x2){d.y, -d.x};
            else { const float ang = -3.14159265358979323846f * (float)mp / (float)h; const f32x2 c = {__builtin_cosf(ang), __builtin_sinf(ang)}; e[m | h] = cmulf(d, c); } } }
}
template <int RL> __device__ __forceinline__ void dft_inv_const(f32x2 (&e)[1 << RL]) {
#pragma unroll
    for (int ss = 0; ss < RL; ++ss) { const int s = RL - 1 - ss; const int h = 1 << (RL - 1 - s);
#pragma unroll
        for (int m = 0; m < (1 << RL); ++m) { if (m & h) continue;
            const int mp = m & (h - 1); const f32x2 a_ = e[m], b_ = e[m | h]; f32x2 t;
            if (mp == 0) t = b_;
            else if (2 * mp == h) t = (f32x2){-b_.y, b_.x};
            else { const float ang = -3.14159265358979323846f * (float)mp / (float)h; const f32x2 c = {__builtin_cosf(ang), __builtin_sinf(ang)}; t = cmulcf(b_, c); }
            e[m] = a_ + t; e[m | h] = a_ - t; } }
}
template <int RL> __device__ __forceinline__ constexpr int brev_c(int m) { int r = 0; for (int i = 0; i < RL; ++i) r |= ((m >> i) & 1) << (RL - 1 - i); return r; }
template <int RL, bool CONJ> __device__ __forceinline__ void apply_tw(f32x2 (&e)[1 << RL], const f32x2 w1) {
    f32x2 tw[1 << RL];
    tw[0] = (f32x2){1.f, 0.f}; tw[1] = w1;
    if (RL >= 2) { tw[2] = cmulf(w1, w1); tw[3] = cmulf(tw[2], w1); }
    if (RL >= 3) { tw[4] = cmulf(tw[2], tw[2]); tw[5] = cmulf(tw[4], tw[1]); tw[6] = cmulf(tw[4], tw[2]); tw[7] = cmulf(tw[4], tw[3]); }
    if (RL >= 4) { tw[8] = cmulf(tw[4], tw[4]);
#pragma unroll
        for (int k = 1; k < 8; ++k) tw[8 + k] = cmulf(tw[8], tw[k]); }
#pragma unroll
    for (int m = 1; m < (1 << RL); ++m) e[m] = CONJ ? cmulcf(e[m], tw[brev_c<RL>(m)]) : cmulf(e[m], tw[brev_c<RL>(m)]);
}
template <int RL, int BETA, bool INV, class WP> __device__ __forceinline__ void fft2_pass(LAS f32x2* X, WP W, int tid) {
    constexpr int LOW = BETA - RL + 1, NG = FFTN >> RL, STR = (1 << LOW) + (1 << (LOW - 5));
#pragma unroll 1
    for (int gi = tid; gi < NG; gi += NT) {
        const int base = ((gi >> LOW) << (BETA + 1)) | (gi & ((1 << LOW) - 1));
        volatile LAS f32x2* p = X + fphys(base);
        f32x2 e[1 << RL];
#pragma unroll
        for (int m = 0; m < (1 << RL); ++m) e[m] = p[m * STR];
        const f32x2 w1 = W[(base & ((1 << LOW) - 1)) << (12 - BETA)];
        if (!INV) { dft_fwd_const<RL>(e); apply_tw<RL, false>(e, w1); }
        else { apply_tw<RL, true>(e, w1); dft_inv_const<RL>(e); }
#pragma unroll
        for (int m = 0; m < (1 << RL); ++m) p[m * STR] = e[m];
    }
}
template <class WP> __device__ __forceinline__ void fft2_fwd_ABC(LAS f32x2* X, WP W, int tid) {
    fft2_pass<4, 12, false>(X, W, tid); __syncthreads(); fft2_pass<4, 8, false>(X, W, tid); __syncthreads();
}
template <class WP> __device__ __forceinline__ void fft2_inv_CBA(LAS f32x2* X, WP W, int tid) {
    fft2_pass<4, 8, true>(X, W, tid); __syncthreads(); fft2_pass<4, 12, true>(X, W, tid); __syncthreads();
}
__device__ __forceinline__ void fft2_mid_mul(LAS f32x2* X, const f32x2* KF, int tid) {
    if (tid < 256) {
        volatile LAS f32x2* p = X + 33 * tid;
        f32x2 e[32];
#pragma unroll
        for (int m = 0; m < 32; ++m) e[m] = p[m];
        dft_fwd_const<5>(e);
#pragma unroll
        for (int q4 = 0; q4 < 4; ++q4) { f32x4 kf[4];
#pragma unroll
            for (int q = 0; q < 4; ++q) kf[q] = *(const f32x4*)(KF + 32 * tid + 8 * q4 + 2 * q);
#pragma unroll
            for (int q = 0; q < 4; ++q) { const int m = 8 * q4 + 2 * q; e[m] = cmulf(e[m], (f32x2){kf[q].x, kf[q].y}); e[m + 1] = cmulf(e[m + 1], (f32x2){kf[q].z, kf[q].w}); } }
        dft_inv_const<5>(e);
#pragma unroll
        for (int m = 0; m < 32; ++m) p[m] = e[m];
    }
}
__device__ __forceinline__ void fft2_fwd_D(LAS f32x2* X, int tid) {
    if (tid < 256) { volatile LAS f32x2* p = X + 33 * tid; f32x2 e[32];
#pragma unroll
        for (int m = 0; m < 32; ++m) e[m] = p[m];
        dft_fwd_const<5>(e);
#pragma unroll
        for (int m = 0; m < 32; ++m) p[m] = e[m]; }
}

__device__ __forceinline__ void filt_item2(const DArgs& a, unsigned char* ws, LAS unsigned char* lds, int l, int c, int tid) {
    LAS f32x2* X = (LAS f32x2*)lds; LAS f32x2* W = (LAS f32x2*)(lds + FFT_PHYS * 8); LAS float* w4s = (LAS float*)(lds + FFT_PHYS * 8 + 32768); LAS float* red = w4s + 256;
    fft_twiddles_g(W, (const f32x2*)(ws + WS_TWID), tid);
    if (tid < 128) { const int cc = tid >> 5, pr = tid & 31; const float* wsrc = a.in[I_HW4] + (size_t)l * 64 * 2048 + (cc >> 1) * 1024 + (cc & 1) * 512 + c;
        ((LAS unsigned*)w4s)[pr * 4 + cc] = pk2(wsrc[(size_t)(2 * pr) * 2048], wsrc[(size_t)(2 * pr + 1) * 2048]); }
    if (tid == 0) { float z0; asm volatile("v_mov_b32 %0, 0" : "=v"(z0)); X[fphys(4096)] = (f32x2){z0, z0}; }
    __syncthreads();
    const float dl = fabsf(HY_D0 + (HY_D1 - HY_D0) * ((float)c / 511.0f));
    const bf16_t* H3 = (const bf16_t*)(ws + WS_H3B) + (size_t)l * 4096 * 64;
    float ss0 = 0.f, ss1 = 0.f;
#pragma unroll 1
    for (int j = 0; j < 8; ++j) {
        const int t = tid + 512 * j;
        const u32x4* hr = (const u32x4*)(H3 + (size_t)t * 64);
        u32x4 hraw[8];
#pragma unroll
        for (int q = 0; q < 8; ++q) hraw[q] = hr[q];
        asm volatile("" ::: "memory");
        float f0 = 0.f, f1 = 0.f, b0 = 0.f, b1 = 0.f;
        typedef __bf16 bfp2 __attribute__((ext_vector_type(2)));
#pragma unroll
        for (int q = 0; q < 8; ++q) {
#pragma unroll
            for (int e = 0; e < 4; ++e) { const u32x4 wq = ((const LAS u32x4*)w4s)[4 * q + e]; const unsigned hx = hraw[q][e];
                f0 += bflo(hx) * bflo(wq.x) + bfhi(hx) * bfhi(wq.x); f1 += bflo(hx) * bflo(wq.y) + bfhi(hx) * bfhi(wq.y);
                b0 += bflo(hx) * bflo(wq.z) + bfhi(hx) * bfhi(wq.z); b1 += bflo(hx) * bflo(wq.w) + bfhi(hx) * bfhi(wq.w); } }
        const float dec = expf(-((float)t / 4095.0f) * dl); f0 *= dec; f1 *= dec; b0 *= dec; b1 *= dec;
        X[fphys(t)] = (f32x2){f0, f1}; ss0 += f0 * f0; ss1 += f1 * f1;
        if (t > 0) { X[fphys(8192 - t)] = (f32x2){b0, b1}; ss0 += b0 * b0; ss1 += b1 * b1; }
    }
    const float rs0 = rsqrtf(block_sum(ss0, red, tid) + EPS), rs1 = rsqrtf(block_sum(ss1, red, tid) + EPS);
#pragma unroll 4
    for (int j = 0; j < 16; ++j) { const int n = fphys(tid + 512 * j); const f32x2 x = X[n]; X[n] = (f32x2){x.x * rs0, x.y * rs1}; }
    __syncthreads(); fft2_fwd_ABC(X, W, tid); fft2_fwd_D(X, tid); __syncthreads();
    f32x2* KF0 = (f32x2*)(ws + WS_KF) + (size_t)(0 * 512 + c) * FFTN; f32x2* KF1 = (f32x2*)(ws + WS_KF) + (size_t)(1 * 512 + c) * FFTN;
#pragma unroll 4
    for (int j = 0; j < 16; ++j) { const int pos = tid + 512 * j; const int k = (int)(__brev((unsigned)pos) >> 19); const int pp = (int)(__brev((unsigned)((8192 - k) & 8191)) >> 19);
        const f32x2 za = X[fphys(pos)], zb = X[fphys(pp)];
        KF0[pos] = (f32x2){0.5f * (za.x + zb.x), 0.5f * (za.y - zb.y)};
        KF1[pos] = (f32x2){0.5f * (za.y + zb.y), 0.5f * (zb.x - za.x)}; }
    __syncthreads();
}

struct Raw8 { u32x4 mid; bf16_t lf, rt; };
__device__ __forceinline__ Raw8 ld_raw8(const bf16_t* p, int t0, int Lx) { Raw8 r; r.mid = *(const u32x4*)(p + t0); r.lf = t0 > 0 ? p[t0 - 1] : (bf16_t)0; r.rt = t0 + 8 < Lx ? p[t0 + 8] : (bf16_t)0; return r; }
__device__ __forceinline__ void sconv8(const Raw8& r, float w0, float w1, float w2, float cb, float (&o)[8]) {
    float x[10]; x[0] = bf2f(r.lf); x[9] = bf2f(r.rt);
    x[1] = bflo(r.mid.x); x[2] = bfhi(r.mid.x); x[3] = bflo(r.mid.y); x[4] = bfhi(r.mid.y); x[5] = bflo(r.mid.z); x[6] = bfhi(r.mid.z); x[7] = bflo(r.mid.w); x[8] = bfhi(r.mid.w);
#pragma unroll
    for (int i = 0; i < 8; ++i) o[i] = w0 * x[i] + w1 * x[i + 1] + w2 * x[i + 2] + cb;
}
__device__ __forceinline__ void hyena_item2(const DArgs& a, unsigned char* ws, LAS unsigned char* lds, int l, int c, int tid) {
    LAS f32x2* X = (LAS f32x2*)lds; LAS f32x2* X2 = (LAS f32x2*)(lds + FFT_PHYS * 8);
    const f32x2* Wg = (const f32x2*)(ws + WS_TWID);
    const float* cw = a.in[I_HCW] + (size_t)l * 3 * 1536; const float* cbp = a.in[I_HCB] + (size_t)l * 1536;
    const float wv0 = cw[c], wv1 = cw[1536 + c], wv2 = cw[3072 + c], bv = cbp[c];
    const float wa0 = cw[512 + c], wa1 = cw[1536 + 512 + c], wa2 = cw[3072 + 512 + c], ba = cbp[512 + c];
    const float wb0 = cw[1024 + c], wb1 = cw[1536 + 1024 + c], wb2 = cw[3072 + 1024 + c], bb = cbp[1024 + c];
    const float bias0 = a.in[I_HBIAS][(l * 2 + 0) * 512 + c], bias1 = a.in[I_HBIAS][(l * 2 + 1) * 512 + c];
    const bf16_t* PT = (const bf16_t*)(ws + WS_PT);
    const bf16_t* pv = PT + (size_t)(PT_V + c) * MR; const bf16_t* pg1 = PT + (size_t)(PT_G1 + c) * MR; const bf16_t* pg2 = PT + (size_t)(PT_G2 + c) * MR; const bf16_t* phg = PT + (size_t)(PT_HG + c) * MR;
    const f32x2* KF0 = (const f32x2*)(ws + WS_KF) + (size_t)(0 * 512 + c) * FFTN; const f32x2* KF1 = (const f32x2*)(ws + WS_KF) + (size_t)(1 * 512 + c) * FFTN;
    const int t0 = 8 * tid;
    const int po = 8 * tid + (tid >> 2);
    LAS f32x2* px = X + po; LAS f32x2* py = X2 + po;
    float z[4][8];
    { Raw8 v[4];
#pragma unroll
      for (int b = 0; b < 4; ++b) v[b] = ld_raw8(pv + b * SEQL, t0, SEQL);
#pragma unroll
      for (int b = 0; b < 4; ++b) sconv8(v[b], wv0, wv1, wv2, bv, z[b]); }
    Raw8 g1r[4];
#pragma unroll
    for (int b = 0; b < 4; ++b) g1r[b] = ld_raw8(pg1 + b * SEQL, t0, SEQL);
#pragma unroll
    for (int x = 0; x < 8; ++x) { px[x] = (f32x2){z[0][x], z[1][x]}; px[4224 + x] = (f32x2){0.f, 0.f}; py[x] = (f32x2){z[2][x], z[3][x]}; py[4224 + x] = (f32x2){0.f, 0.f}; }
    __syncthreads();
#define HY_CONV(KFp) do { \
        fft2_pass<4, 12, false>(X, Wg, tid); fft2_pass<4, 12, false>(X2, Wg, tid); __syncthreads(); \
        fft2_pass<4, 8, false>(X, Wg, tid); fft2_pass<4, 8, false>(X2, Wg, tid); __syncthreads(); \
        fft2_mid_mul(tid < 256 ? X : X2, KFp, tid & 255); __syncthreads(); \
        fft2_pass<4, 8, true>(X, Wg, tid); fft2_pass<4, 8, true>(X2, Wg, tid); __syncthreads(); \
        fft2_pass<4, 12, true>(X, Wg, tid); fft2_pass<4, 12, true>(X2, Wg, tid); __syncthreads(); } while (0)
    HY_CONV(KF0);
    { float g[4][8];
#pragma unroll
      for (int b = 0; b < 4; ++b) sconv8(g1r[b], wa0, wa1, wa2, ba, g[b]);
#pragma unroll
      for (int x = 0; x < 8; ++x) { const f32x2 c0 = px[x] * (1.0f / 8192.0f), c1 = py[x] * (1.0f / 8192.0f);
          z[0][x] = g[0][x] * (c0.x + bias0 * z[0][x]); z[1][x] = g[1][x] * (c0.y + bias0 * z[1][x]); z[2][x] = g[2][x] * (c1.x + bias0 * z[2][x]); z[3][x] = g[3][x] * (c1.y + bias0 * z[3][x]); } }
    Raw8 g2r[4]; u32x4 hgr[4];
#pragma unroll
    for (int b = 0; b < 4; ++b) { g2r[b] = ld_raw8(pg2 + b * SEQL, t0, SEQL); hgr[b] = *(const u32x4*)(phg + b * SEQL + t0); }
    __syncthreads();
#pragma unroll
    for (int x = 0; x < 8; ++x) { px[x] = (f32x2){z[0][x], z[1][x]}; px[4224 + x] = (f32x2){0.f, 0.f}; py[x] = (f32x2){z[2][x], z[3][x]}; py[4224 + x] = (f32x2){0.f, 0.f}; }
    __syncthreads();
    HY_CONV(KF1);
#undef HY_CONV
    bf16_t* pvw = (bf16_t*)(ws + WS_PT) + (size_t)(PT_V + c) * MR;
#pragma unroll
    for (int b = 0; b < 4; ++b) { float g[8], hh[8], o[8]; sconv8(g2r[b], wb0, wb1, wb2, bb, g); unpack8(hgr[b], hh);
#pragma unroll
        for (int x = 0; x < 8; ++x) { const f32x2 cv = ((b < 2) ? px[x] : py[x]) * (1.0f / 8192.0f); const float cvv = (b & 1) ? cv.y : cv.x;
            o[x] = g[x] * (cvv + bias1 * z[b][x]) * siluf_(hh[x]); }
        *(u32x4*)(pvw + b * SEQL + t0) = pack8(o); }
    __syncthreads();
}
__device__ __forceinline__ void hy_transpose_item(unsigned char* ws, LAS unsigned char* lds, int item, int tid, int nrows) {
    const int lane = tid & 63, w = tid >> 6;
    const int wi = item * 8 + w;
    const int nrb = nrows / 64;
    if (wi >= nrb * 8) return;
    const int rb = wi >> 3, cb = wi & 7;
    LAS bf16_t* T = (LAS bf16_t*)(lds + w * 8704);
    const bf16_t* src = (const bf16_t*)(ws + WS_PT) + (size_t)(PT_V + cb * 64) * MR + (size_t)rb * 64;
    u32x4 tv[8];
#pragma unroll
    for (int i = 0; i < 8; ++i) { const int c = 8 * i + (lane >> 3), r8 = (lane & 7) * 8; tv[i] = *(const u32x4*)(src + (size_t)c * MR + r8); }
#pragma unroll
    for (int i = 0; i < 8; ++i) { const int c = 8 * i + (lane >> 3), r8 = (lane & 7) * 8;
        LAS unsigned* d = (LAS unsigned*)(T + c * 66 + r8); d[0] = tv[i].x; d[1] = tv[i].y; d[2] = tv[i].z; d[3] = tv[i].w; }
    asm volatile("s_waitcnt lgkmcnt(0)" ::: "memory");
    bf16_t* dst = (bf16_t*)(ws + WS_H) + (size_t)(rb * 64) * D + 512 + cb * 64;
#pragma unroll 4
    for (int i = 0; i < 8; ++i) { const int r = 8 * i + (lane >> 3), c8 = (lane & 7) * 8;
        unsigned short e[8];
#pragma unroll
        for (int x = 0; x < 8; ++x) e[x] = T[(c8 + x) * 66 + r];
        u32x4 o; o.x = e[0] | ((unsigned)e[1] << 16); o.y = e[2] | ((unsigned)e[3] << 16); o.z = e[4] | ((unsigned)e[5] << 16); o.w = e[6] | ((unsigned)e[7] << 16);
        *(u32x4*)(dst + (size_t)r * D + c8) = o; }
    asm volatile("s_waitcnt lgkmcnt(0)" ::: "memory");
}
#ifndef MK_EN
#define MK_EN 0xffff
#endif
#define EN(x) ((MK_EN >> (x)) & 1)
constexpr int PH_PREP = 0, PH_PER_LAYER = 7, PH_FNORM = 1 + 2 * PH_PER_LAYER, N_PHASES = PH_FNORM + 1;

__global__ void __launch_bounds__(NT, 2) fwd_kernel(Args ka) {
    extern __shared__ __attribute__((aligned(16))) unsigned char lds_raw[];
    LAS unsigned char* lds = (LAS unsigned char*)lds_raw;
    const int G = gridDim.x;
    volatile LAS unsigned* bst = (volatile LAS unsigned*)(lds + LDS_CTL_OFF);
    if (threadIdx.x < 16) bst[threadIdx.x] = 0u;
    if (threadIdx.x == 0) { LAS unsigned long long* tab = (LAS unsigned long long*)(lds + LDS_PTR_OFF);
#pragma unroll
        for (int i = 0; i < N_IN; ++i) tab[i] = (unsigned long long)ka.in[i]; }
    __syncthreads();

    XcdBarrier gbar; gbar.bar = (unsigned*)(ka.ws + WS_CTL); gbar.x = 0; gbar.st = bst;
    if (ka.ph_hi - ka.ph_lo > 1) gbar = xcd_barrier_post((unsigned*)(ka.ws + WS_CTL), bst);

#ifdef REP_SUB
    int repmask = 0;
#endif
    for (int ph = ka.ph_lo; ph < ka.ph_hi; ++ph) {
        int tid = threadIdx.x; asm volatile("" : "+v"(tid));
        int bid = blockIdx.x; asm volatile("" : "+s"(bid));
#define LANE_WAVE() int tid2_ = threadIdx.x; asm volatile("" : "+v"(tid2_)); const int lane = tid2_ & 63, wave = __builtin_amdgcn_readfirstlane(tid2_ >> 6)
        __attribute__((address_space(1))) unsigned char* wsg_ = (__attribute__((address_space(1))) unsigned char*)ka.ws; asm volatile("" : "+s"(wsg_)); unsigned char* ws = (unsigned char*)wsg_;
        __attribute__((address_space(1))) float* outg_ = (__attribute__((address_space(1))) float*)ka.out; asm volatile("" : "+s"(outg_)); float* outp_ = (float*)outg_;
        DArgs a; a.in.t = (const LAS unsigned long long*)(lds + LDS_PTR_OFF); a.out = outp_;
        float* MOD = (float*)(ws + WS_MOD);
        if (EN(0) && ph == PH_PREP) {
            for (int it = bid; it < 1048 + 544 + 8; it += G) {
                int tid = threadIdx.x; asm volatile("" : "+v"(tid));
                __syncthreads();
                if (it < 768) prep_adaln(a.in[I_C], a.in[I_CCTX], a.in[I_ADAW], a.in[I_ADAB], MOD, it, (LAS float*)lds, tid);
                else if (it < 784) prep_s5b(a, ws, it - 768, tid);
                else if (it >= 1048 + 544) { const int j = (it - 1592) * NT + tid; float sn, cs; sincospif(-(float)j * (1.0f / 4096.0f), &sn, &cs); ((f32x2*)(ws + WS_TWID))[j] = (f32x2){cs, sn}; }
                else if (it >= 1048) prep_rope((f32x2*)(ws + WS_ROPE), it - 1048, tid);
                else { const bool big = it < 1040; const int r = big ? it - 784 : it - 1040, l = big ? (r >> 7) : 0, t0 = (big ? (r & 127) : r) * 32;
                    float* H3o = big ? (float*)(ws + WS_H3) + (size_t)l * 4096 * 64 : (float*)(ws + WS_H3C);
                    bf16_t* H3b = big ? (bf16_t*)(ws + WS_H3B) + (size_t)l * 4096 * 64 : (bf16_t*)nullptr;
                    prep_hymlp(a, H3o, H3b, l, big ? 4096 : 256, t0, lds, tid); }
            }
        } else if (EN(1) && ph == PH_FNORM) {
            const float* fw = a.in[I_FNW]; LANE_WAVE();
            for (int row = bid * NWAVES + wave; row < NLAT; row += G * NWAVES) {
                float* xr = a.out + (size_t)row * D; f32x4 v[8]; float ss = 0.f;
#pragma unroll
                for (int j = 0; j < 8; ++j) { v[j] = ((const f32x4*)xr)[lane + 64 * j]; ss += (v[j].x * v[j].x + v[j].y * v[j].y) + (v[j].z * v[j].z + v[j].w * v[j].w); }
                const float rstd = rsqrtf(wave_sum(ss) * (1.0f / D) + EPS);
#pragma unroll
                for (int j = 0; j < 8; ++j) { const f32x4 w = *(const f32x4*)(fw + 4 * (lane + 64 * j)); ((f32x4*)xr)[lane + 64 * j] = v[j] * rstd * w; }
            }
        } else {
            const int l = (ph - 1) / PH_PER_LAYER, sub = (ph - 1) % PH_PER_LAYER;

            const bool ctx_out = (l == 0);
            const int Mrows = ctx_out ? MR : NLAT;
            if (EN(2) && sub == 0) {
                LANE_WAVE();
                LAS float* scr = (LAS float*)(lds + wave * 8704);
                const int gw = bid * NWAVES + wave, NGW = G * NWAVES;
                constexpr int I_W1 = 32 * (NPAD / 32), I_W2 = 32 * 64, I_W3 = 8 * 16;
                for (int it = (l == 0 ? gw : gw + I_W1); it < I_W1 + I_W2 + I_W3; it += NGW) {
                    int r = it;
                    if (r < I_W1) { const int kb = r / (NPAD / 32), nb = r % (NPAD / 32); transpose_item(a.in[I_WIN] + (size_t)l * D * INW, INW, win_srccol(nb * 32 + (lane & 31)), kb * 64, (bf16_t*)(ws + WS_WIN), D, nb * 32, scr, lane); continue; }
                    r -= I_W1;
                    if (r < I_W2) { const int kb = r / 64, nb = r % 64; transpose_item(a.in[I_WOUT] + (size_t)l * D * D, D, nb * 32 + (lane & 31), kb * 64, (bf16_t*)(ws + WS_WOUT), D, nb * 32, scr, lane); continue; }
                    r -= I_W2;
                    { const int kb = r / 16, nb = r % 16; transpose_item(a.in[I_GLUW] + (size_t)l * 512 * 512, 512, nb * 32 + (lane & 31), kb * 64, (bf16_t*)(ws + WS_GLUW), 512, nb * 32, scr, lane); }
                }
                const float* nw = a.in[I_NORMW] + (size_t)l * D;
                for (int row = gw; row < MR; row += NGW) {
                    const float* xr; int v;
                    if (row < NLAT) { xr = (l == 0 ? a.in[I_X] : a.out) + (size_t)row * D; v = row >> 12; }
                    else { xr = (l == 0 ? a.in[I_CTX] : (const float*)(ws + WS_XC1)) + (size_t)(row - NLAT) * D; v = 4; }
                    norm_row(xr, nw, MOD + (size_t)(l * 5 + v) * ADA, (bf16_t*)(ws + WS_H) + (size_t)row * D, lane);
                }
                __syncthreads();
                const int nfilt = ctx_out ? 1024 : 0;
                for (int it = bid; it < nfilt; it += G) { int tid = threadIdx.x; asm volatile("" : "+v"(tid)); __syncthreads(); if (it < 512) filt_item2(a, ws, lds, l, it, tid); else filt_ctx_item(a, ws, lds, it - 512, tid);
#if defined(REP_ITEM) && REP_ITEM == 10
                    __syncthreads(); if (it < 512) filt_item2(a, ws, lds, l, it, tid);
#endif
                }
            } else if (EN(3) && sub == 1) {
                pg8::Gemm g{(const bf16_t*)(ws + WS_H), (const bf16_t*)(ws + WS_WIN), MR, NPAD, D}; pg8::StaticOrder S; S.init(MR, NPAD, G, bid);
                EpiInProj E{(bf16_t*)(ws + WS_P), (bf16_t*)(ws + WS_PT), (float*)(ws + WS_LR), (const float*)(ws + WS_ROPE)};
                { pg8::InProjOrder S1; S1.init(ctx_out ? 0 : 1, G, bid); pg8::gemm_phase<EpiInProj, pg8::InProjOrder, true, true>(lds, g, S1, E, tid); }
            } else if (EN(5) && sub == 2) {
                const int nit = ctx_out ? 3744 : 3232;
                for (int it = bid; it < nit; it += G) {
                    int tid = threadIdx.x; asm volatile("" : "+v"(tid));
                    __syncthreads();
                    if (it < 512) hyena_item2(a, ws, lds, l, it, tid);
                    else if (it < 1600) s5_item<false>(a, ws, lds, l, (it - 512) >> 1, (it - 512) & 1, tid);
                    else if (it < 2144) ret_passA(ws, lds, it - 1600, tid);
                    else if (it < 3232) gla_passA(a, ws, lds, l, it - 2144, tid);
                    else hyena_ctx_item(a, ws, lds, it - 3232, tid);
                }
            } else if (EN(9) && sub == 3) {
                for (int it = bid; it < 256; it += G) { int tid = threadIdx.x; asm volatile("" : "+v"(tid)); __syncthreads(); hy_transpose_item(ws, lds, it, tid, NLAT); }
                for (int it = bid; it < 224; it += G) { int tid = threadIdx.x; asm volatile("" : "+v"(tid)); __syncthreads();
                    if (it < 128) ret_passB(ws, it * NT + tid);
                    else if (it < 192) gla_passB(ws, lds, it - 128, tid);
                    else s5_passB(ws, l, (it - 192) * NT + tid); }
            } else if (EN(6) && sub == 4) {
                const int nsc = ctx_out ? 1088 : 1024, nrc = ctx_out ? 16 * RNCH : 16 * 32, ngc = ctx_out ? 16 * GNCH : 16 * 64;
                for (int it = bid; it < nsc; it += G) { int tid = threadIdx.x; asm volatile("" : "+v"(tid)); __syncthreads();
                    const int i2 = it >> 1; const int item = ctx_out ? i2 : (i2 >> 7) * (SNCH * 2) + 8 + (i2 & 127); s5_item<true>(a, ws, lds, l, item, it & 1, tid); }
                for (int it = (bid + 64) % G; it < nrc; it += G) { int tid = threadIdx.x; asm volatile("" : "+v"(tid)); __syncthreads();
                    const int item = ctx_out ? it : (it >> 5) * RNCH + 2 + (it & 31); ret_passC(a, ws, lds, l, item, tid); }
                for (int it = (bid + 128) % G; it < ngc; it += G) { int tid = threadIdx.x; asm volatile("" : "+v"(tid)); __syncthreads();
                    const int item = ctx_out ? it : (it >> 6) * GNCH + 4 + (it & 63); gla_passC(a, ws, lds, l, item, tid); }
            } else if (EN(7) && sub == 5) {
                pg8::Gemm g{(const bf16_t*)(ws + WS_KF), (const bf16_t*)(ws + WS_GLUW), Mrows, 512, 512}; pg8::StaticOrder S; S.init(Mrows, 512, G, bid);
                EpiGlu E{(const bf16_t*)(ws + WS_KF) + OBSZ, (bf16_t*)(ws + WS_H), a.in[I_GLUB] + (size_t)l * 512};
                pg8::gemm_phase<EpiGlu, pg8::StaticOrder, true, true>(lds, g, S, E, tid);
                if (l == 0 && bid >= 136) {
                    LANE_WAVE(); LAS float* scr = (LAS float*)(lds + wave * 8704);
                    for (int r = (bid - 136) * NWAVES + wave; r < 32 * (NPAD / 32); r += (G - 136) * NWAVES) { const int kb = r / (NPAD / 32), nb = r % (NPAD / 32);
                        transpose_item(a.in[I_WIN] + (size_t)1 * D * INW, INW, win_srccol(nb * 32 + (lane & 31)), kb * 64, (bf16_t*)(ws + WS_WIN), D, nb * 32, scr, lane); }
                }
            } else if (EN(8)) {
                pg8::Gemm g{(const bf16_t*)(ws + WS_H), (const bf16_t*)(ws + WS_WOUT), Mrows, D, D}; pg8::StaticOrder S; S.init(Mrows, D, G, bid);
                EpiOut E{l == 0 ? a.in[I_X] : a.out, a.in[I_CTX], a.out, (float*)(ws + WS_XC1), MOD + (size_t)l * 5 * ADA};
                pg8::gemm_phase<EpiOut, pg8::StaticOrder, true, true>(lds, g, S, E, tid);
                if (l == 0 && bid >= 32) {
                    for (int it = bid - 32; it < 512; it += G - 32) { int tid2 = threadIdx.x; asm volatile("" : "+v"(tid2)); __syncthreads(); filt_item2(a, ws, lds, 1, it, tid2); }
                }
            }
        }
#ifdef REP_SUB
        if (ph != PH_PREP && ph != PH_FNORM && ((ph - 1) % PH_PER_LAYER) == REP_SUB && !((repmask >> ((ph - 1) / PH_PER_LAYER)) & 1)) { repmask |= 1 << ((ph - 1) / PH_PER_LAYER); xcd_barrier(gbar); --ph; continue; }
#endif
        if (ph + 1 < ka.ph_hi) xcd_barrier(gbar);
    }
}

#ifndef MK_LAUNCH_PER_PHASE
#define MK_LAUNCH_PER_PHASE 0
#endif
extern "C" void kernel_launch(void* const* d_in, const int* in_sizes, int n_in, void* d_out, int out_size, void* d_ws, size_t ws_size, hipStream_t stream) {
    static int grid = 0;
    if (grid == 0) {
        if (n_in != N_IN || out_size != NLAT * D || ws_size < WS_END2) { fprintf(stderr, "kernel_launch: unexpected shapes (n_in %d, out %d, ws %zu < %zu); nothing launched\n", n_in, out_size, ws_size, (size_t)WS_END2); grid = -1; return; }
        int dev = 0, cus = 0, per_cu = 0;
        if (hipGetDevice(&dev) != hipSuccess || hipDeviceGetAttribute(&cus, hipDeviceAttributeMultiprocessorCount, dev) != hipSuccess) { grid = -1; return; }
        if (hipFuncSetAttribute((const void*)fwd_kernel, hipFuncAttributeMaxDynamicSharedMemorySize, LDS_BYTES) != hipSuccess) { fprintf(stderr, "kernel_launch: hipFuncSetAttribute failed\n"); grid = -1; return; }
        if (hipOccupancyMaxActiveBlocksPerMultiprocessor(&per_cu, (const void*)fwd_kernel, NT, LDS_BYTES) != hipSuccess || per_cu < 1) { fprintf(stderr, "kernel_launch: occupancy query says %d blocks per CU\n", per_cu); per_cu = 1; }
        (void)hipGetLastError();
        grid = cus;
    }
    if (grid < 0) return;
    (void)hipMemsetAsync((char*)d_ws + WS_CTL, 0, WS_ZERO_BYTES, stream);
    Args a{};
    for (int i = 0; i < N_IN; ++i) a.in[i] = (const float*)d_in[i];
    a.out = (float*)d_out; a.ws = (unsigned char*)d_ws;
#if MK_LAUNCH_PER_PHASE
    for (int ph = 0; ph < N_PHASES; ++ph) {
        a.ph_lo = ph; a.ph_hi = ph + 1;
        hipLaunchKernelGGL(fwd_kernel, dim3(grid), dim3(NT), LDS_BYTES, stream, a);
    }
#else
    a.ph_lo = 0; a.ph_hi = N_PHASES;
    void* args[] = {&a};
    hipError_t e = hipLaunchCooperativeKernel((const void*)fwd_kernel, dim3(grid), dim3(NT), args, LDS_BYTES, stream);
    if (e != hipSuccess) fprintf(stderr, "kernel_launch: cooperative launch failed: %s (grid %d)\n", hipGetErrorString(e), grid);
#endif
}
```

```cpp
#include <hip/hip_runtime.h>
#include <hip/hip_cooperative_groups.h>
#include <cstdio>
#include <cstdint>
namespace cg = cooperative_groups;

#define LAS __attribute__((address_space(3)))
typedef unsigned short bf16_t;
typedef float f32x4 __attribute__((ext_vector_type(4)));
typedef float f32x2 __attribute__((ext_vector_type(2)));
typedef unsigned u32x4 __attribute__((ext_vector_type(4)));
typedef unsigned u32x2 __attribute__((ext_vector_type(2)));

constexpr int D = 2048, NB = 4, SEQL = 4096, LC = 256, NLAT = NB * SEQL, NCTX = NB * LC, MR = NLAT + NCTX;
constexpr int BR = 512, INW = 6688, NPAD = 6912, LDP = 4608, ADA = 3 * D;
constexpr int NT = 512, NWAVES = 8;
constexpr float EPS = 1e-6f;
constexpr int PC_S5U = 0, PC_S5G = 512, PC_RQ = 1024, PC_RK = 1536, PC_RV = 2048, PC_RG = 2560, PC_GQ = 3072, PC_GK = 3328, PC_GV = 3584, PC_GG = 4096;
constexpr int PT_V = 0, PT_G1 = 512, PT_G2 = 1024, PT_HG = 1536;
constexpr int FFTN = 8192;

enum { I_X = 0, I_C, I_CTX, I_CCTX, I_NORMW, I_ADAW, I_ADAB, I_WIN, I_WOUT, I_S5ARE, I_S5AIM, I_S5LDT, I_S5BRE, I_S5BIM, I_S5CRE, I_S5CIM,
       I_S5D, I_GLUW, I_GLUB, I_HCW, I_HCB, I_HW1, I_HB1, I_HF1, I_HW2, I_HB2, I_HF2, I_HW3, I_HB3, I_HF3, I_HW4, I_HBIAS, I_RNW, I_GGW, I_GGB, I_GNW, I_FNW, N_IN };

constexpr size_t al256(size_t x) { return (x + 255) & ~(size_t)255; }
constexpr size_t WS_CTL  = 0;
constexpr size_t WS_MOD  = WS_CTL + 65536;
constexpr size_t WS_ZERO_BYTES = 65536 + al256((size_t)2 * 5 * ADA * 4);
constexpr size_t WS_S5AB = WS_MOD + al256((size_t)2 * 5 * ADA * 4);
constexpr size_t WS_S5BT = WS_S5AB + (size_t)2 * 2 * 32 * 64 * 8;
constexpr size_t WS_H3   = WS_S5BT + (size_t)1048576 + 65536;
constexpr size_t WS_H3C  = WS_H3 + (size_t)2 * 4096 * 64 * 4;
constexpr size_t WS_KC   = WS_H3C + (size_t)256 * 64 * 4;
constexpr size_t WS_LR   = WS_KC + (size_t)2 * 512 * 512 * 4;
constexpr size_t WS_XC1  = WS_LR + (size_t)MR * 32 * 4;
constexpr size_t WS_WOUT = WS_XC1 + (size_t)NCTX * D * 4;
constexpr size_t WS_GLUW = WS_WOUT + (size_t)D * D * 2;
constexpr size_t WS_WIN  = WS_GLUW + (size_t)512 * 512 * 2;
constexpr size_t WS_H    = WS_WIN + (size_t)NPAD * D * 2;
constexpr size_t WS_P    = WS_H + (size_t)MR * D * 2;
constexpr size_t WS_PT   = WS_P + (size_t)MR * LDP * 2;
constexpr size_t WS_KF   = WS_PT + (size_t)2048 * MR * 2;
constexpr size_t WS_OB   = WS_KF + (size_t)2 * 512 * FFTN * 8;
constexpr size_t WS_END  = WS_OB + (size_t)6 * MR * 512 * 2;
constexpr size_t OBSZ = (size_t)MR * 512;

constexpr int LDS_CTL_OFF = 135168 + 1024;
constexpr int LDS_PTR_OFF = LDS_CTL_OFF + 64;
constexpr int LDS_BYTES = LDS_PTR_OFF + 320;

typedef __bf16 hwbf16x2 __attribute__((ext_vector_type(2)));
__device__ __forceinline__ unsigned pk2(float lo, float hi) { const f32x2 v = {lo, hi}; return __builtin_bit_cast(unsigned, __builtin_convertvector(v, hwbf16x2)); }
__device__ __forceinline__ unsigned f2bf(float f) { return pk2(f, 0.f) & 0xffffu; }
__device__ __forceinline__ float bf2f(bf16_t b) { return __uint_as_float((unsigned)b << 16); }
__device__ __forceinline__ float bflo(unsigned w) { return __uint_as_float(w << 16); }
__device__ __forceinline__ float bfhi(unsigned w) { return __uint_as_float(w & 0xffff0000u); }
__device__ __forceinline__ void unpack8(const u32x4 r, float (&f)[8]) { f[0] = bflo(r.x); f[1] = bfhi(r.x); f[2] = bflo(r.y); f[3] = bfhi(r.y); f[4] = bflo(r.z); f[5] = bfhi(r.z); f[6] = bflo(r.w); f[7] = bfhi(r.w); }
__device__ __forceinline__ u32x4 pack8(const float (&f)[8]) { u32x4 o; o.x = pk2(f[0], f[1]); o.y = pk2(f[2], f[3]); o.z = pk2(f[4], f[5]); o.w = pk2(f[6], f[7]); return o; }
__device__ __forceinline__ float sigmoidf_(float x) { return __builtin_amdgcn_rcpf(1.0f + __expf(-x)); }
__device__ __forceinline__ float siluf_(float x) { return x * sigmoidf_(x); }
__device__ __forceinline__ float gelu_tanh(float x) { const float u2 = 1.5957691216057308f * (x + 0.044715f * x * x * x); return x * sigmoidf_(u2); }
__device__ __forceinline__ float wave_sum(float v) {
#pragma unroll
    for (int o = 1; o < 64; o <<= 1) v += __shfl_xor(v, o);
    return v;
}
#define LDS_WAIT() asm volatile("s_waitcnt lgkmcnt(0)" ::: "memory")

struct Args { const float* in[N_IN]; float* out; unsigned char* ws; int ph_lo, ph_hi; };
struct InTab { const LAS unsigned long long* t;
    __device__ __forceinline__ const float* operator[](int i) const { const unsigned long long v = t[i];
        const unsigned lo = __builtin_amdgcn_readfirstlane((unsigned)v), hi = __builtin_amdgcn_readfirstlane((unsigned)(v >> 32)); return (const float*)(__attribute__((address_space(1))) const float*)(((unsigned long long)hi << 32) | lo); } };
struct DArgs { InTab in; float* out; };

#define XB_TMO      128
#define XB_XCNT(j)  (256  + 64 * (j))
#define XB_XSUB(j)  (1280 + 64 * (j))
#define XB_XGEN(j)  (2304 + 64 * (j))
#define XB_TOP      3328
#define XB_TOPGEN   3392
#define XCD_BAR_WORDS 3456
#define XB_SPIN_CAP (1u << 22)
__device__ __forceinline__ unsigned xb_ld(unsigned* p)              { return __hip_atomic_load(p, __ATOMIC_RELAXED, __HIP_MEMORY_SCOPE_AGENT); }
__device__ __forceinline__ unsigned xb_add(unsigned* p, unsigned v) { return __hip_atomic_fetch_add(p, v, __ATOMIC_RELAXED, __HIP_MEMORY_SCOPE_AGENT); }
__device__ __forceinline__ unsigned xb_xcc_id() { return (unsigned)__builtin_amdgcn_s_getreg((3 << 11) | 20) & 0xFu; }
#define XB_SPIN(cond, bar) do { unsigned _sp = 0; while (cond) { __builtin_amdgcn_s_sleep(1); \
    if ((++_sp & 255u) == 0u) { if (xb_ld(&(bar)[XB_TMO])) break; if (_sp > XB_SPIN_CAP) { atomicAdd(&(bar)[XB_TMO], 1u); break; } } } } while (0)
struct XcdBarrier { unsigned* bar; unsigned x; volatile LAS unsigned* st; };
__device__ __forceinline__ XcdBarrier xcd_barrier_post(unsigned* bar, volatile LAS unsigned* st) {
    XcdBarrier b; b.bar = bar; b.x = xb_xcc_id(); b.st = st;
    if (threadIdx.x == 0) (void)xb_add(&bar[XB_XCNT(b.x)], 1u);
    return b;
}
__device__ __forceinline__ void xcd_barrier_complete(unsigned* bar, unsigned x, unsigned& nloc, unsigned& nx) {
    const unsigned G = gridDim.x * gridDim.y * gridDim.z;
    unsigned sum, cnt, mine, sp = 0u;
    for (;;) {
        sum = 0u; cnt = 0u; mine = 0u;
#pragma unroll
        for (unsigned j = 0; j < 16; ++j) { const unsigned c = xb_ld(&bar[XB_XCNT(j)]); sum += c; cnt += (c > 0u) ? 1u : 0u; mine = (j == x) ? c : mine; }
        if (sum == G) break;
        __builtin_amdgcn_s_sleep(1);
        if ((++sp & 255u) == 0u) { if (xb_ld(&bar[XB_TMO])) break; if (sp > XB_SPIN_CAP) { atomicAdd(&bar[XB_TMO], 1u); break; } }
    }
    nloc = mine > 0u ? mine : 1u; nx = cnt > 0u ? cnt : 1u;
}
__device__ __forceinline__ void xcd_barrier(const XcdBarrier& b) {
    asm volatile("s_waitcnt vmcnt(0)" ::: "memory");
    __syncthreads();
    if (threadIdx.x == 0) {
        unsigned* bar = b.bar;
        __builtin_amdgcn_s_waitcnt(0);
        unsigned nloc = b.st[0], nx = b.st[1];
        if (nloc == 0u) { xcd_barrier_complete(bar, b.x, nloc, nx); b.st[0] = nloc; b.st[1] = nx; }
        const unsigned old = xb_add(&bar[XB_XSUB(b.x)], 1u);
        const unsigned gen = old / nloc;
        if (old + 1u == (gen + 1u) * nloc) {
            __builtin_amdgcn_fence(__ATOMIC_RELEASE, "agent");
            asm volatile("s_waitcnt vmcnt(0)" ::: "memory");
            const unsigned og = xb_add(&bar[XB_TOP], 1u);
            const unsigned tg = og / nx;
            if (og + 1u == (tg + 1u) * nx) xb_add(&bar[XB_TOPGEN], 1u);
            else XB_SPIN(xb_ld(&bar[XB_TOPGEN]) == tg, bar);
            __builtin_amdgcn_fence(__ATOMIC_ACQUIRE, "agent");
            xb_add(&bar[XB_XGEN(b.x)], 1u);
            asm volatile("s_waitcnt vmcnt(0)" ::: "memory");
        } else {
            XB_SPIN(xb_ld(&bar[XB_XGEN(b.x)]) == gen, bar);
            __builtin_amdgcn_fence(__ATOMIC_ACQUIRE, "agent");
            asm volatile("s_waitcnt vmcnt(0)" ::: "memory");
        }
    }
    __syncthreads();
}
namespace pg8 {
#define PG8_LAS __attribute__((address_space(3)))
typedef unsigned short bf16_t;
typedef short bf16x8 __attribute__((ext_vector_type(8)));
typedef float f32x4 __attribute__((ext_vector_type(4)));
typedef unsigned u32x4 __attribute__((ext_vector_type(4)));
constexpr int BM = 256, BK = 64, HALF = 128, HTB = HALF * BK * 2, STAGE_BYTES = 8 * HTB, NXCD = 8, WGM = 8;

__host__ __device__ __forceinline__ int lds_byte(int r, int c) { const int st = (r >> 4) * 2 + (c >> 5), rr = r & 15, cc = c & 31, ob = rr * 64 + cc * 2; return st * 1024 + (ob ^ (((ob >> 9) & 1) << 5)); }
__host__ __device__ __forceinline__ void stage_rc(int b, int& R, int& C) { const int st = b / 1024, sb = b % 1024, swz = sb ^ (((sb >> 9) & 1) << 5); R = (st >> 1) * 16 + swz / 64; C = (st & 1) * 32 + (swz % 64) / 2; }
__host__ __device__ __forceinline__ int perm32(int rho) { const int n = rho >> 4, i = rho & 15; return 8 * (i >> 2) + 4 * n + (i & 3); }

struct Unit { int pm, pn; };
struct Gemm { const bf16_t* A; const bf16_t* Bt; int M, N, K; };

struct StaticOrder {
    int nM, nN, nwg, G, c;
    __host__ __device__ void init(int M, int N, int G_, int c_) { nM = M / BM; nN = N / BM; nwg = nM * nN; G = G_; c = c_; }
    __host__ __device__ bool next(int i, Unit& u) const {
        const long L = (long)i * G + c; if (L >= nwg) return false;
        int wgid = (int)L; { const int q = nwg / NXCD, r = nwg % NXCD, xcd = wgid % NXCD, off = wgid / NXCD; wgid = (xcd < r ? xcd * (q + 1) : r * (q + 1) + (xcd - r) * q) + off; }
        const int nig = WGM * nN, gid = wgid / nig, fm = gid * WGM, gsz = (nM - fm) < WGM ? (nM - fm) : WGM;
        u.pm = fm + ((wgid % nig) % gsz); u.pn = (wgid % nig) / gsz; return true;
    }
    __device__ __forceinline__ void a_ready(const Unit&) const {}
    __device__ __forceinline__ void done(const Unit&) const {}
};


struct InProjOrder {
    StaticOrder base; int G, c, last;
    __host__ __device__ void init(int last_, int G_, int c_) { last = last_; base.init((last_ ? 64 : 68) * 256, 27 * 256, G_, c_); G = G_; c = c_; }
    __host__ __device__ bool next(int i, Unit& u) const {
        const long L = (long)i * G + c;
        if (!last || L < 1728) return base.next(i, u);
        if (L >= 1768) return false;
        const int k = (int)L - 1728, j = k % 10; u.pm = 64 + k / 10;
        u.pn = j == 0 ? 0 : j == 1 ? 1 : j == 2 ? 14 : j == 3 ? 15 : j == 4 ? 16 : j == 5 ? 17 : j == 6 ? 21 : j == 7 ? 22 : j == 8 ? 23 : 26;
        return true;
    }
    __device__ __forceinline__ void a_ready(const Unit&) const {}
    __device__ __forceinline__ void done(const Unit&) const {}
};
template <class Epi, class Sched, bool ALIGN_EPI = false, bool SP2 = false>
__device__ __forceinline__ void gemm_phase(PG8_LAS unsigned char* lds, const Gemm g, const Sched& S, const Epi& E, const int tid) {
    const int wid = __builtin_amdgcn_readfirstlane(tid >> 6), lane = tid & 63, wr = wid >> 2, wc = wid & 3, fr = lane & 15, fq = lane >> 4;
    const int K = g.K, nt = K / BK;
    unsigned voffA[2], voffB[2];
#pragma unroll
    for (int i = 0; i < 2; ++i) { int R, C; stage_rc(tid * 16 + i * 8192, R, C); const int Rb = Epi::PERM ? ((R & ~31) + perm32(R & 31)) : R;
        voffA[i] = (unsigned)(R * K + C) * 2u; voffB[i] = (unsigned)(Rb * K + C) * 2u; }
    const size_t kstep = (size_t)(BK * 2);
    const size_t hstep = (size_t)HALF * K * 2;
    const size_t tstep = 2 * hstep;
    const unsigned ldsw = (unsigned)wid * 1024u;
    const int aoff = lds_byte(wr * 64 + fr, fq * 8), boff = lds_byte(wc * 32 + fr, fq * 8);
#define PG8_SA(b, h) (((b) * 2 + (h)) * HTB)
#define PG8_SB(b, h) ((4 + (b) * 2 + (h)) * HTB)
#define PG8_STAGE(bufoff, gbase, voff) do { _Pragma("unroll") for (int _i = 0; _i < 2; ++_i) \
        __builtin_amdgcn_global_load_lds((const unsigned*)((const char*)(gbase) + (voff)[_i]), (PG8_LAS unsigned*)(lds + (bufoff) + ldsw + _i * 8192), 16, 0, 0); } while (0)
#define PG8_LDA(dst, b, h) do { _Pragma("unroll") for (int m = 0; m < 4; ++m) _Pragma("unroll") for (int k = 0; k < 2; ++k) dst[m][k] = *(const PG8_LAS bf16x8*)(lds + PG8_SA(b, h) + aoff + m * 2048 + k * 1024); } while (0)
#define PG8_LDB(dst, b, h) do { _Pragma("unroll") for (int n = 0; n < 2; ++n) _Pragma("unroll") for (int k = 0; k < 2; ++k) dst[n][k] = *(const PG8_LAS bf16x8*)(lds + PG8_SB(b, h) + boff + n * 2048 + k * 1024); } while (0)
#define PG8_MMA(ai, bj, At, Bt) do { __builtin_amdgcn_s_setprio(1); _Pragma("unroll") for (int m = 0; m < 4; ++m) _Pragma("unroll") for (int n = 0; n < 2; ++n) _Pragma("unroll") for (int k = 0; k < 2; ++k) \
        acc[ai][bj][m][n] = __builtin_amdgcn_mfma_f32_16x16x32_bf16(Bt[n][k], At[m][k], acc[ai][bj][m][n], 0, 0, 0); __builtin_amdgcn_s_setprio(0); } while (0)
#define PG8_WAIT_V(n) asm volatile("s_waitcnt vmcnt(" #n ")" ::: "memory")
#define PG8_WAIT_L(n) asm volatile("s_waitcnt lgkmcnt(" #n ")" ::: "memory")
#define PG8_BAR __builtin_amdgcn_s_barrier()
#define PG8_SCHED __builtin_amdgcn_sched_barrier(0)
    Unit cur, nxt; int ui = 0;
    if (!S.next(0, cur)) return;
    f32x4 acc[2][2][4][2];
#pragma unroll
    for (int a = 0; a < 2; ++a)
#pragma unroll
        for (int b = 0; b < 2; ++b)
#pragma unroll
            for (int m = 0; m < 4; ++m)
#pragma unroll
                for (int n = 0; n < 2; ++n) acc[a][b][m][n] = (f32x4){0.f, 0.f, 0.f, 0.f};
    bf16x8 At[4][2], B0[2][2], B1[2][2];
    const char* cA = (const char*)g.A + (size_t)cur.pm * tstep; const char* cB = (const char*)g.Bt + (size_t)cur.pn * tstep;
    S.a_ready(cur);
    if constexpr (SP2) {
        PG8_STAGE(PG8_SB(0, 0), cB, voffB); PG8_STAGE(PG8_SB(0, 1), cB + hstep, voffB); PG8_STAGE(PG8_SA(0, 0), cA, voffA); PG8_STAGE(PG8_SA(0, 1), cA + hstep, voffA);
        if (wr == 1) PG8_BAR;
        PG8_WAIT_V(2); PG8_BAR;
        PG8_STAGE(PG8_SB(1, 0), cB + kstep, voffB); PG8_STAGE(PG8_SA(1, 0), cA + kstep, voffA); PG8_STAGE(PG8_SB(1, 1), cB + hstep + kstep, voffB);
        PG8_WAIT_V(6); PG8_BAR;
    } else {
        PG8_STAGE(PG8_SB(0, 0), cB, voffB); PG8_STAGE(PG8_SA(0, 0), cA, voffA); PG8_STAGE(PG8_SB(0, 1), cB + hstep, voffB); PG8_STAGE(PG8_SA(0, 1), cA + hstep, voffA);
        if (wr == 1) PG8_BAR;
        PG8_WAIT_V(4); PG8_BAR;
        PG8_STAGE(PG8_SB(1, 0), cB + kstep, voffB); PG8_STAGE(PG8_SA(1, 0), cA + kstep, voffA); PG8_STAGE(PG8_SB(1, 1), cB + hstep + kstep, voffB);
        PG8_WAIT_V(6); PG8_BAR;
    }
    for (;;) {
        const bool has_next = S.next(ui + 1, nxt);
        const char* nA = has_next ? (const char*)g.A + (size_t)nxt.pm * tstep : cA; const char* nB = has_next ? (const char*)g.Bt + (size_t)nxt.pn * tstep : cB;
        for (int t = 0; t < nt; t += 2) {
            const bool last = (t == nt - 2);
            const char* a1 = cA + (size_t)(t + 1) * kstep;
            const char* a2 = last ? nA : cA + (size_t)(t + 2) * kstep; const char* b2 = last ? nB : cB + (size_t)(t + 2) * kstep;
            const char* a3 = a2 + kstep; const char* b3 = b2 + kstep;
            if (last && has_next) S.a_ready(nxt);
            if constexpr (SP2) {
            PG8_LDB(B0, 0, 0); PG8_LDB(B1, 0, 1); PG8_SCHED; PG8_LDA(At, 0, 0); PG8_STAGE(PG8_SA(1, 1), a1 + hstep, voffA);
            PG8_WAIT_V(8); PG8_WAIT_L(0); PG8_BAR; PG8_MMA(0, 0, At, B0); PG8_MMA(0, 1, At, B1); PG8_BAR; PG8_SCHED;
            PG8_LDA(At, 0, 1); PG8_STAGE(PG8_SB(0, 0), b2, voffB); PG8_STAGE(PG8_SB(0, 1), b2 + hstep, voffB); PG8_STAGE(PG8_SA(0, 0), a2, voffA);
            PG8_WAIT_V(8); PG8_WAIT_L(0); PG8_BAR; PG8_MMA(1, 0, At, B0); PG8_MMA(1, 1, At, B1); PG8_BAR; PG8_SCHED;
            PG8_LDB(B0, 1, 0); PG8_LDB(B1, 1, 1); PG8_SCHED; PG8_LDA(At, 1, 0); PG8_STAGE(PG8_SA(0, 1), a2 + hstep, voffA);
            PG8_WAIT_V(8); PG8_WAIT_L(0); PG8_BAR; PG8_MMA(0, 0, At, B0); PG8_MMA(0, 1, At, B1); PG8_BAR; PG8_SCHED;
            PG8_LDA(At, 1, 1); PG8_STAGE(PG8_SB(1, 0), b3, voffB); PG8_STAGE(PG8_SB(1, 1), b3 + hstep, voffB); PG8_STAGE(PG8_SA(1, 0), a3, voffA);
            PG8_WAIT_V(8); PG8_WAIT_L(0); PG8_BAR; PG8_MMA(1, 0, At, B0); PG8_MMA(1, 1, At, B1); PG8_BAR; PG8_SCHED;
            } else {
            PG8_LDB(B0, 0, 0); PG8_SCHED; PG8_LDA(At, 0, 0); PG8_STAGE(PG8_SA(1, 1), a1 + hstep, voffA);
            PG8_WAIT_L(8); PG8_BAR; PG8_WAIT_L(0); PG8_MMA(0, 0, At, B0); PG8_BAR; PG8_SCHED;
            PG8_LDB(B1, 0, 1); PG8_STAGE(PG8_SB(0, 0), b2, voffB);
            PG8_BAR; PG8_WAIT_L(0); PG8_MMA(0, 1, At, B1); PG8_BAR;
            PG8_LDA(At, 0, 1); PG8_STAGE(PG8_SA(0, 0), a2, voffA);
            PG8_BAR; PG8_WAIT_L(0); PG8_MMA(1, 0, At, B0); PG8_BAR; PG8_SCHED;
            PG8_STAGE(PG8_SB(0, 1), b2 + hstep, voffB);
            PG8_WAIT_V(6); PG8_BAR; PG8_MMA(1, 1, At, B1); PG8_BAR;
            PG8_LDB(B0, 1, 0); PG8_SCHED; PG8_LDA(At, 1, 0); PG8_STAGE(PG8_SA(0, 1), a2 + hstep, voffA);
            PG8_WAIT_L(8); PG8_BAR; PG8_WAIT_L(0); PG8_MMA(0, 0, At, B0); PG8_BAR; PG8_SCHED;
            PG8_LDB(B1, 1, 1); PG8_STAGE(PG8_SB(1, 0), b3, voffB);
            PG8_BAR; PG8_WAIT_L(0); PG8_MMA(0, 1, At, B1); PG8_BAR;
            PG8_LDA(At, 1, 1); PG8_STAGE(PG8_SA(1, 0), a3, voffA);
            PG8_BAR; PG8_WAIT_L(0); PG8_MMA(1, 0, At, B0); PG8_BAR; PG8_SCHED;
            PG8_STAGE(PG8_SB(1, 1), b3 + hstep, voffB);
            PG8_WAIT_V(6); PG8_BAR; PG8_MMA(1, 1, At, B1); PG8_BAR;
            }
        }
        if constexpr (ALIGN_EPI) { if (wr == 0) PG8_BAR; }
        { int fr_ = fr, fq_ = fq; asm volatile("" : "+v"(fr_), "+v"(fq_));
          E(acc, cur, wr, wc, fr_, fq_); } S.done(cur);
        if (!has_next) break;
#pragma unroll
        for (int a = 0; a < 2; ++a)
#pragma unroll
            for (int b = 0; b < 2; ++b)
#pragma unroll
                for (int m = 0; m < 4; ++m)
#pragma unroll
                    for (int n = 0; n < 2; ++n) acc[a][b][m][n] = (f32x4){0.f, 0.f, 0.f, 0.f};
        cur = nxt; cA = nA; cB = nB; ++ui;
        if constexpr (ALIGN_EPI) { if (wr == 1) PG8_BAR; }
    }
    PG8_WAIT_V(0);
    if constexpr (!ALIGN_EPI) { if (wr == 0) PG8_BAR; }
    PG8_BAR;
#undef PG8_SA
#undef PG8_SB
#undef PG8_STAGE
#undef PG8_LDA
#undef PG8_LDB
#undef PG8_MMA
#undef PG8_WAIT_V
#undef PG8_WAIT_L
#undef PG8_BAR
#undef PG8_SCHED
}
}
__device__ __forceinline__ void prep_adaln(const float* c, const float* cctx, const float* adaw, const float* adab, float* MOD, int it, LAS float* sv, int tid) {
    const int l = it / 384, r = it % 384, ntile = r >> 5, ks = r & 31, k0 = ks * 64;
    if (tid < 320) { const int v = tid >> 6, k = tid & 63; const float cv = v < 4 ? c[v * D + k0 + k] : cctx[k0 + k]; sv[tid] = cv / (1.0f + expf(-cv)); }
    __syncthreads();
    const int n = ntile * 512 + tid; const float* w = adaw + (size_t)l * D * ADA + (size_t)k0 * ADA + n;
    float acc[5] = {0.f, 0.f, 0.f, 0.f, 0.f};
#pragma unroll 1
    for (int k0_ = 0; k0_ < 64; k0_ += 32) {
        float wv[32];
#pragma unroll
        for (int k = 0; k < 32; ++k) wv[k] = w[(size_t)(k0_ + k) * ADA];
#pragma unroll
        for (int k = 0; k < 32; ++k) {
#pragma unroll
            for (int v = 0; v < 5; ++v) acc[v] += sv[v * 64 + k0_ + k] * wv[k]; } }
    if (ks == 0) { const float bb = adab[l * ADA + n];
#pragma unroll
        for (int v = 0; v < 5; ++v) acc[v] += bb; }
#pragma unroll
    for (int v = 0; v < 5; ++v) atomicAdd(MOD + (size_t)(l * 5 + v) * ADA + n, acc[v]);
    __syncthreads();
}

__device__ __forceinline__ void prep_hymlp(const DArgs& a, float* H3out, bf16_t* H3b, int l, int Lx, int t0, LAS unsigned char* lds, int tid) {
    LAS float* zs = (LAS float*)lds;
    LAS float* h1 = (LAS float*)(lds + 4608);
    LAS float* h2 = (LAS float*)(lds + 4608 + 8192);
    LAS float* w1s = (LAS float*)(lds + 24576);
    LAS float* w2s = w1s + 33 * 64;
    LAS float* w3s = w2s + 64 * 64;
    { const float* w1 = a.in[I_HW1] + (size_t)l * 33 * 64; const float* w2 = a.in[I_HW2] + (size_t)l * 64 * 64; const float* w3 = a.in[I_HW3] + (size_t)l * 64 * 64;
      for (int i = tid; i < 33 * 64; i += NT) w1s[i] = w1[i];
      for (int i = tid; i < 64 * 64; i += NT) { w2s[i] = w2[i]; w3s[i] = w3[i]; } }
    for (int i = tid; i < 32 * 33; i += NT) { const int pos = i / 33, f = i % 33, t = t0 + pos;
        float z;
        if (f == 0) z = (float)t / (float)(Lx - 1);
        else { const int j = (f - 1) & 15; const float fj = 1e-4f + (float)j * ((15.0f - 1e-4f) / 15.0f); const float wpos = (6.283185307179586f * (float)t) / (float)Lx; const float arg = fj * wpos;
               z = (f <= 16) ? cosf(arg) : -sinf(arg); }
        zs[pos * 36 + f] = z; }
    __syncthreads();
    const int pos = tid >> 4, f4 = (tid & 15) * 4, t = t0 + pos;
    f32x4 s = *(const f32x4*)(a.in[I_HB1] + l * 64 + f4);
#pragma unroll 3
    for (int j = 0; j < 33; ++j) s += zs[pos * 36 + j] * *(const LAS f32x4*)(w1s + j * 64 + f4);
    { const f32x4 fr = *(const f32x4*)(a.in[I_HF1] + l * 64 + f4); *(LAS f32x4*)(h1 + pos * 64 + f4) = (f32x4){sinf(fr.x * s.x), sinf(fr.y * s.y), sinf(fr.z * s.z), sinf(fr.w * s.w)}; }
    __syncthreads();
    s = *(const f32x4*)(a.in[I_HB2] + l * 64 + f4);
#pragma unroll 4
    for (int j = 0; j < 64; ++j) s += h1[pos * 64 + j] * *(const LAS f32x4*)(w2s + j * 64 + f4);
    { const f32x4 fr = *(const f32x4*)(a.in[I_HF2] + l * 64 + f4); *(LAS f32x4*)(h2 + pos * 64 + f4) = (f32x4){sinf(fr.x * s.x), sinf(fr.y * s.y), sinf(fr.z * s.z), sinf(fr.w * s.w)}; }
    __syncthreads();
    s = *(const f32x4*)(a.in[I_HB3] + l * 64 + f4);
#pragma unroll 4
    for (int j = 0; j < 64; ++j) s += h2[pos * 64 + j] * *(const LAS f32x4*)(w3s + j * 64 + f4);
    { const f32x4 fr = *(const f32x4*)(a.in[I_HF3] + l * 64 + f4); const f32x4 hv = (f32x4){sinf(fr.x * s.x), sinf(fr.y * s.y), sinf(fr.z * s.z), sinf(fr.w * s.w)}; *(f32x4*)(H3out + (size_t)t * 64 + f4) = hv;
      if (H3b) { u32x2 pk; pk.x = pk2(hv.x, hv.y); pk.y = pk2(hv.z, hv.w); *(u32x2*)(H3b + (size_t)t * 64 + f4) = pk; } }
    __syncthreads();
}

__device__ __forceinline__ void transpose_item(const float* W, int ldw, int srccol_lane  , int k0, bf16_t* WT, int K, int dstrow0, LAS float* scr, int lane) {
    float wv[32];
#pragma unroll
    for (int i = 0; i < 32; ++i) { const int kk = 2 * i + (lane >> 5); wv[i] = srccol_lane >= 0 ? W[(size_t)(k0 + kk) * ldw + srccol_lane] : 0.f; }
#pragma unroll
    for (int i = 0; i < 32; ++i) { const int kk = 2 * i + (lane >> 5); scr[kk * 33 + (lane & 31)] = wv[i]; }
    LDS_WAIT();
    const int c = lane & 7;
#pragma unroll
    for (int j = 0; j < 4; ++j) { const int n = (lane >> 3) + 8 * j; const LAS float* s = scr + (8 * c) * 33 + n;
        u32x4 o; o.x = pk2(s[0 * 33], s[1 * 33]); o.y = pk2(s[2 * 33], s[3 * 33]); o.z = pk2(s[4 * 33], s[5 * 33]); o.w = pk2(s[6 * 33], s[7 * 33]);
        *(u32x4*)(WT + (size_t)(dstrow0 + n) * K + k0 + 8 * c) = o; }
    LDS_WAIT();
}
__device__ __forceinline__ int win_srccol(int n) {
    if (n >= 3072 && n < 4096) { const int u = (n - 3072) & 127, grp = u >> 3, e = u & 7; return (n & ~127) + (e < 4 ? 4 * grp + e : 64 + 4 * grp + (e - 4)); }
    return n < 6144 ? n : (n < 6656 ? n + 32 : (n < 6688 ? n - 512 : -1));
}

__device__ __forceinline__ void norm_row(const float* xrow, const float* nw, const float* mod, bf16_t* hrow, int lane) {
    f32x4 v[8]; float ss = 0.f;
#pragma unroll
    for (int j = 0; j < 8; ++j) { v[j] = ((const f32x4*)xrow)[lane + 64 * j]; ss += (v[j].x * v[j].x + v[j].y * v[j].y) + (v[j].z * v[j].z + v[j].w * v[j].w); }
    const float rstd = rsqrtf(wave_sum(ss) * (1.0f / D) + EPS);
#pragma unroll
    for (int j = 0; j < 8; ++j) { const int k = 4 * (lane + 64 * j);
        const f32x4 w = *(const f32x4*)(nw + k), sh = *(const f32x4*)(mod + k), sc = *(const f32x4*)(mod + D + k);
        const f32x4 o = v[j] * rstd * w * (sc + 1.0f) + sh;
        u32x2 pk; pk.x = pk2(o.x, o.y); pk.y = pk2(o.z, o.w);
        *(u32x2*)(hrow + k) = pk; }
}

__device__ __forceinline__ float block_sum(float v, LAS float* red, int tid) {
    v = wave_sum(v);
    if ((tid & 63) == 0) red[tid >> 6] = v;
    __syncthreads();
    float t = 0.f;
#pragma unroll
    for (int i = 0; i < NWAVES; ++i) t += red[i];
    __syncthreads();
    return t;
}
constexpr float HY_D0 = -3.0701134573253945f  , HY_D1 = -15.350567286626973f  ;

__device__ __forceinline__ void filt_ctx_item(const DArgs& a, unsigned char* ws, LAS unsigned char* lds, int c, int tid) {
    LAS float* w4s = (LAS float*)lds; LAS float* red = (LAS float*)(lds + 1024);
    if (tid < 256) { const int cc = tid >> 6, f = tid & 63; w4s[tid] = a.in[I_HW4][(size_t)f * 2048 + (cc >> 1) * 1024 + (cc & 1) * 512 + c]; }
    __syncthreads();
    const float dl = fabsf(HY_D0 + (HY_D1 - HY_D0) * ((float)c / 511.0f));
    const float* H3C = (const float*)(ws + WS_H3C);
    const int n = tid, dir = n >= 256 ? 1 : 0, t = dir ? (512 - n) : n;
    float s0 = 0.f, s1 = 0.f;
    if (n != 256) {
        const f32x4* hr = (const f32x4*)(H3C + (size_t)t * 64);
#pragma unroll
        for (int q = 0; q < 16; ++q) { const f32x4 hv = hr[q]; const f32x4 wa = ((const LAS f32x4*)(w4s + (dir * 2 + 0) * 64))[q], wb = ((const LAS f32x4*)(w4s + (dir * 2 + 1) * 64))[q];
            s0 += (hv.x * wa.x + hv.y * wa.y) + (hv.z * wa.z + hv.w * wa.w); s1 += (hv.x * wb.x + hv.y * wb.y) + (hv.z * wb.z + hv.w * wb.w); }
        const float dec = expf(-((float)t / 255.0f) * dl); s0 *= dec; s1 *= dec;
    }
    const float rs0 = rsqrtf(block_sum(s0 * s0, red, tid) + EPS), rs1 = rsqrtf(block_sum(s1 * s1, red, tid) + EPS);
    float* KC = (float*)(ws + WS_KC);
    KC[(size_t)(0 * 512 + c) * 512 + n] = s0 * rs0; KC[(size_t)(1 * 512 + c) * 512 + n] = s1 * rs1;
    __syncthreads();
}

__device__ __forceinline__ void prep_rope(f32x2* RT, int it, int tid) {
    const int idx = it * NT + tid, pos = idx >> 6, j = idx & 63;
    float ang;
    if (pos < SEQL) { const float inv = exp2f(-(float)(j & 31) * (13.287712379549449f / 32.0f)); ang = (float)(j < 32 ? (pos >> 6) : (pos & 63)) * inv; }
    else { const float inv = exp2f(-(float)j * (13.287712379549449f / 64.0f)); ang = (float)(pos - SEQL) * inv; }
    float sn, cs; sincosf(ang, &sn, &cs);
    RT[idx] = (f32x2){cs, sn};
}

__device__ __forceinline__ float sconv3(const bf16_t* p, int t, int Lx, float w0, float w1, float w2, float cb) {
    const float x0 = t > 0 ? bf2f(p[t - 1]) : 0.f, x1 = bf2f(p[t]), x2 = t < Lx - 1 ? bf2f(p[t + 1]) : 0.f;
    return w0 * x0 + w1 * x1 + w2 * x2 + cb;
}
__device__ __forceinline__ void ctx_conv256(const LAS float* kc, const LAS float* z, int b, int t4, int half, float (&o)[4]) {
    o[0] = o[1] = o[2] = o[3] = 0.f;
#pragma unroll 4
    for (int s4 = 0; s4 < 32; ++s4) { const int s = 128 * half + 4 * s4, d = 4 * t4 - s;
        const f32x4 zv = *(const LAS f32x4*)(z + b * 256 + s);
        const f32x4 wl = *(const LAS f32x4*)(kc + ((d - 4) & 511)), wh = *(const LAS f32x4*)(kc + (d & 511));
        const float w[8] = {wl.x, wl.y, wl.z, wl.w, wh.x, wh.y, wh.z, wh.w};
        const float zz[4] = {zv.x, zv.y, zv.z, zv.w};
#pragma unroll
        for (int j = 0; j < 4; ++j)
#pragma unroll
            for (int i = 0; i < 4; ++i) o[j] += w[4 + j - i] * zz[i]; }
}
__device__ __forceinline__ void hyena_ctx_item(const DArgs& a, unsigned char* ws, LAS unsigned char* lds, int c, int tid) {
    LAS float* kc = (LAS float*)lds; LAS float* za = (LAS float*)(lds + 4096); LAS float* zb = (LAS float*)(lds + 8192); LAS float* part = (LAS float*)(lds + 12288);
    const float* KC = (const float*)(ws + WS_KC);
    kc[tid] = KC[(size_t)(0 * 512 + c) * 512 + tid]; kc[512 + tid] = KC[(size_t)(1 * 512 + c) * 512 + tid];
    const float* cw = a.in[I_HCW]; const float* cbp = a.in[I_HCB];
    const float wv0 = cw[c], wv1 = cw[1536 + c], wv2 = cw[3072 + c], bv = cbp[c];
    const float wa0 = cw[512 + c], wa1 = cw[1536 + 512 + c], wa2 = cw[3072 + 512 + c], ba = cbp[512 + c];
    const float wb0 = cw[1024 + c], wb1 = cw[1536 + 1024 + c], wb2 = cw[3072 + 1024 + c], bb = cbp[1024 + c];
    const float bias0 = a.in[I_HBIAS][0 * 512 + c], bias1 = a.in[I_HBIAS][1 * 512 + c];
    const bf16_t* PT = (const bf16_t*)(ws + WS_PT);
    const int half = tid >> 8, b = (tid >> 6) & 3, t4 = tid & 63; const int rb = NLAT + b * LC;
    const bf16_t* pv = PT + (size_t)(PT_V + c) * MR + rb; const bf16_t* pg1 = PT + (size_t)(PT_G1 + c) * MR + rb; const bf16_t* pg2 = PT + (size_t)(PT_G2 + c) * MR + rb; const bf16_t* phg = PT + (size_t)(PT_HG + c) * MR + rb;
    bf16_t* GATED = (bf16_t*)(ws + WS_H);
    float z0[4], z1[4], o[4], g1v[4], g2v[4], hgv[4];
#pragma unroll
    for (int j = 0; j < 4; ++j) { z0[j] = sconv3(pv, 4 * t4 + j, LC, wv0, wv1, wv2, bv); g1v[j] = sconv3(pg1, 4 * t4 + j, LC, wa0, wa1, wa2, ba); g2v[j] = sconv3(pg2, 4 * t4 + j, LC, wb0, wb1, wb2, bb); hgv[j] = bf2f(phg[4 * t4 + j]); }
    if (half == 0) *(LAS f32x4*)(za + b * 256 + 4 * t4) = (f32x4){z0[0], z0[1], z0[2], z0[3]};
    __syncthreads();
    ctx_conv256(kc, za, b, t4, half, o);
    if (half == 1) *(LAS f32x4*)(part + b * 256 + 4 * t4) = (f32x4){o[0], o[1], o[2], o[3]};
    __syncthreads();
    if (half == 0) { const f32x4 pp = *(const LAS f32x4*)(part + b * 256 + 4 * t4); const float ps[4] = {pp.x, pp.y, pp.z, pp.w};
#pragma unroll
        for (int j = 0; j < 4; ++j) z1[j] = g1v[j] * (o[j] + ps[j] + bias0 * z0[j]);
        *(LAS f32x4*)(zb + b * 256 + 4 * t4) = (f32x4){z1[0], z1[1], z1[2], z1[3]}; }
    __syncthreads();
    ctx_conv256(kc + 512, zb, b, t4, half, o);
    if (half == 1) *(LAS f32x4*)(part + b * 256 + 4 * t4) = (f32x4){o[0], o[1], o[2], o[3]};
    __syncthreads();
    if (half == 0) { const f32x4 pp = *(const LAS f32x4*)(part + b * 256 + 4 * t4); const float ps[4] = {pp.x, pp.y, pp.z, pp.w};
#pragma unroll
        for (int j = 0; j < 4; ++j) { const int t = 4 * t4 + j; const float z2 = g2v[j] * (o[j] + ps[j] + bias1 * z1[j]);
            GATED[(size_t)(rb + t) * D + 512 + c] = (bf16_t)f2bf(z2 * siluf_(hgv[j])); } }
    __syncthreads();
}

struct EpiInProj {
    static constexpr bool PERM = true, AFTER_DRAIN = false;
    bf16_t* P; bf16_t* PT; float* LR; const float* RT;
    __device__ __forceinline__ void operator()(const pg8::f32x4 (&acc)[2][2][4][2], const pg8::Unit& u, int wr, int wc, int fr, int fq) const {
        const int row0 = u.pm * 256 + wr * 64 + fr, pn = u.pn;
        if (pn >= 12 && pn < 16) {
            const int colbase = pn * 256 - 2048 + wc * 32 + 8 * fq; const int j0 = 4 * (4 * wc + fq); const float ksc = pn >= 14 ? 0.08838834764831845f : 1.0f;
#pragma unroll
            for (int ai = 0; ai < 2; ++ai)
#pragma unroll
                for (int m = 0; m < 4; ++m) { const int row = row0 + ai * 128 + m * 16; const int pos = row < NLAT ? (row & (SEQL - 1)) : SEQL + ((row - NLAT) & (LC - 1));
                    const pg8::f32x4 t0 = *(const pg8::f32x4*)(RT + ((size_t)pos * 64 + j0) * 2), t1 = *(const pg8::f32x4*)(RT + ((size_t)pos * 64 + j0) * 2 + 4);
                    bf16_t* rowp = P + (size_t)row * LDP + colbase;
#pragma unroll
                    for (int bj = 0; bj < 2; ++bj) { const pg8::f32x4 x1 = acc[ai][bj][m][0] * ksc, x2 = acc[ai][bj][m][1] * ksc;
                        u32x4 w; w.x = pk2(x1[0] * t0[0] - x2[0] * t0[1], x1[1] * t0[2] - x2[1] * t0[3]); w.y = pk2(x1[2] * t1[0] - x2[2] * t1[1], x1[3] * t1[2] - x2[3] * t1[3]);
                        w.z = pk2(x1[0] * t0[1] + x2[0] * t0[0], x1[1] * t0[3] + x2[1] * t0[2]); w.w = pk2(x1[2] * t1[1] + x2[2] * t1[0], x1[3] * t1[3] + x2[3] * t1[2]);
                        *(u32x4*)(rowp + bj * 128) = w; } }
        } else if (pn < 4 || (pn >= 16 && pn < 26)) {
            const int colbase = (pn < 4 ? pn * 256 : pn * 256 - 2048) + wc * 32 + 8 * fq;
#pragma unroll
            for (int ai = 0; ai < 2; ++ai)
#pragma unroll
                for (int m = 0; m < 4; ++m) { bf16_t* rowp = P + (size_t)(row0 + ai * 128 + m * 16) * LDP + colbase;
#pragma unroll
                    for (int bj = 0; bj < 2; ++bj) { const pg8::f32x4 v0 = acc[ai][bj][m][0], v1 = acc[ai][bj][m][1];
                        u32x4 w; w.x = pk2(v0[0], v0[1]); w.y = pk2(v0[2], v0[3]); w.z = pk2(v1[0], v1[1]); w.w = pk2(v1[2], v1[3]);
                        *(u32x4*)(rowp + bj * 128) = w; } }
        } else if (pn < 12) {
            const int colbase = (pn - 4) * 256 + wc * 32 + 8 * fq;
#pragma unroll
            for (int bj = 0; bj < 2; ++bj)
#pragma unroll
                for (int n = 0; n < 2; ++n)
#pragma unroll
                    for (int j = 0; j < 4; ++j) { bf16_t* cp = PT + (size_t)(colbase + bj * 128 + 4 * n + j) * MR + row0;
#pragma unroll
                        for (int ai = 0; ai < 2; ++ai)
#pragma unroll
                            for (int m = 0; m < 4; ++m) cp[ai * 128 + m * 16] = (bf16_t)f2bf(acc[ai][bj][m][n][j]);
                        asm volatile("" ::: "memory"); }
        } else {
            if (wc == 0) {
#pragma unroll
                for (int ai = 0; ai < 2; ++ai)
#pragma unroll
                    for (int m = 0; m < 4; ++m) { float* rowp = LR + (size_t)(row0 + ai * 128 + m * 16) * 32 + 8 * fq;
                        *(pg8::f32x4*)(rowp) = acc[ai][0][m][0]; *(pg8::f32x4*)(rowp + 4) = acc[ai][0][m][1]; }
            }
        }
    }
};
struct EpiGlu {
    static constexpr bool PERM = true, AFTER_DRAIN = false;
    const bf16_t* GG; bf16_t* GATED; const float* bias;
    __device__ __forceinline__ void operator()(const pg8::f32x4 (&acc)[2][2][4][2], const pg8::Unit& u, int wr, int wc, int fr, int fq) const {
        const int row0 = u.pm * 256 + wr * 64 + fr, col0 = u.pn * 256 + wc * 32 + 8 * fq;
        pg8::f32x4 b0[2], b1[2];
#pragma unroll
        for (int bj = 0; bj < 2; ++bj) { b0[bj] = *(const pg8::f32x4*)(bias + col0 + bj * 128); b1[bj] = *(const pg8::f32x4*)(bias + col0 + bj * 128 + 4); }
#pragma unroll
        for (int ai = 0; ai < 2; ++ai) {
            u32x4 gg[4][2];
#pragma unroll
            for (int m = 0; m < 4; ++m)
#pragma unroll
                for (int bj = 0; bj < 2; ++bj) gg[m][bj] = *(const u32x4*)(GG + (size_t)(row0 + ai * 128 + m * 16) * 512 + col0 + bj * 128);
#pragma unroll
            for (int m = 0; m < 4; ++m) { const size_t row = (size_t)(row0 + ai * 128 + m * 16);
#pragma unroll
                for (int bj = 0; bj < 2; ++bj) { float g[8], res[8]; unpack8(gg[m][bj], g);
#pragma unroll
                    for (int j = 0; j < 4; ++j) { res[j] = g[j] * sigmoidf_(acc[ai][bj][m][0][j] + b0[bj][j]); res[4 + j] = g[4 + j] * sigmoidf_(acc[ai][bj][m][1][j] + b1[bj][j]); }
                    *(u32x4*)(GATED + row * D + col0 + bj * 128) = pack8(res); } }
            asm volatile("" ::: "memory");
        }
    }
};
struct EpiOut {
    static constexpr bool PERM = false, AFTER_DRAIN = false;
    const float* xl_old; const float* xc_old; float* xl_new; float* xc_new; const float* mod;
    __device__ __forceinline__ void operator()(const pg8::f32x4 (&acc)[2][2][4][2], const pg8::Unit& u, int wr, int wc, int fr, int fq) const {
        const int row0 = u.pm * 256 + wr * 64 + fr, col0 = u.pn * 256 + wc * 32 + 4 * fq;
        const bool lat = u.pm < 64;
        const float* xo = lat ? xl_old : xc_old - (size_t)NLAT * D; float* xn = lat ? xl_new : xc_new - (size_t)NLAT * D;
#pragma unroll
        for (int ai = 0; ai < 2; ++ai) {
            const int v = lat ? ((u.pm * 256 + ai * 128) >> 12) : 4;
            const float* gt = mod + (size_t)v * ADA + 2 * D;
#pragma unroll
            for (int m = 0; m < 4; ++m) { const size_t off = (size_t)(row0 + ai * 128 + m * 16) * D + col0;
#pragma unroll
                for (int bj = 0; bj < 2; ++bj)
#pragma unroll
                    for (int n = 0; n < 2; ++n) { const int cc = bj * 128 + n * 16; const pg8::f32x4 gv = *(const pg8::f32x4*)(gt + col0 + cc), xv = *(const pg8::f32x4*)(xo + off + cc);
                        *(pg8::f32x4*)(xn + off + cc) = xv + gv * acc[ai][bj][m][n]; } }
        }
    }
};
typedef short bf16x8 __attribute__((ext_vector_type(8)));
typedef short bf16x4 __attribute__((ext_vector_type(4)));
__device__ __forceinline__ unsigned off_b(unsigned row, unsigned ch) { return 256u * row + 16u * (ch ^ (((row & 3) << 2) | ((row >> 2) & 3))); }
__device__ __forceinline__ bf16x8 img_row_frag(const LAS unsigned char* img, unsigned lane, unsigned rb, unsigned s) { return *(const LAS bf16x8*)(img + off_b((lane & 15) + 16 * rb, 4 * s + (lane >> 4))); }
__device__ __forceinline__ bf16x4 img_tr4(const LAS unsigned char* img, unsigned lane, unsigned c, unsigned row0) {
    const unsigned q = (lane & 15) >> 2, p = lane & 3;
    return __builtin_amdgcn_ds_read_tr16_b64_v4i16((LAS bf16x4*)(img + off_b(row0 + q, 2 * c + (p >> 1)) + 8 * (p & 1)));
}
__device__ __forceinline__ bf16x8 img_tr_frag(const LAS unsigned char* img, unsigned lane, unsigned c, unsigned ks) {
    const unsigned g = lane >> 4; const bf16x4 lo = img_tr4(img, lane, c, 32 * ks + 8 * g), hi = img_tr4(img, lane, c, 32 * ks + 8 * g + 4);
    return __builtin_shufflevector(lo, hi, 0, 1, 2, 3, 4, 5, 6, 7);
}
__device__ __forceinline__ bf16x8 img_tr_frag_acc(const LAS unsigned char* img, unsigned lane, unsigned c, unsigned ks) {
    const unsigned g = lane >> 4; const bf16x4 lo = img_tr4(img, lane, c, 32 * ks + 4 * g), hi = img_tr4(img, lane, c, 32 * ks + 16 + 4 * g);
    return __builtin_shufflevector(lo, hi, 0, 1, 2, 3, 4, 5, 6, 7);
}
__device__ __forceinline__ bf16x8 acc_pair_frag(const f32x4 a0, const f32x4 a1) {
    u32x4 w; w.x = pk2(a0.x, a0.y); w.y = pk2(a0.z, a0.w); w.z = pk2(a1.x, a1.y); w.w = pk2(a1.z, a1.w);
    return __builtin_bit_cast(bf16x8, w);
}
#define MFMA16(A_, B_, C_) __builtin_amdgcn_mfma_f32_16x16x32_bf16((A_), (B_), (C_), 0, 0, 0)
__device__ __forceinline__ void stage_tile128(LAS unsigned char* img, const bf16_t* g, size_t ld, int tid) {
#pragma unroll
    for (int i = 0; i < 4; ++i) { const int n = tid + NT * i, row = n >> 4, ch = n & 15; *(LAS u32x4*)(img + off_b(row, ch)) = *(const u32x4*)(g + (size_t)row * ld + ch * 8); }
}

constexpr int RCH = 128, RNCH = 34;
constexpr size_t WS_RST = WS_OB;
__device__ __forceinline__ int ret_rowbase(int b, int cc) { return cc < 2 ? NLAT + b * LC + cc * RCH : b * SEQL + (cc - 2) * RCH; }
__device__ __forceinline__ float ret_log2g(int h) { return log2f(1.0f - exp2f(-5.0f - (float)h)); }

__device__ __forceinline__ void ret_passA(unsigned char* ws, LAS unsigned char* lds, int item, int tid) {
    const int bh = item / RNCH, cc = item % RNCH, b = bh >> 2, h = bh & 3;
    const int lane = tid & 63, w = tid >> 6, g = lane >> 4;
    LAS unsigned char* KF = lds; LAS unsigned char* KB = lds + 32768; LAS unsigned char* VI = lds + 65536;
    const bf16_t* P = (const bf16_t*)(ws + WS_P) + (size_t)ret_rowbase(b, cc) * LDP;
    const float l2g = ret_log2g(h);
    __syncthreads();
#pragma unroll
    for (int i = 0; i < 4; ++i) { const int n = tid + NT * i, row = n >> 4, ch = n & 15;
        const u32x4 kr = *(const u32x4*)(P + (size_t)row * LDP + PC_RK + h * 128 + ch * 8);
        float kf[8], a[8], c[8]; unpack8(kr, kf);
        const float sf = exp2f(l2g * (float)(RCH - 1 - row)), sb = exp2f(l2g * (float)row);
#pragma unroll
        for (int x = 0; x < 8; ++x) { a[x] = kf[x] * sf; c[x] = kf[x] * sb; }
        *(LAS u32x4*)(KF + off_b(row, ch)) = pack8(a); *(LAS u32x4*)(KB + off_b(row, ch)) = pack8(c);
        *(LAS u32x4*)(VI + off_b(row, ch)) = *(const u32x4*)(P + (size_t)row * LDP + PC_RV + h * 128 + ch * 8); }
    __syncthreads();
    bf16x8 af[4], ab[4];
#pragma unroll
    for (int ks = 0; ks < 4; ++ks) { af[ks] = img_tr_frag(KF, lane, w, ks); ab[ks] = img_tr_frag(KB, lane, w, ks); }
    bf16_t* ST = (bf16_t*)(ws + WS_RST) + ((size_t)(bh * 2) * RNCH + cc) * (128 * 128);
#pragma unroll 2
    for (int E = 0; E < 8; ++E) {
        f32x4 cf = {0.f, 0.f, 0.f, 0.f}, cb = {0.f, 0.f, 0.f, 0.f};
#pragma unroll
        for (int ks = 0; ks < 4; ++ks) { const bf16x8 vb = img_tr_frag(VI, lane, E, ks); cf = MFMA16(af[ks], vb, cf); cb = MFMA16(ab[ks], vb, cb); }
        const int e = 16 * E + (lane & 15), d0 = 16 * w + 4 * g;
        u32x2 o; o.x = pk2(cf.x, cf.y); o.y = pk2(cf.z, cf.w); *(u32x2*)(ST + (size_t)e * 128 + d0) = o;
        o.x = pk2(cb.x, cb.y); o.y = pk2(cb.z, cb.w); *(u32x2*)(ST + (size_t)RNCH * 128 * 128 + (size_t)e * 128 + d0) = o;
    }
}
__device__ __forceinline__ void ret_passB(unsigned char* ws, int gt  ) {
    const int el = gt & 2047, bd = gt >> 11, bh = bd >> 1, dir = bd & 1, h = bh & 3;
    const float gC = exp2f(ret_log2g(h) * (float)RCH);
    bf16_t* base = (bf16_t*)(ws + WS_RST) + (size_t)bd * RNCH * (128 * 128) + (size_t)el * 8;
    float acc[8];
#pragma unroll
    for (int x = 0; x < 8; ++x) acc[x] = 0.f;
#pragma unroll 1
    for (int s0 = 0; s0 < RNCH; s0 += 17) {
        u32x4 kvr[17];
#pragma unroll
        for (int j = 0; j < 17; ++j) { const int s = s0 + j; const int cc = dir == 0 ? s : (s < 2 ? 1 - s : 35 - s); kvr[j] = *(const u32x4*)(base + (size_t)cc * (128 * 128)); }
#pragma unroll
        for (int j = 0; j < 17; ++j) { const int s = s0 + j; const int cc = dir == 0 ? s : (s < 2 ? 1 - s : 35 - s);
            float kv[8]; unpack8(kvr[j], kv);
            *(u32x4*)(base + (size_t)cc * (128 * 128)) = pack8(acc);
#pragma unroll
            for (int x = 0; x < 8; ++x) acc[x] = gC * acc[x] + kv[x]; }
    }
}
__device__ __forceinline__ void ret_passC(const DArgs& a, unsigned char* ws, LAS unsigned char* lds, int l, int item, int tid) {
    const int bh = item / RNCH, cc = item % RNCH, b = bh >> 2, h = bh & 3;
    const int lane = tid & 63, w = tid >> 6, g = lane >> 4, il = lane & 15;
    LAS unsigned char* KI = lds; LAS unsigned char* VI = lds + 32768; LAS unsigned char* SF = lds + 65536; LAS unsigned char* SB = lds + 98304;
    const int rowbase = ret_rowbase(b, cc);
    const bf16_t* P = (const bf16_t*)(ws + WS_P) + (size_t)rowbase * LDP;
    const bf16_t* STf = (const bf16_t*)(ws + WS_RST) + ((size_t)(bh * 2) * RNCH + cc) * (128 * 128);
    const bf16_t* STb = STf + (size_t)RNCH * 128 * 128;
    __syncthreads();
    stage_tile128(KI, P + PC_RK + h * 128, LDP, tid); stage_tile128(VI, P + PC_RV + h * 128, LDP, tid);
    stage_tile128(SF, STf, 128, tid); stage_tile128(SB, STb, 128, tid);
    bf16x8 qf[4];
    { const bf16_t* qr = P + (size_t)(16 * w + il) * LDP + PC_RQ + h * 128 + 8 * g;
#pragma unroll
      for (int ks = 0; ks < 4; ++ks) qf[ks] = *(const bf16x8*)(qr + 32 * ks); }
    const int iloc = 16 * w + il;
    u32x2 grv[8]; f32x4 nvv[8];
    { const bf16_t* gp0 = (const bf16_t*)(ws + WS_P) + ((size_t)rowbase + iloc) * LDP + PC_RG + h * 128 + 4 * g; const float* nw0 = a.in[I_RNW] + l * 512 + h * 128 + 4 * g;
#pragma unroll
      for (int E = 0; E < 8; ++E) { grv[E] = *(const u32x2*)(gp0 + 16 * E); nvv[E] = *(const f32x4*)(nw0 + 16 * E); } }
    __syncthreads();
    const float l2g = ret_log2g(h);
    f32x4 o[8];
    { const float sf = exp2f(l2g * (float)(iloc + 1)), sb = exp2f(l2g * (float)(RCH - iloc));
#pragma unroll
      for (int E = 0; E < 8; ++E) { f32x4 rf = {0.f, 0.f, 0.f, 0.f}, rb = {0.f, 0.f, 0.f, 0.f};
#pragma unroll
          for (int ks = 0; ks < 4; ++ks) { rf = MFMA16(img_row_frag(SF, lane, E, ks), qf[ks], rf); rb = MFMA16(img_row_frag(SB, lane, E, ks), qf[ks], rb); }
          o[E] = rf * sf + rb * sb; } }
    f32x4 at[8];
#pragma unroll
    for (int T = 0; T < 8; ++T) { f32x4 c = {0.f, 0.f, 0.f, 0.f};
#pragma unroll
        for (int ks = 0; ks < 4; ++ks) c = MFMA16(img_row_frag(KI, lane, T, ks), qf[ks], c);
#pragma unroll
        for (int r = 0; r < 4; ++r) { const int j = 16 * T + 4 * g + r; const int dd = iloc > j ? iloc - j : j - iloc; c[r] *= (dd == 0 ? 2.0f : exp2f(l2g * (float)dd)); }
        at[T] = c; }
#pragma unroll
    for (int s = 0; s < 4; ++s) { const bf16x8 bfr = acc_pair_frag(at[2 * s], at[2 * s + 1]);
#pragma unroll
        for (int E = 0; E < 8; ++E) o[E] = MFMA16(img_tr_frag_acc(VI, lane, E, s), bfr, o[E]); }
    float ss = 0.f;
#pragma unroll
    for (int E = 0; E < 8; ++E) ss += (o[E].x * o[E].x + o[E].y * o[E].y) + (o[E].z * o[E].z + o[E].w * o[E].w);
    ss += __shfl_xor(ss, 16); ss += __shfl_xor(ss, 32);
    const float rn = rsqrtf(ss * (1.0f / 128.0f) + EPS);
    const size_t row = (size_t)rowbase + iloc;
    const bf16_t* gp = (const bf16_t*)(ws + WS_P) + row * LDP + PC_RG + h * 128 + 4 * g;
    const float* nw = a.in[I_RNW] + l * 512 + h * 128 + 4 * g;
    bf16_t* op = (bf16_t*)(ws + WS_H) + row * D + 1024 + h * 128 + 4 * g;
#pragma unroll
    for (int E = 0; E < 8; ++E) { const u32x2 gr = grv[E]; const f32x4 nv = nvv[E];
        u32x2 ov; ov.x = pk2(o[E].x * rn * nv.x * siluf_(bflo(gr.x)), o[E].y * rn * nv.y * siluf_(bfhi(gr.x)));
        ov.y = pk2(o[E].z * rn * nv.z * siluf_(bflo(gr.y)), o[E].w * rn * nv.w * siluf_(bfhi(gr.y)));
        *(u32x2*)(op + 16 * E) = ov; }
}
constexpr int GCH = 64, GNCH = 68;
constexpr size_t WS_GST = WS_OB + (size_t)2 * OBSZ * 2;
constexpr size_t WS_GDEC = WS_END;
constexpr size_t WS_H3B = WS_GDEC + (size_t)16 * 2 * GNCH * 64 * 4;
constexpr size_t WS_ROPE = WS_H3B + (size_t)2 * 4096 * 64 * 2;
constexpr size_t WS_TWID = WS_ROPE + (size_t)(SEQL + LC) * 64 * 8;
constexpr size_t WS_END2 = WS_TWID + 4096 * 8;
__device__ __forceinline__ int gla_rowbase(int b, int cg) { return cg < 4 ? NLAT + b * LC + cg * GCH : b * SEQL + (cg - 4) * GCH; }

constexpr int GLS = 68;
__device__ __forceinline__ void gla_gates_compute(const DArgs& a, unsigned char* ws, LAS float* BF, LAS float* BB, LAS float* GW  , int l, int h, int rowbase, int tid) {
    const int t = tid >> 3, d8 = tid & 7;
    const float* lr = (const float*)(ws + WS_LR) + (size_t)(rowbase + t) * 32;
    f32x4 lv[8];
#pragma unroll
    for (int q = 0; q < 8; ++q) lv[q] = ((const f32x4*)lr)[q];
    { const int dir = tid >> 8, r = (tid >> 4) & 15, c4 = (tid & 15) * 4;
      *(LAS f32x4*)(GW + (dir * 17 + r) * 64 + c4) = *(const f32x4*)(a.in[I_GGW] + (size_t)(l * 2 + dir) * 16 * 256 + r * 256 + h * 64 + c4);
      if (tid < 32) { const int dd = tid >> 4; *(LAS f32x4*)(GW + (dd * 17 + 16) * 64 + c4) = *(const f32x4*)(a.in[I_GGB] + (size_t)(l * 2 + dd) * 256 + h * 64 + c4); } }
    __syncthreads();
    bf16_t* GLG = (bf16_t*)(ws + WS_WIN);
#pragma unroll
    for (int dir = 0; dir < 2; ++dir) {
        const LAS float* gw = GW + dir * 17 * 64 + 8 * d8;
        f32x4 s0 = *(const LAS f32x4*)(gw + 16 * 64), s1 = *(const LAS f32x4*)(gw + 16 * 64 + 4);
#pragma unroll
        for (int j = 0; j < 16; ++j) { const float lj = lv[dir * 4 + (j >> 2)][j & 3]; s0 += lj * *(const LAS f32x4*)(gw + j * 64); s1 += lj * *(const LAS f32x4*)(gw + j * 64 + 4); }
        LAS float* dst = (dir ? BB : BF) + t * GLS + 8 * d8;
        float la[8];
#pragma unroll
        for (int x = 0; x < 8; ++x) { const float s = x < 4 ? s0[x] : s1[x - 4]; const float e = __expf(-fabsf(s)); const float ls = fminf(s, 0.f) - __logf(1.0f + e); la[x] = ls * (1.0f / 16.0f); }
        const u32x4 pk = pack8(la);
        *(u32x4*)(GLG + ((size_t)dir * MR + rowbase + t) * 256 + h * 64 + 8 * d8) = pk;
        float lq[8]; unpack8(pk, lq);
        *(LAS f32x4*)dst = (f32x4){lq[0], lq[1], lq[2], lq[3]}; *(LAS f32x4*)(dst + 4) = (f32x4){lq[4], lq[5], lq[6], lq[7]};
    }
}
__device__ __forceinline__ void gla_gates_load(unsigned char* ws, LAS float* BF, LAS float* BB, int h, int rowbase, int tid) {
    const int t = tid >> 3, d8 = tid & 7;
    const bf16_t* GLG = (const bf16_t*)(ws + WS_WIN);
#pragma unroll
    for (int dir = 0; dir < 2; ++dir) { float lq[8]; unpack8(*(const u32x4*)(GLG + ((size_t)dir * MR + rowbase + t) * 256 + h * 64 + 8 * d8), lq);
        LAS float* dst = (dir ? BB : BF) + t * GLS + 8 * d8;
        *(LAS f32x4*)dst = (f32x4){lq[0], lq[1], lq[2], lq[3]}; *(LAS f32x4*)(dst + 4) = (f32x4){lq[4], lq[5], lq[6], lq[7]}; }
}
__device__ __forceinline__ void gla_scan(LAS float* BF, LAS float* BB, int tid) {
    const int lane = tid & 63, w = tid >> 6;
    __syncthreads();
#pragma unroll 4
    for (int c = 0; c < 16; ++c) { const int col = 16 * w + c; const int dir = col >> 6, d = col & 63;
        LAS float* p = (dir ? BB : BF) + (dir ? 63 - lane : lane) * GLS + d;
        float v = *p;
#pragma unroll
        for (int off = 1; off < 64; off <<= 1) { const float u = __shfl_up(v, off); if (lane >= off) v += u; }
        *p = v; }
    __syncthreads();
}

__device__ __forceinline__ void gla_passA(const DArgs& a, unsigned char* ws, LAS unsigned char* lds, int l, int item, int tid) {
    const int bh = item / GNCH, cg = item % GNCH, b = bh >> 2, h = bh & 3;
    const int lane = tid & 63, w = tid >> 6, g = lane >> 4;
    LAS float* BF = (LAS float*)lds; LAS float* BB = (LAS float*)(lds + 17408); LAS unsigned char* KH = lds + 34816; LAS unsigned char* VI = lds + 34816 + 16384;
    const int rowbase = gla_rowbase(b, cg);
    const bf16_t* P = (const bf16_t*)(ws + WS_P) + (size_t)rowbase * LDP;
    const int t = tid >> 3, d8 = tid & 7;
    const u32x4 kraw = *(const u32x4*)(P + (size_t)t * LDP + PC_GK + h * 64 + 8 * d8);
    u32x4 vraw[2];
#pragma unroll
    for (int i = 0; i < 2; ++i) { const int n = tid + NT * i; vraw[i] = *(const u32x4*)(P + (size_t)(n >> 4) * LDP + PC_GV + h * 128 + (n & 15) * 8); }
    gla_gates_compute(a, ws, BF, BB, (LAS float*)(lds + 34816 + 32768), l, h, rowbase, tid);
    gla_scan(BF, BB, tid);
    { float kf[8], x0[8], x1[8]; unpack8(kraw, kf);
#pragma unroll
      for (int x = 0; x < 8; ++x) { const int d = 8 * d8 + x; x0[x] = kf[x] * __expf(BF[63 * GLS + d] - BF[t * GLS + d]); x1[x] = kf[x] * __expf(BB[d] - BB[t * GLS + d]); }
      *(LAS u32x4*)(KH + off_b(t, d8)) = pack8(x0); *(LAS u32x4*)(KH + off_b(t, 8 + d8)) = pack8(x1);
#pragma unroll
      for (int i = 0; i < 2; ++i) { const int n = tid + NT * i; *(LAS u32x4*)(VI + off_b(n >> 4, n & 15)) = vraw[i]; }
      if (tid < 128) { const int dir = tid >> 6, d = tid & 63; ((float*)(ws + WS_GDEC))[((size_t)(bh * 2 + dir) * GNCH + cg) * 64 + d] = __expf(dir ? BB[d] : BF[63 * GLS + d]); } }
    __syncthreads();
    const int dir = w >> 2, Dt = w & 3;
    bf16x8 af[2];
#pragma unroll
    for (int ks = 0; ks < 2; ++ks) af[ks] = img_tr_frag(KH, lane, dir * 4 + Dt, ks);
    bf16_t* ST = (bf16_t*)(ws + WS_GST) + ((size_t)(bh * 2 + dir) * GNCH + cg) * (128 * 64);
#pragma unroll 2
    for (int E = 0; E < 8; ++E) {
        f32x4 c = {0.f, 0.f, 0.f, 0.f};
#pragma unroll
        for (int ks = 0; ks < 2; ++ks) c = MFMA16(af[ks], img_tr_frag(VI, lane, E, ks), c);
        u32x2 o; o.x = pk2(c.x, c.y); o.y = pk2(c.z, c.w);
        *(u32x2*)(ST + (size_t)(16 * E + (lane & 15)) * 64 + 16 * Dt + 4 * g) = o;
    }
}
__device__ __forceinline__ void gla_passB(unsigned char* ws, LAS unsigned char* lds, int blk, int tid) {
    const int bd = blk >> 1, dir = bd & 1, el = (blk & 1) * 512 + tid;
    LAS float* decs = (LAS float*)lds;
    { const float* dsrc = (const float*)(ws + WS_GDEC) + (size_t)bd * GNCH * 64;
      for (int i = tid; i < GNCH * 64; i += NT) decs[i] = dsrc[i]; }
    __syncthreads();
    bf16_t* base = (bf16_t*)(ws + WS_GST) + (size_t)bd * GNCH * (128 * 64) + (size_t)el * 8;
    const int d0 = (el & 7) * 8;
    float acc[8];
#pragma unroll
    for (int x = 0; x < 8; ++x) acc[x] = 0.f;
#pragma unroll 1
    for (int s0 = 0; s0 < GNCH; s0 += 17) {
        u32x4 kvr[17];
#pragma unroll
        for (int j = 0; j < 17; ++j) { const int s = s0 + j; const int cg = dir == 0 ? s : (s < 4 ? 3 - s : 71 - s); kvr[j] = *(const u32x4*)(base + (size_t)cg * (128 * 64)); }
#pragma unroll
        for (int j = 0; j < 17; ++j) { const int s = s0 + j; const int cg = dir == 0 ? s : (s < 4 ? 3 - s : 71 - s);
            float kv[8]; unpack8(kvr[j], kv);
            const f32x4 q0 = *(const LAS f32x4*)(decs + cg * 64 + d0), q1 = *(const LAS f32x4*)(decs + cg * 64 + d0 + 4);
            *(u32x4*)(base + (size_t)cg * (128 * 64)) = pack8(acc);
#pragma unroll
            for (int x = 0; x < 8; ++x) acc[x] = (x < 4 ? q0[x] : q1[x - 4]) * acc[x] + kv[x]; }
    }
    __syncthreads();
}
__device__ __forceinline__ void gla_passC(const DArgs& a, unsigned char* ws, LAS unsigned char* lds, int l, int item, int tid) {
    const int bh = item / GNCH, cg = item % GNCH, b = bh >> 2, h = bh & 3;
    const int lane = tid & 63, w = tid >> 6, g = lane >> 4, il = lane & 15;
    LAS float* BF = (LAS float*)lds; LAS float* BB = (LAS float*)(lds + 17408);
    LAS unsigned char* QKF = lds + 34816; LAS unsigned char* QKB = QKF + 16384; LAS unsigned char* QH = QKB + 16384; LAS unsigned char* VI = QH + 16384; LAS unsigned char* SI = VI + 16384;
    const int rowbase = gla_rowbase(b, cg);
    const bf16_t* P = (const bf16_t*)(ws + WS_P) + (size_t)rowbase * LDP;
    const int t = tid >> 3, d8 = tid & 7;
    const u32x4 qraw = *(const u32x4*)(P + (size_t)t * LDP + PC_GQ + h * 64 + 8 * d8), kraw = *(const u32x4*)(P + (size_t)t * LDP + PC_GK + h * 64 + 8 * d8);
    u32x4 vraw[2], sraw[4];
#pragma unroll
    for (int i = 0; i < 2; ++i) { const int n = tid + NT * i; vraw[i] = *(const u32x4*)(P + (size_t)(n >> 4) * LDP + PC_GV + h * 128 + (n & 15) * 8); }
    { const bf16_t* STf = (const bf16_t*)(ws + WS_GST) + ((size_t)(bh * 2) * GNCH + cg) * (128 * 64); const bf16_t* STb = STf + (size_t)GNCH * 128 * 64;
#pragma unroll
      for (int i = 0; i < 4; ++i) { const int n = tid + NT * i, row = n >> 4, ch = n & 15; sraw[i] = *(const u32x4*)((ch < 8 ? STf : STb) + (size_t)row * 64 + (ch & 7) * 8); } }
    gla_gates_load(ws, BF, BB, h, rowbase, tid);
    gla_scan(BF, BB, tid);
    { float qf[8], kf[8], o0[8], o1[8], o2[8], o3[8], o4[8], o5[8];
      unpack8(qraw, qf); unpack8(kraw, kf);
#pragma unroll
      for (int x = 0; x < 8; ++x) { const int d = 8 * d8 + x; const float bf = BF[t * GLS + d], bb = BB[t * GLS + d], rf = BF[31 * GLS + d], rb = BB[32 * GLS + d]; const float q = qf[x] * 0.125f;
          o0[x] = q * __expf(bf - rf); o1[x] = kf[x] * __expf(rf - bf); o2[x] = q * __expf(bb - rb); o3[x] = kf[x] * __expf(rb - bb); o4[x] = q * __expf(bf); o5[x] = q * __expf(bb); }
      *(LAS u32x4*)(QKF + off_b(t, d8)) = pack8(o0); *(LAS u32x4*)(QKF + off_b(t, 8 + d8)) = pack8(o1);
      *(LAS u32x4*)(QKB + off_b(t, d8)) = pack8(o2); *(LAS u32x4*)(QKB + off_b(t, 8 + d8)) = pack8(o3);
      *(LAS u32x4*)(QH + off_b(t, d8)) = pack8(o4); *(LAS u32x4*)(QH + off_b(t, 8 + d8)) = pack8(o5);
#pragma unroll
      for (int i = 0; i < 2; ++i) { const int n = tid + NT * i; *(LAS u32x4*)(VI + off_b(n >> 4, n & 15)) = vraw[i]; }
#pragma unroll
      for (int i = 0; i < 4; ++i) { const int n = tid + NT * i; *(LAS u32x4*)(SI + off_b(n >> 4, n & 15)) = sraw[i]; } }
    const int ib = w & 3, eh = w >> 2, iloc = 16 * ib + il;
    u32x2 grv[4]; f32x4 nvv[4];
    { const bf16_t* gp0 = (const bf16_t*)(ws + WS_P) + ((size_t)rowbase + iloc) * LDP + PC_GG + h * 128 + 64 * eh + 4 * g; const float* nw0 = a.in[I_GNW] + l * 512 + h * 128 + 64 * eh + 4 * g;
#pragma unroll
      for (int E4 = 0; E4 < 4; ++E4) { grv[E4] = *(const u32x2*)(gp0 + 16 * E4); nvv[E4] = *(const f32x4*)(nw0 + 16 * E4); } }
    __syncthreads();
    f32x4 at[4];
    { bf16x8 qff[2], qfb[2];
#pragma unroll
      for (int ks = 0; ks < 2; ++ks) { qff[ks] = img_row_frag(QKF, lane, ib, ks); qfb[ks] = img_row_frag(QKB, lane, ib, ks); }
#pragma unroll
      for (int T = 0; T < 4; ++T) { f32x4 cf = {0.f, 0.f, 0.f, 0.f}, cb = {0.f, 0.f, 0.f, 0.f};
#pragma unroll
          for (int ks = 0; ks < 2; ++ks) { cf = MFMA16(img_row_frag(QKF, lane, T, 2 + ks), qff[ks], cf); cb = MFMA16(img_row_frag(QKB, lane, T, 2 + ks), qfb[ks], cb); }
#pragma unroll
          for (int r = 0; r < 4; ++r) { const int j = 16 * T + 4 * g + r; cf[r] = (j <= iloc ? cf[r] : 0.f) + (j >= iloc ? cb[r] : 0.f); }
          at[T] = cf; } }
    f32x4 o[4];
    { bf16x8 hf[2], hb[2];
#pragma unroll
      for (int ks = 0; ks < 2; ++ks) { hf[ks] = img_row_frag(QH, lane, ib, ks); hb[ks] = img_row_frag(QH, lane, ib, 2 + ks); }
#pragma unroll
      for (int E4 = 0; E4 < 4; ++E4) { const int E = 4 * eh + E4; f32x4 c = {0.f, 0.f, 0.f, 0.f};
#pragma unroll
          for (int ks = 0; ks < 2; ++ks) { c = MFMA16(img_row_frag(SI, lane, E, ks), hf[ks], c); c = MFMA16(img_row_frag(SI, lane, E, 2 + ks), hb[ks], c); }
          o[E4] = c; } }
#pragma unroll
    for (int s = 0; s < 2; ++s) { const bf16x8 bfr = acc_pair_frag(at[2 * s], at[2 * s + 1]);
#pragma unroll
        for (int E4 = 0; E4 < 4; ++E4) o[E4] = MFMA16(img_tr_frag_acc(VI, lane, 4 * eh + E4, s), bfr, o[E4]); }
    float ss = 0.f;
#pragma unroll
    for (int E4 = 0; E4 < 4; ++E4) ss += (o[E4].x * o[E4].x + o[E4].y * o[E4].y) + (o[E4].z * o[E4].z + o[E4].w * o[E4].w);
    ss += __shfl_xor(ss, 16); ss += __shfl_xor(ss, 32);
    LAS float* red = (LAS float*)lds;
    if (g == 0) red[eh * 64 + iloc] = ss;
    __syncthreads();
    const float rn = rsqrtf((red[iloc] + red[64 + iloc]) * (1.0f / 128.0f) + EPS);
    const size_t row = (size_t)rowbase + iloc;
    const bf16_t* gp = (const bf16_t*)(ws + WS_P) + row * LDP + PC_GG + h * 128 + 64 * eh + 4 * g;
    const float* nw = a.in[I_GNW] + l * 512 + h * 128 + 64 * eh + 4 * g;
    bf16_t* op = (bf16_t*)(ws + WS_H) + row * D + 1536 + h * 128 + 64 * eh + 4 * g;
#pragma unroll
    for (int E4 = 0; E4 < 4; ++E4) { const u32x2 gr = grv[E4]; const f32x4 nv = nvv[E4];
        u32x2 ov; ov.x = pk2(o[E4].x * rn * nv.x * siluf_(bflo(gr.x)), o[E4].y * rn * nv.y * siluf_(bfhi(gr.x)));
        ov.y = pk2(o[E4].z * rn * nv.z * siluf_(bflo(gr.y)), o[E4].w * rn * nv.w * siluf_(bfhi(gr.y)));
        *(u32x2*)(op + 16 * E4) = ov; }
}
constexpr int SNCH = 68;
constexpr size_t WS_S5ST = WS_OB + (size_t)4 * OBSZ * 2;
constexpr size_t WS_S5BTB = WS_S5BT;
constexpr size_t WS_S5CPB = WS_S5BT + 524288;
constexpr size_t WS_S5A64 = WS_S5BT + 1048576;

__device__ __forceinline__ void prep_s5b(const DArgs& a, unsigned char* ws, int it, int tid) {
    const int idx = it * 512 + tid;
    const int gi = idx >> 6, p = idx & 63;
    const float a_re = a.in[I_S5ARE][idx], a_im = a.in[I_S5AIM][idx], ldt = a.in[I_S5LDT][gi];
    const float dt = expf(ldt), mag = expf(a_re * dt);
    float sn, cs; sincosf(a_im * dt, &sn, &cs);
    const float ab_re = mag * cs, ab_im = mag * sn, den = a_re * a_re + a_im * a_im, nr = ab_re - 1.0f;
    const float co_re = (nr * a_re + ab_im * a_im) / den, co_im = (ab_im * a_re - nr * a_im) / den;
    ((f32x2*)(ws + WS_S5AB))[idx] = (f32x2){ab_re, ab_im};
    float pr = ab_re, pi = ab_im;
#pragma unroll
    for (int q = 0; q < 6; ++q) { const float nr2 = pr * pr - pi * pi, ni2 = 2.0f * pr * pi; pr = nr2; pi = ni2; }
    ((f32x2*)(ws + WS_S5A64))[idx] = (f32x2){pr, pi};
    const float* bre = a.in[I_S5BRE] + (size_t)idx * 16; const float* bim = a.in[I_S5BIM] + (size_t)idx * 16;
    float tr[16], ti[16];
#pragma unroll
    for (int i = 0; i < 16; ++i) { const float br = bre[i], bi = bim[i]; tr[i] = co_re * br - co_im * bi; ti[i] = co_re * bi + co_im * br; }
    bf16_t* btb = (bf16_t*)(ws + WS_S5BTB) + (size_t)gi * 128 * 16;
#pragma unroll
    for (int hlf = 0; hlf < 2; ++hlf) { u32x4 w0, w1; const float* s = hlf ? ti : tr;
        w0.x = pk2(s[0], s[1]); w0.y = pk2(s[2], s[3]); w0.z = pk2(s[4], s[5]); w0.w = pk2(s[6], s[7]); w1.x = pk2(s[8], s[9]); w1.y = pk2(s[10], s[11]); w1.z = pk2(s[12], s[13]); w1.w = pk2(s[14], s[15]);
        *(u32x4*)(btb + (size_t)(64 * hlf + p) * 16) = w0; *(u32x4*)(btb + (size_t)(64 * hlf + p) * 16 + 8) = w1; }
    bf16_t* cpb = (bf16_t*)(ws + WS_S5CPB) + (size_t)gi * 16 * 128;
    const float* cre = a.in[I_S5CRE] + (size_t)gi * 1024; const float* cim = a.in[I_S5CIM] + (size_t)gi * 1024;
#pragma unroll
    for (int i = 0; i < 16; ++i) *(unsigned*)(cpb + i * 128 + 2 * p) = pk2(cre[i * 64 + p], -cim[i * 64 + p]);
}

struct S5Unit { bf16x8 btf[8]; f32x2 ab; f32x2 h; const bf16_t* cp; };
template <bool PASSC> __device__ __forceinline__ void s5_load_unit(S5Unit& U, unsigned char* ws, const bf16_t* P, const f32x2* ST, int l, int b, int cs, int rowbase, int grp, int dir, int lane) {
    const int g = lane >> 4, il = lane & 15;
    const bf16x8 zero8 = {0, 0, 0, 0, 0, 0, 0, 0};
    const int gi = (l * 2 + dir) * 32 + grp;
    U.ab = ((const f32x2*)(ws + WS_S5AB))[gi * 64 + lane];
    const size_t sidx = ((size_t)(b * SNCH + cs) * 2 + dir) * 2048 + grp * 64 + lane;
    U.h = PASSC ? ST[sidx] : (f32x2){0.f, 0.f};
    const bf16_t* bt = (const bf16_t*)(ws + WS_S5BTB) + (size_t)gi * 128 * 16 + (size_t)il * 16 + 8 * (g & 1);
#pragma unroll
    for (int Pt = 0; Pt < 8; ++Pt) { const bf16x8 v = *(const bf16x8*)(bt + Pt * 256); U.btf[Pt] = g < 2 ? v : zero8; }
    U.cp = (const bf16_t*)(ws + WS_S5CPB) + (size_t)gi * 16 * 128 + (size_t)il * 128 + 8 * g;
}
__device__ __forceinline__ void s5_load_u(bf16x8 (&ufa)[4], const bf16_t* P, int rowbase, int grp, int lane) {
    const int g = lane >> 4, il = lane & 15; const bf16x8 zero8 = {0, 0, 0, 0, 0, 0, 0, 0};
#pragma unroll
    for (int Tt = 0; Tt < 4; ++Tt) { const bf16x8 v = *(const bf16x8*)(P + (size_t)(rowbase + 16 * Tt + il) * LDP + PC_S5U + grp * 16 + 8 * (g & 1)); ufa[Tt] = g < 2 ? v : zero8; }
}
template <bool PASSC, int DIR> __device__ __forceinline__ void s5_run_unit(const S5Unit& U, const bf16x8 (&ufa)[4], f32x4 (&yacc)[4], f32x2& hout, LAS float* BU, LAS unsigned char* HW, int lane) {
    const int g = lane >> 4, il = lane & 15;
    f32x2 h = U.h; const f32x2 ab = U.ab;
    bf16x8 cpf[4];
    if (PASSC) {
#pragma unroll
        for (int ks = 0; ks < 4; ++ks) cpf[ks] = *(const bf16x8*)(U.cp + 32 * ks); }
    f32x4 d[8];
#pragma unroll
    for (int Pt = 0; Pt < 8; ++Pt) d[Pt] = MFMA16(U.btf[Pt], ufa[DIR ? 3 : 0], ((f32x4){0.f, 0.f, 0.f, 0.f}));
#pragma unroll
    for (int wi = 0; wi < 4; ++wi) {
        const int Tt = DIR ? 3 - wi : wi;
#pragma unroll
        for (int Pt = 0; Pt < 8; ++Pt) {
#pragma unroll
            for (int r = 0; r < 4; ++r) BU[(16 * Pt + 4 * g + r) * 20 + il] = d[Pt][r]; }
        asm volatile("" ::: "memory");
        if (!PASSC) {
            f32x4 br[4], bi[4];
#pragma unroll
            for (int q = 0; q < 4; ++q) { br[q] = *(const LAS f32x4*)(BU + lane * 20 + 4 * q); bi[q] = *(const LAS f32x4*)(BU + (64 + lane) * 20 + 4 * q); }
            if (wi < 3) {
#pragma unroll
                for (int Pt = 0; Pt < 8; ++Pt) d[Pt] = MFMA16(U.btf[Pt], ufa[DIR ? 2 - wi : wi + 1], ((f32x4){0.f, 0.f, 0.f, 0.f})); }
#pragma unroll
            for (int s = 0; s < 16; ++s) { const int tt = DIR ? 15 - s : s;
                const float hr = __builtin_fmaf(ab.x, h.x, __builtin_fmaf(-ab.y, h.y, br[tt >> 2][tt & 3])), hi = __builtin_fmaf(ab.x, h.y, __builtin_fmaf(ab.y, h.x, bi[tt >> 2][tt & 3]));
                h = (f32x2){hr, hi}; }
        } else {
#pragma unroll
            for (int hf2 = 0; hf2 < 2; ++hf2) { const int q0 = DIR ? 2 - 2 * hf2 : 2 * hf2;
                f32x4 br[2], bi[2];
#pragma unroll
                for (int q = 0; q < 2; ++q) { br[q] = *(const LAS f32x4*)(BU + lane * 20 + 4 * (q0 + q)); bi[q] = *(const LAS f32x4*)(BU + (64 + lane) * 20 + 4 * (q0 + q)); }
#pragma unroll
                for (int s = 0; s < 8; ++s) { const int t8 = DIR ? 7 - s : s; const int tt = 4 * q0 + t8;
                    const float hr = __builtin_fmaf(ab.x, h.x, __builtin_fmaf(-ab.y, h.y, br[t8 >> 2][t8 & 3])), hi = __builtin_fmaf(ab.x, h.y, __builtin_fmaf(ab.y, h.x, bi[t8 >> 2][t8 & 3]));
                    h = (f32x2){hr, hi};
                    *(LAS unsigned*)(HW + off_b(tt, lane >> 2) + (lane & 3) * 4) = pk2(hr, hi); }
            }
        }
        asm volatile("" ::: "memory");
        if (PASSC) {
            bf16x8 hf[4];
#pragma unroll
            for (int ks = 0; ks < 4; ++ks) hf[ks] = img_row_frag(HW, lane, 0, ks);
#pragma unroll
            for (int ks = 0; ks < 4; ++ks) yacc[Tt] = MFMA16(cpf[ks], hf[ks], yacc[Tt]);
            }
        asm volatile("" ::: "memory");
        if (PASSC && wi < 3) {
#pragma unroll
            for (int Pt = 0; Pt < 8; ++Pt) d[Pt] = MFMA16(U.btf[Pt], ufa[DIR ? 2 - wi : wi + 1], ((f32x4){0.f, 0.f, 0.f, 0.f})); }
    }
    hout = h;
}
template <bool PASSC> __device__ __forceinline__ void s5_item(const DArgs& a, unsigned char* ws, LAS unsigned char* lds, int l, int item, int ggsel, int tid) {
    const int b = item / (SNCH * 2), rem = item % (SNCH * 2), cs = rem >> 1, half = rem & 1;
    const int lane = tid & 63, w = tid >> 6, g = lane >> 4, il = lane & 15;
    const int rowbase = gla_rowbase(b, cs);
    LAS float* BU = (LAS float*)(lds + w * 14336); LAS unsigned char* HW = lds + w * 14336 + 10240;
    const bf16_t* P = (const bf16_t*)(ws + WS_P);
    f32x2* ST = (f32x2*)(ws + WS_S5ST);
    const int grp0 = 16 * half + w, grp1 = grp0 + 8;
    S5Unit UA; bf16x8 ufa[4];
    { const int gg = ggsel;
        const int grp = gg ? grp1 : grp0;
        f32x4 yacc[4];
#pragma unroll
        for (int q = 0; q < 4; ++q) yacc[q] = (f32x4){0.f, 0.f, 0.f, 0.f};
        f32x2 hend;
        u32x2 urv[4], sgv[4]; f32x4 dskv = {0.f, 0.f, 0.f, 0.f};
        if (PASSC) { dskv = *(const f32x4*)(a.in[I_S5D] + l * 512 + grp * 16 + 4 * g);
#pragma unroll
            for (int Tt = 0; Tt < 4; ++Tt) { const size_t row = (size_t)rowbase + 16 * Tt + il; urv[Tt] = *(const u32x2*)(P + row * LDP + PC_S5U + grp * 16 + 4 * g); sgv[Tt] = *(const u32x2*)(P + row * LDP + PC_S5G + grp * 16 + 4 * g); } }
        s5_load_unit<PASSC>(UA, ws, P, ST, l, b, cs, rowbase, grp, 0, lane); s5_load_u(ufa, P, rowbase, grp, lane);
        s5_run_unit<PASSC, 0>(UA, ufa, yacc, hend, BU, HW, lane);
        if (!PASSC) ST[((size_t)(b * SNCH + cs) * 2 + 0) * 2048 + grp * 64 + lane] = hend;
        s5_load_unit<PASSC>(UA, ws, P, ST, l, b, cs, rowbase, grp, 1, lane);
        s5_run_unit<PASSC, 1>(UA, ufa, yacc, hend, BU, HW, lane);
        if (!PASSC) ST[((size_t)(b * SNCH + cs) * 2 + 1) * 2048 + grp * 64 + lane] = hend;
        if (PASSC) {
            const f32x4 dsk = dskv;
            bf16_t* G5 = (bf16_t*)(ws + WS_KF);
#pragma unroll
            for (int Tt = 0; Tt < 4; ++Tt) { const size_t row = (size_t)rowbase + 16 * Tt + il;
                const u32x2 ur = urv[Tt], sg = sgv[Tt];
                const float g0 = gelu_tanh(yacc[Tt].x + bflo(ur.x) * dsk.x), g1 = gelu_tanh(yacc[Tt].y + bfhi(ur.x) * dsk.y), g2 = gelu_tanh(yacc[Tt].z + bflo(ur.y) * dsk.z), g3 = gelu_tanh(yacc[Tt].w + bfhi(ur.y) * dsk.w);
                u32x2 ov; ov.x = pk2(g0, g1); ov.y = pk2(g2, g3);
                *(u32x2*)(G5 + row * 512 + grp * 16 + 4 * g) = ov;
                ov.x = pk2(g0 * siluf_(bflo(sg.x)), g1 * siluf_(bfhi(sg.x))); ov.y = pk2(g2 * siluf_(bflo(sg.y)), g3 * siluf_(bfhi(sg.y)));
                *(u32x2*)(G5 + OBSZ + row * 512 + grp * 16 + 4 * g) = ov; }
        }
    }
}
__device__ __forceinline__ void s5_passB(unsigned char* ws, int l, int gt) {
    const int p = gt & 63, grp = (gt >> 6) & 31, dir = (gt >> 11) & 1, b = gt >> 12;
    const f32x2 a64 = ((const f32x2*)(ws + WS_S5A64))[((l * 2 + dir) * 32 + grp) * 64 + p];
    f32x2* ST = (f32x2*)(ws + WS_S5ST);
    f32x2 acc = {0.f, 0.f};
#pragma unroll 1
    for (int s0 = 0; s0 < SNCH; s0 += 34) {
        f32x2 ev[34];
#pragma unroll
        for (int j = 0; j < 34; ++j) { const int s = s0 + j; const int cs = dir == 0 ? s : (s < 4 ? 3 - s : 71 - s); ev[j] = ST[((size_t)(b * SNCH + cs) * 2 + dir) * 2048 + grp * 64 + p]; }
#pragma unroll
        for (int j = 0; j < 34; ++j) { const int s = s0 + j; const int cs = dir == 0 ? s : (s < 4 ? 3 - s : 71 - s);
            ST[((size_t)(b * SNCH + cs) * 2 + dir) * 2048 + grp * 64 + p] = acc;
            acc = (f32x2){a64.x * acc.x - a64.y * acc.y + ev[j].x, a64.x * acc.y + a64.y * acc.x + ev[j].y}; }
    }
}
constexpr int FFT_PHYS = 8448;
__device__ __forceinline__ void fft_twiddles_g(LAS f32x2* W, const f32x2* Wg, int tid) {
#pragma unroll
    for (int j = 0; j < 8; ++j) W[tid + NT * j] = Wg[tid + NT * j];
}
__device__ __forceinline__ int fphys(int i) { return i + (i >> 5); }
__device__ __forceinline__ f32x2 cmulf(const f32x2 a, const f32x2 b) { return (f32x2){a.x * b.x - a.y * b.y, a.x * b.y + a.y * b.x}; }
__device__ __forceinline__ f32x2 cmulcf(const f32x2 a, const f32x2 b) { return (f32x2){a.x * b.x + a.y * b.y, a.y * b.x - a.x * b.y}; }
template <int RL> __device__ __forceinline__ void dft_fwd_const(f32x2 (&e)[1 << RL]) {
#pragma unroll
    for (int s = 0; s < RL; ++s) { const int h = 1 << (RL - 1 - s);
#pragma unroll
        for (int m = 0; m < (1 << RL); ++m) { if (m & h) continue;
            const int mp = m & (h - 1); const f32x2 a_ = e[m], b_ = e[m | h]; const f32x2 d = a_ - b_; e[m] = a_ + b_;
            if (mp == 0) e[m | h] = d;
            else if (2 * mp == h) e[m | h] = (f32x2){d.y, -d.x};
            else { const float ang = -3.14159265358979323846f * (float)mp / (float)h; const f32x2 c = {__builtin_cosf(ang), __builtin_sinf(ang)}; e[m | h] = cmulf(d, c); } } }
}
template <int RL> __device__ __forceinline__ void dft_inv_const(f32x2 (&e)[1 << RL]) {
#pragma unroll
    for (int ss = 0; ss < RL; ++ss) { const int s = RL - 1 - ss; const int h = 1 << (RL - 1 - s);
#pragma unroll
        for (int m = 0; m < (1 << RL); ++m) { if (m & h) continue;
            const int mp = m & (h - 1); const f32x2 a_ = e[m], b_ = e[m | h]; f32x2 t;
            if (mp == 0) t = b_;
            else if (2 * mp == h) t = (f32x2){-b_.y, b_.x};
            else { const float ang = -3.14159265358979323846f * (float)mp / (float)h; const f32x2 c = {__builtin_cosf(ang), __builtin_sinf(ang)}; t = cmulcf(b_, c); }
            e[m] = a_ + t; e[m | h] = a_ - t; } }
}
template <int RL> __device__ __forceinline__ constexpr int brev_c(int m) { int r = 0; for (int i = 0; i < RL; ++i) r |= ((m >> i) & 1) << (RL - 1 - i); return r; }
template <int RL, bool CONJ> __device__ __forceinline__ void apply_tw(f32x2 (&e)[1 << RL], const f32x2 w1) {
    f32x2 tw[1 << RL];
    tw[0] = (f32x2){1.f, 0.f}; tw[1] = w1;
    if (RL >= 2) { tw[2] = cmulf(w1, w1); tw[3] = cmulf(tw[2], w1); }
    if (RL >= 3) { tw[4] = cmulf(tw[2], tw[2]); tw[5] = cmulf(tw[4], tw[1]); tw[6] = cmulf(tw[4], tw[2]); tw[7] = cmulf(tw[4], tw[3]); }
    if (RL >= 4) { tw[8] = cmulf(tw[4], tw[4]);
#pragma unroll
        for (int k = 1; k < 8; ++k) tw[8 + k] = cmulf(tw[8], tw[k]); }
#pragma unroll
    for (int m = 1; m < (1 << RL); ++m) e[m] = CONJ ? cmulcf(e[m], tw[brev_c<RL>(m)]) : cmulf(e[m], tw[brev_c<RL>(m)]);
}
template <int RL, int BETA, bool INV, class WP> __device__ __forceinline__ void fft2_pass(LAS f32x2* X, WP W, int tid) {
    constexpr int LOW = BETA - RL + 1, NG = FFTN >> RL, STR = (1 << LOW) + (1 << (LOW - 5));
#pragma unroll 1
    for (int gi = tid; gi < NG; gi += NT) {
        const int base = ((gi >> LOW) << (BETA + 1)) | (gi & ((1 << LOW) - 1));
        volatile LAS f32x2* p = X + fphys(base);
        f32x2 e[1 << RL];
#pragma unroll
        for (int m = 0; m < (1 << RL); ++m) e[m] = p[m * STR];
        const f32x2 w1 = W[(base & ((1 << LOW) - 1)) << (12 - BETA)];
        if (!INV) { dft_fwd_const<RL>(e); apply_tw<RL, false>(e, w1); }
        else { apply_tw<RL, true>(e, w1); dft_inv_const<RL>(e); }
#pragma unroll
        for (int m = 0; m < (1 << RL); ++m) p[m * STR] = e[m];
    }
}
template <class WP> __device__ __forceinline__ void fft2_fwd_ABC(LAS f32x2* X, WP W, int tid) {
    fft2_pass<4, 12, false>(X, W, tid); __syncthreads(); fft2_pass<4, 8, false>(X, W, tid); __syncthreads();
}
template <class WP> __device__ __forceinline__ void fft2_inv_CBA(LAS f32x2* X, WP W, int tid) {
    fft2_pass<4, 8, true>(X, W, tid); __syncthreads(); fft2_pass<4, 12, true>(X, W, tid); __syncthreads();
}
__device__ __forceinline__ void fft2_mid_mul(LAS f32x2* X, const f32x2* KF, int tid) {
    if (tid < 256) {
        volatile LAS f32x2* p = X + 33 * tid;
        f32x2 e[32];
#pragma unroll
        for (int m = 0; m < 32; ++m) e[m] = p[m];
        dft_fwd_const<5>(e);
#pragma unroll
        for (int q4 = 0; q4 < 4; ++q4) { f32x4 kf[4];
#pragma unroll
            for (int q = 0; q < 4; ++q) kf[q] = *(const f32x4*)(KF + 32 * tid + 8 * q4 + 2 * q);
#pragma unroll
            for (int q = 0; q < 4; ++q) { const int m = 8 * q4 + 2 * q; e[m] = cmulf(e[m], (f32x2){kf[q].x, kf[q].y}); e[m + 1] = cmulf(e[m + 1], (f32x2){kf[q].z, kf[q].w}); } }
        dft_inv_const<5>(e);
#pragma unroll
        for (int m = 0; m < 32; ++m) p[m] = e[m];
    }
}
__device__ __forceinline__ void fft2_fwd_D(LAS f32x2* X, int tid) {
    if (tid < 256) { volatile LAS f32x2* p = X + 33 * tid; f32x2 e[32];
#pragma unroll
        for (int m = 0; m < 32; ++m) e[m] = p[m];
        dft_fwd_const<5>(e);
#pragma unroll
        for (int m = 0; m < 32; ++m) p[m] = e[m]; }
}

__device__ __forceinline__ void filt_item2(const DArgs& a, unsigned char* ws, LAS unsigned char* lds, int l, int c0, int tid) {
    LAS f32x2* X = (LAS f32x2*)lds; LAS f32x2* X2 = (LAS f32x2*)(lds + FFT_PHYS * 8); LAS float* red = (LAS float*)(lds + 2 * FFT_PHYS * 8);
    const f32x2* Wg = (const f32x2*)(ws + WS_TWID);
    const int lane = tid & 63, w = tid >> 6, fr = lane & 15, fq = lane >> 4;
    const int cmine = c0 + 256 * (fq & 1);
    bf16x8 af[2];
    { float wv[16];
      const int cc = fr & 3, ca = c0 + 256 * ((fr >> 2) & 1);
      const float* wsrc = a.in[I_HW4] + (size_t)l * 64 * 2048 + (cc >> 1) * 1024 + (cc & 1) * 512 + ca;
#pragma unroll
      for (int q = 0; q < 16; ++q) wv[q] = fr < 8 ? wsrc[(size_t)(32 * (q >> 3) + 8 * fq + (q & 7)) * 2048] : 0.f;
#pragma unroll
      for (int ks = 0; ks < 2; ++ks) { u32x4 pw; pw.x = pk2(wv[8 * ks], wv[8 * ks + 1]); pw.y = pk2(wv[8 * ks + 2], wv[8 * ks + 3]); pw.z = pk2(wv[8 * ks + 4], wv[8 * ks + 5]); pw.w = pk2(wv[8 * ks + 6], wv[8 * ks + 7]); af[ks] = __builtin_bit_cast(bf16x8, pw); } }
    if (tid < 2) { float z0; asm volatile("v_mov_b32 %0, 0" : "=v"(z0)); (tid ? X2 : X)[fphys(4096)] = (f32x2){z0, z0}; }
    const float dl = fabsf(HY_D0 + (HY_D1 - HY_D0) * ((float)cmine / 511.0f)) * (1.0f / 4095.0f);
    const bf16_t* H3 = (const bf16_t*)(ws + WS_H3B) + (size_t)l * 4096 * 64 + (size_t)fr * 64 + 8 * fq;
    LAS f32x2* Xm = (fq & 1) ? X2 : X;
    float ss0 = 0.f, ss1 = 0.f;
#pragma unroll 1
    for (int i0 = 0; i0 < 32; i0 += 4) {
        bf16x8 hb[4][2];
#pragma unroll
        for (int i = 0; i < 4; ++i) { const bf16_t* hp = H3 + (size_t)(16 * (w + 8 * (i0 + i))) * 64; hb[i][0] = *(const bf16x8*)hp; hb[i][1] = *(const bf16x8*)(hp + 32); }
#pragma unroll
        for (int i = 0; i < 4; ++i) {
            f32x4 d = {0.f, 0.f, 0.f, 0.f};
            d = MFMA16(af[0], hb[i][0], d); d = MFMA16(af[1], hb[i][1], d);
            if (fq < 2) { const int t = 16 * (w + 8 * (i0 + i)) + fr;
                const float dec = __expf(-(float)t * dl); const float f0 = d.x * dec, f1 = d.y * dec, b0 = d.z * dec, b1 = d.w * dec;
                Xm[fphys(t)] = (f32x2){f0, f1}; ss0 += f0 * f0; ss1 += f1 * f1;
                if (t > 0) { Xm[fphys(8192 - t)] = (f32x2){b0, b1}; ss0 += b0 * b0; ss1 += b1 * b1; } }
        }
    }
#pragma unroll
    for (int o = 1; o < 16; o <<= 1) { ss0 += __shfl_xor(ss0, o); ss1 += __shfl_xor(ss1, o); }
    if (fr == 0 && fq < 2) { red[w * 4 + fq * 2] = ss0; red[w * 4 + fq * 2 + 1] = ss1; }
    __syncthreads();
    fft2_pass<4, 12, false>(X, Wg, tid); fft2_pass<4, 12, false>(X2, Wg, tid); __syncthreads();
    fft2_pass<4, 8, false>(X, Wg, tid); fft2_pass<4, 8, false>(X2, Wg, tid); __syncthreads();
    fft2_fwd_D(tid < 256 ? X : X2, tid & 255); __syncthreads();
#pragma unroll 1
    for (int ch = 0; ch < 2; ++ch) {
        float s0 = 0.f, s1 = 0.f;
#pragma unroll
        for (int i = 0; i < NWAVES; ++i) { s0 += red[i * 4 + ch * 2]; s1 += red[i * 4 + ch * 2 + 1]; }
        const float rs0 = 0.5f * rsqrtf(s0 + EPS), rs1 = 0.5f * rsqrtf(s1 + EPS);
        const LAS f32x2* Xc = ch ? X2 : X; const int c = c0 + 256 * ch;
        f32x2* KF0 = (f32x2*)(ws + WS_KF) + (size_t)(0 * 512 + c) * FFTN; f32x2* KF1 = (f32x2*)(ws + WS_KF) + (size_t)(1 * 512 + c) * FFTN;
#pragma unroll 4
        for (int j = 0; j < 16; ++j) { const int pos = tid + 512 * j; const int k = (int)(__brev((unsigned)pos) >> 19); const int pp = (int)(__brev((unsigned)((8192 - k) & 8191)) >> 19);
            const f32x2 za = Xc[fphys(pos)], zb = Xc[fphys(pp)];
            KF0[pos] = (f32x2){rs0 * (za.x + zb.x), rs0 * (za.y - zb.y)};
            KF1[pos] = (f32x2){rs1 * (za.y + zb.y), rs1 * (zb.x - za.x)}; }
    }
    __syncthreads();
}

struct Raw8 { u32x4 mid; bf16_t lf, rt; };
__device__ __forceinline__ Raw8 ld_raw8(const bf16_t* p, int t0, int Lx) { Raw8 r; r.mid = *(const u32x4*)(p + t0); r.lf = t0 > 0 ? p[t0 - 1] : (bf16_t)0; r.rt = t0 + 8 < Lx ? p[t0 + 8] : (bf16_t)0; return r; }
__device__ __forceinline__ void sconv8(const Raw8& r, float w0, float w1, float w2, float cb, float (&o)[8]) {
    float x[10]; x[0] = bf2f(r.lf); x[9] = bf2f(r.rt);
    x[1] = bflo(r.mid.x); x[2] = bfhi(r.mid.x); x[3] = bflo(r.mid.y); x[4] = bfhi(r.mid.y); x[5] = bflo(r.mid.z); x[6] = bfhi(r.mid.z); x[7] = bflo(r.mid.w); x[8] = bfhi(r.mid.w);
#pragma unroll
    for (int i = 0; i < 8; ++i) o[i] = w0 * x[i] + w1 * x[i + 1] + w2 * x[i + 2] + cb;
}
__device__ __forceinline__ void hyena_item2(const DArgs& a, unsigned char* ws, LAS unsigned char* lds, int l, int c, int tid) {
    LAS f32x2* X = (LAS f32x2*)lds; LAS f32x2* X2 = (LAS f32x2*)(lds + FFT_PHYS * 8);
    const f32x2* Wg = (const f32x2*)(ws + WS_TWID);
    const float* cw = a.in[I_HCW] + (size_t)l * 3 * 1536; const float* cbp = a.in[I_HCB] + (size_t)l * 1536;
    const float wv0 = cw[c], wv1 = cw[1536 + c], wv2 = cw[3072 + c], bv = cbp[c];
    const float wa0 = cw[512 + c], wa1 = cw[1536 + 512 + c], wa2 = cw[3072 + 512 + c], ba = cbp[512 + c];
    const float wb0 = cw[1024 + c], wb1 = cw[1536 + 1024 + c], wb2 = cw[3072 + 1024 + c], bb = cbp[1024 + c];
    const float bias0 = a.in[I_HBIAS][(l * 2 + 0) * 512 + c], bias1 = a.in[I_HBIAS][(l * 2 + 1) * 512 + c];
    const bf16_t* PT = (const bf16_t*)(ws + WS_PT);
    const bf16_t* pv = PT + (size_t)(PT_V + c) * MR; const bf16_t* pg1 = PT + (size_t)(PT_G1 + c) * MR; const bf16_t* pg2 = PT + (size_t)(PT_G2 + c) * MR; const bf16_t* phg = PT + (size_t)(PT_HG + c) * MR;
    const f32x2* KF0 = (const f32x2*)(ws + WS_KF) + (size_t)(0 * 512 + c) * FFTN; const f32x2* KF1 = (const f32x2*)(ws + WS_KF) + (size_t)(1 * 512 + c) * FFTN;
    const int t0 = 8 * tid;
    const int po = 8 * tid + (tid >> 2);
    LAS f32x2* px = X + po; LAS f32x2* py = X2 + po;
    float z[4][8];
    { Raw8 v[4];
#pragma unroll
      for (int b = 0; b < 4; ++b) v[b] = ld_raw8(pv + b * SEQL, t0, SEQL);
#pragma unroll
      for (int b = 0; b < 4; ++b) sconv8(v[b], wv0, wv1, wv2, bv, z[b]); }
    Raw8 g1r[4];
#pragma unroll
    for (int b = 0; b < 4; ++b) g1r[b] = ld_raw8(pg1 + b * SEQL, t0, SEQL);
#pragma unroll
    for (int x = 0; x < 8; ++x) { px[x] = (f32x2){z[0][x], z[1][x]}; px[4224 + x] = (f32x2){0.f, 0.f}; py[x] = (f32x2){z[2][x], z[3][x]}; py[4224 + x] = (f32x2){0.f, 0.f}; }
    __syncthreads();
#define HY_CONV(KFp) do { \
        fft2_pass<4, 12, false>(X, Wg, tid); fft2_pass<4, 12, false>(X2, Wg, tid); __syncthreads(); \
        fft2_pass<4, 8, false>(X, Wg, tid); fft2_pass<4, 8, false>(X2, Wg, tid); __syncthreads(); \
        fft2_mid_mul(tid < 256 ? X : X2, KFp, tid & 255); __syncthreads(); \
        fft2_pass<4, 8, true>(X, Wg, tid); fft2_pass<4, 8, true>(X2, Wg, tid); __syncthreads(); \
        fft2_pass<4, 12, true>(X, Wg, tid); fft2_pass<4, 12, true>(X2, Wg, tid); __syncthreads(); } while (0)
    HY_CONV(KF0);
    { float g[4][8];
#pragma unroll
      for (int b = 0; b < 4; ++b) sconv8(g1r[b], wa0, wa1, wa2, ba, g[b]);
#pragma unroll
      for (int x = 0; x < 8; ++x) { const f32x2 c0 = px[x] * (1.0f / 8192.0f), c1 = py[x] * (1.0f / 8192.0f);
          z[0][x] = g[0][x] * (c0.x + bias0 * z[0][x]); z[1][x] = g[1][x] * (c0.y + bias0 * z[1][x]); z[2][x] = g[2][x] * (c1.x + bias0 * z[2][x]); z[3][x] = g[3][x] * (c1.y + bias0 * z[3][x]); } }
    Raw8 g2r[4]; u32x4 hgr[4];
#pragma unroll
    for (int b = 0; b < 4; ++b) { g2r[b] = ld_raw8(pg2 + b * SEQL, t0, SEQL); hgr[b] = *(const u32x4*)(phg + b * SEQL + t0); }
    __syncthreads();
#pragma unroll
    for (int x = 0; x < 8; ++x) { px[x] = (f32x2){z[0][x], z[1][x]}; px[4224 + x] = (f32x2){0.f, 0.f}; py[x] = (f32x2){z[2][x], z[3][x]}; py[4224 + x] = (f32x2){0.f, 0.f}; }
    __syncthreads();
    HY_CONV(KF1);
#undef HY_CONV
    bf16_t* pvw = (bf16_t*)(ws + WS_PT) + (size_t)(PT_V + c) * MR;
#pragma unroll
    for (int b = 0; b < 4; ++b) { float g[8], hh[8], o[8]; sconv8(g2r[b], wb0, wb1, wb2, bb, g); unpack8(hgr[b], hh);
#pragma unroll
        for (int x = 0; x < 8; ++x) { const f32x2 cv = ((b < 2) ? px[x] : py[x]) * (1.0f / 8192.0f); const float cvv = (b & 1) ? cv.y : cv.x;
            o[x] = g[x] * (cvv + bias1 * z[b][x]) * siluf_(hh[x]); }
        *(u32x4*)(pvw + b * SEQL + t0) = pack8(o); }
    __syncthreads();
}
__device__ __forceinline__ void hy_transpose_item(unsigned char* ws, LAS unsigned char* lds, int item, int tid, int nrows) {
    const int lane = tid & 63, w = tid >> 6;
    const int wi = item * 8 + w;
    const int nrb = nrows / 64;
    if (wi >= nrb * 8) return;
    const int rb = wi >> 3, cb = wi & 7;
    LAS bf16_t* T = (LAS bf16_t*)(lds + w * 8704);
    const bf16_t* src = (const bf16_t*)(ws + WS_PT) + (size_t)(PT_V + cb * 64) * MR + (size_t)rb * 64;
    u32x4 tv[8];
#pragma unroll
    for (int i = 0; i < 8; ++i) { const int c = 8 * i + (lane >> 3), r8 = (lane & 7) * 8; tv[i] = *(const u32x4*)(src + (size_t)c * MR + r8); }
#pragma unroll
    for (int i = 0; i < 8; ++i) { const int c = 8 * i + (lane >> 3), r8 = (lane & 7) * 8;
        LAS unsigned* d = (LAS unsigned*)(T + c * 66 + r8); d[0] = tv[i].x; d[1] = tv[i].y; d[2] = tv[i].z; d[3] = tv[i].w; }
    asm volatile("s_waitcnt lgkmcnt(0)" ::: "memory");
    bf16_t* dst = (bf16_t*)(ws + WS_H) + (size_t)(rb * 64) * D + 512 + cb * 64;
#pragma unroll 4
    for (int i = 0; i < 8; ++i) { const int r = 8 * i + (lane >> 3), c8 = (lane & 7) * 8;
        unsigned short e[8];
#pragma unroll
        for (int x = 0; x < 8; ++x) e[x] = T[(c8 + x) * 66 + r];
        u32x4 o; o.x = e[0] | ((unsigned)e[1] << 16); o.y = e[2] | ((unsigned)e[3] << 16); o.z = e[4] | ((unsigned)e[5] << 16); o.w = e[6] | ((unsigned)e[7] << 16);
        *(u32x4*)(dst + (size_t)r * D + c8) = o; }
    asm volatile("s_waitcnt lgkmcnt(0)" ::: "memory");
}
#ifndef MK_EN
#define MK_EN 0xffff
#endif
#define EN(x) ((MK_EN >> (x)) & 1)
constexpr int PH_PREP = 0, PH_PER_LAYER = 7, PH_FNORM = 1 + 2 * PH_PER_LAYER, N_PHASES = PH_FNORM + 1;

__global__ void __launch_bounds__(NT, 2) fwd_kernel(Args ka) {
    extern __shared__ __attribute__((aligned(16))) unsigned char lds_raw[];
    LAS unsigned char* lds = (LAS unsigned char*)lds_raw;
    const int G = gridDim.x;
    volatile LAS unsigned* bst = (volatile LAS unsigned*)(lds + LDS_CTL_OFF);
    if (threadIdx.x < 16) bst[threadIdx.x] = 0u;
    if (threadIdx.x == 0) { LAS unsigned long long* tab = (LAS unsigned long long*)(lds + LDS_PTR_OFF);
#pragma unroll
        for (int i = 0; i < N_IN; ++i) tab[i] = (unsigned long long)ka.in[i]; }
    __syncthreads();

    XcdBarrier gbar; gbar.bar = (unsigned*)(ka.ws + WS_CTL); gbar.x = 0; gbar.st = bst;
    if (ka.ph_hi - ka.ph_lo > 1) gbar = xcd_barrier_post((unsigned*)(ka.ws + WS_CTL), bst);

#ifdef REP_SUB
#ifndef REP_LMASK
#define REP_LMASK 3
#endif
    int repmask = 0;
#endif
    for (int ph = ka.ph_lo; ph < ka.ph_hi; ++ph) {
        int tid = threadIdx.x; asm volatile("" : "+v"(tid));
        int bid = blockIdx.x; asm volatile("" : "+s"(bid));
#define LANE_WAVE() int tid2_ = threadIdx.x; asm volatile("" : "+v"(tid2_)); const int lane = tid2_ & 63, wave = __builtin_amdgcn_readfirstlane(tid2_ >> 6)
        __attribute__((address_space(1))) unsigned char* wsg_ = (__attribute__((address_space(1))) unsigned char*)ka.ws; asm volatile("" : "+s"(wsg_)); unsigned char* ws = (unsigned char*)wsg_;
        __attribute__((address_space(1))) float* outg_ = (__attribute__((address_space(1))) float*)ka.out; asm volatile("" : "+s"(outg_)); float* outp_ = (float*)outg_;
        DArgs a; a.in.t = (const LAS unsigned long long*)(lds + LDS_PTR_OFF); a.out = outp_;
        float* MOD = (float*)(ws + WS_MOD);
        if (EN(0) && ph == PH_PREP) {
            for (int it = bid; it < 1048 + 544 + 8; it += G) {
                int tid = threadIdx.x; asm volatile("" : "+v"(tid));
                __syncthreads();
                if (it < 768) prep_adaln(a.in[I_C], a.in[I_CCTX], a.in[I_ADAW], a.in[I_ADAB], MOD, it, (LAS float*)lds, tid);
                else if (it < 784) prep_s5b(a, ws, it - 768, tid);
                else if (it >= 1048 + 544) { const int j = (it - 1592) * NT + tid; float sn, cs; sincospif(-(float)j * (1.0f / 4096.0f), &sn, &cs); ((f32x2*)(ws + WS_TWID))[j] = (f32x2){cs, sn}; }
                else if (it >= 1048) prep_rope((f32x2*)(ws + WS_ROPE), it - 1048, tid);
                else { const bool big = it < 1040; const int r = big ? it - 784 : it - 1040, l = big ? (r >> 7) : 0, t0 = (big ? (r & 127) : r) * 32;
                    float* H3o = big ? (float*)(ws + WS_H3) + (size_t)l * 4096 * 64 : (float*)(ws + WS_H3C);
                    bf16_t* H3b = big ? (bf16_t*)(ws + WS_H3B) + (size_t)l * 4096 * 64 : (bf16_t*)nullptr;
                    prep_hymlp(a, H3o, H3b, l, big ? 4096 : 256, t0, lds, tid); }
            }
        } else if (EN(1) && ph == PH_FNORM) {
            const float* fw = a.in[I_FNW]; LANE_WAVE();
            for (int row = bid * NWAVES + wave; row < NLAT; row += G * NWAVES) {
                float* xr = a.out + (size_t)row * D; f32x4 v[8]; float ss = 0.f;
#pragma unroll
                for (int j = 0; j < 8; ++j) { v[j] = ((const f32x4*)xr)[lane + 64 * j]; ss += (v[j].x * v[j].x + v[j].y * v[j].y) + (v[j].z * v[j].z + v[j].w * v[j].w); }
                const float rstd = rsqrtf(wave_sum(ss) * (1.0f / D) + EPS);
#pragma unroll
                for (int j = 0; j < 8; ++j) { const f32x4 w = *(const f32x4*)(fw + 4 * (lane + 64 * j)); ((f32x4*)xr)[lane + 64 * j] = v[j] * rstd * w; }
            }
        } else {
            const int l = (ph - 1) / PH_PER_LAYER, sub = (ph - 1) % PH_PER_LAYER;

            const bool ctx_out = (l == 0);
            const int Mrows = ctx_out ? MR : NLAT;
            if (EN(2) && sub == 0) {
                LANE_WAVE();
                LAS float* scr = (LAS float*)(lds + wave * 8704);
                const int gw = bid * NWAVES + wave, NGW = G * NWAVES;
                constexpr int I_W1 = 32 * (NPAD / 32), I_W2 = 32 * 64, I_W3 = 8 * 16;
                for (int it = (l == 0 ? gw : gw + I_W1); it < I_W1 + I_W2 + I_W3; it += NGW) {
                    int r = it;
                    if (r < I_W1) { const int kb = r / (NPAD / 32), nb = r % (NPAD / 32); transpose_item(a.in[I_WIN] + (size_t)l * D * INW, INW, win_srccol(nb * 32 + (lane & 31)), kb * 64, (bf16_t*)(ws + WS_WIN), D, nb * 32, scr, lane); continue; }
                    r -= I_W1;
                    if (r < I_W2) { const int kb = r / 64, nb = r % 64; transpose_item(a.in[I_WOUT] + (size_t)l * D * D, D, nb * 32 + (lane & 31), kb * 64, (bf16_t*)(ws + WS_WOUT), D, nb * 32, scr, lane); continue; }
                    r -= I_W2;
                    { const int kb = r / 16, nb = r % 16; transpose_item(a.in[I_GLUW] + (size_t)l * 512 * 512, 512, nb * 32 + (lane & 31), kb * 64, (bf16_t*)(ws + WS_GLUW), 512, nb * 32, scr, lane); }
                }
                const float* nw = a.in[I_NORMW] + (size_t)l * D;
                for (int row = gw; row < MR; row += NGW) {
                    const float* xr; int v;
                    if (row < NLAT) { xr = (l == 0 ? a.in[I_X] : a.out) + (size_t)row * D; v = row >> 12; }
                    else { xr = (l == 0 ? a.in[I_CTX] : (const float*)(ws + WS_XC1)) + (size_t)(row - NLAT) * D; v = 4; }
                    norm_row(xr, nw, MOD + (size_t)(l * 5 + v) * ADA, (bf16_t*)(ws + WS_H) + (size_t)row * D, lane);
                }
                __syncthreads();
                const int nfilt = ctx_out ? 768 : 0;
                for (int it = bid; it < nfilt; it += G) { int tid = threadIdx.x; asm volatile("" : "+v"(tid)); __syncthreads(); if (it < 256) filt_item2(a, ws, lds, l, it, tid); else filt_ctx_item(a, ws, lds, it - 256, tid);
#if defined(REP_ITEM) && REP_ITEM == 10
                    __syncthreads(); if (it < 256) filt_item2(a, ws, lds, l, it, tid);
#endif
                }
            } else if (EN(3) && sub == 1) {
                pg8::Gemm g{(const bf16_t*)(ws + WS_H), (const bf16_t*)(ws + WS_WIN), MR, NPAD, D}; pg8::StaticOrder S; S.init(MR, NPAD, G, bid);
                EpiInProj E{(bf16_t*)(ws + WS_P), (bf16_t*)(ws + WS_PT), (float*)(ws + WS_LR), (const float*)(ws + WS_ROPE)};
                { pg8::InProjOrder S1; S1.init(ctx_out ? 0 : 1, G, bid); pg8::gemm_phase<EpiInProj, pg8::InProjOrder, true, true>(lds, g, S1, E, tid); }
            } else if (EN(5) && sub == 2) {
                const int nit = ctx_out ? 3744 : 3232;
                for (int it = bid; it < nit; it += G) {
                    int tid = threadIdx.x; asm volatile("" : "+v"(tid));
                    __syncthreads();
                    if (it < 512) hyena_item2(a, ws, lds, l, it, tid);
                    else if (it < 1600) s5_item<false>(a, ws, lds, l, (it - 512) >> 1, (it - 512) & 1, tid);
                    else if (it < 2144) ret_passA(ws, lds, it - 1600, tid);
                    else if (it < 3232) gla_passA(a, ws, lds, l, it - 2144, tid);
                    else hyena_ctx_item(a, ws, lds, it - 3232, tid);
                }
            } else if (EN(9) && sub == 3) {
                for (int it = bid; it < 256; it += G) { int tid = threadIdx.x; asm volatile("" : "+v"(tid)); __syncthreads(); hy_transpose_item(ws, lds, it, tid, NLAT); }
                for (int it = bid; it < 224; it += G) { int tid = threadIdx.x; asm volatile("" : "+v"(tid)); __syncthreads();
                    if (it < 128) ret_passB(ws, it * NT + tid);
                    else if (it < 192) gla_passB(ws, lds, it - 128, tid);
                    else s5_passB(ws, l, (it - 192) * NT + tid); }
            } else if (EN(6) && sub == 4) {
                const int nsc = ctx_out ? 1088 : 1024, nrc = ctx_out ? 16 * RNCH : 16 * 32, ngc = ctx_out ? 16 * GNCH : 16 * 64;
                for (int it = bid; it < nsc; it += G) { int tid = threadIdx.x; asm volatile("" : "+v"(tid)); __syncthreads();
                    const int i2 = it >> 1; const int item = ctx_out ? i2 : (i2 >> 7) * (SNCH * 2) + 8 + (i2 & 127); s5_item<true>(a, ws, lds, l, item, it & 1, tid); }
                for (int it = (bid + 64) % G; it < nrc; it += G) { int tid = threadIdx.x; asm volatile("" : "+v"(tid)); __syncthreads();
                    const int item = ctx_out ? it : (it >> 5) * RNCH + 2 + (it & 31); ret_passC(a, ws, lds, l, item, tid); }
                for (int it = (bid + 128) % G; it < ngc; it += G) { int tid = threadIdx.x; asm volatile("" : "+v"(tid)); __syncthreads();
                    const int item = ctx_out ? it : (it >> 6) * GNCH + 4 + (it & 63); gla_passC(a, ws, lds, l, item, tid); }
            } else if (EN(7) && sub == 5) {
                pg8::Gemm g{(const bf16_t*)(ws + WS_KF), (const bf16_t*)(ws + WS_GLUW), Mrows, 512, 512}; pg8::StaticOrder S; S.init(Mrows, 512, G, bid);
                EpiGlu E{(const bf16_t*)(ws + WS_KF) + OBSZ, (bf16_t*)(ws + WS_H), a.in[I_GLUB] + (size_t)l * 512};
                pg8::gemm_phase<EpiGlu, pg8::StaticOrder, true, true>(lds, g, S, E, tid);
                if (l == 0 && bid >= 136) {
                    LANE_WAVE(); LAS float* scr = (LAS float*)(lds + wave * 8704);
                    for (int r = (bid - 136) * NWAVES + wave; r < 32 * (NPAD / 32); r += (G - 136) * NWAVES) { const int kb = r / (NPAD / 32), nb = r % (NPAD / 32);
                        transpose_item(a.in[I_WIN] + (size_t)1 * D * INW, INW, win_srccol(nb * 32 + (lane & 31)), kb * 64, (bf16_t*)(ws + WS_WIN), D, nb * 32, scr, lane); }
                }
            } else if (EN(8)) {
                pg8::Gemm g{(const bf16_t*)(ws + WS_H), (const bf16_t*)(ws + WS_WOUT), Mrows, D, D}; pg8::StaticOrder S; S.init(Mrows, D, G, bid);
                EpiOut E{l == 0 ? a.in[I_X] : a.out, a.in[I_CTX], a.out, (float*)(ws + WS_XC1), MOD + (size_t)l * 5 * ADA};
                pg8::gemm_phase<EpiOut, pg8::StaticOrder, true, true>(lds, g, S, E, tid);
                if (l == 0 && bid >= 32) {
                    for (int it = bid - 32; it < 256; it += G - 32) { int tid2 = threadIdx.x; asm volatile("" : "+v"(tid2)); __syncthreads(); filt_item2(a, ws, lds, 1, it, tid2); }
                }
            }
        }
#ifdef REP_SUB
        if (ph != PH_PREP && ph != PH_FNORM && ((ph - 1) % PH_PER_LAYER) == REP_SUB && ((REP_LMASK >> ((ph - 1) / PH_PER_LAYER)) & 1) && !((repmask >> ((ph - 1) / PH_PER_LAYER)) & 1)) { repmask |= 1 << ((ph - 1) / PH_PER_LAYER); xcd_barrier(gbar); --ph; continue; }
#endif
        if (ph + 1 < ka.ph_hi) xcd_barrier(gbar);
    }
}

#ifndef MK_LAUNCH_PER_PHASE
#define MK_LAUNCH_PER_PHASE 0
#endif
extern "C" void kernel_launch(void* const* d_in, const int* in_sizes, int n_in, void* d_out, int out_size, void* d_ws, size_t ws_size, hipStream_t stream) {
    static int grid = 0;
    if (grid == 0) {
        if (n_in != N_IN || out_size != NLAT * D || ws_size < WS_END2) { fprintf(stderr, "kernel_launch: unexpected shapes (n_in %d, out %d, ws %zu < %zu); nothing launched\n", n_in, out_size, ws_size, (size_t)WS_END2); grid = -1; return; }
        int dev = 0, cus = 0, per_cu = 0;
        if (hipGetDevice(&dev) != hipSuccess || hipDeviceGetAttribute(&cus, hipDeviceAttributeMultiprocessorCount, dev) != hipSuccess) { grid = -1; return; }
        if (hipFuncSetAttribute((const void*)fwd_kernel, hipFuncAttributeMaxDynamicSharedMemorySize, LDS_BYTES) != hipSuccess) { fprintf(stderr, "kernel_launch: hipFuncSetAttribute failed\n"); grid = -1; return; }
        if (hipOccupancyMaxActiveBlocksPerMultiprocessor(&per_cu, (const void*)fwd_kernel, NT, LDS_BYTES) != hipSuccess || per_cu < 1) { fprintf(stderr, "kernel_launch: occupancy query says %d blocks per CU\n", per_cu); per_cu = 1; }
        (void)hipGetLastError();
        grid = cus;
    }
    if (grid < 0) return;
    (void)hipMemsetAsync((char*)d_ws + WS_CTL, 0, WS_ZERO_BYTES, stream);
    Args a{};
    for (int i = 0; i < N_IN; ++i) a.in[i] = (const float*)d_in[i];
    a.out = (float*)d_out; a.ws = (unsigned char*)d_ws;
#if MK_LAUNCH_PER_PHASE
    for (int ph = 0; ph < N_PHASES; ++ph) {
        a.ph_lo = ph; a.ph_hi = ph + 1;
        hipLaunchKernelGGL(fwd_kernel, dim3(grid), dim3(NT), LDS_BYTES, stream, a);
    }
#else
    a.ph_lo = 0; a.ph_hi = N_PHASES;
    void* args[] = {&a};
    hipError_t e = hipLaunchCooperativeKernel((const void*)fwd_kernel, dim3(grid), dim3(NT), args, LDS_BYTES, stream);
    if (e != hipSuccess) fprintf(stderr, "kernel_launch: cooperative launch failed: %s (grid %d)\n", hipGetErrorString(e), grid);
#endif
}
```

```cpp
#include <hip/hip_runtime.h>
#include <hip/hip_cooperative_groups.h>
#include <cstdio>
#include <cstdint>
namespace cg = cooperative_groups;

#define LAS __attribute__((address_space(3)))
typedef unsigned short bf16_t;
typedef float f32x4 __attribute__((ext_vector_type(4)));
typedef float f32x2 __attribute__((ext_vector_type(2)));
typedef unsigned u32x4 __attribute__((ext_vector_type(4)));
typedef unsigned u32x2 __attribute__((ext_vector_type(2)));

constexpr int D = 2048, NB = 4, SEQL = 4096, LC = 256, NLAT = NB * SEQL, NCTX = NB * LC, MR = NLAT + NCTX;
constexpr int BR = 512, INW = 6688, NPAD = 6912, LDP = 4608, ADA = 3 * D;
constexpr int NT = 512, NWAVES = 8;
constexpr float EPS = 1e-6f;
constexpr int PC_S5U = 0, PC_S5G = 512, PC_RQ = 1024, PC_RK = 1536, PC_RV = 2048, PC_RG = 2560, PC_GQ = 3072, PC_GK = 3328, PC_GV = 3584, PC_GG = 4096;
constexpr int PT_V = 0, PT_G1 = 512, PT_G2 = 1024, PT_HG = 1536;
constexpr int FFTN = 8192;

enum { I_X = 0, I_C, I_CTX, I_CCTX, I_NORMW, I_ADAW, I_ADAB, I_WIN, I_WOUT, I_S5ARE, I_S5AIM, I_S5LDT, I_S5BRE, I_S5BIM, I_S5CRE, I_S5CIM,
       I_S5D, I_GLUW, I_GLUB, I_HCW, I_HCB, I_HW1, I_HB1, I_HF1, I_HW2, I_HB2, I_HF2, I_HW3, I_HB3, I_HF3, I_HW4, I_HBIAS, I_RNW, I_GGW, I_GGB, I_GNW, I_FNW, N_IN };

constexpr size_t al256(size_t x) { return (x + 255) & ~(size_t)255; }
constexpr size_t WS_CTL  = 0;
constexpr size_t WS_MOD  = WS_CTL + 65536;
constexpr size_t WS_ZERO_BYTES = 65536 + al256((size_t)2 * 5 * ADA * 4);
constexpr size_t WS_S5AB = WS_MOD + al256((size_t)2 * 5 * ADA * 4);
constexpr size_t WS_S5BT = WS_S5AB + (size_t)2 * 2 * 32 * 64 * 8;
constexpr size_t WS_H3   = WS_S5BT + (size_t)1048576 + 65536;
constexpr size_t WS_H3C  = WS_H3 + (size_t)2 * 4096 * 64 * 4;
constexpr size_t WS_KC   = WS_H3C + (size_t)256 * 64 * 4;
constexpr size_t WS_LR   = WS_KC + (size_t)2 * 512 * 512 * 4;
constexpr size_t WS_XC1  = WS_LR + (size_t)MR * 32 * 4;
constexpr size_t WS_WOUT = WS_XC1 + (size_t)NCTX * D * 4;
constexpr size_t WS_GLUW = WS_WOUT + (size_t)D * D * 2;
constexpr size_t WS_WIN  = WS_GLUW + (size_t)512 * 512 * 2;
constexpr size_t WS_H    = WS_WIN + (size_t)NPAD * D * 2;
constexpr size_t WS_P    = WS_H + (size_t)MR * D * 2;
constexpr size_t WS_PT   = WS_P + (size_t)MR * LDP * 2;
constexpr size_t WS_KF   = WS_PT + (size_t)2048 * MR * 2;
constexpr size_t WS_OB   = WS_KF + (size_t)2 * 512 * FFTN * 8;
constexpr size_t WS_END  = WS_OB + (size_t)6 * MR * 512 * 2;
constexpr size_t OBSZ = (size_t)MR * 512;

constexpr int LDS_CTL_OFF = 135168 + 1024;
constexpr int LDS_PTR_OFF = LDS_CTL_OFF + 64;
constexpr int LDS_BYTES = LDS_PTR_OFF + 320;

typedef __bf16 hwbf16x2 __attribute__((ext_vector_type(2)));
__device__ __forceinline__ unsigned pk2(float lo, float hi) { const f32x2 v = {lo, hi}; return __builtin_bit_cast(unsigned, __builtin_convertvector(v, hwbf16x2)); }
__device__ __forceinline__ unsigned f2bf(float f) { return pk2(f, 0.f) & 0xffffu; }
__device__ __forceinline__ float bf2f(bf16_t b) { return __uint_as_float((unsigned)b << 16); }
__device__ __forceinline__ float bflo(unsigned w) { return __uint_as_float(w << 16); }
__device__ __forceinline__ float bfhi(unsigned w) { return __uint_as_float(w & 0xffff0000u); }
__device__ __forceinline__ void unpack8(const u32x4 r, float (&f)[8]) { f[0] = bflo(r.x); f[1] = bfhi(r.x); f[2] = bflo(r.y); f[3] = bfhi(r.y); f[4] = bflo(r.z); f[5] = bfhi(r.z); f[6] = bflo(r.w); f[7] = bfhi(r.w); }
__device__ __forceinline__ u32x4 pack8(const float (&f)[8]) { u32x4 o; o.x = pk2(f[0], f[1]); o.y = pk2(f[2], f[3]); o.z = pk2(f[4], f[5]); o.w = pk2(f[6], f[7]); return o; }
__device__ __forceinline__ float sigmoidf_(float x) { return __builtin_amdgcn_rcpf(1.0f + __expf(-x)); }
__device__ __forceinline__ float siluf_(float x) { return x * sigmoidf_(x); }
__device__ __forceinline__ float gelu_tanh(float x) { const float u2 = 1.5957691216057308f * (x + 0.044715f * x * x * x); return x * sigmoidf_(u2); }
__device__ __forceinline__ float wave_sum(float v) {
#pragma unroll
    for (int o = 1; o < 64; o <<= 1) v += __shfl_xor(v, o);
    return v;
}
#define LDS_WAIT() asm volatile("s_waitcnt lgkmcnt(0)" ::: "memory")

struct Args { const float* in[N_IN]; float* out; unsigned char* ws; int ph_lo, ph_hi; };
struct InTab { const LAS unsigned long long* t;
    __device__ __forceinline__ const float* operator[](int i) const { const unsigned long long v = t[i];
        const unsigned lo = __builtin_amdgcn_readfirstlane((unsigned)v), hi = __builtin_amdgcn_readfirstlane((unsigned)(v >> 32)); return (const float*)(__attribute__((address_space(1))) const float*)(((unsigned long long)hi << 32) | lo); } };
struct DArgs { InTab in; float* out; };

#define XB_TMO      128
#define XB_XCNT(j)  (256  + 64 * (j))
#define XB_XSUB(j)  (1280 + 64 * (j))
#define XB_XGEN(j)  (2304 + 64 * (j))
#define XB_TOP      3328
#define XB_TOPGEN   3392
#define XCD_BAR_WORDS 3456
#define XB_SPIN_CAP (1u << 22)
__device__ __forceinline__ unsigned xb_ld(unsigned* p)              { return __hip_atomic_load(p, __ATOMIC_RELAXED, __HIP_MEMORY_SCOPE_AGENT); }
__device__ __forceinline__ unsigned xb_add(unsigned* p, unsigned v) { return __hip_atomic_fetch_add(p, v, __ATOMIC_RELAXED, __HIP_MEMORY_SCOPE_AGENT); }
__device__ __forceinline__ unsigned xb_xcc_id() { return (unsigned)__builtin_amdgcn_s_getreg((3 << 11) | 20) & 0xFu; }
#define XB_SPIN(cond, bar) do { unsigned _sp = 0; while (cond) { __builtin_amdgcn_s_sleep(1); \
    if ((++_sp & 255u) == 0u) { if (xb_ld(&(bar)[XB_TMO])) break; if (_sp > XB_SPIN_CAP) { atomicAdd(&(bar)[XB_TMO], 1u); break; } } } } while (0)
struct XcdBarrier { unsigned* bar; unsigned x; volatile LAS unsigned* st; };
__device__ __forceinline__ XcdBarrier xcd_barrier_post(unsigned* bar, volatile LAS unsigned* st) {
    XcdBarrier b; b.bar = bar; b.x = xb_xcc_id(); b.st = st;
    if (threadIdx.x == 0) (void)xb_add(&bar[XB_XCNT(b.x)], 1u);
    return b;
}
__device__ __forceinline__ void xcd_barrier_complete(unsigned* bar, unsigned x, unsigned& nloc, unsigned& nx) {
    const unsigned G = gridDim.x * gridDim.y * gridDim.z;
    unsigned sum, cnt, mine, sp = 0u;
    for (;;) {
        sum = 0u; cnt = 0u; mine = 0u;
#pragma unroll
        for (unsigned j = 0; j < 16; ++j) { const unsigned c = xb_ld(&bar[XB_XCNT(j)]); sum += c; cnt += (c > 0u) ? 1u : 0u; mine = (j == x) ? c : mine; }
        if (sum == G) break;
        __builtin_amdgcn_s_sleep(1);
        if ((++sp & 255u) == 0u) { if (xb_ld(&bar[XB_TMO])) break; if (sp > XB_SPIN_CAP) { atomicAdd(&bar[XB_TMO], 1u); break; } }
    }
    nloc = mine > 0u ? mine : 1u; nx = cnt > 0u ? cnt : 1u;
}
__device__ __forceinline__ void xcd_barrier(const XcdBarrier& b) {
    asm volatile("s_waitcnt vmcnt(0)" ::: "memory");
    __syncthreads();
    if (threadIdx.x == 0) {
        unsigned* bar = b.bar;
        __builtin_amdgcn_s_waitcnt(0);
        unsigned nloc = b.st[0], nx = b.st[1];
        if (nloc == 0u) { xcd_barrier_complete(bar, b.x, nloc, nx); b.st[0] = nloc; b.st[1] = nx; }
        const unsigned old = xb_add(&bar[XB_XSUB(b.x)], 1u);
        const unsigned gen = old / nloc;
        if (old + 1u == (gen + 1u) * nloc) {
            __builtin_amdgcn_fence(__ATOMIC_RELEASE, "agent");
            asm volatile("s_waitcnt vmcnt(0)" ::: "memory");
            const unsigned og = xb_add(&bar[XB_TOP], 1u);
            const unsigned tg = og / nx;
            if (og + 1u == (tg + 1u) * nx) xb_add(&bar[XB_TOPGEN], 1u);
            else XB_SPIN(xb_ld(&bar[XB_TOPGEN]) == tg, bar);
            __builtin_amdgcn_fence(__ATOMIC_ACQUIRE, "agent");
            xb_add(&bar[XB_XGEN(b.x)], 1u);
            asm volatile("s_waitcnt vmcnt(0)" ::: "memory");
        } else {
            XB_SPIN(xb_ld(&bar[XB_XGEN(b.x)]) == gen, bar);
            __builtin_amdgcn_fence(__ATOMIC_ACQUIRE, "agent");
            asm volatile("s_waitcnt vmcnt(0)" ::: "memory");
        }
    }
    __syncthreads();
}
#ifndef PG8_RB
#define PG8_RB 4
#endif
#ifndef PG8_WGM
#define PG8_WGM 4
#endif
namespace pg8 {
#define PG8_LAS __attribute__((address_space(3)))
typedef unsigned short bf16_t;
typedef short bf16x8 __attribute__((ext_vector_type(8)));
typedef float f32x4 __attribute__((ext_vector_type(4)));
typedef unsigned u32x4 __attribute__((ext_vector_type(4)));
constexpr int BM = 256, BK = 64, HALF = 128, HTB = HALF * BK * 2, STAGE_BYTES = 8 * HTB, NXCD = 8, WGM = PG8_WGM;

__host__ __device__ __forceinline__ int lds_byte(int r, int c) { const int st = (r >> 4) * 2 + (c >> 5), rr = r & 15, cc = c & 31, ob = rr * 64 + cc * 2; return st * 1024 + (ob ^ (((ob >> 9) & 1) << 5)); }
__host__ __device__ __forceinline__ void stage_rc(int b, int& R, int& C) { const int st = b / 1024, sb = b % 1024, swz = sb ^ (((sb >> 9) & 1) << 5); R = (st >> 1) * 16 + swz / 64; C = (st & 1) * 32 + (swz % 64) / 2; }
__host__ __device__ __forceinline__ int perm32(int rho) { const int n = rho >> 4, i = rho & 15; return 8 * (i >> 2) + 4 * n + (i & 3); }

struct Unit { int pm, pn; };
struct Gemm { const bf16_t* A; const bf16_t* Bt; int M, N, K; };

struct StaticOrder {
    int nM, nN, nwg, G, c;
    __host__ __device__ void init(int M, int N, int G_, int c_) { nM = M / BM; nN = N / BM; nwg = nM * nN; G = G_; c = c_; }
    __host__ __device__ bool next(int i, Unit& u) const {
        const long L = (long)i * G + c; if (L >= nwg) return false;
        int wgid = (int)L; { const int q = nwg / NXCD, r = nwg % NXCD, xcd = wgid % NXCD, off = wgid / NXCD; wgid = (xcd < r ? xcd * (q + 1) : r * (q + 1) + (xcd - r) * q) + off; }
        const int nig = WGM * nN, gid = wgid / nig, fm = gid * WGM, gsz = (nM - fm) < WGM ? (nM - fm) : WGM;
        u.pm = fm + ((wgid % nig) % gsz); u.pn = (wgid % nig) / gsz; return true;
    }
    __device__ __forceinline__ void a_ready(const Unit&) const {}
    __device__ __forceinline__ void done(const Unit&) const {}
    __device__ __forceinline__ bool swapped(const Unit&) const { return false; }
};


struct InProjOrder {
    int G, c, last;
    __host__ __device__ void init(int last_, int G_, int c_) { last = last_; G = G_; c = c_; }
    __host__ __device__ bool next(int i, Unit& u) const {
        const int L = i * G + c;
        if (L < 1728) { constexpr int RB = PG8_RB, BT = 8 * RB * 27, CB = 32 / RB; const int band = L / BT, r = L % BT, blk = r >> 8, q = r & 255, x = q & 7, j = q >> 3;
            u.pm = 8 * RB * band + RB * x + (j % RB); u.pn = CB * blk + (j / RB); return true; }
        if (!last) { if (L >= 1836) return false; const int r = L - 1728; u.pm = 64 + (r & 3); u.pn = r >> 2; return true; }
        if (L >= 1768) return false;
        const int k = L - 1728, j = k % 10; u.pm = 64 + k / 10;
        u.pn = j == 0 ? 0 : j == 1 ? 1 : j == 2 ? 14 : j == 3 ? 15 : j == 4 ? 16 : j == 5 ? 17 : j == 6 ? 21 : j == 7 ? 22 : j == 8 ? 23 : 26;
        return true;
    }
    __device__ __forceinline__ void a_ready(const Unit&) const {}
    __device__ __forceinline__ void done(const Unit&) const {}
    __device__ __forceinline__ bool swapped(const Unit& u) const { return u.pn >= 4 && u.pn < 12; }
};
template <class Epi, class Sched, bool ALIGN_EPI = false, bool SP2 = false>
__device__ __forceinline__ void gemm_phase(PG8_LAS unsigned char* lds, const Gemm g, const Sched& S, const Epi& E, const int tid) {
    const int wid = __builtin_amdgcn_readfirstlane(tid >> 6), lane = tid & 63, wr = wid >> 2, wc = wid & 3, fr = lane & 15, fq = lane >> 4;
    const int K = g.K, nt = K / BK;
    unsigned voffA[2], voffB[2];
#pragma unroll
    for (int i = 0; i < 2; ++i) { int R, C; stage_rc(tid * 16 + i * 8192, R, C); const int Rb = Epi::PERM ? ((R & ~31) + perm32(R & 31)) : R;
        voffA[i] = (unsigned)(R * K + C) * 2u; voffB[i] = (unsigned)(Rb * K + C) * 2u; }
    const size_t kstep = (size_t)(BK * 2);
    const size_t hstep = (size_t)HALF * K * 2;
    const size_t tstep = 2 * hstep;
    const unsigned ldsw = (unsigned)wid * 1024u;
    const int aoff = lds_byte(wr * 64 + fr, fq * 8), boff = lds_byte(wc * 32 + fr, fq * 8);
#define PG8_SA(b, h) (((b) * 2 + (h)) * HTB)
#define PG8_SB(b, h) ((4 + (b) * 2 + (h)) * HTB)
#define PG8_STAGE(bufoff, gbase, voff) do { _Pragma("unroll") for (int _i = 0; _i < 2; ++_i) \
        __builtin_amdgcn_global_load_lds((const unsigned*)((const char*)(gbase) + (voff)[_i]), (PG8_LAS unsigned*)(lds + (bufoff) + ldsw + _i * 8192), 16, 0, 0); } while (0)
#define PG8_LDA(dst, b, h) do { _Pragma("unroll") for (int m = 0; m < 4; ++m) _Pragma("unroll") for (int k = 0; k < 2; ++k) dst[m][k] = *(const PG8_LAS bf16x8*)(lds + PG8_SA(b, h) + aoff + m * 2048 + k * 1024); } while (0)
#define PG8_LDB(dst, b, h) do { _Pragma("unroll") for (int n = 0; n < 2; ++n) _Pragma("unroll") for (int k = 0; k < 2; ++k) dst[n][k] = *(const PG8_LAS bf16x8*)(lds + PG8_SB(b, h) + boff + n * 2048 + k * 1024); } while (0)
#define PG8_MMA(ai, bj, At, Bt) do { __builtin_amdgcn_s_setprio(1); _Pragma("unroll") for (int m = 0; m < 4; ++m) _Pragma("unroll") for (int n = 0; n < 2; ++n) _Pragma("unroll") for (int k = 0; k < 2; ++k) \
        acc[ai][bj][m][n] = __builtin_amdgcn_mfma_f32_16x16x32_bf16(Bt[n][k], At[m][k], acc[ai][bj][m][n], 0, 0, 0); __builtin_amdgcn_s_setprio(0); } while (0)
#define PG8_WAIT_V(n) asm volatile("s_waitcnt vmcnt(" #n ")" ::: "memory")
#define PG8_WAIT_L(n) asm volatile("s_waitcnt lgkmcnt(" #n ")" ::: "memory")
#define PG8_BAR __builtin_amdgcn_s_barrier()
#define PG8_SCHED __builtin_amdgcn_sched_barrier(0)
    Unit cur, nxt; int ui = 0;
    if (!S.next(0, cur)) return;
    f32x4 acc[2][2][4][2];
#pragma unroll
    for (int a = 0; a < 2; ++a)
#pragma unroll
        for (int b = 0; b < 2; ++b)
#pragma unroll
            for (int m = 0; m < 4; ++m)
#pragma unroll
                for (int n = 0; n < 2; ++n) acc[a][b][m][n] = (f32x4){0.f, 0.f, 0.f, 0.f};
    bf16x8 At[4][2], B0[2][2], B1[2][2];
    const char* cA; const char* cB;
    { const char* pa = (const char*)g.A + (size_t)cur.pm * tstep; const char* pb = (const char*)g.Bt + (size_t)cur.pn * tstep; const bool sw = S.swapped(cur); cA = sw ? pb : pa; cB = sw ? pa : pb; }
    S.a_ready(cur);
    if constexpr (SP2) {
        PG8_STAGE(PG8_SB(0, 0), cB, voffB); PG8_STAGE(PG8_SB(0, 1), cB + hstep, voffB); PG8_STAGE(PG8_SA(0, 0), cA, voffA); PG8_STAGE(PG8_SA(0, 1), cA + hstep, voffA);
        if (wr == 1) PG8_BAR;
        PG8_WAIT_V(2); PG8_BAR;
        PG8_STAGE(PG8_SB(1, 0), cB + kstep, voffB); PG8_STAGE(PG8_SA(1, 0), cA + kstep, voffA); PG8_STAGE(PG8_SB(1, 1), cB + hstep + kstep, voffB);
        PG8_WAIT_V(6); PG8_BAR;
    } else {
        PG8_STAGE(PG8_SB(0, 0), cB, voffB); PG8_STAGE(PG8_SA(0, 0), cA, voffA); PG8_STAGE(PG8_SB(0, 1), cB + hstep, voffB); PG8_STAGE(PG8_SA(0, 1), cA + hstep, voffA);
        if (wr == 1) PG8_BAR;
        PG8_WAIT_V(4); PG8_BAR;
        PG8_STAGE(PG8_SB(1, 0), cB + kstep, voffB); PG8_STAGE(PG8_SA(1, 0), cA + kstep, voffA); PG8_STAGE(PG8_SB(1, 1), cB + hstep + kstep, voffB);
        PG8_WAIT_V(6); PG8_BAR;
    }
    for (;;) {
        const bool has_next = S.next(ui + 1, nxt);
        const char* nA = cA; const char* nB = cB;
        if (has_next) { const char* pa = (const char*)g.A + (size_t)nxt.pm * tstep; const char* pb = (const char*)g.Bt + (size_t)nxt.pn * tstep; const bool sw = S.swapped(nxt); nA = sw ? pb : pa; nB = sw ? pa : pb; }
#ifdef PG8_REPK
        const int nrep_ = (g.N == PG8_REPK) ? 2 : 1;
        for (int rep_ = 0; rep_ < nrep_; ++rep_) {
        if (rep_) {
#pragma unroll
            for (int a = 0; a < 2; ++a)
#pragma unroll
                for (int b = 0; b < 2; ++b)
#pragma unroll
                    for (int m = 0; m < 4; ++m)
#pragma unroll
                        for (int n = 0; n < 2; ++n) acc[a][b][m][n] = (f32x4){0.f, 0.f, 0.f, 0.f}; }
#endif
        for (int t = 0; t < nt; t += 2) {
#ifdef PG8_REPK
            const bool last = (t == nt - 2) && (rep_ == nrep_ - 1);
            const bool lastk_ = (t == nt - 2);
#else
            const bool last = (t == nt - 2);
#endif
            const char* a1 = cA + (size_t)(t + 1) * kstep;
#ifdef PG8_REPK
            const char* a2 = last ? nA : (lastk_ ? cA : cA + (size_t)(t + 2) * kstep); const char* b2 = last ? nB : (lastk_ ? cB : cB + (size_t)(t + 2) * kstep);
#else
            const char* a2 = last ? nA : cA + (size_t)(t + 2) * kstep; const char* b2 = last ? nB : cB + (size_t)(t + 2) * kstep;
#endif
            const char* a3 = a2 + kstep; const char* b3 = b2 + kstep;
            if (last && has_next) S.a_ready(nxt);
            if constexpr (SP2) {
            PG8_LDB(B0, 0, 0); PG8_LDB(B1, 0, 1); PG8_SCHED; PG8_LDA(At, 0, 0); PG8_STAGE(PG8_SA(1, 1), a1 + hstep, voffA);
            PG8_WAIT_V(8); PG8_WAIT_L(0); PG8_BAR; PG8_MMA(0, 0, At, B0); PG8_MMA(0, 1, At, B1); PG8_BAR; PG8_SCHED;
            PG8_LDA(At, 0, 1); PG8_STAGE(PG8_SB(0, 0), b2, voffB); PG8_STAGE(PG8_SB(0, 1), b2 + hstep, voffB); PG8_STAGE(PG8_SA(0, 0), a2, voffA);
            PG8_WAIT_V(8); PG8_WAIT_L(0); PG8_BAR; PG8_MMA(1, 0, At, B0); PG8_MMA(1, 1, At, B1); PG8_BAR; PG8_SCHED;
            PG8_LDB(B0, 1, 0); PG8_LDB(B1, 1, 1); PG8_SCHED; PG8_LDA(At, 1, 0); PG8_STAGE(PG8_SA(0, 1), a2 + hstep, voffA);
            PG8_WAIT_V(8); PG8_WAIT_L(0); PG8_BAR; PG8_MMA(0, 0, At, B0); PG8_MMA(0, 1, At, B1); PG8_BAR; PG8_SCHED;
            PG8_LDA(At, 1, 1); PG8_STAGE(PG8_SB(1, 0), b3, voffB); PG8_STAGE(PG8_SB(1, 1), b3 + hstep, voffB); PG8_STAGE(PG8_SA(1, 0), a3, voffA);
            PG8_WAIT_V(8); PG8_WAIT_L(0); PG8_BAR; PG8_MMA(1, 0, At, B0); PG8_MMA(1, 1, At, B1); PG8_BAR; PG8_SCHED;
            } else {
            PG8_LDB(B0, 0, 0); PG8_SCHED; PG8_LDA(At, 0, 0); PG8_STAGE(PG8_SA(1, 1), a1 + hstep, voffA);
            PG8_WAIT_L(8); PG8_BAR; PG8_WAIT_L(0); PG8_MMA(0, 0, At, B0); PG8_BAR; PG8_SCHED;
            PG8_LDB(B1, 0, 1); PG8_STAGE(PG8_SB(0, 0), b2, voffB);
            PG8_BAR; PG8_WAIT_L(0); PG8_MMA(0, 1, At, B1); PG8_BAR;
            PG8_LDA(At, 0, 1); PG8_STAGE(PG8_SA(0, 0), a2, voffA);
            PG8_BAR; PG8_WAIT_L(0); PG8_MMA(1, 0, At, B0); PG8_BAR; PG8_SCHED;
            PG8_STAGE(PG8_SB(0, 1), b2 + hstep, voffB);
            PG8_WAIT_V(6); PG8_BAR; PG8_MMA(1, 1, At, B1); PG8_BAR;
            PG8_LDB(B0, 1, 0); PG8_SCHED; PG8_LDA(At, 1, 0); PG8_STAGE(PG8_SA(0, 1), a2 + hstep, voffA);
            PG8_WAIT_L(8); PG8_BAR; PG8_WAIT_L(0); PG8_MMA(0, 0, At, B0); PG8_BAR; PG8_SCHED;
            PG8_LDB(B1, 1, 1); PG8_STAGE(PG8_SB(1, 0), b3, voffB);
            PG8_BAR; PG8_WAIT_L(0); PG8_MMA(0, 1, At, B1); PG8_BAR;
            PG8_LDA(At, 1, 1); PG8_STAGE(PG8_SA(1, 0), a3, voffA);
            PG8_BAR; PG8_WAIT_L(0); PG8_MMA(1, 0, At, B0); PG8_BAR; PG8_SCHED;
            PG8_STAGE(PG8_SB(1, 1), b3 + hstep, voffB);
            PG8_WAIT_V(6); PG8_BAR; PG8_MMA(1, 1, At, B1); PG8_BAR;
            }
        }
#ifdef PG8_REPK
        }
#endif
        if constexpr (ALIGN_EPI) { if (wr == 0) PG8_BAR; }
        { int fr_ = fr, fq_ = fq; asm volatile("" : "+v"(fr_), "+v"(fq_));
          E(acc, cur, wr, wc, fr_, fq_);
#ifdef PG8_REPE
          if (g.N == PG8_REPE) { asm volatile("" : "+v"(fr_), "+v"(fq_)); E(acc, cur, wr, wc, fr_, fq_); }
#endif
          } S.done(cur);
        if (!has_next) break;
#pragma unroll
        for (int a = 0; a < 2; ++a)
#pragma unroll
            for (int b = 0; b < 2; ++b)
#pragma unroll
                for (int m = 0; m < 4; ++m)
#pragma unroll
                    for (int n = 0; n < 2; ++n) acc[a][b][m][n] = (f32x4){0.f, 0.f, 0.f, 0.f};
        cur = nxt; cA = nA; cB = nB; ++ui;
        if constexpr (ALIGN_EPI) { if (wr == 1) PG8_BAR; }
    }
    PG8_WAIT_V(0);
    if constexpr (!ALIGN_EPI) { if (wr == 0) PG8_BAR; }
    PG8_BAR;
#undef PG8_SA
#undef PG8_SB
#undef PG8_STAGE
#undef PG8_LDA
#undef PG8_LDB
#undef PG8_MMA
#undef PG8_WAIT_V
#undef PG8_WAIT_L
#undef PG8_BAR
#undef PG8_SCHED
}
}
__device__ __forceinline__ void prep_adaln(const float* c, const float* cctx, const float* adaw, const float* adab, float* MOD, int it, LAS float* sv, int tid) {
    const int l = it / 384, r = it % 384, ntile = r >> 5, ks = r & 31, k0 = ks * 64;
    if (tid < 320) { const int v = tid >> 6, k = tid & 63; const float cv = v < 4 ? c[v * D + k0 + k] : cctx[k0 + k]; sv[tid] = cv / (1.0f + expf(-cv)); }
    __syncthreads();
    const int n = ntile * 512 + tid; const float* w = adaw + (size_t)l * D * ADA + (size_t)k0 * ADA + n;
    float acc[5] = {0.f, 0.f, 0.f, 0.f, 0.f};
#pragma unroll 1
    for (int k0_ = 0; k0_ < 64; k0_ += 32) {
        float wv[32];
#pragma unroll
        for (int k = 0; k < 32; ++k) wv[k] = w[(size_t)(k0_ + k) * ADA];
#pragma unroll
        for (int k = 0; k < 32; ++k) {
#pragma unroll
            for (int v = 0; v < 5; ++v) acc[v] += sv[v * 64 + k0_ + k] * wv[k]; } }
    if (ks == 0) { const float bb = adab[l * ADA + n];
#pragma unroll
        for (int v = 0; v < 5; ++v) acc[v] += bb; }
#pragma unroll
    for (int v = 0; v < 5; ++v) atomicAdd(MOD + (size_t)(l * 5 + v) * ADA + n, acc[v]);
    __syncthreads();
}

__device__ __forceinline__ void prep_hymlp(const DArgs& a, float* H3out, bf16_t* H3b, int l, int Lx, int t0, LAS unsigned char* lds, int tid) {
    LAS float* zs = (LAS float*)lds;
    LAS float* h1 = (LAS float*)(lds + 4608);
    LAS float* h2 = (LAS float*)(lds + 4608 + 8192);
    LAS float* w1s = (LAS float*)(lds + 24576);
    LAS float* w2s = w1s + 33 * 64;
    LAS float* w3s = w2s + 64 * 64;
    { const float* w1 = a.in[I_HW1] + (size_t)l * 33 * 64; const float* w2 = a.in[I_HW2] + (size_t)l * 64 * 64; const float* w3 = a.in[I_HW3] + (size_t)l * 64 * 64;
      for (int i = tid; i < 33 * 64; i += NT) w1s[i] = w1[i];
      for (int i = tid; i < 64 * 64; i += NT) { w2s[i] = w2[i]; w3s[i] = w3[i]; } }
    for (int i = tid; i < 32 * 33; i += NT) { const int pos = i / 33, f = i % 33, t = t0 + pos;
        float z;
        if (f == 0) z = (float)t / (float)(Lx - 1);
        else { const int j = (f - 1) & 15; const float fj = 1e-4f + (float)j * ((15.0f - 1e-4f) / 15.0f); const float wpos = (6.283185307179586f * (float)t) / (float)Lx; const float arg = fj * wpos;
               z = (f <= 16) ? cosf(arg) : -sinf(arg); }
        zs[pos * 36 + f] = z; }
    __syncthreads();
    const int pos = tid >> 4, f4 = (tid & 15) * 4, t = t0 + pos;
    f32x4 s = *(const f32x4*)(a.in[I_HB1] + l * 64 + f4);
#pragma unroll 3
    for (int j = 0; j < 33; ++j) s += zs[pos * 36 + j] * *(const LAS f32x4*)(w1s + j * 64 + f4);
    { const f32x4 fr = *(const f32x4*)(a.in[I_HF1] + l * 64 + f4); *(LAS f32x4*)(h1 + pos * 64 + f4) = (f32x4){sinf(fr.x * s.x), sinf(fr.y * s.y), sinf(fr.z * s.z), sinf(fr.w * s.w)}; }
    __syncthreads();
    s = *(const f32x4*)(a.in[I_HB2] + l * 64 + f4);
#pragma unroll 4
    for (int j = 0; j < 64; ++j) s += h1[pos * 64 + j] * *(const LAS f32x4*)(w2s + j * 64 + f4);
    { const f32x4 fr = *(const f32x4*)(a.in[I_HF2] + l * 64 + f4); *(LAS f32x4*)(h2 + pos * 64 + f4) = (f32x4){sinf(fr.x * s.x), sinf(fr.y * s.y), sinf(fr.z * s.z), sinf(fr.w * s.w)}; }
    __syncthreads();
    s = *(const f32x4*)(a.in[I_HB3] + l * 64 + f4);
#pragma unroll 4
    for (int j = 0; j < 64; ++j) s += h2[pos * 64 + j] * *(const LAS f32x4*)(w3s + j * 64 + f4);
    { const f32x4 fr = *(const f32x4*)(a.in[I_HF3] + l * 64 + f4); const f32x4 hv = (f32x4){sinf(fr.x * s.x), sinf(fr.y * s.y), sinf(fr.z * s.z), sinf(fr.w * s.w)}; *(f32x4*)(H3out + (size_t)t * 64 + f4) = hv;
      if (H3b) { u32x2 pk; pk.x = pk2(hv.x, hv.y); pk.y = pk2(hv.z, hv.w); *(u32x2*)(H3b + (size_t)t * 64 + f4) = pk; } }
    __syncthreads();
}

__device__ __forceinline__ void transpose_item(const float* W, int ldw, int srccol_lane  , int k0, bf16_t* WT, int K, int dstrow0, LAS float* scr, int lane) {
    float wv[32];
#pragma unroll
    for (int i = 0; i < 32; ++i) { const int kk = 2 * i + (lane >> 5); wv[i] = srccol_lane >= 0 ? W[(size_t)(k0 + kk) * ldw + srccol_lane] : 0.f; }
#pragma unroll
    for (int i = 0; i < 32; ++i) { const int kk = 2 * i + (lane >> 5); scr[kk * 33 + (lane & 31)] = wv[i]; }
    LDS_WAIT();
    const int c = lane & 7;
#pragma unroll
    for (int j = 0; j < 4; ++j) { const int n = (lane >> 3) + 8 * j; const LAS float* s = scr + (8 * c) * 33 + n;
        u32x4 o; o.x = pk2(s[0 * 33], s[1 * 33]); o.y = pk2(s[2 * 33], s[3 * 33]); o.z = pk2(s[4 * 33], s[5 * 33]); o.w = pk2(s[6 * 33], s[7 * 33]);
        *(u32x4*)(WT + (size_t)(dstrow0 + n) * K + k0 + 8 * c) = o; }
    LDS_WAIT();
}
__device__ __forceinline__ int win_srccol(int n) {
    if (n >= 3072 && n < 4096) { const int u = (n - 3072) & 127, grp = u >> 3, e = u & 7; return (n & ~127) + (e < 4 ? 4 * grp + e : 64 + 4 * grp + (e - 4)); }
    return n < 6144 ? n : (n < 6656 ? n + 32 : (n < 6688 ? n - 512 : -1));
}

__device__ __forceinline__ void norm_row(const float* xrow, const float* nw, const float* mod, bf16_t* hrow, int lane) {
    f32x4 v[8]; float ss = 0.f;
#pragma unroll
    for (int j = 0; j < 8; ++j) { v[j] = ((const f32x4*)xrow)[lane + 64 * j]; ss += (v[j].x * v[j].x + v[j].y * v[j].y) + (v[j].z * v[j].z + v[j].w * v[j].w); }
    const float rstd = rsqrtf(wave_sum(ss) * (1.0f / D) + EPS);
#pragma unroll
    for (int j = 0; j < 8; ++j) { const int k = 4 * (lane + 64 * j);
        const f32x4 w = *(const f32x4*)(nw + k), sh = *(const f32x4*)(mod + k), sc = *(const f32x4*)(mod + D + k);
        const f32x4 o = v[j] * rstd * w * (sc + 1.0f) + sh;
        u32x2 pk; pk.x = pk2(o.x, o.y); pk.y = pk2(o.z, o.w);
        *(u32x2*)(hrow + k) = pk; }
}

__device__ __forceinline__ float block_sum(float v, LAS float* red, int tid) {
    v = wave_sum(v);
    if ((tid & 63) == 0) red[tid >> 6] = v;
    __syncthreads();
    float t = 0.f;
#pragma unroll
    for (int i = 0; i < NWAVES; ++i) t += red[i];
    __syncthreads();
    return t;
}
constexpr float HY_D0 = -3.0701134573253945f  , HY_D1 = -15.350567286626973f  ;

__device__ __forceinline__ void filt_ctx_item(const DArgs& a, unsigned char* ws, LAS unsigned char* lds, int c, int tid) {
    LAS float* w4s = (LAS float*)lds; LAS float* red = (LAS float*)(lds + 1024);
    if (tid < 256) { const int cc = tid >> 6, f = tid & 63; w4s[tid] = a.in[I_HW4][(size_t)f * 2048 + (cc >> 1) * 1024 + (cc & 1) * 512 + c]; }
    __syncthreads();
    const float dl = fabsf(HY_D0 + (HY_D1 - HY_D0) * ((float)c / 511.0f));
    const float* H3C = (const float*)(ws + WS_H3C);
    const int n = tid, dir = n >= 256 ? 1 : 0, t = dir ? (512 - n) : n;
    float s0 = 0.f, s1 = 0.f;
    if (n != 256) {
        const f32x4* hr = (const f32x4*)(H3C + (size_t)t * 64);
#pragma unroll
        for (int q = 0; q < 16; ++q) { const f32x4 hv = hr[q]; const f32x4 wa = ((const LAS f32x4*)(w4s + (dir * 2 + 0) * 64))[q], wb = ((const LAS f32x4*)(w4s + (dir * 2 + 1) * 64))[q];
            s0 += (hv.x * wa.x + hv.y * wa.y) + (hv.z * wa.z + hv.w * wa.w); s1 += (hv.x * wb.x + hv.y * wb.y) + (hv.z * wb.z + hv.w * wb.w); }
        const float dec = expf(-((float)t / 255.0f) * dl); s0 *= dec; s1 *= dec;
    }
    const float rs0 = rsqrtf(block_sum(s0 * s0, red, tid) + EPS), rs1 = rsqrtf(block_sum(s1 * s1, red, tid) + EPS);
    float* KC = (float*)(ws + WS_KC);
    KC[(size_t)(0 * 512 + c) * 512 + n] = s0 * rs0; KC[(size_t)(1 * 512 + c) * 512 + n] = s1 * rs1;
    __syncthreads();
}

__device__ __forceinline__ void prep_rope(f32x2* RT, int it, int tid) {
    const int idx = it * NT + tid, pos = idx >> 6, j = idx & 63;
    float ang;
    if (pos < SEQL) { const float inv = exp2f(-(float)(j & 31) * (13.287712379549449f / 32.0f)); ang = (float)(j < 32 ? (pos >> 6) : (pos & 63)) * inv; }
    else { const float inv = exp2f(-(float)j * (13.287712379549449f / 64.0f)); ang = (float)(pos - SEQL) * inv; }
    float sn, cs; sincosf(ang, &sn, &cs);
    RT[idx] = (f32x2){cs, sn};
}

__device__ __forceinline__ float sconv3(const bf16_t* p, int t, int Lx, float w0, float w1, float w2, float cb) {
    const float x0 = t > 0 ? bf2f(p[t - 1]) : 0.f, x1 = bf2f(p[t]), x2 = t < Lx - 1 ? bf2f(p[t + 1]) : 0.f;
    return w0 * x0 + w1 * x1 + w2 * x2 + cb;
}
__device__ __forceinline__ void ctx_conv256(const LAS float* kc, const LAS float* z, int b, int t4, int half, float (&o)[4]) {
    o[0] = o[1] = o[2] = o[3] = 0.f;
#pragma unroll 4
    for (int s4 = 0; s4 < 32; ++s4) { const int s = 128 * half + 4 * s4, d = 4 * t4 - s;
        const f32x4 zv = *(const LAS f32x4*)(z + b * 256 + s);
        const f32x4 wl = *(const LAS f32x4*)(kc + ((d - 4) & 511)), wh = *(const LAS f32x4*)(kc + (d & 511));
        const float w[8] = {wl.x, wl.y, wl.z, wl.w, wh.x, wh.y, wh.z, wh.w};
        const float zz[4] = {zv.x, zv.y, zv.z, zv.w};
#pragma unroll
        for (int j = 0; j < 4; ++j)
#pragma unroll
            for (int i = 0; i < 4; ++i) o[j] += w[4 + j - i] * zz[i]; }
}
__device__ __forceinline__ void hyena_ctx_item(const DArgs& a, unsigned char* ws, LAS unsigned char* lds, int c, int tid) {
    LAS float* kc = (LAS float*)lds; LAS float* za = (LAS float*)(lds + 4096); LAS float* zb = (LAS float*)(lds + 8192); LAS float* part = (LAS float*)(lds + 12288);
    const float* KC = (const float*)(ws + WS_KC);
    kc[tid] = KC[(size_t)(0 * 512 + c) * 512 + tid]; kc[512 + tid] = KC[(size_t)(1 * 512 + c) * 512 + tid];
    const float* cw = a.in[I_HCW]; const float* cbp = a.in[I_HCB];
    const float wv0 = cw[c], wv1 = cw[1536 + c], wv2 = cw[3072 + c], bv = cbp[c];
    const float wa0 = cw[512 + c], wa1 = cw[1536 + 512 + c], wa2 = cw[3072 + 512 + c], ba = cbp[512 + c];
    const float wb0 = cw[1024 + c], wb1 = cw[1536 + 1024 + c], wb2 = cw[3072 + 1024 + c], bb = cbp[1024 + c];
    const float bias0 = a.in[I_HBIAS][0 * 512 + c], bias1 = a.in[I_HBIAS][1 * 512 + c];
    const bf16_t* PT = (const bf16_t*)(ws + WS_PT);
    const int half = tid >> 8, b = (tid >> 6) & 3, t4 = tid & 63; const int rb = NLAT + b * LC;
    const bf16_t* pv = PT + (size_t)(PT_V + c) * MR + rb; const bf16_t* pg1 = PT + (size_t)(PT_G1 + c) * MR + rb; const bf16_t* pg2 = PT + (size_t)(PT_G2 + c) * MR + rb; const bf16_t* phg = PT + (size_t)(PT_HG + c) * MR + rb;
    bf16_t* GATED = (bf16_t*)(ws + WS_H);
    float z0[4], z1[4], o[4], g1v[4], g2v[4], hgv[4];
#pragma unroll
    for (int j = 0; j < 4; ++j) { z0[j] = sconv3(pv, 4 * t4 + j, LC, wv0, wv1, wv2, bv); g1v[j] = sconv3(pg1, 4 * t4 + j, LC, wa0, wa1, wa2, ba); g2v[j] = sconv3(pg2, 4 * t4 + j, LC, wb0, wb1, wb2, bb); hgv[j] = bf2f(phg[4 * t4 + j]); }
    if (half == 0) *(LAS f32x4*)(za + b * 256 + 4 * t4) = (f32x4){z0[0], z0[1], z0[2], z0[3]};
    __syncthreads();
    ctx_conv256(kc, za, b, t4, half, o);
    if (half == 1) *(LAS f32x4*)(part + b * 256 + 4 * t4) = (f32x4){o[0], o[1], o[2], o[3]};
    __syncthreads();
    if (half == 0) { const f32x4 pp = *(const LAS f32x4*)(part + b * 256 + 4 * t4); const float ps[4] = {pp.x, pp.y, pp.z, pp.w};
#pragma unroll
        for (int j = 0; j < 4; ++j) z1[j] = g1v[j] * (o[j] + ps[j] + bias0 * z0[j]);
        *(LAS f32x4*)(zb + b * 256 + 4 * t4) = (f32x4){z1[0], z1[1], z1[2], z1[3]}; }
    __syncthreads();
    ctx_conv256(kc + 512, zb, b, t4, half, o);
    if (half == 1) *(LAS f32x4*)(part + b * 256 + 4 * t4) = (f32x4){o[0], o[1], o[2], o[3]};
    __syncthreads();
    if (half == 0) { const f32x4 pp = *(const LAS f32x4*)(part + b * 256 + 4 * t4); const float ps[4] = {pp.x, pp.y, pp.z, pp.w};
#pragma unroll
        for (int j = 0; j < 4; ++j) { const int t = 4 * t4 + j; const float z2 = g2v[j] * (o[j] + ps[j] + bias1 * z1[j]);
            GATED[(size_t)(rb + t) * D + 512 + c] = (bf16_t)f2bf(z2 * siluf_(hgv[j])); } }
    __syncthreads();
}

struct EpiInProj {
    static constexpr bool PERM = true, AFTER_DRAIN = false;
    bf16_t* P; bf16_t* PT; float* LR; const float* RT;
    __device__ __forceinline__ void operator()(const pg8::f32x4 (&acc)[2][2][4][2], const pg8::Unit& u, int wr, int wc, int fr, int fq) const {
        const int row0 = u.pm * 256 + wr * 64 + fr, pn = u.pn;
        if (pn >= 12 && pn < 16) {
            const int colbase = pn * 256 - 2048 + wc * 32 + 8 * fq; const int j0 = 4 * (4 * wc + fq); const float ksc = pn >= 14 ? 0.08838834764831845f : 1.0f;
#pragma unroll
            for (int ai = 0; ai < 2; ++ai)
#pragma unroll
                for (int m = 0; m < 4; ++m) { const int row = row0 + ai * 128 + m * 16; const int pos = row < NLAT ? (row & (SEQL - 1)) : SEQL + ((row - NLAT) & (LC - 1));
                    const pg8::f32x4 t0 = *(const pg8::f32x4*)(RT + ((size_t)pos * 64 + j0) * 2), t1 = *(const pg8::f32x4*)(RT + ((size_t)pos * 64 + j0) * 2 + 4);
                    bf16_t* rowp = P + (size_t)row * LDP + colbase;
#pragma unroll
                    for (int bj = 0; bj < 2; ++bj) { const pg8::f32x4 x1 = acc[ai][bj][m][0] * ksc, x2 = acc[ai][bj][m][1] * ksc;
                        u32x4 w; w.x = pk2(x1[0] * t0[0] - x2[0] * t0[1], x1[1] * t0[2] - x2[1] * t0[3]); w.y = pk2(x1[2] * t1[0] - x2[2] * t1[1], x1[3] * t1[2] - x2[3] * t1[3]);
                        w.z = pk2(x1[0] * t0[1] + x2[0] * t0[0], x1[1] * t0[3] + x2[1] * t0[2]); w.w = pk2(x1[2] * t1[1] + x2[2] * t1[0], x1[3] * t1[3] + x2[3] * t1[2]);
                        __builtin_nontemporal_store(w, (u32x4*)(rowp + bj * 128)); } }
        } else if (pn < 4 || (pn >= 16 && pn < 26)) {
            const int colbase = (pn < 4 ? pn * 256 : pn * 256 - 2048) + wc * 32 + 8 * fq;
#pragma unroll
            for (int ai = 0; ai < 2; ++ai)
#pragma unroll
                for (int m = 0; m < 4; ++m) { bf16_t* rowp = P + (size_t)(row0 + ai * 128 + m * 16) * LDP + colbase;
#pragma unroll
                    for (int bj = 0; bj < 2; ++bj) { const pg8::f32x4 v0 = acc[ai][bj][m][0], v1 = acc[ai][bj][m][1];
                        u32x4 w; w.x = pk2(v0[0], v0[1]); w.y = pk2(v0[2], v0[3]); w.z = pk2(v1[0], v1[1]); w.w = pk2(v1[2], v1[3]);
                        __builtin_nontemporal_store(w, (u32x4*)(rowp + bj * 128)); } }
        } else if (pn < 12) {
            const int prow0 = (pn - 4) * 256 + wr * 64 + fr, tok0 = u.pm * 256 + wc * 32 + 8 * fq;
#pragma unroll
            for (int ai = 0; ai < 2; ++ai)
#pragma unroll
                for (int m = 0; m < 4; ++m) { bf16_t* rowp = PT + (size_t)(prow0 + ai * 128 + m * 16) * MR + tok0;
#pragma unroll
                    for (int bj = 0; bj < 2; ++bj) { const pg8::f32x4 v0 = acc[ai][bj][m][0], v1 = acc[ai][bj][m][1];
                        u32x4 w; w.x = pk2(v0[0], v0[1]); w.y = pk2(v0[2], v0[3]); w.z = pk2(v1[0], v1[1]); w.w = pk2(v1[2], v1[3]);
                        __builtin_nontemporal_store(w, (u32x4*)(rowp + bj * 128)); } }
        } else {
            if (wc == 0) {
#pragma unroll
                for (int ai = 0; ai < 2; ++ai)
#pragma unroll
                    for (int m = 0; m < 4; ++m) { float* rowp = LR + (size_t)(row0 + ai * 128 + m * 16) * 32 + 8 * fq;
                        *(pg8::f32x4*)(rowp) = acc[ai][0][m][0]; *(pg8::f32x4*)(rowp + 4) = acc[ai][0][m][1]; }
            }
        }
    }
};
struct EpiGlu {
    static constexpr bool PERM = true, AFTER_DRAIN = false;
    const bf16_t* GG; bf16_t* GATED; const float* bias;
    __device__ __forceinline__ void operator()(const pg8::f32x4 (&acc)[2][2][4][2], const pg8::Unit& u, int wr, int wc, int fr, int fq) const {
        const int row0 = u.pm * 256 + wr * 64 + fr, col0 = u.pn * 256 + wc * 32 + 8 * fq;
        pg8::f32x4 b0[2], b1[2];
#pragma unroll
        for (int bj = 0; bj < 2; ++bj) { b0[bj] = *(const pg8::f32x4*)(bias + col0 + bj * 128); b1[bj] = *(const pg8::f32x4*)(bias + col0 + bj * 128 + 4); }
#pragma unroll
        for (int ai = 0; ai < 2; ++ai) {
            u32x4 gg[4][2];
#pragma unroll
            for (int m = 0; m < 4; ++m)
#pragma unroll
                for (int bj = 0; bj < 2; ++bj) gg[m][bj] = *(const u32x4*)(GG + (size_t)(row0 + ai * 128 + m * 16) * 512 + col0 + bj * 128);
#pragma unroll
            for (int m = 0; m < 4; ++m) { const size_t row = (size_t)(row0 + ai * 128 + m * 16);
#pragma unroll
                for (int bj = 0; bj < 2; ++bj) { float g[8], res[8]; unpack8(gg[m][bj], g);
#pragma unroll
                    for (int j = 0; j < 4; ++j) { res[j] = g[j] * sigmoidf_(acc[ai][bj][m][0][j] + b0[bj][j]); res[4 + j] = g[4 + j] * sigmoidf_(acc[ai][bj][m][1][j] + b1[bj][j]); }
                    *(u32x4*)(GATED + row * D + col0 + bj * 128) = pack8(res); } }
            asm volatile("" ::: "memory");
        }
    }
};
struct EpiOut {
    static constexpr bool PERM = false, AFTER_DRAIN = false;
    const float* xl_old; const float* xc_old; float* xl_new; float* xc_new; const float* mod;
    __device__ __forceinline__ void operator()(const pg8::f32x4 (&acc)[2][2][4][2], const pg8::Unit& u, int wr, int wc, int fr, int fq) const {
        const int row0 = u.pm * 256 + wr * 64 + fr, col0 = u.pn * 256 + wc * 32 + 4 * fq;
        const bool lat = u.pm < 64;
        const float* xo = lat ? xl_old : xc_old - (size_t)NLAT * D; float* xn = lat ? xl_new : xc_new - (size_t)NLAT * D;
#pragma unroll
        for (int ai = 0; ai < 2; ++ai) {
            const int v = lat ? ((u.pm * 256 + ai * 128) >> 12) : 4;
            const float* gt = mod + (size_t)v * ADA + 2 * D;
#pragma unroll
            for (int m = 0; m < 4; ++m) { const size_t off = (size_t)(row0 + ai * 128 + m * 16) * D + col0;
#pragma unroll
                for (int bj = 0; bj < 2; ++bj)
#pragma unroll
                    for (int n = 0; n < 2; ++n) { const int cc = bj * 128 + n * 16; const pg8::f32x4 gv = *(const pg8::f32x4*)(gt + col0 + cc), xv = *(const pg8::f32x4*)(xo + off + cc);
                        *(pg8::f32x4*)(xn + off + cc) = xv + gv * acc[ai][bj][m][n]; } }
        }
    }
};
typedef short bf16x8 __attribute__((ext_vector_type(8)));
typedef short bf16x4 __attribute__((ext_vector_type(4)));
__device__ __forceinline__ unsigned off_b(unsigned row, unsigned ch) { return 256u * row + 16u * (ch ^ (((row & 3) << 2) | ((row >> 2) & 3))); }
__device__ __forceinline__ bf16x8 img_row_frag(const LAS unsigned char* img, unsigned lane, unsigned rb, unsigned s) { return *(const LAS bf16x8*)(img + off_b((lane & 15) + 16 * rb, 4 * s + (lane >> 4))); }
__device__ __forceinline__ bf16x4 img_tr4(const LAS unsigned char* img, unsigned lane, unsigned c, unsigned row0) {
    const unsigned q = (lane & 15) >> 2, p = lane & 3;
    return __builtin_amdgcn_ds_read_tr16_b64_v4i16((LAS bf16x4*)(img + off_b(row0 + q, 2 * c + (p >> 1)) + 8 * (p & 1)));
}
__device__ __forceinline__ bf16x8 img_tr_frag(const LAS unsigned char* img, unsigned lane, unsigned c, unsigned ks) {
    const unsigned g = lane >> 4; const bf16x4 lo = img_tr4(img, lane, c, 32 * ks + 8 * g), hi = img_tr4(img, lane, c, 32 * ks + 8 * g + 4);
    return __builtin_shufflevector(lo, hi, 0, 1, 2, 3, 4, 5, 6, 7);
}
__device__ __forceinline__ bf16x8 img_tr_frag_acc(const LAS unsigned char* img, unsigned lane, unsigned c, unsigned ks) {
    const unsigned g = lane >> 4; const bf16x4 lo = img_tr4(img, lane, c, 32 * ks + 4 * g), hi = img_tr4(img, lane, c, 32 * ks + 16 + 4 * g);
    return __builtin_shufflevector(lo, hi, 0, 1, 2, 3, 4, 5, 6, 7);
}
__device__ __forceinline__ bf16x8 acc_pair_frag(const f32x4 a0, const f32x4 a1) {
    u32x4 w; w.x = pk2(a0.x, a0.y); w.y = pk2(a0.z, a0.w); w.z = pk2(a1.x, a1.y); w.w = pk2(a1.z, a1.w);
    return __builtin_bit_cast(bf16x8, w);
}
#define MFMA16(A_, B_, C_) __builtin_amdgcn_mfma_f32_16x16x32_bf16((A_), (B_), (C_), 0, 0, 0)
__device__ __forceinline__ void stage_tile128(LAS unsigned char* img, const bf16_t* g, size_t ld, int tid) {
#pragma unroll
    for (int i = 0; i < 4; ++i) { const int n = tid + NT * i, row = n >> 4, ch = n & 15; *(LAS u32x4*)(img + off_b(row, ch)) = *(const u32x4*)(g + (size_t)row * ld + ch * 8); }
}

constexpr int RCH = 128, RNCH = 34;
constexpr size_t WS_RST = WS_OB;
__device__ __forceinline__ int ret_rowbase(int b, int cc) { return cc < 2 ? NLAT + b * LC + cc * RCH : b * SEQL + (cc - 2) * RCH; }
__device__ __forceinline__ float ret_log2g(int h) { return log2f(1.0f - exp2f(-5.0f - (float)h)); }

__device__ __forceinline__ void ret_passA(unsigned char* ws, LAS unsigned char* lds, int item, int tid) {
    const int bh = item / RNCH, cc = item % RNCH, b = bh >> 2, h = bh & 3;
    const int lane = tid & 63, w = tid >> 6, g = lane >> 4;
    LAS unsigned char* KF = lds; LAS unsigned char* KB = lds + 32768; LAS unsigned char* VI = lds + 65536;
    const bf16_t* P = (const bf16_t*)(ws + WS_P) + (size_t)ret_rowbase(b, cc) * LDP;
    const float l2g = ret_log2g(h);
    __syncthreads();
#pragma unroll
    for (int i = 0; i < 4; ++i) { const int n = tid + NT * i, row = n >> 4, ch = n & 15;
        const u32x4 kr = *(const u32x4*)(P + (size_t)row * LDP + PC_RK + h * 128 + ch * 8);
        float kf[8], a[8], c[8]; unpack8(kr, kf);
        const float sf = exp2f(l2g * (float)(RCH - 1 - row)), sb = exp2f(l2g * (float)row);
#pragma unroll
        for (int x = 0; x < 8; ++x) { a[x] = kf[x] * sf; c[x] = kf[x] * sb; }
        *(LAS u32x4*)(KF + off_b(row, ch)) = pack8(a); *(LAS u32x4*)(KB + off_b(row, ch)) = pack8(c);
        *(LAS u32x4*)(VI + off_b(row, ch)) = *(const u32x4*)(P + (size_t)row * LDP + PC_RV + h * 128 + ch * 8); }
    __syncthreads();
    bf16x8 af[4], ab[4];
#pragma unroll
    for (int ks = 0; ks < 4; ++ks) { af[ks] = img_tr_frag(KF, lane, w, ks); ab[ks] = img_tr_frag(KB, lane, w, ks); }
    bf16_t* ST = (bf16_t*)(ws + WS_RST) + ((size_t)(bh * 2) * RNCH + cc) * (128 * 128);
#pragma unroll 2
    for (int E = 0; E < 8; ++E) {
        f32x4 cf = {0.f, 0.f, 0.f, 0.f}, cb = {0.f, 0.f, 0.f, 0.f};
#pragma unroll
        for (int ks = 0; ks < 4; ++ks) { const bf16x8 vb = img_tr_frag(VI, lane, E, ks); cf = MFMA16(af[ks], vb, cf); cb = MFMA16(ab[ks], vb, cb); }
        const int e = 16 * E + (lane & 15), d0 = 16 * w + 4 * g;
        u32x2 o; o.x = pk2(cf.x, cf.y); o.y = pk2(cf.z, cf.w); *(u32x2*)(ST + (size_t)e * 128 + d0) = o;
        o.x = pk2(cb.x, cb.y); o.y = pk2(cb.z, cb.w); *(u32x2*)(ST + (size_t)RNCH * 128 * 128 + (size_t)e * 128 + d0) = o;
    }
}
__device__ __forceinline__ void ret_passB(unsigned char* ws, int gt  ) {
    const int el = gt & 2047, bd = gt >> 11, bh = bd >> 1, dir = bd & 1, h = bh & 3;
    const float gC = exp2f(ret_log2g(h) * (float)RCH);
    bf16_t* base = (bf16_t*)(ws + WS_RST) + (size_t)bd * RNCH * (128 * 128) + (size_t)el * 8;
    float acc[8];
#pragma unroll
    for (int x = 0; x < 8; ++x) acc[x] = 0.f;
#pragma unroll 1
    for (int s0 = 0; s0 < RNCH; s0 += 17) {
        u32x4 kvr[17];
#pragma unroll
        for (int j = 0; j < 17; ++j) { const int s = s0 + j; const int cc = dir == 0 ? s : (s < 2 ? 1 - s : 35 - s); kvr[j] = *(const u32x4*)(base + (size_t)cc * (128 * 128)); }
#pragma unroll
        for (int j = 0; j < 17; ++j) { const int s = s0 + j; const int cc = dir == 0 ? s : (s < 2 ? 1 - s : 35 - s);
            float kv[8]; unpack8(kvr[j], kv);
            *(u32x4*)(base + (size_t)cc * (128 * 128)) = pack8(acc);
#pragma unroll
            for (int x = 0; x < 8; ++x) acc[x] = gC * acc[x] + kv[x]; }
    }
}
__device__ __forceinline__ void ret_passC(const DArgs& a, unsigned char* ws, LAS unsigned char* lds, int l, int item, int tid) {
    const int bh = item / RNCH, cc = item % RNCH, b = bh >> 2, h = bh & 3;
    const int lane = tid & 63, w = tid >> 6, g = lane >> 4, il = lane & 15;
    LAS unsigned char* KI = lds; LAS unsigned char* VI = lds + 32768; LAS unsigned char* SF = lds + 65536; LAS unsigned char* SB = lds + 98304;
    const int rowbase = ret_rowbase(b, cc);
    const bf16_t* P = (const bf16_t*)(ws + WS_P) + (size_t)rowbase * LDP;
    const bf16_t* STf = (const bf16_t*)(ws + WS_RST) + ((size_t)(bh * 2) * RNCH + cc) * (128 * 128);
    const bf16_t* STb = STf + (size_t)RNCH * 128 * 128;
    __syncthreads();
    stage_tile128(KI, P + PC_RK + h * 128, LDP, tid); stage_tile128(VI, P + PC_RV + h * 128, LDP, tid);
    stage_tile128(SF, STf, 128, tid); stage_tile128(SB, STb, 128, tid);
    bf16x8 qf[4];
    { const bf16_t* qr = P + (size_t)(16 * w + il) * LDP + PC_RQ + h * 128 + 8 * g;
#pragma unroll
      for (int ks = 0; ks < 4; ++ks) qf[ks] = *(const bf16x8*)(qr + 32 * ks); }
    const int iloc = 16 * w + il;
    u32x2 grv[8]; f32x4 nvv[8];
    { const bf16_t* gp0 = (const bf16_t*)(ws + WS_P) + ((size_t)rowbase + iloc) * LDP + PC_RG + h * 128 + 4 * g; const float* nw0 = a.in[I_RNW] + l * 512 + h * 128 + 4 * g;
#pragma unroll
      for (int E = 0; E < 8; ++E) { grv[E] = *(const u32x2*)(gp0 + 16 * E); nvv[E] = *(const f32x4*)(nw0 + 16 * E); } }
    __syncthreads();
    const float l2g = ret_log2g(h);
    f32x4 o[8];
    { const float sf = exp2f(l2g * (float)(iloc + 1)), sb = exp2f(l2g * (float)(RCH - iloc));
#pragma unroll
      for (int E = 0; E < 8; ++E) { f32x4 rf = {0.f, 0.f, 0.f, 0.f}, rb = {0.f, 0.f, 0.f, 0.f};
#pragma unroll
          for (int ks = 0; ks < 4; ++ks) { rf = MFMA16(img_row_frag(SF, lane, E, ks), qf[ks], rf); rb = MFMA16(img_row_frag(SB, lane, E, ks), qf[ks], rb); }
          o[E] = rf * sf + rb * sb; } }
    f32x4 at[8];
#pragma unroll
    for (int T = 0; T < 8; ++T) { f32x4 c = {0.f, 0.f, 0.f, 0.f};
#pragma unroll
        for (int ks = 0; ks < 4; ++ks) c = MFMA16(img_row_frag(KI, lane, T, ks), qf[ks], c);
#pragma unroll
        for (int r = 0; r < 4; ++r) { const int j = 16 * T + 4 * g + r; const int dd = iloc > j ? iloc - j : j - iloc; c[r] *= (dd == 0 ? 2.0f : exp2f(l2g * (float)dd)); }
        at[T] = c; }
#pragma unroll
    for (int s = 0; s < 4; ++s) { const bf16x8 bfr = acc_pair_frag(at[2 * s], at[2 * s + 1]);
#pragma unroll
        for (int E = 0; E < 8; ++E) o[E] = MFMA16(img_tr_frag_acc(VI, lane, E, s), bfr, o[E]); }
    float ss = 0.f;
#pragma unroll
    for (int E = 0; E < 8; ++E) ss += (o[E].x * o[E].x + o[E].y * o[E].y) + (o[E].z * o[E].z + o[E].w * o[E].w);
    ss += __shfl_xor(ss, 16); ss += __shfl_xor(ss, 32);
    const float rn = rsqrtf(ss * (1.0f / 128.0f) + EPS);
    const size_t row = (size_t)rowbase + iloc;
    const bf16_t* gp = (const bf16_t*)(ws + WS_P) + row * LDP + PC_RG + h * 128 + 4 * g;
    const float* nw = a.in[I_RNW] + l * 512 + h * 128 + 4 * g;
    bf16_t* op = (bf16_t*)(ws + WS_H) + row * D + 1024 + h * 128 + 4 * g;
#pragma unroll
    for (int E = 0; E < 8; ++E) { const u32x2 gr = grv[E]; const f32x4 nv = nvv[E];
        u32x2 ov; ov.x = pk2(o[E].x * rn * nv.x * siluf_(bflo(gr.x)), o[E].y * rn * nv.y * siluf_(bfhi(gr.x)));
        ov.y = pk2(o[E].z * rn * nv.z * siluf_(bflo(gr.y)), o[E].w * rn * nv.w * siluf_(bfhi(gr.y)));
        *(u32x2*)(op + 16 * E) = ov; }
}
constexpr int GCH = 64, GNCH = 68;
constexpr size_t WS_GST = WS_OB + (size_t)2 * OBSZ * 2;
constexpr size_t WS_GDEC = WS_END;
constexpr size_t WS_H3B = WS_GDEC + (size_t)16 * 2 * GNCH * 64 * 4;
constexpr size_t WS_ROPE = WS_H3B + (size_t)2 * 4096 * 64 * 2;
constexpr size_t WS_TWID = WS_ROPE + (size_t)(SEQL + LC) * 64 * 8;
constexpr size_t WS_END2 = WS_TWID + 4096 * 8;
__device__ __forceinline__ int gla_rowbase(int b, int cg) { return cg < 4 ? NLAT + b * LC + cg * GCH : b * SEQL + (cg - 4) * GCH; }

constexpr int GLS = 68;
__device__ __forceinline__ void gla_gates_compute(const DArgs& a, unsigned char* ws, LAS float* BF, LAS float* BB, LAS float* GW  , int l, int h, int rowbase, int tid) {
    const int t = tid >> 3, d8 = tid & 7;
    const float* lr = (const float*)(ws + WS_LR) + (size_t)(rowbase + t) * 32;
    f32x4 lv[8];
#pragma unroll
    for (int q = 0; q < 8; ++q) lv[q] = ((const f32x4*)lr)[q];
    { const int dir = tid >> 8, r = (tid >> 4) & 15, c4 = (tid & 15) * 4;
      *(LAS f32x4*)(GW + (dir * 17 + r) * 64 + c4) = *(const f32x4*)(a.in[I_GGW] + (size_t)(l * 2 + dir) * 16 * 256 + r * 256 + h * 64 + c4);
      if (tid < 32) { const int dd = tid >> 4; *(LAS f32x4*)(GW + (dd * 17 + 16) * 64 + c4) = *(const f32x4*)(a.in[I_GGB] + (size_t)(l * 2 + dd) * 256 + h * 64 + c4); } }
    __syncthreads();
    bf16_t* GLG = (bf16_t*)(ws + WS_WIN);
#pragma unroll
    for (int dir = 0; dir < 2; ++dir) {
        const LAS float* gw = GW + dir * 17 * 64 + 8 * d8;
        f32x4 s0 = *(const LAS f32x4*)(gw + 16 * 64), s1 = *(const LAS f32x4*)(gw + 16 * 64 + 4);
#pragma unroll
        for (int j = 0; j < 16; ++j) { const float lj = lv[dir * 4 + (j >> 2)][j & 3]; s0 += lj * *(const LAS f32x4*)(gw + j * 64); s1 += lj * *(const LAS f32x4*)(gw + j * 64 + 4); }
        LAS float* dst = (dir ? BB : BF) + t * GLS + 8 * d8;
        float la[8];
#pragma unroll
        for (int x = 0; x < 8; ++x) { const float s = x < 4 ? s0[x] : s1[x - 4]; const float e = __expf(-fabsf(s)); const float ls = fminf(s, 0.f) - __logf(1.0f + e); la[x] = ls * (1.0f / 16.0f); }
        const u32x4 pk = pack8(la);
        *(u32x4*)(GLG + ((size_t)dir * MR + rowbase + t) * 256 + h * 64 + 8 * d8) = pk;
        float lq[8]; unpack8(pk, lq);
        *(LAS f32x4*)dst = (f32x4){lq[0], lq[1], lq[2], lq[3]}; *(LAS f32x4*)(dst + 4) = (f32x4){lq[4], lq[5], lq[6], lq[7]};
    }
}
__device__ __forceinline__ void gla_gates_load(unsigned char* ws, LAS float* BF, LAS float* BB, int h, int rowbase, int tid) {
    const int t = tid >> 3, d8 = tid & 7;
    const bf16_t* GLG = (const bf16_t*)(ws + WS_WIN);
#pragma unroll
    for (int dir = 0; dir < 2; ++dir) { float lq[8]; unpack8(*(const u32x4*)(GLG + ((size_t)dir * MR + rowbase + t) * 256 + h * 64 + 8 * d8), lq);
        LAS float* dst = (dir ? BB : BF) + t * GLS + 8 * d8;
        *(LAS f32x4*)dst = (f32x4){lq[0], lq[1], lq[2], lq[3]}; *(LAS f32x4*)(dst + 4) = (f32x4){lq[4], lq[5], lq[6], lq[7]}; }
}
__device__ __forceinline__ void gla_scan(LAS float* BF, LAS float* BB, int tid) {
    const int lane = tid & 63, w = tid >> 6;
    __syncthreads();
#pragma unroll 4
    for (int c = 0; c < 16; ++c) { const int col = 16 * w + c; const int dir = col >> 6, d = col & 63;
        LAS float* p = (dir ? BB : BF) + (dir ? 63 - lane : lane) * GLS + d;
        float v = *p;
#pragma unroll
        for (int off = 1; off < 64; off <<= 1) { const float u = __shfl_up(v, off); if (lane >= off) v += u; }
        *p = v; }
    __syncthreads();
}

__device__ __forceinline__ void gla_passA(const DArgs& a, unsigned char* ws, LAS unsigned char* lds, int l, int item, int tid) {
    const int bh = item / GNCH, cg = item % GNCH, b = bh >> 2, h = bh & 3;
    const int lane = tid & 63, w = tid >> 6, g = lane >> 4;
    LAS float* BF = (LAS float*)lds; LAS float* BB = (LAS float*)(lds + 17408); LAS unsigned char* KH = lds + 34816; LAS unsigned char* VI = lds + 34816 + 16384;
    const int rowbase = gla_rowbase(b, cg);
    const bf16_t* P = (const bf16_t*)(ws + WS_P) + (size_t)rowbase * LDP;
    const int t = tid >> 3, d8 = tid & 7;
    const u32x4 kraw = *(const u32x4*)(P + (size_t)t * LDP + PC_GK + h * 64 + 8 * d8);
    u32x4 vraw[2];
#pragma unroll
    for (int i = 0; i < 2; ++i) { const int n = tid + NT * i; vraw[i] = *(const u32x4*)(P + (size_t)(n >> 4) * LDP + PC_GV + h * 128 + (n & 15) * 8); }
    gla_gates_compute(a, ws, BF, BB, (LAS float*)(lds + 34816 + 32768), l, h, rowbase, tid);
    gla_scan(BF, BB, tid);
    { float kf[8], x0[8], x1[8]; unpack8(kraw, kf);
#pragma unroll
      for (int x = 0; x < 8; ++x) { const int d = 8 * d8 + x; x0[x] = kf[x] * __expf(BF[63 * GLS + d] - BF[t * GLS + d]); x1[x] = kf[x] * __expf(BB[d] - BB[t * GLS + d]); }
      *(LAS u32x4*)(KH + off_b(t, d8)) = pack8(x0); *(LAS u32x4*)(KH + off_b(t, 8 + d8)) = pack8(x1);
#pragma unroll
      for (int i = 0; i < 2; ++i) { const int n = tid + NT * i; *(LAS u32x4*)(VI + off_b(n >> 4, n & 15)) = vraw[i]; }
      if (tid < 128) { const int dir = tid >> 6, d = tid & 63; ((float*)(ws + WS_GDEC))[((size_t)(bh * 2 + dir) * GNCH + cg) * 64 + d] = __expf(dir ? BB[d] : BF[63 * GLS + d]); } }
    __syncthreads();
    const int dir = w >> 2, Dt = w & 3;
    bf16x8 af[2];
#pragma unroll
    for (int ks = 0; ks < 2; ++ks) af[ks] = img_tr_frag(KH, lane, dir * 4 + Dt, ks);
    bf16_t* ST = (bf16_t*)(ws + WS_GST) + ((size_t)(bh * 2 + dir) * GNCH + cg) * (128 * 64);
#pragma unroll 2
    for (int E = 0; E < 8; ++E) {
        f32x4 c = {0.f, 0.f, 0.f, 0.f};
#pragma unroll
        for (int ks = 0; ks < 2; ++ks) c = MFMA16(af[ks], img_tr_frag(VI, lane, E, ks), c);
        u32x2 o; o.x = pk2(c.x, c.y); o.y = pk2(c.z, c.w);
        *(u32x2*)(ST + (size_t)(16 * E + (lane & 15)) * 64 + 16 * Dt + 4 * g) = o;
    }
}
__device__ __forceinline__ void gla_passB(unsigned char* ws, LAS unsigned char* lds, int blk, int tid) {
    const int bd = blk >> 1, dir = bd & 1, el = (blk & 1) * 512 + tid;
    LAS float* decs = (LAS float*)lds;
    { const float* dsrc = (const float*)(ws + WS_GDEC) + (size_t)bd * GNCH * 64;
      for (int i = tid; i < GNCH * 64; i += NT) decs[i] = dsrc[i]; }
    __syncthreads();
    bf16_t* base = (bf16_t*)(ws + WS_GST) + (size_t)bd * GNCH * (128 * 64) + (size_t)el * 8;
    const int d0 = (el & 7) * 8;
    float acc[8];
#pragma unroll
    for (int x = 0; x < 8; ++x) acc[x] = 0.f;
#pragma unroll 1
    for (int s0 = 0; s0 < GNCH; s0 += 17) {
        u32x4 kvr[17];
#pragma unroll
        for (int j = 0; j < 17; ++j) { const int s = s0 + j; const int cg = dir == 0 ? s : (s < 4 ? 3 - s : 71 - s); kvr[j] = *(const u32x4*)(base + (size_t)cg * (128 * 64)); }
#pragma unroll
        for (int j = 0; j < 17; ++j) { const int s = s0 + j; const int cg = dir == 0 ? s : (s < 4 ? 3 - s : 71 - s);
            float kv[8]; unpack8(kvr[j], kv);
            const f32x4 q0 = *(const LAS f32x4*)(decs + cg * 64 + d0), q1 = *(const LAS f32x4*)(decs + cg * 64 + d0 + 4);
            *(u32x4*)(base + (size_t)cg * (128 * 64)) = pack8(acc);
#pragma unroll
            for (int x = 0; x < 8; ++x) acc[x] = (x < 4 ? q0[x] : q1[x - 4]) * acc[x] + kv[x]; }
    }
    __syncthreads();
}
__device__ __forceinline__ void gla_passC(const DArgs& a, unsigned char* ws, LAS unsigned char* lds, int l, int item, int tid) {
    const int bh = item / GNCH, cg = item % GNCH, b = bh >> 2, h = bh & 3;
    const int lane = tid & 63, w = tid >> 6, g = lane >> 4, il = lane & 15;
    LAS float* BF = (LAS float*)lds; LAS float* BB = (LAS float*)(lds + 17408);
    LAS unsigned char* QKF = lds + 34816; LAS unsigned char* QKB = QKF + 16384; LAS unsigned char* QH = QKB + 16384; LAS unsigned char* VI = QH + 16384; LAS unsigned char* SI = VI + 16384;
    const int rowbase = gla_rowbase(b, cg);
    const bf16_t* P = (const bf16_t*)(ws + WS_P) + (size_t)rowbase * LDP;
    const int t = tid >> 3, d8 = tid & 7;
    const u32x4 qraw = *(const u32x4*)(P + (size_t)t * LDP + PC_GQ + h * 64 + 8 * d8), kraw = *(const u32x4*)(P + (size_t)t * LDP + PC_GK + h * 64 + 8 * d8);
    u32x4 vraw[2], sraw[4];
#pragma unroll
    for (int i = 0; i < 2; ++i) { const int n = tid + NT * i; vraw[i] = *(const u32x4*)(P + (size_t)(n >> 4) * LDP + PC_GV + h * 128 + (n & 15) * 8); }
    { const bf16_t* STf = (const bf16_t*)(ws + WS_GST) + ((size_t)(bh * 2) * GNCH + cg) * (128 * 64); const bf16_t* STb = STf + (size_t)GNCH * 128 * 64;
#pragma unroll
      for (int i = 0; i < 4; ++i) { const int n = tid + NT * i, row = n >> 4, ch = n & 15; sraw[i] = *(const u32x4*)((ch < 8 ? STf : STb) + (size_t)row * 64 + (ch & 7) * 8); } }
    gla_gates_load(ws, BF, BB, h, rowbase, tid);
    gla_scan(BF, BB, tid);
    { float qf[8], kf[8], o0[8], o1[8], o2[8], o3[8], o4[8], o5[8];
      unpack8(qraw, qf); unpack8(kraw, kf);
#pragma unroll
      for (int x = 0; x < 8; ++x) { const int d = 8 * d8 + x; const float bf = BF[t * GLS + d], bb = BB[t * GLS + d], rf = BF[31 * GLS + d], rb = BB[32 * GLS + d]; const float q = qf[x] * 0.125f;
          o0[x] = q * __expf(bf - rf); o1[x] = kf[x] * __expf(rf - bf); o2[x] = q * __expf(bb - rb); o3[x] = kf[x] * __expf(rb - bb); o4[x] = q * __expf(bf); o5[x] = q * __expf(bb); }
      *(LAS u32x4*)(QKF + off_b(t, d8)) = pack8(o0); *(LAS u32x4*)(QKF + off_b(t, 8 + d8)) = pack8(o1);
      *(LAS u32x4*)(QKB + off_b(t, d8)) = pack8(o2); *(LAS u32x4*)(QKB + off_b(t, 8 + d8)) = pack8(o3);
      *(LAS u32x4*)(QH + off_b(t, d8)) = pack8(o4); *(LAS u32x4*)(QH + off_b(t, 8 + d8)) = pack8(o5);
#pragma unroll
      for (int i = 0; i < 2; ++i) { const int n = tid + NT * i; *(LAS u32x4*)(VI + off_b(n >> 4, n & 15)) = vraw[i]; }
#pragma unroll
      for (int i = 0; i < 4; ++i) { const int n = tid + NT * i; *(LAS u32x4*)(SI + off_b(n >> 4, n & 15)) = sraw[i]; } }
    const int ib = w & 3, eh = w >> 2, iloc = 16 * ib + il;
    u32x2 grv[4]; f32x4 nvv[4];
    { const bf16_t* gp0 = (const bf16_t*)(ws + WS_P) + ((size_t)rowbase + iloc) * LDP + PC_GG + h * 128 + 64 * eh + 4 * g; const float* nw0 = a.in[I_GNW] + l * 512 + h * 128 + 64 * eh + 4 * g;
#pragma unroll
      for (int E4 = 0; E4 < 4; ++E4) { grv[E4] = *(const u32x2*)(gp0 + 16 * E4); nvv[E4] = *(const f32x4*)(nw0 + 16 * E4); } }
    __syncthreads();
    f32x4 at[4];
    { bf16x8 qff[2], qfb[2];
#pragma unroll
      for (int ks = 0; ks < 2; ++ks) { qff[ks] = img_row_frag(QKF, lane, ib, ks); qfb[ks] = img_row_frag(QKB, lane, ib, ks); }
#pragma unroll
      for (int T = 0; T < 4; ++T) { f32x4 cf = {0.f, 0.f, 0.f, 0.f}, cb = {0.f, 0.f, 0.f, 0.f};
#pragma unroll
          for (int ks = 0; ks < 2; ++ks) { cf = MFMA16(img_row_frag(QKF, lane, T, 2 + ks), qff[ks], cf); cb = MFMA16(img_row_frag(QKB, lane, T, 2 + ks), qfb[ks], cb); }
#pragma unroll
          for (int r = 0; r < 4; ++r) { const int j = 16 * T + 4 * g + r; cf[r] = (j <= iloc ? cf[r] : 0.f) + (j >= iloc ? cb[r] : 0.f); }
          at[T] = cf; } }
    f32x4 o[4];
    { bf16x8 hf[2], hb[2];
#pragma unroll
      for (int ks = 0; ks < 2; ++ks) { hf[ks] = img_row_frag(QH, lane, ib, ks); hb[ks] = img_row_frag(QH, lane, ib, 2 + ks); }
#pragma unroll
      for (int E4 = 0; E4 < 4; ++E4) { const int E = 4 * eh + E4; f32x4 c = {0.f, 0.f, 0.f, 0.f};
#pragma unroll
          for (int ks = 0; ks < 2; ++ks) { c = MFMA16(img_row_frag(SI, lane, E, ks), hf[ks], c); c = MFMA16(img_row_frag(SI, lane, E, 2 + ks), hb[ks], c); }
          o[E4] = c; } }
#pragma unroll
    for (int s = 0; s < 2; ++s) { const bf16x8 bfr = acc_pair_frag(at[2 * s], at[2 * s + 1]);
#pragma unroll
        for (int E4 = 0; E4 < 4; ++E4) o[E4] = MFMA16(img_tr_frag_acc(VI, lane, 4 * eh + E4, s), bfr, o[E4]); }
    float ss = 0.f;
#pragma unroll
    for (int E4 = 0; E4 < 4; ++E4) ss += (o[E4].x * o[E4].x + o[E4].y * o[E4].y) + (o[E4].z * o[E4].z + o[E4].w * o[E4].w);
    ss += __shfl_xor(ss, 16); ss += __shfl_xor(ss, 32);
    LAS float* red = (LAS float*)lds;
    if (g == 0) red[eh * 64 + iloc] = ss;
    __syncthreads();
    const float rn = rsqrtf((red[iloc] + red[64 + iloc]) * (1.0f / 128.0f) + EPS);
    const size_t row = (size_t)rowbase + iloc;
    const bf16_t* gp = (const bf16_t*)(ws + WS_P) + row * LDP + PC_GG + h * 128 + 64 * eh + 4 * g;
    const float* nw = a.in[I_GNW] + l * 512 + h * 128 + 64 * eh + 4 * g;
    bf16_t* op = (bf16_t*)(ws + WS_H) + row * D + 1536 + h * 128 + 64 * eh + 4 * g;
#pragma unroll
    for (int E4 = 0; E4 < 4; ++E4) { const u32x2 gr = grv[E4]; const f32x4 nv = nvv[E4];
        u32x2 ov; ov.x = pk2(o[E4].x * rn * nv.x * siluf_(bflo(gr.x)), o[E4].y * rn * nv.y * siluf_(bfhi(gr.x)));
        ov.y = pk2(o[E4].z * rn * nv.z * siluf_(bflo(gr.y)), o[E4].w * rn * nv.w * siluf_(bfhi(gr.y)));
        *(u32x2*)(op + 16 * E4) = ov; }
}
constexpr int SNCH = 68;
constexpr size_t WS_S5ST = WS_OB + (size_t)4 * OBSZ * 2;
constexpr size_t WS_S5BTB = WS_S5BT;
constexpr size_t WS_S5CPB = WS_S5BT + 524288;
constexpr size_t WS_S5A64 = WS_S5BT + 1048576;

__device__ __forceinline__ void prep_s5b(const DArgs& a, unsigned char* ws, int it, int tid) {
    const int idx = it * 512 + tid;
    const int gi = idx >> 6, p = idx & 63;
    const float a_re = a.in[I_S5ARE][idx], a_im = a.in[I_S5AIM][idx], ldt = a.in[I_S5LDT][gi];
    const float dt = expf(ldt), mag = expf(a_re * dt);
    float sn, cs; sincosf(a_im * dt, &sn, &cs);
    const float ab_re = mag * cs, ab_im = mag * sn, den = a_re * a_re + a_im * a_im, nr = ab_re - 1.0f;
    const float co_re = (nr * a_re + ab_im * a_im) / den, co_im = (ab_im * a_re - nr * a_im) / den;
    ((f32x2*)(ws + WS_S5AB))[idx] = (f32x2){ab_re, ab_im};
    float pr = ab_re, pi = ab_im;
#pragma unroll
    for (int q = 0; q < 6; ++q) { const float nr2 = pr * pr - pi * pi, ni2 = 2.0f * pr * pi; pr = nr2; pi = ni2; }
    ((f32x2*)(ws + WS_S5A64))[idx] = (f32x2){pr, pi};
    const float* bre = a.in[I_S5BRE] + (size_t)idx * 16; const float* bim = a.in[I_S5BIM] + (size_t)idx * 16;
    float tr[16], ti[16];
#pragma unroll
    for (int i = 0; i < 16; ++i) { const float br = bre[i], bi = bim[i]; tr[i] = co_re * br - co_im * bi; ti[i] = co_re * bi + co_im * br; }
    bf16_t* btb = (bf16_t*)(ws + WS_S5BTB) + (size_t)gi * 128 * 16;
#pragma unroll
    for (int hlf = 0; hlf < 2; ++hlf) { u32x4 w0, w1; const float* s = hlf ? ti : tr;
        w0.x = pk2(s[0], s[1]); w0.y = pk2(s[2], s[3]); w0.z = pk2(s[4], s[5]); w0.w = pk2(s[6], s[7]); w1.x = pk2(s[8], s[9]); w1.y = pk2(s[10], s[11]); w1.z = pk2(s[12], s[13]); w1.w = pk2(s[14], s[15]);
        *(u32x4*)(btb + (size_t)(64 * hlf + p) * 16) = w0; *(u32x4*)(btb + (size_t)(64 * hlf + p) * 16 + 8) = w1; }
    bf16_t* cpb = (bf16_t*)(ws + WS_S5CPB) + (size_t)gi * 16 * 128;
    const float* cre = a.in[I_S5CRE] + (size_t)gi * 1024; const float* cim = a.in[I_S5CIM] + (size_t)gi * 1024;
#pragma unroll
    for (int i = 0; i < 16; ++i) *(unsigned*)(cpb + i * 128 + 2 * p) = pk2(cre[i * 64 + p], -cim[i * 64 + p]);
}

struct S5Unit { bf16x8 btf[8]; f32x2 ab; f32x2 h; const bf16_t* cp; };
template <bool PASSC> __device__ __forceinline__ void s5_load_unit(S5Unit& U, unsigned char* ws, const bf16_t* P, const f32x2* ST, int l, int b, int cs, int rowbase, int grp, int dir, int lane) {
    const int g = lane >> 4, il = lane & 15;
    const bf16x8 zero8 = {0, 0, 0, 0, 0, 0, 0, 0};
    const int gi = (l * 2 + dir) * 32 + grp;
    U.ab = ((const f32x2*)(ws + WS_S5AB))[gi * 64 + lane];
    const size_t sidx = ((size_t)(b * SNCH + cs) * 2 + dir) * 2048 + grp * 64 + lane;
    U.h = PASSC ? ST[sidx] : (f32x2){0.f, 0.f};
    const bf16_t* bt = (const bf16_t*)(ws + WS_S5BTB) + (size_t)gi * 128 * 16 + (size_t)il * 16 + 8 * (g & 1);
#pragma unroll
    for (int Pt = 0; Pt < 8; ++Pt) { const bf16x8 v = *(const bf16x8*)(bt + Pt * 256); U.btf[Pt] = g < 2 ? v : zero8; }
    U.cp = (const bf16_t*)(ws + WS_S5CPB) + (size_t)gi * 16 * 128 + (size_t)il * 128 + 8 * g;
}
__device__ __forceinline__ void s5_load_u(bf16x8 (&ufa)[4], const bf16_t* P, int rowbase, int grp, int lane) {
    const int g = lane >> 4, il = lane & 15; const bf16x8 zero8 = {0, 0, 0, 0, 0, 0, 0, 0};
#pragma unroll
    for (int Tt = 0; Tt < 4; ++Tt) { const bf16x8 v = *(const bf16x8*)(P + (size_t)(rowbase + 16 * Tt + il) * LDP + PC_S5U + grp * 16 + 8 * (g & 1)); ufa[Tt] = g < 2 ? v : zero8; }
}
template <bool PASSC, int DIR> __device__ __forceinline__ void s5_run_unit(const S5Unit& U, const bf16x8 (&ufa)[4], f32x4 (&yacc)[4], f32x2& hout, LAS float* BU, LAS unsigned char* HW, int lane) {
    const int g = lane >> 4, il = lane & 15;
    f32x2 h = U.h; const f32x2 ab = U.ab;
    bf16x8 cpf[4];
    if (PASSC) {
#pragma unroll
        for (int ks = 0; ks < 4; ++ks) cpf[ks] = *(const bf16x8*)(U.cp + 32 * ks); }
    f32x4 d[8];
#pragma unroll
    for (int Pt = 0; Pt < 8; ++Pt) d[Pt] = MFMA16(U.btf[Pt], ufa[DIR ? 3 : 0], ((f32x4){0.f, 0.f, 0.f, 0.f}));
#pragma unroll
    for (int wi = 0; wi < 4; ++wi) {
        const int Tt = DIR ? 3 - wi : wi;
#pragma unroll
        for (int Pt = 0; Pt < 8; ++Pt) {
#pragma unroll
            for (int r = 0; r < 4; ++r) BU[(16 * Pt + 4 * g + r) * 20 + il] = d[Pt][r]; }
        asm volatile("" ::: "memory");
        if (!PASSC) {
            f32x4 br[4], bi[4];
#pragma unroll
            for (int q = 0; q < 4; ++q) { br[q] = *(const LAS f32x4*)(BU + lane * 20 + 4 * q); bi[q] = *(const LAS f32x4*)(BU + (64 + lane) * 20 + 4 * q); }
            if (wi < 3) {
#pragma unroll
                for (int Pt = 0; Pt < 8; ++Pt) d[Pt] = MFMA16(U.btf[Pt], ufa[DIR ? 2 - wi : wi + 1], ((f32x4){0.f, 0.f, 0.f, 0.f})); }
#pragma unroll
            for (int s = 0; s < 16; ++s) { const int tt = DIR ? 15 - s : s;
                const float hr = __builtin_fmaf(ab.x, h.x, __builtin_fmaf(-ab.y, h.y, br[tt >> 2][tt & 3])), hi = __builtin_fmaf(ab.x, h.y, __builtin_fmaf(ab.y, h.x, bi[tt >> 2][tt & 3]));
                h = (f32x2){hr, hi}; }
        } else {
#pragma unroll
            for (int hf2 = 0; hf2 < 2; ++hf2) { const int q0 = DIR ? 2 - 2 * hf2 : 2 * hf2;
                f32x4 br[2], bi[2];
#pragma unroll
                for (int q = 0; q < 2; ++q) { br[q] = *(const LAS f32x4*)(BU + lane * 20 + 4 * (q0 + q)); bi[q] = *(const LAS f32x4*)(BU + (64 + lane) * 20 + 4 * (q0 + q)); }
#pragma unroll
                for (int s = 0; s < 8; ++s) { const int t8 = DIR ? 7 - s : s; const int tt = 4 * q0 + t8;
                    const float hr = __builtin_fmaf(ab.x, h.x, __builtin_fmaf(-ab.y, h.y, br[t8 >> 2][t8 & 3])), hi = __builtin_fmaf(ab.x, h.y, __builtin_fmaf(ab.y, h.x, bi[t8 >> 2][t8 & 3]));
                    h = (f32x2){hr, hi};
                    *(LAS unsigned*)(HW + off_b(tt, lane >> 2) + (lane & 3) * 4) = pk2(hr, hi); }
            }
        }
        asm volatile("" ::: "memory");
        if (PASSC) {
            bf16x8 hf[4];
#pragma unroll
            for (int ks = 0; ks < 4; ++ks) hf[ks] = img_row_frag(HW, lane, 0, ks);
#pragma unroll
            for (int ks = 0; ks < 4; ++ks) yacc[Tt] = MFMA16(cpf[ks], hf[ks], yacc[Tt]);
            }
        asm volatile("" ::: "memory");
        if (PASSC && wi < 3) {
#pragma unroll
            for (int Pt = 0; Pt < 8; ++Pt) d[Pt] = MFMA16(U.btf[Pt], ufa[DIR ? 2 - wi : wi + 1], ((f32x4){0.f, 0.f, 0.f, 0.f})); }
    }
    hout = h;
}
template <bool PASSC> __device__ __forceinline__ void s5_item(const DArgs& a, unsigned char* ws, LAS unsigned char* lds, int l, int item, int ggsel, int tid) {
    const int b = item / (SNCH * 2), rem = item % (SNCH * 2), cs = rem >> 1, half = rem & 1;
    const int lane = tid & 63, w = tid >> 6, g = lane >> 4, il = lane & 15;
    const int rowbase = gla_rowbase(b, cs);
    LAS float* BU = (LAS float*)(lds + w * 14336); LAS unsigned char* HW = lds + w * 14336 + 10240;
    const bf16_t* P = (const bf16_t*)(ws + WS_P);
    f32x2* ST = (f32x2*)(ws + WS_S5ST);
    const int grp0 = 16 * half + w, grp1 = grp0 + 8;
    S5Unit UA; bf16x8 ufa[4];
    { const int gg = ggsel;
        const int grp = gg ? grp1 : grp0;
        f32x4 yacc[4];
#pragma unroll
        for (int q = 0; q < 4; ++q) yacc[q] = (f32x4){0.f, 0.f, 0.f, 0.f};
        f32x2 hend;
        u32x2 urv[4], sgv[4]; f32x4 dskv = {0.f, 0.f, 0.f, 0.f};
        if (PASSC) { dskv = *(const f32x4*)(a.in[I_S5D] + l * 512 + grp * 16 + 4 * g);
#pragma unroll
            for (int Tt = 0; Tt < 4; ++Tt) { const size_t row = (size_t)rowbase + 16 * Tt + il; urv[Tt] = *(const u32x2*)(P + row * LDP + PC_S5U + grp * 16 + 4 * g); sgv[Tt] = *(const u32x2*)(P + row * LDP + PC_S5G + grp * 16 + 4 * g); } }
        s5_load_unit<PASSC>(UA, ws, P, ST, l, b, cs, rowbase, grp, 0, lane); s5_load_u(ufa, P, rowbase, grp, lane);
        s5_run_unit<PASSC, 0>(UA, ufa, yacc, hend, BU, HW, lane);
        if (!PASSC) ST[((size_t)(b * SNCH + cs) * 2 + 0) * 2048 + grp * 64 + lane] = hend;
        s5_load_unit<PASSC>(UA, ws, P, ST, l, b, cs, rowbase, grp, 1, lane);
        s5_run_unit<PASSC, 1>(UA, ufa, yacc, hend, BU, HW, lane);
        if (!PASSC) ST[((size_t)(b * SNCH + cs) * 2 + 1) * 2048 + grp * 64 + lane] = hend;
        if (PASSC) {
            const f32x4 dsk = dskv;
            bf16_t* G5 = (bf16_t*)(ws + WS_KF);
#pragma unroll
            for (int Tt = 0; Tt < 4; ++Tt) { const size_t row = (size_t)rowbase + 16 * Tt + il;
                const u32x2 ur = urv[Tt], sg = sgv[Tt];
                const float g0 = gelu_tanh(yacc[Tt].x + bflo(ur.x) * dsk.x), g1 = gelu_tanh(yacc[Tt].y + bfhi(ur.x) * dsk.y), g2 = gelu_tanh(yacc[Tt].z + bflo(ur.y) * dsk.z), g3 = gelu_tanh(yacc[Tt].w + bfhi(ur.y) * dsk.w);
                u32x2 ov; ov.x = pk2(g0, g1); ov.y = pk2(g2, g3);
                *(u32x2*)(G5 + row * 512 + grp * 16 + 4 * g) = ov;
                ov.x = pk2(g0 * siluf_(bflo(sg.x)), g1 * siluf_(bfhi(sg.x))); ov.y = pk2(g2 * siluf_(bflo(sg.y)), g3 * siluf_(bfhi(sg.y)));
                *(u32x2*)(G5 + OBSZ + row * 512 + grp * 16 + 4 * g) = ov; }
        }
    }
}
__device__ __forceinline__ void s5_passB(unsigned char* ws, int l, int gt) {
    const int p = gt & 63, grp = (gt >> 6) & 31, dir = (gt >> 11) & 1, b = gt >> 12;
    const f32x2 a64 = ((const f32x2*)(ws + WS_S5A64))[((l * 2 + dir) * 32 + grp) * 64 + p];
    f32x2* ST = (f32x2*)(ws + WS_S5ST);
    f32x2 acc = {0.f, 0.f};
#pragma unroll 1
    for (int s0 = 0; s0 < SNCH; s0 += 34) {
        f32x2 ev[34];
#pragma unroll
        for (int j = 0; j < 34; ++j) { const int s = s0 + j; const int cs = dir == 0 ? s : (s < 4 ? 3 - s : 71 - s); ev[j] = ST[((size_t)(b * SNCH + cs) * 2 + dir) * 2048 + grp * 64 + p]; }
#pragma unroll
        for (int j = 0; j < 34; ++j) { const int s = s0 + j; const int cs = dir == 0 ? s : (s < 4 ? 3 - s : 71 - s);
            ST[((size_t)(b * SNCH + cs) * 2 + dir) * 2048 + grp * 64 + p] = acc;
            acc = (f32x2){a64.x * acc.x - a64.y * acc.y + ev[j].x, a64.x * acc.y + a64.y * acc.x + ev[j].y}; }
    }
}
constexpr int FFT_PHYS = 8448;
__device__ __forceinline__ void fft_twiddles_g(LAS f32x2* W, const f32x2* Wg, int tid) {
#pragma unroll
    for (int j = 0; j < 8; ++j) W[tid + NT * j] = Wg[tid + NT * j];
}
__device__ __forceinline__ int fphys(int i) { return i + (i >> 5); }
__device__ __forceinline__ f32x2 cmulf(const f32x2 a, const f32x2 b) { return (f32x2){a.x * b.x - a.y * b.y, a.x * b.y + a.y * b.x}; }
__device__ __forceinline__ f32x2 cmulcf(const f32x2 a, const f32x2 b) { return (f32x2){a.x * b.x + a.y * b.y, a.y * b.x - a.x * b.y}; }
template <int RL> __device__ __forceinline__ void dft_fwd_const(f32x2 (&e)[1 << RL]) {
#pragma unroll
    for (int s = 0; s < RL; ++s) { const int h = 1 << (RL - 1 - s);
#pragma unroll
        for (int m = 0; m < (1 << RL); ++m) { if (m & h) continue;
            const int mp = m & (h - 1); const f32x2 a_ = e[m], b_ = e[m | h]; const f32x2 d = a_ - b_; e[m] = a_ + b_;
            if (mp == 0) e[m | h] = d;
            else if (2 * mp == h) e[m | h] = (f32x2){d.y, -d.x};
            else { const float ang = -3.14159265358979323846f * (float)mp / (float)h; const f32x2 c = {__builtin_cosf(ang), __builtin_sinf(ang)}; e[m | h] = cmulf(d, c); } } }
}
template <int RL> __device__ __forceinline__ void dft_inv_const(f32x2 (&e)[1 << RL]) {
#pragma unroll
    for (int ss = 0; ss < RL; ++ss) { const int s = RL - 1 - ss; const int h = 1 << (RL - 1 - s);
#pragma unroll
        for (int m = 0; m < (1 << RL); ++m) { if (m & h) continue;
            const int mp = m & (h - 1); const f32x2 a_ = e[m], b_ = e[m | h]; f32x2 t;
            if (mp == 0) t = b_;
            else if (2 * mp == h) t = (f32x2){-b_.y, b_.x};
            else { const float ang = -3.14159265358979323846f * (float)mp / (float)h; const f32x2 c = {__builtin_cosf(ang), __builtin_sinf(ang)}; t = cmulcf(b_, c); }
            e[m] = a_ + t; e[m | h] = a_ - t; } }
}
template <int RL> __device__ __forceinline__ constexpr int brev_c(int m) { int r = 0; for (int i = 0; i < RL; ++i) r |= ((m >> i) & 1) << (RL - 1 - i); return r; }
template <int RL, bool CONJ> __device__ __forceinline__ void apply_tw(f32x2 (&e)[1 << RL], const f32x2 w1) {
    f32x2 tw[1 << RL];
    tw[0] = (f32x2){1.f, 0.f}; tw[1] = w1;
    if (RL >= 2) { tw[2] = cmulf(w1, w1); tw[3] = cmulf(tw[2], w1); }
    if (RL >= 3) { tw[4] = cmulf(tw[2], tw[2]); tw[5] = cmulf(tw[4], tw[1]); tw[6] = cmulf(tw[4], tw[2]); tw[7] = cmulf(tw[4], tw[3]); }
    if (RL >= 4) { tw[8] = cmulf(tw[4], tw[4]);
#pragma unroll
        for (int k = 1; k < 8; ++k) tw[8 + k] = cmulf(tw[8], tw[k]); }
#pragma unroll
    for (int m = 1; m < (1 << RL); ++m) e[m] = CONJ ? cmulcf(e[m], tw[brev_c<RL>(m)]) : cmulf(e[m], tw[brev_c<RL>(m)]);
}
template <int RL, int BETA, bool INV, class WP> __device__ __forceinline__ void fft2_pass(LAS f32x2* X, WP W, int tid) {
    constexpr int LOW = BETA - RL + 1, NG = FFTN >> RL, STR = (1 << LOW) + (1 << (LOW - 5));
#pragma unroll 1
    for (int gi = tid; gi < NG; gi += NT) {
        const int base = ((gi >> LOW) << (BETA + 1)) | (gi & ((1 << LOW) - 1));
        volatile LAS f32x2* p = X + fphys(base);
        f32x2 e[1 << RL];
#pragma unroll
        for (int m = 0; m < (1 << RL); ++m) e[m] = p[m * STR];
        const f32x2 w1 = W[(base & ((1 << LOW) - 1)) << (12 - BETA)];
        if (!INV) { dft_fwd_const<RL>(e); apply_tw<RL, false>(e, w1); }
        else { apply_tw<RL, true>(e, w1); dft_inv_const<RL>(e); }
#pragma unroll
        for (int m = 0; m < (1 << RL); ++m) p[m * STR] = e[m];
    }
}
template <class WP> __device__ __forceinline__ void fft2_fwd_ABC(LAS f32x2* X, WP W, int tid) {
    fft2_pass<4, 12, false>(X, W, tid); __syncthreads(); fft2_pass<4, 8, false>(X, W, tid); __syncthreads();
}
template <class WP> __device__ __forceinline__ void fft2_inv_CBA(LAS f32x2* X, WP W, int tid) {
    fft2_pass<4, 8, true>(X, W, tid); __syncthreads(); fft2_pass<4, 12, true>(X, W, tid); __syncthreads();
}
__device__ __forceinline__ void fft2_mid_mul(LAS f32x2* X, const f32x2* KF, int tid) {
    if (tid < 256) {
        volatile LAS f32x2* p = X + 33 * tid;
        f32x2 e[32];
#pragma unroll
        for (int m = 0; m < 32; ++m) e[m] = p[m];
        dft_fwd_const<5>(e);
#pragma unroll
        for (int q4 = 0; q4 < 4; ++q4) { f32x4 kf[4];
#pragma unroll
            for (int q = 0; q < 4; ++q) kf[q] = *(const f32x4*)(KF + 32 * tid + 8 * q4 + 2 * q);
#pragma unroll
            for (int q = 0; q < 4; ++q) { const int m = 8 * q4 + 2 * q; e[m] = cmulf(e[m], (f32x2){kf[q].x, kf[q].y}); e[m + 1] = cmulf(e[m + 1], (f32x2){kf[q].z, kf[q].w}); } }
        dft_inv_const<5>(e);
#pragma unroll
        for (int m = 0; m < 32; ++m) p[m] = e[m];
    }
}
__device__ __forceinline__ void fft2_fwd_D(LAS f32x2* X, int tid) {
    if (tid < 256) { volatile LAS f32x2* p = X + 33 * tid; f32x2 e[32];
#pragma unroll
        for (int m = 0; m < 32; ++m) e[m] = p[m];
        dft_fwd_const<5>(e);
#pragma unroll
        for (int m = 0; m < 32; ++m) p[m] = e[m]; }
}

__device__ __forceinline__ void filt_item2(const DArgs& a, unsigned char* ws, LAS unsigned char* lds, int l, int c0, int tid) {
    LAS f32x2* X = (LAS f32x2*)lds; LAS f32x2* X2 = (LAS f32x2*)(lds + FFT_PHYS * 8); LAS float* red = (LAS float*)(lds + 2 * FFT_PHYS * 8);
    const f32x2* Wg = (const f32x2*)(ws + WS_TWID);
    const int lane = tid & 63, w = tid >> 6, fr = lane & 15, fq = lane >> 4;
    const int cmine = c0 + 256 * (fq & 1);
    bf16x8 af[2];
    { float wv[16];
      const int cc = fr & 3, ca = c0 + 256 * ((fr >> 2) & 1);
      const float* wsrc = a.in[I_HW4] + (size_t)l * 64 * 2048 + (cc >> 1) * 1024 + (cc & 1) * 512 + ca;
#pragma unroll
      for (int q = 0; q < 16; ++q) wv[q] = fr < 8 ? wsrc[(size_t)(32 * (q >> 3) + 8 * fq + (q & 7)) * 2048] : 0.f;
#pragma unroll
      for (int ks = 0; ks < 2; ++ks) { u32x4 pw; pw.x = pk2(wv[8 * ks], wv[8 * ks + 1]); pw.y = pk2(wv[8 * ks + 2], wv[8 * ks + 3]); pw.z = pk2(wv[8 * ks + 4], wv[8 * ks + 5]); pw.w = pk2(wv[8 * ks + 6], wv[8 * ks + 7]); af[ks] = __builtin_bit_cast(bf16x8, pw); } }
    if (tid < 2) { float z0; asm volatile("v_mov_b32 %0, 0" : "=v"(z0)); (tid ? X2 : X)[fphys(4096)] = (f32x2){z0, z0}; }
    const float dl = fabsf(HY_D0 + (HY_D1 - HY_D0) * ((float)cmine / 511.0f)) * (1.0f / 4095.0f);
    const bf16_t* H3 = (const bf16_t*)(ws + WS_H3B) + (size_t)l * 4096 * 64 + (size_t)fr * 64 + 8 * fq;
    LAS f32x2* Xm = (fq & 1) ? X2 : X;
    float ss0 = 0.f, ss1 = 0.f;
#pragma unroll 1
    for (int i0 = 0; i0 < 32; i0 += 4) {
        bf16x8 hb[4][2];
#pragma unroll
        for (int i = 0; i < 4; ++i) { const bf16_t* hp = H3 + (size_t)(16 * (w + 8 * (i0 + i))) * 64; hb[i][0] = *(const bf16x8*)hp; hb[i][1] = *(const bf16x8*)(hp + 32); }
#pragma unroll
        for (int i = 0; i < 4; ++i) {
            f32x4 d = {0.f, 0.f, 0.f, 0.f};
            d = MFMA16(af[0], hb[i][0], d); d = MFMA16(af[1], hb[i][1], d);
            if (fq < 2) { const int t = 16 * (w + 8 * (i0 + i)) + fr;
                const float dec = __expf(-(float)t * dl); const float f0 = d.x * dec, f1 = d.y * dec, b0 = d.z * dec, b1 = d.w * dec;
                Xm[fphys(t)] = (f32x2){f0, f1}; ss0 += f0 * f0; ss1 += f1 * f1;
                if (t > 0) { Xm[fphys(8192 - t)] = (f32x2){b0, b1}; ss0 += b0 * b0; ss1 += b1 * b1; } }
        }
    }
#pragma unroll
    for (int o = 1; o < 16; o <<= 1) { ss0 += __shfl_xor(ss0, o); ss1 += __shfl_xor(ss1, o); }
    if (fr == 0 && fq < 2) { red[w * 4 + fq * 2] = ss0; red[w * 4 + fq * 2 + 1] = ss1; }
    __syncthreads();
    fft2_pass<4, 12, false>(X, Wg, tid); fft2_pass<4, 12, false>(X2, Wg, tid); __syncthreads();
    fft2_pass<4, 8, false>(X, Wg, tid); fft2_pass<4, 8, false>(X2, Wg, tid); __syncthreads();
    fft2_fwd_D(tid < 256 ? X : X2, tid & 255); __syncthreads();
#pragma unroll 1
    for (int ch = 0; ch < 2; ++ch) {
        float s0 = 0.f, s1 = 0.f;
#pragma unroll
        for (int i = 0; i < NWAVES; ++i) { s0 += red[i * 4 + ch * 2]; s1 += red[i * 4 + ch * 2 + 1]; }
        const float rs0 = 0.5f * rsqrtf(s0 + EPS), rs1 = 0.5f * rsqrtf(s1 + EPS);
        const LAS f32x2* Xc = ch ? X2 : X; const int c = c0 + 256 * ch;
        f32x2* KF0 = (f32x2*)(ws + WS_KF) + (size_t)(0 * 512 + c) * FFTN; f32x2* KF1 = (f32x2*)(ws + WS_KF) + (size_t)(1 * 512 + c) * FFTN;
#pragma unroll 4
        for (int j = 0; j < 16; ++j) { const int pos = tid + 512 * j; const int k = (int)(__brev((unsigned)pos) >> 19); const int pp = (int)(__brev((unsigned)((8192 - k) & 8191)) >> 19);
            const f32x2 za = Xc[fphys(pos)], zb = Xc[fphys(pp)];
            KF0[pos] = (f32x2){rs0 * (za.x + zb.x), rs0 * (za.y - zb.y)};
            KF1[pos] = (f32x2){rs1 * (za.y + zb.y), rs1 * (zb.x - za.x)}; }
    }
    __syncthreads();
}

struct Raw8 { u32x4 mid; bf16_t lf, rt; };
__device__ __forceinline__ Raw8 ld_raw8(const bf16_t* p, int t0, int Lx) { Raw8 r; r.mid = *(const u32x4*)(p + t0); r.lf = t0 > 0 ? p[t0 - 1] : (bf16_t)0; r.rt = t0 + 8 < Lx ? p[t0 + 8] : (bf16_t)0; return r; }
__device__ __forceinline__ void sconv8(const Raw8& r, float w0, float w1, float w2, float cb, float (&o)[8]) {
    float x[10]; x[0] = bf2f(r.lf); x[9] = bf2f(r.rt);
    x[1] = bflo(r.mid.x); x[2] = bfhi(r.mid.x); x[3] = bflo(r.mid.y); x[4] = bfhi(r.mid.y); x[5] = bflo(r.mid.z); x[6] = bfhi(r.mid.z); x[7] = bflo(r.mid.w); x[8] = bfhi(r.mid.w);
#pragma unroll
    for (int i = 0; i < 8; ++i) o[i] = w0 * x[i] + w1 * x[i + 1] + w2 * x[i + 2] + cb;
}
__device__ __forceinline__ void hyena_item2(const DArgs& a, unsigned char* ws, LAS unsigned char* lds, int l, int c, int tid, bf16_t* outrows) {
    LAS f32x2* X = (LAS f32x2*)lds; LAS f32x2* X2 = (LAS f32x2*)(lds + FFT_PHYS * 8);
    const f32x2* Wg = (const f32x2*)(ws + WS_TWID);
    const float* cw = a.in[I_HCW] + (size_t)l * 3 * 1536; const float* cbp = a.in[I_HCB] + (size_t)l * 1536;
    const float wv0 = cw[c], wv1 = cw[1536 + c], wv2 = cw[3072 + c], bv = cbp[c];
    const float wa0 = cw[512 + c], wa1 = cw[1536 + 512 + c], wa2 = cw[3072 + 512 + c], ba = cbp[512 + c];
    const float wb0 = cw[1024 + c], wb1 = cw[1536 + 1024 + c], wb2 = cw[3072 + 1024 + c], bb = cbp[1024 + c];
    const float bias0 = a.in[I_HBIAS][(l * 2 + 0) * 512 + c], bias1 = a.in[I_HBIAS][(l * 2 + 1) * 512 + c];
    const bf16_t* PT = (const bf16_t*)(ws + WS_PT);
    const bf16_t* pv = PT + (size_t)(PT_V + c) * MR; const bf16_t* pg1 = PT + (size_t)(PT_G1 + c) * MR; const bf16_t* pg2 = PT + (size_t)(PT_G2 + c) * MR; const bf16_t* phg = PT + (size_t)(PT_HG + c) * MR;
    const f32x2* KF0 = (const f32x2*)(ws + WS_KF) + (size_t)(0 * 512 + c) * FFTN; const f32x2* KF1 = (const f32x2*)(ws + WS_KF) + (size_t)(1 * 512 + c) * FFTN;
    const int t0 = 8 * tid;
    const int po = 8 * tid + (tid >> 2);
    LAS f32x2* px = X + po; LAS f32x2* py = X2 + po;
    float z[4][8];
    { Raw8 v[4];
#pragma unroll
      for (int b = 0; b < 4; ++b) v[b] = ld_raw8(pv + b * SEQL, t0, SEQL);
#pragma unroll
      for (int b = 0; b < 4; ++b) sconv8(v[b], wv0, wv1, wv2, bv, z[b]); }
    Raw8 g1r[4];
#pragma unroll
    for (int b = 0; b < 4; ++b) g1r[b] = ld_raw8(pg1 + b * SEQL, t0, SEQL);
#pragma unroll
    for (int x = 0; x < 8; ++x) { px[x] = (f32x2){z[0][x], z[1][x]}; px[4224 + x] = (f32x2){0.f, 0.f}; py[x] = (f32x2){z[2][x], z[3][x]}; py[4224 + x] = (f32x2){0.f, 0.f}; }
    __syncthreads();
#define HY_CONV(KFp) do { \
        fft2_pass<4, 12, false>(X, Wg, tid); fft2_pass<4, 12, false>(X2, Wg, tid); __syncthreads(); \
        fft2_pass<4, 8, false>(X, Wg, tid); fft2_pass<4, 8, false>(X2, Wg, tid); __syncthreads(); \
        fft2_mid_mul(tid < 256 ? X : X2, KFp, tid & 255); __syncthreads(); \
        fft2_pass<4, 8, true>(X, Wg, tid); fft2_pass<4, 8, true>(X2, Wg, tid); __syncthreads(); \
        fft2_pass<4, 12, true>(X, Wg, tid); fft2_pass<4, 12, true>(X2, Wg, tid); __syncthreads(); } while (0)
    HY_CONV(KF0);
    { float g[4][8];
#pragma unroll
      for (int b = 0; b < 4; ++b) sconv8(g1r[b], wa0, wa1, wa2, ba, g[b]);
#pragma unroll
      for (int x = 0; x < 8; ++x) { const f32x2 c0 = px[x] * (1.0f / 8192.0f), c1 = py[x] * (1.0f / 8192.0f);
          z[0][x] = g[0][x] * (c0.x + bias0 * z[0][x]); z[1][x] = g[1][x] * (c0.y + bias0 * z[1][x]); z[2][x] = g[2][x] * (c1.x + bias0 * z[2][x]); z[3][x] = g[3][x] * (c1.y + bias0 * z[3][x]); } }
    Raw8 g2r[4]; u32x4 hgr[4];
#pragma unroll
    for (int b = 0; b < 4; ++b) { g2r[b] = ld_raw8(pg2 + b * SEQL, t0, SEQL); hgr[b] = *(const u32x4*)(phg + b * SEQL + t0); }
    __syncthreads();
#pragma unroll
    for (int x = 0; x < 8; ++x) { px[x] = (f32x2){z[0][x], z[1][x]}; px[4224 + x] = (f32x2){0.f, 0.f}; py[x] = (f32x2){z[2][x], z[3][x]}; py[4224 + x] = (f32x2){0.f, 0.f}; }
    __syncthreads();
    HY_CONV(KF1);
#undef HY_CONV
    bf16_t* pvw = outrows + (size_t)c * MR;
#pragma unroll
    for (int b = 0; b < 4; ++b) { float g[8], hh[8], o[8]; sconv8(g2r[b], wb0, wb1, wb2, bb, g); unpack8(hgr[b], hh);
#pragma unroll
        for (int x = 0; x < 8; ++x) { const f32x2 cv = ((b < 2) ? px[x] : py[x]) * (1.0f / 8192.0f); const float cvv = (b & 1) ? cv.y : cv.x;
            o[x] = g[x] * (cvv + bias1 * z[b][x]) * siluf_(hh[x]); }
        *(u32x4*)(pvw + b * SEQL + t0) = pack8(o); }
    __syncthreads();
}
__device__ __forceinline__ void hy_transpose_item(unsigned char* ws, LAS unsigned char* lds, int item, int tid, int nrows) {
    const int lane = tid & 63, w = tid >> 6;
    const int wi = item * 8 + w;
    const int nrb = nrows / 64;
    if (wi >= nrb * 8) return;
    const int rb = wi >> 3, cb = wi & 7;
    LAS bf16_t* T = (LAS bf16_t*)(lds + w * 8704);
    const bf16_t* src = (const bf16_t*)(ws + WS_PT) + (size_t)(PT_V + cb * 64) * MR + (size_t)rb * 64;
    u32x4 tv[8];
#pragma unroll
    for (int i = 0; i < 8; ++i) { const int c = 8 * i + (lane >> 3), r8 = (lane & 7) * 8; tv[i] = *(const u32x4*)(src + (size_t)c * MR + r8); }
#pragma unroll
    for (int i = 0; i < 8; ++i) { const int c = 8 * i + (lane >> 3), r8 = (lane & 7) * 8;
        LAS unsigned* d = (LAS unsigned*)(T + c * 66 + r8); d[0] = tv[i].x; d[1] = tv[i].y; d[2] = tv[i].z; d[3] = tv[i].w; }
    asm volatile("s_waitcnt lgkmcnt(0)" ::: "memory");
    bf16_t* dst = (bf16_t*)(ws + WS_H) + (size_t)(rb * 64) * D + 512 + cb * 64;
#pragma unroll 4
    for (int i = 0; i < 8; ++i) { const int r = 8 * i + (lane >> 3), c8 = (lane & 7) * 8;
        unsigned short e[8];
#pragma unroll
        for (int x = 0; x < 8; ++x) e[x] = T[(c8 + x) * 66 + r];
        u32x4 o; o.x = e[0] | ((unsigned)e[1] << 16); o.y = e[2] | ((unsigned)e[3] << 16); o.z = e[4] | ((unsigned)e[5] << 16); o.w = e[6] | ((unsigned)e[7] << 16);
        *(u32x4*)(dst + (size_t)r * D + c8) = o; }
    asm volatile("s_waitcnt lgkmcnt(0)" ::: "memory");
}
#ifndef MK_EN
#define MK_EN 0xffff
#endif
#define EN(x) ((MK_EN >> (x)) & 1)
constexpr int PH_PREP = 0, PH_PER_LAYER = 7, PH_FNORM = 1 + 2 * PH_PER_LAYER, N_PHASES = PH_FNORM + 1;

__global__ void __launch_bounds__(NT, 2) fwd_kernel(Args ka) {
    extern __shared__ __attribute__((aligned(16))) unsigned char lds_raw[];
    LAS unsigned char* lds = (LAS unsigned char*)lds_raw;
    const int G = gridDim.x;
    volatile LAS unsigned* bst = (volatile LAS unsigned*)(lds + LDS_CTL_OFF);
    if (threadIdx.x < 16) bst[threadIdx.x] = 0u;
    if (threadIdx.x == 0) { LAS unsigned long long* tab = (LAS unsigned long long*)(lds + LDS_PTR_OFF);
#pragma unroll
        for (int i = 0; i < N_IN; ++i) tab[i] = (unsigned long long)ka.in[i]; }
    __syncthreads();

    XcdBarrier gbar; gbar.bar = (unsigned*)(ka.ws + WS_CTL); gbar.x = 0; gbar.st = bst;
    if (ka.ph_hi - ka.ph_lo > 1) gbar = xcd_barrier_post((unsigned*)(ka.ws + WS_CTL), bst);

#ifdef REP_SUB
#ifndef REP_LMASK
#define REP_LMASK 3
#endif
    int repmask = 0;
#endif
    for (int ph = ka.ph_lo; ph < ka.ph_hi; ++ph) {
        int tid = threadIdx.x; asm volatile("" : "+v"(tid));
        int bid = blockIdx.x; asm volatile("" : "+s"(bid));
#define LANE_WAVE() int tid2_ = threadIdx.x; asm volatile("" : "+v"(tid2_)); const int lane = tid2_ & 63, wave = __builtin_amdgcn_readfirstlane(tid2_ >> 6)
        __attribute__((address_space(1))) unsigned char* wsg_ = (__attribute__((address_space(1))) unsigned char*)ka.ws; asm volatile("" : "+s"(wsg_)); unsigned char* ws = (unsigned char*)wsg_;
        __attribute__((address_space(1))) float* outg_ = (__attribute__((address_space(1))) float*)ka.out; asm volatile("" : "+s"(outg_)); float* outp_ = (float*)outg_;
        DArgs a; a.in.t = (const LAS unsigned long long*)(lds + LDS_PTR_OFF); a.out = outp_;
        float* MOD = (float*)(ws + WS_MOD);
        if (EN(0) && ph == PH_PREP) {
            for (int it = bid; it < 1048 + 544 + 8; it += G) {
                int tid = threadIdx.x; asm volatile("" : "+v"(tid));
                __syncthreads();
                if (it < 768) prep_adaln(a.in[I_C], a.in[I_CCTX], a.in[I_ADAW], a.in[I_ADAB], MOD, it, (LAS float*)lds, tid);
                else if (it < 784) prep_s5b(a, ws, it - 768, tid);
                else if (it >= 1048 + 544) { const int j = (it - 1592) * NT + tid; float sn, cs; sincospif(-(float)j * (1.0f / 4096.0f), &sn, &cs); ((f32x2*)(ws + WS_TWID))[j] = (f32x2){cs, sn}; }
                else if (it >= 1048) prep_rope((f32x2*)(ws + WS_ROPE), it - 1048, tid);
                else { const bool big = it < 1040; const int r = big ? it - 784 : it - 1040, l = big ? (r >> 7) : 0, t0 = (big ? (r & 127) : r) * 32;
                    float* H3o = big ? (float*)(ws + WS_H3) + (size_t)l * 4096 * 64 : (float*)(ws + WS_H3C);
                    bf16_t* H3b = big ? (bf16_t*)(ws + WS_H3B) + (size_t)l * 4096 * 64 : (bf16_t*)nullptr;
                    prep_hymlp(a, H3o, H3b, l, big ? 4096 : 256, t0, lds, tid); }
            }
        } else if (EN(1) && ph == PH_FNORM) {
            const float* fw = a.in[I_FNW]; LANE_WAVE();
            for (int row = bid * NWAVES + wave; row < NLAT; row += G * NWAVES) {
                float* xr = a.out + (size_t)row * D; f32x4 v[8]; float ss = 0.f;
#pragma unroll
                for (int j = 0; j < 8; ++j) { v[j] = ((const f32x4*)xr)[lane + 64 * j]; ss += (v[j].x * v[j].x + v[j].y * v[j].y) + (v[j].z * v[j].z + v[j].w * v[j].w); }
                const float rstd = rsqrtf(wave_sum(ss) * (1.0f / D) + EPS);
#pragma unroll
                for (int j = 0; j < 8; ++j) { const f32x4 w = *(const f32x4*)(fw + 4 * (lane + 64 * j)); ((f32x4*)xr)[lane + 64 * j] = v[j] * rstd * w; }
            }
        } else {
            const int l = (ph - 1) / PH_PER_LAYER, sub = (ph - 1) % PH_PER_LAYER;

            const bool ctx_out = (l == 0);
            const int Mrows = ctx_out ? MR : NLAT;
            if (EN(2) && sub == 0) {
                LANE_WAVE();
                LAS float* scr = (LAS float*)(lds + wave * 8704);
                const int gw = bid * NWAVES + wave, NGW = G * NWAVES;
                constexpr int I_W1 = 32 * (NPAD / 32), I_W2 = 32 * 64, I_W3 = 8 * 16;
                for (int it = (l == 0 ? gw : gw + I_W1); it < I_W1 + I_W2 + I_W3; it += NGW) {
                    int r = it;
                    if (r < I_W1) { const int kb = r / (NPAD / 32), nb = r % (NPAD / 32); transpose_item(a.in[I_WIN] + (size_t)l * D * INW, INW, win_srccol(nb * 32 + (lane & 31)), kb * 64, (bf16_t*)(ws + WS_WIN), D, nb * 32, scr, lane); continue; }
                    r -= I_W1;
                    if (r < I_W2) { const int kb = r / 64, nb = r % 64; transpose_item(a.in[I_WOUT] + (size_t)l * D * D, D, nb * 32 + (lane & 31), kb * 64, (bf16_t*)(ws + WS_WOUT), D, nb * 32, scr, lane); continue; }
                    r -= I_W2;
                    { const int kb = r / 16, nb = r % 16; transpose_item(a.in[I_GLUW] + (size_t)l * 512 * 512, 512, nb * 32 + (lane & 31), kb * 64, (bf16_t*)(ws + WS_GLUW), 512, nb * 32, scr, lane); }
                }
                const float* nw = a.in[I_NORMW] + (size_t)l * D;
                for (int row = gw; row < MR; row += NGW) {
                    const float* xr; int v;
                    if (row < NLAT) { xr = (l == 0 ? a.in[I_X] : a.out) + (size_t)row * D; v = row >> 12; }
                    else { xr = (l == 0 ? a.in[I_CTX] : (const float*)(ws + WS_XC1)) + (size_t)(row - NLAT) * D; v = 4; }
                    norm_row(xr, nw, MOD + (size_t)(l * 5 + v) * ADA, (bf16_t*)(ws + WS_H) + (size_t)row * D, lane);
                }
                __syncthreads();
                const int nfilt = ctx_out ? 768 : 0;
                for (int it = bid; it < nfilt; it += G) { int tid = threadIdx.x; asm volatile("" : "+v"(tid)); __syncthreads(); if (it < 256) filt_item2(a, ws, lds, l, it, tid); else filt_ctx_item(a, ws, lds, it - 256, tid);
#if defined(REP_ITEM) && REP_ITEM == 10
                    __syncthreads(); if (it < 256) filt_item2(a, ws, lds, l, it, tid);
#endif
                }
            } else if (EN(3) && sub == 1) {
                pg8::Gemm g{(const bf16_t*)(ws + WS_H), (const bf16_t*)(ws + WS_WIN), MR, NPAD, D}; pg8::StaticOrder S; S.init(MR, NPAD, G, bid);
                EpiInProj E{(bf16_t*)(ws + WS_P), (bf16_t*)(ws + WS_PT), (float*)(ws + WS_LR), (const float*)(ws + WS_ROPE)};
                { pg8::InProjOrder S1; S1.init(ctx_out ? 0 : 1, G, bid); pg8::gemm_phase<EpiInProj, pg8::InProjOrder, true, true>(lds, g, S1, E, tid); }
            } else if (EN(5) && sub == 2) {
                const int nit = ctx_out ? 3744 : 3232;
                for (int it = bid; it < nit; it += G) {
                    int tid = threadIdx.x; asm volatile("" : "+v"(tid));
                    __syncthreads();
#ifdef REP_ITEM
                    { const int ty_ = it < 512 ? 0 : it < 1600 ? 1 : it < 2144 ? 2 : it < 3232 ? 3 : 4;
                      if (ty_ == REP_ITEM) { if (ty_ == 0) hyena_item2(a, ws, lds, l, it, tid, (bf16_t*)(ws + WS_H)); else if (ty_ == 1) s5_item<false>(a, ws, lds, l, (it - 512) >> 1, (it - 512) & 1, tid); else if (ty_ == 2) ret_passA(ws, lds, it - 1600, tid);
                          else if (ty_ == 3) gla_passA(a, ws, lds, l, it - 2144, tid); else hyena_ctx_item(a, ws, lds, it - 3232, tid);
                          __syncthreads(); asm volatile("" : "+v"(tid)); } }
#endif
                    if (it < 512) hyena_item2(a, ws, lds, l, it, tid, (bf16_t*)(ws + WS_PT) + (size_t)PT_V * MR);
                    else if (it < 1600) s5_item<false>(a, ws, lds, l, (it - 512) >> 1, (it - 512) & 1, tid);
                    else if (it < 2144) ret_passA(ws, lds, it - 1600, tid);
                    else if (it < 3232) gla_passA(a, ws, lds, l, it - 2144, tid);
                    else hyena_ctx_item(a, ws, lds, it - 3232, tid);
                }
            } else if (EN(9) && sub == 3) {
                for (int it = bid; it < 256; it += G) { int tid = threadIdx.x; asm volatile("" : "+v"(tid)); __syncthreads(); hy_transpose_item(ws, lds, it, tid, NLAT); }
                for (int it = bid; it < 224; it += G) { int tid = threadIdx.x; asm volatile("" : "+v"(tid)); __syncthreads();
                    if (it < 128) ret_passB(ws, it * NT + tid);
                    else if (it < 192) gla_passB(ws, lds, it - 128, tid);
                    else s5_passB(ws, l, (it - 192) * NT + tid); }
            } else if (EN(6) && sub == 4) {
                const int nsc = ctx_out ? 1088 : 1024, nrc = ctx_out ? 16 * RNCH : 16 * 32, ngc = ctx_out ? 16 * GNCH : 16 * 64;
                for (int it = bid; it < nsc; it += G) { int tid = threadIdx.x; asm volatile("" : "+v"(tid)); __syncthreads();
                    const int i2 = it >> 1; const int item = ctx_out ? i2 : (i2 >> 7) * (SNCH * 2) + 8 + (i2 & 127);
#if defined(REP_ITEM) && REP_ITEM == 5
                    s5_item<true>(a, ws, lds, l, item, it & 1, tid); __syncthreads(); asm volatile("" : "+v"(tid));
#endif
                    s5_item<true>(a, ws, lds, l, item, it & 1, tid); }
                for (int it = (bid + 64) % G; it < nrc; it += G) { int tid = threadIdx.x; asm volatile("" : "+v"(tid)); __syncthreads();
                    const int item = ctx_out ? it : (it >> 5) * RNCH + 2 + (it & 31);
#if defined(REP_ITEM) && REP_ITEM == 6
                    ret_passC(a, ws, lds, l, item, tid); __syncthreads(); asm volatile("" : "+v"(tid));
#endif
                    ret_passC(a, ws, lds, l, item, tid); }
                for (int it = (bid + 128) % G; it < ngc; it += G) { int tid = threadIdx.x; asm volatile("" : "+v"(tid)); __syncthreads();
                    const int item = ctx_out ? it : (it >> 6) * GNCH + 4 + (it & 63);
#if defined(REP_ITEM) && REP_ITEM == 7
                    gla_passC(a, ws, lds, l, item, tid); __syncthreads(); asm volatile("" : "+v"(tid));
#endif
                    gla_passC(a, ws, lds, l, item, tid); }
            } else if (EN(7) && sub == 5) {
                pg8::Gemm g{(const bf16_t*)(ws + WS_KF), (const bf16_t*)(ws + WS_GLUW), Mrows, 512, 512}; pg8::StaticOrder S; S.init(Mrows, 512, G, bid);
                EpiGlu E{(const bf16_t*)(ws + WS_KF) + OBSZ, (bf16_t*)(ws + WS_H), a.in[I_GLUB] + (size_t)l * 512};
                pg8::gemm_phase<EpiGlu, pg8::StaticOrder, true, true>(lds, g, S, E, tid);
                if (l == 0 && bid >= 136) {
                    LANE_WAVE(); LAS float* scr = (LAS float*)(lds + wave * 8704);
                    for (int r = (bid - 136) * NWAVES + wave; r < 32 * (NPAD / 32); r += (G - 136) * NWAVES) { const int kb = r / (NPAD / 32), nb = r % (NPAD / 32);
                        transpose_item(a.in[I_WIN] + (size_t)1 * D * INW, INW, win_srccol(nb * 32 + (lane & 31)), kb * 64, (bf16_t*)(ws + WS_WIN), D, nb * 32, scr, lane); }
                }
            } else if (EN(8)) {
                pg8::Gemm g{(const bf16_t*)(ws + WS_H), (const bf16_t*)(ws + WS_WOUT), Mrows, D, D}; pg8::StaticOrder S; S.init(Mrows, D, G, bid);
                EpiOut E{l == 0 ? a.in[I_X] : a.out, a.in[I_CTX], a.out, (float*)(ws + WS_XC1), MOD + (size_t)l * 5 * ADA};
                pg8::gemm_phase<EpiOut, pg8::StaticOrder, true, true>(lds, g, S, E, tid);
                if (l == 0 && bid >= 32) {
                    for (int it = bid - 32; it < 256; it += G - 32) { int tid2 = threadIdx.x; asm volatile("" : "+v"(tid2)); __syncthreads(); filt_item2(a, ws, lds, 1, it, tid2); }
                }
            }
        }
#ifdef REP_SUB
        if (ph != PH_PREP && ph != PH_FNORM && ((ph - 1) % PH_PER_LAYER) == REP_SUB && ((REP_LMASK >> ((ph - 1) / PH_PER_LAYER)) & 1) && !((repmask >> ((ph - 1) / PH_PER_LAYER)) & 1)) { repmask |= 1 << ((ph - 1) / PH_PER_LAYER); xcd_barrier(gbar); --ph; continue; }
#endif
        if (ph + 1 < ka.ph_hi) xcd_barrier(gbar);
    }
}

#ifndef MK_LAUNCH_PER_PHASE
#define MK_LAUNCH_PER_PHASE 0
#endif
extern "C" void kernel_launch(void* const* d_in, const int* in_sizes, int n_in, void* d_out, int out_size, void* d_ws, size_t ws_size, hipStream_t stream) {
    static int grid = 0;
    if (grid == 0) {
        if (n_in != N_IN || out_size != NLAT * D || ws_size < WS_END2) { fprintf(stderr, "kernel_launch: unexpected shapes (n_in %d, out %d, ws %zu < %zu); nothing launched\n", n_in, out_size, ws_size, (size_t)WS_END2); grid = -1; return; }
        int dev = 0, cus = 0, per_cu = 0;
        if (hipGetDevice(&dev) != hipSuccess || hipDeviceGetAttribute(&cus, hipDeviceAttributeMultiprocessorCount, dev) != hipSuccess) { grid = -1; return; }
        if (hipFuncSetAttribute((const void*)fwd_kernel, hipFuncAttributeMaxDynamicSharedMemorySize, LDS_BYTES) != hipSuccess) { fprintf(stderr, "kernel_launch: hipFuncSetAttribute failed\n"); grid = -1; return; }
        if (hipOccupancyMaxActiveBlocksPerMultiprocessor(&per_cu, (const void*)fwd_kernel, NT, LDS_BYTES) != hipSuccess || per_cu < 1) { fprintf(stderr, "kernel_launch: occupancy query says %d blocks per CU\n", per_cu); per_cu = 1; }
        (void)hipGetLastError();
        grid = cus;
    }
    if (grid < 0) return;
    (void)hipMemsetAsync((char*)d_ws + WS_CTL, 0, WS_ZERO_BYTES, stream);
    Args a{};
    for (int i = 0; i < N_IN; ++i) a.in[i] = (const float*)d_in[i];
    a.out = (float*)d_out; a.ws = (unsigned char*)d_ws;
#if MK_LAUNCH_PER_PHASE
    for (int ph = 0; ph < N_PHASES; ++ph) {
        a.ph_lo = ph; a.ph_hi = ph + 1;
        hipLaunchKernelGGL(fwd_kernel, dim3(grid), dim3(NT), LDS_BYTES, stream, a);
    }
#else
    a.ph_lo = 0; a.ph_hi = N_PHASES;
    void* args[] = {&a};
    hipError_t e = hipLaunchCooperativeKernel((const void*)fwd_kernel, dim3(grid), dim3(NT), args, LDS_BYTES, stream);
    if (e != hipSuccess) fprintf(stderr, "kernel_launch: cooperative launch failed: %s (grid %d)\n", hipGetErrorString(e), grid);
#endif
}
```

```cpp
#include <hip/hip_runtime.h>
#include <hip/hip_cooperative_groups.h>
#include <cstdio>
#include <cstdint>
namespace cg = cooperative_groups;

#define LAS __attribute__((address_space(3)))
typedef unsigned short bf16_t;
typedef float f32x4 __attribute__((ext_vector_type(4)));
typedef float f32x2 __attribute__((ext_vector_type(2)));
typedef unsigned u32x4 __attribute__((ext_vector_type(4)));
typedef unsigned u32x2 __attribute__((ext_vector_type(2)));

constexpr int D = 2048, NB = 4, SEQL = 4096, LC = 256, NLAT = NB * SEQL, NCTX = NB * LC, MR = NLAT + NCTX;
constexpr int BR = 512, INW = 6688, NPAD = 6912, LDP = 4608, ADA = 3 * D;
constexpr int NT = 512, NWAVES = 8;
constexpr float EPS = 1e-6f;
constexpr int PC_S5U = 0, PC_S5G = 512, PC_RQ = 1024, PC_RK = 1536, PC_RV = 2048, PC_RG = 2560, PC_GQ = 3072, PC_GK = 3328, PC_GV = 3584, PC_GG = 4096;
constexpr int PT_V = 0, PT_G1 = 512, PT_G2 = 1024, PT_HG = 1536;
constexpr int FFTN = 8192;

enum { I_X = 0, I_C, I_CTX, I_CCTX, I_NORMW, I_ADAW, I_ADAB, I_WIN, I_WOUT, I_S5ARE, I_S5AIM, I_S5LDT, I_S5BRE, I_S5BIM, I_S5CRE, I_S5CIM,
       I_S5D, I_GLUW, I_GLUB, I_HCW, I_HCB, I_HW1, I_HB1, I_HF1, I_HW2, I_HB2, I_HF2, I_HW3, I_HB3, I_HF3, I_HW4, I_HBIAS, I_RNW, I_GGW, I_GGB, I_GNW, I_FNW, N_IN };

constexpr size_t al256(size_t x) { return (x + 255) & ~(size_t)255; }
constexpr size_t WS_CTL  = 0;
constexpr size_t WS_MOD  = WS_CTL + 65536;
constexpr size_t WS_ZERO_BYTES = 65536 + al256((size_t)2 * 5 * ADA * 4);
constexpr size_t WS_S5AB = WS_MOD + al256((size_t)2 * 5 * ADA * 4);
constexpr size_t WS_S5BT = WS_S5AB + (size_t)2 * 2 * 32 * 64 * 8;
constexpr size_t WS_H3   = WS_S5BT + (size_t)1048576 + 65536;
constexpr size_t WS_H3C  = WS_H3 + (size_t)2 * 4096 * 64 * 4;
constexpr size_t WS_KC   = WS_H3C + (size_t)256 * 64 * 4;
constexpr size_t WS_LR   = WS_KC + (size_t)2 * 512 * 512 * 4;
constexpr size_t WS_XC1  = WS_LR + (size_t)MR * 32 * 4;
constexpr size_t WS_WOUT = WS_XC1 + (size_t)NCTX * D * 4;
constexpr size_t WS_GLUW = WS_WOUT + (size_t)D * D * 2;
constexpr size_t WS_WIN  = WS_GLUW + (size_t)512 * 512 * 2;
constexpr size_t WS_H    = WS_WIN + (size_t)NPAD * D * 2;
constexpr size_t WS_P    = WS_H + (size_t)MR * D * 2;
constexpr size_t WS_PT   = WS_P + (size_t)MR * LDP * 2;
constexpr size_t WS_KF   = WS_PT + (size_t)2048 * MR * 2;
constexpr size_t WS_OB   = WS_KF + (size_t)2 * 512 * FFTN * 8;
constexpr size_t WS_END  = WS_OB + (size_t)6 * MR * 512 * 2;
constexpr size_t OBSZ = (size_t)MR * 512;

constexpr int LDS_CTL_OFF = 135168 + 1024;
constexpr int LDS_PTR_OFF = LDS_CTL_OFF + 64;
constexpr int LDS_BYTES = LDS_PTR_OFF + 320;

typedef __bf16 hwbf16x2 __attribute__((ext_vector_type(2)));
__device__ __forceinline__ unsigned pk2(float lo, float hi) { const f32x2 v = {lo, hi}; return __builtin_bit_cast(unsigned, __builtin_convertvector(v, hwbf16x2)); }
__device__ __forceinline__ unsigned f2bf(float f) { return pk2(f, 0.f) & 0xffffu; }
__device__ __forceinline__ float bf2f(bf16_t b) { return __uint_as_float((unsigned)b << 16); }
__device__ __forceinline__ float bflo(unsigned w) { return __uint_as_float(w << 16); }
__device__ __forceinline__ float bfhi(unsigned w) { return __uint_as_float(w & 0xffff0000u); }
__device__ __forceinline__ void unpack8(const u32x4 r, float (&f)[8]) { f[0] = bflo(r.x); f[1] = bfhi(r.x); f[2] = bflo(r.y); f[3] = bfhi(r.y); f[4] = bflo(r.z); f[5] = bfhi(r.z); f[6] = bflo(r.w); f[7] = bfhi(r.w); }
__device__ __forceinline__ u32x4 pack8(const float (&f)[8]) { u32x4 o; o.x = pk2(f[0], f[1]); o.y = pk2(f[2], f[3]); o.z = pk2(f[4], f[5]); o.w = pk2(f[6], f[7]); return o; }
__device__ __forceinline__ float sigmoidf_(float x) { return __builtin_amdgcn_rcpf(1.0f + __expf(-x)); }
__device__ __forceinline__ float siluf_(float x) { return x * sigmoidf_(x); }
__device__ __forceinline__ float gelu_tanh(float x) { const float u2 = 1.5957691216057308f * (x + 0.044715f * x * x * x); return x * sigmoidf_(u2); }
__device__ __forceinline__ float wave_sum(float v) {
#pragma unroll
    for (int o = 1; o < 64; o <<= 1) v += __shfl_xor(v, o);
    return v;
}
#define LDS_WAIT() asm volatile("s_waitcnt lgkmcnt(0)" ::: "memory")

struct Args { const float* in[N_IN]; float* out; unsigned char* ws; int ph_lo, ph_hi; };
struct InTab { const LAS unsigned long long* t;
    __device__ __forceinline__ const float* operator[](int i) const { const unsigned long long v = t[i];
        const unsigned lo = __builtin_amdgcn_readfirstlane((unsigned)v), hi = __builtin_amdgcn_readfirstlane((unsigned)(v >> 32)); return (const float*)(__attribute__((address_space(1))) const float*)(((unsigned long long)hi << 32) | lo); } };
struct DArgs { InTab in; float* out; };

#define XB_TMO      128
#define XB_XCNT(j)  (256  + 64 * (j))
#define XB_XSUB(j)  (1280 + 64 * (j))
#define XB_XGEN(j)  (2304 + 64 * (j))
#define XB_TOP      3328
#define XB_TOPGEN   3392
#define XCD_BAR_WORDS 3456
#define XB_SPIN_CAP (1u << 22)
__device__ __forceinline__ unsigned xb_ld(unsigned* p)              { return __hip_atomic_load(p, __ATOMIC_RELAXED, __HIP_MEMORY_SCOPE_AGENT); }
__device__ __forceinline__ unsigned xb_add(unsigned* p, unsigned v) { return __hip_atomic_fetch_add(p, v, __ATOMIC_RELAXED, __HIP_MEMORY_SCOPE_AGENT); }
__device__ __forceinline__ unsigned xb_xcc_id() { return (unsigned)__builtin_amdgcn_s_getreg((3 << 11) | 20) & 0xFu; }
#define XB_SPIN(cond, bar) do { unsigned _sp = 0; while (cond) { __builtin_amdgcn_s_sleep(1); \
    if ((++_sp & 255u) == 0u) { if (xb_ld(&(bar)[XB_TMO])) break; if (_sp > XB_SPIN_CAP) { atomicAdd(&(bar)[XB_TMO], 1u); break; } } } } while (0)
struct XcdBarrier { unsigned* bar; unsigned x; volatile LAS unsigned* st; };
__device__ __forceinline__ XcdBarrier xcd_barrier_post(unsigned* bar, volatile LAS unsigned* st) {
    XcdBarrier b; b.bar = bar; b.x = xb_xcc_id(); b.st = st;
    if (threadIdx.x == 0) (void)xb_add(&bar[XB_XCNT(b.x)], 1u);
    return b;
}
__device__ __forceinline__ void xcd_barrier_complete(unsigned* bar, unsigned x, unsigned& nloc, unsigned& nx) {
    const unsigned G = gridDim.x * gridDim.y * gridDim.z;
    unsigned sum, cnt, mine, sp = 0u;
    for (;;) {
        sum = 0u; cnt = 0u; mine = 0u;
#pragma unroll
        for (unsigned j = 0; j < 16; ++j) { const unsigned c = xb_ld(&bar[XB_XCNT(j)]); sum += c; cnt += (c > 0u) ? 1u : 0u; mine = (j == x) ? c : mine; }
        if (sum == G) break;
        __builtin_amdgcn_s_sleep(1);
        if ((++sp & 255u) == 0u) { if (xb_ld(&bar[XB_TMO])) break; if (sp > XB_SPIN_CAP) { atomicAdd(&bar[XB_TMO], 1u); break; } }
    }
    nloc = mine > 0u ? mine : 1u; nx = cnt > 0u ? cnt : 1u;
}
__device__ __forceinline__ void xcd_barrier(const XcdBarrier& b) {
    asm volatile("s_waitcnt vmcnt(0)" ::: "memory");
    __syncthreads();
    if (threadIdx.x == 0) {
        unsigned* bar = b.bar;
        __builtin_amdgcn_s_waitcnt(0);
        unsigned nloc = b.st[0], nx = b.st[1];
        if (nloc == 0u) { xcd_barrier_complete(bar, b.x, nloc, nx); b.st[0] = nloc; b.st[1] = nx; }
        const unsigned old = xb_add(&bar[XB_XSUB(b.x)], 1u);
        const unsigned gen = old / nloc;
        if (old + 1u == (gen + 1u) * nloc) {
            __builtin_amdgcn_fence(__ATOMIC_RELEASE, "agent");
            asm volatile("s_waitcnt vmcnt(0)" ::: "memory");
            const unsigned og = xb_add(&bar[XB_TOP], 1u);
            const unsigned tg = og / nx;
            if (og + 1u == (tg + 1u) * nx) xb_add(&bar[XB_TOPGEN], 1u);
            else XB_SPIN(xb_ld(&bar[XB_TOPGEN]) == tg, bar);
            __builtin_amdgcn_fence(__ATOMIC_ACQUIRE, "agent");
            xb_add(&bar[XB_XGEN(b.x)], 1u);
            asm volatile("s_waitcnt vmcnt(0)" ::: "memory");
        } else {
            XB_SPIN(xb_ld(&bar[XB_XGEN(b.x)]) == gen, bar);
            __builtin_amdgcn_fence(__ATOMIC_ACQUIRE, "agent");
            asm volatile("s_waitcnt vmcnt(0)" ::: "memory");
        }
    }
    __syncthreads();
}
#ifndef PG8_RB
#define PG8_RB 4
#endif
#ifndef PG8_WGM
#define PG8_WGM 4
#endif
namespace pg8 {
#define PG8_LAS __attribute__((address_space(3)))
typedef unsigned short bf16_t;
typedef short bf16x8 __attribute__((ext_vector_type(8)));
typedef float f32x4 __attribute__((ext_vector_type(4)));
typedef unsigned u32x4 __attribute__((ext_vector_type(4)));
constexpr int BM = 256, BK = 64, HALF = 128, HTB = HALF * BK * 2, STAGE_BYTES = 8 * HTB, NXCD = 8, WGM = PG8_WGM;

__host__ __device__ __forceinline__ int lds_byte(int r, int c) { const int st = (r >> 4) * 2 + (c >> 5), rr = r & 15, cc = c & 31, ob = rr * 64 + cc * 2; return st * 1024 + (ob ^ (((ob >> 9) & 1) << 5)); }
__host__ __device__ __forceinline__ void stage_rc(int b, int& R, int& C) { const int st = b / 1024, sb = b % 1024, swz = sb ^ (((sb >> 9) & 1) << 5); R = (st >> 1) * 16 + swz / 64; C = (st & 1) * 32 + (swz % 64) / 2; }
__host__ __device__ __forceinline__ int perm32(int rho) { const int n = rho >> 4, i = rho & 15; return 8 * (i >> 2) + 4 * n + (i & 3); }

struct Unit { int pm, pn; };
struct Gemm { const bf16_t* A; const bf16_t* Bt; int M, N, K; };

struct StaticOrder {
    int nM, nN, nwg, G, c;
    __host__ __device__ void init(int M, int N, int G_, int c_) { nM = M / BM; nN = N / BM; nwg = nM * nN; G = G_; c = c_; }
    __host__ __device__ bool next(int i, Unit& u) const {
        const long L = (long)i * G + c; if (L >= nwg) return false;
        int wgid = (int)L; { const int q = nwg / NXCD, r = nwg % NXCD, xcd = wgid % NXCD, off = wgid / NXCD; wgid = (xcd < r ? xcd * (q + 1) : r * (q + 1) + (xcd - r) * q) + off; }
        const int nig = WGM * nN, gid = wgid / nig, fm = gid * WGM, gsz = (nM - fm) < WGM ? (nM - fm) : WGM;
        u.pm = fm + ((wgid % nig) % gsz); u.pn = (wgid % nig) / gsz; return true;
    }
    __device__ __forceinline__ void a_ready(const Unit&) const {}
    __device__ __forceinline__ void done(const Unit&) const {}
    __device__ __forceinline__ bool swapped(const Unit&) const { return false; }
};


struct InProjOrder {
    int G, c, last;
    __host__ __device__ void init(int last_, int G_, int c_) { last = last_; G = G_; c = c_; }
    __host__ __device__ bool next(int i, Unit& u) const {
        const int L = i * G + c;
        if (L < 1728) { constexpr int RB = PG8_RB, BT = 8 * RB * 27, CB = 32 / RB; const int band = L / BT, r = L % BT, blk = r >> 8, q = r & 255, x = q & 7, j = q >> 3;
            u.pm = 8 * RB * band + RB * x + (j % RB); u.pn = CB * blk + (j / RB); return true; }
        if (!last) { if (L >= 1836) return false; const int r = L - 1728; u.pm = 64 + (r & 3); u.pn = r >> 2; return true; }
        if (L >= 1768) return false;
        const int k = L - 1728, j = k % 10; u.pm = 64 + k / 10;
        u.pn = j == 0 ? 0 : j == 1 ? 1 : j == 2 ? 14 : j == 3 ? 15 : j == 4 ? 16 : j == 5 ? 17 : j == 6 ? 21 : j == 7 ? 22 : j == 8 ? 23 : 26;
        return true;
    }
    __device__ __forceinline__ void a_ready(const Unit&) const {}
    __device__ __forceinline__ void done(const Unit&) const {}
    __device__ __forceinline__ bool swapped(const Unit& u) const { return u.pn >= 4 && u.pn < 12; }
};
template <class Epi, class Sched, bool ALIGN_EPI = false, bool SP2 = false>
__device__ __forceinline__ void gemm_phase(PG8_LAS unsigned char* lds, const Gemm g, const Sched& S, const Epi& E, const int tid) {
    const int wid = __builtin_amdgcn_readfirstlane(tid >> 6), lane = tid & 63, wr = wid >> 2, wc = wid & 3, fr = lane & 15, fq = lane >> 4;
    const int K = g.K, nt = K / BK;
    unsigned voffA[2], voffB[2];
#pragma unroll
    for (int i = 0; i < 2; ++i) { int R, C; stage_rc(tid * 16 + i * 8192, R, C); const int Rb = Epi::PERM ? ((R & ~31) + perm32(R & 31)) : R;
        voffA[i] = (unsigned)(R * K + C) * 2u; voffB[i] = (unsigned)(Rb * K + C) * 2u; }
    const size_t kstep = (size_t)(BK * 2);
    const size_t hstep = (size_t)HALF * K * 2;
    const size_t tstep = 2 * hstep;
    const unsigned ldsw = (unsigned)wid * 1024u;
    const int aoff = lds_byte(wr * 64 + fr, fq * 8), boff = lds_byte(wc * 32 + fr, fq * 8);
#define PG8_SA(b, h) (((b) * 2 + (h)) * HTB)
#define PG8_SB(b, h) ((4 + (b) * 2 + (h)) * HTB)
#define PG8_STAGE(bufoff, gbase, voff) do { _Pragma("unroll") for (int _i = 0; _i < 2; ++_i) \
        __builtin_amdgcn_global_load_lds((const unsigned*)((const char*)(gbase) + (voff)[_i]), (PG8_LAS unsigned*)(lds + (bufoff) + ldsw + _i * 8192), 16, 0, 0); } while (0)
#define PG8_LDA(dst, b, h) do { _Pragma("unroll") for (int m = 0; m < 4; ++m) _Pragma("unroll") for (int k = 0; k < 2; ++k) dst[m][k] = *(const PG8_LAS bf16x8*)(lds + PG8_SA(b, h) + aoff + m * 2048 + k * 1024); } while (0)
#define PG8_LDB(dst, b, h) do { _Pragma("unroll") for (int n = 0; n < 2; ++n) _Pragma("unroll") for (int k = 0; k < 2; ++k) dst[n][k] = *(const PG8_LAS bf16x8*)(lds + PG8_SB(b, h) + boff + n * 2048 + k * 1024); } while (0)
#define PG8_MMA(ai, bj, At, Bt) do { __builtin_amdgcn_s_setprio(1); _Pragma("unroll") for (int m = 0; m < 4; ++m) _Pragma("unroll") for (int n = 0; n < 2; ++n) _Pragma("unroll") for (int k = 0; k < 2; ++k) \
        acc[ai][bj][m][n] = __builtin_amdgcn_mfma_f32_16x16x32_bf16(Bt[n][k], At[m][k], acc[ai][bj][m][n], 0, 0, 0); __builtin_amdgcn_s_setprio(0); } while (0)
#define PG8_WAIT_V(n) asm volatile("s_waitcnt vmcnt(" #n ")" ::: "memory")
#define PG8_WAIT_L(n) asm volatile("s_waitcnt lgkmcnt(" #n ")" ::: "memory")
#define PG8_BAR __builtin_amdgcn_s_barrier()
#define PG8_SCHED __builtin_amdgcn_sched_barrier(0)
    Unit cur, nxt; int ui = 0;
    if (!S.next(0, cur)) return;
    f32x4 acc[2][2][4][2];
#pragma unroll
    for (int a = 0; a < 2; ++a)
#pragma unroll
        for (int b = 0; b < 2; ++b)
#pragma unroll
            for (int m = 0; m < 4; ++m)
#pragma unroll
                for (int n = 0; n < 2; ++n) acc[a][b][m][n] = (f32x4){0.f, 0.f, 0.f, 0.f};
    bf16x8 At[4][2], B0[2][2], B1[2][2];
    const char* cA; const char* cB;
    { const char* pa = (const char*)g.A + (size_t)cur.pm * tstep; const char* pb = (const char*)g.Bt + (size_t)cur.pn * tstep; const bool sw = S.swapped(cur); cA = sw ? pb : pa; cB = sw ? pa : pb; }
    S.a_ready(cur);
    if constexpr (SP2) {
        PG8_STAGE(PG8_SB(0, 0), cB, voffB); PG8_STAGE(PG8_SB(0, 1), cB + hstep, voffB); PG8_STAGE(PG8_SA(0, 0), cA, voffA); PG8_STAGE(PG8_SA(0, 1), cA + hstep, voffA);
        if (wr == 1) PG8_BAR;
        PG8_WAIT_V(2); PG8_BAR;
        PG8_STAGE(PG8_SB(1, 0), cB + kstep, voffB); PG8_STAGE(PG8_SA(1, 0), cA + kstep, voffA); PG8_STAGE(PG8_SB(1, 1), cB + hstep + kstep, voffB);
        PG8_WAIT_V(6); PG8_BAR;
    } else {
        PG8_STAGE(PG8_SB(0, 0), cB, voffB); PG8_STAGE(PG8_SA(0, 0), cA, voffA); PG8_STAGE(PG8_SB(0, 1), cB + hstep, voffB); PG8_STAGE(PG8_SA(0, 1), cA + hstep, voffA);
        if (wr == 1) PG8_BAR;
        PG8_WAIT_V(4); PG8_BAR;
        PG8_STAGE(PG8_SB(1, 0), cB + kstep, voffB); PG8_STAGE(PG8_SA(1, 0), cA + kstep, voffA); PG8_STAGE(PG8_SB(1, 1), cB + hstep + kstep, voffB);
        PG8_WAIT_V(6); PG8_BAR;
    }
    for (;;) {
        const bool has_next = S.next(ui + 1, nxt);
        const char* nA = cA; const char* nB = cB;
        if (has_next) { const char* pa = (const char*)g.A + (size_t)nxt.pm * tstep; const char* pb = (const char*)g.Bt + (size_t)nxt.pn * tstep; const bool sw = S.swapped(nxt); nA = sw ? pb : pa; nB = sw ? pa : pb; }
#ifdef PG8_REPK
        const int nrep_ = (g.N == PG8_REPK) ? 2 : 1;
        for (int rep_ = 0; rep_ < nrep_; ++rep_) {
        if (rep_) {
#pragma unroll
            for (int a = 0; a < 2; ++a)
#pragma unroll
                for (int b = 0; b < 2; ++b)
#pragma unroll
                    for (int m = 0; m < 4; ++m)
#pragma unroll
                        for (int n = 0; n < 2; ++n) acc[a][b][m][n] = (f32x4){0.f, 0.f, 0.f, 0.f}; }
#endif
        for (int t = 0; t < nt; t += 2) {
#ifdef PG8_REPK
            const bool last = (t == nt - 2) && (rep_ == nrep_ - 1);
            const bool lastk_ = (t == nt - 2);
#else
            const bool last = (t == nt - 2);
#endif
            const char* a1 = cA + (size_t)(t + 1) * kstep;
#ifdef PG8_REPK
            const char* a2 = last ? nA : (lastk_ ? cA : cA + (size_t)(t + 2) * kstep); const char* b2 = last ? nB : (lastk_ ? cB : cB + (size_t)(t + 2) * kstep);
#else
            const char* a2 = last ? nA : cA + (size_t)(t + 2) * kstep; const char* b2 = last ? nB : cB + (size_t)(t + 2) * kstep;
#endif
            const char* a3 = a2 + kstep; const char* b3 = b2 + kstep;
            if (last && has_next) S.a_ready(nxt);
            if constexpr (SP2) {
            PG8_LDB(B0, 0, 0); PG8_LDB(B1, 0, 1); PG8_SCHED; PG8_LDA(At, 0, 0); PG8_STAGE(PG8_SA(1, 1), a1 + hstep, voffA);
            PG8_WAIT_V(8); PG8_WAIT_L(0); PG8_BAR; PG8_MMA(0, 0, At, B0); PG8_MMA(0, 1, At, B1); PG8_BAR; PG8_SCHED;
            PG8_LDA(At, 0, 1); PG8_STAGE(PG8_SB(0, 0), b2, voffB); PG8_STAGE(PG8_SB(0, 1), b2 + hstep, voffB); PG8_STAGE(PG8_SA(0, 0), a2, voffA);
            PG8_WAIT_V(8); PG8_WAIT_L(0); PG8_BAR; PG8_MMA(1, 0, At, B0); PG8_MMA(1, 1, At, B1); PG8_BAR; PG8_SCHED;
            PG8_LDB(B0, 1, 0); PG8_LDB(B1, 1, 1); PG8_SCHED; PG8_LDA(At, 1, 0); PG8_STAGE(PG8_SA(0, 1), a2 + hstep, voffA);
            PG8_WAIT_V(8); PG8_WAIT_L(0); PG8_BAR; PG8_MMA(0, 0, At, B0); PG8_MMA(0, 1, At, B1); PG8_BAR; PG8_SCHED;
            PG8_LDA(At, 1, 1); PG8_STAGE(PG8_SB(1, 0), b3, voffB); PG8_STAGE(PG8_SB(1, 1), b3 + hstep, voffB); PG8_STAGE(PG8_SA(1, 0), a3, voffA);
            PG8_WAIT_V(8); PG8_WAIT_L(0); PG8_BAR; PG8_MMA(1, 0, At, B0); PG8_MMA(1, 1, At, B1); PG8_BAR; PG8_SCHED;
            } else {
            PG8_LDB(B0, 0, 0); PG8_SCHED; PG8_LDA(At, 0, 0); PG8_STAGE(PG8_SA(1, 1), a1 + hstep, voffA);
            PG8_WAIT_L(8); PG8_BAR; PG8_WAIT_L(0); PG8_MMA(0, 0, At, B0); PG8_BAR; PG8_SCHED;
            PG8_LDB(B1, 0, 1); PG8_STAGE(PG8_SB(0, 0), b2, voffB);
            PG8_BAR; PG8_WAIT_L(0); PG8_MMA(0, 1, At, B1); PG8_BAR;
            PG8_LDA(At, 0, 1); PG8_STAGE(PG8_SA(0, 0), a2, voffA);
            PG8_BAR; PG8_WAIT_L(0); PG8_MMA(1, 0, At, B0); PG8_BAR; PG8_SCHED;
            PG8_STAGE(PG8_SB(0, 1), b2 + hstep, voffB);
            PG8_WAIT_V(6); PG8_BAR; PG8_MMA(1, 1, At, B1); PG8_BAR;
            PG8_LDB(B0, 1, 0); PG8_SCHED; PG8_LDA(At, 1, 0); PG8_STAGE(PG8_SA(0, 1), a2 + hstep, voffA);
            PG8_WAIT_L(8); PG8_BAR; PG8_WAIT_L(0); PG8_MMA(0, 0, At, B0); PG8_BAR; PG8_SCHED;
            PG8_LDB(B1, 1, 1); PG8_STAGE(PG8_SB(1, 0), b3, voffB);
            PG8_BAR; PG8_WAIT_L(0); PG8_MMA(0, 1, At, B1); PG8_BAR;
            PG8_LDA(At, 1, 1); PG8_STAGE(PG8_SA(1, 0), a3, voffA);
            PG8_BAR; PG8_WAIT_L(0); PG8_MMA(1, 0, At, B0); PG8_BAR; PG8_SCHED;
            PG8_STAGE(PG8_SB(1, 1), b3 + hstep, voffB);
            PG8_WAIT_V(6); PG8_BAR; PG8_MMA(1, 1, At, B1); PG8_BAR;
            }
        }
#ifdef PG8_REPK
        }
#endif
        if constexpr (ALIGN_EPI) { if (wr == 0) PG8_BAR; }
        { int fr_ = fr, fq_ = fq; asm volatile("" : "+v"(fr_), "+v"(fq_));
          E(acc, cur, wr, wc, fr_, fq_);
#ifdef PG8_REPE
          if (g.N == PG8_REPE) { asm volatile("" : "+v"(fr_), "+v"(fq_)); E(acc, cur, wr, wc, fr_, fq_); }
#endif
          } S.done(cur);
        if (!has_next) break;
#pragma unroll
        for (int a = 0; a < 2; ++a)
#pragma unroll
            for (int b = 0; b < 2; ++b)
#pragma unroll
                for (int m = 0; m < 4; ++m)
#pragma unroll
                    for (int n = 0; n < 2; ++n) acc[a][b][m][n] = (f32x4){0.f, 0.f, 0.f, 0.f};
        cur = nxt; cA = nA; cB = nB; ++ui;
        if constexpr (ALIGN_EPI) { if (wr == 1) PG8_BAR; }
    }
    PG8_WAIT_V(0);
    if constexpr (!ALIGN_EPI) { if (wr == 0) PG8_BAR; }
    PG8_BAR;
#undef PG8_SA
#undef PG8_SB
#undef PG8_STAGE
#undef PG8_LDA
#undef PG8_LDB
#undef PG8_MMA
#undef PG8_WAIT_V
#undef PG8_WAIT_L
#undef PG8_BAR
#undef PG8_SCHED
}
}
__device__ __forceinline__ void prep_adaln(const float* c, const float* cctx, const float* adaw, const float* adab, float* MOD, int it, LAS float* sv, int tid) {
    const int l = it / 384, r = it % 384, ntile = r >> 5, ks = r & 31, k0 = ks * 64;
    if (tid < 320) { const int v = tid >> 6, k = tid & 63; const float cv = v < 4 ? c[v * D + k0 + k] : cctx[k0 + k]; sv[tid] = cv / (1.0f + expf(-cv)); }
    __syncthreads();
    const int n = ntile * 512 + tid; const float* w = adaw + (size_t)l * D * ADA + (size_t)k0 * ADA + n;
    float acc[5] = {0.f, 0.f, 0.f, 0.f, 0.f};
#pragma unroll 1
    for (int k0_ = 0; k0_ < 64; k0_ += 32) {
        float wv[32];
#pragma unroll
        for (int k = 0; k < 32; ++k) wv[k] = w[(size_t)(k0_ + k) * ADA];
#pragma unroll
        for (int k = 0; k < 32; ++k) {
#pragma unroll
            for (int v = 0; v < 5; ++v) acc[v] += sv[v * 64 + k0_ + k] * wv[k]; } }
    if (ks == 0) { const float bb = adab[l * ADA + n];
#pragma unroll
        for (int v = 0; v < 5; ++v) acc[v] += bb; }
#pragma unroll
    for (int v = 0; v < 5; ++v) atomicAdd(MOD + (size_t)(l * 5 + v) * ADA + n, acc[v]);
    __syncthreads();
}

__device__ __forceinline__ void prep_hymlp(const DArgs& a, float* H3out, bf16_t* H3b, int l, int Lx, int t0, LAS unsigned char* lds, int tid) {
    LAS float* zs = (LAS float*)lds;
    LAS float* h1 = (LAS float*)(lds + 4608);
    LAS float* h2 = (LAS float*)(lds + 4608 + 8192);
    LAS float* w1s = (LAS float*)(lds + 24576);
    LAS float* w2s = w1s + 33 * 64;
    LAS float* w3s = w2s + 64 * 64;
    { const float* w1 = a.in[I_HW1] + (size_t)l * 33 * 64; const float* w2 = a.in[I_HW2] + (size_t)l * 64 * 64; const float* w3 = a.in[I_HW3] + (size_t)l * 64 * 64;
      for (int i = tid; i < 33 * 64; i += NT) w1s[i] = w1[i];
      for (int i = tid; i < 64 * 64; i += NT) { w2s[i] = w2[i]; w3s[i] = w3[i]; } }
    for (int i = tid; i < 32 * 33; i += NT) { const int pos = i / 33, f = i % 33, t = t0 + pos;
        float z;
        if (f == 0) z = (float)t / (float)(Lx - 1);
        else { const int j = (f - 1) & 15; const float fj = 1e-4f + (float)j * ((15.0f - 1e-4f) / 15.0f); const float wpos = (6.283185307179586f * (float)t) / (float)Lx; const float arg = fj * wpos;
               z = (f <= 16) ? cosf(arg) : -sinf(arg); }
        zs[pos * 36 + f] = z; }
    __syncthreads();
    const int pos = tid >> 4, f4 = (tid & 15) * 4, t = t0 + pos;
    f32x4 s = *(const f32x4*)(a.in[I_HB1] + l * 64 + f4);
#pragma unroll 3
    for (int j = 0; j < 33; ++j) s += zs[pos * 36 + j] * *(const LAS f32x4*)(w1s + j * 64 + f4);
    { const f32x4 fr = *(const f32x4*)(a.in[I_HF1] + l * 64 + f4); *(LAS f32x4*)(h1 + pos * 64 + f4) = (f32x4){sinf(fr.x * s.x), sinf(fr.y * s.y), sinf(fr.z * s.z), sinf(fr.w * s.w)}; }
    __syncthreads();
    s = *(const f32x4*)(a.in[I_HB2] + l * 64 + f4);
#pragma unroll 4
    for (int j = 0; j < 64; ++j) s += h1[pos * 64 + j] * *(const LAS f32x4*)(w2s + j * 64 + f4);
    { const f32x4 fr = *(const f32x4*)(a.in[I_HF2] + l * 64 + f4); *(LAS f32x4*)(h2 + pos * 64 + f4) = (f32x4){sinf(fr.x * s.x), sinf(fr.y * s.y), sinf(fr.z * s.z), sinf(fr.w * s.w)}; }
    __syncthreads();
    s = *(const f32x4*)(a.in[I_HB3] + l * 64 + f4);
#pragma unroll 4
    for (int j = 0; j < 64; ++j) s += h2[pos * 64 + j] * *(const LAS f32x4*)(w3s + j * 64 + f4);
    { const f32x4 fr = *(const f32x4*)(a.in[I_HF3] + l * 64 + f4); const f32x4 hv = (f32x4){sinf(fr.x * s.x), sinf(fr.y * s.y), sinf(fr.z * s.z), sinf(fr.w * s.w)}; *(f32x4*)(H3out + (size_t)t * 64 + f4) = hv;
      if (H3b) { u32x2 pk; pk.x = pk2(hv.x, hv.y); pk.y = pk2(hv.z, hv.w); *(u32x2*)(H3b + (size_t)t * 64 + f4) = pk; } }
    __syncthreads();
}

__device__ __forceinline__ void transpose_item(const float* W, int ldw, int srccol_lane  , int k0, bf16_t* WT, int K, int dstrow0, LAS float* scr, int lane) {
    float wv[32];
#pragma unroll
    for (int i = 0; i < 32; ++i) { const int kk = 2 * i + (lane >> 5); wv[i] = srccol_lane >= 0 ? W[(size_t)(k0 + kk) * ldw + srccol_lane] : 0.f; }
#pragma unroll
    for (int i = 0; i < 32; ++i) { const int kk = 2 * i + (lane >> 5); scr[kk * 33 + (lane & 31)] = wv[i]; }
    LDS_WAIT();
    const int c = lane & 7;
#pragma unroll
    for (int j = 0; j < 4; ++j) { const int n = (lane >> 3) + 8 * j; const LAS float* s = scr + (8 * c) * 33 + n;
        u32x4 o; o.x = pk2(s[0 * 33], s[1 * 33]); o.y = pk2(s[2 * 33], s[3 * 33]); o.z = pk2(s[4 * 33], s[5 * 33]); o.w = pk2(s[6 * 33], s[7 * 33]);
        *(u32x4*)(WT + (size_t)(dstrow0 + n) * K + k0 + 8 * c) = o; }
    LDS_WAIT();
}
__device__ __forceinline__ int win_srccol(int n) {
    if (n >= 3072 && n < 4096) { const int u = (n - 3072) & 127, grp = u >> 3, e = u & 7; return (n & ~127) + (e < 4 ? 4 * grp + e : 64 + 4 * grp + (e - 4)); }
    return n < 6144 ? n : (n < 6656 ? n + 32 : (n < 6688 ? n - 512 : -1));
}

__device__ __forceinline__ void norm_row(const float* xrow, const float* nw, const float* mod, bf16_t* hrow, int lane) {
    f32x4 v[8]; float ss = 0.f;
#pragma unroll
    for (int j = 0; j < 8; ++j) { v[j] = ((const f32x4*)xrow)[lane + 64 * j]; ss += (v[j].x * v[j].x + v[j].y * v[j].y) + (v[j].z * v[j].z + v[j].w * v[j].w); }
    const float rstd = rsqrtf(wave_sum(ss) * (1.0f / D) + EPS);
#pragma unroll
    for (int j = 0; j < 8; ++j) { const int k = 4 * (lane + 64 * j);
        const f32x4 w = *(const f32x4*)(nw + k), sh = *(const f32x4*)(mod + k), sc = *(const f32x4*)(mod + D + k);
        const f32x4 o = v[j] * rstd * w * (sc + 1.0f) + sh;
        u32x2 pk; pk.x = pk2(o.x, o.y); pk.y = pk2(o.z, o.w);
        *(u32x2*)(hrow + k) = pk; }
}

__device__ __forceinline__ float block_sum(float v, LAS float* red, int tid) {
    v = wave_sum(v);
    if ((tid & 63) == 0) red[tid >> 6] = v;
    __syncthreads();
    float t = 0.f;
#pragma unroll
    for (int i = 0; i < NWAVES; ++i) t += red[i];
    __syncthreads();
    return t;
}
constexpr float HY_D0 = -3.0701134573253945f  , HY_D1 = -15.350567286626973f  ;

__device__ __forceinline__ void filt_ctx_item(const DArgs& a, unsigned char* ws, LAS unsigned char* lds, int c, int tid) {
    LAS float* w4s = (LAS float*)lds; LAS float* red = (LAS float*)(lds + 1024);
    if (tid < 256) { const int cc = tid >> 6, f = tid & 63; w4s[tid] = a.in[I_HW4][(size_t)f * 2048 + (cc >> 1) * 1024 + (cc & 1) * 512 + c]; }
    __syncthreads();
    const float dl = fabsf(HY_D0 + (HY_D1 - HY_D0) * ((float)c / 511.0f));
    const float* H3C = (const float*)(ws + WS_H3C);
    const int n = tid, dir = n >= 256 ? 1 : 0, t = dir ? (512 - n) : n;
    float s0 = 0.f, s1 = 0.f;
    if (n != 256) {
        const f32x4* hr = (const f32x4*)(H3C + (size_t)t * 64);
#pragma unroll
        for (int q = 0; q < 16; ++q) { const f32x4 hv = hr[q]; const f32x4 wa = ((const LAS f32x4*)(w4s + (dir * 2 + 0) * 64))[q], wb = ((const LAS f32x4*)(w4s + (dir * 2 + 1) * 64))[q];
            s0 += (hv.x * wa.x + hv.y * wa.y) + (hv.z * wa.z + hv.w * wa.w); s1 += (hv.x * wb.x + hv.y * wb.y) + (hv.z * wb.z + hv.w * wb.w); }
        const float dec = expf(-((float)t / 255.0f) * dl); s0 *= dec; s1 *= dec;
    }
    const float rs0 = rsqrtf(block_sum(s0 * s0, red, tid) + EPS), rs1 = rsqrtf(block_sum(s1 * s1, red, tid) + EPS);
    float* KC = (float*)(ws + WS_KC);
    KC[(size_t)(0 * 512 + c) * 512 + n] = s0 * rs0; KC[(size_t)(1 * 512 + c) * 512 + n] = s1 * rs1;
    __syncthreads();
}

__device__ __forceinline__ void prep_rope(f32x2* RT, int it, int tid) {
    const int idx = it * NT + tid, pos = idx >> 6, j = idx & 63;
    float ang;
    if (pos < SEQL) { const float inv = exp2f(-(float)(j & 31) * (13.287712379549449f / 32.0f)); ang = (float)(j < 32 ? (pos >> 6) : (pos & 63)) * inv; }
    else { const float inv = exp2f(-(float)j * (13.287712379549449f / 64.0f)); ang = (float)(pos - SEQL) * inv; }
    float sn, cs; sincosf(ang, &sn, &cs);
    RT[idx] = (f32x2){cs, sn};
}

__device__ __forceinline__ float sconv3(const bf16_t* p, int t, int Lx, float w0, float w1, float w2, float cb) {
    const float x0 = t > 0 ? bf2f(p[t - 1]) : 0.f, x1 = bf2f(p[t]), x2 = t < Lx - 1 ? bf2f(p[t + 1]) : 0.f;
    return w0 * x0 + w1 * x1 + w2 * x2 + cb;
}
__device__ __forceinline__ void ctx_conv256(const LAS float* kc, const LAS float* z, int b, int t4, int half, float (&o)[4]) {
    o[0] = o[1] = o[2] = o[3] = 0.f;
#pragma unroll 4
    for (int s4 = 0; s4 < 32; ++s4) { const int s = 128 * half + 4 * s4, d = 4 * t4 - s;
        const f32x4 zv = *(const LAS f32x4*)(z + b * 256 + s);
        const f32x4 wl = *(const LAS f32x4*)(kc + ((d - 4) & 511)), wh = *(const LAS f32x4*)(kc + (d & 511));
        const float w[8] = {wl.x, wl.y, wl.z, wl.w, wh.x, wh.y, wh.z, wh.w};
        const float zz[4] = {zv.x, zv.y, zv.z, zv.w};
#pragma unroll
        for (int j = 0; j < 4; ++j)
#pragma unroll
            for (int i = 0; i < 4; ++i) o[j] += w[4 + j - i] * zz[i]; }
}
__device__ __forceinline__ void hyena_ctx_item(const DArgs& a, unsigned char* ws, LAS unsigned char* lds, int c, int tid) {
    LAS float* kc = (LAS float*)lds; LAS float* za = (LAS float*)(lds + 4096); LAS float* zb = (LAS float*)(lds + 8192); LAS float* part = (LAS float*)(lds + 12288);
    const float* KC = (const float*)(ws + WS_KC);
    kc[tid] = KC[(size_t)(0 * 512 + c) * 512 + tid]; kc[512 + tid] = KC[(size_t)(1 * 512 + c) * 512 + tid];
    const float* cw = a.in[I_HCW]; const float* cbp = a.in[I_HCB];
    const float wv0 = cw[c], wv1 = cw[1536 + c], wv2 = cw[3072 + c], bv = cbp[c];
    const float wa0 = cw[512 + c], wa1 = cw[1536 + 512 + c], wa2 = cw[3072 + 512 + c], ba = cbp[512 + c];
    const float wb0 = cw[1024 + c], wb1 = cw[1536 + 1024 + c], wb2 = cw[3072 + 1024 + c], bb = cbp[1024 + c];
    const float bias0 = a.in[I_HBIAS][0 * 512 + c], bias1 = a.in[I_HBIAS][1 * 512 + c];
    const bf16_t* PT = (const bf16_t*)(ws + WS_PT);
    const int half = tid >> 8, b = (tid >> 6) & 3, t4 = tid & 63; const int rb = NLAT + b * LC;
    const bf16_t* pv = PT + (size_t)(PT_V + c) * MR + rb; const bf16_t* pg1 = PT + (size_t)(PT_G1 + c) * MR + rb; const bf16_t* pg2 = PT + (size_t)(PT_G2 + c) * MR + rb; const bf16_t* phg = PT + (size_t)(PT_HG + c) * MR + rb;
    bf16_t* GATED = (bf16_t*)(ws + WS_H);
    float z0[4], z1[4], o[4], g1v[4], g2v[4], hgv[4];
#pragma unroll
    for (int j = 0; j < 4; ++j) { z0[j] = sconv3(pv, 4 * t4 + j, LC, wv0, wv1, wv2, bv); g1v[j] = sconv3(pg1, 4 * t4 + j, LC, wa0, wa1, wa2, ba); g2v[j] = sconv3(pg2, 4 * t4 + j, LC, wb0, wb1, wb2, bb); hgv[j] = bf2f(phg[4 * t4 + j]); }
    if (half == 0) *(LAS f32x4*)(za + b * 256 + 4 * t4) = (f32x4){z0[0], z0[1], z0[2], z0[3]};
    __syncthreads();
    ctx_conv256(kc, za, b, t4, half, o);
    if (half == 1) *(LAS f32x4*)(part + b * 256 + 4 * t4) = (f32x4){o[0], o[1], o[2], o[3]};
    __syncthreads();
    if (half == 0) { const f32x4 pp = *(const LAS f32x4*)(part + b * 256 + 4 * t4); const float ps[4] = {pp.x, pp.y, pp.z, pp.w};
#pragma unroll
        for (int j = 0; j < 4; ++j) z1[j] = g1v[j] * (o[j] + ps[j] + bias0 * z0[j]);
        *(LAS f32x4*)(zb + b * 256 + 4 * t4) = (f32x4){z1[0], z1[1], z1[2], z1[3]}; }
    __syncthreads();
    ctx_conv256(kc + 512, zb, b, t4, half, o);
    if (half == 1) *(LAS f32x4*)(part + b * 256 + 4 * t4) = (f32x4){o[0], o[1], o[2], o[3]};
    __syncthreads();
    if (half == 0) { const f32x4 pp = *(const LAS f32x4*)(part + b * 256 + 4 * t4); const float ps[4] = {pp.x, pp.y, pp.z, pp.w};
#pragma unroll
        for (int j = 0; j < 4; ++j) { const int t = 4 * t4 + j; const float z2 = g2v[j] * (o[j] + ps[j] + bias1 * z1[j]);
            GATED[(size_t)(rb + t) * D + 512 + c] = (bf16_t)f2bf(z2 * siluf_(hgv[j])); } }
    __syncthreads();
}

struct EpiInProj {
    static constexpr bool PERM = true, AFTER_DRAIN = false;
    bf16_t* P; bf16_t* PT; float* LR; const float* RT;
    __device__ __forceinline__ void operator()(const pg8::f32x4 (&acc)[2][2][4][2], const pg8::Unit& u, int wr, int wc, int fr, int fq) const {
        const int row0 = u.pm * 256 + wr * 64 + fr, pn = u.pn;
        if (pn >= 12 && pn < 16) {
            const int colbase = pn * 256 - 2048 + wc * 32 + 8 * fq; const int j0 = 4 * (4 * wc + fq); const float ksc = pn >= 14 ? 0.08838834764831845f : 1.0f;
#pragma unroll
            for (int ai = 0; ai < 2; ++ai)
#pragma unroll
                for (int m = 0; m < 4; ++m) { const int row = row0 + ai * 128 + m * 16; const int pos = row < NLAT ? (row & (SEQL - 1)) : SEQL + ((row - NLAT) & (LC - 1));
                    const pg8::f32x4 t0 = *(const pg8::f32x4*)(RT + ((size_t)pos * 64 + j0) * 2), t1 = *(const pg8::f32x4*)(RT + ((size_t)pos * 64 + j0) * 2 + 4);
                    bf16_t* rowp = P + (size_t)row * LDP + colbase;
#pragma unroll
                    for (int bj = 0; bj < 2; ++bj) { const pg8::f32x4 x1 = acc[ai][bj][m][0] * ksc, x2 = acc[ai][bj][m][1] * ksc;
                        u32x4 w; w.x = pk2(x1[0] * t0[0] - x2[0] * t0[1], x1[1] * t0[2] - x2[1] * t0[3]); w.y = pk2(x1[2] * t1[0] - x2[2] * t1[1], x1[3] * t1[2] - x2[3] * t1[3]);
                        w.z = pk2(x1[0] * t0[1] + x2[0] * t0[0], x1[1] * t0[3] + x2[1] * t0[2]); w.w = pk2(x1[2] * t1[1] + x2[2] * t1[0], x1[3] * t1[3] + x2[3] * t1[2]);
                        __builtin_nontemporal_store(w, (u32x4*)(rowp + bj * 128)); } }
        } else if (pn < 4 || (pn >= 16 && pn < 26)) {
            const int colbase = (pn < 4 ? pn * 256 : pn * 256 - 2048) + wc * 32 + 8 * fq;
#pragma unroll
            for (int ai = 0; ai < 2; ++ai)
#pragma unroll
                for (int m = 0; m < 4; ++m) { bf16_t* rowp = P + (size_t)(row0 + ai * 128 + m * 16) * LDP + colbase;
#pragma unroll
                    for (int bj = 0; bj < 2; ++bj) { const pg8::f32x4 v0 = acc[ai][bj][m][0], v1 = acc[ai][bj][m][1];
                        u32x4 w; w.x = pk2(v0[0], v0[1]); w.y = pk2(v0[2], v0[3]); w.z = pk2(v1[0], v1[1]); w.w = pk2(v1[2], v1[3]);
                        __builtin_nontemporal_store(w, (u32x4*)(rowp + bj * 128)); } }
        } else if (pn < 12) {
            const int prow0 = (pn - 4) * 256 + wr * 64 + fr, tok0 = u.pm * 256 + wc * 32 + 8 * fq;
#pragma unroll
            for (int ai = 0; ai < 2; ++ai)
#pragma unroll
                for (int m = 0; m < 4; ++m) { bf16_t* rowp = PT + (size_t)(prow0 + ai * 128 + m * 16) * MR + tok0;
#pragma unroll
                    for (int bj = 0; bj < 2; ++bj) { const pg8::f32x4 v0 = acc[ai][bj][m][0], v1 = acc[ai][bj][m][1];
                        u32x4 w; w.x = pk2(v0[0], v0[1]); w.y = pk2(v0[2], v0[3]); w.z = pk2(v1[0], v1[1]); w.w = pk2(v1[2], v1[3]);
                        __builtin_nontemporal_store(w, (u32x4*)(rowp + bj * 128)); } }
        } else {
            if (wc == 0) {
#pragma unroll
                for (int ai = 0; ai < 2; ++ai)
#pragma unroll
                    for (int m = 0; m < 4; ++m) { float* rowp = LR + (size_t)(row0 + ai * 128 + m * 16) * 32 + 8 * fq;
                        *(pg8::f32x4*)(rowp) = acc[ai][0][m][0]; *(pg8::f32x4*)(rowp + 4) = acc[ai][0][m][1]; }
            }
        }
    }
};
struct EpiGlu {
    static constexpr bool PERM = true, AFTER_DRAIN = false;
    const bf16_t* GG; bf16_t* GATED; const float* bias;
    __device__ __forceinline__ void operator()(const pg8::f32x4 (&acc)[2][2][4][2], const pg8::Unit& u, int wr, int wc, int fr, int fq) const {
        const int row0 = u.pm * 256 + wr * 64 + fr, col0 = u.pn * 256 + wc * 32 + 8 * fq;
        pg8::f32x4 b0[2], b1[2];
#pragma unroll
        for (int bj = 0; bj < 2; ++bj) { b0[bj] = *(const pg8::f32x4*)(bias + col0 + bj * 128); b1[bj] = *(const pg8::f32x4*)(bias + col0 + bj * 128 + 4); }
#pragma unroll
        for (int ai = 0; ai < 2; ++ai) {
            u32x4 gg[4][2];
#pragma unroll
            for (int m = 0; m < 4; ++m)
#pragma unroll
                for (int bj = 0; bj < 2; ++bj) gg[m][bj] = *(const u32x4*)(GG + (size_t)(row0 + ai * 128 + m * 16) * 512 + col0 + bj * 128);
#pragma unroll
            for (int m = 0; m < 4; ++m) { const size_t row = (size_t)(row0 + ai * 128 + m * 16);
#pragma unroll
                for (int bj = 0; bj < 2; ++bj) { float g[8], res[8]; unpack8(gg[m][bj], g);
#pragma unroll
                    for (int j = 0; j < 4; ++j) { res[j] = g[j] * sigmoidf_(acc[ai][bj][m][0][j] + b0[bj][j]); res[4 + j] = g[4 + j] * sigmoidf_(acc[ai][bj][m][1][j] + b1[bj][j]); }
                    *(u32x4*)(GATED + row * D + col0 + bj * 128) = pack8(res); } }
            asm volatile("" ::: "memory");
        }
    }
};
struct EpiOut {
    static constexpr bool PERM = false, AFTER_DRAIN = false;
    const float* xl_old; const float* xc_old; float* xl_new; float* xc_new; const float* mod;
    __device__ __forceinline__ void operator()(const pg8::f32x4 (&acc)[2][2][4][2], const pg8::Unit& u, int wr, int wc, int fr, int fq) const {
        const int row0 = u.pm * 256 + wr * 64 + fr, col0 = u.pn * 256 + wc * 32 + 4 * fq;
        const bool lat = u.pm < 64;
        const float* xo = lat ? xl_old : xc_old - (size_t)NLAT * D; float* xn = lat ? xl_new : xc_new - (size_t)NLAT * D;
#pragma unroll
        for (int ai = 0; ai < 2; ++ai) {
            const int v = lat ? ((u.pm * 256 + ai * 128) >> 12) : 4;
            const float* gt = mod + (size_t)v * ADA + 2 * D;
#pragma unroll
            for (int m = 0; m < 4; ++m) { const size_t off = (size_t)(row0 + ai * 128 + m * 16) * D + col0;
#pragma unroll
                for (int bj = 0; bj < 2; ++bj)
#pragma unroll
                    for (int n = 0; n < 2; ++n) { const int cc = bj * 128 + n * 16; const pg8::f32x4 gv = *(const pg8::f32x4*)(gt + col0 + cc), xv = *(const pg8::f32x4*)(xo + off + cc);
                        *(pg8::f32x4*)(xn + off + cc) = xv + gv * acc[ai][bj][m][n]; } }
        }
    }
};
typedef short bf16x8 __attribute__((ext_vector_type(8)));
typedef short bf16x4 __attribute__((ext_vector_type(4)));
__device__ __forceinline__ unsigned off_b(unsigned row, unsigned ch) { return 256u * row + 16u * (ch ^ (((row & 3) << 2) | ((row >> 2) & 3))); }
__device__ __forceinline__ bf16x8 img_row_frag(const LAS unsigned char* img, unsigned lane, unsigned rb, unsigned s) { return *(const LAS bf16x8*)(img + off_b((lane & 15) + 16 * rb, 4 * s + (lane >> 4))); }
__device__ __forceinline__ bf16x4 img_tr4(const LAS unsigned char* img, unsigned lane, unsigned c, unsigned row0) {
    const unsigned q = (lane & 15) >> 2, p = lane & 3;
    return __builtin_amdgcn_ds_read_tr16_b64_v4i16((LAS bf16x4*)(img + off_b(row0 + q, 2 * c + (p >> 1)) + 8 * (p & 1)));
}
__device__ __forceinline__ bf16x8 img_tr_frag(const LAS unsigned char* img, unsigned lane, unsigned c, unsigned ks) {
    const unsigned g = lane >> 4; const bf16x4 lo = img_tr4(img, lane, c, 32 * ks + 8 * g), hi = img_tr4(img, lane, c, 32 * ks + 8 * g + 4);
    return __builtin_shufflevector(lo, hi, 0, 1, 2, 3, 4, 5, 6, 7);
}
__device__ __forceinline__ bf16x8 img_tr_frag_acc(const LAS unsigned char* img, unsigned lane, unsigned c, unsigned ks) {
    const unsigned g = lane >> 4; const bf16x4 lo = img_tr4(img, lane, c, 32 * ks + 4 * g), hi = img_tr4(img, lane, c, 32 * ks + 16 + 4 * g);
    return __builtin_shufflevector(lo, hi, 0, 1, 2, 3, 4, 5, 6, 7);
}
__device__ __forceinline__ bf16x8 acc_pair_frag(const f32x4 a0, const f32x4 a1) {
    u32x4 w; w.x = pk2(a0.x, a0.y); w.y = pk2(a0.z, a0.w); w.z = pk2(a1.x, a1.y); w.w = pk2(a1.z, a1.w);
    return __builtin_bit_cast(bf16x8, w);
}
#define MFMA16(A_, B_, C_) __builtin_amdgcn_mfma_f32_16x16x32_bf16((A_), (B_), (C_), 0, 0, 0)
__device__ __forceinline__ void stage_tile128(LAS unsigned char* img, const bf16_t* g, size_t ld, int tid) {
#pragma unroll
    for (int i = 0; i < 4; ++i) { const int n = tid + NT * i, row = n >> 4, ch = n & 15; *(LAS u32x4*)(img + off_b(row, ch)) = *(const u32x4*)(g + (size_t)row * ld + ch * 8); }
}

constexpr int RCH = 128, RNCH = 34;
constexpr size_t WS_RST = WS_OB;
__device__ __forceinline__ int ret_rowbase(int b, int cc) { return cc < 2 ? NLAT + b * LC + cc * RCH : b * SEQL + (cc - 2) * RCH; }
__device__ __forceinline__ float ret_log2g(int h) { return log2f(1.0f - exp2f(-5.0f - (float)h)); }

__device__ __forceinline__ void ret_passA(unsigned char* ws, LAS unsigned char* lds, int item, int tid) {
    const int bh = item / RNCH, cc = item % RNCH, b = bh >> 2, h = bh & 3;
    const int lane = tid & 63, w = tid >> 6, g = lane >> 4;
    LAS unsigned char* KF = lds; LAS unsigned char* KB = lds + 32768; LAS unsigned char* VI = lds + 65536;
    const bf16_t* P = (const bf16_t*)(ws + WS_P) + (size_t)ret_rowbase(b, cc) * LDP;
    const float l2g = ret_log2g(h);
    __syncthreads();
#pragma unroll
    for (int i = 0; i < 4; ++i) { const int n = tid + NT * i, row = n >> 4, ch = n & 15;
        const u32x4 kr = *(const u32x4*)(P + (size_t)row * LDP + PC_RK + h * 128 + ch * 8);
        float kf[8], a[8], c[8]; unpack8(kr, kf);
        const float sf = exp2f(l2g * (float)(RCH - 1 - row)), sb = exp2f(l2g * (float)row);
#pragma unroll
        for (int x = 0; x < 8; ++x) { a[x] = kf[x] * sf; c[x] = kf[x] * sb; }
        *(LAS u32x4*)(KF + off_b(row, ch)) = pack8(a); *(LAS u32x4*)(KB + off_b(row, ch)) = pack8(c);
        *(LAS u32x4*)(VI + off_b(row, ch)) = *(const u32x4*)(P + (size_t)row * LDP + PC_RV + h * 128 + ch * 8); }
    __syncthreads();
    bf16x8 af[4], ab[4];
#pragma unroll
    for (int ks = 0; ks < 4; ++ks) { af[ks] = img_tr_frag(KF, lane, w, ks); ab[ks] = img_tr_frag(KB, lane, w, ks); }
    bf16_t* ST = (bf16_t*)(ws + WS_RST) + ((size_t)(bh * 2) * RNCH + cc) * (128 * 128);
#pragma unroll 2
    for (int E = 0; E < 8; ++E) {
        f32x4 cf = {0.f, 0.f, 0.f, 0.f}, cb = {0.f, 0.f, 0.f, 0.f};
#pragma unroll
        for (int ks = 0; ks < 4; ++ks) { const bf16x8 vb = img_tr_frag(VI, lane, E, ks); cf = MFMA16(af[ks], vb, cf); cb = MFMA16(ab[ks], vb, cb); }
        const int e = 16 * E + (lane & 15), d0 = 16 * w + 4 * g;
        u32x2 o; o.x = pk2(cf.x, cf.y); o.y = pk2(cf.z, cf.w); *(u32x2*)(ST + (size_t)e * 128 + d0) = o;
        o.x = pk2(cb.x, cb.y); o.y = pk2(cb.z, cb.w); *(u32x2*)(ST + (size_t)RNCH * 128 * 128 + (size_t)e * 128 + d0) = o;
    }
}
__device__ __forceinline__ void ret_passB(unsigned char* ws, int gt  ) {
    const int el = gt & 2047, bd = gt >> 11, bh = bd >> 1, dir = bd & 1, h = bh & 3;
    const float gC = exp2f(ret_log2g(h) * (float)RCH);
    bf16_t* base = (bf16_t*)(ws + WS_RST) + (size_t)bd * RNCH * (128 * 128) + (size_t)el * 8;
    float acc[8];
#pragma unroll
    for (int x = 0; x < 8; ++x) acc[x] = 0.f;
#pragma unroll 1
    for (int s0 = 0; s0 < RNCH; s0 += 17) {
        u32x4 kvr[17];
#pragma unroll
        for (int j = 0; j < 17; ++j) { const int s = s0 + j; const int cc = dir == 0 ? s : (s < 2 ? 1 - s : 35 - s); kvr[j] = *(const u32x4*)(base + (size_t)cc * (128 * 128)); }
#pragma unroll
        for (int j = 0; j < 17; ++j) { const int s = s0 + j; const int cc = dir == 0 ? s : (s < 2 ? 1 - s : 35 - s);
            float kv[8]; unpack8(kvr[j], kv);
            *(u32x4*)(base + (size_t)cc * (128 * 128)) = pack8(acc);
#pragma unroll
            for (int x = 0; x < 8; ++x) acc[x] = gC * acc[x] + kv[x]; }
    }
}
__device__ __forceinline__ void ret_passC(const DArgs& a, unsigned char* ws, LAS unsigned char* lds, int l, int item, int tid) {
    const int bh = item / RNCH, cc = item % RNCH, b = bh >> 2, h = bh & 3;
    const int lane = tid & 63, w = tid >> 6, g = lane >> 4, il = lane & 15;
    LAS unsigned char* KI = lds; LAS unsigned char* VI = lds + 32768; LAS unsigned char* SF = lds + 65536; LAS unsigned char* SB = lds + 98304;
    const int rowbase = ret_rowbase(b, cc);
    const bf16_t* P = (const bf16_t*)(ws + WS_P) + (size_t)rowbase * LDP;
    const bf16_t* STf = (const bf16_t*)(ws + WS_RST) + ((size_t)(bh * 2) * RNCH + cc) * (128 * 128);
    const bf16_t* STb = STf + (size_t)RNCH * 128 * 128;
    __syncthreads();
    stage_tile128(KI, P + PC_RK + h * 128, LDP, tid); stage_tile128(VI, P + PC_RV + h * 128, LDP, tid);
    stage_tile128(SF, STf, 128, tid); stage_tile128(SB, STb, 128, tid);
    bf16x8 qf[4];
    { const bf16_t* qr = P + (size_t)(16 * w + il) * LDP + PC_RQ + h * 128 + 8 * g;
#pragma unroll
      for (int ks = 0; ks < 4; ++ks) qf[ks] = *(const bf16x8*)(qr + 32 * ks); }
    const int iloc = 16 * w + il;
    u32x2 grv[8]; f32x4 nvv[8];
    { const bf16_t* gp0 = (const bf16_t*)(ws + WS_P) + ((size_t)rowbase + iloc) * LDP + PC_RG + h * 128 + 4 * g; const float* nw0 = a.in[I_RNW] + l * 512 + h * 128 + 4 * g;
#pragma unroll
      for (int E = 0; E < 8; ++E) { grv[E] = *(const u32x2*)(gp0 + 16 * E); nvv[E] = *(const f32x4*)(nw0 + 16 * E); } }
    __syncthreads();
    const float l2g = ret_log2g(h);
    f32x4 o[8];
    { const float sf = exp2f(l2g * (float)(iloc + 1)), sb = exp2f(l2g * (float)(RCH - iloc));
#pragma unroll
      for (int E = 0; E < 8; ++E) { f32x4 rf = {0.f, 0.f, 0.f, 0.f}, rb = {0.f, 0.f, 0.f, 0.f};
#pragma unroll
          for (int ks = 0; ks < 4; ++ks) { rf = MFMA16(img_row_frag(SF, lane, E, ks), qf[ks], rf); rb = MFMA16(img_row_frag(SB, lane, E, ks), qf[ks], rb); }
          o[E] = rf * sf + rb * sb; } }
    f32x4 at[8];
#pragma unroll
    for (int T = 0; T < 8; ++T) { f32x4 c = {0.f, 0.f, 0.f, 0.f};
#pragma unroll
        for (int ks = 0; ks < 4; ++ks) c = MFMA16(img_row_frag(KI, lane, T, ks), qf[ks], c);
#pragma unroll
        for (int r = 0; r < 4; ++r) { const int j = 16 * T + 4 * g + r; const int dd = iloc > j ? iloc - j : j - iloc; c[r] *= (dd == 0 ? 2.0f : exp2f(l2g * (float)dd)); }
        at[T] = c; }
#pragma unroll
    for (int s = 0; s < 4; ++s) { const bf16x8 bfr = acc_pair_frag(at[2 * s], at[2 * s + 1]);
#pragma unroll
        for (int E = 0; E < 8; ++E) o[E] = MFMA16(img_tr_frag_acc(VI, lane, E, s), bfr, o[E]); }
    float ss = 0.f;
#pragma unroll
    for (int E = 0; E < 8; ++E) ss += (o[E].x * o[E].x + o[E].y * o[E].y) + (o[E].z * o[E].z + o[E].w * o[E].w);
    ss += __shfl_xor(ss, 16); ss += __shfl_xor(ss, 32);
    const float rn = rsqrtf(ss * (1.0f / 128.0f) + EPS);
    const size_t row = (size_t)rowbase + iloc;
    const bf16_t* gp = (const bf16_t*)(ws + WS_P) + row * LDP + PC_RG + h * 128 + 4 * g;
    const float* nw = a.in[I_RNW] + l * 512 + h * 128 + 4 * g;
    bf16_t* op = (bf16_t*)(ws + WS_H) + row * D + 1024 + h * 128 + 4 * g;
#pragma unroll
    for (int E = 0; E < 8; ++E) { const u32x2 gr = grv[E]; const f32x4 nv = nvv[E];
        u32x2 ov; ov.x = pk2(o[E].x * rn * nv.x * siluf_(bflo(gr.x)), o[E].y * rn * nv.y * siluf_(bfhi(gr.x)));
        ov.y = pk2(o[E].z * rn * nv.z * siluf_(bflo(gr.y)), o[E].w * rn * nv.w * siluf_(bfhi(gr.y)));
        *(u32x2*)(op + 16 * E) = ov; }
}
constexpr int GCH = 64, GNCH = 68;
constexpr size_t WS_GST = WS_OB + (size_t)2 * OBSZ * 2;
constexpr size_t WS_GDEC = WS_END;
constexpr size_t WS_H3B = WS_GDEC + (size_t)16 * 2 * GNCH * 64 * 4;
constexpr size_t WS_ROPE = WS_H3B + (size_t)2 * 4096 * 64 * 2;
constexpr size_t WS_TWID = WS_ROPE + (size_t)(SEQL + LC) * 64 * 8;
constexpr size_t WS_END2 = WS_TWID + 4096 * 8;
__device__ __forceinline__ int gla_rowbase(int b, int cg) { return cg < 4 ? NLAT + b * LC + cg * GCH : b * SEQL + (cg - 4) * GCH; }

constexpr int GLS = 68;
__device__ __forceinline__ void gla_gates_compute(const DArgs& a, unsigned char* ws, LAS float* BF, LAS float* BB, LAS float* GW  , int l, int h, int rowbase, int tid) {
    const int t = tid >> 3, d8 = tid & 7;
    const float* lr = (const float*)(ws + WS_LR) + (size_t)(rowbase + t) * 32;
    f32x4 lv[8];
#pragma unroll
    for (int q = 0; q < 8; ++q) lv[q] = ((const f32x4*)lr)[q];
    { const int dir = tid >> 8, r = (tid >> 4) & 15, c4 = (tid & 15) * 4;
      *(LAS f32x4*)(GW + (dir * 17 + r) * 64 + c4) = *(const f32x4*)(a.in[I_GGW] + (size_t)(l * 2 + dir) * 16 * 256 + r * 256 + h * 64 + c4);
      if (tid < 32) { const int dd = tid >> 4; *(LAS f32x4*)(GW + (dd * 17 + 16) * 64 + c4) = *(const f32x4*)(a.in[I_GGB] + (size_t)(l * 2 + dd) * 256 + h * 64 + c4); } }
    __syncthreads();
    bf16_t* GLG = (bf16_t*)(ws + WS_WIN);
#pragma unroll
    for (int dir = 0; dir < 2; ++dir) {
        const LAS float* gw = GW + dir * 17 * 64 + 8 * d8;
        f32x4 s0 = *(const LAS f32x4*)(gw + 16 * 64), s1 = *(const LAS f32x4*)(gw + 16 * 64 + 4);
#pragma unroll
        for (int j = 0; j < 16; ++j) { const float lj = lv[dir * 4 + (j >> 2)][j & 3]; s0 += lj * *(const LAS f32x4*)(gw + j * 64); s1 += lj * *(const LAS f32x4*)(gw + j * 64 + 4); }
        LAS float* dst = (dir ? BB : BF) + t * GLS + 8 * d8;
        float la[8];
#pragma unroll
        for (int x = 0; x < 8; ++x) { const float s = x < 4 ? s0[x] : s1[x - 4]; const float e = __expf(-fabsf(s)); const float ls = fminf(s, 0.f) - __logf(1.0f + e); la[x] = ls * (1.0f / 16.0f); }
        const u32x4 pk = pack8(la);
        *(u32x4*)(GLG + ((size_t)dir * MR + rowbase + t) * 256 + h * 64 + 8 * d8) = pk;
        float lq[8]; unpack8(pk, lq);
        *(LAS f32x4*)dst = (f32x4){lq[0], lq[1], lq[2], lq[3]}; *(LAS f32x4*)(dst + 4) = (f32x4){lq[4], lq[5], lq[6], lq[7]};
    }
}
__device__ __forceinline__ void gla_gates_load(unsigned char* ws, LAS float* BF, LAS float* BB, int h, int rowbase, int tid) {
    const int t = tid >> 3, d8 = tid & 7;
    const bf16_t* GLG = (const bf16_t*)(ws + WS_WIN);
#pragma unroll
    for (int dir = 0; dir < 2; ++dir) { float lq[8]; unpack8(*(const u32x4*)(GLG + ((size_t)dir * MR + rowbase + t) * 256 + h * 64 + 8 * d8), lq);
        LAS float* dst = (dir ? BB : BF) + t * GLS + 8 * d8;
        *(LAS f32x4*)dst = (f32x4){lq[0], lq[1], lq[2], lq[3]}; *(LAS f32x4*)(dst + 4) = (f32x4){lq[4], lq[5], lq[6], lq[7]}; }
}
__device__ __forceinline__ void gla_scan(LAS float* BF, LAS float* BB, int tid) {
    const int lane = tid & 63, w = tid >> 6;
    __syncthreads();
#pragma unroll 4
    for (int c = 0; c < 16; ++c) { const int col = 16 * w + c; const int dir = col >> 6, d = col & 63;
        LAS float* p = (dir ? BB : BF) + (dir ? 63 - lane : lane) * GLS + d;
        float v = *p;
#pragma unroll
        for (int off = 1; off < 64; off <<= 1) { const float u = __shfl_up(v, off); if (lane >= off) v += u; }
        *p = v; }
    __syncthreads();
}

__device__ __forceinline__ void gla_passA(const DArgs& a, unsigned char* ws, LAS unsigned char* lds, int l, int item, int tid) {
    const int bh = item / GNCH, cg = item % GNCH, b = bh >> 2, h = bh & 3;
    const int lane = tid & 63, w = tid >> 6, g = lane >> 4;
    LAS float* BF = (LAS float*)lds; LAS float* BB = (LAS float*)(lds + 17408); LAS unsigned char* KH = lds + 34816; LAS unsigned char* VI = lds + 34816 + 16384;
    const int rowbase = gla_rowbase(b, cg);
    const bf16_t* P = (const bf16_t*)(ws + WS_P) + (size_t)rowbase * LDP;
    const int t = tid >> 3, d8 = tid & 7;
    const u32x4 kraw = *(const u32x4*)(P + (size_t)t * LDP + PC_GK + h * 64 + 8 * d8);
    u32x4 vraw[2];
#pragma unroll
    for (int i = 0; i < 2; ++i) { const int n = tid + NT * i; vraw[i] = *(const u32x4*)(P + (size_t)(n >> 4) * LDP + PC_GV + h * 128 + (n & 15) * 8); }
    gla_gates_compute(a, ws, BF, BB, (LAS float*)(lds + 34816 + 32768), l, h, rowbase, tid);
    gla_scan(BF, BB, tid);
    { float kf[8], x0[8], x1[8]; unpack8(kraw, kf);
#pragma unroll
      for (int x = 0; x < 8; ++x) { const int d = 8 * d8 + x; x0[x] = kf[x] * __expf(BF[63 * GLS + d] - BF[t * GLS + d]); x1[x] = kf[x] * __expf(BB[d] - BB[t * GLS + d]); }
      *(LAS u32x4*)(KH + off_b(t, d8)) = pack8(x0); *(LAS u32x4*)(KH + off_b(t, 8 + d8)) = pack8(x1);
#pragma unroll
      for (int i = 0; i < 2; ++i) { const int n = tid + NT * i; *(LAS u32x4*)(VI + off_b(n >> 4, n & 15)) = vraw[i]; }
      if (tid < 128) { const int dir = tid >> 6, d = tid & 63; ((float*)(ws + WS_GDEC))[((size_t)(bh * 2 + dir) * GNCH + cg) * 64 + d] = __expf(dir ? BB[d] : BF[63 * GLS + d]); } }
    __syncthreads();
    const int dir = w >> 2, Dt = w & 3;
    bf16x8 af[2];
#pragma unroll
    for (int ks = 0; ks < 2; ++ks) af[ks] = img_tr_frag(KH, lane, dir * 4 + Dt, ks);
    bf16_t* ST = (bf16_t*)(ws + WS_GST) + ((size_t)(bh * 2 + dir) * GNCH + cg) * (128 * 64);
#pragma unroll 2
    for (int E = 0; E < 8; ++E) {
        f32x4 c = {0.f, 0.f, 0.f, 0.f};
#pragma unroll
        for (int ks = 0; ks < 2; ++ks) c = MFMA16(af[ks], img_tr_frag(VI, lane, E, ks), c);
        u32x2 o; o.x = pk2(c.x, c.y); o.y = pk2(c.z, c.w);
        *(u32x2*)(ST + (size_t)(16 * E + (lane & 15)) * 64 + 16 * Dt + 4 * g) = o;
    }
}
__device__ __forceinline__ void gla_passB(unsigned char* ws, LAS unsigned char* lds, int blk, int tid) {
    const int bd = blk >> 1, dir = bd & 1, el = (blk & 1) * 512 + tid;
    LAS float* decs = (LAS float*)lds;
    { const float* dsrc = (const float*)(ws + WS_GDEC) + (size_t)bd * GNCH * 64;
      for (int i = tid; i < GNCH * 64; i += NT) decs[i] = dsrc[i]; }
    __syncthreads();
    bf16_t* base = (bf16_t*)(ws + WS_GST) + (size_t)bd * GNCH * (128 * 64) + (size_t)el * 8;
    const int d0 = (el & 7) * 8;
    float acc[8];
#pragma unroll
    for (int x = 0; x < 8; ++x) acc[x] = 0.f;
#pragma unroll 1
    for (int s0 = 0; s0 < GNCH; s0 += 17) {
        u32x4 kvr[17];
#pragma unroll
        for (int j = 0; j < 17; ++j) { const int s = s0 + j; const int cg = dir == 0 ? s : (s < 4 ? 3 - s : 71 - s); kvr[j] = *(const u32x4*)(base + (size_t)cg * (128 * 64)); }
#pragma unroll
        for (int j = 0; j < 17; ++j) { const int s = s0 + j; const int cg = dir == 0 ? s : (s < 4 ? 3 - s : 71 - s);
            float kv[8]; unpack8(kvr[j], kv);
            const f32x4 q0 = *(const LAS f32x4*)(decs + cg * 64 + d0), q1 = *(const LAS f32x4*)(decs + cg * 64 + d0 + 4);
            *(u32x4*)(base + (size_t)cg * (128 * 64)) = pack8(acc);
#pragma unroll
            for (int x = 0; x < 8; ++x) acc[x] = (x < 4 ? q0[x] : q1[x - 4]) * acc[x] + kv[x]; }
    }
    __syncthreads();
}
__device__ __forceinline__ void gla_passC(const DArgs& a, unsigned char* ws, LAS unsigned char* lds, int l, int item, int tid) {
    const int bh = item / GNCH, cg = item % GNCH, b = bh >> 2, h = bh & 3;
    const int lane = tid & 63, w = tid >> 6, g = lane >> 4, il = lane & 15;
    LAS float* BF = (LAS float*)lds; LAS float* BB = (LAS float*)(lds + 17408);
    LAS unsigned char* QKF = lds + 34816; LAS unsigned char* QKB = QKF + 16384; LAS unsigned char* QH = QKB + 16384; LAS unsigned char* VI = QH + 16384; LAS unsigned char* SI = VI + 16384;
    const int rowbase = gla_rowbase(b, cg);
    const bf16_t* P = (const bf16_t*)(ws + WS_P) + (size_t)rowbase * LDP;
    const int t = tid >> 3, d8 = tid & 7;
    const u32x4 qraw = *(const u32x4*)(P + (size_t)t * LDP + PC_GQ + h * 64 + 8 * d8), kraw = *(const u32x4*)(P + (size_t)t * LDP + PC_GK + h * 64 + 8 * d8);
    u32x4 vraw[2], sraw[4];
#pragma unroll
    for (int i = 0; i < 2; ++i) { const int n = tid + NT * i; vraw[i] = *(const u32x4*)(P + (size_t)(n >> 4) * LDP + PC_GV + h * 128 + (n & 15) * 8); }
    { const bf16_t* STf = (const bf16_t*)(ws + WS_GST) + ((size_t)(bh * 2) * GNCH + cg) * (128 * 64); const bf16_t* STb = STf + (size_t)GNCH * 128 * 64;
#pragma unroll
      for (int i = 0; i < 4; ++i) { const int n = tid + NT * i, row = n >> 4, ch = n & 15; sraw[i] = *(const u32x4*)((ch < 8 ? STf : STb) + (size_t)row * 64 + (ch & 7) * 8); } }
    gla_gates_load(ws, BF, BB, h, rowbase, tid);
    gla_scan(BF, BB, tid);
    { float qf[8], kf[8], o0[8], o1[8], o2[8], o3[8], o4[8], o5[8];
      unpack8(qraw, qf); unpack8(kraw, kf);
#pragma unroll
      for (int x = 0; x < 8; ++x) { const int d = 8 * d8 + x; const float bf = BF[t * GLS + d], bb = BB[t * GLS + d], rf = BF[31 * GLS + d], rb = BB[32 * GLS + d]; const float q = qf[x] * 0.125f;
          o0[x] = q * __expf(bf - rf); o1[x] = kf[x] * __expf(rf - bf); o2[x] = q * __expf(bb - rb); o3[x] = kf[x] * __expf(rb - bb); o4[x] = q * __expf(bf); o5[x] = q * __expf(bb); }
      *(LAS u32x4*)(QKF + off_b(t, d8)) = pack8(o0); *(LAS u32x4*)(QKF + off_b(t, 8 + d8)) = pack8(o1);
      *(LAS u32x4*)(QKB + off_b(t, d8)) = pack8(o2); *(LAS u32x4*)(QKB + off_b(t, 8 + d8)) = pack8(o3);
      *(LAS u32x4*)(QH + off_b(t, d8)) = pack8(o4); *(LAS u32x4*)(QH + off_b(t, 8 + d8)) = pack8(o5);
#pragma unroll
      for (int i = 0; i < 2; ++i) { const int n = tid + NT * i; *(LAS u32x4*)(VI + off_b(n >> 4, n & 15)) = vraw[i]; }
#pragma unroll
      for (int i = 0; i < 4; ++i) { const int n = tid + NT * i; *(LAS u32x4*)(SI + off_b(n >> 4, n & 15)) = sraw[i]; } }
    const int ib = w & 3, eh = w >> 2, iloc = 16 * ib + il;
    u32x2 grv[4]; f32x4 nvv[4];
    { const bf16_t* gp0 = (const bf16_t*)(ws + WS_P) + ((size_t)rowbase + iloc) * LDP + PC_GG + h * 128 + 64 * eh + 4 * g; const float* nw0 = a.in[I_GNW] + l * 512 + h * 128 + 64 * eh + 4 * g;
#pragma unroll
      for (int E4 = 0; E4 < 4; ++E4) { grv[E4] = *(const u32x2*)(gp0 + 16 * E4); nvv[E4] = *(const f32x4*)(nw0 + 16 * E4); } }
    __syncthreads();
    f32x4 at[4];
    { bf16x8 qff[2], qfb[2];
#pragma unroll
      for (int ks = 0; ks < 2; ++ks) { qff[ks] = img_row_frag(QKF, lane, ib, ks); qfb[ks] = img_row_frag(QKB, lane, ib, ks); }
#pragma unroll
      for (int T = 0; T < 4; ++T) { f32x4 cf = {0.f, 0.f, 0.f, 0.f}, cb = {0.f, 0.f, 0.f, 0.f};
#pragma unroll
          for (int ks = 0; ks < 2; ++ks) { cf = MFMA16(img_row_frag(QKF, lane, T, 2 + ks), qff[ks], cf); cb = MFMA16(img_row_frag(QKB, lane, T, 2 + ks), qfb[ks], cb); }
#pragma unroll
          for (int r = 0; r < 4; ++r) { const int j = 16 * T + 4 * g + r; cf[r] = (j <= iloc ? cf[r] : 0.f) + (j >= iloc ? cb[r] : 0.f); }
          at[T] = cf; } }
    f32x4 o[4];
    { bf16x8 hf[2], hb[2];
#pragma unroll
      for (int ks = 0; ks < 2; ++ks) { hf[ks] = img_row_frag(QH, lane, ib, ks); hb[ks] = img_row_frag(QH, lane, ib, 2 + ks); }
#pragma unroll
      for (int E4 = 0; E4 < 4; ++E4) { const int E = 4 * eh + E4; f32x4 c = {0.f, 0.f, 0.f, 0.f};
#pragma unroll
          for (int ks = 0; ks < 2; ++ks) { c = MFMA16(img_row_frag(SI, lane, E, ks), hf[ks], c); c = MFMA16(img_row_frag(SI, lane, E, 2 + ks), hb[ks], c); }
          o[E4] = c; } }
#pragma unroll
    for (int s = 0; s < 2; ++s) { const bf16x8 bfr = acc_pair_frag(at[2 * s], at[2 * s + 1]);
#pragma unroll
        for (int E4 = 0; E4 < 4; ++E4) o[E4] = MFMA16(img_tr_frag_acc(VI, lane, 4 * eh + E4, s), bfr, o[E4]); }
    float ss = 0.f;
#pragma unroll
    for (int E4 = 0; E4 < 4; ++E4) ss += (o[E4].x * o[E4].x + o[E4].y * o[E4].y) + (o[E4].z * o[E4].z + o[E4].w * o[E4].w);
    ss += __shfl_xor(ss, 16); ss += __shfl_xor(ss, 32);
    LAS float* red = (LAS float*)lds;
    if (g == 0) red[eh * 64 + iloc] = ss;
    __syncthreads();
    const float rn = rsqrtf((red[iloc] + red[64 + iloc]) * (1.0f / 128.0f) + EPS);
    const size_t row = (size_t)rowbase + iloc;
    const bf16_t* gp = (const bf16_t*)(ws + WS_P) + row * LDP + PC_GG + h * 128 + 64 * eh + 4 * g;
    const float* nw = a.in[I_GNW] + l * 512 + h * 128 + 64 * eh + 4 * g;
    bf16_t* op = (bf16_t*)(ws + WS_H) + row * D + 1536 + h * 128 + 64 * eh + 4 * g;
#pragma unroll
    for (int E4 = 0; E4 < 4; ++E4) { const u32x2 gr = grv[E4]; const f32x4 nv = nvv[E4];
        u32x2 ov; ov.x = pk2(o[E4].x * rn * nv.x * siluf_(bflo(gr.x)), o[E4].y * rn * nv.y * siluf_(bfhi(gr.x)));
        ov.y = pk2(o[E4].z * rn * nv.z * siluf_(bflo(gr.y)), o[E4].w * rn * nv.w * siluf_(bfhi(gr.y)));
        *(u32x2*)(op + 16 * E4) = ov; }
}
constexpr int SNCH = 68;
constexpr size_t WS_S5ST = WS_OB + (size_t)4 * OBSZ * 2;
constexpr size_t WS_S5BTB = WS_S5BT;
constexpr size_t WS_S5CPB = WS_S5BT + 524288;
constexpr size_t WS_S5A64 = WS_S5BT + 1048576;

__device__ __forceinline__ void prep_s5b(const DArgs& a, unsigned char* ws, int it, int tid) {
    const int idx = it * 512 + tid;
    const int gi = idx >> 6, p = idx & 63;
    const float a_re = a.in[I_S5ARE][idx], a_im = a.in[I_S5AIM][idx], ldt = a.in[I_S5LDT][gi];
    const float dt = expf(ldt), mag = expf(a_re * dt);
    float sn, cs; sincosf(a_im * dt, &sn, &cs);
    const float ab_re = mag * cs, ab_im = mag * sn, den = a_re * a_re + a_im * a_im, nr = ab_re - 1.0f;
    const float co_re = (nr * a_re + ab_im * a_im) / den, co_im = (ab_im * a_re - nr * a_im) / den;
    ((f32x2*)(ws + WS_S5AB))[idx] = (f32x2){ab_re, ab_im};
    float pr = ab_re, pi = ab_im;
#pragma unroll
    for (int q = 0; q < 6; ++q) { const float nr2 = pr * pr - pi * pi, ni2 = 2.0f * pr * pi; pr = nr2; pi = ni2; }
    ((f32x2*)(ws + WS_S5A64))[idx] = (f32x2){pr, pi};
    const float* bre = a.in[I_S5BRE] + (size_t)idx * 16; const float* bim = a.in[I_S5BIM] + (size_t)idx * 16;
    float tr[16], ti[16];
#pragma unroll
    for (int i = 0; i < 16; ++i) { const float br = bre[i], bi = bim[i]; tr[i] = co_re * br - co_im * bi; ti[i] = co_re * bi + co_im * br; }
    bf16_t* btb = (bf16_t*)(ws + WS_S5BTB) + (size_t)gi * 128 * 16;
#pragma unroll
    for (int hlf = 0; hlf < 2; ++hlf) { u32x4 w0, w1; const float* s = hlf ? ti : tr;
        w0.x = pk2(s[0], s[1]); w0.y = pk2(s[2], s[3]); w0.z = pk2(s[4], s[5]); w0.w = pk2(s[6], s[7]); w1.x = pk2(s[8], s[9]); w1.y = pk2(s[10], s[11]); w1.z = pk2(s[12], s[13]); w1.w = pk2(s[14], s[15]);
        *(u32x4*)(btb + (size_t)(64 * hlf + p) * 16) = w0; *(u32x4*)(btb + (size_t)(64 * hlf + p) * 16 + 8) = w1; }
    bf16_t* cpb = (bf16_t*)(ws + WS_S5CPB) + (size_t)gi * 16 * 128;
    const float* cre = a.in[I_S5CRE] + (size_t)gi * 1024; const float* cim = a.in[I_S5CIM] + (size_t)gi * 1024;
#pragma unroll
    for (int i = 0; i < 16; ++i) *(unsigned*)(cpb + i * 128 + 2 * p) = pk2(cre[i * 64 + p], -cim[i * 64 + p]);
}

struct S5Unit { bf16x8 btf[8]; f32x2 ab; f32x2 h; const bf16_t* cp; };
template <bool PASSC> __device__ __forceinline__ void s5_load_unit(S5Unit& U, unsigned char* ws, const bf16_t* P, const f32x2* ST, int l, int b, int cs, int rowbase, int grp, int dir, int lane) {
    const int g = lane >> 4, il = lane & 15;
    const bf16x8 zero8 = {0, 0, 0, 0, 0, 0, 0, 0};
    const int gi = (l * 2 + dir) * 32 + grp;
    U.ab = ((const f32x2*)(ws + WS_S5AB))[gi * 64 + lane];
    const size_t sidx = ((size_t)(b * SNCH + cs) * 2 + dir) * 2048 + grp * 64 + lane;
    U.h = PASSC ? ST[sidx] : (f32x2){0.f, 0.f};
    const bf16_t* bt = (const bf16_t*)(ws + WS_S5BTB) + (size_t)gi * 128 * 16 + (size_t)il * 16 + 8 * (g & 1);
#pragma unroll
    for (int Pt = 0; Pt < 8; ++Pt) { const bf16x8 v = *(const bf16x8*)(bt + Pt * 256); U.btf[Pt] = g < 2 ? v : zero8; }
    U.cp = (const bf16_t*)(ws + WS_S5CPB) + (size_t)gi * 16 * 128 + (size_t)il * 128 + 8 * g;
}
__device__ __forceinline__ void s5_load_u(bf16x8 (&ufa)[4], const bf16_t* P, int rowbase, int grp, int lane) {
    const int g = lane >> 4, il = lane & 15; const bf16x8 zero8 = {0, 0, 0, 0, 0, 0, 0, 0};
#pragma unroll
    for (int Tt = 0; Tt < 4; ++Tt) { const bf16x8 v = *(const bf16x8*)(P + (size_t)(rowbase + 16 * Tt + il) * LDP + PC_S5U + grp * 16 + 8 * (g & 1)); ufa[Tt] = g < 2 ? v : zero8; }
}
template <bool PASSC, int DIR> __device__ __forceinline__ void s5_run_unit(const S5Unit& U, const bf16x8 (&ufa)[4], f32x4 (&yacc)[4], f32x2& hout, LAS float* BU, LAS unsigned char* HW, int lane) {
    const int g = lane >> 4, il = lane & 15;
    f32x2 h = U.h; const f32x2 ab = U.ab;
    bf16x8 cpf[4];
    if (PASSC) {
#pragma unroll
        for (int ks = 0; ks < 4; ++ks) cpf[ks] = *(const bf16x8*)(U.cp + 32 * ks); }
    f32x4 d[8];
#pragma unroll
    for (int Pt = 0; Pt < 8; ++Pt) d[Pt] = MFMA16(U.btf[Pt], ufa[DIR ? 3 : 0], ((f32x4){0.f, 0.f, 0.f, 0.f}));
#pragma unroll
    for (int wi = 0; wi < 4; ++wi) {
        const int Tt = DIR ? 3 - wi : wi;
#pragma unroll
        for (int Pt = 0; Pt < 8; ++Pt) {
#pragma unroll
            for (int r = 0; r < 4; ++r) BU[(16 * Pt + 4 * g + r) * 20 + il] = d[Pt][r]; }
        asm volatile("" ::: "memory");
        if (!PASSC) {
            f32x4 br[4], bi[4];
#pragma unroll
            for (int q = 0; q < 4; ++q) { br[q] = *(const LAS f32x4*)(BU + lane * 20 + 4 * q); bi[q] = *(const LAS f32x4*)(BU + (64 + lane) * 20 + 4 * q); }
            if (wi < 3) {
#pragma unroll
                for (int Pt = 0; Pt < 8; ++Pt) d[Pt] = MFMA16(U.btf[Pt], ufa[DIR ? 2 - wi : wi + 1], ((f32x4){0.f, 0.f, 0.f, 0.f})); }
#pragma unroll
            for (int s = 0; s < 16; ++s) { const int tt = DIR ? 15 - s : s;
                const float hr = __builtin_fmaf(ab.x, h.x, __builtin_fmaf(-ab.y, h.y, br[tt >> 2][tt & 3])), hi = __builtin_fmaf(ab.x, h.y, __builtin_fmaf(ab.y, h.x, bi[tt >> 2][tt & 3]));
                h = (f32x2){hr, hi}; }
        } else {
#pragma unroll
            for (int hf2 = 0; hf2 < 2; ++hf2) { const int q0 = DIR ? 2 - 2 * hf2 : 2 * hf2;
                f32x4 br[2], bi[2];
#pragma unroll
                for (int q = 0; q < 2; ++q) { br[q] = *(const LAS f32x4*)(BU + lane * 20 + 4 * (q0 + q)); bi[q] = *(const LAS f32x4*)(BU + (64 + lane) * 20 + 4 * (q0 + q)); }
#pragma unroll
                for (int s = 0; s < 8; ++s) { const int t8 = DIR ? 7 - s : s; const int tt = 4 * q0 + t8;
                    const float hr = __builtin_fmaf(ab.x, h.x, __builtin_fmaf(-ab.y, h.y, br[t8 >> 2][t8 & 3])), hi = __builtin_fmaf(ab.x, h.y, __builtin_fmaf(ab.y, h.x, bi[t8 >> 2][t8 & 3]));
                    h = (f32x2){hr, hi};
                    *(LAS unsigned*)(HW + off_b(tt, lane >> 2) + (lane & 3) * 4) = pk2(hr, hi); }
            }
        }
        asm volatile("" ::: "memory");
        if (PASSC) {
            bf16x8 hf[4];
#pragma unroll
            for (int ks = 0; ks < 4; ++ks) hf[ks] = img_row_frag(HW, lane, 0, ks);
#pragma unroll
            for (int ks = 0; ks < 4; ++ks) yacc[Tt] = MFMA16(cpf[ks], hf[ks], yacc[Tt]);
            }
        asm volatile("" ::: "memory");
        if (PASSC && wi < 3) {
#pragma unroll
            for (int Pt = 0; Pt < 8; ++Pt) d[Pt] = MFMA16(U.btf[Pt], ufa[DIR ? 2 - wi : wi + 1], ((f32x4){0.f, 0.f, 0.f, 0.f})); }
    }
    hout = h;
}
template <bool PASSC> __device__ __forceinline__ void s5_item(const DArgs& a, unsigned char* ws, LAS unsigned char* lds, int l, int item, int ggsel, int tid) {
    const int b = item / (SNCH * 2), rem = item % (SNCH * 2), cs = rem >> 1, half = rem & 1;
    const int lane = tid & 63, w = tid >> 6, g = lane >> 4, il = lane & 15;
    const int rowbase = gla_rowbase(b, cs);
    LAS float* BU = (LAS float*)(lds + w * 14336); LAS unsigned char* HW = lds + w * 14336 + 10240;
    const bf16_t* P = (const bf16_t*)(ws + WS_P);
    f32x2* ST = (f32x2*)(ws + WS_S5ST);
    const int grp0 = 16 * half + w, grp1 = grp0 + 8;
    S5Unit UA; bf16x8 ufa[4];
    { const int gg = ggsel;
        const int grp = gg ? grp1 : grp0;
        f32x4 yacc[4];
#pragma unroll
        for (int q = 0; q < 4; ++q) yacc[q] = (f32x4){0.f, 0.f, 0.f, 0.f};
        f32x2 hend;
        u32x2 urv[4], sgv[4]; f32x4 dskv = {0.f, 0.f, 0.f, 0.f};
        if (PASSC) { dskv = *(const f32x4*)(a.in[I_S5D] + l * 512 + grp * 16 + 4 * g);
#pragma unroll
            for (int Tt = 0; Tt < 4; ++Tt) { const size_t row = (size_t)rowbase + 16 * Tt + il; urv[Tt] = *(const u32x2*)(P + row * LDP + PC_S5U + grp * 16 + 4 * g); sgv[Tt] = *(const u32x2*)(P + row * LDP + PC_S5G + grp * 16 + 4 * g); } }
        s5_load_unit<PASSC>(UA, ws, P, ST, l, b, cs, rowbase, grp, 0, lane); s5_load_u(ufa, P, rowbase, grp, lane);
        s5_run_unit<PASSC, 0>(UA, ufa, yacc, hend, BU, HW, lane);
        if (!PASSC) ST[((size_t)(b * SNCH + cs) * 2 + 0) * 2048 + grp * 64 + lane] = hend;
        s5_load_unit<PASSC>(UA, ws, P, ST, l, b, cs, rowbase, grp, 1, lane);
        s5_run_unit<PASSC, 1>(UA, ufa, yacc, hend, BU, HW, lane);
        if (!PASSC) ST[((size_t)(b * SNCH + cs) * 2 + 1) * 2048 + grp * 64 + lane] = hend;
        if (PASSC) {
            const f32x4 dsk = dskv;
            bf16_t* G5 = (bf16_t*)(ws + WS_KF);
#pragma unroll
            for (int Tt = 0; Tt < 4; ++Tt) { const size_t row = (size_t)rowbase + 16 * Tt + il;
                const u32x2 ur = urv[Tt], sg = sgv[Tt];
                const float g0 = gelu_tanh(yacc[Tt].x + bflo(ur.x) * dsk.x), g1 = gelu_tanh(yacc[Tt].y + bfhi(ur.x) * dsk.y), g2 = gelu_tanh(yacc[Tt].z + bflo(ur.y) * dsk.z), g3 = gelu_tanh(yacc[Tt].w + bfhi(ur.y) * dsk.w);
                u32x2 ov; ov.x = pk2(g0, g1); ov.y = pk2(g2, g3);
                *(u32x2*)(G5 + row * 512 + grp * 16 + 4 * g) = ov;
                ov.x = pk2(g0 * siluf_(bflo(sg.x)), g1 * siluf_(bfhi(sg.x))); ov.y = pk2(g2 * siluf_(bflo(sg.y)), g3 * siluf_(bfhi(sg.y)));
                *(u32x2*)(G5 + OBSZ + row * 512 + grp * 16 + 4 * g) = ov; }
        }
    }
}
__device__ __forceinline__ void s5_passB(unsigned char* ws, int l, int gt) {
    const int p = gt & 63, grp = (gt >> 6) & 31, dir = (gt >> 11) & 1, b = gt >> 12;
    const f32x2 a64 = ((const f32x2*)(ws + WS_S5A64))[((l * 2 + dir) * 32 + grp) * 64 + p];
    f32x2* ST = (f32x2*)(ws + WS_S5ST);
    f32x2 acc = {0.f, 0.f};
#pragma unroll 1
    for (int s0 = 0; s0 < SNCH; s0 += 34) {
        f32x2 ev[34];
#pragma unroll
        for (int j = 0; j < 34; ++j) { const int s = s0 + j; const int cs = dir == 0 ? s : (s < 4 ? 3 - s : 71 - s); ev[j] = ST[((size_t)(b * SNCH + cs) * 2 + dir) * 2048 + grp * 64 + p]; }
#pragma unroll
        for (int j = 0; j < 34; ++j) { const int s = s0 + j; const int cs = dir == 0 ? s : (s < 4 ? 3 - s : 71 - s);
            ST[((size_t)(b * SNCH + cs) * 2 + dir) * 2048 + grp * 64 + p] = acc;
            acc = (f32x2){a64.x * acc.x - a64.y * acc.y + ev[j].x, a64.x * acc.y + a64.y * acc.x + ev[j].y}; }
    }
}
constexpr int FFT_PHYS = 8448;
__device__ __forceinline__ void fft_twiddles_g(LAS f32x2* W, const f32x2* Wg, int tid) {
#pragma unroll
    for (int j = 0; j < 8; ++j) W[tid + NT * j] = Wg[tid + NT * j];
}
__device__ __forceinline__ int fphys(int i) { return i + (i >> 5); }
__device__ __forceinline__ f32x2 cmulf(const f32x2 a, const f32x2 b) { return (f32x2){a.x * b.x - a.y * b.y, a.x * b.y + a.y * b.x}; }
__device__ __forceinline__ f32x2 cmulcf(const f32x2 a, const f32x2 b) { return (f32x2){a.x * b.x + a.y * b.y, a.y * b.x - a.x * b.y}; }
template <int RL> __device__ __forceinline__ void dft_fwd_const(f32x2 (&e)[1 << RL]) {
#pragma unroll
    for (int s = 0; s < RL; ++s) { const int h = 1 << (RL - 1 - s);
#pragma unroll
        for (int m = 0; m < (1 << RL); ++m) { if (m & h) continue;
            const int mp = m & (h - 1); const f32x2 a_ = e[m], b_ = e[m | h]; const f32x2 d = a_ - b_; e[m] = a_ + b_;
            if (mp == 0) e[m | h] = d;
            else if (2 * mp == h) e[m | h] = (f32x2){d.y, -d.x};
            else { const float ang = -3.14159265358979323846f * (float)mp / (float)h; const f32x2 c = {__builtin_cosf(ang), __builtin_sinf(ang)}; e[m | h] = cmulf(d, c); } } }
}
template <int RL> __device__ __forceinline__ void dft_inv_const(f32x2 (&e)[1 << RL]) {
#pragma unroll
    for (int ss = 0; ss < RL; ++ss) { const int s = RL - 1 - ss; const int h = 1 << (RL - 1 - s);
#pragma unroll
        for (int m = 0; m < (1 << RL); ++m) { if (m & h) continue;
            const int mp = m & (h - 1); const f32x2 a_ = e[m], b_ = e[m | h]; f32x2 t;
            if (mp == 0) t = b_;
            else if (2 * mp == h) t = (f32x2){-b_.y, b_.x};
            else { const float ang = -3.14159265358979323846f * (float)mp / (float)h; const f32x2 c = {__builtin_cosf(ang), __builtin_sinf(ang)}; t = cmulcf(b_, c); }
            e[m] = a_ + t; e[m | h] = a_ - t; } }
}
template <int RL> __device__ __forceinline__ constexpr int brev_c(int m) { int r = 0; for (int i = 0; i < RL; ++i) r |= ((m >> i) & 1) << (RL - 1 - i); return r; }
template <int RL, bool CONJ> __device__ __forceinline__ void apply_tw(f32x2 (&e)[1 << RL], const f32x2 w1) {
    f32x2 tw[1 << RL];
    tw[0] = (f32x2){1.f, 0.f}; tw[1] = w1;
    if (RL >= 2) { tw[2] = cmulf(w1, w1); tw[3] = cmulf(tw[2], w1); }
    if (RL >= 3) { tw[4] = cmulf(tw[2], tw[2]); tw[5] = cmulf(tw[4], tw[1]); tw[6] = cmulf(tw[4], tw[2]); tw[7] = cmulf(tw[4], tw[3]); }
    if (RL >= 4) { tw[8] = cmulf(tw[4], tw[4]);
#pragma unroll
        for (int k = 1; k < 8; ++k) tw[8 + k] = cmulf(tw[8], tw[k]); }
#pragma unroll
    for (int m = 1; m < (1 << RL); ++m) e[m] = CONJ ? cmulcf(e[m], tw[brev_c<RL>(m)]) : cmulf(e[m], tw[brev_c<RL>(m)]);
}
template <int RL, int BETA, bool INV, class WP> __device__ __forceinline__ void fft2_pass(LAS f32x2* X, WP W, int tid) {
    constexpr int LOW = BETA - RL + 1, NG = FFTN >> RL, STR = (1 << LOW) + (1 << (LOW - 5));
#pragma unroll 1
    for (int gi = tid; gi < NG; gi += NT) {
        const int base = ((gi >> LOW) << (BETA + 1)) | (gi & ((1 << LOW) - 1));
        volatile LAS f32x2* p = X + fphys(base);
        f32x2 e[1 << RL];
#pragma unroll
        for (int m = 0; m < (1 << RL); ++m) e[m] = p[m * STR];
        const f32x2 w1 = W[(base & ((1 << LOW) - 1)) << (12 - BETA)];
        if (!INV) { dft_fwd_const<RL>(e); apply_tw<RL, false>(e, w1); }
        else { apply_tw<RL, true>(e, w1); dft_inv_const<RL>(e); }
#pragma unroll
        for (int m = 0; m < (1 << RL); ++m) p[m * STR] = e[m];
    }
}
template <class WP> __device__ __forceinline__ void fft2_fwd_ABC(LAS f32x2* X, WP W, int tid) {
    fft2_pass<4, 12, false>(X, W, tid); __syncthreads(); fft2_pass<4, 8, false>(X, W, tid); __syncthreads();
}
template <class WP> __device__ __forceinline__ void fft2_inv_CBA(LAS f32x2* X, WP W, int tid) {
    fft2_pass<4, 8, true>(X, W, tid); __syncthreads(); fft2_pass<4, 12, true>(X, W, tid); __syncthreads();
}
__device__ __forceinline__ void fft2_mid_mul(LAS f32x2* X, const f32x2* KF, int tid) {
    if (tid < 256) {
        volatile LAS f32x2* p = X + 33 * tid;
        f32x2 e[32];
#pragma unroll
        for (int m = 0; m < 32; ++m) e[m] = p[m];
        dft_fwd_const<5>(e);
#pragma unroll
        for (int q4 = 0; q4 < 4; ++q4) { f32x4 kf[4];
#pragma unroll
            for (int q = 0; q < 4; ++q) kf[q] = *(const f32x4*)(KF + 32 * tid + 8 * q4 + 2 * q);
#pragma unroll
            for (int q = 0; q < 4; ++q) { const int m = 8 * q4 + 2 * q; e[m] = cmulf(e[m], (f32x2){kf[q].x, kf[q].y}); e[m + 1] = cmulf(e[m + 1], (f32x2){kf[q].z, kf[q].w}); } }
        dft_inv_const<5>(e);
#pragma unroll
        for (int m = 0; m < 32; ++m) p[m] = e[m];
    }
}
__device__ __forceinline__ void fft2_fwd_D(LAS f32x2* X, int tid) {
    if (tid < 256) { volatile LAS f32x2* p = X + 33 * tid; f32x2 e[32];
#pragma unroll
        for (int m = 0; m < 32; ++m) e[m] = p[m];
        dft_fwd_const<5>(e);
#pragma unroll
        for (int m = 0; m < 32; ++m) p[m] = e[m]; }
}

__device__ __forceinline__ void filt_item2(const DArgs& a, unsigned char* ws, LAS unsigned char* lds, int l, int c0, int tid) {
    LAS f32x2* X = (LAS f32x2*)lds; LAS f32x2* X2 = (LAS f32x2*)(lds + FFT_PHYS * 8); LAS float* red = (LAS float*)(lds + 2 * FFT_PHYS * 8);
    const f32x2* Wg = (const f32x2*)(ws + WS_TWID);
    const int lane = tid & 63, w = tid >> 6, fr = lane & 15, fq = lane >> 4;
    const int cmine = c0 + 256 * (fq & 1);
    bf16x8 af[2];
    { float wv[16];
      const int cc = fr & 3, ca = c0 + 256 * ((fr >> 2) & 1);
      const float* wsrc = a.in[I_HW4] + (size_t)l * 64 * 2048 + (cc >> 1) * 1024 + (cc & 1) * 512 + ca;
#pragma unroll
      for (int q = 0; q < 16; ++q) wv[q] = fr < 8 ? wsrc[(size_t)(32 * (q >> 3) + 8 * fq + (q & 7)) * 2048] : 0.f;
#pragma unroll
      for (int ks = 0; ks < 2; ++ks) { u32x4 pw; pw.x = pk2(wv[8 * ks], wv[8 * ks + 1]); pw.y = pk2(wv[8 * ks + 2], wv[8 * ks + 3]); pw.z = pk2(wv[8 * ks + 4], wv[8 * ks + 5]); pw.w = pk2(wv[8 * ks + 6], wv[8 * ks + 7]); af[ks] = __builtin_bit_cast(bf16x8, pw); } }
    if (tid < 2) { float z0; asm volatile("v_mov_b32 %0, 0" : "=v"(z0)); (tid ? X2 : X)[fphys(4096)] = (f32x2){z0, z0}; }
    const float dl = fabsf(HY_D0 + (HY_D1 - HY_D0) * ((float)cmine / 511.0f)) * (1.0f / 4095.0f);
    const bf16_t* H3 = (const bf16_t*)(ws + WS_H3B) + (size_t)l * 4096 * 64 + (size_t)fr * 64 + 8 * fq;
    LAS f32x2* Xm = (fq & 1) ? X2 : X;
    float ss0 = 0.f, ss1 = 0.f;
#pragma unroll 1
    for (int i0 = 0; i0 < 32; i0 += 4) {
        bf16x8 hb[4][2];
#pragma unroll
        for (int i = 0; i < 4; ++i) { const bf16_t* hp = H3 + (size_t)(16 * (w + 8 * (i0 + i))) * 64; hb[i][0] = *(const bf16x8*)hp; hb[i][1] = *(const bf16x8*)(hp + 32); }
#pragma unroll
        for (int i = 0; i < 4; ++i) {
            f32x4 d = {0.f, 0.f, 0.f, 0.f};
            d = MFMA16(af[0], hb[i][0], d); d = MFMA16(af[1], hb[i][1], d);
            if (fq < 2) { const int t = 16 * (w + 8 * (i0 + i)) + fr;
                const float dec = __expf(-(float)t * dl); const float f0 = d.x * dec, f1 = d.y * dec, b0 = d.z * dec, b1 = d.w * dec;
                Xm[fphys(t)] = (f32x2){f0, f1}; ss0 += f0 * f0; ss1 += f1 * f1;
                if (t > 0) { Xm[fphys(8192 - t)] = (f32x2){b0, b1}; ss0 += b0 * b0; ss1 += b1 * b1; } }
        }
    }
#pragma unroll
    for (int o = 1; o < 16; o <<= 1) { ss0 += __shfl_xor(ss0, o); ss1 += __shfl_xor(ss1, o); }
    if (fr == 0 && fq < 2) { red[w * 4 + fq * 2] = ss0; red[w * 4 + fq * 2 + 1] = ss1; }
    __syncthreads();
    fft2_pass<4, 12, false>(X, Wg, tid); fft2_pass<4, 12, false>(X2, Wg, tid); __syncthreads();
    fft2_pass<4, 8, false>(X, Wg, tid); fft2_pass<4, 8, false>(X2, Wg, tid); __syncthreads();
    fft2_fwd_D(tid < 256 ? X : X2, tid & 255); __syncthreads();
#pragma unroll 1
    for (int ch = 0; ch < 2; ++ch) {
        float s0 = 0.f, s1 = 0.f;
#pragma unroll
        for (int i = 0; i < NWAVES; ++i) { s0 += red[i * 4 + ch * 2]; s1 += red[i * 4 + ch * 2 + 1]; }
        const float rs0 = 0.5f * rsqrtf(s0 + EPS), rs1 = 0.5f * rsqrtf(s1 + EPS);
        const LAS f32x2* Xc = ch ? X2 : X; const int c = c0 + 256 * ch;
        f32x2* KF0 = (f32x2*)(ws + WS_KF) + (size_t)(0 * 512 + c) * FFTN; f32x2* KF1 = (f32x2*)(ws + WS_KF) + (size_t)(1 * 512 + c) * FFTN;
#pragma unroll 4
        for (int j = 0; j < 16; ++j) { const int pos = tid + 512 * j; const int k = (int)(__brev((unsigned)pos) >> 19); const int pp = (int)(__brev((unsigned)((8192 - k) & 8191)) >> 19);
            const f32x2 za = Xc[fphys(pos)], zb = Xc[fphys(pp)];
            KF0[pos] = (f32x2){rs0 * (za.x + zb.x), rs0 * (za.y - zb.y)};
            KF1[pos] = (f32x2){rs1 * (za.y + zb.y), rs1 * (zb.x - za.x)}; }
    }
    __syncthreads();
}

struct Raw8 { u32x4 mid; bf16_t lf, rt; };
__device__ __forceinline__ Raw8 ld_raw8(const bf16_t* p, int t0, int Lx) { Raw8 r; r.mid = *(const u32x4*)(p + t0); r.lf = t0 > 0 ? p[t0 - 1] : (bf16_t)0; r.rt = t0 + 8 < Lx ? p[t0 + 8] : (bf16_t)0; return r; }
__device__ __forceinline__ void sconv8(const Raw8& r, float w0, float w1, float w2, float cb, float (&o)[8]) {
    float x[10]; x[0] = bf2f(r.lf); x[9] = bf2f(r.rt);
    x[1] = bflo(r.mid.x); x[2] = bfhi(r.mid.x); x[3] = bflo(r.mid.y); x[4] = bfhi(r.mid.y); x[5] = bflo(r.mid.z); x[6] = bfhi(r.mid.z); x[7] = bflo(r.mid.w); x[8] = bfhi(r.mid.w);
#pragma unroll
    for (int i = 0; i < 8; ++i) o[i] = w0 * x[i] + w1 * x[i + 1] + w2 * x[i + 2] + cb;
}
__device__ __forceinline__ void hyena_item2(const DArgs& a, unsigned char* ws, LAS unsigned char* lds, int l, int c, int tid, bf16_t* outrows) {
    LAS f32x2* X = (LAS f32x2*)lds; LAS f32x2* X2 = (LAS f32x2*)(lds + FFT_PHYS * 8);
    const f32x2* Wg = (const f32x2*)(ws + WS_TWID);
    const float* cw = a.in[I_HCW] + (size_t)l * 3 * 1536; const float* cbp = a.in[I_HCB] + (size_t)l * 1536;
    const float wv0 = cw[c], wv1 = cw[1536 + c], wv2 = cw[3072 + c], bv = cbp[c];
    const float wa0 = cw[512 + c], wa1 = cw[1536 + 512 + c], wa2 = cw[3072 + 512 + c], ba = cbp[512 + c];
    const float wb0 = cw[1024 + c], wb1 = cw[1536 + 1024 + c], wb2 = cw[3072 + 1024 + c], bb = cbp[1024 + c];
    const float bias0 = a.in[I_HBIAS][(l * 2 + 0) * 512 + c], bias1 = a.in[I_HBIAS][(l * 2 + 1) * 512 + c];
    const bf16_t* PT = (const bf16_t*)(ws + WS_PT);
    const bf16_t* pv = PT + (size_t)(PT_V + c) * MR; const bf16_t* pg1 = PT + (size_t)(PT_G1 + c) * MR; const bf16_t* pg2 = PT + (size_t)(PT_G2 + c) * MR; const bf16_t* phg = PT + (size_t)(PT_HG + c) * MR;
    const f32x2* KF0 = (const f32x2*)(ws + WS_KF) + (size_t)(0 * 512 + c) * FFTN; const f32x2* KF1 = (const f32x2*)(ws + WS_KF) + (size_t)(1 * 512 + c) * FFTN;
    const int t0 = 8 * tid;
    const int po = 8 * tid + (tid >> 2);
    LAS f32x2* px = X + po; LAS f32x2* py = X2 + po;
    float z[4][8];
    { Raw8 v[4];
#pragma unroll
      for (int b = 0; b < 4; ++b) v[b] = ld_raw8(pv + b * SEQL, t0, SEQL);
#pragma unroll
      for (int b = 0; b < 4; ++b) sconv8(v[b], wv0, wv1, wv2, bv, z[b]); }
    Raw8 g1r[4];
#pragma unroll
    for (int b = 0; b < 4; ++b) g1r[b] = ld_raw8(pg1 + b * SEQL, t0, SEQL);
#pragma unroll
    for (int x = 0; x < 8; ++x) { px[x] = (f32x2){z[0][x], z[1][x]}; px[4224 + x] = (f32x2){0.f, 0.f}; py[x] = (f32x2){z[2][x], z[3][x]}; py[4224 + x] = (f32x2){0.f, 0.f}; }
    __syncthreads();
#define HY_CONV(KFp) do { \
        fft2_pass<4, 12, false>(X, Wg, tid); fft2_pass<4, 12, false>(X2, Wg, tid); __syncthreads(); \
        fft2_pass<4, 8, false>(X, Wg, tid); fft2_pass<4, 8, false>(X2, Wg, tid); __syncthreads(); \
        fft2_mid_mul(tid < 256 ? X : X2, KFp, tid & 255); __syncthreads(); \
        fft2_pass<4, 8, true>(X, Wg, tid); fft2_pass<4, 8, true>(X2, Wg, tid); __syncthreads(); \
        fft2_pass<4, 12, true>(X, Wg, tid); fft2_pass<4, 12, true>(X2, Wg, tid); __syncthreads(); } while (0)
    HY_CONV(KF0);
    { float g[4][8];
#pragma unroll
      for (int b = 0; b < 4; ++b) sconv8(g1r[b], wa0, wa1, wa2, ba, g[b]);
#pragma unroll
      for (int x = 0; x < 8; ++x) { const f32x2 c0 = px[x] * (1.0f / 8192.0f), c1 = py[x] * (1.0f / 8192.0f);
          z[0][x] = g[0][x] * (c0.x + bias0 * z[0][x]); z[1][x] = g[1][x] * (c0.y + bias0 * z[1][x]); z[2][x] = g[2][x] * (c1.x + bias0 * z[2][x]); z[3][x] = g[3][x] * (c1.y + bias0 * z[3][x]); } }
    Raw8 g2r[4]; u32x4 hgr[4];
#pragma unroll
    for (int b = 0; b < 4; ++b) { g2r[b] = ld_raw8(pg2 + b * SEQL, t0, SEQL); hgr[b] = *(const u32x4*)(phg + b * SEQL + t0); }
    __syncthreads();
#pragma unroll
    for (int x = 0; x < 8; ++x) { px[x] = (f32x2){z[0][x], z[1][x]}; px[4224 + x] = (f32x2){0.f, 0.f}; py[x] = (f32x2){z[2][x], z[3][x]}; py[4224 + x] = (f32x2){0.f, 0.f}; }
    __syncthreads();
    HY_CONV(KF1);
#undef HY_CONV
    bf16_t* pvw = outrows + (size_t)c * MR;
#pragma unroll
    for (int b = 0; b < 4; ++b) { float g[8], hh[8], o[8]; sconv8(g2r[b], wb0, wb1, wb2, bb, g); unpack8(hgr[b], hh);
#pragma unroll
        for (int x = 0; x < 8; ++x) { const f32x2 cv = ((b < 2) ? px[x] : py[x]) * (1.0f / 8192.0f); const float cvv = (b & 1) ? cv.y : cv.x;
            o[x] = g[x] * (cvv + bias1 * z[b][x]) * siluf_(hh[x]); }
        *(u32x4*)(pvw + b * SEQL + t0) = pack8(o); }
    __syncthreads();
}
__device__ __forceinline__ void hy_transpose_item(unsigned char* ws, LAS unsigned char* lds, int item, int tid, int nrows) {
    const int lane = tid & 63, w = tid >> 6;
    const int wi = item * 8 + w;
    const int nrb = nrows / 64;
    if (wi >= nrb * 8) return;
    const int rb = wi >> 3, cb = wi & 7;
    LAS bf16_t* T = (LAS bf16_t*)(lds + w * 8704);
    const bf16_t* src = (const bf16_t*)(ws + WS_PT) + (size_t)(PT_V + cb * 64) * MR + (size_t)rb * 64;
    u32x4 tv[8];
#pragma unroll
    for (int i = 0; i < 8; ++i) { const int c = 8 * i + (lane >> 3), r8 = (lane & 7) * 8; tv[i] = *(const u32x4*)(src + (size_t)c * MR + r8); }
#pragma unroll
    for (int i = 0; i < 8; ++i) { const int c = 8 * i + (lane >> 3), r8 = (lane & 7) * 8;
        LAS unsigned* d = (LAS unsigned*)(T + c * 66 + r8); d[0] = tv[i].x; d[1] = tv[i].y; d[2] = tv[i].z; d[3] = tv[i].w; }
    asm volatile("s_waitcnt lgkmcnt(0)" ::: "memory");
    bf16_t* dst = (bf16_t*)(ws + WS_H) + (size_t)(rb * 64) * D + 512 + cb * 64;
#pragma unroll 4
    for (int i = 0; i < 8; ++i) { const int r = 8 * i + (lane >> 3), c8 = (lane & 7) * 8;
        unsigned short e[8];
#pragma unroll
        for (int x = 0; x < 8; ++x) e[x] = T[(c8 + x) * 66 + r];
        u32x4 o; o.x = e[0] | ((unsigned)e[1] << 16); o.y = e[2] | ((unsigned)e[3] << 16); o.z = e[4] | ((unsigned)e[5] << 16); o.w = e[6] | ((unsigned)e[7] << 16);
        *(u32x4*)(dst + (size_t)r * D + c8) = o; }
    asm volatile("s_waitcnt lgkmcnt(0)" ::: "memory");
}
#ifndef MK_EN
#define MK_EN 0xffff
#endif
#define EN(x) ((MK_EN >> (x)) & 1)
constexpr int PH_PREP = 0, PH_PER_LAYER = 7, PH_FNORM = 1 + 2 * PH_PER_LAYER, N_PHASES = PH_FNORM + 1;

__global__ void __launch_bounds__(NT, 2) fwd_kernel(Args ka) {
    extern __shared__ __attribute__((aligned(16))) unsigned char lds_raw[];
    LAS unsigned char* lds = (LAS unsigned char*)lds_raw;
    const int G = gridDim.x;
    volatile LAS unsigned* bst = (volatile LAS unsigned*)(lds + LDS_CTL_OFF);
    if (threadIdx.x < 16) bst[threadIdx.x] = 0u;
    if (threadIdx.x == 0) { LAS unsigned long long* tab = (LAS unsigned long long*)(lds + LDS_PTR_OFF);
#pragma unroll
        for (int i = 0; i < N_IN; ++i) tab[i] = (unsigned long long)ka.in[i]; }
    __syncthreads();

    XcdBarrier gbar; gbar.bar = (unsigned*)(ka.ws + WS_CTL); gbar.x = 0; gbar.st = bst;
    if (ka.ph_hi - ka.ph_lo > 1) gbar = xcd_barrier_post((unsigned*)(ka.ws + WS_CTL), bst);

#ifdef REP_SUB
#ifndef REP_LMASK
#define REP_LMASK 3
#endif
    int repmask = 0;
#endif
    for (int ph = ka.ph_lo; ph < ka.ph_hi; ++ph) {
        int tid = threadIdx.x; asm volatile("" : "+v"(tid));
        int bid = blockIdx.x; asm volatile("" : "+s"(bid));
#define LANE_WAVE() int tid2_ = threadIdx.x; asm volatile("" : "+v"(tid2_)); const int lane = tid2_ & 63, wave = __builtin_amdgcn_readfirstlane(tid2_ >> 6)
        __attribute__((address_space(1))) unsigned char* wsg_ = (__attribute__((address_space(1))) unsigned char*)ka.ws; asm volatile("" : "+s"(wsg_)); unsigned char* ws = (unsigned char*)wsg_;
        __attribute__((address_space(1))) float* outg_ = (__attribute__((address_space(1))) float*)ka.out; asm volatile("" : "+s"(outg_)); float* outp_ = (float*)outg_;
        DArgs a; a.in.t = (const LAS unsigned long long*)(lds + LDS_PTR_OFF); a.out = outp_;
        float* MOD = (float*)(ws + WS_MOD);
        if (EN(0) && ph == PH_PREP) {
            for (int it = bid; it < 1048 + 544 + 8; it += G) {
                int tid = threadIdx.x; asm volatile("" : "+v"(tid));
                __syncthreads();
                if (it < 768) prep_adaln(a.in[I_C], a.in[I_CCTX], a.in[I_ADAW], a.in[I_ADAB], MOD, it, (LAS float*)lds, tid);
                else if (it < 784) prep_s5b(a, ws, it - 768, tid);
                else if (it >= 1048 + 544) { const int j = (it - 1592) * NT + tid; float sn, cs; sincospif(-(float)j * (1.0f / 4096.0f), &sn, &cs); ((f32x2*)(ws + WS_TWID))[j] = (f32x2){cs, sn}; }
                else if (it >= 1048) prep_rope((f32x2*)(ws + WS_ROPE), it - 1048, tid);
                else { const bool big = it < 1040; const int r = big ? it - 784 : it - 1040, l = big ? (r >> 7) : 0, t0 = (big ? (r & 127) : r) * 32;
                    float* H3o = big ? (float*)(ws + WS_H3) + (size_t)l * 4096 * 64 : (float*)(ws + WS_H3C);
                    bf16_t* H3b = big ? (bf16_t*)(ws + WS_H3B) + (size_t)l * 4096 * 64 : (bf16_t*)nullptr;
                    prep_hymlp(a, H3o, H3b, l, big ? 4096 : 256, t0, lds, tid); }
            }
        } else if (EN(1) && ph == PH_FNORM) {
            const float* fw = a.in[I_FNW]; LANE_WAVE();
            for (int row = bid * NWAVES + wave; row < NLAT; row += G * NWAVES) {
                float* xr = a.out + (size_t)row * D; f32x4 v[8]; float ss = 0.f;
#pragma unroll
                for (int j = 0; j < 8; ++j) { v[j] = ((const f32x4*)xr)[lane + 64 * j]; ss += (v[j].x * v[j].x + v[j].y * v[j].y) + (v[j].z * v[j].z + v[j].w * v[j].w); }
                const float rstd = rsqrtf(wave_sum(ss) * (1.0f / D) + EPS);
#pragma unroll
                for (int j = 0; j < 8; ++j) { const f32x4 w = *(const f32x4*)(fw + 4 * (lane + 64 * j)); ((f32x4*)xr)[lane + 64 * j] = v[j] * rstd * w; }
            }
        } else {
            const int l = (ph - 1) / PH_PER_LAYER, sub = (ph - 1) % PH_PER_LAYER;

            const bool ctx_out = (l == 0);
            const int Mrows = ctx_out ? MR : NLAT;
            if (EN(2) && sub == 0) {
                LANE_WAVE();
                LAS float* scr = (LAS float*)(lds + wave * 8704);
                const int gw = bid * NWAVES + wave, NGW = G * NWAVES;
                constexpr int I_W1 = 32 * (NPAD / 32), I_W2 = 32 * 64, I_W3 = 8 * 16;
                for (int pass_ = 0; pass_ < 2; ++pass_) {
                if ((pass_ ^ ((bid >> 3) & 1)) == 0) {
                for (int it = (l == 0 ? gw : gw + I_W1); it < I_W1 + I_W2 + I_W3; it += NGW) {
                    int r = it;
                    if (r < I_W1) { const int kb = r / (NPAD / 32), nb = r % (NPAD / 32); transpose_item(a.in[I_WIN] + (size_t)l * D * INW, INW, win_srccol(nb * 32 + (lane & 31)), kb * 64, (bf16_t*)(ws + WS_WIN), D, nb * 32, scr, lane); continue; }
                    r -= I_W1;
                    if (r < I_W2) { const int kb = r / 64, nb = r % 64; transpose_item(a.in[I_WOUT] + (size_t)l * D * D, D, nb * 32 + (lane & 31), kb * 64, (bf16_t*)(ws + WS_WOUT), D, nb * 32, scr, lane); continue; }
                    r -= I_W2;
                    { const int kb = r / 16, nb = r % 16; transpose_item(a.in[I_GLUW] + (size_t)l * 512 * 512, 512, nb * 32 + (lane & 31), kb * 64, (bf16_t*)(ws + WS_GLUW), 512, nb * 32, scr, lane); }
                }
                const float* nw = a.in[I_NORMW] + (size_t)l * D;
                for (int row = gw; row < MR; row += NGW) {
                    const float* xr; int v;
                    if (row < NLAT) { xr = (l == 0 ? a.in[I_X] : a.out) + (size_t)row * D; v = row >> 12; }
                    else { xr = (l == 0 ? a.in[I_CTX] : (const float*)(ws + WS_XC1)) + (size_t)(row - NLAT) * D; v = 4; }
                    norm_row(xr, nw, MOD + (size_t)(l * 5 + v) * ADA, (bf16_t*)(ws + WS_H) + (size_t)row * D, lane);
                }
                __syncthreads();
                } else {
                const int nfilt = ctx_out ? 768 : 0;
                for (int it = bid; it < nfilt; it += G) { int tid = threadIdx.x; asm volatile("" : "+v"(tid)); __syncthreads(); if (it < 256) filt_item2(a, ws, lds, l, it, tid); else filt_ctx_item(a, ws, lds, it - 256, tid);
#if defined(REP_ITEM) && REP_ITEM == 10
                    __syncthreads(); if (it < 256) filt_item2(a, ws, lds, l, it, tid);
#endif
                }
                __syncthreads();
                } }
            } else if (EN(3) && sub == 1) {
                pg8::Gemm g{(const bf16_t*)(ws + WS_H), (const bf16_t*)(ws + WS_WIN), MR, NPAD, D}; pg8::StaticOrder S; S.init(MR, NPAD, G, bid);
                EpiInProj E{(bf16_t*)(ws + WS_P), (bf16_t*)(ws + WS_PT), (float*)(ws + WS_LR), (const float*)(ws + WS_ROPE)};
                { pg8::InProjOrder S1; S1.init(ctx_out ? 0 : 1, G, bid); pg8::gemm_phase<EpiInProj, pg8::InProjOrder, true, true>(lds, g, S1, E, tid); }
            } else if (EN(5) && sub == 2) {
                const int nit = ctx_out ? 3744 : 3232;
                for (int it = bid; it < nit; it += G) {
                    int tid = threadIdx.x; asm volatile("" : "+v"(tid));
                    __syncthreads();
#ifdef REP_ITEM
                    { const int ty_ = it < 512 ? 0 : it < 1600 ? 1 : it < 2144 ? 2 : it < 3232 ? 3 : 4;
                      if (ty_ == REP_ITEM) { if (ty_ == 0) hyena_item2(a, ws, lds, l, it, tid, (bf16_t*)(ws + WS_H)); else if (ty_ == 1) s5_item<false>(a, ws, lds, l, (it - 512) >> 1, (it - 512) & 1, tid); else if (ty_ == 2) ret_passA(ws, lds, it - 1600, tid);
                          else if (ty_ == 3) gla_passA(a, ws, lds, l, it - 2144, tid); else hyena_ctx_item(a, ws, lds, it - 3232, tid);
                          __syncthreads(); asm volatile("" : "+v"(tid)); } }
#endif
                    if (it < 512) hyena_item2(a, ws, lds, l, it, tid, (bf16_t*)(ws + WS_PT) + (size_t)PT_V * MR);
                    else if (it < 1600) s5_item<false>(a, ws, lds, l, (it - 512) >> 1, (it - 512) & 1, tid);
                    else if (it < 2144) ret_passA(ws, lds, it - 1600, tid);
                    else if (it < 3232) gla_passA(a, ws, lds, l, it - 2144, tid);
                    else hyena_ctx_item(a, ws, lds, it - 3232, tid);
                }
            } else if (EN(9) && sub == 3) {
                for (int it = bid; it < 256; it += G) { int tid = threadIdx.x; asm volatile("" : "+v"(tid)); __syncthreads(); hy_transpose_item(ws, lds, it, tid, NLAT); }
                for (int it = bid; it < 224; it += G) { int tid = threadIdx.x; asm volatile("" : "+v"(tid)); __syncthreads();
                    if (it < 128) ret_passB(ws, it * NT + tid);
                    else if (it < 192) gla_passB(ws, lds, it - 128, tid);
                    else s5_passB(ws, l, (it - 192) * NT + tid); }
            } else if (EN(6) && sub == 4) {
                const int nsc = ctx_out ? 1088 : 1024, nrc = ctx_out ? 16 * RNCH : 16 * 32, ngc = ctx_out ? 16 * GNCH : 16 * 64;
                for (int it = bid; it < nsc; it += G) { int tid = threadIdx.x; asm volatile("" : "+v"(tid)); __syncthreads();
                    const int i2 = it >> 1; const int item = ctx_out ? i2 : (i2 >> 7) * (SNCH * 2) + 8 + (i2 & 127);
#if defined(REP_ITEM) && REP_ITEM == 5
                    s5_item<true>(a, ws, lds, l, item, it & 1, tid); __syncthreads(); asm volatile("" : "+v"(tid));
#endif
                    s5_item<true>(a, ws, lds, l, item, it & 1, tid); }
                for (int it = (bid + 64) % G; it < nrc; it += G) { int tid = threadIdx.x; asm volatile("" : "+v"(tid)); __syncthreads();
                    const int item = ctx_out ? it : (it >> 5) * RNCH + 2 + (it & 31);
#if defined(REP_ITEM) && REP_ITEM == 6
                    ret_passC(a, ws, lds, l, item, tid); __syncthreads(); asm volatile("" : "+v"(tid));
#endif
                    ret_passC(a, ws, lds, l, item, tid); }
                for (int it = (bid + 128) % G; it < ngc; it += G) { int tid = threadIdx.x; asm volatile("" : "+v"(tid)); __syncthreads();
                    const int item = ctx_out ? it : (it >> 6) * GNCH + 4 + (it & 63);
#if defined(REP_ITEM) && REP_ITEM == 7
                    gla_passC(a, ws, lds, l, item, tid); __syncthreads(); asm volatile("" : "+v"(tid));
#endif
                    gla_passC(a, ws, lds, l, item, tid); }
            } else if (EN(7) && sub == 5) {
                pg8::Gemm g{(const bf16_t*)(ws + WS_KF), (const bf16_t*)(ws + WS_GLUW), Mrows, 512, 512}; pg8::StaticOrder S; S.init(Mrows, 512, G, bid);
                EpiGlu E{(const bf16_t*)(ws + WS_KF) + OBSZ, (bf16_t*)(ws + WS_H), a.in[I_GLUB] + (size_t)l * 512};
                pg8::gemm_phase<EpiGlu, pg8::StaticOrder, true, true>(lds, g, S, E, tid);
                if (l == 0 && bid >= 136) {
                    LANE_WAVE(); LAS float* scr = (LAS float*)(lds + wave * 8704);
                    for (int r = (bid - 136) * NWAVES + wave; r < 32 * (NPAD / 32); r += (G - 136) * NWAVES) { const int kb = r / (NPAD / 32), nb = r % (NPAD / 32);
                        transpose_item(a.in[I_WIN] + (size_t)1 * D * INW, INW, win_srccol(nb * 32 + (lane & 31)), kb * 64, (bf16_t*)(ws + WS_WIN), D, nb * 32, scr, lane); }
                }
            } else if (EN(8)) {
                pg8::Gemm g{(const bf16_t*)(ws + WS_H), (const bf16_t*)(ws + WS_WOUT), Mrows, D, D}; pg8::StaticOrder S; S.init(Mrows, D, G, bid);
                EpiOut E{l == 0 ? a.in[I_X] : a.out, a.in[I_CTX], a.out, (float*)(ws + WS_XC1), MOD + (size_t)l * 5 * ADA};
                pg8::gemm_phase<EpiOut, pg8::StaticOrder, true, true>(lds, g, S, E, tid);
                if (l == 0 && bid >= 32) {
                    for (int it = bid - 32; it < 256; it += G - 32) { int tid2 = threadIdx.x; asm volatile("" : "+v"(tid2)); __syncthreads(); filt_item2(a, ws, lds, 1, it, tid2); }
                }
            }
        }
#ifdef REP_SUB
        if (ph != PH_PREP && ph != PH_FNORM && ((ph - 1) % PH_PER_LAYER) == REP_SUB && ((REP_LMASK >> ((ph - 1) / PH_PER_LAYER)) & 1) && !((repmask >> ((ph - 1) / PH_PER_LAYER)) & 1)) { repmask |= 1 << ((ph - 1) / PH_PER_LAYER); xcd_barrier(gbar); --ph; continue; }
#endif
        if (ph + 1 < ka.ph_hi) xcd_barrier(gbar);
    }
}

#ifndef MK_LAUNCH_PER_PHASE
#define MK_LAUNCH_PER_PHASE 0
#endif
extern "C" void kernel_launch(void* const* d_in, const int* in_sizes, int n_in, void* d_out, int out_size, void* d_ws, size_t ws_size, hipStream_t stream) {
    static int grid = 0;
    if (grid == 0) {
        if (n_in != N_IN || out_size != NLAT * D || ws_size < WS_END2) { fprintf(stderr, "kernel_launch: unexpected shapes (n_in %d, out %d, ws %zu < %zu); nothing launched\n", n_in, out_size, ws_size, (size_t)WS_END2); grid = -1; return; }
        int dev = 0, cus = 0, per_cu = 0;
        if (hipGetDevice(&dev) != hipSuccess || hipDeviceGetAttribute(&cus, hipDeviceAttributeMultiprocessorCount, dev) != hipSuccess) { grid = -1; return; }
        if (hipFuncSetAttribute((const void*)fwd_kernel, hipFuncAttributeMaxDynamicSharedMemorySize, LDS_BYTES) != hipSuccess) { fprintf(stderr, "kernel_launch: hipFuncSetAttribute failed\n"); grid = -1; return; }
        if (hipOccupancyMaxActiveBlocksPerMultiprocessor(&per_cu, (const void*)fwd_kernel, NT, LDS_BYTES) != hipSuccess || per_cu < 1) { fprintf(stderr, "kernel_launch: occupancy query says %d blocks per CU\n", per_cu); per_cu = 1; }
        (void)hipGetLastError();
        grid = cus;
    }
    if (grid < 0) return;
    (void)hipMemsetAsync((char*)d_ws + WS_CTL, 0, WS_ZERO_BYTES, stream);
    Args a{};
    for (int i = 0; i < N_IN; ++i) a.in[i] = (const float*)d_in[i];
    a.out = (float*)d_out; a.ws = (unsigned char*)d_ws;
#if MK_LAUNCH_PER_PHASE
    for (int ph = 0; ph < N_PHASES; ++ph) {
        a.ph_lo = ph; a.ph_hi = ph + 1;
        hipLaunchKernelGGL(fwd_kernel, dim3(grid), dim3(NT), LDS_BYTES, stream, a);
    }
#else
    a.ph_lo = 0; a.ph_hi = N_PHASES;
    void* args[] = {&a};
    hipError_t e = hipLaunchCooperativeKernel((const void*)fwd_kernel, dim3(grid), dim3(NT), args, LDS_BYTES, stream);
    if (e != hipSuccess) fprintf(stderr, "kernel_launch: cooperative launch failed: %s (grid %d)\n", hipGetErrorString(e), grid);
#endif
}
```

```cpp
#include <hip/hip_runtime.h>
#include <hip/hip_cooperative_groups.h>
#include <cstdio>
#include <cstdint>
namespace cg = cooperative_groups;

#define LAS __attribute__((address_space(3)))
typedef unsigned short bf16_t;
typedef float f32x4 __attribute__((ext_vector_type(4)));
typedef float f32x2 __attribute__((ext_vector_type(2)));
typedef unsigned u32x4 __attribute__((ext_vector_type(4)));
typedef unsigned u32x2 __attribute__((ext_vector_type(2)));

constexpr int D = 2048, NB = 4, SEQL = 4096, LC = 256, NLAT = NB * SEQL, NCTX = NB * LC, MR = NLAT + NCTX;
constexpr int BR = 512, INW = 6688, NPAD = 6912, LDP = 4608, ADA = 3 * D;
constexpr int NT = 512, NWAVES = 8;
constexpr float EPS = 1e-6f;
constexpr int PC_S5U = 0, PC_S5G = 512, PC_RQ = 1024, PC_RK = 1536, PC_RV = 2048, PC_RG = 2560, PC_GQ = 3072, PC_GK = 3328, PC_GV = 3584, PC_GG = 4096;
constexpr int PT_V = 0, PT_G1 = 512, PT_G2 = 1024, PT_HG = 1536;
constexpr int FFTN = 8192;

enum { I_X = 0, I_C, I_CTX, I_CCTX, I_NORMW, I_ADAW, I_ADAB, I_WIN, I_WOUT, I_S5ARE, I_S5AIM, I_S5LDT, I_S5BRE, I_S5BIM, I_S5CRE, I_S5CIM,
       I_S5D, I_GLUW, I_GLUB, I_HCW, I_HCB, I_HW1, I_HB1, I_HF1, I_HW2, I_HB2, I_HF2, I_HW3, I_HB3, I_HF3, I_HW4, I_HBIAS, I_RNW, I_GGW, I_GGB, I_GNW, I_FNW, N_IN };

constexpr size_t al256(size_t x) { return (x + 255) & ~(size_t)255; }
constexpr size_t WS_CTL  = 0;
constexpr size_t WS_MOD  = WS_CTL + 65536;
constexpr size_t WS_ZERO_BYTES = 65536 + al256((size_t)2 * 5 * ADA * 4);
constexpr size_t WS_S5AB = WS_MOD + al256((size_t)2 * 5 * ADA * 4);
constexpr size_t WS_S5BT = WS_S5AB + (size_t)2 * 2 * 32 * 64 * 8;
constexpr size_t WS_H3   = WS_S5BT + (size_t)1048576 + 65536;
constexpr size_t WS_H3C  = WS_H3 + (size_t)2 * 4096 * 64 * 4;
constexpr size_t WS_KC   = WS_H3C + (size_t)256 * 64 * 4;
constexpr size_t WS_LR   = WS_KC + (size_t)2 * 512 * 512 * 4;
constexpr size_t WS_XC1  = WS_LR + (size_t)MR * 32 * 4;
constexpr size_t WS_WOUT = WS_XC1 + (size_t)NCTX * D * 4;
constexpr size_t WS_GLUW = WS_WOUT + (size_t)D * D * 2;
constexpr size_t WS_WIN  = WS_GLUW + (size_t)512 * 512 * 2;
constexpr size_t WS_H    = WS_WIN + (size_t)NPAD * D * 2;
constexpr size_t WS_P    = WS_H + (size_t)MR * D * 2;
constexpr size_t WS_PT   = WS_P + (size_t)MR * LDP * 2;
constexpr size_t WS_KF   = WS_PT + (size_t)2048 * MR * 2;
constexpr size_t WS_OB   = WS_KF + (size_t)2 * 512 * FFTN * 8;
constexpr size_t WS_END  = WS_OB + (size_t)6 * MR * 512 * 2;
constexpr size_t OBSZ = (size_t)MR * 512;

constexpr int LDS_CTL_OFF = 135168 + 1024;
constexpr int LDS_PTR_OFF = LDS_CTL_OFF + 64;
constexpr int LDS_BYTES = LDS_PTR_OFF + 320;

typedef __bf16 hwbf16x2 __attribute__((ext_vector_type(2)));
__device__ __forceinline__ unsigned pk2(float lo, float hi) { const f32x2 v = {lo, hi}; return __builtin_bit_cast(unsigned, __builtin_convertvector(v, hwbf16x2)); }
__device__ __forceinline__ unsigned f2bf(float f) { return pk2(f, 0.f) & 0xffffu; }
__device__ __forceinline__ float bf2f(bf16_t b) { return __uint_as_float((unsigned)b << 16); }
__device__ __forceinline__ float bflo(unsigned w) { return __uint_as_float(w << 16); }
__device__ __forceinline__ float bfhi(unsigned w) { return __uint_as_float(w & 0xffff0000u); }
__device__ __forceinline__ void unpack8(const u32x4 r, float (&f)[8]) { f[0] = bflo(r.x); f[1] = bfhi(r.x); f[2] = bflo(r.y); f[3] = bfhi(r.y); f[4] = bflo(r.z); f[5] = bfhi(r.z); f[6] = bflo(r.w); f[7] = bfhi(r.w); }
__device__ __forceinline__ u32x4 pack8(const float (&f)[8]) { u32x4 o; o.x = pk2(f[0], f[1]); o.y = pk2(f[2], f[3]); o.z = pk2(f[4], f[5]); o.w = pk2(f[6], f[7]); return o; }
__device__ __forceinline__ float sigmoidf_(float x) { return __builtin_amdgcn_rcpf(1.0f + __expf(-x)); }
__device__ __forceinline__ float siluf_(float x) { return x * sigmoidf_(x); }
__device__ __forceinline__ float gelu_tanh(float x) { const float u2 = 1.5957691216057308f * (x + 0.044715f * x * x * x); return x * sigmoidf_(u2); }
__device__ __forceinline__ float wave_sum(float v) {
#pragma unroll
    for (int o = 1; o < 64; o <<= 1) v += __shfl_xor(v, o);
    return v;
}
#define LDS_WAIT() asm volatile("s_waitcnt lgkmcnt(0)" ::: "memory")

struct Args { const float* in[N_IN]; float* out; unsigned char* ws; int ph_lo, ph_hi; };
struct InTab { const LAS unsigned long long* t;
    __device__ __forceinline__ const float* operator[](int i) const { const unsigned long long v = t[i];
        const unsigned lo = __builtin_amdgcn_readfirstlane((unsigned)v), hi = __builtin_amdgcn_readfirstlane((unsigned)(v >> 32)); return (const float*)(__attribute__((address_space(1))) const float*)(((unsigned long long)hi << 32) | lo); } };
struct DArgs { InTab in; float* out; };

#define XB_TMO      128
#define XB_XCNT(j)  (256  + 64 * (j))
#define XB_XSUB(j)  (1280 + 64 * (j))
#define XB_XGEN(j)  (2304 + 64 * (j))
#define XB_TOP      3328
#define XB_TOPGEN   3392
#define XCD_BAR_WORDS 3456
#define XB_SPIN_CAP (1u << 22)
__device__ __forceinline__ unsigned xb_ld(unsigned* p)              { return __hip_atomic_load(p, __ATOMIC_RELAXED, __HIP_MEMORY_SCOPE_AGENT); }
__device__ __forceinline__ unsigned xb_add(unsigned* p, unsigned v) { return __hip_atomic_fetch_add(p, v, __ATOMIC_RELAXED, __HIP_MEMORY_SCOPE_AGENT); }
__device__ __forceinline__ unsigned xb_xcc_id() { return (unsigned)__builtin_amdgcn_s_getreg((3 << 11) | 20) & 0xFu; }
#define XB_SPIN(cond, bar) do { unsigned _sp = 0; while (cond) { __builtin_amdgcn_s_sleep(1); \
    if ((++_sp & 255u) == 0u) { if (xb_ld(&(bar)[XB_TMO])) break; if (_sp > XB_SPIN_CAP) { atomicAdd(&(bar)[XB_TMO], 1u); break; } } } } while (0)
struct XcdBarrier { unsigned* bar; unsigned x; volatile LAS unsigned* st; };
__device__ __forceinline__ XcdBarrier xcd_barrier_post(unsigned* bar, volatile LAS unsigned* st) {
    XcdBarrier b; b.bar = bar; b.x = xb_xcc_id(); b.st = st;
    if (threadIdx.x == 0) (void)xb_add(&bar[XB_XCNT(b.x)], 1u);
    return b;
}
__device__ __forceinline__ void xcd_barrier_complete(unsigned* bar, unsigned x, unsigned& nloc, unsigned& nx) {
    const unsigned G = gridDim.x * gridDim.y * gridDim.z;
    unsigned sum, cnt, mine, sp = 0u;
    for (;;) {
        sum = 0u; cnt = 0u; mine = 0u;
#pragma unroll
        for (unsigned j = 0; j < 16; ++j) { const unsigned c = xb_ld(&bar[XB_XCNT(j)]); sum += c; cnt += (c > 0u) ? 1u : 0u; mine = (j == x) ? c : mine; }
        if (sum == G) break;
        __builtin_amdgcn_s_sleep(1);
        if ((++sp & 255u) == 0u) { if (xb_ld(&bar[XB_TMO])) break; if (sp > XB_SPIN_CAP) { atomicAdd(&bar[XB_TMO], 1u); break; } }
    }
    nloc = mine > 0u ? mine : 1u; nx = cnt > 0u ? cnt : 1u;
}
__device__ __forceinline__ void xcd_barrier(const XcdBarrier& b) {
    asm volatile("s_waitcnt vmcnt(0)" ::: "memory");
    __syncthreads();
    if (threadIdx.x == 0) {
        unsigned* bar = b.bar;
        __builtin_amdgcn_s_waitcnt(0);
        unsigned nloc = b.st[0], nx = b.st[1];
        if (nloc == 0u) { xcd_barrier_complete(bar, b.x, nloc, nx); b.st[0] = nloc; b.st[1] = nx; }
        const unsigned old = xb_add(&bar[XB_XSUB(b.x)], 1u);
        const unsigned gen = old / nloc;
        if (old + 1u == (gen + 1u) * nloc) {
            __builtin_amdgcn_fence(__ATOMIC_RELEASE, "agent");
            asm volatile("s_waitcnt vmcnt(0)" ::: "memory");
            const unsigned og = xb_add(&bar[XB_TOP], 1u);
            const unsigned tg = og / nx;
            if (og + 1u == (tg + 1u) * nx) xb_add(&bar[XB_TOPGEN], 1u);
            else XB_SPIN(xb_ld(&bar[XB_TOPGEN]) == tg, bar);
            __builtin_amdgcn_fence(__ATOMIC_ACQUIRE, "agent");
            xb_add(&bar[XB_XGEN(b.x)], 1u);
            asm volatile("s_waitcnt vmcnt(0)" ::: "memory");
        } else {
            XB_SPIN(xb_ld(&bar[XB_XGEN(b.x)]) == gen, bar);
            __builtin_amdgcn_fence(__ATOMIC_ACQUIRE, "agent");
            asm volatile("s_waitcnt vmcnt(0)" ::: "memory");
        }
    }
    __syncthreads();
}
#ifndef PG8_RB
#define PG8_RB 4
#endif
#ifndef PG8_WGM
#define PG8_WGM 4
#endif
namespace pg8 {
#define PG8_LAS __attribute__((address_space(3)))
typedef unsigned short bf16_t;
typedef short bf16x8 __attribute__((ext_vector_type(8)));
typedef float f32x4 __attribute__((ext_vector_type(4)));
typedef unsigned u32x4 __attribute__((ext_vector_type(4)));
constexpr int BM = 256, BK = 64, HALF = 128, HTB = HALF * BK * 2, STAGE_BYTES = 8 * HTB, NXCD = 8, WGM = PG8_WGM;

__host__ __device__ __forceinline__ int lds_byte(int r, int c) { const int st = (r >> 4) * 2 + (c >> 5), rr = r & 15, cc = c & 31, ob = rr * 64 + cc * 2; return st * 1024 + (ob ^ (((ob >> 9) & 1) << 5)); }
__host__ __device__ __forceinline__ void stage_rc(int b, int& R, int& C) { const int st = b / 1024, sb = b % 1024, swz = sb ^ (((sb >> 9) & 1) << 5); R = (st >> 1) * 16 + swz / 64; C = (st & 1) * 32 + (swz % 64) / 2; }
__host__ __device__ __forceinline__ int perm32(int rho) { const int n = rho >> 4, i = rho & 15; return 8 * (i >> 2) + 4 * n + (i & 3); }

struct Unit { int pm, pn; };
struct Gemm { const bf16_t* A; const bf16_t* Bt; int M, N, K; };

struct StaticOrder {
    int nM, nN, nwg, G, c;
    __host__ __device__ void init(int M, int N, int G_, int c_) { nM = M / BM; nN = N / BM; nwg = nM * nN; G = G_; c = c_; }
    __host__ __device__ bool next(int i, Unit& u) const {
        const long L = (long)i * G + c; if (L >= nwg) return false;
        int wgid = (int)L; { const int q = nwg / NXCD, r = nwg % NXCD, xcd = wgid % NXCD, off = wgid / NXCD; wgid = (xcd < r ? xcd * (q + 1) : r * (q + 1) + (xcd - r) * q) + off; }
        const int nig = WGM * nN, gid = wgid / nig, fm = gid * WGM, gsz = (nM - fm) < WGM ? (nM - fm) : WGM;
        u.pm = fm + ((wgid % nig) % gsz); u.pn = (wgid % nig) / gsz; return true;
    }
    __device__ __forceinline__ void a_ready(const Unit&) const {}
    __device__ __forceinline__ void done(const Unit&) const {}
    __device__ __forceinline__ bool swapped(const Unit&) const { return false; }
};


struct InProjOrder {
    int G, c, last;
    __host__ __device__ void init(int last_, int G_, int c_) { last = last_; G = G_; c = c_; }
    __host__ __device__ bool next(int i, Unit& u) const {
        const int L = i * G + c;
        if (L < 1728) { constexpr int RB = PG8_RB, BT = 8 * RB * 27, CB = 32 / RB; const int band = L / BT, r = L % BT, blk = r >> 8, q = r & 255, x = q & 7, j = q >> 3;
            u.pm = 8 * RB * band + RB * x + (j % RB); u.pn = CB * blk + (j / RB); return true; }
        if (!last) { if (L >= 1836) return false; const int r = L - 1728; u.pm = 64 + (r & 3); u.pn = r >> 2; return true; }
        if (L >= 1768) return false;
        const int k = L - 1728, j = k % 10; u.pm = 64 + k / 10;
        u.pn = j == 0 ? 0 : j == 1 ? 1 : j == 2 ? 14 : j == 3 ? 15 : j == 4 ? 16 : j == 5 ? 17 : j == 6 ? 21 : j == 7 ? 22 : j == 8 ? 23 : 26;
        return true;
    }
    __device__ __forceinline__ void a_ready(const Unit&) const {}
    __device__ __forceinline__ void done(const Unit&) const {}
    __device__ __forceinline__ bool swapped(const Unit& u) const { return u.pn >= 4 && u.pn < 12; }
};
template <class Epi, class Sched, bool ALIGN_EPI = false, bool SP2 = false>
__device__ __forceinline__ void gemm_phase(PG8_LAS unsigned char* lds, const Gemm g, const Sched& S, const Epi& E, const int tid) {
    const int wid = __builtin_amdgcn_readfirstlane(tid >> 6), lane = tid & 63, wr = wid >> 2, wc = wid & 3, fr = lane & 15, fq = lane >> 4;
    const int K = g.K, nt = K / BK;
    unsigned voffA[2], voffB[2];
#pragma unroll
    for (int i = 0; i < 2; ++i) { int R, C; stage_rc(tid * 16 + i * 8192, R, C); const int Rb = Epi::PERM ? ((R & ~31) + perm32(R & 31)) : R;
        voffA[i] = (unsigned)(R * K + C) * 2u; voffB[i] = (unsigned)(Rb * K + C) * 2u; }
    const size_t kstep = (size_t)(BK * 2);
    const size_t hstep = (size_t)HALF * K * 2;
    const size_t tstep = 2 * hstep;
    const unsigned ldsw = (unsigned)wid * 1024u;
    const int aoff = lds_byte(wr * 64 + fr, fq * 8), boff = lds_byte(wc * 32 + fr, fq * 8);
#define PG8_SA(b, h) (((b) * 2 + (h)) * HTB)
#define PG8_SB(b, h) ((4 + (b) * 2 + (h)) * HTB)
#define PG8_STAGE(bufoff, gbase, voff) do { _Pragma("unroll") for (int _i = 0; _i < 2; ++_i) \
        __builtin_amdgcn_global_load_lds((const unsigned*)((const char*)(gbase) + (voff)[_i]), (PG8_LAS unsigned*)(lds + (bufoff) + ldsw + _i * 8192), 16, 0, 0); } while (0)
#define PG8_LDA(dst, b, h) do { _Pragma("unroll") for (int m = 0; m < 4; ++m) _Pragma("unroll") for (int k = 0; k < 2; ++k) dst[m][k] = *(const PG8_LAS bf16x8*)(lds + PG8_SA(b, h) + aoff + m * 2048 + k * 1024); } while (0)
#define PG8_LDB(dst, b, h) do { _Pragma("unroll") for (int n = 0; n < 2; ++n) _Pragma("unroll") for (int k = 0; k < 2; ++k) dst[n][k] = *(const PG8_LAS bf16x8*)(lds + PG8_SB(b, h) + boff + n * 2048 + k * 1024); } while (0)
#define PG8_MMA(ai, bj, At, Bt) do { __builtin_amdgcn_s_setprio(1); _Pragma("unroll") for (int m = 0; m < 4; ++m) _Pragma("unroll") for (int n = 0; n < 2; ++n) _Pragma("unroll") for (int k = 0; k < 2; ++k) \
        acc[ai][bj][m][n] = __builtin_amdgcn_mfma_f32_16x16x32_bf16(Bt[n][k], At[m][k], acc[ai][bj][m][n], 0, 0, 0); __builtin_amdgcn_s_setprio(0); } while (0)
#define PG8_WAIT_V(n) asm volatile("s_waitcnt vmcnt(" #n ")" ::: "memory")
#define PG8_WAIT_L(n) asm volatile("s_waitcnt lgkmcnt(" #n ")" ::: "memory")
#define PG8_BAR __builtin_amdgcn_s_barrier()
#define PG8_SCHED __builtin_amdgcn_sched_barrier(0)
    Unit cur, nxt; int ui = 0;
    if (!S.next(0, cur)) return;
    f32x4 acc[2][2][4][2];
#pragma unroll
    for (int a = 0; a < 2; ++a)
#pragma unroll
        for (int b = 0; b < 2; ++b)
#pragma unroll
            for (int m = 0; m < 4; ++m)
#pragma unroll
                for (int n = 0; n < 2; ++n) acc[a][b][m][n] = (f32x4){0.f, 0.f, 0.f, 0.f};
    bf16x8 At[4][2], B0[2][2], B1[2][2];
    const char* cA; const char* cB;
    { const char* pa = (const char*)g.A + (size_t)cur.pm * tstep; const char* pb = (const char*)g.Bt + (size_t)cur.pn * tstep; const bool sw = S.swapped(cur); cA = sw ? pb : pa; cB = sw ? pa : pb; }
    S.a_ready(cur);
    if constexpr (SP2) {
        PG8_STAGE(PG8_SB(0, 0), cB, voffB); PG8_STAGE(PG8_SB(0, 1), cB + hstep, voffB); PG8_STAGE(PG8_SA(0, 0), cA, voffA); PG8_STAGE(PG8_SA(0, 1), cA + hstep, voffA);
        if (wr == 1) PG8_BAR;
        PG8_WAIT_V(2); PG8_BAR;
        PG8_STAGE(PG8_SB(1, 0), cB + kstep, voffB); PG8_STAGE(PG8_SA(1, 0), cA + kstep, voffA); PG8_STAGE(PG8_SB(1, 1), cB + hstep + kstep, voffB);
        PG8_WAIT_V(6); PG8_BAR;
    } else {
        PG8_STAGE(PG8_SB(0, 0), cB, voffB); PG8_STAGE(PG8_SA(0, 0), cA, voffA); PG8_STAGE(PG8_SB(0, 1), cB + hstep, voffB); PG8_STAGE(PG8_SA(0, 1), cA + hstep, voffA);
        if (wr == 1) PG8_BAR;
        PG8_WAIT_V(4); PG8_BAR;
        PG8_STAGE(PG8_SB(1, 0), cB + kstep, voffB); PG8_STAGE(PG8_SA(1, 0), cA + kstep, voffA); PG8_STAGE(PG8_SB(1, 1), cB + hstep + kstep, voffB);
        PG8_WAIT_V(6); PG8_BAR;
    }
    for (;;) {
        const bool has_next = S.next(ui + 1, nxt);
        const char* nA = cA; const char* nB = cB;
        if (has_next) { const char* pa = (const char*)g.A + (size_t)nxt.pm * tstep; const char* pb = (const char*)g.Bt + (size_t)nxt.pn * tstep; const bool sw = S.swapped(nxt); nA = sw ? pb : pa; nB = sw ? pa : pb; }
#ifdef PG8_REPK
        const int nrep_ = (g.N == PG8_REPK) ? 2 : 1;
        for (int rep_ = 0; rep_ < nrep_; ++rep_) {
        if (rep_) {
#pragma unroll
            for (int a = 0; a < 2; ++a)
#pragma unroll
                for (int b = 0; b < 2; ++b)
#pragma unroll
                    for (int m = 0; m < 4; ++m)
#pragma unroll
                        for (int n = 0; n < 2; ++n) acc[a][b][m][n] = (f32x4){0.f, 0.f, 0.f, 0.f}; }
#endif
        for (int t = 0; t < nt; t += 2) {
#ifdef PG8_REPK
            const bool last = (t == nt - 2) && (rep_ == nrep_ - 1);
            const bool lastk_ = (t == nt - 2);
#else
            const bool last = (t == nt - 2);
#endif
            const char* a1 = cA + (size_t)(t + 1) * kstep;
#ifdef PG8_REPK
            const char* a2 = last ? nA : (lastk_ ? cA : cA + (size_t)(t + 2) * kstep); const char* b2 = last ? nB : (lastk_ ? cB : cB + (size_t)(t + 2) * kstep);
#else
            const char* a2 = last ? nA : cA + (size_t)(t + 2) * kstep; const char* b2 = last ? nB : cB + (size_t)(t + 2) * kstep;
#endif
            const char* a3 = a2 + kstep; const char* b3 = b2 + kstep;
            if (last && has_next) S.a_ready(nxt);
            if constexpr (SP2) {
            PG8_LDB(B0, 0, 0); PG8_LDB(B1, 0, 1); PG8_SCHED; PG8_LDA(At, 0, 0); PG8_STAGE(PG8_SA(1, 1), a1 + hstep, voffA);
            PG8_WAIT_V(8); PG8_WAIT_L(0); PG8_BAR; PG8_MMA(0, 0, At, B0); PG8_MMA(0, 1, At, B1); PG8_BAR; PG8_SCHED;
            PG8_LDA(At, 0, 1); PG8_STAGE(PG8_SB(0, 0), b2, voffB); PG8_STAGE(PG8_SB(0, 1), b2 + hstep, voffB); PG8_STAGE(PG8_SA(0, 0), a2, voffA);
            PG8_WAIT_V(8); PG8_WAIT_L(0); PG8_BAR; PG8_MMA(1, 0, At, B0); PG8_MMA(1, 1, At, B1); PG8_BAR; PG8_SCHED;
            PG8_LDB(B0, 1, 0); PG8_LDB(B1, 1, 1); PG8_SCHED; PG8_LDA(At, 1, 0); PG8_STAGE(PG8_SA(0, 1), a2 + hstep, voffA);
            PG8_WAIT_V(8); PG8_WAIT_L(0); PG8_BAR; PG8_MMA(0, 0, At, B0); PG8_MMA(0, 1, At, B1); PG8_BAR; PG8_SCHED;
            PG8_LDA(At, 1, 1); PG8_STAGE(PG8_SB(1, 0), b3, voffB); PG8_STAGE(PG8_SB(1, 1), b3 + hstep, voffB); PG8_STAGE(PG8_SA(1, 0), a3, voffA);
            PG8_WAIT_V(8); PG8_WAIT_L(0); PG8_BAR; PG8_MMA(1, 0, At, B0); PG8_MMA(1, 1, At, B1); PG8_BAR; PG8_SCHED;
            } else {
            PG8_LDB(B0, 0, 0); PG8_SCHED; PG8_LDA(At, 0, 0); PG8_STAGE(PG8_SA(1, 1), a1 + hstep, voffA);
            PG8_WAIT_L(8); PG8_BAR; PG8_WAIT_L(0); PG8_MMA(0, 0, At, B0); PG8_BAR; PG8_SCHED;
            PG8_LDB(B1, 0, 1); PG8_STAGE(PG8_SB(0, 0), b2, voffB);
            PG8_BAR; PG8_WAIT_L(0); PG8_MMA(0, 1, At, B1); PG8_BAR;
            PG8_LDA(At, 0, 1); PG8_STAGE(PG8_SA(0, 0), a2, voffA);
            PG8_BAR; PG8_WAIT_L(0); PG8_MMA(1, 0, At, B0); PG8_BAR; PG8_SCHED;
            PG8_STAGE(PG8_SB(0, 1), b2 + hstep, voffB);
            PG8_WAIT_V(6); PG8_BAR; PG8_MMA(1, 1, At, B1); PG8_BAR;
            PG8_LDB(B0, 1, 0); PG8_SCHED; PG8_LDA(At, 1, 0); PG8_STAGE(PG8_SA(0, 1), a2 + hstep, voffA);
            PG8_WAIT_L(8); PG8_BAR; PG8_WAIT_L(0); PG8_MMA(0, 0, At, B0); PG8_BAR; PG8_SCHED;
            PG8_LDB(B1, 1, 1); PG8_STAGE(PG8_SB(1, 0), b3, voffB);
            PG8_BAR; PG8_WAIT_L(0); PG8_MMA(0, 1, At, B1); PG8_BAR;
            PG8_LDA(At, 1, 1); PG8_STAGE(PG8_SA(1, 0), a3, voffA);
            PG8_BAR; PG8_WAIT_L(0); PG8_MMA(1, 0, At, B0); PG8_BAR; PG8_SCHED;
            PG8_STAGE(PG8_SB(1, 1), b3 + hstep, voffB);
            PG8_WAIT_V(6); PG8_BAR; PG8_MMA(1, 1, At, B1); PG8_BAR;
            }
        }
#ifdef PG8_REPK
        }
#endif
        if constexpr (ALIGN_EPI) { if (wr == 0) PG8_BAR; }
        { int fr_ = fr, fq_ = fq; asm volatile("" : "+v"(fr_), "+v"(fq_));
          E(acc, cur, wr, wc, fr_, fq_);
#ifdef PG8_REPE
          if (g.N == PG8_REPE) { asm volatile("" : "+v"(fr_), "+v"(fq_)); E(acc, cur, wr, wc, fr_, fq_); }
#endif
          } S.done(cur);
        if (!has_next) break;
#pragma unroll
        for (int a = 0; a < 2; ++a)
#pragma unroll
            for (int b = 0; b < 2; ++b)
#pragma unroll
                for (int m = 0; m < 4; ++m)
#pragma unroll
                    for (int n = 0; n < 2; ++n) acc[a][b][m][n] = (f32x4){0.f, 0.f, 0.f, 0.f};
        cur = nxt; cA = nA; cB = nB; ++ui;
        if constexpr (ALIGN_EPI) { if (wr == 1) PG8_BAR; }
    }
    PG8_WAIT_V(0);
    if constexpr (!ALIGN_EPI) { if (wr == 0) PG8_BAR; }
    PG8_BAR;
#undef PG8_SA
#undef PG8_SB
#undef PG8_STAGE
#undef PG8_LDA
#undef PG8_LDB
#undef PG8_MMA
#undef PG8_WAIT_V
#undef PG8_WAIT_L
#undef PG8_BAR
#undef PG8_SCHED
}
}
__device__ __forceinline__ void prep_adaln(const float* c, const float* cctx, const float* adaw, const float* adab, float* MOD, int it, LAS float* sv, int tid) {
    const int l = it / 96, ct = it % 96, lane = tid & 63, w = tid >> 6;
    for (int i = tid; i < 5 * D; i += NT) { const int v = i >> 11, k = i & (D - 1); const float cv = v < 4 ? c[v * D + k] : cctx[k]; sv[i] = cv / (1.0f + expf(-cv)); }
    __syncthreads();
    const float* wp = adaw + (size_t)l * D * ADA + (size_t)(256 * w) * ADA + ct * 64 + lane;
    float acc[5] = {0.f, 0.f, 0.f, 0.f, 0.f};
#pragma unroll 1
    for (int k0 = 0; k0 < 256; k0 += 32) {
        float wv[32];
#pragma unroll
        for (int k = 0; k < 32; ++k) wv[k] = wp[(size_t)(k0 + k) * ADA];
#pragma unroll
        for (int k4 = 0; k4 < 32; k4 += 4) {
#pragma unroll
            for (int v = 0; v < 5; ++v) { const f32x4 s4 = *(const LAS f32x4*)(sv + v * D + 256 * w + k0 + k4);
                acc[v] += s4.x * wv[k4]; acc[v] += s4.y * wv[k4 + 1]; acc[v] += s4.z * wv[k4 + 2]; acc[v] += s4.w * wv[k4 + 3]; } } }
    LAS float* part = sv + 5 * D;
#pragma unroll
    for (int v = 0; v < 5; ++v) part[(w * 5 + v) * 64 + lane] = acc[v];
    __syncthreads();
    if (tid < 320) { const int v = tid >> 6; float s = adab[l * ADA + ct * 64 + lane];
#pragma unroll
        for (int ww = 0; ww < 8; ++ww) s += part[(ww * 5 + v) * 64 + lane];
        MOD[(size_t)(l * 5 + v) * ADA + ct * 64 + lane] = s; }
    __syncthreads();
}

__device__ __forceinline__ void prep_hymlp(const DArgs& a, float* H3out, bf16_t* H3b, int l, int Lx, int t0, LAS unsigned char* lds, int tid) {
    LAS float* zs = (LAS float*)lds;
    LAS float* h1 = (LAS float*)(lds + 4608);
    LAS float* h2 = (LAS float*)(lds + 4608 + 8192);
    LAS float* w1s = (LAS float*)(lds + 24576);
    LAS float* w2s = w1s + 33 * 64;
    LAS float* w3s = w2s + 64 * 64;
    { const float* w1 = a.in[I_HW1] + (size_t)l * 33 * 64; const float* w2 = a.in[I_HW2] + (size_t)l * 64 * 64; const float* w3 = a.in[I_HW3] + (size_t)l * 64 * 64;
      for (int i = tid; i < 33 * 64; i += NT) w1s[i] = w1[i];
      for (int i = tid; i < 64 * 64; i += NT) { w2s[i] = w2[i]; w3s[i] = w3[i]; } }
    for (int i = tid; i < 32 * 33; i += NT) { const int pos = i / 33, f = i % 33, t = t0 + pos;
        float z;
        if (f == 0) z = (float)t / (float)(Lx - 1);
        else { const int j = (f - 1) & 15; const float fj = 1e-4f + (float)j * ((15.0f - 1e-4f) / 15.0f); const float wpos = (6.283185307179586f * (float)t) / (float)Lx; const float arg = fj * wpos;
               z = (f <= 16) ? cosf(arg) : -sinf(arg); }
        zs[pos * 36 + f] = z; }
    __syncthreads();
    const int pos = tid >> 4, f4 = (tid & 15) * 4, t = t0 + pos;
    f32x4 s = *(const f32x4*)(a.in[I_HB1] + l * 64 + f4);
#pragma unroll 3
    for (int j = 0; j < 33; ++j) s += zs[pos * 36 + j] * *(const LAS f32x4*)(w1s + j * 64 + f4);
    { const f32x4 fr = *(const f32x4*)(a.in[I_HF1] + l * 64 + f4); *(LAS f32x4*)(h1 + pos * 64 + f4) = (f32x4){sinf(fr.x * s.x), sinf(fr.y * s.y), sinf(fr.z * s.z), sinf(fr.w * s.w)}; }
    __syncthreads();
    s = *(const f32x4*)(a.in[I_HB2] + l * 64 + f4);
#pragma unroll 4
    for (int j = 0; j < 64; ++j) s += h1[pos * 64 + j] * *(const LAS f32x4*)(w2s + j * 64 + f4);
    { const f32x4 fr = *(const f32x4*)(a.in[I_HF2] + l * 64 + f4); *(LAS f32x4*)(h2 + pos * 64 + f4) = (f32x4){sinf(fr.x * s.x), sinf(fr.y * s.y), sinf(fr.z * s.z), sinf(fr.w * s.w)}; }
    __syncthreads();
    s = *(const f32x4*)(a.in[I_HB3] + l * 64 + f4);
#pragma unroll 4
    for (int j = 0; j < 64; ++j) s += h2[pos * 64 + j] * *(const LAS f32x4*)(w3s + j * 64 + f4);
    { const f32x4 fr = *(const f32x4*)(a.in[I_HF3] + l * 64 + f4); const f32x4 hv = (f32x4){sinf(fr.x * s.x), sinf(fr.y * s.y), sinf(fr.z * s.z), sinf(fr.w * s.w)}; *(f32x4*)(H3out + (size_t)t * 64 + f4) = hv;
      if (H3b) { u32x2 pk; pk.x = pk2(hv.x, hv.y); pk.y = pk2(hv.z, hv.w); *(u32x2*)(H3b + (size_t)t * 64 + f4) = pk; } }
    __syncthreads();
}

__device__ __forceinline__ void transpose_item(const float* W, int ldw, int srccol_lane  , int k0, bf16_t* WT, int K, int dstrow0, LAS float* scr, int lane) {
    float wv[32];
#pragma unroll
    for (int i = 0; i < 32; ++i) { const int kk = 2 * i + (lane >> 5); wv[i] = srccol_lane >= 0 ? W[(size_t)(k0 + kk) * ldw + srccol_lane] : 0.f; }
#pragma unroll
    for (int i = 0; i < 32; ++i) { const int kk = 2 * i + (lane >> 5); scr[kk * 33 + (lane & 31)] = wv[i]; }
    LDS_WAIT();
    const int c = lane & 7;
#pragma unroll
    for (int j = 0; j < 4; ++j) { const int n = (lane >> 3) + 8 * j; const LAS float* s = scr + (8 * c) * 33 + n;
        u32x4 o; o.x = pk2(s[0 * 33], s[1 * 33]); o.y = pk2(s[2 * 33], s[3 * 33]); o.z = pk2(s[4 * 33], s[5 * 33]); o.w = pk2(s[6 * 33], s[7 * 33]);
        *(u32x4*)(WT + (size_t)(dstrow0 + n) * K + k0 + 8 * c) = o; }
    LDS_WAIT();
}
__device__ __forceinline__ int win_srccol(int n) {
    if (n >= 3072 && n < 4096) { const int u = (n - 3072) & 127, grp = u >> 3, e = u & 7; return (n & ~127) + (e < 4 ? 4 * grp + e : 64 + 4 * grp + (e - 4)); }
    return n < 6144 ? n : (n < 6656 ? n + 32 : (n < 6688 ? n - 512 : -1));
}

__device__ __forceinline__ void norm_row(const float* xrow, const float* nw, const float* mod, bf16_t* hrow, int lane) {
    f32x4 v[8]; float ss = 0.f;
#pragma unroll
    for (int j = 0; j < 8; ++j) { v[j] = ((const f32x4*)xrow)[lane + 64 * j]; ss += (v[j].x * v[j].x + v[j].y * v[j].y) + (v[j].z * v[j].z + v[j].w * v[j].w); }
    const float rstd = rsqrtf(wave_sum(ss) * (1.0f / D) + EPS);
#pragma unroll
    for (int j = 0; j < 8; ++j) { const int k = 4 * (lane + 64 * j);
        const f32x4 w = *(const f32x4*)(nw + k), sh = *(const f32x4*)(mod + k), sc = *(const f32x4*)(mod + D + k);
        const f32x4 o = v[j] * rstd * w * (sc + 1.0f) + sh;
        u32x2 pk; pk.x = pk2(o.x, o.y); pk.y = pk2(o.z, o.w);
        *(u32x2*)(hrow + k) = pk; }
}

__device__ __forceinline__ void norm_row_bf(const bf16_t* xrow, const float* nw, const float* mod, bf16_t* hrow, int lane) {
    u32x4 raw[4]; float ss = 0.f;
#pragma unroll
    for (int j = 0; j < 4; ++j) raw[j] = ((const u32x4*)xrow)[lane + 64 * j];
#pragma unroll
    for (int j = 0; j < 4; ++j) { float f[8]; unpack8(raw[j], f);
#pragma unroll
        for (int x = 0; x < 8; ++x) ss += f[x] * f[x]; }
    const float rstd = rsqrtf(wave_sum(ss) * (1.0f / D) + EPS);
#pragma unroll
    for (int j = 0; j < 4; ++j) { const int k = 8 * (lane + 64 * j); float f[8], o[8]; unpack8(raw[j], f);
#pragma unroll
        for (int h = 0; h < 2; ++h) { const f32x4 w = *(const f32x4*)(nw + k + 4 * h), sh = *(const f32x4*)(mod + k + 4 * h), sc = *(const f32x4*)(mod + D + k + 4 * h);
#pragma unroll
            for (int x = 0; x < 4; ++x) o[4 * h + x] = f[4 * h + x] * rstd * w[x] * (sc[x] + 1.0f) + sh[x]; }
        *(u32x4*)(hrow + k) = pack8(o); }
}

__device__ __forceinline__ float block_sum(float v, LAS float* red, int tid) {
    v = wave_sum(v);
    if ((tid & 63) == 0) red[tid >> 6] = v;
    __syncthreads();
    float t = 0.f;
#pragma unroll
    for (int i = 0; i < NWAVES; ++i) t += red[i];
    __syncthreads();
    return t;
}
constexpr float HY_D0 = -3.0701134573253945f  , HY_D1 = -15.350567286626973f  ;

__device__ __forceinline__ void filt_ctx_item(const DArgs& a, unsigned char* ws, LAS unsigned char* lds, int c, int tid) {
    LAS float* w4s = (LAS float*)lds; LAS float* red = (LAS float*)(lds + 1024);
    if (tid < 256) { const int cc = tid >> 6, f = tid & 63; w4s[tid] = a.in[I_HW4][(size_t)f * 2048 + (cc >> 1) * 1024 + (cc & 1) * 512 + c]; }
    __syncthreads();
    const float dl = fabsf(HY_D0 + (HY_D1 - HY_D0) * ((float)c / 511.0f));
    const float* H3C = (const float*)(ws + WS_H3C);
    const int n = tid, dir = n >= 256 ? 1 : 0, t = dir ? (512 - n) : n;
    float s0 = 0.f, s1 = 0.f;
    if (n != 256) {
        const f32x4* hr = (const f32x4*)(H3C + (size_t)t * 64);
#pragma unroll
        for (int q = 0; q < 16; ++q) { const f32x4 hv = hr[q]; const f32x4 wa = ((const LAS f32x4*)(w4s + (dir * 2 + 0) * 64))[q], wb = ((const LAS f32x4*)(w4s + (dir * 2 + 1) * 64))[q];
            s0 += (hv.x * wa.x + hv.y * wa.y) + (hv.z * wa.z + hv.w * wa.w); s1 += (hv.x * wb.x + hv.y * wb.y) + (hv.z * wb.z + hv.w * wb.w); }
        const float dec = expf(-((float)t / 255.0f) * dl); s0 *= dec; s1 *= dec;
    }
    const float rs0 = rsqrtf(block_sum(s0 * s0, red, tid) + EPS), rs1 = rsqrtf(block_sum(s1 * s1, red, tid) + EPS);
    float* KC = (float*)(ws + WS_KC);
    KC[(size_t)(0 * 512 + c) * 512 + n] = s0 * rs0; KC[(size_t)(1 * 512 + c) * 512 + n] = s1 * rs1;
    __syncthreads();
}

__device__ __forceinline__ void prep_rope(f32x2* RT, int it, int tid) {
    const int idx = it * NT + tid, pos = idx >> 6, j = idx & 63;
    float ang;
    if (pos < SEQL) { const float inv = exp2f(-(float)(j & 31) * (13.287712379549449f / 32.0f)); ang = (float)(j < 32 ? (pos >> 6) : (pos & 63)) * inv; }
    else { const float inv = exp2f(-(float)j * (13.287712379549449f / 64.0f)); ang = (float)(pos - SEQL) * inv; }
    float sn, cs; sincosf(ang, &sn, &cs);
    RT[idx] = (f32x2){cs, sn};
}

__device__ __forceinline__ float sconv3(const bf16_t* p, int t, int Lx, float w0, float w1, float w2, float cb) {
    const float x0 = t > 0 ? bf2f(p[t - 1]) : 0.f, x1 = bf2f(p[t]), x2 = t < Lx - 1 ? bf2f(p[t + 1]) : 0.f;
    return w0 * x0 + w1 * x1 + w2 * x2 + cb;
}
__device__ __forceinline__ void ctx_conv256(const LAS float* kc, const LAS float* z, int b, int t4, int half, float (&o)[4]) {
    o[0] = o[1] = o[2] = o[3] = 0.f;
#pragma unroll 4
    for (int s4 = 0; s4 < 32; ++s4) { const int s = 128 * half + 4 * s4, d = 4 * t4 - s;
        const f32x4 zv = *(const LAS f32x4*)(z + b * 256 + s);
        const f32x4 wl = *(const LAS f32x4*)(kc + ((d - 4) & 511)), wh = *(const LAS f32x4*)(kc + (d & 511));
        const float w[8] = {wl.x, wl.y, wl.z, wl.w, wh.x, wh.y, wh.z, wh.w};
        const float zz[4] = {zv.x, zv.y, zv.z, zv.w};
#pragma unroll
        for (int j = 0; j < 4; ++j)
#pragma unroll
            for (int i = 0; i < 4; ++i) o[j] += w[4 + j - i] * zz[i]; }
}
__device__ __forceinline__ void hyena_ctx_item(const DArgs& a, unsigned char* ws, LAS unsigned char* lds, int c, int tid) {
    LAS float* kc = (LAS float*)lds; LAS float* za = (LAS float*)(lds + 4096); LAS float* zb = (LAS float*)(lds + 8192); LAS float* part = (LAS float*)(lds + 12288);
    const float* KC = (const float*)(ws + WS_KC);
    kc[tid] = KC[(size_t)(0 * 512 + c) * 512 + tid]; kc[512 + tid] = KC[(size_t)(1 * 512 + c) * 512 + tid];
    const float* cw = a.in[I_HCW]; const float* cbp = a.in[I_HCB];
    const float wv0 = cw[c], wv1 = cw[1536 + c], wv2 = cw[3072 + c], bv = cbp[c];
    const float wa0 = cw[512 + c], wa1 = cw[1536 + 512 + c], wa2 = cw[3072 + 512 + c], ba = cbp[512 + c];
    const float wb0 = cw[1024 + c], wb1 = cw[1536 + 1024 + c], wb2 = cw[3072 + 1024 + c], bb = cbp[1024 + c];
    const float bias0 = a.in[I_HBIAS][0 * 512 + c], bias1 = a.in[I_HBIAS][1 * 512 + c];
    const bf16_t* PT = (const bf16_t*)(ws + WS_PT);
    const int half = tid >> 8, b = (tid >> 6) & 3, t4 = tid & 63; const int rb = NLAT + b * LC;
    const bf16_t* pv = PT + (size_t)(PT_V + c) * MR + rb; const bf16_t* pg1 = PT + (size_t)(PT_G1 + c) * MR + rb; const bf16_t* pg2 = PT + (size_t)(PT_G2 + c) * MR + rb; const bf16_t* phg = PT + (size_t)(PT_HG + c) * MR + rb;
    bf16_t* GATED = (bf16_t*)(ws + WS_H);
    float z0[4], z1[4], o[4], g1v[4], g2v[4], hgv[4];
#pragma unroll
    for (int j = 0; j < 4; ++j) { z0[j] = sconv3(pv, 4 * t4 + j, LC, wv0, wv1, wv2, bv); g1v[j] = sconv3(pg1, 4 * t4 + j, LC, wa0, wa1, wa2, ba); g2v[j] = sconv3(pg2, 4 * t4 + j, LC, wb0, wb1, wb2, bb); hgv[j] = bf2f(phg[4 * t4 + j]); }
    if (half == 0) *(LAS f32x4*)(za + b * 256 + 4 * t4) = (f32x4){z0[0], z0[1], z0[2], z0[3]};
    __syncthreads();
    ctx_conv256(kc, za, b, t4, half, o);
    if (half == 1) *(LAS f32x4*)(part + b * 256 + 4 * t4) = (f32x4){o[0], o[1], o[2], o[3]};
    __syncthreads();
    if (half == 0) { const f32x4 pp = *(const LAS f32x4*)(part + b * 256 + 4 * t4); const float ps[4] = {pp.x, pp.y, pp.z, pp.w};
#pragma unroll
        for (int j = 0; j < 4; ++j) z1[j] = g1v[j] * (o[j] + ps[j] + bias0 * z0[j]);
        *(LAS f32x4*)(zb + b * 256 + 4 * t4) = (f32x4){z1[0], z1[1], z1[2], z1[3]}; }
    __syncthreads();
    ctx_conv256(kc + 512, zb, b, t4, half, o);
    if (half == 1) *(LAS f32x4*)(part + b * 256 + 4 * t4) = (f32x4){o[0], o[1], o[2], o[3]};
    __syncthreads();
    if (half == 0) { const f32x4 pp = *(const LAS f32x4*)(part + b * 256 + 4 * t4); const float ps[4] = {pp.x, pp.y, pp.z, pp.w};
#pragma unroll
        for (int j = 0; j < 4; ++j) { const int t = 4 * t4 + j; const float z2 = g2v[j] * (o[j] + ps[j] + bias1 * z1[j]);
            GATED[(size_t)(rb + t) * D + 512 + c] = (bf16_t)f2bf(z2 * siluf_(hgv[j])); } }
    __syncthreads();
}

struct EpiInProj {
    static constexpr bool PERM = true, AFTER_DRAIN = false;
    bf16_t* P; bf16_t* PT; float* LR; const float* RT;
    __device__ __forceinline__ void operator()(const pg8::f32x4 (&acc)[2][2][4][2], const pg8::Unit& u, int wr, int wc, int fr, int fq) const {
        const int row0 = u.pm * 256 + wr * 64 + fr, pn = u.pn;
        if (pn >= 12 && pn < 16) {
            const int colbase = pn * 256 - 2048 + wc * 32 + 8 * fq; const int j0 = 4 * (4 * wc + fq); const float ksc = pn >= 14 ? 0.08838834764831845f : 1.0f;
#pragma unroll
            for (int ai = 0; ai < 2; ++ai)
#pragma unroll
                for (int m = 0; m < 4; ++m) { const int row = row0 + ai * 128 + m * 16; const int pos = row < NLAT ? (row & (SEQL - 1)) : SEQL + ((row - NLAT) & (LC - 1));
                    const pg8::f32x4 t0 = *(const pg8::f32x4*)(RT + ((size_t)pos * 64 + j0) * 2), t1 = *(const pg8::f32x4*)(RT + ((size_t)pos * 64 + j0) * 2 + 4);
                    bf16_t* rowp = P + (size_t)row * LDP + colbase;
#pragma unroll
                    for (int bj = 0; bj < 2; ++bj) { const pg8::f32x4 x1 = acc[ai][bj][m][0] * ksc, x2 = acc[ai][bj][m][1] * ksc;
                        u32x4 w; w.x = pk2(x1[0] * t0[0] - x2[0] * t0[1], x1[1] * t0[2] - x2[1] * t0[3]); w.y = pk2(x1[2] * t1[0] - x2[2] * t1[1], x1[3] * t1[2] - x2[3] * t1[3]);
                        w.z = pk2(x1[0] * t0[1] + x2[0] * t0[0], x1[1] * t0[3] + x2[1] * t0[2]); w.w = pk2(x1[2] * t1[1] + x2[2] * t1[0], x1[3] * t1[3] + x2[3] * t1[2]);
                        __builtin_nontemporal_store(w, (u32x4*)(rowp + bj * 128)); } }
        } else if (pn < 4 || (pn >= 16 && pn < 26)) {
            const int colbase = (pn < 4 ? pn * 256 : pn * 256 - 2048) + wc * 32 + 8 * fq;
#pragma unroll
            for (int ai = 0; ai < 2; ++ai)
#pragma unroll
                for (int m = 0; m < 4; ++m) { bf16_t* rowp = P + (size_t)(row0 + ai * 128 + m * 16) * LDP + colbase;
#pragma unroll
                    for (int bj = 0; bj < 2; ++bj) { const pg8::f32x4 v0 = acc[ai][bj][m][0], v1 = acc[ai][bj][m][1];
                        u32x4 w; w.x = pk2(v0[0], v0[1]); w.y = pk2(v0[2], v0[3]); w.z = pk2(v1[0], v1[1]); w.w = pk2(v1[2], v1[3]);
                        __builtin_nontemporal_store(w, (u32x4*)(rowp + bj * 128)); } }
        } else if (pn < 12) {
            const int prow0 = (pn - 4) * 256 + wr * 64 + fr, tok0 = u.pm * 256 + wc * 32 + 8 * fq;
#pragma unroll
            for (int ai = 0; ai < 2; ++ai)
#pragma unroll
                for (int m = 0; m < 4; ++m) { bf16_t* rowp = PT + (size_t)(prow0 + ai * 128 + m * 16) * MR + tok0;
#pragma unroll
                    for (int bj = 0; bj < 2; ++bj) { const pg8::f32x4 v0 = acc[ai][bj][m][0], v1 = acc[ai][bj][m][1];
                        u32x4 w; w.x = pk2(v0[0], v0[1]); w.y = pk2(v0[2], v0[3]); w.z = pk2(v1[0], v1[1]); w.w = pk2(v1[2], v1[3]);
                        __builtin_nontemporal_store(w, (u32x4*)(rowp + bj * 128)); } }
        } else {
            if (wc == 0) {
#pragma unroll
                for (int ai = 0; ai < 2; ++ai)
#pragma unroll
                    for (int m = 0; m < 4; ++m) { float* rowp = LR + (size_t)(row0 + ai * 128 + m * 16) * 32 + 8 * fq;
                        *(pg8::f32x4*)(rowp) = acc[ai][0][m][0]; *(pg8::f32x4*)(rowp + 4) = acc[ai][0][m][1]; }
            }
        }
    }
};
struct EpiGlu {
    static constexpr bool PERM = true, AFTER_DRAIN = false;
    const bf16_t* GG; bf16_t* GATED; const float* bias;
    __device__ __forceinline__ void operator()(const pg8::f32x4 (&acc)[2][2][4][2], const pg8::Unit& u, int wr, int wc, int fr, int fq) const {
        const int row0 = u.pm * 256 + wr * 64 + fr, col0 = u.pn * 256 + wc * 32 + 8 * fq;
        pg8::f32x4 b0[2], b1[2];
#pragma unroll
        for (int bj = 0; bj < 2; ++bj) { b0[bj] = *(const pg8::f32x4*)(bias + col0 + bj * 128); b1[bj] = *(const pg8::f32x4*)(bias + col0 + bj * 128 + 4); }
#pragma unroll
        for (int ai = 0; ai < 2; ++ai) {
            u32x4 gg[4][2];
#pragma unroll
            for (int m = 0; m < 4; ++m)
#pragma unroll
                for (int bj = 0; bj < 2; ++bj) gg[m][bj] = *(const u32x4*)(GG + (size_t)(row0 + ai * 128 + m * 16) * 512 + col0 + bj * 128);
#pragma unroll
            for (int m = 0; m < 4; ++m) { const size_t row = (size_t)(row0 + ai * 128 + m * 16);
#pragma unroll
                for (int bj = 0; bj < 2; ++bj) { float g[8], res[8]; unpack8(gg[m][bj], g);
#pragma unroll
                    for (int j = 0; j < 4; ++j) { res[j] = g[j] * sigmoidf_(acc[ai][bj][m][0][j] + b0[bj][j]); res[4 + j] = g[4 + j] * sigmoidf_(acc[ai][bj][m][1][j] + b1[bj][j]); }
                    *(u32x4*)(GATED + row * D + col0 + bj * 128) = pack8(res); } }
            asm volatile("" ::: "memory");
        }
    }
};
struct EpiOut {
    static constexpr bool PERM = true, AFTER_DRAIN = false;
    const float* xl_old_f; const bf16_t* xl_old_b; const float* xc_old; bf16_t* xl_new; float* xc_new; const float* mod;
    __device__ __forceinline__ void operator()(const pg8::f32x4 (&acc)[2][2][4][2], const pg8::Unit& u, int wr, int wc, int fr, int fq) const {
        const int row0 = u.pm * 256 + wr * 64 + fr, col0 = u.pn * 256 + wc * 32 + 8 * fq;
        const bool lat = u.pm < 64;
#pragma unroll
        for (int ai = 0; ai < 2; ++ai) {
            const int v = lat ? ((u.pm * 256 + ai * 128) >> 12) : 4;
            const float* gt = mod + (size_t)v * ADA + 2 * D + col0;
            pg8::f32x4 gv[2][2];
#pragma unroll
            for (int bj = 0; bj < 2; ++bj) { gv[bj][0] = *(const pg8::f32x4*)(gt + bj * 128); gv[bj][1] = *(const pg8::f32x4*)(gt + bj * 128 + 4); }
            if (lat) {
                if (xl_old_f) {
#pragma unroll
                    for (int m = 0; m < 4; ++m) { const size_t off = (size_t)(row0 + ai * 128 + m * 16) * D + col0;
#pragma unroll
                        for (int bj = 0; bj < 2; ++bj) { const pg8::f32x4 x0 = *(const pg8::f32x4*)(xl_old_f + off + bj * 128), x1 = *(const pg8::f32x4*)(xl_old_f + off + bj * 128 + 4);
                            const pg8::f32x4 r0 = x0 + gv[bj][0] * acc[ai][bj][m][0], r1 = x1 + gv[bj][1] * acc[ai][bj][m][1];
                            u32x4 w; w.x = pk2(r0[0], r0[1]); w.y = pk2(r0[2], r0[3]); w.z = pk2(r1[0], r1[1]); w.w = pk2(r1[2], r1[3]);
                            *(u32x4*)(xl_new + off + bj * 128) = w; } }
                } else {
#pragma unroll
                    for (int m = 0; m < 4; ++m) { const size_t off = (size_t)(row0 + ai * 128 + m * 16) * D + col0;
#pragma unroll
                        for (int bj = 0; bj < 2; ++bj) { float xo[8]; unpack8(*(const u32x4*)(xl_old_b + off + bj * 128), xo);
                            const pg8::f32x4 a0 = acc[ai][bj][m][0], a1 = acc[ai][bj][m][1];
                            u32x4 w; w.x = pk2(xo[0] + gv[bj][0][0] * a0[0], xo[1] + gv[bj][0][1] * a0[1]); w.y = pk2(xo[2] + gv[bj][0][2] * a0[2], xo[3] + gv[bj][0][3] * a0[3]);
                            w.z = pk2(xo[4] + gv[bj][1][0] * a1[0], xo[5] + gv[bj][1][1] * a1[1]); w.w = pk2(xo[6] + gv[bj][1][2] * a1[2], xo[7] + gv[bj][1][3] * a1[3]);
                            *(u32x4*)(xl_new + off + bj * 128) = w; } }
                }
            } else {
#pragma unroll
                for (int m = 0; m < 4; ++m) { const size_t off = (size_t)(row0 - NLAT + ai * 128 + m * 16) * D + col0;
#pragma unroll
                    for (int bj = 0; bj < 2; ++bj) { const pg8::f32x4 x0 = *(const pg8::f32x4*)(xc_old + off + bj * 128), x1 = *(const pg8::f32x4*)(xc_old + off + bj * 128 + 4);
                        *(pg8::f32x4*)(xc_new + off + bj * 128) = x0 + gv[bj][0] * acc[ai][bj][m][0]; *(pg8::f32x4*)(xc_new + off + bj * 128 + 4) = x1 + gv[bj][1] * acc[ai][bj][m][1]; } }
            }
        }
    }
};
typedef short bf16x8 __attribute__((ext_vector_type(8)));
typedef short bf16x4 __attribute__((ext_vector_type(4)));
__device__ __forceinline__ unsigned off_b(unsigned row, unsigned ch) { return 256u * row + 16u * (ch ^ (((row & 3) << 2) | ((row >> 2) & 3))); }
__device__ __forceinline__ bf16x8 img_row_frag(const LAS unsigned char* img, unsigned lane, unsigned rb, unsigned s) { return *(const LAS bf16x8*)(img + off_b((lane & 15) + 16 * rb, 4 * s + (lane >> 4))); }
__device__ __forceinline__ bf16x4 img_tr4(const LAS unsigned char* img, unsigned lane, unsigned c, unsigned row0) {
    const unsigned q = (lane & 15) >> 2, p = lane & 3;
    return __builtin_amdgcn_ds_read_tr16_b64_v4i16((LAS bf16x4*)(img + off_b(row0 + q, 2 * c + (p >> 1)) + 8 * (p & 1)));
}
__device__ __forceinline__ bf16x8 img_tr_frag(const LAS unsigned char* img, unsigned lane, unsigned c, unsigned ks) {
    const unsigned g = lane >> 4; const bf16x4 lo = img_tr4(img, lane, c, 32 * ks + 8 * g), hi = img_tr4(img, lane, c, 32 * ks + 8 * g + 4);
    return __builtin_shufflevector(lo, hi, 0, 1, 2, 3, 4, 5, 6, 7);
}
__device__ __forceinline__ bf16x8 img_tr_frag_acc(const LAS unsigned char* img, unsigned lane, unsigned c, unsigned ks) {
    const unsigned g = lane >> 4; const bf16x4 lo = img_tr4(img, lane, c, 32 * ks + 4 * g), hi = img_tr4(img, lane, c, 32 * ks + 16 + 4 * g);
    return __builtin_shufflevector(lo, hi, 0, 1, 2, 3, 4, 5, 6, 7);
}
__device__ __forceinline__ bf16x8 acc_pair_frag(const f32x4 a0, const f32x4 a1) {
    u32x4 w; w.x = pk2(a0.x, a0.y); w.y = pk2(a0.z, a0.w); w.z = pk2(a1.x, a1.y); w.w = pk2(a1.z, a1.w);
    return __builtin_bit_cast(bf16x8, w);
}
#define MFMA16(A_, B_, C_) __builtin_amdgcn_mfma_f32_16x16x32_bf16((A_), (B_), (C_), 0, 0, 0)
__device__ __forceinline__ void stage_tile128(LAS unsigned char* img, const bf16_t* g, size_t ld, int tid) {
#pragma unroll
    for (int i = 0; i < 4; ++i) { const int n = tid + NT * i, row = n >> 4, ch = n & 15; *(LAS u32x4*)(img + off_b(row, ch)) = *(const u32x4*)(g + (size_t)row * ld + ch * 8); }
}

constexpr int RCH = 128, RNCH = 34;
constexpr size_t WS_RST = WS_OB;
__device__ __forceinline__ int ret_rowbase(int b, int cc) { return cc < 2 ? NLAT + b * LC + cc * RCH : b * SEQL + (cc - 2) * RCH; }
__device__ __forceinline__ float ret_log2g(int h) { return log2f(1.0f - exp2f(-5.0f - (float)h)); }

__device__ __forceinline__ void ret_passA(unsigned char* ws, LAS unsigned char* lds, int item, int tid) {
    const int bh = item / RNCH, cc = item % RNCH, b = bh >> 2, h = bh & 3;
    const int lane = tid & 63, w = tid >> 6, g = lane >> 4;
    LAS unsigned char* KF = lds; LAS unsigned char* KB = lds + 32768; LAS unsigned char* VI = lds + 65536;
    const bf16_t* P = (const bf16_t*)(ws + WS_P) + (size_t)ret_rowbase(b, cc) * LDP;
    const float l2g = ret_log2g(h);
    __syncthreads();
#pragma unroll
    for (int i = 0; i < 4; ++i) { const int n = tid + NT * i, row = n >> 4, ch = n & 15;
        const u32x4 kr = *(const u32x4*)(P + (size_t)row * LDP + PC_RK + h * 128 + ch * 8);
        float kf[8], a[8], c[8]; unpack8(kr, kf);
        const float sf = exp2f(l2g * (float)(RCH - 1 - row)), sb = exp2f(l2g * (float)row);
#pragma unroll
        for (int x = 0; x < 8; ++x) { a[x] = kf[x] * sf; c[x] = kf[x] * sb; }
        *(LAS u32x4*)(KF + off_b(row, ch)) = pack8(a); *(LAS u32x4*)(KB + off_b(row, ch)) = pack8(c);
        *(LAS u32x4*)(VI + off_b(row, ch)) = *(const u32x4*)(P + (size_t)row * LDP + PC_RV + h * 128 + ch * 8); }
    __syncthreads();
    bf16x8 af[4], ab[4];
#pragma unroll
    for (int ks = 0; ks < 4; ++ks) { af[ks] = img_tr_frag(KF, lane, w, ks); ab[ks] = img_tr_frag(KB, lane, w, ks); }
    bf16_t* ST = (bf16_t*)(ws + WS_RST) + ((size_t)(bh * 2) * RNCH + cc) * (128 * 128);
#pragma unroll 2
    for (int E = 0; E < 8; ++E) {
        f32x4 cf = {0.f, 0.f, 0.f, 0.f}, cb = {0.f, 0.f, 0.f, 0.f};
#pragma unroll
        for (int ks = 0; ks < 4; ++ks) { const bf16x8 vb = img_tr_frag(VI, lane, E, ks); cf = MFMA16(af[ks], vb, cf); cb = MFMA16(ab[ks], vb, cb); }
        const int e = 16 * E + (lane & 15), d0 = 16 * w + 4 * g;
        u32x2 o; o.x = pk2(cf.x, cf.y); o.y = pk2(cf.z, cf.w); *(u32x2*)(ST + (size_t)e * 128 + d0) = o;
        o.x = pk2(cb.x, cb.y); o.y = pk2(cb.z, cb.w); *(u32x2*)(ST + (size_t)RNCH * 128 * 128 + (size_t)e * 128 + d0) = o;
    }
}
__device__ __forceinline__ void ret_passB(unsigned char* ws, int gt  ) {
    const int el = gt & 2047, bd = gt >> 11, bh = bd >> 1, dir = bd & 1, h = bh & 3;
    const float gC = exp2f(ret_log2g(h) * (float)RCH);
    bf16_t* base = (bf16_t*)(ws + WS_RST) + (size_t)bd * RNCH * (128 * 128) + (size_t)el * 8;
    float acc[8];
#pragma unroll
    for (int x = 0; x < 8; ++x) acc[x] = 0.f;
#pragma unroll 1
    for (int s0 = 0; s0 < RNCH; s0 += 17) {
        u32x4 kvr[17];
#pragma unroll
        for (int j = 0; j < 17; ++j) { const int s = s0 + j; const int cc = dir == 0 ? s : (s < 2 ? 1 - s : 35 - s); kvr[j] = *(const u32x4*)(base + (size_t)cc * (128 * 128)); }
#pragma unroll
        for (int j = 0; j < 17; ++j) { const int s = s0 + j; const int cc = dir == 0 ? s : (s < 2 ? 1 - s : 35 - s);
            float kv[8]; unpack8(kvr[j], kv);
            *(u32x4*)(base + (size_t)cc * (128 * 128)) = pack8(acc);
#pragma unroll
            for (int x = 0; x < 8; ++x) acc[x] = gC * acc[x] + kv[x]; }
    }
}
__device__ __forceinline__ void ret_passC(const DArgs& a, unsigned char* ws, LAS unsigned char* lds, int l, int item, int tid) {
    const int bh = item / RNCH, cc = item % RNCH, b = bh >> 2, h = bh & 3;
    const int lane = tid & 63, w = tid >> 6, g = lane >> 4, il = lane & 15;
    LAS unsigned char* KI = lds; LAS unsigned char* VI = lds + 32768; LAS unsigned char* SF = lds + 65536; LAS unsigned char* SB = lds + 98304;
    const int rowbase = ret_rowbase(b, cc);
    const bf16_t* P = (const bf16_t*)(ws + WS_P) + (size_t)rowbase * LDP;
    const bf16_t* STf = (const bf16_t*)(ws + WS_RST) + ((size_t)(bh * 2) * RNCH + cc) * (128 * 128);
    const bf16_t* STb = STf + (size_t)RNCH * 128 * 128;
    __syncthreads();
    stage_tile128(KI, P + PC_RK + h * 128, LDP, tid); stage_tile128(VI, P + PC_RV + h * 128, LDP, tid);
    stage_tile128(SF, STf, 128, tid); stage_tile128(SB, STb, 128, tid);
    bf16x8 qf[4];
    { const bf16_t* qr = P + (size_t)(16 * w + il) * LDP + PC_RQ + h * 128 + 8 * g;
#pragma unroll
      for (int ks = 0; ks < 4; ++ks) qf[ks] = *(const bf16x8*)(qr + 32 * ks); }
    const int iloc = 16 * w + il;
    u32x2 grv[8]; f32x4 nvv[8];
    { const bf16_t* gp0 = (const bf16_t*)(ws + WS_P) + ((size_t)rowbase + iloc) * LDP + PC_RG + h * 128 + 4 * g; const float* nw0 = a.in[I_RNW] + l * 512 + h * 128 + 4 * g;
#pragma unroll
      for (int E = 0; E < 8; ++E) { grv[E] = *(const u32x2*)(gp0 + 16 * E); nvv[E] = *(const f32x4*)(nw0 + 16 * E); } }
    __syncthreads();
    const float l2g = ret_log2g(h);
    f32x4 o[8];
    { const float sf = exp2f(l2g * (float)(iloc + 1)), sb = exp2f(l2g * (float)(RCH - iloc));
#pragma unroll
      for (int E = 0; E < 8; ++E) { f32x4 rf = {0.f, 0.f, 0.f, 0.f}, rb = {0.f, 0.f, 0.f, 0.f};
#pragma unroll
          for (int ks = 0; ks < 4; ++ks) { rf = MFMA16(img_row_frag(SF, lane, E, ks), qf[ks], rf); rb = MFMA16(img_row_frag(SB, lane, E, ks), qf[ks], rb); }
          o[E] = rf * sf + rb * sb; } }
    f32x4 at[8];
#pragma unroll
    for (int T = 0; T < 8; ++T) { f32x4 c = {0.f, 0.f, 0.f, 0.f};
#pragma unroll
        for (int ks = 0; ks < 4; ++ks) c = MFMA16(img_row_frag(KI, lane, T, ks), qf[ks], c);
#pragma unroll
        for (int r = 0; r < 4; ++r) { const int j = 16 * T + 4 * g + r; const int dd = iloc > j ? iloc - j : j - iloc; c[r] *= (dd == 0 ? 2.0f : exp2f(l2g * (float)dd)); }
        at[T] = c; }
#pragma unroll
    for (int s = 0; s < 4; ++s) { const bf16x8 bfr = acc_pair_frag(at[2 * s], at[2 * s + 1]);
#pragma unroll
        for (int E = 0; E < 8; ++E) o[E] = MFMA16(img_tr_frag_acc(VI, lane, E, s), bfr, o[E]); }
    float ss = 0.f;
#pragma unroll
    for (int E = 0; E < 8; ++E) ss += (o[E].x * o[E].x + o[E].y * o[E].y) + (o[E].z * o[E].z + o[E].w * o[E].w);
    ss += __shfl_xor(ss, 16); ss += __shfl_xor(ss, 32);
    const float rn = rsqrtf(ss * (1.0f / 128.0f) + EPS);
    const size_t row = (size_t)rowbase + iloc;
    const bf16_t* gp = (const bf16_t*)(ws + WS_P) + row * LDP + PC_RG + h * 128 + 4 * g;
    const float* nw = a.in[I_RNW] + l * 512 + h * 128 + 4 * g;
    bf16_t* op = (bf16_t*)(ws + WS_H) + row * D + 1024 + h * 128 + 4 * g;
#pragma unroll
    for (int E = 0; E < 8; ++E) { const u32x2 gr = grv[E]; const f32x4 nv = nvv[E];
        u32x2 ov; ov.x = pk2(o[E].x * rn * nv.x * siluf_(bflo(gr.x)), o[E].y * rn * nv.y * siluf_(bfhi(gr.x)));
        ov.y = pk2(o[E].z * rn * nv.z * siluf_(bflo(gr.y)), o[E].w * rn * nv.w * siluf_(bfhi(gr.y)));
        *(u32x2*)(op + 16 * E) = ov; }
}
constexpr int GCH = 64, GNCH = 68;
constexpr size_t WS_GST = WS_OB + (size_t)2 * OBSZ * 2;
constexpr size_t WS_GDEC = WS_END;
constexpr size_t WS_H3B = WS_GDEC + (size_t)16 * 2 * GNCH * 64 * 4;
constexpr size_t WS_ROPE = WS_H3B + (size_t)2 * 4096 * 64 * 2;
constexpr size_t WS_TWID = WS_ROPE + (size_t)(SEQL + LC) * 64 * 8;
constexpr size_t WS_END2 = WS_TWID + 4096 * 8;
__device__ __forceinline__ int gla_rowbase(int b, int cg) { return cg < 4 ? NLAT + b * LC + cg * GCH : b * SEQL + (cg - 4) * GCH; }

constexpr int GLS = 68;
__device__ __forceinline__ void gla_gates_compute(const DArgs& a, unsigned char* ws, LAS float* BF, LAS float* BB, LAS float* GW  , int l, int h, int rowbase, int tid) {
    const int t = tid >> 3, d8 = tid & 7;
    const float* lr = (const float*)(ws + WS_LR) + (size_t)(rowbase + t) * 32;
    f32x4 lv[8];
#pragma unroll
    for (int q = 0; q < 8; ++q) lv[q] = ((const f32x4*)lr)[q];
    { const int dir = tid >> 8, r = (tid >> 4) & 15, c4 = (tid & 15) * 4;
      *(LAS f32x4*)(GW + (dir * 17 + r) * 64 + c4) = *(const f32x4*)(a.in[I_GGW] + (size_t)(l * 2 + dir) * 16 * 256 + r * 256 + h * 64 + c4);
      if (tid < 32) { const int dd = tid >> 4; *(LAS f32x4*)(GW + (dd * 17 + 16) * 64 + c4) = *(const f32x4*)(a.in[I_GGB] + (size_t)(l * 2 + dd) * 256 + h * 64 + c4); } }
    __syncthreads();
    bf16_t* GLG = (bf16_t*)(ws + WS_WIN);
#pragma unroll
    for (int dir = 0; dir < 2; ++dir) {
        const LAS float* gw = GW + dir * 17 * 64 + 8 * d8;
        f32x4 s0 = *(const LAS f32x4*)(gw + 16 * 64), s1 = *(const LAS f32x4*)(gw + 16 * 64 + 4);
#pragma unroll
        for (int j = 0; j < 16; ++j) { const float lj = lv[dir * 4 + (j >> 2)][j & 3]; s0 += lj * *(const LAS f32x4*)(gw + j * 64); s1 += lj * *(const LAS f32x4*)(gw + j * 64 + 4); }
        LAS float* dst = (dir ? BB : BF) + t * GLS + 8 * d8;
        float la[8];
#pragma unroll
        for (int x = 0; x < 8; ++x) { const float s = x < 4 ? s0[x] : s1[x - 4]; const float e = __expf(-fabsf(s)); const float ls = fminf(s, 0.f) - __logf(1.0f + e); la[x] = ls * (1.0f / 16.0f); }
        const u32x4 pk = pack8(la);
        *(u32x4*)(GLG + ((size_t)dir * MR + rowbase + t) * 256 + h * 64 + 8 * d8) = pk;
        float lq[8]; unpack8(pk, lq);
        *(LAS f32x4*)dst = (f32x4){lq[0], lq[1], lq[2], lq[3]}; *(LAS f32x4*)(dst + 4) = (f32x4){lq[4], lq[5], lq[6], lq[7]};
    }
}
__device__ __forceinline__ void gla_gates_load(unsigned char* ws, LAS float* BF, LAS float* BB, int h, int rowbase, int tid) {
    const int t = tid >> 3, d8 = tid & 7;
    const bf16_t* GLG = (const bf16_t*)(ws + WS_WIN);
#pragma unroll
    for (int dir = 0; dir < 2; ++dir) { float lq[8]; unpack8(*(const u32x4*)(GLG + ((size_t)dir * MR + rowbase + t) * 256 + h * 64 + 8 * d8), lq);
        LAS float* dst = (dir ? BB : BF) + t * GLS + 8 * d8;
        *(LAS f32x4*)dst = (f32x4){lq[0], lq[1], lq[2], lq[3]}; *(LAS f32x4*)(dst + 4) = (f32x4){lq[4], lq[5], lq[6], lq[7]}; }
}
__device__ __forceinline__ void gla_scan(LAS float* BF, LAS float* BB, int tid) {
    const int lane = tid & 63, w = tid >> 6;
    __syncthreads();
#pragma unroll 4
    for (int c = 0; c < 16; ++c) { const int col = 16 * w + c; const int dir = col >> 6, d = col & 63;
        LAS float* p = (dir ? BB : BF) + (dir ? 63 - lane : lane) * GLS + d;
        float v = *p;
#pragma unroll
        for (int off = 1; off < 64; off <<= 1) { const float u = __shfl_up(v, off); if (lane >= off) v += u; }
        *p = v; }
    __syncthreads();
}

__device__ __forceinline__ void gla_passA(const DArgs& a, unsigned char* ws, LAS unsigned char* lds, int l, int item, int tid) {
    const int bh = item / GNCH, cg = item % GNCH, b = bh >> 2, h = bh & 3;
    const int lane = tid & 63, w = tid >> 6, g = lane >> 4;
    LAS float* BF = (LAS float*)lds; LAS float* BB = (LAS float*)(lds + 17408); LAS unsigned char* KH = lds + 34816; LAS unsigned char* VI = lds + 34816 + 16384;
    const int rowbase = gla_rowbase(b, cg);
    const bf16_t* P = (const bf16_t*)(ws + WS_P) + (size_t)rowbase * LDP;
    const int t = tid >> 3, d8 = tid & 7;
    const u32x4 kraw = *(const u32x4*)(P + (size_t)t * LDP + PC_GK + h * 64 + 8 * d8);
    u32x4 vraw[2];
#pragma unroll
    for (int i = 0; i < 2; ++i) { const int n = tid + NT * i; vraw[i] = *(const u32x4*)(P + (size_t)(n >> 4) * LDP + PC_GV + h * 128 + (n & 15) * 8); }
    gla_gates_compute(a, ws, BF, BB, (LAS float*)(lds + 34816 + 32768), l, h, rowbase, tid);
    gla_scan(BF, BB, tid);
    { float kf[8], x0[8], x1[8]; unpack8(kraw, kf);
#pragma unroll
      for (int x = 0; x < 8; ++x) { const int d = 8 * d8 + x; x0[x] = kf[x] * __expf(BF[63 * GLS + d] - BF[t * GLS + d]); x1[x] = kf[x] * __expf(BB[d] - BB[t * GLS + d]); }
      *(LAS u32x4*)(KH + off_b(t, d8)) = pack8(x0); *(LAS u32x4*)(KH + off_b(t, 8 + d8)) = pack8(x1);
#pragma unroll
      for (int i = 0; i < 2; ++i) { const int n = tid + NT * i; *(LAS u32x4*)(VI + off_b(n >> 4, n & 15)) = vraw[i]; }
      if (tid < 128) { const int dir = tid >> 6, d = tid & 63; ((float*)(ws + WS_GDEC))[((size_t)(bh * 2 + dir) * GNCH + cg) * 64 + d] = __expf(dir ? BB[d] : BF[63 * GLS + d]); } }
    __syncthreads();
    const int dir = w >> 2, Dt = w & 3;
    bf16x8 af[2];
#pragma unroll
    for (int ks = 0; ks < 2; ++ks) af[ks] = img_tr_frag(KH, lane, dir * 4 + Dt, ks);
    bf16_t* ST = (bf16_t*)(ws + WS_GST) + ((size_t)(bh * 2 + dir) * GNCH + cg) * (128 * 64);
#pragma unroll 2
    for (int E = 0; E < 8; ++E) {
        f32x4 c = {0.f, 0.f, 0.f, 0.f};
#pragma unroll
        for (int ks = 0; ks < 2; ++ks) c = MFMA16(af[ks], img_tr_frag(VI, lane, E, ks), c);
        u32x2 o; o.x = pk2(c.x, c.y); o.y = pk2(c.z, c.w);
        *(u32x2*)(ST + (size_t)(16 * E + (lane & 15)) * 64 + 16 * Dt + 4 * g) = o;
    }
}
__device__ __forceinline__ void gla_passB(unsigned char* ws, LAS unsigned char* lds, int blk, int tid) {
    const int bd = blk >> 1, dir = bd & 1, el = (blk & 1) * 512 + tid;
    LAS float* decs = (LAS float*)lds;
    { const float* dsrc = (const float*)(ws + WS_GDEC) + (size_t)bd * GNCH * 64;
      for (int i = tid; i < GNCH * 64; i += NT) decs[i] = dsrc[i]; }
    __syncthreads();
    bf16_t* base = (bf16_t*)(ws + WS_GST) + (size_t)bd * GNCH * (128 * 64) + (size_t)el * 8;
    const int d0 = (el & 7) * 8;
    float acc[8];
#pragma unroll
    for (int x = 0; x < 8; ++x) acc[x] = 0.f;
#pragma unroll 1
    for (int s0 = 0; s0 < GNCH; s0 += 17) {
        u32x4 kvr[17];
#pragma unroll
        for (int j = 0; j < 17; ++j) { const int s = s0 + j; const int cg = dir == 0 ? s : (s < 4 ? 3 - s : 71 - s); kvr[j] = *(const u32x4*)(base + (size_t)cg * (128 * 64)); }
#pragma unroll
        for (int j = 0; j < 17; ++j) { const int s = s0 + j; const int cg = dir == 0 ? s : (s < 4 ? 3 - s : 71 - s);
            float kv[8]; unpack8(kvr[j], kv);
            const f32x4 q0 = *(const LAS f32x4*)(decs + cg * 64 + d0), q1 = *(const LAS f32x4*)(decs + cg * 64 + d0 + 4);
            *(u32x4*)(base + (size_t)cg * (128 * 64)) = pack8(acc);
#pragma unroll
            for (int x = 0; x < 8; ++x) acc[x] = (x < 4 ? q0[x] : q1[x - 4]) * acc[x] + kv[x]; }
    }
    __syncthreads();
}
__device__ __forceinline__ void gla_passC(const DArgs& a, unsigned char* ws, LAS unsigned char* lds, int l, int item, int tid) {
    const int bh = item / GNCH, cg = item % GNCH, b = bh >> 2, h = bh & 3;
    const int lane = tid & 63, w = tid >> 6, g = lane >> 4, il = lane & 15;
    LAS float* BF = (LAS float*)lds; LAS float* BB = (LAS float*)(lds + 17408);
    LAS unsigned char* QKF = lds + 34816; LAS unsigned char* QKB = QKF + 16384; LAS unsigned char* QH = QKB + 16384; LAS unsigned char* VI = QH + 16384; LAS unsigned char* SI = VI + 16384;
    const int rowbase = gla_rowbase(b, cg);
    const bf16_t* P = (const bf16_t*)(ws + WS_P) + (size_t)rowbase * LDP;
    const int t = tid >> 3, d8 = tid & 7;
    const u32x4 qraw = *(const u32x4*)(P + (size_t)t * LDP + PC_GQ + h * 64 + 8 * d8), kraw = *(const u32x4*)(P + (size_t)t * LDP + PC_GK + h * 64 + 8 * d8);
    u32x4 vraw[2], sraw[4];
#pragma unroll
    for (int i = 0; i < 2; ++i) { const int n = tid + NT * i; vraw[i] = *(const u32x4*)(P + (size_t)(n >> 4) * LDP + PC_GV + h * 128 + (n & 15) * 8); }
    { const bf16_t* STf = (const bf16_t*)(ws + WS_GST) + ((size_t)(bh * 2) * GNCH + cg) * (128 * 64); const bf16_t* STb = STf + (size_t)GNCH * 128 * 64;
#pragma unroll
      for (int i = 0; i < 4; ++i) { const int n = tid + NT * i, row = n >> 4, ch = n & 15; sraw[i] = *(const u32x4*)((ch < 8 ? STf : STb) + (size_t)row * 64 + (ch & 7) * 8); } }
    gla_gates_load(ws, BF, BB, h, rowbase, tid);
    gla_scan(BF, BB, tid);
    { float qf[8], kf[8], o0[8], o1[8], o2[8], o3[8], o4[8], o5[8];
      unpack8(qraw, qf); unpack8(kraw, kf);
#pragma unroll
      for (int x = 0; x < 8; ++x) { const int d = 8 * d8 + x; const float bf = BF[t * GLS + d], bb = BB[t * GLS + d], rf = BF[31 * GLS + d], rb = BB[32 * GLS + d]; const float q = qf[x] * 0.125f;
          o0[x] = q * __expf(bf - rf); o1[x] = kf[x] * __expf(rf - bf); o2[x] = q * __expf(bb - rb); o3[x] = kf[x] * __expf(rb - bb); o4[x] = q * __expf(bf); o5[x] = q * __expf(bb); }
      *(LAS u32x4*)(QKF + off_b(t, d8)) = pack8(o0); *(LAS u32x4*)(QKF + off_b(t, 8 + d8)) = pack8(o1);
      *(LAS u32x4*)(QKB + off_b(t, d8)) = pack8(o2); *(LAS u32x4*)(QKB + off_b(t, 8 + d8)) = pack8(o3);
      *(LAS u32x4*)(QH + off_b(t, d8)) = pack8(o4); *(LAS u32x4*)(QH + off_b(t, 8 + d8)) = pack8(o5);
#pragma unroll
      for (int i = 0; i < 2; ++i) { const int n = tid + NT * i; *(LAS u32x4*)(VI + off_b(n >> 4, n & 15)) = vraw[i]; }
#pragma unroll
      for (int i = 0; i < 4; ++i) { const int n = tid + NT * i; *(LAS u32x4*)(SI + off_b(n >> 4, n & 15)) = sraw[i]; } }
    const int ib = w & 3, eh = w >> 2, iloc = 16 * ib + il;
    u32x2 grv[4]; f32x4 nvv[4];
    { const bf16_t* gp0 = (const bf16_t*)(ws + WS_P) + ((size_t)rowbase + iloc) * LDP + PC_GG + h * 128 + 64 * eh + 4 * g; const float* nw0 = a.in[I_GNW] + l * 512 + h * 128 + 64 * eh + 4 * g;
#pragma unroll
      for (int E4 = 0; E4 < 4; ++E4) { grv[E4] = *(const u32x2*)(gp0 + 16 * E4); nvv[E4] = *(const f32x4*)(nw0 + 16 * E4); } }
    __syncthreads();
    f32x4 at[4];
    { bf16x8 qff[2], qfb[2];
#pragma unroll
      for (int ks = 0; ks < 2; ++ks) { qff[ks] = img_row_frag(QKF, lane, ib, ks); qfb[ks] = img_row_frag(QKB, lane, ib, ks); }
#pragma unroll
      for (int T = 0; T < 4; ++T) { f32x4 cf = {0.f, 0.f, 0.f, 0.f}, cb = {0.f, 0.f, 0.f, 0.f};
#pragma unroll
          for (int ks = 0; ks < 2; ++ks) { cf = MFMA16(img_row_frag(QKF, lane, T, 2 + ks), qff[ks], cf); cb = MFMA16(img_row_frag(QKB, lane, T, 2 + ks), qfb[ks], cb); }
#pragma unroll
          for (int r = 0; r < 4; ++r) { const int j = 16 * T + 4 * g + r; cf[r] = (j <= iloc ? cf[r] : 0.f) + (j >= iloc ? cb[r] : 0.f); }
          at[T] = cf; } }
    f32x4 o[4];
    { bf16x8 hf[2], hb[2];
#pragma unroll
      for (int ks = 0; ks < 2; ++ks) { hf[ks] = img_row_frag(QH, lane, ib, ks); hb[ks] = img_row_frag(QH, lane, ib, 2 + ks); }
#pragma unroll
      for (int E4 = 0; E4 < 4; ++E4) { const int E = 4 * eh + E4; f32x4 c = {0.f, 0.f, 0.f, 0.f};
#pragma unroll
          for (int ks = 0; ks < 2; ++ks) { c = MFMA16(img_row_frag(SI, lane, E, ks), hf[ks], c); c = MFMA16(img_row_frag(SI, lane, E, 2 + ks), hb[ks], c); }
          o[E4] = c; } }
#pragma unroll
    for (int s = 0; s < 2; ++s) { const bf16x8 bfr = acc_pair_frag(at[2 * s], at[2 * s + 1]);
#pragma unroll
        for (int E4 = 0; E4 < 4; ++E4) o[E4] = MFMA16(img_tr_frag_acc(VI, lane, 4 * eh + E4, s), bfr, o[E4]); }
    float ss = 0.f;
#pragma unroll
    for (int E4 = 0; E4 < 4; ++E4) ss += (o[E4].x * o[E4].x + o[E4].y * o[E4].y) + (o[E4].z * o[E4].z + o[E4].w * o[E4].w);
    ss += __shfl_xor(ss, 16); ss += __shfl_xor(ss, 32);
    LAS float* red = (LAS float*)lds;
    if (g == 0) red[eh * 64 + iloc] = ss;
    __syncthreads();
    const float rn = rsqrtf((red[iloc] + red[64 + iloc]) * (1.0f / 128.0f) + EPS);
    const size_t row = (size_t)rowbase + iloc;
    const bf16_t* gp = (const bf16_t*)(ws + WS_P) + row * LDP + PC_GG + h * 128 + 64 * eh + 4 * g;
    const float* nw = a.in[I_GNW] + l * 512 + h * 128 + 64 * eh + 4 * g;
    bf16_t* op = (bf16_t*)(ws + WS_H) + row * D + 1536 + h * 128 + 64 * eh + 4 * g;
#pragma unroll
    for (int E4 = 0; E4 < 4; ++E4) { const u32x2 gr = grv[E4]; const f32x4 nv = nvv[E4];
        u32x2 ov; ov.x = pk2(o[E4].x * rn * nv.x * siluf_(bflo(gr.x)), o[E4].y * rn * nv.y * siluf_(bfhi(gr.x)));
        ov.y = pk2(o[E4].z * rn * nv.z * siluf_(bflo(gr.y)), o[E4].w * rn * nv.w * siluf_(bfhi(gr.y)));
        *(u32x2*)(op + 16 * E4) = ov; }
}
constexpr int SNCH = 68;
constexpr size_t WS_S5ST = WS_OB + (size_t)4 * OBSZ * 2;
constexpr size_t WS_S5BTB = WS_S5BT;
constexpr size_t WS_S5CPB = WS_S5BT + 524288;
constexpr size_t WS_S5A64 = WS_S5BT + 1048576;

__device__ __forceinline__ void prep_s5b(const DArgs& a, unsigned char* ws, int it, int tid) {
    const int idx = it * 512 + tid;
    const int gi = idx >> 6, p = idx & 63;
    const float a_re = a.in[I_S5ARE][idx], a_im = a.in[I_S5AIM][idx], ldt = a.in[I_S5LDT][gi];
    const float dt = expf(ldt), mag = expf(a_re * dt);
    float sn, cs; sincosf(a_im * dt, &sn, &cs);
    const float ab_re = mag * cs, ab_im = mag * sn, den = a_re * a_re + a_im * a_im, nr = ab_re - 1.0f;
    const float co_re = (nr * a_re + ab_im * a_im) / den, co_im = (ab_im * a_re - nr * a_im) / den;
    ((f32x2*)(ws + WS_S5AB))[idx] = (f32x2){ab_re, ab_im};
    float pr = ab_re, pi = ab_im;
#pragma unroll
    for (int q = 0; q < 6; ++q) { const float nr2 = pr * pr - pi * pi, ni2 = 2.0f * pr * pi; pr = nr2; pi = ni2; }
    ((f32x2*)(ws + WS_S5A64))[idx] = (f32x2){pr, pi};
    const float* bre = a.in[I_S5BRE] + (size_t)idx * 16; const float* bim = a.in[I_S5BIM] + (size_t)idx * 16;
    float tr[16], ti[16];
#pragma unroll
    for (int i = 0; i < 16; ++i) { const float br = bre[i], bi = bim[i]; tr[i] = co_re * br - co_im * bi; ti[i] = co_re * bi + co_im * br; }
    bf16_t* btb = (bf16_t*)(ws + WS_S5BTB) + (size_t)gi * 128 * 16;
#pragma unroll
    for (int hlf = 0; hlf < 2; ++hlf) { u32x4 w0, w1; const float* s = hlf ? ti : tr;
        w0.x = pk2(s[0], s[1]); w0.y = pk2(s[2], s[3]); w0.z = pk2(s[4], s[5]); w0.w = pk2(s[6], s[7]); w1.x = pk2(s[8], s[9]); w1.y = pk2(s[10], s[11]); w1.z = pk2(s[12], s[13]); w1.w = pk2(s[14], s[15]);
        *(u32x4*)(btb + (size_t)(64 * hlf + p) * 16) = w0; *(u32x4*)(btb + (size_t)(64 * hlf + p) * 16 + 8) = w1; }
    bf16_t* cpb = (bf16_t*)(ws + WS_S5CPB) + (size_t)gi * 16 * 128;
    const float* cre = a.in[I_S5CRE] + (size_t)gi * 1024; const float* cim = a.in[I_S5CIM] + (size_t)gi * 1024;
#pragma unroll
    for (int i = 0; i < 16; ++i) *(unsigned*)(cpb + i * 128 + 2 * p) = pk2(cre[i * 64 + p], -cim[i * 64 + p]);
}

struct S5Unit { bf16x8 btf[8]; f32x2 ab; f32x2 h; const bf16_t* cp; };
template <bool PASSC> __device__ __forceinline__ void s5_load_unit(S5Unit& U, unsigned char* ws, const bf16_t* P, const f32x2* ST, int l, int b, int cs, int rowbase, int grp, int dir, int lane) {
    const int g = lane >> 4, il = lane & 15;
    const bf16x8 zero8 = {0, 0, 0, 0, 0, 0, 0, 0};
    const int gi = (l * 2 + dir) * 32 + grp;
    U.ab = ((const f32x2*)(ws + WS_S5AB))[gi * 64 + lane];
    const size_t sidx = ((size_t)(b * SNCH + cs) * 2 + dir) * 2048 + grp * 64 + lane;
    U.h = PASSC ? ST[sidx] : (f32x2){0.f, 0.f};
    const bf16_t* bt = (const bf16_t*)(ws + WS_S5BTB) + (size_t)gi * 128 * 16 + (size_t)il * 16 + 8 * (g & 1);
#pragma unroll
    for (int Pt = 0; Pt < 8; ++Pt) { const bf16x8 v = *(const bf16x8*)(bt + Pt * 256); U.btf[Pt] = g < 2 ? v : zero8; }
    U.cp = (const bf16_t*)(ws + WS_S5CPB) + (size_t)gi * 16 * 128 + (size_t)il * 128 + 8 * g;
}
__device__ __forceinline__ void s5_load_u(bf16x8 (&ufa)[4], const bf16_t* P, int rowbase, int grp, int lane) {
    const int g = lane >> 4, il = lane & 15; const bf16x8 zero8 = {0, 0, 0, 0, 0, 0, 0, 0};
#pragma unroll
    for (int Tt = 0; Tt < 4; ++Tt) { const bf16x8 v = *(const bf16x8*)(P + (size_t)(rowbase + 16 * Tt + il) * LDP + PC_S5U + grp * 16 + 8 * (g & 1)); ufa[Tt] = g < 2 ? v : zero8; }
}
template <bool PASSC, int DIR> __device__ __forceinline__ void s5_run_unit(const S5Unit& U, const bf16x8 (&ufa)[4], f32x4 (&yacc)[4], f32x2& hout, LAS float* BU, LAS unsigned char* HW, int lane) {
    const int g = lane >> 4, il = lane & 15;
    f32x2 h = U.h; const f32x2 ab = U.ab;
    bf16x8 cpf[4];
    if (PASSC) {
#pragma unroll
        for (int ks = 0; ks < 4; ++ks) cpf[ks] = *(const bf16x8*)(U.cp + 32 * ks); }
    f32x4 d[8];
#pragma unroll
    for (int Pt = 0; Pt < 8; ++Pt) d[Pt] = MFMA16(U.btf[Pt], ufa[DIR ? 3 : 0], ((f32x4){0.f, 0.f, 0.f, 0.f}));
#pragma unroll
    for (int wi = 0; wi < 4; ++wi) {
        const int Tt = DIR ? 3 - wi : wi;
#pragma unroll
        for (int Pt = 0; Pt < 8; ++Pt) {
#pragma unroll
            for (int r = 0; r < 4; ++r) BU[(16 * Pt + 4 * g + r) * 20 + il] = d[Pt][r]; }
        asm volatile("" ::: "memory");
        if (!PASSC) {
            f32x4 br[4], bi[4];
#pragma unroll
            for (int q = 0; q < 4; ++q) { br[q] = *(const LAS f32x4*)(BU + lane * 20 + 4 * q); bi[q] = *(const LAS f32x4*)(BU + (64 + lane) * 20 + 4 * q); }
            if (wi < 3) {
#pragma unroll
                for (int Pt = 0; Pt < 8; ++Pt) d[Pt] = MFMA16(U.btf[Pt], ufa[DIR ? 2 - wi : wi + 1], ((f32x4){0.f, 0.f, 0.f, 0.f})); }
#pragma unroll
            for (int s = 0; s < 16; ++s) { const int tt = DIR ? 15 - s : s;
                const float hr = __builtin_fmaf(ab.x, h.x, __builtin_fmaf(-ab.y, h.y, br[tt >> 2][tt & 3])), hi = __builtin_fmaf(ab.x, h.y, __builtin_fmaf(ab.y, h.x, bi[tt >> 2][tt & 3]));
                h = (f32x2){hr, hi}; }
        } else {
#pragma unroll
            for (int hf2 = 0; hf2 < 2; ++hf2) { const int q0 = DIR ? 2 - 2 * hf2 : 2 * hf2;
                f32x4 br[2], bi[2];
#pragma unroll
                for (int q = 0; q < 2; ++q) { br[q] = *(const LAS f32x4*)(BU + lane * 20 + 4 * (q0 + q)); bi[q] = *(const LAS f32x4*)(BU + (64 + lane) * 20 + 4 * (q0 + q)); }
#pragma unroll
                for (int s = 0; s < 8; ++s) { const int t8 = DIR ? 7 - s : s; const int tt = 4 * q0 + t8;
                    const float hr = __builtin_fmaf(ab.x, h.x, __builtin_fmaf(-ab.y, h.y, br[t8 >> 2][t8 & 3])), hi = __builtin_fmaf(ab.x, h.y, __builtin_fmaf(ab.y, h.x, bi[t8 >> 2][t8 & 3]));
                    h = (f32x2){hr, hi};
                    *(LAS unsigned*)(HW + off_b(tt, lane >> 2) + (lane & 3) * 4) = pk2(hr, hi); }
            }
        }
        asm volatile("" ::: "memory");
        if (PASSC) {
            bf16x8 hf[4];
#pragma unroll
            for (int ks = 0; ks < 4; ++ks) hf[ks] = img_row_frag(HW, lane, 0, ks);
#pragma unroll
            for (int ks = 0; ks < 4; ++ks) yacc[Tt] = MFMA16(cpf[ks], hf[ks], yacc[Tt]);
            }
        asm volatile("" ::: "memory");
        if (PASSC && wi < 3) {
#pragma unroll
            for (int Pt = 0; Pt < 8; ++Pt) d[Pt] = MFMA16(U.btf[Pt], ufa[DIR ? 2 - wi : wi + 1], ((f32x4){0.f, 0.f, 0.f, 0.f})); }
    }
    hout = h;
}
template <bool PASSC> __device__ __forceinline__ void s5_item(const DArgs& a, unsigned char* ws, LAS unsigned char* lds, int l, int item, int ggsel, int tid) {
    const int b = item / (SNCH * 2), rem = item % (SNCH * 2), cs = rem >> 1, half = rem & 1;
    const int lane = tid & 63, w = tid >> 6, g = lane >> 4, il = lane & 15;
    const int rowbase = gla_rowbase(b, cs);
    LAS float* BU = (LAS float*)(lds + w * 14336); LAS unsigned char* HW = lds + w * 14336 + 10240;
    const bf16_t* P = (const bf16_t*)(ws + WS_P);
    f32x2* ST = (f32x2*)(ws + WS_S5ST);
    const int grp0 = 16 * half + w, grp1 = grp0 + 8;
    S5Unit UA; bf16x8 ufa[4];
    { const int gg = ggsel;
        const int grp = gg ? grp1 : grp0;
        f32x4 yacc[4];
#pragma unroll
        for (int q = 0; q < 4; ++q) yacc[q] = (f32x4){0.f, 0.f, 0.f, 0.f};
        f32x2 hend;
        u32x2 urv[4], sgv[4]; f32x4 dskv = {0.f, 0.f, 0.f, 0.f};
        if (PASSC) { dskv = *(const f32x4*)(a.in[I_S5D] + l * 512 + grp * 16 + 4 * g);
#pragma unroll
            for (int Tt = 0; Tt < 4; ++Tt) { const size_t row = (size_t)rowbase + 16 * Tt + il; urv[Tt] = *(const u32x2*)(P + row * LDP + PC_S5U + grp * 16 + 4 * g); sgv[Tt] = *(const u32x2*)(P + row * LDP + PC_S5G + grp * 16 + 4 * g); } }
        s5_load_unit<PASSC>(UA, ws, P, ST, l, b, cs, rowbase, grp, 0, lane); s5_load_u(ufa, P, rowbase, grp, lane);
        s5_run_unit<PASSC, 0>(UA, ufa, yacc, hend, BU, HW, lane);
        if (!PASSC) ST[((size_t)(b * SNCH + cs) * 2 + 0) * 2048 + grp * 64 + lane] = hend;
        s5_load_unit<PASSC>(UA, ws, P, ST, l, b, cs, rowbase, grp, 1, lane);
        s5_run_unit<PASSC, 1>(UA, ufa, yacc, hend, BU, HW, lane);
        if (!PASSC) ST[((size_t)(b * SNCH + cs) * 2 + 1) * 2048 + grp * 64 + lane] = hend;
        if (PASSC) {
            const f32x4 dsk = dskv;
            bf16_t* G5 = (bf16_t*)(ws + WS_KF);
#pragma unroll
            for (int Tt = 0; Tt < 4; ++Tt) { const size_t row = (size_t)rowbase + 16 * Tt + il;
                const u32x2 ur = urv[Tt], sg = sgv[Tt];
                const float g0 = gelu_tanh(yacc[Tt].x + bflo(ur.x) * dsk.x), g1 = gelu_tanh(yacc[Tt].y + bfhi(ur.x) * dsk.y), g2 = gelu_tanh(yacc[Tt].z + bflo(ur.y) * dsk.z), g3 = gelu_tanh(yacc[Tt].w + bfhi(ur.y) * dsk.w);
                u32x2 ov; ov.x = pk2(g0, g1); ov.y = pk2(g2, g3);
                *(u32x2*)(G5 + row * 512 + grp * 16 + 4 * g) = ov;
                ov.x = pk2(g0 * siluf_(bflo(sg.x)), g1 * siluf_(bfhi(sg.x))); ov.y = pk2(g2 * siluf_(bflo(sg.y)), g3 * siluf_(bfhi(sg.y)));
                *(u32x2*)(G5 + OBSZ + row * 512 + grp * 16 + 4 * g) = ov; }
        }
    }
}
__device__ __forceinline__ void s5_passB(unsigned char* ws, int l, int gt) {
    const int p = gt & 63, grp = (gt >> 6) & 31, dir = (gt >> 11) & 1, b = gt >> 12;
    const f32x2 a64 = ((const f32x2*)(ws + WS_S5A64))[((l * 2 + dir) * 32 + grp) * 64 + p];
    f32x2* ST = (f32x2*)(ws + WS_S5ST);
    f32x2 acc = {0.f, 0.f};
#pragma unroll 1
    for (int s0 = 0; s0 < SNCH; s0 += 34) {
        f32x2 ev[34];
#pragma unroll
        for (int j = 0; j < 34; ++j) { const int s = s0 + j; const int cs = dir == 0 ? s : (s < 4 ? 3 - s : 71 - s); ev[j] = ST[((size_t)(b * SNCH + cs) * 2 + dir) * 2048 + grp * 64 + p]; }
#pragma unroll
        for (int j = 0; j < 34; ++j) { const int s = s0 + j; const int cs = dir == 0 ? s : (s < 4 ? 3 - s : 71 - s);
            ST[((size_t)(b * SNCH + cs) * 2 + dir) * 2048 + grp * 64 + p] = acc;
            acc = (f32x2){a64.x * acc.x - a64.y * acc.y + ev[j].x, a64.x * acc.y + a64.y * acc.x + ev[j].y}; }
    }
}
constexpr int FFT_PHYS = 8448;
__device__ __forceinline__ void fft_twiddles_g(LAS f32x2* W, const f32x2* Wg, int tid) {
#pragma unroll
    for (int j = 0; j < 8; ++j) W[tid + NT * j] = Wg[tid + NT * j];
}
__device__ __forceinline__ int fphys(int i) { return i + (i >> 5); }
__device__ __forceinline__ f32x2 cmulf(const f32x2 a, const f32x2 b) { return (f32x2){a.x * b.x - a.y * b.y, a.x * b.y + a.y * b.x}; }
__device__ __forceinline__ f32x2 cmulcf(const f32x2 a, const f32x2 b) { return (f32x2){a.x * b.x + a.y * b.y, a.y * b.x - a.x * b.y}; }
template <int RL> __device__ __forceinline__ void dft_fwd_const(f32x2 (&e)[1 << RL]) {
#pragma unroll
    for (int s = 0; s < RL; ++s) { const int h = 1 << (RL - 1 - s);
#pragma unroll
        for (int m = 0; m < (1 << RL); ++m) { if (m & h) continue;
            const int mp = m & (h - 1); const f32x2 a_ = e[m], b_ = e[m | h]; const f32x2 d = a_ - b_; e[m] = a_ + b_;
            if (mp == 0) e[m | h] = d;
            else if (2 * mp == h) e[m | h] = (f32x2){d.y, -d.x};
            else { const float ang = -3.14159265358979323846f * (float)mp / (float)h; const f32x2 c = {__builtin_cosf(ang), __builtin_sinf(ang)}; e[m | h] = cmulf(d, c); } } }
}
template <int RL> __device__ __forceinline__ void dft_inv_const(f32x2 (&e)[1 << RL]) {
#pragma unroll
    for (int ss = 0; ss < RL; ++ss) { const int s = RL - 1 - ss; const int h = 1 << (RL - 1 - s);
#pragma unroll
        for (int m = 0; m < (1 << RL); ++m) { if (m & h) continue;
            const int mp = m & (h - 1); const f32x2 a_ = e[m], b_ = e[m | h]; f32x2 t;
            if (mp == 0) t = b_;
            else if (2 * mp == h) t = (f32x2){-b_.y, b_.x};
            else { const float ang = -3.14159265358979323846f * (float)mp / (float)h; const f32x2 c = {__builtin_cosf(ang), __builtin_sinf(ang)}; t = cmulcf(b_, c); }
            e[m] = a_ + t; e[m | h] = a_ - t; } }
}
template <int RL> __device__ __forceinline__ constexpr int brev_c(int m) { int r = 0; for (int i = 0; i < RL; ++i) r |= ((m >> i) & 1) << (RL - 1 - i); return r; }
template <int RL, bool CONJ> __device__ __forceinline__ void apply_tw(f32x2 (&e)[1 << RL], const f32x2 w1) {
    f32x2 tw[1 << RL];
    tw[0] = (f32x2){1.f, 0.f}; tw[1] = w1;
    if (RL >= 2) { tw[2] = cmulf(w1, w1); tw[3] = cmulf(tw[2], w1); }
    if (RL >= 3) { tw[4] = cmulf(tw[2], tw[2]); tw[5] = cmulf(tw[4], tw[1]); tw[6] = cmulf(tw[4], tw[2]); tw[7] = cmulf(tw[4], tw[3]); }
    if (RL >= 4) { tw[8] = cmulf(tw[4], tw[4]);
#pragma unroll
        for (int k = 1; k < 8; ++k) tw[8 + k] = cmulf(tw[8], tw[k]); }
#pragma unroll
    for (int m = 1; m < (1 << RL); ++m) e[m] = CONJ ? cmulcf(e[m], tw[brev_c<RL>(m)]) : cmulf(e[m], tw[brev_c<RL>(m)]);
}
template <int RL, int BETA, bool INV, class WP> __device__ __forceinline__ void fft2_pass(LAS f32x2* X, WP W, int tid) {
    constexpr int LOW = BETA - RL + 1, NG = FFTN >> RL, STR = (1 << LOW) + (1 << (LOW - 5));
#pragma unroll 1
    for (int gi = tid; gi < NG; gi += NT) {
        const int base = ((gi >> LOW) << (BETA + 1)) | (gi & ((1 << LOW) - 1));
        volatile LAS f32x2* p = X + fphys(base);
        f32x2 e[1 << RL];
#pragma unroll
        for (int m = 0; m < (1 << RL); ++m) e[m] = p[m * STR];
        const f32x2 w1 = W[(base & ((1 << LOW) - 1)) << (12 - BETA)];
        if (!INV) { dft_fwd_const<RL>(e); apply_tw<RL, false>(e, w1); }
        else { apply_tw<RL, true>(e, w1); dft_inv_const<RL>(e); }
#pragma unroll
        for (int m = 0; m < (1 << RL); ++m) p[m * STR] = e[m];
    }
}
template <class WP> __device__ __forceinline__ void fft2_fwd_ABC(LAS f32x2* X, WP W, int tid) {
    fft2_pass<4, 12, false>(X, W, tid); __syncthreads(); fft2_pass<4, 8, false>(X, W, tid); __syncthreads();
}
template <class WP> __device__ __forceinline__ void fft2_inv_CBA(LAS f32x2* X, WP W, int tid) {
    fft2_pass<4, 8, true>(X, W, tid); __syncthreads(); fft2_pass<4, 12, true>(X, W, tid); __syncthreads();
}
__device__ __forceinline__ void fft2_mid_mul(LAS f32x2* X, const f32x2* KF, int tid) {
    if (tid < 256) {
        volatile LAS f32x2* p = X + 33 * tid;
        f32x2 e[32];
#pragma unroll
        for (int m = 0; m < 32; ++m) e[m] = p[m];
        dft_fwd_const<5>(e);
#pragma unroll
        for (int q4 = 0; q4 < 4; ++q4) { f32x4 kf[4];
#pragma unroll
            for (int q = 0; q < 4; ++q) kf[q] = *(const f32x4*)(KF + 32 * tid + 8 * q4 + 2 * q);
#pragma unroll
            for (int q = 0; q < 4; ++q) { const int m = 8 * q4 + 2 * q; e[m] = cmulf(e[m], (f32x2){kf[q].x, kf[q].y}); e[m + 1] = cmulf(e[m + 1], (f32x2){kf[q].z, kf[q].w}); } }
        dft_inv_const<5>(e);
#pragma unroll
        for (int m = 0; m < 32; ++m) p[m] = e[m];
    }
}
__device__ __forceinline__ void fft2_fwd_D(LAS f32x2* X, int tid) {
    if (tid < 256) { volatile LAS f32x2* p = X + 33 * tid; f32x2 e[32];
#pragma unroll
        for (int m = 0; m < 32; ++m) e[m] = p[m];
        dft_fwd_const<5>(e);
#pragma unroll
        for (int m = 0; m < 32; ++m) p[m] = e[m]; }
}

__device__ __forceinline__ void filt_item2(const DArgs& a, unsigned char* ws, LAS unsigned char* lds, int l, int c0, int tid) {
    LAS f32x2* X = (LAS f32x2*)lds; LAS f32x2* X2 = (LAS f32x2*)(lds + FFT_PHYS * 8); LAS float* red = (LAS float*)(lds + 2 * FFT_PHYS * 8);
    const f32x2* Wg = (const f32x2*)(ws + WS_TWID);
    const int lane = tid & 63, w = tid >> 6, fr = lane & 15, fq = lane >> 4;
    const int cmine = c0 + 256 * (fq & 1);
    bf16x8 af[2];
    { float wv[16];
      const int cc = fr & 3, ca = c0 + 256 * ((fr >> 2) & 1);
      const float* wsrc = a.in[I_HW4] + (size_t)l * 64 * 2048 + (cc >> 1) * 1024 + (cc & 1) * 512 + ca;
#pragma unroll
      for (int q = 0; q < 16; ++q) wv[q] = fr < 8 ? wsrc[(size_t)(32 * (q >> 3) + 8 * fq + (q & 7)) * 2048] : 0.f;
#pragma unroll
      for (int ks = 0; ks < 2; ++ks) { u32x4 pw; pw.x = pk2(wv[8 * ks], wv[8 * ks + 1]); pw.y = pk2(wv[8 * ks + 2], wv[8 * ks + 3]); pw.z = pk2(wv[8 * ks + 4], wv[8 * ks + 5]); pw.w = pk2(wv[8 * ks + 6], wv[8 * ks + 7]); af[ks] = __builtin_bit_cast(bf16x8, pw); } }
    if (tid < 2) { float z0; asm volatile("v_mov_b32 %0, 0" : "=v"(z0)); (tid ? X2 : X)[fphys(4096)] = (f32x2){z0, z0}; }
    const float dl = fabsf(HY_D0 + (HY_D1 - HY_D0) * ((float)cmine / 511.0f)) * (1.0f / 4095.0f);
    const bf16_t* H3 = (const bf16_t*)(ws + WS_H3B) + (size_t)l * 4096 * 64 + (size_t)fr * 64 + 8 * fq;
    LAS f32x2* Xm = (fq & 1) ? X2 : X;
    float ss0 = 0.f, ss1 = 0.f;
#pragma unroll 1
    for (int i0 = 0; i0 < 32; i0 += 4) {
        bf16x8 hb[4][2];
#pragma unroll
        for (int i = 0; i < 4; ++i) { const bf16_t* hp = H3 + (size_t)(16 * (w + 8 * (i0 + i))) * 64; hb[i][0] = *(const bf16x8*)hp; hb[i][1] = *(const bf16x8*)(hp + 32); }
#pragma unroll
        for (int i = 0; i < 4; ++i) {
            f32x4 d = {0.f, 0.f, 0.f, 0.f};
            d = MFMA16(af[0], hb[i][0], d); d = MFMA16(af[1], hb[i][1], d);
            if (fq < 2) { const int t = 16 * (w + 8 * (i0 + i)) + fr;
                const float dec = __expf(-(float)t * dl); const float f0 = d.x * dec, f1 = d.y * dec, b0 = d.z * dec, b1 = d.w * dec;
                Xm[fphys(t)] = (f32x2){f0, f1}; ss0 += f0 * f0; ss1 += f1 * f1;
                if (t > 0) { Xm[fphys(8192 - t)] = (f32x2){b0, b1}; ss0 += b0 * b0; ss1 += b1 * b1; } }
        }
    }
#pragma unroll
    for (int o = 1; o < 16; o <<= 1) { ss0 += __shfl_xor(ss0, o); ss1 += __shfl_xor(ss1, o); }
    if (fr == 0 && fq < 2) { red[w * 4 + fq * 2] = ss0; red[w * 4 + fq * 2 + 1] = ss1; }
    __syncthreads();
    fft2_pass<4, 12, false>(X, Wg, tid); fft2_pass<4, 12, false>(X2, Wg, tid); __syncthreads();
    fft2_pass<4, 8, false>(X, Wg, tid); fft2_pass<4, 8, false>(X2, Wg, tid); __syncthreads();
    fft2_fwd_D(tid < 256 ? X : X2, tid & 255); __syncthreads();
#pragma unroll 1
    for (int ch = 0; ch < 2; ++ch) {
        float s0 = 0.f, s1 = 0.f;
#pragma unroll
        for (int i = 0; i < NWAVES; ++i) { s0 += red[i * 4 + ch * 2]; s1 += red[i * 4 + ch * 2 + 1]; }
        const float rs0 = 0.5f * rsqrtf(s0 + EPS), rs1 = 0.5f * rsqrtf(s1 + EPS);
        const LAS f32x2* Xc = ch ? X2 : X; const int c = c0 + 256 * ch;
        f32x2* KF0 = (f32x2*)(ws + WS_KF) + (size_t)(0 * 512 + c) * FFTN; f32x2* KF1 = (f32x2*)(ws + WS_KF) + (size_t)(1 * 512 + c) * FFTN;
#pragma unroll 4
        for (int j = 0; j < 16; ++j) { const int pos = tid + 512 * j; const int k = (int)(__brev((unsigned)pos) >> 19); const int pp = (int)(__brev((unsigned)((8192 - k) & 8191)) >> 19);
            const f32x2 za = Xc[fphys(pos)], zb = Xc[fphys(pp)];
            KF0[pos] = (f32x2){rs0 * (za.x + zb.x), rs0 * (za.y - zb.y)};
            KF1[pos] = (f32x2){rs1 * (za.y + zb.y), rs1 * (zb.x - za.x)}; }
    }
    __syncthreads();
}

struct Raw8 { u32x4 mid; bf16_t lf, rt; };
__device__ __forceinline__ Raw8 ld_raw8(const bf16_t* p, int t0, int Lx) { Raw8 r; r.mid = *(const u32x4*)(p + t0); r.lf = t0 > 0 ? p[t0 - 1] : (bf16_t)0; r.rt = t0 + 8 < Lx ? p[t0 + 8] : (bf16_t)0; return r; }
__device__ __forceinline__ void sconv8(const Raw8& r, float w0, float w1, float w2, float cb, float (&o)[8]) {
    float x[10]; x[0] = bf2f(r.lf); x[9] = bf2f(r.rt);
    x[1] = bflo(r.mid.x); x[2] = bfhi(r.mid.x); x[3] = bflo(r.mid.y); x[4] = bfhi(r.mid.y); x[5] = bflo(r.mid.z); x[6] = bfhi(r.mid.z); x[7] = bflo(r.mid.w); x[8] = bfhi(r.mid.w);
#pragma unroll
    for (int i = 0; i < 8; ++i) o[i] = w0 * x[i] + w1 * x[i + 1] + w2 * x[i + 2] + cb;
}
__device__ __forceinline__ void hyena_item2(const DArgs& a, unsigned char* ws, LAS unsigned char* lds, int l, int c, int tid, bf16_t* outrows) {
    LAS f32x2* X = (LAS f32x2*)lds; LAS f32x2* X2 = (LAS f32x2*)(lds + FFT_PHYS * 8);
    const f32x2* Wg = (const f32x2*)(ws + WS_TWID);
    const float* cw = a.in[I_HCW] + (size_t)l * 3 * 1536; const float* cbp = a.in[I_HCB] + (size_t)l * 1536;
    const float wv0 = cw[c], wv1 = cw[1536 + c], wv2 = cw[3072 + c], bv = cbp[c];
    const float wa0 = cw[512 + c], wa1 = cw[1536 + 512 + c], wa2 = cw[3072 + 512 + c], ba = cbp[512 + c];
    const float wb0 = cw[1024 + c], wb1 = cw[1536 + 1024 + c], wb2 = cw[3072 + 1024 + c], bb = cbp[1024 + c];
    const float bias0 = a.in[I_HBIAS][(l * 2 + 0) * 512 + c], bias1 = a.in[I_HBIAS][(l * 2 + 1) * 512 + c];
    const bf16_t* PT = (const bf16_t*)(ws + WS_PT);
    const bf16_t* pv = PT + (size_t)(PT_V + c) * MR; const bf16_t* pg1 = PT + (size_t)(PT_G1 + c) * MR; const bf16_t* pg2 = PT + (size_t)(PT_G2 + c) * MR; const bf16_t* phg = PT + (size_t)(PT_HG + c) * MR;
    const f32x2* KF0 = (const f32x2*)(ws + WS_KF) + (size_t)(0 * 512 + c) * FFTN; const f32x2* KF1 = (const f32x2*)(ws + WS_KF) + (size_t)(1 * 512 + c) * FFTN;
    const int t0 = 8 * tid;
    const int po = 8 * tid + (tid >> 2);
    LAS f32x2* px = X + po; LAS f32x2* py = X2 + po;
    float z[4][8];
    { Raw8 v[4];
#pragma unroll
      for (int b = 0; b < 4; ++b) v[b] = ld_raw8(pv + b * SEQL, t0, SEQL);
#pragma unroll
      for (int b = 0; b < 4; ++b) sconv8(v[b], wv0, wv1, wv2, bv, z[b]); }
    Raw8 g1r[4];
#pragma unroll
    for (int b = 0; b < 4; ++b) g1r[b] = ld_raw8(pg1 + b * SEQL, t0, SEQL);
#pragma unroll
    for (int x = 0; x < 8; ++x) { px[x] = (f32x2){z[0][x], z[1][x]}; px[4224 + x] = (f32x2){0.f, 0.f}; py[x] = (f32x2){z[2][x], z[3][x]}; py[4224 + x] = (f32x2){0.f, 0.f}; }
    __syncthreads();
#define HY_CONV(KFp) do { \
        fft2_pass<4, 12, false>(X, Wg, tid); fft2_pass<4, 12, false>(X2, Wg, tid); __syncthreads(); \
        fft2_pass<4, 8, false>(X, Wg, tid); fft2_pass<4, 8, false>(X2, Wg, tid); __syncthreads(); \
        fft2_mid_mul(tid < 256 ? X : X2, KFp, tid & 255); __syncthreads(); \
        fft2_pass<4, 8, true>(X, Wg, tid); fft2_pass<4, 8, true>(X2, Wg, tid); __syncthreads(); \
        fft2_pass<4, 12, true>(X, Wg, tid); fft2_pass<4, 12, true>(X2, Wg, tid); __syncthreads(); } while (0)
    HY_CONV(KF0);
    { float g[4][8];
#pragma unroll
      for (int b = 0; b < 4; ++b) sconv8(g1r[b], wa0, wa1, wa2, ba, g[b]);
#pragma unroll
      for (int x = 0; x < 8; ++x) { const f32x2 c0 = px[x] * (1.0f / 8192.0f), c1 = py[x] * (1.0f / 8192.0f);
          z[0][x] = g[0][x] * (c0.x + bias0 * z[0][x]); z[1][x] = g[1][x] * (c0.y + bias0 * z[1][x]); z[2][x] = g[2][x] * (c1.x + bias0 * z[2][x]); z[3][x] = g[3][x] * (c1.y + bias0 * z[3][x]); } }
    Raw8 g2r[4]; u32x4 hgr[4];
#pragma unroll
    for (int b = 0; b < 4; ++b) { g2r[b] = ld_raw8(pg2 + b * SEQL, t0, SEQL); hgr[b] = *(const u32x4*)(phg + b * SEQL + t0); }
    __syncthreads();
#pragma unroll
    for (int x = 0; x < 8; ++x) { px[x] = (f32x2){z[0][x], z[1][x]}; px[4224 + x] = (f32x2){0.f, 0.f}; py[x] = (f32x2){z[2][x], z[3][x]}; py[4224 + x] = (f32x2){0.f, 0.f}; }
    __syncthreads();
    HY_CONV(KF1);
#undef HY_CONV
    bf16_t* pvw = outrows + (size_t)c * MR;
#pragma unroll
    for (int b = 0; b < 4; ++b) { float g[8], hh[8], o[8]; sconv8(g2r[b], wb0, wb1, wb2, bb, g); unpack8(hgr[b], hh);
#pragma unroll
        for (int x = 0; x < 8; ++x) { const f32x2 cv = ((b < 2) ? px[x] : py[x]) * (1.0f / 8192.0f); const float cvv = (b & 1) ? cv.y : cv.x;
            o[x] = g[x] * (cvv + bias1 * z[b][x]) * siluf_(hh[x]); }
        *(u32x4*)(pvw + b * SEQL + t0) = pack8(o); }
    __syncthreads();
}
__device__ __forceinline__ void hy_transpose_item(unsigned char* ws, LAS unsigned char* lds, int item, int tid, int nrows) {
    const int lane = tid & 63, w = tid >> 6;
    const int wi = item * 8 + w;
    const int nrb = nrows / 64;
    if (wi >= nrb * 8) return;
    const int rb = wi >> 3, cb = wi & 7;
    LAS bf16_t* T = (LAS bf16_t*)(lds + w * 8704);
    const bf16_t* src = (const bf16_t*)(ws + WS_PT) + (size_t)(PT_V + cb * 64) * MR + (size_t)rb * 64;
    u32x4 tv[8];
#pragma unroll
    for (int i = 0; i < 8; ++i) { const int c = 8 * i + (lane >> 3), r8 = (lane & 7) * 8; tv[i] = *(const u32x4*)(src + (size_t)c * MR + r8); }
#pragma unroll
    for (int i = 0; i < 8; ++i) { const int c = 8 * i + (lane >> 3), r8 = (lane & 7) * 8;
        LAS unsigned* d = (LAS unsigned*)(T + c * 66 + r8); d[0] = tv[i].x; d[1] = tv[i].y; d[2] = tv[i].z; d[3] = tv[i].w; }
    asm volatile("s_waitcnt lgkmcnt(0)" ::: "memory");
    bf16_t* dst = (bf16_t*)(ws + WS_H) + (size_t)(rb * 64) * D + 512 + cb * 64;
#pragma unroll 4
    for (int i = 0; i < 8; ++i) { const int r = 8 * i + (lane >> 3), c8 = (lane & 7) * 8;
        unsigned short e[8];
#pragma unroll
        for (int x = 0; x < 8; ++x) e[x] = T[(c8 + x) * 66 + r];
        u32x4 o; o.x = e[0] | ((unsigned)e[1] << 16); o.y = e[2] | ((unsigned)e[3] << 16); o.z = e[4] | ((unsigned)e[5] << 16); o.w = e[6] | ((unsigned)e[7] << 16);
        *(u32x4*)(dst + (size_t)r * D + c8) = o; }
    asm volatile("s_waitcnt lgkmcnt(0)" ::: "memory");
}
#ifndef MK_EN
#define MK_EN 0xffff
#endif
#define EN(x) ((MK_EN >> (x)) & 1)
constexpr int PH_PREP = 0, PH_PER_LAYER = 7, PH_FNORM = 1 + 2 * PH_PER_LAYER, N_PHASES = PH_FNORM + 1;

__global__ void __launch_bounds__(NT, 2) fwd_kernel(Args ka) {
    extern __shared__ __attribute__((aligned(16))) unsigned char lds_raw[];
    LAS unsigned char* lds = (LAS unsigned char*)lds_raw;
    const int G = gridDim.x;
    volatile LAS unsigned* bst = (volatile LAS unsigned*)(lds + LDS_CTL_OFF);
    if (threadIdx.x < 16) bst[threadIdx.x] = 0u;
    if (threadIdx.x == 0) { LAS unsigned long long* tab = (LAS unsigned long long*)(lds + LDS_PTR_OFF);
#pragma unroll
        for (int i = 0; i < N_IN; ++i) tab[i] = (unsigned long long)ka.in[i]; }
    __syncthreads();

    XcdBarrier gbar; gbar.bar = (unsigned*)(ka.ws + WS_CTL); gbar.x = 0; gbar.st = bst;
    if (ka.ph_hi - ka.ph_lo > 1) gbar = xcd_barrier_post((unsigned*)(ka.ws + WS_CTL), bst);

#ifdef REP_SUB
#ifndef REP_LMASK
#define REP_LMASK 3
#endif
    int repmask = 0;
#endif
    for (int ph = ka.ph_lo; ph < ka.ph_hi; ++ph) {
        int tid = threadIdx.x; asm volatile("" : "+v"(tid));
        int bid = blockIdx.x; asm volatile("" : "+s"(bid));
#define LANE_WAVE() int tid2_ = threadIdx.x; asm volatile("" : "+v"(tid2_)); const int lane = tid2_ & 63, wave = __builtin_amdgcn_readfirstlane(tid2_ >> 6)
        __attribute__((address_space(1))) unsigned char* wsg_ = (__attribute__((address_space(1))) unsigned char*)ka.ws; asm volatile("" : "+s"(wsg_)); unsigned char* ws = (unsigned char*)wsg_;
        __attribute__((address_space(1))) float* outg_ = (__attribute__((address_space(1))) float*)ka.out; asm volatile("" : "+s"(outg_)); float* outp_ = (float*)outg_;
        DArgs a; a.in.t = (const LAS unsigned long long*)(lds + LDS_PTR_OFF); a.out = outp_;
        float* MOD = (float*)(ws + WS_MOD);
        if (EN(0) && ph == PH_PREP) {
            for (int it = bid; it < 1024; it += G) {
                int tid = threadIdx.x; asm volatile("" : "+v"(tid));
                __syncthreads();
                if (it < 192) prep_adaln(a.in[I_C], a.in[I_CCTX], a.in[I_ADAW], a.in[I_ADAB], MOD, it, (LAS float*)lds, tid);
                else if (it < 208) prep_s5b(a, ws, it - 192, tid);
                else if (it >= 1016) { const int j = (it - 1016) * NT + tid; float sn, cs; sincospif(-(float)j * (1.0f / 4096.0f), &sn, &cs); ((f32x2*)(ws + WS_TWID))[j] = (f32x2){cs, sn}; }
                else if (it >= 472) prep_rope((f32x2*)(ws + WS_ROPE), it - 472, tid);
                else { const bool big = it < 464; const int r = big ? it - 208 : it - 464, l = big ? (r >> 7) : 0, t0 = (big ? (r & 127) : r) * 32;
                    float* H3o = big ? (float*)(ws + WS_H3) + (size_t)l * 4096 * 64 : (float*)(ws + WS_H3C);
                    bf16_t* H3b = big ? (bf16_t*)(ws + WS_H3B) + (size_t)l * 4096 * 64 : (bf16_t*)nullptr;
                    prep_hymlp(a, H3o, H3b, l, big ? 4096 : 256, t0, lds, tid); }
            }
        } else if (EN(1) && ph == PH_FNORM) {
            const float* fw = a.in[I_FNW]; LANE_WAVE();
            const bf16_t* X2 = (const bf16_t*)(ws + WS_P);
            for (int row = bid * NWAVES + wave; row < NLAT; row += G * NWAVES) {
                u32x4 raw[4]; float ss = 0.f;
#pragma unroll
                for (int j = 0; j < 4; ++j) raw[j] = ((const u32x4*)(X2 + (size_t)row * D))[lane + 64 * j];
#pragma unroll
                for (int j = 0; j < 4; ++j) { float f[8]; unpack8(raw[j], f);
#pragma unroll
                    for (int x = 0; x < 8; ++x) ss += f[x] * f[x]; }
                const float rstd = rsqrtf(wave_sum(ss) * (1.0f / D) + EPS);
                float* xr = a.out + (size_t)row * D;
#pragma unroll
                for (int j = 0; j < 4; ++j) { const int k = 8 * (lane + 64 * j); float f[8]; unpack8(raw[j], f);
                    const f32x4 w0 = *(const f32x4*)(fw + k), w1 = *(const f32x4*)(fw + k + 4);
                    *(f32x4*)(xr + k) = (f32x4){f[0] * rstd * w0.x, f[1] * rstd * w0.y, f[2] * rstd * w0.z, f[3] * rstd * w0.w};
                    *(f32x4*)(xr + k + 4) = (f32x4){f[4] * rstd * w1.x, f[5] * rstd * w1.y, f[6] * rstd * w1.z, f[7] * rstd * w1.w}; }
            }
        } else {
            const int l = (ph - 1) / PH_PER_LAYER, sub = (ph - 1) % PH_PER_LAYER;

            const bool ctx_out = (l == 0);
            const int Mrows = ctx_out ? MR : NLAT;
            if (EN(2) && sub == 0) {
                LANE_WAVE();
                LAS float* scr = (LAS float*)(lds + wave * 8704);
                const int gw = bid * NWAVES + wave, NGW = G * NWAVES;
                constexpr int I_W1 = 32 * (NPAD / 32), I_W2 = 32 * 64, I_W3 = 8 * 16;
                for (int pass_ = 0; pass_ < 2; ++pass_) {
                if ((pass_ ^ ((bid >> 3) & 1)) == 0) {
                for (int it = (l == 0 ? gw : gw + I_W1); it < I_W1 + I_W2 + I_W3; it += NGW) {
                    int r = it;
                    if (r < I_W1) { const int kb = r / (NPAD / 32), nb = r % (NPAD / 32); transpose_item(a.in[I_WIN] + (size_t)l * D * INW, INW, win_srccol(nb * 32 + (lane & 31)), kb * 64, (bf16_t*)(ws + WS_WIN), D, nb * 32, scr, lane); continue; }
                    r -= I_W1;
                    if (r < I_W2) { const int kb = r / 64, nb = r % 64; transpose_item(a.in[I_WOUT] + (size_t)l * D * D, D, nb * 32 + (lane & 31), kb * 64, (bf16_t*)(ws + WS_WOUT), D, nb * 32, scr, lane); continue; }
                    r -= I_W2;
                    { const int kb = r / 16, nb = r % 16; transpose_item(a.in[I_GLUW] + (size_t)l * 512 * 512, 512, nb * 32 + (lane & 31), kb * 64, (bf16_t*)(ws + WS_GLUW), 512, nb * 32, scr, lane); }
                }
                const float* nw = a.in[I_NORMW] + (size_t)l * D;
                for (int row = gw; row < MR; row += NGW) {
                    const float* xr; int v;
                    if (row < NLAT) { xr = a.in[I_X] + (size_t)row * D; v = row >> 12; }
                    else { xr = (l == 0 ? a.in[I_CTX] : (const float*)(ws + WS_XC1)) + (size_t)(row - NLAT) * D; v = 4; }
                    if (l != 0 && row < NLAT) norm_row_bf((const bf16_t*)a.out + (size_t)row * D, nw, MOD + (size_t)(l * 5 + v) * ADA, (bf16_t*)(ws + WS_H) + (size_t)row * D, lane);
                    else norm_row(xr, nw, MOD + (size_t)(l * 5 + v) * ADA, (bf16_t*)(ws + WS_H) + (size_t)row * D, lane);
                }
                __syncthreads();
                } else {
                const int nfilt = ctx_out ? 768 : 0;
                for (int it = bid; it < nfilt; it += G) { int tid = threadIdx.x; asm volatile("" : "+v"(tid)); __syncthreads(); if (it < 256) filt_item2(a, ws, lds, l, it, tid); else filt_ctx_item(a, ws, lds, it - 256, tid);
#if defined(REP_ITEM) && REP_ITEM == 10
                    __syncthreads(); if (it < 256) filt_item2(a, ws, lds, l, it, tid);
#endif
                }
                __syncthreads();
                } }
            } else if (EN(3) && sub == 1) {
                pg8::Gemm g{(const bf16_t*)(ws + WS_H), (const bf16_t*)(ws + WS_WIN), MR, NPAD, D}; pg8::StaticOrder S; S.init(MR, NPAD, G, bid);
                EpiInProj E{(bf16_t*)(ws + WS_P), (bf16_t*)(ws + WS_PT), (float*)(ws + WS_LR), (const float*)(ws + WS_ROPE)};
                { pg8::InProjOrder S1; S1.init(ctx_out ? 0 : 1, G, bid); pg8::gemm_phase<EpiInProj, pg8::InProjOrder, true, true>(lds, g, S1, E, tid); }
            } else if (EN(5) && sub == 2) {
                const int nit = ctx_out ? 3744 : 3232;
                for (int it = bid; it < nit; it += G) {
                    int tid = threadIdx.x; asm volatile("" : "+v"(tid));
                    __syncthreads();
#ifdef REP_ITEM
                    { const int ty_ = it < 512 ? 0 : it < 1600 ? 1 : it < 2144 ? 2 : it < 3232 ? 3 : 4;
                      if (ty_ == REP_ITEM) { if (ty_ == 0) hyena_item2(a, ws, lds, l, it, tid, (bf16_t*)(ws + WS_H)); else if (ty_ == 1) s5_item<false>(a, ws, lds, l, (it - 512) >> 1, (it - 512) & 1, tid); else if (ty_ == 2) ret_passA(ws, lds, it - 1600, tid);
                          else if (ty_ == 3) gla_passA(a, ws, lds, l, it - 2144, tid); else hyena_ctx_item(a, ws, lds, it - 3232, tid);
                          __syncthreads(); asm volatile("" : "+v"(tid)); } }
#endif
                    if (it < 512) hyena_item2(a, ws, lds, l, it, tid, (bf16_t*)(ws + WS_PT) + (size_t)PT_V * MR);
                    else if (it < 1600) s5_item<false>(a, ws, lds, l, (it - 512) >> 1, (it - 512) & 1, tid);
                    else if (it < 2144) ret_passA(ws, lds, it - 1600, tid);
                    else if (it < 3232) gla_passA(a, ws, lds, l, it - 2144, tid);
                    else hyena_ctx_item(a, ws, lds, it - 3232, tid);
                }
            } else if (EN(9) && sub == 3) {
                for (int it = bid; it < 256; it += G) { int tid = threadIdx.x; asm volatile("" : "+v"(tid)); __syncthreads(); hy_transpose_item(ws, lds, it, tid, NLAT); }
                for (int it = bid; it < 224; it += G) { int tid = threadIdx.x; asm volatile("" : "+v"(tid)); __syncthreads();
                    if (it < 128) ret_passB(ws, it * NT + tid);
                    else if (it < 192) gla_passB(ws, lds, it - 128, tid);
                    else s5_passB(ws, l, (it - 192) * NT + tid); }
            } else if (EN(6) && sub == 4) {
                const int nsc = ctx_out ? 1088 : 1024, nrc = ctx_out ? 16 * RNCH : 16 * 32, ngc = ctx_out ? 16 * GNCH : 16 * 64;
                for (int it = bid; it < nsc; it += G) { int tid = threadIdx.x; asm volatile("" : "+v"(tid)); __syncthreads();
                    const int i2 = it >> 1; const int item = ctx_out ? i2 : (i2 >> 7) * (SNCH * 2) + 8 + (i2 & 127);
#if defined(REP_ITEM) && REP_ITEM == 5
                    s5_item<true>(a, ws, lds, l, item, it & 1, tid); __syncthreads(); asm volatile("" : "+v"(tid));
#endif
                    s5_item<true>(a, ws, lds, l, item, it & 1, tid); }
                for (int it = (bid + 64) % G; it < nrc; it += G) { int tid = threadIdx.x; asm volatile("" : "+v"(tid)); __syncthreads();
                    const int item = ctx_out ? it : (it >> 5) * RNCH + 2 + (it & 31);
#if defined(REP_ITEM) && REP_ITEM == 6
                    ret_passC(a, ws, lds, l, item, tid); __syncthreads(); asm volatile("" : "+v"(tid));
#endif
                    ret_passC(a, ws, lds, l, item, tid); }
                for (int it = (bid + 128) % G; it < ngc; it += G) { int tid = threadIdx.x; asm volatile("" : "+v"(tid)); __syncthreads();
                    const int item = ctx_out ? it : (it >> 6) * GNCH + 4 + (it & 63);
#if defined(REP_ITEM) && REP_ITEM == 7
                    gla_passC(a, ws, lds, l, item, tid); __syncthreads(); asm volatile("" : "+v"(tid));
#endif
                    gla_passC(a, ws, lds, l, item, tid); }
            } else if (EN(7) && sub == 5) {
                pg8::Gemm g{(const bf16_t*)(ws + WS_KF), (const bf16_t*)(ws + WS_GLUW), Mrows, 512, 512}; pg8::StaticOrder S; S.init(Mrows, 512, G, bid);
                EpiGlu E{(const bf16_t*)(ws + WS_KF) + OBSZ, (bf16_t*)(ws + WS_H), a.in[I_GLUB] + (size_t)l * 512};
                pg8::gemm_phase<EpiGlu, pg8::StaticOrder, true, true>(lds, g, S, E, tid);
                if (l == 0 && bid >= 136) {
                    LANE_WAVE(); LAS float* scr = (LAS float*)(lds + wave * 8704);
                    for (int r = (bid - 136) * NWAVES + wave; r < 32 * (NPAD / 32); r += (G - 136) * NWAVES) { const int kb = r / (NPAD / 32), nb = r % (NPAD / 32);
                        transpose_item(a.in[I_WIN] + (size_t)1 * D * INW, INW, win_srccol(nb * 32 + (lane & 31)), kb * 64, (bf16_t*)(ws + WS_WIN), D, nb * 32, scr, lane); }
                }
            } else if (EN(8)) {
                pg8::Gemm g{(const bf16_t*)(ws + WS_H), (const bf16_t*)(ws + WS_WOUT), Mrows, D, D}; pg8::StaticOrder S; S.init(Mrows, D, G, bid);
                EpiOut E{l == 0 ? a.in[I_X] : (const float*)nullptr, (const bf16_t*)a.out, a.in[I_CTX], l == 0 ? (bf16_t*)a.out : (bf16_t*)(ws + WS_P), (float*)(ws + WS_XC1), MOD + (size_t)l * 5 * ADA};
                pg8::gemm_phase<EpiOut, pg8::StaticOrder, true, true>(lds, g, S, E, tid);
                if (l == 0 && bid >= 32) {
                    for (int it = bid - 32; it < 256; it += G - 32) { int tid2 = threadIdx.x; asm volatile("" : "+v"(tid2)); __syncthreads(); filt_item2(a, ws, lds, 1, it, tid2); }
                }
            }
        }
#ifdef REP_SUB
        if (ph != PH_PREP && ph != PH_FNORM && ((ph - 1) % PH_PER_LAYER) == REP_SUB && ((REP_LMASK >> ((ph - 1) / PH_PER_LAYER)) & 1) && !((repmask >> ((ph - 1) / PH_PER_LAYER)) & 1)) { repmask |= 1 << ((ph - 1) / PH_PER_LAYER); xcd_barrier(gbar); --ph; continue; }
#endif
        if (ph + 1 < ka.ph_hi) xcd_barrier(gbar);
    }
}

#ifndef MK_LAUNCH_PER_PHASE
#define MK_LAUNCH_PER_PHASE 0
#endif
extern "C" void kernel_launch(void* const* d_in, const int* in_sizes, int n_in, void* d_out, int out_size, void* d_ws, size_t ws_size, hipStream_t stream) {
    static int grid = 0;
    if (grid == 0) {
        if (n_in != N_IN || out_size != NLAT * D || ws_size < WS_END2) { fprintf(stderr, "kernel_launch: unexpected shapes (n_in %d, out %d, ws %zu < %zu); nothing launched\n", n_in, out_size, ws_size, (size_t)WS_END2); grid = -1; return; }
        int dev = 0, cus = 0, per_cu = 0;
        if (hipGetDevice(&dev) != hipSuccess || hipDeviceGetAttribute(&cus, hipDeviceAttributeMultiprocessorCount, dev) != hipSuccess) { grid = -1; return; }
        if (hipFuncSetAttribute((const void*)fwd_kernel, hipFuncAttributeMaxDynamicSharedMemorySize, LDS_BYTES) != hipSuccess) { fprintf(stderr, "kernel_launch: hipFuncSetAttribute failed\n"); grid = -1; return; }
        if (hipOccupancyMaxActiveBlocksPerMultiprocessor(&per_cu, (const void*)fwd_kernel, NT, LDS_BYTES) != hipSuccess || per_cu < 1) { fprintf(stderr, "kernel_launch: occupancy query says %d blocks per CU\n", per_cu); per_cu = 1; }
        (void)hipGetLastError();
        grid = cus;
    }
    if (grid < 0) return;
    (void)hipMemsetAsync((char*)d_ws + WS_CTL, 0, WS_ZERO_BYTES, stream);
    Args a{};
    for (int i = 0; i < N_IN; ++i) a.in[i] = (const float*)d_in[i];
    a.out = (float*)d_out; a.ws = (unsigned char*)d_ws;
#if MK_LAUNCH_PER_PHASE
    for (int ph = 0; ph < N_PHASES; ++ph) {
        a.ph_lo = ph; a.ph_hi = ph + 1;
        hipLaunchKernelGGL(fwd_kernel, dim3(grid), dim3(NT), LDS_BYTES, stream, a);
    }
#else
    a.ph_lo = 0; a.ph_hi = N_PHASES;
    void* args[] = {&a};
    hipError_t e = hipLaunchCooperativeKernel((const void*)fwd_kernel, dim3(grid), dim3(NT), args, LDS_BYTES, stream);
    if (e != hipSuccess) fprintf(stderr, "kernel_launch: cooperative launch failed: %s (grid %d)\n", hipGetErrorString(e), grid);
#endif
}
```

```cpp
#include <hip/hip_runtime.h>
#include <hip/hip_cooperative_groups.h>
#include <cstdio>
#include <cstdint>
namespace cg = cooperative_groups;

#define LAS __attribute__((address_space(3)))
typedef unsigned short bf16_t;
typedef float f32x4 __attribute__((ext_vector_type(4)));
typedef float f32x2 __attribute__((ext_vector_type(2)));
typedef unsigned u32x4 __attribute__((ext_vector_type(4)));
typedef unsigned u32x2 __attribute__((ext_vector_type(2)));

constexpr int D = 2048, NB = 4, SEQL = 4096, LC = 256, NLAT = NB * SEQL, NCTX = NB * LC, MR = NLAT + NCTX;
constexpr int BR = 512, INW = 6688, NPAD = 6656, LDP = 4608, ADA = 3 * D;
constexpr int NT = 512, NWAVES = 8;
constexpr float EPS = 1e-6f;
constexpr int PC_S5U = 0, PC_S5G = 512, PC_RQ = 1024, PC_RK = 1536, PC_RV = 2048, PC_RG = 2560, PC_GQ = 3072, PC_GK = 3328, PC_GV = 3584, PC_GG = 4096;
constexpr int PT_V = 0, PT_G1 = 512, PT_G2 = 1024, PT_HG = 1536;
constexpr int FFTN = 8192;

enum { I_X = 0, I_C, I_CTX, I_CCTX, I_NORMW, I_ADAW, I_ADAB, I_WIN, I_WOUT, I_S5ARE, I_S5AIM, I_S5LDT, I_S5BRE, I_S5BIM, I_S5CRE, I_S5CIM,
       I_S5D, I_GLUW, I_GLUB, I_HCW, I_HCB, I_HW1, I_HB1, I_HF1, I_HW2, I_HB2, I_HF2, I_HW3, I_HB3, I_HF3, I_HW4, I_HBIAS, I_RNW, I_GGW, I_GGB, I_GNW, I_FNW, N_IN };

constexpr size_t al256(size_t x) { return (x + 255) & ~(size_t)255; }
constexpr size_t WS_CTL  = 0;
constexpr size_t WS_MOD  = WS_CTL + 65536;
constexpr size_t WS_ZERO_BYTES = 65536 + al256((size_t)2 * 5 * ADA * 4);
constexpr size_t WS_S5AB = WS_MOD + al256((size_t)2 * 5 * ADA * 4);
constexpr size_t WS_S5BT = WS_S5AB + (size_t)2 * 2 * 32 * 64 * 8;
constexpr size_t WS_H3   = WS_S5BT + (size_t)1048576 + 65536;
constexpr size_t WS_H3C  = WS_H3 + (size_t)2 * 4096 * 64 * 4;
constexpr size_t WS_KC   = WS_H3C + (size_t)256 * 64 * 4;
constexpr size_t WS_LR   = WS_KC + (size_t)2 * 512 * 512 * 4;
constexpr size_t WS_XC1  = WS_LR + (size_t)MR * 32 * 4;
constexpr size_t WS_WOUT = WS_XC1 + (size_t)NCTX * D * 4;
constexpr size_t WS_GLUW = WS_WOUT + (size_t)D * D * 2;
constexpr size_t WS_WIN  = WS_GLUW + (size_t)512 * 512 * 2;
constexpr size_t WS_H    = WS_WIN + (size_t)NPAD * D * 2;
constexpr size_t WS_P    = WS_H + (size_t)MR * D * 2;
constexpr size_t WS_PT   = WS_P + (size_t)MR * LDP * 2;
constexpr size_t WS_KF   = WS_PT + (size_t)2048 * MR * 2;
constexpr size_t WS_OB   = WS_KF + (size_t)2 * 512 * FFTN * 8;
constexpr size_t WS_END  = WS_OB + (size_t)6 * MR * 512 * 2;
constexpr size_t OBSZ = (size_t)MR * 512;

constexpr int LDS_CTL_OFF = 135168 + 1024;
constexpr int LDS_PTR_OFF = LDS_CTL_OFF + 64;
constexpr int LDS_BYTES = LDS_PTR_OFF + 320;

typedef __bf16 hwbf16x2 __attribute__((ext_vector_type(2)));
__device__ __forceinline__ unsigned pk2(float lo, float hi) { const f32x2 v = {lo, hi}; return __builtin_bit_cast(unsigned, __builtin_convertvector(v, hwbf16x2)); }
__device__ __forceinline__ unsigned f2bf(float f) { return pk2(f, 0.f) & 0xffffu; }
__device__ __forceinline__ float bf2f(bf16_t b) { return __uint_as_float((unsigned)b << 16); }
__device__ __forceinline__ float bflo(unsigned w) { return __uint_as_float(w << 16); }
__device__ __forceinline__ float bfhi(unsigned w) { return __uint_as_float(w & 0xffff0000u); }
__device__ __forceinline__ void unpack8(const u32x4 r, float (&f)[8]) { f[0] = bflo(r.x); f[1] = bfhi(r.x); f[2] = bflo(r.y); f[3] = bfhi(r.y); f[4] = bflo(r.z); f[5] = bfhi(r.z); f[6] = bflo(r.w); f[7] = bfhi(r.w); }
__device__ __forceinline__ u32x4 pack8(const float (&f)[8]) { u32x4 o; o.x = pk2(f[0], f[1]); o.y = pk2(f[2], f[3]); o.z = pk2(f[4], f[5]); o.w = pk2(f[6], f[7]); return o; }
__device__ __forceinline__ float sigmoidf_(float x) { return __builtin_amdgcn_rcpf(1.0f + __expf(-x)); }
__device__ __forceinline__ float siluf_(float x) { return x * sigmoidf_(x); }
__device__ __forceinline__ float gelu_tanh(float x) { const float u2 = 1.5957691216057308f * (x + 0.044715f * x * x * x); return x * sigmoidf_(u2); }
__device__ __forceinline__ float wave_sum(float v) {
#pragma unroll
    for (int o = 1; o < 64; o <<= 1) v += __shfl_xor(v, o);
    return v;
}
#define LDS_WAIT() asm volatile("s_waitcnt lgkmcnt(0)" ::: "memory")

struct Args { const float* in[N_IN]; float* out; unsigned char* ws; int ph_lo, ph_hi; };
struct InTab { const LAS unsigned long long* t;
    __device__ __forceinline__ const float* operator[](int i) const { const unsigned long long v = t[i];
        const unsigned lo = __builtin_amdgcn_readfirstlane((unsigned)v), hi = __builtin_amdgcn_readfirstlane((unsigned)(v >> 32)); return (const float*)(__attribute__((address_space(1))) const float*)(((unsigned long long)hi << 32) | lo); } };
struct DArgs { InTab in; float* out; };

#define XB_TMO      128
#define XB_XCNT(j)  (256  + 64 * (j))
#define XB_XSUB(j)  (1280 + 64 * (j))
#define XB_XGEN(j)  (2304 + 64 * (j))
#define XB_TOP      3328
#define XB_TOPGEN   3392
#define XCD_BAR_WORDS 3456
#define XB_SPIN_CAP (1u << 22)
__device__ __forceinline__ unsigned xb_ld(unsigned* p)              { return __hip_atomic_load(p, __ATOMIC_RELAXED, __HIP_MEMORY_SCOPE_AGENT); }
__device__ __forceinline__ unsigned xb_add(unsigned* p, unsigned v) { return __hip_atomic_fetch_add(p, v, __ATOMIC_RELAXED, __HIP_MEMORY_SCOPE_AGENT); }
__device__ __forceinline__ unsigned xb_xcc_id() { return (unsigned)__builtin_amdgcn_s_getreg((3 << 11) | 20) & 0xFu; }
#define XB_SPIN(cond, bar) do { unsigned _sp = 0; while (cond) { __builtin_amdgcn_s_sleep(1); \
    if ((++_sp & 255u) == 0u) { if (xb_ld(&(bar)[XB_TMO])) break; if (_sp > XB_SPIN_CAP) { atomicAdd(&(bar)[XB_TMO], 1u); break; } } } } while (0)
struct XcdBarrier { unsigned* bar; unsigned x; volatile LAS unsigned* st; };
__device__ __forceinline__ XcdBarrier xcd_barrier_post(unsigned* bar, volatile LAS unsigned* st) {
    XcdBarrier b; b.bar = bar; b.x = xb_xcc_id(); b.st = st;
    if (threadIdx.x == 0) (void)xb_add(&bar[XB_XCNT(b.x)], 1u);
    return b;
}
__device__ __forceinline__ void xcd_barrier_complete(unsigned* bar, unsigned x, unsigned& nloc, unsigned& nx) {
    const unsigned G = gridDim.x * gridDim.y * gridDim.z;
    unsigned sum, cnt, mine, sp = 0u;
    for (;;) {
        sum = 0u; cnt = 0u; mine = 0u;
#pragma unroll
        for (unsigned j = 0; j < 16; ++j) { const unsigned c = xb_ld(&bar[XB_XCNT(j)]); sum += c; cnt += (c > 0u) ? 1u : 0u; mine = (j == x) ? c : mine; }
        if (sum == G) break;
        __builtin_amdgcn_s_sleep(1);
        if ((++sp & 255u) == 0u) { if (xb_ld(&bar[XB_TMO])) break; if (sp > XB_SPIN_CAP) { atomicAdd(&bar[XB_TMO], 1u); break; } }
    }
    nloc = mine > 0u ? mine : 1u; nx = cnt > 0u ? cnt : 1u;
}
__device__ __forceinline__ void xcd_barrier(const XcdBarrier& b) {
    asm volatile("s_waitcnt vmcnt(0)" ::: "memory");
    __syncthreads();
    if (threadIdx.x == 0) {
        unsigned* bar = b.bar;
        __builtin_amdgcn_s_waitcnt(0);
        unsigned nloc = b.st[0], nx = b.st[1];
        if (nloc == 0u) { xcd_barrier_complete(bar, b.x, nloc, nx); b.st[0] = nloc; b.st[1] = nx; }
        const unsigned old = xb_add(&bar[XB_XSUB(b.x)], 1u);
        const unsigned gen = old / nloc;
        if (old + 1u == (gen + 1u) * nloc) {
            __builtin_amdgcn_fence(__ATOMIC_RELEASE, "agent");
            asm volatile("s_waitcnt vmcnt(0)" ::: "memory");
            const unsigned og = xb_add(&bar[XB_TOP], 1u);
            const unsigned tg = og / nx;
            if (og + 1u == (tg + 1u) * nx) xb_add(&bar[XB_TOPGEN], 1u);
            else XB_SPIN(xb_ld(&bar[XB_TOPGEN]) == tg, bar);
            __builtin_amdgcn_fence(__ATOMIC_ACQUIRE, "agent");
            xb_add(&bar[XB_XGEN(b.x)], 1u);
            asm volatile("s_waitcnt vmcnt(0)" ::: "memory");
        } else {
            XB_SPIN(xb_ld(&bar[XB_XGEN(b.x)]) == gen, bar);
            __builtin_amdgcn_fence(__ATOMIC_ACQUIRE, "agent");
            asm volatile("s_waitcnt vmcnt(0)" ::: "memory");
        }
    }
    __syncthreads();
}
#ifndef PG8_RB
#define PG8_RB 4
#endif
#ifndef PG8_WGM
#define PG8_WGM 4
#endif
namespace pg8 {
#define PG8_LAS __attribute__((address_space(3)))
typedef unsigned short bf16_t;
typedef short bf16x8 __attribute__((ext_vector_type(8)));
typedef float f32x4 __attribute__((ext_vector_type(4)));
typedef unsigned u32x4 __attribute__((ext_vector_type(4)));
constexpr int BM = 256, BK = 64, HALF = 128, HTB = HALF * BK * 2, STAGE_BYTES = 8 * HTB, NXCD = 8, WGM = PG8_WGM;

__host__ __device__ __forceinline__ int lds_byte(int r, int c) { const int st = (r >> 4) * 2 + (c >> 5), rr = r & 15, cc = c & 31, ob = rr * 64 + cc * 2; return st * 1024 + (ob ^ (((ob >> 9) & 1) << 5)); }
__host__ __device__ __forceinline__ void stage_rc(int b, int& R, int& C) { const int st = b / 1024, sb = b % 1024, swz = sb ^ (((sb >> 9) & 1) << 5); R = (st >> 1) * 16 + swz / 64; C = (st & 1) * 32 + (swz % 64) / 2; }
__host__ __device__ __forceinline__ int perm32(int rho) { const int n = rho >> 4, i = rho & 15; return 8 * (i >> 2) + 4 * n + (i & 3); }

struct Unit { int pm, pn; };
struct Gemm { const bf16_t* A; const bf16_t* Bt; int M, N, K; };

struct StaticOrder {
    int nM, nN, nwg, G, c;
    __host__ __device__ void init(int M, int N, int G_, int c_) { nM = M / BM; nN = N / BM; nwg = nM * nN; G = G_; c = c_; }
    __host__ __device__ bool next(int i, Unit& u) const {
        const long L = (long)i * G + c; if (L >= nwg) return false;
        int wgid = (int)L; { const int q = nwg / NXCD, r = nwg % NXCD, xcd = wgid % NXCD, off = wgid / NXCD; wgid = (xcd < r ? xcd * (q + 1) : r * (q + 1) + (xcd - r) * q) + off; }
        const int nig = WGM * nN, gid = wgid / nig, fm = gid * WGM, gsz = (nM - fm) < WGM ? (nM - fm) : WGM;
        u.pm = fm + ((wgid % nig) % gsz); u.pn = (wgid % nig) / gsz; return true;
    }
    __device__ __forceinline__ void a_ready(const Unit&) const {}
    __device__ __forceinline__ void done(const Unit&) const {}
    __device__ __forceinline__ bool swapped(const Unit&) const { return false; }
};


struct InProjOrder {
    int G, c, last;
    __host__ __device__ void init(int last_, int G_, int c_) { last = last_; G = G_; c = c_; }
    __host__ __device__ bool next(int i, Unit& u) const {
        const int L = i * G + c;
        constexpr int NC = 26, NLT = 64 * NC;
        if (L < NLT) { constexpr int RB = PG8_RB, BT = 8 * RB * NC, CB = 32 / RB; const int band = L / BT, r = L % BT, blk = r >> 8, q = r & 255, x = q & 7, j = q >> 3;
            u.pm = 8 * RB * band + RB * x + (j % RB); u.pn = CB * blk + (j / RB); return true; }
        if (!last) { if (L >= NLT + 4 * NC) return false; const int r = L - NLT; u.pm = 64 + (r & 3); u.pn = r >> 2; return true; }
        if (L >= NLT + 36) return false;
        const int k = L - NLT, j = k % 9; u.pm = 64 + k / 9;
        u.pn = j == 0 ? 0 : j == 1 ? 1 : j == 2 ? 14 : j == 3 ? 15 : j == 4 ? 16 : j == 5 ? 17 : j == 6 ? 21 : j == 7 ? 22 : 23;
        return true;
    }
    __device__ __forceinline__ void a_ready(const Unit&) const {}
    __device__ __forceinline__ void done(const Unit&) const {}
    __device__ __forceinline__ bool swapped(const Unit& u) const { return u.pn >= 4 && u.pn < 12; }
};
template <class Epi, class Sched, bool ALIGN_EPI = false, bool SP2 = false>
__device__ __forceinline__ void gemm_phase(PG8_LAS unsigned char* lds, const Gemm g, const Sched& S, const Epi& E, const int tid) {
    const int wid = __builtin_amdgcn_readfirstlane(tid >> 6), lane = tid & 63, wr = wid >> 2, wc = wid & 3, fr = lane & 15, fq = lane >> 4;
    const int K = g.K, nt = K / BK;
    unsigned voffA[2], voffB[2];
#pragma unroll
    for (int i = 0; i < 2; ++i) { int R, C; stage_rc(tid * 16 + i * 8192, R, C); const int Rb = Epi::PERM ? ((R & ~31) + perm32(R & 31)) : R;
        voffA[i] = (unsigned)(R * K + C) * 2u; voffB[i] = (unsigned)(Rb * K + C) * 2u; }
    const size_t kstep = (size_t)(BK * 2);
    const size_t hstep = (size_t)HALF * K * 2;
    const size_t tstep = 2 * hstep;
    const unsigned ldsw = (unsigned)wid * 1024u;
    const int aoff = lds_byte(wr * 64 + fr, fq * 8), boff = lds_byte(wc * 32 + fr, fq * 8);
#define PG8_SA(b, h) (((b) * 2 + (h)) * HTB)
#define PG8_SB(b, h) ((4 + (b) * 2 + (h)) * HTB)
#define PG8_STAGE(bufoff, gbase, voff) do { _Pragma("unroll") for (int _i = 0; _i < 2; ++_i) \
        __builtin_amdgcn_global_load_lds((const unsigned*)((const char*)(gbase) + (voff)[_i]), (PG8_LAS unsigned*)(lds + (bufoff) + ldsw + _i * 8192), 16, 0, 0); } while (0)
#define PG8_LDA(dst, b, h) do { _Pragma("unroll") for (int m = 0; m < 4; ++m) _Pragma("unroll") for (int k = 0; k < 2; ++k) dst[m][k] = *(const PG8_LAS bf16x8*)(lds + PG8_SA(b, h) + aoff + m * 2048 + k * 1024); } while (0)
#define PG8_LDB(dst, b, h) do { _Pragma("unroll") for (int n = 0; n < 2; ++n) _Pragma("unroll") for (int k = 0; k < 2; ++k) dst[n][k] = *(const PG8_LAS bf16x8*)(lds + PG8_SB(b, h) + boff + n * 2048 + k * 1024); } while (0)
#define PG8_MMA(ai, bj, At, Bt) do { __builtin_amdgcn_s_setprio(1); _Pragma("unroll") for (int m = 0; m < 4; ++m) _Pragma("unroll") for (int n = 0; n < 2; ++n) _Pragma("unroll") for (int k = 0; k < 2; ++k) \
        acc[ai][bj][m][n] = __builtin_amdgcn_mfma_f32_16x16x32_bf16(Bt[n][k], At[m][k], acc[ai][bj][m][n], 0, 0, 0); __builtin_amdgcn_s_setprio(0); } while (0)
#define PG8_WAIT_V(n) asm volatile("s_waitcnt vmcnt(" #n ")" ::: "memory")
#define PG8_WAIT_L(n) asm volatile("s_waitcnt lgkmcnt(" #n ")" ::: "memory")
#define PG8_BAR __builtin_amdgcn_s_barrier()
#define PG8_SCHED __builtin_amdgcn_sched_barrier(0)
    Unit cur, nxt; int ui = 0;
    if (!S.next(0, cur)) return;
    f32x4 acc[2][2][4][2];
#pragma unroll
    for (int a = 0; a < 2; ++a)
#pragma unroll
        for (int b = 0; b < 2; ++b)
#pragma unroll
            for (int m = 0; m < 4; ++m)
#pragma unroll
                for (int n = 0; n < 2; ++n) acc[a][b][m][n] = (f32x4){0.f, 0.f, 0.f, 0.f};
    bf16x8 At[4][2], B0[2][2], B1[2][2];
    const char* cA; const char* cB;
    { const char* pa = (const char*)g.A + (size_t)cur.pm * tstep; const char* pb = (const char*)g.Bt + (size_t)cur.pn * tstep; const bool sw = S.swapped(cur); cA = sw ? pb : pa; cB = sw ? pa : pb; }
    S.a_ready(cur);
    if constexpr (SP2) {
        PG8_STAGE(PG8_SB(0, 0), cB, voffB); PG8_STAGE(PG8_SB(0, 1), cB + hstep, voffB); PG8_STAGE(PG8_SA(0, 0), cA, voffA); PG8_STAGE(PG8_SA(0, 1), cA + hstep, voffA);
        if (wr == 1) PG8_BAR;
        PG8_WAIT_V(2); PG8_BAR;
        PG8_STAGE(PG8_SB(1, 0), cB + kstep, voffB); PG8_STAGE(PG8_SA(1, 0), cA + kstep, voffA); PG8_STAGE(PG8_SB(1, 1), cB + hstep + kstep, voffB);
        PG8_WAIT_V(6); PG8_BAR;
    } else {
        PG8_STAGE(PG8_SB(0, 0), cB, voffB); PG8_STAGE(PG8_SA(0, 0), cA, voffA); PG8_STAGE(PG8_SB(0, 1), cB + hstep, voffB); PG8_STAGE(PG8_SA(0, 1), cA + hstep, voffA);
        if (wr == 1) PG8_BAR;
        PG8_WAIT_V(4); PG8_BAR;
        PG8_STAGE(PG8_SB(1, 0), cB + kstep, voffB); PG8_STAGE(PG8_SA(1, 0), cA + kstep, voffA); PG8_STAGE(PG8_SB(1, 1), cB + hstep + kstep, voffB);
        PG8_WAIT_V(6); PG8_BAR;
    }
    for (;;) {
        const bool has_next = S.next(ui + 1, nxt);
        const char* nA = cA; const char* nB = cB;
        if (has_next) { const char* pa = (const char*)g.A + (size_t)nxt.pm * tstep; const char* pb = (const char*)g.Bt + (size_t)nxt.pn * tstep; const bool sw = S.swapped(nxt); nA = sw ? pb : pa; nB = sw ? pa : pb; }
#ifdef PG8_REPK
        const int nrep_ = (g.N == PG8_REPK) ? 2 : 1;
        for (int rep_ = 0; rep_ < nrep_; ++rep_) {
        if (rep_) {
#pragma unroll
            for (int a = 0; a < 2; ++a)
#pragma unroll
                for (int b = 0; b < 2; ++b)
#pragma unroll
                    for (int m = 0; m < 4; ++m)
#pragma unroll
                        for (int n = 0; n < 2; ++n) acc[a][b][m][n] = (f32x4){0.f, 0.f, 0.f, 0.f}; }
#endif
        for (int t = 0; t < nt; t += 2) {
#ifdef PG8_REPK
            const bool last = (t == nt - 2) && (rep_ == nrep_ - 1);
            const bool lastk_ = (t == nt - 2);
#else
            const bool last = (t == nt - 2);
#endif
            const char* a1 = cA + (size_t)(t + 1) * kstep;
#ifdef PG8_REPK
            const char* a2 = last ? nA : (lastk_ ? cA : cA + (size_t)(t + 2) * kstep); const char* b2 = last ? nB : (lastk_ ? cB : cB + (size_t)(t + 2) * kstep);
#else
            const char* a2 = last ? nA : cA + (size_t)(t + 2) * kstep; const char* b2 = last ? nB : cB + (size_t)(t + 2) * kstep;
#endif
            const char* a3 = a2 + kstep; const char* b3 = b2 + kstep;
            if (last && has_next) S.a_ready(nxt);
            if constexpr (SP2) {
            PG8_LDB(B0, 0, 0); PG8_LDB(B1, 0, 1); PG8_SCHED; PG8_LDA(At, 0, 0); PG8_STAGE(PG8_SA(1, 1), a1 + hstep, voffA);
            PG8_WAIT_V(8); PG8_WAIT_L(0); PG8_BAR; PG8_MMA(0, 0, At, B0); PG8_MMA(0, 1, At, B1); PG8_BAR; PG8_SCHED;
            PG8_LDA(At, 0, 1); PG8_STAGE(PG8_SB(0, 0), b2, voffB); PG8_STAGE(PG8_SB(0, 1), b2 + hstep, voffB); PG8_STAGE(PG8_SA(0, 0), a2, voffA);
            PG8_WAIT_V(8); PG8_WAIT_L(0); PG8_BAR; PG8_MMA(1, 0, At, B0); PG8_MMA(1, 1, At, B1); PG8_BAR; PG8_SCHED;
            PG8_LDB(B0, 1, 0); PG8_LDB(B1, 1, 1); PG8_SCHED; PG8_LDA(At, 1, 0); PG8_STAGE(PG8_SA(0, 1), a2 + hstep, voffA);
            PG8_WAIT_V(8); PG8_WAIT_L(0); PG8_BAR; PG8_MMA(0, 0, At, B0); PG8_MMA(0, 1, At, B1); PG8_BAR; PG8_SCHED;
            PG8_LDA(At, 1, 1); PG8_STAGE(PG8_SB(1, 0), b3, voffB); PG8_STAGE(PG8_SB(1, 1), b3 + hstep, voffB); PG8_STAGE(PG8_SA(1, 0), a3, voffA);
            PG8_WAIT_V(8); PG8_WAIT_L(0); PG8_BAR; PG8_MMA(1, 0, At, B0); PG8_MMA(1, 1, At, B1); PG8_BAR; PG8_SCHED;
            } else {
            PG8_LDB(B0, 0, 0); PG8_SCHED; PG8_LDA(At, 0, 0); PG8_STAGE(PG8_SA(1, 1), a1 + hstep, voffA);
            PG8_WAIT_L(8); PG8_BAR; PG8_WAIT_L(0); PG8_MMA(0, 0, At, B0); PG8_BAR; PG8_SCHED;
            PG8_LDB(B1, 0, 1); PG8_STAGE(PG8_SB(0, 0), b2, voffB);
            PG8_BAR; PG8_WAIT_L(0); PG8_MMA(0, 1, At, B1); PG8_BAR;
            PG8_LDA(At, 0, 1); PG8_STAGE(PG8_SA(0, 0), a2, voffA);
            PG8_BAR; PG8_WAIT_L(0); PG8_MMA(1, 0, At, B0); PG8_BAR; PG8_SCHED;
            PG8_STAGE(PG8_SB(0, 1), b2 + hstep, voffB);
            PG8_WAIT_V(6); PG8_BAR; PG8_MMA(1, 1, At, B1); PG8_BAR;
            PG8_LDB(B0, 1, 0); PG8_SCHED; PG8_LDA(At, 1, 0); PG8_STAGE(PG8_SA(0, 1), a2 + hstep, voffA);
            PG8_WAIT_L(8); PG8_BAR; PG8_WAIT_L(0); PG8_MMA(0, 0, At, B0); PG8_BAR; PG8_SCHED;
            PG8_LDB(B1, 1, 1); PG8_STAGE(PG8_SB(1, 0), b3, voffB);
            PG8_BAR; PG8_WAIT_L(0); PG8_MMA(0, 1, At, B1); PG8_BAR;
            PG8_LDA(At, 1, 1); PG8_STAGE(PG8_SA(1, 0), a3, voffA);
            PG8_BAR; PG8_WAIT_L(0); PG8_MMA(1, 0, At, B0); PG8_BAR; PG8_SCHED;
            PG8_STAGE(PG8_SB(1, 1), b3 + hstep, voffB);
            PG8_WAIT_V(6); PG8_BAR; PG8_MMA(1, 1, At, B1); PG8_BAR;
            }
        }
#ifdef PG8_REPK
        }
#endif
        if constexpr (ALIGN_EPI) { if (wr == 0) PG8_BAR; }
        { int fr_ = fr, fq_ = fq; asm volatile("" : "+v"(fr_), "+v"(fq_));
          E(acc, cur, wr, wc, fr_, fq_);
#ifdef PG8_REPE
          if (g.N == PG8_REPE) { asm volatile("" : "+v"(fr_), "+v"(fq_)); E(acc, cur, wr, wc, fr_, fq_); }
#endif
          } S.done(cur);
        if (!has_next) break;
#pragma unroll
        for (int a = 0; a < 2; ++a)
#pragma unroll
            for (int b = 0; b < 2; ++b)
#pragma unroll
                for (int m = 0; m < 4; ++m)
#pragma unroll
                    for (int n = 0; n < 2; ++n) acc[a][b][m][n] = (f32x4){0.f, 0.f, 0.f, 0.f};
        cur = nxt; cA = nA; cB = nB; ++ui;
        if constexpr (ALIGN_EPI) { if (wr == 1) PG8_BAR; }
    }
    PG8_WAIT_V(0);
    if constexpr (!ALIGN_EPI) { if (wr == 0) PG8_BAR; }
    PG8_BAR;
#undef PG8_SA
#undef PG8_SB
#undef PG8_STAGE
#undef PG8_LDA
#undef PG8_LDB
#undef PG8_MMA
#undef PG8_WAIT_V
#undef PG8_WAIT_L
#undef PG8_BAR
#undef PG8_SCHED
}
}
__device__ __forceinline__ void prep_adaln(const float* c, const float* cctx, const float* adaw, const float* adab, float* MOD, int it, LAS float* sv, int tid) {
    const int l = it / 96, ct = it % 96, lane = tid & 63, w = tid >> 6;
    for (int i = tid; i < 5 * D; i += NT) { const int v = i >> 11, k = i & (D - 1); const float cv = v < 4 ? c[v * D + k] : cctx[k]; sv[i] = cv / (1.0f + expf(-cv)); }
    __syncthreads();
    const float* wp = adaw + (size_t)l * D * ADA + (size_t)(256 * w) * ADA + ct * 64 + lane;
    float acc[5] = {0.f, 0.f, 0.f, 0.f, 0.f};
#pragma unroll 1
    for (int k0 = 0; k0 < 256; k0 += 32) {
        float wv[32];
#pragma unroll
        for (int k = 0; k < 32; ++k) wv[k] = wp[(size_t)(k0 + k) * ADA];
#pragma unroll
        for (int k4 = 0; k4 < 32; k4 += 4) {
#pragma unroll
            for (int v = 0; v < 5; ++v) { const f32x4 s4 = *(const LAS f32x4*)(sv + v * D + 256 * w + k0 + k4);
                acc[v] += s4.x * wv[k4]; acc[v] += s4.y * wv[k4 + 1]; acc[v] += s4.z * wv[k4 + 2]; acc[v] += s4.w * wv[k4 + 3]; } } }
    LAS float* part = sv + 5 * D;
#pragma unroll
    for (int v = 0; v < 5; ++v) part[(w * 5 + v) * 64 + lane] = acc[v];
    __syncthreads();
    if (tid < 320) { const int v = tid >> 6; float s = adab[l * ADA + ct * 64 + lane];
#pragma unroll
        for (int ww = 0; ww < 8; ++ww) s += part[(ww * 5 + v) * 64 + lane];
        MOD[(size_t)(l * 5 + v) * ADA + ct * 64 + lane] = s; }
    __syncthreads();
}

__device__ __forceinline__ void prep_hymlp(const DArgs& a, float* H3out, bf16_t* H3b, int l, int Lx, int t0, LAS unsigned char* lds, int tid) {
    LAS float* zs = (LAS float*)lds;
    LAS float* h1 = (LAS float*)(lds + 4608);
    LAS float* h2 = (LAS float*)(lds + 4608 + 8192);
    LAS float* w1s = (LAS float*)(lds + 24576);
    LAS float* w2s = w1s + 33 * 64;
    LAS float* w3s = w2s + 64 * 64;
    { const float* w1 = a.in[I_HW1] + (size_t)l * 33 * 64; const float* w2 = a.in[I_HW2] + (size_t)l * 64 * 64; const float* w3 = a.in[I_HW3] + (size_t)l * 64 * 64;
      for (int i = tid; i < 33 * 64; i += NT) w1s[i] = w1[i];
      for (int i = tid; i < 64 * 64; i += NT) { w2s[i] = w2[i]; w3s[i] = w3[i]; } }
    for (int i = tid; i < 32 * 33; i += NT) { const int pos = i / 33, f = i % 33, t = t0 + pos;
        float z;
        if (f == 0) z = (float)t / (float)(Lx - 1);
        else { const int j = (f - 1) & 15; const float fj = 1e-4f + (float)j * ((15.0f - 1e-4f) / 15.0f); const float wpos = (6.283185307179586f * (float)t) / (float)Lx; const float arg = fj * wpos;
               z = (f <= 16) ? cosf(arg) : -sinf(arg); }
        zs[pos * 36 + f] = z; }
    __syncthreads();
    const int pos = tid >> 4, f4 = (tid & 15) * 4, t = t0 + pos;
    f32x4 s = *(const f32x4*)(a.in[I_HB1] + l * 64 + f4);
#pragma unroll 3
    for (int j = 0; j < 33; ++j) s += zs[pos * 36 + j] * *(const LAS f32x4*)(w1s + j * 64 + f4);
    { const f32x4 fr = *(const f32x4*)(a.in[I_HF1] + l * 64 + f4); *(LAS f32x4*)(h1 + pos * 64 + f4) = (f32x4){sinf(fr.x * s.x), sinf(fr.y * s.y), sinf(fr.z * s.z), sinf(fr.w * s.w)}; }
    __syncthreads();
    s = *(const f32x4*)(a.in[I_HB2] + l * 64 + f4);
#pragma unroll 4
    for (int j = 0; j < 64; ++j) s += h1[pos * 64 + j] * *(const LAS f32x4*)(w2s + j * 64 + f4);
    { const f32x4 fr = *(const f32x4*)(a.in[I_HF2] + l * 64 + f4); *(LAS f32x4*)(h2 + pos * 64 + f4) = (f32x4){sinf(fr.x * s.x), sinf(fr.y * s.y), sinf(fr.z * s.z), sinf(fr.w * s.w)}; }
    __syncthreads();
    s = *(const f32x4*)(a.in[I_HB3] + l * 64 + f4);
#pragma unroll 4
    for (int j = 0; j < 64; ++j) s += h2[pos * 64 + j] * *(const LAS f32x4*)(w3s + j * 64 + f4);
    { const f32x4 fr = *(const f32x4*)(a.in[I_HF3] + l * 64 + f4); const f32x4 hv = (f32x4){sinf(fr.x * s.x), sinf(fr.y * s.y), sinf(fr.z * s.z), sinf(fr.w * s.w)}; *(f32x4*)(H3out + (size_t)t * 64 + f4) = hv;
      if (H3b) { u32x2 pk; pk.x = pk2(hv.x, hv.y); pk.y = pk2(hv.z, hv.w); *(u32x2*)(H3b + (size_t)t * 64 + f4) = pk; } }
    __syncthreads();
}

__device__ __forceinline__ void transpose_item(const float* W, int ldw, int srccol_lane  , int k0, bf16_t* WT, int K, int dstrow0, LAS float* scr, int lane) {
    float wv[32];
#pragma unroll
    for (int i = 0; i < 32; ++i) { const int kk = 2 * i + (lane >> 5); wv[i] = srccol_lane >= 0 ? W[(size_t)(k0 + kk) * ldw + srccol_lane] : 0.f; }
#pragma unroll
    for (int i = 0; i < 32; ++i) { const int kk = 2 * i + (lane >> 5); scr[kk * 33 + (lane & 31)] = wv[i]; }
    LDS_WAIT();
    const int c = lane & 7;
#pragma unroll
    for (int j = 0; j < 4; ++j) { const int n = (lane >> 3) + 8 * j; const LAS float* s = scr + (8 * c) * 33 + n;
        u32x4 o; o.x = pk2(s[0 * 33], s[1 * 33]); o.y = pk2(s[2 * 33], s[3 * 33]); o.z = pk2(s[4 * 33], s[5 * 33]); o.w = pk2(s[6 * 33], s[7 * 33]);
        *(u32x4*)(WT + (size_t)(dstrow0 + n) * K + k0 + 8 * c) = o; }
    LDS_WAIT();
}
__device__ __forceinline__ int win_srccol(int n) {
    if (n >= 3072 && n < 4096) { const int u = (n - 3072) & 127, grp = u >> 3, e = u & 7; return (n & ~127) + (e < 4 ? 4 * grp + e : 64 + 4 * grp + (e - 4)); }
    return n < 6144 ? n : n + 32;
}

__device__ __forceinline__ void norm_row(const float* xrow, const float* nw, const float* mod, bf16_t* hrow, int lane) {
    f32x4 v[8]; float ss = 0.f;
#pragma unroll
    for (int j = 0; j < 8; ++j) { v[j] = ((const f32x4*)xrow)[lane + 64 * j]; ss += (v[j].x * v[j].x + v[j].y * v[j].y) + (v[j].z * v[j].z + v[j].w * v[j].w); }
    const float rstd = rsqrtf(wave_sum(ss) * (1.0f / D) + EPS);
#pragma unroll
    for (int j = 0; j < 8; ++j) { const int k = 4 * (lane + 64 * j);
        const f32x4 w = *(const f32x4*)(nw + k), sh = *(const f32x4*)(mod + k), sc = *(const f32x4*)(mod + D + k);
        const f32x4 o = v[j] * rstd * w * (sc + 1.0f) + sh;
        u32x2 pk; pk.x = pk2(o.x, o.y); pk.y = pk2(o.z, o.w);
        *(u32x2*)(hrow + k) = pk; }
}

__device__ __forceinline__ void norm_row_bf(const bf16_t* xrow, const float* nw, const float* mod, bf16_t* hrow, int lane) {
    u32x4 raw[4]; float ss = 0.f;
#pragma unroll
    for (int j = 0; j < 4; ++j) raw[j] = ((const u32x4*)xrow)[lane + 64 * j];
#pragma unroll
    for (int j = 0; j < 4; ++j) { float f[8]; unpack8(raw[j], f);
#pragma unroll
        for (int x = 0; x < 8; ++x) ss += f[x] * f[x]; }
    const float rstd = rsqrtf(wave_sum(ss) * (1.0f / D) + EPS);
#pragma unroll
    for (int j = 0; j < 4; ++j) { const int k = 8 * (lane + 64 * j); float f[8], o[8]; unpack8(raw[j], f);
#pragma unroll
        for (int h = 0; h < 2; ++h) { const f32x4 w = *(const f32x4*)(nw + k + 4 * h), sh = *(const f32x4*)(mod + k + 4 * h), sc = *(const f32x4*)(mod + D + k + 4 * h);
#pragma unroll
            for (int x = 0; x < 4; ++x) o[4 * h + x] = f[4 * h + x] * rstd * w[x] * (sc[x] + 1.0f) + sh[x]; }
        *(u32x4*)(hrow + k) = pack8(o); }
}

__device__ __forceinline__ float block_sum(float v, LAS float* red, int tid) {
    v = wave_sum(v);
    if ((tid & 63) == 0) red[tid >> 6] = v;
    __syncthreads();
    float t = 0.f;
#pragma unroll
    for (int i = 0; i < NWAVES; ++i) t += red[i];
    __syncthreads();
    return t;
}
constexpr float HY_D0 = -3.0701134573253945f  , HY_D1 = -15.350567286626973f  ;

__device__ __forceinline__ void filt_ctx_item(const DArgs& a, unsigned char* ws, LAS unsigned char* lds, int c, int tid) {
    LAS float* w4s = (LAS float*)lds; LAS float* red = (LAS float*)(lds + 1024);
    if (tid < 256) { const int cc = tid >> 6, f = tid & 63; w4s[tid] = a.in[I_HW4][(size_t)f * 2048 + (cc >> 1) * 1024 + (cc & 1) * 512 + c]; }
    __syncthreads();
    const float dl = fabsf(HY_D0 + (HY_D1 - HY_D0) * ((float)c / 511.0f));
    const float* H3C = (const float*)(ws + WS_H3C);
    const int n = tid, dir = n >= 256 ? 1 : 0, t = dir ? (512 - n) : n;
    float s0 = 0.f, s1 = 0.f;
    if (n != 256) {
        const f32x4* hr = (const f32x4*)(H3C + (size_t)t * 64);
#pragma unroll
        for (int q = 0; q < 16; ++q) { const f32x4 hv = hr[q]; const f32x4 wa = ((const LAS f32x4*)(w4s + (dir * 2 + 0) * 64))[q], wb = ((const LAS f32x4*)(w4s + (dir * 2 + 1) * 64))[q];
            s0 += (hv.x * wa.x + hv.y * wa.y) + (hv.z * wa.z + hv.w * wa.w); s1 += (hv.x * wb.x + hv.y * wb.y) + (hv.z * wb.z + hv.w * wb.w); }
        const float dec = expf(-((float)t / 255.0f) * dl); s0 *= dec; s1 *= dec;
    }
    const float rs0 = rsqrtf(block_sum(s0 * s0, red, tid) + EPS), rs1 = rsqrtf(block_sum(s1 * s1, red, tid) + EPS);
    float* KC = (float*)(ws + WS_KC);
    KC[(size_t)(0 * 512 + c) * 512 + n] = s0 * rs0; KC[(size_t)(1 * 512 + c) * 512 + n] = s1 * rs1;
    __syncthreads();
}

__device__ __forceinline__ void prep_rope(f32x2* RT, int it, int tid) {
    const int idx = it * NT + tid, pos = idx >> 6, j = idx & 63;
    float ang;
    if (pos < SEQL) { const float inv = exp2f(-(float)(j & 31) * (13.287712379549449f / 32.0f)); ang = (float)(j < 32 ? (pos >> 6) : (pos & 63)) * inv; }
    else { const float inv = exp2f(-(float)j * (13.287712379549449f / 64.0f)); ang = (float)(pos - SEQL) * inv; }
    float sn, cs; sincosf(ang, &sn, &cs);
    RT[idx] = (f32x2){cs, sn};
}

__device__ __forceinline__ float sconv3(const bf16_t* p, int t, int Lx, float w0, float w1, float w2, float cb) {
    const float x0 = t > 0 ? bf2f(p[t - 1]) : 0.f, x1 = bf2f(p[t]), x2 = t < Lx - 1 ? bf2f(p[t + 1]) : 0.f;
    return w0 * x0 + w1 * x1 + w2 * x2 + cb;
}
__device__ __forceinline__ void ctx_conv256(const LAS float* kc, const LAS float* z, int b, int t4, int half, float (&o)[4]) {
    o[0] = o[1] = o[2] = o[3] = 0.f;
#pragma unroll 4
    for (int s4 = 0; s4 < 32; ++s4) { const int s = 128 * half + 4 * s4, d = 4 * t4 - s;
        const f32x4 zv = *(const LAS f32x4*)(z + b * 256 + s);
        const f32x4 wl = *(const LAS f32x4*)(kc + ((d - 4) & 511)), wh = *(const LAS f32x4*)(kc + (d & 511));
        const float w[8] = {wl.x, wl.y, wl.z, wl.w, wh.x, wh.y, wh.z, wh.w};
        const float zz[4] = {zv.x, zv.y, zv.z, zv.w};
#pragma unroll
        for (int j = 0; j < 4; ++j)
#pragma unroll
            for (int i = 0; i < 4; ++i) o[j] += w[4 + j - i] * zz[i]; }
}
__device__ __forceinline__ void hyena_ctx_item(const DArgs& a, unsigned char* ws, LAS unsigned char* lds, int c, int tid) {
    LAS float* kc = (LAS float*)lds; LAS float* za = (LAS float*)(lds + 4096); LAS float* zb = (LAS float*)(lds + 8192); LAS float* part = (LAS float*)(lds + 12288);
    const float* KC = (const float*)(ws + WS_KC);
    kc[tid] = KC[(size_t)(0 * 512 + c) * 512 + tid]; kc[512 + tid] = KC[(size_t)(1 * 512 + c) * 512 + tid];
    const float* cw = a.in[I_HCW]; const float* cbp = a.in[I_HCB];
    const float wv0 = cw[c], wv1 = cw[1536 + c], wv2 = cw[3072 + c], bv = cbp[c];
    const float wa0 = cw[512 + c], wa1 = cw[1536 + 512 + c], wa2 = cw[3072 + 512 + c], ba = cbp[512 + c];
    const float wb0 = cw[1024 + c], wb1 = cw[1536 + 1024 + c], wb2 = cw[3072 + 1024 + c], bb = cbp[1024 + c];
    const float bias0 = a.in[I_HBIAS][0 * 512 + c], bias1 = a.in[I_HBIAS][1 * 512 + c];
    const bf16_t* PT = (const bf16_t*)(ws + WS_PT);
    const int half = tid >> 8, b = (tid >> 6) & 3, t4 = tid & 63; const int rb = NLAT + b * LC;
    const bf16_t* pv = PT + (size_t)(PT_V + c) * MR + rb; const bf16_t* pg1 = PT + (size_t)(PT_G1 + c) * MR + rb; const bf16_t* pg2 = PT + (size_t)(PT_G2 + c) * MR + rb; const bf16_t* phg = PT + (size_t)(PT_HG + c) * MR + rb;
    bf16_t* GATED = (bf16_t*)(ws + WS_H);
    float z0[4], z1[4], o[4], g1v[4], g2v[4], hgv[4];
#pragma unroll
    for (int j = 0; j < 4; ++j) { z0[j] = sconv3(pv, 4 * t4 + j, LC, wv0, wv1, wv2, bv); g1v[j] = sconv3(pg1, 4 * t4 + j, LC, wa0, wa1, wa2, ba); g2v[j] = sconv3(pg2, 4 * t4 + j, LC, wb0, wb1, wb2, bb); hgv[j] = bf2f(phg[4 * t4 + j]); }
    if (half == 0) *(LAS f32x4*)(za + b * 256 + 4 * t4) = (f32x4){z0[0], z0[1], z0[2], z0[3]};
    __syncthreads();
    ctx_conv256(kc, za, b, t4, half, o);
    if (half == 1) *(LAS f32x4*)(part + b * 256 + 4 * t4) = (f32x4){o[0], o[1], o[2], o[3]};
    __syncthreads();
    if (half == 0) { const f32x4 pp = *(const LAS f32x4*)(part + b * 256 + 4 * t4); const float ps[4] = {pp.x, pp.y, pp.z, pp.w};
#pragma unroll
        for (int j = 0; j < 4; ++j) z1[j] = g1v[j] * (o[j] + ps[j] + bias0 * z0[j]);
        *(LAS f32x4*)(zb + b * 256 + 4 * t4) = (f32x4){z1[0], z1[1], z1[2], z1[3]}; }
    __syncthreads();
    ctx_conv256(kc + 512, zb, b, t4, half, o);
    if (half == 1) *(LAS f32x4*)(part + b * 256 + 4 * t4) = (f32x4){o[0], o[1], o[2], o[3]};
    __syncthreads();
    if (half == 0) { const f32x4 pp = *(const LAS f32x4*)(part + b * 256 + 4 * t4); const float ps[4] = {pp.x, pp.y, pp.z, pp.w};
#pragma unroll
        for (int j = 0; j < 4; ++j) { const int t = 4 * t4 + j; const float z2 = g2v[j] * (o[j] + ps[j] + bias1 * z1[j]);
            GATED[(size_t)(rb + t) * D + 512 + c] = (bf16_t)f2bf(z2 * siluf_(hgv[j])); } }
    __syncthreads();
}

struct EpiInProj {
    static constexpr bool PERM = true, AFTER_DRAIN = false;
    bf16_t* P; bf16_t* PT; float* LR; const float* RT;
    __device__ __forceinline__ void operator()(const pg8::f32x4 (&acc)[2][2][4][2], const pg8::Unit& u, int wr, int wc, int fr, int fq) const {
        const int row0 = u.pm * 256 + wr * 64 + fr, pn = u.pn;
        if (pn >= 12 && pn < 16) {
            const int colbase = pn * 256 - 2048 + wc * 32 + 8 * fq; const int j0 = 4 * (4 * wc + fq); const float ksc = pn >= 14 ? 0.08838834764831845f : 1.0f;
#pragma unroll
            for (int ai = 0; ai < 2; ++ai)
#pragma unroll
                for (int m = 0; m < 4; ++m) { const int row = row0 + ai * 128 + m * 16; const int pos = row < NLAT ? (row & (SEQL - 1)) : SEQL + ((row - NLAT) & (LC - 1));
                    const pg8::f32x4 t0 = *(const pg8::f32x4*)(RT + ((size_t)pos * 64 + j0) * 2), t1 = *(const pg8::f32x4*)(RT + ((size_t)pos * 64 + j0) * 2 + 4);
                    bf16_t* rowp = P + (size_t)row * LDP + colbase;
#pragma unroll
                    for (int bj = 0; bj < 2; ++bj) { const pg8::f32x4 x1 = acc[ai][bj][m][0] * ksc, x2 = acc[ai][bj][m][1] * ksc;
                        u32x4 w; w.x = pk2(x1[0] * t0[0] - x2[0] * t0[1], x1[1] * t0[2] - x2[1] * t0[3]); w.y = pk2(x1[2] * t1[0] - x2[2] * t1[1], x1[3] * t1[2] - x2[3] * t1[3]);
                        w.z = pk2(x1[0] * t0[1] + x2[0] * t0[0], x1[1] * t0[3] + x2[1] * t0[2]); w.w = pk2(x1[2] * t1[1] + x2[2] * t1[0], x1[3] * t1[3] + x2[3] * t1[2]);
                        __builtin_nontemporal_store(w, (u32x4*)(rowp + bj * 128)); } }
        } else if (pn < 4 || (pn >= 16 && pn < 26)) {
            const int colbase = (pn < 4 ? pn * 256 : pn * 256 - 2048) + wc * 32 + 8 * fq;
#pragma unroll
            for (int ai = 0; ai < 2; ++ai)
#pragma unroll
                for (int m = 0; m < 4; ++m) { bf16_t* rowp = P + (size_t)(row0 + ai * 128 + m * 16) * LDP + colbase;
#pragma unroll
                    for (int bj = 0; bj < 2; ++bj) { const pg8::f32x4 v0 = acc[ai][bj][m][0], v1 = acc[ai][bj][m][1];
                        u32x4 w; w.x = pk2(v0[0], v0[1]); w.y = pk2(v0[2], v0[3]); w.z = pk2(v1[0], v1[1]); w.w = pk2(v1[2], v1[3]);
                        __builtin_nontemporal_store(w, (u32x4*)(rowp + bj * 128)); } }
        } else if (pn < 12) {
            const int prow0 = (pn - 4) * 256 + wr * 64 + fr, tok0 = u.pm * 256 + wc * 32 + 8 * fq;
#pragma unroll
            for (int ai = 0; ai < 2; ++ai)
#pragma unroll
                for (int m = 0; m < 4; ++m) { bf16_t* rowp = PT + (size_t)(prow0 + ai * 128 + m * 16) * MR + tok0;
#pragma unroll
                    for (int bj = 0; bj < 2; ++bj) { const pg8::f32x4 v0 = acc[ai][bj][m][0], v1 = acc[ai][bj][m][1];
                        u32x4 w; w.x = pk2(v0[0], v0[1]); w.y = pk2(v0[2], v0[3]); w.z = pk2(v1[0], v1[1]); w.w = pk2(v1[2], v1[3]);
                        __builtin_nontemporal_store(w, (u32x4*)(rowp + bj * 128)); } }
        }
    }
};
struct EpiGlu {
    static constexpr bool PERM = true, AFTER_DRAIN = false;
    const bf16_t* GG; bf16_t* GATED; const float* bias;
    __device__ __forceinline__ void operator()(const pg8::f32x4 (&acc)[2][2][4][2], const pg8::Unit& u, int wr, int wc, int fr, int fq) const {
        const int row0 = u.pm * 256 + wr * 64 + fr, col0 = u.pn * 256 + wc * 32 + 8 * fq;
        pg8::f32x4 b0[2], b1[2];
#pragma unroll
        for (int bj = 0; bj < 2; ++bj) { b0[bj] = *(const pg8::f32x4*)(bias + col0 + bj * 128); b1[bj] = *(const pg8::f32x4*)(bias + col0 + bj * 128 + 4); }
#pragma unroll
        for (int ai = 0; ai < 2; ++ai) {
            u32x4 gg[4][2];
#pragma unroll
            for (int m = 0; m < 4; ++m)
#pragma unroll
                for (int bj = 0; bj < 2; ++bj) gg[m][bj] = *(const u32x4*)(GG + (size_t)(row0 + ai * 128 + m * 16) * 512 + col0 + bj * 128);
#pragma unroll
            for (int m = 0; m < 4; ++m) { const size_t row = (size_t)(row0 + ai * 128 + m * 16);
#pragma unroll
                for (int bj = 0; bj < 2; ++bj) { float g[8], res[8]; unpack8(gg[m][bj], g);
#pragma unroll
                    for (int j = 0; j < 4; ++j) { res[j] = g[j] * sigmoidf_(acc[ai][bj][m][0][j] + b0[bj][j]); res[4 + j] = g[4 + j] * sigmoidf_(acc[ai][bj][m][1][j] + b1[bj][j]); }
                    *(u32x4*)(GATED + row * D + col0 + bj * 128) = pack8(res); } }
            asm volatile("" ::: "memory");
        }
    }
};
struct EpiOut {
    static constexpr bool PERM = true, AFTER_DRAIN = false;
    const float* xl_old_f; const bf16_t* xl_old_b; const float* xc_old; bf16_t* xl_new; float* xc_new; const float* mod;
    __device__ __forceinline__ void operator()(const pg8::f32x4 (&acc)[2][2][4][2], const pg8::Unit& u, int wr, int wc, int fr, int fq) const {
        const int row0 = u.pm * 256 + wr * 64 + fr, col0 = u.pn * 256 + wc * 32 + 8 * fq;
        const bool lat = u.pm < 64;
#pragma unroll
        for (int ai = 0; ai < 2; ++ai) {
            const int v = lat ? ((u.pm * 256 + ai * 128) >> 12) : 4;
            const float* gt = mod + (size_t)v * ADA + 2 * D + col0;
            pg8::f32x4 gv[2][2];
#pragma unroll
            for (int bj = 0; bj < 2; ++bj) { gv[bj][0] = *(const pg8::f32x4*)(gt + bj * 128); gv[bj][1] = *(const pg8::f32x4*)(gt + bj * 128 + 4); }
            if (lat) {
                if (xl_old_f) {
#pragma unroll
                    for (int m = 0; m < 4; ++m) { const size_t off = (size_t)(row0 + ai * 128 + m * 16) * D + col0;
#pragma unroll
                        for (int bj = 0; bj < 2; ++bj) { const pg8::f32x4 x0 = *(const pg8::f32x4*)(xl_old_f + off + bj * 128), x1 = *(const pg8::f32x4*)(xl_old_f + off + bj * 128 + 4);
                            const pg8::f32x4 r0 = x0 + gv[bj][0] * acc[ai][bj][m][0], r1 = x1 + gv[bj][1] * acc[ai][bj][m][1];
                            u32x4 w; w.x = pk2(r0[0], r0[1]); w.y = pk2(r0[2], r0[3]); w.z = pk2(r1[0], r1[1]); w.w = pk2(r1[2], r1[3]);
                            *(u32x4*)(xl_new + off + bj * 128) = w; } }
                } else {
#pragma unroll
                    for (int m = 0; m < 4; ++m) { const size_t off = (size_t)(row0 + ai * 128 + m * 16) * D + col0;
#pragma unroll
                        for (int bj = 0; bj < 2; ++bj) { float xo[8]; unpack8(*(const u32x4*)(xl_old_b + off + bj * 128), xo);
                            const pg8::f32x4 a0 = acc[ai][bj][m][0], a1 = acc[ai][bj][m][1];
                            u32x4 w; w.x = pk2(xo[0] + gv[bj][0][0] * a0[0], xo[1] + gv[bj][0][1] * a0[1]); w.y = pk2(xo[2] + gv[bj][0][2] * a0[2], xo[3] + gv[bj][0][3] * a0[3]);
                            w.z = pk2(xo[4] + gv[bj][1][0] * a1[0], xo[5] + gv[bj][1][1] * a1[1]); w.w = pk2(xo[6] + gv[bj][1][2] * a1[2], xo[7] + gv[bj][1][3] * a1[3]);
                            *(u32x4*)(xl_new + off + bj * 128) = w; } }
                }
            } else {
#pragma unroll
                for (int m = 0; m < 4; ++m) { const size_t off = (size_t)(row0 - NLAT + ai * 128 + m * 16) * D + col0;
#pragma unroll
                    for (int bj = 0; bj < 2; ++bj) { const pg8::f32x4 x0 = *(const pg8::f32x4*)(xc_old + off + bj * 128), x1 = *(const pg8::f32x4*)(xc_old + off + bj * 128 + 4);
                        *(pg8::f32x4*)(xc_new + off + bj * 128) = x0 + gv[bj][0] * acc[ai][bj][m][0]; *(pg8::f32x4*)(xc_new + off + bj * 128 + 4) = x1 + gv[bj][1] * acc[ai][bj][m][1]; } }
            }
        }
    }
};
typedef short bf16x8 __attribute__((ext_vector_type(8)));
typedef short bf16x4 __attribute__((ext_vector_type(4)));
__device__ __forceinline__ unsigned off_b(unsigned row, unsigned ch) { return 256u * row + 16u * (ch ^ (((row & 3) << 2) | ((row >> 2) & 3))); }
__device__ __forceinline__ bf16x8 img_row_frag(const LAS unsigned char* img, unsigned lane, unsigned rb, unsigned s) { return *(const LAS bf16x8*)(img + off_b((lane & 15) + 16 * rb, 4 * s + (lane >> 4))); }
__device__ __forceinline__ bf16x4 img_tr4(const LAS unsigned char* img, unsigned lane, unsigned c, unsigned row0) {
    const unsigned q = (lane & 15) >> 2, p = lane & 3;
    return __builtin_amdgcn_ds_read_tr16_b64_v4i16((LAS bf16x4*)(img + off_b(row0 + q, 2 * c + (p >> 1)) + 8 * (p & 1)));
}
__device__ __forceinline__ bf16x8 img_tr_frag(const LAS unsigned char* img, unsigned lane, unsigned c, unsigned ks) {
    const unsigned g = lane >> 4; const bf16x4 lo = img_tr4(img, lane, c, 32 * ks + 8 * g), hi = img_tr4(img, lane, c, 32 * ks + 8 * g + 4);
    return __builtin_shufflevector(lo, hi, 0, 1, 2, 3, 4, 5, 6, 7);
}
__device__ __forceinline__ bf16x8 img_tr_frag_acc(const LAS unsigned char* img, unsigned lane, unsigned c, unsigned ks) {
    const unsigned g = lane >> 4; const bf16x4 lo = img_tr4(img, lane, c, 32 * ks + 4 * g), hi = img_tr4(img, lane, c, 32 * ks + 16 + 4 * g);
    return __builtin_shufflevector(lo, hi, 0, 1, 2, 3, 4, 5, 6, 7);
}
__device__ __forceinline__ bf16x8 acc_pair_frag(const f32x4 a0, const f32x4 a1) {
    u32x4 w; w.x = pk2(a0.x, a0.y); w.y = pk2(a0.z, a0.w); w.z = pk2(a1.x, a1.y); w.w = pk2(a1.z, a1.w);
    return __builtin_bit_cast(bf16x8, w);
}
#define MFMA16(A_, B_, C_) __builtin_amdgcn_mfma_f32_16x16x32_bf16((A_), (B_), (C_), 0, 0, 0)
__device__ __forceinline__ void stage_tile128(LAS unsigned char* img, const bf16_t* g, size_t ld, int tid) {
#pragma unroll
    for (int i = 0; i < 4; ++i) { const int n = tid + NT * i, row = n >> 4, ch = n & 15; *(LAS u32x4*)(img + off_b(row, ch)) = *(const u32x4*)(g + (size_t)row * ld + ch * 8); }
}

constexpr int RCH = 128, RNCH = 34;
constexpr size_t WS_RST = WS_OB;
__device__ __forceinline__ int ret_rowbase(int b, int cc) { return cc < 2 ? NLAT + b * LC + cc * RCH : b * SEQL + (cc - 2) * RCH; }
__device__ __forceinline__ float ret_log2g(int h) { return log2f(1.0f - exp2f(-5.0f - (float)h)); }

__device__ __forceinline__ void ret_passA(unsigned char* ws, LAS unsigned char* lds, int item, int tid) {
    const int bh = item / RNCH, cc = item % RNCH, b = bh >> 2, h = bh & 3;
    const int lane = tid & 63, w = tid >> 6, g = lane >> 4;
    LAS unsigned char* KF = lds; LAS unsigned char* KB = lds + 32768; LAS unsigned char* VI = lds + 65536;
    const bf16_t* P = (const bf16_t*)(ws + WS_P) + (size_t)ret_rowbase(b, cc) * LDP;
    const float l2g = ret_log2g(h);
    __syncthreads();
#pragma unroll
    for (int i = 0; i < 4; ++i) { const int n = tid + NT * i, row = n >> 4, ch = n & 15;
        const u32x4 kr = *(const u32x4*)(P + (size_t)row * LDP + PC_RK + h * 128 + ch * 8);
        float kf[8], a[8], c[8]; unpack8(kr, kf);
        const float sf = exp2f(l2g * (float)(RCH - 1 - row)), sb = exp2f(l2g * (float)row);
#pragma unroll
        for (int x = 0; x < 8; ++x) { a[x] = kf[x] * sf; c[x] = kf[x] * sb; }
        *(LAS u32x4*)(KF + off_b(row, ch)) = pack8(a); *(LAS u32x4*)(KB + off_b(row, ch)) = pack8(c);
        *(LAS u32x4*)(VI + off_b(row, ch)) = *(const u32x4*)(P + (size_t)row * LDP + PC_RV + h * 128 + ch * 8); }
    __syncthreads();
    bf16x8 af[4], ab[4];
#pragma unroll
    for (int ks = 0; ks < 4; ++ks) { af[ks] = img_tr_frag(KF, lane, w, ks); ab[ks] = img_tr_frag(KB, lane, w, ks); }
    bf16_t* ST = (bf16_t*)(ws + WS_RST) + ((size_t)(bh * 2) * RNCH + cc) * (128 * 128);
#pragma unroll 2
    for (int E = 0; E < 8; ++E) {
        f32x4 cf = {0.f, 0.f, 0.f, 0.f}, cb = {0.f, 0.f, 0.f, 0.f};
#pragma unroll
        for (int ks = 0; ks < 4; ++ks) { const bf16x8 vb = img_tr_frag(VI, lane, E, ks); cf = MFMA16(af[ks], vb, cf); cb = MFMA16(ab[ks], vb, cb); }
        const int e = 16 * E + (lane & 15), d0 = 16 * w + 4 * g;
        u32x2 o; o.x = pk2(cf.x, cf.y); o.y = pk2(cf.z, cf.w); *(u32x2*)(ST + (size_t)e * 128 + d0) = o;
        o.x = pk2(cb.x, cb.y); o.y = pk2(cb.z, cb.w); *(u32x2*)(ST + (size_t)RNCH * 128 * 128 + (size_t)e * 128 + d0) = o;
    }
}
__device__ __forceinline__ void ret_passB(unsigned char* ws, int gt  ) {
    const int el = gt & 2047, bd = gt >> 11, bh = bd >> 1, dir = bd & 1, h = bh & 3;
    const float gC = exp2f(ret_log2g(h) * (float)RCH);
    bf16_t* base = (bf16_t*)(ws + WS_RST) + (size_t)bd * RNCH * (128 * 128) + (size_t)el * 8;
    float acc[8];
#pragma unroll
    for (int x = 0; x < 8; ++x) acc[x] = 0.f;
#pragma unroll 1
    for (int s0 = 0; s0 < RNCH; s0 += 17) {
        u32x4 kvr[17];
#pragma unroll
        for (int j = 0; j < 17; ++j) { const int s = s0 + j; const int cc = dir == 0 ? s : (s < 2 ? 1 - s : 35 - s); kvr[j] = *(const u32x4*)(base + (size_t)cc * (128 * 128)); }
#pragma unroll
        for (int j = 0; j < 17; ++j) { const int s = s0 + j; const int cc = dir == 0 ? s : (s < 2 ? 1 - s : 35 - s);
            float kv[8]; unpack8(kvr[j], kv);
            *(u32x4*)(base + (size_t)cc * (128 * 128)) = pack8(acc);
#pragma unroll
            for (int x = 0; x < 8; ++x) acc[x] = gC * acc[x] + kv[x]; }
    }
}
__device__ __forceinline__ void ret_passC(const DArgs& a, unsigned char* ws, LAS unsigned char* lds, int l, int item, int tid) {
    const int bh = item / RNCH, cc = item % RNCH, b = bh >> 2, h = bh & 3;
    const int lane = tid & 63, w = tid >> 6, g = lane >> 4, il = lane & 15;
    LAS unsigned char* KI = lds; LAS unsigned char* VI = lds + 32768; LAS unsigned char* SF = lds + 65536; LAS unsigned char* SB = lds + 98304;
    const int rowbase = ret_rowbase(b, cc);
    const bf16_t* P = (const bf16_t*)(ws + WS_P) + (size_t)rowbase * LDP;
    const bf16_t* STf = (const bf16_t*)(ws + WS_RST) + ((size_t)(bh * 2) * RNCH + cc) * (128 * 128);
    const bf16_t* STb = STf + (size_t)RNCH * 128 * 128;
    __syncthreads();
    stage_tile128(KI, P + PC_RK + h * 128, LDP, tid); stage_tile128(VI, P + PC_RV + h * 128, LDP, tid);
    stage_tile128(SF, STf, 128, tid); stage_tile128(SB, STb, 128, tid);
    bf16x8 qf[4];
    { const bf16_t* qr = P + (size_t)(16 * w + il) * LDP + PC_RQ + h * 128 + 8 * g;
#pragma unroll
      for (int ks = 0; ks < 4; ++ks) qf[ks] = *(const bf16x8*)(qr + 32 * ks); }
    const int iloc = 16 * w + il;
    u32x2 grv[8]; f32x4 nvv[8];
    { const bf16_t* gp0 = (const bf16_t*)(ws + WS_P) + ((size_t)rowbase + iloc) * LDP + PC_RG + h * 128 + 4 * g; const float* nw0 = a.in[I_RNW] + l * 512 + h * 128 + 4 * g;
#pragma unroll
      for (int E = 0; E < 8; ++E) { grv[E] = *(const u32x2*)(gp0 + 16 * E); nvv[E] = *(const f32x4*)(nw0 + 16 * E); } }
    __syncthreads();
    const float l2g = ret_log2g(h);
    f32x4 o[8];
    { const float sf = exp2f(l2g * (float)(iloc + 1)), sb = exp2f(l2g * (float)(RCH - iloc));
#pragma unroll
      for (int E = 0; E < 8; ++E) { f32x4 rf = {0.f, 0.f, 0.f, 0.f}, rb = {0.f, 0.f, 0.f, 0.f};
#pragma unroll
          for (int ks = 0; ks < 4; ++ks) { rf = MFMA16(img_row_frag(SF, lane, E, ks), qf[ks], rf); rb = MFMA16(img_row_frag(SB, lane, E, ks), qf[ks], rb); }
          o[E] = rf * sf + rb * sb; } }
    f32x4 at[8];
#pragma unroll
    for (int T = 0; T < 8; ++T) { f32x4 c = {0.f, 0.f, 0.f, 0.f};
#pragma unroll
        for (int ks = 0; ks < 4; ++ks) c = MFMA16(img_row_frag(KI, lane, T, ks), qf[ks], c);
#pragma unroll
        for (int r = 0; r < 4; ++r) { const int j = 16 * T + 4 * g + r; const int dd = iloc > j ? iloc - j : j - iloc; c[r] *= (dd == 0 ? 2.0f : exp2f(l2g * (float)dd)); }
        at[T] = c; }
#pragma unroll
    for (int s = 0; s < 4; ++s) { const bf16x8 bfr = acc_pair_frag(at[2 * s], at[2 * s + 1]);
#pragma unroll
        for (int E = 0; E < 8; ++E) o[E] = MFMA16(img_tr_frag_acc(VI, lane, E, s), bfr, o[E]); }
    float ss = 0.f;
#pragma unroll
    for (int E = 0; E < 8; ++E) ss += (o[E].x * o[E].x + o[E].y * o[E].y) + (o[E].z * o[E].z + o[E].w * o[E].w);
    ss += __shfl_xor(ss, 16); ss += __shfl_xor(ss, 32);
    const float rn = rsqrtf(ss * (1.0f / 128.0f) + EPS);
    const size_t row = (size_t)rowbase + iloc;
    const bf16_t* gp = (const bf16_t*)(ws + WS_P) + row * LDP + PC_RG + h * 128 + 4 * g;
    const float* nw = a.in[I_RNW] + l * 512 + h * 128 + 4 * g;
    bf16_t* op = (bf16_t*)(ws + WS_H) + row * D + 1024 + h * 128 + 4 * g;
#pragma unroll
    for (int E = 0; E < 8; ++E) { const u32x2 gr = grv[E]; const f32x4 nv = nvv[E];
        u32x2 ov; ov.x = pk2(o[E].x * rn * nv.x * siluf_(bflo(gr.x)), o[E].y * rn * nv.y * siluf_(bfhi(gr.x)));
        ov.y = pk2(o[E].z * rn * nv.z * siluf_(bflo(gr.y)), o[E].w * rn * nv.w * siluf_(bfhi(gr.y)));
        *(u32x2*)(op + 16 * E) = ov; }
}
constexpr int GCH = 64, GNCH = 68;
constexpr size_t WS_GST = WS_OB + (size_t)2 * OBSZ * 2;
constexpr size_t WS_GDEC = WS_END;
constexpr size_t WS_H3B = WS_GDEC + (size_t)16 * 2 * GNCH * 64 * 4;
constexpr size_t WS_ROPE = WS_H3B + (size_t)2 * 4096 * 64 * 2;
constexpr size_t WS_TWID = WS_ROPE + (size_t)(SEQL + LC) * 64 * 8;
constexpr size_t WS_WLR = WS_TWID + 4096 * 8;
constexpr size_t WS_END2 = WS_WLR + (size_t)2 * 32 * 2048 * 2;
__device__ __forceinline__ int gla_rowbase(int b, int cg) { return cg < 4 ? NLAT + b * LC + cg * GCH : b * SEQL + (cg - 4) * GCH; }

constexpr int GLS = 68;
__device__ __forceinline__ void gla_gates_compute(const DArgs& a, unsigned char* ws, LAS float* BF, LAS float* BB, LAS float* GW  , int l, int h, int rowbase, int tid) {
    const int t = tid >> 3, d8 = tid & 7;
    const float* lr = (const float*)(ws + WS_LR) + (size_t)(rowbase + t) * 32;
    f32x4 lv[8];
#pragma unroll
    for (int q = 0; q < 8; ++q) lv[q] = ((const f32x4*)lr)[q];
    { const int dir = tid >> 8, r = (tid >> 4) & 15, c4 = (tid & 15) * 4;
      *(LAS f32x4*)(GW + (dir * 17 + r) * 64 + c4) = *(const f32x4*)(a.in[I_GGW] + (size_t)(l * 2 + dir) * 16 * 256 + r * 256 + h * 64 + c4);
      if (tid < 32) { const int dd = tid >> 4; *(LAS f32x4*)(GW + (dd * 17 + 16) * 64 + c4) = *(const f32x4*)(a.in[I_GGB] + (size_t)(l * 2 + dd) * 256 + h * 64 + c4); } }
    __syncthreads();
    bf16_t* GLG = (bf16_t*)(ws + WS_WIN);
#pragma unroll
    for (int dir = 0; dir < 2; ++dir) {
        const LAS float* gw = GW + dir * 17 * 64 + 8 * d8;
        f32x4 s0 = *(const LAS f32x4*)(gw + 16 * 64), s1 = *(const LAS f32x4*)(gw + 16 * 64 + 4);
#pragma unroll
        for (int j = 0; j < 16; ++j) { const float lj = lv[dir * 4 + (j >> 2)][j & 3]; s0 += lj * *(const LAS f32x4*)(gw + j * 64); s1 += lj * *(const LAS f32x4*)(gw + j * 64 + 4); }
        LAS float* dst = (dir ? BB : BF) + t * GLS + 8 * d8;
        float la[8];
#pragma unroll
        for (int x = 0; x < 8; ++x) { const float s = x < 4 ? s0[x] : s1[x - 4]; const float e = __expf(-fabsf(s)); const float ls = fminf(s, 0.f) - __logf(1.0f + e); la[x] = ls * (1.0f / 16.0f); }
        const u32x4 pk = pack8(la);
        *(u32x4*)(GLG + ((size_t)dir * MR + rowbase + t) * 256 + h * 64 + 8 * d8) = pk;
        float lq[8]; unpack8(pk, lq);
        *(LAS f32x4*)dst = (f32x4){lq[0], lq[1], lq[2], lq[3]}; *(LAS f32x4*)(dst + 4) = (f32x4){lq[4], lq[5], lq[6], lq[7]};
    }
}
__device__ __forceinline__ void gla_gates_load(unsigned char* ws, LAS float* BF, LAS float* BB, int h, int rowbase, int tid) {
    const int t = tid >> 3, d8 = tid & 7;
    const bf16_t* GLG = (const bf16_t*)(ws + WS_WIN);
#pragma unroll
    for (int dir = 0; dir < 2; ++dir) { float lq[8]; unpack8(*(const u32x4*)(GLG + ((size_t)dir * MR + rowbase + t) * 256 + h * 64 + 8 * d8), lq);
        LAS float* dst = (dir ? BB : BF) + t * GLS + 8 * d8;
        *(LAS f32x4*)dst = (f32x4){lq[0], lq[1], lq[2], lq[3]}; *(LAS f32x4*)(dst + 4) = (f32x4){lq[4], lq[5], lq[6], lq[7]}; }
}
__device__ __forceinline__ void gla_scan(LAS float* BF, LAS float* BB, int tid) {
    const int lane = tid & 63, w = tid >> 6;
    __syncthreads();
#pragma unroll 4
    for (int c = 0; c < 16; ++c) { const int col = 16 * w + c; const int dir = col >> 6, d = col & 63;
        LAS float* p = (dir ? BB : BF) + (dir ? 63 - lane : lane) * GLS + d;
        float v = *p;
#pragma unroll
        for (int off = 1; off < 64; off <<= 1) { const float u = __shfl_up(v, off); if (lane >= off) v += u; }
        *p = v; }
    __syncthreads();
}

__device__ __forceinline__ void gla_passA(const DArgs& a, unsigned char* ws, LAS unsigned char* lds, int l, int item, int tid) {
    const int bh = item / GNCH, cg = item % GNCH, b = bh >> 2, h = bh & 3;
    const int lane = tid & 63, w = tid >> 6, g = lane >> 4;
    LAS float* BF = (LAS float*)lds; LAS float* BB = (LAS float*)(lds + 17408); LAS unsigned char* KH = lds + 34816; LAS unsigned char* VI = lds + 34816 + 16384;
    const int rowbase = gla_rowbase(b, cg);
    const bf16_t* P = (const bf16_t*)(ws + WS_P) + (size_t)rowbase * LDP;
    const int t = tid >> 3, d8 = tid & 7;
    const u32x4 kraw = *(const u32x4*)(P + (size_t)t * LDP + PC_GK + h * 64 + 8 * d8);
    u32x4 vraw[2];
#pragma unroll
    for (int i = 0; i < 2; ++i) { const int n = tid + NT * i; vraw[i] = *(const u32x4*)(P + (size_t)(n >> 4) * LDP + PC_GV + h * 128 + (n & 15) * 8); }
    gla_gates_compute(a, ws, BF, BB, (LAS float*)(lds + 34816 + 32768), l, h, rowbase, tid);
    gla_scan(BF, BB, tid);
    { float kf[8], x0[8], x1[8]; unpack8(kraw, kf);
#pragma unroll
      for (int x = 0; x < 8; ++x) { const int d = 8 * d8 + x; x0[x] = kf[x] * __expf(BF[63 * GLS + d] - BF[t * GLS + d]); x1[x] = kf[x] * __expf(BB[d] - BB[t * GLS + d]); }
      *(LAS u32x4*)(KH + off_b(t, d8)) = pack8(x0); *(LAS u32x4*)(KH + off_b(t, 8 + d8)) = pack8(x1);
#pragma unroll
      for (int i = 0; i < 2; ++i) { const int n = tid + NT * i; *(LAS u32x4*)(VI + off_b(n >> 4, n & 15)) = vraw[i]; }
      if (tid < 128) { const int dir = tid >> 6, d = tid & 63; ((float*)(ws + WS_GDEC))[((size_t)(bh * 2 + dir) * GNCH + cg) * 64 + d] = __expf(dir ? BB[d] : BF[63 * GLS + d]); } }
    __syncthreads();
    const int dir = w >> 2, Dt = w & 3;
    bf16x8 af[2];
#pragma unroll
    for (int ks = 0; ks < 2; ++ks) af[ks] = img_tr_frag(KH, lane, dir * 4 + Dt, ks);
    bf16_t* ST = (bf16_t*)(ws + WS_GST) + ((size_t)(bh * 2 + dir) * GNCH + cg) * (128 * 64);
#pragma unroll 2
    for (int E = 0; E < 8; ++E) {
        f32x4 c = {0.f, 0.f, 0.f, 0.f};
#pragma unroll
        for (int ks = 0; ks < 2; ++ks) c = MFMA16(af[ks], img_tr_frag(VI, lane, E, ks), c);
        u32x2 o; o.x = pk2(c.x, c.y); o.y = pk2(c.z, c.w);
        *(u32x2*)(ST + (size_t)(16 * E + (lane & 15)) * 64 + 16 * Dt + 4 * g) = o;
    }
}
__device__ __forceinline__ void gla_passB(unsigned char* ws, LAS unsigned char* lds, int blk, int tid) {
    const int bd = blk >> 1, dir = bd & 1, el = (blk & 1) * 512 + tid;
    LAS float* decs = (LAS float*)lds;
    { const float* dsrc = (const float*)(ws + WS_GDEC) + (size_t)bd * GNCH * 64;
      for (int i = tid; i < GNCH * 64; i += NT) decs[i] = dsrc[i]; }
    __syncthreads();
    bf16_t* base = (bf16_t*)(ws + WS_GST) + (size_t)bd * GNCH * (128 * 64) + (size_t)el * 8;
    const int d0 = (el & 7) * 8;
    float acc[8];
#pragma unroll
    for (int x = 0; x < 8; ++x) acc[x] = 0.f;
#pragma unroll 1
    for (int s0 = 0; s0 < GNCH; s0 += 17) {
        u32x4 kvr[17];
#pragma unroll
        for (int j = 0; j < 17; ++j) { const int s = s0 + j; const int cg = dir == 0 ? s : (s < 4 ? 3 - s : 71 - s); kvr[j] = *(const u32x4*)(base + (size_t)cg * (128 * 64)); }
#pragma unroll
        for (int j = 0; j < 17; ++j) { const int s = s0 + j; const int cg = dir == 0 ? s : (s < 4 ? 3 - s : 71 - s);
            float kv[8]; unpack8(kvr[j], kv);
            const f32x4 q0 = *(const LAS f32x4*)(decs + cg * 64 + d0), q1 = *(const LAS f32x4*)(decs + cg * 64 + d0 + 4);
            *(u32x4*)(base + (size_t)cg * (128 * 64)) = pack8(acc);
#pragma unroll
            for (int x = 0; x < 8; ++x) acc[x] = (x < 4 ? q0[x] : q1[x - 4]) * acc[x] + kv[x]; }
    }
    __syncthreads();
}
__device__ __forceinline__ void gla_passC(const DArgs& a, unsigned char* ws, LAS unsigned char* lds, int l, int item, int tid) {
    const int bh = item / GNCH, cg = item % GNCH, b = bh >> 2, h = bh & 3;
    const int lane = tid & 63, w = tid >> 6, g = lane >> 4, il = lane & 15;
    LAS float* BF = (LAS float*)lds; LAS float* BB = (LAS float*)(lds + 17408);
    LAS unsigned char* QKF = lds + 34816; LAS unsigned char* QKB = QKF + 16384; LAS unsigned char* QH = QKB + 16384; LAS unsigned char* VI = QH + 16384; LAS unsigned char* SI = VI + 16384;
    const int rowbase = gla_rowbase(b, cg);
    const bf16_t* P = (const bf16_t*)(ws + WS_P) + (size_t)rowbase * LDP;
    const int t = tid >> 3, d8 = tid & 7;
    const u32x4 qraw = *(const u32x4*)(P + (size_t)t * LDP + PC_GQ + h * 64 + 8 * d8), kraw = *(const u32x4*)(P + (size_t)t * LDP + PC_GK + h * 64 + 8 * d8);
    u32x4 vraw[2], sraw[4];
#pragma unroll
    for (int i = 0; i < 2; ++i) { const int n = tid + NT * i; vraw[i] = *(const u32x4*)(P + (size_t)(n >> 4) * LDP + PC_GV + h * 128 + (n & 15) * 8); }
    { const bf16_t* STf = (const bf16_t*)(ws + WS_GST) + ((size_t)(bh * 2) * GNCH + cg) * (128 * 64); const bf16_t* STb = STf + (size_t)GNCH * 128 * 64;
#pragma unroll
      for (int i = 0; i < 4; ++i) { const int n = tid + NT * i, row = n >> 4, ch = n & 15; sraw[i] = *(const u32x4*)((ch < 8 ? STf : STb) + (size_t)row * 64 + (ch & 7) * 8); } }
    gla_gates_load(ws, BF, BB, h, rowbase, tid);
    gla_scan(BF, BB, tid);
    { float qf[8], kf[8], o0[8], o1[8], o2[8], o3[8], o4[8], o5[8];
      unpack8(qraw, qf); unpack8(kraw, kf);
#pragma unroll
      for (int x = 0; x < 8; ++x) { const int d = 8 * d8 + x; const float bf = BF[t * GLS + d], bb = BB[t * GLS + d], rf = BF[31 * GLS + d], rb = BB[32 * GLS + d]; const float q = qf[x] * 0.125f;
          o0[x] = q * __expf(bf - rf); o1[x] = kf[x] * __expf(rf - bf); o2[x] = q * __expf(bb - rb); o3[x] = kf[x] * __expf(rb - bb); o4[x] = q * __expf(bf); o5[x] = q * __expf(bb); }
      *(LAS u32x4*)(QKF + off_b(t, d8)) = pack8(o0); *(LAS u32x4*)(QKF + off_b(t, 8 + d8)) = pack8(o1);
      *(LAS u32x4*)(QKB + off_b(t, d8)) = pack8(o2); *(LAS u32x4*)(QKB + off_b(t, 8 + d8)) = pack8(o3);
      *(LAS u32x4*)(QH + off_b(t, d8)) = pack8(o4); *(LAS u32x4*)(QH + off_b(t, 8 + d8)) = pack8(o5);
#pragma unroll
      for (int i = 0; i < 2; ++i) { const int n = tid + NT * i; *(LAS u32x4*)(VI + off_b(n >> 4, n & 15)) = vraw[i]; }
#pragma unroll
      for (int i = 0; i < 4; ++i) { const int n = tid + NT * i; *(LAS u32x4*)(SI + off_b(n >> 4, n & 15)) = sraw[i]; } }
    const int ib = w & 3, eh = w >> 2, iloc = 16 * ib + il;
    u32x2 grv[4]; f32x4 nvv[4];
    { const bf16_t* gp0 = (const bf16_t*)(ws + WS_P) + ((size_t)rowbase + iloc) * LDP + PC_GG + h * 128 + 64 * eh + 4 * g; const float* nw0 = a.in[I_GNW] + l * 512 + h * 128 + 64 * eh + 4 * g;
#pragma unroll
      for (int E4 = 0; E4 < 4; ++E4) { grv[E4] = *(const u32x2*)(gp0 + 16 * E4); nvv[E4] = *(const f32x4*)(nw0 + 16 * E4); } }
    __syncthreads();
    f32x4 at[4];
    { bf16x8 qff[2], qfb[2];
#pragma unroll
      for (int ks = 0; ks < 2; ++ks) { qff[ks] = img_row_frag(QKF, lane, ib, ks); qfb[ks] = img_row_frag(QKB, lane, ib, ks); }
#pragma unroll
      for (int T = 0; T < 4; ++T) { f32x4 cf = {0.f, 0.f, 0.f, 0.f}, cb = {0.f, 0.f, 0.f, 0.f};
#pragma unroll
          for (int ks = 0; ks < 2; ++ks) { cf = MFMA16(img_row_frag(QKF, lane, T, 2 + ks), qff[ks], cf); cb = MFMA16(img_row_frag(QKB, lane, T, 2 + ks), qfb[ks], cb); }
#pragma unroll
          for (int r = 0; r < 4; ++r) { const int j = 16 * T + 4 * g + r; cf[r] = (j <= iloc ? cf[r] : 0.f) + (j >= iloc ? cb[r] : 0.f); }
          at[T] = cf; } }
    f32x4 o[4];
    { bf16x8 hf[2], hb[2];
#pragma unroll
      for (int ks = 0; ks < 2; ++ks) { hf[ks] = img_row_frag(QH, lane, ib, ks); hb[ks] = img_row_frag(QH, lane, ib, 2 + ks); }
#pragma unroll
      for (int E4 = 0; E4 < 4; ++E4) { const int E = 4 * eh + E4; f32x4 c = {0.f, 0.f, 0.f, 0.f};
#pragma unroll
          for (int ks = 0; ks < 2; ++ks) { c = MFMA16(img_row_frag(SI, lane, E, ks), hf[ks], c); c = MFMA16(img_row_frag(SI, lane, E, 2 + ks), hb[ks], c); }
          o[E4] = c; } }
#pragma unroll
    for (int s = 0; s < 2; ++s) { const bf16x8 bfr = acc_pair_frag(at[2 * s], at[2 * s + 1]);
#pragma unroll
        for (int E4 = 0; E4 < 4; ++E4) o[E4] = MFMA16(img_tr_frag_acc(VI, lane, 4 * eh + E4, s), bfr, o[E4]); }
    float ss = 0.f;
#pragma unroll
    for (int E4 = 0; E4 < 4; ++E4) ss += (o[E4].x * o[E4].x + o[E4].y * o[E4].y) + (o[E4].z * o[E4].z + o[E4].w * o[E4].w);
    ss += __shfl_xor(ss, 16); ss += __shfl_xor(ss, 32);
    LAS float* red = (LAS float*)lds;
    if (g == 0) red[eh * 64 + iloc] = ss;
    __syncthreads();
    const float rn = rsqrtf((red[iloc] + red[64 + iloc]) * (1.0f / 128.0f) + EPS);
    const size_t row = (size_t)rowbase + iloc;
    const bf16_t* gp = (const bf16_t*)(ws + WS_P) + row * LDP + PC_GG + h * 128 + 64 * eh + 4 * g;
    const float* nw = a.in[I_GNW] + l * 512 + h * 128 + 64 * eh + 4 * g;
    bf16_t* op = (bf16_t*)(ws + WS_H) + row * D + 1536 + h * 128 + 64 * eh + 4 * g;
#pragma unroll
    for (int E4 = 0; E4 < 4; ++E4) { const u32x2 gr = grv[E4]; const f32x4 nv = nvv[E4];
        u32x2 ov; ov.x = pk2(o[E4].x * rn * nv.x * siluf_(bflo(gr.x)), o[E4].y * rn * nv.y * siluf_(bfhi(gr.x)));
        ov.y = pk2(o[E4].z * rn * nv.z * siluf_(bflo(gr.y)), o[E4].w * rn * nv.w * siluf_(bfhi(gr.y)));
        *(u32x2*)(op + 16 * E4) = ov; }
}

constexpr int WLR_LD = 4112;
__device__ __forceinline__ void lr_stage(unsigned char* ws, LAS unsigned char* lds, int l, int tid) {
    const bf16_t* src = (const bf16_t*)(ws + WS_WLR) + (size_t)l * 32 * D;
    u32x4 v[16];
#pragma unroll
    for (int i = 0; i < 16; ++i) { const int n = tid + NT * i; v[i] = *(const u32x4*)(src + (size_t)n * 8); }
#pragma unroll
    for (int i = 0; i < 16; ++i) { const int n = tid + NT * i, j = n >> 8, c = n & 255; *(LAS u32x4*)(lds + j * WLR_LD + c * 16) = v[i]; }
}
__device__ __forceinline__ void lr_rows(unsigned char* ws, const LAS unsigned char* lds, int gw, int NGW, int lane) {
    const int fr = lane & 15, fq = lane >> 4;
    const int row = gw + NGW * fr; const bool valid = row < MR;
    const bf16_t* hp = (const bf16_t*)(ws + WS_H) + (size_t)(valid ? row : gw) * D + 8 * fq;
    const LAS unsigned char* wl = lds + fr * WLR_LD + 16 * fq;
    f32x4 acc0 = {0.f, 0.f, 0.f, 0.f}, acc1 = {0.f, 0.f, 0.f, 0.f};
    const bf16x8 zero8 = {0, 0, 0, 0, 0, 0, 0, 0};
#pragma unroll 1
    for (int k0 = 0; k0 < 64; k0 += 16) {
        bf16x8 hb[16];
#pragma unroll
        for (int i = 0; i < 16; ++i) hb[i] = *(const bf16x8*)(hp + 32 * (k0 + i));
#pragma unroll
        for (int i = 0; i < 16; ++i) { const bf16x8 hv = valid ? hb[i] : zero8;
            acc0 = MFMA16(*(const LAS bf16x8*)(wl + 64 * (k0 + i)), hv, acc0); acc1 = MFMA16(*(const LAS bf16x8*)(wl + 16 * WLR_LD + 64 * (k0 + i)), hv, acc1); }
    }
    if (valid) { float* lr = (float*)(ws + WS_LR) + (size_t)row * 32 + 4 * fq; *(f32x4*)lr = acc0; *(f32x4*)(lr + 16) = acc1; }
}
constexpr int SNCH = 68;
constexpr size_t WS_S5ST = WS_OB + (size_t)4 * OBSZ * 2;
constexpr size_t WS_S5BTB = WS_S5BT;
constexpr size_t WS_S5CPB = WS_S5BT + 524288;
constexpr size_t WS_S5A64 = WS_S5BT + 1048576;

__device__ __forceinline__ void prep_s5b(const DArgs& a, unsigned char* ws, int it, int tid) {
    const int idx = it * 512 + tid;
    const int gi = idx >> 6, p = idx & 63;
    const float a_re = a.in[I_S5ARE][idx], a_im = a.in[I_S5AIM][idx], ldt = a.in[I_S5LDT][gi];
    const float dt = expf(ldt), mag = expf(a_re * dt);
    float sn, cs; sincosf(a_im * dt, &sn, &cs);
    const float ab_re = mag * cs, ab_im = mag * sn, den = a_re * a_re + a_im * a_im, nr = ab_re - 1.0f;
    const float co_re = (nr * a_re + ab_im * a_im) / den, co_im = (ab_im * a_re - nr * a_im) / den;
    ((f32x2*)(ws + WS_S5AB))[idx] = (f32x2){ab_re, ab_im};
    float pr = ab_re, pi = ab_im;
#pragma unroll
    for (int q = 0; q < 6; ++q) { const float nr2 = pr * pr - pi * pi, ni2 = 2.0f * pr * pi; pr = nr2; pi = ni2; }
    ((f32x2*)(ws + WS_S5A64))[idx] = (f32x2){pr, pi};
    const float* bre = a.in[I_S5BRE] + (size_t)idx * 16; const float* bim = a.in[I_S5BIM] + (size_t)idx * 16;
    float tr[16], ti[16];
#pragma unroll
    for (int i = 0; i < 16; ++i) { const float br = bre[i], bi = bim[i]; tr[i] = co_re * br - co_im * bi; ti[i] = co_re * bi + co_im * br; }
    bf16_t* btb = (bf16_t*)(ws + WS_S5BTB) + (size_t)gi * 128 * 16;
#pragma unroll
    for (int hlf = 0; hlf < 2; ++hlf) { u32x4 w0, w1; const float* s = hlf ? ti : tr;
        w0.x = pk2(s[0], s[1]); w0.y = pk2(s[2], s[3]); w0.z = pk2(s[4], s[5]); w0.w = pk2(s[6], s[7]); w1.x = pk2(s[8], s[9]); w1.y = pk2(s[10], s[11]); w1.z = pk2(s[12], s[13]); w1.w = pk2(s[14], s[15]);
        *(u32x4*)(btb + (size_t)(64 * hlf + p) * 16) = w0; *(u32x4*)(btb + (size_t)(64 * hlf + p) * 16 + 8) = w1; }
    bf16_t* cpb = (bf16_t*)(ws + WS_S5CPB) + (size_t)gi * 16 * 128;
    const float* cre = a.in[I_S5CRE] + (size_t)gi * 1024; const float* cim = a.in[I_S5CIM] + (size_t)gi * 1024;
#pragma unroll
    for (int i = 0; i < 16; ++i) *(unsigned*)(cpb + i * 128 + 2 * p) = pk2(cre[i * 64 + p], -cim[i * 64 + p]);
}

struct S5Unit { bf16x8 btf[8]; f32x2 ab; f32x2 h; const bf16_t* cp; };
template <bool PASSC> __device__ __forceinline__ void s5_load_unit(S5Unit& U, unsigned char* ws, const bf16_t* P, const f32x2* ST, int l, int b, int cs, int rowbase, int grp, int dir, int lane) {
    const int g = lane >> 4, il = lane & 15;
    const bf16x8 zero8 = {0, 0, 0, 0, 0, 0, 0, 0};
    const int gi = (l * 2 + dir) * 32 + grp;
    U.ab = ((const f32x2*)(ws + WS_S5AB))[gi * 64 + lane];
    const size_t sidx = ((size_t)(b * SNCH + cs) * 2 + dir) * 2048 + grp * 64 + lane;
    U.h = PASSC ? ST[sidx] : (f32x2){0.f, 0.f};
    const bf16_t* bt = (const bf16_t*)(ws + WS_S5BTB) + (size_t)gi * 128 * 16 + (size_t)il * 16 + 8 * (g & 1);
#pragma unroll
    for (int Pt = 0; Pt < 8; ++Pt) { const bf16x8 v = *(const bf16x8*)(bt + Pt * 256); U.btf[Pt] = g < 2 ? v : zero8; }
    U.cp = (const bf16_t*)(ws + WS_S5CPB) + (size_t)gi * 16 * 128 + (size_t)il * 128 + 8 * g;
}
__device__ __forceinline__ void s5_load_u(bf16x8 (&ufa)[4], const bf16_t* P, int rowbase, int grp, int lane) {
    const int g = lane >> 4, il = lane & 15; const bf16x8 zero8 = {0, 0, 0, 0, 0, 0, 0, 0};
#pragma unroll
    for (int Tt = 0; Tt < 4; ++Tt) { const bf16x8 v = *(const bf16x8*)(P + (size_t)(rowbase + 16 * Tt + il) * LDP + PC_S5U + grp * 16 + 8 * (g & 1)); ufa[Tt] = g < 2 ? v : zero8; }
}
template <bool PASSC, int DIR> __device__ __forceinline__ void s5_run_unit(const S5Unit& U, const bf16x8 (&ufa)[4], f32x4 (&yacc)[4], f32x2& hout, LAS float* BU, LAS unsigned char* HW, int lane) {
    const int g = lane >> 4, il = lane & 15;
    f32x2 h = U.h; const f32x2 ab = U.ab;
    bf16x8 cpf[4];
    if (PASSC) {
#pragma unroll
        for (int ks = 0; ks < 4; ++ks) cpf[ks] = *(const bf16x8*)(U.cp + 32 * ks); }
    f32x4 d[8];
#pragma unroll
    for (int Pt = 0; Pt < 8; ++Pt) d[Pt] = MFMA16(U.btf[Pt], ufa[DIR ? 3 : 0], ((f32x4){0.f, 0.f, 0.f, 0.f}));
#pragma unroll
    for (int wi = 0; wi < 4; ++wi) {
        const int Tt = DIR ? 3 - wi : wi;
#pragma unroll
        for (int Pt = 0; Pt < 8; ++Pt) {
#pragma unroll
            for (int r = 0; r < 4; ++r) BU[(16 * Pt + 4 * g + r) * 20 + il] = d[Pt][r]; }
        asm volatile("" ::: "memory");
        if (!PASSC) {
            f32x4 br[4], bi[4];
#pragma unroll
            for (int q = 0; q < 4; ++q) { br[q] = *(const LAS f32x4*)(BU + lane * 20 + 4 * q); bi[q] = *(const LAS f32x4*)(BU + (64 + lane) * 20 + 4 * q); }
            if (wi < 3) {
#pragma unroll
                for (int Pt = 0; Pt < 8; ++Pt) d[Pt] = MFMA16(U.btf[Pt], ufa[DIR ? 2 - wi : wi + 1], ((f32x4){0.f, 0.f, 0.f, 0.f})); }
#pragma unroll
            for (int s = 0; s < 16; ++s) { const int tt = DIR ? 15 - s : s;
                const float hr = __builtin_fmaf(ab.x, h.x, __builtin_fmaf(-ab.y, h.y, br[tt >> 2][tt & 3])), hi = __builtin_fmaf(ab.x, h.y, __builtin_fmaf(ab.y, h.x, bi[tt >> 2][tt & 3]));
                h = (f32x2){hr, hi}; }
        } else {
#pragma unroll
            for (int hf2 = 0; hf2 < 2; ++hf2) { const int q0 = DIR ? 2 - 2 * hf2 : 2 * hf2;
                f32x4 br[2], bi[2];
#pragma unroll
                for (int q = 0; q < 2; ++q) { br[q] = *(const LAS f32x4*)(BU + lane * 20 + 4 * (q0 + q)); bi[q] = *(const LAS f32x4*)(BU + (64 + lane) * 20 + 4 * (q0 + q)); }
#pragma unroll
                for (int s = 0; s < 8; ++s) { const int t8 = DIR ? 7 - s : s; const int tt = 4 * q0 + t8;
                    const float hr = __builtin_fmaf(ab.x, h.x, __builtin_fmaf(-ab.y, h.y, br[t8 >> 2][t8 & 3])), hi = __builtin_fmaf(ab.x, h.y, __builtin_fmaf(ab.y, h.x, bi[t8 >> 2][t8 & 3]));
                    h = (f32x2){hr, hi};
                    *(LAS unsigned*)(HW + off_b(tt, lane >> 2) + (lane & 3) * 4) = pk2(hr, hi); }
            }
        }
        asm volatile("" ::: "memory");
        if (PASSC) {
            bf16x8 hf[4];
#pragma unroll
            for (int ks = 0; ks < 4; ++ks) hf[ks] = img_row_frag(HW, lane, 0, ks);
#pragma unroll
            for (int ks = 0; ks < 4; ++ks) yacc[Tt] = MFMA16(cpf[ks], hf[ks], yacc[Tt]);
            }
        asm volatile("" ::: "memory");
        if (PASSC && wi < 3) {
#pragma unroll
            for (int Pt = 0; Pt < 8; ++Pt) d[Pt] = MFMA16(U.btf[Pt], ufa[DIR ? 2 - wi : wi + 1], ((f32x4){0.f, 0.f, 0.f, 0.f})); }
    }
    hout = h;
}
template <bool PASSC> __device__ __forceinline__ void s5_item(const DArgs& a, unsigned char* ws, LAS unsigned char* lds, int l, int item, int ggsel, int tid) {
    const int b = item / (SNCH * 2), rem = item % (SNCH * 2), cs = rem >> 1, half = rem & 1;
    const int lane = tid & 63, w = tid >> 6, g = lane >> 4, il = lane & 15;
    const int rowbase = gla_rowbase(b, cs);
    LAS float* BU = (LAS float*)(lds + w * 14336); LAS unsigned char* HW = lds + w * 14336 + 10240;
    const bf16_t* P = (const bf16_t*)(ws + WS_P);
    f32x2* ST = (f32x2*)(ws + WS_S5ST);
    const int grp0 = 16 * half + w, grp1 = grp0 + 8;
    S5Unit UA; bf16x8 ufa[4];
    { const int gg = ggsel;
        const int grp = gg ? grp1 : grp0;
        f32x4 yacc[4];
#pragma unroll
        for (int q = 0; q < 4; ++q) yacc[q] = (f32x4){0.f, 0.f, 0.f, 0.f};
        f32x2 hend;
        u32x2 urv[4], sgv[4]; f32x4 dskv = {0.f, 0.f, 0.f, 0.f};
        if (PASSC) { dskv = *(const f32x4*)(a.in[I_S5D] + l * 512 + grp * 16 + 4 * g);
#pragma unroll
            for (int Tt = 0; Tt < 4; ++Tt) { const size_t row = (size_t)rowbase + 16 * Tt + il; urv[Tt] = *(const u32x2*)(P + row * LDP + PC_S5U + grp * 16 + 4 * g); sgv[Tt] = *(const u32x2*)(P + row * LDP + PC_S5G + grp * 16 + 4 * g); } }
        s5_load_unit<PASSC>(UA, ws, P, ST, l, b, cs, rowbase, grp, 0, lane); s5_load_u(ufa, P, rowbase, grp, lane);
        s5_run_unit<PASSC, 0>(UA, ufa, yacc, hend, BU, HW, lane);
        if (!PASSC) ST[((size_t)(b * SNCH + cs) * 2 + 0) * 2048 + grp * 64 + lane] = hend;
        s5_load_unit<PASSC>(UA, ws, P, ST, l, b, cs, rowbase, grp, 1, lane);
        s5_run_unit<PASSC, 1>(UA, ufa, yacc, hend, BU, HW, lane);
        if (!PASSC) ST[((size_t)(b * SNCH + cs) * 2 + 1) * 2048 + grp * 64 + lane] = hend;
        if (PASSC) {
            const f32x4 dsk = dskv;
            bf16_t* G5 = (bf16_t*)(ws + WS_KF);
#pragma unroll
            for (int Tt = 0; Tt < 4; ++Tt) { const size_t row = (size_t)rowbase + 16 * Tt + il;
                const u32x2 ur = urv[Tt], sg = sgv[Tt];
                const float g0 = gelu_tanh(yacc[Tt].x + bflo(ur.x) * dsk.x), g1 = gelu_tanh(yacc[Tt].y + bfhi(ur.x) * dsk.y), g2 = gelu_tanh(yacc[Tt].z + bflo(ur.y) * dsk.z), g3 = gelu_tanh(yacc[Tt].w + bfhi(ur.y) * dsk.w);
                u32x2 ov; ov.x = pk2(g0, g1); ov.y = pk2(g2, g3);
                *(u32x2*)(G5 + row * 512 + grp * 16 + 4 * g) = ov;
                ov.x = pk2(g0 * siluf_(bflo(sg.x)), g1 * siluf_(bfhi(sg.x))); ov.y = pk2(g2 * siluf_(bflo(sg.y)), g3 * siluf_(bfhi(sg.y)));
                *(u32x2*)(G5 + OBSZ + row * 512 + grp * 16 + 4 * g) = ov; }
        }
    }
}
__device__ __forceinline__ void s5_passB(unsigned char* ws, int l, int gt) {
    const int p = gt & 63, grp = (gt >> 6) & 31, dir = (gt >> 11) & 1, b = gt >> 12;
    const f32x2 a64 = ((const f32x2*)(ws + WS_S5A64))[((l * 2 + dir) * 32 + grp) * 64 + p];
    f32x2* ST = (f32x2*)(ws + WS_S5ST);
    f32x2 acc = {0.f, 0.f};
#pragma unroll 1
    for (int s0 = 0; s0 < SNCH; s0 += 34) {
        f32x2 ev[34];
#pragma unroll
        for (int j = 0; j < 34; ++j) { const int s = s0 + j; const int cs = dir == 0 ? s : (s < 4 ? 3 - s : 71 - s); ev[j] = ST[((size_t)(b * SNCH + cs) * 2 + dir) * 2048 + grp * 64 + p]; }
#pragma unroll
        for (int j = 0; j < 34; ++j) { const int s = s0 + j; const int cs = dir == 0 ? s : (s < 4 ? 3 - s : 71 - s);
            ST[((size_t)(b * SNCH + cs) * 2 + dir) * 2048 + grp * 64 + p] = acc;
            acc = (f32x2){a64.x * acc.x - a64.y * acc.y + ev[j].x, a64.x * acc.y + a64.y * acc.x + ev[j].y}; }
    }
}
constexpr int FFT_PHYS = 8448;
__device__ __forceinline__ void fft_twiddles_g(LAS f32x2* W, const f32x2* Wg, int tid) {
#pragma unroll
    for (int j = 0; j < 8; ++j) W[tid + NT * j] = Wg[tid + NT * j];
}
__device__ __forceinline__ int fphys(int i) { return i + (i >> 5); }
__device__ __forceinline__ f32x2 cmulf(const f32x2 a, const f32x2 b) { return (f32x2){a.x * b.x - a.y * b.y, a.x * b.y + a.y * b.x}; }
__device__ __forceinline__ f32x2 cmulcf(const f32x2 a, const f32x2 b) { return (f32x2){a.x * b.x + a.y * b.y, a.y * b.x - a.x * b.y}; }
template <int RL> __device__ __forceinline__ void dft_fwd_const(f32x2 (&e)[1 << RL]) {
#pragma unroll
    for (int s = 0; s < RL; ++s) { const int h = 1 << (RL - 1 - s);
#pragma unroll
        for (int m = 0; m < (1 << RL); ++m) { if (m & h) continue;
            const int mp = m & (h - 1); const f32x2 a_ = e[m], b_ = e[m | h]; const f32x2 d = a_ - b_; e[m] = a_ + b_;
            if (mp == 0) e[m | h] = d;
            else if (2 * mp == h) e[m | h] = (f32x2){d.y, -d.x};
            else { const float ang = -3.14159265358979323846f * (float)mp / (float)h; const f32x2 c = {__builtin_cosf(ang), __builtin_sinf(ang)}; e[m | h] = cmulf(d, c); } } }
}
template <int RL> __device__ __forceinline__ void dft_inv_const(f32x2 (&e)[1 << RL]) {
#pragma unroll
    for (int ss = 0; ss < RL; ++ss) { const int s = RL - 1 - ss; const int h = 1 << (RL - 1 - s);
#pragma unroll
        for (int m = 0; m < (1 << RL); ++m) { if (m & h) continue;
            const int mp = m & (h - 1); const f32x2 a_ = e[m], b_ = e[m | h]; f32x2 t;
            if (mp == 0) t = b_;
            else if (2 * mp == h) t = (f32x2){-b_.y, b_.x};
            else { const float ang = -3.14159265358979323846f * (float)mp / (float)h; const f32x2 c = {__builtin_cosf(ang), __builtin_sinf(ang)}; t = cmulcf(b_, c); }
            e[m] = a_ + t; e[m | h] = a_ - t; } }
}
template <int RL> __device__ __forceinline__ constexpr int brev_c(int m) { int r = 0; for (int i = 0; i < RL; ++i) r |= ((m >> i) & 1) << (RL - 1 - i); return r; }
template <int RL, bool CONJ> __device__ __forceinline__ void apply_tw(f32x2 (&e)[1 << RL], const f32x2 w1) {
    f32x2 tw[1 << RL];
    tw[0] = (f32x2){1.f, 0.f}; tw[1] = w1;
    if (RL >= 2) { tw[2] = cmulf(w1, w1); tw[3] = cmulf(tw[2], w1); }
    if (RL >= 3) { tw[4] = cmulf(tw[2], tw[2]); tw[5] = cmulf(tw[4], tw[1]); tw[6] = cmulf(tw[4], tw[2]); tw[7] = cmulf(tw[4], tw[3]); }
    if (RL >= 4) { tw[8] = cmulf(tw[4], tw[4]);
#pragma unroll
        for (int k = 1; k < 8; ++k) tw[8 + k] = cmulf(tw[8], tw[k]); }
#pragma unroll
    for (int m = 1; m < (1 << RL); ++m) e[m] = CONJ ? cmulcf(e[m], tw[brev_c<RL>(m)]) : cmulf(e[m], tw[brev_c<RL>(m)]);
}
template <int RL, int BETA, bool INV, class WP> __device__ __forceinline__ void fft2_pass(LAS f32x2* X, WP W, int tid) {
    constexpr int LOW = BETA - RL + 1, NG = FFTN >> RL, STR = (1 << LOW) + (1 << (LOW - 5));
#pragma unroll 1
    for (int gi = tid; gi < NG; gi += NT) {
        const int base = ((gi >> LOW) << (BETA + 1)) | (gi & ((1 << LOW) - 1));
        volatile LAS f32x2* p = X + fphys(base);
        f32x2 e[1 << RL];
#pragma unroll
        for (int m = 0; m < (1 << RL); ++m) e[m] = p[m * STR];
        const f32x2 w1 = W[(base & ((1 << LOW) - 1)) << (12 - BETA)];
        if (!INV) { dft_fwd_const<RL>(e); apply_tw<RL, false>(e, w1); }
        else { apply_tw<RL, true>(e, w1); dft_inv_const<RL>(e); }
#pragma unroll
        for (int m = 0; m < (1 << RL); ++m) p[m * STR] = e[m];
    }
}
template <class WP> __device__ __forceinline__ void fft2_fwd_ABC(LAS f32x2* X, WP W, int tid) {
    fft2_pass<4, 12, false>(X, W, tid); __syncthreads(); fft2_pass<4, 8, false>(X, W, tid); __syncthreads();
}
template <class WP> __device__ __forceinline__ void fft2_inv_CBA(LAS f32x2* X, WP W, int tid) {
    fft2_pass<4, 8, true>(X, W, tid); __syncthreads(); fft2_pass<4, 12, true>(X, W, tid); __syncthreads();
}
__device__ __forceinline__ void fft2_mid_mul(LAS f32x2* X, const f32x2* KF, int tid) {
    if (tid < 256) {
        volatile LAS f32x2* p = X + 33 * tid;
        f32x2 e[32];
#pragma unroll
        for (int m = 0; m < 32; ++m) e[m] = p[m];
        dft_fwd_const<5>(e);
#pragma unroll
        for (int q4 = 0; q4 < 4; ++q4) { f32x4 kf[4];
#pragma unroll
            for (int q = 0; q < 4; ++q) kf[q] = *(const f32x4*)(KF + 32 * tid + 8 * q4 + 2 * q);
#pragma unroll
            for (int q = 0; q < 4; ++q) { const int m = 8 * q4 + 2 * q; e[m] = cmulf(e[m], (f32x2){kf[q].x, kf[q].y}); e[m + 1] = cmulf(e[m + 1], (f32x2){kf[q].z, kf[q].w}); } }
        dft_inv_const<5>(e);
#pragma unroll
        for (int m = 0; m < 32; ++m) p[m] = e[m];
    }
}
__device__ __forceinline__ void fft2_fwd_D(LAS f32x2* X, int tid) {
    if (tid < 256) { volatile LAS f32x2* p = X + 33 * tid; f32x2 e[32];
#pragma unroll
        for (int m = 0; m < 32; ++m) e[m] = p[m];
        dft_fwd_const<5>(e);
#pragma unroll
        for (int m = 0; m < 32; ++m) p[m] = e[m]; }
}

__device__ __forceinline__ void filt_item2(const DArgs& a, unsigned char* ws, LAS unsigned char* lds, int l, int c0, int tid) {
    LAS f32x2* X = (LAS f32x2*)lds; LAS f32x2* X2 = (LAS f32x2*)(lds + FFT_PHYS * 8); LAS float* red = (LAS float*)(lds + 2 * FFT_PHYS * 8);
    const f32x2* Wg = (const f32x2*)(ws + WS_TWID);
    const int lane = tid & 63, w = tid >> 6, fr = lane & 15, fq = lane >> 4;
    const int cmine = c0 + 256 * (fq & 1);
    bf16x8 af[2];
    { float wv[16];
      const int cc = fr & 3, ca = c0 + 256 * ((fr >> 2) & 1);
      const float* wsrc = a.in[I_HW4] + (size_t)l * 64 * 2048 + (cc >> 1) * 1024 + (cc & 1) * 512 + ca;
#pragma unroll
      for (int q = 0; q < 16; ++q) wv[q] = fr < 8 ? wsrc[(size_t)(32 * (q >> 3) + 8 * fq + (q & 7)) * 2048] : 0.f;
#pragma unroll
      for (int ks = 0; ks < 2; ++ks) { u32x4 pw; pw.x = pk2(wv[8 * ks], wv[8 * ks + 1]); pw.y = pk2(wv[8 * ks + 2], wv[8 * ks + 3]); pw.z = pk2(wv[8 * ks + 4], wv[8 * ks + 5]); pw.w = pk2(wv[8 * ks + 6], wv[8 * ks + 7]); af[ks] = __builtin_bit_cast(bf16x8, pw); } }
    if (tid < 2) { float z0; asm volatile("v_mov_b32 %0, 0" : "=v"(z0)); (tid ? X2 : X)[fphys(4096)] = (f32x2){z0, z0}; }
    const float dl = fabsf(HY_D0 + (HY_D1 - HY_D0) * ((float)cmine / 511.0f)) * (1.0f / 4095.0f);
    const bf16_t* H3 = (const bf16_t*)(ws + WS_H3B) + (size_t)l * 4096 * 64 + (size_t)fr * 64 + 8 * fq;
    LAS f32x2* Xm = (fq & 1) ? X2 : X;
    float ss0 = 0.f, ss1 = 0.f;
#pragma unroll 1
    for (int i0 = 0; i0 < 32; i0 += 4) {
        bf16x8 hb[4][2];
#pragma unroll
        for (int i = 0; i < 4; ++i) { const bf16_t* hp = H3 + (size_t)(16 * (w + 8 * (i0 + i))) * 64; hb[i][0] = *(const bf16x8*)hp; hb[i][1] = *(const bf16x8*)(hp + 32); }
#pragma unroll
        for (int i = 0; i < 4; ++i) {
            f32x4 d = {0.f, 0.f, 0.f, 0.f};
            d = MFMA16(af[0], hb[i][0], d); d = MFMA16(af[1], hb[i][1], d);
            if (fq < 2) { const int t = 16 * (w + 8 * (i0 + i)) + fr;
                const float dec = __expf(-(float)t * dl); const float f0 = d.x * dec, f1 = d.y * dec, b0 = d.z * dec, b1 = d.w * dec;
                Xm[fphys(t)] = (f32x2){f0, f1}; ss0 += f0 * f0; ss1 += f1 * f1;
                if (t > 0) { Xm[fphys(8192 - t)] = (f32x2){b0, b1}; ss0 += b0 * b0; ss1 += b1 * b1; } }
        }
    }
#pragma unroll
    for (int o = 1; o < 16; o <<= 1) { ss0 += __shfl_xor(ss0, o); ss1 += __shfl_xor(ss1, o); }
    if (fr == 0 && fq < 2) { red[w * 4 + fq * 2] = ss0; red[w * 4 + fq * 2 + 1] = ss1; }
    __syncthreads();
    fft2_pass<4, 12, false>(X, Wg, tid); fft2_pass<4, 12, false>(X2, Wg, tid); __syncthreads();
    fft2_pass<4, 8, false>(X, Wg, tid); fft2_pass<4, 8, false>(X2, Wg, tid); __syncthreads();
    fft2_fwd_D(tid < 256 ? X : X2, tid & 255); __syncthreads();
#pragma unroll 1
    for (int ch = 0; ch < 2; ++ch) {
        float s0 = 0.f, s1 = 0.f;
#pragma unroll
        for (int i = 0; i < NWAVES; ++i) { s0 += red[i * 4 + ch * 2]; s1 += red[i * 4 + ch * 2 + 1]; }
        const float rs0 = 0.5f * rsqrtf(s0 + EPS), rs1 = 0.5f * rsqrtf(s1 + EPS);
        const LAS f32x2* Xc = ch ? X2 : X; const int c = c0 + 256 * ch;
        f32x2* KF0 = (f32x2*)(ws + WS_KF) + (size_t)(0 * 512 + c) * FFTN; f32x2* KF1 = (f32x2*)(ws + WS_KF) + (size_t)(1 * 512 + c) * FFTN;
#pragma unroll 4
        for (int j = 0; j < 16; ++j) { const int pos = tid + 512 * j; const int k = (int)(__brev((unsigned)pos) >> 19); const int pp = (int)(__brev((unsigned)((8192 - k) & 8191)) >> 19);
            const f32x2 za = Xc[fphys(pos)], zb = Xc[fphys(pp)];
            KF0[pos] = (f32x2){rs0 * (za.x + zb.x), rs0 * (za.y - zb.y)};
            KF1[pos] = (f32x2){rs1 * (za.y + zb.y), rs1 * (zb.x - za.x)}; }
    }
    __syncthreads();
}

struct Raw8 { u32x4 mid; bf16_t lf, rt; };
__device__ __forceinline__ Raw8 ld_raw8(const bf16_t* p, int t0, int Lx) { Raw8 r; r.mid = *(const u32x4*)(p + t0); r.lf = t0 > 0 ? p[t0 - 1] : (bf16_t)0; r.rt = t0 + 8 < Lx ? p[t0 + 8] : (bf16_t)0; return r; }
__device__ __forceinline__ void sconv8(const Raw8& r, float w0, float w1, float w2, float cb, float (&o)[8]) {
    float x[10]; x[0] = bf2f(r.lf); x[9] = bf2f(r.rt);
    x[1] = bflo(r.mid.x); x[2] = bfhi(r.mid.x); x[3] = bflo(r.mid.y); x[4] = bfhi(r.mid.y); x[5] = bflo(r.mid.z); x[6] = bfhi(r.mid.z); x[7] = bflo(r.mid.w); x[8] = bfhi(r.mid.w);
#pragma unroll
    for (int i = 0; i < 8; ++i) o[i] = w0 * x[i] + w1 * x[i + 1] + w2 * x[i + 2] + cb;
}
__device__ __forceinline__ void hyena_item2(const DArgs& a, unsigned char* ws, LAS unsigned char* lds, int l, int c, int tid, bf16_t* outrows) {
    LAS f32x2* X = (LAS f32x2*)lds; LAS f32x2* X2 = (LAS f32x2*)(lds + FFT_PHYS * 8);
    const f32x2* Wg = (const f32x2*)(ws + WS_TWID);
    const float* cw = a.in[I_HCW] + (size_t)l * 3 * 1536; const float* cbp = a.in[I_HCB] + (size_t)l * 1536;
    const float wv0 = cw[c], wv1 = cw[1536 + c], wv2 = cw[3072 + c], bv = cbp[c];
    const float wa0 = cw[512 + c], wa1 = cw[1536 + 512 + c], wa2 = cw[3072 + 512 + c], ba = cbp[512 + c];
    const float wb0 = cw[1024 + c], wb1 = cw[1536 + 1024 + c], wb2 = cw[3072 + 1024 + c], bb = cbp[1024 + c];
    const float bias0 = a.in[I_HBIAS][(l * 2 + 0) * 512 + c], bias1 = a.in[I_HBIAS][(l * 2 + 1) * 512 + c];
    const bf16_t* PT = (const bf16_t*)(ws + WS_PT);
    const bf16_t* pv = PT + (size_t)(PT_V + c) * MR; const bf16_t* pg1 = PT + (size_t)(PT_G1 + c) * MR; const bf16_t* pg2 = PT + (size_t)(PT_G2 + c) * MR; const bf16_t* phg = PT + (size_t)(PT_HG + c) * MR;
    const f32x2* KF0 = (const f32x2*)(ws + WS_KF) + (size_t)(0 * 512 + c) * FFTN; const f32x2* KF1 = (const f32x2*)(ws + WS_KF) + (size_t)(1 * 512 + c) * FFTN;
    const int t0 = 8 * tid;
    const int po = 8 * tid + (tid >> 2);
    LAS f32x2* px = X + po; LAS f32x2* py = X2 + po;
    float z[4][8];
    { Raw8 v[4];
#pragma unroll
      for (int b = 0; b < 4; ++b) v[b] = ld_raw8(pv + b * SEQL, t0, SEQL);
#pragma unroll
      for (int b = 0; b < 4; ++b) sconv8(v[b], wv0, wv1, wv2, bv, z[b]); }
    Raw8 g1r[4];
#pragma unroll
    for (int b = 0; b < 4; ++b) g1r[b] = ld_raw8(pg1 + b * SEQL, t0, SEQL);
#pragma unroll
    for (int x = 0; x < 8; ++x) { px[x] = (f32x2){z[0][x], z[1][x]}; px[4224 + x] = (f32x2){0.f, 0.f}; py[x] = (f32x2){z[2][x], z[3][x]}; py[4224 + x] = (f32x2){0.f, 0.f}; }
    __syncthreads();
#define HY_CONV(KFp) do { \
        fft2_pass<4, 12, false>(X, Wg, tid); fft2_pass<4, 12, false>(X2, Wg, tid); __syncthreads(); \
        fft2_pass<4, 8, false>(X, Wg, tid); fft2_pass<4, 8, false>(X2, Wg, tid); __syncthreads(); \
        fft2_mid_mul(tid < 256 ? X : X2, KFp, tid & 255); __syncthreads(); \
        fft2_pass<4, 8, true>(X, Wg, tid); fft2_pass<4, 8, true>(X2, Wg, tid); __syncthreads(); \
        fft2_pass<4, 12, true>(X, Wg, tid); fft2_pass<4, 12, true>(X2, Wg, tid); __syncthreads(); } while (0)
    HY_CONV(KF0);
    { float g[4][8];
#pragma unroll
      for (int b = 0; b < 4; ++b) sconv8(g1r[b], wa0, wa1, wa2, ba, g[b]);
#pragma unroll
      for (int x = 0; x < 8; ++x) { const f32x2 c0 = px[x] * (1.0f / 8192.0f), c1 = py[x] * (1.0f / 8192.0f);
          z[0][x] = g[0][x] * (c0.x + bias0 * z[0][x]); z[1][x] = g[1][x] * (c0.y + bias0 * z[1][x]); z[2][x] = g[2][x] * (c1.x + bias0 * z[2][x]); z[3][x] = g[3][x] * (c1.y + bias0 * z[3][x]); } }
    Raw8 g2r[4]; u32x4 hgr[4];
#pragma unroll
    for (int b = 0; b < 4; ++b) { g2r[b] = ld_raw8(pg2 + b * SEQL, t0, SEQL); hgr[b] = *(const u32x4*)(phg + b * SEQL + t0); }
    __syncthreads();
#pragma unroll
    for (int x = 0; x < 8; ++x) { px[x] = (f32x2){z[0][x], z[1][x]}; px[4224 + x] = (f32x2){0.f, 0.f}; py[x] = (f32x2){z[2][x], z[3][x]}; py[4224 + x] = (f32x2){0.f, 0.f}; }
    __syncthreads();
    HY_CONV(KF1);
#undef HY_CONV
    bf16_t* pvw = outrows + (size_t)c * MR;
#pragma unroll
    for (int b = 0; b < 4; ++b) { float g[8], hh[8], o[8]; sconv8(g2r[b], wb0, wb1, wb2, bb, g); unpack8(hgr[b], hh);
#pragma unroll
        for (int x = 0; x < 8; ++x) { const f32x2 cv = ((b < 2) ? px[x] : py[x]) * (1.0f / 8192.0f); const float cvv = (b & 1) ? cv.y : cv.x;
            o[x] = g[x] * (cvv + bias1 * z[b][x]) * siluf_(hh[x]); }
        *(u32x4*)(pvw + b * SEQL + t0) = pack8(o); }
    __syncthreads();
}
__device__ __forceinline__ void hy_transpose_item(unsigned char* ws, LAS unsigned char* lds, int item, int tid, int nrows) {
    const int lane = tid & 63, w = tid >> 6;
    const int wi = item * 8 + w;
    const int nrb = nrows / 64;
    if (wi >= nrb * 8) return;
    const int rb = wi >> 3, cb = wi & 7;
    LAS bf16_t* T = (LAS bf16_t*)(lds + w * 8704);
    const bf16_t* src = (const bf16_t*)(ws + WS_PT) + (size_t)(PT_V + cb * 64) * MR + (size_t)rb * 64;
    u32x4 tv[8];
#pragma unroll
    for (int i = 0; i < 8; ++i) { const int c = 8 * i + (lane >> 3), r8 = (lane & 7) * 8; tv[i] = *(const u32x4*)(src + (size_t)c * MR + r8); }
#pragma unroll
    for (int i = 0; i < 8; ++i) { const int c = 8 * i + (lane >> 3), r8 = (lane & 7) * 8;
        LAS unsigned* d = (LAS unsigned*)(T + c * 66 + r8); d[0] = tv[i].x; d[1] = tv[i].y; d[2] = tv[i].z; d[3] = tv[i].w; }
    asm volatile("s_waitcnt lgkmcnt(0)" ::: "memory");
    bf16_t* dst = (bf16_t*)(ws + WS_H) + (size_t)(rb * 64) * D + 512 + cb * 64;
#pragma unroll 4
    for (int i = 0; i < 8; ++i) { const int r = 8 * i + (lane >> 3), c8 = (lane & 7) * 8;
        unsigned short e[8];
#pragma unroll
        for (int x = 0; x < 8; ++x) e[x] = T[(c8 + x) * 66 + r];
        u32x4 o; o.x = e[0] | ((unsigned)e[1] << 16); o.y = e[2] | ((unsigned)e[3] << 16); o.z = e[4] | ((unsigned)e[5] << 16); o.w = e[6] | ((unsigned)e[7] << 16);
        *(u32x4*)(dst + (size_t)r * D + c8) = o; }
    asm volatile("s_waitcnt lgkmcnt(0)" ::: "memory");
}
#ifndef MK_EN
#define MK_EN 0xffff
#endif
#define EN(x) ((MK_EN >> (x)) & 1)
constexpr int PH_PREP = 0, PH_PER_LAYER = 7, PH_FNORM = 1 + 2 * PH_PER_LAYER, N_PHASES = PH_FNORM + 1;

__global__ void __launch_bounds__(NT, 2) fwd_kernel(Args ka) {
    extern __shared__ __attribute__((aligned(16))) unsigned char lds_raw[];
    LAS unsigned char* lds = (LAS unsigned char*)lds_raw;
    const int G = gridDim.x;
    volatile LAS unsigned* bst = (volatile LAS unsigned*)(lds + LDS_CTL_OFF);
    if (threadIdx.x < 16) bst[threadIdx.x] = 0u;
    if (threadIdx.x == 0) { LAS unsigned long long* tab = (LAS unsigned long long*)(lds + LDS_PTR_OFF);
#pragma unroll
        for (int i = 0; i < N_IN; ++i) tab[i] = (unsigned long long)ka.in[i]; }
    __syncthreads();

    XcdBarrier gbar; gbar.bar = (unsigned*)(ka.ws + WS_CTL); gbar.x = 0; gbar.st = bst;
    if (ka.ph_hi - ka.ph_lo > 1) gbar = xcd_barrier_post((unsigned*)(ka.ws + WS_CTL), bst);

#ifdef REP_SUB
#ifndef REP_LMASK
#define REP_LMASK 3
#endif
    int repmask = 0;
#endif
    for (int ph = ka.ph_lo; ph < ka.ph_hi; ++ph) {
        int tid = threadIdx.x; asm volatile("" : "+v"(tid));
        int bid = blockIdx.x; asm volatile("" : "+s"(bid));
#define LANE_WAVE() int tid2_ = threadIdx.x; asm volatile("" : "+v"(tid2_)); const int lane = tid2_ & 63, wave = __builtin_amdgcn_readfirstlane(tid2_ >> 6)
        __attribute__((address_space(1))) unsigned char* wsg_ = (__attribute__((address_space(1))) unsigned char*)ka.ws; asm volatile("" : "+s"(wsg_)); unsigned char* ws = (unsigned char*)wsg_;
        __attribute__((address_space(1))) float* outg_ = (__attribute__((address_space(1))) float*)ka.out; asm volatile("" : "+s"(outg_)); float* outp_ = (float*)outg_;
        DArgs a; a.in.t = (const LAS unsigned long long*)(lds + LDS_PTR_OFF); a.out = outp_;
        float* MOD = (float*)(ws + WS_MOD);
        if (EN(0) && ph == PH_PREP) {
            for (int it = bid; it < 1024; it += G) {
                int tid = threadIdx.x; asm volatile("" : "+v"(tid));
                __syncthreads();
                if (it < 192) prep_adaln(a.in[I_C], a.in[I_CCTX], a.in[I_ADAW], a.in[I_ADAB], MOD, it, (LAS float*)lds, tid);
                else if (it < 208) prep_s5b(a, ws, it - 192, tid);
                else if (it >= 1016) { const int j = (it - 1016) * NT + tid; float sn, cs; sincospif(-(float)j * (1.0f / 4096.0f), &sn, &cs); ((f32x2*)(ws + WS_TWID))[j] = (f32x2){cs, sn}; }
                else if (it >= 472) prep_rope((f32x2*)(ws + WS_ROPE), it - 472, tid);
                else { const bool big = it < 464; const int r = big ? it - 208 : it - 464, l = big ? (r >> 7) : 0, t0 = (big ? (r & 127) : r) * 32;
                    float* H3o = big ? (float*)(ws + WS_H3) + (size_t)l * 4096 * 64 : (float*)(ws + WS_H3C);
                    bf16_t* H3b = big ? (bf16_t*)(ws + WS_H3B) + (size_t)l * 4096 * 64 : (bf16_t*)nullptr;
                    prep_hymlp(a, H3o, H3b, l, big ? 4096 : 256, t0, lds, tid); }
            }
            { __syncthreads(); LANE_WAVE(); LAS float* scr = (LAS float*)(lds + wave * 8704);
              for (int r = (G - 1 - bid) * NWAVES + wave; r < 64; r += G * NWAVES) { const int l = r >> 5, kb = r & 31;
                  transpose_item(a.in[I_WIN] + (size_t)l * D * INW, INW, 6144 + (lane & 31), kb * 64, (bf16_t*)(ws + WS_WLR) + (size_t)l * 32 * D, D, 0, scr, lane); } }
        } else if (EN(1) && ph == PH_FNORM) {
            const float* fw = a.in[I_FNW]; LANE_WAVE();
            const bf16_t* X2 = (const bf16_t*)(ws + WS_P);
            for (int row = bid * NWAVES + wave; row < NLAT; row += G * NWAVES) {
                u32x4 raw[4]; float ss = 0.f;
#pragma unroll
                for (int j = 0; j < 4; ++j) raw[j] = ((const u32x4*)(X2 + (size_t)row * D))[lane + 64 * j];
#pragma unroll
                for (int j = 0; j < 4; ++j) { float f[8]; unpack8(raw[j], f);
#pragma unroll
                    for (int x = 0; x < 8; ++x) ss += f[x] * f[x]; }
                const float rstd = rsqrtf(wave_sum(ss) * (1.0f / D) + EPS);
                float* xr = a.out + (size_t)row * D;
#pragma unroll
                for (int j = 0; j < 4; ++j) { const int k = 8 * (lane + 64 * j); float f[8]; unpack8(raw[j], f);
                    const f32x4 w0 = *(const f32x4*)(fw + k), w1 = *(const f32x4*)(fw + k + 4);
                    *(f32x4*)(xr + k) = (f32x4){f[0] * rstd * w0.x, f[1] * rstd * w0.y, f[2] * rstd * w0.z, f[3] * rstd * w0.w};
                    *(f32x4*)(xr + k + 4) = (f32x4){f[4] * rstd * w1.x, f[5] * rstd * w1.y, f[6] * rstd * w1.z, f[7] * rstd * w1.w}; }
            }
        } else {
            const int l = (ph - 1) / PH_PER_LAYER, sub = (ph - 1) % PH_PER_LAYER;

            const bool ctx_out = (l == 0);
            const int Mrows = ctx_out ? MR : NLAT;
            if (EN(2) && sub == 0) {
                LANE_WAVE();
                LAS float* scr = (LAS float*)(lds + wave * 8704);
                const int gw = bid * NWAVES + wave, NGW = G * NWAVES;
                constexpr int I_W1 = 32 * (NPAD / 32), I_W2 = 32 * 64, I_W3 = 8 * 16;
                for (int pass_ = 0; pass_ < 2; ++pass_) {
                if ((pass_ ^ ((bid >> 3) & 1)) == 0) {
                for (int it = (l == 0 ? gw : gw + I_W1); it < I_W1 + I_W2 + I_W3; it += NGW) {
                    int r = it;
                    if (r < I_W1) { const int kb = r / (NPAD / 32), nb = r % (NPAD / 32); transpose_item(a.in[I_WIN] + (size_t)l * D * INW, INW, win_srccol(nb * 32 + (lane & 31)), kb * 64, (bf16_t*)(ws + WS_WIN), D, nb * 32, scr, lane); continue; }
                    r -= I_W1;
                    if (r < I_W2) { const int kb = r / 64, nb = r % 64; transpose_item(a.in[I_WOUT] + (size_t)l * D * D, D, nb * 32 + (lane & 31), kb * 64, (bf16_t*)(ws + WS_WOUT), D, nb * 32, scr, lane); continue; }
                    r -= I_W2;
                    { const int kb = r / 16, nb = r % 16; transpose_item(a.in[I_GLUW] + (size_t)l * 512 * 512, 512, nb * 32 + (lane & 31), kb * 64, (bf16_t*)(ws + WS_GLUW), 512, nb * 32, scr, lane); }
                }
                const float* nw = a.in[I_NORMW] + (size_t)l * D;
                for (int row = gw; row < MR; row += NGW) {
                    const float* xr; int v;
                    if (row < NLAT) { xr = a.in[I_X] + (size_t)row * D; v = row >> 12; }
                    else { xr = (l == 0 ? a.in[I_CTX] : (const float*)(ws + WS_XC1)) + (size_t)(row - NLAT) * D; v = 4; }
                    if (l != 0 && row < NLAT) norm_row_bf((const bf16_t*)a.out + (size_t)row * D, nw, MOD + (size_t)(l * 5 + v) * ADA, (bf16_t*)(ws + WS_H) + (size_t)row * D, lane);
                    else norm_row(xr, nw, MOD + (size_t)(l * 5 + v) * ADA, (bf16_t*)(ws + WS_H) + (size_t)row * D, lane);
                }
                __syncthreads();
                { int tid2 = threadIdx.x; asm volatile("" : "+v"(tid2)); lr_stage(ws, lds, l, tid2); }
                asm volatile("s_waitcnt vmcnt(0)" ::: "memory"); __builtin_amdgcn_fence(__ATOMIC_RELEASE, "workgroup"); __builtin_amdgcn_fence(__ATOMIC_ACQUIRE, "workgroup");
                __syncthreads();
                lr_rows(ws, lds, gw, NGW, lane);
                __syncthreads();
                } else {
                const int nfilt = ctx_out ? 768 : 0;
                for (int it = bid; it < nfilt; it += G) { int tid = threadIdx.x; asm volatile("" : "+v"(tid)); __syncthreads(); if (it < 256) filt_item2(a, ws, lds, l, it, tid); else filt_ctx_item(a, ws, lds, it - 256, tid);
#if defined(REP_ITEM) && REP_ITEM == 10
                    __syncthreads(); if (it < 256) filt_item2(a, ws, lds, l, it, tid);
#endif
                }
                __syncthreads();
                } }
            } else if (EN(3) && sub == 1) {
                pg8::Gemm g{(const bf16_t*)(ws + WS_H), (const bf16_t*)(ws + WS_WIN), MR, NPAD, D}; pg8::StaticOrder S; S.init(MR, NPAD, G, bid);
                EpiInProj E{(bf16_t*)(ws + WS_P), (bf16_t*)(ws + WS_PT), (float*)(ws + WS_LR), (const float*)(ws + WS_ROPE)};
                { pg8::InProjOrder S1; S1.init(ctx_out ? 0 : 1, G, bid); pg8::gemm_phase<EpiInProj, pg8::InProjOrder, true, true>(lds, g, S1, E, tid); }
            } else if (EN(5) && sub == 2) {
                const int nit = ctx_out ? 3744 : 3232;
                for (int it = bid; it < nit; it += G) {
                    int tid = threadIdx.x; asm volatile("" : "+v"(tid));
                    __syncthreads();
#ifdef REP_ITEM
                    { const int ty_ = it < 512 ? 0 : it < 1600 ? 1 : it < 2144 ? 2 : it < 3232 ? 3 : 4;
                      if (ty_ == REP_ITEM) { if (ty_ == 0) hyena_item2(a, ws, lds, l, it, tid, (bf16_t*)(ws + WS_H)); else if (ty_ == 1) s5_item<false>(a, ws, lds, l, (it - 512) >> 1, (it - 512) & 1, tid); else if (ty_ == 2) ret_passA(ws, lds, it - 1600, tid);
                          else if (ty_ == 3) gla_passA(a, ws, lds, l, it - 2144, tid); else hyena_ctx_item(a, ws, lds, it - 3232, tid);
                          __syncthreads(); asm volatile("" : "+v"(tid)); } }
#endif
                    if (it < 512) hyena_item2(a, ws, lds, l, it, tid, (bf16_t*)(ws + WS_PT) + (size_t)PT_V * MR);
                    else if (it < 1600) s5_item<false>(a, ws, lds, l, (it - 512) >> 1, (it - 512) & 1, tid);
                    else if (it < 2144) ret_passA(ws, lds, it - 1600, tid);
                    else if (it < 3232) gla_passA(a, ws, lds, l, it - 2144, tid);
                    else hyena_ctx_item(a, ws, lds, it - 3232, tid);
                }
            } else if (EN(9) && sub == 3) {
                for (int it = bid; it < 256; it += G) { int tid = threadIdx.x; asm volatile("" : "+v"(tid)); __syncthreads(); hy_transpose_item(ws, lds, it, tid, NLAT); }
                for (int it = bid; it < 224; it += G) { int tid = threadIdx.x; asm volatile("" : "+v"(tid)); __syncthreads();
                    if (it < 128) ret_passB(ws, it * NT + tid);
                    else if (it < 192) gla_passB(ws, lds, it - 128, tid);
                    else s5_passB(ws, l, (it - 192) * NT + tid); }
            } else if (EN(6) && sub == 4) {
                const int nsc = ctx_out ? 1088 : 1024, nrc = ctx_out ? 16 * RNCH : 16 * 32, ngc = ctx_out ? 16 * GNCH : 16 * 64;
                for (int it = bid; it < nsc; it += G) { int tid = threadIdx.x; asm volatile("" : "+v"(tid)); __syncthreads();
                    const int i2 = it >> 1; const int item = ctx_out ? i2 : (i2 >> 7) * (SNCH * 2) + 8 + (i2 & 127);
#if defined(REP_ITEM) && REP_ITEM == 5
                    s5_item<true>(a, ws, lds, l, item, it & 1, tid); __syncthreads(); asm volatile("" : "+v"(tid));
#endif
                    s5_item<true>(a, ws, lds, l, item, it & 1, tid); }
                for (int it = (bid + 64) % G; it < nrc; it += G) { int tid = threadIdx.x; asm volatile("" : "+v"(tid)); __syncthreads();
                    const int item = ctx_out ? it : (it >> 5) * RNCH + 2 + (it & 31);
#if defined(REP_ITEM) && REP_ITEM == 6
                    ret_passC(a, ws, lds, l, item, tid); __syncthreads(); asm volatile("" : "+v"(tid));
#endif
                    ret_passC(a, ws, lds, l, item, tid); }
                for (int it = (bid + 128) % G; it < ngc; it += G) { int tid = threadIdx.x; asm volatile("" : "+v"(tid)); __syncthreads();
                    const int item = ctx_out ? it : (it >> 6) * GNCH + 4 + (it & 63);
#if defined(REP_ITEM) && REP_ITEM == 7
                    gla_passC(a, ws, lds, l, item, tid); __syncthreads(); asm volatile("" : "+v"(tid));
#endif
                    gla_passC(a, ws, lds, l, item, tid); }
            } else if (EN(7) && sub == 5) {
                pg8::Gemm g{(const bf16_t*)(ws + WS_KF), (const bf16_t*)(ws + WS_GLUW), Mrows, 512, 512}; pg8::StaticOrder S; S.init(Mrows, 512, G, bid);
                EpiGlu E{(const bf16_t*)(ws + WS_KF) + OBSZ, (bf16_t*)(ws + WS_H), a.in[I_GLUB] + (size_t)l * 512};
                pg8::gemm_phase<EpiGlu, pg8::StaticOrder, true, true>(lds, g, S, E, tid);
                if (l == 0 && bid >= 136) {
                    LANE_WAVE(); LAS float* scr = (LAS float*)(lds + wave * 8704);
                    for (int r = (bid - 136) * NWAVES + wave; r < 32 * (NPAD / 32); r += (G - 136) * NWAVES) { const int kb = r / (NPAD / 32), nb = r % (NPAD / 32);
                        transpose_item(a.in[I_WIN] + (size_t)1 * D * INW, INW, win_srccol(nb * 32 + (lane & 31)), kb * 64, (bf16_t*)(ws + WS_WIN), D, nb * 32, scr, lane); }
                }
            } else if (EN(8)) {
                pg8::Gemm g{(const bf16_t*)(ws + WS_H), (const bf16_t*)(ws + WS_WOUT), Mrows, D, D}; pg8::StaticOrder S; S.init(Mrows, D, G, bid);
                EpiOut E{l == 0 ? a.in[I_X] : (const float*)nullptr, (const bf16_t*)a.out, a.in[I_CTX], l == 0 ? (bf16_t*)a.out : (bf16_t*)(ws + WS_P), (float*)(ws + WS_XC1), MOD + (size_t)l * 5 * ADA};
                pg8::gemm_phase<EpiOut, pg8::StaticOrder, true, true>(lds, g, S, E, tid);
                if (l == 0 && bid >= 32) {
                    for (int it = bid - 32; it < 256; it += G - 32) { int tid2 = threadIdx.x; asm volatile("" : "+v"(tid2)); __syncthreads(); filt_item2(a, ws, lds, 1, it, tid2); }
                }
            }
        }
#ifdef REP_SUB
        if (ph != PH_PREP && ph != PH_FNORM && ((ph - 1) % PH_PER_LAYER) == REP_SUB && ((REP_LMASK >> ((ph - 1) / PH_PER_LAYER)) & 1) && !((repmask >> ((ph - 1) / PH_PER_LAYER)) & 1)) { repmask |= 1 << ((ph - 1) / PH_PER_LAYER); xcd_barrier(gbar); --ph; continue; }
#endif
        if (ph + 1 < ka.ph_hi) xcd_barrier(gbar);
    }
}

#ifndef MK_LAUNCH_PER_PHASE
#define MK_LAUNCH_PER_PHASE 0
#endif
extern "C" void kernel_launch(void* const* d_in, const int* in_sizes, int n_in, void* d_out, int out_size, void* d_ws, size_t ws_size, hipStream_t stream) {
    static int grid = 0;
    if (grid == 0) {
        if (n_in != N_IN || out_size != NLAT * D || ws_size < WS_END2) { fprintf(stderr, "kernel_launch: unexpected shapes (n_in %d, out %d, ws %zu < %zu); nothing launched\n", n_in, out_size, ws_size, (size_t)WS_END2); grid = -1; return; }
        int dev = 0, cus = 0, per_cu = 0;
        if (hipGetDevice(&dev) != hipSuccess || hipDeviceGetAttribute(&cus, hipDeviceAttributeMultiprocessorCount, dev) != hipSuccess) { grid = -1; return; }
        if (hipFuncSetAttribute((const void*)fwd_kernel, hipFuncAttributeMaxDynamicSharedMemorySize, LDS_BYTES) != hipSuccess) { fprintf(stderr, "kernel_launch: hipFuncSetAttribute failed\n"); grid = -1; return; }
        if (hipOccupancyMaxActiveBlocksPerMultiprocessor(&per_cu, (const void*)fwd_kernel, NT, LDS_BYTES) != hipSuccess || per_cu < 1) { fprintf(stderr, "kernel_launch: occupancy query says %d blocks per CU\n", per_cu); per_cu = 1; }
        (void)hipGetLastError();
        grid = cus;
    }
    if (grid < 0) return;
    (void)hipMemsetAsync((char*)d_ws + WS_CTL, 0, WS_ZERO_BYTES, stream);
    Args a{};
    for (int i = 0; i < N_IN; ++i) a.in[i] = (const float*)d_in[i];
    a.out = (float*)d_out; a.ws = (unsigned char*)d_ws;
#if MK_LAUNCH_PER_PHASE
    for (int ph = 0; ph < N_PHASES; ++ph) {
        a.ph_lo = ph; a.ph_hi = ph + 1;
        hipLaunchKernelGGL(fwd_kernel, dim3(grid), dim3(NT), LDS_BYTES, stream, a);
    }
#else
    a.ph_lo = 0; a.ph_hi = N_PHASES;
    void* args[] = {&a};
    hipError_t e = hipLaunchCooperativeKernel((const void*)fwd_kernel, dim3(grid), dim3(NT), args, LDS_BYTES, stream);
    if (e != hipSuccess) fprintf(stderr, "kernel_launch: cooperative launch failed: %s (grid %d)\n", hipGetErrorString(e), grid);
#endif
}
```
